# Optimizing an MI355X kernel written in HIP

```python
import math
import jax, jax.numpy as jnp
from jax import lax
import numpy as np

D_MODEL = 2048
BATCH = 8
SEQ = 4096
DEPTH = 4

N_BRANCH = 4
BRANCH_W = D_MODEL // 4
RET_HEADS = 4
RET_DK = BRANCH_W // (2 * RET_HEADS)
RET_DV = BRANCH_W // RET_HEADS
RET_CHUNK = 128
ROPE_BASE = 10000.0
S5_GROUP = 16
S5_GROUPS = BRANCH_W // S5_GROUP
S5_STATE = 64
GLA_HEADS = 4
GLA_DK = BRANCH_W // (2 * GLA_HEADS)
GLA_DV = BRANCH_W // GLA_HEADS
GLA_RANK = 16
GLA_GATE_TEMP = 16.0
GLA_CHUNK = 16
POOL_WINDOWS = (2, 4, 8, 16)
POOL_GROUP = BRANCH_W // len(POOL_WINDOWS)
POOL_PAD = max(POOL_WINDOWS)
D_FF = 5504
CONV_W = 3
EPS = 1e-6

IN_SIZES = (
    RET_HEADS * RET_DK, RET_HEADS * RET_DK, RET_HEADS * RET_DV, BRANCH_W,
    BRANCH_W,
    GLA_HEADS * GLA_DK, GLA_HEADS * GLA_DK, GLA_HEADS * GLA_DV, BRANCH_W, GLA_RANK,
    BRANCH_W,
    N_BRANCH * D_MODEL,
)
N_IN = sum(IN_SIZES)

kernel_name = 'hybrid_gated_parallel_mixer'


def _split_points():
    pts, acc = [], 0
    for s in IN_SIZES[:-1]:
        acc += s
        pts.append(acc)
    return pts


def rmsnorm(x, g):
    xf = x.astype(jnp.float32)
    r = lax.rsqrt(jnp.mean(xf * xf, axis=-1, keepdims=True) + EPS)
    return (xf * r * g.astype(jnp.float32)).astype(x.dtype)


def head_norm(o):
    mu = jnp.mean(o, axis=-1, keepdims=True)
    var = jnp.mean(jnp.square(o - mu), axis=-1, keepdims=True)
    return (o - mu) * lax.rsqrt(var + EPS)


def rotary(x, positions):
    d = x.shape[-1]
    inv = ROPE_BASE ** (-jnp.arange(0, d, 2, dtype=jnp.float32) / d)
    ang = positions.astype(jnp.float32)[..., None] * inv
    cos = jnp.cos(ang)[:, :, None, :]
    sin = jnp.sin(ang)[:, :, None, :]
    x1, x2 = x[..., : d // 2], x[..., d // 2:]
    return jnp.concatenate([x1 * cos - x2 * sin, x1 * sin + x2 * cos], axis=-1)


def retention(q, k, v):
    B_, S_, H, dk = q.shape
    dv = v.shape[-1]
    C = RET_CHUNK
    n = S_ // C
    log_g = jnp.log(1.0 - 2.0 ** (-5.0 - jnp.arange(H, dtype=jnp.float32)))
    q = q.reshape(B_, n, C, H, dk)
    k = k.reshape(B_, n, C, H, dk)
    v = v.reshape(B_, n, C, H, dv)
    idx = jnp.arange(C, dtype=jnp.float32)
    rel = idx[:, None] - idx[None, :]
    causal = rel >= 0
    decay = jnp.where(causal[None], jnp.exp(jnp.where(causal, rel, 0.0)[None] * log_g[:, None, None]), 0.0)
    scores = jnp.einsum('bnthd,bnshd->bnhts', q, k) * decay
    intra = jnp.einsum('bnhts,bnshe->bnthe', scores, v)
    k_dec = k * jnp.exp((C - 1.0 - idx)[:, None] * log_g[None, :])[None, None, :, :, None]
    chunk_state = jnp.einsum('bnshd,bnshe->nbhde', k_dec, v)
    chunk_decay = jnp.exp(C * log_g)[None, :, None, None]

    def step(R, s):
        return chunk_decay * R + s, R

    _, R_prev = lax.scan(step, jnp.zeros((B_, H, dk, dv), jnp.float32), chunk_state)
    q_dec = q * jnp.exp((idx + 1.0)[:, None] * log_g[None, :])[None, None, :, :, None]
    cross = jnp.einsum('bnthd,nbhde->bnthe', q_dec, R_prev)
    return (intra + cross).reshape(B_, S_, H, dv)


def s5_branch(u, a_re, a_im, log_dt, b_re, b_im, c_re, c_im, d_skip, w_glu):
    B_, S_, _ = u.shape
    ug = u.reshape(B_, S_, S5_GROUPS, S5_GROUP)
    a_re = a_re.astype(jnp.float32)
    a_im = a_im.astype(jnp.float32)
    dt = jnp.exp(log_dt.astype(jnp.float32))[:, None]
    mag = jnp.exp(a_re * dt)
    abar_re = mag * jnp.cos(a_im * dt)
    abar_im = mag * jnp.sin(a_im * dt)
    den = a_re * a_re + a_im * a_im
    nr, ni = abar_re - 1.0, abar_im
    f_re = (nr * a_re + ni * a_im) / den
    f_im = (ni * a_re - nr * a_im) / den
    b_re = b_re.astype(jnp.float32)
    b_im = b_im.astype(jnp.float32)
    bb_re = f_re[..., None] * b_re - f_im[..., None] * b_im
    bb_im = f_re[..., None] * b_im + f_im[..., None] * b_re
    bu_re = jnp.einsum('bsgc,gpc->bsgp', ug, bb_re)
    bu_im = jnp.einsum('bsgc,gpc->bsgp', ug, bb_im)
    ar = jnp.broadcast_to(abar_re[None, None], bu_re.shape)
    ai = jnp.broadcast_to(abar_im[None, None], bu_re.shape)

    def combine(l, r):
        ar1, ai1, br1, bi1 = l
        ar2, ai2, br2, bi2 = r
        return (ar2 * ar1 - ai2 * ai1, ar2 * ai1 + ai2 * ar1,
                ar2 * br1 - ai2 * bi1 + br2, ar2 * bi1 + ai2 * br1 + bi2)

    _, _, xr, xi = lax.associative_scan(combine, (ar, ai, bu_re, bu_im), axis=1)
    y = jnp.einsum('bsgp,gcp->bsgc', xr, c_re) - jnp.einsum('bsgp,gcp->bsgc', xi, c_im)
    y = y + d_skip.reshape(S5_GROUPS, S5_GROUP) * ug
    y = jax.nn.gelu(y.reshape(B_, S_, BRANCH_W))
    return y * jax.nn.sigmoid(y @ w_glu)


def gla(q, k, v, log_a):
    B_, S_, H, dk = q.shape
    dv = v.shape[-1]
    C = GLA_CHUNK
    n = S_ // C
    q = q.reshape(B_, n, C, H, dk)
    k = k.reshape(B_, n, C, H, dk)
    v = v.reshape(B_, n, C, H, dv)
    b = jnp.cumsum(log_a.reshape(B_, n, C, H, dk), axis=2)
    idx = jnp.arange(C)
    mask = (idx[:, None] >= idx[None, :])[None, None, :, :, None, None]
    diff = b[:, :, :, None] - b[:, :, None, :]
    w = jnp.where(mask, jnp.exp(jnp.where(mask, diff, 0.0)), 0.0)
    scores = jnp.einsum('bnthd,bnshd,bntshd->bnhts', q, k, w)
    intra = jnp.einsum('bnhts,bnshe->bnthe', scores, v)
    b_last = b[:, :, -1]
    k_dec = k * jnp.exp(b_last[:, :, None] - b)
    chunk_state = jnp.einsum('bnshd,bnshe->nbhde', k_dec, v)
    chunk_decay = jnp.moveaxis(jnp.exp(b_last), 1, 0)

    def step(Sst, inp):
        s_in, dec = inp
        return dec[..., None] * Sst + s_in, Sst

    _, S_prev = lax.scan(step, jnp.zeros((B_, H, dk, dv), jnp.float32), (chunk_state, chunk_decay))
    cross = jnp.einsum('bnthd,nbhde->bnthe', q * jnp.exp(b), S_prev)
    return (intra + cross).reshape(B_, S_, H, dv)


def pool_branch(p, pool_w, pool_scale):
    B_, S_, _ = p.shape
    G = len(POOL_WINDOWS)
    pg = p.reshape(B_, S_, G, POOL_GROUP)
    cs = jnp.cumsum(pg, axis=1)
    cs_pad = jnp.concatenate([jnp.zeros((B_, POOL_PAD, G, POOL_GROUP), cs.dtype), cs], axis=1)
    pos1 = jnp.arange(S_, dtype=jnp.float32) + 1.0
    means = []
    for g, win in enumerate(POOL_WINDOWS):
        prev = cs_pad[:, POOL_PAD - win: POOL_PAD - win + S_, g]
        cnt = jnp.minimum(pos1, float(win))[None, :, None]
        means.append((cs[:, :, g] - prev) / cnt)
    mixed = jnp.stack(means, axis=2) - pg
    out = jnp.einsum('bsgc,gcd->bsgd', mixed, pool_w).reshape(B_, S_, BRANCH_W)
    return out * pool_scale


def hybrid_mixer(h, positions, w_in, s5_a_re, s5_a_im, s5_log_dt, s5_b_re, s5_b_im, s5_c_re, s5_c_im,
                 s5_d, s5_w_glu, gla_w_gate, gla_b_gate, pool_w, pool_scale, w_branch, w_out):
    B_, S_, _ = h.shape
    proj = (h @ w_in).astype(jnp.float32)
    rq, rk, rv, rg, su, gq, gk, gv, gg, gr, pu, gate_logits = jnp.split(proj, _split_points(), axis=-1)
    rq = rotary(rq.reshape(B_, S_, RET_HEADS, RET_DK), positions)
    rk = rotary(rk.reshape(B_, S_, RET_HEADS, RET_DK), positions) * (RET_DK ** -0.5)
    ra = retention(rq, rk, rv.reshape(B_, S_, RET_HEADS, RET_DV))
    ya = head_norm(ra).reshape(B_, S_, BRANCH_W) * jax.nn.silu(rg)
    yb = s5_branch(su, s5_a_re, s5_a_im, s5_log_dt, s5_b_re, s5_b_im, s5_c_re, s5_c_im, s5_d, s5_w_glu)
    log_a = jax.nn.log_sigmoid(gr @ gla_w_gate + gla_b_gate) / GLA_GATE_TEMP
    gc = gla(gq.reshape(B_, S_, GLA_HEADS, GLA_DK) * (GLA_DK ** -0.5),
             gk.reshape(B_, S_, GLA_HEADS, GLA_DK),
             gv.reshape(B_, S_, GLA_HEADS, GLA_DV),
             log_a.reshape(B_, S_, GLA_HEADS, GLA_DK))
    yc = head_norm(gc).reshape(B_, S_, BRANCH_W) * jax.nn.silu(gg)
    yd = pool_branch(pu, pool_w, pool_scale)
    branches = jnp.stack([ya, yb, yc, yd], axis=2)
    up = jnp.einsum('bsnc,ncd->bsnd', branches, w_branch)
    gates = jax.nn.sigmoid(gate_logits.reshape(B_, S_, N_BRANCH, D_MODEL))
    merged = jnp.sum(gates * up, axis=2)
    return merged @ w_out


def conv_ffn(h, w_up, conv_w, conv_b, w_down):
    S_ = h.shape[1]
    u = h @ w_up
    up = jnp.pad(u, ((0, 0), (CONV_W - 1, 0), (0, 0)))
    uc = conv_b + up[:, 0:S_] * conv_w[0] + up[:, 1:S_ + 1] * conv_w[1] + up[:, 2:S_ + 2] * conv_w[2]
    a, v = jnp.split(uc, 2, axis=-1)
    return (jax.nn.silu(a) * v) @ w_down


def setup_inputs(seed: int = 0) -> dict:
    key = jax.random.key(seed)
    ks = jax.random.split(key, 32)
    f32 = jnp.float32
    L = DEPTH

    def nrm(k, shape, scale):
        return jax.random.normal(k, shape, f32) * scale

    x = nrm(ks[0], (BATCH, SEQ, D_MODEL), 1.0)
    offsets = jax.random.randint(ks[1], (BATCH, 1), 0, 1024, dtype=jnp.int32)
    positions = offsets + jnp.arange(SEQ, dtype=jnp.int32)[None, :]
    norm_mix_g = 1.0 + nrm(ks[2], (L, D_MODEL), 0.02)
    w_in = nrm(ks[3], (L, D_MODEL, N_IN), D_MODEL ** -0.5)
    n_idx = jnp.arange(S5_STATE, dtype=f32)
    s5_a_re = -0.5 + nrm(ks[4], (L, S5_GROUPS, S5_STATE), 0.01)
    s5_a_im = math.pi * n_idx + nrm(ks[5], (L, S5_GROUPS, S5_STATE), 0.01)
    s5_log_dt = jax.random.uniform(ks[6], (L, S5_GROUPS), f32, math.log(1e-3), math.log(1e-1))
    s5_b_re = nrm(ks[7], (L, S5_GROUPS, S5_STATE, S5_GROUP), (2.0 * S5_GROUP) ** -0.5)
    s5_b_im = nrm(ks[8], (L, S5_GROUPS, S5_STATE, S5_GROUP), (2.0 * S5_GROUP) ** -0.5)
    s5_c_re = nrm(ks[9], (L, S5_GROUPS, S5_GROUP, S5_STATE), 2.0 ** -0.5)
    s5_c_im = nrm(ks[10], (L, S5_GROUPS, S5_GROUP, S5_STATE), 2.0 ** -0.5)
    s5_d = nrm(ks[11], (L, BRANCH_W), 1.0)
    s5_w_glu = nrm(ks[12], (L, BRANCH_W, BRANCH_W), BRANCH_W ** -0.5)
    gla_w_gate = nrm(ks[13], (L, GLA_RANK, GLA_HEADS * GLA_DK), GLA_RANK ** -0.5)
    gla_b_gate = nrm(ks[14], (L, GLA_HEADS * GLA_DK), 0.01)
    pool_w = nrm(ks[15], (L, len(POOL_WINDOWS), POOL_GROUP, POOL_GROUP), POOL_GROUP ** -0.5)
    pool_scale = 1.0 + nrm(ks[16], (L, BRANCH_W), 0.1)
    w_branch = nrm(ks[17], (L, N_BRANCH, BRANCH_W, D_MODEL), BRANCH_W ** -0.5)
    w_out = nrm(ks[18], (L, D_MODEL, D_MODEL), D_MODEL ** -0.5)
    norm_ffn_g = 1.0 + nrm(ks[19], (L, D_MODEL), 0.02)
    w_up = nrm(ks[20], (L, D_MODEL, 2 * D_FF), D_MODEL ** -0.5)
    conv_w = nrm(ks[21], (L, CONV_W, 2 * D_FF), CONV_W ** -0.5)
    conv_b = nrm(ks[22], (L, 2 * D_FF), 0.01)
    w_down = nrm(ks[23], (L, D_FF, D_MODEL), D_FF ** -0.5)
    final_g = 1.0 + nrm(ks[24], (D_MODEL,), 0.02)
    return {'x': x, 'positions': positions, 'norm_mix_g': norm_mix_g, 'w_in': w_in,
            's5_a_re': s5_a_re, 's5_a_im': s5_a_im, 's5_log_dt': s5_log_dt,
            's5_b_re': s5_b_re, 's5_b_im': s5_b_im, 's5_c_re': s5_c_re, 's5_c_im': s5_c_im,
            's5_d': s5_d, 's5_w_glu': s5_w_glu, 'gla_w_gate': gla_w_gate, 'gla_b_gate': gla_b_gate,
            'pool_w': pool_w, 'pool_scale': pool_scale, 'w_branch': w_branch, 'w_out': w_out,
            'norm_ffn_g': norm_ffn_g, 'w_up': w_up, 'conv_w': conv_w, 'conv_b': conv_b,
            'w_down': w_down, 'final_g': final_g}


def reference(x, positions, norm_mix_g, w_in, s5_a_re, s5_a_im, s5_log_dt, s5_b_re, s5_b_im,
              s5_c_re, s5_c_im, s5_d, s5_w_glu, gla_w_gate, gla_b_gate, pool_w, pool_scale,
              w_branch, w_out, norm_ffn_g, w_up, conv_w, conv_b, w_down, final_g):
    h = x
    for l in range(DEPTH):
        hn = rmsnorm(h, norm_mix_g[l])
        mix = hybrid_mixer(hn, positions, w_in[l], s5_a_re[l], s5_a_im[l], s5_log_dt[l],
                           s5_b_re[l], s5_b_im[l], s5_c_re[l], s5_c_im[l], s5_d[l], s5_w_glu[l],
                           gla_w_gate[l], gla_b_gate[l], pool_w[l], pool_scale[l], w_branch[l], w_out[l])
        h = h + mix.astype(h.dtype)
        hn = rmsnorm(h, norm_ffn_g[l])
        h = h + conv_ffn(hn, w_up[l], conv_w[l], conv_b[l], w_down[l]).astype(h.dtype)
    return rmsnorm(h, final_g)
```

```cpp
#include <hip/hip_runtime.h>
#include <cstdio>
#include <cstdint>

#ifndef MK_SINGLE
#define MK_SINGLE 1
#endif

#define LAS __attribute__((address_space(3)))
#define GAS __attribute__((address_space(1)))
typedef unsigned short bf16_t;
typedef short bf16x8 __attribute__((ext_vector_type(8)));
typedef float f32x4 __attribute__((ext_vector_type(4)));
typedef float f32x2 __attribute__((ext_vector_type(2)));
typedef unsigned u32x4 __attribute__((ext_vector_type(4)));
typedef unsigned u32x2 __attribute__((ext_vector_type(2)));

constexpr int D = 2048, BATCH = 8, SEQ = 4096, DEPTH = 4, M = BATCH * SEQ;
constexpr int BW = 512;
constexpr int NIN_SRC = 12304, NIN = 12544;
constexpr int DFF = 5504, NUP = 11008;
constexpr int C_RQ = 0, C_RK = 256, C_RV = 512, C_RG = 1024, C_SU = 1536, C_GQ = 2048, C_GK = 2304, C_GV = 2560, C_GG = 3072, C_PU = 3584, C_GR = 4096, C_GATE = 4352;
constexpr float EPS = 1e-6f;
constexpr int NWAVES = 8;
constexpr int CH = 64;
constexpr int NCH = SEQ / CH;

constexpr size_t MiB = 1u << 20;
constexpr size_t WS_CTL = 0, CTL_ZERO_BYTES = 1 * MiB;
constexpr size_t WS_ROT = 1 * MiB;
constexpr size_t WS_S5T = 9 * MiB;
constexpr size_t S5T_ABAR = 0, S5T_APOW = 16384, S5T_BBAR = 32768, S5T_CMT = 32768 + 262144;
constexpr size_t WS_WGLU = 10 * MiB;
constexpr size_t WS_POOLW = 10 * MiB + 512 * 1024;
constexpr size_t WS_WIN = 11 * MiB;
constexpr size_t WS_WBR = 60 * MiB;
constexpr size_t WS_WOUT = 68 * MiB;
constexpr size_t WS_WUP = 76 * MiB;
constexpr size_t WS_WDN = 119 * MiB;
constexpr size_t WS_HN = 141 * MiB;
constexpr size_t WS_Y = 269 * MiB;
constexpr size_t WS_SCR = 397 * MiB;
constexpr size_t WS_YBP = WS_SCR;
constexpr size_t WS_STATE = WS_SCR + 32 * MiB;
constexpr size_t WS_SPREV = WS_SCR + 160 * MiB;
constexpr size_t WS_DEC = WS_SCR + 224 * MiB;
constexpr size_t WS_XEND = WS_SCR + 225 * MiB;
constexpr size_t WS_PROJ = 637 * MiB;
constexpr size_t WS_ACT = WS_HN;
constexpr size_t WS_END = 1421 * MiB;
static_assert(WS_PROJ + (size_t)M * NIN * 2 <= WS_END, "ws map");
static_assert(WS_ACT + (size_t)M * DFF * 2 <= WS_PROJ, "ws map");
static_assert(WS_XEND + 8 * MiB <= WS_PROJ, "ws map");
constexpr int CW_TMO = 0, CW_BAR = 4096;

constexpr int LDS_BYTES = 155648;
constexpr int MISC_OFF = LDS_BYTES - 256;

#define RLX_AGENT __ATOMIC_RELAXED, __HIP_MEMORY_SCOPE_AGENT
#define LDS_WAIT() asm volatile("s_waitcnt lgkmcnt(0)" ::: "memory")
#define VM_WAIT() asm volatile("s_waitcnt vmcnt(0)" ::: "memory")
__device__ __forceinline__ unsigned f2bf(float f) { unsigned u = __builtin_bit_cast(unsigned, f); return (u + 0x7fffu + ((u >> 16) & 1u)) >> 16; }
__device__ __forceinline__ unsigned pk2(float lo, float hi) { return f2bf(lo) | (f2bf(hi) << 16); }
__device__ __forceinline__ float bflo(unsigned w) { return __builtin_bit_cast(float, w << 16); }
__device__ __forceinline__ float bfhi(unsigned w) { return __builtin_bit_cast(float, w & 0xffff0000u); }
__device__ __forceinline__ void unpack8(const u32x4 w, float (&v)[8]) { v[0] = bflo(w.x); v[1] = bfhi(w.x); v[2] = bflo(w.y); v[3] = bfhi(w.y); v[4] = bflo(w.z); v[5] = bfhi(w.z); v[6] = bflo(w.w); v[7] = bfhi(w.w); }
__device__ __forceinline__ u32x4 pack8(const float (&v)[8]) { u32x4 w; w.x = pk2(v[0], v[1]); w.y = pk2(v[2], v[3]); w.z = pk2(v[4], v[5]); w.w = pk2(v[6], v[7]); return w; }
__device__ __forceinline__ float sigmoidf_(float x) { return 1.0f / (1.0f + __expf(-x)); }
__device__ __forceinline__ float siluf_(float x) { return x / (1.0f + __expf(-x)); }
__device__ __forceinline__ float gelu_tanh(float x) { const float u = 1.5957691216f * (x + 0.044715f * x * x * x); return x / (1.0f + __expf(-u)); }
__device__ __forceinline__ float logsigmoidf_(float x) { return fminf(x, 0.f) - log1pf(__expf(-fabsf(x))); }

namespace pg8 {
constexpr int BM = 256, BK = 64, HALF = 128, HTB = HALF * BK * 2, STAGE_BYTES = 8 * HTB, NXCD = 8, WGM = 8;
__host__ __device__ __forceinline__ int lds_byte(int r, int c) { const int st = (r >> 4) * 2 + (c >> 5), rr = r & 15, cc = c & 31, ob = rr * 64 + cc * 2; return st * 1024 + (ob ^ (((ob >> 9) & 1) << 5)); }
__host__ __device__ __forceinline__ void stage_rc(int b, int& R, int& C) { const int st = b / 1024, sb = b % 1024, swz = sb ^ (((sb >> 9) & 1) << 5); R = (st >> 1) * 16 + swz / 64; C = (st & 1) * 32 + (swz % 64) / 2; }
__host__ __device__ __forceinline__ int perm32(int rho) { const int n = rho >> 4, i = rho & 15; return 8 * (i >> 2) + 4 * n + (i & 3); }

struct Unit { int pm, pn; };
struct Gemm { const bf16_t* A; const bf16_t* Bt; int M, N, K, lda, ldb; };

struct StaticOrder {
    int nM, nN, nwg, G, c;
    __host__ __device__ void init(int M_, int N_, int G_, int c_) { nM = M_ / BM; nN = N_ / BM; nwg = nM * nN; G = G_; c = c_; }
    __host__ __device__ bool next(int i, Unit& u) const {
        const long L = (long)i * G + c; if (L >= nwg) return false;
        int wgid = (int)L; { const int q = nwg / NXCD, r = nwg % NXCD, xcd = wgid % NXCD, off = wgid / NXCD; wgid = (xcd < r ? xcd * (q + 1) : r * (q + 1) + (xcd - r) * q) + off; }
        const int nig = WGM * nN, gid = wgid / nig, fm = gid * WGM, gsz = (nM - fm) < WGM ? (nM - fm) : WGM;
        u.pm = fm + ((wgid % nig) % gsz); u.pn = (wgid % nig) / gsz; return true;
    }
};

__device__ __forceinline__ unsigned cvt_pk_bf16(float lo, float hi) { unsigned r; asm volatile("v_cvt_pk_bf16_f32 %0, %1, %2" : "=v"(r) : "v"(lo), "v"(hi)); return r; }

struct EpiStoreBf16 {
    static constexpr bool PERM = true, KHOOK = false;
    bf16_t* O; int ldc;
    __device__ __forceinline__ void khook(f32x4 (&)[2][2][4][2], const Unit&, int, int, int, int, int) const {}
    __device__ __forceinline__ void operator()(const f32x4 (&acc)[2][2][4][2], const Unit& u, int wr, int wc, int fr, int fq) const {
        const int row0 = u.pm * BM + wr * 64 + fr, col0 = u.pn * BM + wc * 32 + 8 * fq;
#pragma unroll
        for (int ai = 0; ai < 2; ++ai)
#pragma unroll
            for (int m = 0; m < 4; ++m) { bf16_t* rowp = O + (size_t)(row0 + ai * HALF + m * 16) * ldc + col0;
#pragma unroll
                for (int bj = 0; bj < 2; ++bj) { const f32x4 v0 = acc[ai][bj][m][0], v1 = acc[ai][bj][m][1];
                    u32x4 w; w.x = cvt_pk_bf16(v0[0], v0[1]); w.y = cvt_pk_bf16(v0[2], v0[3]); w.z = cvt_pk_bf16(v1[0], v1[1]); w.w = cvt_pk_bf16(v1[2], v1[3]);
                    *(u32x4*)(rowp + bj * HALF) = w; } }
    }
};
struct EpiResid {
    static constexpr bool PERM = false, KHOOK = false;
    const float* base; float* out; int ldc;
    __device__ __forceinline__ void khook(f32x4 (&)[2][2][4][2], const Unit&, int, int, int, int, int) const {}
    __device__ __forceinline__ void operator()(const f32x4 (&acc)[2][2][4][2], const Unit& u, int wr, int wc, int fr, int fq) const {
        const int row0 = u.pm * BM + wr * 64 + fr, col0 = u.pn * BM + wc * 32 + 4 * fq;
#pragma unroll
        for (int ai = 0; ai < 2; ++ai)
#pragma unroll
            for (int m = 0; m < 4; ++m) { const size_t off = (size_t)(row0 + ai * HALF + m * 16) * ldc + col0;
#pragma unroll
                for (int bj = 0; bj < 2; ++bj)
#pragma unroll
                    for (int n = 0; n < 2; ++n) { const f32x4 bs = *(const f32x4*)(base + off + bj * HALF + n * 16); *(f32x4*)(out + off + bj * HALF + n * 16) = bs + acc[ai][bj][m][n]; }
                asm volatile("" ::: "memory"); }
    }
};
struct EpiGlu {
    static constexpr bool PERM = true, KHOOK = false;
    const bf16_t* Yp; int ldy; bf16_t* O; int ldc;
    __device__ __forceinline__ void khook(f32x4 (&)[2][2][4][2], const Unit&, int, int, int, int, int) const {}
    __device__ __forceinline__ void operator()(const f32x4 (&acc)[2][2][4][2], const Unit& u, int wr, int wc, int fr, int fq) const {
        const int row0 = u.pm * BM + wr * 64 + fr, col0 = u.pn * BM + wc * 32 + 8 * fq;
#pragma unroll
        for (int ai = 0; ai < 2; ++ai)
#pragma unroll
            for (int m = 0; m < 4; ++m) { const size_t r = (size_t)(row0 + ai * HALF + m * 16);
#pragma unroll
                for (int bj = 0; bj < 2; ++bj) { const u32x4 yw = *(const u32x4*)(Yp + r * ldy + col0 + bj * HALF); float y[8]; unpack8(yw, y);
                    const f32x4 v0 = acc[ai][bj][m][0], v1 = acc[ai][bj][m][1]; float o[8];
#pragma unroll
                    for (int j = 0; j < 4; ++j) { o[j] = y[j] * sigmoidf_(v0[j]); o[4 + j] = y[4 + j] * sigmoidf_(v1[j]); }
                    u32x4 w; w.x = cvt_pk_bf16(o[0], o[1]); w.y = cvt_pk_bf16(o[2], o[3]); w.z = cvt_pk_bf16(o[4], o[5]); w.w = cvt_pk_bf16(o[6], o[7]);
                    *(u32x4*)(O + r * ldc + col0 + bj * HALF) = w; } }
    }
};
struct EpiMerge {
    static constexpr bool PERM = true, KHOOK = true;
    const bf16_t* G; int ldg; bf16_t* O; int ldc;
    __device__ __forceinline__ void khook(f32x4 (&acc)[2][2][4][2], const Unit& u, int seg, int wr, int wc, int fr, int fq) const {
        int row0 = u.pm * BM + wr * 64 + fr, col0 = u.pn * BM + wc * 32 + 8 * fq; asm volatile("" : "+v"(row0), "+v"(col0));
#pragma unroll
        for (int ai = 0; ai < 2; ++ai)
#pragma unroll
            for (int m = 0; m < 4; ++m) { const bf16_t* gp = G + (size_t)(row0 + ai * HALF + m * 16) * ldg + col0;
#pragma unroll
                for (int bj = 0; bj < 2; ++bj) { const u32x4 w0 = *(const u32x4*)(gp + (seg - 1) * D + bj * HALF), w1 = *(const u32x4*)(gp + seg * D + bj * HALF);
                    float a[8], b[8]; unpack8(w0, a); unpack8(w1, b);
#pragma unroll
                    for (int j = 0; j < 8; ++j) { const float ea = __expf(-fminf(fmaxf(a[j], -30.f), 30.f)), eb = __expf(-fminf(fmaxf(b[j], -30.f), 30.f));
                        const float ratio = (1.0f + eb) * __builtin_amdgcn_rcpf(1.0f + ea); acc[ai][bj][m][j >> 2][j & 3] *= ratio; } } }
    }
    __device__ __forceinline__ void operator()(const f32x4 (&acc)[2][2][4][2], const Unit& u, int wr, int wc, int fr, int fq) const {
        const int row0 = u.pm * BM + wr * 64 + fr, col0 = u.pn * BM + wc * 32 + 8 * fq;
#pragma unroll
        for (int ai = 0; ai < 2; ++ai)
#pragma unroll
            for (int m = 0; m < 4; ++m) { const size_t r = (size_t)(row0 + ai * HALF + m * 16);
#pragma unroll
                for (int bj = 0; bj < 2; ++bj) { const u32x4 gw = *(const u32x4*)(G + r * ldg + 3 * D + col0 + bj * HALF); float gl[8]; unpack8(gw, gl);
                    const f32x4 v0 = acc[ai][bj][m][0], v1 = acc[ai][bj][m][1]; float o[8];
#pragma unroll
                    for (int j = 0; j < 4; ++j) { o[j] = v0[j] * __builtin_amdgcn_rcpf(1.0f + __expf(-fminf(fmaxf(gl[j], -30.f), 30.f))); o[4 + j] = v1[j] * __builtin_amdgcn_rcpf(1.0f + __expf(-fminf(fmaxf(gl[4 + j], -30.f), 30.f))); }
                    u32x4 w; w.x = cvt_pk_bf16(o[0], o[1]); w.y = cvt_pk_bf16(o[2], o[3]); w.z = cvt_pk_bf16(o[4], o[5]); w.w = cvt_pk_bf16(o[6], o[7]);
                    *(u32x4*)(O + r * ldc + col0 + bj * HALF) = w; } }
    }
};

template <class Epi>
__device__ __forceinline__ void gemm_phase(LAS unsigned char* lds, const Gemm g, const StaticOrder& S, const Epi& E) {
    int tid_ = threadIdx.x; asm volatile("" : "+v"(tid_));
    const int tid = tid_, wid = __builtin_amdgcn_readfirstlane(tid >> 6), lane = tid & 63, wr = wid >> 2, wc = wid & 3, fr = lane & 15, fq = lane >> 4;
    const int K = g.K, nt = K / BK;
    unsigned voffA[2], voffB[2];
#pragma unroll
    for (int i = 0; i < 2; ++i) { int R, C; stage_rc(tid * 16 + i * 8192, R, C); const int Rb = Epi::PERM ? ((R & ~31) + perm32(R & 31)) : R;
        voffA[i] = (unsigned)(R * g.lda + C) * 2u; voffB[i] = (unsigned)(Rb * g.ldb + C) * 2u; }
    const size_t kstep = (size_t)(BK * 2);
    const size_t hstepA = (size_t)HALF * g.lda * 2, hstepB = (size_t)HALF * g.ldb * 2;
    const size_t tstepA = 2 * hstepA, tstepB = 2 * hstepB;
    const unsigned ldsw = (unsigned)wid * 1024u;
    const int aoff = lds_byte(wr * 64 + fr, fq * 8), boff = lds_byte(wc * 32 + fr, fq * 8);
#define PG8_SA(b, h) (((b) * 2 + (h)) * HTB)
#define PG8_SB(b, h) ((4 + (b) * 2 + (h)) * HTB)
#define PG8_STAGE(bufoff, gbase, voff) do { _Pragma("unroll") for (int _i = 0; _i < 2; ++_i) \
        __builtin_amdgcn_global_load_lds((const unsigned*)((const char*)(gbase) + (voff)[_i]), (LAS unsigned*)(lds + (bufoff) + ldsw + _i * 8192), 16, 0, 0); } while (0)
#define PG8_LDA(dst, b, h) do { _Pragma("unroll") for (int m = 0; m < 4; ++m) _Pragma("unroll") for (int k = 0; k < 2; ++k) dst[m][k] = *(const LAS bf16x8*)(lds + PG8_SA(b, h) + aoff + m * 2048 + k * 1024); } while (0)
#define PG8_LDB(dst, b, h) do { _Pragma("unroll") for (int n = 0; n < 2; ++n) _Pragma("unroll") for (int k = 0; k < 2; ++k) dst[n][k] = *(const LAS bf16x8*)(lds + PG8_SB(b, h) + boff + n * 2048 + k * 1024); } while (0)
#define PG8_MMA(ai, bj, At, Bt) do { __builtin_amdgcn_s_setprio(1); _Pragma("unroll") for (int m = 0; m < 4; ++m) _Pragma("unroll") for (int n = 0; n < 2; ++n) _Pragma("unroll") for (int k = 0; k < 2; ++k) \
        acc[ai][bj][m][n] = __builtin_amdgcn_mfma_f32_16x16x32_bf16(Bt[n][k], At[m][k], acc[ai][bj][m][n], 0, 0, 0); __builtin_amdgcn_s_setprio(0); } while (0)
#define PG8_WAIT_V(n) asm volatile("s_waitcnt vmcnt(" #n ")" ::: "memory")
#define PG8_WAIT_L(n) asm volatile("s_waitcnt lgkmcnt(" #n ")" ::: "memory")
#define PG8_BAR __builtin_amdgcn_s_barrier()
#define PG8_SCHED __builtin_amdgcn_sched_barrier(0)
    Unit cur, nxt; int ui = 0;
    if (!S.next(0, cur)) return;
    f32x4 acc[2][2][4][2];
#pragma unroll
    for (int a = 0; a < 2; ++a)
#pragma unroll
        for (int b = 0; b < 2; ++b)
#pragma unroll
            for (int m = 0; m < 4; ++m)
#pragma unroll
                for (int n = 0; n < 2; ++n) acc[a][b][m][n] = (f32x4){0.f, 0.f, 0.f, 0.f};
    bf16x8 At[4][2], B0[2][2], B1[2][2];
    const char* cA = (const char*)g.A + (size_t)cur.pm * tstepA; const char* cB = (const char*)g.Bt + (size_t)cur.pn * tstepB;
    PG8_STAGE(PG8_SB(0, 0), cB, voffB); PG8_STAGE(PG8_SB(0, 1), cB + hstepB, voffB); PG8_STAGE(PG8_SA(0, 0), cA, voffA); PG8_STAGE(PG8_SA(0, 1), cA + hstepA, voffA);
    if (wr == 1) PG8_BAR;
    PG8_WAIT_V(2); PG8_BAR;
    PG8_STAGE(PG8_SB(1, 0), cB + kstep, voffB); PG8_STAGE(PG8_SA(1, 0), cA + kstep, voffA); PG8_STAGE(PG8_SB(1, 1), cB + hstepB + kstep, voffB);
    PG8_WAIT_V(6); PG8_BAR;
    for (;;) {
        const bool has_next = S.next(ui + 1, nxt);
        const char* nA = has_next ? (const char*)g.A + (size_t)nxt.pm * tstepA : cA; const char* nB = has_next ? (const char*)g.Bt + (size_t)nxt.pn * tstepB : cB;
        for (int t = 0; t < nt; t += 2) {
            const bool last = (t == nt - 2);
            const char* a1 = cA + (size_t)(t + 1) * kstep;
            const char* a2 = last ? nA : cA + (size_t)(t + 2) * kstep; const char* b2 = last ? nB : cB + (size_t)(t + 2) * kstep;
            const char* a3 = a2 + kstep; const char* b3 = b2 + kstep;
            if constexpr (Epi::KHOOK) { if (t != 0 && (t & 7) == 0) E.khook(acc, cur, t >> 3, wr, wc, fr, fq); }
            PG8_LDB(B0, 0, 0); PG8_LDB(B1, 0, 1); PG8_SCHED; PG8_LDA(At, 0, 0); PG8_STAGE(PG8_SA(1, 1), a1 + hstepA, voffA);
            PG8_WAIT_V(8); PG8_WAIT_L(0); PG8_BAR; PG8_MMA(0, 0, At, B0); PG8_MMA(0, 1, At, B1); PG8_BAR; PG8_SCHED;
            PG8_LDA(At, 0, 1); PG8_STAGE(PG8_SB(0, 0), b2, voffB); PG8_STAGE(PG8_SB(0, 1), b2 + hstepB, voffB); PG8_STAGE(PG8_SA(0, 0), a2, voffA);
            PG8_WAIT_V(8); PG8_WAIT_L(0); PG8_BAR; PG8_MMA(1, 0, At, B0); PG8_MMA(1, 1, At, B1); PG8_BAR; PG8_SCHED;
            PG8_LDB(B0, 1, 0); PG8_LDB(B1, 1, 1); PG8_SCHED; PG8_LDA(At, 1, 0); PG8_STAGE(PG8_SA(0, 1), a2 + hstepA, voffA);
            PG8_WAIT_V(8); PG8_WAIT_L(0); PG8_BAR; PG8_MMA(0, 0, At, B0); PG8_MMA(0, 1, At, B1); PG8_BAR; PG8_SCHED;
            PG8_LDA(At, 1, 1); PG8_STAGE(PG8_SB(1, 0), b3, voffB); PG8_STAGE(PG8_SB(1, 1), b3 + hstepB, voffB); PG8_STAGE(PG8_SA(1, 0), a3, voffA);
            PG8_WAIT_V(8); PG8_WAIT_L(0); PG8_BAR; PG8_MMA(1, 0, At, B0); PG8_MMA(1, 1, At, B1); PG8_BAR; PG8_SCHED;
        }
        if (wr == 0) PG8_BAR;
        E(acc, cur, wr, wc, fr, fq);
        if (!has_next) break;
#pragma unroll
        for (int a = 0; a < 2; ++a)
#pragma unroll
            for (int b = 0; b < 2; ++b)
#pragma unroll
                for (int m = 0; m < 4; ++m)
#pragma unroll
                    for (int n = 0; n < 2; ++n) acc[a][b][m][n] = (f32x4){0.f, 0.f, 0.f, 0.f};
        cur = nxt; cA = nA; cB = nB; ++ui;
        if (wr == 1) PG8_BAR;
    }
    PG8_WAIT_V(0);
    PG8_BAR;
#undef PG8_SA
#undef PG8_SB
#undef PG8_STAGE
#undef PG8_LDA
#undef PG8_LDB
#undef PG8_MMA
#undef PG8_WAIT_V
#undef PG8_WAIT_L
#undef PG8_BAR
#undef PG8_SCHED
}
}

#define XB_TMO      128
#define XB_XCNT(j)  (256  + 64 * (j))
#define XB_XSUB(j)  (1280 + 64 * (j))
#define XB_XGEN(j)  (2304 + 64 * (j))
#define XB_TOP      3328
#define XB_TOPGEN   3392
#define XCD_BAR_WORDS 3456
#define XB_SPIN_CAP (1u << 18)
__device__ __forceinline__ unsigned xb_ld(unsigned* p)              { return __hip_atomic_load(p, __ATOMIC_RELAXED, __HIP_MEMORY_SCOPE_AGENT); }
__device__ __forceinline__ unsigned xb_add(unsigned* p, unsigned v) { return __hip_atomic_fetch_add(p, v, __ATOMIC_RELAXED, __HIP_MEMORY_SCOPE_AGENT); }
__device__ __forceinline__ unsigned xb_xcc_id() { return (unsigned)__builtin_amdgcn_s_getreg((3 << 11) | 20) & 0xFu; }
#define XB_SPIN(cond, bar) do { unsigned _sp = 0; while (cond) { __builtin_amdgcn_s_sleep(1); \
    if ((++_sp & 255u) == 0u) { if (xb_ld(&(bar)[XB_TMO])) break; if (_sp > XB_SPIN_CAP) { atomicAdd(&(bar)[XB_TMO], 1u); break; } } } } while (0)
struct XcdBarrier { unsigned* bar; unsigned x; volatile LAS unsigned* st; };
__device__ __forceinline__ XcdBarrier xcd_barrier_post(unsigned* bar, volatile LAS unsigned* st) {
    XcdBarrier b; b.bar = bar; b.x = xb_xcc_id(); b.st = st;
    if (threadIdx.x == 0) (void)xb_add(&bar[XB_XCNT(b.x)], 1u);
    return b;
}
__device__ __forceinline__ void xcd_barrier_complete(unsigned* bar, unsigned x, unsigned& nloc, unsigned& nx) {
    const unsigned G = gridDim.x * gridDim.y * gridDim.z;
    unsigned sum, cnt, mine, sp = 0u;
    for (;;) {
        sum = 0u; cnt = 0u; mine = 0u;
#pragma nounroll
        for (unsigned j = 0; j < 16; ++j) { const unsigned c = xb_ld(&bar[XB_XCNT(j)]); sum += c; cnt += (c > 0u) ? 1u : 0u; mine = (j == x) ? c : mine; }
        if (sum == G) break;
        __builtin_amdgcn_s_sleep(1);
        if ((++sp & 255u) == 0u) { if (xb_ld(&bar[XB_TMO])) break; if (sp > XB_SPIN_CAP) { atomicAdd(&bar[XB_TMO], 1u); break; } }
    }
    nloc = mine > 0u ? mine : 1u; nx = cnt > 0u ? cnt : 1u;
}
__device__ __forceinline__ void xcd_barrier(const XcdBarrier& b) {
    asm volatile("s_waitcnt vmcnt(0)" ::: "memory");
    __syncthreads();
    if (threadIdx.x == 0) {
        unsigned* bar = b.bar;
        __builtin_amdgcn_s_waitcnt(0);
        unsigned nloc = b.st[0], nx = b.st[1];
        if (nloc == 0u) { xcd_barrier_complete(bar, b.x, nloc, nx); b.st[0] = nloc; b.st[1] = nx; }
        const unsigned old = xb_add(&bar[XB_XSUB(b.x)], 1u);
        const unsigned gen = old / nloc;
        if (old + 1u == (gen + 1u) * nloc) {
            __builtin_amdgcn_fence(__ATOMIC_RELEASE, "agent");
            asm volatile("s_waitcnt vmcnt(0)" ::: "memory");
            const unsigned og = xb_add(&bar[XB_TOP], 1u);
            const unsigned tg = og / nx;
            if (og + 1u == (tg + 1u) * nx) xb_add(&bar[XB_TOPGEN], 1u);
            else XB_SPIN(xb_ld(&bar[XB_TOPGEN]) == tg, bar);
            __builtin_amdgcn_fence(__ATOMIC_ACQUIRE, "agent");
            xb_add(&bar[XB_XGEN(b.x)], 1u);
            asm volatile("s_waitcnt vmcnt(0)" ::: "memory");
        } else {
            XB_SPIN(xb_ld(&bar[XB_XGEN(b.x)]) == gen, bar);
            __builtin_amdgcn_fence(__ATOMIC_ACQUIRE, "agent");
            asm volatile("s_waitcnt vmcnt(0)" ::: "memory");
        }
    }
    __syncthreads();
}

__device__ __forceinline__ const void* kin(int k) {
    typedef __attribute__((address_space(4))) const char* kptr_t;
    kptr_t p = (kptr_t)__builtin_amdgcn_kernarg_segment_ptr(); asm volatile("" : "+s"(p));
    const unsigned long long v = *(__attribute__((address_space(4))) const unsigned long long*)(p + 8 * k);
    return (const void*)(GAS const void*)v;
}
struct Frame {
    LAS unsigned char* lds;
    int tid, lane, wave, vcu, G;
    unsigned char* ws; float* out;
#define FIN(name, T, k) __device__ __forceinline__ const T* name() const { return (const T*)kin(k); }
    FIN(x, float, 0) FIN(pos, int, 1) FIN(g_mix, float, 2) FIN(w_in, float, 3) FIN(a_re, float, 4) FIN(a_im, float, 5) FIN(log_dt, float, 6) FIN(b_re, float, 7) FIN(b_im, float, 8)
    FIN(c_re, float, 9) FIN(c_im, float, 10) FIN(s5_d, float, 11) FIN(w_glu, float, 12) FIN(gla_wg, float, 13) FIN(gla_bg, float, 14) FIN(pool_w, float, 15) FIN(pool_scale, float, 16)
    FIN(w_branch, float, 17) FIN(w_out, float, 18) FIN(g_ffn, float, 19) FIN(w_up, float, 20) FIN(conv_w, float, 21) FIN(conv_b, float, 22) FIN(w_down, float, 23) FIN(g_final, float, 24)
#undef FIN
#define FWS(name, T, off) __device__ __forceinline__ T* name() const { return (T*)(ws + (off)); }
    FWS(rotc, float, WS_ROT) FWS(rots, float, WS_ROT + (size_t)M * 32 * 4) FWS(abar, float, WS_S5T + S5T_ABAR) FWS(apow, float, WS_S5T + S5T_APOW) FWS(bbar, float, WS_S5T + S5T_BBAR) FWS(cmt, bf16_t, WS_S5T + S5T_CMT)
    FWS(wglu_t, bf16_t, WS_WGLU) FWS(poolw_t, bf16_t, WS_POOLW) FWS(win_t, bf16_t, WS_WIN) FWS(wbr_t, bf16_t, WS_WBR) FWS(wout_t, bf16_t, WS_WOUT) FWS(wup_t, bf16_t, WS_WUP) FWS(wdn_t, bf16_t, WS_WDN)
    FWS(HN, bf16_t, WS_HN) FWS(Y, bf16_t, WS_Y) FWS(YBP, bf16_t, WS_YBP) FWS(PROJ, bf16_t, WS_PROJ) FWS(SPREV, bf16_t, WS_SPREV) FWS(ACT, bf16_t, WS_ACT)
    FWS(STATE, float, WS_STATE) FWS(DEC, float, WS_DEC) FWS(XEND, float, WS_XEND)
#undef FWS
};

__device__ __forceinline__ float wave_sum(float v) {
#pragma unroll
    for (int o = 1; o < 64; o <<= 1) v += __shfl_xor(v, o);
    return v;
}

template <class SrcCol>
__device__ __forceinline__ void transpose_item(const float* W, int Nsrc, bf16_t* WT, int ldt, int kdst0, int k0, int n0, SrcCol srccol, LAS float* scr, int lane) {
    const int sc = srccol(n0 + (lane & 31));
#pragma unroll 8
    for (int i = 0; i < 32; ++i) { const int kk = 2 * i + (lane >> 5); scr[kk * 33 + (lane & 31)] = sc >= 0 ? W[(size_t)(k0 + kk) * Nsrc + sc] : 0.f; }
    LDS_WAIT();
    const int c = lane & 7;
#pragma unroll
    for (int j = 0; j < 4; ++j) { const int n = (lane >> 3) + 8 * j; const LAS float* s = scr + (8 * c) * 33 + n;
        u32x4 o; o.x = pk2(s[0 * 33], s[1 * 33]); o.y = pk2(s[2 * 33], s[3 * 33]); o.z = pk2(s[4 * 33], s[5 * 33]); o.w = pk2(s[6 * 33], s[7 * 33]);
        *(u32x4*)(WT + (size_t)(n0 + n) * ldt + kdst0 + k0 + 8 * c) = o; }
    LDS_WAIT();
}
struct ColIdent { __device__ __forceinline__ int operator()(int n) const { return n; } };
struct ColWin { __device__ __forceinline__ int operator()(int n) const { return n < 3584 ? n : (n < 4096 ? n + 16 : (n < 4112 ? n - 512 : (n < 4352 ? -1 : n - 240))); } };
struct ColWup { __device__ __forceinline__ int operator()(int n) const { const int blk = n >> 8, r = n & 255; return (r < 128) ? (blk * 128 + r) : (DFF + blk * 128 + (r - 128)); } };

__device__ __forceinline__ void rms_row_to_bf16(const float* xrow, const float* g, bf16_t* orow, int lane) {
    const f32x4* xr = (const f32x4*)xrow + lane; const f32x4* gr = (const f32x4*)g + lane;
    f32x4 v[8]; float s = 0.f;
#pragma unroll
    for (int j = 0; j < 8; ++j) { v[j] = xr[64 * j]; s += (v[j].x * v[j].x + v[j].y * v[j].y) + (v[j].z * v[j].z + v[j].w * v[j].w); }
    const float r = 1.0f / sqrtf(wave_sum(s) * (1.f / D) + EPS);
    u32x2* o8 = (u32x2*)orow + lane;
#pragma unroll
    for (int j = 0; j < 8; ++j) { const f32x4 gg = gr[64 * j]; u32x2 w; w.x = pk2(v[j].x * r * gg.x, v[j].y * r * gg.y); w.y = pk2(v[j].z * r * gg.z, v[j].w * r * gg.w); o8[64 * j] = w; }
}
__device__ __forceinline__ void rms_rows(Frame& F, const float* src, const float* g, bf16_t* dst) {
    const int gw = F.vcu * NWAVES + F.wave, NGW = F.G * NWAVES;
    for (int m = gw; m < M; m += NGW) rms_row_to_bf16(src + (size_t)m * D, g, dst + (size_t)m * D, F.lane);
}
__device__ __forceinline__ void rms_rows_f32_inplace(Frame& F, float* buf, const float* g) {
    const int gw = F.vcu * NWAVES + F.wave, NGW = F.G * NWAVES;
    for (int m = gw; m < M; m += NGW) {
        f32x4* xr = (f32x4*)(buf + (size_t)m * D) + F.lane; const f32x4* gr = (const f32x4*)g + F.lane;
        f32x4 v[8]; float s = 0.f;
#pragma unroll
        for (int j = 0; j < 8; ++j) { v[j] = xr[64 * j]; s += (v[j].x * v[j].x + v[j].y * v[j].y) + (v[j].z * v[j].z + v[j].w * v[j].w); }
        const float r = 1.0f / sqrtf(wave_sum(s) * (1.f / D) + EPS);
#pragma unroll
        for (int j = 0; j < 8; ++j) { const f32x4 gg = gr[64 * j]; xr[64 * j] = (f32x4){v[j].x * r * gg.x, v[j].y * r * gg.y, v[j].z * r * gg.z, v[j].w * r * gg.w}; }
    }
}

__device__ __forceinline__ void phase_prep(Frame& F, int l) {
    LAS float* scr = (LAS float*)(F.lds + F.wave * 16384);
    const int gw = F.vcu * NWAVES + F.wave, NGW = F.G * NWAVES;
    constexpr int I_IN = (D / 64) * (NIN / 32), I_UP = (D / 64) * (NUP / 32), I_DN = (DFF / 64) * (D / 32), I_BR = 4 * (BW / 64) * (D / 32), I_OUT = (D / 64) * (D / 32), I_GLU = (BW / 64) * (BW / 32), I_PL = 4 * (128 / 64) * (128 / 32);
    constexpr int NITEMS = I_IN + I_UP + I_DN + I_BR + I_OUT + I_GLU + I_PL;
    for (int it = gw; it < NITEMS; it += NGW) {
        int r = it;
        if (r < I_IN) { const int nb = NIN / 32; transpose_item(F.w_in() + (size_t)l * D * NIN_SRC, NIN_SRC, F.win_t(), D, 0, 64 * (r / nb), 32 * (r % nb), ColWin(), scr, F.lane); continue; } r -= I_IN;
        if (r < I_UP) { const int nb = NUP / 32; transpose_item(F.w_up() + (size_t)l * D * NUP, NUP, F.wup_t(), D, 0, 64 * (r / nb), 32 * (r % nb), ColWup(), scr, F.lane); continue; } r -= I_UP;
        if (r < I_DN) { const int nb = D / 32; transpose_item(F.w_down() + (size_t)l * DFF * D, D, F.wdn_t(), DFF, 0, 64 * (r / nb), 32 * (r % nb), ColIdent(), scr, F.lane); continue; } r -= I_DN;
        if (r < I_BR) { const int per = (BW / 64) * (D / 32), br = r / per, q = r % per, nb = D / 32;
            transpose_item(F.w_branch() + ((size_t)l * 4 + br) * BW * D, D, F.wbr_t(), D, br * BW, 64 * (q / nb), 32 * (q % nb), ColIdent(), scr, F.lane); continue; } r -= I_BR;
        if (r < I_OUT) { const int nb = D / 32; transpose_item(F.w_out() + (size_t)l * D * D, D, F.wout_t(), D, 0, 64 * (r / nb), 32 * (r % nb), ColIdent(), scr, F.lane); continue; } r -= I_OUT;
        if (r < I_GLU) { const int nb = BW / 32; transpose_item(F.w_glu() + (size_t)l * BW * BW, BW, F.wglu_t(), BW, 0, 64 * (r / nb), 32 * (r % nb), ColIdent(), scr, F.lane); continue; } r -= I_GLU;
        { const int grp = r / 8, q = r % 8; transpose_item(F.pool_w() + ((size_t)l * 4 + grp) * 128 * 128, 128, F.poolw_t() + (size_t)grp * 128 * 128, 128, 0, 64 * (q / 4), 32 * (q % 4), ColIdent(), scr, F.lane); }
    }
    const int gt = F.vcu * (NWAVES * 64) + F.tid, NGT = F.G * NWAVES * 64;
    for (int i = gt; i < 32 * 64; i += NGT) {
        const int g = i >> 6;
        const float are = F.a_re()[(size_t)l * 2048 + i], aim = F.a_im()[(size_t)l * 2048 + i], dt = expf(F.log_dt()[l * 32 + g]);
        const float mag = expf(are * dt), th = aim * dt;
        const float abr = mag * cosf(th), abi = mag * sinf(th);
        const float den = are * are + aim * aim, nr = abr - 1.0f, ni = abi;
        const float fre = (nr * are + ni * aim) / den, fim = (ni * are - nr * aim) / den;
        F.abar()[2 * i] = abr; F.abar()[2 * i + 1] = abi;
        float pr = abr, pi = abi;
#pragma unroll
        for (int q = 0; q < 6; ++q) { const float tr = pr * pr - pi * pi, ti = 2.f * pr * pi; pr = tr; pi = ti; }
        F.apow()[2 * i] = pr; F.apow()[2 * i + 1] = pi;
        const float* br = F.b_re() + ((size_t)l * 2048 + i) * 16; const float* bi = F.b_im() + ((size_t)l * 2048 + i) * 16;
#pragma unroll
        for (int c = 0; c < 16; ++c) { const float x = br[c], y = bi[c]; F.bbar()[(size_t)i * 32 + 2 * c] = fre * x - fim * y; F.bbar()[(size_t)i * 32 + 2 * c + 1] = fre * y + fim * x; }
    }
    for (int i = gt; i < 32 * 16 * 128; i += NGT) {
        const int k = i & 127, gc = i >> 7;
        const float v = (k < 64) ? F.c_re()[((size_t)l * 512 + gc) * 64 + k] : -F.c_im()[((size_t)l * 512 + gc) * 64 + (k - 64)];
        F.cmt()[i] = (bf16_t)f2bf(v);
    }
    if (l == 0) {
        for (int i = gt; i < M * 32; i += NGT) {
            const int row = i >> 5, j = i & 31;
            const float inv = exp2f(-(float)j * (13.287712379549449f / 32.0f));
            const float ang = (float)F.pos()[row] * inv;
            F.rotc()[i] = cosf(ang); F.rots()[i] = sinf(ang);
        }
    }
    rms_rows(F, l == 0 ? F.x() : F.out, F.g_mix() + (size_t)l * D, F.HN());
}

__device__ __forceinline__ f32x4 mma_nt_lds(const LAS bf16_t* X, int px, const LAS bf16_t* Y, int py, int ksteps, f32x4 acc, int lane) {
    const LAS bf16_t* xp = X + (lane & 15) * px + 8 * (lane >> 4);
    const LAS bf16_t* yp = Y + (lane & 15) * py + 8 * (lane >> 4);
    for (int ks = 0; ks < ksteps; ++ks) {
        const bf16x8 a = *(const LAS bf16x8*)(xp + 32 * ks), b = *(const LAS bf16x8*)(yp + 32 * ks);
        acc = __builtin_amdgcn_mfma_f32_16x16x32_bf16(a, b, acc, 0, 0, 0);
    }
    return acc;
}

constexpr int LN_B = 0, LN_TOT = 16384, LN_QD = 18432, LN_KI = 27648, LN_PM = 36864, LN_VT = 46080, LN_OB = 64512, LN_END = 98304;
constexpr int LP = 72;

__device__ __forceinline__ void lin_decay(Frame& F, int l, int mixer, size_t row0, int h) {
    LAS float* B = (LAS float*)(F.lds + LN_B); LAS float* TOT = (LAS float*)(F.lds + LN_TOT);
    const int t = F.tid >> 3, d0 = (F.tid & 7) * 8;
    if (mixer == 0) {
        const float lg = log1pf(-exp2f(-5.0f - (float)h));
#pragma unroll
        for (int j = 0; j < 8; ++j) B[t * 64 + d0 + j] = (float)(t + 1) * lg;
        __syncthreads();
        return;
    }
    const bf16_t* gr = F.PROJ() + (row0 + t) * NIN + C_GR;
    float grf[16]; { float a[8], b[8]; unpack8(*(const u32x4*)gr, a); unpack8(*(const u32x4*)(gr + 8), b);
#pragma unroll
        for (int j = 0; j < 8; ++j) { grf[j] = a[j]; grf[8 + j] = b[j]; } }
    const float* Wg = F.gla_wg() + (size_t)l * 16 * 256 + h * 64 + d0; const float* bg = F.gla_bg() + l * 256 + h * 64 + d0;
    float acc[8]; { const f32x4 b0 = *(const f32x4*)bg, b1 = *(const f32x4*)(bg + 4); acc[0] = b0.x; acc[1] = b0.y; acc[2] = b0.z; acc[3] = b0.w; acc[4] = b1.x; acc[5] = b1.y; acc[6] = b1.z; acc[7] = b1.w; }
#pragma unroll
    for (int r = 0; r < 16; ++r) { const f32x4 w0 = *(const f32x4*)(Wg + r * 256), w1 = *(const f32x4*)(Wg + r * 256 + 4);
        acc[0] += grf[r] * w0.x; acc[1] += grf[r] * w0.y; acc[2] += grf[r] * w0.z; acc[3] += grf[r] * w0.w; acc[4] += grf[r] * w1.x; acc[5] += grf[r] * w1.y; acc[6] += grf[r] * w1.z; acc[7] += grf[r] * w1.w; }
#pragma unroll
    for (int j = 0; j < 8; ++j) B[t * 64 + d0 + j] = logsigmoidf_(acc[j]) * (1.0f / 16.0f);
    __syncthreads();
    const int part = F.wave, d = F.lane;
    float v[8];
#pragma unroll
    for (int i = 0; i < 8; ++i) v[i] = B[(8 * part + i) * 64 + d];
#pragma unroll
    for (int i = 1; i < 8; ++i) v[i] += v[i - 1];
    TOT[part * 64 + d] = v[7];
    __syncthreads();
    float off = 0.f;
#pragma unroll
    for (int q = 0; q < 7; ++q) { const float tq = TOT[q * 64 + d]; off += (q < part) ? tq : 0.f; }
#pragma unroll
    for (int i = 0; i < 8; ++i) B[(8 * part + i) * 64 + d] = v[i] + off;
    __syncthreads();
}
__device__ __forceinline__ void lin_load_qk(Frame& F, size_t row, int col0, int c, bool rot, float scale, float (&v)[8]) {
    const bf16_t* p = F.PROJ() + row * NIN + col0;
    float own[8]; unpack8(*(const u32x4*)(p + 8 * c), own);
    if (!rot) {
#pragma unroll
        for (int j = 0; j < 8; ++j) v[j] = own[j] * scale;
        return;
    }
    float oth[8]; unpack8(*(const u32x4*)(p + 8 * (c ^ 4)), oth);
    const int i0 = (c & 3) * 8; const bool hi = c >= 4;
    const float* cp = F.rotc() + row * 32 + i0; const float* sp = F.rots() + row * 32 + i0;
    const f32x4 c0 = *(const f32x4*)cp, c1 = *(const f32x4*)(cp + 4), s0 = *(const f32x4*)sp, s1 = *(const f32x4*)(sp + 4);
    const float cs[8] = {c0.x, c0.y, c0.z, c0.w, c1.x, c1.y, c1.z, c1.w}, sn[8] = {s0.x, s0.y, s0.z, s0.w, s1.x, s1.y, s1.z, s1.w};
#pragma unroll
    for (int j = 0; j < 8; ++j) { const float os = oth[j] * sn[j]; v[j] = (own[j] * cs[j] + (hi ? os : -os)) * scale; }
}
__device__ __forceinline__ void lin_load_vt(Frame& F, size_t row0, int colv) {
    LAS bf16_t* VT = (LAS bf16_t*)(F.lds + LN_VT);
#pragma unroll
    for (int i = 0; i < 2; ++i) { const int idx = F.tid + 512 * i, s = idx >> 4, e0 = (idx & 15) * 8;
        const u32x4 w = *(const u32x4*)(F.PROJ() + (row0 + s) * NIN + colv + e0);
        VT[(e0 + 0) * LP + s] = (bf16_t)(w.x & 0xffffu); VT[(e0 + 1) * LP + s] = (bf16_t)(w.x >> 16); VT[(e0 + 2) * LP + s] = (bf16_t)(w.y & 0xffffu); VT[(e0 + 3) * LP + s] = (bf16_t)(w.y >> 16);
        VT[(e0 + 4) * LP + s] = (bf16_t)(w.z & 0xffffu); VT[(e0 + 5) * LP + s] = (bf16_t)(w.z >> 16); VT[(e0 + 6) * LP + s] = (bf16_t)(w.w & 0xffffu); VT[(e0 + 7) * LP + s] = (bf16_t)(w.w >> 16); }
}
__device__ __forceinline__ void lin_state_unit(Frame& F, int l, int unit) {
    const int n = unit & 63, h = (unit >> 6) & 3, b = (unit >> 8) & 7, mixer = unit >> 11;
    const size_t row0 = (size_t)b * SEQ + (size_t)n * CH;
    const int ck = (mixer == 0 ? C_RK : C_GK) + h * 64, cv = (mixer == 0 ? C_RV : C_GV) + h * 128;
    LAS float* B = (LAS float*)(F.lds + LN_B); LAS bf16_t* KDT = (LAS bf16_t*)(F.lds + LN_KI); LAS bf16_t* VT = (LAS bf16_t*)(F.lds + LN_VT);
    lin_decay(F, l, mixer, row0, h);
    { const int s = F.tid >> 3, c = F.tid & 7, d0 = c * 8; float k[8];
      lin_load_qk(F, row0 + s, ck, c, mixer == 0, mixer == 0 ? 0.125f : 1.0f, k);
#pragma unroll
      for (int j = 0; j < 8; ++j) { const float kd = k[j] * __expf(B[63 * 64 + d0 + j] - B[s * 64 + d0 + j]); KDT[(d0 + j) * LP + s] = (bf16_t)f2bf(kd); } }
    lin_load_vt(F, row0, cv);
    __syncthreads();
    { const int w = F.wave, lane = F.lane; float* st = F.STATE() + (size_t)unit * 8192;
#pragma unroll
      for (int dt = 0; dt < 4; ++dt) { f32x4 acc = (f32x4){0.f, 0.f, 0.f, 0.f}; acc = mma_nt_lds(VT + 16 * w * LP, LP, KDT + 16 * dt * LP, LP, 2, acc, lane);
#pragma unroll
          for (int i = 0; i < 4; ++i) st[(16 * w + 4 * (lane >> 4) + i) * 64 + 16 * dt + (lane & 15)] = acc[i]; }
      if (F.tid < 64) F.DEC()[(size_t)unit * 64 + F.tid] = __expf(B[63 * 64 + F.tid]); }
    __syncthreads();
}
__device__ __forceinline__ void lin_scan(Frame& F) {
    const int gt = F.vcu * (NWAVES * 64) + F.tid, NGT = F.G * NWAVES * 64;
    for (int i = gt; i < 64 * 8192; i += NGT) {
        const int seq = i >> 13, idx = i & 8191, d = idx & 63;
        float carry = 0.f;
#pragma unroll 8
        for (int n = 0; n < NCH; ++n) { const size_t u = (size_t)seq * NCH + n; const float v = F.STATE()[u * 8192 + idx]; const float dc = F.DEC()[u * 64 + d];
            F.SPREV()[u * 8192 + idx] = (bf16_t)f2bf(carry); carry = dc * carry + v; }
    }
}
__device__ __forceinline__ void lin_out_unit(Frame& F, int l, int unit) {
    const int n = unit & 63, h = (unit >> 6) & 3, b = (unit >> 8) & 7, mixer = unit >> 11;
    const size_t row0 = (size_t)b * SEQ + (size_t)n * CH;
    const int cq = (mixer == 0 ? C_RQ : C_GQ) + h * 64, ck = (mixer == 0 ? C_RK : C_GK) + h * 64, cv = (mixer == 0 ? C_RV : C_GV) + h * 128, cg = (mixer == 0 ? C_RG : C_GG) + h * 128;
    const int ycol = (mixer == 0 ? 0 : 1024) + h * 128;
    LAS float* B = (LAS float*)(F.lds + LN_B); LAS bf16_t* QD = (LAS bf16_t*)(F.lds + LN_QD); LAS bf16_t* KI = (LAS bf16_t*)(F.lds + LN_KI); LAS bf16_t* PM = (LAS bf16_t*)(F.lds + LN_PM);
    LAS bf16_t* VT = (LAS bf16_t*)(F.lds + LN_VT); LAS float* OB = (LAS float*)(F.lds + LN_OB);
    lin_decay(F, l, mixer, row0, h);
    { const int s = F.tid >> 3, c = F.tid & 7, d0 = c * 8; float q[8], k[8], bb[8];
      lin_load_qk(F, row0 + s, cq, c, mixer == 0, mixer == 0 ? 1.0f : 0.125f, q);
      lin_load_qk(F, row0 + s, ck, c, mixer == 0, mixer == 0 ? 0.125f : 1.0f, k);
#pragma unroll
      for (int j = 0; j < 8; ++j) bb[j] = B[s * 64 + d0 + j];
      float qd[8], ki[8];
#pragma unroll
      for (int j = 0; j < 8; ++j) { qd[j] = q[j] * __expf(bb[j]); ki[j] = k[j] * __expf(-bb[j]); }
      *(LAS u32x4*)(QD + s * LP + d0) = pack8(qd); *(LAS u32x4*)(KI + s * LP + d0) = pack8(ki); }
    lin_load_vt(F, row0, cv);
    __syncthreads();
    { const int lane = F.lane;
#pragma unroll
      for (int j = 0; j < 2; ++j) { const int tile = 2 * F.wave + j, tt = tile >> 2, st = tile & 3;
          f32x4 acc = (f32x4){0.f, 0.f, 0.f, 0.f};
          if (st <= tt) acc = mma_nt_lds(QD + 16 * tt * LP, LP, KI + 16 * st * LP, LP, 2, acc, lane);
#pragma unroll
          for (int i = 0; i < 4; ++i) { const int t = 16 * tt + 4 * (lane >> 4) + i, s = 16 * st + (lane & 15); const float p = (st <= tt && s <= t) ? acc[i] : 0.f; PM[t * LP + s] = (bf16_t)f2bf(p); } } }
    __syncthreads();
    { const int w = F.wave, lane = F.lane; const bf16_t* sp = F.SPREV() + (size_t)unit * 8192 + (size_t)(16 * w + (lane & 15)) * 64 + 8 * (lane >> 4);
      const bf16x8 s0 = *(const bf16x8*)sp, s1 = *(const bf16x8*)(sp + 32);
#pragma unroll
      for (int tt = 0; tt < 4; ++tt) { f32x4 acc = (f32x4){0.f, 0.f, 0.f, 0.f};
          acc = mma_nt_lds(PM + 16 * tt * LP, LP, VT + 16 * w * LP, LP, 2, acc, lane);
          const LAS bf16_t* xp = QD + (16 * tt + (lane & 15)) * LP + 8 * (lane >> 4);
          acc = __builtin_amdgcn_mfma_f32_16x16x32_bf16(*(const LAS bf16x8*)xp, s0, acc, 0, 0, 0);
          acc = __builtin_amdgcn_mfma_f32_16x16x32_bf16(*(const LAS bf16x8*)(xp + 32), s1, acc, 0, 0, 0);
#pragma unroll
          for (int i = 0; i < 4; ++i) OB[(16 * tt + 4 * (lane >> 4) + i) * 132 + 16 * w + (lane & 15)] = acc[i]; } }
    __syncthreads();
    { const int t = F.tid >> 3, part = F.tid & 7; float o[16];
#pragma unroll
      for (int j = 0; j < 4; ++j) { const f32x4 v = *(const LAS f32x4*)(OB + t * 132 + 16 * part + 4 * j); o[4 * j] = v.x; o[4 * j + 1] = v.y; o[4 * j + 2] = v.z; o[4 * j + 3] = v.w; }
      float s = 0.f;
#pragma unroll
      for (int j = 0; j < 16; ++j) s += o[j];
      s += __shfl_xor(s, 1); s += __shfl_xor(s, 2); s += __shfl_xor(s, 4);
      const float mu = s * (1.0f / 128.0f); float q = 0.f;
#pragma unroll
      for (int j = 0; j < 16; ++j) { const float dlt = o[j] - mu; q += dlt * dlt; }
      q += __shfl_xor(q, 1); q += __shfl_xor(q, 2); q += __shfl_xor(q, 4);
      const float r = 1.0f / sqrtf(q * (1.0f / 128.0f) + EPS);
      const bf16_t* gp = F.PROJ() + (row0 + t) * NIN + cg + 16 * part; float g0[8], g1[8]; unpack8(*(const u32x4*)gp, g0); unpack8(*(const u32x4*)(gp + 8), g1);
      float y0[8], y1[8];
#pragma unroll
      for (int j = 0; j < 8; ++j) { y0[j] = (o[j] - mu) * r * siluf_(g0[j]); y1[j] = (o[8 + j] - mu) * r * siluf_(g1[j]); }
      bf16_t* yp = F.Y() + (row0 + t) * D + ycol + 16 * part; *(u32x4*)yp = pack8(y0); *(u32x4*)(yp + 8) = pack8(y1); }
    __syncthreads();
}

constexpr int S5_WL = 12288;
__device__ __forceinline__ void s5_load_u(Frame& F, LAS bf16_t* UT, size_t row0, int g) {
    const bf16_t* up = F.PROJ() + (row0 + F.lane) * NIN + C_SU + g * 16;
    const u32x4 a = *(const u32x4*)up, b = *(const u32x4*)(up + 8);
    *(LAS u32x4*)(UT + F.lane * 16) = a; *(LAS u32x4*)(UT + F.lane * 16 + 8) = b;
    LDS_WAIT();
}
__device__ __forceinline__ void s5_step(const LAS bf16_t* ut, const float (&bb)[32], float ar, float ai, float& xr, float& xi) {
    float u[16]; { float a[8], b[8]; unpack8(*(const LAS u32x4*)ut, a); unpack8(*(const LAS u32x4*)(ut + 8), b);
#pragma unroll
        for (int j = 0; j < 8; ++j) { u[j] = a[j]; u[8 + j] = b[j]; } }
    float bur = 0.f, bui = 0.f;
#pragma unroll
    for (int c = 0; c < 16; ++c) { bur += bb[2 * c] * u[c]; bui += bb[2 * c + 1] * u[c]; }
    const float nr = ar * xr - ai * xi + bur, ni = ar * xi + ai * xr + bui; xr = nr; xi = ni;
}
__device__ __forceinline__ void s5_pass1(Frame& F) {
    LAS bf16_t* UT = (LAS bf16_t*)(F.lds + F.wave * S5_WL);
    const int gw = F.vcu * NWAVES + F.wave, NGW = F.G * NWAVES;
    for (int unit = gw; unit < BATCH * NCH * 32; unit += NGW) {
        const int g = unit & 31, n = (unit >> 5) & 63, b = unit >> 11; const size_t row0 = (size_t)b * SEQ + (size_t)n * CH;
        s5_load_u(F, UT, row0, g);
        const int gp = g * 64 + F.lane; const float ar = F.abar()[2 * gp], ai = F.abar()[2 * gp + 1];
        float bb[32];
#pragma unroll
        for (int j = 0; j < 8; ++j) { const f32x4 v = *(const f32x4*)(F.bbar() + (size_t)gp * 32 + 4 * j); bb[4 * j] = v.x; bb[4 * j + 1] = v.y; bb[4 * j + 2] = v.z; bb[4 * j + 3] = v.w; }
        float xr = 0.f, xi = 0.f;
        for (int t = 0; t < CH; ++t) s5_step(UT + t * 16, bb, ar, ai, xr, xi);
        *(f32x2*)(F.XEND() + ((((size_t)(b * 32 + g)) * NCH + n) * 64 + F.lane) * 2) = (f32x2){xr, xi};
        LDS_WAIT();
    }
}
__device__ __forceinline__ void s5_scan(Frame& F) {
    const int gt = F.vcu * (NWAVES * 64) + F.tid, NGT = F.G * NWAVES * 64;
    for (int i = gt; i < BATCH * 32 * 64; i += NGT) {
        const int p = i & 63, bg = i >> 6, g = bg & 31; const float pr = F.apow()[2 * (g * 64 + p)], pi = F.apow()[2 * (g * 64 + p) + 1];
        float cr = 0.f, ci = 0.f;
#pragma unroll 8
        for (int n = 0; n < NCH; ++n) { f32x2* xp = (f32x2*)(F.XEND() + (((size_t)bg * NCH + n) * 64 + p) * 2); const f32x2 v = *xp; *xp = (f32x2){cr, ci};
            const float nr = pr * cr - pi * ci + v.x, ni = pr * ci + pi * cr + v.y; cr = nr; ci = ni; }
    }
}
__device__ __forceinline__ void s5_pass3(Frame& F, int l) {
    LAS bf16_t* UT = (LAS bf16_t*)(F.lds + F.wave * S5_WL); LAS bf16_t* X = UT + 1024;
    const int gw = F.vcu * NWAVES + F.wave, NGW = F.G * NWAVES, lane = F.lane;
    for (int unit = gw; unit < BATCH * NCH * 32; unit += NGW) {
        const int g = unit & 31, n = (unit >> 5) & 63, b = unit >> 11; const size_t row0 = (size_t)b * SEQ + (size_t)n * CH;
        s5_load_u(F, UT, row0, g);
        const int gp = g * 64 + lane; const float ar = F.abar()[2 * gp], ai = F.abar()[2 * gp + 1];
        float bb[32];
#pragma unroll
        for (int j = 0; j < 8; ++j) { const f32x4 v = *(const f32x4*)(F.bbar() + (size_t)gp * 32 + 4 * j); bb[4 * j] = v.x; bb[4 * j + 1] = v.y; bb[4 * j + 2] = v.z; bb[4 * j + 3] = v.w; }
        const f32x2 x0 = *(const f32x2*)(F.XEND() + ((((size_t)(b * 32 + g)) * NCH + n) * 64 + lane) * 2);
        float xr = x0.x, xi = x0.y;
        bf16x8 cf[4];
#pragma unroll
        for (int ks = 0; ks < 4; ++ks) cf[ks] = *(const bf16x8*)(F.cmt() + ((size_t)(g * 16 + (lane & 15))) * 128 + 32 * ks + 8 * (lane >> 4));
        const float dsk = F.s5_d()[(size_t)l * BW + g * 16 + (lane & 15)];
        for (int sb = 0; sb < 2; ++sb) {
            for (int tt = 0; tt < 32; ++tt) { s5_step(UT + (sb * 32 + tt) * 16, bb, ar, ai, xr, xi); X[tt * 136 + lane] = (bf16_t)f2bf(xr); X[tt * 136 + 64 + lane] = (bf16_t)f2bf(xi); }
            LDS_WAIT();
#pragma unroll
            for (int j = 0; j < 2; ++j) { f32x4 acc = (f32x4){0.f, 0.f, 0.f, 0.f};
                const LAS bf16_t* xp = X + (16 * j + (lane & 15)) * 136 + 8 * (lane >> 4);
#pragma unroll
                for (int ks = 0; ks < 4; ++ks) acc = __builtin_amdgcn_mfma_f32_16x16x32_bf16(*(const LAS bf16x8*)(xp + 32 * ks), cf[ks], acc, 0, 0, 0);
#pragma unroll
                for (int i = 0; i < 4; ++i) { const int tl = sb * 32 + 16 * j + 4 * (lane >> 4) + i, c = lane & 15;
                    const float u = bflo((unsigned)UT[tl * 16 + c]); const float y = gelu_tanh(acc[i] + dsk * u);
                    F.YBP()[(row0 + tl) * BW + g * 16 + c] = (bf16_t)f2bf(y); } }
            LDS_WAIT();
        }
    }
}

constexpr int PL_P = 520, PL_ROWS = 79, PL_MIX = PL_ROWS * PL_P * 2;
__device__ __forceinline__ void pool_unit(Frame& F, int l, int unit) {
    const int n = unit & 63, b = unit >> 6; const size_t row0 = (size_t)b * SEQ + (size_t)n * CH;
    LAS bf16_t* PL = (LAS bf16_t*)F.lds; LAS bf16_t* MIX = (LAS bf16_t*)(F.lds + PL_MIX);
    for (int i = F.tid; i < PL_ROWS * 64; i += NWAVES * 64) { const int r = i >> 6, c8 = (i & 63) * 8; const int tpos = n * CH - 15 + r;
        u32x4 w = (u32x4){0u, 0u, 0u, 0u}; if (tpos >= 0) w = *(const u32x4*)(F.PROJ() + ((size_t)b * SEQ + tpos) * NIN + C_PU + c8);
        *(LAS u32x4*)(PL + r * PL_P + c8) = w; }
    __syncthreads();
    for (int g = 0; g < 4; ++g) {
        const int win = 2 << g;
        { const int t = F.tid >> 3, c0 = (F.tid & 7) * 16; const int tpos = n * CH + t; const float inv = 1.0f / (float)min(tpos + 1, win);
          float s[16];
#pragma unroll
          for (int j = 0; j < 16; ++j) s[j] = 0.f;
          for (int jj = 0; jj < win; ++jj) { const LAS bf16_t* p = PL + (15 + t - jj) * PL_P + g * 128 + c0; float a[8], bq[8]; unpack8(*(const LAS u32x4*)p, a); unpack8(*(const LAS u32x4*)(p + 8), bq);
#pragma unroll
              for (int j = 0; j < 8; ++j) { s[j] += a[j]; s[8 + j] += bq[j]; } }
          const LAS bf16_t* p = PL + (15 + t) * PL_P + g * 128 + c0; float a[8], bq[8]; unpack8(*(const LAS u32x4*)p, a); unpack8(*(const LAS u32x4*)(p + 8), bq);
          float m0[8], m1[8];
#pragma unroll
          for (int j = 0; j < 8; ++j) { m0[j] = s[j] * inv - a[j]; m1[j] = s[8 + j] * inv - bq[j]; }
          *(LAS u32x4*)(MIX + t * 136 + c0) = pack8(m0); *(LAS u32x4*)(MIX + t * 136 + c0 + 8) = pack8(m1); }
        __syncthreads();
        { const int lane = F.lane, tt = F.wave >> 1, dh = F.wave & 1; const bf16_t* pw = F.poolw_t() + (size_t)g * 128 * 128;
#pragma unroll
          for (int j = 0; j < 4; ++j) { const int dt = dh * 4 + j; f32x4 acc = (f32x4){0.f, 0.f, 0.f, 0.f};
              const LAS bf16_t* xp = MIX + (16 * tt + (lane & 15)) * 136 + 8 * (lane >> 4); const bf16_t* yp = pw + (size_t)(16 * dt + (lane & 15)) * 128 + 8 * (lane >> 4);
#pragma unroll
              for (int ks = 0; ks < 4; ++ks) acc = __builtin_amdgcn_mfma_f32_16x16x32_bf16(*(const LAS bf16x8*)(xp + 32 * ks), *(const bf16x8*)(yp + 32 * ks), acc, 0, 0, 0);
              const int dcol = g * 128 + 16 * dt + (lane & 15); const float sc = F.pool_scale()[(size_t)l * BW + dcol];
#pragma unroll
              for (int i = 0; i < 4; ++i) F.Y()[(row0 + 16 * tt + 4 * (lane >> 4) + i) * D + 1536 + dcol] = (bf16_t)f2bf(acc[i] * sc); } }
        __syncthreads();
    }
}

__device__ __forceinline__ void conv_phase(Frame& F, int l) {
    const bf16_t* U = F.PROJ();
    const float* cw = F.conv_w() + (size_t)l * 3 * NUP; const float* cb = F.conv_b() + (size_t)l * NUP;
    const int gt = F.vcu * (NWAVES * 64) + F.tid, NGT = F.G * NWAVES * 64;
    constexpr int JG = DFF / 8, TB = SEQ / 64;
    for (int task = gt; task < BATCH * TB * JG; task += NGT) {
        const int jg = task % JG, tb = (task / JG) % TB, b = task / (JG * TB); const int j0 = jg * 8;
        const int ucol = 256 * (j0 >> 7) + (j0 & 127);
        float wa[3][8], wv[3][8], ba[8], bv[8];
#pragma unroll
        for (int q = 0; q < 3; ++q) { const f32x4 a0 = *(const f32x4*)(cw + q * NUP + j0), a1 = *(const f32x4*)(cw + q * NUP + j0 + 4), v0 = *(const f32x4*)(cw + q * NUP + DFF + j0), v1 = *(const f32x4*)(cw + q * NUP + DFF + j0 + 4);
            wa[q][0] = a0.x; wa[q][1] = a0.y; wa[q][2] = a0.z; wa[q][3] = a0.w; wa[q][4] = a1.x; wa[q][5] = a1.y; wa[q][6] = a1.z; wa[q][7] = a1.w;
            wv[q][0] = v0.x; wv[q][1] = v0.y; wv[q][2] = v0.z; wv[q][3] = v0.w; wv[q][4] = v1.x; wv[q][5] = v1.y; wv[q][6] = v1.z; wv[q][7] = v1.w; }
        { const f32x4 a0 = *(const f32x4*)(cb + j0), a1 = *(const f32x4*)(cb + j0 + 4), v0 = *(const f32x4*)(cb + DFF + j0), v1 = *(const f32x4*)(cb + DFF + j0 + 4);
          ba[0] = a0.x; ba[1] = a0.y; ba[2] = a0.z; ba[3] = a0.w; ba[4] = a1.x; ba[5] = a1.y; ba[6] = a1.z; ba[7] = a1.w; bv[0] = v0.x; bv[1] = v0.y; bv[2] = v0.z; bv[3] = v0.w; bv[4] = v1.x; bv[5] = v1.y; bv[6] = v1.z; bv[7] = v1.w; }
        float a2[8], a1_[8], v2[8], v1_[8];
        const int t0 = tb * 64; const size_t rowb = (size_t)b * SEQ;
#pragma unroll
        for (int j = 0; j < 8; ++j) { a2[j] = 0.f; a1_[j] = 0.f; v2[j] = 0.f; v1_[j] = 0.f; }
        if (t0 >= 2) { const bf16_t* p2 = U + (rowb + t0 - 2) * NUP + ucol; const bf16_t* p1 = U + (rowb + t0 - 1) * NUP + ucol;
            unpack8(*(const u32x4*)p2, a2); unpack8(*(const u32x4*)(p2 + 128), v2); unpack8(*(const u32x4*)p1, a1_); unpack8(*(const u32x4*)(p1 + 128), v1_); }
        for (int t = 0; t < 64; ++t) {
            const bf16_t* p = U + (rowb + t0 + t) * NUP + ucol; float a0[8], v0[8]; unpack8(*(const u32x4*)p, a0); unpack8(*(const u32x4*)(p + 128), v0);
            float o[8];
#pragma unroll
            for (int j = 0; j < 8; ++j) { const float ca = ba[j] + a2[j] * wa[0][j] + a1_[j] * wa[1][j] + a0[j] * wa[2][j]; const float cv = bv[j] + v2[j] * wv[0][j] + v1_[j] * wv[1][j] + v0[j] * wv[2][j];
                o[j] = siluf_(ca) * cv; a2[j] = a1_[j]; a1_[j] = a0[j]; v2[j] = v1_[j]; v1_[j] = v0[j]; }
            *(u32x4*)(F.ACT() + (rowb + t0 + t) * DFF + j0) = pack8(o);
        }
    }
}

constexpr int NPH = 13;
struct Args { const void* in[25]; float* out; unsigned char* ws; int l_lo, l_hi, ph_lo, ph_hi, single, pad; };
__global__ void __launch_bounds__(NWAVES * 64, 2) hybrid_fwd(Args args) {
    extern __shared__ __attribute__((aligned(16))) unsigned char lds[];
    Frame F;
    F.lds = (LAS unsigned char*)lds;
    F.tid = threadIdx.x; F.lane = F.tid & 63; F.wave = __builtin_amdgcn_readfirstlane(F.tid >> 6);
    F.G = gridDim.x; { const int bx = blockIdx.x; F.vcu = (F.G % 8 == 0) ? (bx % 8) * (F.G / 8) + bx / 8 : bx; }
    unsigned char* ws = args.ws; F.ws = ws; F.out = args.out;

    volatile LAS unsigned* MISC = (volatile LAS unsigned*)(F.lds + MISC_OFF);
    if (F.tid < 64) MISC[F.tid] = 0u;
    __syncthreads();
    unsigned* ctl = (unsigned*)(ws + WS_CTL);
    XcdBarrier bar; bar.bar = ctl + CW_BAR; bar.x = 0; bar.st = nullptr;
    if (args.single) bar = xcd_barrier_post(ctl + CW_BAR, MISC);
#define GRID_BAR() do { if (args.single) xcd_barrier(bar); } while (0)
    const int lo = args.ph_lo, hi = args.ph_hi;
#define IN(k) (lo <= (k) && (k) < hi)
#define PH_BEGIN() do { int t_ = threadIdx.x; asm volatile("" : "+v"(t_)); F.tid = t_; F.lane = t_ & 63; F.wave = __builtin_amdgcn_readfirstlane(t_ >> 6); } while (0)

    for (int l = args.l_lo; l < args.l_hi; ++l) {
        const float* hsrc = (l == 0) ? F.x() : F.out;
        if (IN(0)) { PH_BEGIN(); phase_prep(F, l); GRID_BAR(); }
        if (IN(1)) { PH_BEGIN(); pg8::Gemm g{F.HN(), F.win_t(), M, NIN, D, D, D}; pg8::StaticOrder S; S.init(M, NIN, F.G, (int)blockIdx.x); pg8::EpiStoreBf16 E{F.PROJ(), NIN};
            pg8::gemm_phase(F.lds, g, S, E); GRID_BAR(); }
        if (IN(2)) { PH_BEGIN(); for (int u = F.vcu; u < 4096; u += F.G) lin_state_unit(F, l, u);
            s5_pass1(F); __syncthreads();
            for (int u = F.vcu; u < BATCH * NCH; u += F.G) pool_unit(F, l, u);
            GRID_BAR(); }
        if (IN(3)) { PH_BEGIN(); lin_scan(F); s5_scan(F); GRID_BAR(); }
        if (IN(4)) { PH_BEGIN(); for (int u = F.vcu; u < 4096; u += F.G) lin_out_unit(F, l, u);
            s5_pass3(F, l); __syncthreads();
            GRID_BAR(); }
        if (IN(5)) { PH_BEGIN(); pg8::Gemm g{F.YBP(), F.wglu_t(), M, BW, BW, BW, BW}; pg8::StaticOrder S; S.init(M, BW, F.G, (int)blockIdx.x); pg8::EpiGlu E{F.YBP(), BW, F.Y() + BW, D};
            pg8::gemm_phase(F.lds, g, S, E); GRID_BAR(); }
        if (IN(6)) { PH_BEGIN(); pg8::Gemm g{F.Y(), F.wbr_t(), M, D, D, D, D}; pg8::StaticOrder S; S.init(M, D, F.G, (int)blockIdx.x); pg8::EpiMerge E{F.PROJ() + C_GATE, NIN, F.HN(), D};
            pg8::gemm_phase(F.lds, g, S, E); GRID_BAR(); }
        if (IN(7)) { PH_BEGIN(); pg8::Gemm g{F.HN(), F.wout_t(), M, D, D, D, D}; pg8::StaticOrder S; S.init(M, D, F.G, (int)blockIdx.x); pg8::EpiResid E{hsrc, F.out, D};
            pg8::gemm_phase(F.lds, g, S, E); GRID_BAR(); }
        if (IN(8)) { PH_BEGIN(); rms_rows(F, F.out, F.g_ffn() + (size_t)l * D, F.HN()); GRID_BAR(); }
        if (IN(9)) { PH_BEGIN(); pg8::Gemm g{F.HN(), F.wup_t(), M, NUP, D, D, D}; pg8::StaticOrder S; S.init(M, NUP, F.G, (int)blockIdx.x); pg8::EpiStoreBf16 E{F.PROJ(), NUP};
            pg8::gemm_phase(F.lds, g, S, E); GRID_BAR(); }
        if (IN(10)) { PH_BEGIN(); conv_phase(F, l); GRID_BAR(); }
        if (IN(11)) { PH_BEGIN(); pg8::Gemm g{F.ACT(), F.wdn_t(), M, D, DFF, DFF, DFF}; pg8::StaticOrder S; S.init(M, D, F.G, (int)blockIdx.x); pg8::EpiResid E{F.out, F.out, D};
            pg8::gemm_phase(F.lds, g, S, E); GRID_BAR(); }
        if (IN(12) && l == DEPTH - 1) { PH_BEGIN(); rms_rows_f32_inplace(F, F.out, F.g_final()); }
    }
#undef IN
#undef PH_BEGIN
#undef GRID_BAR
}

extern "C" void kernel_launch(void* const* d_in, const int* in_sizes, int n_in, void* d_out, int out_size, void* d_ws, size_t ws_size, hipStream_t stream) {
    static int grid = 0;
    if (grid == 0) {
        if (n_in != 25 || in_sizes[0] != M * D || out_size != M * D || ws_size < WS_END) { fprintf(stderr, "kernel_launch: shape/workspace mismatch (n_in %d, in0 %d, out %d, ws %zu, need %zu); nothing launched\n", n_in, n_in > 0 ? in_sizes[0] : -1, out_size, ws_size, (size_t)WS_END); grid = -1; return; }
        int dev = 0, cus = 0, per_cu = 0;
        if (hipGetDevice(&dev) != hipSuccess || hipDeviceGetAttribute(&cus, hipDeviceAttributeMultiprocessorCount, dev) != hipSuccess) { grid = -1; return; }
        if (hipFuncSetAttribute((const void*)hybrid_fwd, hipFuncAttributeMaxDynamicSharedMemorySize, LDS_BYTES) != hipSuccess) { fprintf(stderr, "kernel_launch: hipFuncSetAttribute failed\n"); grid = -1; return; }
        if (hipOccupancyMaxActiveBlocksPerMultiprocessor(&per_cu, (const void*)hybrid_fwd, NWAVES * 64, LDS_BYTES) != hipSuccess || per_cu < 1) { fprintf(stderr, "kernel_launch: occupancy query reports %d workgroups per CU\n", per_cu); }
        (void)hipGetLastError();
        grid = cus;
    }
    if (grid < 0) return;
    if (hipMemsetAsync((char*)d_ws + WS_CTL, 0, CTL_ZERO_BYTES, stream) != hipSuccess) return;
    Args a{};
    for (int i = 0; i < 25; ++i) a.in[i] = d_in[i];
    a.out = (float*)d_out; a.ws = (unsigned char*)d_ws;
#if MK_SINGLE
    a.l_lo = 0; a.l_hi = DEPTH; a.ph_lo = 0; a.ph_hi = NPH; a.single = 1;
    hipLaunchKernelGGL(hybrid_fwd, dim3(grid), dim3(NWAVES * 64), LDS_BYTES, stream, a);
#else
    a.single = 0;
    for (int l = 0; l < DEPTH; ++l)
        for (int p = 0; p < NPH; ++p) { if (p == 12 && l != DEPTH - 1) continue; a.l_lo = l; a.l_hi = l + 1; a.ph_lo = p; a.ph_hi = p + 1;
            hipLaunchKernelGGL(hybrid_fwd, dim3(grid), dim3(NWAVES * 64), LDS_BYTES, stream, a); }
#endif
}
```

```cpp
#include <hip/hip_runtime.h>
#include <cstdio>
#include <cstdint>

#ifndef MK_SINGLE
#define MK_SINGLE 1
#endif

#define LAS __attribute__((address_space(3)))
#define GAS __attribute__((address_space(1)))
typedef unsigned short bf16_t;
typedef short bf16x8 __attribute__((ext_vector_type(8)));
typedef float f32x4 __attribute__((ext_vector_type(4)));
typedef float f32x2 __attribute__((ext_vector_type(2)));
typedef unsigned u32x4 __attribute__((ext_vector_type(4)));
typedef unsigned u32x2 __attribute__((ext_vector_type(2)));

constexpr int D = 2048, BATCH = 8, SEQ = 4096, DEPTH = 4, M = BATCH * SEQ;
constexpr int BW = 512;
constexpr int NIN_SRC = 12304, NIN = 12544;
constexpr int DFF = 5504, NUP = 11008;
constexpr int C_RQ = 0, C_RK = 256, C_RV = 512, C_RG = 1024, C_SU = 1536, C_GQ = 2048, C_GK = 2304, C_GV = 2560, C_GG = 3072, C_PU = 3584, C_GR = 4096, C_GATE = 4352;
constexpr float EPS = 1e-6f;
constexpr int NWAVES = 8;
constexpr int CH = 64;
constexpr int NCH = SEQ / CH;

constexpr size_t MiB = 1u << 20;
constexpr size_t WS_CTL = 0, CTL_ZERO_BYTES = 1 * MiB;
constexpr size_t WS_ROT = 1 * MiB;
constexpr size_t WS_S5T = 9 * MiB;
constexpr size_t S5T_ABAR = 0, S5T_APOW = 16384, S5T_BBAR = 32768, S5T_CMT = 32768 + 262144;
constexpr size_t WS_WGLU = 10 * MiB;
constexpr size_t WS_POOLW = 10 * MiB + 512 * 1024;
constexpr size_t WS_WIN = 11 * MiB;
constexpr size_t WS_WBR = 60 * MiB;
constexpr size_t WS_WOUT = 68 * MiB;
constexpr size_t WS_WUP = 76 * MiB;
constexpr size_t WS_WDN = 119 * MiB;
constexpr size_t WS_HN = 141 * MiB;
constexpr size_t WS_Y = 269 * MiB;
constexpr size_t WS_SCR = 397 * MiB;
constexpr size_t WS_YBP = WS_SCR;
constexpr size_t WS_STATE = WS_SCR + 32 * MiB;
constexpr size_t WS_SPREV = WS_SCR + 160 * MiB;
constexpr size_t WS_DEC = WS_SCR + 224 * MiB;
constexpr size_t WS_XEND = WS_SCR + 225 * MiB;
constexpr size_t WS_UH = WS_SCR + 128 * MiB;
constexpr size_t WS_PROJ = 637 * MiB;
constexpr size_t WS_ACT = WS_PROJ;
constexpr size_t WS_END = 1421 * MiB;
static_assert(WS_PROJ + (size_t)M * NIN * 2 <= WS_END, "ws map");
static_assert(WS_ACT + (size_t)M * DFF * 2 <= WS_END, "ws map");
static_assert(WS_XEND + 8 * MiB <= WS_PROJ, "ws map");
static_assert(WS_UH + (size_t)(M / 256) * 4 * NUP * 4 <= WS_PROJ, "ws map");
constexpr int CW_TMO = 0, CW_BAR = 4096;

constexpr int LDS_BYTES = 155648;
constexpr int MISC_OFF = LDS_BYTES - 256;

#define RLX_AGENT __ATOMIC_RELAXED, __HIP_MEMORY_SCOPE_AGENT
#define LDS_WAIT() asm volatile("s_waitcnt lgkmcnt(0)" ::: "memory")
#define VM_WAIT() asm volatile("s_waitcnt vmcnt(0)" ::: "memory")
__device__ __forceinline__ unsigned f2bf(float f) { unsigned u = __builtin_bit_cast(unsigned, f); return (u + 0x7fffu + ((u >> 16) & 1u)) >> 16; }
__device__ __forceinline__ unsigned pk2(float lo, float hi) { return f2bf(lo) | (f2bf(hi) << 16); }
__device__ __forceinline__ float bflo(unsigned w) { return __builtin_bit_cast(float, w << 16); }
__device__ __forceinline__ float bfhi(unsigned w) { return __builtin_bit_cast(float, w & 0xffff0000u); }
__device__ __forceinline__ void unpack8(const u32x4 w, float (&v)[8]) { v[0] = bflo(w.x); v[1] = bfhi(w.x); v[2] = bflo(w.y); v[3] = bfhi(w.y); v[4] = bflo(w.z); v[5] = bfhi(w.z); v[6] = bflo(w.w); v[7] = bfhi(w.w); }
__device__ __forceinline__ u32x4 pack8(const float (&v)[8]) { u32x4 w; w.x = pk2(v[0], v[1]); w.y = pk2(v[2], v[3]); w.z = pk2(v[4], v[5]); w.w = pk2(v[6], v[7]); return w; }
__device__ __forceinline__ float sigmoidf_(float x) { return 1.0f / (1.0f + __expf(-x)); }
__device__ __forceinline__ float siluf_(float x) { return x / (1.0f + __expf(-x)); }
__device__ __forceinline__ float gelu_tanh(float x) { const float u = 1.5957691216f * (x + 0.044715f * x * x * x); return x / (1.0f + __expf(-u)); }
__device__ __forceinline__ float logsigmoidf_(float x) { return fminf(x, 0.f) - log1pf(__expf(-fabsf(x))); }

namespace pg8 {
constexpr int BM = 256, BK = 64, HALF = 128, HTB = HALF * BK * 2, STAGE_BYTES = 8 * HTB, NXCD = 8, WGM = 8;
__host__ __device__ __forceinline__ int lds_byte(int r, int c) { const int st = (r >> 4) * 2 + (c >> 5), rr = r & 15, cc = c & 31, ob = rr * 64 + cc * 2; return st * 1024 + (ob ^ (((ob >> 9) & 1) << 5)); }
__host__ __device__ __forceinline__ void stage_rc(int b, int& R, int& C) { const int st = b / 1024, sb = b % 1024, swz = sb ^ (((sb >> 9) & 1) << 5); R = (st >> 1) * 16 + swz / 64; C = (st & 1) * 32 + (swz % 64) / 2; }
__host__ __device__ __forceinline__ int perm32(int rho) { const int n = rho >> 4, i = rho & 15; return 8 * (i >> 2) + 4 * n + (i & 3); }

struct Unit { int pm, pn; };
struct Gemm { const bf16_t* A; const bf16_t* Bt; int M, N, K, lda, ldb; };

struct StaticOrder {
    int nM, nN, nwg, G, c;
    __host__ __device__ void init(int M_, int N_, int G_, int c_) { nM = M_ / BM; nN = N_ / BM; nwg = nM * nN; G = G_; c = c_; }
    __host__ __device__ bool next(int i, Unit& u) const {
        const long L = (long)i * G + c; if (L >= nwg) return false;
        int wgid = (int)L; { const int q = nwg / NXCD, r = nwg % NXCD, xcd = wgid % NXCD, off = wgid / NXCD; wgid = (xcd < r ? xcd * (q + 1) : r * (q + 1) + (xcd - r) * q) + off; }
        const int nig = WGM * nN, gid = wgid / nig, fm = gid * WGM, gsz = (nM - fm) < WGM ? (nM - fm) : WGM;
        u.pm = fm + ((wgid % nig) % gsz); u.pn = (wgid % nig) / gsz; return true;
    }
};

__device__ __forceinline__ unsigned cvt_pk_bf16(float lo, float hi) { unsigned r; asm volatile("v_cvt_pk_bf16_f32 %0, %1, %2" : "=v"(r) : "v"(lo), "v"(hi)); return r; }

struct EpiStoreBf16 {
    static constexpr bool PERM = true, KHOOK = false;
    bf16_t* O; int ldc;
    __device__ __forceinline__ void khook(f32x4 (&)[2][2][4][2], const Unit&, int, int, int, int, int) const {}
    __device__ __forceinline__ void operator()(const f32x4 (&acc)[2][2][4][2], const Unit& u, int wr, int wc, int fr, int fq) const {
        const int row0 = u.pm * BM + wr * 64 + fr, col0 = u.pn * BM + wc * 32 + 8 * fq;
#pragma unroll
        for (int ai = 0; ai < 2; ++ai)
#pragma unroll
            for (int m = 0; m < 4; ++m) { bf16_t* rowp = O + (size_t)(row0 + ai * HALF + m * 16) * ldc + col0;
#pragma unroll
                for (int bj = 0; bj < 2; ++bj) { const f32x4 v0 = acc[ai][bj][m][0], v1 = acc[ai][bj][m][1];
                    u32x4 w; w.x = cvt_pk_bf16(v0[0], v0[1]); w.y = cvt_pk_bf16(v0[2], v0[3]); w.z = cvt_pk_bf16(v1[0], v1[1]); w.w = cvt_pk_bf16(v1[2], v1[3]);
                    *(u32x4*)(rowp + bj * HALF) = w; } }
    }
};
struct EpiProj {
    static constexpr bool PERM = true, KHOOK = false;
    bf16_t* O; int ldc; int gate_pn0; int gate_col0;
    __device__ __forceinline__ void khook(f32x4 (&)[2][2][4][2], const Unit&, int, int, int, int, int) const {}
    __device__ __forceinline__ void operator()(const f32x4 (&acc)[2][2][4][2], const Unit& u, int wr, int wc, int fr, int fq) const {
        const int row0 = u.pm * BM + wr * 64 + fr;
        if (u.pn < gate_pn0) {
            const int col0 = u.pn * BM + wc * 32 + 8 * fq;
#pragma unroll
            for (int ai = 0; ai < 2; ++ai)
#pragma unroll
                for (int m = 0; m < 4; ++m) { bf16_t* rowp = O + (size_t)(row0 + ai * HALF + m * 16) * ldc + col0;
#pragma unroll
                    for (int bj = 0; bj < 2; ++bj) { const f32x4 v0 = acc[ai][bj][m][0], v1 = acc[ai][bj][m][1];
                        u32x4 w; w.x = cvt_pk_bf16(v0[0], v0[1]); w.y = cvt_pk_bf16(v0[2], v0[3]); w.z = cvt_pk_bf16(v1[0], v1[1]); w.w = cvt_pk_bf16(v1[2], v1[3]);
                        *(u32x4*)(rowp + bj * HALF) = w; } }
        } else {
            const int col0 = gate_col0 + 64 * (u.pn - gate_pn0) + 16 * wc + 4 * fq;
#pragma unroll
            for (int ai = 0; ai < 2; ++ai)
#pragma unroll
                for (int m = 0; m < 4; ++m) { bf16_t* rowp = O + (size_t)(row0 + ai * HALF + m * 16) * ldc + col0;
                    float r1[4], r2[4], r3[4], g3[4];
#pragma unroll
                    for (int i = 0; i < 4; ++i) {
                        const float e0 = __expf(-fminf(fmaxf(acc[ai][0][m][0][i], -30.f), 30.f)), e1 = __expf(-fminf(fmaxf(acc[ai][0][m][1][i], -30.f), 30.f));
                        const float e2 = __expf(-fminf(fmaxf(acc[ai][1][m][0][i], -30.f), 30.f)), e3 = __expf(-fminf(fmaxf(acc[ai][1][m][1][i], -30.f), 30.f));
                        const float i0 = __builtin_amdgcn_rcpf(1.f + e0), i1 = __builtin_amdgcn_rcpf(1.f + e1), i2 = __builtin_amdgcn_rcpf(1.f + e2), i3 = __builtin_amdgcn_rcpf(1.f + e3);
                        r1[i] = (1.f + e1) * i0; r2[i] = (1.f + e2) * i1; r3[i] = (1.f + e3) * i2; g3[i] = i3; }
                    u32x2 w;
                    w.x = cvt_pk_bf16(r1[0], r1[1]); w.y = cvt_pk_bf16(r1[2], r1[3]); *(u32x2*)(rowp) = w;
                    w.x = cvt_pk_bf16(r2[0], r2[1]); w.y = cvt_pk_bf16(r2[2], r2[3]); *(u32x2*)(rowp + D) = w;
                    w.x = cvt_pk_bf16(r3[0], r3[1]); w.y = cvt_pk_bf16(r3[2], r3[3]); *(u32x2*)(rowp + 2 * D) = w;
                    w.x = cvt_pk_bf16(g3[0], g3[1]); w.y = cvt_pk_bf16(g3[2], g3[3]); *(u32x2*)(rowp + 3 * D) = w; }
        }
    }
};
__device__ __forceinline__ float dpp_ror1(float x) { return __builtin_bit_cast(float, __builtin_amdgcn_update_dpp(0, __builtin_bit_cast(int, x), 0x121, 0xf, 0xf, false)); }
__device__ __forceinline__ float dpp_ror2(float x) { return __builtin_bit_cast(float, __builtin_amdgcn_update_dpp(0, __builtin_bit_cast(int, x), 0x122, 0xf, 0xf, false)); }
struct EpiConv {
    static constexpr bool PERM = true, KHOOK = false;
    const float* cw; const float* cb; bf16_t* O; float* UH; LAS float* halo;
    __device__ __forceinline__ void khook(f32x4 (&)[2][2][4][2], const Unit&, int, int, int, int, int) const {}
    __device__ __forceinline__ void operator()(const f32x4 (&acc)[2][2][4][2], const Unit& u, int wr, int wc, int fr_, int fq_) const {
        int fr = fr_, fq = fq_; asm volatile("" : "+v"(fr), "+v"(fq));
        const int cl0 = wc * 32 + 8 * fq;
        if (fr >= 14) {
#pragma unroll
            for (int ai = 0; ai < 2; ++ai)
#pragma unroll
                for (int bj = 0; bj < 2; ++bj)
#pragma unroll
                    for (int n = 0; n < 2; ++n) *(LAS f32x4*)(halo + (((2 * ai + wr) * 2 + (fr - 14)) * 256 + 128 * bj + cl0 + 4 * n)) = acc[ai][bj][3][n];
        }
        if (wr == 0 && fr < 2) {
#pragma unroll
            for (int bj = 0; bj < 2; ++bj)
#pragma unroll
                for (int n = 0; n < 2; ++n) *(f32x4*)(UH + ((size_t)u.pm * 4 + fr) * NUP + 256 * u.pn + 128 * bj + cl0 + 4 * n) = acc[0][bj][0][n];
        }
        if (wr == 1 && fr >= 14) {
#pragma unroll
            for (int bj = 0; bj < 2; ++bj)
#pragma unroll
                for (int n = 0; n < 2; ++n) *(f32x4*)(UH + ((size_t)u.pm * 4 + 2 + (fr - 14)) * NUP + 256 * u.pn + 128 * bj + cl0 + 4 * n) = acc[1][bj][3][n];
        }
        asm volatile("s_waitcnt lgkmcnt(0)" ::: "memory"); __builtin_amdgcn_s_barrier(); asm volatile("" ::: "memory");
        const int j0 = 128 * u.pn + cl0;
        const bool is15 = fr == 15, ge14 = fr >= 14;
        unsigned keep[2][4][2];
#pragma unroll
        for (int n = 0; n < 2; ++n) {
            f32x4 wa[3], wv[3];
#pragma unroll
            for (int q = 0; q < 3; ++q) { wa[q] = *(const f32x4*)(cw + q * NUP + j0 + 4 * n); wv[q] = *(const f32x4*)(cw + q * NUP + DFF + j0 + 4 * n); }
            const f32x4 ba = *(const f32x4*)(cb + j0 + 4 * n), bv = *(const f32x4*)(cb + DFF + j0 + 4 * n);
#pragma unroll
            for (int ai = 0; ai < 2; ++ai) {
                const int blk = 2 * ai + wr;
                f32x4 pa = (f32x4){0.f, 0.f, 0.f, 0.f}, pv = (f32x4){0.f, 0.f, 0.f, 0.f};
                if (blk > 0 && ge14) { pa = *(const LAS f32x4*)(halo + (((blk - 1) * 2 + (fr - 14)) * 256 + cl0 + 4 * n)); pv = *(const LAS f32x4*)(halo + (((blk - 1) * 2 + (fr - 14)) * 256 + 128 + cl0 + 4 * n)); }
#pragma unroll
                for (int m = 0; m < 4; ++m) {
                    const f32x4 ca_ = acc[ai][0][m][n], cv_ = acc[ai][1][m][n]; float o[4];
#pragma unroll
                    for (int i = 0; i < 4; ++i) {
                        const float a1 = dpp_ror1(is15 ? pa[i] : ca_[i]), a2 = dpp_ror2(ge14 ? pa[i] : ca_[i]);
                        const float v1 = dpp_ror1(is15 ? pv[i] : cv_[i]), v2 = dpp_ror2(ge14 ? pv[i] : cv_[i]);
                        const float ca = ba[i] + wa[0][i] * a2 + wa[1][i] * a1 + wa[2][i] * ca_[i];
                        const float cv = bv[i] + wv[0][i] * v2 + wv[1][i] * v1 + wv[2][i] * cv_[i];
                        o[i] = siluf_(ca) * cv; }
                    pa = ca_; pv = cv_;
                    const unsigned lo = cvt_pk_bf16(o[0], o[1]), hi = cvt_pk_bf16(o[2], o[3]);
                    if (n == 0) { keep[ai][m][0] = lo; keep[ai][m][1] = hi; }
                    else { u32x4 w; w.x = keep[ai][m][0]; w.y = keep[ai][m][1]; w.z = lo; w.w = hi;
                        *(u32x4*)(O + (size_t)(u.pm * BM + ai * HALF + wr * 64 + m * 16 + fr) * DFF + j0) = w; }
                }
            }
        }
    }
};
struct EpiResid {
    static constexpr bool PERM = false, KHOOK = false;
    const float* base; float* out; int ldc;
    __device__ __forceinline__ void khook(f32x4 (&)[2][2][4][2], const Unit&, int, int, int, int, int) const {}
    __device__ __forceinline__ void operator()(const f32x4 (&acc)[2][2][4][2], const Unit& u, int wr, int wc, int fr, int fq) const {
        const int row0 = u.pm * BM + wr * 64 + fr, col0 = u.pn * BM + wc * 32 + 4 * fq;
#pragma unroll
        for (int ai = 0; ai < 2; ++ai)
#pragma unroll
            for (int m = 0; m < 4; ++m) { const size_t off = (size_t)(row0 + ai * HALF + m * 16) * ldc + col0;
#pragma unroll
                for (int bj = 0; bj < 2; ++bj)
#pragma unroll
                    for (int n = 0; n < 2; ++n) { const f32x4 bs = *(const f32x4*)(base + off + bj * HALF + n * 16); *(f32x4*)(out + off + bj * HALF + n * 16) = bs + acc[ai][bj][m][n]; }
                asm volatile("" ::: "memory"); }
    }
};
struct EpiGlu {
    static constexpr bool PERM = true, KHOOK = false;
    const bf16_t* Yp; int ldy; bf16_t* O; int ldc;
    __device__ __forceinline__ void khook(f32x4 (&)[2][2][4][2], const Unit&, int, int, int, int, int) const {}
    __device__ __forceinline__ void operator()(const f32x4 (&acc)[2][2][4][2], const Unit& u, int wr, int wc, int fr, int fq) const {
        const int row0 = u.pm * BM + wr * 64 + fr, col0 = u.pn * BM + wc * 32 + 8 * fq;
#pragma unroll
        for (int ai = 0; ai < 2; ++ai)
#pragma unroll
            for (int m = 0; m < 4; ++m) { const size_t r = (size_t)(row0 + ai * HALF + m * 16);
#pragma unroll
                for (int bj = 0; bj < 2; ++bj) { const u32x4 yw = *(const u32x4*)(Yp + r * ldy + col0 + bj * HALF); float y[8]; unpack8(yw, y);
                    const f32x4 v0 = acc[ai][bj][m][0], v1 = acc[ai][bj][m][1]; float o[8];
#pragma unroll
                    for (int j = 0; j < 4; ++j) { o[j] = y[j] * sigmoidf_(v0[j]); o[4 + j] = y[4 + j] * sigmoidf_(v1[j]); }
                    u32x4 w; w.x = cvt_pk_bf16(o[0], o[1]); w.y = cvt_pk_bf16(o[2], o[3]); w.z = cvt_pk_bf16(o[4], o[5]); w.w = cvt_pk_bf16(o[6], o[7]);
                    *(u32x4*)(O + r * ldc + col0 + bj * HALF) = w; } }
    }
};
struct EpiMerge {
    static constexpr bool PERM = true, KHOOK = true;
    const bf16_t* G; int ldg; bf16_t* O; int ldc;
    __device__ __forceinline__ void scale(f32x4 (&acc)[2][2][4][2], const Unit& u, int s, int wr, int wc, int fr, int fq) const {
        int row0 = u.pm * BM + wr * 64 + fr, col0 = u.pn * BM + wc * 32 + 8 * fq + s * D; asm volatile("" : "+v"(row0), "+v"(col0));
        u32x4 w[2][4][2];
#pragma unroll
        for (int ai = 0; ai < 2; ++ai)
#pragma unroll
            for (int m = 0; m < 4; ++m) { const bf16_t* gp = G + (size_t)(row0 + ai * HALF + m * 16) * ldg + col0;
#pragma unroll
                for (int bj = 0; bj < 2; ++bj) w[ai][m][bj] = *(const u32x4*)(gp + bj * HALF); }
#pragma unroll
        for (int ai = 0; ai < 2; ++ai)
#pragma unroll
            for (int m = 0; m < 4; ++m)
#pragma unroll
                for (int bj = 0; bj < 2; ++bj) { float f[8]; unpack8(w[ai][m][bj], f);
#pragma unroll
                    for (int j = 0; j < 8; ++j) acc[ai][bj][m][j >> 2][j & 3] *= f[j]; }
    }
    __device__ __forceinline__ void khook(f32x4 (&acc)[2][2][4][2], const Unit& u, int seg, int wr, int wc, int fr, int fq) const { scale(acc, u, seg - 1, wr, wc, fr, fq); }
    __device__ __forceinline__ void operator()(f32x4 (&acc)[2][2][4][2], const Unit& u, int wr, int wc, int fr, int fq) const {
        scale(acc, u, 3, wr, wc, fr, fq);
        const int row0 = u.pm * BM + wr * 64 + fr, col0 = u.pn * BM + wc * 32 + 8 * fq;
#pragma unroll
        for (int ai = 0; ai < 2; ++ai)
#pragma unroll
            for (int m = 0; m < 4; ++m) { bf16_t* rowp = O + (size_t)(row0 + ai * HALF + m * 16) * ldc + col0;
#pragma unroll
                for (int bj = 0; bj < 2; ++bj) { const f32x4 v0 = acc[ai][bj][m][0], v1 = acc[ai][bj][m][1];
                    u32x4 w; w.x = cvt_pk_bf16(v0[0], v0[1]); w.y = cvt_pk_bf16(v0[2], v0[3]); w.z = cvt_pk_bf16(v1[0], v1[1]); w.w = cvt_pk_bf16(v1[2], v1[3]);
                    *(u32x4*)(rowp + bj * HALF) = w; } }
    }
};

template <class Epi>
__device__ __forceinline__ void gemm_phase(LAS unsigned char* lds, const Gemm g, const StaticOrder& S, const Epi& E, int tid_in) {
    int tid_ = tid_in; asm volatile("" : "+v"(tid_));
    const int tid = tid_, wid = __builtin_amdgcn_readfirstlane(tid >> 6), lane = tid & 63, wr = wid >> 2, wc = wid & 3, fr = lane & 15, fq = lane >> 4;
    const int K = g.K, nt = K / BK;
    unsigned voffA[2], voffB[2];
#pragma unroll
    for (int i = 0; i < 2; ++i) { int R, C; stage_rc(tid * 16 + i * 8192, R, C); const int Rb = Epi::PERM ? ((R & ~31) + perm32(R & 31)) : R;
        voffA[i] = (unsigned)(R * g.lda + C) * 2u; voffB[i] = (unsigned)(Rb * g.ldb + C) * 2u; }
    const size_t kstep = (size_t)(BK * 2);
    const size_t hstepA = (size_t)HALF * g.lda * 2, hstepB = (size_t)HALF * g.ldb * 2;
    const size_t tstepA = 2 * hstepA, tstepB = 2 * hstepB;
    const unsigned ldsw = (unsigned)wid * 1024u;
    const int aoff = lds_byte(wr * 64 + fr, fq * 8), boff = lds_byte(wc * 32 + fr, fq * 8);
#define PG8_SA(b, h) (((b) * 2 + (h)) * HTB)
#define PG8_SB(b, h) ((4 + (b) * 2 + (h)) * HTB)
#define PG8_STAGE(bufoff, gbase, voff) do { _Pragma("unroll") for (int _i = 0; _i < 2; ++_i) \
        __builtin_amdgcn_global_load_lds((const unsigned*)((const char*)(gbase) + (voff)[_i]), (LAS unsigned*)(lds + (bufoff) + ldsw + _i * 8192), 16, 0, 0); } while (0)
#define PG8_LDA(dst, b, h) do { _Pragma("unroll") for (int m = 0; m < 4; ++m) _Pragma("unroll") for (int k = 0; k < 2; ++k) dst[m][k] = *(const LAS bf16x8*)(lds + PG8_SA(b, h) + aoff + m * 2048 + k * 1024); } while (0)
#define PG8_LDB(dst, b, h) do { _Pragma("unroll") for (int n = 0; n < 2; ++n) _Pragma("unroll") for (int k = 0; k < 2; ++k) dst[n][k] = *(const LAS bf16x8*)(lds + PG8_SB(b, h) + boff + n * 2048 + k * 1024); } while (0)
#define PG8_MMA(ai, bj, At, Bt) do { __builtin_amdgcn_s_setprio(1); _Pragma("unroll") for (int m = 0; m < 4; ++m) _Pragma("unroll") for (int n = 0; n < 2; ++n) _Pragma("unroll") for (int k = 0; k < 2; ++k) \
        acc[ai][bj][m][n] = __builtin_amdgcn_mfma_f32_16x16x32_bf16(Bt[n][k], At[m][k], acc[ai][bj][m][n], 0, 0, 0); __builtin_amdgcn_s_setprio(0); } while (0)
#define PG8_WAIT_V(n) asm volatile("s_waitcnt vmcnt(" #n ")" ::: "memory")
#define PG8_WAIT_L(n) asm volatile("s_waitcnt lgkmcnt(" #n ")" ::: "memory")
#define PG8_BAR __builtin_amdgcn_s_barrier()
#define PG8_SCHED __builtin_amdgcn_sched_barrier(0)
    Unit cur, nxt; int ui = 0;
    if (!S.next(0, cur)) return;
    f32x4 acc[2][2][4][2];
#pragma unroll
    for (int a = 0; a < 2; ++a)
#pragma unroll
        for (int b = 0; b < 2; ++b)
#pragma unroll
            for (int m = 0; m < 4; ++m)
#pragma unroll
                for (int n = 0; n < 2; ++n) acc[a][b][m][n] = (f32x4){0.f, 0.f, 0.f, 0.f};
    bf16x8 At[4][2], B0[2][2], B1[2][2];
    const char* cA = (const char*)g.A + (size_t)cur.pm * tstepA; const char* cB = (const char*)g.Bt + (size_t)cur.pn * tstepB;
    PG8_STAGE(PG8_SB(0, 0), cB, voffB); PG8_STAGE(PG8_SB(0, 1), cB + hstepB, voffB); PG8_STAGE(PG8_SA(0, 0), cA, voffA); PG8_STAGE(PG8_SA(0, 1), cA + hstepA, voffA);
    if (wr == 1) PG8_BAR;
    PG8_WAIT_V(2); PG8_BAR;
    PG8_STAGE(PG8_SB(1, 0), cB + kstep, voffB); PG8_STAGE(PG8_SA(1, 0), cA + kstep, voffA); PG8_STAGE(PG8_SB(1, 1), cB + hstepB + kstep, voffB);
    PG8_WAIT_V(6); PG8_BAR;
    for (;;) {
        const bool has_next = S.next(ui + 1, nxt);
        const char* nA = has_next ? (const char*)g.A + (size_t)nxt.pm * tstepA : cA; const char* nB = has_next ? (const char*)g.Bt + (size_t)nxt.pn * tstepB : cB;
        for (int t = 0; t < nt; t += 2) {
            const bool last = (t == nt - 2);
            const char* a1 = cA + (size_t)(t + 1) * kstep;
            const char* a2 = last ? nA : cA + (size_t)(t + 2) * kstep; const char* b2 = last ? nB : cB + (size_t)(t + 2) * kstep;
            const char* a3 = a2 + kstep; const char* b3 = b2 + kstep;
            if constexpr (Epi::KHOOK) { if (t != 0 && (t & 7) == 0) E.khook(acc, cur, t >> 3, wr, wc, fr, fq); }
            PG8_LDB(B0, 0, 0); PG8_LDB(B1, 0, 1); PG8_SCHED; PG8_LDA(At, 0, 0); PG8_STAGE(PG8_SA(1, 1), a1 + hstepA, voffA);
            PG8_WAIT_V(8); PG8_WAIT_L(0); PG8_BAR; PG8_MMA(0, 0, At, B0); PG8_MMA(0, 1, At, B1); PG8_BAR; PG8_SCHED;
            PG8_LDA(At, 0, 1); PG8_STAGE(PG8_SB(0, 0), b2, voffB); PG8_STAGE(PG8_SB(0, 1), b2 + hstepB, voffB); PG8_STAGE(PG8_SA(0, 0), a2, voffA);
            PG8_WAIT_V(8); PG8_WAIT_L(0); PG8_BAR; PG8_MMA(1, 0, At, B0); PG8_MMA(1, 1, At, B1); PG8_BAR; PG8_SCHED;
            PG8_LDB(B0, 1, 0); PG8_LDB(B1, 1, 1); PG8_SCHED; PG8_LDA(At, 1, 0); PG8_STAGE(PG8_SA(0, 1), a2 + hstepA, voffA);
            PG8_WAIT_V(8); PG8_WAIT_L(0); PG8_BAR; PG8_MMA(0, 0, At, B0); PG8_MMA(0, 1, At, B1); PG8_BAR; PG8_SCHED;
            PG8_LDA(At, 1, 1); PG8_STAGE(PG8_SB(1, 0), b3, voffB); PG8_STAGE(PG8_SB(1, 1), b3 + hstepB, voffB); PG8_STAGE(PG8_SA(1, 0), a3, voffA);
            PG8_WAIT_V(8); PG8_WAIT_L(0); PG8_BAR; PG8_MMA(1, 0, At, B0); PG8_MMA(1, 1, At, B1); PG8_BAR; PG8_SCHED;
        }
        if (wr == 0) PG8_BAR;
        E(acc, cur, wr, wc, fr, fq);
        if (!has_next) break;
#pragma unroll
        for (int a = 0; a < 2; ++a)
#pragma unroll
            for (int b = 0; b < 2; ++b)
#pragma unroll
                for (int m = 0; m < 4; ++m)
#pragma unroll
                    for (int n = 0; n < 2; ++n) acc[a][b][m][n] = (f32x4){0.f, 0.f, 0.f, 0.f};
        cur = nxt; cA = nA; cB = nB; ++ui;
        if (wr == 1) PG8_BAR;
    }
    PG8_WAIT_V(0);
    PG8_BAR;
#undef PG8_SA
#undef PG8_SB
#undef PG8_STAGE
#undef PG8_LDA
#undef PG8_LDB
#undef PG8_MMA
#undef PG8_WAIT_V
#undef PG8_WAIT_L
#undef PG8_BAR
#undef PG8_SCHED
}
}

#define XB_TMO      128
#define XB_XCNT(j)  (256  + 64 * (j))
#define XB_XSUB(j)  (1280 + 64 * (j))
#define XB_XGEN(j)  (2304 + 64 * (j))
#define XB_TOP      3328
#define XB_TOPGEN   3392
#define XCD_BAR_WORDS 3456
#define XB_SPIN_CAP (1u << 18)
__device__ __forceinline__ unsigned xb_ld(unsigned* p)              { return __hip_atomic_load(p, __ATOMIC_RELAXED, __HIP_MEMORY_SCOPE_AGENT); }
__device__ __forceinline__ unsigned xb_add(unsigned* p, unsigned v) { return __hip_atomic_fetch_add(p, v, __ATOMIC_RELAXED, __HIP_MEMORY_SCOPE_AGENT); }
__device__ __forceinline__ unsigned xb_xcc_id() { return (unsigned)__builtin_amdgcn_s_getreg((3 << 11) | 20) & 0xFu; }
#define XB_SPIN(cond, bar) do { unsigned _sp = 0; while (cond) { __builtin_amdgcn_s_sleep(1); \
    if ((++_sp & 255u) == 0u) { if (xb_ld(&(bar)[XB_TMO])) break; if (_sp > XB_SPIN_CAP) { atomicAdd(&(bar)[XB_TMO], 1u); break; } } } } while (0)
struct XcdBarrier { unsigned* bar; unsigned x; volatile LAS unsigned* st; };
__device__ __forceinline__ XcdBarrier xcd_barrier_post(unsigned* bar, volatile LAS unsigned* st) {
    XcdBarrier b; b.bar = bar; b.x = xb_xcc_id(); b.st = st;
    if (threadIdx.x == 0) (void)xb_add(&bar[XB_XCNT(b.x)], 1u);
    return b;
}
__device__ __forceinline__ void xcd_barrier_complete(unsigned* bar, unsigned x, unsigned& nloc, unsigned& nx) {
    const unsigned G = gridDim.x * gridDim.y * gridDim.z;
    unsigned sum, cnt, mine, sp = 0u;
    for (;;) {
        sum = 0u; cnt = 0u; mine = 0u;
#pragma nounroll
        for (unsigned j = 0; j < 16; ++j) { const unsigned c = xb_ld(&bar[XB_XCNT(j)]); sum += c; cnt += (c > 0u) ? 1u : 0u; mine = (j == x) ? c : mine; }
        if (sum == G) break;
        __builtin_amdgcn_s_sleep(1);
        if ((++sp & 255u) == 0u) { if (xb_ld(&bar[XB_TMO])) break; if (sp > XB_SPIN_CAP) { atomicAdd(&bar[XB_TMO], 1u); break; } }
    }
    nloc = mine > 0u ? mine : 1u; nx = cnt > 0u ? cnt : 1u;
}
__device__ __forceinline__ void xcd_barrier(const XcdBarrier& b) {
    asm volatile("s_waitcnt vmcnt(0)" ::: "memory");
    __syncthreads();
    if (threadIdx.x == 0) {
        unsigned* bar = b.bar;
        __builtin_amdgcn_s_waitcnt(0);
        unsigned nloc = b.st[0], nx = b.st[1];
        if (nloc == 0u) { xcd_barrier_complete(bar, b.x, nloc, nx); b.st[0] = nloc; b.st[1] = nx; }
        const unsigned old = xb_add(&bar[XB_XSUB(b.x)], 1u);
        const unsigned gen = old / nloc;
        if (old + 1u == (gen + 1u) * nloc) {
            __builtin_amdgcn_fence(__ATOMIC_RELEASE, "agent");
            asm volatile("s_waitcnt vmcnt(0)" ::: "memory");
            const unsigned og = xb_add(&bar[XB_TOP], 1u);
            const unsigned tg = og / nx;
            if (og + 1u == (tg + 1u) * nx) xb_add(&bar[XB_TOPGEN], 1u);
            else XB_SPIN(xb_ld(&bar[XB_TOPGEN]) == tg, bar);
            __builtin_amdgcn_fence(__ATOMIC_ACQUIRE, "agent");
            xb_add(&bar[XB_XGEN(b.x)], 1u);
            asm volatile("s_waitcnt vmcnt(0)" ::: "memory");
        } else {
            XB_SPIN(xb_ld(&bar[XB_XGEN(b.x)]) == gen, bar);
            __builtin_amdgcn_fence(__ATOMIC_ACQUIRE, "agent");
            asm volatile("s_waitcnt vmcnt(0)" ::: "memory");
        }
    }
    __syncthreads();
}

__device__ __forceinline__ const void* kin(int k) {
    typedef __attribute__((address_space(4))) const char* kptr_t;
    kptr_t p = (kptr_t)__builtin_amdgcn_kernarg_segment_ptr(); asm volatile("" : "+s"(p));
    const unsigned long long v = *(__attribute__((address_space(4))) const unsigned long long*)(p + 8 * k);
    return (const void*)(GAS const void*)v;
}
struct Frame {
    LAS unsigned char* lds;
    int tid, lane, wave, vcu, G;
    unsigned char* ws; float* out;
#define FIN(name, T, k) __device__ __forceinline__ const T* name() const { return (const T*)kin(k); }
    FIN(x, float, 0) FIN(pos, int, 1) FIN(g_mix, float, 2) FIN(w_in, float, 3) FIN(a_re, float, 4) FIN(a_im, float, 5) FIN(log_dt, float, 6) FIN(b_re, float, 7) FIN(b_im, float, 8)
    FIN(c_re, float, 9) FIN(c_im, float, 10) FIN(s5_d, float, 11) FIN(w_glu, float, 12) FIN(gla_wg, float, 13) FIN(gla_bg, float, 14) FIN(pool_w, float, 15) FIN(pool_scale, float, 16)
    FIN(w_branch, float, 17) FIN(w_out, float, 18) FIN(g_ffn, float, 19) FIN(w_up, float, 20) FIN(conv_w, float, 21) FIN(conv_b, float, 22) FIN(w_down, float, 23) FIN(g_final, float, 24)
#undef FIN
#define FWS(name, T, off) __device__ __forceinline__ T* name() const { return (T*)(ws + (off)); }
    FWS(rotc, float, WS_ROT) FWS(rots, float, WS_ROT + (size_t)M * 32 * 4) FWS(abar, float, WS_S5T + S5T_ABAR) FWS(apow, float, WS_S5T + S5T_APOW) FWS(bbar, float, WS_S5T + S5T_BBAR) FWS(cmt, bf16_t, WS_S5T + S5T_CMT)
    FWS(wglu_t, bf16_t, WS_WGLU) FWS(poolw_t, bf16_t, WS_POOLW) FWS(win_t, bf16_t, WS_WIN) FWS(wbr_t, bf16_t, WS_WBR) FWS(wout_t, bf16_t, WS_WOUT) FWS(wup_t, bf16_t, WS_WUP) FWS(wdn_t, bf16_t, WS_WDN)
    FWS(HN, bf16_t, WS_HN) FWS(Y, bf16_t, WS_Y) FWS(YBP, bf16_t, WS_YBP) FWS(PROJ, bf16_t, WS_PROJ) FWS(SPREV, bf16_t, WS_SPREV) FWS(ACT, bf16_t, WS_ACT)
    FWS(STATE, float, WS_STATE) FWS(DEC, float, WS_DEC) FWS(XEND, float, WS_XEND) FWS(UH, float, WS_UH)
#undef FWS
};

__device__ __forceinline__ float wave_sum(float v) {
#pragma unroll
    for (int o = 1; o < 64; o <<= 1) v += __shfl_xor(v, o);
    return v;
}

template <class SrcCol>
__device__ __forceinline__ void transpose_item(const float* W, int Nsrc, bf16_t* WT, int ldt, int kdst0, int k0, int n0, SrcCol srccol, LAS float* scr, int lane) {
    const int sc = srccol(n0 + (lane & 31));
#pragma unroll 8
    for (int i = 0; i < 32; ++i) { const int kk = 2 * i + (lane >> 5); scr[kk * 33 + (lane & 31)] = sc >= 0 ? W[(size_t)(k0 + kk) * Nsrc + sc] : 0.f; }
    LDS_WAIT();
    const int c = lane & 7;
#pragma unroll
    for (int j = 0; j < 4; ++j) { const int n = (lane >> 3) + 8 * j; const LAS float* s = scr + (8 * c) * 33 + n;
        u32x4 o; o.x = pk2(s[0 * 33], s[1 * 33]); o.y = pk2(s[2 * 33], s[3 * 33]); o.z = pk2(s[4 * 33], s[5 * 33]); o.w = pk2(s[6 * 33], s[7 * 33]);
        *(u32x4*)(WT + (size_t)(n0 + n) * ldt + kdst0 + k0 + 8 * c) = o; }
    LDS_WAIT();
}
struct ColIdent { __device__ __forceinline__ int operator()(int n) const { return n; } };
struct ColWin { __device__ __forceinline__ int operator()(int n) const {
    if (n < 3584) return n; if (n < 4096) return n + 16; if (n < 4112) return n - 512; if (n < 4352) return -1;
    const int t = (n - 4352) >> 8, cl = (n - 4352) & 255; const int br = 2 * (cl >> 7) + ((cl >> 2) & 1), ch = 16 * ((cl >> 5) & 3) + 4 * ((cl >> 3) & 3) + (cl & 3);
    return 4112 + br * 2048 + 64 * t + ch; } };
struct ColWup { __device__ __forceinline__ int operator()(int n) const { const int blk = n >> 8, r = n & 255; return (r < 128) ? (blk * 128 + r) : (DFF + blk * 128 + (r - 128)); } };

__device__ __forceinline__ void rms_row_to_bf16(const float* xrow, const float* g, bf16_t* orow, int lane) {
    const f32x4* xr = (const f32x4*)xrow + lane; const f32x4* gr = (const f32x4*)g + lane;
    f32x4 v[8]; float s = 0.f;
#pragma unroll
    for (int j = 0; j < 8; ++j) { v[j] = xr[64 * j]; s += (v[j].x * v[j].x + v[j].y * v[j].y) + (v[j].z * v[j].z + v[j].w * v[j].w); }
    const float r = 1.0f / sqrtf(wave_sum(s) * (1.f / D) + EPS);
    u32x2* o8 = (u32x2*)orow + lane;
#pragma unroll
    for (int j = 0; j < 8; ++j) { const f32x4 gg = gr[64 * j]; u32x2 w; w.x = pk2(v[j].x * r * gg.x, v[j].y * r * gg.y); w.y = pk2(v[j].z * r * gg.z, v[j].w * r * gg.w); o8[64 * j] = w; }
}
__device__ __forceinline__ void rms_rows(Frame& F, const float* src, const float* g, bf16_t* dst) {
    const int gw = F.vcu * NWAVES + F.wave, NGW = F.G * NWAVES;
    for (int m = gw; m < M; m += NGW) rms_row_to_bf16(src + (size_t)m * D, g, dst + (size_t)m * D, F.lane);
}
__device__ __forceinline__ void rms_rows_f32_inplace(Frame& F, float* buf, const float* g) {
    const int gw = F.vcu * NWAVES + F.wave, NGW = F.G * NWAVES;
    for (int m = gw; m < M; m += NGW) {
        f32x4* xr = (f32x4*)(buf + (size_t)m * D) + F.lane; const f32x4* gr = (const f32x4*)g + F.lane;
        f32x4 v[8]; float s = 0.f;
#pragma unroll
        for (int j = 0; j < 8; ++j) { v[j] = xr[64 * j]; s += (v[j].x * v[j].x + v[j].y * v[j].y) + (v[j].z * v[j].z + v[j].w * v[j].w); }
        const float r = 1.0f / sqrtf(wave_sum(s) * (1.f / D) + EPS);
#pragma unroll
        for (int j = 0; j < 8; ++j) { const f32x4 gg = gr[64 * j]; xr[64 * j] = (f32x4){v[j].x * r * gg.x, v[j].y * r * gg.y, v[j].z * r * gg.z, v[j].w * r * gg.w}; }
    }
}

__device__ __forceinline__ void phase_prep(Frame& F, int l) {
    LAS float* scr = (LAS float*)(F.lds + F.wave * 16384);
    const int gw = F.vcu * NWAVES + F.wave, NGW = F.G * NWAVES;
    constexpr int I_IN = (D / 64) * (NIN / 32), I_UP = (D / 64) * (NUP / 32), I_DN = (DFF / 64) * (D / 32), I_BR = 4 * (BW / 64) * (D / 32), I_OUT = (D / 64) * (D / 32), I_GLU = (BW / 64) * (BW / 32), I_PL = 4 * (128 / 64) * (128 / 32);
    constexpr int NITEMS = I_IN + I_UP + I_DN + I_BR + I_OUT + I_GLU + I_PL;
    for (int it = gw; it < NITEMS; it += NGW) {
        int r = it;
        if (r < I_IN) { const int nb = NIN / 32; transpose_item(F.w_in() + (size_t)l * D * NIN_SRC, NIN_SRC, F.win_t(), D, 0, 64 * (r / nb), 32 * (r % nb), ColWin(), scr, F.lane); continue; } r -= I_IN;
        if (r < I_UP) { const int nb = NUP / 32; transpose_item(F.w_up() + (size_t)l * D * NUP, NUP, F.wup_t(), D, 0, 64 * (r / nb), 32 * (r % nb), ColWup(), scr, F.lane); continue; } r -= I_UP;
        if (r < I_DN) { const int nb = D / 32; transpose_item(F.w_down() + (size_t)l * DFF * D, D, F.wdn_t(), DFF, 0, 64 * (r / nb), 32 * (r % nb), ColIdent(), scr, F.lane); continue; } r -= I_DN;
        if (r < I_BR) { const int per = (BW / 64) * (D / 32), br = r / per, q = r % per, nb = D / 32;
            transpose_item(F.w_branch() + ((size_t)l * 4 + br) * BW * D, D, F.wbr_t(), D, br * BW, 64 * (q / nb), 32 * (q % nb), ColIdent(), scr, F.lane); continue; } r -= I_BR;
        if (r < I_OUT) { const int nb = D / 32; transpose_item(F.w_out() + (size_t)l * D * D, D, F.wout_t(), D, 0, 64 * (r / nb), 32 * (r % nb), ColIdent(), scr, F.lane); continue; } r -= I_OUT;
        if (r < I_GLU) { const int nb = BW / 32; transpose_item(F.w_glu() + (size_t)l * BW * BW, BW, F.wglu_t(), BW, 0, 64 * (r / nb), 32 * (r % nb), ColIdent(), scr, F.lane); continue; } r -= I_GLU;
        { const int grp = r / 8, q = r % 8; transpose_item(F.pool_w() + ((size_t)l * 4 + grp) * 128 * 128, 128, F.poolw_t() + (size_t)grp * 128 * 128, 128, 0, 64 * (q / 4), 32 * (q % 4), ColIdent(), scr, F.lane); }
    }
    const int gt = F.vcu * (NWAVES * 64) + F.tid, NGT = F.G * NWAVES * 64;
    for (int i = gt; i < 32 * 64; i += NGT) {
        const int g = i >> 6;
        const float are = F.a_re()[(size_t)l * 2048 + i], aim = F.a_im()[(size_t)l * 2048 + i], dt = expf(F.log_dt()[l * 32 + g]);
        const float mag = expf(are * dt), th = aim * dt;
        const float abr = mag * cosf(th), abi = mag * sinf(th);
        const float den = are * are + aim * aim, nr = abr - 1.0f, ni = abi;
        const float fre = (nr * are + ni * aim) / den, fim = (ni * are - nr * aim) / den;
        F.abar()[2 * i] = abr; F.abar()[2 * i + 1] = abi;
        float pr = abr, pi = abi;
#pragma unroll
        for (int q = 0; q < 6; ++q) { const float tr = pr * pr - pi * pi, ti = 2.f * pr * pi; pr = tr; pi = ti; }
        F.apow()[2 * i] = pr; F.apow()[2 * i + 1] = pi;
        const float* br = F.b_re() + ((size_t)l * 2048 + i) * 16; const float* bi = F.b_im() + ((size_t)l * 2048 + i) * 16;
#pragma unroll
        for (int c = 0; c < 16; ++c) { const float x = br[c], y = bi[c]; F.bbar()[(size_t)i * 32 + 2 * c] = fre * x - fim * y; F.bbar()[(size_t)i * 32 + 2 * c + 1] = fre * y + fim * x; }
    }
    for (int i = gt; i < 32 * 16 * 128; i += NGT) {
        const int k = i & 127, gc = i >> 7;
        const float v = (k < 64) ? F.c_re()[((size_t)l * 512 + gc) * 64 + k] : -F.c_im()[((size_t)l * 512 + gc) * 64 + (k - 64)];
        F.cmt()[i] = (bf16_t)f2bf(v);
    }
    if (l == 0) {
        for (int i = gt; i < M * 32; i += NGT) {
            const int row = i >> 5, j = i & 31;
            const float inv = exp2f(-(float)j * (13.287712379549449f / 32.0f));
            const float ang = (float)F.pos()[row] * inv;
            F.rotc()[i] = cosf(ang); F.rots()[i] = sinf(ang);
        }
    }
    rms_rows(F, l == 0 ? F.x() : F.out, F.g_mix() + (size_t)l * D, F.HN());
}

__device__ __forceinline__ f32x4 mma_nt_lds(const LAS bf16_t* X, int px, const LAS bf16_t* Y, int py, int ksteps, f32x4 acc, int lane) {
    const LAS bf16_t* xp = X + (lane & 15) * px + 8 * (lane >> 4);
    const LAS bf16_t* yp = Y + (lane & 15) * py + 8 * (lane >> 4);
    for (int ks = 0; ks < ksteps; ++ks) {
        const bf16x8 a = *(const LAS bf16x8*)(xp + 32 * ks), b = *(const LAS bf16x8*)(yp + 32 * ks);
        acc = __builtin_amdgcn_mfma_f32_16x16x32_bf16(a, b, acc, 0, 0, 0);
    }
    return acc;
}

constexpr int LN_B = 0, LN_TOT = 16384, LN_QD = 18432, LN_KI = 27648, LN_PM = 36864, LN_VT = 46080, LN_OB = 64512, LN_END = 98304;
constexpr int LP = 72;

__device__ __forceinline__ void lin_decay(Frame& F, int l, int mixer, size_t row0, int h) {
    LAS float* B = (LAS float*)(F.lds + LN_B); LAS float* TOT = (LAS float*)(F.lds + LN_TOT);
    const int t = F.tid >> 3, d0 = (F.tid & 7) * 8;
    if (mixer == 0) {
        const float lg = log1pf(-exp2f(-5.0f - (float)h));
#pragma unroll
        for (int j = 0; j < 8; ++j) B[t * 64 + d0 + j] = (float)(t + 1) * lg;
        __syncthreads();
        return;
    }
    const bf16_t* gr = F.PROJ() + (row0 + t) * NIN + C_GR;
    float grf[16]; { float a[8], b[8]; unpack8(*(const u32x4*)gr, a); unpack8(*(const u32x4*)(gr + 8), b);
#pragma unroll
        for (int j = 0; j < 8; ++j) { grf[j] = a[j]; grf[8 + j] = b[j]; } }
    const float* Wg = F.gla_wg() + (size_t)l * 16 * 256 + h * 64 + d0; const float* bg = F.gla_bg() + l * 256 + h * 64 + d0;
    float acc[8]; { const f32x4 b0 = *(const f32x4*)bg, b1 = *(const f32x4*)(bg + 4); acc[0] = b0.x; acc[1] = b0.y; acc[2] = b0.z; acc[3] = b0.w; acc[4] = b1.x; acc[5] = b1.y; acc[6] = b1.z; acc[7] = b1.w; }
#pragma unroll
    for (int r = 0; r < 16; ++r) { const f32x4 w0 = *(const f32x4*)(Wg + r * 256), w1 = *(const f32x4*)(Wg + r * 256 + 4);
        acc[0] += grf[r] * w0.x; acc[1] += grf[r] * w0.y; acc[2] += grf[r] * w0.z; acc[3] += grf[r] * w0.w; acc[4] += grf[r] * w1.x; acc[5] += grf[r] * w1.y; acc[6] += grf[r] * w1.z; acc[7] += grf[r] * w1.w; }
#pragma unroll
    for (int j = 0; j < 8; ++j) B[t * 64 + d0 + j] = logsigmoidf_(acc[j]) * (1.0f / 16.0f);
    __syncthreads();
    const int part = F.wave, d = F.lane;
    float v[8];
#pragma unroll
    for (int i = 0; i < 8; ++i) v[i] = B[(8 * part + i) * 64 + d];
#pragma unroll
    for (int i = 1; i < 8; ++i) v[i] += v[i - 1];
    TOT[part * 64 + d] = v[7];
    __syncthreads();
    float off = 0.f;
#pragma unroll
    for (int q = 0; q < 7; ++q) { const float tq = TOT[q * 64 + d]; off += (q < part) ? tq : 0.f; }
#pragma unroll
    for (int i = 0; i < 8; ++i) B[(8 * part + i) * 64 + d] = v[i] + off;
    __syncthreads();
}
__device__ __forceinline__ void lin_load_qk(Frame& F, size_t row, int col0, int c, bool rot, float scale, float (&v)[8]) {
    const bf16_t* p = F.PROJ() + row * NIN + col0;
    float own[8]; unpack8(*(const u32x4*)(p + 8 * c), own);
    if (!rot) {
#pragma unroll
        for (int j = 0; j < 8; ++j) v[j] = own[j] * scale;
        return;
    }
    float oth[8]; unpack8(*(const u32x4*)(p + 8 * (c ^ 4)), oth);
    const int i0 = (c & 3) * 8; const bool hi = c >= 4;
    const float* cp = F.rotc() + row * 32 + i0; const float* sp = F.rots() + row * 32 + i0;
    const f32x4 c0 = *(const f32x4*)cp, c1 = *(const f32x4*)(cp + 4), s0 = *(const f32x4*)sp, s1 = *(const f32x4*)(sp + 4);
    const float cs[8] = {c0.x, c0.y, c0.z, c0.w, c1.x, c1.y, c1.z, c1.w}, sn[8] = {s0.x, s0.y, s0.z, s0.w, s1.x, s1.y, s1.z, s1.w};
#pragma unroll
    for (int j = 0; j < 8; ++j) { const float os = oth[j] * sn[j]; v[j] = (own[j] * cs[j] + (hi ? os : -os)) * scale; }
}
__device__ __forceinline__ void lin_load_vt(Frame& F, size_t row0, int colv) {
    LAS bf16_t* VT = (LAS bf16_t*)(F.lds + LN_VT);
#pragma unroll
    for (int i = 0; i < 2; ++i) { const int idx = F.tid + 512 * i, s = idx >> 4, e0 = (idx & 15) * 8;
        const u32x4 w = *(const u32x4*)(F.PROJ() + (row0 + s) * NIN + colv + e0);
        VT[(e0 + 0) * LP + s] = (bf16_t)(w.x & 0xffffu); VT[(e0 + 1) * LP + s] = (bf16_t)(w.x >> 16); VT[(e0 + 2) * LP + s] = (bf16_t)(w.y & 0xffffu); VT[(e0 + 3) * LP + s] = (bf16_t)(w.y >> 16);
        VT[(e0 + 4) * LP + s] = (bf16_t)(w.z & 0xffffu); VT[(e0 + 5) * LP + s] = (bf16_t)(w.z >> 16); VT[(e0 + 6) * LP + s] = (bf16_t)(w.w & 0xffffu); VT[(e0 + 7) * LP + s] = (bf16_t)(w.w >> 16); }
}
__device__ __forceinline__ void lin_state_unit(Frame& F, int l, int unit) {
    const int n = unit & 63, h = (unit >> 6) & 3, b = (unit >> 8) & 7, mixer = unit >> 11;
    const size_t row0 = (size_t)b * SEQ + (size_t)n * CH;
    const int ck = (mixer == 0 ? C_RK : C_GK) + h * 64, cv = (mixer == 0 ? C_RV : C_GV) + h * 128;
    LAS float* B = (LAS float*)(F.lds + LN_B); LAS bf16_t* KDT = (LAS bf16_t*)(F.lds + LN_KI); LAS bf16_t* VT = (LAS bf16_t*)(F.lds + LN_VT);
    lin_decay(F, l, mixer, row0, h);
    { const int s = F.tid >> 3, c = F.tid & 7, d0 = c * 8; float k[8];
      lin_load_qk(F, row0 + s, ck, c, mixer == 0, mixer == 0 ? 0.125f : 1.0f, k);
#pragma unroll
      for (int j = 0; j < 8; ++j) { const float kd = k[j] * __expf(B[63 * 64 + d0 + j] - B[s * 64 + d0 + j]); KDT[(d0 + j) * LP + s] = (bf16_t)f2bf(kd); } }
    lin_load_vt(F, row0, cv);
    __syncthreads();
    { const int w = F.wave, lane = F.lane; float* st = F.STATE() + (size_t)unit * 8192;
#pragma unroll
      for (int dt = 0; dt < 4; ++dt) { f32x4 acc = (f32x4){0.f, 0.f, 0.f, 0.f}; acc = mma_nt_lds(VT + 16 * w * LP, LP, KDT + 16 * dt * LP, LP, 2, acc, lane);
#pragma unroll
          for (int i = 0; i < 4; ++i) st[(16 * w + 4 * (lane >> 4) + i) * 64 + 16 * dt + (lane & 15)] = acc[i]; }
      if (F.tid < 64) F.DEC()[(size_t)unit * 64 + F.tid] = __expf(B[63 * 64 + F.tid]); }
    __syncthreads();
}
__device__ __forceinline__ void lin_scan(Frame& F) {
    const int gt = F.vcu * (NWAVES * 64) + F.tid, NGT = F.G * NWAVES * 64;
    for (int i = gt; i < 64 * 8192; i += NGT) {
        const int seq = i >> 13, idx = i & 8191, d = idx & 63;
        float carry = 0.f;
#pragma unroll 8
        for (int n = 0; n < NCH; ++n) { const size_t u = (size_t)seq * NCH + n; const float v = F.STATE()[u * 8192 + idx]; const float dc = F.DEC()[u * 64 + d];
            F.SPREV()[u * 8192 + idx] = (bf16_t)f2bf(carry); carry = dc * carry + v; }
    }
}
__device__ __forceinline__ void lin_out_unit(Frame& F, int l, int unit) {
    const int n = unit & 63, h = (unit >> 6) & 3, b = (unit >> 8) & 7, mixer = unit >> 11;
    const size_t row0 = (size_t)b * SEQ + (size_t)n * CH;
    const int cq = (mixer == 0 ? C_RQ : C_GQ) + h * 64, ck = (mixer == 0 ? C_RK : C_GK) + h * 64, cv = (mixer == 0 ? C_RV : C_GV) + h * 128, cg = (mixer == 0 ? C_RG : C_GG) + h * 128;
    const int ycol = (mixer == 0 ? 0 : 1024) + h * 128;
    LAS float* B = (LAS float*)(F.lds + LN_B); LAS bf16_t* QD = (LAS bf16_t*)(F.lds + LN_QD); LAS bf16_t* KI = (LAS bf16_t*)(F.lds + LN_KI); LAS bf16_t* PM = (LAS bf16_t*)(F.lds + LN_PM);
    LAS bf16_t* VT = (LAS bf16_t*)(F.lds + LN_VT); LAS float* OB = (LAS float*)(F.lds + LN_OB);
    lin_decay(F, l, mixer, row0, h);
    { const int s = F.tid >> 3, c = F.tid & 7, d0 = c * 8; float q[8], k[8], bb[8];
      lin_load_qk(F, row0 + s, cq, c, mixer == 0, mixer == 0 ? 1.0f : 0.125f, q);
      lin_load_qk(F, row0 + s, ck, c, mixer == 0, mixer == 0 ? 0.125f : 1.0f, k);
#pragma unroll
      for (int j = 0; j < 8; ++j) bb[j] = B[s * 64 + d0 + j];
      float qd[8], ki[8];
#pragma unroll
      for (int j = 0; j < 8; ++j) { qd[j] = q[j] * __expf(bb[j]); ki[j] = k[j] * __expf(-bb[j]); }
      *(LAS u32x4*)(QD + s * LP + d0) = pack8(qd); *(LAS u32x4*)(KI + s * LP + d0) = pack8(ki); }
    lin_load_vt(F, row0, cv);
    __syncthreads();
    { const int lane = F.lane;
#pragma unroll
      for (int j = 0; j < 2; ++j) { const int tile = 2 * F.wave + j, tt = tile >> 2, st = tile & 3;
          f32x4 acc = (f32x4){0.f, 0.f, 0.f, 0.f};
          if (st <= tt) acc = mma_nt_lds(QD + 16 * tt * LP, LP, KI + 16 * st * LP, LP, 2, acc, lane);
#pragma unroll
          for (int i = 0; i < 4; ++i) { const int t = 16 * tt + 4 * (lane >> 4) + i, s = 16 * st + (lane & 15); const float p = (st <= tt && s <= t) ? acc[i] : 0.f; PM[t * LP + s] = (bf16_t)f2bf(p); } } }
    __syncthreads();
    { const int w = F.wave, lane = F.lane; const bf16_t* sp = F.SPREV() + (size_t)unit * 8192 + (size_t)(16 * w + (lane & 15)) * 64 + 8 * (lane >> 4);
      const bf16x8 s0 = *(const bf16x8*)sp, s1 = *(const bf16x8*)(sp + 32);
#pragma unroll
      for (int tt = 0; tt < 4; ++tt) { f32x4 acc = (f32x4){0.f, 0.f, 0.f, 0.f};
          acc = mma_nt_lds(PM + 16 * tt * LP, LP, VT + 16 * w * LP, LP, 2, acc, lane);
          const LAS bf16_t* xp = QD + (16 * tt + (lane & 15)) * LP + 8 * (lane >> 4);
          acc = __builtin_amdgcn_mfma_f32_16x16x32_bf16(*(const LAS bf16x8*)xp, s0, acc, 0, 0, 0);
          acc = __builtin_amdgcn_mfma_f32_16x16x32_bf16(*(const LAS bf16x8*)(xp + 32), s1, acc, 0, 0, 0);
#pragma unroll
          for (int i = 0; i < 4; ++i) OB[(16 * tt + 4 * (lane >> 4) + i) * 132 + 16 * w + (lane & 15)] = acc[i]; } }
    __syncthreads();
    { const int t = F.tid >> 3, part = F.tid & 7; float o[16];
#pragma unroll
      for (int j = 0; j < 4; ++j) { const f32x4 v = *(const LAS f32x4*)(OB + t * 132 + 16 * part + 4 * j); o[4 * j] = v.x; o[4 * j + 1] = v.y; o[4 * j + 2] = v.z; o[4 * j + 3] = v.w; }
      float s = 0.f;
#pragma unroll
      for (int j = 0; j < 16; ++j) s += o[j];
      s += __shfl_xor(s, 1); s += __shfl_xor(s, 2); s += __shfl_xor(s, 4);
      const float mu = s * (1.0f / 128.0f); float q = 0.f;
#pragma unroll
      for (int j = 0; j < 16; ++j) { const float dlt = o[j] - mu; q += dlt * dlt; }
      q += __shfl_xor(q, 1); q += __shfl_xor(q, 2); q += __shfl_xor(q, 4);
      const float r = 1.0f / sqrtf(q * (1.0f / 128.0f) + EPS);
      const bf16_t* gp = F.PROJ() + (row0 + t) * NIN + cg + 16 * part; float g0[8], g1[8]; unpack8(*(const u32x4*)gp, g0); unpack8(*(const u32x4*)(gp + 8), g1);
      float y0[8], y1[8];
#pragma unroll
      for (int j = 0; j < 8; ++j) { y0[j] = (o[j] - mu) * r * siluf_(g0[j]); y1[j] = (o[8 + j] - mu) * r * siluf_(g1[j]); }
      bf16_t* yp = F.Y() + (row0 + t) * D + ycol + 16 * part; *(u32x4*)yp = pack8(y0); *(u32x4*)(yp + 8) = pack8(y1); }
    __syncthreads();
}

constexpr int S5_WL = 12288;
__device__ __forceinline__ void s5_load_u(Frame& F, LAS bf16_t* UT, size_t row0, int g) {
    const bf16_t* up = F.PROJ() + (row0 + F.lane) * NIN + C_SU + g * 16;
    const u32x4 a = *(const u32x4*)up, b = *(const u32x4*)(up + 8);
    *(LAS u32x4*)(UT + F.lane * 16) = a; *(LAS u32x4*)(UT + F.lane * 16 + 8) = b;
    LDS_WAIT();
}
__device__ __forceinline__ void s5_step(const LAS bf16_t* ut, const float (&bb)[32], float ar, float ai, float& xr, float& xi) {
    float u[16]; { float a[8], b[8]; unpack8(*(const LAS u32x4*)ut, a); unpack8(*(const LAS u32x4*)(ut + 8), b);
#pragma unroll
        for (int j = 0; j < 8; ++j) { u[j] = a[j]; u[8 + j] = b[j]; } }
    float bur = 0.f, bui = 0.f;
#pragma unroll
    for (int c = 0; c < 16; ++c) { bur += bb[2 * c] * u[c]; bui += bb[2 * c + 1] * u[c]; }
    const float nr = ar * xr - ai * xi + bur, ni = ar * xi + ai * xr + bui; xr = nr; xi = ni;
}
__device__ __forceinline__ void s5_pass1(Frame& F) {
    LAS bf16_t* UT = (LAS bf16_t*)(F.lds + F.wave * S5_WL);
    const int gw = F.vcu * NWAVES + F.wave, NGW = F.G * NWAVES;
    for (int unit = gw; unit < BATCH * NCH * 32; unit += NGW) {
        const int g = unit & 31, n = (unit >> 5) & 63, b = unit >> 11; const size_t row0 = (size_t)b * SEQ + (size_t)n * CH;
        s5_load_u(F, UT, row0, g);
        const int gp = g * 64 + F.lane; const float ar = F.abar()[2 * gp], ai = F.abar()[2 * gp + 1];
        float bb[32];
#pragma unroll
        for (int j = 0; j < 8; ++j) { const f32x4 v = *(const f32x4*)(F.bbar() + (size_t)gp * 32 + 4 * j); bb[4 * j] = v.x; bb[4 * j + 1] = v.y; bb[4 * j + 2] = v.z; bb[4 * j + 3] = v.w; }
        float xr = 0.f, xi = 0.f;
        for (int t = 0; t < CH; ++t) s5_step(UT + t * 16, bb, ar, ai, xr, xi);
        *(f32x2*)(F.XEND() + ((((size_t)(b * 32 + g)) * NCH + n) * 64 + F.lane) * 2) = (f32x2){xr, xi};
        LDS_WAIT();
    }
}
__device__ __forceinline__ void s5_scan(Frame& F) {
    const int gt = F.vcu * (NWAVES * 64) + F.tid, NGT = F.G * NWAVES * 64;
    for (int i = gt; i < BATCH * 32 * 64; i += NGT) {
        const int p = i & 63, bg = i >> 6, g = bg & 31; const float pr = F.apow()[2 * (g * 64 + p)], pi = F.apow()[2 * (g * 64 + p) + 1];
        float cr = 0.f, ci = 0.f;
#pragma unroll 8
        for (int n = 0; n < NCH; ++n) { f32x2* xp = (f32x2*)(F.XEND() + (((size_t)bg * NCH + n) * 64 + p) * 2); const f32x2 v = *xp; *xp = (f32x2){cr, ci};
            const float nr = pr * cr - pi * ci + v.x, ni = pr * ci + pi * cr + v.y; cr = nr; ci = ni; }
    }
}
__device__ __forceinline__ void s5_pass3(Frame& F, int l) {
    LAS bf16_t* UT = (LAS bf16_t*)(F.lds + F.wave * S5_WL); LAS bf16_t* X = UT + 1024;
    const int gw = F.vcu * NWAVES + F.wave, NGW = F.G * NWAVES, lane = F.lane;
    for (int unit = gw; unit < BATCH * NCH * 32; unit += NGW) {
        const int g = unit & 31, n = (unit >> 5) & 63, b = unit >> 11; const size_t row0 = (size_t)b * SEQ + (size_t)n * CH;
        s5_load_u(F, UT, row0, g);
        const int gp = g * 64 + lane; const float ar = F.abar()[2 * gp], ai = F.abar()[2 * gp + 1];
        float bb[32];
#pragma unroll
        for (int j = 0; j < 8; ++j) { const f32x4 v = *(const f32x4*)(F.bbar() + (size_t)gp * 32 + 4 * j); bb[4 * j] = v.x; bb[4 * j + 1] = v.y; bb[4 * j + 2] = v.z; bb[4 * j + 3] = v.w; }
        const f32x2 x0 = *(const f32x2*)(F.XEND() + ((((size_t)(b * 32 + g)) * NCH + n) * 64 + lane) * 2);
        float xr = x0.x, xi = x0.y;
        bf16x8 cf[4];
#pragma unroll
        for (int ks = 0; ks < 4; ++ks) cf[ks] = *(const bf16x8*)(F.cmt() + ((size_t)(g * 16 + (lane & 15))) * 128 + 32 * ks + 8 * (lane >> 4));
        const float dsk = F.s5_d()[(size_t)l * BW + g * 16 + (lane & 15)];
        for (int sb = 0; sb < 2; ++sb) {
            for (int tt = 0; tt < 32; ++tt) { s5_step(UT + (sb * 32 + tt) * 16, bb, ar, ai, xr, xi); X[tt * 136 + lane] = (bf16_t)f2bf(xr); X[tt * 136 + 64 + lane] = (bf16_t)f2bf(xi); }
            LDS_WAIT();
#pragma unroll
            for (int j = 0; j < 2; ++j) { f32x4 acc = (f32x4){0.f, 0.f, 0.f, 0.f};
                const LAS bf16_t* xp = X + (16 * j + (lane & 15)) * 136 + 8 * (lane >> 4);
#pragma unroll
                for (int ks = 0; ks < 4; ++ks) acc = __builtin_amdgcn_mfma_f32_16x16x32_bf16(*(const LAS bf16x8*)(xp + 32 * ks), cf[ks], acc, 0, 0, 0);
#pragma unroll
                for (int i = 0; i < 4; ++i) { const int tl = sb * 32 + 16 * j + 4 * (lane >> 4) + i, c = lane & 15;
                    const float u = bflo((unsigned)UT[tl * 16 + c]); const float y = gelu_tanh(acc[i] + dsk * u);
                    F.YBP()[(row0 + tl) * BW + g * 16 + c] = (bf16_t)f2bf(y); } }
            LDS_WAIT();
        }
    }
}

constexpr int PL_P = 520, PL_ROWS = 79, PL_MIX = PL_ROWS * PL_P * 2;
__device__ __forceinline__ void pool_unit(Frame& F, int l, int unit) {
    const int n = unit & 63, b = unit >> 6; const size_t row0 = (size_t)b * SEQ + (size_t)n * CH;
    LAS bf16_t* PL = (LAS bf16_t*)F.lds; LAS bf16_t* MIX = (LAS bf16_t*)(F.lds + PL_MIX);
    for (int i = F.tid; i < PL_ROWS * 64; i += NWAVES * 64) { const int r = i >> 6, c8 = (i & 63) * 8; const int tpos = n * CH - 15 + r;
        u32x4 w = (u32x4){0u, 0u, 0u, 0u}; if (tpos >= 0) w = *(const u32x4*)(F.PROJ() + ((size_t)b * SEQ + tpos) * NIN + C_PU + c8);
        *(LAS u32x4*)(PL + r * PL_P + c8) = w; }
    __syncthreads();
    for (int g = 0; g < 4; ++g) {
        const int win = 2 << g;
        { const int t = F.tid >> 3, c0 = (F.tid & 7) * 16; const int tpos = n * CH + t; const float inv = 1.0f / (float)min(tpos + 1, win);
          float s[16];
#pragma unroll
          for (int j = 0; j < 16; ++j) s[j] = 0.f;
          for (int jj = 0; jj < win; ++jj) { const LAS bf16_t* p = PL + (15 + t - jj) * PL_P + g * 128 + c0; float a[8], bq[8]; unpack8(*(const LAS u32x4*)p, a); unpack8(*(const LAS u32x4*)(p + 8), bq);
#pragma unroll
              for (int j = 0; j < 8; ++j) { s[j] += a[j]; s[8 + j] += bq[j]; } }
          const LAS bf16_t* p = PL + (15 + t) * PL_P + g * 128 + c0; float a[8], bq[8]; unpack8(*(const LAS u32x4*)p, a); unpack8(*(const LAS u32x4*)(p + 8), bq);
          float m0[8], m1[8];
#pragma unroll
          for (int j = 0; j < 8; ++j) { m0[j] = s[j] * inv - a[j]; m1[j] = s[8 + j] * inv - bq[j]; }
          *(LAS u32x4*)(MIX + t * 136 + c0) = pack8(m0); *(LAS u32x4*)(MIX + t * 136 + c0 + 8) = pack8(m1); }
        __syncthreads();
        { const int lane = F.lane, tt = F.wave >> 1, dh = F.wave & 1; const bf16_t* pw = F.poolw_t() + (size_t)g * 128 * 128;
#pragma unroll
          for (int j = 0; j < 4; ++j) { const int dt = dh * 4 + j; f32x4 acc = (f32x4){0.f, 0.f, 0.f, 0.f};
              const LAS bf16_t* xp = MIX + (16 * tt + (lane & 15)) * 136 + 8 * (lane >> 4); const bf16_t* yp = pw + (size_t)(16 * dt + (lane & 15)) * 128 + 8 * (lane >> 4);
#pragma unroll
              for (int ks = 0; ks < 4; ++ks) acc = __builtin_amdgcn_mfma_f32_16x16x32_bf16(*(const LAS bf16x8*)(xp + 32 * ks), *(const bf16x8*)(yp + 32 * ks), acc, 0, 0, 0);
              const int dcol = g * 128 + 16 * dt + (lane & 15); const float sc = F.pool_scale()[(size_t)l * BW + dcol];
#pragma unroll
              for (int i = 0; i < 4; ++i) F.Y()[(row0 + 16 * tt + 4 * (lane >> 4) + i) * D + 1536 + dcol] = (bf16_t)f2bf(acc[i] * sc); } }
        __syncthreads();
    }
}

__device__ __forceinline__ void conv_fix_phase(Frame& F, int l) {
    const float* cw = F.conv_w() + (size_t)l * 3 * NUP; const float* cb = F.conv_b() + (size_t)l * NUP; const float* UH = F.UH();
    const int gt = F.vcu * (NWAVES * 64) + F.tid, NGT = F.G * NWAVES * 64;
    constexpr int JG = DFF / 4;
    for (int task = gt; task < (M / 256) * 2 * JG; task += NGT) {
        const int jg = task % JG, q = (task / JG) & 1, pm = task / (2 * JG);
        if ((pm & 15) == 0) continue;
        const int j0 = jg * 4, ucol = 256 * (j0 >> 7) + (j0 & 127);
        const float* u0p = UH + ((size_t)pm * 4 + q) * NUP + ucol;
        const float* u1p = (q == 1) ? UH + ((size_t)pm * 4 + 0) * NUP + ucol : UH + ((size_t)(pm - 1) * 4 + 3) * NUP + ucol;
        const float* u2p = (q == 1) ? UH + ((size_t)(pm - 1) * 4 + 3) * NUP + ucol : UH + ((size_t)(pm - 1) * 4 + 2) * NUP + ucol;
        const f32x4 a0 = *(const f32x4*)u0p, a1 = *(const f32x4*)u1p, a2 = *(const f32x4*)u2p, v0 = *(const f32x4*)(u0p + 128), v1 = *(const f32x4*)(u1p + 128), v2 = *(const f32x4*)(u2p + 128);
        const f32x4 wa0 = *(const f32x4*)(cw + j0), wa1 = *(const f32x4*)(cw + NUP + j0), wa2 = *(const f32x4*)(cw + 2 * NUP + j0), ba = *(const f32x4*)(cb + j0);
        const f32x4 wv0 = *(const f32x4*)(cw + DFF + j0), wv1 = *(const f32x4*)(cw + NUP + DFF + j0), wv2 = *(const f32x4*)(cw + 2 * NUP + DFF + j0), bv = *(const f32x4*)(cb + DFF + j0);
        float o[4];
#pragma unroll
        for (int i = 0; i < 4; ++i) { const float ca = ba[i] + wa0[i] * a2[i] + wa1[i] * a1[i] + wa2[i] * a0[i], cv = bv[i] + wv0[i] * v2[i] + wv1[i] * v1[i] + wv2[i] * v0[i]; o[i] = siluf_(ca) * cv; }
        u32x2 w; w.x = pk2(o[0], o[1]); w.y = pk2(o[2], o[3]);
        *(u32x2*)(F.ACT() + ((size_t)pm * 256 + q) * DFF + j0) = w;
    }
}

constexpr int NPH = 13;
struct Args { const void* in[25]; float* out; unsigned char* ws; int l_lo, l_hi, ph_lo, ph_hi, single, pad; };
__global__ void __launch_bounds__(NWAVES * 64, 2) hybrid_fwd(Args args) {
    extern __shared__ __attribute__((aligned(16))) unsigned char lds[];
    Frame F;
    F.lds = (LAS unsigned char*)lds;
    F.tid = threadIdx.x; F.lane = F.tid & 63; F.wave = __builtin_amdgcn_readfirstlane(F.tid >> 6);
    const int wave0 = F.wave;
    F.G = gridDim.x; { const int bx = blockIdx.x; F.vcu = (F.G % 8 == 0) ? (bx % 8) * (F.G / 8) + bx / 8 : bx; }
    unsigned char* ws = args.ws; F.ws = ws; F.out = args.out;

    volatile LAS unsigned* MISC = (volatile LAS unsigned*)(F.lds + MISC_OFF);
    if (F.tid < 64) MISC[F.tid] = 0u;
    __syncthreads();
    unsigned* ctl = (unsigned*)(ws + WS_CTL);
    XcdBarrier bar; bar.bar = ctl + CW_BAR; bar.x = 0; bar.st = nullptr;
    if (args.single) bar = xcd_barrier_post(ctl + CW_BAR, MISC);
#define GRID_BAR() do { if (args.single) xcd_barrier(bar); } while (0)
    const int lo = args.ph_lo, hi = args.ph_hi;
#define IN(k) (lo <= (k) && (k) < hi)
#define PH_BEGIN() do { unsigned z_ = 0u; asm volatile("" : "+v"(z_)); const int ln_ = (int)__builtin_amdgcn_mbcnt_hi(~0u, __builtin_amdgcn_mbcnt_lo(~0u, z_)); F.lane = ln_; F.tid = wave0 * 64 + ln_; F.wave = wave0; } while (0)

    for (int l = args.l_lo; l < args.l_hi; ++l) {
        const float* hsrc = (l == 0) ? F.x() : F.out;
        if (IN(0)) { PH_BEGIN(); phase_prep(F, l); GRID_BAR(); }
        if (IN(1)) { PH_BEGIN(); pg8::Gemm g{F.HN(), F.win_t(), M, NIN, D, D, D}; pg8::StaticOrder S; S.init(M, NIN, F.G, (int)blockIdx.x); pg8::EpiProj E{F.PROJ(), NIN, C_GATE / 256, C_GATE};
            pg8::gemm_phase(F.lds, g, S, E, F.tid); GRID_BAR(); }
        if (IN(2)) { PH_BEGIN(); for (int u = F.vcu; u < 4096; u += F.G) lin_state_unit(F, l, u);
            s5_pass1(F); __syncthreads();
            for (int u = F.vcu; u < BATCH * NCH; u += F.G) pool_unit(F, l, u);
            GRID_BAR(); }
        if (IN(3)) { PH_BEGIN(); lin_scan(F); s5_scan(F); GRID_BAR(); }
        if (IN(4)) { PH_BEGIN(); for (int u = F.vcu; u < 4096; u += F.G) lin_out_unit(F, l, u);
            s5_pass3(F, l); __syncthreads();
            GRID_BAR(); }
        if (IN(5)) { PH_BEGIN(); pg8::Gemm g{F.YBP(), F.wglu_t(), M, BW, BW, BW, BW}; pg8::StaticOrder S; S.init(M, BW, F.G, (int)blockIdx.x); pg8::EpiGlu E{F.YBP(), BW, F.Y() + BW, D};
            pg8::gemm_phase(F.lds, g, S, E, F.tid); GRID_BAR(); }
        if (IN(6)) { PH_BEGIN(); pg8::Gemm g{F.Y(), F.wbr_t(), M, D, D, D, D}; pg8::StaticOrder S; S.init(M, D, F.G, (int)blockIdx.x); pg8::EpiMerge E{F.PROJ() + C_GATE, NIN, F.HN(), D};
            pg8::gemm_phase(F.lds, g, S, E, F.tid); GRID_BAR(); }
        if (IN(7)) { PH_BEGIN(); pg8::Gemm g{F.HN(), F.wout_t(), M, D, D, D, D}; pg8::StaticOrder S; S.init(M, D, F.G, (int)blockIdx.x); pg8::EpiResid E{hsrc, F.out, D};
            pg8::gemm_phase(F.lds, g, S, E, F.tid); GRID_BAR(); }
        if (IN(8)) { PH_BEGIN(); rms_rows(F, F.out, F.g_ffn() + (size_t)l * D, F.HN()); GRID_BAR(); }
        if (IN(9)) { PH_BEGIN(); pg8::Gemm g{F.HN(), F.wup_t(), M, NUP, D, D, D}; pg8::StaticOrder S; S.init(M, NUP, F.G, (int)blockIdx.x); pg8::EpiConv E{F.conv_w() + (size_t)l * 3 * NUP, F.conv_b() + (size_t)l * NUP, F.ACT(), F.UH(), (LAS float*)(F.lds + pg8::STAGE_BYTES)};
            pg8::gemm_phase(F.lds, g, S, E, F.tid); GRID_BAR(); }
        if (IN(10)) { PH_BEGIN(); conv_fix_phase(F, l); GRID_BAR(); }
        if (IN(11)) { PH_BEGIN(); pg8::Gemm g{F.ACT(), F.wdn_t(), M, D, DFF, DFF, DFF}; pg8::StaticOrder S; S.init(M, D, F.G, (int)blockIdx.x); pg8::EpiResid E{F.out, F.out, D};
            pg8::gemm_phase(F.lds, g, S, E, F.tid); GRID_BAR(); }
        if (IN(12) && l == DEPTH - 1) { PH_BEGIN(); rms_rows_f32_inplace(F, F.out, F.g_final()); }
    }
#undef IN
#undef PH_BEGIN
#undef GRID_BAR
}

extern "C" void kernel_launch(void* const* d_in, const int* in_sizes, int n_in, void* d_out, int out_size, void* d_ws, size_t ws_size, hipStream_t stream) {
    static int grid = 0;
    if (grid == 0) {
        if (n_in != 25 || in_sizes[0] != M * D || out_size != M * D || ws_size < WS_END) { fprintf(stderr, "kernel_launch: shape/workspace mismatch (n_in %d, in0 %d, out %d, ws %zu, need %zu); nothing launched\n", n_in, n_in > 0 ? in_sizes[0] : -1, out_size, ws_size, (size_t)WS_END); grid = -1; return; }
        int dev = 0, cus = 0, per_cu = 0;
        if (hipGetDevice(&dev) != hipSuccess || hipDeviceGetAttribute(&cus, hipDeviceAttributeMultiprocessorCount, dev) != hipSuccess) { grid = -1; return; }
        if (hipFuncSetAttribute((const void*)hybrid_fwd, hipFuncAttributeMaxDynamicSharedMemorySize, LDS_BYTES) != hipSuccess) { fprintf(stderr, "kernel_launch: hipFuncSetAttribute failed\n"); grid = -1; return; }
        if (hipOccupancyMaxActiveBlocksPerMultiprocessor(&per_cu, (const void*)hybrid_fwd, NWAVES * 64, LDS_BYTES) != hipSuccess || per_cu < 1) { fprintf(stderr, "kernel_launch: occupancy query reports %d workgroups per CU\n", per_cu); }
        (void)hipGetLastError();
        grid = cus;
    }
    if (grid < 0) return;
    if (hipMemsetAsync((char*)d_ws + WS_CTL, 0, CTL_ZERO_BYTES, stream) != hipSuccess) return;
    Args a{};
    for (int i = 0; i < 25; ++i) a.in[i] = d_in[i];
    a.out = (float*)d_out; a.ws = (unsigned char*)d_ws;
#if MK_SINGLE
    a.l_lo = 0; a.l_hi = DEPTH; a.ph_lo = 0; a.ph_hi = NPH; a.single = 1;
    hipLaunchKernelGGL(hybrid_fwd, dim3(grid), dim3(NWAVES * 64), LDS_BYTES, stream, a);
#else
    a.single = 0;
    for (int l = 0; l < DEPTH; ++l)
        for (int p = 0; p < NPH; ++p) { if (p == 12 && l != DEPTH - 1) continue; a.l_lo = l; a.l_hi = l + 1; a.ph_lo = p; a.ph_hi = p + 1;
            hipLaunchKernelGGL(hybrid_fwd, dim3(grid), dim3(NWAVES * 64), LDS_BYTES, stream, a); }
#endif
}
```

```cpp
#include <hip/hip_runtime.h>
#include <cstdio>
#include <cstdint>

#ifndef MK_SINGLE
#define MK_SINGLE 1
#endif

#define LAS __attribute__((address_space(3)))
#define GAS __attribute__((address_space(1)))
typedef unsigned short bf16_t;
typedef short bf16x8 __attribute__((ext_vector_type(8)));
typedef float f32x4 __attribute__((ext_vector_type(4)));
typedef float f32x2 __attribute__((ext_vector_type(2)));
typedef unsigned u32x4 __attribute__((ext_vector_type(4)));
typedef unsigned u32x2 __attribute__((ext_vector_type(2)));

constexpr int D = 2048, BATCH = 8, SEQ = 4096, DEPTH = 4, M = BATCH * SEQ;
constexpr int BW = 512;
constexpr int NIN_SRC = 12304, NIN = 12544;
constexpr int DFF = 5504, NUP = 11008;
constexpr int C_RQ = 0, C_RK = 256, C_RV = 512, C_RG = 1024, C_SU = 1536, C_GQ = 2048, C_GK = 2304, C_GV = 2560, C_GG = 3072, C_PU = 3584, C_GR = 4096, C_GATE = 4352;
constexpr float EPS = 1e-6f;
constexpr int NWAVES = 8;
constexpr int CH = 64;
constexpr int NCH = SEQ / CH;

constexpr size_t MiB = 1u << 20;
constexpr size_t WS_CTL = 0, CTL_ZERO_BYTES = 1 * MiB;
constexpr size_t WS_ROT = 1 * MiB;
constexpr size_t WS_S5T = 9 * MiB;
constexpr size_t S5T_ABAR = 0, S5T_APOW = 16384, S5T_BBAR = 32768, S5T_CMT = 32768 + 262144, S5T_BBT = S5T_CMT + 131072;
constexpr size_t WS_WGLU = 10 * MiB;
constexpr size_t WS_POOLW = 10 * MiB + 512 * 1024;
constexpr size_t WS_WIN = 11 * MiB;
constexpr size_t WS_WBR = 60 * MiB;
constexpr size_t WS_WOUT = 68 * MiB;
constexpr size_t WS_WUP = 76 * MiB;
constexpr size_t WS_WDN = 119 * MiB;
constexpr size_t WS_HN = 141 * MiB;
constexpr size_t WS_Y = 269 * MiB;
constexpr size_t WS_SCR = 397 * MiB;
constexpr size_t WS_YBP = WS_SCR;
constexpr size_t WS_STATE = WS_SCR + 32 * MiB;
constexpr size_t WS_SPREV = WS_SCR + 160 * MiB;
constexpr size_t WS_DEC = WS_SCR + 224 * MiB;
constexpr size_t WS_XEND = WS_SCR + 225 * MiB;
constexpr size_t WS_UH = WS_SCR + 128 * MiB;
constexpr size_t WS_PROJ = 637 * MiB;
constexpr size_t WS_ACT = WS_PROJ;
constexpr size_t WS_END = 1421 * MiB;
static_assert(WS_PROJ + (size_t)M * NIN * 2 <= WS_END, "ws map");
static_assert(WS_ACT + (size_t)M * DFF * 2 <= WS_END, "ws map");
static_assert(WS_XEND + 8 * MiB <= WS_PROJ, "ws map");
static_assert(WS_UH + (size_t)(M / 256) * 4 * NUP * 4 <= WS_PROJ, "ws map");
constexpr int CW_TMO = 0, CW_BAR = 4096;

constexpr int LDS_BYTES = 155648;
constexpr int MISC_OFF = LDS_BYTES - 256;

#define RLX_AGENT __ATOMIC_RELAXED, __HIP_MEMORY_SCOPE_AGENT
#define LDS_WAIT() asm volatile("s_waitcnt lgkmcnt(0)" ::: "memory")
#define VM_WAIT() asm volatile("s_waitcnt vmcnt(0)" ::: "memory")
__device__ __forceinline__ unsigned f2bf(float f) { unsigned u = __builtin_bit_cast(unsigned, f); return (u + 0x7fffu + ((u >> 16) & 1u)) >> 16; }
__device__ __forceinline__ unsigned pk2(float lo, float hi) { return f2bf(lo) | (f2bf(hi) << 16); }
__device__ __forceinline__ float bflo(unsigned w) { return __builtin_bit_cast(float, w << 16); }
__device__ __forceinline__ float bfhi(unsigned w) { return __builtin_bit_cast(float, w & 0xffff0000u); }
__device__ __forceinline__ void unpack8(const u32x4 w, float (&v)[8]) { v[0] = bflo(w.x); v[1] = bfhi(w.x); v[2] = bflo(w.y); v[3] = bfhi(w.y); v[4] = bflo(w.z); v[5] = bfhi(w.z); v[6] = bflo(w.w); v[7] = bfhi(w.w); }
__device__ __forceinline__ u32x4 pack8(const float (&v)[8]) { u32x4 w; w.x = pk2(v[0], v[1]); w.y = pk2(v[2], v[3]); w.z = pk2(v[4], v[5]); w.w = pk2(v[6], v[7]); return w; }
__device__ __forceinline__ float sigmoidf_(float x) { return 1.0f / (1.0f + __expf(-x)); }
__device__ __forceinline__ float siluf_(float x) { return x / (1.0f + __expf(-x)); }
__device__ __forceinline__ float gelu_tanh(float x) { const float u = 1.5957691216f * (x + 0.044715f * x * x * x); return x / (1.0f + __expf(-u)); }
__device__ __forceinline__ float logsigmoidf_(float x) { return fminf(x, 0.f) - log1pf(__expf(-fabsf(x))); }

namespace pg8 {
constexpr int BM = 256, BK = 64, HALF = 128, HTB = HALF * BK * 2, STAGE_BYTES = 8 * HTB, NXCD = 8, WGM = 8;
__host__ __device__ __forceinline__ int lds_byte(int r, int c) { const int st = (r >> 4) * 2 + (c >> 5), rr = r & 15, cc = c & 31, ob = rr * 64 + cc * 2; return st * 1024 + (ob ^ (((ob >> 9) & 1) << 5)); }
__host__ __device__ __forceinline__ void stage_rc(int b, int& R, int& C) { const int st = b / 1024, sb = b % 1024, swz = sb ^ (((sb >> 9) & 1) << 5); R = (st >> 1) * 16 + swz / 64; C = (st & 1) * 32 + (swz % 64) / 2; }
__host__ __device__ __forceinline__ int perm32(int rho) { const int n = rho >> 4, i = rho & 15; return 8 * (i >> 2) + 4 * n + (i & 3); }

struct Unit { int pm, pn; };
struct Gemm { const bf16_t* A; const bf16_t* Bt; int M, N, K, lda, ldb; };

struct StaticOrder {
    int nM, nN, nwg, G, c;
    __host__ __device__ void init(int M_, int N_, int G_, int c_) { nM = M_ / BM; nN = N_ / BM; nwg = nM * nN; G = G_; c = c_; }
    __host__ __device__ bool next(int i, Unit& u) const {
        const long L = (long)i * G + c; if (L >= nwg) return false;
        int wgid = (int)L; { const int q = nwg / NXCD, r = nwg % NXCD, xcd = wgid % NXCD, off = wgid / NXCD; wgid = (xcd < r ? xcd * (q + 1) : r * (q + 1) + (xcd - r) * q) + off; }
        const int nig = WGM * nN, gid = wgid / nig, fm = gid * WGM, gsz = (nM - fm) < WGM ? (nM - fm) : WGM;
        u.pm = fm + ((wgid % nig) % gsz); u.pn = (wgid % nig) / gsz; return true;
    }
};

__device__ __forceinline__ unsigned cvt_pk_bf16(float lo, float hi) { unsigned r; asm volatile("v_cvt_pk_bf16_f32 %0, %1, %2" : "=v"(r) : "v"(lo), "v"(hi)); return r; }

struct EpiStoreBf16 {
    static constexpr bool PERM = true, KHOOK = false;
    bf16_t* O; int ldc;
    __device__ __forceinline__ void khook(f32x4 (&)[2][2][4][2], const Unit&, int, int, int, int, int) const {}
    __device__ __forceinline__ void operator()(const f32x4 (&acc)[2][2][4][2], const Unit& u, int wr, int wc, int fr, int fq) const {
        const int row0 = u.pm * BM + wr * 64 + fr, col0 = u.pn * BM + wc * 32 + 8 * fq;
#pragma unroll
        for (int ai = 0; ai < 2; ++ai)
#pragma unroll
            for (int m = 0; m < 4; ++m) { bf16_t* rowp = O + (size_t)(row0 + ai * HALF + m * 16) * ldc + col0;
#pragma unroll
                for (int bj = 0; bj < 2; ++bj) { const f32x4 v0 = acc[ai][bj][m][0], v1 = acc[ai][bj][m][1];
                    u32x4 w; w.x = cvt_pk_bf16(v0[0], v0[1]); w.y = cvt_pk_bf16(v0[2], v0[3]); w.z = cvt_pk_bf16(v1[0], v1[1]); w.w = cvt_pk_bf16(v1[2], v1[3]);
                    *(u32x4*)(rowp + bj * HALF) = w; } }
    }
};
struct EpiProj {
    static constexpr bool PERM = true, KHOOK = false;
    bf16_t* O; int ldc; int gate_pn0; int gate_col0;
    __device__ __forceinline__ void khook(f32x4 (&)[2][2][4][2], const Unit&, int, int, int, int, int) const {}
    __device__ __forceinline__ void operator()(const f32x4 (&acc)[2][2][4][2], const Unit& u, int wr, int wc, int fr, int fq) const {
        const int row0 = u.pm * BM + wr * 64 + fr;
        if (u.pn < gate_pn0) {
            const int col0 = u.pn * BM + wc * 32 + 8 * fq;
#pragma unroll
            for (int ai = 0; ai < 2; ++ai)
#pragma unroll
                for (int m = 0; m < 4; ++m) { bf16_t* rowp = O + (size_t)(row0 + ai * HALF + m * 16) * ldc + col0;
#pragma unroll
                    for (int bj = 0; bj < 2; ++bj) { const f32x4 v0 = acc[ai][bj][m][0], v1 = acc[ai][bj][m][1];
                        u32x4 w; w.x = cvt_pk_bf16(v0[0], v0[1]); w.y = cvt_pk_bf16(v0[2], v0[3]); w.z = cvt_pk_bf16(v1[0], v1[1]); w.w = cvt_pk_bf16(v1[2], v1[3]);
                        *(u32x4*)(rowp + bj * HALF) = w; } }
        } else {
            const int col0 = gate_col0 + 64 * (u.pn - gate_pn0) + 16 * wc + 4 * fq;
#pragma unroll
            for (int ai = 0; ai < 2; ++ai)
#pragma unroll
                for (int m = 0; m < 4; ++m) { bf16_t* rowp = O + (size_t)(row0 + ai * HALF + m * 16) * ldc + col0;
                    float r1[4], r2[4], r3[4], g3[4];
#pragma unroll
                    for (int i = 0; i < 4; ++i) {
                        const float e0 = __expf(-fminf(fmaxf(acc[ai][0][m][0][i], -30.f), 30.f)), e1 = __expf(-fminf(fmaxf(acc[ai][0][m][1][i], -30.f), 30.f));
                        const float e2 = __expf(-fminf(fmaxf(acc[ai][1][m][0][i], -30.f), 30.f)), e3 = __expf(-fminf(fmaxf(acc[ai][1][m][1][i], -30.f), 30.f));
                        const float i0 = __builtin_amdgcn_rcpf(1.f + e0), i1 = __builtin_amdgcn_rcpf(1.f + e1), i2 = __builtin_amdgcn_rcpf(1.f + e2), i3 = __builtin_amdgcn_rcpf(1.f + e3);
                        r1[i] = (1.f + e1) * i0; r2[i] = (1.f + e2) * i1; r3[i] = (1.f + e3) * i2; g3[i] = i3; }
                    u32x2 w;
                    w.x = cvt_pk_bf16(r1[0], r1[1]); w.y = cvt_pk_bf16(r1[2], r1[3]); *(u32x2*)(rowp) = w;
                    w.x = cvt_pk_bf16(r2[0], r2[1]); w.y = cvt_pk_bf16(r2[2], r2[3]); *(u32x2*)(rowp + D) = w;
                    w.x = cvt_pk_bf16(r3[0], r3[1]); w.y = cvt_pk_bf16(r3[2], r3[3]); *(u32x2*)(rowp + 2 * D) = w;
                    w.x = cvt_pk_bf16(g3[0], g3[1]); w.y = cvt_pk_bf16(g3[2], g3[3]); *(u32x2*)(rowp + 3 * D) = w; }
        }
    }
};
__device__ __forceinline__ float dpp_ror1(float x) { return __builtin_bit_cast(float, __builtin_amdgcn_update_dpp(0, __builtin_bit_cast(int, x), 0x121, 0xf, 0xf, false)); }
__device__ __forceinline__ float dpp_ror2(float x) { return __builtin_bit_cast(float, __builtin_amdgcn_update_dpp(0, __builtin_bit_cast(int, x), 0x122, 0xf, 0xf, false)); }
struct EpiConv {
    static constexpr bool PERM = true, KHOOK = false;
    const float* cw; const float* cb; bf16_t* O; float* UH; LAS float* halo;
    __device__ __forceinline__ void khook(f32x4 (&)[2][2][4][2], const Unit&, int, int, int, int, int) const {}
    __device__ __forceinline__ void operator()(const f32x4 (&acc)[2][2][4][2], const Unit& u, int wr, int wc, int fr_, int fq_) const {
        int fr = fr_, fq = fq_; asm volatile("" : "+v"(fr), "+v"(fq));
        const int cl0 = wc * 32 + 8 * fq;
        if (fr >= 14) {
#pragma unroll
            for (int ai = 0; ai < 2; ++ai)
#pragma unroll
                for (int bj = 0; bj < 2; ++bj)
#pragma unroll
                    for (int n = 0; n < 2; ++n) *(LAS f32x4*)(halo + (((2 * ai + wr) * 2 + (fr - 14)) * 256 + 128 * bj + cl0 + 4 * n)) = acc[ai][bj][3][n];
        }
        if (wr == 0 && fr < 2) {
#pragma unroll
            for (int bj = 0; bj < 2; ++bj)
#pragma unroll
                for (int n = 0; n < 2; ++n) *(f32x4*)(UH + ((size_t)u.pm * 4 + fr) * NUP + 256 * u.pn + 128 * bj + cl0 + 4 * n) = acc[0][bj][0][n];
        }
        if (wr == 1 && fr >= 14) {
#pragma unroll
            for (int bj = 0; bj < 2; ++bj)
#pragma unroll
                for (int n = 0; n < 2; ++n) *(f32x4*)(UH + ((size_t)u.pm * 4 + 2 + (fr - 14)) * NUP + 256 * u.pn + 128 * bj + cl0 + 4 * n) = acc[1][bj][3][n];
        }
        asm volatile("s_waitcnt lgkmcnt(0)" ::: "memory"); __builtin_amdgcn_s_barrier(); asm volatile("" ::: "memory");
        const int j0 = 128 * u.pn + cl0;
        const bool is15 = fr == 15, ge14 = fr >= 14;
        unsigned keep[2][4][2];
#pragma unroll
        for (int n = 0; n < 2; ++n) {
            f32x4 wa[3], wv[3];
#pragma unroll
            for (int q = 0; q < 3; ++q) { wa[q] = *(const f32x4*)(cw + q * NUP + j0 + 4 * n); wv[q] = *(const f32x4*)(cw + q * NUP + DFF + j0 + 4 * n); }
            const f32x4 ba = *(const f32x4*)(cb + j0 + 4 * n), bv = *(const f32x4*)(cb + DFF + j0 + 4 * n);
#pragma unroll
            for (int ai = 0; ai < 2; ++ai) {
                const int blk = 2 * ai + wr;
                f32x4 pa = (f32x4){0.f, 0.f, 0.f, 0.f}, pv = (f32x4){0.f, 0.f, 0.f, 0.f};
                if (blk > 0 && ge14) { pa = *(const LAS f32x4*)(halo + (((blk - 1) * 2 + (fr - 14)) * 256 + cl0 + 4 * n)); pv = *(const LAS f32x4*)(halo + (((blk - 1) * 2 + (fr - 14)) * 256 + 128 + cl0 + 4 * n)); }
#pragma unroll
                for (int m = 0; m < 4; ++m) {
                    const f32x4 ca_ = acc[ai][0][m][n], cv_ = acc[ai][1][m][n]; float o[4];
#pragma unroll
                    for (int i = 0; i < 4; ++i) {
                        const float a1 = dpp_ror1(is15 ? pa[i] : ca_[i]), a2 = dpp_ror2(ge14 ? pa[i] : ca_[i]);
                        const float v1 = dpp_ror1(is15 ? pv[i] : cv_[i]), v2 = dpp_ror2(ge14 ? pv[i] : cv_[i]);
                        const float ca = ba[i] + wa[0][i] * a2 + wa[1][i] * a1 + wa[2][i] * ca_[i];
                        const float cv = bv[i] + wv[0][i] * v2 + wv[1][i] * v1 + wv[2][i] * cv_[i];
                        o[i] = siluf_(ca) * cv; }
                    pa = ca_; pv = cv_;
                    const unsigned lo = cvt_pk_bf16(o[0], o[1]), hi = cvt_pk_bf16(o[2], o[3]);
                    if (n == 0) { keep[ai][m][0] = lo; keep[ai][m][1] = hi; }
                    else { u32x4 w; w.x = keep[ai][m][0]; w.y = keep[ai][m][1]; w.z = lo; w.w = hi;
                        *(u32x4*)(O + (size_t)(u.pm * BM + ai * HALF + wr * 64 + m * 16 + fr) * DFF + j0) = w; }
                }
            }
        }
    }
};
struct EpiResid {
    static constexpr bool PERM = false, KHOOK = false;
    const float* base; float* out; int ldc;
    __device__ __forceinline__ void khook(f32x4 (&)[2][2][4][2], const Unit&, int, int, int, int, int) const {}
    __device__ __forceinline__ void operator()(const f32x4 (&acc)[2][2][4][2], const Unit& u, int wr, int wc, int fr, int fq) const {
        const int row0 = u.pm * BM + wr * 64 + fr, col0 = u.pn * BM + wc * 32 + 4 * fq;
#pragma unroll
        for (int ai = 0; ai < 2; ++ai)
#pragma unroll
            for (int m = 0; m < 4; ++m) { const size_t off = (size_t)(row0 + ai * HALF + m * 16) * ldc + col0;
#pragma unroll
                for (int bj = 0; bj < 2; ++bj)
#pragma unroll
                    for (int n = 0; n < 2; ++n) { const f32x4 bs = *(const f32x4*)(base + off + bj * HALF + n * 16); *(f32x4*)(out + off + bj * HALF + n * 16) = bs + acc[ai][bj][m][n]; }
                asm volatile("" ::: "memory"); }
    }
};
struct EpiGlu {
    static constexpr bool PERM = true, KHOOK = false;
    const bf16_t* Yp; int ldy; bf16_t* O; int ldc;
    __device__ __forceinline__ void khook(f32x4 (&)[2][2][4][2], const Unit&, int, int, int, int, int) const {}
    __device__ __forceinline__ void operator()(const f32x4 (&acc)[2][2][4][2], const Unit& u, int wr, int wc, int fr, int fq) const {
        const int row0 = u.pm * BM + wr * 64 + fr, col0 = u.pn * BM + wc * 32 + 8 * fq;
#pragma unroll
        for (int ai = 0; ai < 2; ++ai)
#pragma unroll
            for (int m = 0; m < 4; ++m) { const size_t r = (size_t)(row0 + ai * HALF + m * 16);
#pragma unroll
                for (int bj = 0; bj < 2; ++bj) { const u32x4 yw = *(const u32x4*)(Yp + r * ldy + col0 + bj * HALF); float y[8]; unpack8(yw, y);
                    const f32x4 v0 = acc[ai][bj][m][0], v1 = acc[ai][bj][m][1]; float o[8];
#pragma unroll
                    for (int j = 0; j < 4; ++j) { o[j] = y[j] * sigmoidf_(v0[j]); o[4 + j] = y[4 + j] * sigmoidf_(v1[j]); }
                    u32x4 w; w.x = cvt_pk_bf16(o[0], o[1]); w.y = cvt_pk_bf16(o[2], o[3]); w.z = cvt_pk_bf16(o[4], o[5]); w.w = cvt_pk_bf16(o[6], o[7]);
                    *(u32x4*)(O + r * ldc + col0 + bj * HALF) = w; } }
    }
};
struct EpiMerge {
    static constexpr bool PERM = true, KHOOK = true;
    const bf16_t* G; int ldg; bf16_t* O; int ldc;
    __device__ __forceinline__ void scale(f32x4 (&acc)[2][2][4][2], const Unit& u, int s, int wr, int wc, int fr, int fq) const {
        int row0 = u.pm * BM + wr * 64 + fr, col0 = u.pn * BM + wc * 32 + 8 * fq + s * D; asm volatile("" : "+v"(row0), "+v"(col0));
        u32x4 w[2][4][2];
#pragma unroll
        for (int ai = 0; ai < 2; ++ai)
#pragma unroll
            for (int m = 0; m < 4; ++m) { const bf16_t* gp = G + (size_t)(row0 + ai * HALF + m * 16) * ldg + col0;
#pragma unroll
                for (int bj = 0; bj < 2; ++bj) w[ai][m][bj] = *(const u32x4*)(gp + bj * HALF); }
#pragma unroll
        for (int ai = 0; ai < 2; ++ai)
#pragma unroll
            for (int m = 0; m < 4; ++m)
#pragma unroll
                for (int bj = 0; bj < 2; ++bj) { float f[8]; unpack8(w[ai][m][bj], f);
#pragma unroll
                    for (int j = 0; j < 8; ++j) acc[ai][bj][m][j >> 2][j & 3] *= f[j]; }
    }
    __device__ __forceinline__ void khook(f32x4 (&acc)[2][2][4][2], const Unit& u, int seg, int wr, int wc, int fr, int fq) const { scale(acc, u, seg - 1, wr, wc, fr, fq); }
    __device__ __forceinline__ void operator()(f32x4 (&acc)[2][2][4][2], const Unit& u, int wr, int wc, int fr, int fq) const {
        scale(acc, u, 3, wr, wc, fr, fq);
        const int row0 = u.pm * BM + wr * 64 + fr, col0 = u.pn * BM + wc * 32 + 8 * fq;
#pragma unroll
        for (int ai = 0; ai < 2; ++ai)
#pragma unroll
            for (int m = 0; m < 4; ++m) { bf16_t* rowp = O + (size_t)(row0 + ai * HALF + m * 16) * ldc + col0;
#pragma unroll
                for (int bj = 0; bj < 2; ++bj) { const f32x4 v0 = acc[ai][bj][m][0], v1 = acc[ai][bj][m][1];
                    u32x4 w; w.x = cvt_pk_bf16(v0[0], v0[1]); w.y = cvt_pk_bf16(v0[2], v0[3]); w.z = cvt_pk_bf16(v1[0], v1[1]); w.w = cvt_pk_bf16(v1[2], v1[3]);
                    *(u32x4*)(rowp + bj * HALF) = w; } }
    }
};

template <class Epi>
__device__ __forceinline__ void gemm_phase(LAS unsigned char* lds, const Gemm g, const StaticOrder& S, const Epi& E, int tid_in) {
    int tid_ = tid_in; asm volatile("" : "+v"(tid_));
    const int tid = tid_, wid = __builtin_amdgcn_readfirstlane(tid >> 6), lane = tid & 63, wr = wid >> 2, wc = wid & 3, fr = lane & 15, fq = lane >> 4;
    const int K = g.K, nt = K / BK;
    unsigned voffA[2], voffB[2];
#pragma unroll
    for (int i = 0; i < 2; ++i) { int R, C; stage_rc(tid * 16 + i * 8192, R, C); const int Rb = Epi::PERM ? ((R & ~31) + perm32(R & 31)) : R;
        voffA[i] = (unsigned)(R * g.lda + C) * 2u; voffB[i] = (unsigned)(Rb * g.ldb + C) * 2u; }
    const size_t kstep = (size_t)(BK * 2);
    const size_t hstepA = (size_t)HALF * g.lda * 2, hstepB = (size_t)HALF * g.ldb * 2;
    const size_t tstepA = 2 * hstepA, tstepB = 2 * hstepB;
    const unsigned ldsw = (unsigned)wid * 1024u;
    const int aoff = lds_byte(wr * 64 + fr, fq * 8), boff = lds_byte(wc * 32 + fr, fq * 8);
#define PG8_SA(b, h) (((b) * 2 + (h)) * HTB)
#define PG8_SB(b, h) ((4 + (b) * 2 + (h)) * HTB)
#define PG8_STAGE(bufoff, gbase, voff) do { _Pragma("unroll") for (int _i = 0; _i < 2; ++_i) \
        __builtin_amdgcn_global_load_lds((const unsigned*)((const char*)(gbase) + (voff)[_i]), (LAS unsigned*)(lds + (bufoff) + ldsw + _i * 8192), 16, 0, 0); } while (0)
#define PG8_LDA(dst, b, h) do { _Pragma("unroll") for (int m = 0; m < 4; ++m) _Pragma("unroll") for (int k = 0; k < 2; ++k) dst[m][k] = *(const LAS bf16x8*)(lds + PG8_SA(b, h) + aoff + m * 2048 + k * 1024); } while (0)
#define PG8_LDB(dst, b, h) do { _Pragma("unroll") for (int n = 0; n < 2; ++n) _Pragma("unroll") for (int k = 0; k < 2; ++k) dst[n][k] = *(const LAS bf16x8*)(lds + PG8_SB(b, h) + boff + n * 2048 + k * 1024); } while (0)
#define PG8_MMA(ai, bj, At, Bt) do { __builtin_amdgcn_s_setprio(1); _Pragma("unroll") for (int m = 0; m < 4; ++m) _Pragma("unroll") for (int n = 0; n < 2; ++n) _Pragma("unroll") for (int k = 0; k < 2; ++k) \
        acc[ai][bj][m][n] = __builtin_amdgcn_mfma_f32_16x16x32_bf16(Bt[n][k], At[m][k], acc[ai][bj][m][n], 0, 0, 0); __builtin_amdgcn_s_setprio(0); } while (0)
#define PG8_WAIT_V(n) asm volatile("s_waitcnt vmcnt(" #n ")" ::: "memory")
#define PG8_WAIT_L(n) asm volatile("s_waitcnt lgkmcnt(" #n ")" ::: "memory")
#define PG8_BAR __builtin_amdgcn_s_barrier()
#define PG8_SCHED __builtin_amdgcn_sched_barrier(0)
    Unit cur, nxt; int ui = 0;
    if (!S.next(0, cur)) return;
    f32x4 acc[2][2][4][2];
#pragma unroll
    for (int a = 0; a < 2; ++a)
#pragma unroll
        for (int b = 0; b < 2; ++b)
#pragma unroll
            for (int m = 0; m < 4; ++m)
#pragma unroll
                for (int n = 0; n < 2; ++n) acc[a][b][m][n] = (f32x4){0.f, 0.f, 0.f, 0.f};
    bf16x8 At[4][2], B0[2][2], B1[2][2];
    const char* cA = (const char*)g.A + (size_t)cur.pm * tstepA; const char* cB = (const char*)g.Bt + (size_t)cur.pn * tstepB;
    PG8_STAGE(PG8_SB(0, 0), cB, voffB); PG8_STAGE(PG8_SB(0, 1), cB + hstepB, voffB); PG8_STAGE(PG8_SA(0, 0), cA, voffA); PG8_STAGE(PG8_SA(0, 1), cA + hstepA, voffA);
    if (wr == 1) PG8_BAR;
    PG8_WAIT_V(2); PG8_BAR;
    PG8_STAGE(PG8_SB(1, 0), cB + kstep, voffB); PG8_STAGE(PG8_SA(1, 0), cA + kstep, voffA); PG8_STAGE(PG8_SB(1, 1), cB + hstepB + kstep, voffB);
    PG8_WAIT_V(6); PG8_BAR;
    for (;;) {
        const bool has_next = S.next(ui + 1, nxt);
        const char* nA = has_next ? (const char*)g.A + (size_t)nxt.pm * tstepA : cA; const char* nB = has_next ? (const char*)g.Bt + (size_t)nxt.pn * tstepB : cB;
        for (int t = 0; t < nt; t += 2) {
            const bool last = (t == nt - 2);
            const char* a1 = cA + (size_t)(t + 1) * kstep;
            const char* a2 = last ? nA : cA + (size_t)(t + 2) * kstep; const char* b2 = last ? nB : cB + (size_t)(t + 2) * kstep;
            const char* a3 = a2 + kstep; const char* b3 = b2 + kstep;
            if constexpr (Epi::KHOOK) { if (t != 0 && (t & 7) == 0) E.khook(acc, cur, t >> 3, wr, wc, fr, fq); }
            PG8_LDB(B0, 0, 0); PG8_LDB(B1, 0, 1); PG8_SCHED; PG8_LDA(At, 0, 0); PG8_STAGE(PG8_SA(1, 1), a1 + hstepA, voffA);
            PG8_WAIT_V(8); PG8_WAIT_L(0); PG8_BAR; PG8_MMA(0, 0, At, B0); PG8_MMA(0, 1, At, B1); PG8_BAR; PG8_SCHED;
            PG8_LDA(At, 0, 1); PG8_STAGE(PG8_SB(0, 0), b2, voffB); PG8_STAGE(PG8_SB(0, 1), b2 + hstepB, voffB); PG8_STAGE(PG8_SA(0, 0), a2, voffA);
            PG8_WAIT_V(8); PG8_WAIT_L(0); PG8_BAR; PG8_MMA(1, 0, At, B0); PG8_MMA(1, 1, At, B1); PG8_BAR; PG8_SCHED;
            PG8_LDB(B0, 1, 0); PG8_LDB(B1, 1, 1); PG8_SCHED; PG8_LDA(At, 1, 0); PG8_STAGE(PG8_SA(0, 1), a2 + hstepA, voffA);
            PG8_WAIT_V(8); PG8_WAIT_L(0); PG8_BAR; PG8_MMA(0, 0, At, B0); PG8_MMA(0, 1, At, B1); PG8_BAR; PG8_SCHED;
            PG8_LDA(At, 1, 1); PG8_STAGE(PG8_SB(1, 0), b3, voffB); PG8_STAGE(PG8_SB(1, 1), b3 + hstepB, voffB); PG8_STAGE(PG8_SA(1, 0), a3, voffA);
            PG8_WAIT_V(8); PG8_WAIT_L(0); PG8_BAR; PG8_MMA(1, 0, At, B0); PG8_MMA(1, 1, At, B1); PG8_BAR; PG8_SCHED;
        }
        if (wr == 0) PG8_BAR;
        E(acc, cur, wr, wc, fr, fq);
        if (!has_next) break;
#pragma unroll
        for (int a = 0; a < 2; ++a)
#pragma unroll
            for (int b = 0; b < 2; ++b)
#pragma unroll
                for (int m = 0; m < 4; ++m)
#pragma unroll
                    for (int n = 0; n < 2; ++n) acc[a][b][m][n] = (f32x4){0.f, 0.f, 0.f, 0.f};
        cur = nxt; cA = nA; cB = nB; ++ui;
        if (wr == 1) PG8_BAR;
    }
    PG8_WAIT_V(0);
    PG8_BAR;
#undef PG8_SA
#undef PG8_SB
#undef PG8_STAGE
#undef PG8_LDA
#undef PG8_LDB
#undef PG8_MMA
#undef PG8_WAIT_V
#undef PG8_WAIT_L
#undef PG8_BAR
#undef PG8_SCHED
}
}

#define XB_TMO      128
#define XB_XCNT(j)  (256  + 64 * (j))
#define XB_XSUB(j)  (1280 + 64 * (j))
#define XB_XGEN(j)  (2304 + 64 * (j))
#define XB_TOP      3328
#define XB_TOPGEN   3392
#define XCD_BAR_WORDS 3456
#define XB_SPIN_CAP (1u << 18)
__device__ __forceinline__ unsigned xb_ld(unsigned* p)              { return __hip_atomic_load(p, __ATOMIC_RELAXED, __HIP_MEMORY_SCOPE_AGENT); }
__device__ __forceinline__ unsigned xb_add(unsigned* p, unsigned v) { return __hip_atomic_fetch_add(p, v, __ATOMIC_RELAXED, __HIP_MEMORY_SCOPE_AGENT); }
__device__ __forceinline__ unsigned xb_xcc_id() { return (unsigned)__builtin_amdgcn_s_getreg((3 << 11) | 20) & 0xFu; }
#define XB_SPIN(cond, bar) do { unsigned _sp = 0; while (cond) { __builtin_amdgcn_s_sleep(1); \
    if ((++_sp & 255u) == 0u) { if (xb_ld(&(bar)[XB_TMO])) break; if (_sp > XB_SPIN_CAP) { atomicAdd(&(bar)[XB_TMO], 1u); break; } } } } while (0)
struct XcdBarrier { unsigned* bar; unsigned x; volatile LAS unsigned* st; };
__device__ __forceinline__ XcdBarrier xcd_barrier_post(unsigned* bar, volatile LAS unsigned* st) {
    XcdBarrier b; b.bar = bar; b.x = xb_xcc_id(); b.st = st;
    if (threadIdx.x == 0) (void)xb_add(&bar[XB_XCNT(b.x)], 1u);
    return b;
}
__device__ __forceinline__ void xcd_barrier_complete(unsigned* bar, unsigned x, unsigned& nloc, unsigned& nx) {
    const unsigned G = gridDim.x * gridDim.y * gridDim.z;
    unsigned sum, cnt, mine, sp = 0u;
    for (;;) {
        sum = 0u; cnt = 0u; mine = 0u;
#pragma nounroll
        for (unsigned j = 0; j < 16; ++j) { const unsigned c = xb_ld(&bar[XB_XCNT(j)]); sum += c; cnt += (c > 0u) ? 1u : 0u; mine = (j == x) ? c : mine; }
        if (sum == G) break;
        __builtin_amdgcn_s_sleep(1);
        if ((++sp & 255u) == 0u) { if (xb_ld(&bar[XB_TMO])) break; if (sp > XB_SPIN_CAP) { atomicAdd(&bar[XB_TMO], 1u); break; } }
    }
    nloc = mine > 0u ? mine : 1u; nx = cnt > 0u ? cnt : 1u;
}
__device__ __forceinline__ void xcd_barrier(const XcdBarrier& b) {
    asm volatile("s_waitcnt vmcnt(0)" ::: "memory");
    __syncthreads();
    if (threadIdx.x == 0) {
        unsigned* bar = b.bar;
        __builtin_amdgcn_s_waitcnt(0);
        unsigned nloc = b.st[0], nx = b.st[1];
        if (nloc == 0u) { xcd_barrier_complete(bar, b.x, nloc, nx); b.st[0] = nloc; b.st[1] = nx; }
        const unsigned old = xb_add(&bar[XB_XSUB(b.x)], 1u);
        const unsigned gen = old / nloc;
        if (old + 1u == (gen + 1u) * nloc) {
            __builtin_amdgcn_fence(__ATOMIC_RELEASE, "agent");
            asm volatile("s_waitcnt vmcnt(0)" ::: "memory");
            const unsigned og = xb_add(&bar[XB_TOP], 1u);
            const unsigned tg = og / nx;
            if (og + 1u == (tg + 1u) * nx) xb_add(&bar[XB_TOPGEN], 1u);
            else XB_SPIN(xb_ld(&bar[XB_TOPGEN]) == tg, bar);
            __builtin_amdgcn_fence(__ATOMIC_ACQUIRE, "agent");
            xb_add(&bar[XB_XGEN(b.x)], 1u);
            asm volatile("s_waitcnt vmcnt(0)" ::: "memory");
        } else {
            XB_SPIN(xb_ld(&bar[XB_XGEN(b.x)]) == gen, bar);
            __builtin_amdgcn_fence(__ATOMIC_ACQUIRE, "agent");
            asm volatile("s_waitcnt vmcnt(0)" ::: "memory");
        }
    }
    __syncthreads();
}

__device__ __forceinline__ const void* kin(int k) {
    typedef __attribute__((address_space(4))) const char* kptr_t;
    kptr_t p = (kptr_t)__builtin_amdgcn_kernarg_segment_ptr(); asm volatile("" : "+s"(p));
    const unsigned long long v = *(__attribute__((address_space(4))) const unsigned long long*)(p + 8 * k);
    return (const void*)(GAS const void*)v;
}
struct Frame {
    LAS unsigned char* lds;
    int tid, lane, wave, vcu, G;
    unsigned char* ws; float* out;
#define FIN(name, T, k) __device__ __forceinline__ const T* name() const { return (const T*)kin(k); }
    FIN(x, float, 0) FIN(pos, int, 1) FIN(g_mix, float, 2) FIN(w_in, float, 3) FIN(a_re, float, 4) FIN(a_im, float, 5) FIN(log_dt, float, 6) FIN(b_re, float, 7) FIN(b_im, float, 8)
    FIN(c_re, float, 9) FIN(c_im, float, 10) FIN(s5_d, float, 11) FIN(w_glu, float, 12) FIN(gla_wg, float, 13) FIN(gla_bg, float, 14) FIN(pool_w, float, 15) FIN(pool_scale, float, 16)
    FIN(w_branch, float, 17) FIN(w_out, float, 18) FIN(g_ffn, float, 19) FIN(w_up, float, 20) FIN(conv_w, float, 21) FIN(conv_b, float, 22) FIN(w_down, float, 23) FIN(g_final, float, 24)
#undef FIN
#define FWS(name, T, off) __device__ __forceinline__ T* name() const { return (T*)(ws + (off)); }
    FWS(rotc, float, WS_ROT) FWS(rots, float, WS_ROT + (size_t)M * 32 * 4) FWS(abar, float, WS_S5T + S5T_ABAR) FWS(apow, float, WS_S5T + S5T_APOW) FWS(bbar, float, WS_S5T + S5T_BBAR) FWS(cmt, bf16_t, WS_S5T + S5T_CMT) FWS(bbt, bf16_t, WS_S5T + S5T_BBT)
    FWS(wglu_t, bf16_t, WS_WGLU) FWS(poolw_t, bf16_t, WS_POOLW) FWS(win_t, bf16_t, WS_WIN) FWS(wbr_t, bf16_t, WS_WBR) FWS(wout_t, bf16_t, WS_WOUT) FWS(wup_t, bf16_t, WS_WUP) FWS(wdn_t, bf16_t, WS_WDN)
    FWS(HN, bf16_t, WS_HN) FWS(Y, bf16_t, WS_Y) FWS(YBP, bf16_t, WS_YBP) FWS(PROJ, bf16_t, WS_PROJ) FWS(SPREV, bf16_t, WS_SPREV) FWS(ACT, bf16_t, WS_ACT)
    FWS(STATE, float, WS_STATE) FWS(DEC, float, WS_DEC) FWS(XEND, float, WS_XEND) FWS(UH, float, WS_UH)
#undef FWS
};

__device__ __forceinline__ float wave_sum(float v) {
#pragma unroll
    for (int o = 1; o < 64; o <<= 1) v += __shfl_xor(v, o);
    return v;
}

template <class SrcCol>
__device__ __forceinline__ void transpose_item(const float* W, int Nsrc, bf16_t* WT, int ldt, int kdst0, int k0, int n0, SrcCol srccol, LAS float* scr, int lane) {
    const int sc = srccol(n0 + (lane & 31));
#pragma unroll 8
    for (int i = 0; i < 32; ++i) { const int kk = 2 * i + (lane >> 5); scr[kk * 33 + (lane & 31)] = sc >= 0 ? W[(size_t)(k0 + kk) * Nsrc + sc] : 0.f; }
    LDS_WAIT();
    const int c = lane & 7;
#pragma unroll
    for (int j = 0; j < 4; ++j) { const int n = (lane >> 3) + 8 * j; const LAS float* s = scr + (8 * c) * 33 + n;
        u32x4 o; o.x = pk2(s[0 * 33], s[1 * 33]); o.y = pk2(s[2 * 33], s[3 * 33]); o.z = pk2(s[4 * 33], s[5 * 33]); o.w = pk2(s[6 * 33], s[7 * 33]);
        *(u32x4*)(WT + (size_t)(n0 + n) * ldt + kdst0 + k0 + 8 * c) = o; }
    LDS_WAIT();
}
struct ColIdent { __device__ __forceinline__ int operator()(int n) const { return n; } };
struct ColWin { __device__ __forceinline__ int operator()(int n) const {
    if (n < 3584) return n; if (n < 4096) return n + 16; if (n < 4112) return n - 512; if (n < 4352) return -1;
    const int t = (n - 4352) >> 8, cl = (n - 4352) & 255; const int br = 2 * (cl >> 7) + ((cl >> 2) & 1), ch = 16 * ((cl >> 5) & 3) + 4 * ((cl >> 3) & 3) + (cl & 3);
    return 4112 + br * 2048 + 64 * t + ch; } };
struct ColWup { __device__ __forceinline__ int operator()(int n) const { const int blk = n >> 8, r = n & 255; return (r < 128) ? (blk * 128 + r) : (DFF + blk * 128 + (r - 128)); } };

__device__ __forceinline__ void rms_row_to_bf16(const float* xrow, const float* g, bf16_t* orow, int lane) {
    const f32x4* xr = (const f32x4*)xrow + lane; const f32x4* gr = (const f32x4*)g + lane;
    f32x4 v[8]; float s = 0.f;
#pragma unroll
    for (int j = 0; j < 8; ++j) { v[j] = xr[64 * j]; s += (v[j].x * v[j].x + v[j].y * v[j].y) + (v[j].z * v[j].z + v[j].w * v[j].w); }
    const float r = 1.0f / sqrtf(wave_sum(s) * (1.f / D) + EPS);
    u32x2* o8 = (u32x2*)orow + lane;
#pragma unroll
    for (int j = 0; j < 8; ++j) { const f32x4 gg = gr[64 * j]; u32x2 w; w.x = pk2(v[j].x * r * gg.x, v[j].y * r * gg.y); w.y = pk2(v[j].z * r * gg.z, v[j].w * r * gg.w); o8[64 * j] = w; }
}
__device__ __forceinline__ void rms_rows(Frame& F, const float* src, const float* g, bf16_t* dst) {
    const int gw = F.vcu * NWAVES + F.wave, NGW = F.G * NWAVES;
    for (int m = gw; m < M; m += NGW) rms_row_to_bf16(src + (size_t)m * D, g, dst + (size_t)m * D, F.lane);
}
__device__ __forceinline__ void rms_rows_f32_inplace(Frame& F, float* buf, const float* g) {
    const int gw = F.vcu * NWAVES + F.wave, NGW = F.G * NWAVES;
    for (int m = gw; m < M; m += NGW) {
        f32x4* xr = (f32x4*)(buf + (size_t)m * D) + F.lane; const f32x4* gr = (const f32x4*)g + F.lane;
        f32x4 v[8]; float s = 0.f;
#pragma unroll
        for (int j = 0; j < 8; ++j) { v[j] = xr[64 * j]; s += (v[j].x * v[j].x + v[j].y * v[j].y) + (v[j].z * v[j].z + v[j].w * v[j].w); }
        const float r = 1.0f / sqrtf(wave_sum(s) * (1.f / D) + EPS);
#pragma unroll
        for (int j = 0; j < 8; ++j) { const f32x4 gg = gr[64 * j]; xr[64 * j] = (f32x4){v[j].x * r * gg.x, v[j].y * r * gg.y, v[j].z * r * gg.z, v[j].w * r * gg.w}; }
    }
}

__device__ __forceinline__ void phase_prep(Frame& F, int l) {
    LAS float* scr = (LAS float*)(F.lds + F.wave * 16384);
    const int gw = F.vcu * NWAVES + F.wave, NGW = F.G * NWAVES;
    constexpr int I_IN = (D / 64) * (NIN / 32), I_UP = (D / 64) * (NUP / 32), I_DN = (DFF / 64) * (D / 32), I_BR = 4 * (BW / 64) * (D / 32), I_OUT = (D / 64) * (D / 32), I_GLU = (BW / 64) * (BW / 32), I_PL = 4 * (128 / 64) * (128 / 32);
    constexpr int NITEMS = I_IN + I_UP + I_DN + I_BR + I_OUT + I_GLU + I_PL;
    for (int it = gw; it < NITEMS; it += NGW) {
        int r = it;
        if (r < I_IN) { const int nb = NIN / 32; transpose_item(F.w_in() + (size_t)l * D * NIN_SRC, NIN_SRC, F.win_t(), D, 0, 64 * (r / nb), 32 * (r % nb), ColWin(), scr, F.lane); continue; } r -= I_IN;
        if (r < I_UP) { const int nb = NUP / 32; transpose_item(F.w_up() + (size_t)l * D * NUP, NUP, F.wup_t(), D, 0, 64 * (r / nb), 32 * (r % nb), ColWup(), scr, F.lane); continue; } r -= I_UP;
        if (r < I_DN) { const int nb = D / 32; transpose_item(F.w_down() + (size_t)l * DFF * D, D, F.wdn_t(), DFF, 0, 64 * (r / nb), 32 * (r % nb), ColIdent(), scr, F.lane); continue; } r -= I_DN;
        if (r < I_BR) { const int per = (BW / 64) * (D / 32), br = r / per, q = r % per, nb = D / 32;
            transpose_item(F.w_branch() + ((size_t)l * 4 + br) * BW * D, D, F.wbr_t(), D, br * BW, 64 * (q / nb), 32 * (q % nb), ColIdent(), scr, F.lane); continue; } r -= I_BR;
        if (r < I_OUT) { const int nb = D / 32; transpose_item(F.w_out() + (size_t)l * D * D, D, F.wout_t(), D, 0, 64 * (r / nb), 32 * (r % nb), ColIdent(), scr, F.lane); continue; } r -= I_OUT;
        if (r < I_GLU) { const int nb = BW / 32; transpose_item(F.w_glu() + (size_t)l * BW * BW, BW, F.wglu_t(), BW, 0, 64 * (r / nb), 32 * (r % nb), ColIdent(), scr, F.lane); continue; } r -= I_GLU;
        { const int grp = r / 8, q = r % 8; transpose_item(F.pool_w() + ((size_t)l * 4 + grp) * 128 * 128, 128, F.poolw_t() + (size_t)grp * 128 * 128, 128, 0, 64 * (q / 4), 32 * (q % 4), ColIdent(), scr, F.lane); }
    }
    const int gt = F.vcu * (NWAVES * 64) + F.tid, NGT = F.G * NWAVES * 64;
    for (int i = gt; i < 32 * 64; i += NGT) {
        const int g = i >> 6;
        const float are = F.a_re()[(size_t)l * 2048 + i], aim = F.a_im()[(size_t)l * 2048 + i], dt = expf(F.log_dt()[l * 32 + g]);
        const float mag = expf(are * dt), th = aim * dt;
        const float abr = mag * cosf(th), abi = mag * sinf(th);
        const float den = are * are + aim * aim, nr = abr - 1.0f, ni = abi;
        const float fre = (nr * are + ni * aim) / den, fim = (ni * are - nr * aim) / den;
        F.abar()[2 * i] = abr; F.abar()[2 * i + 1] = abi;
        float pr = abr, pi = abi;
#pragma unroll
        for (int q = 0; q < 6; ++q) { const float tr = pr * pr - pi * pi, ti = 2.f * pr * pi; pr = tr; pi = ti; }
        F.apow()[2 * i] = pr; F.apow()[2 * i + 1] = pi;
        const float* br = F.b_re() + ((size_t)l * 2048 + i) * 16; const float* bi = F.b_im() + ((size_t)l * 2048 + i) * 16;
#pragma unroll
        for (int c = 0; c < 16; ++c) { const float x = br[c], y = bi[c]; const float vr = fre * x - fim * y, vi = fre * y + fim * x; const int p = i & 63;
            F.bbt()[((size_t)g * 128 + p) * 16 + c] = (bf16_t)f2bf(vr); F.bbt()[((size_t)g * 128 + 64 + p) * 16 + c] = (bf16_t)f2bf(vi); }
    }
    for (int i = gt; i < 32 * 16 * 128; i += NGT) {
        const int k = i & 127, gc = i >> 7;
        const float v = (k < 64) ? F.c_re()[((size_t)l * 512 + gc) * 64 + k] : -F.c_im()[((size_t)l * 512 + gc) * 64 + (k - 64)];
        F.cmt()[i] = (bf16_t)f2bf(v);
    }
    if (l == 0) {
        for (int i = gt; i < M * 32; i += NGT) {
            const int row = i >> 5, j = i & 31;
            const float inv = exp2f(-(float)j * (13.287712379549449f / 32.0f));
            const float ang = (float)F.pos()[row] * inv;
            F.rotc()[i] = cosf(ang); F.rots()[i] = sinf(ang);
        }
    }
    rms_rows(F, l == 0 ? F.x() : F.out, F.g_mix() + (size_t)l * D, F.HN());
}

__device__ __forceinline__ f32x4 mma_nt_lds(const LAS bf16_t* X, int px, const LAS bf16_t* Y, int py, int ksteps, f32x4 acc, int lane) {
    const LAS bf16_t* xp = X + (lane & 15) * px + 8 * (lane >> 4);
    const LAS bf16_t* yp = Y + (lane & 15) * py + 8 * (lane >> 4);
    for (int ks = 0; ks < ksteps; ++ks) {
        const bf16x8 a = *(const LAS bf16x8*)(xp + 32 * ks), b = *(const LAS bf16x8*)(yp + 32 * ks);
        acc = __builtin_amdgcn_mfma_f32_16x16x32_bf16(a, b, acc, 0, 0, 0);
    }
    return acc;
}

constexpr int LN_B = 0, LN_TOT = 16384, LN_QD = 18432, LN_KI = 27648, LN_PM = 36864, LN_VT = 46080, LN_OB = 64512, LN_END = 98304;
constexpr int LP = 72;

__device__ __forceinline__ void lin_decay(Frame& F, int l, int mixer, size_t row0, int h) {
    LAS float* B = (LAS float*)(F.lds + LN_B); LAS float* TOT = (LAS float*)(F.lds + LN_TOT);
    const int t = F.tid >> 3, d0 = (F.tid & 7) * 8;
    if (mixer == 0) {
        const float lg = log1pf(-exp2f(-5.0f - (float)h));
#pragma unroll
        for (int j = 0; j < 8; ++j) B[t * 64 + d0 + j] = (float)(t + 1) * lg;
        __syncthreads();
        return;
    }
    const bf16_t* gr = F.PROJ() + (row0 + t) * NIN + C_GR;
    float grf[16]; { float a[8], b[8]; unpack8(*(const u32x4*)gr, a); unpack8(*(const u32x4*)(gr + 8), b);
#pragma unroll
        for (int j = 0; j < 8; ++j) { grf[j] = a[j]; grf[8 + j] = b[j]; } }
    const float* Wg = F.gla_wg() + (size_t)l * 16 * 256 + h * 64 + d0; const float* bg = F.gla_bg() + l * 256 + h * 64 + d0;
    float acc[8]; { const f32x4 b0 = *(const f32x4*)bg, b1 = *(const f32x4*)(bg + 4); acc[0] = b0.x; acc[1] = b0.y; acc[2] = b0.z; acc[3] = b0.w; acc[4] = b1.x; acc[5] = b1.y; acc[6] = b1.z; acc[7] = b1.w; }
#pragma unroll
    for (int r = 0; r < 16; ++r) { const f32x4 w0 = *(const f32x4*)(Wg + r * 256), w1 = *(const f32x4*)(Wg + r * 256 + 4);
        acc[0] += grf[r] * w0.x; acc[1] += grf[r] * w0.y; acc[2] += grf[r] * w0.z; acc[3] += grf[r] * w0.w; acc[4] += grf[r] * w1.x; acc[5] += grf[r] * w1.y; acc[6] += grf[r] * w1.z; acc[7] += grf[r] * w1.w; }
#pragma unroll
    for (int j = 0; j < 8; ++j) B[t * 64 + d0 + j] = logsigmoidf_(acc[j]) * (1.0f / 16.0f);
    __syncthreads();
    const int part = F.wave, d = F.lane;
    float v[8];
#pragma unroll
    for (int i = 0; i < 8; ++i) v[i] = B[(8 * part + i) * 64 + d];
#pragma unroll
    for (int i = 1; i < 8; ++i) v[i] += v[i - 1];
    TOT[part * 64 + d] = v[7];
    __syncthreads();
    float off = 0.f;
#pragma unroll
    for (int q = 0; q < 7; ++q) { const float tq = TOT[q * 64 + d]; off += (q < part) ? tq : 0.f; }
#pragma unroll
    for (int i = 0; i < 8; ++i) B[(8 * part + i) * 64 + d] = v[i] + off;
    __syncthreads();
}
__device__ __forceinline__ void lin_load_qk(Frame& F, size_t row, int col0, int c, bool rot, float scale, float (&v)[8]) {
    const bf16_t* p = F.PROJ() + row * NIN + col0;
    float own[8]; unpack8(*(const u32x4*)(p + 8 * c), own);
    if (!rot) {
#pragma unroll
        for (int j = 0; j < 8; ++j) v[j] = own[j] * scale;
        return;
    }
    float oth[8]; unpack8(*(const u32x4*)(p + 8 * (c ^ 4)), oth);
    const int i0 = (c & 3) * 8; const bool hi = c >= 4;
    const float* cp = F.rotc() + row * 32 + i0; const float* sp = F.rots() + row * 32 + i0;
    const f32x4 c0 = *(const f32x4*)cp, c1 = *(const f32x4*)(cp + 4), s0 = *(const f32x4*)sp, s1 = *(const f32x4*)(sp + 4);
    const float cs[8] = {c0.x, c0.y, c0.z, c0.w, c1.x, c1.y, c1.z, c1.w}, sn[8] = {s0.x, s0.y, s0.z, s0.w, s1.x, s1.y, s1.z, s1.w};
#pragma unroll
    for (int j = 0; j < 8; ++j) { const float os = oth[j] * sn[j]; v[j] = (own[j] * cs[j] + (hi ? os : -os)) * scale; }
}
__device__ __forceinline__ void lin_load_vt(Frame& F, size_t row0, int colv) {
    LAS bf16_t* VT = (LAS bf16_t*)(F.lds + LN_VT);
#pragma unroll
    for (int i = 0; i < 2; ++i) { const int idx = F.tid + 512 * i, s = idx >> 4, e0 = (idx & 15) * 8;
        const u32x4 w = *(const u32x4*)(F.PROJ() + (row0 + s) * NIN + colv + e0);
        VT[(e0 + 0) * LP + s] = (bf16_t)(w.x & 0xffffu); VT[(e0 + 1) * LP + s] = (bf16_t)(w.x >> 16); VT[(e0 + 2) * LP + s] = (bf16_t)(w.y & 0xffffu); VT[(e0 + 3) * LP + s] = (bf16_t)(w.y >> 16);
        VT[(e0 + 4) * LP + s] = (bf16_t)(w.z & 0xffffu); VT[(e0 + 5) * LP + s] = (bf16_t)(w.z >> 16); VT[(e0 + 6) * LP + s] = (bf16_t)(w.w & 0xffffu); VT[(e0 + 7) * LP + s] = (bf16_t)(w.w >> 16); }
}
__device__ __forceinline__ void lin_state_unit(Frame& F, int l, int unit) {
    const int n = unit & 63, h = (unit >> 6) & 3, b = (unit >> 8) & 7, mixer = unit >> 11;
    const size_t row0 = (size_t)b * SEQ + (size_t)n * CH;
    const int ck = (mixer == 0 ? C_RK : C_GK) + h * 64, cv = (mixer == 0 ? C_RV : C_GV) + h * 128;
    LAS float* B = (LAS float*)(F.lds + LN_B); LAS bf16_t* KDT = (LAS bf16_t*)(F.lds + LN_KI); LAS bf16_t* VT = (LAS bf16_t*)(F.lds + LN_VT);
    lin_decay(F, l, mixer, row0, h);
    { const int s = F.tid >> 3, c = F.tid & 7, d0 = c * 8; float k[8];
      lin_load_qk(F, row0 + s, ck, c, mixer == 0, mixer == 0 ? 0.125f : 1.0f, k);
#pragma unroll
      for (int j = 0; j < 8; ++j) { const float kd = k[j] * __expf(B[63 * 64 + d0 + j] - B[s * 64 + d0 + j]); KDT[(d0 + j) * LP + s] = (bf16_t)f2bf(kd); } }
    lin_load_vt(F, row0, cv);
    __syncthreads();
    { const int w = F.wave, lane = F.lane; float* st = F.STATE() + (size_t)unit * 8192;
#pragma unroll
      for (int dt = 0; dt < 4; ++dt) { f32x4 acc = (f32x4){0.f, 0.f, 0.f, 0.f}; acc = mma_nt_lds(VT + 16 * w * LP, LP, KDT + 16 * dt * LP, LP, 2, acc, lane);
#pragma unroll
          for (int i = 0; i < 4; ++i) st[(16 * w + 4 * (lane >> 4) + i) * 64 + 16 * dt + (lane & 15)] = acc[i]; }
      if (F.tid < 64) F.DEC()[(size_t)unit * 64 + F.tid] = __expf(B[63 * 64 + F.tid]); }
    __syncthreads();
}
__device__ __forceinline__ void lin_scan(Frame& F) {
    const int gt = F.vcu * (NWAVES * 64) + F.tid, NGT = F.G * NWAVES * 64;
    for (int i = gt; i < 64 * 8192; i += NGT) {
        const int seq = i >> 13, idx = i & 8191, d = idx & 63;
        float carry = 0.f;
#pragma unroll 8
        for (int n = 0; n < NCH; ++n) { const size_t u = (size_t)seq * NCH + n; const float v = F.STATE()[u * 8192 + idx]; const float dc = F.DEC()[u * 64 + d];
            F.SPREV()[u * 8192 + idx] = (bf16_t)f2bf(carry); carry = dc * carry + v; }
    }
}
__device__ __forceinline__ void lin_out_unit(Frame& F, int l, int unit) {
    const int n = unit & 63, h = (unit >> 6) & 3, b = (unit >> 8) & 7, mixer = unit >> 11;
    const size_t row0 = (size_t)b * SEQ + (size_t)n * CH;
    const int cq = (mixer == 0 ? C_RQ : C_GQ) + h * 64, ck = (mixer == 0 ? C_RK : C_GK) + h * 64, cv = (mixer == 0 ? C_RV : C_GV) + h * 128, cg = (mixer == 0 ? C_RG : C_GG) + h * 128;
    const int ycol = (mixer == 0 ? 0 : 1024) + h * 128;
    LAS float* B = (LAS float*)(F.lds + LN_B); LAS bf16_t* QD = (LAS bf16_t*)(F.lds + LN_QD); LAS bf16_t* KI = (LAS bf16_t*)(F.lds + LN_KI); LAS bf16_t* PM = (LAS bf16_t*)(F.lds + LN_PM);
    LAS bf16_t* VT = (LAS bf16_t*)(F.lds + LN_VT); LAS float* OB = (LAS float*)(F.lds + LN_OB);
    lin_decay(F, l, mixer, row0, h);
    { const int s = F.tid >> 3, c = F.tid & 7, d0 = c * 8; float q[8], k[8], bb[8];
      lin_load_qk(F, row0 + s, cq, c, mixer == 0, mixer == 0 ? 1.0f : 0.125f, q);
      lin_load_qk(F, row0 + s, ck, c, mixer == 0, mixer == 0 ? 0.125f : 1.0f, k);
#pragma unroll
      for (int j = 0; j < 8; ++j) bb[j] = B[s * 64 + d0 + j];
      float qd[8], ki[8];
#pragma unroll
      for (int j = 0; j < 8; ++j) { qd[j] = q[j] * __expf(bb[j]); ki[j] = k[j] * __expf(-bb[j]); }
      *(LAS u32x4*)(QD + s * LP + d0) = pack8(qd); *(LAS u32x4*)(KI + s * LP + d0) = pack8(ki); }
    lin_load_vt(F, row0, cv);
    __syncthreads();
    { const int lane = F.lane;
#pragma unroll
      for (int j = 0; j < 2; ++j) { const int tile = 2 * F.wave + j, tt = tile >> 2, st = tile & 3;
          f32x4 acc = (f32x4){0.f, 0.f, 0.f, 0.f};
          if (st <= tt) acc = mma_nt_lds(QD + 16 * tt * LP, LP, KI + 16 * st * LP, LP, 2, acc, lane);
#pragma unroll
          for (int i = 0; i < 4; ++i) { const int t = 16 * tt + 4 * (lane >> 4) + i, s = 16 * st + (lane & 15); const float p = (st <= tt && s <= t) ? acc[i] : 0.f; PM[t * LP + s] = (bf16_t)f2bf(p); } } }
    __syncthreads();
    { const int w = F.wave, lane = F.lane; const bf16_t* sp = F.SPREV() + (size_t)unit * 8192 + (size_t)(16 * w + (lane & 15)) * 64 + 8 * (lane >> 4);
      const bf16x8 s0 = *(const bf16x8*)sp, s1 = *(const bf16x8*)(sp + 32);
#pragma unroll
      for (int tt = 0; tt < 4; ++tt) { f32x4 acc = (f32x4){0.f, 0.f, 0.f, 0.f};
          acc = mma_nt_lds(PM + 16 * tt * LP, LP, VT + 16 * w * LP, LP, 2, acc, lane);
          const LAS bf16_t* xp = QD + (16 * tt + (lane & 15)) * LP + 8 * (lane >> 4);
          acc = __builtin_amdgcn_mfma_f32_16x16x32_bf16(*(const LAS bf16x8*)xp, s0, acc, 0, 0, 0);
          acc = __builtin_amdgcn_mfma_f32_16x16x32_bf16(*(const LAS bf16x8*)(xp + 32), s1, acc, 0, 0, 0);
#pragma unroll
          for (int i = 0; i < 4; ++i) OB[(16 * tt + 4 * (lane >> 4) + i) * 132 + 16 * w + (lane & 15)] = acc[i]; } }
    __syncthreads();
    { const int t = F.tid >> 3, part = F.tid & 7; float o[16];
#pragma unroll
      for (int j = 0; j < 4; ++j) { const f32x4 v = *(const LAS f32x4*)(OB + t * 132 + 16 * part + 4 * j); o[4 * j] = v.x; o[4 * j + 1] = v.y; o[4 * j + 2] = v.z; o[4 * j + 3] = v.w; }
      float s = 0.f;
#pragma unroll
      for (int j = 0; j < 16; ++j) s += o[j];
      s += __shfl_xor(s, 1); s += __shfl_xor(s, 2); s += __shfl_xor(s, 4);
      const float mu = s * (1.0f / 128.0f); float q = 0.f;
#pragma unroll
      for (int j = 0; j < 16; ++j) { const float dlt = o[j] - mu; q += dlt * dlt; }
      q += __shfl_xor(q, 1); q += __shfl_xor(q, 2); q += __shfl_xor(q, 4);
      const float r = 1.0f / sqrtf(q * (1.0f / 128.0f) + EPS);
      const bf16_t* gp = F.PROJ() + (row0 + t) * NIN + cg + 16 * part; float g0[8], g1[8]; unpack8(*(const u32x4*)gp, g0); unpack8(*(const u32x4*)(gp + 8), g1);
      float y0[8], y1[8];
#pragma unroll
      for (int j = 0; j < 8; ++j) { y0[j] = (o[j] - mu) * r * siluf_(g0[j]); y1[j] = (o[8 + j] - mu) * r * siluf_(g1[j]); }
      bf16_t* yp = F.Y() + (row0 + t) * D + ycol + 16 * part; *(u32x4*)yp = pack8(y0); *(u32x4*)(yp + 8) = pack8(y1); }
    __syncthreads();
}

constexpr int S5_WL = 16384, S5_BU = 2048, S5_X = 2048 + 8320;
template <bool OUT>
__device__ __forceinline__ void s5_pass(Frame& F, int l) {
    LAS bf16_t* UT = (LAS bf16_t*)(F.lds + F.wave * S5_WL); LAS float* BU = (LAS float*)(F.lds + F.wave * S5_WL + S5_BU); LAS bf16_t* X = (LAS bf16_t*)(F.lds + F.wave * S5_WL + S5_X);
    const int gw = F.vcu * NWAVES + F.wave, NGW = F.G * NWAVES, lane = F.lane, lr = lane & 15, lq = lane >> 4;
    for (int unit = gw; unit < BATCH * NCH * 32; unit += NGW) {
        const int g = unit & 31, n = (unit >> 5) & 63, b = unit >> 11; const size_t row0 = (size_t)b * SEQ + (size_t)n * CH;
        { const bf16_t* up = F.PROJ() + (row0 + lane) * NIN + C_SU + g * 16; const u32x4 a = *(const u32x4*)up, c = *(const u32x4*)(up + 8);
          *(LAS u32x4*)(UT + lane * 16) = a; *(LAS u32x4*)(UT + lane * 16 + 8) = c; }
        const int gp = g * 64 + lane; const float ar = F.abar()[2 * gp], ai = F.abar()[2 * gp + 1];
        bf16x8 bfr[8];
#pragma unroll
        for (int q = 0; q < 8; ++q) { bfr[q] = (bf16x8){0, 0, 0, 0, 0, 0, 0, 0}; if (lq < 2) bfr[q] = *(const bf16x8*)(F.bbt() + ((size_t)g * 128 + 16 * q + lr) * 16 + 8 * lq); }
        float xr = 0.f, xi = 0.f;
        bf16x8 cf[4]; float dsk = 0.f;
        if (OUT) { const f32x2 x0 = *(const f32x2*)(F.XEND() + ((((size_t)(b * 32 + g)) * NCH + n) * 64 + lane) * 2); xr = x0.x; xi = x0.y;
#pragma unroll
            for (int ks = 0; ks < 4; ++ks) cf[ks] = *(const bf16x8*)(F.cmt() + ((size_t)(g * 16 + lr)) * 128 + 32 * ks + 8 * lq);
            dsk = F.s5_d()[(size_t)l * BW + g * 16 + lr]; }
        LDS_WAIT();
        for (int sb = 0; sb < 4; ++sb) {
            bf16x8 af = (bf16x8){0, 0, 0, 0, 0, 0, 0, 0}; if (lq < 2) af = *(const LAS bf16x8*)(UT + (16 * sb + lr) * 16 + 8 * lq);
#pragma unroll
            for (int q = 0; q < 8; ++q) { f32x4 acc = (f32x4){0.f, 0.f, 0.f, 0.f}; acc = __builtin_amdgcn_mfma_f32_16x16x32_bf16(af, bfr[q], acc, 0, 0, 0);
#pragma unroll
                for (int i = 0; i < 4; ++i) BU[(4 * lq + i) * 130 + 16 * q + lr] = acc[i]; }
            LDS_WAIT();
            float br[16], bi[16];
#pragma unroll
            for (int tt = 0; tt < 16; ++tt) { br[tt] = BU[tt * 130 + lane]; bi[tt] = BU[tt * 130 + 64 + lane]; }
#pragma unroll
            for (int tt = 0; tt < 16; ++tt) { const float nr = ar * xr - ai * xi + br[tt], ni = ar * xi + ai * xr + bi[tt]; xr = nr; xi = ni; asm volatile("" : "+v"(xr), "+v"(xi));
                if (OUT) { X[tt * 136 + lane] = (bf16_t)f2bf(xr); X[tt * 136 + 64 + lane] = (bf16_t)f2bf(xi); } }
            if (OUT) {
                LDS_WAIT();
                f32x4 acc = (f32x4){0.f, 0.f, 0.f, 0.f}; const LAS bf16_t* xp = X + lr * 136 + 8 * lq;
#pragma unroll
                for (int ks = 0; ks < 4; ++ks) acc = __builtin_amdgcn_mfma_f32_16x16x32_bf16(*(const LAS bf16x8*)(xp + 32 * ks), cf[ks], acc, 0, 0, 0);
#pragma unroll
                for (int i = 0; i < 4; ++i) { const int tl = 16 * sb + 4 * lq + i; const float u = bflo((unsigned)UT[tl * 16 + lr]); const float y = gelu_tanh(acc[i] + dsk * u);
                    F.YBP()[(row0 + tl) * BW + g * 16 + lr] = (bf16_t)f2bf(y); }
            }
            LDS_WAIT();
        }
        if (!OUT) *(f32x2*)(F.XEND() + ((((size_t)(b * 32 + g)) * NCH + n) * 64 + lane) * 2) = (f32x2){xr, xi};
    }
}
__device__ __forceinline__ void s5_scan(Frame& F) {
    const int gt = F.vcu * (NWAVES * 64) + F.tid, NGT = F.G * NWAVES * 64;
    for (int i = gt; i < BATCH * 32 * 64; i += NGT) {
        const int p = i & 63, bg = i >> 6, g = bg & 31; const float pr = F.apow()[2 * (g * 64 + p)], pi = F.apow()[2 * (g * 64 + p) + 1];
        float cr = 0.f, ci = 0.f;
#pragma unroll 8
        for (int n = 0; n < NCH; ++n) { f32x2* xp = (f32x2*)(F.XEND() + (((size_t)bg * NCH + n) * 64 + p) * 2); const f32x2 v = *xp; *xp = (f32x2){cr, ci};
            const float nr = pr * cr - pi * ci + v.x, ni = pr * ci + pi * cr + v.y; cr = nr; ci = ni; }
    }
}
__device__ __forceinline__ void pool_phase(Frame& F, int l) {
    const int gw = F.vcu * NWAVES + F.wave, NGW = F.G * NWAVES, lane = F.lane, lr = lane & 15, lq = lane >> 4;
    for (int unit = gw; unit < BATCH * (SEQ / 16) * 4; unit += NGW) {
        const int g = unit & 3, tile = (unit >> 2) & 255, b = unit >> 10; const int win = 2 << g, tpos = 16 * tile + lr; const size_t row = (size_t)b * SEQ + tpos;
        const bf16_t* pp = F.PROJ() + row * NIN + C_PU + g * 128 + 8 * lq;
        float s[4][8];
#pragma unroll
        for (int ks = 0; ks < 4; ++ks)
#pragma unroll
            for (int j = 0; j < 8; ++j) s[ks][j] = 0.f;
        for (int jj = 1; jj < win; ++jj) { if (tpos - jj >= 0) {
#pragma unroll
            for (int ks = 0; ks < 4; ++ks) { float a[8]; unpack8(*(const u32x4*)(pp - (size_t)jj * NIN + 32 * ks), a);
#pragma unroll
                for (int j = 0; j < 8; ++j) s[ks][j] += a[j]; } } }
        const float inv = 1.0f / (float)min(tpos + 1, win);
        bf16x8 mf[4];
#pragma unroll
        for (int ks = 0; ks < 4; ++ks) { float a[8], m[8]; unpack8(*(const u32x4*)(pp + 32 * ks), a);
#pragma unroll
            for (int j = 0; j < 8; ++j) m[j] = (s[ks][j] + a[j]) * inv - a[j];
            const u32x4 w = pack8(m); mf[ks] = __builtin_bit_cast(bf16x8, w); }
        const bf16_t* pw = F.poolw_t() + (size_t)g * 128 * 128 + (size_t)lr * 128 + 8 * lq;
#pragma unroll
        for (int q = 0; q < 8; ++q) { f32x4 acc = (f32x4){0.f, 0.f, 0.f, 0.f};
#pragma unroll
            for (int ks = 0; ks < 4; ++ks) acc = __builtin_amdgcn_mfma_f32_16x16x32_bf16(*(const bf16x8*)(pw + (size_t)(16 * q) * 128 + 32 * ks), mf[ks], acc, 0, 0, 0);
            const int dcol = g * 128 + 16 * q + 4 * lq; const f32x4 sc = *(const f32x4*)(F.pool_scale() + (size_t)l * BW + dcol);
            u32x2 w; w.x = pk2(acc[0] * sc.x, acc[1] * sc.y); w.y = pk2(acc[2] * sc.z, acc[3] * sc.w);
            *(u32x2*)(F.Y() + row * D + 1536 + dcol) = w; }
    }
}

__device__ __forceinline__ void conv_fix_phase(Frame& F, int l) {
    const float* cw = F.conv_w() + (size_t)l * 3 * NUP; const float* cb = F.conv_b() + (size_t)l * NUP; const float* UH = F.UH();
    const int gt = F.vcu * (NWAVES * 64) + F.tid, NGT = F.G * NWAVES * 64;
    constexpr int JG = DFF / 4;
    for (int task = gt; task < (M / 256) * 2 * JG; task += NGT) {
        const int jg = task % JG, q = (task / JG) & 1, pm = task / (2 * JG);
        if ((pm & 15) == 0) continue;
        const int j0 = jg * 4, ucol = 256 * (j0 >> 7) + (j0 & 127);
        const float* u0p = UH + ((size_t)pm * 4 + q) * NUP + ucol;
        const float* u1p = (q == 1) ? UH + ((size_t)pm * 4 + 0) * NUP + ucol : UH + ((size_t)(pm - 1) * 4 + 3) * NUP + ucol;
        const float* u2p = (q == 1) ? UH + ((size_t)(pm - 1) * 4 + 3) * NUP + ucol : UH + ((size_t)(pm - 1) * 4 + 2) * NUP + ucol;
        const f32x4 a0 = *(const f32x4*)u0p, a1 = *(const f32x4*)u1p, a2 = *(const f32x4*)u2p, v0 = *(const f32x4*)(u0p + 128), v1 = *(const f32x4*)(u1p + 128), v2 = *(const f32x4*)(u2p + 128);
        const f32x4 wa0 = *(const f32x4*)(cw + j0), wa1 = *(const f32x4*)(cw + NUP + j0), wa2 = *(const f32x4*)(cw + 2 * NUP + j0), ba = *(const f32x4*)(cb + j0);
        const f32x4 wv0 = *(const f32x4*)(cw + DFF + j0), wv1 = *(const f32x4*)(cw + NUP + DFF + j0), wv2 = *(const f32x4*)(cw + 2 * NUP + DFF + j0), bv = *(const f32x4*)(cb + DFF + j0);
        float o[4];
#pragma unroll
        for (int i = 0; i < 4; ++i) { const float ca = ba[i] + wa0[i] * a2[i] + wa1[i] * a1[i] + wa2[i] * a0[i], cv = bv[i] + wv0[i] * v2[i] + wv1[i] * v1[i] + wv2[i] * v0[i]; o[i] = siluf_(ca) * cv; }
        u32x2 w; w.x = pk2(o[0], o[1]); w.y = pk2(o[2], o[3]);
        *(u32x2*)(F.ACT() + ((size_t)pm * 256 + q) * DFF + j0) = w;
    }
}

constexpr int NPH = 13;
struct Args { const void* in[25]; float* out; unsigned char* ws; int l_lo, l_hi, ph_lo, ph_hi, single, pad; };
__global__ void __launch_bounds__(NWAVES * 64, 2) hybrid_fwd(Args args) {
    extern __shared__ __attribute__((aligned(16))) unsigned char lds[];
    Frame F;
    F.lds = (LAS unsigned char*)lds;
    F.tid = threadIdx.x; F.lane = F.tid & 63; F.wave = __builtin_amdgcn_readfirstlane(F.tid >> 6);
    const int wave0 = F.wave;
    F.G = gridDim.x; { const int bx = blockIdx.x; F.vcu = (F.G % 8 == 0) ? (bx % 8) * (F.G / 8) + bx / 8 : bx; }
    unsigned char* ws = args.ws; F.ws = ws; F.out = args.out;

    volatile LAS unsigned* MISC = (volatile LAS unsigned*)(F.lds + MISC_OFF);
    if (F.tid < 64) MISC[F.tid] = 0u;
    __syncthreads();
    unsigned* ctl = (unsigned*)(ws + WS_CTL);
    XcdBarrier bar; bar.bar = ctl + CW_BAR; bar.x = 0; bar.st = nullptr;
    if (args.single) bar = xcd_barrier_post(ctl + CW_BAR, MISC);
#define GRID_BAR() do { if (args.single) xcd_barrier(bar); } while (0)
    const int lo = args.ph_lo, hi = args.ph_hi;
#define IN(k) (lo <= (k) && (k) < hi)
#define PH_BEGIN() do { unsigned z_ = 0u; asm volatile("" : "+v"(z_)); const int ln_ = (int)__builtin_amdgcn_mbcnt_hi(~0u, __builtin_amdgcn_mbcnt_lo(~0u, z_)); F.lane = ln_; F.tid = wave0 * 64 + ln_; F.wave = wave0; } while (0)

    for (int l = args.l_lo; l < args.l_hi; ++l) {
        const float* hsrc = (l == 0) ? F.x() : F.out;
        if (IN(0)) { PH_BEGIN(); phase_prep(F, l); GRID_BAR(); }
        if (IN(1)) { PH_BEGIN(); pg8::Gemm g{F.HN(), F.win_t(), M, NIN, D, D, D}; pg8::StaticOrder S; S.init(M, NIN, F.G, (int)blockIdx.x); pg8::EpiProj E{F.PROJ(), NIN, C_GATE / 256, C_GATE};
            pg8::gemm_phase(F.lds, g, S, E, F.tid); GRID_BAR(); }
        if (IN(2)) { PH_BEGIN(); for (int u = F.vcu; u < 4096; u += F.G) lin_state_unit(F, l, u);
            s5_pass<false>(F, l); pool_phase(F, l); __syncthreads();
            GRID_BAR(); }
        if (IN(3)) { PH_BEGIN(); lin_scan(F); s5_scan(F); GRID_BAR(); }
        if (IN(4)) { PH_BEGIN(); for (int u = F.vcu; u < 4096; u += F.G) lin_out_unit(F, l, u);
            s5_pass<true>(F, l); __syncthreads();
            GRID_BAR(); }
        if (IN(5)) { PH_BEGIN(); pg8::Gemm g{F.YBP(), F.wglu_t(), M, BW, BW, BW, BW}; pg8::StaticOrder S; S.init(M, BW, F.G, (int)blockIdx.x); pg8::EpiGlu E{F.YBP(), BW, F.Y() + BW, D};
            pg8::gemm_phase(F.lds, g, S, E, F.tid); GRID_BAR(); }
        if (IN(6)) { PH_BEGIN(); pg8::Gemm g{F.Y(), F.wbr_t(), M, D, D, D, D}; pg8::StaticOrder S; S.init(M, D, F.G, (int)blockIdx.x); pg8::EpiMerge E{F.PROJ() + C_GATE, NIN, F.HN(), D};
            pg8::gemm_phase(F.lds, g, S, E, F.tid); GRID_BAR(); }
        if (IN(7)) { PH_BEGIN(); pg8::Gemm g{F.HN(), F.wout_t(), M, D, D, D, D}; pg8::StaticOrder S; S.init(M, D, F.G, (int)blockIdx.x); pg8::EpiResid E{hsrc, F.out, D};
            pg8::gemm_phase(F.lds, g, S, E, F.tid); GRID_BAR(); }
        if (IN(8)) { PH_BEGIN(); rms_rows(F, F.out, F.g_ffn() + (size_t)l * D, F.HN()); GRID_BAR(); }
        if (IN(9)) { PH_BEGIN(); pg8::Gemm g{F.HN(), F.wup_t(), M, NUP, D, D, D}; pg8::StaticOrder S; S.init(M, NUP, F.G, (int)blockIdx.x); pg8::EpiConv E{F.conv_w() + (size_t)l * 3 * NUP, F.conv_b() + (size_t)l * NUP, F.ACT(), F.UH(), (LAS float*)(F.lds + pg8::STAGE_BYTES)};
            pg8::gemm_phase(F.lds, g, S, E, F.tid); GRID_BAR(); }
        if (IN(10)) { PH_BEGIN(); conv_fix_phase(F, l); GRID_BAR(); }
        if (IN(11)) { PH_BEGIN(); pg8::Gemm g{F.ACT(), F.wdn_t(), M, D, DFF, DFF, DFF}; pg8::StaticOrder S; S.init(M, D, F.G, (int)blockIdx.x); pg8::EpiResid E{F.out, F.out, D};
            pg8::gemm_phase(F.lds, g, S, E, F.tid); GRID_BAR(); }
        if (IN(12) && l == DEPTH - 1) { PH_BEGIN(); rms_rows_f32_inplace(F, F.out, F.g_final()); }
    }
#undef IN
#undef PH_BEGIN
#undef GRID_BAR
}

extern "C" void kernel_launch(void* const* d_in, const int* in_sizes, int n_in, void* d_out, int out_size, void* d_ws, size_t ws_size, hipStream_t stream) {
    static int grid = 0;
    if (grid == 0) {
        if (n_in != 25 || in_sizes[0] != M * D || out_size != M * D || ws_size < WS_END) { fprintf(stderr, "kernel_launch: shape/workspace mismatch (n_in %d, in0 %d, out %d, ws %zu, need %zu); nothing launched\n", n_in, n_in > 0 ? in_sizes[0] : -1, out_size, ws_size, (size_t)WS_END); grid = -1; return; }
        int dev = 0, cus = 0, per_cu = 0;
        if (hipGetDevice(&dev) != hipSuccess || hipDeviceGetAttribute(&cus, hipDeviceAttributeMultiprocessorCount, dev) != hipSuccess) { grid = -1; return; }
        if (hipFuncSetAttribute((const void*)hybrid_fwd, hipFuncAttributeMaxDynamicSharedMemorySize, LDS_BYTES) != hipSuccess) { fprintf(stderr, "kernel_launch: hipFuncSetAttribute failed\n"); grid = -1; return; }
        if (hipOccupancyMaxActiveBlocksPerMultiprocessor(&per_cu, (const void*)hybrid_fwd, NWAVES * 64, LDS_BYTES) != hipSuccess || per_cu < 1) { fprintf(stderr, "kernel_launch: occupancy query reports %d workgroups per CU\n", per_cu); }
        (void)hipGetLastError();
        grid = cus;
    }
    if (grid < 0) return;
    if (hipMemsetAsync((char*)d_ws + WS_CTL, 0, CTL_ZERO_BYTES, stream) != hipSuccess) return;
    Args a{};
    for (int i = 0; i < 25; ++i) a.in[i] = d_in[i];
    a.out = (float*)d_out; a.ws = (unsigned char*)d_ws;
#if MK_SINGLE
    a.l_lo = 0; a.l_hi = DEPTH; a.ph_lo = 0; a.ph_hi = NPH; a.single = 1;
    hipLaunchKernelGGL(hybrid_fwd, dim3(grid), dim3(NWAVES * 64), LDS_BYTES, stream, a);
#else
    a.single = 0;
    for (int l = 0; l < DEPTH; ++l)
        for (int p = 0; p < NPH; ++p) { if (p == 12 && l != DEPTH - 1) continue; a.l_lo = l; a.l_hi = l + 1; a.ph_lo = p; a.ph_hi = p + 1;
            hipLaunchKernelGGL(hybrid_fwd, dim3(grid), dim3(NWAVES * 64), LDS_BYTES, stream, a); }
#endif
}
```

```cpp
#include <hip/hip_runtime.h>
#include <cstdio>
#include <cstdint>

#ifndef MK_SINGLE
#define MK_SINGLE 1
#endif

#define LAS __attribute__((address_space(3)))
#define GAS __attribute__((address_space(1)))
typedef unsigned short bf16_t;
typedef short bf16x8 __attribute__((ext_vector_type(8)));
typedef float f32x4 __attribute__((ext_vector_type(4)));
typedef float f32x2 __attribute__((ext_vector_type(2)));
typedef unsigned u32x4 __attribute__((ext_vector_type(4)));
typedef unsigned u32x2 __attribute__((ext_vector_type(2)));

constexpr int D = 2048, BATCH = 8, SEQ = 4096, DEPTH = 4, M = BATCH * SEQ;
constexpr int BW = 512;
constexpr int NIN_SRC = 12304, NIN = 12544;
constexpr int DFF = 5504, NUP = 11008;
constexpr int C_RQ = 0, C_RK = 256, C_RV = 512, C_RG = 1024, C_SU = 1536, C_GQ = 2048, C_GK = 2304, C_GV = 2560, C_GG = 3072, C_PU = 3584, C_GR = 4096, C_GATE = 4352;
constexpr float EPS = 1e-6f;
constexpr int NWAVES = 8;
constexpr int CH = 64;
constexpr int NCH = SEQ / CH;

constexpr size_t MiB = 1u << 20;
constexpr size_t WS_CTL = 0, CTL_ZERO_BYTES = 1 * MiB;
constexpr size_t WS_ROT = 1 * MiB;
constexpr size_t WS_S5T = 9 * MiB;
constexpr size_t S5T_ABAR = 0, S5T_APOW = 16384, S5T_BBAR = 32768, S5T_CMT = 32768 + 262144, S5T_BBT = S5T_CMT + 131072;
constexpr size_t WS_WGLU = 10 * MiB;
constexpr size_t WS_POOLW = 10 * MiB + 512 * 1024;
constexpr size_t WS_WIN = 11 * MiB;
constexpr size_t WS_WBR = 60 * MiB;
constexpr size_t WS_WOUT = 68 * MiB;
constexpr size_t WS_WUP = 76 * MiB;
constexpr size_t WS_WDN = 119 * MiB;
constexpr size_t WS_HN = 141 * MiB;
constexpr size_t WS_Y = 269 * MiB;
constexpr size_t WS_SCR = 397 * MiB;
constexpr size_t WS_YBP = WS_SCR;
constexpr size_t WS_STATE = WS_SCR + 32 * MiB;
constexpr size_t WS_SPREV = WS_SCR + 160 * MiB;
constexpr size_t WS_DEC = WS_SCR + 224 * MiB;
constexpr size_t WS_XEND = WS_SCR + 225 * MiB;
constexpr size_t WS_UH = WS_SCR + 128 * MiB;
constexpr size_t WS_PROJ = 637 * MiB;
constexpr size_t WS_ACT = WS_PROJ;
constexpr size_t WS_END = 1421 * MiB;
static_assert(WS_PROJ + (size_t)M * NIN * 2 <= WS_END, "ws map");
static_assert(WS_ACT + (size_t)M * DFF * 2 <= WS_END, "ws map");
static_assert(WS_XEND + 8 * MiB <= WS_PROJ, "ws map");
static_assert(WS_UH + (size_t)(M / 256) * 4 * NUP * 4 <= WS_PROJ, "ws map");
constexpr int CW_TMO = 0, CW_BAR = 4096;

constexpr int LDS_BYTES = 155648;
constexpr int MISC_OFF = LDS_BYTES - 256;

#define RLX_AGENT __ATOMIC_RELAXED, __HIP_MEMORY_SCOPE_AGENT
#define LDS_WAIT() asm volatile("s_waitcnt lgkmcnt(0)" ::: "memory")
#define VM_WAIT() asm volatile("s_waitcnt vmcnt(0)" ::: "memory")
__device__ __forceinline__ unsigned f2bf(float f) { unsigned u = __builtin_bit_cast(unsigned, f); return (u + 0x7fffu + ((u >> 16) & 1u)) >> 16; }
__device__ __forceinline__ unsigned pk2(float lo, float hi) { return f2bf(lo) | (f2bf(hi) << 16); }
__device__ __forceinline__ float bflo(unsigned w) { return __builtin_bit_cast(float, w << 16); }
__device__ __forceinline__ float bfhi(unsigned w) { return __builtin_bit_cast(float, w & 0xffff0000u); }
__device__ __forceinline__ void unpack8(const u32x4 w, float (&v)[8]) { v[0] = bflo(w.x); v[1] = bfhi(w.x); v[2] = bflo(w.y); v[3] = bfhi(w.y); v[4] = bflo(w.z); v[5] = bfhi(w.z); v[6] = bflo(w.w); v[7] = bfhi(w.w); }
__device__ __forceinline__ u32x4 pack8(const float (&v)[8]) { u32x4 w; w.x = pk2(v[0], v[1]); w.y = pk2(v[2], v[3]); w.z = pk2(v[4], v[5]); w.w = pk2(v[6], v[7]); return w; }
__device__ __forceinline__ float sigmoidf_(float x) { return 1.0f / (1.0f + __expf(-x)); }
__device__ __forceinline__ float siluf_(float x) { return x / (1.0f + __expf(-x)); }
__device__ __forceinline__ float gelu_tanh(float x) { const float u = 1.5957691216f * (x + 0.044715f * x * x * x); return x / (1.0f + __expf(-u)); }
__device__ __forceinline__ float logsigmoidf_(float x) { return fminf(x, 0.f) - __logf(1.0f + __expf(-fabsf(x))); }

namespace pg8 {
constexpr int BM = 256, BK = 64, HALF = 128, HTB = HALF * BK * 2, STAGE_BYTES = 8 * HTB, NXCD = 8, WGM = 8;
__host__ __device__ __forceinline__ int lds_byte(int r, int c) { const int st = (r >> 4) * 2 + (c >> 5), rr = r & 15, cc = c & 31, ob = rr * 64 + cc * 2; return st * 1024 + (ob ^ (((ob >> 9) & 1) << 5)); }
__host__ __device__ __forceinline__ void stage_rc(int b, int& R, int& C) { const int st = b / 1024, sb = b % 1024, swz = sb ^ (((sb >> 9) & 1) << 5); R = (st >> 1) * 16 + swz / 64; C = (st & 1) * 32 + (swz % 64) / 2; }
__host__ __device__ __forceinline__ int perm32(int rho) { const int n = rho >> 4, i = rho & 15; return 8 * (i >> 2) + 4 * n + (i & 3); }

struct Unit { int pm, pn; };
struct Gemm { const bf16_t* A; const bf16_t* Bt; int M, N, K, lda, ldb; };

struct StaticOrder {
    int nM, nN, nwg, G, c;
    __host__ __device__ void init(int M_, int N_, int G_, int c_) { nM = M_ / BM; nN = N_ / BM; nwg = nM * nN; G = G_; c = c_; }
    __host__ __device__ bool next(int i, Unit& u) const {
        const long L = (long)i * G + c; if (L >= nwg) return false;
        int wgid = (int)L; { const int q = nwg / NXCD, r = nwg % NXCD, xcd = wgid % NXCD, off = wgid / NXCD; wgid = (xcd < r ? xcd * (q + 1) : r * (q + 1) + (xcd - r) * q) + off; }
        const int nig = WGM * nN, gid = wgid / nig, fm = gid * WGM, gsz = (nM - fm) < WGM ? (nM - fm) : WGM;
        u.pm = fm + ((wgid % nig) % gsz); u.pn = (wgid % nig) / gsz; return true;
    }
};

__device__ __forceinline__ unsigned cvt_pk_bf16(float lo, float hi) { unsigned r; asm volatile("v_cvt_pk_bf16_f32 %0, %1, %2" : "=v"(r) : "v"(lo), "v"(hi)); return r; }

struct EpiStoreBf16 {
    static constexpr bool PERM = true, KHOOK = false;
    bf16_t* O; int ldc;
    __device__ __forceinline__ void khook(f32x4 (&)[2][2][4][2], const Unit&, int, int, int, int, int) const {}
    __device__ __forceinline__ void operator()(const f32x4 (&acc)[2][2][4][2], const Unit& u, int wr, int wc, int fr, int fq) const {
        const int row0 = u.pm * BM + wr * 64 + fr, col0 = u.pn * BM + wc * 32 + 8 * fq;
#pragma unroll
        for (int ai = 0; ai < 2; ++ai)
#pragma unroll
            for (int m = 0; m < 4; ++m) { bf16_t* rowp = O + (size_t)(row0 + ai * HALF + m * 16) * ldc + col0;
#pragma unroll
                for (int bj = 0; bj < 2; ++bj) { const f32x4 v0 = acc[ai][bj][m][0], v1 = acc[ai][bj][m][1];
                    u32x4 w; w.x = cvt_pk_bf16(v0[0], v0[1]); w.y = cvt_pk_bf16(v0[2], v0[3]); w.z = cvt_pk_bf16(v1[0], v1[1]); w.w = cvt_pk_bf16(v1[2], v1[3]);
                    *(u32x4*)(rowp + bj * HALF) = w; } }
    }
};
struct EpiProj {
    static constexpr bool PERM = true, KHOOK = false;
    bf16_t* O; int ldc; int gate_pn0; int gate_col0;
    __device__ __forceinline__ void khook(f32x4 (&)[2][2][4][2], const Unit&, int, int, int, int, int) const {}
    __device__ __forceinline__ void operator()(const f32x4 (&acc)[2][2][4][2], const Unit& u, int wr, int wc, int fr, int fq) const {
        const int row0 = u.pm * BM + wr * 64 + fr;
        if (u.pn < gate_pn0) {
            const int col0 = u.pn * BM + wc * 32 + 8 * fq;
#pragma unroll
            for (int ai = 0; ai < 2; ++ai)
#pragma unroll
                for (int m = 0; m < 4; ++m) { bf16_t* rowp = O + (size_t)(row0 + ai * HALF + m * 16) * ldc + col0;
#pragma unroll
                    for (int bj = 0; bj < 2; ++bj) { const f32x4 v0 = acc[ai][bj][m][0], v1 = acc[ai][bj][m][1];
                        u32x4 w; w.x = cvt_pk_bf16(v0[0], v0[1]); w.y = cvt_pk_bf16(v0[2], v0[3]); w.z = cvt_pk_bf16(v1[0], v1[1]); w.w = cvt_pk_bf16(v1[2], v1[3]);
                        *(u32x4*)(rowp + bj * HALF) = w; } }
        } else {
            const int col0 = gate_col0 + 64 * (u.pn - gate_pn0) + 16 * wc + 4 * fq;
#pragma unroll
            for (int ai = 0; ai < 2; ++ai)
#pragma unroll
                for (int m = 0; m < 4; ++m) { bf16_t* rowp = O + (size_t)(row0 + ai * HALF + m * 16) * ldc + col0;
                    float r1[4], r2[4], r3[4], g3[4];
#pragma unroll
                    for (int i = 0; i < 4; ++i) {
                        const float e0 = __expf(-fminf(fmaxf(acc[ai][0][m][0][i], -30.f), 30.f)), e1 = __expf(-fminf(fmaxf(acc[ai][0][m][1][i], -30.f), 30.f));
                        const float e2 = __expf(-fminf(fmaxf(acc[ai][1][m][0][i], -30.f), 30.f)), e3 = __expf(-fminf(fmaxf(acc[ai][1][m][1][i], -30.f), 30.f));
                        const float i0 = __builtin_amdgcn_rcpf(1.f + e0), i1 = __builtin_amdgcn_rcpf(1.f + e1), i2 = __builtin_amdgcn_rcpf(1.f + e2), i3 = __builtin_amdgcn_rcpf(1.f + e3);
                        r1[i] = (1.f + e1) * i0; r2[i] = (1.f + e2) * i1; r3[i] = (1.f + e3) * i2; g3[i] = i3; }
                    u32x2 w;
                    w.x = cvt_pk_bf16(r1[0], r1[1]); w.y = cvt_pk_bf16(r1[2], r1[3]); *(u32x2*)(rowp) = w;
                    w.x = cvt_pk_bf16(r2[0], r2[1]); w.y = cvt_pk_bf16(r2[2], r2[3]); *(u32x2*)(rowp + D) = w;
                    w.x = cvt_pk_bf16(r3[0], r3[1]); w.y = cvt_pk_bf16(r3[2], r3[3]); *(u32x2*)(rowp + 2 * D) = w;
                    w.x = cvt_pk_bf16(g3[0], g3[1]); w.y = cvt_pk_bf16(g3[2], g3[3]); *(u32x2*)(rowp + 3 * D) = w; }
        }
    }
};
__device__ __forceinline__ float dpp_ror1(float x) { return __builtin_bit_cast(float, __builtin_amdgcn_update_dpp(0, __builtin_bit_cast(int, x), 0x121, 0xf, 0xf, false)); }
__device__ __forceinline__ float dpp_ror2(float x) { return __builtin_bit_cast(float, __builtin_amdgcn_update_dpp(0, __builtin_bit_cast(int, x), 0x122, 0xf, 0xf, false)); }
struct EpiConv {
    static constexpr bool PERM = true, KHOOK = false;
    const float* cw; const float* cb; bf16_t* O; float* UH; LAS float* halo;
    __device__ __forceinline__ void khook(f32x4 (&)[2][2][4][2], const Unit&, int, int, int, int, int) const {}
    __device__ __forceinline__ void operator()(const f32x4 (&acc)[2][2][4][2], const Unit& u, int wr, int wc, int fr_, int fq_) const {
        int fr = fr_, fq = fq_; asm volatile("" : "+v"(fr), "+v"(fq));
        const int cl0 = wc * 32 + 8 * fq;
        if (fr >= 14) {
#pragma unroll
            for (int ai = 0; ai < 2; ++ai)
#pragma unroll
                for (int bj = 0; bj < 2; ++bj)
#pragma unroll
                    for (int n = 0; n < 2; ++n) *(LAS f32x4*)(halo + (((2 * ai + wr) * 2 + (fr - 14)) * 256 + 128 * bj + cl0 + 4 * n)) = acc[ai][bj][3][n];
        }
        if (wr == 0 && fr < 2) {
#pragma unroll
            for (int bj = 0; bj < 2; ++bj)
#pragma unroll
                for (int n = 0; n < 2; ++n) *(f32x4*)(UH + ((size_t)u.pm * 4 + fr) * NUP + 256 * u.pn + 128 * bj + cl0 + 4 * n) = acc[0][bj][0][n];
        }
        if (wr == 1 && fr >= 14) {
#pragma unroll
            for (int bj = 0; bj < 2; ++bj)
#pragma unroll
                for (int n = 0; n < 2; ++n) *(f32x4*)(UH + ((size_t)u.pm * 4 + 2 + (fr - 14)) * NUP + 256 * u.pn + 128 * bj + cl0 + 4 * n) = acc[1][bj][3][n];
        }
        asm volatile("s_waitcnt lgkmcnt(0)" ::: "memory"); __builtin_amdgcn_s_barrier(); asm volatile("" ::: "memory");
        const int j0 = 128 * u.pn + cl0;
        const bool is15 = fr == 15, ge14 = fr >= 14;
        unsigned keep[2][4][2];
#pragma unroll
        for (int n = 0; n < 2; ++n) {
            f32x4 wa[3], wv[3];
#pragma unroll
            for (int q = 0; q < 3; ++q) { wa[q] = *(const f32x4*)(cw + q * NUP + j0 + 4 * n); wv[q] = *(const f32x4*)(cw + q * NUP + DFF + j0 + 4 * n); }
            const f32x4 ba = *(const f32x4*)(cb + j0 + 4 * n), bv = *(const f32x4*)(cb + DFF + j0 + 4 * n);
#pragma unroll
            for (int ai = 0; ai < 2; ++ai) {
                const int blk = 2 * ai + wr;
                f32x4 pa = (f32x4){0.f, 0.f, 0.f, 0.f}, pv = (f32x4){0.f, 0.f, 0.f, 0.f};
                if (blk > 0 && ge14) { pa = *(const LAS f32x4*)(halo + (((blk - 1) * 2 + (fr - 14)) * 256 + cl0 + 4 * n)); pv = *(const LAS f32x4*)(halo + (((blk - 1) * 2 + (fr - 14)) * 256 + 128 + cl0 + 4 * n)); }
#pragma unroll
                for (int m = 0; m < 4; ++m) {
                    const f32x4 ca_ = acc[ai][0][m][n], cv_ = acc[ai][1][m][n]; float o[4];
#pragma unroll
                    for (int i = 0; i < 4; ++i) {
                        const float a1 = dpp_ror1(is15 ? pa[i] : ca_[i]), a2 = dpp_ror2(ge14 ? pa[i] : ca_[i]);
                        const float v1 = dpp_ror1(is15 ? pv[i] : cv_[i]), v2 = dpp_ror2(ge14 ? pv[i] : cv_[i]);
                        const float ca = ba[i] + wa[0][i] * a2 + wa[1][i] * a1 + wa[2][i] * ca_[i];
                        const float cv = bv[i] + wv[0][i] * v2 + wv[1][i] * v1 + wv[2][i] * cv_[i];
                        o[i] = siluf_(ca) * cv; }
                    pa = ca_; pv = cv_;
                    const unsigned lo = cvt_pk_bf16(o[0], o[1]), hi = cvt_pk_bf16(o[2], o[3]);
                    if (n == 0) { keep[ai][m][0] = lo; keep[ai][m][1] = hi; }
                    else { u32x4 w; w.x = keep[ai][m][0]; w.y = keep[ai][m][1]; w.z = lo; w.w = hi;
                        *(u32x4*)(O + (size_t)(u.pm * BM + ai * HALF + wr * 64 + m * 16 + fr) * DFF + j0) = w; }
                }
            }
        }
    }
};
struct EpiResid {
    static constexpr bool PERM = false, KHOOK = false;
    const float* base; float* out; int ldc;
    __device__ __forceinline__ void khook(f32x4 (&)[2][2][4][2], const Unit&, int, int, int, int, int) const {}
    __device__ __forceinline__ void operator()(const f32x4 (&acc)[2][2][4][2], const Unit& u, int wr, int wc, int fr, int fq) const {
        const int row0 = u.pm * BM + wr * 64 + fr, col0 = u.pn * BM + wc * 32 + 4 * fq;
#pragma unroll
        for (int ai = 0; ai < 2; ++ai)
#pragma unroll
            for (int m = 0; m < 4; ++m) { const size_t off = (size_t)(row0 + ai * HALF + m * 16) * ldc + col0;
#pragma unroll
                for (int bj = 0; bj < 2; ++bj)
#pragma unroll
                    for (int n = 0; n < 2; ++n) { const f32x4 bs = *(const f32x4*)(base + off + bj * HALF + n * 16); *(f32x4*)(out + off + bj * HALF + n * 16) = bs + acc[ai][bj][m][n]; }
                asm volatile("" ::: "memory"); }
    }
};
struct EpiGlu {
    static constexpr bool PERM = true, KHOOK = false;
    const bf16_t* Yp; int ldy; bf16_t* O; int ldc;
    __device__ __forceinline__ void khook(f32x4 (&)[2][2][4][2], const Unit&, int, int, int, int, int) const {}
    __device__ __forceinline__ void operator()(const f32x4 (&acc)[2][2][4][2], const Unit& u, int wr, int wc, int fr, int fq) const {
        const int row0 = u.pm * BM + wr * 64 + fr, col0 = u.pn * BM + wc * 32 + 8 * fq;
#pragma unroll
        for (int ai = 0; ai < 2; ++ai)
#pragma unroll
            for (int m = 0; m < 4; ++m) { const size_t r = (size_t)(row0 + ai * HALF + m * 16);
#pragma unroll
                for (int bj = 0; bj < 2; ++bj) { const u32x4 yw = *(const u32x4*)(Yp + r * ldy + col0 + bj * HALF); float y[8]; unpack8(yw, y);
                    const f32x4 v0 = acc[ai][bj][m][0], v1 = acc[ai][bj][m][1]; float o[8];
#pragma unroll
                    for (int j = 0; j < 4; ++j) { o[j] = y[j] * sigmoidf_(v0[j]); o[4 + j] = y[4 + j] * sigmoidf_(v1[j]); }
                    u32x4 w; w.x = cvt_pk_bf16(o[0], o[1]); w.y = cvt_pk_bf16(o[2], o[3]); w.z = cvt_pk_bf16(o[4], o[5]); w.w = cvt_pk_bf16(o[6], o[7]);
                    *(u32x4*)(O + r * ldc + col0 + bj * HALF) = w; } }
    }
};
struct EpiMerge {
    static constexpr bool PERM = true, KHOOK = true;
    const bf16_t* G; int ldg; bf16_t* O; int ldc;
    __device__ __forceinline__ void scale(f32x4 (&acc)[2][2][4][2], const Unit& u, int s, int wr, int wc, int fr, int fq) const {
        int row0 = u.pm * BM + wr * 64 + fr, col0 = u.pn * BM + wc * 32 + 8 * fq + s * D; asm volatile("" : "+v"(row0), "+v"(col0));
        u32x4 w[2][4][2];
#pragma unroll
        for (int ai = 0; ai < 2; ++ai)
#pragma unroll
            for (int m = 0; m < 4; ++m) { const bf16_t* gp = G + (size_t)(row0 + ai * HALF + m * 16) * ldg + col0;
#pragma unroll
                for (int bj = 0; bj < 2; ++bj) w[ai][m][bj] = *(const u32x4*)(gp + bj * HALF); }
#pragma unroll
        for (int ai = 0; ai < 2; ++ai)
#pragma unroll
            for (int m = 0; m < 4; ++m)
#pragma unroll
                for (int bj = 0; bj < 2; ++bj) { float f[8]; unpack8(w[ai][m][bj], f);
#pragma unroll
                    for (int j = 0; j < 8; ++j) acc[ai][bj][m][j >> 2][j & 3] *= f[j]; }
    }
    __device__ __forceinline__ void khook(f32x4 (&acc)[2][2][4][2], const Unit& u, int seg, int wr, int wc, int fr, int fq) const { scale(acc, u, seg - 1, wr, wc, fr, fq); }
    __device__ __forceinline__ void operator()(f32x4 (&acc)[2][2][4][2], const Unit& u, int wr, int wc, int fr, int fq) const {
        scale(acc, u, 3, wr, wc, fr, fq);
        const int row0 = u.pm * BM + wr * 64 + fr, col0 = u.pn * BM + wc * 32 + 8 * fq;
#pragma unroll
        for (int ai = 0; ai < 2; ++ai)
#pragma unroll
            for (int m = 0; m < 4; ++m) { bf16_t* rowp = O + (size_t)(row0 + ai * HALF + m * 16) * ldc + col0;
#pragma unroll
                for (int bj = 0; bj < 2; ++bj) { const f32x4 v0 = acc[ai][bj][m][0], v1 = acc[ai][bj][m][1];
                    u32x4 w; w.x = cvt_pk_bf16(v0[0], v0[1]); w.y = cvt_pk_bf16(v0[2], v0[3]); w.z = cvt_pk_bf16(v1[0], v1[1]); w.w = cvt_pk_bf16(v1[2], v1[3]);
                    *(u32x4*)(rowp + bj * HALF) = w; } }
    }
};

template <class Epi>
__device__ __forceinline__ void gemm_phase(LAS unsigned char* lds, const Gemm g, const StaticOrder& S, const Epi& E, int tid_in) {
    int tid_ = tid_in; asm volatile("" : "+v"(tid_));
    const int tid = tid_, wid = __builtin_amdgcn_readfirstlane(tid >> 6), lane = tid & 63, wr = wid >> 2, wc = wid & 3, fr = lane & 15, fq = lane >> 4;
    const int K = g.K, nt = K / BK;
    unsigned voffA[2], voffB[2];
#pragma unroll
    for (int i = 0; i < 2; ++i) { int R, C; stage_rc(tid * 16 + i * 8192, R, C); const int Rb = Epi::PERM ? ((R & ~31) + perm32(R & 31)) : R;
        voffA[i] = (unsigned)(R * g.lda + C) * 2u; voffB[i] = (unsigned)(Rb * g.ldb + C) * 2u; }
    const size_t kstep = (size_t)(BK * 2);
    const size_t hstepA = (size_t)HALF * g.lda * 2, hstepB = (size_t)HALF * g.ldb * 2;
    const size_t tstepA = 2 * hstepA, tstepB = 2 * hstepB;
    const unsigned ldsw = (unsigned)wid * 1024u;
    const int aoff = lds_byte(wr * 64 + fr, fq * 8), boff = lds_byte(wc * 32 + fr, fq * 8);
#define PG8_SA(b, h) (((b) * 2 + (h)) * HTB)
#define PG8_SB(b, h) ((4 + (b) * 2 + (h)) * HTB)
#define PG8_STAGE(bufoff, gbase, voff) do { _Pragma("unroll") for (int _i = 0; _i < 2; ++_i) \
        __builtin_amdgcn_global_load_lds((const unsigned*)((const char*)(gbase) + (voff)[_i]), (LAS unsigned*)(lds + (bufoff) + ldsw + _i * 8192), 16, 0, 0); } while (0)
#define PG8_LDA(dst, b, h) do { _Pragma("unroll") for (int m = 0; m < 4; ++m) _Pragma("unroll") for (int k = 0; k < 2; ++k) dst[m][k] = *(const LAS bf16x8*)(lds + PG8_SA(b, h) + aoff + m * 2048 + k * 1024); } while (0)
#define PG8_LDB(dst, b, h) do { _Pragma("unroll") for (int n = 0; n < 2; ++n) _Pragma("unroll") for (int k = 0; k < 2; ++k) dst[n][k] = *(const LAS bf16x8*)(lds + PG8_SB(b, h) + boff + n * 2048 + k * 1024); } while (0)
#define PG8_MMA(ai, bj, At, Bt) do { __builtin_amdgcn_s_setprio(1); _Pragma("unroll") for (int m = 0; m < 4; ++m) _Pragma("unroll") for (int n = 0; n < 2; ++n) _Pragma("unroll") for (int k = 0; k < 2; ++k) \
        acc[ai][bj][m][n] = __builtin_amdgcn_mfma_f32_16x16x32_bf16(Bt[n][k], At[m][k], acc[ai][bj][m][n], 0, 0, 0); __builtin_amdgcn_s_setprio(0); } while (0)
#define PG8_WAIT_V(n) asm volatile("s_waitcnt vmcnt(" #n ")" ::: "memory")
#define PG8_WAIT_L(n) asm volatile("s_waitcnt lgkmcnt(" #n ")" ::: "memory")
#define PG8_BAR __builtin_amdgcn_s_barrier()
#define PG8_SCHED __builtin_amdgcn_sched_barrier(0)
    Unit cur, nxt; int ui = 0;
    if (!S.next(0, cur)) return;
    f32x4 acc[2][2][4][2];
#pragma unroll
    for (int a = 0; a < 2; ++a)
#pragma unroll
        for (int b = 0; b < 2; ++b)
#pragma unroll
            for (int m = 0; m < 4; ++m)
#pragma unroll
                for (int n = 0; n < 2; ++n) acc[a][b][m][n] = (f32x4){0.f, 0.f, 0.f, 0.f};
    bf16x8 At[4][2], B0[2][2], B1[2][2];
    const char* cA = (const char*)g.A + (size_t)cur.pm * tstepA; const char* cB = (const char*)g.Bt + (size_t)cur.pn * tstepB;
    PG8_STAGE(PG8_SB(0, 0), cB, voffB); PG8_STAGE(PG8_SB(0, 1), cB + hstepB, voffB); PG8_STAGE(PG8_SA(0, 0), cA, voffA); PG8_STAGE(PG8_SA(0, 1), cA + hstepA, voffA);
    if (wr == 1) PG8_BAR;
    PG8_WAIT_V(2); PG8_BAR;
    PG8_STAGE(PG8_SB(1, 0), cB + kstep, voffB); PG8_STAGE(PG8_SA(1, 0), cA + kstep, voffA); PG8_STAGE(PG8_SB(1, 1), cB + hstepB + kstep, voffB);
    PG8_WAIT_V(6); PG8_BAR;
    for (;;) {
        const bool has_next = S.next(ui + 1, nxt);
        const char* nA = has_next ? (const char*)g.A + (size_t)nxt.pm * tstepA : cA; const char* nB = has_next ? (const char*)g.Bt + (size_t)nxt.pn * tstepB : cB;
        for (int t = 0; t < nt; t += 2) {
            const bool last = (t == nt - 2);
            const char* a1 = cA + (size_t)(t + 1) * kstep;
            const char* a2 = last ? nA : cA + (size_t)(t + 2) * kstep; const char* b2 = last ? nB : cB + (size_t)(t + 2) * kstep;
            const char* a3 = a2 + kstep; const char* b3 = b2 + kstep;
            if constexpr (Epi::KHOOK) { if (t != 0 && (t & 7) == 0) E.khook(acc, cur, t >> 3, wr, wc, fr, fq); }
            PG8_LDB(B0, 0, 0); PG8_LDB(B1, 0, 1); PG8_SCHED; PG8_LDA(At, 0, 0); PG8_STAGE(PG8_SA(1, 1), a1 + hstepA, voffA);
            PG8_WAIT_V(8); PG8_WAIT_L(0); PG8_BAR; PG8_MMA(0, 0, At, B0); PG8_MMA(0, 1, At, B1); PG8_BAR; PG8_SCHED;
            PG8_LDA(At, 0, 1); PG8_STAGE(PG8_SB(0, 0), b2, voffB); PG8_STAGE(PG8_SB(0, 1), b2 + hstepB, voffB); PG8_STAGE(PG8_SA(0, 0), a2, voffA);
            PG8_WAIT_V(8); PG8_WAIT_L(0); PG8_BAR; PG8_MMA(1, 0, At, B0); PG8_MMA(1, 1, At, B1); PG8_BAR; PG8_SCHED;
            PG8_LDB(B0, 1, 0); PG8_LDB(B1, 1, 1); PG8_SCHED; PG8_LDA(At, 1, 0); PG8_STAGE(PG8_SA(0, 1), a2 + hstepA, voffA);
            PG8_WAIT_V(8); PG8_WAIT_L(0); PG8_BAR; PG8_MMA(0, 0, At, B0); PG8_MMA(0, 1, At, B1); PG8_BAR; PG8_SCHED;
            PG8_LDA(At, 1, 1); PG8_STAGE(PG8_SB(1, 0), b3, voffB); PG8_STAGE(PG8_SB(1, 1), b3 + hstepB, voffB); PG8_STAGE(PG8_SA(1, 0), a3, voffA);
            PG8_WAIT_V(8); PG8_WAIT_L(0); PG8_BAR; PG8_MMA(1, 0, At, B0); PG8_MMA(1, 1, At, B1); PG8_BAR; PG8_SCHED;
        }
        if (wr == 0) PG8_BAR;
        E(acc, cur, wr, wc, fr, fq);
        if (!has_next) break;
#pragma unroll
        for (int a = 0; a < 2; ++a)
#pragma unroll
            for (int b = 0; b < 2; ++b)
#pragma unroll
                for (int m = 0; m < 4; ++m)
#pragma unroll
                    for (int n = 0; n < 2; ++n) acc[a][b][m][n] = (f32x4){0.f, 0.f, 0.f, 0.f};
        cur = nxt; cA = nA; cB = nB; ++ui;
        if (wr == 1) PG8_BAR;
    }
    PG8_WAIT_V(0);
    PG8_BAR;
#undef PG8_SA
#undef PG8_SB
#undef PG8_STAGE
#undef PG8_LDA
#undef PG8_LDB
#undef PG8_MMA
#undef PG8_WAIT_V
#undef PG8_WAIT_L
#undef PG8_BAR
#undef PG8_SCHED
}
}

#define XB_TMO      128
#define XB_XCNT(j)  (256  + 64 * (j))
#define XB_XSUB(j)  (1280 + 64 * (j))
#define XB_XGEN(j)  (2304 + 64 * (j))
#define XB_TOP      3328
#define XB_TOPGEN   3392
#define XCD_BAR_WORDS 3456
#define XB_SPIN_CAP (1u << 18)
__device__ __forceinline__ unsigned xb_ld(unsigned* p)              { return __hip_atomic_load(p, __ATOMIC_RELAXED, __HIP_MEMORY_SCOPE_AGENT); }
__device__ __forceinline__ unsigned xb_add(unsigned* p, unsigned v) { return __hip_atomic_fetch_add(p, v, __ATOMIC_RELAXED, __HIP_MEMORY_SCOPE_AGENT); }
__device__ __forceinline__ unsigned xb_xcc_id() { return (unsigned)__builtin_amdgcn_s_getreg((3 << 11) | 20) & 0xFu; }
#define XB_SPIN(cond, bar) do { unsigned _sp = 0; while (cond) { __builtin_amdgcn_s_sleep(1); \
    if ((++_sp & 255u) == 0u) { if (xb_ld(&(bar)[XB_TMO])) break; if (_sp > XB_SPIN_CAP) { atomicAdd(&(bar)[XB_TMO], 1u); break; } } } } while (0)
struct XcdBarrier { unsigned* bar; unsigned x; volatile LAS unsigned* st; };
__device__ __forceinline__ XcdBarrier xcd_barrier_post(unsigned* bar, volatile LAS unsigned* st) {
    XcdBarrier b; b.bar = bar; b.x = xb_xcc_id(); b.st = st;
    if (threadIdx.x == 0) (void)xb_add(&bar[XB_XCNT(b.x)], 1u);
    return b;
}
__device__ __forceinline__ void xcd_barrier_complete(unsigned* bar, unsigned x, unsigned& nloc, unsigned& nx) {
    const unsigned G = gridDim.x * gridDim.y * gridDim.z;
    unsigned sum, cnt, mine, sp = 0u;
    for (;;) {
        sum = 0u; cnt = 0u; mine = 0u;
#pragma nounroll
        for (unsigned j = 0; j < 16; ++j) { const unsigned c = xb_ld(&bar[XB_XCNT(j)]); sum += c; cnt += (c > 0u) ? 1u : 0u; mine = (j == x) ? c : mine; }
        if (sum == G) break;
        __builtin_amdgcn_s_sleep(1);
        if ((++sp & 255u) == 0u) { if (xb_ld(&bar[XB_TMO])) break; if (sp > XB_SPIN_CAP) { atomicAdd(&bar[XB_TMO], 1u); break; } }
    }
    nloc = mine > 0u ? mine : 1u; nx = cnt > 0u ? cnt : 1u;
}
__device__ __forceinline__ void xcd_barrier(const XcdBarrier& b) {
    asm volatile("s_waitcnt vmcnt(0)" ::: "memory");
    __syncthreads();
    if (threadIdx.x == 0) {
        unsigned* bar = b.bar;
        __builtin_amdgcn_s_waitcnt(0);
        unsigned nloc = b.st[0], nx = b.st[1];
        if (nloc == 0u) { xcd_barrier_complete(bar, b.x, nloc, nx); b.st[0] = nloc; b.st[1] = nx; }
        const unsigned old = xb_add(&bar[XB_XSUB(b.x)], 1u);
        const unsigned gen = old / nloc;
        if (old + 1u == (gen + 1u) * nloc) {
            __builtin_amdgcn_fence(__ATOMIC_RELEASE, "agent");
            asm volatile("s_waitcnt vmcnt(0)" ::: "memory");
            const unsigned og = xb_add(&bar[XB_TOP], 1u);
            const unsigned tg = og / nx;
            if (og + 1u == (tg + 1u) * nx) xb_add(&bar[XB_TOPGEN], 1u);
            else XB_SPIN(xb_ld(&bar[XB_TOPGEN]) == tg, bar);
            __builtin_amdgcn_fence(__ATOMIC_ACQUIRE, "agent");
            xb_add(&bar[XB_XGEN(b.x)], 1u);
            asm volatile("s_waitcnt vmcnt(0)" ::: "memory");
        } else {
            XB_SPIN(xb_ld(&bar[XB_XGEN(b.x)]) == gen, bar);
            __builtin_amdgcn_fence(__ATOMIC_ACQUIRE, "agent");
            asm volatile("s_waitcnt vmcnt(0)" ::: "memory");
        }
    }
    __syncthreads();
}

__device__ __forceinline__ const void* kin(int k) {
    typedef __attribute__((address_space(4))) const char* kptr_t;
    kptr_t p = (kptr_t)__builtin_amdgcn_kernarg_segment_ptr(); asm volatile("" : "+s"(p));
    const unsigned long long v = *(__attribute__((address_space(4))) const unsigned long long*)(p + 8 * k);
    return (const void*)(GAS const void*)v;
}
struct Frame {
    LAS unsigned char* lds;
    int tid, lane, wave, vcu, G;
    unsigned char* ws; float* out;
#define FIN(name, T, k) __device__ __forceinline__ const T* name() const { return (const T*)kin(k); }
    FIN(x, float, 0) FIN(pos, int, 1) FIN(g_mix, float, 2) FIN(w_in, float, 3) FIN(a_re, float, 4) FIN(a_im, float, 5) FIN(log_dt, float, 6) FIN(b_re, float, 7) FIN(b_im, float, 8)
    FIN(c_re, float, 9) FIN(c_im, float, 10) FIN(s5_d, float, 11) FIN(w_glu, float, 12) FIN(gla_wg, float, 13) FIN(gla_bg, float, 14) FIN(pool_w, float, 15) FIN(pool_scale, float, 16)
    FIN(w_branch, float, 17) FIN(w_out, float, 18) FIN(g_ffn, float, 19) FIN(w_up, float, 20) FIN(conv_w, float, 21) FIN(conv_b, float, 22) FIN(w_down, float, 23) FIN(g_final, float, 24)
#undef FIN
#define FWS(name, T, off) __device__ __forceinline__ T* name() const { return (T*)(ws + (off)); }
    FWS(rotc, float, WS_ROT) FWS(rots, float, WS_ROT + (size_t)M * 32 * 4) FWS(abar, float, WS_S5T + S5T_ABAR) FWS(apow, float, WS_S5T + S5T_APOW) FWS(bbar, float, WS_S5T + S5T_BBAR) FWS(cmt, bf16_t, WS_S5T + S5T_CMT) FWS(bbt, bf16_t, WS_S5T + S5T_BBT)
    FWS(wglu_t, bf16_t, WS_WGLU) FWS(poolw_t, bf16_t, WS_POOLW) FWS(win_t, bf16_t, WS_WIN) FWS(wbr_t, bf16_t, WS_WBR) FWS(wout_t, bf16_t, WS_WOUT) FWS(wup_t, bf16_t, WS_WUP) FWS(wdn_t, bf16_t, WS_WDN)
    FWS(HN, bf16_t, WS_HN) FWS(Y, bf16_t, WS_Y) FWS(YBP, bf16_t, WS_YBP) FWS(PROJ, bf16_t, WS_PROJ) FWS(SPREV, bf16_t, WS_SPREV) FWS(ACT, bf16_t, WS_ACT)
    FWS(STATE, float, WS_STATE) FWS(DEC, float, WS_DEC) FWS(XEND, float, WS_XEND) FWS(UH, float, WS_UH)
#undef FWS
};

__device__ __forceinline__ float lane_read(float v, int src_lane) { return __builtin_bit_cast(float, __builtin_amdgcn_ds_bpermute(src_lane << 2, __builtin_bit_cast(int, v))); }
__device__ __forceinline__ float wave_sum(float v, int lane) {
#pragma unroll
    for (int o = 1; o < 64; o <<= 1) v += lane_read(v, lane ^ o);
    return v;
}

template <class SrcCol>
__device__ __forceinline__ void transpose_item(const float* W, int Nsrc, bf16_t* WT, int ldt, int kdst0, int k0, int n0, SrcCol srccol, LAS float* scr, int lane) {
    const int sc = srccol(n0 + (lane & 31));
#pragma unroll 8
    for (int i = 0; i < 32; ++i) { const int kk = 2 * i + (lane >> 5); scr[kk * 33 + (lane & 31)] = sc >= 0 ? W[(size_t)(k0 + kk) * Nsrc + sc] : 0.f; }
    LDS_WAIT();
    const int c = lane & 7;
#pragma unroll
    for (int j = 0; j < 4; ++j) { const int n = (lane >> 3) + 8 * j; const LAS float* s = scr + (8 * c) * 33 + n;
        u32x4 o; o.x = pk2(s[0 * 33], s[1 * 33]); o.y = pk2(s[2 * 33], s[3 * 33]); o.z = pk2(s[4 * 33], s[5 * 33]); o.w = pk2(s[6 * 33], s[7 * 33]);
        *(u32x4*)(WT + (size_t)(n0 + n) * ldt + kdst0 + k0 + 8 * c) = o; }
    LDS_WAIT();
}
struct ColIdent { __device__ __forceinline__ int operator()(int n) const { return n; } };
struct ColWin { __device__ __forceinline__ int operator()(int n) const {
    if (n < 3584) return n; if (n < 4096) return n + 16; if (n < 4112) return n - 512; if (n < 4352) return -1;
    const int t = (n - 4352) >> 8, cl = (n - 4352) & 255; const int br = 2 * (cl >> 7) + ((cl >> 2) & 1), ch = 16 * ((cl >> 5) & 3) + 4 * ((cl >> 3) & 3) + (cl & 3);
    return 4112 + br * 2048 + 64 * t + ch; } };
struct ColWup { __device__ __forceinline__ int operator()(int n) const { const int blk = n >> 8, r = n & 255; return (r < 128) ? (blk * 128 + r) : (DFF + blk * 128 + (r - 128)); } };

__device__ __forceinline__ void rms_row_to_bf16(const float* xrow, const float* g, bf16_t* orow, int lane) {
    const f32x4* xr = (const f32x4*)xrow + lane; const f32x4* gr = (const f32x4*)g + lane;
    f32x4 v[8]; float s = 0.f;
#pragma unroll
    for (int j = 0; j < 8; ++j) { v[j] = xr[64 * j]; s += (v[j].x * v[j].x + v[j].y * v[j].y) + (v[j].z * v[j].z + v[j].w * v[j].w); }
    const float r = 1.0f / sqrtf(wave_sum(s, lane) * (1.f / D) + EPS);
    u32x2* o8 = (u32x2*)orow + lane;
#pragma unroll
    for (int j = 0; j < 8; ++j) { const f32x4 gg = gr[64 * j]; u32x2 w; w.x = pk2(v[j].x * r * gg.x, v[j].y * r * gg.y); w.y = pk2(v[j].z * r * gg.z, v[j].w * r * gg.w); o8[64 * j] = w; }
}
__device__ __forceinline__ void rms_rows(Frame& F, const float* src, const float* g, bf16_t* dst) {
    const int gw = F.vcu * NWAVES + F.wave, NGW = F.G * NWAVES;
    for (int m = gw; m < M; m += NGW) rms_row_to_bf16(src + (size_t)m * D, g, dst + (size_t)m * D, F.lane);
}
__device__ __forceinline__ void rms_rows_f32_inplace(Frame& F, float* buf, const float* g) {
    const int gw = F.vcu * NWAVES + F.wave, NGW = F.G * NWAVES;
    for (int m = gw; m < M; m += NGW) {
        f32x4* xr = (f32x4*)(buf + (size_t)m * D) + F.lane; const f32x4* gr = (const f32x4*)g + F.lane;
        f32x4 v[8]; float s = 0.f;
#pragma unroll
        for (int j = 0; j < 8; ++j) { v[j] = xr[64 * j]; s += (v[j].x * v[j].x + v[j].y * v[j].y) + (v[j].z * v[j].z + v[j].w * v[j].w); }
        const float r = 1.0f / sqrtf(wave_sum(s, F.lane) * (1.f / D) + EPS);
#pragma unroll
        for (int j = 0; j < 8; ++j) { const f32x4 gg = gr[64 * j]; xr[64 * j] = (f32x4){v[j].x * r * gg.x, v[j].y * r * gg.y, v[j].z * r * gg.z, v[j].w * r * gg.w}; }
    }
}

__device__ __forceinline__ void phase_prep(Frame& F, int l) {
    LAS float* scr = (LAS float*)(F.lds + F.wave * 16384);
    const int gw = F.vcu * NWAVES + F.wave, NGW = F.G * NWAVES;
    constexpr int I_IN = (D / 64) * (NIN / 32), I_UP = (D / 64) * (NUP / 32), I_DN = (DFF / 64) * (D / 32), I_BR = 4 * (BW / 64) * (D / 32), I_OUT = (D / 64) * (D / 32), I_GLU = (BW / 64) * (BW / 32), I_PL = 4 * (128 / 64) * (128 / 32);
    constexpr int NITEMS = I_IN + I_UP + I_DN + I_BR + I_OUT + I_GLU + I_PL;
    for (int it = gw; it < NITEMS; it += NGW) {
        int r = it;
        if (r < I_IN) { const int nb = NIN / 32; transpose_item(F.w_in() + (size_t)l * D * NIN_SRC, NIN_SRC, F.win_t(), D, 0, 64 * (r / nb), 32 * (r % nb), ColWin(), scr, F.lane); continue; } r -= I_IN;
        if (r < I_UP) { const int nb = NUP / 32; transpose_item(F.w_up() + (size_t)l * D * NUP, NUP, F.wup_t(), D, 0, 64 * (r / nb), 32 * (r % nb), ColWup(), scr, F.lane); continue; } r -= I_UP;
        if (r < I_DN) { const int nb = D / 32; transpose_item(F.w_down() + (size_t)l * DFF * D, D, F.wdn_t(), DFF, 0, 64 * (r / nb), 32 * (r % nb), ColIdent(), scr, F.lane); continue; } r -= I_DN;
        if (r < I_BR) { const int per = (BW / 64) * (D / 32), br = r / per, q = r % per, nb = D / 32;
            transpose_item(F.w_branch() + ((size_t)l * 4 + br) * BW * D, D, F.wbr_t(), D, br * BW, 64 * (q / nb), 32 * (q % nb), ColIdent(), scr, F.lane); continue; } r -= I_BR;
        if (r < I_OUT) { const int nb = D / 32; transpose_item(F.w_out() + (size_t)l * D * D, D, F.wout_t(), D, 0, 64 * (r / nb), 32 * (r % nb), ColIdent(), scr, F.lane); continue; } r -= I_OUT;
        if (r < I_GLU) { const int nb = BW / 32; transpose_item(F.w_glu() + (size_t)l * BW * BW, BW, F.wglu_t(), BW, 0, 64 * (r / nb), 32 * (r % nb), ColIdent(), scr, F.lane); continue; } r -= I_GLU;
        { const int grp = r / 8, q = r % 8; transpose_item(F.pool_w() + ((size_t)l * 4 + grp) * 128 * 128, 128, F.poolw_t() + (size_t)grp * 128 * 128, 128, 0, 64 * (q / 4), 32 * (q % 4), ColIdent(), scr, F.lane); }
    }
    const int gt = F.vcu * (NWAVES * 64) + F.tid, NGT = F.G * NWAVES * 64;
    for (int i = gt; i < 32 * 64; i += NGT) {
        const int g = i >> 6;
        const float are = F.a_re()[(size_t)l * 2048 + i], aim = F.a_im()[(size_t)l * 2048 + i], dt = expf(F.log_dt()[l * 32 + g]);
        const float mag = expf(are * dt), th = aim * dt;
        const float abr = mag * cosf(th), abi = mag * sinf(th);
        const float den = are * are + aim * aim, nr = abr - 1.0f, ni = abi;
        const float fre = (nr * are + ni * aim) / den, fim = (ni * are - nr * aim) / den;
        F.abar()[2 * i] = abr; F.abar()[2 * i + 1] = abi;
        float pr = abr, pi = abi;
#pragma unroll
        for (int q = 0; q < 6; ++q) { const float tr = pr * pr - pi * pi, ti = 2.f * pr * pi; pr = tr; pi = ti; }
        F.apow()[2 * i] = pr; F.apow()[2 * i + 1] = pi;
        const float* br = F.b_re() + ((size_t)l * 2048 + i) * 16; const float* bi = F.b_im() + ((size_t)l * 2048 + i) * 16;
#pragma unroll
        for (int c = 0; c < 16; ++c) { const float x = br[c], y = bi[c]; const float vr = fre * x - fim * y, vi = fre * y + fim * x; const int p = i & 63;
            F.bbt()[((size_t)g * 128 + p) * 16 + c] = (bf16_t)f2bf(vr); F.bbt()[((size_t)g * 128 + 64 + p) * 16 + c] = (bf16_t)f2bf(vi); }
    }
    for (int i = gt; i < 32 * 16 * 128; i += NGT) {
        const int k = i & 127, gc = i >> 7;
        const float v = (k < 64) ? F.c_re()[((size_t)l * 512 + gc) * 64 + k] : -F.c_im()[((size_t)l * 512 + gc) * 64 + (k - 64)];
        F.cmt()[i] = (bf16_t)f2bf(v);
    }
    if (l == 0) {
        for (int i = gt; i < M * 32; i += NGT) {
            const int row = i >> 5, j = i & 31;
            const float inv = exp2f(-(float)j * (13.287712379549449f / 32.0f));
            const float ang = (float)F.pos()[row] * inv;
            F.rotc()[i] = cosf(ang); F.rots()[i] = sinf(ang);
        }
    }
    rms_rows(F, l == 0 ? F.x() : F.out, F.g_mix() + (size_t)l * D, F.HN());
}

__device__ __forceinline__ f32x4 mma_nt_lds(const LAS bf16_t* X, int px, const LAS bf16_t* Y, int py, int ksteps, f32x4 acc, int lane) {
    const LAS bf16_t* xp = X + (lane & 15) * px + 8 * (lane >> 4);
    const LAS bf16_t* yp = Y + (lane & 15) * py + 8 * (lane >> 4);
    for (int ks = 0; ks < ksteps; ++ks) {
        const bf16x8 a = *(const LAS bf16x8*)(xp + 32 * ks), b = *(const LAS bf16x8*)(yp + 32 * ks);
        acc = __builtin_amdgcn_mfma_f32_16x16x32_bf16(a, b, acc, 0, 0, 0);
    }
    return acc;
}

constexpr int LN_TOT = 16384, LN_QD = 18432, LN_KI = 27648, LN_PM = 36864, LN_VT = 46080, LN_OB = 64512, LN_WG = 98304, LN_END = 98304 + 4096 + 256;
constexpr int LP = 72;
struct LinRaw { u32x4 q0, q1, k0, k1, v0, v1, g0, g1, gr0, gr1; f32x4 c0, c1, s0, s1; bf16x8 sp0, sp1; };
template <bool OUT>
__device__ __forceinline__ void lin_issue(Frame& F, int unit, LinRaw& R) {
    const int n = unit & 63, h = (unit >> 6) & 3, b = (unit >> 8) & 7, mixer = unit >> 11;
    const size_t row0 = (size_t)b * SEQ + (size_t)n * CH; const int s = F.tid >> 3, c = F.tid & 7;
    const int cq = (mixer == 0 ? C_RQ : C_GQ) + h * 64, ck = (mixer == 0 ? C_RK : C_GK) + h * 64, cv = (mixer == 0 ? C_RV : C_GV) + h * 128, cg = (mixer == 0 ? C_RG : C_GG) + h * 128;
    const bf16_t* pr = F.PROJ() + (row0 + s) * NIN;
    R.k0 = *(const u32x4*)(pr + ck + 8 * c); R.k1 = *(const u32x4*)(pr + ck + 8 * (c ^ 4));
    if (OUT) { R.q0 = *(const u32x4*)(pr + cq + 8 * c); R.q1 = *(const u32x4*)(pr + cq + 8 * (c ^ 4)); }
    { const float* cp = F.rotc() + (row0 + s) * 32 + (c & 3) * 8; const float* sp = F.rots() + (row0 + s) * 32 + (c & 3) * 8;
      R.c0 = *(const f32x4*)cp; R.c1 = *(const f32x4*)(cp + 4); R.s0 = *(const f32x4*)sp; R.s1 = *(const f32x4*)(sp + 4); }
    R.gr0 = *(const u32x4*)(pr + C_GR); R.gr1 = *(const u32x4*)(pr + C_GR + 8);
    R.v0 = *(const u32x4*)(F.PROJ() + (row0 + (F.tid >> 4)) * NIN + cv + (F.tid & 15) * 8);
    R.v1 = *(const u32x4*)(F.PROJ() + (row0 + 32 + (F.tid >> 4)) * NIN + cv + (F.tid & 15) * 8);
    if (OUT) { R.g0 = *(const u32x4*)(pr + cg + 16 * c); R.g1 = *(const u32x4*)(pr + cg + 16 * c + 8);
        const bf16_t* sq = F.SPREV() + (size_t)unit * 8192 + (size_t)(16 * F.wave + (F.lane & 15)) * 64 + 8 * (F.lane >> 4);
        R.sp0 = *(const bf16x8*)sq; R.sp1 = *(const bf16x8*)(sq + 32); }
}
__device__ __forceinline__ void lin_rot(const u32x4 own_, const u32x4 oth_, const LinRaw& R, bool rot, bool hi, float scale, float (&v)[8]) {
    float own[8]; unpack8(own_, own);
    if (!rot) {
#pragma unroll
        for (int j = 0; j < 8; ++j) v[j] = own[j] * scale;
        return; }
    float oth[8]; unpack8(oth_, oth);
    const float cs[8] = {R.c0.x, R.c0.y, R.c0.z, R.c0.w, R.c1.x, R.c1.y, R.c1.z, R.c1.w}, sn[8] = {R.s0.x, R.s0.y, R.s0.z, R.s0.w, R.s1.x, R.s1.y, R.s1.z, R.s1.w};
#pragma unroll
    for (int j = 0; j < 8; ++j) { const float os = oth[j] * sn[j]; v[j] = (own[j] * cs[j] + (hi ? os : -os)) * scale; }
}
__device__ __forceinline__ void lin_decay(Frame& F, int mixer, int h, const LinRaw& R, float (&bcum)[8], float (&blast)[8]) {
    LAS float* TOT = (LAS float*)(F.lds + LN_TOT);
    const int s = F.tid >> 3, c = F.tid & 7, d0 = 8 * c;
    if (mixer == 0) {
        const float lg = __logf(1.0f - exp2f(-5.0f - (float)h));
#pragma unroll
        for (int j = 0; j < 8; ++j) { bcum[j] = (float)(s + 1) * lg; blast[j] = 64.0f * lg; }
        __syncthreads();
        return;
    }
    const LAS float* WG = (const LAS float*)(F.lds + LN_WG);
    float grf[16]; { float a[8], b2[8]; unpack8(R.gr0, a); unpack8(R.gr1, b2);
#pragma unroll
        for (int j = 0; j < 8; ++j) { grf[j] = a[j]; grf[8 + j] = b2[j]; } }
    float x[8]; { const f32x4 b0 = *(const LAS f32x4*)(WG + 1024 + d0), b1 = *(const LAS f32x4*)(WG + 1024 + d0 + 4); x[0] = b0.x; x[1] = b0.y; x[2] = b0.z; x[3] = b0.w; x[4] = b1.x; x[5] = b1.y; x[6] = b1.z; x[7] = b1.w; }
#pragma unroll
    for (int r = 0; r < 16; ++r) { const f32x4 w0 = *(const LAS f32x4*)(WG + r * 64 + d0), w1 = *(const LAS f32x4*)(WG + r * 64 + d0 + 4);
        x[0] += grf[r] * w0.x; x[1] += grf[r] * w0.y; x[2] += grf[r] * w0.z; x[3] += grf[r] * w0.w; x[4] += grf[r] * w1.x; x[5] += grf[r] * w1.y; x[6] += grf[r] * w1.z; x[7] += grf[r] * w1.w; }
#pragma unroll
    for (int j = 0; j < 8; ++j) x[j] = logsigmoidf_(x[j]) * (1.0f / 16.0f);
#pragma unroll
    for (int st = 8; st <= 32; st <<= 1) {
#pragma unroll
        for (int j = 0; j < 8; ++j) { const float t = lane_read(x[j], F.lane - st); if (F.lane >= st) x[j] += t; } }
    if ((F.lane >> 3) == 7) { *(LAS f32x4*)(TOT + F.wave * 64 + d0) = (f32x4){x[0], x[1], x[2], x[3]}; *(LAS f32x4*)(TOT + F.wave * 64 + d0 + 4) = (f32x4){x[4], x[5], x[6], x[7]}; }
    __syncthreads();
    float off[8], tot[8];
#pragma unroll
    for (int j = 0; j < 8; ++j) { off[j] = 0.f; tot[j] = 0.f; }
#pragma unroll
    for (int w = 0; w < 8; ++w) { const f32x4 t0 = *(const LAS f32x4*)(TOT + w * 64 + d0), t1 = *(const LAS f32x4*)(TOT + w * 64 + d0 + 4); const float tv[8] = {t0.x, t0.y, t0.z, t0.w, t1.x, t1.y, t1.z, t1.w};
#pragma unroll
        for (int j = 0; j < 8; ++j) { tot[j] += tv[j]; off[j] += (w < F.wave) ? tv[j] : 0.f; } }
#pragma unroll
    for (int j = 0; j < 8; ++j) { bcum[j] = x[j] + off[j]; blast[j] = tot[j]; }
}
__device__ __forceinline__ void lin_store_vt(Frame& F, const LinRaw& R) {
    LAS bf16_t* VT = (LAS bf16_t*)(F.lds + LN_VT); const int e0 = (F.tid & 15) * 8;
#pragma unroll
    for (int i = 0; i < 2; ++i) { const int s = 32 * i + (F.tid >> 4); const u32x4 w = i == 0 ? R.v0 : R.v1;
        VT[(e0 + 0) * LP + s] = (bf16_t)(w.x & 0xffffu); VT[(e0 + 1) * LP + s] = (bf16_t)(w.x >> 16); VT[(e0 + 2) * LP + s] = (bf16_t)(w.y & 0xffffu); VT[(e0 + 3) * LP + s] = (bf16_t)(w.y >> 16);
        VT[(e0 + 4) * LP + s] = (bf16_t)(w.z & 0xffffu); VT[(e0 + 5) * LP + s] = (bf16_t)(w.z >> 16); VT[(e0 + 6) * LP + s] = (bf16_t)(w.w & 0xffffu); VT[(e0 + 7) * LP + s] = (bf16_t)(w.w >> 16); }
}
__device__ __forceinline__ void lin_state_compute(Frame& F, int unit, const LinRaw& R) {
    const int h = (unit >> 6) & 3, mixer = unit >> 11; const int s = F.tid >> 3, c = F.tid & 7, d0 = 8 * c;
    LAS bf16_t* KDT = (LAS bf16_t*)(F.lds + LN_KI); LAS bf16_t* VT = (LAS bf16_t*)(F.lds + LN_VT);
    float k[8], bcum[8], blast[8];
    lin_rot(R.k0, R.k1, R, mixer == 0, c >= 4, mixer == 0 ? 0.125f : 1.0f, k);
    lin_decay(F, mixer, h, R, bcum, blast);
#pragma unroll
    for (int j = 0; j < 8; ++j) KDT[(d0 + j) * LP + s] = (bf16_t)f2bf(k[j] * __expf(blast[j] - bcum[j]));
    lin_store_vt(F, R);
    if (s == 0) { float* dc = F.DEC() + (size_t)unit * 64 + d0;
        *(f32x4*)dc = (f32x4){__expf(blast[0]), __expf(blast[1]), __expf(blast[2]), __expf(blast[3])}; *(f32x4*)(dc + 4) = (f32x4){__expf(blast[4]), __expf(blast[5]), __expf(blast[6]), __expf(blast[7])}; }
    __syncthreads();
    { const int w = F.wave, lane = F.lane; float* st = F.STATE() + (size_t)unit * 8192;
#pragma unroll
      for (int dt = 0; dt < 4; ++dt) { f32x4 acc = (f32x4){0.f, 0.f, 0.f, 0.f}; acc = mma_nt_lds(VT + 16 * w * LP, LP, KDT + 16 * dt * LP, LP, 2, acc, lane);
#pragma unroll
          for (int i = 0; i < 4; ++i) st[(16 * w + 4 * (lane >> 4) + i) * 64 + 16 * dt + (lane & 15)] = acc[i]; } }
}
__device__ __forceinline__ void lin_out_compute(Frame& F, int unit, const LinRaw& R) {
    const int n = unit & 63, h = (unit >> 6) & 3, b = (unit >> 8) & 7, mixer = unit >> 11;
    const size_t row0 = (size_t)b * SEQ + (size_t)n * CH; const int s = F.tid >> 3, c = F.tid & 7, d0 = 8 * c;
    const int ycol = (mixer == 0 ? 0 : 1024) + h * 128;
    LAS bf16_t* QD = (LAS bf16_t*)(F.lds + LN_QD); LAS bf16_t* KI = (LAS bf16_t*)(F.lds + LN_KI); LAS bf16_t* PM = (LAS bf16_t*)(F.lds + LN_PM);
    LAS bf16_t* VT = (LAS bf16_t*)(F.lds + LN_VT); LAS float* OB = (LAS float*)(F.lds + LN_OB);
    float q[8], k[8], bcum[8], blast[8];
    lin_rot(R.q0, R.q1, R, mixer == 0, c >= 4, mixer == 0 ? 1.0f : 0.125f, q);
    lin_rot(R.k0, R.k1, R, mixer == 0, c >= 4, mixer == 0 ? 0.125f : 1.0f, k);
    lin_decay(F, mixer, h, R, bcum, blast);
    { float qd[8], ki[8];
#pragma unroll
      for (int j = 0; j < 8; ++j) { qd[j] = q[j] * __expf(bcum[j]); ki[j] = k[j] * __expf(-bcum[j]); }
      *(LAS u32x4*)(QD + s * LP + d0) = pack8(qd); *(LAS u32x4*)(KI + s * LP + d0) = pack8(ki); }
    lin_store_vt(F, R);
    __syncthreads();
    { const int lane = F.lane;
#pragma unroll
      for (int j = 0; j < 2; ++j) { const int tile = 2 * F.wave + j, tt = tile >> 2, st = tile & 3;
          f32x4 acc = (f32x4){0.f, 0.f, 0.f, 0.f};
          if (st <= tt) acc = mma_nt_lds(QD + 16 * tt * LP, LP, KI + 16 * st * LP, LP, 2, acc, lane);
#pragma unroll
          for (int i = 0; i < 4; ++i) { const int t = 16 * tt + 4 * (lane >> 4) + i, s2 = 16 * st + (lane & 15); const float p = (st <= tt && s2 <= t) ? acc[i] : 0.f; PM[t * LP + s2] = (bf16_t)f2bf(p); } } }
    __syncthreads();
    { const int w = F.wave, lane = F.lane;
#pragma unroll
      for (int tt = 0; tt < 4; ++tt) { f32x4 acc = (f32x4){0.f, 0.f, 0.f, 0.f};
          acc = mma_nt_lds(PM + 16 * tt * LP, LP, VT + 16 * w * LP, LP, 2, acc, lane);
          const LAS bf16_t* xp = QD + (16 * tt + (lane & 15)) * LP + 8 * (lane >> 4);
          acc = __builtin_amdgcn_mfma_f32_16x16x32_bf16(*(const LAS bf16x8*)xp, R.sp0, acc, 0, 0, 0);
          acc = __builtin_amdgcn_mfma_f32_16x16x32_bf16(*(const LAS bf16x8*)(xp + 32), R.sp1, acc, 0, 0, 0);
#pragma unroll
          for (int i = 0; i < 4; ++i) OB[(16 * tt + 4 * (lane >> 4) + i) * 132 + 16 * w + (lane & 15)] = acc[i]; } }
    __syncthreads();
    { const int t = s, part = c; float o[16];
#pragma unroll
      for (int j = 0; j < 4; ++j) { const f32x4 v = *(const LAS f32x4*)(OB + t * 132 + 16 * part + 4 * j); o[4 * j] = v.x; o[4 * j + 1] = v.y; o[4 * j + 2] = v.z; o[4 * j + 3] = v.w; }
      float sm = 0.f;
#pragma unroll
      for (int j = 0; j < 16; ++j) sm += o[j];
      sm += lane_read(sm, F.lane ^ 1); sm += lane_read(sm, F.lane ^ 2); sm += lane_read(sm, F.lane ^ 4);
      const float mu = sm * (1.0f / 128.0f); float qv = 0.f;
#pragma unroll
      for (int j = 0; j < 16; ++j) { const float dlt = o[j] - mu; qv += dlt * dlt; }
      qv += lane_read(qv, F.lane ^ 1); qv += lane_read(qv, F.lane ^ 2); qv += lane_read(qv, F.lane ^ 4);
      const float r = 1.0f / sqrtf(qv * (1.0f / 128.0f) + EPS);
      float g0[8], g1[8]; unpack8(R.g0, g0); unpack8(R.g1, g1);
      float y0[8], y1[8];
#pragma unroll
      for (int j = 0; j < 8; ++j) { y0[j] = (o[j] - mu) * r * siluf_(g0[j]); y1[j] = (o[8 + j] - mu) * r * siluf_(g1[j]); }
      bf16_t* yp = F.Y() + (row0 + t) * D + ycol + 16 * part; *(u32x4*)yp = pack8(y0); *(u32x4*)(yp + 8) = pack8(y1); }
}
template <bool OUT>
__device__ __forceinline__ void lin_phase(Frame& F, int l) {
    { const int h = (F.vcu >> 6) & 3; LAS float* WG = (LAS float*)(F.lds + LN_WG);
      for (int i = F.tid; i < 16 * 64 + 64; i += NWAVES * 64) WG[i] = (i < 1024) ? F.gla_wg()[(size_t)l * 16 * 256 + (i >> 6) * 256 + h * 64 + (i & 63)] : F.gla_bg()[l * 256 + h * 64 + (i - 1024)];
      __syncthreads(); }
    LinRaw A, B;
    lin_issue<OUT>(F, F.vcu, A);
    for (int u = F.vcu; u < 4096; u += 2 * F.G) {
        lin_issue<OUT>(F, u + F.G, B);
        if (OUT) lin_out_compute(F, u, A); else lin_state_compute(F, u, A);
        if (u + 2 * F.G < 4096) lin_issue<OUT>(F, u + 2 * F.G, A);
        if (OUT) lin_out_compute(F, u + F.G, B); else lin_state_compute(F, u + F.G, B);
    }
    __syncthreads();
}
__device__ __forceinline__ void lin_scan(Frame& F) {
    const int gt = F.vcu * (NWAVES * 64) + F.tid, NGT = F.G * NWAVES * 64;
    for (int i = gt; i < 64 * 8192; i += NGT) {
        const int seq = i >> 13, idx = i & 8191, d = idx & 63;
        const float* st = F.STATE() + (size_t)seq * NCH * 8192 + idx; const float* dc = F.DEC() + (size_t)seq * NCH * 64 + d; bf16_t* sp = F.SPREV() + (size_t)seq * NCH * 8192 + idx;
        float carry = 0.f; asm volatile("" : "+v"(carry));
#pragma unroll
        for (int h = 0; h < 2; ++h) {
            float v[32], c[32];
#pragma unroll
            for (int n = 0; n < 32; ++n) { v[n] = st[(size_t)(32 * h + n) * 8192]; c[n] = dc[(size_t)(32 * h + n) * 64]; }
#pragma unroll
            for (int n = 0; n < 32; ++n) { sp[(size_t)(32 * h + n) * 8192] = (bf16_t)f2bf(carry); carry = c[n] * carry + v[n]; asm volatile("" : "+v"(carry)); }
        }
    }
}
constexpr int S5_WL = 16384, S5_BU = 2048, S5_X = 2048 + 8320;
template <bool OUT>
__device__ __forceinline__ void s5_pass(Frame& F, int l) {
    LAS bf16_t* UT = (LAS bf16_t*)(F.lds + F.wave * S5_WL); LAS float* BU = (LAS float*)(F.lds + F.wave * S5_WL + S5_BU); LAS bf16_t* X = (LAS bf16_t*)(F.lds + F.wave * S5_WL + S5_X);
    const int gw = F.vcu * NWAVES + F.wave, NGW = F.G * NWAVES, lane = F.lane, lr = lane & 15, lq = lane >> 4;
    for (int unit = gw; unit < BATCH * NCH * 32; unit += NGW) {
        const int g = unit & 31, n = (unit >> 5) & 63, b = unit >> 11; const size_t row0 = (size_t)b * SEQ + (size_t)n * CH;
        { const bf16_t* up = F.PROJ() + (row0 + lane) * NIN + C_SU + g * 16; const u32x4 a = *(const u32x4*)up, c = *(const u32x4*)(up + 8);
          *(LAS u32x4*)(UT + lane * 16) = a; *(LAS u32x4*)(UT + lane * 16 + 8) = c; }
        const int gp = g * 64 + lane; const float ar = F.abar()[2 * gp], ai = F.abar()[2 * gp + 1];
        bf16x8 bfr[8];
#pragma unroll
        for (int q = 0; q < 8; ++q) { bfr[q] = (bf16x8){0, 0, 0, 0, 0, 0, 0, 0}; if (lq < 2) bfr[q] = *(const bf16x8*)(F.bbt() + ((size_t)g * 128 + 16 * q + lr) * 16 + 8 * lq); }
        float xr = 0.f, xi = 0.f;
        bf16x8 cf[4]; float dsk = 0.f;
        if (OUT) { const f32x2 x0 = *(const f32x2*)(F.XEND() + ((((size_t)(b * 32 + g)) * NCH + n) * 64 + lane) * 2); xr = x0.x; xi = x0.y;
#pragma unroll
            for (int ks = 0; ks < 4; ++ks) cf[ks] = *(const bf16x8*)(F.cmt() + ((size_t)(g * 16 + lr)) * 128 + 32 * ks + 8 * lq);
            dsk = F.s5_d()[(size_t)l * BW + g * 16 + lr]; }
        LDS_WAIT();
        for (int sb = 0; sb < 4; ++sb) {
            bf16x8 af = (bf16x8){0, 0, 0, 0, 0, 0, 0, 0}; if (lq < 2) af = *(const LAS bf16x8*)(UT + (16 * sb + lr) * 16 + 8 * lq);
#pragma unroll
            for (int q = 0; q < 8; ++q) { f32x4 acc = (f32x4){0.f, 0.f, 0.f, 0.f}; acc = __builtin_amdgcn_mfma_f32_16x16x32_bf16(af, bfr[q], acc, 0, 0, 0);
#pragma unroll
                for (int i = 0; i < 4; ++i) BU[(4 * lq + i) * 130 + 16 * q + lr] = acc[i]; }
            LDS_WAIT();
            float br[16], bi[16];
#pragma unroll
            for (int tt = 0; tt < 16; ++tt) { br[tt] = BU[tt * 130 + lane]; bi[tt] = BU[tt * 130 + 64 + lane]; }
#pragma unroll
            for (int tt = 0; tt < 16; ++tt) { const float nr = ar * xr - ai * xi + br[tt], ni = ar * xi + ai * xr + bi[tt]; xr = nr; xi = ni; asm volatile("" : "+v"(xr), "+v"(xi));
                if (OUT) { X[tt * 136 + lane] = (bf16_t)f2bf(xr); X[tt * 136 + 64 + lane] = (bf16_t)f2bf(xi); } }
            if (OUT) {
                LDS_WAIT();
                f32x4 acc = (f32x4){0.f, 0.f, 0.f, 0.f}; const LAS bf16_t* xp = X + lr * 136 + 8 * lq;
#pragma unroll
                for (int ks = 0; ks < 4; ++ks) acc = __builtin_amdgcn_mfma_f32_16x16x32_bf16(*(const LAS bf16x8*)(xp + 32 * ks), cf[ks], acc, 0, 0, 0);
#pragma unroll
                for (int i = 0; i < 4; ++i) { const int tl = 16 * sb + 4 * lq + i; const float u = bflo((unsigned)UT[tl * 16 + lr]); const float y = gelu_tanh(acc[i] + dsk * u);
                    F.YBP()[(row0 + tl) * BW + g * 16 + lr] = (bf16_t)f2bf(y); }
            }
            LDS_WAIT();
        }
        if (!OUT) *(f32x2*)(F.XEND() + ((((size_t)(b * 32 + g)) * NCH + n) * 64 + lane) * 2) = (f32x2){xr, xi};
    }
}
__device__ __forceinline__ void s5_scan(Frame& F) {
    const int gt = F.vcu * (NWAVES * 64) + F.tid, NGT = F.G * NWAVES * 64;
    for (int i = gt; i < BATCH * 32 * 64; i += NGT) {
        const int p = i & 63, bg = i >> 6, g = bg & 31; const float pr = F.apow()[2 * (g * 64 + p)], pi = F.apow()[2 * (g * 64 + p) + 1];
        f32x2* xp = (f32x2*)(F.XEND() + (((size_t)bg * NCH) * 64 + p) * 2);
        float cr = 0.f, ci = 0.f; asm volatile("" : "+v"(cr), "+v"(ci));
#pragma unroll
        for (int h = 0; h < 2; ++h) {
            f32x2 v[32];
#pragma unroll
            for (int n = 0; n < 32; ++n) v[n] = xp[(size_t)(32 * h + n) * 64];
#pragma unroll
            for (int n = 0; n < 32; ++n) { xp[(size_t)(32 * h + n) * 64] = (f32x2){cr, ci};
                const float nr = pr * cr - pi * ci + v[n].x, ni = pr * ci + pi * cr + v[n].y; cr = nr; ci = ni; asm volatile("" : "+v"(cr), "+v"(ci)); }
        }
    }
}

__device__ __forceinline__ void pool_phase(Frame& F, int l) {
    const int gw = F.vcu * NWAVES + F.wave, NGW = F.G * NWAVES, lane = F.lane, lr = lane & 15, lq = lane >> 4;
    for (int unit = gw; unit < BATCH * (SEQ / 16) * 4; unit += NGW) {
        const int g = unit & 3, tile = (unit >> 2) & 255, b = unit >> 10; const int win = 2 << g, tpos = 16 * tile + lr; const size_t row = (size_t)b * SEQ + tpos;
        const bf16_t* pp = F.PROJ() + row * NIN + C_PU + g * 128 + 8 * lq;
        float s[4][8];
#pragma unroll
        for (int ks = 0; ks < 4; ++ks)
#pragma unroll
            for (int j = 0; j < 8; ++j) s[ks][j] = 0.f;
        for (int jj = 1; jj < win; ++jj) { if (tpos - jj >= 0) {
#pragma unroll
            for (int ks = 0; ks < 4; ++ks) { float a[8]; unpack8(*(const u32x4*)(pp - (size_t)jj * NIN + 32 * ks), a);
#pragma unroll
                for (int j = 0; j < 8; ++j) s[ks][j] += a[j]; } } }
        const float inv = 1.0f / (float)min(tpos + 1, win);
        bf16x8 mf[4];
#pragma unroll
        for (int ks = 0; ks < 4; ++ks) { float a[8], m[8]; unpack8(*(const u32x4*)(pp + 32 * ks), a);
#pragma unroll
            for (int j = 0; j < 8; ++j) m[j] = (s[ks][j] + a[j]) * inv - a[j];
            const u32x4 w = pack8(m); mf[ks] = __builtin_bit_cast(bf16x8, w); }
        const bf16_t* pw = F.poolw_t() + (size_t)g * 128 * 128 + (size_t)lr * 128 + 8 * lq;
#pragma unroll
        for (int q = 0; q < 8; ++q) { f32x4 acc = (f32x4){0.f, 0.f, 0.f, 0.f};
#pragma unroll
            for (int ks = 0; ks < 4; ++ks) acc = __builtin_amdgcn_mfma_f32_16x16x32_bf16(*(const bf16x8*)(pw + (size_t)(16 * q) * 128 + 32 * ks), mf[ks], acc, 0, 0, 0);
            const int dcol = g * 128 + 16 * q + 4 * lq; const f32x4 sc = *(const f32x4*)(F.pool_scale() + (size_t)l * BW + dcol);
            u32x2 w; w.x = pk2(acc[0] * sc.x, acc[1] * sc.y); w.y = pk2(acc[2] * sc.z, acc[3] * sc.w);
            *(u32x2*)(F.Y() + row * D + 1536 + dcol) = w; }
    }
}

__device__ __forceinline__ void conv_fix_phase(Frame& F, int l) {
    const float* cw = F.conv_w() + (size_t)l * 3 * NUP; const float* cb = F.conv_b() + (size_t)l * NUP; const float* UH = F.UH();
    const int gt = F.vcu * (NWAVES * 64) + F.tid, NGT = F.G * NWAVES * 64;
    constexpr int JG = DFF / 4;
    for (int task = gt; task < (M / 256) * 2 * JG; task += NGT) {
        const int jg = task % JG, q = (task / JG) & 1, pm = task / (2 * JG);
        if ((pm & 15) == 0) continue;
        const int j0 = jg * 4, ucol = 256 * (j0 >> 7) + (j0 & 127);
        const float* u0p = UH + ((size_t)pm * 4 + q) * NUP + ucol;
        const float* u1p = (q == 1) ? UH + ((size_t)pm * 4 + 0) * NUP + ucol : UH + ((size_t)(pm - 1) * 4 + 3) * NUP + ucol;
        const float* u2p = (q == 1) ? UH + ((size_t)(pm - 1) * 4 + 3) * NUP + ucol : UH + ((size_t)(pm - 1) * 4 + 2) * NUP + ucol;
        const f32x4 a0 = *(const f32x4*)u0p, a1 = *(const f32x4*)u1p, a2 = *(const f32x4*)u2p, v0 = *(const f32x4*)(u0p + 128), v1 = *(const f32x4*)(u1p + 128), v2 = *(const f32x4*)(u2p + 128);
        const f32x4 wa0 = *(const f32x4*)(cw + j0), wa1 = *(const f32x4*)(cw + NUP + j0), wa2 = *(const f32x4*)(cw + 2 * NUP + j0), ba = *(const f32x4*)(cb + j0);
        const f32x4 wv0 = *(const f32x4*)(cw + DFF + j0), wv1 = *(const f32x4*)(cw + NUP + DFF + j0), wv2 = *(const f32x4*)(cw + 2 * NUP + DFF + j0), bv = *(const f32x4*)(cb + DFF + j0);
        float o[4];
#pragma unroll
        for (int i = 0; i < 4; ++i) { const float ca = ba[i] + wa0[i] * a2[i] + wa1[i] * a1[i] + wa2[i] * a0[i], cv = bv[i] + wv0[i] * v2[i] + wv1[i] * v1[i] + wv2[i] * v0[i]; o[i] = siluf_(ca) * cv; }
        u32x2 w; w.x = pk2(o[0], o[1]); w.y = pk2(o[2], o[3]);
        *(u32x2*)(F.ACT() + ((size_t)pm * 256 + q) * DFF + j0) = w;
    }
}

constexpr int NPH = 13;
struct Args { const void* in[25]; float* out; unsigned char* ws; int l_lo, l_hi, ph_lo, ph_hi, single, pad; };
__global__ void __launch_bounds__(NWAVES * 64, 2) hybrid_fwd(Args args) {
    extern __shared__ __attribute__((aligned(16))) unsigned char lds[];
    Frame F;
    F.lds = (LAS unsigned char*)lds;
    F.tid = threadIdx.x; F.lane = F.tid & 63; F.wave = __builtin_amdgcn_readfirstlane(F.tid >> 6);
    const int wave0 = F.wave;
    F.G = gridDim.x; { const int bx = blockIdx.x; F.vcu = (F.G % 8 == 0) ? (bx % 8) * (F.G / 8) + bx / 8 : bx; }
    unsigned char* ws = args.ws; F.ws = ws; F.out = args.out;

    volatile LAS unsigned* MISC = (volatile LAS unsigned*)(F.lds + MISC_OFF);
    if (F.tid < 64) MISC[F.tid] = 0u;
    __syncthreads();
    unsigned* ctl = (unsigned*)(ws + WS_CTL);
    XcdBarrier bar; bar.bar = ctl + CW_BAR; bar.x = 0; bar.st = nullptr;
    if (args.single) bar = xcd_barrier_post(ctl + CW_BAR, MISC);
#define GRID_BAR() do { if (args.single) xcd_barrier(bar); } while (0)
    const int lo = args.ph_lo, hi = args.ph_hi;
#define IN(k) (lo <= (k) && (k) < hi)
#define PH_BEGIN() do { unsigned z_ = 0u; asm volatile("" : "+v"(z_)); const int ln_ = (int)__builtin_amdgcn_mbcnt_hi(~0u, __builtin_amdgcn_mbcnt_lo(~0u, z_)); F.lane = ln_; F.tid = wave0 * 64 + ln_; F.wave = wave0; unsigned long long w_ = (unsigned long long)args.ws, o_ = (unsigned long long)args.out; asm volatile("" : "+s"(w_), "+s"(o_)); F.ws = (unsigned char*)(GAS unsigned char*)w_; F.out = (float*)(GAS float*)o_; } while (0)

    for (int l = args.l_lo; l < args.l_hi; ++l) {
        const float* hsrc = (l == 0) ? F.x() : F.out;
        if (IN(0)) { PH_BEGIN(); phase_prep(F, l); GRID_BAR(); }
        if (IN(1)) { PH_BEGIN(); pg8::Gemm g{F.HN(), F.win_t(), M, NIN, D, D, D}; pg8::StaticOrder S; S.init(M, NIN, F.G, (int)blockIdx.x); pg8::EpiProj E{F.PROJ(), NIN, C_GATE / 256, C_GATE};
            pg8::gemm_phase(F.lds, g, S, E, F.tid); GRID_BAR(); }
        if (IN(2)) { PH_BEGIN(); lin_phase<false>(F, l); PH_BEGIN();
            s5_pass<false>(F, l); pool_phase(F, l); __syncthreads();
            GRID_BAR(); }
        if (IN(3)) { PH_BEGIN(); lin_scan(F); s5_scan(F); GRID_BAR(); }
        if (IN(4)) { PH_BEGIN(); lin_phase<true>(F, l); PH_BEGIN();
            s5_pass<true>(F, l); __syncthreads();
            GRID_BAR(); }
        if (IN(5)) { PH_BEGIN(); pg8::Gemm g{F.YBP(), F.wglu_t(), M, BW, BW, BW, BW}; pg8::StaticOrder S; S.init(M, BW, F.G, (int)blockIdx.x); pg8::EpiGlu E{F.YBP(), BW, F.Y() + BW, D};
            pg8::gemm_phase(F.lds, g, S, E, F.tid); GRID_BAR(); }
        if (IN(6)) { PH_BEGIN(); pg8::Gemm g{F.Y(), F.wbr_t(), M, D, D, D, D}; pg8::StaticOrder S; S.init(M, D, F.G, (int)blockIdx.x); pg8::EpiMerge E{F.PROJ() + C_GATE, NIN, F.HN(), D};
            pg8::gemm_phase(F.lds, g, S, E, F.tid); GRID_BAR(); }
        if (IN(7)) { PH_BEGIN(); pg8::Gemm g{F.HN(), F.wout_t(), M, D, D, D, D}; pg8::StaticOrder S; S.init(M, D, F.G, (int)blockIdx.x); pg8::EpiResid E{hsrc, F.out, D};
            pg8::gemm_phase(F.lds, g, S, E, F.tid); GRID_BAR(); }
        if (IN(8)) { PH_BEGIN(); rms_rows(F, F.out, F.g_ffn() + (size_t)l * D, F.HN()); GRID_BAR(); }
        if (IN(9)) { PH_BEGIN(); pg8::Gemm g{F.HN(), F.wup_t(), M, NUP, D, D, D}; pg8::StaticOrder S; S.init(M, NUP, F.G, (int)blockIdx.x); pg8::EpiConv E{F.conv_w() + (size_t)l * 3 * NUP, F.conv_b() + (size_t)l * NUP, F.ACT(), F.UH(), (LAS float*)(F.lds + pg8::STAGE_BYTES)};
            pg8::gemm_phase(F.lds, g, S, E, F.tid); GRID_BAR(); }
        if (IN(10)) { PH_BEGIN(); conv_fix_phase(F, l); GRID_BAR(); }
        if (IN(11)) { PH_BEGIN(); pg8::Gemm g{F.ACT(), F.wdn_t(), M, D, DFF, DFF, DFF}; pg8::StaticOrder S; S.init(M, D, F.G, (int)blockIdx.x); pg8::EpiResid E{F.out, F.out, D};
            pg8::gemm_phase(F.lds, g, S, E, F.tid); GRID_BAR(); }
        if (IN(12) && l == DEPTH - 1) { PH_BEGIN(); rms_rows_f32_inplace(F, F.out, F.g_final()); }
    }
#undef IN
#undef PH_BEGIN
#undef GRID_BAR
}

extern "C" void kernel_launch(void* const* d_in, const int* in_sizes, int n_in, void* d_out, int out_size, void* d_ws, size_t ws_size, hipStream_t stream) {
    static int grid = 0;
    if (grid == 0) {
        if (n_in != 25 || in_sizes[0] != M * D || out_size != M * D || ws_size < WS_END) { fprintf(stderr, "kernel_launch: shape/workspace mismatch (n_in %d, in0 %d, out %d, ws %zu, need %zu); nothing launched\n", n_in, n_in > 0 ? in_sizes[0] : -1, out_size, ws_size, (size_t)WS_END); grid = -1; return; }
        int dev = 0, cus = 0, per_cu = 0;
        if (hipGetDevice(&dev) != hipSuccess || hipDeviceGetAttribute(&cus, hipDeviceAttributeMultiprocessorCount, dev) != hipSuccess) { grid = -1; return; }
        if (hipFuncSetAttribute((const void*)hybrid_fwd, hipFuncAttributeMaxDynamicSharedMemorySize, LDS_BYTES) != hipSuccess) { fprintf(stderr, "kernel_launch: hipFuncSetAttribute failed\n"); grid = -1; return; }
        if (hipOccupancyMaxActiveBlocksPerMultiprocessor(&per_cu, (const void*)hybrid_fwd, NWAVES * 64, LDS_BYTES) != hipSuccess || per_cu < 1) { fprintf(stderr, "kernel_launch: occupancy query reports %d workgroups per CU\n", per_cu); }
        (void)hipGetLastError();
        grid = cus;
    }
    if (grid < 0) return;
    if (hipMemsetAsync((char*)d_ws + WS_CTL, 0, CTL_ZERO_BYTES, stream) != hipSuccess) return;
    Args a{};
    for (int i = 0; i < 25; ++i) a.in[i] = d_in[i];
    a.out = (float*)d_out; a.ws = (unsigned char*)d_ws;
#if MK_SINGLE
    a.l_lo = 0; a.l_hi = DEPTH; a.ph_lo = 0; a.ph_hi = NPH; a.single = 1;
    hipLaunchKernelGGL(hybrid_fwd, dim3(grid), dim3(NWAVES * 64), LDS_BYTES, stream, a);
#else
    a.single = 0;
    for (int l = 0; l < DEPTH; ++l)
        for (int p = 0; p < NPH; ++p) { if (p == 12 && l != DEPTH - 1) continue; a.l_lo = l; a.l_hi = l + 1; a.ph_lo = p; a.ph_hi = p + 1;
            hipLaunchKernelGGL(hybrid_fwd, dim3(grid), dim3(NWAVES * 64), LDS_BYTES, stream, a); }
#endif
}
```

```cpp
#include <hip/hip_runtime.h>
#include <cstdio>
#include <cstdint>

#ifndef MK_SINGLE
#define MK_SINGLE 1
#endif

#pragma clang attribute push(__attribute__((target("no-packed-fp32-ops"))), apply_to = function)
#define LAS __attribute__((address_space(3)))
#define GAS __attribute__((address_space(1)))
typedef unsigned short bf16_t;
typedef short bf16x8 __attribute__((ext_vector_type(8)));
typedef float f32x4 __attribute__((ext_vector_type(4)));
typedef float f32x2 __attribute__((ext_vector_type(2)));
typedef unsigned u32x4 __attribute__((ext_vector_type(4)));
typedef unsigned u32x2 __attribute__((ext_vector_type(2)));

constexpr int D = 2048, BATCH = 8, SEQ = 4096, DEPTH = 4, M = BATCH * SEQ;
constexpr int BW = 512;
constexpr int NIN_SRC = 12304, NIN = 12544;
constexpr int DFF = 5504, NUP = 11008;
constexpr int C_RQ = 0, C_RK = 256, C_RV = 512, C_RG = 1024, C_SU = 1536, C_GQ = 2048, C_GK = 2304, C_GV = 2560, C_GG = 3072, C_PU = 3584, C_GR = 4096, C_GATE = 4352;
constexpr float EPS = 1e-6f;
constexpr int NWAVES = 8;
constexpr int CH = 64;
constexpr int NCH = SEQ / CH;

constexpr size_t MiB = 1u << 20;
constexpr size_t WS_CTL = 0, CTL_ZERO_BYTES = 1 * MiB;
constexpr size_t WS_ROT = 1 * MiB;
constexpr size_t WS_S5T = 9 * MiB;
constexpr size_t S5T_ABAR = 0, S5T_APOW = 16384, S5T_BBAR = 32768, S5T_CMT = 32768 + 262144, S5T_BBT = S5T_CMT + 131072;
constexpr size_t WS_WGLU = 10 * MiB;
constexpr size_t WS_POOLW = 10 * MiB + 512 * 1024;
constexpr size_t WS_WIN = 11 * MiB;
constexpr size_t WS_WBR = 60 * MiB;
constexpr size_t WS_WOUT = 68 * MiB;
constexpr size_t WS_WUP = 76 * MiB;
constexpr size_t WS_WDN = 119 * MiB;
constexpr size_t WS_HN = 141 * MiB;
constexpr size_t WS_Y = 269 * MiB;
constexpr size_t WS_SCR = 397 * MiB;
constexpr size_t WS_YBP = WS_SCR;
constexpr size_t WS_STATE = WS_SCR + 32 * MiB;
constexpr size_t WS_SPREV = WS_SCR + 160 * MiB;
constexpr size_t WS_DEC = WS_SCR + 224 * MiB;
constexpr size_t WS_XEND = WS_SCR + 225 * MiB;
constexpr size_t WS_UH = WS_SCR + 128 * MiB;
constexpr size_t WS_PROJ = 637 * MiB;
constexpr size_t WS_ACT = WS_PROJ;
constexpr size_t WS_RS = 1421 * MiB;
constexpr size_t WS_SS = 1422 * MiB;
constexpr size_t WS_END = 1438 * MiB;
static_assert(WS_PROJ + (size_t)M * NIN * 2 <= WS_RS, "ws map");
static_assert(WS_ACT + (size_t)M * DFF * 2 <= WS_RS, "ws map");
static_assert(WS_XEND + 8 * MiB <= WS_PROJ, "ws map");
static_assert(WS_UH + (size_t)(M / 256) * 4 * NUP * 4 <= WS_PROJ, "ws map");
constexpr int CW_TMO = 0, CW_BAR = 4096;

constexpr int LDS_BYTES = 155648;
constexpr int MISC_OFF = LDS_BYTES - 256;

#define RLX_AGENT __ATOMIC_RELAXED, __HIP_MEMORY_SCOPE_AGENT
__device__ __forceinline__ void wg_sync() { __builtin_amdgcn_fence(__ATOMIC_RELEASE, "workgroup"); __builtin_amdgcn_s_barrier(); __builtin_amdgcn_fence(__ATOMIC_ACQUIRE, "workgroup"); }
#define LDS_WAIT() asm volatile("s_waitcnt lgkmcnt(0)" ::: "memory")
#define VM_WAIT() asm volatile("s_waitcnt vmcnt(0)" ::: "memory")
__device__ __forceinline__ unsigned f2bf(float f) { unsigned u = __builtin_bit_cast(unsigned, f); return (u + 0x7fffu + ((u >> 16) & 1u)) >> 16; }
__device__ __forceinline__ unsigned pk2(float lo, float hi) { return f2bf(lo) | (f2bf(hi) << 16); }
__device__ __forceinline__ float bflo(unsigned w) { return __builtin_bit_cast(float, w << 16); }
__device__ __forceinline__ float bfhi(unsigned w) { return __builtin_bit_cast(float, w & 0xffff0000u); }
__device__ __forceinline__ void unpack8(const u32x4 w, float (&v)[8]) { v[0] = bflo(w.x); v[1] = bfhi(w.x); v[2] = bflo(w.y); v[3] = bfhi(w.y); v[4] = bflo(w.z); v[5] = bfhi(w.z); v[6] = bflo(w.w); v[7] = bfhi(w.w); }
__device__ __forceinline__ u32x4 pack8(const float (&v)[8]) { u32x4 w; w.x = pk2(v[0], v[1]); w.y = pk2(v[2], v[3]); w.z = pk2(v[4], v[5]); w.w = pk2(v[6], v[7]); return w; }
__device__ __forceinline__ float sigmoidf_(float x) { return 1.0f / (1.0f + __expf(-x)); }
__device__ __forceinline__ float siluf_(float x) { return x / (1.0f + __expf(-x)); }
__device__ __forceinline__ float gelu_tanh(float x) { const float u = 1.5957691216f * (x + 0.044715f * x * x * x); return x / (1.0f + __expf(-u)); }
__device__ __forceinline__ float logsigmoidf_(float x) { return fminf(x, 0.f) - __logf(1.0f + __expf(-fabsf(x))); }

namespace pg8 {
constexpr int BM = 256, BK = 64, HALF = 128, HTB = HALF * BK * 2, STAGE_BYTES = 8 * HTB, NXCD = 8, WGM = 8;
__host__ __device__ __forceinline__ int lds_byte(int r, int c) { const int st = (r >> 4) * 2 + (c >> 5), rr = r & 15, cc = c & 31, ob = rr * 64 + cc * 2; return st * 1024 + (ob ^ (((ob >> 9) & 1) << 5)); }
__host__ __device__ __forceinline__ void stage_rc(int b, int& R, int& C) { const int st = b / 1024, sb = b % 1024, swz = sb ^ (((sb >> 9) & 1) << 5); R = (st >> 1) * 16 + swz / 64; C = (st & 1) * 32 + (swz % 64) / 2; }
__host__ __device__ __forceinline__ int perm32(int rho) { const int n = rho >> 4, i = rho & 15; return 8 * (i >> 2) + 4 * n + (i & 3); }

struct Unit { int pm, pn; };
struct Gemm { const bf16_t* A; const bf16_t* Bt; int M, N, K, lda, ldb; };

struct StaticOrder {
    int nM, nN, nwg, G, c;
    __host__ __device__ void init(int M_, int N_, int G_, int c_) { nM = M_ / BM; nN = N_ / BM; nwg = nM * nN; G = G_; c = c_; }
    __host__ __device__ bool next(int i, Unit& u) const {
        const long L = (long)i * G + c; if (L >= nwg) return false;
        int wgid = (int)L; { const int q = nwg / NXCD, r = nwg % NXCD, xcd = wgid % NXCD, off = wgid / NXCD; wgid = (xcd < r ? xcd * (q + 1) : r * (q + 1) + (xcd - r) * q) + off; }
        const int nig = WGM * nN, gid = wgid / nig, fm = gid * WGM, gsz = (nM - fm) < WGM ? (nM - fm) : WGM;
        u.pm = fm + ((wgid % nig) % gsz); u.pn = (wgid % nig) / gsz; return true;
    }
};

__device__ __forceinline__ unsigned cvt_pk_bf16(float lo, float hi) { unsigned r; asm volatile("v_cvt_pk_bf16_f32 %0, %1, %2" : "=v"(r) : "v"(lo), "v"(hi)); return r; }

struct EpiStoreBf16 {
    static constexpr bool PERM = true, KHOOK = false;
    bf16_t* O; int ldc;
    __device__ __forceinline__ void khook(f32x4 (&)[2][2][4][2], const Unit&, int, int, int, int, int) const {}
    __device__ __forceinline__ void operator()(f32x4 (&acc)[2][2][4][2], const Unit& u, int wr, int wc, int fr, int fq) const {
        const int row0 = u.pm * BM + wr * 64 + fr, col0 = u.pn * BM + wc * 32 + 8 * fq;
#pragma unroll
        for (int ai = 0; ai < 2; ++ai)
#pragma unroll
            for (int m = 0; m < 4; ++m) { bf16_t* rowp = O + (size_t)(row0 + ai * HALF + m * 16) * ldc + col0;
#pragma unroll
                for (int bj = 0; bj < 2; ++bj) { const f32x4 v0 = acc[ai][bj][m][0], v1 = acc[ai][bj][m][1];
                    u32x4 w; w.x = cvt_pk_bf16(v0[0], v0[1]); w.y = cvt_pk_bf16(v0[2], v0[3]); w.z = cvt_pk_bf16(v1[0], v1[1]); w.w = cvt_pk_bf16(v1[2], v1[3]);
                    *(u32x4*)(rowp + bj * HALF) = w; } }
    }
};
struct EpiProj {
    static constexpr bool PERM = true, KHOOK = false;
    bf16_t* O; int ldc; int gate_pn0; int gate_col0;
    __device__ __forceinline__ void khook(f32x4 (&)[2][2][4][2], const Unit&, int, int, int, int, int) const {}
    __device__ __forceinline__ void operator()(f32x4 (&acc)[2][2][4][2], const Unit& u, int wr, int wc, int fr, int fq) const {
        const int row0 = u.pm * BM + wr * 64 + fr;
        if (u.pn < gate_pn0) {
            const int col0 = u.pn * BM + wc * 32 + 8 * fq;
#pragma unroll
            for (int ai = 0; ai < 2; ++ai)
#pragma unroll
                for (int m = 0; m < 4; ++m) { bf16_t* rowp = O + (size_t)(row0 + ai * HALF + m * 16) * ldc + col0;
#pragma unroll
                    for (int bj = 0; bj < 2; ++bj) { const f32x4 v0 = acc[ai][bj][m][0], v1 = acc[ai][bj][m][1];
                        u32x4 w; w.x = cvt_pk_bf16(v0[0], v0[1]); w.y = cvt_pk_bf16(v0[2], v0[3]); w.z = cvt_pk_bf16(v1[0], v1[1]); w.w = cvt_pk_bf16(v1[2], v1[3]);
                        *(u32x4*)(rowp + bj * HALF) = w; } }
        } else {
            const int col0 = gate_col0 + 64 * (u.pn - gate_pn0) + 16 * wc + 4 * fq;
#pragma unroll
            for (int ai = 0; ai < 2; ++ai)
#pragma unroll
                for (int m = 0; m < 4; ++m) { bf16_t* rowp = O + (size_t)(row0 + ai * HALF + m * 16) * ldc + col0;
                    float r1[4], r2[4], r3[4], g3[4];
#pragma unroll
                    for (int i = 0; i < 4; ++i) {
                        const float e0 = __expf(-fminf(fmaxf(acc[ai][0][m][0][i], -30.f), 30.f)), e1 = __expf(-fminf(fmaxf(acc[ai][0][m][1][i], -30.f), 30.f));
                        const float e2 = __expf(-fminf(fmaxf(acc[ai][1][m][0][i], -30.f), 30.f)), e3 = __expf(-fminf(fmaxf(acc[ai][1][m][1][i], -30.f), 30.f));
                        const float i0 = __builtin_amdgcn_rcpf(1.f + e0), i1 = __builtin_amdgcn_rcpf(1.f + e1), i2 = __builtin_amdgcn_rcpf(1.f + e2), i3 = __builtin_amdgcn_rcpf(1.f + e3);
                        r1[i] = (1.f + e1) * i0; r2[i] = (1.f + e2) * i1; r3[i] = (1.f + e3) * i2; g3[i] = i3; }
                    u32x2 w;
                    w.x = cvt_pk_bf16(r1[0], r1[1]); w.y = cvt_pk_bf16(r1[2], r1[3]); *(u32x2*)(rowp) = w;
                    w.x = cvt_pk_bf16(r2[0], r2[1]); w.y = cvt_pk_bf16(r2[2], r2[3]); *(u32x2*)(rowp + D) = w;
                    w.x = cvt_pk_bf16(r3[0], r3[1]); w.y = cvt_pk_bf16(r3[2], r3[3]); *(u32x2*)(rowp + 2 * D) = w;
                    w.x = cvt_pk_bf16(g3[0], g3[1]); w.y = cvt_pk_bf16(g3[2], g3[3]); *(u32x2*)(rowp + 3 * D) = w; }
        }
    }
};
__device__ __forceinline__ float dpp_ror1(float x) { return __builtin_bit_cast(float, __builtin_amdgcn_update_dpp(0, __builtin_bit_cast(int, x), 0x121, 0xf, 0xf, false)); }
__device__ __forceinline__ float dpp_ror2(float x) { return __builtin_bit_cast(float, __builtin_amdgcn_update_dpp(0, __builtin_bit_cast(int, x), 0x122, 0xf, 0xf, false)); }
struct EpiConv {
    static constexpr bool PERM = true, KHOOK = false;
    const float* cw; const float* cb; bf16_t* O; float* UH; LAS float* halo; const float* RS;
    __device__ __forceinline__ void khook(f32x4 (&)[2][2][4][2], const Unit&, int, int, int, int, int) const {}
    __device__ __forceinline__ void operator()(f32x4 (&acc)[2][2][4][2], const Unit& u, int wr, int wc, int fr_, int fq_) const {
        int fr = fr_, fq = fq_; asm volatile("" : "+v"(fr), "+v"(fq));
        const int cl0 = wc * 32 + 8 * fq;
#pragma unroll
        for (int ai = 0; ai < 2; ++ai)
#pragma unroll
            for (int m = 0; m < 4; ++m) { const float r = RS[u.pm * BM + ai * HALF + wr * 64 + m * 16 + fr];
#pragma unroll
                for (int bj = 0; bj < 2; ++bj)
#pragma unroll
                    for (int n = 0; n < 2; ++n) acc[ai][bj][m][n] *= r; }
        if (fr >= 14) {
#pragma unroll
            for (int ai = 0; ai < 2; ++ai)
#pragma unroll
                for (int bj = 0; bj < 2; ++bj)
#pragma unroll
                    for (int n = 0; n < 2; ++n) *(LAS f32x4*)(halo + (((2 * ai + wr) * 2 + (fr - 14)) * 256 + 128 * bj + cl0 + 4 * n)) = acc[ai][bj][3][n];
        }
        if (wr == 0 && fr < 2) {
#pragma unroll
            for (int bj = 0; bj < 2; ++bj)
#pragma unroll
                for (int n = 0; n < 2; ++n) *(f32x4*)(UH + ((size_t)u.pm * 4 + fr) * NUP + 256 * u.pn + 128 * bj + cl0 + 4 * n) = acc[0][bj][0][n];
        }
        if (wr == 1 && fr >= 14) {
#pragma unroll
            for (int bj = 0; bj < 2; ++bj)
#pragma unroll
                for (int n = 0; n < 2; ++n) *(f32x4*)(UH + ((size_t)u.pm * 4 + 2 + (fr - 14)) * NUP + 256 * u.pn + 128 * bj + cl0 + 4 * n) = acc[1][bj][3][n];
        }
        asm volatile("s_waitcnt lgkmcnt(0)" ::: "memory"); __builtin_amdgcn_s_barrier(); asm volatile("" ::: "memory");
        const int j0 = 128 * u.pn + cl0;
        const bool is15 = fr == 15, ge14 = fr >= 14;
        unsigned keep[2][4][2];
#pragma unroll
        for (int n = 0; n < 2; ++n) {
            f32x4 wa[3], wv[3];
#pragma unroll
            for (int q = 0; q < 3; ++q) { wa[q] = *(const f32x4*)(cw + q * NUP + j0 + 4 * n); wv[q] = *(const f32x4*)(cw + q * NUP + DFF + j0 + 4 * n); }
            const f32x4 ba = *(const f32x4*)(cb + j0 + 4 * n), bv = *(const f32x4*)(cb + DFF + j0 + 4 * n);
#pragma unroll
            for (int ai = 0; ai < 2; ++ai) {
                const int blk = 2 * ai + wr;
                f32x4 pa = (f32x4){0.f, 0.f, 0.f, 0.f}, pv = (f32x4){0.f, 0.f, 0.f, 0.f};
                if (blk > 0 && ge14) { pa = *(const LAS f32x4*)(halo + (((blk - 1) * 2 + (fr - 14)) * 256 + cl0 + 4 * n)); pv = *(const LAS f32x4*)(halo + (((blk - 1) * 2 + (fr - 14)) * 256 + 128 + cl0 + 4 * n)); }
#pragma unroll
                for (int m = 0; m < 4; ++m) {
                    const f32x4 ca_ = acc[ai][0][m][n], cv_ = acc[ai][1][m][n]; float o[4];
#pragma unroll
                    for (int i = 0; i < 4; ++i) {
                        const float a1 = dpp_ror1(is15 ? pa[i] : ca_[i]), a2 = dpp_ror2(ge14 ? pa[i] : ca_[i]);
                        const float v1 = dpp_ror1(is15 ? pv[i] : cv_[i]), v2 = dpp_ror2(ge14 ? pv[i] : cv_[i]);
                        const float ca = ba[i] + wa[0][i] * a2 + wa[1][i] * a1 + wa[2][i] * ca_[i];
                        const float cv = bv[i] + wv[0][i] * v2 + wv[1][i] * v1 + wv[2][i] * cv_[i];
                        o[i] = siluf_(ca) * cv; }
                    pa = ca_; pv = cv_;
                    const unsigned lo = cvt_pk_bf16(o[0], o[1]), hi = cvt_pk_bf16(o[2], o[3]);
                    if (n == 0) { keep[ai][m][0] = lo; keep[ai][m][1] = hi; }
                    else { u32x4 w; w.x = keep[ai][m][0]; w.y = keep[ai][m][1]; w.z = lo; w.w = hi;
                        *(u32x4*)(O + (size_t)(u.pm * BM + ai * HALF + wr * 64 + m * 16 + fr) * DFF + j0) = w; }
                }
            }
        }
    }
};
struct EpiResid {
    static constexpr bool PERM = false, KHOOK = false;
    const float* base; float* out; int ldc; bf16_t* HB; float* SS;
    __device__ __forceinline__ void khook(f32x4 (&)[2][2][4][2], const Unit&, int, int, int, int, int) const {}
    __device__ __forceinline__ void operator()(f32x4 (&acc)[2][2][4][2], const Unit& u, int wr, int wc, int fr_, int fq_) const {
        int fr = fr_, fq = fq_; asm volatile("" : "+v"(fr), "+v"(fq));
        const int row0 = u.pm * BM + wr * 64 + fr, col0 = u.pn * BM + wc * 32 + 4 * fq, lane = fq * 16 + fr;
#pragma unroll
        for (int ai = 0; ai < 2; ++ai)
#pragma unroll
            for (int m = 0; m < 4; ++m) { const size_t off = (size_t)(row0 + ai * HALF + m * 16) * ldc + col0; float sq = 0.f;
#pragma unroll
                for (int bj = 0; bj < 2; ++bj)
#pragma unroll
                    for (int n = 0; n < 2; ++n) { const f32x4 bs = *(const f32x4*)(base + off + bj * HALF + n * 16); const f32x4 o = bs + acc[ai][bj][m][n]; *(f32x4*)(out + off + bj * HALF + n * 16) = o;
                        if (HB) { u32x2 w; w.x = cvt_pk_bf16(o[0], o[1]); w.y = cvt_pk_bf16(o[2], o[3]); *(u32x2*)(HB + off + bj * HALF + n * 16) = w;
                            sq += (o[0] * o[0] + o[1] * o[1]) + (o[2] * o[2] + o[3] * o[3]); } }
                if (HB) { sq += __builtin_bit_cast(float, __builtin_amdgcn_ds_bpermute((lane ^ 16) << 2, __builtin_bit_cast(int, sq)));
                    sq += __builtin_bit_cast(float, __builtin_amdgcn_ds_bpermute((lane ^ 32) << 2, __builtin_bit_cast(int, sq)));
                    if (fq == 0) SS[(size_t)(u.pn * 4 + wc) * M + row0 + ai * HALF + m * 16] = sq; }
                asm volatile("" ::: "memory"); }
    }
};
struct EpiGlu {
    static constexpr bool PERM = true, KHOOK = false;
    const bf16_t* Yp; int ldy; bf16_t* O; int ldc;
    __device__ __forceinline__ void khook(f32x4 (&)[2][2][4][2], const Unit&, int, int, int, int, int) const {}
    __device__ __forceinline__ void operator()(f32x4 (&acc)[2][2][4][2], const Unit& u, int wr, int wc, int fr, int fq) const {
        const int row0 = u.pm * BM + wr * 64 + fr, col0 = u.pn * BM + wc * 32 + 8 * fq;
#pragma unroll
        for (int ai = 0; ai < 2; ++ai)
#pragma unroll
            for (int m = 0; m < 4; ++m) { const size_t r = (size_t)(row0 + ai * HALF + m * 16);
#pragma unroll
                for (int bj = 0; bj < 2; ++bj) { const u32x4 yw = *(const u32x4*)(Yp + r * ldy + col0 + bj * HALF); float y[8]; unpack8(yw, y);
                    const f32x4 v0 = acc[ai][bj][m][0], v1 = acc[ai][bj][m][1]; float o[8];
#pragma unroll
                    for (int j = 0; j < 4; ++j) { o[j] = y[j] * sigmoidf_(v0[j]); o[4 + j] = y[4 + j] * sigmoidf_(v1[j]); }
                    u32x4 w; w.x = cvt_pk_bf16(o[0], o[1]); w.y = cvt_pk_bf16(o[2], o[3]); w.z = cvt_pk_bf16(o[4], o[5]); w.w = cvt_pk_bf16(o[6], o[7]);
                    *(u32x4*)(O + r * ldc + col0 + bj * HALF) = w; } }
    }
};
struct EpiMerge {
    static constexpr bool PERM = true, KHOOK = true;
    const bf16_t* G; int ldg; bf16_t* O; int ldc;
    __device__ __forceinline__ void scale(f32x4 (&acc)[2][2][4][2], const Unit& u, int s, int wr, int wc, int fr, int fq) const {
        int row0 = u.pm * BM + wr * 64 + fr, col0 = u.pn * BM + wc * 32 + 8 * fq + s * D; asm volatile("" : "+v"(row0), "+v"(col0));
        u32x4 w[2][4][2];
#pragma unroll
        for (int ai = 0; ai < 2; ++ai)
#pragma unroll
            for (int m = 0; m < 4; ++m) { const bf16_t* gp = G + (size_t)(row0 + ai * HALF + m * 16) * ldg + col0;
#pragma unroll
                for (int bj = 0; bj < 2; ++bj) w[ai][m][bj] = *(const u32x4*)(gp + bj * HALF); }
#pragma unroll
        for (int ai = 0; ai < 2; ++ai)
#pragma unroll
            for (int m = 0; m < 4; ++m)
#pragma unroll
                for (int bj = 0; bj < 2; ++bj) { float f[8]; unpack8(w[ai][m][bj], f);
#pragma unroll
                    for (int j = 0; j < 8; ++j) acc[ai][bj][m][j >> 2][j & 3] *= f[j]; }
    }
    __device__ __forceinline__ void khook(f32x4 (&acc)[2][2][4][2], const Unit& u, int seg, int wr, int wc, int fr, int fq) const { scale(acc, u, seg - 1, wr, wc, fr, fq); }
    __device__ __forceinline__ void operator()(f32x4 (&acc)[2][2][4][2], const Unit& u, int wr, int wc, int fr, int fq) const {
        scale(acc, u, 3, wr, wc, fr, fq);
        const int row0 = u.pm * BM + wr * 64 + fr, col0 = u.pn * BM + wc * 32 + 8 * fq;
#pragma unroll
        for (int ai = 0; ai < 2; ++ai)
#pragma unroll
            for (int m = 0; m < 4; ++m) { bf16_t* rowp = O + (size_t)(row0 + ai * HALF + m * 16) * ldc + col0;
#pragma unroll
                for (int bj = 0; bj < 2; ++bj) { const f32x4 v0 = acc[ai][bj][m][0], v1 = acc[ai][bj][m][1];
                    u32x4 w; w.x = cvt_pk_bf16(v0[0], v0[1]); w.y = cvt_pk_bf16(v0[2], v0[3]); w.z = cvt_pk_bf16(v1[0], v1[1]); w.w = cvt_pk_bf16(v1[2], v1[3]);
                    *(u32x4*)(rowp + bj * HALF) = w; } }
    }
};

template <class Epi>
__device__ __forceinline__ void gemm_phase(LAS unsigned char* lds, const Gemm g, const StaticOrder& S, const Epi& E, int tid_in) {
    int tid_ = tid_in; asm volatile("" : "+v"(tid_));
    const int tid = tid_, wid = __builtin_amdgcn_readfirstlane(tid >> 6), lane = tid & 63, wr = wid >> 2, wc = wid & 3, fr = lane & 15, fq = lane >> 4;
    const int K = g.K, nt = K / BK;
    unsigned voffA[2], voffB[2];
#pragma unroll
    for (int i = 0; i < 2; ++i) { int R, C; stage_rc(tid * 16 + i * 8192, R, C); const int Rb = Epi::PERM ? ((R & ~31) + perm32(R & 31)) : R;
        voffA[i] = (unsigned)(R * g.lda + C) * 2u; voffB[i] = (unsigned)(Rb * g.ldb + C) * 2u; }
    const size_t kstep = (size_t)(BK * 2);
    const size_t hstepA = (size_t)HALF * g.lda * 2, hstepB = (size_t)HALF * g.ldb * 2;
    const size_t tstepA = 2 * hstepA, tstepB = 2 * hstepB;
    const unsigned ldsw = (unsigned)wid * 1024u;
    const int aoff = lds_byte(wr * 64 + fr, fq * 8), boff = lds_byte(wc * 32 + fr, fq * 8);
#define PG8_SA(b, h) (((b) * 2 + (h)) * HTB)
#define PG8_SB(b, h) ((4 + (b) * 2 + (h)) * HTB)
#define PG8_STAGE(bufoff, gbase, voff) do { _Pragma("unroll") for (int _i = 0; _i < 2; ++_i) \
        __builtin_amdgcn_global_load_lds((const unsigned*)((const char*)(gbase) + (voff)[_i]), (LAS unsigned*)(lds + (bufoff) + ldsw + _i * 8192), 16, 0, 0); } while (0)
#define PG8_LDA(dst, b, h) do { _Pragma("unroll") for (int m = 0; m < 4; ++m) _Pragma("unroll") for (int k = 0; k < 2; ++k) dst[m][k] = *(const LAS bf16x8*)(lds + PG8_SA(b, h) + aoff + m * 2048 + k * 1024); } while (0)
#define PG8_LDB(dst, b, h) do { _Pragma("unroll") for (int n = 0; n < 2; ++n) _Pragma("unroll") for (int k = 0; k < 2; ++k) dst[n][k] = *(const LAS bf16x8*)(lds + PG8_SB(b, h) + boff + n * 2048 + k * 1024); } while (0)
#define PG8_MMA(ai, bj, At, Bt) do { __builtin_amdgcn_s_setprio(1); _Pragma("unroll") for (int m = 0; m < 4; ++m) _Pragma("unroll") for (int n = 0; n < 2; ++n) _Pragma("unroll") for (int k = 0; k < 2; ++k) \
        acc[ai][bj][m][n] = __builtin_amdgcn_mfma_f32_16x16x32_bf16(Bt[n][k], At[m][k], acc[ai][bj][m][n], 0, 0, 0); __builtin_amdgcn_s_setprio(0); } while (0)
#define PG8_WAIT_V(n) asm volatile("s_waitcnt vmcnt(" #n ")" ::: "memory")
#define PG8_WAIT_L(n) asm volatile("s_waitcnt lgkmcnt(" #n ")" ::: "memory")
#define PG8_BAR __builtin_amdgcn_s_barrier()
#define PG8_SCHED __builtin_amdgcn_sched_barrier(0)
    Unit cur, nxt; int ui = 0;
    if (!S.next(0, cur)) return;
    f32x4 acc[2][2][4][2];
#pragma unroll
    for (int a = 0; a < 2; ++a)
#pragma unroll
        for (int b = 0; b < 2; ++b)
#pragma unroll
            for (int m = 0; m < 4; ++m)
#pragma unroll
                for (int n = 0; n < 2; ++n) acc[a][b][m][n] = (f32x4){0.f, 0.f, 0.f, 0.f};
    bf16x8 At[4][2], B0[2][2], B1[2][2];
    const char* cA = (const char*)g.A + (size_t)cur.pm * tstepA; const char* cB = (const char*)g.Bt + (size_t)cur.pn * tstepB;
    PG8_STAGE(PG8_SB(0, 0), cB, voffB); PG8_STAGE(PG8_SB(0, 1), cB + hstepB, voffB); PG8_STAGE(PG8_SA(0, 0), cA, voffA); PG8_STAGE(PG8_SA(0, 1), cA + hstepA, voffA);
    if (wr == 1) PG8_BAR;
    PG8_WAIT_V(2); PG8_BAR;
    PG8_STAGE(PG8_SB(1, 0), cB + kstep, voffB); PG8_STAGE(PG8_SA(1, 0), cA + kstep, voffA); PG8_STAGE(PG8_SB(1, 1), cB + hstepB + kstep, voffB);
    PG8_WAIT_V(6); PG8_BAR;
    for (;;) {
        const bool has_next = S.next(ui + 1, nxt);
        const char* nA = has_next ? (const char*)g.A + (size_t)nxt.pm * tstepA : cA; const char* nB = has_next ? (const char*)g.Bt + (size_t)nxt.pn * tstepB : cB;
        for (int t = 0; t < nt; t += 2) {
            const bool last = (t == nt - 2);
            const char* a1 = cA + (size_t)(t + 1) * kstep;
            const char* a2 = last ? nA : cA + (size_t)(t + 2) * kstep; const char* b2 = last ? nB : cB + (size_t)(t + 2) * kstep;
            const char* a3 = a2 + kstep; const char* b3 = b2 + kstep;
            if constexpr (Epi::KHOOK) { if (t != 0 && (t & 7) == 0) E.khook(acc, cur, t >> 3, wr, wc, fr, fq); }
            PG8_LDB(B0, 0, 0); PG8_LDB(B1, 0, 1); PG8_SCHED; PG8_LDA(At, 0, 0); PG8_STAGE(PG8_SA(1, 1), a1 + hstepA, voffA);
            PG8_WAIT_V(8); PG8_WAIT_L(0); PG8_BAR; PG8_MMA(0, 0, At, B0); PG8_MMA(0, 1, At, B1); PG8_BAR; PG8_SCHED;
            PG8_LDA(At, 0, 1); PG8_STAGE(PG8_SB(0, 0), b2, voffB); PG8_STAGE(PG8_SB(0, 1), b2 + hstepB, voffB); PG8_STAGE(PG8_SA(0, 0), a2, voffA);
            PG8_WAIT_V(8); PG8_WAIT_L(0); PG8_BAR; PG8_MMA(1, 0, At, B0); PG8_MMA(1, 1, At, B1); PG8_BAR; PG8_SCHED;
            PG8_LDB(B0, 1, 0); PG8_LDB(B1, 1, 1); PG8_SCHED; PG8_LDA(At, 1, 0); PG8_STAGE(PG8_SA(0, 1), a2 + hstepA, voffA);
            PG8_WAIT_V(8); PG8_WAIT_L(0); PG8_BAR; PG8_MMA(0, 0, At, B0); PG8_MMA(0, 1, At, B1); PG8_BAR; PG8_SCHED;
            PG8_LDA(At, 1, 1); PG8_STAGE(PG8_SB(1, 0), b3, voffB); PG8_STAGE(PG8_SB(1, 1), b3 + hstepB, voffB); PG8_STAGE(PG8_SA(1, 0), a3, voffA);
            PG8_WAIT_V(8); PG8_WAIT_L(0); PG8_BAR; PG8_MMA(1, 0, At, B0); PG8_MMA(1, 1, At, B1); PG8_BAR; PG8_SCHED;
        }
        if (wr == 0) PG8_BAR;
        E(acc, cur, wr, wc, fr, fq);
        if (!has_next) break;
#pragma unroll
        for (int a = 0; a < 2; ++a)
#pragma unroll
            for (int b = 0; b < 2; ++b)
#pragma unroll
                for (int m = 0; m < 4; ++m)
#pragma unroll
                    for (int n = 0; n < 2; ++n) acc[a][b][m][n] = (f32x4){0.f, 0.f, 0.f, 0.f};
        cur = nxt; cA = nA; cB = nB; ++ui;
        if (wr == 1) PG8_BAR;
    }
    PG8_WAIT_V(0);
    PG8_BAR;
#undef PG8_SA
#undef PG8_SB
#undef PG8_STAGE
#undef PG8_LDA
#undef PG8_LDB
#undef PG8_MMA
#undef PG8_WAIT_V
#undef PG8_WAIT_L
#undef PG8_BAR
#undef PG8_SCHED
}
}

#define XB_TMO      128
#define XB_XCNT(j)  (256  + 64 * (j))
#define XB_XSUB(j)  (1280 + 64 * (j))
#define XB_XGEN(j)  (2304 + 64 * (j))
#define XB_TOP      3328
#define XB_TOPGEN   3392
#define XCD_BAR_WORDS 3456
#define XB_SPIN_CAP (1u << 18)
__device__ __forceinline__ unsigned xb_ld(unsigned* p)              { return __hip_atomic_load(p, __ATOMIC_RELAXED, __HIP_MEMORY_SCOPE_AGENT); }
__device__ __forceinline__ unsigned xb_add(unsigned* p, unsigned v) { return __hip_atomic_fetch_add(p, v, __ATOMIC_RELAXED, __HIP_MEMORY_SCOPE_AGENT); }
__device__ __forceinline__ unsigned xb_xcc_id() { return (unsigned)__builtin_amdgcn_s_getreg((3 << 11) | 20) & 0xFu; }
#define XB_SPIN(cond, bar) do { unsigned _sp = 0; while (cond) { __builtin_amdgcn_s_sleep(1); \
    if ((++_sp & 255u) == 0u) { if (xb_ld(&(bar)[XB_TMO])) break; if (_sp > XB_SPIN_CAP) { (void)__hip_atomic_fetch_add(&(bar)[XB_TMO], 1u, __ATOMIC_RELAXED, __HIP_MEMORY_SCOPE_AGENT); break; } } } } while (0)
struct XcdBarrier { unsigned* bar; unsigned x; volatile LAS unsigned* st; };
__device__ __forceinline__ XcdBarrier xcd_barrier_post(unsigned* bar, volatile LAS unsigned* st) {
    XcdBarrier b; b.bar = bar; b.x = xb_xcc_id(); b.st = st;
    if (threadIdx.x == 0) (void)xb_add(&bar[XB_XCNT(b.x)], 1u);
    return b;
}
__device__ __forceinline__ void xcd_barrier_complete(unsigned* bar, unsigned x, unsigned& nloc, unsigned& nx) {
    const unsigned G = gridDim.x * gridDim.y * gridDim.z;
    unsigned sum, cnt, mine, sp = 0u;
    for (;;) {
        sum = 0u; cnt = 0u; mine = 0u;
#pragma nounroll
        for (unsigned j = 0; j < 16; ++j) { const unsigned c = xb_ld(&bar[XB_XCNT(j)]); sum += c; cnt += (c > 0u) ? 1u : 0u; mine = (j == x) ? c : mine; }
        if (sum == G) break;
        __builtin_amdgcn_s_sleep(1);
        if ((++sp & 255u) == 0u) { if (xb_ld(&bar[XB_TMO])) break; if (sp > XB_SPIN_CAP) { (void)__hip_atomic_fetch_add(&bar[XB_TMO], 1u, __ATOMIC_RELAXED, __HIP_MEMORY_SCOPE_AGENT); break; } }
    }
    nloc = mine > 0u ? mine : 1u; nx = cnt > 0u ? cnt : 1u;
}
__device__ __forceinline__ void xcd_barrier(const XcdBarrier& b) {
    asm volatile("s_waitcnt vmcnt(0)" ::: "memory");
    wg_sync();
    if (threadIdx.x == 0) {
        unsigned* bar = b.bar;
        __builtin_amdgcn_s_waitcnt(0);
        unsigned nloc = b.st[0], nx = b.st[1];
        if (nloc == 0u) { xcd_barrier_complete(bar, b.x, nloc, nx); b.st[0] = nloc; b.st[1] = nx; }
        const unsigned old = xb_add(&bar[XB_XSUB(b.x)], 1u);
        const unsigned gen = old / nloc;
        if (old + 1u == (gen + 1u) * nloc) {
            __builtin_amdgcn_fence(__ATOMIC_RELEASE, "agent");
            asm volatile("s_waitcnt vmcnt(0)" ::: "memory");
            const unsigned og = xb_add(&bar[XB_TOP], 1u);
            const unsigned tg = og / nx;
            if (og + 1u == (tg + 1u) * nx) xb_add(&bar[XB_TOPGEN], 1u);
            else XB_SPIN(xb_ld(&bar[XB_TOPGEN]) == tg, bar);
            __builtin_amdgcn_fence(__ATOMIC_ACQUIRE, "agent");
            xb_add(&bar[XB_XGEN(b.x)], 1u);
            asm volatile("s_waitcnt vmcnt(0)" ::: "memory");
        } else {
            XB_SPIN(xb_ld(&bar[XB_XGEN(b.x)]) == gen, bar);
            __builtin_amdgcn_fence(__ATOMIC_ACQUIRE, "agent");
            asm volatile("s_waitcnt vmcnt(0)" ::: "memory");
        }
    }
    wg_sync();
}

__device__ __forceinline__ const void* kin(int k) {
    typedef __attribute__((address_space(4))) const char* kptr_t;
    kptr_t p = (kptr_t)__builtin_amdgcn_kernarg_segment_ptr(); asm volatile("" : "+s"(p));
    const unsigned long long v = *(__attribute__((address_space(4))) const unsigned long long*)(p + 8 * k);
    return (const void*)(GAS const void*)v;
}
struct Frame {
    LAS unsigned char* lds;
    int tid, lane, wave, vcu, G, l;
    unsigned char* ws; float* out;
#define FIN(name, T, k) __device__ __forceinline__ const T* name() const { return (const T*)kin(k); }
    FIN(x, float, 0) FIN(pos, int, 1) FIN(g_mix, float, 2) FIN(w_in, float, 3) FIN(a_re, float, 4) FIN(a_im, float, 5) FIN(log_dt, float, 6) FIN(b_re, float, 7) FIN(b_im, float, 8)
    FIN(c_re, float, 9) FIN(c_im, float, 10) FIN(s5_d, float, 11) FIN(w_glu, float, 12) FIN(gla_wg, float, 13) FIN(gla_bg, float, 14) FIN(pool_w, float, 15) FIN(pool_scale, float, 16)
    FIN(w_branch, float, 17) FIN(w_out, float, 18) FIN(g_ffn, float, 19) FIN(w_up, float, 20) FIN(conv_w, float, 21) FIN(conv_b, float, 22) FIN(w_down, float, 23) FIN(g_final, float, 24)
#undef FIN
#define FWS(name, T, off) __device__ __forceinline__ T* name() const { return (T*)(ws + (off)); }
    FWS(rotc, float, WS_ROT) FWS(rots, float, WS_ROT + (size_t)M * 32 * 4) FWS(abar, float, WS_S5T + S5T_ABAR) FWS(apow, float, WS_S5T + S5T_APOW) FWS(bbar, float, WS_S5T + S5T_BBAR) FWS(cmt, bf16_t, WS_S5T + S5T_CMT) FWS(bbt, bf16_t, WS_S5T + S5T_BBT)
    FWS(wglu_t, bf16_t, WS_WGLU) FWS(poolw_t, bf16_t, WS_POOLW) FWS(win_t, bf16_t, WS_WIN) FWS(wbr_t, bf16_t, WS_WBR) FWS(wout_t, bf16_t, WS_WOUT) FWS(wup_t, bf16_t, WS_WUP) FWS(wdn_t, bf16_t, WS_WDN)
    FWS(HN, bf16_t, WS_HN) FWS(Y, bf16_t, WS_Y) FWS(YBP, bf16_t, WS_YBP) FWS(PROJ, bf16_t, WS_PROJ) FWS(SPREV, bf16_t, WS_SPREV) FWS(ACT, bf16_t, WS_ACT)
    FWS(SS, float, WS_SS + (size_t)l * 32 * M * 4) FWS(RS, float, WS_RS + (size_t)l * M * 4) FWS(STATE, float, WS_STATE) FWS(DEC, float, WS_DEC) FWS(XEND, float, WS_XEND) FWS(UH, float, WS_UH)
#undef FWS
};

__device__ __forceinline__ float lane_read(float v, int src_lane) { return __builtin_bit_cast(float, __builtin_amdgcn_ds_bpermute(src_lane << 2, __builtin_bit_cast(int, v))); }
__device__ __forceinline__ float wave_sum(float v, int lane) {
#pragma unroll
    for (int o = 1; o < 64; o <<= 1) v += lane_read(v, lane ^ o);
    return v;
}

template <class SrcCol>
__device__ __forceinline__ void transpose_item(const float* W, int Nsrc, bf16_t* WT, int ldt, int kdst0, int k0, int n0, SrcCol srccol, LAS float* scr, int lane, const float* kscale = nullptr) {
    const int sc = srccol(n0 + (lane & 31));
    float wv[32];
#pragma unroll
    for (int i = 0; i < 32; ++i) { const int kk = 2 * i + (lane >> 5); wv[i] = sc >= 0 ? W[(size_t)(k0 + kk) * Nsrc + sc] : 0.f; }
#pragma unroll
    for (int i = 0; i < 32; ++i) { const int kk = 2 * i + (lane >> 5); scr[kk * 33 + (lane & 31)] = kscale ? wv[i] * kscale[k0 + kk] : wv[i]; }
    LDS_WAIT();
    const int c = lane & 7;
#pragma unroll
    for (int j = 0; j < 4; ++j) { const int n = (lane >> 3) + 8 * j; const LAS float* s = scr + (8 * c) * 33 + n;
        u32x4 o; o.x = pk2(s[0 * 33], s[1 * 33]); o.y = pk2(s[2 * 33], s[3 * 33]); o.z = pk2(s[4 * 33], s[5 * 33]); o.w = pk2(s[6 * 33], s[7 * 33]);
        *(u32x4*)(WT + (size_t)(n0 + n) * ldt + kdst0 + k0 + 8 * c) = o; }
    LDS_WAIT();
}
struct ColIdent { __device__ __forceinline__ int operator()(int n) const { return n; } };
struct ColWin { __device__ __forceinline__ int operator()(int n) const {
    if (n < 3584) return n; if (n < 4096) return n + 16; if (n < 4112) return n - 512; if (n < 4352) return -1;
    const int t = (n - 4352) >> 8, cl = (n - 4352) & 255; const int br = 2 * (cl >> 7) + ((cl >> 2) & 1), ch = 16 * ((cl >> 5) & 3) + 4 * ((cl >> 3) & 3) + (cl & 3);
    return 4112 + br * 2048 + 64 * t + ch; } };
struct ColWup { __device__ __forceinline__ int operator()(int n) const { const int blk = n >> 8, r = n & 255; return (r < 128) ? (blk * 128 + r) : (DFF + blk * 128 + (r - 128)); } };

__device__ __forceinline__ void rms_row_to_bf16(const float* xrow, const float* g, bf16_t* orow, int lane) {
    const f32x4* xr = (const f32x4*)xrow + lane; const f32x4* gr = (const f32x4*)g + lane;
    f32x4 v[8]; float s = 0.f;
#pragma unroll
    for (int j = 0; j < 8; ++j) { v[j] = xr[64 * j]; s += (v[j].x * v[j].x + v[j].y * v[j].y) + (v[j].z * v[j].z + v[j].w * v[j].w); }
    const float r = 1.0f / sqrtf(wave_sum(s, lane) * (1.f / D) + EPS);
    u32x2* o8 = (u32x2*)orow + lane;
#pragma unroll
    for (int j = 0; j < 8; ++j) { const f32x4 gg = gr[64 * j]; u32x2 w; w.x = pk2(v[j].x * r * gg.x, v[j].y * r * gg.y); w.y = pk2(v[j].z * r * gg.z, v[j].w * r * gg.w); o8[64 * j] = w; }
}
__device__ __forceinline__ void rms_rows(Frame& F, const float* src, const float* g, bf16_t* dst) {
    const int gw = F.vcu * NWAVES + F.wave, NGW = F.G * NWAVES;
    for (int m = gw; m < M; m += NGW) rms_row_to_bf16(src + (size_t)m * D, g, dst + (size_t)m * D, F.lane);
}
__device__ __forceinline__ void row_scale(Frame& F) {
    const int gt = F.vcu * (NWAVES * 64) + F.tid, NGT = F.G * NWAVES * 64;
    for (int m = gt; m < M; m += NGT) { float s = 0.f;
#pragma unroll
        for (int j = 0; j < 32; ++j) s += F.SS()[(size_t)j * M + m];
        F.RS()[m] = 1.0f / sqrtf(s * (1.f / D) + EPS); }
}
__device__ __forceinline__ void rms_rows_f32_inplace(Frame& F, float* buf, const float* g) {
    const int gw = F.vcu * NWAVES + F.wave, NGW = F.G * NWAVES;
    for (int m = gw; m < M; m += NGW) {
        f32x4* xr = (f32x4*)(buf + (size_t)m * D) + F.lane; const f32x4* gr = (const f32x4*)g + F.lane;
        f32x4 v[8]; float s = 0.f;
#pragma unroll
        for (int j = 0; j < 8; ++j) { v[j] = xr[64 * j]; s += (v[j].x * v[j].x + v[j].y * v[j].y) + (v[j].z * v[j].z + v[j].w * v[j].w); }
        const float r = 1.0f / sqrtf(wave_sum(s, F.lane) * (1.f / D) + EPS);
#pragma unroll
        for (int j = 0; j < 8; ++j) { const f32x4 gg = gr[64 * j]; xr[64 * j] = (f32x4){v[j].x * r * gg.x, v[j].y * r * gg.y, v[j].z * r * gg.z, v[j].w * r * gg.w}; }
    }
}

__device__ __forceinline__ void phase_prep(Frame& F, int l) {
    LAS float* scr = (LAS float*)(F.lds + F.wave * 16384);
    const int gw = F.vcu * NWAVES + F.wave, NGW = F.G * NWAVES;
    constexpr int I_IN = (D / 64) * (NIN / 32), I_UP = (D / 64) * (NUP / 32), I_DN = (DFF / 64) * (D / 32), I_BR = 4 * (BW / 64) * (D / 32), I_OUT = (D / 64) * (D / 32), I_GLU = (BW / 64) * (BW / 32), I_PL = 4 * (128 / 64) * (128 / 32);
    constexpr int NITEMS = I_IN + I_UP + I_DN + I_BR + I_OUT + I_GLU + I_PL;
    for (int it = gw; it < NITEMS; it += NGW) {
        int r = it;
        if (r < I_IN) { const int nb = NIN / 32; transpose_item(F.w_in() + (size_t)l * D * NIN_SRC, NIN_SRC, F.win_t(), D, 0, 64 * (r / nb), 32 * (r % nb), ColWin(), scr, F.lane); continue; } r -= I_IN;
        if (r < I_UP) { const int nb = NUP / 32; transpose_item(F.w_up() + (size_t)l * D * NUP, NUP, F.wup_t(), D, 0, 64 * (r / nb), 32 * (r % nb), ColWup(), scr, F.lane, F.g_ffn() + (size_t)l * D); continue; } r -= I_UP;
        if (r < I_DN) { const int nb = D / 32; transpose_item(F.w_down() + (size_t)l * DFF * D, D, F.wdn_t(), DFF, 0, 64 * (r / nb), 32 * (r % nb), ColIdent(), scr, F.lane); continue; } r -= I_DN;
        if (r < I_BR) { const int per = (BW / 64) * (D / 32), br = r / per, q = r % per, nb = D / 32;
            transpose_item(F.w_branch() + ((size_t)l * 4 + br) * BW * D, D, F.wbr_t(), D, br * BW, 64 * (q / nb), 32 * (q % nb), ColIdent(), scr, F.lane); continue; } r -= I_BR;
        if (r < I_OUT) { const int nb = D / 32; transpose_item(F.w_out() + (size_t)l * D * D, D, F.wout_t(), D, 0, 64 * (r / nb), 32 * (r % nb), ColIdent(), scr, F.lane); continue; } r -= I_OUT;
        if (r < I_GLU) { const int nb = BW / 32; transpose_item(F.w_glu() + (size_t)l * BW * BW, BW, F.wglu_t(), BW, 0, 64 * (r / nb), 32 * (r % nb), ColIdent(), scr, F.lane); continue; } r -= I_GLU;
        { const int grp = r / 8, q = r % 8; transpose_item(F.pool_w() + ((size_t)l * 4 + grp) * 128 * 128, 128, F.poolw_t() + (size_t)grp * 128 * 128, 128, 0, 64 * (q / 4), 32 * (q % 4), ColIdent(), scr, F.lane); }
    }
    const int gt = F.vcu * (NWAVES * 64) + F.tid, NGT = F.G * NWAVES * 64;
    for (int i = gt; i < 32 * 64; i += NGT) {
        const int g = i >> 6;
        const float are = F.a_re()[(size_t)l * 2048 + i], aim = F.a_im()[(size_t)l * 2048 + i], dt = expf(F.log_dt()[l * 32 + g]);
        const float mag = expf(are * dt), th = aim * dt;
        const float abr = mag * cosf(th), abi = mag * sinf(th);
        const float den = are * are + aim * aim, nr = abr - 1.0f, ni = abi;
        const float fre = (nr * are + ni * aim) / den, fim = (ni * are - nr * aim) / den;
        F.abar()[2 * i] = abr; F.abar()[2 * i + 1] = abi;
        float pr = abr, pi = abi;
#pragma unroll
        for (int q = 0; q < 6; ++q) { const float tr = pr * pr - pi * pi, ti = 2.f * pr * pi; pr = tr; pi = ti; }
        F.apow()[2 * i] = pr; F.apow()[2 * i + 1] = pi;
        const float* br = F.b_re() + ((size_t)l * 2048 + i) * 16; const float* bi = F.b_im() + ((size_t)l * 2048 + i) * 16;
#pragma unroll
        for (int c = 0; c < 16; ++c) { const float x = br[c], y = bi[c]; const float vr = fre * x - fim * y, vi = fre * y + fim * x; const int p = i & 63;
            F.bbt()[((size_t)g * 128 + p) * 16 + c] = (bf16_t)f2bf(vr); F.bbt()[((size_t)g * 128 + 64 + p) * 16 + c] = (bf16_t)f2bf(vi); }
    }
    for (int i = gt; i < 32 * 16 * 128; i += NGT) {
        const int k = i & 127, gc = i >> 7;
        const float v = (k < 64) ? F.c_re()[((size_t)l * 512 + gc) * 64 + k] : -F.c_im()[((size_t)l * 512 + gc) * 64 + (k - 64)];
        F.cmt()[i] = (bf16_t)f2bf(v);
    }
    if (l == 0) {
        for (int i = gt; i < M * 32; i += NGT) {
            const int row = i >> 5, j = i & 31;
            const float inv = exp2f(-(float)j * (13.287712379549449f / 32.0f));
            const float ang = (float)F.pos()[row] * inv;
            F.rotc()[i] = cosf(ang); F.rots()[i] = sinf(ang);
        }
    }
    rms_rows(F, l == 0 ? F.x() : F.out, F.g_mix() + (size_t)l * D, F.HN());
}

__device__ __forceinline__ f32x4 mma_nt_lds(const LAS bf16_t* X, int px, const LAS bf16_t* Y, int py, int ksteps, f32x4 acc, int lane) {
    const LAS bf16_t* xp = X + (lane & 15) * px + 8 * (lane >> 4);
    const LAS bf16_t* yp = Y + (lane & 15) * py + 8 * (lane >> 4);
    for (int ks = 0; ks < ksteps; ++ks) {
        const bf16x8 a = *(const LAS bf16x8*)(xp + 32 * ks), b = *(const LAS bf16x8*)(yp + 32 * ks);
        acc = __builtin_amdgcn_mfma_f32_16x16x32_bf16(a, b, acc, 0, 0, 0);
    }
    return acc;
}

constexpr int LN_TOT = 16384, LN_QD = 18432, LN_KI = 27648, LN_PM = 36864, LN_VT = 46080, LN_OB = 64512, LN_WG = 98304, LN_END = 98304 + 4096 + 256;
constexpr int LP = 72;
struct LinRaw { u32x4 q0, q1, k0, k1, v0, v1, g0, g1, gr0, gr1; f32x4 c0, c1, s0, s1; bf16x8 sp0, sp1; };
template <bool OUT>
__device__ __forceinline__ void lin_issue(Frame& F, int unit, LinRaw& R) {
    const int n = unit & 63, h = (unit >> 6) & 3, b = (unit >> 8) & 7, mixer = unit >> 11;
    const size_t row0 = (size_t)b * SEQ + (size_t)n * CH; const int s = F.tid >> 3, c = F.tid & 7;
    const int cq = (mixer == 0 ? C_RQ : C_GQ) + h * 64, ck = (mixer == 0 ? C_RK : C_GK) + h * 64, cv = (mixer == 0 ? C_RV : C_GV) + h * 128, cg = (mixer == 0 ? C_RG : C_GG) + h * 128;
    const bf16_t* pr = F.PROJ() + (row0 + s) * NIN;
    R.k0 = *(const u32x4*)(pr + ck + 8 * c); R.k1 = *(const u32x4*)(pr + ck + 8 * (c ^ 4));
    if (OUT) { R.q0 = *(const u32x4*)(pr + cq + 8 * c); R.q1 = *(const u32x4*)(pr + cq + 8 * (c ^ 4)); }
    { const float* cp = F.rotc() + (row0 + s) * 32 + (c & 3) * 8; const float* sp = F.rots() + (row0 + s) * 32 + (c & 3) * 8;
      R.c0 = *(const f32x4*)cp; R.c1 = *(const f32x4*)(cp + 4); R.s0 = *(const f32x4*)sp; R.s1 = *(const f32x4*)(sp + 4); }
    R.gr0 = *(const u32x4*)(pr + C_GR); R.gr1 = *(const u32x4*)(pr + C_GR + 8);
    R.v0 = *(const u32x4*)(F.PROJ() + (row0 + (F.tid >> 4)) * NIN + cv + (F.tid & 15) * 8);
    R.v1 = *(const u32x4*)(F.PROJ() + (row0 + 32 + (F.tid >> 4)) * NIN + cv + (F.tid & 15) * 8);
    if (OUT) { R.g0 = *(const u32x4*)(pr + cg + 16 * c); R.g1 = *(const u32x4*)(pr + cg + 16 * c + 8);
        const bf16_t* sq = F.SPREV() + (size_t)unit * 8192 + (size_t)(16 * F.wave + (F.lane & 15)) * 64 + 8 * (F.lane >> 4);
        R.sp0 = *(const bf16x8*)sq; R.sp1 = *(const bf16x8*)(sq + 32); }
}
__device__ __forceinline__ void lin_rot(const u32x4 own_, const u32x4 oth_, const LinRaw& R, bool rot, bool hi, float scale, float (&v)[8]) {
    float own[8]; unpack8(own_, own);
    if (!rot) {
#pragma unroll
        for (int j = 0; j < 8; ++j) v[j] = own[j] * scale;
        return; }
    float oth[8]; unpack8(oth_, oth);
    const float cs[8] = {R.c0.x, R.c0.y, R.c0.z, R.c0.w, R.c1.x, R.c1.y, R.c1.z, R.c1.w}, sn[8] = {R.s0.x, R.s0.y, R.s0.z, R.s0.w, R.s1.x, R.s1.y, R.s1.z, R.s1.w};
#pragma unroll
    for (int j = 0; j < 8; ++j) { const float os = oth[j] * sn[j]; v[j] = (own[j] * cs[j] + (hi ? os : -os)) * scale; }
}
__device__ __forceinline__ void lin_decay(Frame& F, int mixer, int h, const LinRaw& R, float (&bcum)[8], float (&blast)[8]) {
    LAS float* TOT = (LAS float*)(F.lds + LN_TOT);
    const int s = F.tid >> 3, c = F.tid & 7, d0 = 8 * c;
    if (mixer == 0) {
        const float lg = __logf(1.0f - exp2f(-5.0f - (float)h));
#pragma unroll
        for (int j = 0; j < 8; ++j) { bcum[j] = (float)(s + 1) * lg; blast[j] = 64.0f * lg; }
        wg_sync();
        return;
    }
    const LAS float* WG = (const LAS float*)(F.lds + LN_WG);
    float grf[16]; { float a[8], b2[8]; unpack8(R.gr0, a); unpack8(R.gr1, b2);
#pragma unroll
        for (int j = 0; j < 8; ++j) { grf[j] = a[j]; grf[8 + j] = b2[j]; } }
    float x[8]; { const f32x4 b0 = *(const LAS f32x4*)(WG + 1024 + d0), b1 = *(const LAS f32x4*)(WG + 1024 + d0 + 4); x[0] = b0.x; x[1] = b0.y; x[2] = b0.z; x[3] = b0.w; x[4] = b1.x; x[5] = b1.y; x[6] = b1.z; x[7] = b1.w; }
#pragma unroll
    for (int r = 0; r < 16; ++r) { const f32x4 w0 = *(const LAS f32x4*)(WG + r * 64 + d0), w1 = *(const LAS f32x4*)(WG + r * 64 + d0 + 4);
        x[0] += grf[r] * w0.x; x[1] += grf[r] * w0.y; x[2] += grf[r] * w0.z; x[3] += grf[r] * w0.w; x[4] += grf[r] * w1.x; x[5] += grf[r] * w1.y; x[6] += grf[r] * w1.z; x[7] += grf[r] * w1.w; }
#pragma unroll
    for (int j = 0; j < 8; ++j) x[j] = logsigmoidf_(x[j]) * (1.0f / 16.0f);
#pragma unroll
    for (int st = 8; st <= 32; st <<= 1) {
#pragma unroll
        for (int j = 0; j < 8; ++j) { const float t = lane_read(x[j], F.lane - st); if (F.lane >= st) x[j] += t; } }
    if ((F.lane >> 3) == 7) { *(LAS f32x4*)(TOT + F.wave * 64 + d0) = (f32x4){x[0], x[1], x[2], x[3]}; *(LAS f32x4*)(TOT + F.wave * 64 + d0 + 4) = (f32x4){x[4], x[5], x[6], x[7]}; }
    wg_sync();
    float off[8], tot[8];
#pragma unroll
    for (int j = 0; j < 8; ++j) { off[j] = 0.f; tot[j] = 0.f; }
#pragma unroll
    for (int w = 0; w < 8; ++w) { const f32x4 t0 = *(const LAS f32x4*)(TOT + w * 64 + d0), t1 = *(const LAS f32x4*)(TOT + w * 64 + d0 + 4); const float tv[8] = {t0.x, t0.y, t0.z, t0.w, t1.x, t1.y, t1.z, t1.w};
#pragma unroll
        for (int j = 0; j < 8; ++j) { tot[j] += tv[j]; off[j] += (w < F.wave) ? tv[j] : 0.f; } }
#pragma unroll
    for (int j = 0; j < 8; ++j) { bcum[j] = x[j] + off[j]; blast[j] = tot[j]; }
}
__device__ __forceinline__ void lin_store_vt(Frame& F, const LinRaw& R) {
    LAS bf16_t* VT = (LAS bf16_t*)(F.lds + LN_VT); const int e0 = (F.tid & 15) * 8;
#pragma unroll
    for (int i = 0; i < 2; ++i) { const int s = 32 * i + (F.tid >> 4); const u32x4 w = i == 0 ? R.v0 : R.v1;
        VT[(e0 + 0) * LP + s] = (bf16_t)(w.x & 0xffffu); VT[(e0 + 1) * LP + s] = (bf16_t)(w.x >> 16); VT[(e0 + 2) * LP + s] = (bf16_t)(w.y & 0xffffu); VT[(e0 + 3) * LP + s] = (bf16_t)(w.y >> 16);
        VT[(e0 + 4) * LP + s] = (bf16_t)(w.z & 0xffffu); VT[(e0 + 5) * LP + s] = (bf16_t)(w.z >> 16); VT[(e0 + 6) * LP + s] = (bf16_t)(w.w & 0xffffu); VT[(e0 + 7) * LP + s] = (bf16_t)(w.w >> 16); }
}
__device__ __forceinline__ void lin_state_compute(Frame& F, int unit, const LinRaw& R) {
    const int h = (unit >> 6) & 3, mixer = unit >> 11; const int s = F.tid >> 3, c = F.tid & 7, d0 = 8 * c;
    LAS bf16_t* KDT = (LAS bf16_t*)(F.lds + LN_KI); LAS bf16_t* VT = (LAS bf16_t*)(F.lds + LN_VT);
    float k[8], bcum[8], blast[8];
    lin_rot(R.k0, R.k1, R, mixer == 0, c >= 4, mixer == 0 ? 0.125f : 1.0f, k);
    lin_decay(F, mixer, h, R, bcum, blast);
#pragma unroll
    for (int j = 0; j < 8; ++j) KDT[(d0 + j) * LP + s] = (bf16_t)f2bf(k[j] * __expf(blast[j] - bcum[j]));
    lin_store_vt(F, R);
    if (s == 0) { float* dc = F.DEC() + (size_t)unit * 64 + d0;
        *(f32x4*)dc = (f32x4){__expf(blast[0]), __expf(blast[1]), __expf(blast[2]), __expf(blast[3])}; *(f32x4*)(dc + 4) = (f32x4){__expf(blast[4]), __expf(blast[5]), __expf(blast[6]), __expf(blast[7])}; }
    wg_sync();
    { const int w = F.wave, lane = F.lane; float* st = F.STATE() + (size_t)unit * 8192;
#pragma unroll
      for (int dt = 0; dt < 4; ++dt) { f32x4 acc = (f32x4){0.f, 0.f, 0.f, 0.f}; acc = mma_nt_lds(VT + 16 * w * LP, LP, KDT + 16 * dt * LP, LP, 2, acc, lane);
#pragma unroll
          for (int i = 0; i < 4; ++i) st[(16 * w + 4 * (lane >> 4) + i) * 64 + 16 * dt + (lane & 15)] = acc[i]; } }
}
__device__ __forceinline__ void lin_out_compute(Frame& F, int unit, const LinRaw& R) {
    const int n = unit & 63, h = (unit >> 6) & 3, b = (unit >> 8) & 7, mixer = unit >> 11;
    const size_t row0 = (size_t)b * SEQ + (size_t)n * CH; const int s = F.tid >> 3, c = F.tid & 7, d0 = 8 * c;
    const int ycol = (mixer == 0 ? 0 : 1024) + h * 128;
    LAS bf16_t* QD = (LAS bf16_t*)(F.lds + LN_QD); LAS bf16_t* KI = (LAS bf16_t*)(F.lds + LN_KI); LAS bf16_t* PM = (LAS bf16_t*)(F.lds + LN_PM);
    LAS bf16_t* VT = (LAS bf16_t*)(F.lds + LN_VT); LAS float* OB = (LAS float*)(F.lds + LN_OB);
    float q[8], k[8], bcum[8], blast[8];
    lin_rot(R.q0, R.q1, R, mixer == 0, c >= 4, mixer == 0 ? 1.0f : 0.125f, q);
    lin_rot(R.k0, R.k1, R, mixer == 0, c >= 4, mixer == 0 ? 0.125f : 1.0f, k);
    lin_decay(F, mixer, h, R, bcum, blast);
    { float qd[8], ki[8];
#pragma unroll
      for (int j = 0; j < 8; ++j) { qd[j] = q[j] * __expf(bcum[j]); ki[j] = k[j] * __expf(-bcum[j]); }
      *(LAS u32x4*)(QD + s * LP + d0) = pack8(qd); *(LAS u32x4*)(KI + s * LP + d0) = pack8(ki); }
    lin_store_vt(F, R);
    wg_sync();
    { const int lane = F.lane;
#pragma unroll
      for (int j = 0; j < 2; ++j) { const int tile = 2 * F.wave + j, tt = tile >> 2, st = tile & 3;
          f32x4 acc = (f32x4){0.f, 0.f, 0.f, 0.f};
          if (st <= tt) acc = mma_nt_lds(QD + 16 * tt * LP, LP, KI + 16 * st * LP, LP, 2, acc, lane);
#pragma unroll
          for (int i = 0; i < 4; ++i) { const int t = 16 * tt + 4 * (lane >> 4) + i, s2 = 16 * st + (lane & 15); const float p = (st <= tt && s2 <= t) ? acc[i] : 0.f; PM[t * LP + s2] = (bf16_t)f2bf(p); } } }
    wg_sync();
    { const int w = F.wave, lane = F.lane;
#pragma unroll
      for (int tt = 0; tt < 4; ++tt) { f32x4 acc = (f32x4){0.f, 0.f, 0.f, 0.f};
          acc = mma_nt_lds(PM + 16 * tt * LP, LP, VT + 16 * w * LP, LP, 2, acc, lane);
          const LAS bf16_t* xp = QD + (16 * tt + (lane & 15)) * LP + 8 * (lane >> 4);
          acc = __builtin_amdgcn_mfma_f32_16x16x32_bf16(*(const LAS bf16x8*)xp, R.sp0, acc, 0, 0, 0);
          acc = __builtin_amdgcn_mfma_f32_16x16x32_bf16(*(const LAS bf16x8*)(xp + 32), R.sp1, acc, 0, 0, 0);
#pragma unroll
          for (int i = 0; i < 4; ++i) OB[(16 * tt + 4 * (lane >> 4) + i) * 132 + 16 * w + (lane & 15)] = acc[i]; } }
    wg_sync();
    { const int t = s, part = c; float o[16];
#pragma unroll
      for (int j = 0; j < 4; ++j) { const f32x4 v = *(const LAS f32x4*)(OB + t * 132 + 16 * part + 4 * j); o[4 * j] = v.x; o[4 * j + 1] = v.y; o[4 * j + 2] = v.z; o[4 * j + 3] = v.w; }
      float sm = 0.f;
#pragma unroll
      for (int j = 0; j < 16; ++j) sm += o[j];
      sm += lane_read(sm, F.lane ^ 1); sm += lane_read(sm, F.lane ^ 2); sm += lane_read(sm, F.lane ^ 4);
      const float mu = sm * (1.0f / 128.0f); float qv = 0.f;
#pragma unroll
      for (int j = 0; j < 16; ++j) { const float dlt = o[j] - mu; qv += dlt * dlt; }
      qv += lane_read(qv, F.lane ^ 1); qv += lane_read(qv, F.lane ^ 2); qv += lane_read(qv, F.lane ^ 4);
      const float r = 1.0f / sqrtf(qv * (1.0f / 128.0f) + EPS);
      float g0[8], g1[8]; unpack8(R.g0, g0); unpack8(R.g1, g1);
      float y0[8], y1[8];
#pragma unroll
      for (int j = 0; j < 8; ++j) { y0[j] = (o[j] - mu) * r * siluf_(g0[j]); y1[j] = (o[8 + j] - mu) * r * siluf_(g1[j]); }
      bf16_t* yp = F.Y() + (row0 + t) * D + ycol + 16 * part; *(u32x4*)yp = pack8(y0); *(u32x4*)(yp + 8) = pack8(y1); }
}
template <bool OUT>
__device__ __forceinline__ void lin_phase(Frame& F, int l) {
    { const int h = (F.vcu >> 6) & 3; LAS float* WG = (LAS float*)(F.lds + LN_WG);
      for (int i = F.tid; i < 16 * 64 + 64; i += NWAVES * 64) WG[i] = (i < 1024) ? F.gla_wg()[(size_t)l * 16 * 256 + (i >> 6) * 256 + h * 64 + (i & 63)] : F.gla_bg()[l * 256 + h * 64 + (i - 1024)];
      wg_sync(); }
    LinRaw A, B;
    lin_issue<OUT>(F, F.vcu, A);
    for (int u = F.vcu; u < 4096; u += 2 * F.G) {
        lin_issue<OUT>(F, u + F.G, B);
        if (OUT) lin_out_compute(F, u, A); else lin_state_compute(F, u, A);
        if (u + 2 * F.G < 4096) lin_issue<OUT>(F, u + 2 * F.G, A);
        if (OUT) lin_out_compute(F, u + F.G, B); else lin_state_compute(F, u + F.G, B);
    }
    wg_sync();
}
__device__ __forceinline__ void lin_scan(Frame& F) {
    const int gt = F.vcu * (NWAVES * 64) + F.tid, NGT = F.G * NWAVES * 64;
    for (int i = gt; i < 64 * 8192; i += NGT) {
        const int seq = i >> 13, idx = i & 8191, d = idx & 63;
        const float* st = F.STATE() + (size_t)seq * NCH * 8192 + idx; const float* dc = F.DEC() + (size_t)seq * NCH * 64 + d; bf16_t* sp = F.SPREV() + (size_t)seq * NCH * 8192 + idx;
        float carry = 0.f; asm volatile("" : "+v"(carry));
#pragma unroll
        for (int h = 0; h < 2; ++h) {
            float v[32], c[32];
#pragma unroll
            for (int n = 0; n < 32; ++n) { v[n] = st[(size_t)(32 * h + n) * 8192]; c[n] = dc[(size_t)(32 * h + n) * 64]; }
#pragma unroll
            for (int n = 0; n < 32; ++n) { sp[(size_t)(32 * h + n) * 8192] = (bf16_t)f2bf(carry); carry = c[n] * carry + v[n]; asm volatile("" : "+v"(carry)); }
        }
    }
}
constexpr int S5_WL = 16384, S5_BU = 2048, S5_X = 2048 + 8320;
template <bool OUT>
__device__ __forceinline__ void s5_pass(Frame& F, int l) {
    LAS bf16_t* UT = (LAS bf16_t*)(F.lds + F.wave * S5_WL); LAS float* BU = (LAS float*)(F.lds + F.wave * S5_WL + S5_BU); LAS bf16_t* X = (LAS bf16_t*)(F.lds + F.wave * S5_WL + S5_X);
    const int gw = F.vcu * NWAVES + F.wave, NGW = F.G * NWAVES, lane = F.lane, lr = lane & 15, lq = lane >> 4;
    u32x4 ua, uc;
    { const int g = gw & 31, n = (gw >> 5) & 63, b = gw >> 11; const bf16_t* up = F.PROJ() + ((size_t)b * SEQ + (size_t)n * CH + lane) * NIN + C_SU + g * 16; ua = *(const u32x4*)up; uc = *(const u32x4*)(up + 8); }
    for (int unit = gw; unit < BATCH * NCH * 32; unit += NGW) {
        const int g = unit & 31, n = (unit >> 5) & 63, b = unit >> 11; const size_t row0 = (size_t)b * SEQ + (size_t)n * CH;
        *(LAS u32x4*)(UT + lane * 16) = ua; *(LAS u32x4*)(UT + lane * 16 + 8) = uc;
        if (unit + NGW < BATCH * NCH * 32) { const int un = unit + NGW, g2 = un & 31, n2 = (un >> 5) & 63, b2 = un >> 11;
            const bf16_t* up = F.PROJ() + ((size_t)b2 * SEQ + (size_t)n2 * CH + lane) * NIN + C_SU + g2 * 16; ua = *(const u32x4*)up; uc = *(const u32x4*)(up + 8); }
        const int gp = g * 64 + lane; const float ar = F.abar()[2 * gp], ai = F.abar()[2 * gp + 1];
        bf16x8 bfr[8];
#pragma unroll
        for (int q = 0; q < 8; ++q) { bfr[q] = (bf16x8){0, 0, 0, 0, 0, 0, 0, 0}; if (lq < 2) bfr[q] = *(const bf16x8*)(F.bbt() + ((size_t)g * 128 + 16 * q + lr) * 16 + 8 * lq); }
        float xr = 0.f, xi = 0.f;
        bf16x8 cf[4]; float dsk = 0.f;
        if (OUT) { const f32x2 x0 = *(const f32x2*)(F.XEND() + ((((size_t)(b * 32 + g)) * NCH + n) * 64 + lane) * 2); xr = x0.x; xi = x0.y;
#pragma unroll
            for (int ks = 0; ks < 4; ++ks) cf[ks] = *(const bf16x8*)(F.cmt() + ((size_t)(g * 16 + lr)) * 128 + 32 * ks + 8 * lq);
            dsk = F.s5_d()[(size_t)l * BW + g * 16 + lr]; }
        LDS_WAIT();
        for (int sb = 0; sb < 4; ++sb) {
            bf16x8 af = (bf16x8){0, 0, 0, 0, 0, 0, 0, 0}; if (lq < 2) af = *(const LAS bf16x8*)(UT + (16 * sb + lr) * 16 + 8 * lq);
#pragma unroll
            for (int q = 0; q < 8; ++q) { f32x4 acc = (f32x4){0.f, 0.f, 0.f, 0.f}; acc = __builtin_amdgcn_mfma_f32_16x16x32_bf16(af, bfr[q], acc, 0, 0, 0);
#pragma unroll
                for (int i = 0; i < 4; ++i) BU[(4 * lq + i) * 130 + 16 * q + lr] = acc[i]; }
            LDS_WAIT();
            float br[16], bi[16];
#pragma unroll
            for (int tt = 0; tt < 16; ++tt) { br[tt] = BU[tt * 130 + lane]; bi[tt] = BU[tt * 130 + 64 + lane]; }
#pragma unroll
            for (int tt = 0; tt < 16; ++tt) { const float nr = ar * xr - ai * xi + br[tt], ni = ar * xi + ai * xr + bi[tt]; xr = nr; xi = ni; asm volatile("" : "+v"(xr), "+v"(xi));
                if (OUT) { X[tt * 136 + lane] = (bf16_t)f2bf(xr); X[tt * 136 + 64 + lane] = (bf16_t)f2bf(xi); } }
            if (OUT) {
                LDS_WAIT();
                f32x4 acc = (f32x4){0.f, 0.f, 0.f, 0.f}; const LAS bf16_t* xp = X + lr * 136 + 8 * lq;
#pragma unroll
                for (int ks = 0; ks < 4; ++ks) acc = __builtin_amdgcn_mfma_f32_16x16x32_bf16(*(const LAS bf16x8*)(xp + 32 * ks), cf[ks], acc, 0, 0, 0);
#pragma unroll
                for (int i = 0; i < 4; ++i) { const int tl = 16 * sb + 4 * lq + i; const float u = bflo((unsigned)UT[tl * 16 + lr]); const float y = gelu_tanh(acc[i] + dsk * u);
                    F.YBP()[(row0 + tl) * BW + g * 16 + lr] = (bf16_t)f2bf(y); }
            }
            LDS_WAIT();
        }
        if (!OUT) *(f32x2*)(F.XEND() + ((((size_t)(b * 32 + g)) * NCH + n) * 64 + lane) * 2) = (f32x2){xr, xi};
    }
}
__device__ __forceinline__ void s5_scan(Frame& F) {
    const int gt = F.vcu * (NWAVES * 64) + F.tid, NGT = F.G * NWAVES * 64;
    for (int i = gt; i < BATCH * 32 * 64; i += NGT) {
        const int p = i & 63, bg = i >> 6, g = bg & 31; const float pr = F.apow()[2 * (g * 64 + p)], pi = F.apow()[2 * (g * 64 + p) + 1];
        f32x2* xp = (f32x2*)(F.XEND() + (((size_t)bg * NCH) * 64 + p) * 2);
        float cr = 0.f, ci = 0.f; asm volatile("" : "+v"(cr), "+v"(ci));
#pragma unroll
        for (int h = 0; h < 2; ++h) {
            f32x2 v[32];
#pragma unroll
            for (int n = 0; n < 32; ++n) v[n] = xp[(size_t)(32 * h + n) * 64];
#pragma unroll
            for (int n = 0; n < 32; ++n) { xp[(size_t)(32 * h + n) * 64] = (f32x2){cr, ci};
                const float nr = pr * cr - pi * ci + v[n].x, ni = pr * ci + pi * cr + v[n].y; cr = nr; ci = ni; asm volatile("" : "+v"(cr), "+v"(ci)); }
        }
    }
}

__device__ __forceinline__ void pool_phase(Frame& F, int l) {
    const int gw = F.vcu * NWAVES + F.wave, NGW = F.G * NWAVES, lane = F.lane, lr = lane & 15, lq = lane >> 4;
    for (int unit = gw; unit < BATCH * (SEQ / 16) * 4; unit += NGW) {
        const int g = unit & 3, tile = (unit >> 2) & 255, b = unit >> 10; const int win = 2 << g, tpos = 16 * tile + lr; const size_t row = (size_t)b * SEQ + tpos;
        const bf16_t* pp = F.PROJ() + row * NIN + C_PU + g * 128 + 8 * lq;
        float s[4][8];
#pragma unroll
        for (int ks = 0; ks < 4; ++ks)
#pragma unroll
            for (int j = 0; j < 8; ++j) s[ks][j] = 0.f;
        for (int jj = 1; jj < win; ++jj) { if (tpos - jj >= 0) {
#pragma unroll
            for (int ks = 0; ks < 4; ++ks) { float a[8]; unpack8(*(const u32x4*)(pp - (size_t)jj * NIN + 32 * ks), a);
#pragma unroll
                for (int j = 0; j < 8; ++j) s[ks][j] += a[j]; } } }
        const float inv = 1.0f / (float)min(tpos + 1, win);
        bf16x8 mf[4];
#pragma unroll
        for (int ks = 0; ks < 4; ++ks) { float a[8], m[8]; unpack8(*(const u32x4*)(pp + 32 * ks), a);
#pragma unroll
            for (int j = 0; j < 8; ++j) m[j] = (s[ks][j] + a[j]) * inv - a[j];
            const u32x4 w = pack8(m); mf[ks] = __builtin_bit_cast(bf16x8, w); }
        const bf16_t* pw = F.poolw_t() + (size_t)g * 128 * 128 + (size_t)lr * 128 + 8 * lq;
#pragma unroll
        for (int q = 0; q < 8; ++q) { f32x4 acc = (f32x4){0.f, 0.f, 0.f, 0.f};
#pragma unroll
            for (int ks = 0; ks < 4; ++ks) acc = __builtin_amdgcn_mfma_f32_16x16x32_bf16(*(const bf16x8*)(pw + (size_t)(16 * q) * 128 + 32 * ks), mf[ks], acc, 0, 0, 0);
            const int dcol = g * 128 + 16 * q + 4 * lq; const f32x4 sc = *(const f32x4*)(F.pool_scale() + (size_t)l * BW + dcol);
            u32x2 w; w.x = pk2(acc[0] * sc.x, acc[1] * sc.y); w.y = pk2(acc[2] * sc.z, acc[3] * sc.w);
            *(u32x2*)(F.Y() + row * D + 1536 + dcol) = w; }
    }
}

__device__ __forceinline__ void conv_fix_phase(Frame& F, int l) {
    const float* cw = F.conv_w() + (size_t)l * 3 * NUP; const float* cb = F.conv_b() + (size_t)l * NUP; const float* UH = F.UH();
    const int gt = F.vcu * (NWAVES * 64) + F.tid, NGT = F.G * NWAVES * 64;
    constexpr int JG = DFF / 4;
    for (int task = gt; task < (M / 256) * 2 * JG; task += NGT) {
        const int jg = task % JG, q = (task / JG) & 1, pm = task / (2 * JG);
        if ((pm & 15) == 0) continue;
        const int j0 = jg * 4, ucol = 256 * (j0 >> 7) + (j0 & 127);
        const float* u0p = UH + ((size_t)pm * 4 + q) * NUP + ucol;
        const float* u1p = (q == 1) ? UH + ((size_t)pm * 4 + 0) * NUP + ucol : UH + ((size_t)(pm - 1) * 4 + 3) * NUP + ucol;
        const float* u2p = (q == 1) ? UH + ((size_t)(pm - 1) * 4 + 3) * NUP + ucol : UH + ((size_t)(pm - 1) * 4 + 2) * NUP + ucol;
        const f32x4 a0 = *(const f32x4*)u0p, a1 = *(const f32x4*)u1p, a2 = *(const f32x4*)u2p, v0 = *(const f32x4*)(u0p + 128), v1 = *(const f32x4*)(u1p + 128), v2 = *(const f32x4*)(u2p + 128);
        const f32x4 wa0 = *(const f32x4*)(cw + j0), wa1 = *(const f32x4*)(cw + NUP + j0), wa2 = *(const f32x4*)(cw + 2 * NUP + j0), ba = *(const f32x4*)(cb + j0);
        const f32x4 wv0 = *(const f32x4*)(cw + DFF + j0), wv1 = *(const f32x4*)(cw + NUP + DFF + j0), wv2 = *(const f32x4*)(cw + 2 * NUP + DFF + j0), bv = *(const f32x4*)(cb + DFF + j0);
        float o[4];
#pragma unroll
        for (int i = 0; i < 4; ++i) { const float ca = ba[i] + wa0[i] * a2[i] + wa1[i] * a1[i] + wa2[i] * a0[i], cv = bv[i] + wv0[i] * v2[i] + wv1[i] * v1[i] + wv2[i] * v0[i]; o[i] = siluf_(ca) * cv; }
        u32x2 w; w.x = pk2(o[0], o[1]); w.y = pk2(o[2], o[3]);
        *(u32x2*)(F.ACT() + ((size_t)pm * 256 + q) * DFF + j0) = w;
    }
}

constexpr int NPH = 13;
struct Args { const void* in[25]; float* out; unsigned char* ws; int l_lo, l_hi, ph_lo, ph_hi, single, pad; };
__global__ void __launch_bounds__(NWAVES * 64, 2) hybrid_fwd(Args args) {
    extern __shared__ __attribute__((aligned(16))) unsigned char lds[];
    Frame F;
    F.lds = (LAS unsigned char*)lds;
    F.tid = threadIdx.x; F.lane = F.tid & 63; F.wave = __builtin_amdgcn_readfirstlane(F.tid >> 6);
    const int wave0 = F.wave;
    F.G = gridDim.x; { const int bx = blockIdx.x; F.vcu = (F.G % 8 == 0) ? (bx % 8) * (F.G / 8) + bx / 8 : bx; }
    unsigned char* ws = args.ws; F.ws = ws; F.out = args.out; F.l = 0;

    volatile LAS unsigned* MISC = (volatile LAS unsigned*)(F.lds + MISC_OFF);
    if (F.tid < 64) MISC[F.tid] = 0u;
    wg_sync();
    unsigned* ctl = (unsigned*)(ws + WS_CTL);
    XcdBarrier bar; bar.bar = ctl + CW_BAR; bar.x = 0; bar.st = nullptr;
    if (args.single) bar = xcd_barrier_post(ctl + CW_BAR, MISC);
#define GRID_BAR() do { if (args.single) xcd_barrier(bar); } while (0)
    const int lo = args.ph_lo, hi = args.ph_hi;
#define IN(k) (lo <= (k) && (k) < hi)
#define PH_BEGIN() do { unsigned z_ = 0u; asm volatile("" : "+v"(z_)); const int ln_ = (int)__builtin_amdgcn_mbcnt_hi(~0u, __builtin_amdgcn_mbcnt_lo(~0u, z_)); F.lane = ln_; F.tid = wave0 * 64 + ln_; F.wave = wave0; unsigned long long w_ = (unsigned long long)args.ws, o_ = (unsigned long long)args.out; asm volatile("" : "+s"(w_), "+s"(o_)); F.ws = (unsigned char*)(GAS unsigned char*)w_; F.out = (float*)(GAS float*)o_; } while (0)

    for (int l = args.l_lo; l < args.l_hi; ++l) {
        const float* hsrc = (l == 0) ? F.x() : F.out;
        F.l = l;
        if (IN(0)) { PH_BEGIN(); phase_prep(F, l); GRID_BAR(); }
        if (IN(1)) { PH_BEGIN(); pg8::Gemm g{F.HN(), F.win_t(), M, NIN, D, D, D}; pg8::StaticOrder S; S.init(M, NIN, F.G, (int)blockIdx.x); pg8::EpiProj E{F.PROJ(), NIN, C_GATE / 256, C_GATE};
            pg8::gemm_phase(F.lds, g, S, E, F.tid); GRID_BAR(); }
        if (IN(2)) { PH_BEGIN(); lin_phase<false>(F, l); PH_BEGIN();
            s5_pass<false>(F, l); pool_phase(F, l); wg_sync();
            GRID_BAR(); }
        if (IN(3)) { PH_BEGIN(); lin_scan(F); s5_scan(F); GRID_BAR(); }
        if (IN(4)) { PH_BEGIN(); lin_phase<true>(F, l); PH_BEGIN();
            s5_pass<true>(F, l); wg_sync();
            GRID_BAR(); }
        if (IN(5)) { PH_BEGIN(); pg8::Gemm g{F.YBP(), F.wglu_t(), M, BW, BW, BW, BW}; pg8::StaticOrder S; S.init(M, BW, F.G, (int)blockIdx.x); pg8::EpiGlu E{F.YBP(), BW, F.Y() + BW, D};
            pg8::gemm_phase(F.lds, g, S, E, F.tid); GRID_BAR(); }
        if (IN(6)) { PH_BEGIN(); pg8::Gemm g{F.Y(), F.wbr_t(), M, D, D, D, D}; pg8::StaticOrder S; S.init(M, D, F.G, (int)blockIdx.x); pg8::EpiMerge E{F.PROJ() + C_GATE, NIN, F.HN(), D};
            pg8::gemm_phase(F.lds, g, S, E, F.tid); GRID_BAR(); }
        if (IN(7)) { PH_BEGIN(); pg8::Gemm g{F.HN(), F.wout_t(), M, D, D, D, D}; pg8::StaticOrder S; S.init(M, D, F.G, (int)blockIdx.x); pg8::EpiResid E{hsrc, F.out, D, F.Y(), F.SS()};
            pg8::gemm_phase(F.lds, g, S, E, F.tid); GRID_BAR(); }
        if (IN(8)) { PH_BEGIN(); row_scale(F); GRID_BAR(); }
        if (IN(9)) { PH_BEGIN(); pg8::Gemm g{F.Y(), F.wup_t(), M, NUP, D, D, D}; pg8::StaticOrder S; S.init(M, NUP, F.G, (int)blockIdx.x); pg8::EpiConv E{F.conv_w() + (size_t)l * 3 * NUP, F.conv_b() + (size_t)l * NUP, F.ACT(), F.UH(), (LAS float*)(F.lds + pg8::STAGE_BYTES), F.RS()};
            pg8::gemm_phase(F.lds, g, S, E, F.tid); GRID_BAR(); }
        if (IN(10)) { PH_BEGIN(); conv_fix_phase(F, l); GRID_BAR(); }
        if (IN(11)) { PH_BEGIN(); pg8::Gemm g{F.ACT(), F.wdn_t(), M, D, DFF, DFF, DFF}; pg8::StaticOrder S; S.init(M, D, F.G, (int)blockIdx.x); pg8::EpiResid E{F.out, F.out, D, nullptr, nullptr};
            pg8::gemm_phase(F.lds, g, S, E, F.tid); GRID_BAR(); }
        if (IN(12) && l == DEPTH - 1) { PH_BEGIN(); rms_rows_f32_inplace(F, F.out, F.g_final()); }
    }
#undef IN
#undef PH_BEGIN
#undef GRID_BAR
}

#pragma clang attribute pop
extern "C" void kernel_launch(void* const* d_in, const int* in_sizes, int n_in, void* d_out, int out_size, void* d_ws, size_t ws_size, hipStream_t stream) {
    static int grid = 0;
    if (grid == 0) {
        if (n_in != 25 || in_sizes[0] != M * D || out_size != M * D || ws_size < WS_END) { fprintf(stderr, "kernel_launch: shape/workspace mismatch (n_in %d, in0 %d, out %d, ws %zu, need %zu); nothing launched\n", n_in, n_in > 0 ? in_sizes[0] : -1, out_size, ws_size, (size_t)WS_END); grid = -1; return; }
        int dev = 0, cus = 0, per_cu = 0;
        if (hipGetDevice(&dev) != hipSuccess || hipDeviceGetAttribute(&cus, hipDeviceAttributeMultiprocessorCount, dev) != hipSuccess) { grid = -1; return; }
        if (hipFuncSetAttribute((const void*)hybrid_fwd, hipFuncAttributeMaxDynamicSharedMemorySize, LDS_BYTES) != hipSuccess) { fprintf(stderr, "kernel_launch: hipFuncSetAttribute failed\n"); grid = -1; return; }
        if (hipOccupancyMaxActiveBlocksPerMultiprocessor(&per_cu, (const void*)hybrid_fwd, NWAVES * 64, LDS_BYTES) != hipSuccess || per_cu < 1) { fprintf(stderr, "kernel_launch: occupancy query reports %d workgroups per CU\n", per_cu); }
        (void)hipGetLastError();
        grid = cus;
    }
    if (grid < 0) return;
    if (hipMemsetAsync((char*)d_ws + WS_CTL, 0, CTL_ZERO_BYTES, stream) != hipSuccess) return;
    Args a{};
    for (int i = 0; i < 25; ++i) a.in[i] = d_in[i];
    a.out = (float*)d_out; a.ws = (unsigned char*)d_ws;
#if MK_SINGLE
    a.l_lo = 0; a.l_hi = DEPTH; a.ph_lo = 0; a.ph_hi = NPH; a.single = 1;
    hipLaunchKernelGGL(hybrid_fwd, dim3(grid), dim3(NWAVES * 64), LDS_BYTES, stream, a);
#else
    a.single = 0;
    for (int l = 0; l < DEPTH; ++l)
        for (int p = 0; p < NPH; ++p) { if (p == 12 && l != DEPTH - 1) continue; a.l_lo = l; a.l_hi = l + 1; a.ph_lo = p; a.ph_hi = p + 1;
            hipLaunchKernelGGL(hybrid_fwd, dim3(grid), dim3(NWAVES * 64), LDS_BYTES, stream, a); }
#endif
}
```

```cpp
#include <hip/hip_runtime.h>
#include <cstdio>
#include <cstdint>

#ifndef MK_SINGLE
#define MK_SINGLE 1
#endif

#pragma clang attribute push(__attribute__((target("no-packed-fp32-ops"))), apply_to = function)
#define LAS __attribute__((address_space(3)))
#define GAS __attribute__((address_space(1)))
typedef unsigned short bf16_t;
typedef short bf16x8 __attribute__((ext_vector_type(8)));
typedef float f32x4 __attribute__((ext_vector_type(4)));
typedef float f32x2 __attribute__((ext_vector_type(2)));
typedef unsigned u32x4 __attribute__((ext_vector_type(4)));
typedef unsigned u32x2 __attribute__((ext_vector_type(2)));

constexpr int D = 2048, BATCH = 8, SEQ = 4096, DEPTH = 4, M = BATCH * SEQ;
constexpr int BW = 512;
constexpr int NIN_SRC = 12304, NIN = 12544;
constexpr int DFF = 5504, NUP = 11008;
constexpr int C_RQ = 0, C_RK = 256, C_RV = 512, C_RG = 1024, C_SU = 1536, C_GQ = 2048, C_GK = 2304, C_GV = 2560, C_GG = 3072, C_PU = 3584, C_GR = 4096, C_GATE = 4352;
constexpr float EPS = 1e-6f;
constexpr int NWAVES = 8;
constexpr int CH = 64;
constexpr int NCH = SEQ / CH;

constexpr size_t MiB = 1u << 20;
constexpr size_t WS_CTL = 0, CTL_ZERO_BYTES = 1 * MiB;
constexpr size_t WS_ROT = 1 * MiB;
constexpr size_t WS_S5T = 9 * MiB;
constexpr size_t S5T_ABAR = 0, S5T_APOW = 16384, S5T_BBAR = 32768, S5T_CMT = 32768 + 262144, S5T_BBT = S5T_CMT + 131072;
constexpr size_t WS_WGLU = 10 * MiB;
constexpr size_t WS_POOLW = 10 * MiB + 512 * 1024;
constexpr size_t WS_WIN = 11 * MiB;
constexpr size_t WS_WBR = 60 * MiB;
constexpr size_t WS_WOUT = 68 * MiB;
constexpr size_t WS_WUP = 76 * MiB;
constexpr size_t WS_WDN = 119 * MiB;
constexpr size_t WS_HN = 141 * MiB;
constexpr size_t WS_Y = 269 * MiB;
constexpr size_t WS_SCR = 397 * MiB;
constexpr size_t WS_YBP = WS_SCR;
constexpr size_t WS_STATE = WS_SCR + 32 * MiB;
constexpr size_t WS_SPREV = WS_SCR + 160 * MiB;
constexpr size_t WS_DEC = WS_SCR + 224 * MiB;
constexpr size_t WS_XEND = WS_SCR + 225 * MiB;
constexpr size_t WS_UH = WS_SCR + 128 * MiB;
constexpr size_t WS_PROJ = 637 * MiB;
constexpr size_t WS_ACT = WS_PROJ;
constexpr size_t WS_RS = 1421 * MiB;
constexpr size_t WS_SS = 1422 * MiB;
constexpr size_t WS_HN8 = 1438 * MiB;
constexpr size_t WS_W8 = 1502 * MiB;
constexpr size_t WS_END = 1518 * MiB;
static_assert(WS_PROJ + (size_t)M * NIN * 2 <= WS_RS, "ws map");
static_assert(WS_ACT + (size_t)M * DFF * 2 <= WS_RS, "ws map");
static_assert(WS_XEND + 8 * MiB <= WS_PROJ, "ws map");
static_assert(WS_UH + (size_t)(M / 256) * 4 * NUP * 4 <= WS_PROJ, "ws map");
constexpr int CW_TMO = 0, CW_BAR = 4096;

constexpr int LDS_BYTES = 155648;
constexpr int MISC_OFF = LDS_BYTES - 256;

#define RLX_AGENT __ATOMIC_RELAXED, __HIP_MEMORY_SCOPE_AGENT
__device__ __forceinline__ void wg_sync() { __builtin_amdgcn_fence(__ATOMIC_RELEASE, "workgroup"); __builtin_amdgcn_s_barrier(); __builtin_amdgcn_fence(__ATOMIC_ACQUIRE, "workgroup"); }
#define LDS_WAIT() asm volatile("s_waitcnt lgkmcnt(0)" ::: "memory")
#define VM_WAIT() asm volatile("s_waitcnt vmcnt(0)" ::: "memory")
__device__ __forceinline__ unsigned f2bf(float f) { unsigned u = __builtin_bit_cast(unsigned, f); return (u + 0x7fffu + ((u >> 16) & 1u)) >> 16; }
__device__ __forceinline__ unsigned pk2(float lo, float hi) { return f2bf(lo) | (f2bf(hi) << 16); }
__device__ __forceinline__ float bflo(unsigned w) { return __builtin_bit_cast(float, w << 16); }
__device__ __forceinline__ float bfhi(unsigned w) { return __builtin_bit_cast(float, w & 0xffff0000u); }
__device__ __forceinline__ void unpack8(const u32x4 w, float (&v)[8]) { v[0] = bflo(w.x); v[1] = bfhi(w.x); v[2] = bflo(w.y); v[3] = bfhi(w.y); v[4] = bflo(w.z); v[5] = bfhi(w.z); v[6] = bflo(w.w); v[7] = bfhi(w.w); }
__device__ __forceinline__ u32x4 pack8(const float (&v)[8]) { u32x4 w; w.x = pk2(v[0], v[1]); w.y = pk2(v[2], v[3]); w.z = pk2(v[4], v[5]); w.w = pk2(v[6], v[7]); return w; }
__device__ __forceinline__ unsigned pk4_fp8(float a, float b, float c, float d) { unsigned w = 0u; w = __builtin_amdgcn_cvt_pk_fp8_f32(a, b, w, false); w = __builtin_amdgcn_cvt_pk_fp8_f32(c, d, w, true); return w; }
__device__ __forceinline__ float sigmoidf_(float x) { return 1.0f / (1.0f + __expf(-x)); }
__device__ __forceinline__ float siluf_(float x) { return x / (1.0f + __expf(-x)); }
__device__ __forceinline__ float gelu_tanh(float x) { const float u = 1.5957691216f * (x + 0.044715f * x * x * x); return x / (1.0f + __expf(-u)); }
__device__ __forceinline__ float logsigmoidf_(float x) { return fminf(x, 0.f) - __logf(1.0f + __expf(-fabsf(x))); }

namespace pg8 {
constexpr int BM = 256, BK = 64, HALF = 128, HTB = HALF * BK * 2, STAGE_BYTES = 8 * HTB, NXCD = 8, WGM = 8;
__host__ __device__ __forceinline__ int lds_byte(int r, int c) { const int st = (r >> 4) * 2 + (c >> 5), rr = r & 15, cc = c & 31, ob = rr * 64 + cc * 2; return st * 1024 + (ob ^ (((ob >> 9) & 1) << 5)); }
__host__ __device__ __forceinline__ void stage_rc(int b, int& R, int& C) { const int st = b / 1024, sb = b % 1024, swz = sb ^ (((sb >> 9) & 1) << 5); R = (st >> 1) * 16 + swz / 64; C = (st & 1) * 32 + (swz % 64) / 2; }
__host__ __device__ __forceinline__ int perm32(int rho) { const int n = rho >> 4, i = rho & 15; return 8 * (i >> 2) + 4 * n + (i & 3); }

struct Unit { int pm, pn; };
struct Gemm { const bf16_t* A; const bf16_t* Bt; int M, N, K, lda, ldb; };

struct StaticOrder {
    int nM, nN, nwg, G, c;
    __host__ __device__ void init(int M_, int N_, int G_, int c_) { nM = M_ / BM; nN = N_ / BM; nwg = nM * nN; G = G_; c = c_; }
    __host__ __device__ bool next(int i, Unit& u) const {
        const long L = (long)i * G + c; if (L >= nwg) return false;
        int wgid = (int)L; { const int q = nwg / NXCD, r = nwg % NXCD, xcd = wgid % NXCD, off = wgid / NXCD; wgid = (xcd < r ? xcd * (q + 1) : r * (q + 1) + (xcd - r) * q) + off; }
        const int nig = WGM * nN, gid = wgid / nig, fm = gid * WGM, gsz = (nM - fm) < WGM ? (nM - fm) : WGM;
        u.pm = fm + ((wgid % nig) % gsz); u.pn = (wgid % nig) / gsz; return true;
    }
};

__device__ __forceinline__ unsigned cvt_pk_bf16(float lo, float hi) { unsigned r; asm volatile("v_cvt_pk_bf16_f32 %0, %1, %2" : "=v"(r) : "v"(lo), "v"(hi)); return r; }

struct EpiStoreBf16 {
    static constexpr bool PERM = true, KHOOK = false;
    bf16_t* O; int ldc;
    __device__ __forceinline__ void khook(f32x4 (&)[2][2][4][2], const Unit&, int, int, int, int, int) const {}
    __device__ __forceinline__ void operator()(f32x4 (&acc)[2][2][4][2], const Unit& u, int wr, int wc, int fr, int fq) const {
        const int row0 = u.pm * BM + wr * 64 + fr, col0 = u.pn * BM + wc * 32 + 8 * fq;
#pragma unroll
        for (int ai = 0; ai < 2; ++ai)
#pragma unroll
            for (int m = 0; m < 4; ++m) { bf16_t* rowp = O + (size_t)(row0 + ai * HALF + m * 16) * ldc + col0;
#pragma unroll
                for (int bj = 0; bj < 2; ++bj) { const f32x4 v0 = acc[ai][bj][m][0], v1 = acc[ai][bj][m][1];
                    u32x4 w; w.x = cvt_pk_bf16(v0[0], v0[1]); w.y = cvt_pk_bf16(v0[2], v0[3]); w.z = cvt_pk_bf16(v1[0], v1[1]); w.w = cvt_pk_bf16(v1[2], v1[3]);
                    *(u32x4*)(rowp + bj * HALF) = w; } }
    }
};
struct EpiProj {
    static constexpr bool PERM = true, KHOOK = false;
    bf16_t* O; int ldc; int gate_pn0; int gate_col0; float gscale;
    __device__ __forceinline__ void khook(f32x4 (&)[2][2][4][2], const Unit&, int, int, int, int, int) const {}
    __device__ __forceinline__ void operator()(f32x4 (&acc)[2][2][4][2], const Unit& u, int wr, int wc, int fr_, int fq_) const {
        int fr = fr_, fq = fq_; asm volatile("" : "+v"(fr), "+v"(fq));
        const int row0 = u.pm * BM + wr * 64 + fr;
        if (u.pn < gate_pn0) {
            const int col0 = u.pn * BM + wc * 32 + 8 * fq;
#pragma unroll
            for (int ai = 0; ai < 2; ++ai)
#pragma unroll
                for (int m = 0; m < 4; ++m) { bf16_t* rowp = O + (size_t)(row0 + ai * HALF + m * 16) * ldc + col0;
#pragma unroll
                    for (int bj = 0; bj < 2; ++bj) { const f32x4 v0 = acc[ai][bj][m][0], v1 = acc[ai][bj][m][1];
                        u32x4 w; w.x = cvt_pk_bf16(v0[0], v0[1]); w.y = cvt_pk_bf16(v0[2], v0[3]); w.z = cvt_pk_bf16(v1[0], v1[1]); w.w = cvt_pk_bf16(v1[2], v1[3]);
                        *(u32x4*)(rowp + bj * HALF) = w; } }
        } else {
            const int col0 = gate_col0 + 64 * (u.pn - gate_pn0) + 16 * wc + 4 * fq;
#pragma unroll
            for (int ai = 0; ai < 2; ++ai)
#pragma unroll
                for (int m = 0; m < 4; ++m) { bf16_t* rowp = O + (size_t)(row0 + ai * HALF + m * 16) * ldc + col0;
                    float r1[4], r2[4], r3[4], g3[4];
#pragma unroll
                    for (int i = 0; i < 4; ++i) {
                        const float e0 = __expf(-fminf(fmaxf(acc[ai][0][m][0][i] * gscale, -30.f), 30.f)), e1 = __expf(-fminf(fmaxf(acc[ai][0][m][1][i] * gscale, -30.f), 30.f));
                        const float e2 = __expf(-fminf(fmaxf(acc[ai][1][m][0][i] * gscale, -30.f), 30.f)), e3 = __expf(-fminf(fmaxf(acc[ai][1][m][1][i] * gscale, -30.f), 30.f));
                        const float i0 = __builtin_amdgcn_rcpf(1.f + e0), i1 = __builtin_amdgcn_rcpf(1.f + e1), i2 = __builtin_amdgcn_rcpf(1.f + e2), i3 = __builtin_amdgcn_rcpf(1.f + e3);
                        r1[i] = (1.f + e1) * i0; r2[i] = (1.f + e2) * i1; r3[i] = (1.f + e3) * i2; g3[i] = i3; }
                    u32x2 w;
                    w.x = cvt_pk_bf16(r1[0], r1[1]); w.y = cvt_pk_bf16(r1[2], r1[3]); *(u32x2*)(rowp) = w;
                    w.x = cvt_pk_bf16(r2[0], r2[1]); w.y = cvt_pk_bf16(r2[2], r2[3]); *(u32x2*)(rowp + D) = w;
                    w.x = cvt_pk_bf16(r3[0], r3[1]); w.y = cvt_pk_bf16(r3[2], r3[3]); *(u32x2*)(rowp + 2 * D) = w;
                    w.x = cvt_pk_bf16(g3[0], g3[1]); w.y = cvt_pk_bf16(g3[2], g3[3]); *(u32x2*)(rowp + 3 * D) = w; }
        }
    }
};
__device__ __forceinline__ float dpp_ror1(float x) { return __builtin_bit_cast(float, __builtin_amdgcn_update_dpp(0, __builtin_bit_cast(int, x), 0x121, 0xf, 0xf, false)); }
__device__ __forceinline__ float dpp_ror2(float x) { return __builtin_bit_cast(float, __builtin_amdgcn_update_dpp(0, __builtin_bit_cast(int, x), 0x122, 0xf, 0xf, false)); }
struct EpiConv {
    static constexpr bool PERM = true, KHOOK = false;
    const float* cw; const float* cb; bf16_t* O; float* UH; LAS float* halo; const float* RS;
    __device__ __forceinline__ void khook(f32x4 (&)[2][2][4][2], const Unit&, int, int, int, int, int) const {}
    __device__ __forceinline__ void operator()(f32x4 (&acc)[2][2][4][2], const Unit& u, int wr, int wc, int fr_, int fq_) const {
        int fr = fr_, fq = fq_; asm volatile("" : "+v"(fr), "+v"(fq));
        const int cl0 = wc * 32 + 8 * fq;
#pragma unroll
        for (int ai = 0; ai < 2; ++ai)
#pragma unroll
            for (int m = 0; m < 4; ++m) { const float r = RS[u.pm * BM + ai * HALF + wr * 64 + m * 16 + fr];
#pragma unroll
                for (int bj = 0; bj < 2; ++bj)
#pragma unroll
                    for (int n = 0; n < 2; ++n) acc[ai][bj][m][n] *= r; }
        if (fr >= 14) {
#pragma unroll
            for (int ai = 0; ai < 2; ++ai)
#pragma unroll
                for (int bj = 0; bj < 2; ++bj)
#pragma unroll
                    for (int n = 0; n < 2; ++n) *(LAS f32x4*)(halo + (((2 * ai + wr) * 2 + (fr - 14)) * 256 + 128 * bj + cl0 + 4 * n)) = acc[ai][bj][3][n];
        }
        if (wr == 0 && fr < 2) {
#pragma unroll
            for (int bj = 0; bj < 2; ++bj)
#pragma unroll
                for (int n = 0; n < 2; ++n) *(f32x4*)(UH + ((size_t)u.pm * 4 + fr) * NUP + 256 * u.pn + 128 * bj + cl0 + 4 * n) = acc[0][bj][0][n];
        }
        if (wr == 1 && fr >= 14) {
#pragma unroll
            for (int bj = 0; bj < 2; ++bj)
#pragma unroll
                for (int n = 0; n < 2; ++n) *(f32x4*)(UH + ((size_t)u.pm * 4 + 2 + (fr - 14)) * NUP + 256 * u.pn + 128 * bj + cl0 + 4 * n) = acc[1][bj][3][n];
        }
        asm volatile("s_waitcnt lgkmcnt(0)" ::: "memory"); __builtin_amdgcn_s_barrier(); asm volatile("" ::: "memory");
        const int j0 = 128 * u.pn + cl0;
        const bool is15 = fr == 15, ge14 = fr >= 14;
        unsigned keep[2][4][2];
#pragma unroll
        for (int n = 0; n < 2; ++n) {
            f32x4 wa[3], wv[3];
#pragma unroll
            for (int q = 0; q < 3; ++q) { wa[q] = *(const f32x4*)(cw + q * NUP + j0 + 4 * n); wv[q] = *(const f32x4*)(cw + q * NUP + DFF + j0 + 4 * n); }
            const f32x4 ba = *(const f32x4*)(cb + j0 + 4 * n), bv = *(const f32x4*)(cb + DFF + j0 + 4 * n);
#pragma unroll
            for (int ai = 0; ai < 2; ++ai) {
                const int blk = 2 * ai + wr;
                f32x4 pa = (f32x4){0.f, 0.f, 0.f, 0.f}, pv = (f32x4){0.f, 0.f, 0.f, 0.f};
                if (blk > 0 && ge14) { pa = *(const LAS f32x4*)(halo + (((blk - 1) * 2 + (fr - 14)) * 256 + cl0 + 4 * n)); pv = *(const LAS f32x4*)(halo + (((blk - 1) * 2 + (fr - 14)) * 256 + 128 + cl0 + 4 * n)); }
#pragma unroll
                for (int m = 0; m < 4; ++m) {
                    const f32x4 ca_ = acc[ai][0][m][n], cv_ = acc[ai][1][m][n]; float o[4];
#pragma unroll
                    for (int i = 0; i < 4; ++i) {
                        const float a1 = dpp_ror1(is15 ? pa[i] : ca_[i]), a2 = dpp_ror2(ge14 ? pa[i] : ca_[i]);
                        const float v1 = dpp_ror1(is15 ? pv[i] : cv_[i]), v2 = dpp_ror2(ge14 ? pv[i] : cv_[i]);
                        const float ca = ba[i] + wa[0][i] * a2 + wa[1][i] * a1 + wa[2][i] * ca_[i];
                        const float cv = bv[i] + wv[0][i] * v2 + wv[1][i] * v1 + wv[2][i] * cv_[i];
                        o[i] = siluf_(ca) * cv; }
                    pa = ca_; pv = cv_;
                    const unsigned lo = cvt_pk_bf16(o[0], o[1]), hi = cvt_pk_bf16(o[2], o[3]);
                    if (n == 0) { keep[ai][m][0] = lo; keep[ai][m][1] = hi; }
                    else { u32x4 w; w.x = keep[ai][m][0]; w.y = keep[ai][m][1]; w.z = lo; w.w = hi;
                        *(u32x4*)(O + (size_t)(u.pm * BM + ai * HALF + wr * 64 + m * 16 + fr) * DFF + j0) = w; }
                }
            }
        }
    }
};
struct EpiResid {
    static constexpr bool PERM = false, KHOOK = false;
    const float* base; float* out; int ldc; bf16_t* HB; float* SS;
    __device__ __forceinline__ void khook(f32x4 (&)[2][2][4][2], const Unit&, int, int, int, int, int) const {}
    __device__ __forceinline__ void operator()(f32x4 (&acc)[2][2][4][2], const Unit& u, int wr, int wc, int fr_, int fq_) const {
        int fr = fr_, fq = fq_; asm volatile("" : "+v"(fr), "+v"(fq));
        const int row0 = u.pm * BM + wr * 64 + fr, col0 = u.pn * BM + wc * 32 + 4 * fq, lane = fq * 16 + fr;
#pragma unroll
        for (int ai = 0; ai < 2; ++ai)
#pragma unroll
            for (int m = 0; m < 4; ++m) { const size_t off = (size_t)(row0 + ai * HALF + m * 16) * ldc + col0; float sq = 0.f;
#pragma unroll
                for (int bj = 0; bj < 2; ++bj)
#pragma unroll
                    for (int n = 0; n < 2; ++n) { const f32x4 bs = *(const f32x4*)(base + off + bj * HALF + n * 16); const f32x4 o = bs + acc[ai][bj][m][n]; *(f32x4*)(out + off + bj * HALF + n * 16) = o;
                        if (HB) { u32x2 w; w.x = cvt_pk_bf16(o[0], o[1]); w.y = cvt_pk_bf16(o[2], o[3]); *(u32x2*)(HB + off + bj * HALF + n * 16) = w;
                            sq += (o[0] * o[0] + o[1] * o[1]) + (o[2] * o[2] + o[3] * o[3]); } }
                if (HB) { sq += __builtin_bit_cast(float, __builtin_amdgcn_ds_bpermute((lane ^ 16) << 2, __builtin_bit_cast(int, sq)));
                    sq += __builtin_bit_cast(float, __builtin_amdgcn_ds_bpermute((lane ^ 32) << 2, __builtin_bit_cast(int, sq)));
                    if (fq == 0) SS[(size_t)(u.pn * 4 + wc) * M + row0 + ai * HALF + m * 16] = sq; }
                asm volatile("" ::: "memory"); }
    }
};
struct EpiGlu {
    static constexpr bool PERM = true, KHOOK = false;
    const bf16_t* Yp; int ldy; bf16_t* O; int ldc;
    __device__ __forceinline__ void khook(f32x4 (&)[2][2][4][2], const Unit&, int, int, int, int, int) const {}
    __device__ __forceinline__ void operator()(f32x4 (&acc)[2][2][4][2], const Unit& u, int wr, int wc, int fr, int fq) const {
        const int row0 = u.pm * BM + wr * 64 + fr, col0 = u.pn * BM + wc * 32 + 8 * fq;
#pragma unroll
        for (int ai = 0; ai < 2; ++ai)
#pragma unroll
            for (int m = 0; m < 4; ++m) { const size_t r = (size_t)(row0 + ai * HALF + m * 16);
#pragma unroll
                for (int bj = 0; bj < 2; ++bj) { const u32x4 yw = *(const u32x4*)(Yp + r * ldy + col0 + bj * HALF); float y[8]; unpack8(yw, y);
                    const f32x4 v0 = acc[ai][bj][m][0], v1 = acc[ai][bj][m][1]; float o[8];
#pragma unroll
                    for (int j = 0; j < 4; ++j) { o[j] = y[j] * sigmoidf_(v0[j]); o[4 + j] = y[4 + j] * sigmoidf_(v1[j]); }
                    u32x4 w; w.x = cvt_pk_bf16(o[0], o[1]); w.y = cvt_pk_bf16(o[2], o[3]); w.z = cvt_pk_bf16(o[4], o[5]); w.w = cvt_pk_bf16(o[6], o[7]);
                    *(u32x4*)(O + r * ldc + col0 + bj * HALF) = w; } }
    }
};
struct EpiMerge {
    static constexpr bool PERM = true, KHOOK = true;
    const bf16_t* G; int ldg; bf16_t* O; int ldc;
    __device__ __forceinline__ void scale(f32x4 (&acc)[2][2][4][2], const Unit& u, int s, int wr, int wc, int fr, int fq) const {
        int row0 = u.pm * BM + wr * 64 + fr, col0 = u.pn * BM + wc * 32 + 8 * fq + s * D; asm volatile("" : "+v"(row0), "+v"(col0));
        u32x4 w[2][4][2];
#pragma unroll
        for (int ai = 0; ai < 2; ++ai)
#pragma unroll
            for (int m = 0; m < 4; ++m) { const bf16_t* gp = G + (size_t)(row0 + ai * HALF + m * 16) * ldg + col0;
#pragma unroll
                for (int bj = 0; bj < 2; ++bj) w[ai][m][bj] = *(const u32x4*)(gp + bj * HALF); }
#pragma unroll
        for (int ai = 0; ai < 2; ++ai)
#pragma unroll
            for (int m = 0; m < 4; ++m)
#pragma unroll
                for (int bj = 0; bj < 2; ++bj) { float f[8]; unpack8(w[ai][m][bj], f);
#pragma unroll
                    for (int j = 0; j < 8; ++j) acc[ai][bj][m][j >> 2][j & 3] *= f[j]; }
    }
    __device__ __forceinline__ void khook(f32x4 (&acc)[2][2][4][2], const Unit& u, int seg, int wr, int wc, int fr, int fq) const { scale(acc, u, seg - 1, wr, wc, fr, fq); }
    __device__ __forceinline__ void operator()(f32x4 (&acc)[2][2][4][2], const Unit& u, int wr, int wc, int fr, int fq) const {
        scale(acc, u, 3, wr, wc, fr, fq);
        const int row0 = u.pm * BM + wr * 64 + fr, col0 = u.pn * BM + wc * 32 + 8 * fq;
#pragma unroll
        for (int ai = 0; ai < 2; ++ai)
#pragma unroll
            for (int m = 0; m < 4; ++m) { bf16_t* rowp = O + (size_t)(row0 + ai * HALF + m * 16) * ldc + col0;
#pragma unroll
                for (int bj = 0; bj < 2; ++bj) { const f32x4 v0 = acc[ai][bj][m][0], v1 = acc[ai][bj][m][1];
                    u32x4 w; w.x = cvt_pk_bf16(v0[0], v0[1]); w.y = cvt_pk_bf16(v0[2], v0[3]); w.z = cvt_pk_bf16(v1[0], v1[1]); w.w = cvt_pk_bf16(v1[2], v1[3]);
                    *(u32x4*)(rowp + bj * HALF) = w; } }
    }
};

typedef int v4i_t __attribute__((ext_vector_type(4)));
typedef int v8i_t __attribute__((ext_vector_type(8)));
template <class Epi, bool F8 = false>
__device__ __forceinline__ void gemm_phase(LAS unsigned char* lds, const Gemm g, const StaticOrder& S, const Epi& E, int tid_in) {
    int tid_ = tid_in; asm volatile("" : "+v"(tid_));
    const int tid = tid_, wid = __builtin_amdgcn_readfirstlane(tid >> 6), lane = tid & 63, wr = wid >> 2, wc = wid & 3, fr = lane & 15, fq = lane >> 4;
    const int K = g.K, nt = K / BK;
    unsigned voffA[2], voffB[2];
#pragma unroll
    for (int i = 0; i < 2; ++i) { int R, C; stage_rc(tid * 16 + i * 8192, R, C); const int Rb = Epi::PERM ? ((R & ~31) + perm32(R & 31)) : R;
        voffA[i] = (unsigned)(R * g.lda + C) * 2u; voffB[i] = (unsigned)(Rb * g.ldb + C) * 2u; }
    const size_t kstep = (size_t)(BK * 2);
    const size_t hstepA = (size_t)HALF * g.lda * 2, hstepB = (size_t)HALF * g.ldb * 2;
    const size_t tstepA = 2 * hstepA, tstepB = 2 * hstepB;
    const unsigned ldsw = (unsigned)wid * 1024u;
    const int aoff = lds_byte(wr * 64 + fr, fq * 8), boff = lds_byte(wc * 32 + fr, fq * 8);
#define PG8_SA(b, h) (((b) * 2 + (h)) * HTB)
#define PG8_SB(b, h) ((4 + (b) * 2 + (h)) * HTB)
#define PG8_STAGE(bufoff, gbase, voff) do { _Pragma("unroll") for (int _i = 0; _i < 2; ++_i) \
        __builtin_amdgcn_global_load_lds((const unsigned*)((const char*)(gbase) + (voff)[_i]), (LAS unsigned*)(lds + (bufoff) + ldsw + _i * 8192), 16, 0, 0); } while (0)
#define PG8_LDA(dst, b, h) do { _Pragma("unroll") for (int m = 0; m < 4; ++m) _Pragma("unroll") for (int k = 0; k < 2; ++k) dst[m][k] = *(const LAS bf16x8*)(lds + PG8_SA(b, h) + aoff + m * 2048 + k * 1024); } while (0)
#define PG8_LDB(dst, b, h) do { _Pragma("unroll") for (int n = 0; n < 2; ++n) _Pragma("unroll") for (int k = 0; k < 2; ++k) dst[n][k] = *(const LAS bf16x8*)(lds + PG8_SB(b, h) + boff + n * 2048 + k * 1024); } while (0)
#define PG8_MMA(ai, bj, At, Bt) do { __builtin_amdgcn_s_setprio(1); _Pragma("unroll") for (int m = 0; m < 4; ++m) _Pragma("unroll") for (int n = 0; n < 2; ++n) _Pragma("unroll") for (int k = 0; k < 2; ++k) \
        acc[ai][bj][m][n] = __builtin_amdgcn_mfma_f32_16x16x32_bf16(Bt[n][k], At[m][k], acc[ai][bj][m][n], 0, 0, 0); __builtin_amdgcn_s_setprio(0); } while (0)
#define PG8_MMA16(ai, bj, At, Bt) PG8_MMA(ai, bj, At, Bt)
#define PG8_MMA8(ai, bj, A8, B8) do { __builtin_amdgcn_s_setprio(1); _Pragma("unroll") for (int m = 0; m < 4; ++m) _Pragma("unroll") for (int n = 0; n < 2; ++n) \
        asm volatile("v_mfma_f32_16x16x128_f8f6f4 %0, %1, %2, %0" : "+v"(acc[ai][bj][m][n]) : "v"(B8[n]), "v"(A8[m])); __builtin_amdgcn_s_setprio(0); } while (0)
#define PG8_LDA8(dst, b, h) do { _Pragma("unroll") for (int m = 0; m < 4; ++m) { dst[m].lo = *(const LAS v4i_t*)(lds + PG8_SA(b, h) + aoff + m * 2048); dst[m].hi = *(const LAS v4i_t*)(lds + PG8_SA(b, h) + aoff + m * 2048 + 1024); } } while (0)
#define PG8_LDB8(dst, b, h) do { _Pragma("unroll") for (int n = 0; n < 2; ++n) { dst[n].lo = *(const LAS v4i_t*)(lds + PG8_SB(b, h) + boff + n * 2048); dst[n].hi = *(const LAS v4i_t*)(lds + PG8_SB(b, h) + boff + n * 2048 + 1024); } } while (0)
#define PG8_XLDA(b, h) do { if constexpr (F8) PG8_LDA8(A8, b, h); else PG8_LDA(At, b, h); } while (0)
#define PG8_XLDB0(b, h) do { if constexpr (F8) PG8_LDB8(B08, b, h); else PG8_LDB(B0, b, h); } while (0)
#define PG8_XLDB1(b, h) do { if constexpr (F8) PG8_LDB8(B18, b, h); else PG8_LDB(B1, b, h); } while (0)
#define PG8_MM0(ai, bj) do { if constexpr (F8) PG8_MMA8(ai, bj, A8, B08); else PG8_MMA16(ai, bj, At, B0); } while (0)
#define PG8_MM1(ai, bj) do { if constexpr (F8) PG8_MMA8(ai, bj, A8, B18); else PG8_MMA16(ai, bj, At, B1); } while (0)
#define PG8_WAIT_V(n) asm volatile("s_waitcnt vmcnt(" #n ")" ::: "memory")
#define PG8_WAIT_L(n) asm volatile("s_waitcnt lgkmcnt(" #n ")" ::: "memory")
#define PG8_BAR __builtin_amdgcn_s_barrier()
#define PG8_SCHED __builtin_amdgcn_sched_barrier(0)
    Unit cur, nxt; int ui = 0;
    if (!S.next(0, cur)) return;
    f32x4 acc[2][2][4][2];
#pragma unroll
    for (int a = 0; a < 2; ++a)
#pragma unroll
        for (int b = 0; b < 2; ++b)
#pragma unroll
            for (int m = 0; m < 4; ++m)
#pragma unroll
                for (int n = 0; n < 2; ++n) acc[a][b][m][n] = (f32x4){0.f, 0.f, 0.f, 0.f};
    bf16x8 At[4][2], B0[2][2], B1[2][2]; v8i_t A8[4], B08[2], B18[2];
    const char* cA = (const char*)g.A + (size_t)cur.pm * tstepA; const char* cB = (const char*)g.Bt + (size_t)cur.pn * tstepB;
    PG8_STAGE(PG8_SB(0, 0), cB, voffB); PG8_STAGE(PG8_SB(0, 1), cB + hstepB, voffB); PG8_STAGE(PG8_SA(0, 0), cA, voffA); PG8_STAGE(PG8_SA(0, 1), cA + hstepA, voffA);
    if (wr == 1) PG8_BAR;
    PG8_WAIT_V(2); PG8_BAR;
    PG8_STAGE(PG8_SB(1, 0), cB + kstep, voffB); PG8_STAGE(PG8_SA(1, 0), cA + kstep, voffA); PG8_STAGE(PG8_SB(1, 1), cB + hstepB + kstep, voffB);
    PG8_WAIT_V(6); PG8_BAR;
    for (;;) {
        const bool has_next = S.next(ui + 1, nxt);
        const char* nA = has_next ? (const char*)g.A + (size_t)nxt.pm * tstepA : cA; const char* nB = has_next ? (const char*)g.Bt + (size_t)nxt.pn * tstepB : cB;
        for (int t = 0; t < nt; t += 2) {
            const bool last = (t == nt - 2);
            const char* a1 = cA + (size_t)(t + 1) * kstep;
            const char* a2 = last ? nA : cA + (size_t)(t + 2) * kstep; const char* b2 = last ? nB : cB + (size_t)(t + 2) * kstep;
            const char* a3 = a2 + kstep; const char* b3 = b2 + kstep;
            if constexpr (Epi::KHOOK) { if (t != 0 && (t & 7) == 0) E.khook(acc, cur, t >> 3, wr, wc, fr, fq); }
            PG8_XLDB0(0, 0); PG8_XLDB1(0, 1); PG8_SCHED; PG8_XLDA(0, 0); PG8_STAGE(PG8_SA(1, 1), a1 + hstepA, voffA);
            PG8_WAIT_V(8); PG8_WAIT_L(0); PG8_BAR; PG8_MM0(0, 0); PG8_MM1(0, 1); PG8_BAR; PG8_SCHED;
            PG8_XLDA(0, 1); PG8_STAGE(PG8_SB(0, 0), b2, voffB); PG8_STAGE(PG8_SB(0, 1), b2 + hstepB, voffB); PG8_STAGE(PG8_SA(0, 0), a2, voffA);
            PG8_WAIT_V(8); PG8_WAIT_L(0); PG8_BAR; PG8_MM0(1, 0); PG8_MM1(1, 1); PG8_BAR; PG8_SCHED;
            PG8_XLDB0(1, 0); PG8_XLDB1(1, 1); PG8_SCHED; PG8_XLDA(1, 0); PG8_STAGE(PG8_SA(0, 1), a2 + hstepA, voffA);
            PG8_WAIT_V(8); PG8_WAIT_L(0); PG8_BAR; PG8_MM0(0, 0); PG8_MM1(0, 1); PG8_BAR; PG8_SCHED;
            PG8_XLDA(1, 1); PG8_STAGE(PG8_SB(1, 0), b3, voffB); PG8_STAGE(PG8_SB(1, 1), b3 + hstepB, voffB); PG8_STAGE(PG8_SA(1, 0), a3, voffA);
            PG8_WAIT_V(8); PG8_WAIT_L(0); PG8_BAR; PG8_MM0(1, 0); PG8_MM1(1, 1); PG8_BAR; PG8_SCHED;
        }
        if (wr == 0) PG8_BAR;
        E(acc, cur, wr, wc, fr, fq);
        if (!has_next) break;
#pragma unroll
        for (int a = 0; a < 2; ++a)
#pragma unroll
            for (int b = 0; b < 2; ++b)
#pragma unroll
                for (int m = 0; m < 4; ++m)
#pragma unroll
                    for (int n = 0; n < 2; ++n) acc[a][b][m][n] = (f32x4){0.f, 0.f, 0.f, 0.f};
        cur = nxt; cA = nA; cB = nB; ++ui;
        if (wr == 1) PG8_BAR;
    }
    PG8_WAIT_V(0);
    PG8_BAR;
#undef PG8_SA
#undef PG8_SB
#undef PG8_STAGE
#undef PG8_LDA
#undef PG8_LDB
#undef PG8_MMA
#undef PG8_MMA8
#undef PG8_MMA16
#undef PG8_LDA8
#undef PG8_LDB8
#undef PG8_XLDA
#undef PG8_XLDB0
#undef PG8_XLDB1
#undef PG8_MM0
#undef PG8_MM1
#undef PG8_WAIT_V
#undef PG8_WAIT_L
#undef PG8_BAR
#undef PG8_SCHED
}
}

#define XB_TMO      128
#define XB_XCNT(j)  (256  + 64 * (j))
#define XB_XSUB(j)  (1280 + 64 * (j))
#define XB_XGEN(j)  (2304 + 64 * (j))
#define XB_TOP      3328
#define XB_TOPGEN   3392
#define XCD_BAR_WORDS 3456
#define XB_SPIN_CAP (1u << 18)
__device__ __forceinline__ unsigned xb_ld(unsigned* p)              { return __hip_atomic_load(p, __ATOMIC_RELAXED, __HIP_MEMORY_SCOPE_AGENT); }
__device__ __forceinline__ unsigned xb_add(unsigned* p, unsigned v) { return __hip_atomic_fetch_add(p, v, __ATOMIC_RELAXED, __HIP_MEMORY_SCOPE_AGENT); }
__device__ __forceinline__ unsigned xb_xcc_id() { return (unsigned)__builtin_amdgcn_s_getreg((3 << 11) | 20) & 0xFu; }
#define XB_SPIN(cond, bar) do { unsigned _sp = 0; while (cond) { __builtin_amdgcn_s_sleep(1); \
    if ((++_sp & 255u) == 0u) { if (xb_ld(&(bar)[XB_TMO])) break; if (_sp > XB_SPIN_CAP) { (void)__hip_atomic_fetch_add(&(bar)[XB_TMO], 1u, __ATOMIC_RELAXED, __HIP_MEMORY_SCOPE_AGENT); break; } } } } while (0)
struct XcdBarrier { unsigned* bar; unsigned x; volatile LAS unsigned* st; };
__device__ __forceinline__ XcdBarrier xcd_barrier_post(unsigned* bar, volatile LAS unsigned* st) {
    XcdBarrier b; b.bar = bar; b.x = xb_xcc_id(); b.st = st;
    if (threadIdx.x == 0) (void)xb_add(&bar[XB_XCNT(b.x)], 1u);
    return b;
}
__device__ __forceinline__ void xcd_barrier_complete(unsigned* bar, unsigned x, unsigned& nloc, unsigned& nx) {
    const unsigned G = gridDim.x * gridDim.y * gridDim.z;
    unsigned sum, cnt, mine, sp = 0u;
    for (;;) {
        sum = 0u; cnt = 0u; mine = 0u;
#pragma nounroll
        for (unsigned j = 0; j < 16; ++j) { const unsigned c = xb_ld(&bar[XB_XCNT(j)]); sum += c; cnt += (c > 0u) ? 1u : 0u; mine = (j == x) ? c : mine; }
        if (sum == G) break;
        __builtin_amdgcn_s_sleep(1);
        if ((++sp & 255u) == 0u) { if (xb_ld(&bar[XB_TMO])) break; if (sp > XB_SPIN_CAP) { (void)__hip_atomic_fetch_add(&bar[XB_TMO], 1u, __ATOMIC_RELAXED, __HIP_MEMORY_SCOPE_AGENT); break; } }
    }
    nloc = mine > 0u ? mine : 1u; nx = cnt > 0u ? cnt : 1u;
}
__device__ __forceinline__ void xcd_barrier(const XcdBarrier& b) {
    asm volatile("s_waitcnt vmcnt(0)" ::: "memory");
    wg_sync();
    if (threadIdx.x == 0) {
        unsigned* bar = b.bar;
        __builtin_amdgcn_s_waitcnt(0);
        unsigned nloc = b.st[0], nx = b.st[1];
        if (nloc == 0u) { xcd_barrier_complete(bar, b.x, nloc, nx); b.st[0] = nloc; b.st[1] = nx; }
        const unsigned old = xb_add(&bar[XB_XSUB(b.x)], 1u);
        const unsigned gen = old / nloc;
        if (old + 1u == (gen + 1u) * nloc) {
            __builtin_amdgcn_fence(__ATOMIC_RELEASE, "agent");
            asm volatile("s_waitcnt vmcnt(0)" ::: "memory");
            const unsigned og = xb_add(&bar[XB_TOP], 1u);
            const unsigned tg = og / nx;
            if (og + 1u == (tg + 1u) * nx) xb_add(&bar[XB_TOPGEN], 1u);
            else XB_SPIN(xb_ld(&bar[XB_TOPGEN]) == tg, bar);
            __builtin_amdgcn_fence(__ATOMIC_ACQUIRE, "agent");
            xb_add(&bar[XB_XGEN(b.x)], 1u);
            asm volatile("s_waitcnt vmcnt(0)" ::: "memory");
        } else {
            XB_SPIN(xb_ld(&bar[XB_XGEN(b.x)]) == gen, bar);
            __builtin_amdgcn_fence(__ATOMIC_ACQUIRE, "agent");
            asm volatile("s_waitcnt vmcnt(0)" ::: "memory");
        }
    }
    wg_sync();
}

__device__ __forceinline__ const void* kin(int k) {
    typedef __attribute__((address_space(4))) const char* kptr_t;
    kptr_t p = (kptr_t)__builtin_amdgcn_kernarg_segment_ptr(); asm volatile("" : "+s"(p));
    const unsigned long long v = *(__attribute__((address_space(4))) const unsigned long long*)(p + 8 * k);
    return (const void*)(GAS const void*)v;
}
struct Frame {
    LAS unsigned char* lds;
    int tid, lane, wave, vcu, G, l;
    unsigned char* ws; float* out;
#define FIN(name, T, k) __device__ __forceinline__ const T* name() const { return (const T*)kin(k); }
    FIN(x, float, 0) FIN(pos, int, 1) FIN(g_mix, float, 2) FIN(w_in, float, 3) FIN(a_re, float, 4) FIN(a_im, float, 5) FIN(log_dt, float, 6) FIN(b_re, float, 7) FIN(b_im, float, 8)
    FIN(c_re, float, 9) FIN(c_im, float, 10) FIN(s5_d, float, 11) FIN(w_glu, float, 12) FIN(gla_wg, float, 13) FIN(gla_bg, float, 14) FIN(pool_w, float, 15) FIN(pool_scale, float, 16)
    FIN(w_branch, float, 17) FIN(w_out, float, 18) FIN(g_ffn, float, 19) FIN(w_up, float, 20) FIN(conv_w, float, 21) FIN(conv_b, float, 22) FIN(w_down, float, 23) FIN(g_final, float, 24)
#undef FIN
#define FWS(name, T, off) __device__ __forceinline__ T* name() const { return (T*)(ws + (off)); }
    FWS(rotc, float, WS_ROT) FWS(rots, float, WS_ROT + (size_t)M * 32 * 4) FWS(abar, float, WS_S5T + S5T_ABAR) FWS(apow, float, WS_S5T + S5T_APOW) FWS(bbar, float, WS_S5T + S5T_BBAR) FWS(cmt, bf16_t, WS_S5T + S5T_CMT) FWS(bbt, bf16_t, WS_S5T + S5T_BBT)
    FWS(wglu_t, bf16_t, WS_WGLU) FWS(poolw_t, bf16_t, WS_POOLW) FWS(win_t, bf16_t, WS_WIN) FWS(wbr_t, bf16_t, WS_WBR) FWS(wout_t, bf16_t, WS_WOUT) FWS(wup_t, bf16_t, WS_WUP) FWS(wdn_t, bf16_t, WS_WDN)
    FWS(HN8, unsigned char, WS_HN8) FWS(W8, unsigned char, WS_W8) FWS(HN, bf16_t, WS_HN) FWS(Y, bf16_t, WS_Y) FWS(YBP, bf16_t, WS_YBP) FWS(PROJ, bf16_t, WS_PROJ) FWS(SPREV, bf16_t, WS_SPREV) FWS(ACT, bf16_t, WS_ACT)
    FWS(SS, float, WS_SS + (size_t)l * 32 * M * 4) FWS(RS, float, WS_RS + (size_t)l * M * 4) FWS(STATE, float, WS_STATE) FWS(DEC, float, WS_DEC) FWS(XEND, float, WS_XEND) FWS(UH, float, WS_UH)
#undef FWS
};

__device__ __forceinline__ float lane_read(float v, int src_lane) { return __builtin_bit_cast(float, __builtin_amdgcn_ds_bpermute(src_lane << 2, __builtin_bit_cast(int, v))); }
__device__ __forceinline__ float wave_sum(float v, int lane) {
#pragma unroll
    for (int o = 1; o < 64; o <<= 1) v += lane_read(v, lane ^ o);
    return v;
}

template <class SrcCol>
__device__ __forceinline__ void transpose_item(const float* W, int Nsrc, bf16_t* WT, int ldt, int kdst0, int k0, int n0, SrcCol srccol, LAS float* scr, int lane, const float* kscale = nullptr) {
    const int sc = srccol(n0 + (lane & 31));
    float wv[32];
#pragma unroll
    for (int i = 0; i < 32; ++i) { const int kk = 2 * i + (lane >> 5); wv[i] = sc >= 0 ? W[(size_t)(k0 + kk) * Nsrc + sc] : 0.f; }
#pragma unroll
    for (int i = 0; i < 32; ++i) { const int kk = 2 * i + (lane >> 5); scr[kk * 33 + (lane & 31)] = kscale ? wv[i] * kscale[k0 + kk] : wv[i]; }
    LDS_WAIT();
    const int c = lane & 7;
#pragma unroll
    for (int j = 0; j < 4; ++j) { const int n = (lane >> 3) + 8 * j; const LAS float* s = scr + (8 * c) * 33 + n;
        u32x4 o; o.x = pk2(s[0 * 33], s[1 * 33]); o.y = pk2(s[2 * 33], s[3 * 33]); o.z = pk2(s[4 * 33], s[5 * 33]); o.w = pk2(s[6 * 33], s[7 * 33]);
        *(u32x4*)(WT + (size_t)(n0 + n) * ldt + kdst0 + k0 + 8 * c) = o; }
    LDS_WAIT();
}
template <class SrcCol>
__device__ __forceinline__ void transpose_item_fp8(const float* W, int Nsrc, unsigned char* WT, int ldt, int k0, int n0src, int n0dst, SrcCol srccol, LAS float* scr, int lane, const float* kscale, float scale) {
    const int sc = srccol(n0src + (lane & 31));
    float wv[32];
#pragma unroll
    for (int i = 0; i < 32; ++i) { const int kk = 2 * i + (lane >> 5); wv[i] = sc >= 0 ? W[(size_t)(k0 + kk) * Nsrc + sc] : 0.f; }
#pragma unroll
    for (int i = 0; i < 32; ++i) { const int kk = 2 * i + (lane >> 5); scr[kk * 33 + (lane & 31)] = (kscale ? wv[i] * kscale[k0 + kk] : wv[i]) * scale; }
    LDS_WAIT();
    const int c = lane & 7;
#pragma unroll
    for (int j = 0; j < 4; ++j) { const int n = (lane >> 3) + 8 * j; const LAS float* s = scr + (8 * c) * 33 + n;
        u32x2 o; o.x = pk4_fp8(s[0 * 33], s[1 * 33], s[2 * 33], s[3 * 33]); o.y = pk4_fp8(s[4 * 33], s[5 * 33], s[6 * 33], s[7 * 33]);
        *(u32x2*)(WT + (size_t)(n0dst + n) * ldt + k0 + 8 * c) = o; }
    LDS_WAIT();
}
struct ColIdent { __device__ __forceinline__ int operator()(int n) const { return n; } };
struct ColWin { __device__ __forceinline__ int operator()(int n) const {
    if (n < 3584) return n; if (n < 4096) return n + 16; if (n < 4112) return n - 512; if (n < 4352) return -1;
    const int t = (n - 4352) >> 8, cl = (n - 4352) & 255; const int br = 2 * (cl >> 7) + ((cl >> 2) & 1), ch = 16 * ((cl >> 5) & 3) + 4 * ((cl >> 3) & 3) + (cl & 3);
    return 4112 + br * 2048 + 64 * t + ch; } };
struct ColWup { __device__ __forceinline__ int operator()(int n) const { const int blk = n >> 8, r = n & 255; return (r < 128) ? (blk * 128 + r) : (DFF + blk * 128 + (r - 128)); } };

__device__ __forceinline__ void rms_row_to_bf16(const float* xrow, const float* g, bf16_t* orow, int lane, unsigned char* orow8 = nullptr) {
    const f32x4* xr = (const f32x4*)xrow + lane; const f32x4* gr = (const f32x4*)g + lane;
    f32x4 v[8]; float s = 0.f;
#pragma unroll
    for (int j = 0; j < 8; ++j) { v[j] = xr[64 * j]; s += (v[j].x * v[j].x + v[j].y * v[j].y) + (v[j].z * v[j].z + v[j].w * v[j].w); }
    const float r = 1.0f / sqrtf(wave_sum(s, lane) * (1.f / D) + EPS);
    u32x2* o8 = (u32x2*)orow + lane;
#pragma unroll
    for (int j = 0; j < 8; ++j) { const f32x4 gg = gr[64 * j]; const float a = v[j].x * r * gg.x, b = v[j].y * r * gg.y, c = v[j].z * r * gg.z, d = v[j].w * r * gg.w; u32x2 w; w.x = pk2(a, b); w.y = pk2(c, d); o8[64 * j] = w;
        if (orow8) ((unsigned*)orow8)[lane + 64 * j] = pk4_fp8(a, b, c, d); }
}
__device__ __forceinline__ void rms_rows(Frame& F, const float* src, const float* g, bf16_t* dst, unsigned char* dst8 = nullptr) {
    const int gw = F.vcu * NWAVES + F.wave, NGW = F.G * NWAVES;
    for (int m = gw; m < M; m += NGW) rms_row_to_bf16(src + (size_t)m * D, g, dst + (size_t)m * D, F.lane, dst8 ? dst8 + (size_t)m * D : nullptr);
}
__device__ __forceinline__ void row_scale(Frame& F) {
    const int gt = F.vcu * (NWAVES * 64) + F.tid, NGT = F.G * NWAVES * 64;
    for (int m = gt; m < M; m += NGT) { float s = 0.f;
#pragma unroll
        for (int j = 0; j < 32; ++j) s += F.SS()[(size_t)j * M + m];
        F.RS()[m] = 1.0f / sqrtf(s * (1.f / D) + EPS); }
}
__device__ __forceinline__ void rms_rows_f32_inplace(Frame& F, float* buf, const float* g) {
    const int gw = F.vcu * NWAVES + F.wave, NGW = F.G * NWAVES;
    for (int m = gw; m < M; m += NGW) {
        f32x4* xr = (f32x4*)(buf + (size_t)m * D) + F.lane; const f32x4* gr = (const f32x4*)g + F.lane;
        f32x4 v[8]; float s = 0.f;
#pragma unroll
        for (int j = 0; j < 8; ++j) { v[j] = xr[64 * j]; s += (v[j].x * v[j].x + v[j].y * v[j].y) + (v[j].z * v[j].z + v[j].w * v[j].w); }
        const float r = 1.0f / sqrtf(wave_sum(s, F.lane) * (1.f / D) + EPS);
#pragma unroll
        for (int j = 0; j < 8; ++j) { const f32x4 gg = gr[64 * j]; xr[64 * j] = (f32x4){v[j].x * r * gg.x, v[j].y * r * gg.y, v[j].z * r * gg.z, v[j].w * r * gg.w}; }
    }
}

__device__ __forceinline__ void phase_prep(Frame& F, int l) {
    LAS float* scr = (LAS float*)(F.lds + F.wave * 16384);
    const int gw = F.vcu * NWAVES + F.wave, NGW = F.G * NWAVES;
    constexpr int I_IN = (D / 64) * (NIN / 32), I_UP = (D / 64) * (NUP / 32), I_DN = (DFF / 64) * (D / 32), I_BR = 4 * (BW / 64) * (D / 32), I_OUT = (D / 64) * (D / 32), I_GLU = (BW / 64) * (BW / 32), I_PL = 4 * (128 / 64) * (128 / 32);
    constexpr int NITEMS = I_IN + I_UP + I_DN + I_BR + I_OUT + I_GLU + I_PL;
    for (int it = gw; it < NITEMS; it += NGW) {
        int r = it;
        if (r < I_IN) { const int nb = NIN / 32, n0 = 32 * (r % nb);
            if (n0 < C_GATE) transpose_item(F.w_in() + (size_t)l * D * NIN_SRC, NIN_SRC, F.win_t(), D, 0, 64 * (r / nb), n0, ColWin(), scr, F.lane);
            else transpose_item_fp8(F.w_in() + (size_t)l * D * NIN_SRC, NIN_SRC, F.W8(), D, 64 * (r / nb), n0, n0 - C_GATE, ColWin(), scr, F.lane, nullptr, 64.0f);
            continue; } r -= I_IN;
        if (r < I_UP) { const int nb = NUP / 32; transpose_item(F.w_up() + (size_t)l * D * NUP, NUP, F.wup_t(), D, 0, 64 * (r / nb), 32 * (r % nb), ColWup(), scr, F.lane, F.g_ffn() + (size_t)l * D); continue; } r -= I_UP;
        if (r < I_DN) { const int nb = D / 32; transpose_item(F.w_down() + (size_t)l * DFF * D, D, F.wdn_t(), DFF, 0, 64 * (r / nb), 32 * (r % nb), ColIdent(), scr, F.lane); continue; } r -= I_DN;
        if (r < I_BR) { const int per = (BW / 64) * (D / 32), br = r / per, q = r % per, nb = D / 32;
            transpose_item(F.w_branch() + ((size_t)l * 4 + br) * BW * D, D, F.wbr_t(), D, br * BW, 64 * (q / nb), 32 * (q % nb), ColIdent(), scr, F.lane); continue; } r -= I_BR;
        if (r < I_OUT) { const int nb = D / 32; transpose_item(F.w_out() + (size_t)l * D * D, D, F.wout_t(), D, 0, 64 * (r / nb), 32 * (r % nb), ColIdent(), scr, F.lane); continue; } r -= I_OUT;
        if (r < I_GLU) { const int nb = BW / 32; transpose_item(F.w_glu() + (size_t)l * BW * BW, BW, F.wglu_t(), BW, 0, 64 * (r / nb), 32 * (r % nb), ColIdent(), scr, F.lane); continue; } r -= I_GLU;
        { const int grp = r / 8, q = r % 8; transpose_item(F.pool_w() + ((size_t)l * 4 + grp) * 128 * 128, 128, F.poolw_t() + (size_t)grp * 128 * 128, 128, 0, 64 * (q / 4), 32 * (q % 4), ColIdent(), scr, F.lane); }
    }
    const int gt = F.vcu * (NWAVES * 64) + F.tid, NGT = F.G * NWAVES * 64;
    for (int i = gt; i < 32 * 64; i += NGT) {
        const int g = i >> 6;
        const float are = F.a_re()[(size_t)l * 2048 + i], aim = F.a_im()[(size_t)l * 2048 + i], dt = expf(F.log_dt()[l * 32 + g]);
        const float mag = expf(are * dt), th = aim * dt;
        const float abr = mag * cosf(th), abi = mag * sinf(th);
        const float den = are * are + aim * aim, nr = abr - 1.0f, ni = abi;
        const float fre = (nr * are + ni * aim) / den, fim = (ni * are - nr * aim) / den;
        F.abar()[2 * i] = abr; F.abar()[2 * i + 1] = abi;
        float pr = abr, pi = abi;
#pragma unroll
        for (int q = 0; q < 6; ++q) { const float tr = pr * pr - pi * pi, ti = 2.f * pr * pi; pr = tr; pi = ti; }
        F.apow()[2 * i] = pr; F.apow()[2 * i + 1] = pi;
        const float* br = F.b_re() + ((size_t)l * 2048 + i) * 16; const float* bi = F.b_im() + ((size_t)l * 2048 + i) * 16;
#pragma unroll
        for (int c = 0; c < 16; ++c) { const float x = br[c], y = bi[c]; const float vr = fre * x - fim * y, vi = fre * y + fim * x; const int p = i & 63;
            F.bbt()[((size_t)g * 128 + p) * 16 + c] = (bf16_t)f2bf(vr); F.bbt()[((size_t)g * 128 + 64 + p) * 16 + c] = (bf16_t)f2bf(vi); }
    }
    for (int i = gt; i < 32 * 16 * 128; i += NGT) {
        const int k = i & 127, gc = i >> 7;
        const float v = (k < 64) ? F.c_re()[((size_t)l * 512 + gc) * 64 + k] : -F.c_im()[((size_t)l * 512 + gc) * 64 + (k - 64)];
        F.cmt()[i] = (bf16_t)f2bf(v);
    }
    if (l == 0) {
        for (int i = gt; i < M * 32; i += NGT) {
            const int row = i >> 5, j = i & 31;
            const float inv = exp2f(-(float)j * (13.287712379549449f / 32.0f));
            const float ang = (float)F.pos()[row] * inv;
            F.rotc()[i] = cosf(ang); F.rots()[i] = sinf(ang);
        }
    }
    rms_rows(F, l == 0 ? F.x() : F.out, F.g_mix() + (size_t)l * D, F.HN(), F.HN8());
}

__device__ __forceinline__ f32x4 mma_nt_lds(const LAS bf16_t* X, int px, const LAS bf16_t* Y, int py, int ksteps, f32x4 acc, int lane) {
    const LAS bf16_t* xp = X + (lane & 15) * px + 8 * (lane >> 4);
    const LAS bf16_t* yp = Y + (lane & 15) * py + 8 * (lane >> 4);
    for (int ks = 0; ks < ksteps; ++ks) {
        const bf16x8 a = *(const LAS bf16x8*)(xp + 32 * ks), b = *(const LAS bf16x8*)(yp + 32 * ks);
        acc = __builtin_amdgcn_mfma_f32_16x16x32_bf16(a, b, acc, 0, 0, 0);
    }
    return acc;
}

constexpr int LN_TOT = 16384, LN_QD = 18432, LN_KI = 27648, LN_PM = 36864, LN_VT = 46080, LN_OB = 64512, LN_WG = 98304, LN_END = 98304 + 4096 + 256;
constexpr int LP = 72;
struct LinRaw { u32x4 q0, q1, k0, k1, v0, v1, g0, g1, gr0, gr1; f32x4 c0, c1, s0, s1; bf16x8 sp0, sp1; };
template <bool OUT>
__device__ __forceinline__ void lin_issue(Frame& F, int unit, LinRaw& R) {
    const int n = unit & 63, h = (unit >> 6) & 3, b = (unit >> 8) & 7, mixer = unit >> 11;
    const size_t row0 = (size_t)b * SEQ + (size_t)n * CH; const int s = F.tid >> 3, c = F.tid & 7;
    const int cq = (mixer == 0 ? C_RQ : C_GQ) + h * 64, ck = (mixer == 0 ? C_RK : C_GK) + h * 64, cv = (mixer == 0 ? C_RV : C_GV) + h * 128, cg = (mixer == 0 ? C_RG : C_GG) + h * 128;
    const bf16_t* pr = F.PROJ() + (row0 + s) * NIN;
    R.k0 = *(const u32x4*)(pr + ck + 8 * c); R.k1 = *(const u32x4*)(pr + ck + 8 * (c ^ 4));
    if (OUT) { R.q0 = *(const u32x4*)(pr + cq + 8 * c); R.q1 = *(const u32x4*)(pr + cq + 8 * (c ^ 4)); }
    { const float* cp = F.rotc() + (row0 + s) * 32 + (c & 3) * 8; const float* sp = F.rots() + (row0 + s) * 32 + (c & 3) * 8;
      R.c0 = *(const f32x4*)cp; R.c1 = *(const f32x4*)(cp + 4); R.s0 = *(const f32x4*)sp; R.s1 = *(const f32x4*)(sp + 4); }
    R.gr0 = *(const u32x4*)(pr + C_GR); R.gr1 = *(const u32x4*)(pr + C_GR + 8);
    R.v0 = *(const u32x4*)(F.PROJ() + (row0 + (F.tid >> 4)) * NIN + cv + (F.tid & 15) * 8);
    R.v1 = *(const u32x4*)(F.PROJ() + (row0 + 32 + (F.tid >> 4)) * NIN + cv + (F.tid & 15) * 8);
    if (OUT) { R.g0 = *(const u32x4*)(pr + cg + 16 * c); R.g1 = *(const u32x4*)(pr + cg + 16 * c + 8);
        const bf16_t* sq = F.SPREV() + (size_t)unit * 8192 + (size_t)(16 * F.wave + (F.lane & 15)) * 64 + 8 * (F.lane >> 4);
        R.sp0 = *(const bf16x8*)sq; R.sp1 = *(const bf16x8*)(sq + 32); }
}
__device__ __forceinline__ void lin_rot(const u32x4 own_, const u32x4 oth_, const LinRaw& R, bool rot, bool hi, float scale, float (&v)[8]) {
    float own[8]; unpack8(own_, own);
    if (!rot) {
#pragma unroll
        for (int j = 0; j < 8; ++j) v[j] = own[j] * scale;
        return; }
    float oth[8]; unpack8(oth_, oth);
    const float cs[8] = {R.c0.x, R.c0.y, R.c0.z, R.c0.w, R.c1.x, R.c1.y, R.c1.z, R.c1.w}, sn[8] = {R.s0.x, R.s0.y, R.s0.z, R.s0.w, R.s1.x, R.s1.y, R.s1.z, R.s1.w};
#pragma unroll
    for (int j = 0; j < 8; ++j) { const float os = oth[j] * sn[j]; v[j] = (own[j] * cs[j] + (hi ? os : -os)) * scale; }
}
__device__ __forceinline__ void lin_decay(Frame& F, int mixer, int h, const LinRaw& R, float (&bcum)[8], float (&blast)[8]) {
    LAS float* TOT = (LAS float*)(F.lds + LN_TOT);
    const int s = F.tid >> 3, c = F.tid & 7, d0 = 8 * c;
    if (mixer == 0) {
        const float lg = __logf(1.0f - exp2f(-5.0f - (float)h));
#pragma unroll
        for (int j = 0; j < 8; ++j) { bcum[j] = (float)(s + 1) * lg; blast[j] = 64.0f * lg; }
        wg_sync();
        return;
    }
    const LAS float* WG = (const LAS float*)(F.lds + LN_WG);
    float grf[16]; { float a[8], b2[8]; unpack8(R.gr0, a); unpack8(R.gr1, b2);
#pragma unroll
        for (int j = 0; j < 8; ++j) { grf[j] = a[j]; grf[8 + j] = b2[j]; } }
    float x[8]; { const f32x4 b0 = *(const LAS f32x4*)(WG + 1024 + d0), b1 = *(const LAS f32x4*)(WG + 1024 + d0 + 4); x[0] = b0.x; x[1] = b0.y; x[2] = b0.z; x[3] = b0.w; x[4] = b1.x; x[5] = b1.y; x[6] = b1.z; x[7] = b1.w; }
#pragma unroll
    for (int r = 0; r < 16; ++r) { const f32x4 w0 = *(const LAS f32x4*)(WG + r * 64 + d0), w1 = *(const LAS f32x4*)(WG + r * 64 + d0 + 4);
        x[0] += grf[r] * w0.x; x[1] += grf[r] * w0.y; x[2] += grf[r] * w0.z; x[3] += grf[r] * w0.w; x[4] += grf[r] * w1.x; x[5] += grf[r] * w1.y; x[6] += grf[r] * w1.z; x[7] += grf[r] * w1.w; }
#pragma unroll
    for (int j = 0; j < 8; ++j) x[j] = logsigmoidf_(x[j]) * (1.0f / 16.0f);
#pragma unroll
    for (int st = 8; st <= 32; st <<= 1) {
#pragma unroll
        for (int j = 0; j < 8; ++j) { const float t = lane_read(x[j], F.lane - st); if (F.lane >= st) x[j] += t; } }
    if ((F.lane >> 3) == 7) { *(LAS f32x4*)(TOT + F.wave * 64 + d0) = (f32x4){x[0], x[1], x[2], x[3]}; *(LAS f32x4*)(TOT + F.wave * 64 + d0 + 4) = (f32x4){x[4], x[5], x[6], x[7]}; }
    wg_sync();
    float off[8], tot[8];
#pragma unroll
    for (int j = 0; j < 8; ++j) { off[j] = 0.f; tot[j] = 0.f; }
#pragma unroll
    for (int w = 0; w < 8; ++w) { const f32x4 t0 = *(const LAS f32x4*)(TOT + w * 64 + d0), t1 = *(const LAS f32x4*)(TOT + w * 64 + d0 + 4); const float tv[8] = {t0.x, t0.y, t0.z, t0.w, t1.x, t1.y, t1.z, t1.w};
#pragma unroll
        for (int j = 0; j < 8; ++j) { tot[j] += tv[j]; off[j] += (w < F.wave) ? tv[j] : 0.f; } }
#pragma unroll
    for (int j = 0; j < 8; ++j) { bcum[j] = x[j] + off[j]; blast[j] = tot[j]; }
}
__device__ __forceinline__ void lin_store_vt(Frame& F, const LinRaw& R) {
    LAS bf16_t* VT = (LAS bf16_t*)(F.lds + LN_VT); const int e0 = (F.tid & 15) * 8;
#pragma unroll
    for (int i = 0; i < 2; ++i) { const int s = 32 * i + (F.tid >> 4); const u32x4 w = i == 0 ? R.v0 : R.v1;
        VT[(e0 + 0) * LP + s] = (bf16_t)(w.x & 0xffffu); VT[(e0 + 1) * LP + s] = (bf16_t)(w.x >> 16); VT[(e0 + 2) * LP + s] = (bf16_t)(w.y & 0xffffu); VT[(e0 + 3) * LP + s] = (bf16_t)(w.y >> 16);
        VT[(e0 + 4) * LP + s] = (bf16_t)(w.z & 0xffffu); VT[(e0 + 5) * LP + s] = (bf16_t)(w.z >> 16); VT[(e0 + 6) * LP + s] = (bf16_t)(w.w & 0xffffu); VT[(e0 + 7) * LP + s] = (bf16_t)(w.w >> 16); }
}
__device__ __forceinline__ void lin_state_compute(Frame& F, int unit, const LinRaw& R) {
    const int h = (unit >> 6) & 3, mixer = unit >> 11; const int s = F.tid >> 3, c = F.tid & 7, d0 = 8 * c;
    LAS bf16_t* KDT = (LAS bf16_t*)(F.lds + LN_KI); LAS bf16_t* VT = (LAS bf16_t*)(F.lds + LN_VT);
    float k[8], bcum[8], blast[8];
    lin_rot(R.k0, R.k1, R, mixer == 0, c >= 4, mixer == 0 ? 0.125f : 1.0f, k);
    lin_decay(F, mixer, h, R, bcum, blast);
#pragma unroll
    for (int j = 0; j < 8; ++j) KDT[(d0 + j) * LP + s] = (bf16_t)f2bf(k[j] * __expf(blast[j] - bcum[j]));
    lin_store_vt(F, R);
    if (s == 0) { float* dc = F.DEC() + (size_t)unit * 64 + d0;
        *(f32x4*)dc = (f32x4){__expf(blast[0]), __expf(blast[1]), __expf(blast[2]), __expf(blast[3])}; *(f32x4*)(dc + 4) = (f32x4){__expf(blast[4]), __expf(blast[5]), __expf(blast[6]), __expf(blast[7])}; }
    wg_sync();
    { const int w = F.wave, lane = F.lane; float* st = F.STATE() + (size_t)unit * 8192;
#pragma unroll
      for (int dt = 0; dt < 4; ++dt) { f32x4 acc = (f32x4){0.f, 0.f, 0.f, 0.f}; acc = mma_nt_lds(VT + 16 * w * LP, LP, KDT + 16 * dt * LP, LP, 2, acc, lane);
#pragma unroll
          for (int i = 0; i < 4; ++i) st[(16 * w + 4 * (lane >> 4) + i) * 64 + 16 * dt + (lane & 15)] = acc[i]; } }
}
__device__ __forceinline__ void lin_out_compute(Frame& F, int unit, const LinRaw& R) {
    const int n = unit & 63, h = (unit >> 6) & 3, b = (unit >> 8) & 7, mixer = unit >> 11;
    const size_t row0 = (size_t)b * SEQ + (size_t)n * CH; const int s = F.tid >> 3, c = F.tid & 7, d0 = 8 * c;
    const int ycol = (mixer == 0 ? 0 : 1024) + h * 128;
    LAS bf16_t* QD = (LAS bf16_t*)(F.lds + LN_QD); LAS bf16_t* KI = (LAS bf16_t*)(F.lds + LN_KI); LAS bf16_t* PM = (LAS bf16_t*)(F.lds + LN_PM);
    LAS bf16_t* VT = (LAS bf16_t*)(F.lds + LN_VT); LAS float* OB = (LAS float*)(F.lds + LN_OB);
    float q[8], k[8], bcum[8], blast[8];
    lin_rot(R.q0, R.q1, R, mixer == 0, c >= 4, mixer == 0 ? 1.0f : 0.125f, q);
    lin_rot(R.k0, R.k1, R, mixer == 0, c >= 4, mixer == 0 ? 0.125f : 1.0f, k);
    lin_decay(F, mixer, h, R, bcum, blast);
    { float qd[8], ki[8];
#pragma unroll
      for (int j = 0; j < 8; ++j) { qd[j] = q[j] * __expf(bcum[j]); ki[j] = k[j] * __expf(-bcum[j]); }
      *(LAS u32x4*)(QD + s * LP + d0) = pack8(qd); *(LAS u32x4*)(KI + s * LP + d0) = pack8(ki); }
    lin_store_vt(F, R);
    wg_sync();
    { const int lane = F.lane;
#pragma unroll
      for (int j = 0; j < 2; ++j) { const int tile = 2 * F.wave + j, tt = tile >> 2, st = tile & 3;
          f32x4 acc = (f32x4){0.f, 0.f, 0.f, 0.f};
          if (st <= tt) acc = mma_nt_lds(QD + 16 * tt * LP, LP, KI + 16 * st * LP, LP, 2, acc, lane);
#pragma unroll
          for (int i = 0; i < 4; ++i) { const int t = 16 * tt + 4 * (lane >> 4) + i, s2 = 16 * st + (lane & 15); const float p = (st <= tt && s2 <= t) ? acc[i] : 0.f; PM[t * LP + s2] = (bf16_t)f2bf(p); } } }
    wg_sync();
    { const int w = F.wave, lane = F.lane;
#pragma unroll
      for (int tt = 0; tt < 4; ++tt) { f32x4 acc = (f32x4){0.f, 0.f, 0.f, 0.f};
          acc = mma_nt_lds(PM + 16 * tt * LP, LP, VT + 16 * w * LP, LP, 2, acc, lane);
          const LAS bf16_t* xp = QD + (16 * tt + (lane & 15)) * LP + 8 * (lane >> 4);
          acc = __builtin_amdgcn_mfma_f32_16x16x32_bf16(*(const LAS bf16x8*)xp, R.sp0, acc, 0, 0, 0);
          acc = __builtin_amdgcn_mfma_f32_16x16x32_bf16(*(const LAS bf16x8*)(xp + 32), R.sp1, acc, 0, 0, 0);
#pragma unroll
          for (int i = 0; i < 4; ++i) OB[(16 * tt + 4 * (lane >> 4) + i) * 132 + 16 * w + (lane & 15)] = acc[i]; } }
    wg_sync();
    { const int t = s, part = c; float o[16];
#pragma unroll
      for (int j = 0; j < 4; ++j) { const f32x4 v = *(const LAS f32x4*)(OB + t * 132 + 16 * part + 4 * j); o[4 * j] = v.x; o[4 * j + 1] = v.y; o[4 * j + 2] = v.z; o[4 * j + 3] = v.w; }
      float sm = 0.f;
#pragma unroll
      for (int j = 0; j < 16; ++j) sm += o[j];
      sm += lane_read(sm, F.lane ^ 1); sm += lane_read(sm, F.lane ^ 2); sm += lane_read(sm, F.lane ^ 4);
      const float mu = sm * (1.0f / 128.0f); float qv = 0.f;
#pragma unroll
      for (int j = 0; j < 16; ++j) { const float dlt = o[j] - mu; qv += dlt * dlt; }
      qv += lane_read(qv, F.lane ^ 1); qv += lane_read(qv, F.lane ^ 2); qv += lane_read(qv, F.lane ^ 4);
      const float r = 1.0f / sqrtf(qv * (1.0f / 128.0f) + EPS);
      float g0[8], g1[8]; unpack8(R.g0, g0); unpack8(R.g1, g1);
      float y0[8], y1[8];
#pragma unroll
      for (int j = 0; j < 8; ++j) { y0[j] = (o[j] - mu) * r * siluf_(g0[j]); y1[j] = (o[8 + j] - mu) * r * siluf_(g1[j]); }
      bf16_t* yp = F.Y() + (row0 + t) * D + ycol + 16 * part; *(u32x4*)yp = pack8(y0); *(u32x4*)(yp + 8) = pack8(y1); }
}
template <bool OUT>
__device__ __forceinline__ void lin_phase(Frame& F, int l) {
    { const int h = (F.vcu >> 6) & 3; LAS float* WG = (LAS float*)(F.lds + LN_WG);
      for (int i = F.tid; i < 16 * 64 + 64; i += NWAVES * 64) WG[i] = (i < 1024) ? F.gla_wg()[(size_t)l * 16 * 256 + (i >> 6) * 256 + h * 64 + (i & 63)] : F.gla_bg()[l * 256 + h * 64 + (i - 1024)];
      wg_sync(); }
    LinRaw A, B;
    lin_issue<OUT>(F, F.vcu, A);
    for (int u = F.vcu; u < 4096; u += 2 * F.G) {
        lin_issue<OUT>(F, u + F.G, B);
        if (OUT) lin_out_compute(F, u, A); else lin_state_compute(F, u, A);
        if (u + 2 * F.G < 4096) lin_issue<OUT>(F, u + 2 * F.G, A);
        if (OUT) lin_out_compute(F, u + F.G, B); else lin_state_compute(F, u + F.G, B);
    }
    wg_sync();
}
__device__ __forceinline__ void lin_scan(Frame& F) {
    const int gt = F.vcu * (NWAVES * 64) + F.tid, NGT = F.G * NWAVES * 64;
    for (int i = gt; i < 64 * 8192; i += NGT) {
        const int seq = i >> 13, idx = i & 8191, d = idx & 63;
        const float* st = F.STATE() + (size_t)seq * NCH * 8192 + idx; const float* dc = F.DEC() + (size_t)seq * NCH * 64 + d; bf16_t* sp = F.SPREV() + (size_t)seq * NCH * 8192 + idx;
        float carry = 0.f; asm volatile("" : "+v"(carry));
#pragma unroll
        for (int h = 0; h < 2; ++h) {
            float v[32], c[32];
#pragma unroll
            for (int n = 0; n < 32; ++n) { v[n] = st[(size_t)(32 * h + n) * 8192]; c[n] = dc[(size_t)(32 * h + n) * 64]; }
#pragma unroll
            for (int n = 0; n < 32; ++n) { sp[(size_t)(32 * h + n) * 8192] = (bf16_t)f2bf(carry); carry = c[n] * carry + v[n]; asm volatile("" : "+v"(carry)); }
        }
    }
}
constexpr int S5_WL = 16384, S5_BU = 2048, S5_X = 2048 + 8320;
template <bool OUT>
__device__ __forceinline__ void s5_pass(Frame& F, int l) {
    LAS bf16_t* UT = (LAS bf16_t*)(F.lds + F.wave * S5_WL); LAS float* BU = (LAS float*)(F.lds + F.wave * S5_WL + S5_BU); LAS bf16_t* X = (LAS bf16_t*)(F.lds + F.wave * S5_WL + S5_X);
    const int gw = F.vcu * NWAVES + F.wave, NGW = F.G * NWAVES, lane = F.lane, lr = lane & 15, lq = lane >> 4;
    u32x4 ua, uc;
    { const int g = gw & 31, n = (gw >> 5) & 63, b = gw >> 11; const bf16_t* up = F.PROJ() + ((size_t)b * SEQ + (size_t)n * CH + lane) * NIN + C_SU + g * 16; ua = *(const u32x4*)up; uc = *(const u32x4*)(up + 8); }
    for (int unit = gw; unit < BATCH * NCH * 32; unit += NGW) {
        const int g = unit & 31, n = (unit >> 5) & 63, b = unit >> 11; const size_t row0 = (size_t)b * SEQ + (size_t)n * CH;
        *(LAS u32x4*)(UT + lane * 16) = ua; *(LAS u32x4*)(UT + lane * 16 + 8) = uc;
        if (unit + NGW < BATCH * NCH * 32) { const int un = unit + NGW, g2 = un & 31, n2 = (un >> 5) & 63, b2 = un >> 11;
            const bf16_t* up = F.PROJ() + ((size_t)b2 * SEQ + (size_t)n2 * CH + lane) * NIN + C_SU + g2 * 16; ua = *(const u32x4*)up; uc = *(const u32x4*)(up + 8); }
        const int gp = g * 64 + lane; const float ar = F.abar()[2 * gp], ai = F.abar()[2 * gp + 1];
        bf16x8 bfr[8];
#pragma unroll
        for (int q = 0; q < 8; ++q) { bfr[q] = (bf16x8){0, 0, 0, 0, 0, 0, 0, 0}; if (lq < 2) bfr[q] = *(const bf16x8*)(F.bbt() + ((size_t)g * 128 + 16 * q + lr) * 16 + 8 * lq); }
        float xr = 0.f, xi = 0.f;
        bf16x8 cf[4]; float dsk = 0.f;
        if (OUT) { const f32x2 x0 = *(const f32x2*)(F.XEND() + ((((size_t)(b * 32 + g)) * NCH + n) * 64 + lane) * 2); xr = x0.x; xi = x0.y;
#pragma unroll
            for (int ks = 0; ks < 4; ++ks) cf[ks] = *(const bf16x8*)(F.cmt() + ((size_t)(g * 16 + lr)) * 128 + 32 * ks + 8 * lq);
            dsk = F.s5_d()[(size_t)l * BW + g * 16 + lr]; }
        LDS_WAIT();
        for (int sb = 0; sb < 4; ++sb) {
            bf16x8 af = (bf16x8){0, 0, 0, 0, 0, 0, 0, 0}; if (lq < 2) af = *(const LAS bf16x8*)(UT + (16 * sb + lr) * 16 + 8 * lq);
#pragma unroll
            for (int q = 0; q < 8; ++q) { f32x4 acc = (f32x4){0.f, 0.f, 0.f, 0.f}; acc = __builtin_amdgcn_mfma_f32_16x16x32_bf16(af, bfr[q], acc, 0, 0, 0);
#pragma unroll
                for (int i = 0; i < 4; ++i) BU[(4 * lq + i) * 130 + 16 * q + lr] = acc[i]; }
            LDS_WAIT();
            float br[16], bi[16];
#pragma unroll
            for (int tt = 0; tt < 16; ++tt) { br[tt] = BU[tt * 130 + lane]; bi[tt] = BU[tt * 130 + 64 + lane]; }
#pragma unroll
            for (int tt = 0; tt < 16; ++tt) { const float nr = ar * xr - ai * xi + br[tt], ni = ar * xi + ai * xr + bi[tt]; xr = nr; xi = ni; asm volatile("" : "+v"(xr), "+v"(xi));
                if (OUT) { X[tt * 136 + lane] = (bf16_t)f2bf(xr); X[tt * 136 + 64 + lane] = (bf16_t)f2bf(xi); } }
            if (OUT) {
                LDS_WAIT();
                f32x4 acc = (f32x4){0.f, 0.f, 0.f, 0.f}; const LAS bf16_t* xp = X + lr * 136 + 8 * lq;
#pragma unroll
                for (int ks = 0; ks < 4; ++ks) acc = __builtin_amdgcn_mfma_f32_16x16x32_bf16(*(const LAS bf16x8*)(xp + 32 * ks), cf[ks], acc, 0, 0, 0);
#pragma unroll
                for (int i = 0; i < 4; ++i) { const int tl = 16 * sb + 4 * lq + i; const float u = bflo((unsigned)UT[tl * 16 + lr]); const float y = gelu_tanh(acc[i] + dsk * u);
                    F.YBP()[(row0 + tl) * BW + g * 16 + lr] = (bf16_t)f2bf(y); }
            }
            LDS_WAIT();
        }
        if (!OUT) *(f32x2*)(F.XEND() + ((((size_t)(b * 32 + g)) * NCH + n) * 64 + lane) * 2) = (f32x2){xr, xi};
    }
}
__device__ __forceinline__ void s5_scan(Frame& F) {
    const int gt = F.vcu * (NWAVES * 64) + F.tid, NGT = F.G * NWAVES * 64;
    for (int i = gt; i < BATCH * 32 * 64; i += NGT) {
        const int p = i & 63, bg = i >> 6, g = bg & 31; const float pr = F.apow()[2 * (g * 64 + p)], pi = F.apow()[2 * (g * 64 + p) + 1];
        f32x2* xp = (f32x2*)(F.XEND() + (((size_t)bg * NCH) * 64 + p) * 2);
        float cr = 0.f, ci = 0.f; asm volatile("" : "+v"(cr), "+v"(ci));
#pragma unroll
        for (int h = 0; h < 2; ++h) {
            f32x2 v[32];
#pragma unroll
            for (int n = 0; n < 32; ++n) v[n] = xp[(size_t)(32 * h + n) * 64];
#pragma unroll
            for (int n = 0; n < 32; ++n) { xp[(size_t)(32 * h + n) * 64] = (f32x2){cr, ci};
                const float nr = pr * cr - pi * ci + v[n].x, ni = pr * ci + pi * cr + v[n].y; cr = nr; ci = ni; asm volatile("" : "+v"(cr), "+v"(ci)); }
        }
    }
}

__device__ __forceinline__ void pool_phase(Frame& F, int l) {
    const int gw = F.vcu * NWAVES + F.wave, NGW = F.G * NWAVES, lane = F.lane, lr = lane & 15, lq = lane >> 4;
    for (int unit = gw; unit < BATCH * (SEQ / 16) * 4; unit += NGW) {
        const int g = unit & 3, tile = (unit >> 2) & 255, b = unit >> 10; const int win = 2 << g, tpos = 16 * tile + lr; const size_t row = (size_t)b * SEQ + tpos;
        const bf16_t* pp = F.PROJ() + row * NIN + C_PU + g * 128 + 8 * lq;
        float s[4][8];
#pragma unroll
        for (int ks = 0; ks < 4; ++ks)
#pragma unroll
            for (int j = 0; j < 8; ++j) s[ks][j] = 0.f;
        for (int jj = 1; jj < win; ++jj) { if (tpos - jj >= 0) {
#pragma unroll
            for (int ks = 0; ks < 4; ++ks) { float a[8]; unpack8(*(const u32x4*)(pp - (size_t)jj * NIN + 32 * ks), a);
#pragma unroll
                for (int j = 0; j < 8; ++j) s[ks][j] += a[j]; } } }
        const float inv = 1.0f / (float)min(tpos + 1, win);
        bf16x8 mf[4];
#pragma unroll
        for (int ks = 0; ks < 4; ++ks) { float a[8], m[8]; unpack8(*(const u32x4*)(pp + 32 * ks), a);
#pragma unroll
            for (int j = 0; j < 8; ++j) m[j] = (s[ks][j] + a[j]) * inv - a[j];
            const u32x4 w = pack8(m); mf[ks] = __builtin_bit_cast(bf16x8, w); }
        const bf16_t* pw = F.poolw_t() + (size_t)g * 128 * 128 + (size_t)lr * 128 + 8 * lq;
#pragma unroll
        for (int q = 0; q < 8; ++q) { f32x4 acc = (f32x4){0.f, 0.f, 0.f, 0.f};
#pragma unroll
            for (int ks = 0; ks < 4; ++ks) acc = __builtin_amdgcn_mfma_f32_16x16x32_bf16(*(const bf16x8*)(pw + (size_t)(16 * q) * 128 + 32 * ks), mf[ks], acc, 0, 0, 0);
            const int dcol = g * 128 + 16 * q + 4 * lq; const f32x4 sc = *(const f32x4*)(F.pool_scale() + (size_t)l * BW + dcol);
            u32x2 w; w.x = pk2(acc[0] * sc.x, acc[1] * sc.y); w.y = pk2(acc[2] * sc.z, acc[3] * sc.w);
            *(u32x2*)(F.Y() + row * D + 1536 + dcol) = w; }
    }
}

__device__ __forceinline__ void conv_fix_phase(Frame& F, int l) {
    const float* cw = F.conv_w() + (size_t)l * 3 * NUP; const float* cb = F.conv_b() + (size_t)l * NUP; const float* UH = F.UH();
    const int gt = F.vcu * (NWAVES * 64) + F.tid, NGT = F.G * NWAVES * 64;
    constexpr int JG = DFF / 4;
    for (int task = gt; task < (M / 256) * 2 * JG; task += NGT) {
        const int jg = task % JG, q = (task / JG) & 1, pm = task / (2 * JG);
        if ((pm & 15) == 0) continue;
        const int j0 = jg * 4, ucol = 256 * (j0 >> 7) + (j0 & 127);
        const float* u0p = UH + ((size_t)pm * 4 + q) * NUP + ucol;
        const float* u1p = (q == 1) ? UH + ((size_t)pm * 4 + 0) * NUP + ucol : UH + ((size_t)(pm - 1) * 4 + 3) * NUP + ucol;
        const float* u2p = (q == 1) ? UH + ((size_t)(pm - 1) * 4 + 3) * NUP + ucol : UH + ((size_t)(pm - 1) * 4 + 2) * NUP + ucol;
        const f32x4 a0 = *(const f32x4*)u0p, a1 = *(const f32x4*)u1p, a2 = *(const f32x4*)u2p, v0 = *(const f32x4*)(u0p + 128), v1 = *(const f32x4*)(u1p + 128), v2 = *(const f32x4*)(u2p + 128);
        const f32x4 wa0 = *(const f32x4*)(cw + j0), wa1 = *(const f32x4*)(cw + NUP + j0), wa2 = *(const f32x4*)(cw + 2 * NUP + j0), ba = *(const f32x4*)(cb + j0);
        const f32x4 wv0 = *(const f32x4*)(cw + DFF + j0), wv1 = *(const f32x4*)(cw + NUP + DFF + j0), wv2 = *(const f32x4*)(cw + 2 * NUP + DFF + j0), bv = *(const f32x4*)(cb + DFF + j0);
        float o[4];
#pragma unroll
        for (int i = 0; i < 4; ++i) { const float ca = ba[i] + wa0[i] * a2[i] + wa1[i] * a1[i] + wa2[i] * a0[i], cv = bv[i] + wv0[i] * v2[i] + wv1[i] * v1[i] + wv2[i] * v0[i]; o[i] = siluf_(ca) * cv; }
        u32x2 w; w.x = pk2(o[0], o[1]); w.y = pk2(o[2], o[3]);
        *(u32x2*)(F.ACT() + ((size_t)pm * 256 + q) * DFF + j0) = w;
    }
}

constexpr int NPH = 13;
struct Args { const void* in[25]; float* out; unsigned char* ws; int l_lo, l_hi, ph_lo, ph_hi, single, pad; };
__global__ void __launch_bounds__(NWAVES * 64, 2) hybrid_fwd(Args args) {
    extern __shared__ __attribute__((aligned(16))) unsigned char lds[];
    Frame F;
    F.lds = (LAS unsigned char*)lds;
    F.tid = threadIdx.x; F.lane = F.tid & 63; F.wave = __builtin_amdgcn_readfirstlane(F.tid >> 6);
    const int wave0 = F.wave;
    F.G = gridDim.x; { const int bx = blockIdx.x; F.vcu = (F.G % 8 == 0) ? (bx % 8) * (F.G / 8) + bx / 8 : bx; }
    unsigned char* ws = args.ws; F.ws = ws; F.out = args.out; F.l = 0;

    volatile LAS unsigned* MISC = (volatile LAS unsigned*)(F.lds + MISC_OFF);
    if (F.tid < 64) MISC[F.tid] = 0u;
    wg_sync();
    unsigned* ctl = (unsigned*)(ws + WS_CTL);
    XcdBarrier bar; bar.bar = ctl + CW_BAR; bar.x = 0; bar.st = nullptr;
    if (args.single) bar = xcd_barrier_post(ctl + CW_BAR, MISC);
#define GRID_BAR() do { if (args.single) xcd_barrier(bar); } while (0)
    const int lo = args.ph_lo, hi = args.ph_hi;
#define IN(k) (lo <= (k) && (k) < hi)
#define PH_BEGIN() do { unsigned z_ = 0u; asm volatile("" : "+v"(z_)); const int ln_ = (int)__builtin_amdgcn_mbcnt_hi(~0u, __builtin_amdgcn_mbcnt_lo(~0u, z_)); F.lane = ln_; F.tid = wave0 * 64 + ln_; F.wave = wave0; unsigned long long w_ = (unsigned long long)args.ws, o_ = (unsigned long long)args.out; asm volatile("" : "+s"(w_), "+s"(o_)); F.ws = (unsigned char*)(GAS unsigned char*)w_; F.out = (float*)(GAS float*)o_; } while (0)

    for (int l = args.l_lo; l < args.l_hi; ++l) {
        const float* hsrc = (l == 0) ? F.x() : F.out;
        F.l = l;
        if (IN(0)) { PH_BEGIN(); phase_prep(F, l); GRID_BAR(); }
        if (IN(1)) { PH_BEGIN();
            { pg8::Gemm g{(const bf16_t*)F.HN8(), (const bf16_t*)F.W8(), M, 4 * D, D / 2, D / 2, D / 2}; pg8::StaticOrder S; S.init(M, 4 * D, F.G, (int)blockIdx.x); pg8::EpiProj E{F.PROJ(), NIN, 0, C_GATE, 1.0f / 64.0f};
              pg8::gemm_phase<pg8::EpiProj, true>(F.lds, g, S, E, F.tid); }
            PH_BEGIN();
            { pg8::Gemm g{F.HN(), F.win_t(), M, C_GATE, D, D, D}; pg8::StaticOrder S; S.init(M, C_GATE, F.G, (int)blockIdx.x); pg8::EpiProj E{F.PROJ(), NIN, 1 << 20, C_GATE, 1.0f};
              pg8::gemm_phase(F.lds, g, S, E, F.tid); }
            GRID_BAR(); }
        if (IN(2)) { PH_BEGIN(); lin_phase<false>(F, l); PH_BEGIN();
            s5_pass<false>(F, l); pool_phase(F, l); wg_sync();
            GRID_BAR(); }
        if (IN(3)) { PH_BEGIN(); lin_scan(F); s5_scan(F); GRID_BAR(); }
        if (IN(4)) { PH_BEGIN(); lin_phase<true>(F, l); PH_BEGIN();
            s5_pass<true>(F, l); wg_sync();
            GRID_BAR(); }
        if (IN(5)) { PH_BEGIN(); pg8::Gemm g{F.YBP(), F.wglu_t(), M, BW, BW, BW, BW}; pg8::StaticOrder S; S.init(M, BW, F.G, (int)blockIdx.x); pg8::EpiGlu E{F.YBP(), BW, F.Y() + BW, D};
            pg8::gemm_phase(F.lds, g, S, E, F.tid); GRID_BAR(); }
        if (IN(6)) { PH_BEGIN(); pg8::Gemm g{F.Y(), F.wbr_t(), M, D, D, D, D}; pg8::StaticOrder S; S.init(M, D, F.G, (int)blockIdx.x); pg8::EpiMerge E{F.PROJ() + C_GATE, NIN, F.HN(), D};
            pg8::gemm_phase(F.lds, g, S, E, F.tid); GRID_BAR(); }
        if (IN(7)) { PH_BEGIN(); pg8::Gemm g{F.HN(), F.wout_t(), M, D, D, D, D}; pg8::StaticOrder S; S.init(M, D, F.G, (int)blockIdx.x); pg8::EpiResid E{hsrc, F.out, D, F.Y(), F.SS()};
            pg8::gemm_phase(F.lds, g, S, E, F.tid); GRID_BAR(); }
        if (IN(8)) { PH_BEGIN(); row_scale(F); GRID_BAR(); }
        if (IN(9)) { PH_BEGIN(); pg8::Gemm g{F.Y(), F.wup_t(), M, NUP, D, D, D}; pg8::StaticOrder S; S.init(M, NUP, F.G, (int)blockIdx.x); pg8::EpiConv E{F.conv_w() + (size_t)l * 3 * NUP, F.conv_b() + (size_t)l * NUP, F.ACT(), F.UH(), (LAS float*)(F.lds + pg8::STAGE_BYTES), F.RS()};
            pg8::gemm_phase(F.lds, g, S, E, F.tid); GRID_BAR(); }
        if (IN(10)) { PH_BEGIN(); conv_fix_phase(F, l); GRID_BAR(); }
        if (IN(11)) { PH_BEGIN(); pg8::Gemm g{F.ACT(), F.wdn_t(), M, D, DFF, DFF, DFF}; pg8::StaticOrder S; S.init(M, D, F.G, (int)blockIdx.x); pg8::EpiResid E{F.out, F.out, D, nullptr, nullptr};
            pg8::gemm_phase(F.lds, g, S, E, F.tid); GRID_BAR(); }
        if (IN(12) && l == DEPTH - 1) { PH_BEGIN(); rms_rows_f32_inplace(F, F.out, F.g_final()); }
    }
#undef IN
#undef PH_BEGIN
#undef GRID_BAR
}

#pragma clang attribute pop
extern "C" void kernel_launch(void* const* d_in, const int* in_sizes, int n_in, void* d_out, int out_size, void* d_ws, size_t ws_size, hipStream_t stream) {
    static int grid = 0;
    if (grid == 0) {
        if (n_in != 25 || in_sizes[0] != M * D || out_size != M * D || ws_size < WS_END) { fprintf(stderr, "kernel_launch: shape/workspace mismatch (n_in %d, in0 %d, out %d, ws %zu, need %zu); nothing launched\n", n_in, n_in > 0 ? in_sizes[0] : -1, out_size, ws_size, (size_t)WS_END); grid = -1; return; }
        int dev = 0, cus = 0, per_cu = 0;
        if (hipGetDevice(&dev) != hipSuccess || hipDeviceGetAttribute(&cus, hipDeviceAttributeMultiprocessorCount, dev) != hipSuccess) { grid = -1; return; }
        if (hipFuncSetAttribute((const void*)hybrid_fwd, hipFuncAttributeMaxDynamicSharedMemorySize, LDS_BYTES) != hipSuccess) { fprintf(stderr, "kernel_launch: hipFuncSetAttribute failed\n"); grid = -1; return; }
        if (hipOccupancyMaxActiveBlocksPerMultiprocessor(&per_cu, (const void*)hybrid_fwd, NWAVES * 64, LDS_BYTES) != hipSuccess || per_cu < 1) { fprintf(stderr, "kernel_launch: occupancy query reports %d workgroups per CU\n", per_cu); }
        (void)hipGetLastError();
        grid = cus;
    }
    if (grid < 0) return;
    if (hipMemsetAsync((char*)d_ws + WS_CTL, 0, CTL_ZERO_BYTES, stream) != hipSuccess) return;
    Args a{};
    for (int i = 0; i < 25; ++i) a.in[i] = d_in[i];
    a.out = (float*)d_out; a.ws = (unsigned char*)d_ws;
#if MK_SINGLE
    a.l_lo = 0; a.l_hi = DEPTH; a.ph_lo = 0; a.ph_hi = NPH; a.single = 1;
    hipLaunchKernelGGL(hybrid_fwd, dim3(grid), dim3(NWAVES * 64), LDS_BYTES, stream, a);
#else
    a.single = 0;
    for (int l = 0; l < DEPTH; ++l)
        for (int p = 0; p < NPH; ++p) { if (p == 12 && l != DEPTH - 1) continue; a.l_lo = l; a.l_hi = l + 1; a.ph_lo = p; a.ph_hi = p + 1;
            hipLaunchKernelGGL(hybrid_fwd, dim3(grid), dim3(NWAVES * 64), LDS_BYTES, stream, a); }
#endif
}
```

```cpp
#include <hip/hip_runtime.h>
#include <cstdio>
#include <cstdint>

#ifndef MK_SINGLE
#define MK_SINGLE 1
#endif

#pragma clang attribute push(__attribute__((target("no-packed-fp32-ops"))), apply_to = function)
#define LAS __attribute__((address_space(3)))
#define GAS __attribute__((address_space(1)))
typedef unsigned short bf16_t;
typedef short bf16x8 __attribute__((ext_vector_type(8)));
typedef float f32x4 __attribute__((ext_vector_type(4)));
typedef float f32x2 __attribute__((ext_vector_type(2)));
typedef unsigned u32x4 __attribute__((ext_vector_type(4)));
typedef unsigned u32x2 __attribute__((ext_vector_type(2)));

constexpr int D = 2048, BATCH = 8, SEQ = 4096, DEPTH = 4, M = BATCH * SEQ;
constexpr int BW = 512;
constexpr int NIN_SRC = 12304, NIN = 12544;
constexpr int DFF = 5504, NUP = 11008;
constexpr int C_RQ = 0, C_RK = 256, C_RV = 512, C_RG = 1024, C_SU = 1536, C_GQ = 2048, C_GK = 2304, C_GV = 2560, C_GG = 3072, C_PU = 3584, C_GR = 4096, C_GATE = 4352;
constexpr float EPS = 1e-6f;
constexpr int NWAVES = 8;
constexpr int CH = 64;
constexpr int NCH = SEQ / CH;

constexpr size_t MiB = 1u << 20;
constexpr size_t WS_CTL = 0, CTL_ZERO_BYTES = 1 * MiB;
constexpr size_t WS_ROT = 1 * MiB;
constexpr size_t WS_S5T = 9 * MiB;
constexpr size_t S5T_ABAR = 0, S5T_APOW = 16384, S5T_BBAR = 32768, S5T_CMT = 32768 + 262144, S5T_BBT = S5T_CMT + 131072;
constexpr size_t WS_WGLU = 10 * MiB;
constexpr size_t WS_POOLW = 10 * MiB + 512 * 1024;
constexpr size_t WS_WIN = 11 * MiB;
constexpr size_t WS_WBR = 60 * MiB;
constexpr size_t WS_WOUT = 68 * MiB;
constexpr size_t WS_WUP = 76 * MiB;
constexpr size_t WS_WDN = 119 * MiB;
constexpr size_t WS_HN = 141 * MiB;
constexpr size_t WS_Y = 269 * MiB;
constexpr size_t WS_SCR = 397 * MiB;
constexpr size_t WS_YBP = WS_SCR;
constexpr size_t WS_STATE = WS_SCR + 32 * MiB;
constexpr size_t WS_SPREV = WS_SCR + 160 * MiB;
constexpr size_t WS_DEC = WS_SCR + 224 * MiB;
constexpr size_t WS_XEND = WS_SCR + 225 * MiB;
constexpr size_t WS_UH = WS_SCR + 128 * MiB;
constexpr size_t WS_PROJ = 637 * MiB;
constexpr size_t WS_ACT = WS_PROJ;
constexpr size_t WS_RS = 1421 * MiB;
constexpr size_t WS_SS = 1422 * MiB;
constexpr size_t WS_HN8 = 1438 * MiB;
constexpr size_t WS_W8 = 1502 * MiB;
constexpr size_t WS_END = 1518 * MiB;
static_assert(WS_PROJ + (size_t)M * NIN * 2 <= WS_RS, "ws map");
static_assert(WS_ACT + (size_t)M * DFF * 2 <= WS_RS, "ws map");
static_assert(WS_XEND + 8 * MiB <= WS_PROJ, "ws map");
static_assert(WS_UH + (size_t)(M / 256) * 4 * NUP * 4 <= WS_PROJ, "ws map");
constexpr int CW_TMO = 0, CW_BAR = 4096;

constexpr int LDS_BYTES = 155648;
constexpr int MISC_OFF = LDS_BYTES - 256;

#define RLX_AGENT __ATOMIC_RELAXED, __HIP_MEMORY_SCOPE_AGENT
__device__ __forceinline__ void wg_sync() { __builtin_amdgcn_fence(__ATOMIC_RELEASE, "workgroup"); __builtin_amdgcn_s_barrier(); __builtin_amdgcn_fence(__ATOMIC_ACQUIRE, "workgroup"); }
#define LDS_WAIT() asm volatile("s_waitcnt lgkmcnt(0)" ::: "memory")
#define VM_WAIT() asm volatile("s_waitcnt vmcnt(0)" ::: "memory")
__device__ __forceinline__ unsigned f2bf(float f) { unsigned u = __builtin_bit_cast(unsigned, f); return (u + 0x7fffu + ((u >> 16) & 1u)) >> 16; }
__device__ __forceinline__ unsigned pk2(float lo, float hi) { return f2bf(lo) | (f2bf(hi) << 16); }
__device__ __forceinline__ float bflo(unsigned w) { return __builtin_bit_cast(float, w << 16); }
__device__ __forceinline__ float bfhi(unsigned w) { return __builtin_bit_cast(float, w & 0xffff0000u); }
__device__ __forceinline__ void unpack8(const u32x4 w, float (&v)[8]) { v[0] = bflo(w.x); v[1] = bfhi(w.x); v[2] = bflo(w.y); v[3] = bfhi(w.y); v[4] = bflo(w.z); v[5] = bfhi(w.z); v[6] = bflo(w.w); v[7] = bfhi(w.w); }
__device__ __forceinline__ u32x4 pack8(const float (&v)[8]) { u32x4 w; w.x = pk2(v[0], v[1]); w.y = pk2(v[2], v[3]); w.z = pk2(v[4], v[5]); w.w = pk2(v[6], v[7]); return w; }
__device__ __forceinline__ unsigned pk4_fp8(float a, float b, float c, float d) { unsigned w = 0u; w = __builtin_amdgcn_cvt_pk_fp8_f32(a, b, w, false); w = __builtin_amdgcn_cvt_pk_fp8_f32(c, d, w, true); return w; }
__device__ __forceinline__ float sigmoidf_(float x) { return 1.0f / (1.0f + __expf(-x)); }
__device__ __forceinline__ float siluf_(float x) { return x / (1.0f + __expf(-x)); }
__device__ __forceinline__ float gelu_tanh(float x) { const float u = 1.5957691216f * (x + 0.044715f * x * x * x); return x / (1.0f + __expf(-u)); }
__device__ __forceinline__ float logsigmoidf_(float x) { return fminf(x, 0.f) - __logf(1.0f + __expf(-fabsf(x))); }

namespace pg8 {
constexpr int BM = 256, BK = 64, HALF = 128, HTB = HALF * BK * 2, STAGE_BYTES = 8 * HTB, NXCD = 8, WGM = 8;
__host__ __device__ __forceinline__ int lds_byte(int r, int c) { const int st = (r >> 4) * 2 + (c >> 5), rr = r & 15, cc = c & 31, ob = rr * 64 + cc * 2; return st * 1024 + (ob ^ (((ob >> 9) & 1) << 5)); }
__host__ __device__ __forceinline__ void stage_rc(int b, int& R, int& C) { const int st = b / 1024, sb = b % 1024, swz = sb ^ (((sb >> 9) & 1) << 5); R = (st >> 1) * 16 + swz / 64; C = (st & 1) * 32 + (swz % 64) / 2; }
__host__ __device__ __forceinline__ int perm32(int rho) { const int n = rho >> 4, i = rho & 15; return 8 * (i >> 2) + 4 * n + (i & 3); }

struct Unit { int pm, pn; };
struct Gemm { const bf16_t* A; const bf16_t* Bt; int M, N, K, lda, ldb; };

struct StaticOrder {
    int nM, nN, nwg, G, c;
    __host__ __device__ void init(int M_, int N_, int G_, int c_) { nM = M_ / BM; nN = N_ / BM; nwg = nM * nN; G = G_; c = c_; }
    __host__ __device__ bool next(int i, Unit& u) const {
        const long L = (long)i * G + c; if (L >= nwg) return false;
        int wgid = (int)L; { const int q = nwg / NXCD, r = nwg % NXCD, xcd = wgid % NXCD, off = wgid / NXCD; wgid = (xcd < r ? xcd * (q + 1) : r * (q + 1) + (xcd - r) * q) + off; }
        const int nig = WGM * nN, gid = wgid / nig, fm = gid * WGM, gsz = (nM - fm) < WGM ? (nM - fm) : WGM;
        u.pm = fm + ((wgid % nig) % gsz); u.pn = (wgid % nig) / gsz; return true;
    }
};

__device__ __forceinline__ unsigned cvt_pk_bf16(float lo, float hi) { unsigned r; asm volatile("v_cvt_pk_bf16_f32 %0, %1, %2" : "=v"(r) : "v"(lo), "v"(hi)); return r; }

struct EpiStoreBf16 {
    static constexpr bool PERM = true, KHOOK = false;
    bf16_t* O; int ldc;
    __device__ __forceinline__ void khook(f32x4 (&)[2][2][4][2], const Unit&, int, int, int, int, int) const {}
    __device__ __forceinline__ void operator()(f32x4 (&acc)[2][2][4][2], const Unit& u, int wr, int wc, int fr, int fq) const {
        const int row0 = u.pm * BM + wr * 64 + fr, col0 = u.pn * BM + wc * 32 + 8 * fq;
#pragma unroll
        for (int ai = 0; ai < 2; ++ai)
#pragma unroll
            for (int m = 0; m < 4; ++m) { bf16_t* rowp = O + (size_t)(row0 + ai * HALF + m * 16) * ldc + col0;
#pragma unroll
                for (int bj = 0; bj < 2; ++bj) { const f32x4 v0 = acc[ai][bj][m][0], v1 = acc[ai][bj][m][1];
                    u32x4 w; w.x = cvt_pk_bf16(v0[0], v0[1]); w.y = cvt_pk_bf16(v0[2], v0[3]); w.z = cvt_pk_bf16(v1[0], v1[1]); w.w = cvt_pk_bf16(v1[2], v1[3]);
                    *(u32x4*)(rowp + bj * HALF) = w; } }
    }
};
struct EpiProj {
    static constexpr bool PERM = true, KHOOK = false;
    bf16_t* O; int ldc; int gate_pn0; int gate_col0; float gscale;
    __device__ __forceinline__ void khook(f32x4 (&)[2][2][4][2], const Unit&, int, int, int, int, int) const {}
    __device__ __forceinline__ void operator()(f32x4 (&acc)[2][2][4][2], const Unit& u, int wr, int wc, int fr_, int fq_) const {
        int fr = fr_, fq = fq_; asm volatile("" : "+v"(fr), "+v"(fq));
        const int row0 = u.pm * BM + wr * 64 + fr;
        if (u.pn < gate_pn0) {
            const int col0 = u.pn * BM + wc * 32 + 8 * fq;
#pragma unroll
            for (int ai = 0; ai < 2; ++ai)
#pragma unroll
                for (int m = 0; m < 4; ++m) { bf16_t* rowp = O + (size_t)(row0 + ai * HALF + m * 16) * ldc + col0;
#pragma unroll
                    for (int bj = 0; bj < 2; ++bj) { const f32x4 v0 = acc[ai][bj][m][0], v1 = acc[ai][bj][m][1];
                        u32x4 w; w.x = cvt_pk_bf16(v0[0], v0[1]); w.y = cvt_pk_bf16(v0[2], v0[3]); w.z = cvt_pk_bf16(v1[0], v1[1]); w.w = cvt_pk_bf16(v1[2], v1[3]);
                        *(u32x4*)(rowp + bj * HALF) = w; } }
        } else {
            const int col0 = gate_col0 + 64 * (u.pn - gate_pn0) + 16 * wc + 4 * fq;
#pragma unroll
            for (int ai = 0; ai < 2; ++ai)
#pragma unroll
                for (int m = 0; m < 4; ++m) { bf16_t* rowp = O + (size_t)(row0 + ai * HALF + m * 16) * ldc + col0;
                    float r1[4], r2[4], r3[4], g3[4];
#pragma unroll
                    for (int i = 0; i < 4; ++i) {
                        const float e0 = __expf(-fminf(fmaxf(acc[ai][0][m][0][i] * gscale, -30.f), 30.f)), e1 = __expf(-fminf(fmaxf(acc[ai][0][m][1][i] * gscale, -30.f), 30.f));
                        const float e2 = __expf(-fminf(fmaxf(acc[ai][1][m][0][i] * gscale, -30.f), 30.f)), e3 = __expf(-fminf(fmaxf(acc[ai][1][m][1][i] * gscale, -30.f), 30.f));
                        const float i0 = __builtin_amdgcn_rcpf(1.f + e0), i1 = __builtin_amdgcn_rcpf(1.f + e1), i2 = __builtin_amdgcn_rcpf(1.f + e2), i3 = __builtin_amdgcn_rcpf(1.f + e3);
                        r1[i] = (1.f + e1) * i0; r2[i] = (1.f + e2) * i1; r3[i] = (1.f + e3) * i2; g3[i] = i3; }
                    u32x2 w;
                    w.x = cvt_pk_bf16(r1[0], r1[1]); w.y = cvt_pk_bf16(r1[2], r1[3]); *(u32x2*)(rowp) = w;
                    w.x = cvt_pk_bf16(r2[0], r2[1]); w.y = cvt_pk_bf16(r2[2], r2[3]); *(u32x2*)(rowp + D) = w;
                    w.x = cvt_pk_bf16(r3[0], r3[1]); w.y = cvt_pk_bf16(r3[2], r3[3]); *(u32x2*)(rowp + 2 * D) = w;
                    w.x = cvt_pk_bf16(g3[0], g3[1]); w.y = cvt_pk_bf16(g3[2], g3[3]); *(u32x2*)(rowp + 3 * D) = w; }
        }
    }
};
__device__ __forceinline__ float dpp_ror1(float x) { return __builtin_bit_cast(float, __builtin_amdgcn_update_dpp(0, __builtin_bit_cast(int, x), 0x121, 0xf, 0xf, false)); }
__device__ __forceinline__ float dpp_ror2(float x) { return __builtin_bit_cast(float, __builtin_amdgcn_update_dpp(0, __builtin_bit_cast(int, x), 0x122, 0xf, 0xf, false)); }
struct EpiConv {
    static constexpr bool PERM = true, KHOOK = false;
    const float* cw; const float* cb; bf16_t* O; float* UH; LAS float* halo; const float* RS;
    __device__ __forceinline__ void khook(f32x4 (&)[2][2][4][2], const Unit&, int, int, int, int, int) const {}
    __device__ __forceinline__ void operator()(f32x4 (&acc)[2][2][4][2], const Unit& u, int wr, int wc, int fr_, int fq_) const {
        int fr = fr_, fq = fq_; asm volatile("" : "+v"(fr), "+v"(fq));
        const int cl0 = wc * 32 + 8 * fq;
#pragma unroll
        for (int ai = 0; ai < 2; ++ai)
#pragma unroll
            for (int m = 0; m < 4; ++m) { const float r = RS[u.pm * BM + ai * HALF + wr * 64 + m * 16 + fr];
#pragma unroll
                for (int bj = 0; bj < 2; ++bj)
#pragma unroll
                    for (int n = 0; n < 2; ++n) acc[ai][bj][m][n] *= r; }
        if (fr >= 14) {
#pragma unroll
            for (int ai = 0; ai < 2; ++ai)
#pragma unroll
                for (int bj = 0; bj < 2; ++bj)
#pragma unroll
                    for (int n = 0; n < 2; ++n) *(LAS f32x4*)(halo + (((2 * ai + wr) * 2 + (fr - 14)) * 256 + 128 * bj + cl0 + 4 * n)) = acc[ai][bj][3][n];
        }
        if (wr == 0 && fr < 2) {
#pragma unroll
            for (int bj = 0; bj < 2; ++bj)
#pragma unroll
                for (int n = 0; n < 2; ++n) *(f32x4*)(UH + ((size_t)u.pm * 4 + fr) * NUP + 256 * u.pn + 128 * bj + cl0 + 4 * n) = acc[0][bj][0][n];
        }
        if (wr == 1 && fr >= 14) {
#pragma unroll
            for (int bj = 0; bj < 2; ++bj)
#pragma unroll
                for (int n = 0; n < 2; ++n) *(f32x4*)(UH + ((size_t)u.pm * 4 + 2 + (fr - 14)) * NUP + 256 * u.pn + 128 * bj + cl0 + 4 * n) = acc[1][bj][3][n];
        }
        asm volatile("s_waitcnt lgkmcnt(0)" ::: "memory"); __builtin_amdgcn_s_barrier(); asm volatile("" ::: "memory");
        const int j0 = 128 * u.pn + cl0;
        const bool is15 = fr == 15, ge14 = fr >= 14;
        unsigned keep[2][4][2];
#pragma unroll
        for (int n = 0; n < 2; ++n) {
            f32x4 wa[3], wv[3];
#pragma unroll
            for (int q = 0; q < 3; ++q) { wa[q] = *(const f32x4*)(cw + q * NUP + j0 + 4 * n); wv[q] = *(const f32x4*)(cw + q * NUP + DFF + j0 + 4 * n); }
            const f32x4 ba = *(const f32x4*)(cb + j0 + 4 * n), bv = *(const f32x4*)(cb + DFF + j0 + 4 * n);
#pragma unroll
            for (int ai = 0; ai < 2; ++ai) {
                const int blk = 2 * ai + wr;
                f32x4 pa = (f32x4){0.f, 0.f, 0.f, 0.f}, pv = (f32x4){0.f, 0.f, 0.f, 0.f};
                if (blk > 0 && ge14) { pa = *(const LAS f32x4*)(halo + (((blk - 1) * 2 + (fr - 14)) * 256 + cl0 + 4 * n)); pv = *(const LAS f32x4*)(halo + (((blk - 1) * 2 + (fr - 14)) * 256 + 128 + cl0 + 4 * n)); }
#pragma unroll
                for (int m = 0; m < 4; ++m) {
                    const f32x4 ca_ = acc[ai][0][m][n], cv_ = acc[ai][1][m][n]; float o[4];
#pragma unroll
                    for (int i = 0; i < 4; ++i) {
                        const float a1 = dpp_ror1(is15 ? pa[i] : ca_[i]), a2 = dpp_ror2(ge14 ? pa[i] : ca_[i]);
                        const float v1 = dpp_ror1(is15 ? pv[i] : cv_[i]), v2 = dpp_ror2(ge14 ? pv[i] : cv_[i]);
                        const float ca = ba[i] + wa[0][i] * a2 + wa[1][i] * a1 + wa[2][i] * ca_[i];
                        const float cv = bv[i] + wv[0][i] * v2 + wv[1][i] * v1 + wv[2][i] * cv_[i];
                        o[i] = siluf_(ca) * cv; }
                    pa = ca_; pv = cv_;
                    const unsigned lo = cvt_pk_bf16(o[0], o[1]), hi = cvt_pk_bf16(o[2], o[3]);
                    if (n == 0) { keep[ai][m][0] = lo; keep[ai][m][1] = hi; }
                    else { u32x4 w; w.x = keep[ai][m][0]; w.y = keep[ai][m][1]; w.z = lo; w.w = hi;
                        *(u32x4*)(O + (size_t)(u.pm * BM + ai * HALF + wr * 64 + m * 16 + fr) * DFF + j0) = w; }
                }
            }
        }
    }
};
struct EpiResid {
    static constexpr bool PERM = true, KHOOK = false;
    const void* base; int base_f32; bf16_t* O; int ldc; float* SS;
    __device__ __forceinline__ void khook(f32x4 (&)[2][2][4][2], const Unit&, int, int, int, int, int) const {}
    __device__ __forceinline__ void operator()(f32x4 (&acc)[2][2][4][2], const Unit& u, int wr, int wc, int fr_, int fq_) const {
        int fr = fr_, fq = fq_; asm volatile("" : "+v"(fr), "+v"(fq));
        const int row0 = u.pm * BM + wr * 64 + fr, col0 = u.pn * BM + wc * 32 + 8 * fq, lane = fq * 16 + fr;
#pragma unroll
        for (int ai = 0; ai < 2; ++ai)
#pragma unroll
            for (int m = 0; m < 4; ++m) { const size_t off = (size_t)(row0 + ai * HALF + m * 16) * ldc + col0; float sq = 0.f;
#pragma unroll
                for (int bj = 0; bj < 2; ++bj) { float b[8];
                    if (base_f32) { const float* bp = (const float*)base + off + bj * HALF; const f32x4 b0 = *(const f32x4*)bp, b1 = *(const f32x4*)(bp + 4); b[0] = b0.x; b[1] = b0.y; b[2] = b0.z; b[3] = b0.w; b[4] = b1.x; b[5] = b1.y; b[6] = b1.z; b[7] = b1.w; }
                    else unpack8(*(const u32x4*)((const bf16_t*)base + off + bj * HALF), b);
                    const f32x4 v0 = acc[ai][bj][m][0], v1 = acc[ai][bj][m][1];
                    const float o0 = b[0] + v0[0], o1 = b[1] + v0[1], o2 = b[2] + v0[2], o3 = b[3] + v0[3], o4 = b[4] + v1[0], o5 = b[5] + v1[1], o6 = b[6] + v1[2], o7 = b[7] + v1[3];
                    u32x4 w; w.x = cvt_pk_bf16(o0, o1); w.y = cvt_pk_bf16(o2, o3); w.z = cvt_pk_bf16(o4, o5); w.w = cvt_pk_bf16(o6, o7);
                    *(u32x4*)(O + off + bj * HALF) = w;
                    sq += ((o0 * o0 + o1 * o1) + (o2 * o2 + o3 * o3)) + ((o4 * o4 + o5 * o5) + (o6 * o6 + o7 * o7)); }
                if (SS) { sq += __builtin_bit_cast(float, __builtin_amdgcn_ds_bpermute((lane ^ 16) << 2, __builtin_bit_cast(int, sq)));
                    sq += __builtin_bit_cast(float, __builtin_amdgcn_ds_bpermute((lane ^ 32) << 2, __builtin_bit_cast(int, sq)));
                    if (fq == 0) SS[(size_t)(u.pn * 4 + wc) * M + row0 + ai * HALF + m * 16] = sq; }
                asm volatile("" ::: "memory"); }
    }
};
struct EpiGlu {
    static constexpr bool PERM = true, KHOOK = false;
    const bf16_t* Yp; int ldy; bf16_t* O; int ldc;
    __device__ __forceinline__ void khook(f32x4 (&)[2][2][4][2], const Unit&, int, int, int, int, int) const {}
    __device__ __forceinline__ void operator()(f32x4 (&acc)[2][2][4][2], const Unit& u, int wr, int wc, int fr, int fq) const {
        const int row0 = u.pm * BM + wr * 64 + fr, col0 = u.pn * BM + wc * 32 + 8 * fq;
#pragma unroll
        for (int ai = 0; ai < 2; ++ai)
#pragma unroll
            for (int m = 0; m < 4; ++m) { const size_t r = (size_t)(row0 + ai * HALF + m * 16);
#pragma unroll
                for (int bj = 0; bj < 2; ++bj) { const u32x4 yw = *(const u32x4*)(Yp + r * ldy + col0 + bj * HALF); float y[8]; unpack8(yw, y);
                    const f32x4 v0 = acc[ai][bj][m][0], v1 = acc[ai][bj][m][1]; float o[8];
#pragma unroll
                    for (int j = 0; j < 4; ++j) { o[j] = y[j] * sigmoidf_(v0[j]); o[4 + j] = y[4 + j] * sigmoidf_(v1[j]); }
                    u32x4 w; w.x = cvt_pk_bf16(o[0], o[1]); w.y = cvt_pk_bf16(o[2], o[3]); w.z = cvt_pk_bf16(o[4], o[5]); w.w = cvt_pk_bf16(o[6], o[7]);
                    *(u32x4*)(O + r * ldc + col0 + bj * HALF) = w; } }
    }
};
struct EpiMerge {
    static constexpr bool PERM = true, KHOOK = true;
    const bf16_t* G; int ldg; bf16_t* O; int ldc;
    __device__ __forceinline__ void scale(f32x4 (&acc)[2][2][4][2], const Unit& u, int s, int wr, int wc, int fr, int fq) const {
        int row0 = u.pm * BM + wr * 64 + fr, col0 = u.pn * BM + wc * 32 + 8 * fq + s * D; asm volatile("" : "+v"(row0), "+v"(col0));
        u32x4 w[2][4][2];
#pragma unroll
        for (int ai = 0; ai < 2; ++ai)
#pragma unroll
            for (int m = 0; m < 4; ++m) { const bf16_t* gp = G + (size_t)(row0 + ai * HALF + m * 16) * ldg + col0;
#pragma unroll
                for (int bj = 0; bj < 2; ++bj) w[ai][m][bj] = *(const u32x4*)(gp + bj * HALF); }
#pragma unroll
        for (int ai = 0; ai < 2; ++ai)
#pragma unroll
            for (int m = 0; m < 4; ++m)
#pragma unroll
                for (int bj = 0; bj < 2; ++bj) { float f[8]; unpack8(w[ai][m][bj], f);
#pragma unroll
                    for (int j = 0; j < 8; ++j) acc[ai][bj][m][j >> 2][j & 3] *= f[j]; }
    }
    __device__ __forceinline__ void khook(f32x4 (&acc)[2][2][4][2], const Unit& u, int seg, int wr, int wc, int fr, int fq) const { scale(acc, u, seg - 1, wr, wc, fr, fq); }
    __device__ __forceinline__ void operator()(f32x4 (&acc)[2][2][4][2], const Unit& u, int wr, int wc, int fr, int fq) const {
        scale(acc, u, 3, wr, wc, fr, fq);
        const int row0 = u.pm * BM + wr * 64 + fr, col0 = u.pn * BM + wc * 32 + 8 * fq;
#pragma unroll
        for (int ai = 0; ai < 2; ++ai)
#pragma unroll
            for (int m = 0; m < 4; ++m) { bf16_t* rowp = O + (size_t)(row0 + ai * HALF + m * 16) * ldc + col0;
#pragma unroll
                for (int bj = 0; bj < 2; ++bj) { const f32x4 v0 = acc[ai][bj][m][0], v1 = acc[ai][bj][m][1];
                    u32x4 w; w.x = cvt_pk_bf16(v0[0], v0[1]); w.y = cvt_pk_bf16(v0[2], v0[3]); w.z = cvt_pk_bf16(v1[0], v1[1]); w.w = cvt_pk_bf16(v1[2], v1[3]);
                    *(u32x4*)(rowp + bj * HALF) = w; } }
    }
};

typedef int v4i_t __attribute__((ext_vector_type(4)));
typedef int v8i_t __attribute__((ext_vector_type(8)));
template <class Epi, bool F8 = false>
__device__ __forceinline__ void gemm_phase(LAS unsigned char* lds, const Gemm g, const StaticOrder& S, const Epi& E, int tid_in) {
    int tid_ = tid_in; asm volatile("" : "+v"(tid_));
    const int tid = tid_, wid = __builtin_amdgcn_readfirstlane(tid >> 6), lane = tid & 63, wr = wid >> 2, wc = wid & 3, fr = lane & 15, fq = lane >> 4;
    const int K = g.K, nt = K / BK;
    unsigned voffA[2], voffB[2];
#pragma unroll
    for (int i = 0; i < 2; ++i) { int R, C; stage_rc(tid * 16 + i * 8192, R, C); const int Rb = Epi::PERM ? ((R & ~31) + perm32(R & 31)) : R;
        voffA[i] = (unsigned)(R * g.lda + C) * 2u; voffB[i] = (unsigned)(Rb * g.ldb + C) * 2u; }
    const size_t kstep = (size_t)(BK * 2);
    const size_t hstepA = (size_t)HALF * g.lda * 2, hstepB = (size_t)HALF * g.ldb * 2;
    const size_t tstepA = 2 * hstepA, tstepB = 2 * hstepB;
    const unsigned ldsw = (unsigned)wid * 1024u;
    const int aoff = lds_byte(wr * 64 + fr, fq * 8), boff = lds_byte(wc * 32 + fr, fq * 8);
#define PG8_SA(b, h) (((b) * 2 + (h)) * HTB)
#define PG8_SB(b, h) ((4 + (b) * 2 + (h)) * HTB)
#define PG8_STAGE(bufoff, gbase, voff) do { _Pragma("unroll") for (int _i = 0; _i < 2; ++_i) \
        __builtin_amdgcn_global_load_lds((const unsigned*)((const char*)(gbase) + (voff)[_i]), (LAS unsigned*)(lds + (bufoff) + ldsw + _i * 8192), 16, 0, 0); } while (0)
#define PG8_LDA(dst, b, h) do { _Pragma("unroll") for (int m = 0; m < 4; ++m) _Pragma("unroll") for (int k = 0; k < 2; ++k) dst[m][k] = *(const LAS bf16x8*)(lds + PG8_SA(b, h) + aoff + m * 2048 + k * 1024); } while (0)
#define PG8_LDB(dst, b, h) do { _Pragma("unroll") for (int n = 0; n < 2; ++n) _Pragma("unroll") for (int k = 0; k < 2; ++k) dst[n][k] = *(const LAS bf16x8*)(lds + PG8_SB(b, h) + boff + n * 2048 + k * 1024); } while (0)
#define PG8_MMA(ai, bj, At, Bt) do { __builtin_amdgcn_s_setprio(1); _Pragma("unroll") for (int m = 0; m < 4; ++m) _Pragma("unroll") for (int n = 0; n < 2; ++n) _Pragma("unroll") for (int k = 0; k < 2; ++k) \
        acc[ai][bj][m][n] = __builtin_amdgcn_mfma_f32_16x16x32_bf16(Bt[n][k], At[m][k], acc[ai][bj][m][n], 0, 0, 0); __builtin_amdgcn_s_setprio(0); } while (0)
#define PG8_MMA16(ai, bj, At, Bt) PG8_MMA(ai, bj, At, Bt)
#define PG8_MMA8(ai, bj, A8, B8) do { __builtin_amdgcn_s_setprio(1); _Pragma("unroll") for (int m = 0; m < 4; ++m) _Pragma("unroll") for (int n = 0; n < 2; ++n) \
        asm volatile("v_mfma_f32_16x16x128_f8f6f4 %0, %1, %2, %0" : "+v"(acc[ai][bj][m][n]) : "v"(B8[n]), "v"(A8[m])); __builtin_amdgcn_s_setprio(0); } while (0)
#define PG8_LDA8(dst, b, h) do { _Pragma("unroll") for (int m = 0; m < 4; ++m) { dst[m].lo = *(const LAS v4i_t*)(lds + PG8_SA(b, h) + aoff + m * 2048); dst[m].hi = *(const LAS v4i_t*)(lds + PG8_SA(b, h) + aoff + m * 2048 + 1024); } } while (0)
#define PG8_LDB8(dst, b, h) do { _Pragma("unroll") for (int n = 0; n < 2; ++n) { dst[n].lo = *(const LAS v4i_t*)(lds + PG8_SB(b, h) + boff + n * 2048); dst[n].hi = *(const LAS v4i_t*)(lds + PG8_SB(b, h) + boff + n * 2048 + 1024); } } while (0)
#define PG8_XLDA(b, h) do { if constexpr (F8) PG8_LDA8(A8, b, h); else PG8_LDA(At, b, h); } while (0)
#define PG8_XLDB0(b, h) do { if constexpr (F8) PG8_LDB8(B08, b, h); else PG8_LDB(B0, b, h); } while (0)
#define PG8_XLDB1(b, h) do { if constexpr (F8) PG8_LDB8(B18, b, h); else PG8_LDB(B1, b, h); } while (0)
#define PG8_MM0(ai, bj) do { if constexpr (F8) PG8_MMA8(ai, bj, A8, B08); else PG8_MMA16(ai, bj, At, B0); } while (0)
#define PG8_MM1(ai, bj) do { if constexpr (F8) PG8_MMA8(ai, bj, A8, B18); else PG8_MMA16(ai, bj, At, B1); } while (0)
#define PG8_WAIT_V(n) asm volatile("s_waitcnt vmcnt(" #n ")" ::: "memory")
#define PG8_WAIT_L(n) asm volatile("s_waitcnt lgkmcnt(" #n ")" ::: "memory")
#define PG8_BAR __builtin_amdgcn_s_barrier()
#define PG8_SCHED __builtin_amdgcn_sched_barrier(0)
    Unit cur, nxt; int ui = 0;
    if (!S.next(0, cur)) return;
    f32x4 acc[2][2][4][2];
#pragma unroll
    for (int a = 0; a < 2; ++a)
#pragma unroll
        for (int b = 0; b < 2; ++b)
#pragma unroll
            for (int m = 0; m < 4; ++m)
#pragma unroll
                for (int n = 0; n < 2; ++n) acc[a][b][m][n] = (f32x4){0.f, 0.f, 0.f, 0.f};
    bf16x8 At[4][2], B0[2][2], B1[2][2]; v8i_t A8[4], B08[2], B18[2];
    const char* cA = (const char*)g.A + (size_t)cur.pm * tstepA; const char* cB = (const char*)g.Bt + (size_t)cur.pn * tstepB;
    PG8_STAGE(PG8_SB(0, 0), cB, voffB); PG8_STAGE(PG8_SB(0, 1), cB + hstepB, voffB); PG8_STAGE(PG8_SA(0, 0), cA, voffA); PG8_STAGE(PG8_SA(0, 1), cA + hstepA, voffA);
    if (wr == 1) PG8_BAR;
    PG8_WAIT_V(2); PG8_BAR;
    PG8_STAGE(PG8_SB(1, 0), cB + kstep, voffB); PG8_STAGE(PG8_SA(1, 0), cA + kstep, voffA); PG8_STAGE(PG8_SB(1, 1), cB + hstepB + kstep, voffB);
    PG8_WAIT_V(6); PG8_BAR;
    for (;;) {
        const bool has_next = S.next(ui + 1, nxt);
        const char* nA = has_next ? (const char*)g.A + (size_t)nxt.pm * tstepA : cA; const char* nB = has_next ? (const char*)g.Bt + (size_t)nxt.pn * tstepB : cB;
        for (int t = 0; t < nt; t += 2) {
            const bool last = (t == nt - 2);
            const char* a1 = cA + (size_t)(t + 1) * kstep;
            const char* a2 = last ? nA : cA + (size_t)(t + 2) * kstep; const char* b2 = last ? nB : cB + (size_t)(t + 2) * kstep;
            const char* a3 = a2 + kstep; const char* b3 = b2 + kstep;
            if constexpr (Epi::KHOOK) { if (t != 0 && (t & 7) == 0) E.khook(acc, cur, t >> 3, wr, wc, fr, fq); }
            PG8_XLDB0(0, 0); PG8_XLDB1(0, 1); PG8_SCHED; PG8_XLDA(0, 0); PG8_STAGE(PG8_SA(1, 1), a1 + hstepA, voffA);
            PG8_WAIT_V(8); PG8_WAIT_L(0); PG8_BAR; PG8_MM0(0, 0); PG8_MM1(0, 1); PG8_BAR; PG8_SCHED;
            PG8_XLDA(0, 1); PG8_STAGE(PG8_SB(0, 0), b2, voffB); PG8_STAGE(PG8_SB(0, 1), b2 + hstepB, voffB); PG8_STAGE(PG8_SA(0, 0), a2, voffA);
            PG8_WAIT_V(8); PG8_WAIT_L(0); PG8_BAR; PG8_MM0(1, 0); PG8_MM1(1, 1); PG8_BAR; PG8_SCHED;
            PG8_XLDB0(1, 0); PG8_XLDB1(1, 1); PG8_SCHED; PG8_XLDA(1, 0); PG8_STAGE(PG8_SA(0, 1), a2 + hstepA, voffA);
            PG8_WAIT_V(8); PG8_WAIT_L(0); PG8_BAR; PG8_MM0(0, 0); PG8_MM1(0, 1); PG8_BAR; PG8_SCHED;
            PG8_XLDA(1, 1); PG8_STAGE(PG8_SB(1, 0), b3, voffB); PG8_STAGE(PG8_SB(1, 1), b3 + hstepB, voffB); PG8_STAGE(PG8_SA(1, 0), a3, voffA);
            PG8_WAIT_V(8); PG8_WAIT_L(0); PG8_BAR; PG8_MM0(1, 0); PG8_MM1(1, 1); PG8_BAR; PG8_SCHED;
        }
        if (wr == 0) PG8_BAR;
        E(acc, cur, wr, wc, fr, fq);
        if (!has_next) break;
#pragma unroll
        for (int a = 0; a < 2; ++a)
#pragma unroll
            for (int b = 0; b < 2; ++b)
#pragma unroll
                for (int m = 0; m < 4; ++m)
#pragma unroll
                    for (int n = 0; n < 2; ++n) acc[a][b][m][n] = (f32x4){0.f, 0.f, 0.f, 0.f};
        cur = nxt; cA = nA; cB = nB; ++ui;
        if (wr == 1) PG8_BAR;
    }
    PG8_WAIT_V(0);
    PG8_BAR;
#undef PG8_SA
#undef PG8_SB
#undef PG8_STAGE
#undef PG8_LDA
#undef PG8_LDB
#undef PG8_MMA
#undef PG8_MMA8
#undef PG8_MMA16
#undef PG8_LDA8
#undef PG8_LDB8
#undef PG8_XLDA
#undef PG8_XLDB0
#undef PG8_XLDB1
#undef PG8_MM0
#undef PG8_MM1
#undef PG8_WAIT_V
#undef PG8_WAIT_L
#undef PG8_BAR
#undef PG8_SCHED
}
}

#define XB_TMO      128
#define XB_XCNT(j)  (256  + 64 * (j))
#define XB_XSUB(j)  (1280 + 64 * (j))
#define XB_XGEN(j)  (2304 + 64 * (j))
#define XB_TOP      3328
#define XB_TOPGEN   3392
#define XCD_BAR_WORDS 3456
#define XB_SPIN_CAP (1u << 18)
__device__ __forceinline__ unsigned xb_ld(unsigned* p)              { return __hip_atomic_load(p, __ATOMIC_RELAXED, __HIP_MEMORY_SCOPE_AGENT); }
__device__ __forceinline__ unsigned xb_add(unsigned* p, unsigned v) { return __hip_atomic_fetch_add(p, v, __ATOMIC_RELAXED, __HIP_MEMORY_SCOPE_AGENT); }
__device__ __forceinline__ unsigned xb_xcc_id() { return (unsigned)__builtin_amdgcn_s_getreg((3 << 11) | 20) & 0xFu; }
#define XB_SPIN(cond, bar) do { unsigned _sp = 0; while (cond) { __builtin_amdgcn_s_sleep(1); \
    if ((++_sp & 255u) == 0u) { if (xb_ld(&(bar)[XB_TMO])) break; if (_sp > XB_SPIN_CAP) { (void)__hip_atomic_fetch_add(&(bar)[XB_TMO], 1u, __ATOMIC_RELAXED, __HIP_MEMORY_SCOPE_AGENT); break; } } } } while (0)
struct XcdBarrier { unsigned* bar; unsigned x; volatile LAS unsigned* st; };
__device__ __forceinline__ XcdBarrier xcd_barrier_post(unsigned* bar, volatile LAS unsigned* st) {
    XcdBarrier b; b.bar = bar; b.x = xb_xcc_id(); b.st = st;
    if (threadIdx.x == 0) (void)xb_add(&bar[XB_XCNT(b.x)], 1u);
    return b;
}
__device__ __forceinline__ void xcd_barrier_complete(unsigned* bar, unsigned x, unsigned& nloc, unsigned& nx) {
    const unsigned G = gridDim.x * gridDim.y * gridDim.z;
    unsigned sum, cnt, mine, sp = 0u;
    for (;;) {
        sum = 0u; cnt = 0u; mine = 0u;
#pragma nounroll
        for (unsigned j = 0; j < 16; ++j) { const unsigned c = xb_ld(&bar[XB_XCNT(j)]); sum += c; cnt += (c > 0u) ? 1u : 0u; mine = (j == x) ? c : mine; }
        if (sum == G) break;
        __builtin_amdgcn_s_sleep(1);
        if ((++sp & 255u) == 0u) { if (xb_ld(&bar[XB_TMO])) break; if (sp > XB_SPIN_CAP) { (void)__hip_atomic_fetch_add(&bar[XB_TMO], 1u, __ATOMIC_RELAXED, __HIP_MEMORY_SCOPE_AGENT); break; } }
    }
    nloc = mine > 0u ? mine : 1u; nx = cnt > 0u ? cnt : 1u;
}
__device__ __forceinline__ void xcd_barrier(const XcdBarrier& b) {
    asm volatile("s_waitcnt vmcnt(0)" ::: "memory");
    wg_sync();
    if (threadIdx.x == 0) {
        unsigned* bar = b.bar;
        __builtin_amdgcn_s_waitcnt(0);
        unsigned nloc = b.st[0], nx = b.st[1];
        if (nloc == 0u) { xcd_barrier_complete(bar, b.x, nloc, nx); b.st[0] = nloc; b.st[1] = nx; }
        const unsigned old = xb_add(&bar[XB_XSUB(b.x)], 1u);
        const unsigned gen = old / nloc;
        if (old + 1u == (gen + 1u) * nloc) {
            __builtin_amdgcn_fence(__ATOMIC_RELEASE, "agent");
            asm volatile("s_waitcnt vmcnt(0)" ::: "memory");
            const unsigned og = xb_add(&bar[XB_TOP], 1u);
            const unsigned tg = og / nx;
            if (og + 1u == (tg + 1u) * nx) xb_add(&bar[XB_TOPGEN], 1u);
            else XB_SPIN(xb_ld(&bar[XB_TOPGEN]) == tg, bar);
            __builtin_amdgcn_fence(__ATOMIC_ACQUIRE, "agent");
            xb_add(&bar[XB_XGEN(b.x)], 1u);
            asm volatile("s_waitcnt vmcnt(0)" ::: "memory");
        } else {
            XB_SPIN(xb_ld(&bar[XB_XGEN(b.x)]) == gen, bar);
            __builtin_amdgcn_fence(__ATOMIC_ACQUIRE, "agent");
            asm volatile("s_waitcnt vmcnt(0)" ::: "memory");
        }
    }
    wg_sync();
}

__device__ __forceinline__ const void* kin(int k) {
    typedef __attribute__((address_space(4))) const char* kptr_t;
    kptr_t p = (kptr_t)__builtin_amdgcn_kernarg_segment_ptr(); asm volatile("" : "+s"(p));
    const unsigned long long v = *(__attribute__((address_space(4))) const unsigned long long*)(p + 8 * k);
    return (const void*)(GAS const void*)v;
}
struct Frame {
    LAS unsigned char* lds;
    int tid, lane, wave, vcu, G, l;
    unsigned char* ws; float* out;
#define FIN(name, T, k) __device__ __forceinline__ const T* name() const { return (const T*)kin(k); }
    FIN(x, float, 0) FIN(pos, int, 1) FIN(g_mix, float, 2) FIN(w_in, float, 3) FIN(a_re, float, 4) FIN(a_im, float, 5) FIN(log_dt, float, 6) FIN(b_re, float, 7) FIN(b_im, float, 8)
    FIN(c_re, float, 9) FIN(c_im, float, 10) FIN(s5_d, float, 11) FIN(w_glu, float, 12) FIN(gla_wg, float, 13) FIN(gla_bg, float, 14) FIN(pool_w, float, 15) FIN(pool_scale, float, 16)
    FIN(w_branch, float, 17) FIN(w_out, float, 18) FIN(g_ffn, float, 19) FIN(w_up, float, 20) FIN(conv_w, float, 21) FIN(conv_b, float, 22) FIN(w_down, float, 23) FIN(g_final, float, 24)
#undef FIN
#define FWS(name, T, off) __device__ __forceinline__ T* name() const { return (T*)(ws + (off)); }
    FWS(rotc, float, WS_ROT) FWS(rots, float, WS_ROT + (size_t)M * 32 * 4) FWS(abar, float, WS_S5T + S5T_ABAR) FWS(apow, float, WS_S5T + S5T_APOW) FWS(bbar, float, WS_S5T + S5T_BBAR) FWS(cmt, bf16_t, WS_S5T + S5T_CMT) FWS(bbt, bf16_t, WS_S5T + S5T_BBT)
    FWS(wglu_t, bf16_t, WS_WGLU) FWS(poolw_t, bf16_t, WS_POOLW) FWS(win_t, bf16_t, WS_WIN) FWS(wbr_t, bf16_t, WS_WBR) FWS(wout_t, bf16_t, WS_WOUT) FWS(wup_t, bf16_t, WS_WUP) FWS(wdn_t, bf16_t, WS_WDN)
    FWS(HN8, unsigned char, WS_HN8) FWS(W8, unsigned char, WS_W8) FWS(HN, bf16_t, WS_HN) FWS(Y, bf16_t, WS_Y) FWS(YBP, bf16_t, WS_YBP) FWS(PROJ, bf16_t, WS_PROJ) FWS(SPREV, bf16_t, WS_SPREV) FWS(ACT, bf16_t, WS_ACT)
    FWS(SS, float, WS_SS + (size_t)l * 32 * M * 4) FWS(RS, float, WS_RS + (size_t)l * M * 4) FWS(STATE, float, WS_STATE) FWS(DEC, float, WS_DEC) FWS(XEND, float, WS_XEND) FWS(UH, float, WS_UH)
#undef FWS
};

__device__ __forceinline__ float lane_read(float v, int src_lane) { return __builtin_bit_cast(float, __builtin_amdgcn_ds_bpermute(src_lane << 2, __builtin_bit_cast(int, v))); }
__device__ __forceinline__ float wave_sum(float v, int lane) {
#pragma unroll
    for (int o = 1; o < 64; o <<= 1) v += lane_read(v, lane ^ o);
    return v;
}

template <class SrcCol>
__device__ __forceinline__ void transpose_item(const float* W, int Nsrc, bf16_t* WT, int ldt, int kdst0, int k0, int n0, SrcCol srccol, LAS float* scr, int lane, const float* kscale = nullptr) {
    const int sc = srccol(n0 + (lane & 31));
    float wv[32];
#pragma unroll
    for (int i = 0; i < 32; ++i) { const int kk = 2 * i + (lane >> 5); wv[i] = sc >= 0 ? W[(size_t)(k0 + kk) * Nsrc + sc] : 0.f; }
#pragma unroll
    for (int i = 0; i < 32; ++i) { const int kk = 2 * i + (lane >> 5); scr[kk * 33 + (lane & 31)] = kscale ? wv[i] * kscale[k0 + kk] : wv[i]; }
    LDS_WAIT();
    const int c = lane & 7;
#pragma unroll
    for (int j = 0; j < 4; ++j) { const int n = (lane >> 3) + 8 * j; const LAS float* s = scr + (8 * c) * 33 + n;
        u32x4 o; o.x = pk2(s[0 * 33], s[1 * 33]); o.y = pk2(s[2 * 33], s[3 * 33]); o.z = pk2(s[4 * 33], s[5 * 33]); o.w = pk2(s[6 * 33], s[7 * 33]);
        *(u32x4*)(WT + (size_t)(n0 + n) * ldt + kdst0 + k0 + 8 * c) = o; }
    LDS_WAIT();
}
template <class SrcCol>
__device__ __forceinline__ void transpose_item_fp8(const float* W, int Nsrc, unsigned char* WT, int ldt, int k0, int n0src, int n0dst, SrcCol srccol, LAS float* scr, int lane, const float* kscale, float scale) {
    const int sc = srccol(n0src + (lane & 31));
    float wv[32];
#pragma unroll
    for (int i = 0; i < 32; ++i) { const int kk = 2 * i + (lane >> 5); wv[i] = sc >= 0 ? W[(size_t)(k0 + kk) * Nsrc + sc] : 0.f; }
#pragma unroll
    for (int i = 0; i < 32; ++i) { const int kk = 2 * i + (lane >> 5); scr[kk * 33 + (lane & 31)] = (kscale ? wv[i] * kscale[k0 + kk] : wv[i]) * scale; }
    LDS_WAIT();
    const int c = lane & 7;
#pragma unroll
    for (int j = 0; j < 4; ++j) { const int n = (lane >> 3) + 8 * j; const LAS float* s = scr + (8 * c) * 33 + n;
        u32x2 o; o.x = pk4_fp8(s[0 * 33], s[1 * 33], s[2 * 33], s[3 * 33]); o.y = pk4_fp8(s[4 * 33], s[5 * 33], s[6 * 33], s[7 * 33]);
        *(u32x2*)(WT + (size_t)(n0dst + n) * ldt + k0 + 8 * c) = o; }
    LDS_WAIT();
}
struct ColIdent { __device__ __forceinline__ int operator()(int n) const { return n; } };
struct ColWin { __device__ __forceinline__ int operator()(int n) const {
    if (n < 3584) return n; if (n < 4096) return n + 16; if (n < 4112) return n - 512; if (n < 4352) return -1;
    const int t = (n - 4352) >> 8, cl = (n - 4352) & 255; const int br = 2 * (cl >> 7) + ((cl >> 2) & 1), ch = 16 * ((cl >> 5) & 3) + 4 * ((cl >> 3) & 3) + (cl & 3);
    return 4112 + br * 2048 + 64 * t + ch; } };
struct ColWup { __device__ __forceinline__ int operator()(int n) const { const int blk = n >> 8, r = n & 255; return (r < 128) ? (blk * 128 + r) : (DFF + blk * 128 + (r - 128)); } };

__device__ __forceinline__ void rms_row_to_bf16(const float* xrow, const float* g, bf16_t* orow, int lane, unsigned char* orow8 = nullptr) {
    const f32x4* xr = (const f32x4*)xrow + lane; const f32x4* gr = (const f32x4*)g + lane;
    f32x4 v[8]; float s = 0.f;
#pragma unroll
    for (int j = 0; j < 8; ++j) { v[j] = xr[64 * j]; s += (v[j].x * v[j].x + v[j].y * v[j].y) + (v[j].z * v[j].z + v[j].w * v[j].w); }
    const float r = 1.0f / sqrtf(wave_sum(s, lane) * (1.f / D) + EPS);
    u32x2* o8 = (u32x2*)orow + lane;
#pragma unroll
    for (int j = 0; j < 8; ++j) { const f32x4 gg = gr[64 * j]; const float a = v[j].x * r * gg.x, b = v[j].y * r * gg.y, c = v[j].z * r * gg.z, d = v[j].w * r * gg.w; u32x2 w; w.x = pk2(a, b); w.y = pk2(c, d); o8[64 * j] = w;
        if (orow8) ((unsigned*)orow8)[lane + 64 * j] = pk4_fp8(a, b, c, d); }
}
__device__ __forceinline__ void rms_rows(Frame& F, const float* src, const float* g, bf16_t* dst, unsigned char* dst8 = nullptr) {
    const int gw = F.vcu * NWAVES + F.wave, NGW = F.G * NWAVES;
    for (int m = gw; m < M; m += NGW) rms_row_to_bf16(src + (size_t)m * D, g, dst + (size_t)m * D, F.lane, dst8 ? dst8 + (size_t)m * D : nullptr);
}
__device__ __forceinline__ void row_scale(Frame& F) {
    const int gt = F.vcu * (NWAVES * 64) + F.tid, NGT = F.G * NWAVES * 64;
    for (int m = gt; m < M; m += NGT) { float s = 0.f;
#pragma unroll
        for (int j = 0; j < 32; ++j) s += F.SS()[(size_t)j * M + m];
        F.RS()[m] = 1.0f / sqrtf(s * (1.f / D) + EPS); }
}
__device__ __forceinline__ void rms_rows16(Frame& F, const bf16_t* src, const float* g, bf16_t* dst, unsigned char* dst8) {
    const int gw = F.vcu * NWAVES + F.wave, NGW = F.G * NWAVES, lane = F.lane;
    for (int m = gw; m < M; m += NGW) {
        const u32x4* xr = (const u32x4*)(src + (size_t)m * D) + lane; float v[4][8]; float s = 0.f;
#pragma unroll
        for (int j = 0; j < 4; ++j) { unpack8(xr[64 * j], v[j]);
#pragma unroll
            for (int q = 0; q < 8; ++q) s += v[j][q] * v[j][q]; }
        const float r = 1.0f / sqrtf(wave_sum(s, lane) * (1.f / D) + EPS);
        u32x4* o16 = (u32x4*)(dst + (size_t)m * D) + lane; u32x2* o8 = (u32x2*)(dst8 + (size_t)m * D) + lane;
#pragma unroll
        for (int j = 0; j < 4; ++j) { const f32x4 g0 = *((const f32x4*)g + 2 * (lane + 64 * j)), g1 = *((const f32x4*)g + 2 * (lane + 64 * j) + 1); float y[8];
            y[0] = v[j][0] * r * g0.x; y[1] = v[j][1] * r * g0.y; y[2] = v[j][2] * r * g0.z; y[3] = v[j][3] * r * g0.w; y[4] = v[j][4] * r * g1.x; y[5] = v[j][5] * r * g1.y; y[6] = v[j][6] * r * g1.z; y[7] = v[j][7] * r * g1.w;
            o16[64 * j] = pack8(y); u32x2 w8; w8.x = pk4_fp8(y[0], y[1], y[2], y[3]); w8.y = pk4_fp8(y[4], y[5], y[6], y[7]); o8[64 * j] = w8; }
    }
}
__device__ __forceinline__ void rms_rows16_to_f32(Frame& F, const bf16_t* src, const float* g, float* out) {
    const int gw = F.vcu * NWAVES + F.wave, NGW = F.G * NWAVES, lane = F.lane;
    for (int m = gw; m < M; m += NGW) {
        const u32x4* xr = (const u32x4*)(src + (size_t)m * D) + lane; float v[4][8]; float s = 0.f;
#pragma unroll
        for (int j = 0; j < 4; ++j) { unpack8(xr[64 * j], v[j]);
#pragma unroll
            for (int q = 0; q < 8; ++q) s += v[j][q] * v[j][q]; }
        const float r = 1.0f / sqrtf(wave_sum(s, lane) * (1.f / D) + EPS);
        f32x4* o = (f32x4*)(out + (size_t)m * D);
#pragma unroll
        for (int j = 0; j < 4; ++j) { const f32x4 g0 = *((const f32x4*)g + 2 * (lane + 64 * j)), g1 = *((const f32x4*)g + 2 * (lane + 64 * j) + 1);
            o[2 * (lane + 64 * j)] = (f32x4){v[j][0] * r * g0.x, v[j][1] * r * g0.y, v[j][2] * r * g0.z, v[j][3] * r * g0.w};
            o[2 * (lane + 64 * j) + 1] = (f32x4){v[j][4] * r * g1.x, v[j][5] * r * g1.y, v[j][6] * r * g1.z, v[j][7] * r * g1.w}; }
    }
}
__device__ __forceinline__ void rms_rows_f32_inplace(Frame& F, float* buf, const float* g) {
    const int gw = F.vcu * NWAVES + F.wave, NGW = F.G * NWAVES;
    for (int m = gw; m < M; m += NGW) {
        f32x4* xr = (f32x4*)(buf + (size_t)m * D) + F.lane; const f32x4* gr = (const f32x4*)g + F.lane;
        f32x4 v[8]; float s = 0.f;
#pragma unroll
        for (int j = 0; j < 8; ++j) { v[j] = xr[64 * j]; s += (v[j].x * v[j].x + v[j].y * v[j].y) + (v[j].z * v[j].z + v[j].w * v[j].w); }
        const float r = 1.0f / sqrtf(wave_sum(s, F.lane) * (1.f / D) + EPS);
#pragma unroll
        for (int j = 0; j < 8; ++j) { const f32x4 gg = gr[64 * j]; xr[64 * j] = (f32x4){v[j].x * r * gg.x, v[j].y * r * gg.y, v[j].z * r * gg.z, v[j].w * r * gg.w}; }
    }
}

__device__ __forceinline__ void phase_prep(Frame& F, int l) {
    LAS float* scr = (LAS float*)(F.lds + F.wave * 16384);
    const int gw = F.vcu * NWAVES + F.wave, NGW = F.G * NWAVES;
    constexpr int I_IN = (D / 64) * (NIN / 32), I_UP = (D / 64) * (NUP / 32), I_DN = (DFF / 64) * (D / 32), I_BR = 4 * (BW / 64) * (D / 32), I_OUT = (D / 64) * (D / 32), I_GLU = (BW / 64) * (BW / 32), I_PL = 4 * (128 / 64) * (128 / 32);
    constexpr int NITEMS = I_IN + I_UP + I_DN + I_BR + I_OUT + I_GLU + I_PL;
    for (int it = gw; it < NITEMS; it += NGW) {
        int r = it;
        if (r < I_IN) { const int nb = NIN / 32, n0 = 32 * (r % nb);
            if (n0 < C_GATE) transpose_item(F.w_in() + (size_t)l * D * NIN_SRC, NIN_SRC, F.win_t(), D, 0, 64 * (r / nb), n0, ColWin(), scr, F.lane);
            else transpose_item_fp8(F.w_in() + (size_t)l * D * NIN_SRC, NIN_SRC, F.W8(), D, 64 * (r / nb), n0, n0 - C_GATE, ColWin(), scr, F.lane, nullptr, 64.0f);
            continue; } r -= I_IN;
        if (r < I_UP) { const int nb = NUP / 32; transpose_item(F.w_up() + (size_t)l * D * NUP, NUP, F.wup_t(), D, 0, 64 * (r / nb), 32 * (r % nb), ColWup(), scr, F.lane, F.g_ffn() + (size_t)l * D); continue; } r -= I_UP;
        if (r < I_DN) { const int nb = D / 32; transpose_item(F.w_down() + (size_t)l * DFF * D, D, F.wdn_t(), DFF, 0, 64 * (r / nb), 32 * (r % nb), ColIdent(), scr, F.lane); continue; } r -= I_DN;
        if (r < I_BR) { const int per = (BW / 64) * (D / 32), br = r / per, q = r % per, nb = D / 32;
            transpose_item(F.w_branch() + ((size_t)l * 4 + br) * BW * D, D, F.wbr_t(), D, br * BW, 64 * (q / nb), 32 * (q % nb), ColIdent(), scr, F.lane); continue; } r -= I_BR;
        if (r < I_OUT) { const int nb = D / 32; transpose_item(F.w_out() + (size_t)l * D * D, D, F.wout_t(), D, 0, 64 * (r / nb), 32 * (r % nb), ColIdent(), scr, F.lane); continue; } r -= I_OUT;
        if (r < I_GLU) { const int nb = BW / 32; transpose_item(F.w_glu() + (size_t)l * BW * BW, BW, F.wglu_t(), BW, 0, 64 * (r / nb), 32 * (r % nb), ColIdent(), scr, F.lane); continue; } r -= I_GLU;
        { const int grp = r / 8, q = r % 8; transpose_item(F.pool_w() + ((size_t)l * 4 + grp) * 128 * 128, 128, F.poolw_t() + (size_t)grp * 128 * 128, 128, 0, 64 * (q / 4), 32 * (q % 4), ColIdent(), scr, F.lane); }
    }
    const int gt = F.vcu * (NWAVES * 64) + F.tid, NGT = F.G * NWAVES * 64;
    for (int i = gt; i < 32 * 64; i += NGT) {
        const int g = i >> 6;
        const float are = F.a_re()[(size_t)l * 2048 + i], aim = F.a_im()[(size_t)l * 2048 + i], dt = expf(F.log_dt()[l * 32 + g]);
        const float mag = expf(are * dt), th = aim * dt;
        const float abr = mag * cosf(th), abi = mag * sinf(th);
        const float den = are * are + aim * aim, nr = abr - 1.0f, ni = abi;
        const float fre = (nr * are + ni * aim) / den, fim = (ni * are - nr * aim) / den;
        F.abar()[2 * i] = abr; F.abar()[2 * i + 1] = abi;
        float pr = abr, pi = abi;
#pragma unroll
        for (int q = 0; q < 6; ++q) { const float tr = pr * pr - pi * pi, ti = 2.f * pr * pi; pr = tr; pi = ti; }
        F.apow()[2 * i] = pr; F.apow()[2 * i + 1] = pi;
        const float* br = F.b_re() + ((size_t)l * 2048 + i) * 16; const float* bi = F.b_im() + ((size_t)l * 2048 + i) * 16;
#pragma unroll
        for (int c = 0; c < 16; ++c) { const float x = br[c], y = bi[c]; const float vr = fre * x - fim * y, vi = fre * y + fim * x; const int p = i & 63;
            F.bbt()[((size_t)g * 128 + p) * 16 + c] = (bf16_t)f2bf(vr); F.bbt()[((size_t)g * 128 + 64 + p) * 16 + c] = (bf16_t)f2bf(vi); }
    }
    for (int i = gt; i < 32 * 16 * 128; i += NGT) {
        const int k = i & 127, gc = i >> 7;
        const float v = (k < 64) ? F.c_re()[((size_t)l * 512 + gc) * 64 + k] : -F.c_im()[((size_t)l * 512 + gc) * 64 + (k - 64)];
        F.cmt()[i] = (bf16_t)f2bf(v);
    }
    if (l == 0) {
        for (int i = gt; i < M * 32; i += NGT) {
            const int row = i >> 5, j = i & 31;
            const float inv = exp2f(-(float)j * (13.287712379549449f / 32.0f));
            const float ang = (float)F.pos()[row] * inv;
            F.rotc()[i] = cosf(ang); F.rots()[i] = sinf(ang);
        }
    }
    if (l == 0) rms_rows(F, F.x(), F.g_mix(), F.HN(), F.HN8()); else rms_rows16(F, (const bf16_t*)F.out, F.g_mix() + (size_t)l * D, F.HN(), F.HN8());
}

__device__ __forceinline__ f32x4 mma_nt_lds(const LAS bf16_t* X, int px, const LAS bf16_t* Y, int py, int ksteps, f32x4 acc, int lane) {
    const LAS bf16_t* xp = X + (lane & 15) * px + 8 * (lane >> 4);
    const LAS bf16_t* yp = Y + (lane & 15) * py + 8 * (lane >> 4);
    for (int ks = 0; ks < ksteps; ++ks) {
        const bf16x8 a = *(const LAS bf16x8*)(xp + 32 * ks), b = *(const LAS bf16x8*)(yp + 32 * ks);
        acc = __builtin_amdgcn_mfma_f32_16x16x32_bf16(a, b, acc, 0, 0, 0);
    }
    return acc;
}

constexpr int LN_TOT = 16384, LN_QD = 18432, LN_KI = 27648, LN_PM = 36864, LN_VT = 46080, LN_OB = 64512, LN_WG = 98304, LN_END = 98304 + 4096 + 256;
constexpr int LP = 72;
struct LinRaw { u32x4 q0, q1, k0, k1, v0, v1, g0, g1, gr0, gr1; f32x4 c0, c1, s0, s1; bf16x8 sp0, sp1; };
template <bool OUT>
__device__ __forceinline__ void lin_issue(Frame& F, int unit, LinRaw& R) {
    const int n = unit & 63, h = (unit >> 6) & 3, b = (unit >> 8) & 7, mixer = unit >> 11;
    const size_t row0 = (size_t)b * SEQ + (size_t)n * CH; const int s = F.tid >> 3, c = F.tid & 7;
    const int cq = (mixer == 0 ? C_RQ : C_GQ) + h * 64, ck = (mixer == 0 ? C_RK : C_GK) + h * 64, cv = (mixer == 0 ? C_RV : C_GV) + h * 128, cg = (mixer == 0 ? C_RG : C_GG) + h * 128;
    const bf16_t* pr = F.PROJ() + (row0 + s) * NIN;
    R.k0 = *(const u32x4*)(pr + ck + 8 * c); R.k1 = *(const u32x4*)(pr + ck + 8 * (c ^ 4));
    if (OUT) { R.q0 = *(const u32x4*)(pr + cq + 8 * c); R.q1 = *(const u32x4*)(pr + cq + 8 * (c ^ 4)); }
    { const float* cp = F.rotc() + (row0 + s) * 32 + (c & 3) * 8; const float* sp = F.rots() + (row0 + s) * 32 + (c & 3) * 8;
      R.c0 = *(const f32x4*)cp; R.c1 = *(const f32x4*)(cp + 4); R.s0 = *(const f32x4*)sp; R.s1 = *(const f32x4*)(sp + 4); }
    R.gr0 = *(const u32x4*)(pr + C_GR); R.gr1 = *(const u32x4*)(pr + C_GR + 8);
    R.v0 = *(const u32x4*)(F.PROJ() + (row0 + (F.tid >> 4)) * NIN + cv + (F.tid & 15) * 8);
    R.v1 = *(const u32x4*)(F.PROJ() + (row0 + 32 + (F.tid >> 4)) * NIN + cv + (F.tid & 15) * 8);
    if (OUT) { R.g0 = *(const u32x4*)(pr + cg + 16 * c); R.g1 = *(const u32x4*)(pr + cg + 16 * c + 8);
        const bf16_t* sq = F.SPREV() + (size_t)unit * 8192 + (size_t)(16 * F.wave + (F.lane & 15)) * 64 + 8 * (F.lane >> 4);
        R.sp0 = *(const bf16x8*)sq; R.sp1 = *(const bf16x8*)(sq + 32); }
}
__device__ __forceinline__ void lin_rot(const u32x4 own_, const u32x4 oth_, const LinRaw& R, bool rot, bool hi, float scale, float (&v)[8]) {
    float own[8]; unpack8(own_, own);
    if (!rot) {
#pragma unroll
        for (int j = 0; j < 8; ++j) v[j] = own[j] * scale;
        return; }
    float oth[8]; unpack8(oth_, oth);
    const float cs[8] = {R.c0.x, R.c0.y, R.c0.z, R.c0.w, R.c1.x, R.c1.y, R.c1.z, R.c1.w}, sn[8] = {R.s0.x, R.s0.y, R.s0.z, R.s0.w, R.s1.x, R.s1.y, R.s1.z, R.s1.w};
#pragma unroll
    for (int j = 0; j < 8; ++j) { const float os = oth[j] * sn[j]; v[j] = (own[j] * cs[j] + (hi ? os : -os)) * scale; }
}
__device__ __forceinline__ void lin_decay(Frame& F, int mixer, int h, const LinRaw& R, float (&bcum)[8], float (&blast)[8]) {
    LAS float* TOT = (LAS float*)(F.lds + LN_TOT);
    const int s = F.tid >> 3, c = F.tid & 7, d0 = 8 * c;
    if (mixer == 0) {
        const float lg = __logf(1.0f - exp2f(-5.0f - (float)h));
#pragma unroll
        for (int j = 0; j < 8; ++j) { bcum[j] = (float)(s + 1) * lg; blast[j] = 64.0f * lg; }
        wg_sync();
        return;
    }
    const LAS float* WG = (const LAS float*)(F.lds + LN_WG);
    float grf[16]; { float a[8], b2[8]; unpack8(R.gr0, a); unpack8(R.gr1, b2);
#pragma unroll
        for (int j = 0; j < 8; ++j) { grf[j] = a[j]; grf[8 + j] = b2[j]; } }
    float x[8]; { const f32x4 b0 = *(const LAS f32x4*)(WG + 1024 + d0), b1 = *(const LAS f32x4*)(WG + 1024 + d0 + 4); x[0] = b0.x; x[1] = b0.y; x[2] = b0.z; x[3] = b0.w; x[4] = b1.x; x[5] = b1.y; x[6] = b1.z; x[7] = b1.w; }
#pragma unroll
    for (int r = 0; r < 16; ++r) { const f32x4 w0 = *(const LAS f32x4*)(WG + r * 64 + d0), w1 = *(const LAS f32x4*)(WG + r * 64 + d0 + 4);
        x[0] += grf[r] * w0.x; x[1] += grf[r] * w0.y; x[2] += grf[r] * w0.z; x[3] += grf[r] * w0.w; x[4] += grf[r] * w1.x; x[5] += grf[r] * w1.y; x[6] += grf[r] * w1.z; x[7] += grf[r] * w1.w; }
#pragma unroll
    for (int j = 0; j < 8; ++j) x[j] = logsigmoidf_(x[j]) * (1.0f / 16.0f);
#pragma unroll
    for (int st = 8; st <= 32; st <<= 1) {
#pragma unroll
        for (int j = 0; j < 8; ++j) { const float t = lane_read(x[j], F.lane - st); if (F.lane >= st) x[j] += t; } }
    if ((F.lane >> 3) == 7) { *(LAS f32x4*)(TOT + F.wave * 64 + d0) = (f32x4){x[0], x[1], x[2], x[3]}; *(LAS f32x4*)(TOT + F.wave * 64 + d0 + 4) = (f32x4){x[4], x[5], x[6], x[7]}; }
    wg_sync();
    float off[8], tot[8];
#pragma unroll
    for (int j = 0; j < 8; ++j) { off[j] = 0.f; tot[j] = 0.f; }
#pragma unroll
    for (int w = 0; w < 8; ++w) { const f32x4 t0 = *(const LAS f32x4*)(TOT + w * 64 + d0), t1 = *(const LAS f32x4*)(TOT + w * 64 + d0 + 4); const float tv[8] = {t0.x, t0.y, t0.z, t0.w, t1.x, t1.y, t1.z, t1.w};
#pragma unroll
        for (int j = 0; j < 8; ++j) { tot[j] += tv[j]; off[j] += (w < F.wave) ? tv[j] : 0.f; } }
#pragma unroll
    for (int j = 0; j < 8; ++j) { bcum[j] = x[j] + off[j]; blast[j] = tot[j]; }
}
__device__ __forceinline__ void lin_store_vt(Frame& F, const LinRaw& R) {
    LAS bf16_t* VT = (LAS bf16_t*)(F.lds + LN_VT); const int e0 = (F.tid & 15) * 8;
#pragma unroll
    for (int i = 0; i < 2; ++i) { const int s = 32 * i + (F.tid >> 4); const u32x4 w = i == 0 ? R.v0 : R.v1;
        VT[(e0 + 0) * LP + s] = (bf16_t)(w.x & 0xffffu); VT[(e0 + 1) * LP + s] = (bf16_t)(w.x >> 16); VT[(e0 + 2) * LP + s] = (bf16_t)(w.y & 0xffffu); VT[(e0 + 3) * LP + s] = (bf16_t)(w.y >> 16);
        VT[(e0 + 4) * LP + s] = (bf16_t)(w.z & 0xffffu); VT[(e0 + 5) * LP + s] = (bf16_t)(w.z >> 16); VT[(e0 + 6) * LP + s] = (bf16_t)(w.w & 0xffffu); VT[(e0 + 7) * LP + s] = (bf16_t)(w.w >> 16); }
}
__device__ __forceinline__ void lin_state_compute(Frame& F, int unit, const LinRaw& R) {
    const int h = (unit >> 6) & 3, mixer = unit >> 11; const int s = F.tid >> 3, c = F.tid & 7, d0 = 8 * c;
    LAS bf16_t* KDT = (LAS bf16_t*)(F.lds + LN_KI); LAS bf16_t* VT = (LAS bf16_t*)(F.lds + LN_VT);
    float k[8], bcum[8], blast[8];
    lin_rot(R.k0, R.k1, R, mixer == 0, c >= 4, mixer == 0 ? 0.125f : 1.0f, k);
    lin_decay(F, mixer, h, R, bcum, blast);
#pragma unroll
    for (int j = 0; j < 8; ++j) KDT[(d0 + j) * LP + s] = (bf16_t)f2bf(k[j] * __expf(blast[j] - bcum[j]));
    lin_store_vt(F, R);
    if (s == 0) { float* dc = F.DEC() + (size_t)unit * 64 + d0;
        *(f32x4*)dc = (f32x4){__expf(blast[0]), __expf(blast[1]), __expf(blast[2]), __expf(blast[3])}; *(f32x4*)(dc + 4) = (f32x4){__expf(blast[4]), __expf(blast[5]), __expf(blast[6]), __expf(blast[7])}; }
    wg_sync();
    { const int w = F.wave, lane = F.lane; float* st = F.STATE() + (size_t)unit * 8192;
#pragma unroll
      for (int dt = 0; dt < 4; ++dt) { f32x4 acc = (f32x4){0.f, 0.f, 0.f, 0.f}; acc = mma_nt_lds(VT + 16 * w * LP, LP, KDT + 16 * dt * LP, LP, 2, acc, lane);
#pragma unroll
          for (int i = 0; i < 4; ++i) st[(16 * w + 4 * (lane >> 4) + i) * 64 + 16 * dt + (lane & 15)] = acc[i]; } }
}
__device__ __forceinline__ void lin_out_compute(Frame& F, int unit, const LinRaw& R) {
    const int n = unit & 63, h = (unit >> 6) & 3, b = (unit >> 8) & 7, mixer = unit >> 11;
    const size_t row0 = (size_t)b * SEQ + (size_t)n * CH; const int s = F.tid >> 3, c = F.tid & 7, d0 = 8 * c;
    const int ycol = (mixer == 0 ? 0 : 1024) + h * 128;
    LAS bf16_t* QD = (LAS bf16_t*)(F.lds + LN_QD); LAS bf16_t* KI = (LAS bf16_t*)(F.lds + LN_KI); LAS bf16_t* PM = (LAS bf16_t*)(F.lds + LN_PM);
    LAS bf16_t* VT = (LAS bf16_t*)(F.lds + LN_VT); LAS float* OB = (LAS float*)(F.lds + LN_OB);
    float q[8], k[8], bcum[8], blast[8];
    lin_rot(R.q0, R.q1, R, mixer == 0, c >= 4, mixer == 0 ? 1.0f : 0.125f, q);
    lin_rot(R.k0, R.k1, R, mixer == 0, c >= 4, mixer == 0 ? 0.125f : 1.0f, k);
    lin_decay(F, mixer, h, R, bcum, blast);
    { float qd[8], ki[8];
#pragma unroll
      for (int j = 0; j < 8; ++j) { qd[j] = q[j] * __expf(bcum[j]); ki[j] = k[j] * __expf(-bcum[j]); }
      *(LAS u32x4*)(QD + s * LP + d0) = pack8(qd); *(LAS u32x4*)(KI + s * LP + d0) = pack8(ki); }
    lin_store_vt(F, R);
    wg_sync();
    { const int lane = F.lane;
#pragma unroll
      for (int j = 0; j < 2; ++j) { const int tile = 2 * F.wave + j, tt = tile >> 2, st = tile & 3;
          f32x4 acc = (f32x4){0.f, 0.f, 0.f, 0.f};
          if (st <= tt) acc = mma_nt_lds(QD + 16 * tt * LP, LP, KI + 16 * st * LP, LP, 2, acc, lane);
#pragma unroll
          for (int i = 0; i < 4; ++i) { const int t = 16 * tt + 4 * (lane >> 4) + i, s2 = 16 * st + (lane & 15); const float p = (st <= tt && s2 <= t) ? acc[i] : 0.f; PM[t * LP + s2] = (bf16_t)f2bf(p); } } }
    wg_sync();
    { const int w = F.wave, lane = F.lane;
#pragma unroll
      for (int tt = 0; tt < 4; ++tt) { f32x4 acc = (f32x4){0.f, 0.f, 0.f, 0.f};
          acc = mma_nt_lds(PM + 16 * tt * LP, LP, VT + 16 * w * LP, LP, 2, acc, lane);
          const LAS bf16_t* xp = QD + (16 * tt + (lane & 15)) * LP + 8 * (lane >> 4);
          acc = __builtin_amdgcn_mfma_f32_16x16x32_bf16(*(const LAS bf16x8*)xp, R.sp0, acc, 0, 0, 0);
          acc = __builtin_amdgcn_mfma_f32_16x16x32_bf16(*(const LAS bf16x8*)(xp + 32), R.sp1, acc, 0, 0, 0);
#pragma unroll
          for (int i = 0; i < 4; ++i) OB[(16 * tt + 4 * (lane >> 4) + i) * 132 + 16 * w + (lane & 15)] = acc[i]; } }
    wg_sync();
    { const int t = s, part = c; float o[16];
#pragma unroll
      for (int j = 0; j < 4; ++j) { const f32x4 v = *(const LAS f32x4*)(OB + t * 132 + 16 * part + 4 * j); o[4 * j] = v.x; o[4 * j + 1] = v.y; o[4 * j + 2] = v.z; o[4 * j + 3] = v.w; }
      float sm = 0.f;
#pragma unroll
      for (int j = 0; j < 16; ++j) sm += o[j];
      sm += lane_read(sm, F.lane ^ 1); sm += lane_read(sm, F.lane ^ 2); sm += lane_read(sm, F.lane ^ 4);
      const float mu = sm * (1.0f / 128.0f); float qv = 0.f;
#pragma unroll
      for (int j = 0; j < 16; ++j) { const float dlt = o[j] - mu; qv += dlt * dlt; }
      qv += lane_read(qv, F.lane ^ 1); qv += lane_read(qv, F.lane ^ 2); qv += lane_read(qv, F.lane ^ 4);
      const float r = 1.0f / sqrtf(qv * (1.0f / 128.0f) + EPS);
      float g0[8], g1[8]; unpack8(R.g0, g0); unpack8(R.g1, g1);
      float y0[8], y1[8];
#pragma unroll
      for (int j = 0; j < 8; ++j) { y0[j] = (o[j] - mu) * r * siluf_(g0[j]); y1[j] = (o[8 + j] - mu) * r * siluf_(g1[j]); }
      bf16_t* yp = F.Y() + (row0 + t) * D + ycol + 16 * part; *(u32x4*)yp = pack8(y0); *(u32x4*)(yp + 8) = pack8(y1); }
}
template <bool OUT>
__device__ __forceinline__ void lin_phase(Frame& F, int l) {
    { const int h = (F.vcu >> 6) & 3; LAS float* WG = (LAS float*)(F.lds + LN_WG);
      for (int i = F.tid; i < 16 * 64 + 64; i += NWAVES * 64) WG[i] = (i < 1024) ? F.gla_wg()[(size_t)l * 16 * 256 + (i >> 6) * 256 + h * 64 + (i & 63)] : F.gla_bg()[l * 256 + h * 64 + (i - 1024)];
      wg_sync(); }
    LinRaw A, B;
    lin_issue<OUT>(F, F.vcu, A);
    for (int u = F.vcu; u < 4096; u += 2 * F.G) {
        lin_issue<OUT>(F, u + F.G, B);
        if (OUT) lin_out_compute(F, u, A); else lin_state_compute(F, u, A);
        if (u + 2 * F.G < 4096) lin_issue<OUT>(F, u + 2 * F.G, A);
        if (OUT) lin_out_compute(F, u + F.G, B); else lin_state_compute(F, u + F.G, B);
    }
    wg_sync();
}
__device__ __forceinline__ void lin_scan(Frame& F) {
    const int gt = F.vcu * (NWAVES * 64) + F.tid, NGT = F.G * NWAVES * 64;
    for (int i = gt; i < 64 * 8192; i += NGT) {
        const int seq = i >> 13, idx = i & 8191, d = idx & 63;
        const float* st = F.STATE() + (size_t)seq * NCH * 8192 + idx; const float* dc = F.DEC() + (size_t)seq * NCH * 64 + d; bf16_t* sp = F.SPREV() + (size_t)seq * NCH * 8192 + idx;
        float carry = 0.f; asm volatile("" : "+v"(carry));
#pragma unroll
        for (int h = 0; h < 2; ++h) {
            float v[32], c[32];
#pragma unroll
            for (int n = 0; n < 32; ++n) { v[n] = st[(size_t)(32 * h + n) * 8192]; c[n] = dc[(size_t)(32 * h + n) * 64]; }
#pragma unroll
            for (int n = 0; n < 32; ++n) { sp[(size_t)(32 * h + n) * 8192] = (bf16_t)f2bf(carry); carry = c[n] * carry + v[n]; asm volatile("" : "+v"(carry)); }
        }
    }
}
constexpr int S5_WL = 16384, S5_BU = 2048, S5_X = 2048 + 8320;
template <bool OUT>
__device__ __forceinline__ void s5_pass(Frame& F, int l) {
    LAS bf16_t* UT = (LAS bf16_t*)(F.lds + F.wave * S5_WL); LAS float* BU = (LAS float*)(F.lds + F.wave * S5_WL + S5_BU); LAS bf16_t* X = (LAS bf16_t*)(F.lds + F.wave * S5_WL + S5_X);
    const int gw = F.vcu * NWAVES + F.wave, NGW = F.G * NWAVES, lane = F.lane, lr = lane & 15, lq = lane >> 4;
    u32x4 ua, uc;
    { const int g = gw & 31, n = (gw >> 5) & 63, b = gw >> 11; const bf16_t* up = F.PROJ() + ((size_t)b * SEQ + (size_t)n * CH + lane) * NIN + C_SU + g * 16; ua = *(const u32x4*)up; uc = *(const u32x4*)(up + 8); }
    for (int unit = gw; unit < BATCH * NCH * 32; unit += NGW) {
        const int g = unit & 31, n = (unit >> 5) & 63, b = unit >> 11; const size_t row0 = (size_t)b * SEQ + (size_t)n * CH;
        *(LAS u32x4*)(UT + lane * 16) = ua; *(LAS u32x4*)(UT + lane * 16 + 8) = uc;
        if (unit + NGW < BATCH * NCH * 32) { const int un = unit + NGW, g2 = un & 31, n2 = (un >> 5) & 63, b2 = un >> 11;
            const bf16_t* up = F.PROJ() + ((size_t)b2 * SEQ + (size_t)n2 * CH + lane) * NIN + C_SU + g2 * 16; ua = *(const u32x4*)up; uc = *(const u32x4*)(up + 8); }
        const int gp = g * 64 + lane; const float ar = F.abar()[2 * gp], ai = F.abar()[2 * gp + 1];
        bf16x8 bfr[8];
#pragma unroll
        for (int q = 0; q < 8; ++q) { bfr[q] = (bf16x8){0, 0, 0, 0, 0, 0, 0, 0}; if (lq < 2) bfr[q] = *(const bf16x8*)(F.bbt() + ((size_t)g * 128 + 16 * q + lr) * 16 + 8 * lq); }
        float xr = 0.f, xi = 0.f;
        bf16x8 cf[4]; float dsk = 0.f;
        if (OUT) { const f32x2 x0 = *(const f32x2*)(F.XEND() + ((((size_t)(b * 32 + g)) * NCH + n) * 64 + lane) * 2); xr = x0.x; xi = x0.y;
#pragma unroll
            for (int ks = 0; ks < 4; ++ks) cf[ks] = *(const bf16x8*)(F.cmt() + ((size_t)(g * 16 + lr)) * 128 + 32 * ks + 8 * lq);
            dsk = F.s5_d()[(size_t)l * BW + g * 16 + lr]; }
        LDS_WAIT();
        for (int sb = 0; sb < 4; ++sb) {
            bf16x8 af = (bf16x8){0, 0, 0, 0, 0, 0, 0, 0}; if (lq < 2) af = *(const LAS bf16x8*)(UT + (16 * sb + lr) * 16 + 8 * lq);
#pragma unroll
            for (int q = 0; q < 8; ++q) { f32x4 acc = (f32x4){0.f, 0.f, 0.f, 0.f}; acc = __builtin_amdgcn_mfma_f32_16x16x32_bf16(af, bfr[q], acc, 0, 0, 0);
#pragma unroll
                for (int i = 0; i < 4; ++i) BU[(4 * lq + i) * 130 + 16 * q + lr] = acc[i]; }
            LDS_WAIT();
            float br[16], bi[16];
#pragma unroll
            for (int tt = 0; tt < 16; ++tt) { br[tt] = BU[tt * 130 + lane]; bi[tt] = BU[tt * 130 + 64 + lane]; }
#pragma unroll
            for (int tt = 0; tt < 16; ++tt) { const float nr = ar * xr - ai * xi + br[tt], ni = ar * xi + ai * xr + bi[tt]; xr = nr; xi = ni; asm volatile("" : "+v"(xr), "+v"(xi));
                if (OUT) { X[tt * 136 + lane] = (bf16_t)f2bf(xr); X[tt * 136 + 64 + lane] = (bf16_t)f2bf(xi); } }
            if (OUT) {
                LDS_WAIT();
                f32x4 acc = (f32x4){0.f, 0.f, 0.f, 0.f}; const LAS bf16_t* xp = X + lr * 136 + 8 * lq;
#pragma unroll
                for (int ks = 0; ks < 4; ++ks) acc = __builtin_amdgcn_mfma_f32_16x16x32_bf16(*(const LAS bf16x8*)(xp + 32 * ks), cf[ks], acc, 0, 0, 0);
#pragma unroll
                for (int i = 0; i < 4; ++i) { const int tl = 16 * sb + 4 * lq + i; const float u = bflo((unsigned)UT[tl * 16 + lr]); const float y = gelu_tanh(acc[i] + dsk * u);
                    F.YBP()[(row0 + tl) * BW + g * 16 + lr] = (bf16_t)f2bf(y); }
            }
            LDS_WAIT();
        }
        if (!OUT) *(f32x2*)(F.XEND() + ((((size_t)(b * 32 + g)) * NCH + n) * 64 + lane) * 2) = (f32x2){xr, xi};
    }
}
__device__ __forceinline__ void s5_scan(Frame& F) {
    const int gt = F.vcu * (NWAVES * 64) + F.tid, NGT = F.G * NWAVES * 64;
    for (int i = gt; i < BATCH * 32 * 64; i += NGT) {
        const int p = i & 63, bg = i >> 6, g = bg & 31; const float pr = F.apow()[2 * (g * 64 + p)], pi = F.apow()[2 * (g * 64 + p) + 1];
        f32x2* xp = (f32x2*)(F.XEND() + (((size_t)bg * NCH) * 64 + p) * 2);
        float cr = 0.f, ci = 0.f; asm volatile("" : "+v"(cr), "+v"(ci));
#pragma unroll
        for (int h = 0; h < 2; ++h) {
            f32x2 v[32];
#pragma unroll
            for (int n = 0; n < 32; ++n) v[n] = xp[(size_t)(32 * h + n) * 64];
#pragma unroll
            for (int n = 0; n < 32; ++n) { xp[(size_t)(32 * h + n) * 64] = (f32x2){cr, ci};
                const float nr = pr * cr - pi * ci + v[n].x, ni = pr * ci + pi * cr + v[n].y; cr = nr; ci = ni; asm volatile("" : "+v"(cr), "+v"(ci)); }
        }
    }
}

__device__ __forceinline__ void pool_phase(Frame& F, int l) {
    const int gw = F.vcu * NWAVES + F.wave, NGW = F.G * NWAVES, lane = F.lane, lr = lane & 15, lq = lane >> 4;
    for (int unit = gw; unit < BATCH * (SEQ / 16) * 4; unit += NGW) {
        const int g = unit & 3, tile = (unit >> 2) & 255, b = unit >> 10; const int win = 2 << g, tpos = 16 * tile + lr; const size_t row = (size_t)b * SEQ + tpos;
        const bf16_t* pp = F.PROJ() + row * NIN + C_PU + g * 128 + 8 * lq;
        float s[4][8];
#pragma unroll
        for (int ks = 0; ks < 4; ++ks)
#pragma unroll
            for (int j = 0; j < 8; ++j) s[ks][j] = 0.f;
        for (int jj = 1; jj < win; ++jj) { if (tpos - jj >= 0) {
#pragma unroll
            for (int ks = 0; ks < 4; ++ks) { float a[8]; unpack8(*(const u32x4*)(pp - (size_t)jj * NIN + 32 * ks), a);
#pragma unroll
                for (int j = 0; j < 8; ++j) s[ks][j] += a[j]; } } }
        const float inv = 1.0f / (float)min(tpos + 1, win);
        bf16x8 mf[4];
#pragma unroll
        for (int ks = 0; ks < 4; ++ks) { float a[8], m[8]; unpack8(*(const u32x4*)(pp + 32 * ks), a);
#pragma unroll
            for (int j = 0; j < 8; ++j) m[j] = (s[ks][j] + a[j]) * inv - a[j];
            const u32x4 w = pack8(m); mf[ks] = __builtin_bit_cast(bf16x8, w); }
        const bf16_t* pw = F.poolw_t() + (size_t)g * 128 * 128 + (size_t)lr * 128 + 8 * lq;
#pragma unroll
        for (int q = 0; q < 8; ++q) { f32x4 acc = (f32x4){0.f, 0.f, 0.f, 0.f};
#pragma unroll
            for (int ks = 0; ks < 4; ++ks) acc = __builtin_amdgcn_mfma_f32_16x16x32_bf16(*(const bf16x8*)(pw + (size_t)(16 * q) * 128 + 32 * ks), mf[ks], acc, 0, 0, 0);
            const int dcol = g * 128 + 16 * q + 4 * lq; const f32x4 sc = *(const f32x4*)(F.pool_scale() + (size_t)l * BW + dcol);
            u32x2 w; w.x = pk2(acc[0] * sc.x, acc[1] * sc.y); w.y = pk2(acc[2] * sc.z, acc[3] * sc.w);
            *(u32x2*)(F.Y() + row * D + 1536 + dcol) = w; }
    }
}

__device__ __forceinline__ void conv_fix_phase(Frame& F, int l) {
    const float* cw = F.conv_w() + (size_t)l * 3 * NUP; const float* cb = F.conv_b() + (size_t)l * NUP; const float* UH = F.UH();
    const int gt = F.vcu * (NWAVES * 64) + F.tid, NGT = F.G * NWAVES * 64;
    constexpr int JG = DFF / 4;
    for (int task = gt; task < (M / 256) * 2 * JG; task += NGT) {
        const int jg = task % JG, q = (task / JG) & 1, pm = task / (2 * JG);
        if ((pm & 15) == 0) continue;
        const int j0 = jg * 4, ucol = 256 * (j0 >> 7) + (j0 & 127);
        const float* u0p = UH + ((size_t)pm * 4 + q) * NUP + ucol;
        const float* u1p = (q == 1) ? UH + ((size_t)pm * 4 + 0) * NUP + ucol : UH + ((size_t)(pm - 1) * 4 + 3) * NUP + ucol;
        const float* u2p = (q == 1) ? UH + ((size_t)(pm - 1) * 4 + 3) * NUP + ucol : UH + ((size_t)(pm - 1) * 4 + 2) * NUP + ucol;
        const f32x4 a0 = *(const f32x4*)u0p, a1 = *(const f32x4*)u1p, a2 = *(const f32x4*)u2p, v0 = *(const f32x4*)(u0p + 128), v1 = *(const f32x4*)(u1p + 128), v2 = *(const f32x4*)(u2p + 128);
        const f32x4 wa0 = *(const f32x4*)(cw + j0), wa1 = *(const f32x4*)(cw + NUP + j0), wa2 = *(const f32x4*)(cw + 2 * NUP + j0), ba = *(const f32x4*)(cb + j0);
        const f32x4 wv0 = *(const f32x4*)(cw + DFF + j0), wv1 = *(const f32x4*)(cw + NUP + DFF + j0), wv2 = *(const f32x4*)(cw + 2 * NUP + DFF + j0), bv = *(const f32x4*)(cb + DFF + j0);
        float o[4];
#pragma unroll
        for (int i = 0; i < 4; ++i) { const float ca = ba[i] + wa0[i] * a2[i] + wa1[i] * a1[i] + wa2[i] * a0[i], cv = bv[i] + wv0[i] * v2[i] + wv1[i] * v1[i] + wv2[i] * v0[i]; o[i] = siluf_(ca) * cv; }
        u32x2 w; w.x = pk2(o[0], o[1]); w.y = pk2(o[2], o[3]);
        *(u32x2*)(F.ACT() + ((size_t)pm * 256 + q) * DFF + j0) = w;
    }
}

constexpr int NPH = 13;
struct Args { const void* in[25]; float* out; unsigned char* ws; int l_lo, l_hi, ph_lo, ph_hi, single, pad; };
__global__ void __launch_bounds__(NWAVES * 64, 2) hybrid_fwd(Args args) {
    extern __shared__ __attribute__((aligned(16))) unsigned char lds[];
    Frame F;
    F.lds = (LAS unsigned char*)lds;
    F.tid = threadIdx.x; F.lane = F.tid & 63; F.wave = __builtin_amdgcn_readfirstlane(F.tid >> 6);
    const int wave0 = F.wave;
    F.G = gridDim.x; { const int bx = blockIdx.x; F.vcu = (F.G % 8 == 0) ? (bx % 8) * (F.G / 8) + bx / 8 : bx; }
    unsigned char* ws = args.ws; F.ws = ws; F.out = args.out; F.l = 0;

    volatile LAS unsigned* MISC = (volatile LAS unsigned*)(F.lds + MISC_OFF);
    if (F.tid < 64) MISC[F.tid] = 0u;
    wg_sync();
    unsigned* ctl = (unsigned*)(ws + WS_CTL);
    XcdBarrier bar; bar.bar = ctl + CW_BAR; bar.x = 0; bar.st = nullptr;
    if (args.single) bar = xcd_barrier_post(ctl + CW_BAR, MISC);
#define GRID_BAR() do { if (args.single) xcd_barrier(bar); } while (0)
    const int lo = args.ph_lo, hi = args.ph_hi;
#define IN(k) (lo <= (k) && (k) < hi)
#define PH_BEGIN() do { unsigned z_ = 0u; asm volatile("" : "+v"(z_)); const int ln_ = (int)__builtin_amdgcn_mbcnt_hi(~0u, __builtin_amdgcn_mbcnt_lo(~0u, z_)); F.lane = ln_; F.tid = wave0 * 64 + ln_; F.wave = wave0; unsigned long long w_ = (unsigned long long)args.ws, o_ = (unsigned long long)args.out; asm volatile("" : "+s"(w_), "+s"(o_)); F.ws = (unsigned char*)(GAS unsigned char*)w_; F.out = (float*)(GAS float*)o_; } while (0)

    for (int l = args.l_lo; l < args.l_hi; ++l) {
        F.l = l;
        if (IN(0)) { PH_BEGIN(); phase_prep(F, l); GRID_BAR(); }
        if (IN(1)) { PH_BEGIN();
            { pg8::Gemm g{(const bf16_t*)F.HN8(), (const bf16_t*)F.W8(), M, 4 * D, D / 2, D / 2, D / 2}; pg8::StaticOrder S; S.init(M, 4 * D, F.G, (int)blockIdx.x); pg8::EpiProj E{F.PROJ(), NIN, 0, C_GATE, 1.0f / 64.0f};
              pg8::gemm_phase<pg8::EpiProj, true>(F.lds, g, S, E, F.tid); }
            PH_BEGIN();
            { pg8::Gemm g{F.HN(), F.win_t(), M, C_GATE, D, D, D}; pg8::StaticOrder S; S.init(M, C_GATE, F.G, (int)blockIdx.x); pg8::EpiProj E{F.PROJ(), NIN, 1 << 20, C_GATE, 1.0f};
              pg8::gemm_phase(F.lds, g, S, E, F.tid); }
            GRID_BAR(); }
        if (IN(2)) { PH_BEGIN(); lin_phase<false>(F, l); PH_BEGIN();
            s5_pass<false>(F, l); pool_phase(F, l); wg_sync();
            GRID_BAR(); }
        if (IN(3)) { PH_BEGIN(); lin_scan(F); s5_scan(F); GRID_BAR(); }
        if (IN(4)) { PH_BEGIN(); lin_phase<true>(F, l); PH_BEGIN();
            s5_pass<true>(F, l); wg_sync();
            GRID_BAR(); }
        if (IN(5)) { PH_BEGIN(); pg8::Gemm g{F.YBP(), F.wglu_t(), M, BW, BW, BW, BW}; pg8::StaticOrder S; S.init(M, BW, F.G, (int)blockIdx.x); pg8::EpiGlu E{F.YBP(), BW, F.Y() + BW, D};
            pg8::gemm_phase(F.lds, g, S, E, F.tid); GRID_BAR(); }
        if (IN(6)) { PH_BEGIN(); pg8::Gemm g{F.Y(), F.wbr_t(), M, D, D, D, D}; pg8::StaticOrder S; S.init(M, D, F.G, (int)blockIdx.x); pg8::EpiMerge E{F.PROJ() + C_GATE, NIN, F.HN(), D};
            pg8::gemm_phase(F.lds, g, S, E, F.tid); GRID_BAR(); }
        if (IN(7)) { PH_BEGIN(); pg8::Gemm g{F.HN(), F.wout_t(), M, D, D, D, D}; pg8::StaticOrder S; S.init(M, D, F.G, (int)blockIdx.x); pg8::EpiResid E{l == 0 ? (const void*)F.x() : (const void*)F.out, l == 0 ? 1 : 0, F.Y(), D, F.SS()};
            pg8::gemm_phase(F.lds, g, S, E, F.tid); GRID_BAR(); }
        if (IN(8)) { PH_BEGIN(); row_scale(F); GRID_BAR(); }
        if (IN(9)) { PH_BEGIN(); pg8::Gemm g{F.Y(), F.wup_t(), M, NUP, D, D, D}; pg8::StaticOrder S; S.init(M, NUP, F.G, (int)blockIdx.x); pg8::EpiConv E{F.conv_w() + (size_t)l * 3 * NUP, F.conv_b() + (size_t)l * NUP, F.ACT(), F.UH(), (LAS float*)(F.lds + pg8::STAGE_BYTES), F.RS()};
            pg8::gemm_phase(F.lds, g, S, E, F.tid); GRID_BAR(); }
        if (IN(10)) { PH_BEGIN(); conv_fix_phase(F, l); GRID_BAR(); }
        if (IN(11)) { PH_BEGIN(); pg8::Gemm g{F.ACT(), F.wdn_t(), M, D, DFF, DFF, DFF}; pg8::StaticOrder S; S.init(M, D, F.G, (int)blockIdx.x); pg8::EpiResid E{(const void*)F.Y(), 0, l == DEPTH - 1 ? F.HN() : (bf16_t*)F.out, D, nullptr};
            pg8::gemm_phase(F.lds, g, S, E, F.tid); GRID_BAR(); }
        if (IN(12) && l == DEPTH - 1) { PH_BEGIN(); rms_rows16_to_f32(F, F.HN(), F.g_final(), F.out); }
    }
#undef IN
#undef PH_BEGIN
#undef GRID_BAR
}

#pragma clang attribute pop
extern "C" void kernel_launch(void* const* d_in, const int* in_sizes, int n_in, void* d_out, int out_size, void* d_ws, size_t ws_size, hipStream_t stream) {
    static int grid = 0;
    if (grid == 0) {
        if (n_in != 25 || in_sizes[0] != M * D || out_size != M * D || ws_size < WS_END) { fprintf(stderr, "kernel_launch: shape/workspace mismatch (n_in %d, in0 %d, out %d, ws %zu, need %zu); nothing launched\n", n_in, n_in > 0 ? in_sizes[0] : -1, out_size, ws_size, (size_t)WS_END); grid = -1; return; }
        int dev = 0, cus = 0, per_cu = 0;
        if (hipGetDevice(&dev) != hipSuccess || hipDeviceGetAttribute(&cus, hipDeviceAttributeMultiprocessorCount, dev) != hipSuccess) { grid = -1; return; }
        if (hipFuncSetAttribute((const void*)hybrid_fwd, hipFuncAttributeMaxDynamicSharedMemorySize, LDS_BYTES) != hipSuccess) { fprintf(stderr, "kernel_launch: hipFuncSetAttribute failed\n"); grid = -1; return; }
        if (hipOccupancyMaxActiveBlocksPerMultiprocessor(&per_cu, (const void*)hybrid_fwd, NWAVES * 64, LDS_BYTES) != hipSuccess || per_cu < 1) { fprintf(stderr, "kernel_launch: occupancy query reports %d workgroups per CU\n", per_cu); }
        (void)hipGetLastError();
        grid = cus;
    }
    if (grid < 0) return;
    if (hipMemsetAsync((char*)d_ws + WS_CTL, 0, CTL_ZERO_BYTES, stream) != hipSuccess) return;
    Args a{};
    for (int i = 0; i < 25; ++i) a.in[i] = d_in[i];
    a.out = (float*)d_out; a.ws = (unsigned char*)d_ws;
#if MK_SINGLE
    a.l_lo = 0; a.l_hi = DEPTH; a.ph_lo = 0; a.ph_hi = NPH; a.single = 1;
    hipLaunchKernelGGL(hybrid_fwd, dim3(grid), dim3(NWAVES * 64), LDS_BYTES, stream, a);
#else
    a.single = 0;
    for (int l = 0; l < DEPTH; ++l)
        for (int p = 0; p < NPH; ++p) { if (p == 12 && l != DEPTH - 1) continue; a.l_lo = l; a.l_hi = l + 1; a.ph_lo = p; a.ph_hi = p + 1;
            hipLaunchKernelGGL(hybrid_fwd, dim3(grid), dim3(NWAVES * 64), LDS_BYTES, stream, a); }
#endif
}
```

```cpp
#include <hip/hip_runtime.h>
#include <cstdio>
#include <cstdint>

#ifndef MK_SINGLE
#define MK_SINGLE 1
#endif

#pragma clang attribute push(__attribute__((target("no-packed-fp32-ops"))), apply_to = function)
#define LAS __attribute__((address_space(3)))
#define GAS __attribute__((address_space(1)))
typedef unsigned short bf16_t;
typedef short bf16x8 __attribute__((ext_vector_type(8)));
typedef float f32x4 __attribute__((ext_vector_type(4)));
typedef float f32x2 __attribute__((ext_vector_type(2)));
typedef unsigned u32x4 __attribute__((ext_vector_type(4)));
typedef unsigned u32x2 __attribute__((ext_vector_type(2)));

constexpr int D = 2048, BATCH = 8, SEQ = 4096, DEPTH = 4, M = BATCH * SEQ;
constexpr int BW = 512;
constexpr int NIN_SRC = 12304, NIN = 12544;
constexpr int DFF = 5504, NUP = 11008;
constexpr int C_RQ = 0, C_RK = 256, C_RV = 512, C_RG = 1024, C_SU = 1536, C_GQ = 2048, C_GK = 2304, C_GV = 2560, C_GG = 3072, C_PU = 3584, C_GR = 4096, C_GATE = 4352;
constexpr float EPS = 1e-6f;
constexpr int NWAVES = 8;
constexpr int CH = 64;
constexpr int NCH = SEQ / CH;

constexpr size_t MiB = 1u << 20;
constexpr size_t WS_CTL = 0, CTL_ZERO_BYTES = 1 * MiB;
constexpr size_t WS_ROT = 1 * MiB;
constexpr size_t WS_S5T = 9 * MiB;
constexpr size_t S5T_ABAR = 0, S5T_APOW = 16384, S5T_BBAR = 32768, S5T_CMT = 32768 + 262144, S5T_BBT = S5T_CMT + 131072;
constexpr size_t WS_WGLU = 10 * MiB;
constexpr size_t WS_POOLW = 10 * MiB + 512 * 1024;
constexpr size_t WS_WIN = 11 * MiB;
constexpr size_t WS_WBR = 60 * MiB;
constexpr size_t WS_WOUT = 68 * MiB;
constexpr size_t WS_WUP = 76 * MiB;
constexpr size_t WS_WDN = 119 * MiB;
constexpr size_t WS_HN = 141 * MiB;
constexpr size_t WS_Y = 269 * MiB;
constexpr size_t WS_SCR = 397 * MiB;
constexpr size_t WS_YBP = WS_SCR;
constexpr size_t WS_STATE = WS_SCR + 32 * MiB;
constexpr size_t WS_SPREV = WS_SCR + 160 * MiB;
constexpr size_t WS_DEC = WS_SCR + 224 * MiB;
constexpr size_t WS_XEND = WS_SCR + 225 * MiB;
constexpr size_t WS_UH = WS_SCR + 128 * MiB;
constexpr size_t WS_PROJ = 637 * MiB;
constexpr size_t WS_ACT = WS_PROJ;
constexpr size_t WS_RS = 1421 * MiB;
constexpr size_t WS_SS = 1422 * MiB;
constexpr size_t WS_HN8 = 1438 * MiB;
constexpr size_t WS_W8 = 1502 * MiB;
constexpr size_t WS_END = 1518 * MiB;
static_assert(WS_PROJ + (size_t)M * NIN * 2 <= WS_RS, "ws map");
static_assert(WS_ACT + (size_t)M * DFF * 2 <= WS_RS, "ws map");
static_assert(WS_XEND + 8 * MiB <= WS_PROJ, "ws map");
static_assert(WS_UH + (size_t)(M / 256) * 4 * NUP * 4 <= WS_PROJ, "ws map");
constexpr int CW_TMO = 0, CW_BAR = 4096;

constexpr int LDS_BYTES = 155648;
constexpr int MISC_OFF = LDS_BYTES - 256;

#define RLX_AGENT __ATOMIC_RELAXED, __HIP_MEMORY_SCOPE_AGENT
__device__ __forceinline__ void wg_sync() { __builtin_amdgcn_fence(__ATOMIC_RELEASE, "workgroup"); __builtin_amdgcn_s_barrier(); __builtin_amdgcn_fence(__ATOMIC_ACQUIRE, "workgroup"); }
#define LDS_WAIT() asm volatile("s_waitcnt lgkmcnt(0)" ::: "memory")
#define VM_WAIT() asm volatile("s_waitcnt vmcnt(0)" ::: "memory")
__device__ __forceinline__ unsigned f2bf(float f) { unsigned u = __builtin_bit_cast(unsigned, f); return (u + 0x7fffu + ((u >> 16) & 1u)) >> 16; }
__device__ __forceinline__ unsigned pk2(float lo, float hi) { return f2bf(lo) | (f2bf(hi) << 16); }
__device__ __forceinline__ float bflo(unsigned w) { return __builtin_bit_cast(float, w << 16); }
__device__ __forceinline__ float bfhi(unsigned w) { return __builtin_bit_cast(float, w & 0xffff0000u); }
__device__ __forceinline__ void unpack8(const u32x4 w, float (&v)[8]) { v[0] = bflo(w.x); v[1] = bfhi(w.x); v[2] = bflo(w.y); v[3] = bfhi(w.y); v[4] = bflo(w.z); v[5] = bfhi(w.z); v[6] = bflo(w.w); v[7] = bfhi(w.w); }
__device__ __forceinline__ u32x4 pack8(const float (&v)[8]) { u32x4 w; w.x = pk2(v[0], v[1]); w.y = pk2(v[2], v[3]); w.z = pk2(v[4], v[5]); w.w = pk2(v[6], v[7]); return w; }
__device__ __forceinline__ unsigned pk4_fp8(float a, float b, float c, float d) { unsigned w = 0u; w = __builtin_amdgcn_cvt_pk_fp8_f32(a, b, w, false); w = __builtin_amdgcn_cvt_pk_fp8_f32(c, d, w, true); return w; }
__device__ __forceinline__ float sigmoidf_(float x) { return 1.0f / (1.0f + __expf(-x)); }
__device__ __forceinline__ float siluf_(float x) { return x / (1.0f + __expf(-x)); }
__device__ __forceinline__ float gelu_tanh(float x) { const float u = 1.5957691216f * (x + 0.044715f * x * x * x); return x / (1.0f + __expf(-u)); }
__device__ __forceinline__ float logsigmoidf_(float x) { return fminf(x, 0.f) - __logf(1.0f + __expf(-fabsf(x))); }

namespace pg8 {
constexpr int BM = 256, BK = 64, HALF = 128, HTB = HALF * BK * 2, STAGE_BYTES = 8 * HTB, NXCD = 8, WGM = 4;
__host__ __device__ __forceinline__ int lds_byte(int r, int c) { const int st = (r >> 4) * 2 + (c >> 5), rr = r & 15, cc = c & 31, ob = rr * 64 + cc * 2; return st * 1024 + (ob ^ (((ob >> 9) & 1) << 5)); }
__host__ __device__ __forceinline__ void stage_rc(int b, int& R, int& C) { const int st = b / 1024, sb = b % 1024, swz = sb ^ (((sb >> 9) & 1) << 5); R = (st >> 1) * 16 + swz / 64; C = (st & 1) * 32 + (swz % 64) / 2; }
__host__ __device__ __forceinline__ int perm32(int rho) { const int n = rho >> 4, i = rho & 15; return 8 * (i >> 2) + 4 * n + (i & 3); }

struct Unit { int pm, pn; };
struct Gemm { const bf16_t* A; const bf16_t* Bt; int M, N, K, lda, ldb; };

struct StaticOrder {
    int nM, nN, nwg, G, c;
    __host__ __device__ void init(int M_, int N_, int G_, int c_) { nM = M_ / BM; nN = N_ / BM; nwg = nM * nN; G = G_; c = c_; }
    __host__ __device__ bool next(int i, Unit& u) const {
        const long L = (long)i * G + c; if (L >= nwg) return false;
        int wgid = (int)L; { const int q = nwg / NXCD, r = nwg % NXCD, xcd = wgid % NXCD, off = wgid / NXCD; wgid = (xcd < r ? xcd * (q + 1) : r * (q + 1) + (xcd - r) * q) + off; }
        const int nig = WGM * nN, gid = wgid / nig, fm = gid * WGM, gsz = (nM - fm) < WGM ? (nM - fm) : WGM;
        u.pm = fm + ((wgid % nig) % gsz); u.pn = (wgid % nig) / gsz; return true;
    }
};

__device__ __forceinline__ unsigned cvt_pk_bf16(float lo, float hi) { unsigned r; asm volatile("v_cvt_pk_bf16_f32 %0, %1, %2" : "=v"(r) : "v"(lo), "v"(hi)); return r; }

struct EpiStoreBf16 {
    static constexpr bool PERM = true, KHOOK = false;
    bf16_t* O; int ldc;
    __device__ __forceinline__ void khook(f32x4 (&)[2][2][4][2], const Unit&, int, int, int, int, int) const {}
    __device__ __forceinline__ void operator()(f32x4 (&acc)[2][2][4][2], const Unit& u, int wr, int wc, int fr, int fq) const {
        const int row0 = u.pm * BM + wr * 64 + fr, col0 = u.pn * BM + wc * 32 + 8 * fq;
#pragma unroll
        for (int ai = 0; ai < 2; ++ai)
#pragma unroll
            for (int m = 0; m < 4; ++m) { bf16_t* rowp = O + (size_t)(row0 + ai * HALF + m * 16) * ldc + col0;
#pragma unroll
                for (int bj = 0; bj < 2; ++bj) { const f32x4 v0 = acc[ai][bj][m][0], v1 = acc[ai][bj][m][1];
                    u32x4 w; w.x = cvt_pk_bf16(v0[0], v0[1]); w.y = cvt_pk_bf16(v0[2], v0[3]); w.z = cvt_pk_bf16(v1[0], v1[1]); w.w = cvt_pk_bf16(v1[2], v1[3]);
                    *(u32x4*)(rowp + bj * HALF) = w; } }
    }
};
struct EpiProj {
    static constexpr bool PERM = true, KHOOK = false;
    bf16_t* O; int ldc; int gate_pn0; int gate_col0; float gscale;
    __device__ __forceinline__ void khook(f32x4 (&)[2][2][4][2], const Unit&, int, int, int, int, int) const {}
    __device__ __forceinline__ void operator()(f32x4 (&acc)[2][2][4][2], const Unit& u, int wr, int wc, int fr_, int fq_) const {
        int fr = fr_, fq = fq_; asm volatile("" : "+v"(fr), "+v"(fq));
        const int row0 = u.pm * BM + wr * 64 + fr;
        if (u.pn < gate_pn0) {
            const int col0 = u.pn * BM + wc * 32 + 8 * fq;
#pragma unroll
            for (int ai = 0; ai < 2; ++ai)
#pragma unroll
                for (int m = 0; m < 4; ++m) { bf16_t* rowp = O + (size_t)(row0 + ai * HALF + m * 16) * ldc + col0;
#pragma unroll
                    for (int bj = 0; bj < 2; ++bj) { const f32x4 v0 = acc[ai][bj][m][0], v1 = acc[ai][bj][m][1];
                        u32x4 w; w.x = cvt_pk_bf16(v0[0], v0[1]); w.y = cvt_pk_bf16(v0[2], v0[3]); w.z = cvt_pk_bf16(v1[0], v1[1]); w.w = cvt_pk_bf16(v1[2], v1[3]);
                        *(u32x4*)(rowp + bj * HALF) = w; } }
        } else {
            const int col0 = gate_col0 + 64 * (u.pn - gate_pn0) + 16 * wc + 4 * fq;
#pragma unroll
            for (int ai = 0; ai < 2; ++ai)
#pragma unroll
                for (int m = 0; m < 4; ++m) { bf16_t* rowp = O + (size_t)(row0 + ai * HALF + m * 16) * ldc + col0;
                    float r1[4], r2[4], r3[4], g3[4];
#pragma unroll
                    for (int i = 0; i < 4; ++i) {
                        const float e0 = __expf(-fminf(fmaxf(acc[ai][0][m][0][i] * gscale, -30.f), 30.f)), e1 = __expf(-fminf(fmaxf(acc[ai][0][m][1][i] * gscale, -30.f), 30.f));
                        const float e2 = __expf(-fminf(fmaxf(acc[ai][1][m][0][i] * gscale, -30.f), 30.f)), e3 = __expf(-fminf(fmaxf(acc[ai][1][m][1][i] * gscale, -30.f), 30.f));
                        const float i0 = __builtin_amdgcn_rcpf(1.f + e0), i1 = __builtin_amdgcn_rcpf(1.f + e1), i2 = __builtin_amdgcn_rcpf(1.f + e2), i3 = __builtin_amdgcn_rcpf(1.f + e3);
                        r1[i] = (1.f + e1) * i0; r2[i] = (1.f + e2) * i1; r3[i] = (1.f + e3) * i2; g3[i] = i3; }
                    u32x2 w;
                    w.x = cvt_pk_bf16(r1[0], r1[1]); w.y = cvt_pk_bf16(r1[2], r1[3]); *(u32x2*)(rowp) = w;
                    w.x = cvt_pk_bf16(r2[0], r2[1]); w.y = cvt_pk_bf16(r2[2], r2[3]); *(u32x2*)(rowp + D) = w;
                    w.x = cvt_pk_bf16(r3[0], r3[1]); w.y = cvt_pk_bf16(r3[2], r3[3]); *(u32x2*)(rowp + 2 * D) = w;
                    w.x = cvt_pk_bf16(g3[0], g3[1]); w.y = cvt_pk_bf16(g3[2], g3[3]); *(u32x2*)(rowp + 3 * D) = w; }
        }
    }
};
__device__ __forceinline__ float dpp_ror1(float x) { return __builtin_bit_cast(float, __builtin_amdgcn_update_dpp(0, __builtin_bit_cast(int, x), 0x121, 0xf, 0xf, false)); }
__device__ __forceinline__ float dpp_ror2(float x) { return __builtin_bit_cast(float, __builtin_amdgcn_update_dpp(0, __builtin_bit_cast(int, x), 0x122, 0xf, 0xf, false)); }
struct EpiConv {
    static constexpr bool PERM = true, KHOOK = false;
    const float* cw; const float* cb; bf16_t* O; float* UH; LAS float* halo; const float* RS;
    __device__ __forceinline__ void khook(f32x4 (&)[2][2][4][2], const Unit&, int, int, int, int, int) const {}
    __device__ __forceinline__ void operator()(f32x4 (&acc)[2][2][4][2], const Unit& u, int wr, int wc, int fr_, int fq_) const {
        int fr = fr_, fq = fq_; asm volatile("" : "+v"(fr), "+v"(fq));
        const int cl0 = wc * 32 + 8 * fq;
#pragma unroll
        for (int ai = 0; ai < 2; ++ai)
#pragma unroll
            for (int m = 0; m < 4; ++m) { const float r = RS[u.pm * BM + ai * HALF + wr * 64 + m * 16 + fr];
#pragma unroll
                for (int bj = 0; bj < 2; ++bj)
#pragma unroll
                    for (int n = 0; n < 2; ++n) acc[ai][bj][m][n] *= r; }
        if (fr >= 14) {
#pragma unroll
            for (int ai = 0; ai < 2; ++ai)
#pragma unroll
                for (int bj = 0; bj < 2; ++bj)
#pragma unroll
                    for (int n = 0; n < 2; ++n) *(LAS f32x4*)(halo + (((2 * ai + wr) * 2 + (fr - 14)) * 256 + 128 * bj + cl0 + 4 * n)) = acc[ai][bj][3][n];
        }
        if (wr == 0 && fr < 2) {
#pragma unroll
            for (int bj = 0; bj < 2; ++bj)
#pragma unroll
                for (int n = 0; n < 2; ++n) *(f32x4*)(UH + ((size_t)u.pm * 4 + fr) * NUP + 256 * u.pn + 128 * bj + cl0 + 4 * n) = acc[0][bj][0][n];
        }
        if (wr == 1 && fr >= 14) {
#pragma unroll
            for (int bj = 0; bj < 2; ++bj)
#pragma unroll
                for (int n = 0; n < 2; ++n) *(f32x4*)(UH + ((size_t)u.pm * 4 + 2 + (fr - 14)) * NUP + 256 * u.pn + 128 * bj + cl0 + 4 * n) = acc[1][bj][3][n];
        }
        asm volatile("s_waitcnt lgkmcnt(0)" ::: "memory"); __builtin_amdgcn_s_barrier(); asm volatile("" ::: "memory");
        const int j0 = 128 * u.pn + cl0;
        const bool is15 = fr == 15, ge14 = fr >= 14;
        unsigned keep[2][4][2];
#pragma unroll
        for (int n = 0; n < 2; ++n) {
            f32x4 wa[3], wv[3];
#pragma unroll
            for (int q = 0; q < 3; ++q) { wa[q] = *(const f32x4*)(cw + q * NUP + j0 + 4 * n); wv[q] = *(const f32x4*)(cw + q * NUP + DFF + j0 + 4 * n); }
            const f32x4 ba = *(const f32x4*)(cb + j0 + 4 * n), bv = *(const f32x4*)(cb + DFF + j0 + 4 * n);
#pragma unroll
            for (int ai = 0; ai < 2; ++ai) {
                const int blk = 2 * ai + wr;
                f32x4 pa = (f32x4){0.f, 0.f, 0.f, 0.f}, pv = (f32x4){0.f, 0.f, 0.f, 0.f};
                if (blk > 0 && ge14) { pa = *(const LAS f32x4*)(halo + (((blk - 1) * 2 + (fr - 14)) * 256 + cl0 + 4 * n)); pv = *(const LAS f32x4*)(halo + (((blk - 1) * 2 + (fr - 14)) * 256 + 128 + cl0 + 4 * n)); }
#pragma unroll
                for (int m = 0; m < 4; ++m) {
                    const f32x4 ca_ = acc[ai][0][m][n], cv_ = acc[ai][1][m][n]; float o[4];
#pragma unroll
                    for (int i = 0; i < 4; ++i) {
                        const float a1 = dpp_ror1(is15 ? pa[i] : ca_[i]), a2 = dpp_ror2(ge14 ? pa[i] : ca_[i]);
                        const float v1 = dpp_ror1(is15 ? pv[i] : cv_[i]), v2 = dpp_ror2(ge14 ? pv[i] : cv_[i]);
                        const float ca = ba[i] + wa[0][i] * a2 + wa[1][i] * a1 + wa[2][i] * ca_[i];
                        const float cv = bv[i] + wv[0][i] * v2 + wv[1][i] * v1 + wv[2][i] * cv_[i];
                        o[i] = siluf_(ca) * cv; }
                    pa = ca_; pv = cv_;
                    const unsigned lo = cvt_pk_bf16(o[0], o[1]), hi = cvt_pk_bf16(o[2], o[3]);
                    if (n == 0) { keep[ai][m][0] = lo; keep[ai][m][1] = hi; }
                    else { u32x4 w; w.x = keep[ai][m][0]; w.y = keep[ai][m][1]; w.z = lo; w.w = hi;
                        *(u32x4*)(O + (size_t)(u.pm * BM + ai * HALF + wr * 64 + m * 16 + fr) * DFF + j0) = w; }
                }
            }
        }
    }
};
struct EpiResid {
    static constexpr bool PERM = true, KHOOK = false;
    const void* base; int base_f32; bf16_t* O; int ldc; float* SS;
    __device__ __forceinline__ void khook(f32x4 (&)[2][2][4][2], const Unit&, int, int, int, int, int) const {}
    __device__ __forceinline__ void operator()(f32x4 (&acc)[2][2][4][2], const Unit& u, int wr, int wc, int fr_, int fq_) const {
        int fr = fr_, fq = fq_; asm volatile("" : "+v"(fr), "+v"(fq));
        const int row0 = u.pm * BM + wr * 64 + fr, col0 = u.pn * BM + wc * 32 + 8 * fq, lane = fq * 16 + fr;
#pragma unroll
        for (int ai = 0; ai < 2; ++ai)
#pragma unroll
            for (int m = 0; m < 4; ++m) { const size_t off = (size_t)(row0 + ai * HALF + m * 16) * ldc + col0; float sq = 0.f;
#pragma unroll
                for (int bj = 0; bj < 2; ++bj) { float b[8];
                    if (base_f32) { const float* bp = (const float*)base + off + bj * HALF; const f32x4 b0 = *(const f32x4*)bp, b1 = *(const f32x4*)(bp + 4); b[0] = b0.x; b[1] = b0.y; b[2] = b0.z; b[3] = b0.w; b[4] = b1.x; b[5] = b1.y; b[6] = b1.z; b[7] = b1.w; }
                    else unpack8(*(const u32x4*)((const bf16_t*)base + off + bj * HALF), b);
                    const f32x4 v0 = acc[ai][bj][m][0], v1 = acc[ai][bj][m][1];
                    const float o0 = b[0] + v0[0], o1 = b[1] + v0[1], o2 = b[2] + v0[2], o3 = b[3] + v0[3], o4 = b[4] + v1[0], o5 = b[5] + v1[1], o6 = b[6] + v1[2], o7 = b[7] + v1[3];
                    u32x4 w; w.x = cvt_pk_bf16(o0, o1); w.y = cvt_pk_bf16(o2, o3); w.z = cvt_pk_bf16(o4, o5); w.w = cvt_pk_bf16(o6, o7);
                    *(u32x4*)(O + off + bj * HALF) = w;
                    sq += ((o0 * o0 + o1 * o1) + (o2 * o2 + o3 * o3)) + ((o4 * o4 + o5 * o5) + (o6 * o6 + o7 * o7)); }
                if (SS) { sq += __builtin_bit_cast(float, __builtin_amdgcn_ds_bpermute((lane ^ 16) << 2, __builtin_bit_cast(int, sq)));
                    sq += __builtin_bit_cast(float, __builtin_amdgcn_ds_bpermute((lane ^ 32) << 2, __builtin_bit_cast(int, sq)));
                    if (fq == 0) SS[(size_t)(u.pn * 4 + wc) * M + row0 + ai * HALF + m * 16] = sq; }
                asm volatile("" ::: "memory"); }
    }
};
struct EpiGlu {
    static constexpr bool PERM = true, KHOOK = false;
    const bf16_t* Yp; int ldy; bf16_t* O; int ldc;
    __device__ __forceinline__ void khook(f32x4 (&)[2][2][4][2], const Unit&, int, int, int, int, int) const {}
    __device__ __forceinline__ void operator()(f32x4 (&acc)[2][2][4][2], const Unit& u, int wr, int wc, int fr, int fq) const {
        const int row0 = u.pm * BM + wr * 64 + fr, col0 = u.pn * BM + wc * 32 + 8 * fq;
#pragma unroll
        for (int ai = 0; ai < 2; ++ai)
#pragma unroll
            for (int m = 0; m < 4; ++m) { const size_t r = (size_t)(row0 + ai * HALF + m * 16);
#pragma unroll
                for (int bj = 0; bj < 2; ++bj) { const u32x4 yw = *(const u32x4*)(Yp + r * ldy + col0 + bj * HALF); float y[8]; unpack8(yw, y);
                    const f32x4 v0 = acc[ai][bj][m][0], v1 = acc[ai][bj][m][1]; float o[8];
#pragma unroll
                    for (int j = 0; j < 4; ++j) { o[j] = y[j] * sigmoidf_(v0[j]); o[4 + j] = y[4 + j] * sigmoidf_(v1[j]); }
                    u32x4 w; w.x = cvt_pk_bf16(o[0], o[1]); w.y = cvt_pk_bf16(o[2], o[3]); w.z = cvt_pk_bf16(o[4], o[5]); w.w = cvt_pk_bf16(o[6], o[7]);
                    *(u32x4*)(O + r * ldc + col0 + bj * HALF) = w; } }
    }
};
struct EpiMerge {
    static constexpr bool PERM = true, KHOOK = true;
    const bf16_t* G; int ldg; bf16_t* O; int ldc;
    __device__ __forceinline__ void scale(f32x4 (&acc)[2][2][4][2], const Unit& u, int s, int wr, int wc, int fr, int fq) const {
        int row0 = u.pm * BM + wr * 64 + fr, col0 = u.pn * BM + wc * 32 + 8 * fq + s * D; asm volatile("" : "+v"(row0), "+v"(col0));
        u32x4 w[2][4][2];
#pragma unroll
        for (int ai = 0; ai < 2; ++ai)
#pragma unroll
            for (int m = 0; m < 4; ++m) { const bf16_t* gp = G + (size_t)(row0 + ai * HALF + m * 16) * ldg + col0;
#pragma unroll
                for (int bj = 0; bj < 2; ++bj) w[ai][m][bj] = *(const u32x4*)(gp + bj * HALF); }
#pragma unroll
        for (int ai = 0; ai < 2; ++ai)
#pragma unroll
            for (int m = 0; m < 4; ++m)
#pragma unroll
                for (int bj = 0; bj < 2; ++bj) { float f[8]; unpack8(w[ai][m][bj], f);
#pragma unroll
                    for (int j = 0; j < 8; ++j) acc[ai][bj][m][j >> 2][j & 3] *= f[j]; }
    }
    __device__ __forceinline__ void khook(f32x4 (&acc)[2][2][4][2], const Unit& u, int seg, int wr, int wc, int fr, int fq) const { scale(acc, u, seg - 1, wr, wc, fr, fq); }
    __device__ __forceinline__ void operator()(f32x4 (&acc)[2][2][4][2], const Unit& u, int wr, int wc, int fr, int fq) const {
        scale(acc, u, 3, wr, wc, fr, fq);
        const int row0 = u.pm * BM + wr * 64 + fr, col0 = u.pn * BM + wc * 32 + 8 * fq;
#pragma unroll
        for (int ai = 0; ai < 2; ++ai)
#pragma unroll
            for (int m = 0; m < 4; ++m) { bf16_t* rowp = O + (size_t)(row0 + ai * HALF + m * 16) * ldc + col0;
#pragma unroll
                for (int bj = 0; bj < 2; ++bj) { const f32x4 v0 = acc[ai][bj][m][0], v1 = acc[ai][bj][m][1];
                    u32x4 w; w.x = cvt_pk_bf16(v0[0], v0[1]); w.y = cvt_pk_bf16(v0[2], v0[3]); w.z = cvt_pk_bf16(v1[0], v1[1]); w.w = cvt_pk_bf16(v1[2], v1[3]);
                    *(u32x4*)(rowp + bj * HALF) = w; } }
    }
};

typedef int v4i_t __attribute__((ext_vector_type(4)));
typedef int v8i_t __attribute__((ext_vector_type(8)));
template <class Epi, bool F8 = false>
__device__ __forceinline__ void gemm_phase(LAS unsigned char* lds, const Gemm g, const StaticOrder& S, const Epi& E, int tid_in) {
    int tid_ = tid_in; asm volatile("" : "+v"(tid_));
    const int tid = tid_, wid = __builtin_amdgcn_readfirstlane(tid >> 6), lane = tid & 63, wr = wid >> 2, wc = wid & 3, fr = lane & 15, fq = lane >> 4;
    const int K = g.K, nt = K / BK;
    unsigned voffA[2], voffB[2];
#pragma unroll
    for (int i = 0; i < 2; ++i) { int R, C; stage_rc(tid * 16 + i * 8192, R, C); const int Rb = Epi::PERM ? ((R & ~31) + perm32(R & 31)) : R;
        voffA[i] = (unsigned)(R * g.lda + C) * 2u; voffB[i] = (unsigned)(Rb * g.ldb + C) * 2u; }
    const size_t kstep = (size_t)(BK * 2);
    const size_t hstepA = (size_t)HALF * g.lda * 2, hstepB = (size_t)HALF * g.ldb * 2;
    const size_t tstepA = 2 * hstepA, tstepB = 2 * hstepB;
    const unsigned ldsw = (unsigned)wid * 1024u;
    const int aoff = lds_byte(wr * 64 + fr, fq * 8), boff = lds_byte(wc * 32 + fr, fq * 8);
#define PG8_SA(b, h) (((b) * 2 + (h)) * HTB)
#define PG8_SB(b, h) ((4 + (b) * 2 + (h)) * HTB)
#define PG8_STAGE(bufoff, gbase, voff) do { _Pragma("unroll") for (int _i = 0; _i < 2; ++_i) \
        __builtin_amdgcn_global_load_lds((const unsigned*)((const char*)(gbase) + (voff)[_i]), (LAS unsigned*)(lds + (bufoff) + ldsw + _i * 8192), 16, 0, 0); } while (0)
#define PG8_LDA(dst, b, h) do { _Pragma("unroll") for (int m = 0; m < 4; ++m) _Pragma("unroll") for (int k = 0; k < 2; ++k) dst[m][k] = *(const LAS bf16x8*)(lds + PG8_SA(b, h) + aoff + m * 2048 + k * 1024); } while (0)
#define PG8_LDB(dst, b, h) do { _Pragma("unroll") for (int n = 0; n < 2; ++n) _Pragma("unroll") for (int k = 0; k < 2; ++k) dst[n][k] = *(const LAS bf16x8*)(lds + PG8_SB(b, h) + boff + n * 2048 + k * 1024); } while (0)
#define PG8_MMA(ai, bj, At, Bt) do { __builtin_amdgcn_s_setprio(1); _Pragma("unroll") for (int m = 0; m < 4; ++m) _Pragma("unroll") for (int n = 0; n < 2; ++n) _Pragma("unroll") for (int k = 0; k < 2; ++k) \
        acc[ai][bj][m][n] = __builtin_amdgcn_mfma_f32_16x16x32_bf16(Bt[n][k], At[m][k], acc[ai][bj][m][n], 0, 0, 0); __builtin_amdgcn_s_setprio(0); } while (0)
#define PG8_MMA16(ai, bj, At, Bt) PG8_MMA(ai, bj, At, Bt)
#define PG8_MMA8(ai, bj, A8, B8) do { __builtin_amdgcn_s_setprio(1); _Pragma("unroll") for (int m = 0; m < 4; ++m) _Pragma("unroll") for (int n = 0; n < 2; ++n) \
        asm volatile("v_mfma_f32_16x16x128_f8f6f4 %0, %1, %2, %0" : "+v"(acc[ai][bj][m][n]) : "v"(B8[n]), "v"(A8[m])); __builtin_amdgcn_s_setprio(0); } while (0)
#define PG8_LDA8(dst, b, h) do { _Pragma("unroll") for (int m = 0; m < 4; ++m) { dst[m].lo = *(const LAS v4i_t*)(lds + PG8_SA(b, h) + aoff + m * 2048); dst[m].hi = *(const LAS v4i_t*)(lds + PG8_SA(b, h) + aoff + m * 2048 + 1024); } } while (0)
#define PG8_LDB8(dst, b, h) do { _Pragma("unroll") for (int n = 0; n < 2; ++n) { dst[n].lo = *(const LAS v4i_t*)(lds + PG8_SB(b, h) + boff + n * 2048); dst[n].hi = *(const LAS v4i_t*)(lds + PG8_SB(b, h) + boff + n * 2048 + 1024); } } while (0)
#define PG8_XLDA(b, h) do { if constexpr (F8) PG8_LDA8(A8, b, h); else PG8_LDA(At, b, h); } while (0)
#define PG8_XLDB0(b, h) do { if constexpr (F8) PG8_LDB8(B08, b, h); else PG8_LDB(B0, b, h); } while (0)
#define PG8_XLDB1(b, h) do { if constexpr (F8) PG8_LDB8(B18, b, h); else PG8_LDB(B1, b, h); } while (0)
#define PG8_MM0(ai, bj) do { if constexpr (F8) PG8_MMA8(ai, bj, A8, B08); else PG8_MMA16(ai, bj, At, B0); } while (0)
#define PG8_MM1(ai, bj) do { if constexpr (F8) PG8_MMA8(ai, bj, A8, B18); else PG8_MMA16(ai, bj, At, B1); } while (0)
#define PG8_WAIT_V(n) asm volatile("s_waitcnt vmcnt(" #n ")" ::: "memory")
#define PG8_WAIT_L(n) asm volatile("s_waitcnt lgkmcnt(" #n ")" ::: "memory")
#define PG8_BAR __builtin_amdgcn_s_barrier()
#define PG8_SCHED __builtin_amdgcn_sched_barrier(0)
    Unit cur, nxt; int ui = 0;
    if (!S.next(0, cur)) return;
    f32x4 acc[2][2][4][2];
#pragma unroll
    for (int a = 0; a < 2; ++a)
#pragma unroll
        for (int b = 0; b < 2; ++b)
#pragma unroll
            for (int m = 0; m < 4; ++m)
#pragma unroll
                for (int n = 0; n < 2; ++n) acc[a][b][m][n] = (f32x4){0.f, 0.f, 0.f, 0.f};
    bf16x8 At[4][2], B0[2][2], B1[2][2]; v8i_t A8[4], B08[2], B18[2];
    const char* cA = (const char*)g.A + (size_t)cur.pm * tstepA; const char* cB = (const char*)g.Bt + (size_t)cur.pn * tstepB;
    PG8_STAGE(PG8_SB(0, 0), cB, voffB); PG8_STAGE(PG8_SB(0, 1), cB + hstepB, voffB); PG8_STAGE(PG8_SA(0, 0), cA, voffA); PG8_STAGE(PG8_SA(0, 1), cA + hstepA, voffA);
    if (wr == 1) PG8_BAR;
    PG8_WAIT_V(2); PG8_BAR;
    PG8_STAGE(PG8_SB(1, 0), cB + kstep, voffB); PG8_STAGE(PG8_SA(1, 0), cA + kstep, voffA); PG8_STAGE(PG8_SB(1, 1), cB + hstepB + kstep, voffB);
    PG8_WAIT_V(6); PG8_BAR;
    for (;;) {
        const bool has_next = S.next(ui + 1, nxt);
        const char* nA = has_next ? (const char*)g.A + (size_t)nxt.pm * tstepA : cA; const char* nB = has_next ? (const char*)g.Bt + (size_t)nxt.pn * tstepB : cB;
        for (int t = 0; t < nt; t += 2) {
            const bool last = (t == nt - 2);
            const char* a1 = cA + (size_t)(t + 1) * kstep;
            const char* a2 = last ? nA : cA + (size_t)(t + 2) * kstep; const char* b2 = last ? nB : cB + (size_t)(t + 2) * kstep;
            const char* a3 = a2 + kstep; const char* b3 = b2 + kstep;
            if constexpr (Epi::KHOOK) { if (t != 0 && (t & 7) == 0) E.khook(acc, cur, t >> 3, wr, wc, fr, fq); }
            PG8_XLDB0(0, 0); PG8_XLDB1(0, 1); PG8_SCHED; PG8_XLDA(0, 0); PG8_STAGE(PG8_SA(1, 1), a1 + hstepA, voffA);
            PG8_WAIT_V(8); PG8_WAIT_L(0); PG8_BAR; PG8_MM0(0, 0); PG8_MM1(0, 1); PG8_BAR; PG8_SCHED;
            PG8_XLDA(0, 1); PG8_STAGE(PG8_SB(0, 0), b2, voffB); PG8_STAGE(PG8_SB(0, 1), b2 + hstepB, voffB); PG8_STAGE(PG8_SA(0, 0), a2, voffA);
            PG8_WAIT_V(8); PG8_WAIT_L(0); PG8_BAR; PG8_MM0(1, 0); PG8_MM1(1, 1); PG8_BAR; PG8_SCHED;
            PG8_XLDB0(1, 0); PG8_XLDB1(1, 1); PG8_SCHED; PG8_XLDA(1, 0); PG8_STAGE(PG8_SA(0, 1), a2 + hstepA, voffA);
            PG8_WAIT_V(8); PG8_WAIT_L(0); PG8_BAR; PG8_MM0(0, 0); PG8_MM1(0, 1); PG8_BAR; PG8_SCHED;
            PG8_XLDA(1, 1); PG8_STAGE(PG8_SB(1, 0), b3, voffB); PG8_STAGE(PG8_SB(1, 1), b3 + hstepB, voffB); PG8_STAGE(PG8_SA(1, 0), a3, voffA);
            PG8_WAIT_V(8); PG8_WAIT_L(0); PG8_BAR; PG8_MM0(1, 0); PG8_MM1(1, 1); PG8_BAR; PG8_SCHED;
        }
        if (wr == 0) PG8_BAR;
        E(acc, cur, wr, wc, fr, fq);
        if (!has_next) break;
#pragma unroll
        for (int a = 0; a < 2; ++a)
#pragma unroll
            for (int b = 0; b < 2; ++b)
#pragma unroll
                for (int m = 0; m < 4; ++m)
#pragma unroll
                    for (int n = 0; n < 2; ++n) acc[a][b][m][n] = (f32x4){0.f, 0.f, 0.f, 0.f};
        cur = nxt; cA = nA; cB = nB; ++ui;
        if (wr == 1) PG8_BAR;
    }
    PG8_WAIT_V(0);
    PG8_BAR;
#undef PG8_SA
#undef PG8_SB
#undef PG8_STAGE
#undef PG8_LDA
#undef PG8_LDB
#undef PG8_MMA
#undef PG8_MMA8
#undef PG8_MMA16
#undef PG8_LDA8
#undef PG8_LDB8
#undef PG8_XLDA
#undef PG8_XLDB0
#undef PG8_XLDB1
#undef PG8_MM0
#undef PG8_MM1
#undef PG8_WAIT_V
#undef PG8_WAIT_L
#undef PG8_BAR
#undef PG8_SCHED
}
}

#define XB_TMO      128
#define XB_XCNT(j)  (256  + 64 * (j))
#define XB_XSUB(j)  (1280 + 64 * (j))
#define XB_XGEN(j)  (2304 + 64 * (j))
#define XB_TOP      3328
#define XB_TOPGEN   3392
#define XCD_BAR_WORDS 3456
#define XB_SPIN_CAP (1u << 18)
__device__ __forceinline__ unsigned xb_ld(unsigned* p)              { return __hip_atomic_load(p, __ATOMIC_RELAXED, __HIP_MEMORY_SCOPE_AGENT); }
__device__ __forceinline__ unsigned xb_add(unsigned* p, unsigned v) { return __hip_atomic_fetch_add(p, v, __ATOMIC_RELAXED, __HIP_MEMORY_SCOPE_AGENT); }
__device__ __forceinline__ unsigned xb_xcc_id() { return (unsigned)__builtin_amdgcn_s_getreg((3 << 11) | 20) & 0xFu; }
#define XB_SPIN(cond, bar) do { unsigned _sp = 0; while (cond) { __builtin_amdgcn_s_sleep(1); \
    if ((++_sp & 255u) == 0u) { if (xb_ld(&(bar)[XB_TMO])) break; if (_sp > XB_SPIN_CAP) { (void)__hip_atomic_fetch_add(&(bar)[XB_TMO], 1u, __ATOMIC_RELAXED, __HIP_MEMORY_SCOPE_AGENT); break; } } } } while (0)
struct XcdBarrier { unsigned* bar; unsigned x; volatile LAS unsigned* st; };
__device__ __forceinline__ XcdBarrier xcd_barrier_post(unsigned* bar, volatile LAS unsigned* st) {
    XcdBarrier b; b.bar = bar; b.x = xb_xcc_id(); b.st = st;
    if (threadIdx.x == 0) (void)xb_add(&bar[XB_XCNT(b.x)], 1u);
    return b;
}
__device__ __forceinline__ void xcd_barrier_complete(unsigned* bar, unsigned x, unsigned& nloc, unsigned& nx) {
    const unsigned G = gridDim.x * gridDim.y * gridDim.z;
    unsigned sum, cnt, mine, sp = 0u;
    for (;;) {
        sum = 0u; cnt = 0u; mine = 0u;
#pragma nounroll
        for (unsigned j = 0; j < 16; ++j) { const unsigned c = xb_ld(&bar[XB_XCNT(j)]); sum += c; cnt += (c > 0u) ? 1u : 0u; mine = (j == x) ? c : mine; }
        if (sum == G) break;
        __builtin_amdgcn_s_sleep(1);
        if ((++sp & 255u) == 0u) { if (xb_ld(&bar[XB_TMO])) break; if (sp > XB_SPIN_CAP) { (void)__hip_atomic_fetch_add(&bar[XB_TMO], 1u, __ATOMIC_RELAXED, __HIP_MEMORY_SCOPE_AGENT); break; } }
    }
    nloc = mine > 0u ? mine : 1u; nx = cnt > 0u ? cnt : 1u;
}
__device__ __forceinline__ void xcd_barrier(const XcdBarrier& b) {
    asm volatile("s_waitcnt vmcnt(0)" ::: "memory");
    wg_sync();
    if (threadIdx.x == 0) {
        unsigned* bar = b.bar;
        __builtin_amdgcn_s_waitcnt(0);
        unsigned nloc = b.st[0], nx = b.st[1];
        if (nloc == 0u) { xcd_barrier_complete(bar, b.x, nloc, nx); b.st[0] = nloc; b.st[1] = nx; }
        const unsigned old = xb_add(&bar[XB_XSUB(b.x)], 1u);
        const unsigned gen = old / nloc;
        if (old + 1u == (gen + 1u) * nloc) {
            __builtin_amdgcn_fence(__ATOMIC_RELEASE, "agent");
            asm volatile("s_waitcnt vmcnt(0)" ::: "memory");
            const unsigned og = xb_add(&bar[XB_TOP], 1u);
            const unsigned tg = og / nx;
            if (og + 1u == (tg + 1u) * nx) xb_add(&bar[XB_TOPGEN], 1u);
            else XB_SPIN(xb_ld(&bar[XB_TOPGEN]) == tg, bar);
            __builtin_amdgcn_fence(__ATOMIC_ACQUIRE, "agent");
            xb_add(&bar[XB_XGEN(b.x)], 1u);
            asm volatile("s_waitcnt vmcnt(0)" ::: "memory");
        } else {
            XB_SPIN(xb_ld(&bar[XB_XGEN(b.x)]) == gen, bar);
            __builtin_amdgcn_fence(__ATOMIC_ACQUIRE, "agent");
            asm volatile("s_waitcnt vmcnt(0)" ::: "memory");
        }
    }
    wg_sync();
}

__device__ __forceinline__ const void* kin(int k) {
    typedef __attribute__((address_space(4))) const char* kptr_t;
    kptr_t p = (kptr_t)__builtin_amdgcn_kernarg_segment_ptr(); asm volatile("" : "+s"(p));
    const unsigned long long v = *(__attribute__((address_space(4))) const unsigned long long*)(p + 8 * k);
    return (const void*)(GAS const void*)v;
}
struct Frame {
    LAS unsigned char* lds;
    int tid, lane, wave, vcu, G, l;
    unsigned char* ws; float* out;
#define FIN(name, T, k) __device__ __forceinline__ const T* name() const { return (const T*)kin(k); }
    FIN(x, float, 0) FIN(pos, int, 1) FIN(g_mix, float, 2) FIN(w_in, float, 3) FIN(a_re, float, 4) FIN(a_im, float, 5) FIN(log_dt, float, 6) FIN(b_re, float, 7) FIN(b_im, float, 8)
    FIN(c_re, float, 9) FIN(c_im, float, 10) FIN(s5_d, float, 11) FIN(w_glu, float, 12) FIN(gla_wg, float, 13) FIN(gla_bg, float, 14) FIN(pool_w, float, 15) FIN(pool_scale, float, 16)
    FIN(w_branch, float, 17) FIN(w_out, float, 18) FIN(g_ffn, float, 19) FIN(w_up, float, 20) FIN(conv_w, float, 21) FIN(conv_b, float, 22) FIN(w_down, float, 23) FIN(g_final, float, 24)
#undef FIN
#define FWS(name, T, off) __device__ __forceinline__ T* name() const { return (T*)(ws + (off)); }
    FWS(rotc, float, WS_ROT) FWS(rots, float, WS_ROT + (size_t)M * 32 * 4) FWS(abar, float, WS_S5T + S5T_ABAR) FWS(apow, float, WS_S5T + S5T_APOW) FWS(bbar, float, WS_S5T + S5T_BBAR) FWS(cmt, bf16_t, WS_S5T + S5T_CMT) FWS(bbt, bf16_t, WS_S5T + S5T_BBT)
    FWS(wglu_t, bf16_t, WS_WGLU) FWS(poolw_t, bf16_t, WS_POOLW) FWS(win_t, bf16_t, WS_WIN) FWS(wbr_t, bf16_t, WS_WBR) FWS(wout_t, bf16_t, WS_WOUT) FWS(wup_t, bf16_t, WS_WUP) FWS(wdn_t, bf16_t, WS_WDN)
    FWS(HN8, unsigned char, WS_HN8) FWS(W8, unsigned char, WS_W8) FWS(HN, bf16_t, WS_HN) FWS(Y, bf16_t, WS_Y) FWS(YBP, bf16_t, WS_YBP) FWS(PROJ, bf16_t, WS_PROJ) FWS(SPREV, bf16_t, WS_SPREV) FWS(ACT, bf16_t, WS_ACT)
    FWS(SS, float, WS_SS + (size_t)l * 32 * M * 4) FWS(RS, float, WS_RS + (size_t)l * M * 4) FWS(STATE, float, WS_STATE) FWS(DEC, float, WS_DEC) FWS(XEND, float, WS_XEND) FWS(UH, float, WS_UH)
#undef FWS
};

__device__ __forceinline__ float lane_read(float v, int src_lane) { return __builtin_bit_cast(float, __builtin_amdgcn_ds_bpermute(src_lane << 2, __builtin_bit_cast(int, v))); }
__device__ __forceinline__ float wave_sum(float v, int lane) {
#pragma unroll
    for (int o = 1; o < 64; o <<= 1) v += lane_read(v, lane ^ o);
    return v;
}

template <class SrcCol>
__device__ __forceinline__ void transpose_item(const float* W, int Nsrc, bf16_t* WT, int ldt, int kdst0, int k0, int n0, SrcCol srccol, LAS float* scr, int lane, const float* kscale = nullptr) {
    const int sc = srccol(n0 + (lane & 31));
    float wv[32];
#pragma unroll
    for (int i = 0; i < 32; ++i) { const int kk = 2 * i + (lane >> 5); wv[i] = sc >= 0 ? W[(size_t)(k0 + kk) * Nsrc + sc] : 0.f; }
#pragma unroll
    for (int i = 0; i < 32; ++i) { const int kk = 2 * i + (lane >> 5); scr[kk * 33 + (lane & 31)] = kscale ? wv[i] * kscale[k0 + kk] : wv[i]; }
    LDS_WAIT();
    const int c = lane & 7;
#pragma unroll
    for (int j = 0; j < 4; ++j) { const int n = (lane >> 3) + 8 * j; const LAS float* s = scr + (8 * c) * 33 + n;
        u32x4 o; o.x = pk2(s[0 * 33], s[1 * 33]); o.y = pk2(s[2 * 33], s[3 * 33]); o.z = pk2(s[4 * 33], s[5 * 33]); o.w = pk2(s[6 * 33], s[7 * 33]);
        *(u32x4*)(WT + (size_t)(n0 + n) * ldt + kdst0 + k0 + 8 * c) = o; }
    LDS_WAIT();
}
template <class SrcCol>
__device__ __forceinline__ void transpose_item_fp8(const float* W, int Nsrc, unsigned char* WT, int ldt, int k0, int n0src, int n0dst, SrcCol srccol, LAS float* scr, int lane, const float* kscale, float scale) {
    const int sc = srccol(n0src + (lane & 31));
    float wv[32];
#pragma unroll
    for (int i = 0; i < 32; ++i) { const int kk = 2 * i + (lane >> 5); wv[i] = sc >= 0 ? W[(size_t)(k0 + kk) * Nsrc + sc] : 0.f; }
#pragma unroll
    for (int i = 0; i < 32; ++i) { const int kk = 2 * i + (lane >> 5); scr[kk * 33 + (lane & 31)] = (kscale ? wv[i] * kscale[k0 + kk] : wv[i]) * scale; }
    LDS_WAIT();
    const int c = lane & 7;
#pragma unroll
    for (int j = 0; j < 4; ++j) { const int n = (lane >> 3) + 8 * j; const LAS float* s = scr + (8 * c) * 33 + n;
        u32x2 o; o.x = pk4_fp8(s[0 * 33], s[1 * 33], s[2 * 33], s[3 * 33]); o.y = pk4_fp8(s[4 * 33], s[5 * 33], s[6 * 33], s[7 * 33]);
        *(u32x2*)(WT + (size_t)(n0dst + n) * ldt + k0 + 8 * c) = o; }
    LDS_WAIT();
}
struct ColIdent { __device__ __forceinline__ int operator()(int n) const { return n; } };
struct ColWin { __device__ __forceinline__ int operator()(int n) const {
    if (n < 3584) return n; if (n < 4096) return n + 16; if (n < 4112) return n - 512; if (n < 4352) return -1;
    const int t = (n - 4352) >> 8, cl = (n - 4352) & 255; const int br = 2 * (cl >> 7) + ((cl >> 2) & 1), ch = 16 * ((cl >> 5) & 3) + 4 * ((cl >> 3) & 3) + (cl & 3);
    return 4112 + br * 2048 + 64 * t + ch; } };
struct ColWup { __device__ __forceinline__ int operator()(int n) const { const int blk = n >> 8, r = n & 255; return (r < 128) ? (blk * 128 + r) : (DFF + blk * 128 + (r - 128)); } };

__device__ __forceinline__ void rms_row_to_bf16(const float* xrow, const float* g, bf16_t* orow, int lane, unsigned char* orow8 = nullptr) {
    const f32x4* xr = (const f32x4*)xrow + lane; const f32x4* gr = (const f32x4*)g + lane;
    f32x4 v[8]; float s = 0.f;
#pragma unroll
    for (int j = 0; j < 8; ++j) { v[j] = xr[64 * j]; s += (v[j].x * v[j].x + v[j].y * v[j].y) + (v[j].z * v[j].z + v[j].w * v[j].w); }
    const float r = 1.0f / sqrtf(wave_sum(s, lane) * (1.f / D) + EPS);
    u32x2* o8 = (u32x2*)orow + lane;
#pragma unroll
    for (int j = 0; j < 8; ++j) { const f32x4 gg = gr[64 * j]; const float a = v[j].x * r * gg.x, b = v[j].y * r * gg.y, c = v[j].z * r * gg.z, d = v[j].w * r * gg.w; u32x2 w; w.x = pk2(a, b); w.y = pk2(c, d); o8[64 * j] = w;
        if (orow8) ((unsigned*)orow8)[lane + 64 * j] = pk4_fp8(a, b, c, d); }
}
__device__ __forceinline__ void rms_rows(Frame& F, const float* src, const float* g, bf16_t* dst, unsigned char* dst8 = nullptr) {
    const int gw = F.vcu * NWAVES + F.wave, NGW = F.G * NWAVES;
    for (int m = gw; m < M; m += NGW) rms_row_to_bf16(src + (size_t)m * D, g, dst + (size_t)m * D, F.lane, dst8 ? dst8 + (size_t)m * D : nullptr);
}
__device__ __forceinline__ void row_scale(Frame& F) {
    const int gt = F.vcu * (NWAVES * 64) + F.tid, NGT = F.G * NWAVES * 64;
    for (int m = gt; m < M; m += NGT) { float s = 0.f;
#pragma unroll
        for (int j = 0; j < 32; ++j) s += F.SS()[(size_t)j * M + m];
        F.RS()[m] = 1.0f / sqrtf(s * (1.f / D) + EPS); }
}
__device__ __forceinline__ void rms_rows16(Frame& F, const bf16_t* src, const float* g, bf16_t* dst, unsigned char* dst8) {
    const int gw = F.vcu * NWAVES + F.wave, NGW = F.G * NWAVES, lane = F.lane;
    for (int m = gw; m < M; m += NGW) {
        const u32x4* xr = (const u32x4*)(src + (size_t)m * D) + lane; float v[4][8]; float s = 0.f;
#pragma unroll
        for (int j = 0; j < 4; ++j) { unpack8(xr[64 * j], v[j]);
#pragma unroll
            for (int q = 0; q < 8; ++q) s += v[j][q] * v[j][q]; }
        const float r = 1.0f / sqrtf(wave_sum(s, lane) * (1.f / D) + EPS);
        u32x4* o16 = (u32x4*)(dst + (size_t)m * D) + lane; u32x2* o8 = (u32x2*)(dst8 + (size_t)m * D) + lane;
#pragma unroll
        for (int j = 0; j < 4; ++j) { const f32x4 g0 = *((const f32x4*)g + 2 * (lane + 64 * j)), g1 = *((const f32x4*)g + 2 * (lane + 64 * j) + 1); float y[8];
            y[0] = v[j][0] * r * g0.x; y[1] = v[j][1] * r * g0.y; y[2] = v[j][2] * r * g0.z; y[3] = v[j][3] * r * g0.w; y[4] = v[j][4] * r * g1.x; y[5] = v[j][5] * r * g1.y; y[6] = v[j][6] * r * g1.z; y[7] = v[j][7] * r * g1.w;
            o16[64 * j] = pack8(y); u32x2 w8; w8.x = pk4_fp8(y[0], y[1], y[2], y[3]); w8.y = pk4_fp8(y[4], y[5], y[6], y[7]); o8[64 * j] = w8; }
    }
}
__device__ __forceinline__ void rms_rows16_to_f32(Frame& F, const bf16_t* src, const float* g, float* out) {
    const int gw = F.vcu * NWAVES + F.wave, NGW = F.G * NWAVES, lane = F.lane;
    for (int m = gw; m < M; m += NGW) {
        const u32x4* xr = (const u32x4*)(src + (size_t)m * D) + lane; float v[4][8]; float s = 0.f;
#pragma unroll
        for (int j = 0; j < 4; ++j) { unpack8(xr[64 * j], v[j]);
#pragma unroll
            for (int q = 0; q < 8; ++q) s += v[j][q] * v[j][q]; }
        const float r = 1.0f / sqrtf(wave_sum(s, lane) * (1.f / D) + EPS);
        f32x4* o = (f32x4*)(out + (size_t)m * D);
#pragma unroll
        for (int j = 0; j < 4; ++j) { const f32x4 g0 = *((const f32x4*)g + 2 * (lane + 64 * j)), g1 = *((const f32x4*)g + 2 * (lane + 64 * j) + 1);
            o[2 * (lane + 64 * j)] = (f32x4){v[j][0] * r * g0.x, v[j][1] * r * g0.y, v[j][2] * r * g0.z, v[j][3] * r * g0.w};
            o[2 * (lane + 64 * j) + 1] = (f32x4){v[j][4] * r * g1.x, v[j][5] * r * g1.y, v[j][6] * r * g1.z, v[j][7] * r * g1.w}; }
    }
}
__device__ __forceinline__ void rms_rows_f32_inplace(Frame& F, float* buf, const float* g) {
    const int gw = F.vcu * NWAVES + F.wave, NGW = F.G * NWAVES;
    for (int m = gw; m < M; m += NGW) {
        f32x4* xr = (f32x4*)(buf + (size_t)m * D) + F.lane; const f32x4* gr = (const f32x4*)g + F.lane;
        f32x4 v[8]; float s = 0.f;
#pragma unroll
        for (int j = 0; j < 8; ++j) { v[j] = xr[64 * j]; s += (v[j].x * v[j].x + v[j].y * v[j].y) + (v[j].z * v[j].z + v[j].w * v[j].w); }
        const float r = 1.0f / sqrtf(wave_sum(s, F.lane) * (1.f / D) + EPS);
#pragma unroll
        for (int j = 0; j < 8; ++j) { const f32x4 gg = gr[64 * j]; xr[64 * j] = (f32x4){v[j].x * r * gg.x, v[j].y * r * gg.y, v[j].z * r * gg.z, v[j].w * r * gg.w}; }
    }
}

__device__ __forceinline__ void phase_prep(Frame& F, int l) {
    LAS float* scr = (LAS float*)(F.lds + F.wave * 16384);
    const int gw = F.vcu * NWAVES + F.wave, NGW = F.G * NWAVES;
    constexpr int I_IN = (D / 64) * (NIN / 32), I_UP = (D / 64) * (NUP / 32), I_DN = (DFF / 64) * (D / 32), I_BR = 4 * (BW / 64) * (D / 32), I_OUT = (D / 64) * (D / 32), I_GLU = (BW / 64) * (BW / 32), I_PL = 4 * (128 / 64) * (128 / 32);
    constexpr int NITEMS = I_IN + I_UP + I_DN + I_BR + I_OUT + I_GLU + I_PL;
    for (int it = gw; it < NITEMS; it += NGW) {
        int r = it;
        if (r < I_IN) { const int nb = NIN / 32, n0 = 32 * (r % nb);
            if (n0 < C_GATE) transpose_item(F.w_in() + (size_t)l * D * NIN_SRC, NIN_SRC, F.win_t(), D, 0, 64 * (r / nb), n0, ColWin(), scr, F.lane);
            else transpose_item_fp8(F.w_in() + (size_t)l * D * NIN_SRC, NIN_SRC, F.W8(), D, 64 * (r / nb), n0, n0 - C_GATE, ColWin(), scr, F.lane, nullptr, 64.0f);
            continue; } r -= I_IN;
        if (r < I_UP) { const int nb = NUP / 32; transpose_item(F.w_up() + (size_t)l * D * NUP, NUP, F.wup_t(), D, 0, 64 * (r / nb), 32 * (r % nb), ColWup(), scr, F.lane, F.g_ffn() + (size_t)l * D); continue; } r -= I_UP;
        if (r < I_DN) { const int nb = D / 32; transpose_item(F.w_down() + (size_t)l * DFF * D, D, F.wdn_t(), DFF, 0, 64 * (r / nb), 32 * (r % nb), ColIdent(), scr, F.lane); continue; } r -= I_DN;
        if (r < I_BR) { const int per = (BW / 64) * (D / 32), br = r / per, q = r % per, nb = D / 32;
            transpose_item(F.w_branch() + ((size_t)l * 4 + br) * BW * D, D, F.wbr_t(), D, br * BW, 64 * (q / nb), 32 * (q % nb), ColIdent(), scr, F.lane); continue; } r -= I_BR;
        if (r < I_OUT) { const int nb = D / 32; transpose_item(F.w_out() + (size_t)l * D * D, D, F.wout_t(), D, 0, 64 * (r / nb), 32 * (r % nb), ColIdent(), scr, F.lane); continue; } r -= I_OUT;
        if (r < I_GLU) { const int nb = BW / 32; transpose_item(F.w_glu() + (size_t)l * BW * BW, BW, F.wglu_t(), BW, 0, 64 * (r / nb), 32 * (r % nb), ColIdent(), scr, F.lane); continue; } r -= I_GLU;
        { const int grp = r / 8, q = r % 8; transpose_item(F.pool_w() + ((size_t)l * 4 + grp) * 128 * 128, 128, F.poolw_t() + (size_t)grp * 128 * 128, 128, 0, 64 * (q / 4), 32 * (q % 4), ColIdent(), scr, F.lane); }
    }
    const int gt = F.vcu * (NWAVES * 64) + F.tid, NGT = F.G * NWAVES * 64;
    for (int i = gt; i < 32 * 64; i += NGT) {
        const int g = i >> 6;
        const float are = F.a_re()[(size_t)l * 2048 + i], aim = F.a_im()[(size_t)l * 2048 + i], dt = expf(F.log_dt()[l * 32 + g]);
        const float mag = expf(are * dt), th = aim * dt;
        const float abr = mag * cosf(th), abi = mag * sinf(th);
        const float den = are * are + aim * aim, nr = abr - 1.0f, ni = abi;
        const float fre = (nr * are + ni * aim) / den, fim = (ni * are - nr * aim) / den;
        F.abar()[2 * i] = abr; F.abar()[2 * i + 1] = abi;
        float pr = abr, pi = abi;
#pragma unroll
        for (int q = 0; q < 6; ++q) { const float tr = pr * pr - pi * pi, ti = 2.f * pr * pi; pr = tr; pi = ti; }
        F.apow()[2 * i] = pr; F.apow()[2 * i + 1] = pi;
        const float* br = F.b_re() + ((size_t)l * 2048 + i) * 16; const float* bi = F.b_im() + ((size_t)l * 2048 + i) * 16;
#pragma unroll
        for (int c = 0; c < 16; ++c) { const float x = br[c], y = bi[c]; const float vr = fre * x - fim * y, vi = fre * y + fim * x; const int p = i & 63;
            F.bbt()[((size_t)g * 128 + p) * 16 + c] = (bf16_t)f2bf(vr); F.bbt()[((size_t)g * 128 + 64 + p) * 16 + c] = (bf16_t)f2bf(vi); }
    }
    for (int i = gt; i < 32 * 16 * 128; i += NGT) {
        const int k = i & 127, gc = i >> 7;
        const float v = (k < 64) ? F.c_re()[((size_t)l * 512 + gc) * 64 + k] : -F.c_im()[((size_t)l * 512 + gc) * 64 + (k - 64)];
        F.cmt()[i] = (bf16_t)f2bf(v);
    }
    if (l == 0) {
        for (int i = gt; i < M * 32; i += NGT) {
            const int row = i >> 5, j = i & 31;
            const float inv = exp2f(-(float)j * (13.287712379549449f / 32.0f));
            const float ang = (float)F.pos()[row] * inv;
            F.rotc()[i] = cosf(ang); F.rots()[i] = sinf(ang);
        }
    }
    if (l == 0) rms_rows(F, F.x(), F.g_mix(), F.HN(), F.HN8()); else rms_rows16(F, (const bf16_t*)F.out, F.g_mix() + (size_t)l * D, F.HN(), F.HN8());
}

__device__ __forceinline__ f32x4 mma_nt_lds(const LAS bf16_t* X, int px, const LAS bf16_t* Y, int py, int ksteps, f32x4 acc, int lane) {
    const LAS bf16_t* xp = X + (lane & 15) * px + 8 * (lane >> 4);
    const LAS bf16_t* yp = Y + (lane & 15) * py + 8 * (lane >> 4);
    for (int ks = 0; ks < ksteps; ++ks) {
        const bf16x8 a = *(const LAS bf16x8*)(xp + 32 * ks), b = *(const LAS bf16x8*)(yp + 32 * ks);
        acc = __builtin_amdgcn_mfma_f32_16x16x32_bf16(a, b, acc, 0, 0, 0);
    }
    return acc;
}

constexpr int LN_TOT = 16384, LN_QD = 18432, LN_KI = 27648, LN_PM = 36864, LN_VT = 46080, LN_OB = 64512, LN_WG = 98304, LN_END = 98304 + 4096 + 256;
constexpr int LP = 72;
struct LinRaw { u32x4 q0, q1, k0, k1, v0, v1, g0, g1, gr0, gr1; f32x4 c0, c1, s0, s1; bf16x8 sp0, sp1; };
template <bool OUT>
__device__ __forceinline__ void lin_issue(Frame& F, int unit, LinRaw& R) {
    const int n = unit & 63, h = (unit >> 6) & 3, b = (unit >> 8) & 7, mixer = unit >> 11;
    const size_t row0 = (size_t)b * SEQ + (size_t)n * CH; const int s = F.tid >> 3, c = F.tid & 7;
    const int cq = (mixer == 0 ? C_RQ : C_GQ) + h * 64, ck = (mixer == 0 ? C_RK : C_GK) + h * 64, cv = (mixer == 0 ? C_RV : C_GV) + h * 128, cg = (mixer == 0 ? C_RG : C_GG) + h * 128;
    const bf16_t* pr = F.PROJ() + (row0 + s) * NIN;
    R.k0 = *(const u32x4*)(pr + ck + 8 * c); R.k1 = *(const u32x4*)(pr + ck + 8 * (c ^ 4));
    if (OUT) { R.q0 = *(const u32x4*)(pr + cq + 8 * c); R.q1 = *(const u32x4*)(pr + cq + 8 * (c ^ 4)); }
    { const float* cp = F.rotc() + (row0 + s) * 32 + (c & 3) * 8; const float* sp = F.rots() + (row0 + s) * 32 + (c & 3) * 8;
      R.c0 = *(const f32x4*)cp; R.c1 = *(const f32x4*)(cp + 4); R.s0 = *(const f32x4*)sp; R.s1 = *(const f32x4*)(sp + 4); }
    R.gr0 = *(const u32x4*)(pr + C_GR); R.gr1 = *(const u32x4*)(pr + C_GR + 8);
    R.v0 = *(const u32x4*)(F.PROJ() + (row0 + (F.tid >> 4)) * NIN + cv + (F.tid & 15) * 8);
    R.v1 = *(const u32x4*)(F.PROJ() + (row0 + 32 + (F.tid >> 4)) * NIN + cv + (F.tid & 15) * 8);
    if (OUT) { R.g0 = *(const u32x4*)(pr + cg + 16 * c); R.g1 = *(const u32x4*)(pr + cg + 16 * c + 8);
        const bf16_t* sq = F.SPREV() + (size_t)unit * 8192 + (size_t)(16 * F.wave + (F.lane & 15)) * 64 + 8 * (F.lane >> 4);
        R.sp0 = *(const bf16x8*)sq; R.sp1 = *(const bf16x8*)(sq + 32); }
}
__device__ __forceinline__ void lin_rot(const u32x4 own_, const u32x4 oth_, const LinRaw& R, bool rot, bool hi, float scale, float (&v)[8]) {
    float own[8]; unpack8(own_, own);
    if (!rot) {
#pragma unroll
        for (int j = 0; j < 8; ++j) v[j] = own[j] * scale;
        return; }
    float oth[8]; unpack8(oth_, oth);
    const float cs[8] = {R.c0.x, R.c0.y, R.c0.z, R.c0.w, R.c1.x, R.c1.y, R.c1.z, R.c1.w}, sn[8] = {R.s0.x, R.s0.y, R.s0.z, R.s0.w, R.s1.x, R.s1.y, R.s1.z, R.s1.w};
#pragma unroll
    for (int j = 0; j < 8; ++j) { const float os = oth[j] * sn[j]; v[j] = (own[j] * cs[j] + (hi ? os : -os)) * scale; }
}
__device__ __forceinline__ void lin_decay(Frame& F, int mixer, int h, const LinRaw& R, float (&bcum)[8], float (&blast)[8]) {
    LAS float* TOT = (LAS float*)(F.lds + LN_TOT);
    const int s = F.tid >> 3, c = F.tid & 7, d0 = 8 * c;
    if (mixer == 0) {
        const float lg = __logf(1.0f - exp2f(-5.0f - (float)h));
#pragma unroll
        for (int j = 0; j < 8; ++j) { bcum[j] = (float)(s + 1) * lg; blast[j] = 64.0f * lg; }
        wg_sync();
        return;
    }
    const LAS float* WG = (const LAS float*)(F.lds + LN_WG);
    float grf[16]; { float a[8], b2[8]; unpack8(R.gr0, a); unpack8(R.gr1, b2);
#pragma unroll
        for (int j = 0; j < 8; ++j) { grf[j] = a[j]; grf[8 + j] = b2[j]; } }
    float x[8]; { const f32x4 b0 = *(const LAS f32x4*)(WG + 1024 + d0), b1 = *(const LAS f32x4*)(WG + 1024 + d0 + 4); x[0] = b0.x; x[1] = b0.y; x[2] = b0.z; x[3] = b0.w; x[4] = b1.x; x[5] = b1.y; x[6] = b1.z; x[7] = b1.w; }
#pragma unroll
    for (int r = 0; r < 16; ++r) { const f32x4 w0 = *(const LAS f32x4*)(WG + r * 64 + d0), w1 = *(const LAS f32x4*)(WG + r * 64 + d0 + 4);
        x[0] += grf[r] * w0.x; x[1] += grf[r] * w0.y; x[2] += grf[r] * w0.z; x[3] += grf[r] * w0.w; x[4] += grf[r] * w1.x; x[5] += grf[r] * w1.y; x[6] += grf[r] * w1.z; x[7] += grf[r] * w1.w; }
#pragma unroll
    for (int j = 0; j < 8; ++j) x[j] = logsigmoidf_(x[j]) * (1.0f / 16.0f);
#pragma unroll
    for (int st = 8; st <= 32; st <<= 1) {
#pragma unroll
        for (int j = 0; j < 8; ++j) { const float t = lane_read(x[j], F.lane - st); if (F.lane >= st) x[j] += t; } }
    if ((F.lane >> 3) == 7) { *(LAS f32x4*)(TOT + F.wave * 64 + d0) = (f32x4){x[0], x[1], x[2], x[3]}; *(LAS f32x4*)(TOT + F.wave * 64 + d0 + 4) = (f32x4){x[4], x[5], x[6], x[7]}; }
    wg_sync();
    float off[8], tot[8];
#pragma unroll
    for (int j = 0; j < 8; ++j) { off[j] = 0.f; tot[j] = 0.f; }
#pragma unroll
    for (int w = 0; w < 8; ++w) { const f32x4 t0 = *(const LAS f32x4*)(TOT + w * 64 + d0), t1 = *(const LAS f32x4*)(TOT + w * 64 + d0 + 4); const float tv[8] = {t0.x, t0.y, t0.z, t0.w, t1.x, t1.y, t1.z, t1.w};
#pragma unroll
        for (int j = 0; j < 8; ++j) { tot[j] += tv[j]; off[j] += (w < F.wave) ? tv[j] : 0.f; } }
#pragma unroll
    for (int j = 0; j < 8; ++j) { bcum[j] = x[j] + off[j]; blast[j] = tot[j]; }
}
__device__ __forceinline__ void lin_store_vt(Frame& F, const LinRaw& R) {
    LAS bf16_t* VT = (LAS bf16_t*)(F.lds + LN_VT); const int e0 = (F.tid & 15) * 8;
#pragma unroll
    for (int i = 0; i < 2; ++i) { const int s = 32 * i + (F.tid >> 4); const u32x4 w = i == 0 ? R.v0 : R.v1;
        VT[(e0 + 0) * LP + s] = (bf16_t)(w.x & 0xffffu); VT[(e0 + 1) * LP + s] = (bf16_t)(w.x >> 16); VT[(e0 + 2) * LP + s] = (bf16_t)(w.y & 0xffffu); VT[(e0 + 3) * LP + s] = (bf16_t)(w.y >> 16);
        VT[(e0 + 4) * LP + s] = (bf16_t)(w.z & 0xffffu); VT[(e0 + 5) * LP + s] = (bf16_t)(w.z >> 16); VT[(e0 + 6) * LP + s] = (bf16_t)(w.w & 0xffffu); VT[(e0 + 7) * LP + s] = (bf16_t)(w.w >> 16); }
}
__device__ __forceinline__ void lin_state_compute(Frame& F, int unit, const LinRaw& R) {
    const int h = (unit >> 6) & 3, mixer = unit >> 11; const int s = F.tid >> 3, c = F.tid & 7, d0 = 8 * c;
    LAS bf16_t* KDT = (LAS bf16_t*)(F.lds + LN_KI); LAS bf16_t* VT = (LAS bf16_t*)(F.lds + LN_VT);
    float k[8], bcum[8], blast[8];
    lin_rot(R.k0, R.k1, R, mixer == 0, c >= 4, mixer == 0 ? 0.125f : 1.0f, k);
    lin_decay(F, mixer, h, R, bcum, blast);
#pragma unroll
    for (int j = 0; j < 8; ++j) KDT[(d0 + j) * LP + s] = (bf16_t)f2bf(k[j] * __expf(blast[j] - bcum[j]));
    lin_store_vt(F, R);
    if (s == 0) { float* dc = F.DEC() + (size_t)unit * 64 + d0;
        *(f32x4*)dc = (f32x4){__expf(blast[0]), __expf(blast[1]), __expf(blast[2]), __expf(blast[3])}; *(f32x4*)(dc + 4) = (f32x4){__expf(blast[4]), __expf(blast[5]), __expf(blast[6]), __expf(blast[7])}; }
    wg_sync();
    { const int w = F.wave, lane = F.lane; float* st = F.STATE() + (size_t)unit * 8192;
#pragma unroll
      for (int dt = 0; dt < 4; ++dt) { f32x4 acc = (f32x4){0.f, 0.f, 0.f, 0.f}; acc = mma_nt_lds(VT + 16 * w * LP, LP, KDT + 16 * dt * LP, LP, 2, acc, lane);
#pragma unroll
          for (int i = 0; i < 4; ++i) st[(16 * w + 4 * (lane >> 4) + i) * 64 + 16 * dt + (lane & 15)] = acc[i]; } }
}
__device__ __forceinline__ void lin_out_compute(Frame& F, int unit, const LinRaw& R) {
    const int n = unit & 63, h = (unit >> 6) & 3, b = (unit >> 8) & 7, mixer = unit >> 11;
    const size_t row0 = (size_t)b * SEQ + (size_t)n * CH; const int s = F.tid >> 3, c = F.tid & 7, d0 = 8 * c;
    const int ycol = (mixer == 0 ? 0 : 1024) + h * 128;
    LAS bf16_t* QD = (LAS bf16_t*)(F.lds + LN_QD); LAS bf16_t* KI = (LAS bf16_t*)(F.lds + LN_KI); LAS bf16_t* PM = (LAS bf16_t*)(F.lds + LN_PM);
    LAS bf16_t* VT = (LAS bf16_t*)(F.lds + LN_VT); LAS float* OB = (LAS float*)(F.lds + LN_OB);
    float q[8], k[8], bcum[8], blast[8];
    lin_rot(R.q0, R.q1, R, mixer == 0, c >= 4, mixer == 0 ? 1.0f : 0.125f, q);
    lin_rot(R.k0, R.k1, R, mixer == 0, c >= 4, mixer == 0 ? 0.125f : 1.0f, k);
    lin_decay(F, mixer, h, R, bcum, blast);
    { float qd[8], ki[8];
#pragma unroll
      for (int j = 0; j < 8; ++j) { qd[j] = q[j] * __expf(bcum[j]); ki[j] = k[j] * __expf(-bcum[j]); }
      *(LAS u32x4*)(QD + s * LP + d0) = pack8(qd); *(LAS u32x4*)(KI + s * LP + d0) = pack8(ki); }
    lin_store_vt(F, R);
    wg_sync();
    { const int lane = F.lane;
#pragma unroll
      for (int j = 0; j < 2; ++j) { const int tile = 2 * F.wave + j, tt = tile >> 2, st = tile & 3;
          f32x4 acc = (f32x4){0.f, 0.f, 0.f, 0.f};
          if (st <= tt) acc = mma_nt_lds(QD + 16 * tt * LP, LP, KI + 16 * st * LP, LP, 2, acc, lane);
#pragma unroll
          for (int i = 0; i < 4; ++i) { const int t = 16 * tt + 4 * (lane >> 4) + i, s2 = 16 * st + (lane & 15); const float p = (st <= tt && s2 <= t) ? acc[i] : 0.f; PM[t * LP + s2] = (bf16_t)f2bf(p); } } }
    wg_sync();
    { const int w = F.wave, lane = F.lane;
#pragma unroll
      for (int tt = 0; tt < 4; ++tt) { f32x4 acc = (f32x4){0.f, 0.f, 0.f, 0.f};
          acc = mma_nt_lds(PM + 16 * tt * LP, LP, VT + 16 * w * LP, LP, 2, acc, lane);
          const LAS bf16_t* xp = QD + (16 * tt + (lane & 15)) * LP + 8 * (lane >> 4);
          acc = __builtin_amdgcn_mfma_f32_16x16x32_bf16(*(const LAS bf16x8*)xp, R.sp0, acc, 0, 0, 0);
          acc = __builtin_amdgcn_mfma_f32_16x16x32_bf16(*(const LAS bf16x8*)(xp + 32), R.sp1, acc, 0, 0, 0);
#pragma unroll
          for (int i = 0; i < 4; ++i) OB[(16 * tt + 4 * (lane >> 4) + i) * 132 + 16 * w + (lane & 15)] = acc[i]; } }
    wg_sync();
    { const int t = s, part = c; float o[16];
#pragma unroll
      for (int j = 0; j < 4; ++j) { const f32x4 v = *(const LAS f32x4*)(OB + t * 132 + 16 * part + 4 * j); o[4 * j] = v.x; o[4 * j + 1] = v.y; o[4 * j + 2] = v.z; o[4 * j + 3] = v.w; }
      float sm = 0.f;
#pragma unroll
      for (int j = 0; j < 16; ++j) sm += o[j];
      sm += lane_read(sm, F.lane ^ 1); sm += lane_read(sm, F.lane ^ 2); sm += lane_read(sm, F.lane ^ 4);
      const float mu = sm * (1.0f / 128.0f); float qv = 0.f;
#pragma unroll
      for (int j = 0; j < 16; ++j) { const float dlt = o[j] - mu; qv += dlt * dlt; }
      qv += lane_read(qv, F.lane ^ 1); qv += lane_read(qv, F.lane ^ 2); qv += lane_read(qv, F.lane ^ 4);
      const float r = 1.0f / sqrtf(qv * (1.0f / 128.0f) + EPS);
      float g0[8], g1[8]; unpack8(R.g0, g0); unpack8(R.g1, g1);
      float y0[8], y1[8];
#pragma unroll
      for (int j = 0; j < 8; ++j) { y0[j] = (o[j] - mu) * r * siluf_(g0[j]); y1[j] = (o[8 + j] - mu) * r * siluf_(g1[j]); }
      bf16_t* yp = F.Y() + (row0 + t) * D + ycol + 16 * part; *(u32x4*)yp = pack8(y0); *(u32x4*)(yp + 8) = pack8(y1); }
}
template <bool OUT>
__device__ __forceinline__ void lin_phase(Frame& F, int l) {
    { const int h = (F.vcu >> 6) & 3; LAS float* WG = (LAS float*)(F.lds + LN_WG);
      for (int i = F.tid; i < 16 * 64 + 64; i += NWAVES * 64) WG[i] = (i < 1024) ? F.gla_wg()[(size_t)l * 16 * 256 + (i >> 6) * 256 + h * 64 + (i & 63)] : F.gla_bg()[l * 256 + h * 64 + (i - 1024)];
      wg_sync(); }
    LinRaw A, B;
    lin_issue<OUT>(F, F.vcu, A);
    for (int u = F.vcu; u < 4096; u += 2 * F.G) {
        lin_issue<OUT>(F, u + F.G, B);
        if (OUT) lin_out_compute(F, u, A); else lin_state_compute(F, u, A);
        if (u + 2 * F.G < 4096) lin_issue<OUT>(F, u + 2 * F.G, A);
        if (OUT) lin_out_compute(F, u + F.G, B); else lin_state_compute(F, u + F.G, B);
    }
    wg_sync();
}
__device__ __forceinline__ void lin_scan(Frame& F) {
    const int gt = F.vcu * (NWAVES * 64) + F.tid, NGT = F.G * NWAVES * 64;
    for (int i = gt; i < 64 * 8192; i += NGT) {
        const int seq = i >> 13, idx = i & 8191, d = idx & 63;
        const float* st = F.STATE() + (size_t)seq * NCH * 8192 + idx; const float* dc = F.DEC() + (size_t)seq * NCH * 64 + d; bf16_t* sp = F.SPREV() + (size_t)seq * NCH * 8192 + idx;
        float carry = 0.f; asm volatile("" : "+v"(carry));
#pragma unroll
        for (int h = 0; h < 2; ++h) {
            float v[32], c[32];
#pragma unroll
            for (int n = 0; n < 32; ++n) { v[n] = st[(size_t)(32 * h + n) * 8192]; c[n] = dc[(size_t)(32 * h + n) * 64]; }
#pragma unroll
            for (int n = 0; n < 32; ++n) { sp[(size_t)(32 * h + n) * 8192] = (bf16_t)f2bf(carry); carry = c[n] * carry + v[n]; asm volatile("" : "+v"(carry)); }
        }
    }
}
constexpr int S5_WL = 16384, S5_BU = 2048, S5_X = 2048 + 8320;
template <bool OUT>
__device__ __forceinline__ void s5_pass(Frame& F, int l) {
    LAS bf16_t* UT = (LAS bf16_t*)(F.lds + F.wave * S5_WL); LAS float* BU = (LAS float*)(F.lds + F.wave * S5_WL + S5_BU); LAS bf16_t* X = (LAS bf16_t*)(F.lds + F.wave * S5_WL + S5_X);
    const int gw = F.vcu * NWAVES + F.wave, NGW = F.G * NWAVES, lane = F.lane, lr = lane & 15, lq = lane >> 4;
    u32x4 ua, uc;
    { const int g = gw & 31, n = (gw >> 5) & 63, b = gw >> 11; const bf16_t* up = F.PROJ() + ((size_t)b * SEQ + (size_t)n * CH + lane) * NIN + C_SU + g * 16; ua = *(const u32x4*)up; uc = *(const u32x4*)(up + 8); }
    for (int unit = gw; unit < BATCH * NCH * 32; unit += NGW) {
        const int g = unit & 31, n = (unit >> 5) & 63, b = unit >> 11; const size_t row0 = (size_t)b * SEQ + (size_t)n * CH;
        *(LAS u32x4*)(UT + lane * 16) = ua; *(LAS u32x4*)(UT + lane * 16 + 8) = uc;
        if (unit + NGW < BATCH * NCH * 32) { const int un = unit + NGW, g2 = un & 31, n2 = (un >> 5) & 63, b2 = un >> 11;
            const bf16_t* up = F.PROJ() + ((size_t)b2 * SEQ + (size_t)n2 * CH + lane) * NIN + C_SU + g2 * 16; ua = *(const u32x4*)up; uc = *(const u32x4*)(up + 8); }
        const int gp = g * 64 + lane; const float ar = F.abar()[2 * gp], ai = F.abar()[2 * gp + 1];
        bf16x8 bfr[8];
#pragma unroll
        for (int q = 0; q < 8; ++q) { bfr[q] = (bf16x8){0, 0, 0, 0, 0, 0, 0, 0}; if (lq < 2) bfr[q] = *(const bf16x8*)(F.bbt() + ((size_t)g * 128 + 16 * q + lr) * 16 + 8 * lq); }
        float xr = 0.f, xi = 0.f;
        bf16x8 cf[4]; float dsk = 0.f;
        if (OUT) { const f32x2 x0 = *(const f32x2*)(F.XEND() + ((((size_t)(b * 32 + g)) * NCH + n) * 64 + lane) * 2); xr = x0.x; xi = x0.y;
#pragma unroll
            for (int ks = 0; ks < 4; ++ks) cf[ks] = *(const bf16x8*)(F.cmt() + ((size_t)(g * 16 + lr)) * 128 + 32 * ks + 8 * lq);
            dsk = F.s5_d()[(size_t)l * BW + g * 16 + lr]; }
        LDS_WAIT();
        for (int sb = 0; sb < 4; ++sb) {
            bf16x8 af = (bf16x8){0, 0, 0, 0, 0, 0, 0, 0}; if (lq < 2) af = *(const LAS bf16x8*)(UT + (16 * sb + lr) * 16 + 8 * lq);
#pragma unroll
            for (int q = 0; q < 8; ++q) { f32x4 acc = (f32x4){0.f, 0.f, 0.f, 0.f}; acc = __builtin_amdgcn_mfma_f32_16x16x32_bf16(af, bfr[q], acc, 0, 0, 0);
#pragma unroll
                for (int i = 0; i < 4; ++i) BU[(4 * lq + i) * 130 + 16 * q + lr] = acc[i]; }
            LDS_WAIT();
            float br[16], bi[16];
#pragma unroll
            for (int tt = 0; tt < 16; ++tt) { br[tt] = BU[tt * 130 + lane]; bi[tt] = BU[tt * 130 + 64 + lane]; }
#pragma unroll
            for (int tt = 0; tt < 16; ++tt) { const float nr = ar * xr - ai * xi + br[tt], ni = ar * xi + ai * xr + bi[tt]; xr = nr; xi = ni; asm volatile("" : "+v"(xr), "+v"(xi));
                if (OUT) { X[tt * 136 + lane] = (bf16_t)f2bf(xr); X[tt * 136 + 64 + lane] = (bf16_t)f2bf(xi); } }
            if (OUT) {
                LDS_WAIT();
                f32x4 acc = (f32x4){0.f, 0.f, 0.f, 0.f}; const LAS bf16_t* xp = X + lr * 136 + 8 * lq;
#pragma unroll
                for (int ks = 0; ks < 4; ++ks) acc = __builtin_amdgcn_mfma_f32_16x16x32_bf16(*(const LAS bf16x8*)(xp + 32 * ks), cf[ks], acc, 0, 0, 0);
#pragma unroll
                for (int i = 0; i < 4; ++i) { const int tl = 16 * sb + 4 * lq + i; const float u = bflo((unsigned)UT[tl * 16 + lr]); const float y = gelu_tanh(acc[i] + dsk * u);
                    F.YBP()[(row0 + tl) * BW + g * 16 + lr] = (bf16_t)f2bf(y); }
            }
            LDS_WAIT();
        }
        if (!OUT) *(f32x2*)(F.XEND() + ((((size_t)(b * 32 + g)) * NCH + n) * 64 + lane) * 2) = (f32x2){xr, xi};
    }
}
__device__ __forceinline__ void s5_scan(Frame& F) {
    const int gt = F.vcu * (NWAVES * 64) + F.tid, NGT = F.G * NWAVES * 64;
    for (int i = gt; i < BATCH * 32 * 64; i += NGT) {
        const int p = i & 63, bg = i >> 6, g = bg & 31; const float pr = F.apow()[2 * (g * 64 + p)], pi = F.apow()[2 * (g * 64 + p) + 1];
        f32x2* xp = (f32x2*)(F.XEND() + (((size_t)bg * NCH) * 64 + p) * 2);
        float cr = 0.f, ci = 0.f; asm volatile("" : "+v"(cr), "+v"(ci));
#pragma unroll
        for (int h = 0; h < 2; ++h) {
            f32x2 v[32];
#pragma unroll
            for (int n = 0; n < 32; ++n) v[n] = xp[(size_t)(32 * h + n) * 64];
#pragma unroll
            for (int n = 0; n < 32; ++n) { xp[(size_t)(32 * h + n) * 64] = (f32x2){cr, ci};
                const float nr = pr * cr - pi * ci + v[n].x, ni = pr * ci + pi * cr + v[n].y; cr = nr; ci = ni; asm volatile("" : "+v"(cr), "+v"(ci)); }
        }
    }
}

__device__ __forceinline__ void pool_phase(Frame& F, int l) {
    const int gw = F.vcu * NWAVES + F.wave, NGW = F.G * NWAVES, lane = F.lane, lr = lane & 15, lq = lane >> 4;
    for (int unit = gw; unit < BATCH * (SEQ / 16) * 4; unit += NGW) {
        const int g = unit & 3, tile = (unit >> 2) & 255, b = unit >> 10; const int win = 2 << g, tpos = 16 * tile + lr; const size_t row = (size_t)b * SEQ + tpos;
        const bf16_t* pp = F.PROJ() + row * NIN + C_PU + g * 128 + 8 * lq;
        float s[4][8];
#pragma unroll
        for (int ks = 0; ks < 4; ++ks)
#pragma unroll
            for (int j = 0; j < 8; ++j) s[ks][j] = 0.f;
        for (int jj = 1; jj < win; ++jj) { if (tpos - jj >= 0) {
#pragma unroll
            for (int ks = 0; ks < 4; ++ks) { float a[8]; unpack8(*(const u32x4*)(pp - (size_t)jj * NIN + 32 * ks), a);
#pragma unroll
                for (int j = 0; j < 8; ++j) s[ks][j] += a[j]; } } }
        const float inv = 1.0f / (float)min(tpos + 1, win);
        bf16x8 mf[4];
#pragma unroll
        for (int ks = 0; ks < 4; ++ks) { float a[8], m[8]; unpack8(*(const u32x4*)(pp + 32 * ks), a);
#pragma unroll
            for (int j = 0; j < 8; ++j) m[j] = (s[ks][j] + a[j]) * inv - a[j];
            const u32x4 w = pack8(m); mf[ks] = __builtin_bit_cast(bf16x8, w); }
        const bf16_t* pw = F.poolw_t() + (size_t)g * 128 * 128 + (size_t)lr * 128 + 8 * lq;
#pragma unroll
        for (int q = 0; q < 8; ++q) { f32x4 acc = (f32x4){0.f, 0.f, 0.f, 0.f};
#pragma unroll
            for (int ks = 0; ks < 4; ++ks) acc = __builtin_amdgcn_mfma_f32_16x16x32_bf16(*(const bf16x8*)(pw + (size_t)(16 * q) * 128 + 32 * ks), mf[ks], acc, 0, 0, 0);
            const int dcol = g * 128 + 16 * q + 4 * lq; const f32x4 sc = *(const f32x4*)(F.pool_scale() + (size_t)l * BW + dcol);
            u32x2 w; w.x = pk2(acc[0] * sc.x, acc[1] * sc.y); w.y = pk2(acc[2] * sc.z, acc[3] * sc.w);
            *(u32x2*)(F.Y() + row * D + 1536 + dcol) = w; }
    }
}

__device__ __forceinline__ void conv_fix_phase(Frame& F, int l) {
    const float* cw = F.conv_w() + (size_t)l * 3 * NUP; const float* cb = F.conv_b() + (size_t)l * NUP; const float* UH = F.UH();
    const int gt = F.vcu * (NWAVES * 64) + F.tid, NGT = F.G * NWAVES * 64;
    constexpr int JG = DFF / 4;
    for (int task = gt; task < (M / 256) * 2 * JG; task += NGT) {
        const int jg = task % JG, q = (task / JG) & 1, pm = task / (2 * JG);
        if ((pm & 15) == 0) continue;
        const int j0 = jg * 4, ucol = 256 * (j0 >> 7) + (j0 & 127);
        const float* u0p = UH + ((size_t)pm * 4 + q) * NUP + ucol;
        const float* u1p = (q == 1) ? UH + ((size_t)pm * 4 + 0) * NUP + ucol : UH + ((size_t)(pm - 1) * 4 + 3) * NUP + ucol;
        const float* u2p = (q == 1) ? UH + ((size_t)(pm - 1) * 4 + 3) * NUP + ucol : UH + ((size_t)(pm - 1) * 4 + 2) * NUP + ucol;
        const f32x4 a0 = *(const f32x4*)u0p, a1 = *(const f32x4*)u1p, a2 = *(const f32x4*)u2p, v0 = *(const f32x4*)(u0p + 128), v1 = *(const f32x4*)(u1p + 128), v2 = *(const f32x4*)(u2p + 128);
        const f32x4 wa0 = *(const f32x4*)(cw + j0), wa1 = *(const f32x4*)(cw + NUP + j0), wa2 = *(const f32x4*)(cw + 2 * NUP + j0), ba = *(const f32x4*)(cb + j0);
        const f32x4 wv0 = *(const f32x4*)(cw + DFF + j0), wv1 = *(const f32x4*)(cw + NUP + DFF + j0), wv2 = *(const f32x4*)(cw + 2 * NUP + DFF + j0), bv = *(const f32x4*)(cb + DFF + j0);
        float o[4];
#pragma unroll
        for (int i = 0; i < 4; ++i) { const float ca = ba[i] + wa0[i] * a2[i] + wa1[i] * a1[i] + wa2[i] * a0[i], cv = bv[i] + wv0[i] * v2[i] + wv1[i] * v1[i] + wv2[i] * v0[i]; o[i] = siluf_(ca) * cv; }
        u32x2 w; w.x = pk2(o[0], o[1]); w.y = pk2(o[2], o[3]);
        *(u32x2*)(F.ACT() + ((size_t)pm * 256 + q) * DFF + j0) = w;
    }
}

constexpr int NPH = 13;
struct Args { const void* in[25]; float* out; unsigned char* ws; int l_lo, l_hi, ph_lo, ph_hi, single, pad; };
__global__ void __launch_bounds__(NWAVES * 64, 2) hybrid_fwd(Args args) {
    extern __shared__ __attribute__((aligned(16))) unsigned char lds[];
    Frame F;
    F.lds = (LAS unsigned char*)lds;
    F.tid = threadIdx.x; F.lane = F.tid & 63; F.wave = __builtin_amdgcn_readfirstlane(F.tid >> 6);
    const int wave0 = F.wave;
    F.G = gridDim.x; { const int bx = blockIdx.x; F.vcu = (F.G % 8 == 0) ? (bx % 8) * (F.G / 8) + bx / 8 : bx; }
    unsigned char* ws = args.ws; F.ws = ws; F.out = args.out; F.l = 0;

    volatile LAS unsigned* MISC = (volatile LAS unsigned*)(F.lds + MISC_OFF);
    if (F.tid < 64) MISC[F.tid] = 0u;
    wg_sync();
    unsigned* ctl = (unsigned*)(ws + WS_CTL);
    XcdBarrier bar; bar.bar = ctl + CW_BAR; bar.x = 0; bar.st = nullptr;
    if (args.single) bar = xcd_barrier_post(ctl + CW_BAR, MISC);
#define GRID_BAR() do { if (args.single) xcd_barrier(bar); } while (0)
    const int lo = args.ph_lo, hi = args.ph_hi;
#define IN(k) (lo <= (k) && (k) < hi)
#define PH_BEGIN() do { unsigned z_ = 0u; asm volatile("" : "+v"(z_)); const int ln_ = (int)__builtin_amdgcn_mbcnt_hi(~0u, __builtin_amdgcn_mbcnt_lo(~0u, z_)); F.lane = ln_; F.tid = wave0 * 64 + ln_; F.wave = wave0; unsigned long long w_ = (unsigned long long)args.ws, o_ = (unsigned long long)args.out; asm volatile("" : "+s"(w_), "+s"(o_)); F.ws = (unsigned char*)(GAS unsigned char*)w_; F.out = (float*)(GAS float*)o_; } while (0)

    for (int l = args.l_lo; l < args.l_hi; ++l) {
        F.l = l;
        if (IN(0)) { PH_BEGIN(); phase_prep(F, l); GRID_BAR(); }
        if (IN(1)) { PH_BEGIN();
            { pg8::Gemm g{(const bf16_t*)F.HN8(), (const bf16_t*)F.W8(), M, 4 * D, D / 2, D / 2, D / 2}; pg8::StaticOrder S; S.init(M, 4 * D, F.G, (int)blockIdx.x); pg8::EpiProj E{F.PROJ(), NIN, 0, C_GATE, 1.0f / 64.0f};
              pg8::gemm_phase<pg8::EpiProj, true>(F.lds, g, S, E, F.tid); }
            PH_BEGIN();
            { pg8::Gemm g{F.HN(), F.win_t(), M, C_GATE, D, D, D}; pg8::StaticOrder S; S.init(M, C_GATE, F.G, (int)blockIdx.x); pg8::EpiProj E{F.PROJ(), NIN, 1 << 20, C_GATE, 1.0f};
              pg8::gemm_phase(F.lds, g, S, E, F.tid); }
            GRID_BAR(); }
        if (IN(2)) { PH_BEGIN(); lin_phase<false>(F, l); PH_BEGIN();
            s5_pass<false>(F, l); pool_phase(F, l); wg_sync();
            GRID_BAR(); }
        if (IN(3)) { PH_BEGIN(); lin_scan(F); s5_scan(F); GRID_BAR(); }
        if (IN(4)) { PH_BEGIN(); lin_phase<true>(F, l); PH_BEGIN();
            s5_pass<true>(F, l); wg_sync();
            GRID_BAR(); }
        if (IN(5)) { PH_BEGIN(); pg8::Gemm g{F.YBP(), F.wglu_t(), M, BW, BW, BW, BW}; pg8::StaticOrder S; S.init(M, BW, F.G, (int)blockIdx.x); pg8::EpiGlu E{F.YBP(), BW, F.Y() + BW, D};
            pg8::gemm_phase(F.lds, g, S, E, F.tid); GRID_BAR(); }
        if (IN(6)) { PH_BEGIN(); pg8::Gemm g{F.Y(), F.wbr_t(), M, D, D, D, D}; pg8::StaticOrder S; S.init(M, D, F.G, (int)blockIdx.x); pg8::EpiMerge E{F.PROJ() + C_GATE, NIN, F.HN(), D};
            pg8::gemm_phase(F.lds, g, S, E, F.tid); GRID_BAR(); }
        if (IN(7)) { PH_BEGIN(); pg8::Gemm g{F.HN(), F.wout_t(), M, D, D, D, D}; pg8::StaticOrder S; S.init(M, D, F.G, (int)blockIdx.x); pg8::EpiResid E{l == 0 ? (const void*)F.x() : (const void*)F.out, l == 0 ? 1 : 0, F.Y(), D, F.SS()};
            pg8::gemm_phase(F.lds, g, S, E, F.tid); GRID_BAR(); }
        if (IN(8)) { PH_BEGIN(); row_scale(F); GRID_BAR(); }
        if (IN(9)) { PH_BEGIN(); pg8::Gemm g{F.Y(), F.wup_t(), M, NUP, D, D, D}; pg8::StaticOrder S; S.init(M, NUP, F.G, (int)blockIdx.x); pg8::EpiConv E{F.conv_w() + (size_t)l * 3 * NUP, F.conv_b() + (size_t)l * NUP, F.ACT(), F.UH(), (LAS float*)(F.lds + pg8::STAGE_BYTES), F.RS()};
            pg8::gemm_phase(F.lds, g, S, E, F.tid); GRID_BAR(); }
        if (IN(10)) { PH_BEGIN(); conv_fix_phase(F, l); GRID_BAR(); }
        if (IN(11)) { PH_BEGIN(); pg8::Gemm g{F.ACT(), F.wdn_t(), M, D, DFF, DFF, DFF}; pg8::StaticOrder S; S.init(M, D, F.G, (int)blockIdx.x); pg8::EpiResid E{(const void*)F.Y(), 0, l == DEPTH - 1 ? F.HN() : (bf16_t*)F.out, D, nullptr};
            pg8::gemm_phase(F.lds, g, S, E, F.tid); GRID_BAR(); }
        if (IN(12) && l == DEPTH - 1) { PH_BEGIN(); rms_rows16_to_f32(F, F.HN(), F.g_final(), F.out); }
    }
#undef IN
#undef PH_BEGIN
#undef GRID_BAR
}

#pragma clang attribute pop
extern "C" void kernel_launch(void* const* d_in, const int* in_sizes, int n_in, void* d_out, int out_size, void* d_ws, size_t ws_size, hipStream_t stream) {
    static int grid = 0;
    if (grid == 0) {
        if (n_in != 25 || in_sizes[0] != M * D || out_size != M * D || ws_size < WS_END) { fprintf(stderr, "kernel_launch: shape/workspace mismatch (n_in %d, in0 %d, out %d, ws %zu, need %zu); nothing launched\n", n_in, n_in > 0 ? in_sizes[0] : -1, out_size, ws_size, (size_t)WS_END); grid = -1; return; }
        int dev = 0, cus = 0, per_cu = 0;
        if (hipGetDevice(&dev) != hipSuccess || hipDeviceGetAttribute(&cus, hipDeviceAttributeMultiprocessorCount, dev) != hipSuccess) { grid = -1; return; }
        if (hipFuncSetAttribute((const void*)hybrid_fwd, hipFuncAttributeMaxDynamicSharedMemorySize, LDS_BYTES) != hipSuccess) { fprintf(stderr, "kernel_launch: hipFuncSetAttribute failed\n"); grid = -1; return; }
        if (hipOccupancyMaxActiveBlocksPerMultiprocessor(&per_cu, (const void*)hybrid_fwd, NWAVES * 64, LDS_BYTES) != hipSuccess || per_cu < 1) { fprintf(stderr, "kernel_launch: occupancy query reports %d workgroups per CU\n", per_cu); }
        (void)hipGetLastError();
        grid = cus;
    }
    if (grid < 0) return;
    if (hipMemsetAsync((char*)d_ws + WS_CTL, 0, CTL_ZERO_BYTES, stream) != hipSuccess) return;
    Args a{};
    for (int i = 0; i < 25; ++i) a.in[i] = d_in[i];
    a.out = (float*)d_out; a.ws = (unsigned char*)d_ws;
#if MK_SINGLE
    a.l_lo = 0; a.l_hi = DEPTH; a.ph_lo = 0; a.ph_hi = NPH; a.single = 1;
    hipLaunchKernelGGL(hybrid_fwd, dim3(grid), dim3(NWAVES * 64), LDS_BYTES, stream, a);
#else
    a.single = 0;
    for (int l = 0; l < DEPTH; ++l)
        for (int p = 0; p < NPH; ++p) { if (p == 12 && l != DEPTH - 1) continue; a.l_lo = l; a.l_hi = l + 1; a.ph_lo = p; a.ph_hi = p + 1;
            hipLaunchKernelGGL(hybrid_fwd, dim3(grid), dim3(NWAVES * 64), LDS_BYTES, stream, a); }
#endif
}
```

```cpp
#include <hip/hip_runtime.h>
#include <cstdio>
#include <cstdint>

#ifndef MK_SINGLE
#define MK_SINGLE 1
#endif

#pragma clang attribute push(__attribute__((target("no-packed-fp32-ops"))), apply_to = function)
#define LAS __attribute__((address_space(3)))
#define GAS __attribute__((address_space(1)))
typedef unsigned short bf16_t;
typedef short bf16x8 __attribute__((ext_vector_type(8)));
typedef float f32x4 __attribute__((ext_vector_type(4)));
typedef float f32x2 __attribute__((ext_vector_type(2)));
typedef unsigned u32x4 __attribute__((ext_vector_type(4)));
typedef unsigned u32x2 __attribute__((ext_vector_type(2)));

constexpr int D = 2048, BATCH = 8, SEQ = 4096, DEPTH = 4, M = BATCH * SEQ;
constexpr int BW = 512;
constexpr int NIN_SRC = 12304, NIN = 12544;
constexpr int DFF = 5504, NUP = 11008;
constexpr int C_RQ = 0, C_RK = 256, C_RV = 512, C_RG = 1024, C_SU = 1536, C_GQ = 2048, C_GK = 2304, C_GV = 2560, C_GG = 3072, C_PU = 3584, C_GR = 4096, C_GATE = 4352;
constexpr float EPS = 1e-6f;
constexpr int NWAVES = 8;
constexpr int CH = 64;
constexpr int NCH = SEQ / CH;

constexpr size_t MiB = 1u << 20;
constexpr size_t WS_CTL = 0, CTL_ZERO_BYTES = 1 * MiB;
constexpr size_t WS_ROT = 1 * MiB;
constexpr size_t WS_S5T = 9 * MiB;
constexpr size_t S5T_ABAR = 0, S5T_APOW = 16384, S5T_BBAR = 32768, S5T_CMT = 32768 + 262144, S5T_BBT = S5T_CMT + 131072;
constexpr size_t WS_WGLU = 10 * MiB;
constexpr size_t WS_POOLW = 10 * MiB + 512 * 1024;
constexpr size_t WS_WIN = 11 * MiB;
constexpr size_t WS_WBR = 60 * MiB;
constexpr size_t WS_WOUT = 68 * MiB;
constexpr size_t WS_WUP = 76 * MiB;
constexpr size_t WS_WDN = 119 * MiB;
constexpr size_t WS_HN = 141 * MiB;
constexpr size_t WS_Y = 269 * MiB;
constexpr size_t WS_SCR = 397 * MiB;
constexpr size_t WS_YBP = WS_SCR;
constexpr size_t WS_STATE = WS_SCR + 32 * MiB;
constexpr size_t WS_SPREV = WS_SCR + 160 * MiB;
constexpr size_t WS_DEC = WS_SCR + 224 * MiB;
constexpr size_t WS_XEND = WS_SCR + 225 * MiB;
constexpr size_t WS_UH = WS_SCR + 128 * MiB;
constexpr size_t WS_PROJ = 637 * MiB;
constexpr size_t WS_ACT = WS_PROJ;
constexpr size_t WS_RS = 1421 * MiB;
constexpr size_t WS_SS = 1422 * MiB;
constexpr size_t WS_HN8 = 1438 * MiB;
constexpr size_t WS_W8 = 1502 * MiB;
constexpr size_t WS_END = 1518 * MiB;
static_assert(WS_PROJ + (size_t)M * NIN * 2 <= WS_RS, "ws map");
static_assert(WS_ACT + (size_t)M * DFF * 2 <= WS_RS, "ws map");
static_assert(WS_XEND + 8 * MiB <= WS_PROJ, "ws map");
static_assert(WS_UH + (size_t)(M / 256) * 4 * NUP * 4 <= WS_PROJ, "ws map");
constexpr int CW_TMO = 0, CW_BAR = 4096;

constexpr int LDS_BYTES = 155648;
constexpr int MISC_OFF = LDS_BYTES - 256;

#define RLX_AGENT __ATOMIC_RELAXED, __HIP_MEMORY_SCOPE_AGENT
__device__ __forceinline__ void lds_sync() { asm volatile("s_waitcnt lgkmcnt(0)" ::: "memory"); __builtin_amdgcn_s_barrier(); asm volatile("" ::: "memory"); }
__device__ __forceinline__ void wg_sync() { __builtin_amdgcn_fence(__ATOMIC_RELEASE, "workgroup"); __builtin_amdgcn_s_barrier(); __builtin_amdgcn_fence(__ATOMIC_ACQUIRE, "workgroup"); }
#define LDS_WAIT() asm volatile("s_waitcnt lgkmcnt(0)" ::: "memory")
#define VM_WAIT() asm volatile("s_waitcnt vmcnt(0)" ::: "memory")
__device__ __forceinline__ unsigned f2bf(float f) { unsigned u = __builtin_bit_cast(unsigned, f); return (u + 0x7fffu + ((u >> 16) & 1u)) >> 16; }
__device__ __forceinline__ unsigned pk2(float lo, float hi) { return f2bf(lo) | (f2bf(hi) << 16); }
__device__ __forceinline__ float bflo(unsigned w) { return __builtin_bit_cast(float, w << 16); }
__device__ __forceinline__ float bfhi(unsigned w) { return __builtin_bit_cast(float, w & 0xffff0000u); }
__device__ __forceinline__ void unpack8(const u32x4 w, float (&v)[8]) { v[0] = bflo(w.x); v[1] = bfhi(w.x); v[2] = bflo(w.y); v[3] = bfhi(w.y); v[4] = bflo(w.z); v[5] = bfhi(w.z); v[6] = bflo(w.w); v[7] = bfhi(w.w); }
__device__ __forceinline__ u32x4 pack8(const float (&v)[8]) { u32x4 w; w.x = pk2(v[0], v[1]); w.y = pk2(v[2], v[3]); w.z = pk2(v[4], v[5]); w.w = pk2(v[6], v[7]); return w; }
__device__ __forceinline__ unsigned pk4_fp8(float a, float b, float c, float d) { unsigned w = 0u; w = __builtin_amdgcn_cvt_pk_fp8_f32(a, b, w, false); w = __builtin_amdgcn_cvt_pk_fp8_f32(c, d, w, true); return w; }
__device__ __forceinline__ float sigmoidf_(float x) { return 1.0f / (1.0f + __expf(-x)); }
__device__ __forceinline__ float siluf_(float x) { return x / (1.0f + __expf(-x)); }
__device__ __forceinline__ float gelu_tanh(float x) { const float u = 1.5957691216f * (x + 0.044715f * x * x * x); return x / (1.0f + __expf(-u)); }
__device__ __forceinline__ float logsigmoidf_(float x) { return fminf(x, 0.f) - __logf(1.0f + __expf(-fabsf(x))); }

namespace pg8 {
constexpr int BM = 256, BK = 64, HALF = 128, HTB = HALF * BK * 2, STAGE_BYTES = 8 * HTB, NXCD = 8, WGM = 4;
__host__ __device__ __forceinline__ int lds_byte(int r, int c) { const int st = (r >> 4) * 2 + (c >> 5), rr = r & 15, cc = c & 31, ob = rr * 64 + cc * 2; return st * 1024 + (ob ^ (((ob >> 9) & 1) << 5)); }
__host__ __device__ __forceinline__ void stage_rc(int b, int& R, int& C) { const int st = b / 1024, sb = b % 1024, swz = sb ^ (((sb >> 9) & 1) << 5); R = (st >> 1) * 16 + swz / 64; C = (st & 1) * 32 + (swz % 64) / 2; }
__host__ __device__ __forceinline__ int perm32(int rho) { const int n = rho >> 4, i = rho & 15; return 8 * (i >> 2) + 4 * n + (i & 3); }

struct Unit { int pm, pn; };
struct Gemm { const bf16_t* A; const bf16_t* Bt; int M, N, K, lda, ldb; };

struct StaticOrder {
    int nM, nN, nwg, G, c;
    __host__ __device__ void init(int M_, int N_, int G_, int c_) { nM = M_ / BM; nN = N_ / BM; nwg = nM * nN; G = G_; c = c_; }
    __host__ __device__ bool next(int i, Unit& u) const {
        const long L = (long)i * G + c; if (L >= nwg) return false;
        int wgid = (int)L; { const int q = nwg / NXCD, r = nwg % NXCD, xcd = wgid % NXCD, off = wgid / NXCD; wgid = (xcd < r ? xcd * (q + 1) : r * (q + 1) + (xcd - r) * q) + off; }
        const int nig = WGM * nN, gid = wgid / nig, fm = gid * WGM, gsz = (nM - fm) < WGM ? (nM - fm) : WGM;
        u.pm = fm + ((wgid % nig) % gsz); u.pn = (wgid % nig) / gsz; return true;
    }
};

__device__ __forceinline__ unsigned cvt_pk_bf16(float lo, float hi) { unsigned r; asm volatile("v_cvt_pk_bf16_f32 %0, %1, %2" : "=v"(r) : "v"(lo), "v"(hi)); return r; }

struct EpiStoreBf16 {
    static constexpr bool PERM = true, KHOOK = false;
    bf16_t* O; int ldc;
    __device__ __forceinline__ void khook(f32x4 (&)[2][2][4][2], const Unit&, int, int, int, int, int) const {}
    __device__ __forceinline__ void operator()(f32x4 (&acc)[2][2][4][2], const Unit& u, int wr, int wc, int fr, int fq) const {
        const int row0 = u.pm * BM + wr * 64 + fr, col0 = u.pn * BM + wc * 32 + 8 * fq;
#pragma unroll
        for (int ai = 0; ai < 2; ++ai)
#pragma unroll
            for (int m = 0; m < 4; ++m) { bf16_t* rowp = O + (size_t)(row0 + ai * HALF + m * 16) * ldc + col0;
#pragma unroll
                for (int bj = 0; bj < 2; ++bj) { const f32x4 v0 = acc[ai][bj][m][0], v1 = acc[ai][bj][m][1];
                    u32x4 w; w.x = cvt_pk_bf16(v0[0], v0[1]); w.y = cvt_pk_bf16(v0[2], v0[3]); w.z = cvt_pk_bf16(v1[0], v1[1]); w.w = cvt_pk_bf16(v1[2], v1[3]);
                    *(u32x4*)(rowp + bj * HALF) = w; } }
    }
};
struct EpiProj {
    static constexpr bool PERM = true, KHOOK = false;
    bf16_t* O; int ldc; int gate_pn0; int gate_col0; float gscale;
    __device__ __forceinline__ void khook(f32x4 (&)[2][2][4][2], const Unit&, int, int, int, int, int) const {}
    __device__ __forceinline__ void operator()(f32x4 (&acc)[2][2][4][2], const Unit& u, int wr, int wc, int fr_, int fq_) const {
        int fr = fr_, fq = fq_; asm volatile("" : "+v"(fr), "+v"(fq));
        const int row0 = u.pm * BM + wr * 64 + fr;
        if (u.pn < gate_pn0) {
            const int col0 = u.pn * BM + wc * 32 + 8 * fq;
#pragma unroll
            for (int ai = 0; ai < 2; ++ai)
#pragma unroll
                for (int m = 0; m < 4; ++m) { bf16_t* rowp = O + (size_t)(row0 + ai * HALF + m * 16) * ldc + col0;
#pragma unroll
                    for (int bj = 0; bj < 2; ++bj) { const f32x4 v0 = acc[ai][bj][m][0], v1 = acc[ai][bj][m][1];
                        u32x4 w; w.x = cvt_pk_bf16(v0[0], v0[1]); w.y = cvt_pk_bf16(v0[2], v0[3]); w.z = cvt_pk_bf16(v1[0], v1[1]); w.w = cvt_pk_bf16(v1[2], v1[3]);
                        *(u32x4*)(rowp + bj * HALF) = w; } }
        } else {
            const int col0 = gate_col0 + 64 * (u.pn - gate_pn0) + 16 * wc + 4 * fq;
#pragma unroll
            for (int ai = 0; ai < 2; ++ai)
#pragma unroll
                for (int m = 0; m < 4; ++m) { bf16_t* rowp = O + (size_t)(row0 + ai * HALF + m * 16) * ldc + col0;
                    float r1[4], r2[4], r3[4], g3[4];
#pragma unroll
                    for (int i = 0; i < 4; ++i) {
                        const float e0 = __expf(-fminf(fmaxf(acc[ai][0][m][0][i] * gscale, -30.f), 30.f)), e1 = __expf(-fminf(fmaxf(acc[ai][0][m][1][i] * gscale, -30.f), 30.f));
                        const float e2 = __expf(-fminf(fmaxf(acc[ai][1][m][0][i] * gscale, -30.f), 30.f)), e3 = __expf(-fminf(fmaxf(acc[ai][1][m][1][i] * gscale, -30.f), 30.f));
                        const float i0 = __builtin_amdgcn_rcpf(1.f + e0), i1 = __builtin_amdgcn_rcpf(1.f + e1), i2 = __builtin_amdgcn_rcpf(1.f + e2), i3 = __builtin_amdgcn_rcpf(1.f + e3);
                        r1[i] = (1.f + e1) * i0; r2[i] = (1.f + e2) * i1; r3[i] = (1.f + e3) * i2; g3[i] = i3; }
                    u32x2 w;
                    w.x = cvt_pk_bf16(r1[0], r1[1]); w.y = cvt_pk_bf16(r1[2], r1[3]); *(u32x2*)(rowp) = w;
                    w.x = cvt_pk_bf16(r2[0], r2[1]); w.y = cvt_pk_bf16(r2[2], r2[3]); *(u32x2*)(rowp + D) = w;
                    w.x = cvt_pk_bf16(r3[0], r3[1]); w.y = cvt_pk_bf16(r3[2], r3[3]); *(u32x2*)(rowp + 2 * D) = w;
                    w.x = cvt_pk_bf16(g3[0], g3[1]); w.y = cvt_pk_bf16(g3[2], g3[3]); *(u32x2*)(rowp + 3 * D) = w; }
        }
    }
};
__device__ __forceinline__ float dpp_ror1(float x) { return __builtin_bit_cast(float, __builtin_amdgcn_update_dpp(0, __builtin_bit_cast(int, x), 0x121, 0xf, 0xf, false)); }
__device__ __forceinline__ float dpp_ror2(float x) { return __builtin_bit_cast(float, __builtin_amdgcn_update_dpp(0, __builtin_bit_cast(int, x), 0x122, 0xf, 0xf, false)); }
struct EpiConv {
    static constexpr bool PERM = true, KHOOK = false;
    const float* cw; const float* cb; bf16_t* O; float* UH; LAS float* halo; const float* RS;
    __device__ __forceinline__ void khook(f32x4 (&)[2][2][4][2], const Unit&, int, int, int, int, int) const {}
    __device__ __forceinline__ void operator()(f32x4 (&acc)[2][2][4][2], const Unit& u, int wr, int wc, int fr_, int fq_) const {
        int fr = fr_, fq = fq_; asm volatile("" : "+v"(fr), "+v"(fq));
        const int cl0 = wc * 32 + 8 * fq;
        const int j0 = 128 * u.pn + cl0;
        const float* rp = RS + ((size_t)(u.pm * 2 + wr) * 16 + fr) * 8; const f32x4 rs0 = *(const f32x4*)rp, rs1 = *(const f32x4*)(rp + 4);
        f32x4 wa0[3], wv0[3];
#pragma unroll
        for (int q = 0; q < 3; ++q) { wa0[q] = *(const f32x4*)(cw + q * NUP + j0); wv0[q] = *(const f32x4*)(cw + q * NUP + DFF + j0); }
        const f32x4 ba0 = *(const f32x4*)(cb + j0), bv0 = *(const f32x4*)(cb + DFF + j0);
#pragma unroll
        for (int ai = 0; ai < 2; ++ai)
#pragma unroll
            for (int m = 0; m < 4; ++m) { const float r = ai == 0 ? rs0[m] : rs1[m];
#pragma unroll
                for (int bj = 0; bj < 2; ++bj)
#pragma unroll
                    for (int n = 0; n < 2; ++n) acc[ai][bj][m][n] *= r; }
        if (fr >= 14) {
#pragma unroll
            for (int ai = 0; ai < 2; ++ai)
#pragma unroll
                for (int bj = 0; bj < 2; ++bj)
#pragma unroll
                    for (int n = 0; n < 2; ++n) *(LAS f32x4*)(halo + (((2 * ai + wr) * 2 + (fr - 14)) * 256 + 128 * bj + cl0 + 4 * n)) = acc[ai][bj][3][n];
        }
        if (wr == 0 && fr < 2) {
#pragma unroll
            for (int bj = 0; bj < 2; ++bj)
#pragma unroll
                for (int n = 0; n < 2; ++n) *(f32x4*)(UH + ((size_t)u.pm * 4 + fr) * NUP + 256 * u.pn + 128 * bj + cl0 + 4 * n) = acc[0][bj][0][n];
        }
        if (wr == 1 && fr >= 14) {
#pragma unroll
            for (int bj = 0; bj < 2; ++bj)
#pragma unroll
                for (int n = 0; n < 2; ++n) *(f32x4*)(UH + ((size_t)u.pm * 4 + 2 + (fr - 14)) * NUP + 256 * u.pn + 128 * bj + cl0 + 4 * n) = acc[1][bj][3][n];
        }
        asm volatile("s_waitcnt lgkmcnt(0)" ::: "memory"); __builtin_amdgcn_s_barrier(); asm volatile("" ::: "memory");
        const bool is15 = fr == 15, ge14 = fr >= 14;
        unsigned keep[2][4][2];
        f32x4 wa1[3], wv1[3];
#pragma unroll
        for (int q = 0; q < 3; ++q) { wa1[q] = *(const f32x4*)(cw + q * NUP + j0 + 4); wv1[q] = *(const f32x4*)(cw + q * NUP + DFF + j0 + 4); }
        const f32x4 ba1 = *(const f32x4*)(cb + j0 + 4), bv1 = *(const f32x4*)(cb + DFF + j0 + 4);
#pragma unroll
        for (int n = 0; n < 2; ++n) {
            f32x4 wa[3], wv[3];
#pragma unroll
            for (int q = 0; q < 3; ++q) { wa[q] = n == 0 ? wa0[q] : wa1[q]; wv[q] = n == 0 ? wv0[q] : wv1[q]; }
            const f32x4 ba = n == 0 ? ba0 : ba1, bv = n == 0 ? bv0 : bv1;
#pragma unroll
            for (int ai = 0; ai < 2; ++ai) {
                const int blk = 2 * ai + wr;
                f32x4 pa = (f32x4){0.f, 0.f, 0.f, 0.f}, pv = (f32x4){0.f, 0.f, 0.f, 0.f};
                if (blk > 0 && ge14) { pa = *(const LAS f32x4*)(halo + (((blk - 1) * 2 + (fr - 14)) * 256 + cl0 + 4 * n)); pv = *(const LAS f32x4*)(halo + (((blk - 1) * 2 + (fr - 14)) * 256 + 128 + cl0 + 4 * n)); }
#pragma unroll
                for (int m = 0; m < 4; ++m) {
                    const f32x4 ca_ = acc[ai][0][m][n], cv_ = acc[ai][1][m][n]; float o[4];
#pragma unroll
                    for (int i = 0; i < 4; ++i) {
                        const float a1 = dpp_ror1(is15 ? pa[i] : ca_[i]), a2 = dpp_ror2(ge14 ? pa[i] : ca_[i]);
                        const float v1 = dpp_ror1(is15 ? pv[i] : cv_[i]), v2 = dpp_ror2(ge14 ? pv[i] : cv_[i]);
                        const float ca = ba[i] + wa[0][i] * a2 + wa[1][i] * a1 + wa[2][i] * ca_[i];
                        const float cv = bv[i] + wv[0][i] * v2 + wv[1][i] * v1 + wv[2][i] * cv_[i];
                        o[i] = siluf_(ca) * cv; }
                    pa = ca_; pv = cv_;
                    const unsigned lo = cvt_pk_bf16(o[0], o[1]), hi = cvt_pk_bf16(o[2], o[3]);
                    if (n == 0) { keep[ai][m][0] = lo; keep[ai][m][1] = hi; }
                    else { u32x4 w; w.x = keep[ai][m][0]; w.y = keep[ai][m][1]; w.z = lo; w.w = hi;
                        *(u32x4*)(O + (size_t)(u.pm * BM + ai * HALF + wr * 64 + m * 16 + fr) * DFF + j0) = w; }
                }
            }
        }
    }
};
struct EpiResid {
    static constexpr bool PERM = true, KHOOK = false;
    const void* base; int base_f32; bf16_t* O; int ldc; float* SS;
    __device__ __forceinline__ void khook(f32x4 (&)[2][2][4][2], const Unit&, int, int, int, int, int) const {}
    __device__ __forceinline__ void finish(const float (&b)[8], const f32x4 v0, const f32x4 v1, bf16_t* op, float& sq) const {
        const float o0 = b[0] + v0[0], o1 = b[1] + v0[1], o2 = b[2] + v0[2], o3 = b[3] + v0[3], o4 = b[4] + v1[0], o5 = b[5] + v1[1], o6 = b[6] + v1[2], o7 = b[7] + v1[3];
        u32x4 w; w.x = cvt_pk_bf16(o0, o1); w.y = cvt_pk_bf16(o2, o3); w.z = cvt_pk_bf16(o4, o5); w.w = cvt_pk_bf16(o6, o7);
        *(u32x4*)op = w;
        sq += ((o0 * o0 + o1 * o1) + (o2 * o2 + o3 * o3)) + ((o4 * o4 + o5 * o5) + (o6 * o6 + o7 * o7));
    }
    __device__ __forceinline__ void rowsum(float sq, const Unit& u, int wc, int fq, int lane, int row) const {
        sq += __builtin_bit_cast(float, __builtin_amdgcn_ds_bpermute((lane ^ 16) << 2, __builtin_bit_cast(int, sq)));
        sq += __builtin_bit_cast(float, __builtin_amdgcn_ds_bpermute((lane ^ 32) << 2, __builtin_bit_cast(int, sq)));
        if (fq == 0) SS[(size_t)(u.pn * 4 + wc) * M + row] = sq;
    }
    __device__ __forceinline__ void operator()(f32x4 (&acc)[2][2][4][2], const Unit& u, int wr, int wc, int fr_, int fq_) const {
        int fr = fr_, fq = fq_; asm volatile("" : "+v"(fr), "+v"(fq));
        const int row0 = u.pm * BM + wr * 64 + fr, col0 = u.pn * BM + wc * 32 + 8 * fq, lane = fq * 16 + fr;
        if (!base_f32) {
            u32x4 bw[2][4][2];
#pragma unroll
            for (int ai = 0; ai < 2; ++ai)
#pragma unroll
                for (int m = 0; m < 4; ++m)
#pragma unroll
                    for (int bj = 0; bj < 2; ++bj) bw[ai][m][bj] = *(const u32x4*)((const bf16_t*)base + (size_t)(row0 + ai * HALF + m * 16) * ldc + col0 + bj * HALF);
#pragma unroll
            for (int ai = 0; ai < 2; ++ai)
#pragma unroll
                for (int m = 0; m < 4; ++m) { const size_t off = (size_t)(row0 + ai * HALF + m * 16) * ldc + col0; float sq = 0.f;
#pragma unroll
                    for (int bj = 0; bj < 2; ++bj) { float b[8]; unpack8(bw[ai][m][bj], b); finish(b, acc[ai][bj][m][0], acc[ai][bj][m][1], O + off + bj * HALF, sq); }
                    if (SS) rowsum(sq, u, wc, fq, lane, row0 + ai * HALF + m * 16); }
        } else {
#pragma unroll
            for (int ai = 0; ai < 2; ++ai)
#pragma unroll
                for (int m = 0; m < 4; ++m) { const size_t off = (size_t)(row0 + ai * HALF + m * 16) * ldc + col0; float sq = 0.f;
#pragma unroll
                    for (int bj = 0; bj < 2; ++bj) { float b[8]; const float* bp = (const float*)base + off + bj * HALF; const f32x4 b0 = *(const f32x4*)bp, b1 = *(const f32x4*)(bp + 4);
                        b[0] = b0.x; b[1] = b0.y; b[2] = b0.z; b[3] = b0.w; b[4] = b1.x; b[5] = b1.y; b[6] = b1.z; b[7] = b1.w;
                        finish(b, acc[ai][bj][m][0], acc[ai][bj][m][1], O + off + bj * HALF, sq); }
                    if (SS) rowsum(sq, u, wc, fq, lane, row0 + ai * HALF + m * 16);
                    asm volatile("" ::: "memory"); }
        }
    }
};
struct EpiGlu {
    static constexpr bool PERM = true, KHOOK = false;
    const bf16_t* Yp; int ldy; bf16_t* O; int ldc;
    __device__ __forceinline__ void khook(f32x4 (&)[2][2][4][2], const Unit&, int, int, int, int, int) const {}
    __device__ __forceinline__ void operator()(f32x4 (&acc)[2][2][4][2], const Unit& u, int wr, int wc, int fr, int fq) const {
        const int row0 = u.pm * BM + wr * 64 + fr, col0 = u.pn * BM + wc * 32 + 8 * fq;
#pragma unroll
        for (int ai = 0; ai < 2; ++ai)
#pragma unroll
            for (int m = 0; m < 4; ++m) { const size_t r = (size_t)(row0 + ai * HALF + m * 16);
#pragma unroll
                for (int bj = 0; bj < 2; ++bj) { const u32x4 yw = *(const u32x4*)(Yp + r * ldy + col0 + bj * HALF); float y[8]; unpack8(yw, y);
                    const f32x4 v0 = acc[ai][bj][m][0], v1 = acc[ai][bj][m][1]; float o[8];
#pragma unroll
                    for (int j = 0; j < 4; ++j) { o[j] = y[j] * sigmoidf_(v0[j]); o[4 + j] = y[4 + j] * sigmoidf_(v1[j]); }
                    u32x4 w; w.x = cvt_pk_bf16(o[0], o[1]); w.y = cvt_pk_bf16(o[2], o[3]); w.z = cvt_pk_bf16(o[4], o[5]); w.w = cvt_pk_bf16(o[6], o[7]);
                    *(u32x4*)(O + r * ldc + col0 + bj * HALF) = w; } }
    }
};
struct EpiMerge {
    static constexpr bool PERM = true, KHOOK = true;
    const bf16_t* G; int ldg; bf16_t* O; int ldc;
    __device__ __forceinline__ void scale(f32x4 (&acc)[2][2][4][2], const Unit& u, int s, int wr, int wc, int fr, int fq) const {
        int row0 = u.pm * BM + wr * 64 + fr, col0 = u.pn * BM + wc * 32 + 8 * fq + s * D; asm volatile("" : "+v"(row0), "+v"(col0));
        u32x4 w[2][4][2];
#pragma unroll
        for (int ai = 0; ai < 2; ++ai)
#pragma unroll
            for (int m = 0; m < 4; ++m) { const bf16_t* gp = G + (size_t)(row0 + ai * HALF + m * 16) * ldg + col0;
#pragma unroll
                for (int bj = 0; bj < 2; ++bj) w[ai][m][bj] = *(const u32x4*)(gp + bj * HALF); }
#pragma unroll
        for (int ai = 0; ai < 2; ++ai)
#pragma unroll
            for (int m = 0; m < 4; ++m)
#pragma unroll
                for (int bj = 0; bj < 2; ++bj) { float f[8]; unpack8(w[ai][m][bj], f);
#pragma unroll
                    for (int j = 0; j < 8; ++j) acc[ai][bj][m][j >> 2][j & 3] *= f[j]; }
    }
    __device__ __forceinline__ void khook(f32x4 (&acc)[2][2][4][2], const Unit& u, int seg, int wr, int wc, int fr, int fq) const { scale(acc, u, seg - 1, wr, wc, fr, fq); }
    __device__ __forceinline__ void operator()(f32x4 (&acc)[2][2][4][2], const Unit& u, int wr, int wc, int fr, int fq) const {
        scale(acc, u, 3, wr, wc, fr, fq);
        const int row0 = u.pm * BM + wr * 64 + fr, col0 = u.pn * BM + wc * 32 + 8 * fq;
#pragma unroll
        for (int ai = 0; ai < 2; ++ai)
#pragma unroll
            for (int m = 0; m < 4; ++m) { bf16_t* rowp = O + (size_t)(row0 + ai * HALF + m * 16) * ldc + col0;
#pragma unroll
                for (int bj = 0; bj < 2; ++bj) { const f32x4 v0 = acc[ai][bj][m][0], v1 = acc[ai][bj][m][1];
                    u32x4 w; w.x = cvt_pk_bf16(v0[0], v0[1]); w.y = cvt_pk_bf16(v0[2], v0[3]); w.z = cvt_pk_bf16(v1[0], v1[1]); w.w = cvt_pk_bf16(v1[2], v1[3]);
                    *(u32x4*)(rowp + bj * HALF) = w; } }
    }
};

typedef int v4i_t __attribute__((ext_vector_type(4)));
typedef int v8i_t __attribute__((ext_vector_type(8)));
template <class Epi, bool F8 = false>
__device__ __forceinline__ void gemm_phase(LAS unsigned char* lds, const Gemm g, const StaticOrder& S, const Epi& E, int tid_in) {
    int tid_ = tid_in; asm volatile("" : "+v"(tid_));
    const int tid = tid_, wid = __builtin_amdgcn_readfirstlane(tid >> 6), lane = tid & 63, wr = wid >> 2, wc = wid & 3, fr = lane & 15, fq = lane >> 4;
    const int K = g.K, nt = K / BK;
    unsigned voffA[2], voffB[2];
#pragma unroll
    for (int i = 0; i < 2; ++i) { int R, C; stage_rc(tid * 16 + i * 8192, R, C); const int Rb = Epi::PERM ? ((R & ~31) + perm32(R & 31)) : R;
        voffA[i] = (unsigned)(R * g.lda + C) * 2u; voffB[i] = (unsigned)(Rb * g.ldb + C) * 2u; }
    const size_t kstep = (size_t)(BK * 2);
    const size_t hstepA = (size_t)HALF * g.lda * 2, hstepB = (size_t)HALF * g.ldb * 2;
    const size_t tstepA = 2 * hstepA, tstepB = 2 * hstepB;
    const unsigned ldsw = (unsigned)wid * 1024u;
    const int aoff = lds_byte(wr * 64 + fr, fq * 8), boff = lds_byte(wc * 32 + fr, fq * 8);
#define PG8_SA(b, h) (((b) * 2 + (h)) * HTB)
#define PG8_SB(b, h) ((4 + (b) * 2 + (h)) * HTB)
#define PG8_STAGE(bufoff, gbase, voff) do { _Pragma("unroll") for (int _i = 0; _i < 2; ++_i) \
        __builtin_amdgcn_global_load_lds((const unsigned*)((const char*)(gbase) + (voff)[_i]), (LAS unsigned*)(lds + (bufoff) + ldsw + _i * 8192), 16, 0, 0); } while (0)
#define PG8_LDA(dst, b, h) do { _Pragma("unroll") for (int m = 0; m < 4; ++m) _Pragma("unroll") for (int k = 0; k < 2; ++k) dst[m][k] = *(const LAS bf16x8*)(lds + PG8_SA(b, h) + aoff + m * 2048 + k * 1024); } while (0)
#define PG8_LDB(dst, b, h) do { _Pragma("unroll") for (int n = 0; n < 2; ++n) _Pragma("unroll") for (int k = 0; k < 2; ++k) dst[n][k] = *(const LAS bf16x8*)(lds + PG8_SB(b, h) + boff + n * 2048 + k * 1024); } while (0)
#define PG8_MMA(ai, bj, At, Bt) do { __builtin_amdgcn_s_setprio(1); _Pragma("unroll") for (int m = 0; m < 4; ++m) _Pragma("unroll") for (int n = 0; n < 2; ++n) _Pragma("unroll") for (int k = 0; k < 2; ++k) \
        acc[ai][bj][m][n] = __builtin_amdgcn_mfma_f32_16x16x32_bf16(Bt[n][k], At[m][k], acc[ai][bj][m][n], 0, 0, 0); __builtin_amdgcn_s_setprio(0); } while (0)
#define PG8_MMA16(ai, bj, At, Bt) PG8_MMA(ai, bj, At, Bt)
#define PG8_MMA8(ai, bj, A8, B8) do { __builtin_amdgcn_s_setprio(1); _Pragma("unroll") for (int m = 0; m < 4; ++m) _Pragma("unroll") for (int n = 0; n < 2; ++n) \
        asm volatile("v_mfma_f32_16x16x128_f8f6f4 %0, %1, %2, %0" : "+v"(acc[ai][bj][m][n]) : "v"(B8[n]), "v"(A8[m])); __builtin_amdgcn_s_setprio(0); } while (0)
#define PG8_LDA8(dst, b, h) do { _Pragma("unroll") for (int m = 0; m < 4; ++m) { dst[m].lo = *(const LAS v4i_t*)(lds + PG8_SA(b, h) + aoff + m * 2048); dst[m].hi = *(const LAS v4i_t*)(lds + PG8_SA(b, h) + aoff + m * 2048 + 1024); } } while (0)
#define PG8_LDB8(dst, b, h) do { _Pragma("unroll") for (int n = 0; n < 2; ++n) { dst[n].lo = *(const LAS v4i_t*)(lds + PG8_SB(b, h) + boff + n * 2048); dst[n].hi = *(const LAS v4i_t*)(lds + PG8_SB(b, h) + boff + n * 2048 + 1024); } } while (0)
#define PG8_XLDA(b, h) do { if constexpr (F8) PG8_LDA8(A8, b, h); else PG8_LDA(At, b, h); } while (0)
#define PG8_XLDB0(b, h) do { if constexpr (F8) PG8_LDB8(B08, b, h); else PG8_LDB(B0, b, h); } while (0)
#define PG8_XLDB1(b, h) do { if constexpr (F8) PG8_LDB8(B18, b, h); else PG8_LDB(B1, b, h); } while (0)
#define PG8_MM0(ai, bj) do { if constexpr (F8) PG8_MMA8(ai, bj, A8, B08); else PG8_MMA16(ai, bj, At, B0); } while (0)
#define PG8_MM1(ai, bj) do { if constexpr (F8) PG8_MMA8(ai, bj, A8, B18); else PG8_MMA16(ai, bj, At, B1); } while (0)
#define PG8_WAIT_V(n) asm volatile("s_waitcnt vmcnt(" #n ")" ::: "memory")
#define PG8_WAIT_L(n) asm volatile("s_waitcnt lgkmcnt(" #n ")" ::: "memory")
#define PG8_BAR __builtin_amdgcn_s_barrier()
#define PG8_SCHED __builtin_amdgcn_sched_barrier(0)
    Unit cur, nxt; int ui = 0;
    if (!S.next(0, cur)) return;
    f32x4 acc[2][2][4][2];
#pragma unroll
    for (int a = 0; a < 2; ++a)
#pragma unroll
        for (int b = 0; b < 2; ++b)
#pragma unroll
            for (int m = 0; m < 4; ++m)
#pragma unroll
                for (int n = 0; n < 2; ++n) acc[a][b][m][n] = (f32x4){0.f, 0.f, 0.f, 0.f};
    bf16x8 At[4][2], B0[2][2], B1[2][2]; v8i_t A8[4], B08[2], B18[2];
    const char* cA = (const char*)g.A + (size_t)cur.pm * tstepA; const char* cB = (const char*)g.Bt + (size_t)cur.pn * tstepB;
    PG8_STAGE(PG8_SB(0, 0), cB, voffB); PG8_STAGE(PG8_SB(0, 1), cB + hstepB, voffB); PG8_STAGE(PG8_SA(0, 0), cA, voffA); PG8_STAGE(PG8_SA(0, 1), cA + hstepA, voffA);
    if (wr == 1) PG8_BAR;
    PG8_WAIT_V(2); PG8_BAR;
    PG8_STAGE(PG8_SB(1, 0), cB + kstep, voffB); PG8_STAGE(PG8_SA(1, 0), cA + kstep, voffA); PG8_STAGE(PG8_SB(1, 1), cB + hstepB + kstep, voffB);
    PG8_WAIT_V(6); PG8_BAR;
    for (;;) {
        const bool has_next = S.next(ui + 1, nxt);
        const char* nA = has_next ? (const char*)g.A + (size_t)nxt.pm * tstepA : cA; const char* nB = has_next ? (const char*)g.Bt + (size_t)nxt.pn * tstepB : cB;
        for (int t = 0; t < nt; t += 2) {
            const bool last = (t == nt - 2);
            const char* a1 = cA + (size_t)(t + 1) * kstep;
            const char* a2 = last ? nA : cA + (size_t)(t + 2) * kstep; const char* b2 = last ? nB : cB + (size_t)(t + 2) * kstep;
            const char* a3 = a2 + kstep; const char* b3 = b2 + kstep;
            if constexpr (Epi::KHOOK) { if (t != 0 && (t & 7) == 0) E.khook(acc, cur, t >> 3, wr, wc, fr, fq); }
            PG8_XLDB0(0, 0); PG8_XLDB1(0, 1); PG8_SCHED; PG8_XLDA(0, 0); PG8_STAGE(PG8_SA(1, 1), a1 + hstepA, voffA);
            PG8_WAIT_V(8); PG8_WAIT_L(0); PG8_BAR; PG8_MM0(0, 0); PG8_MM1(0, 1); PG8_BAR; PG8_SCHED;
            PG8_XLDA(0, 1); PG8_STAGE(PG8_SB(0, 0), b2, voffB); PG8_STAGE(PG8_SB(0, 1), b2 + hstepB, voffB); PG8_STAGE(PG8_SA(0, 0), a2, voffA);
            PG8_WAIT_V(8); PG8_WAIT_L(0); PG8_BAR; PG8_MM0(1, 0); PG8_MM1(1, 1); PG8_BAR; PG8_SCHED;
            PG8_XLDB0(1, 0); PG8_XLDB1(1, 1); PG8_SCHED; PG8_XLDA(1, 0); PG8_STAGE(PG8_SA(0, 1), a2 + hstepA, voffA);
            PG8_WAIT_V(8); PG8_WAIT_L(0); PG8_BAR; PG8_MM0(0, 0); PG8_MM1(0, 1); PG8_BAR; PG8_SCHED;
            PG8_XLDA(1, 1); PG8_STAGE(PG8_SB(1, 0), b3, voffB); PG8_STAGE(PG8_SB(1, 1), b3 + hstepB, voffB); PG8_STAGE(PG8_SA(1, 0), a3, voffA);
            PG8_WAIT_V(8); PG8_WAIT_L(0); PG8_BAR; PG8_MM0(1, 0); PG8_MM1(1, 1); PG8_BAR; PG8_SCHED;
        }
        if (wr == 0) PG8_BAR;
        E(acc, cur, wr, wc, fr, fq);
        if (!has_next) break;
#pragma unroll
        for (int a = 0; a < 2; ++a)
#pragma unroll
            for (int b = 0; b < 2; ++b)
#pragma unroll
                for (int m = 0; m < 4; ++m)
#pragma unroll
                    for (int n = 0; n < 2; ++n) acc[a][b][m][n] = (f32x4){0.f, 0.f, 0.f, 0.f};
        cur = nxt; cA = nA; cB = nB; ++ui;
        if (wr == 1) PG8_BAR;
    }
    PG8_WAIT_V(0);
    PG8_BAR;
#undef PG8_SA
#undef PG8_SB
#undef PG8_STAGE
#undef PG8_LDA
#undef PG8_LDB
#undef PG8_MMA
#undef PG8_MMA8
#undef PG8_MMA16
#undef PG8_LDA8
#undef PG8_LDB8
#undef PG8_XLDA
#undef PG8_XLDB0
#undef PG8_XLDB1
#undef PG8_MM0
#undef PG8_MM1
#undef PG8_WAIT_V
#undef PG8_WAIT_L
#undef PG8_BAR
#undef PG8_SCHED
}
}

#define XB_TMO      128
#define XB_XCNT(j)  (256  + 64 * (j))
#define XB_XSUB(j)  (1280 + 64 * (j))
#define XB_XGEN(j)  (2304 + 64 * (j))
#define XB_TOP      3328
#define XB_TOPGEN   3392
#define XCD_BAR_WORDS 3456
#define XB_SPIN_CAP (1u << 18)
__device__ __forceinline__ unsigned xb_ld(unsigned* p)              { return __hip_atomic_load(p, __ATOMIC_RELAXED, __HIP_MEMORY_SCOPE_AGENT); }
__device__ __forceinline__ unsigned xb_add(unsigned* p, unsigned v) { return __hip_atomic_fetch_add(p, v, __ATOMIC_RELAXED, __HIP_MEMORY_SCOPE_AGENT); }
__device__ __forceinline__ unsigned xb_xcc_id() { return (unsigned)__builtin_amdgcn_s_getreg((3 << 11) | 20) & 0xFu; }
#define XB_SPIN(cond, bar) do { unsigned _sp = 0; while (cond) { __builtin_amdgcn_s_sleep(1); \
    if ((++_sp & 255u) == 0u) { if (xb_ld(&(bar)[XB_TMO])) break; if (_sp > XB_SPIN_CAP) { (void)__hip_atomic_fetch_add(&(bar)[XB_TMO], 1u, __ATOMIC_RELAXED, __HIP_MEMORY_SCOPE_AGENT); break; } } } } while (0)
struct XcdBarrier { unsigned* bar; unsigned x; volatile LAS unsigned* st; };
__device__ __forceinline__ XcdBarrier xcd_barrier_post(unsigned* bar, volatile LAS unsigned* st) {
    XcdBarrier b; b.bar = bar; b.x = xb_xcc_id(); b.st = st;
    if (threadIdx.x == 0) (void)xb_add(&bar[XB_XCNT(b.x)], 1u);
    return b;
}
__device__ __forceinline__ void xcd_barrier_complete(unsigned* bar, unsigned x, unsigned& nloc, unsigned& nx) {
    const unsigned G = gridDim.x * gridDim.y * gridDim.z;
    unsigned sum, cnt, mine, sp = 0u;
    for (;;) {
        sum = 0u; cnt = 0u; mine = 0u;
#pragma nounroll
        for (unsigned j = 0; j < 16; ++j) { const unsigned c = xb_ld(&bar[XB_XCNT(j)]); sum += c; cnt += (c > 0u) ? 1u : 0u; mine = (j == x) ? c : mine; }
        if (sum == G) break;
        __builtin_amdgcn_s_sleep(1);
        if ((++sp & 255u) == 0u) { if (xb_ld(&bar[XB_TMO])) break; if (sp > XB_SPIN_CAP) { (void)__hip_atomic_fetch_add(&bar[XB_TMO], 1u, __ATOMIC_RELAXED, __HIP_MEMORY_SCOPE_AGENT); break; } }
    }
    nloc = mine > 0u ? mine : 1u; nx = cnt > 0u ? cnt : 1u;
}
__device__ __forceinline__ void xcd_barrier(const XcdBarrier& b) {
    asm volatile("s_waitcnt vmcnt(0)" ::: "memory");
    wg_sync();
    if (threadIdx.x == 0) {
        unsigned* bar = b.bar;
        __builtin_amdgcn_s_waitcnt(0);
        unsigned nloc = b.st[0], nx = b.st[1];
        if (nloc == 0u) { xcd_barrier_complete(bar, b.x, nloc, nx); b.st[0] = nloc; b.st[1] = nx; }
        const unsigned old = xb_add(&bar[XB_XSUB(b.x)], 1u);
        const unsigned gen = old / nloc;
        if (old + 1u == (gen + 1u) * nloc) {
            __builtin_amdgcn_fence(__ATOMIC_RELEASE, "agent");
            asm volatile("s_waitcnt vmcnt(0)" ::: "memory");
            const unsigned og = xb_add(&bar[XB_TOP], 1u);
            const unsigned tg = og / nx;
            if (og + 1u == (tg + 1u) * nx) xb_add(&bar[XB_TOPGEN], 1u);
            else XB_SPIN(xb_ld(&bar[XB_TOPGEN]) == tg, bar);
            __builtin_amdgcn_fence(__ATOMIC_ACQUIRE, "agent");
            xb_add(&bar[XB_XGEN(b.x)], 1u);
            asm volatile("s_waitcnt vmcnt(0)" ::: "memory");
        } else {
            XB_SPIN(xb_ld(&bar[XB_XGEN(b.x)]) == gen, bar);
            __builtin_amdgcn_fence(__ATOMIC_ACQUIRE, "agent");
            asm volatile("s_waitcnt vmcnt(0)" ::: "memory");
        }
    }
    wg_sync();
}

__device__ __forceinline__ const void* kin(int k) {
    typedef __attribute__((address_space(4))) const char* kptr_t;
    kptr_t p = (kptr_t)__builtin_amdgcn_kernarg_segment_ptr(); asm volatile("" : "+s"(p));
    const unsigned long long v = *(__attribute__((address_space(4))) const unsigned long long*)(p + 8 * k);
    return (const void*)(GAS const void*)v;
}
struct Frame {
    LAS unsigned char* lds;
    int tid, lane, wave, vcu, G, l;
    unsigned char* ws; float* out;
#define FIN(name, T, k) __device__ __forceinline__ const T* name() const { return (const T*)kin(k); }
    FIN(x, float, 0) FIN(pos, int, 1) FIN(g_mix, float, 2) FIN(w_in, float, 3) FIN(a_re, float, 4) FIN(a_im, float, 5) FIN(log_dt, float, 6) FIN(b_re, float, 7) FIN(b_im, float, 8)
    FIN(c_re, float, 9) FIN(c_im, float, 10) FIN(s5_d, float, 11) FIN(w_glu, float, 12) FIN(gla_wg, float, 13) FIN(gla_bg, float, 14) FIN(pool_w, float, 15) FIN(pool_scale, float, 16)
    FIN(w_branch, float, 17) FIN(w_out, float, 18) FIN(g_ffn, float, 19) FIN(w_up, float, 20) FIN(conv_w, float, 21) FIN(conv_b, float, 22) FIN(w_down, float, 23) FIN(g_final, float, 24)
#undef FIN
#define FWS(name, T, off) __device__ __forceinline__ T* name() const { return (T*)(ws + (off)); }
    FWS(rotc, float, WS_ROT) FWS(rots, float, WS_ROT + (size_t)M * 32 * 4) FWS(abar, float, WS_S5T + S5T_ABAR) FWS(apow, float, WS_S5T + S5T_APOW) FWS(bbar, float, WS_S5T + S5T_BBAR) FWS(cmt, bf16_t, WS_S5T + S5T_CMT) FWS(bbt, bf16_t, WS_S5T + S5T_BBT)
    FWS(wglu_t, bf16_t, WS_WGLU) FWS(poolw_t, bf16_t, WS_POOLW) FWS(win_t, bf16_t, WS_WIN) FWS(wbr_t, bf16_t, WS_WBR) FWS(wout_t, bf16_t, WS_WOUT) FWS(wup_t, bf16_t, WS_WUP) FWS(wdn_t, bf16_t, WS_WDN)
    FWS(HN8, unsigned char, WS_HN8) FWS(W8, unsigned char, WS_W8) FWS(HN, bf16_t, WS_HN) FWS(Y, bf16_t, WS_Y) FWS(YBP, bf16_t, WS_YBP) FWS(PROJ, bf16_t, WS_PROJ) FWS(SPREV, bf16_t, WS_SPREV) FWS(ACT, bf16_t, WS_ACT)
    FWS(SS, float, WS_SS + (size_t)l * 32 * M * 4) FWS(RS, float, WS_RS + (size_t)l * M * 4) FWS(STATE, float, WS_STATE) FWS(DEC, float, WS_DEC) FWS(XEND, float, WS_XEND) FWS(UH, float, WS_UH)
#undef FWS
};

__device__ __forceinline__ float lane_read(float v, int src_lane) { return __builtin_bit_cast(float, __builtin_amdgcn_ds_bpermute(src_lane << 2, __builtin_bit_cast(int, v))); }
__device__ __forceinline__ float wave_sum(float v, int lane) {
#pragma unroll
    for (int o = 1; o < 64; o <<= 1) v += lane_read(v, lane ^ o);
    return v;
}

template <class SrcCol>
__device__ __forceinline__ void transpose_item(const float* W, int Nsrc, bf16_t* WT, int ldt, int kdst0, int k0, int n0, SrcCol srccol, LAS float* scr, int lane, const float* kscale = nullptr) {
    const int sc = srccol(n0 + (lane & 31));
    float wv[32];
#pragma unroll
    for (int i = 0; i < 32; ++i) { const int kk = 2 * i + (lane >> 5); wv[i] = sc >= 0 ? W[(size_t)(k0 + kk) * Nsrc + sc] : 0.f; }
#pragma unroll
    for (int i = 0; i < 32; ++i) { const int kk = 2 * i + (lane >> 5); scr[kk * 33 + (lane & 31)] = kscale ? wv[i] * kscale[k0 + kk] : wv[i]; }
    LDS_WAIT();
    const int c = lane & 7;
#pragma unroll
    for (int j = 0; j < 4; ++j) { const int n = (lane >> 3) + 8 * j; const LAS float* s = scr + (8 * c) * 33 + n;
        u32x4 o; o.x = pk2(s[0 * 33], s[1 * 33]); o.y = pk2(s[2 * 33], s[3 * 33]); o.z = pk2(s[4 * 33], s[5 * 33]); o.w = pk2(s[6 * 33], s[7 * 33]);
        *(u32x4*)(WT + (size_t)(n0 + n) * ldt + kdst0 + k0 + 8 * c) = o; }
    LDS_WAIT();
}
template <class SrcCol>
__device__ __forceinline__ void transpose_item_fp8(const float* W, int Nsrc, unsigned char* WT, int ldt, int k0, int n0src, int n0dst, SrcCol srccol, LAS float* scr, int lane, const float* kscale, float scale) {
    const int sc = srccol(n0src + (lane & 31));
    float wv[32];
#pragma unroll
    for (int i = 0; i < 32; ++i) { const int kk = 2 * i + (lane >> 5); wv[i] = sc >= 0 ? W[(size_t)(k0 + kk) * Nsrc + sc] : 0.f; }
#pragma unroll
    for (int i = 0; i < 32; ++i) { const int kk = 2 * i + (lane >> 5); scr[kk * 33 + (lane & 31)] = (kscale ? wv[i] * kscale[k0 + kk] : wv[i]) * scale; }
    LDS_WAIT();
    const int c = lane & 7;
#pragma unroll
    for (int j = 0; j < 4; ++j) { const int n = (lane >> 3) + 8 * j; const LAS float* s = scr + (8 * c) * 33 + n;
        u32x2 o; o.x = pk4_fp8(s[0 * 33], s[1 * 33], s[2 * 33], s[3 * 33]); o.y = pk4_fp8(s[4 * 33], s[5 * 33], s[6 * 33], s[7 * 33]);
        *(u32x2*)(WT + (size_t)(n0dst + n) * ldt + k0 + 8 * c) = o; }
    LDS_WAIT();
}
struct ColIdent { __device__ __forceinline__ int operator()(int n) const { return n; } };
struct ColWin { __device__ __forceinline__ int operator()(int n) const {
    if (n < 3584) return n; if (n < 4096) return n + 16; if (n < 4112) return n - 512; if (n < 4352) return -1;
    const int t = (n - 4352) >> 8, cl = (n - 4352) & 255; const int br = 2 * (cl >> 7) + ((cl >> 2) & 1), ch = 16 * ((cl >> 5) & 3) + 4 * ((cl >> 3) & 3) + (cl & 3);
    return 4112 + br * 2048 + 64 * t + ch; } };
struct ColWup { __device__ __forceinline__ int operator()(int n) const { const int blk = n >> 8, r = n & 255; return (r < 128) ? (blk * 128 + r) : (DFF + blk * 128 + (r - 128)); } };

__device__ __forceinline__ void rms_row_to_bf16(const float* xrow, const float* g, bf16_t* orow, int lane, unsigned char* orow8 = nullptr) {
    const f32x4* xr = (const f32x4*)xrow + lane; const f32x4* gr = (const f32x4*)g + lane;
    f32x4 v[8]; float s = 0.f;
#pragma unroll
    for (int j = 0; j < 8; ++j) { v[j] = xr[64 * j]; s += (v[j].x * v[j].x + v[j].y * v[j].y) + (v[j].z * v[j].z + v[j].w * v[j].w); }
    const float r = 1.0f / sqrtf(wave_sum(s, lane) * (1.f / D) + EPS);
    u32x2* o8 = (u32x2*)orow + lane;
#pragma unroll
    for (int j = 0; j < 8; ++j) { const f32x4 gg = gr[64 * j]; const float a = v[j].x * r * gg.x, b = v[j].y * r * gg.y, c = v[j].z * r * gg.z, d = v[j].w * r * gg.w; u32x2 w; w.x = pk2(a, b); w.y = pk2(c, d); o8[64 * j] = w;
        if (orow8) ((unsigned*)orow8)[lane + 64 * j] = pk4_fp8(a, b, c, d); }
}
__device__ __forceinline__ void rms_rows(Frame& F, const float* src, const float* g, bf16_t* dst, unsigned char* dst8 = nullptr) {
    const int gw = F.vcu * NWAVES + F.wave, NGW = F.G * NWAVES;
    for (int m = gw; m < M; m += NGW) rms_row_to_bf16(src + (size_t)m * D, g, dst + (size_t)m * D, F.lane, dst8 ? dst8 + (size_t)m * D : nullptr);
}
__device__ __forceinline__ void row_scale(Frame& F) {
    const int gt = F.vcu * (NWAVES * 64) + F.tid, NGT = F.G * NWAVES * 64;
    for (int m = gt; m < M; m += NGT) { float s = 0.f;
#pragma unroll
        for (int j = 0; j < 32; ++j) s += F.SS()[(size_t)j * M + m];
        const int r = m & 255;
        F.RS()[((size_t)((m >> 8) * 2 + ((r >> 6) & 1)) * 16 + (r & 15)) * 8 + (r >> 7) * 4 + ((r >> 4) & 3)] = 1.0f / sqrtf(s * (1.f / D) + EPS); }
}
__device__ __forceinline__ void rms_rows16(Frame& F, const bf16_t* src, const float* g, bf16_t* dst, unsigned char* dst8) {
    const int gw = F.vcu * NWAVES + F.wave, NGW = F.G * NWAVES, lane = F.lane;
    for (int m = gw; m < M; m += NGW) {
        const u32x4* xr = (const u32x4*)(src + (size_t)m * D) + lane; float v[4][8]; float s = 0.f;
#pragma unroll
        for (int j = 0; j < 4; ++j) { unpack8(xr[64 * j], v[j]);
#pragma unroll
            for (int q = 0; q < 8; ++q) s += v[j][q] * v[j][q]; }
        const float r = 1.0f / sqrtf(wave_sum(s, lane) * (1.f / D) + EPS);
        u32x4* o16 = (u32x4*)(dst + (size_t)m * D) + lane; u32x2* o8 = (u32x2*)(dst8 + (size_t)m * D) + lane;
#pragma unroll
        for (int j = 0; j < 4; ++j) { const f32x4 g0 = *((const f32x4*)g + 2 * (lane + 64 * j)), g1 = *((const f32x4*)g + 2 * (lane + 64 * j) + 1); float y[8];
            y[0] = v[j][0] * r * g0.x; y[1] = v[j][1] * r * g0.y; y[2] = v[j][2] * r * g0.z; y[3] = v[j][3] * r * g0.w; y[4] = v[j][4] * r * g1.x; y[5] = v[j][5] * r * g1.y; y[6] = v[j][6] * r * g1.z; y[7] = v[j][7] * r * g1.w;
            o16[64 * j] = pack8(y); u32x2 w8; w8.x = pk4_fp8(y[0], y[1], y[2], y[3]); w8.y = pk4_fp8(y[4], y[5], y[6], y[7]); o8[64 * j] = w8; }
    }
}
__device__ __forceinline__ void rms_rows16_to_f32(Frame& F, const bf16_t* src, const float* g, float* out) {
    const int gw = F.vcu * NWAVES + F.wave, NGW = F.G * NWAVES, lane = F.lane;
    for (int m = gw; m < M; m += NGW) {
        const u32x4* xr = (const u32x4*)(src + (size_t)m * D) + lane; float v[4][8]; float s = 0.f;
#pragma unroll
        for (int j = 0; j < 4; ++j) { unpack8(xr[64 * j], v[j]);
#pragma unroll
            for (int q = 0; q < 8; ++q) s += v[j][q] * v[j][q]; }
        const float r = 1.0f / sqrtf(wave_sum(s, lane) * (1.f / D) + EPS);
        f32x4* o = (f32x4*)(out + (size_t)m * D);
#pragma unroll
        for (int j = 0; j < 4; ++j) { const f32x4 g0 = *((const f32x4*)g + 2 * (lane + 64 * j)), g1 = *((const f32x4*)g + 2 * (lane + 64 * j) + 1);
            o[2 * (lane + 64 * j)] = (f32x4){v[j][0] * r * g0.x, v[j][1] * r * g0.y, v[j][2] * r * g0.z, v[j][3] * r * g0.w};
            o[2 * (lane + 64 * j) + 1] = (f32x4){v[j][4] * r * g1.x, v[j][5] * r * g1.y, v[j][6] * r * g1.z, v[j][7] * r * g1.w}; }
    }
}
__device__ __forceinline__ void rms_rows_f32_inplace(Frame& F, float* buf, const float* g) {
    const int gw = F.vcu * NWAVES + F.wave, NGW = F.G * NWAVES;
    for (int m = gw; m < M; m += NGW) {
        f32x4* xr = (f32x4*)(buf + (size_t)m * D) + F.lane; const f32x4* gr = (const f32x4*)g + F.lane;
        f32x4 v[8]; float s = 0.f;
#pragma unroll
        for (int j = 0; j < 8; ++j) { v[j] = xr[64 * j]; s += (v[j].x * v[j].x + v[j].y * v[j].y) + (v[j].z * v[j].z + v[j].w * v[j].w); }
        const float r = 1.0f / sqrtf(wave_sum(s, F.lane) * (1.f / D) + EPS);
#pragma unroll
        for (int j = 0; j < 8; ++j) { const f32x4 gg = gr[64 * j]; xr[64 * j] = (f32x4){v[j].x * r * gg.x, v[j].y * r * gg.y, v[j].z * r * gg.z, v[j].w * r * gg.w}; }
    }
}

__device__ __forceinline__ void phase_prep(Frame& F, int l) {
    LAS float* scr = (LAS float*)(F.lds + F.wave * 16384);
    const int gw = F.vcu * NWAVES + F.wave, NGW = F.G * NWAVES;
    constexpr int I_IN = (D / 64) * (NIN / 32), I_UP = (D / 64) * (NUP / 32), I_DN = (DFF / 64) * (D / 32), I_BR = 4 * (BW / 64) * (D / 32), I_OUT = (D / 64) * (D / 32), I_GLU = (BW / 64) * (BW / 32), I_PL = 4 * (128 / 64) * (128 / 32);
    constexpr int NITEMS = I_IN + I_UP + I_DN + I_BR + I_OUT + I_GLU + I_PL;
    for (int it = gw; it < NITEMS; it += NGW) {
        int r = it;
        if (r < I_IN) { const int nb = NIN / 32, n0 = 32 * (r % nb);
            if (n0 < C_GATE) transpose_item(F.w_in() + (size_t)l * D * NIN_SRC, NIN_SRC, F.win_t(), D, 0, 64 * (r / nb), n0, ColWin(), scr, F.lane);
            else transpose_item_fp8(F.w_in() + (size_t)l * D * NIN_SRC, NIN_SRC, F.W8(), D, 64 * (r / nb), n0, n0 - C_GATE, ColWin(), scr, F.lane, nullptr, 64.0f);
            continue; } r -= I_IN;
        if (r < I_UP) { const int nb = NUP / 32; transpose_item(F.w_up() + (size_t)l * D * NUP, NUP, F.wup_t(), D, 0, 64 * (r / nb), 32 * (r % nb), ColWup(), scr, F.lane, F.g_ffn() + (size_t)l * D); continue; } r -= I_UP;
        if (r < I_DN) { const int nb = D / 32; transpose_item(F.w_down() + (size_t)l * DFF * D, D, F.wdn_t(), DFF, 0, 64 * (r / nb), 32 * (r % nb), ColIdent(), scr, F.lane); continue; } r -= I_DN;
        if (r < I_BR) { const int per = (BW / 64) * (D / 32), br = r / per, q = r % per, nb = D / 32;
            transpose_item(F.w_branch() + ((size_t)l * 4 + br) * BW * D, D, F.wbr_t(), D, br * BW, 64 * (q / nb), 32 * (q % nb), ColIdent(), scr, F.lane); continue; } r -= I_BR;
        if (r < I_OUT) { const int nb = D / 32; transpose_item(F.w_out() + (size_t)l * D * D, D, F.wout_t(), D, 0, 64 * (r / nb), 32 * (r % nb), ColIdent(), scr, F.lane); continue; } r -= I_OUT;
        if (r < I_GLU) { const int nb = BW / 32; transpose_item(F.w_glu() + (size_t)l * BW * BW, BW, F.wglu_t(), BW, 0, 64 * (r / nb), 32 * (r % nb), ColIdent(), scr, F.lane); continue; } r -= I_GLU;
        { const int grp = r / 8, q = r % 8; transpose_item(F.pool_w() + ((size_t)l * 4 + grp) * 128 * 128, 128, F.poolw_t() + (size_t)grp * 128 * 128, 128, 0, 64 * (q / 4), 32 * (q % 4), ColIdent(), scr, F.lane); }
    }
    const int gt = F.vcu * (NWAVES * 64) + F.tid, NGT = F.G * NWAVES * 64;
    for (int i = gt; i < 32 * 64; i += NGT) {
        const int g = i >> 6;
        const float are = F.a_re()[(size_t)l * 2048 + i], aim = F.a_im()[(size_t)l * 2048 + i], dt = expf(F.log_dt()[l * 32 + g]);
        const float mag = expf(are * dt), th = aim * dt;
        const float abr = mag * cosf(th), abi = mag * sinf(th);
        const float den = are * are + aim * aim, nr = abr - 1.0f, ni = abi;
        const float fre = (nr * are + ni * aim) / den, fim = (ni * are - nr * aim) / den;
        F.abar()[2 * i] = abr; F.abar()[2 * i + 1] = abi;
        float pr = abr, pi = abi;
#pragma unroll
        for (int q = 0; q < 6; ++q) { const float tr = pr * pr - pi * pi, ti = 2.f * pr * pi; pr = tr; pi = ti; }
        F.apow()[2 * i] = pr; F.apow()[2 * i + 1] = pi;
        const float* br = F.b_re() + ((size_t)l * 2048 + i) * 16; const float* bi = F.b_im() + ((size_t)l * 2048 + i) * 16;
#pragma unroll
        for (int c = 0; c < 16; ++c) { const float x = br[c], y = bi[c]; const float vr = fre * x - fim * y, vi = fre * y + fim * x; const int p = i & 63;
            F.bbt()[((size_t)g * 128 + p) * 16 + c] = (bf16_t)f2bf(vr); F.bbt()[((size_t)g * 128 + 64 + p) * 16 + c] = (bf16_t)f2bf(vi); }
    }
    for (int i = gt; i < 32 * 16 * 128; i += NGT) {
        const int k = i & 127, gc = i >> 7;
        const float v = (k < 64) ? F.c_re()[((size_t)l * 512 + gc) * 64 + k] : -F.c_im()[((size_t)l * 512 + gc) * 64 + (k - 64)];
        F.cmt()[i] = (bf16_t)f2bf(v);
    }
    if (l == 0) {
        for (int i = gt; i < M * 32; i += NGT) {
            const int row = i >> 5, j = i & 31;
            const float inv = exp2f(-(float)j * (13.287712379549449f / 32.0f));
            const float ang = (float)F.pos()[row] * inv;
            F.rotc()[i] = cosf(ang); F.rots()[i] = sinf(ang);
        }
    }
    if (l == 0) rms_rows(F, F.x(), F.g_mix(), F.HN(), F.HN8()); else rms_rows16(F, (const bf16_t*)F.out, F.g_mix() + (size_t)l * D, F.HN(), F.HN8());
}

__device__ __forceinline__ f32x4 mma_nt_lds(const LAS bf16_t* X, int px, const LAS bf16_t* Y, int py, int ksteps, f32x4 acc, int lane) {
    const LAS bf16_t* xp = X + (lane & 15) * px + 8 * (lane >> 4);
    const LAS bf16_t* yp = Y + (lane & 15) * py + 8 * (lane >> 4);
    for (int ks = 0; ks < ksteps; ++ks) {
        const bf16x8 a = *(const LAS bf16x8*)(xp + 32 * ks), b = *(const LAS bf16x8*)(yp + 32 * ks);
        acc = __builtin_amdgcn_mfma_f32_16x16x32_bf16(a, b, acc, 0, 0, 0);
    }
    return acc;
}

constexpr int LN_TOT = 16384, LN_QD = 18432, LN_KI = 27648, LN_PM = 36864, LN_VT = 46080, LN_OB = 64512, LN_WG = 98304, LN_END = 98304 + 4096 + 256;
constexpr int LP = 72;
struct LinRaw { u32x4 q0, q1, k0, k1, v0, v1, g0, g1, gr0, gr1; f32x4 c0, c1, s0, s1; bf16x8 sp0, sp1; };
template <bool OUT>
__device__ __forceinline__ void lin_issue(Frame& F, int unit, LinRaw& R) {
    const int n = unit & 63, h = (unit >> 6) & 3, b = (unit >> 8) & 7, mixer = unit >> 11;
    const size_t row0 = (size_t)b * SEQ + (size_t)n * CH; const int s = F.tid >> 3, c = F.tid & 7;
    const int cq = (mixer == 0 ? C_RQ : C_GQ) + h * 64, ck = (mixer == 0 ? C_RK : C_GK) + h * 64, cv = (mixer == 0 ? C_RV : C_GV) + h * 128, cg = (mixer == 0 ? C_RG : C_GG) + h * 128;
    const bf16_t* pr = F.PROJ() + (row0 + s) * NIN;
    R.k0 = *(const u32x4*)(pr + ck + 8 * c); R.k1 = *(const u32x4*)(pr + ck + 8 * (c ^ 4));
    if (OUT) { R.q0 = *(const u32x4*)(pr + cq + 8 * c); R.q1 = *(const u32x4*)(pr + cq + 8 * (c ^ 4)); }
    { const float* cp = F.rotc() + (row0 + s) * 32 + (c & 3) * 8; const float* sp = F.rots() + (row0 + s) * 32 + (c & 3) * 8;
      R.c0 = *(const f32x4*)cp; R.c1 = *(const f32x4*)(cp + 4); R.s0 = *(const f32x4*)sp; R.s1 = *(const f32x4*)(sp + 4); }
    R.gr0 = *(const u32x4*)(pr + C_GR); R.gr1 = *(const u32x4*)(pr + C_GR + 8);
    R.v0 = *(const u32x4*)(F.PROJ() + (row0 + (F.tid >> 4)) * NIN + cv + (F.tid & 15) * 8);
    R.v1 = *(const u32x4*)(F.PROJ() + (row0 + 32 + (F.tid >> 4)) * NIN + cv + (F.tid & 15) * 8);
    if (OUT) { R.g0 = *(const u32x4*)(pr + cg + 16 * c); R.g1 = *(const u32x4*)(pr + cg + 16 * c + 8);
        const bf16_t* sq = F.SPREV() + (size_t)unit * 8192 + (size_t)(16 * F.wave + (F.lane & 15)) * 64 + 8 * (F.lane >> 4);
        R.sp0 = *(const bf16x8*)sq; R.sp1 = *(const bf16x8*)(sq + 32); }
}
__device__ __forceinline__ void lin_rot(const u32x4 own_, const u32x4 oth_, const LinRaw& R, bool rot, bool hi, float scale, float (&v)[8]) {
    float own[8]; unpack8(own_, own);
    if (!rot) {
#pragma unroll
        for (int j = 0; j < 8; ++j) v[j] = own[j] * scale;
        return; }
    float oth[8]; unpack8(oth_, oth);
    const float cs[8] = {R.c0.x, R.c0.y, R.c0.z, R.c0.w, R.c1.x, R.c1.y, R.c1.z, R.c1.w}, sn[8] = {R.s0.x, R.s0.y, R.s0.z, R.s0.w, R.s1.x, R.s1.y, R.s1.z, R.s1.w};
#pragma unroll
    for (int j = 0; j < 8; ++j) { const float os = oth[j] * sn[j]; v[j] = (own[j] * cs[j] + (hi ? os : -os)) * scale; }
}
__device__ __forceinline__ void lin_decay(Frame& F, int mixer, int h, const LinRaw& R, float (&bcum)[8], float (&blast)[8]) {
    LAS float* TOT = (LAS float*)(F.lds + LN_TOT);
    const int s = F.tid >> 3, c = F.tid & 7, d0 = 8 * c;
    if (mixer == 0) {
        const float lg = __logf(1.0f - exp2f(-5.0f - (float)h));
#pragma unroll
        for (int j = 0; j < 8; ++j) { bcum[j] = (float)(s + 1) * lg; blast[j] = 64.0f * lg; }
        lds_sync();
        return;
    }
    const LAS float* WG = (const LAS float*)(F.lds + LN_WG);
    float grf[16]; { float a[8], b2[8]; unpack8(R.gr0, a); unpack8(R.gr1, b2);
#pragma unroll
        for (int j = 0; j < 8; ++j) { grf[j] = a[j]; grf[8 + j] = b2[j]; } }
    float x[8]; { const f32x4 b0 = *(const LAS f32x4*)(WG + 1024 + d0), b1 = *(const LAS f32x4*)(WG + 1024 + d0 + 4); x[0] = b0.x; x[1] = b0.y; x[2] = b0.z; x[3] = b0.w; x[4] = b1.x; x[5] = b1.y; x[6] = b1.z; x[7] = b1.w; }
#pragma unroll
    for (int r = 0; r < 16; ++r) { const f32x4 w0 = *(const LAS f32x4*)(WG + r * 64 + d0), w1 = *(const LAS f32x4*)(WG + r * 64 + d0 + 4);
        x[0] += grf[r] * w0.x; x[1] += grf[r] * w0.y; x[2] += grf[r] * w0.z; x[3] += grf[r] * w0.w; x[4] += grf[r] * w1.x; x[5] += grf[r] * w1.y; x[6] += grf[r] * w1.z; x[7] += grf[r] * w1.w; }
#pragma unroll
    for (int j = 0; j < 8; ++j) x[j] = logsigmoidf_(x[j]) * (1.0f / 16.0f);
#pragma unroll
    for (int st = 8; st <= 32; st <<= 1) {
#pragma unroll
        for (int j = 0; j < 8; ++j) { const float t = lane_read(x[j], F.lane - st); if (F.lane >= st) x[j] += t; } }
    if ((F.lane >> 3) == 7) { *(LAS f32x4*)(TOT + F.wave * 64 + d0) = (f32x4){x[0], x[1], x[2], x[3]}; *(LAS f32x4*)(TOT + F.wave * 64 + d0 + 4) = (f32x4){x[4], x[5], x[6], x[7]}; }
    lds_sync();
    float off[8], tot[8];
#pragma unroll
    for (int j = 0; j < 8; ++j) { off[j] = 0.f; tot[j] = 0.f; }
#pragma unroll
    for (int w = 0; w < 8; ++w) { const f32x4 t0 = *(const LAS f32x4*)(TOT + w * 64 + d0), t1 = *(const LAS f32x4*)(TOT + w * 64 + d0 + 4); const float tv[8] = {t0.x, t0.y, t0.z, t0.w, t1.x, t1.y, t1.z, t1.w};
#pragma unroll
        for (int j = 0; j < 8; ++j) { tot[j] += tv[j]; off[j] += (w < F.wave) ? tv[j] : 0.f; } }
#pragma unroll
    for (int j = 0; j < 8; ++j) { bcum[j] = x[j] + off[j]; blast[j] = tot[j]; }
}
__device__ __forceinline__ void lin_store_vt(Frame& F, const LinRaw& R) {
    LAS bf16_t* VT = (LAS bf16_t*)(F.lds + LN_VT); const int e0 = (F.tid & 15) * 8;
#pragma unroll
    for (int i = 0; i < 2; ++i) { const int s = 32 * i + (F.tid >> 4); const u32x4 w = i == 0 ? R.v0 : R.v1;
        VT[(e0 + 0) * LP + s] = (bf16_t)(w.x & 0xffffu); VT[(e0 + 1) * LP + s] = (bf16_t)(w.x >> 16); VT[(e0 + 2) * LP + s] = (bf16_t)(w.y & 0xffffu); VT[(e0 + 3) * LP + s] = (bf16_t)(w.y >> 16);
        VT[(e0 + 4) * LP + s] = (bf16_t)(w.z & 0xffffu); VT[(e0 + 5) * LP + s] = (bf16_t)(w.z >> 16); VT[(e0 + 6) * LP + s] = (bf16_t)(w.w & 0xffffu); VT[(e0 + 7) * LP + s] = (bf16_t)(w.w >> 16); }
}
__device__ __forceinline__ void lin_state_compute(Frame& F, int unit, const LinRaw& R) {
    const int h = (unit >> 6) & 3, mixer = unit >> 11; const int s = F.tid >> 3, c = F.tid & 7, d0 = 8 * c;
    LAS bf16_t* KDT = (LAS bf16_t*)(F.lds + LN_KI); LAS bf16_t* VT = (LAS bf16_t*)(F.lds + LN_VT);
    float k[8], bcum[8], blast[8];
    lin_rot(R.k0, R.k1, R, mixer == 0, c >= 4, mixer == 0 ? 0.125f : 1.0f, k);
    lin_decay(F, mixer, h, R, bcum, blast);
#pragma unroll
    for (int j = 0; j < 8; ++j) KDT[(d0 + j) * LP + s] = (bf16_t)f2bf(k[j] * __expf(blast[j] - bcum[j]));
    lin_store_vt(F, R);
    if (s == 0) { float* dc = F.DEC() + (size_t)unit * 64 + d0;
        *(f32x4*)dc = (f32x4){__expf(blast[0]), __expf(blast[1]), __expf(blast[2]), __expf(blast[3])}; *(f32x4*)(dc + 4) = (f32x4){__expf(blast[4]), __expf(blast[5]), __expf(blast[6]), __expf(blast[7])}; }
    lds_sync();
    { const int w = F.wave, lane = F.lane; float* st = F.STATE() + (size_t)unit * 8192;
#pragma unroll
      for (int dt = 0; dt < 4; ++dt) { f32x4 acc = (f32x4){0.f, 0.f, 0.f, 0.f}; acc = mma_nt_lds(VT + 16 * w * LP, LP, KDT + 16 * dt * LP, LP, 2, acc, lane);
#pragma unroll
          for (int i = 0; i < 4; ++i) st[(16 * w + 4 * (lane >> 4) + i) * 64 + 16 * dt + (lane & 15)] = acc[i]; } }
}
__device__ __forceinline__ void lin_out_compute(Frame& F, int unit, const LinRaw& R) {
    const int n = unit & 63, h = (unit >> 6) & 3, b = (unit >> 8) & 7, mixer = unit >> 11;
    const size_t row0 = (size_t)b * SEQ + (size_t)n * CH; const int s = F.tid >> 3, c = F.tid & 7, d0 = 8 * c;
    const int ycol = (mixer == 0 ? 0 : 1024) + h * 128;
    LAS bf16_t* QD = (LAS bf16_t*)(F.lds + LN_QD); LAS bf16_t* KI = (LAS bf16_t*)(F.lds + LN_KI); LAS bf16_t* PM = (LAS bf16_t*)(F.lds + LN_PM);
    LAS bf16_t* VT = (LAS bf16_t*)(F.lds + LN_VT); LAS float* OB = (LAS float*)(F.lds + LN_OB);
    float q[8], k[8], bcum[8], blast[8];
    lin_rot(R.q0, R.q1, R, mixer == 0, c >= 4, mixer == 0 ? 1.0f : 0.125f, q);
    lin_rot(R.k0, R.k1, R, mixer == 0, c >= 4, mixer == 0 ? 0.125f : 1.0f, k);
    lin_decay(F, mixer, h, R, bcum, blast);
    { float qd[8], ki[8];
#pragma unroll
      for (int j = 0; j < 8; ++j) { qd[j] = q[j] * __expf(bcum[j]); ki[j] = k[j] * __expf(-bcum[j]); }
      *(LAS u32x4*)(QD + s * LP + d0) = pack8(qd); *(LAS u32x4*)(KI + s * LP + d0) = pack8(ki); }
    lin_store_vt(F, R);
    lds_sync();
    { const int lane = F.lane;
#pragma unroll
      for (int j = 0; j < 2; ++j) { const int tile = 2 * F.wave + j, tt = tile >> 2, st = tile & 3;
          f32x4 acc = (f32x4){0.f, 0.f, 0.f, 0.f};
          if (st <= tt) acc = mma_nt_lds(QD + 16 * tt * LP, LP, KI + 16 * st * LP, LP, 2, acc, lane);
#pragma unroll
          for (int i = 0; i < 4; ++i) { const int t = 16 * tt + 4 * (lane >> 4) + i, s2 = 16 * st + (lane & 15); const float p = (st <= tt && s2 <= t) ? acc[i] : 0.f; PM[t * LP + s2] = (bf16_t)f2bf(p); } } }
    lds_sync();
    { const int w = F.wave, lane = F.lane;
#pragma unroll
      for (int tt = 0; tt < 4; ++tt) { f32x4 acc = (f32x4){0.f, 0.f, 0.f, 0.f};
          acc = mma_nt_lds(PM + 16 * tt * LP, LP, VT + 16 * w * LP, LP, 2, acc, lane);
          const LAS bf16_t* xp = QD + (16 * tt + (lane & 15)) * LP + 8 * (lane >> 4);
          acc = __builtin_amdgcn_mfma_f32_16x16x32_bf16(*(const LAS bf16x8*)xp, R.sp0, acc, 0, 0, 0);
          acc = __builtin_amdgcn_mfma_f32_16x16x32_bf16(*(const LAS bf16x8*)(xp + 32), R.sp1, acc, 0, 0, 0);
#pragma unroll
          for (int i = 0; i < 4; ++i) OB[(16 * tt + 4 * (lane >> 4) + i) * 132 + 16 * w + (lane & 15)] = acc[i]; } }
    lds_sync();
    { const int t = s, part = c; float o[16];
#pragma unroll
      for (int j = 0; j < 4; ++j) { const f32x4 v = *(const LAS f32x4*)(OB + t * 132 + 16 * part + 4 * j); o[4 * j] = v.x; o[4 * j + 1] = v.y; o[4 * j + 2] = v.z; o[4 * j + 3] = v.w; }
      float sm = 0.f;
#pragma unroll
      for (int j = 0; j < 16; ++j) sm += o[j];
      sm += lane_read(sm, F.lane ^ 1); sm += lane_read(sm, F.lane ^ 2); sm += lane_read(sm, F.lane ^ 4);
      const float mu = sm * (1.0f / 128.0f); float qv = 0.f;
#pragma unroll
      for (int j = 0; j < 16; ++j) { const float dlt = o[j] - mu; qv += dlt * dlt; }
      qv += lane_read(qv, F.lane ^ 1); qv += lane_read(qv, F.lane ^ 2); qv += lane_read(qv, F.lane ^ 4);
      const float r = 1.0f / sqrtf(qv * (1.0f / 128.0f) + EPS);
      float g0[8], g1[8]; unpack8(R.g0, g0); unpack8(R.g1, g1);
      float y0[8], y1[8];
#pragma unroll
      for (int j = 0; j < 8; ++j) { y0[j] = (o[j] - mu) * r * siluf_(g0[j]); y1[j] = (o[8 + j] - mu) * r * siluf_(g1[j]); }
      bf16_t* yp = F.Y() + (row0 + t) * D + ycol + 16 * part; *(u32x4*)yp = pack8(y0); *(u32x4*)(yp + 8) = pack8(y1); }
}
template <bool OUT>
__device__ __forceinline__ void lin_phase(Frame& F, int l) {
    { const int h = (F.vcu >> 6) & 3; LAS float* WG = (LAS float*)(F.lds + LN_WG);
      for (int i = F.tid; i < 16 * 64 + 64; i += NWAVES * 64) WG[i] = (i < 1024) ? F.gla_wg()[(size_t)l * 16 * 256 + (i >> 6) * 256 + h * 64 + (i & 63)] : F.gla_bg()[l * 256 + h * 64 + (i - 1024)];
      lds_sync(); }
    LinRaw A, B;
    lin_issue<OUT>(F, F.vcu, A);
    for (int u = F.vcu; u < 4096; u += 2 * F.G) {
        lin_issue<OUT>(F, u + F.G, B);
        if (OUT) lin_out_compute(F, u, A); else lin_state_compute(F, u, A);
        if (u + 2 * F.G < 4096) lin_issue<OUT>(F, u + 2 * F.G, A);
        if (OUT) lin_out_compute(F, u + F.G, B); else lin_state_compute(F, u + F.G, B);
    }
    lds_sync();
}
__device__ __forceinline__ void lin_scan(Frame& F) {
    const int gt = F.vcu * (NWAVES * 64) + F.tid, NGT = F.G * NWAVES * 64;
    for (int i = gt; i < 64 * 8192; i += NGT) {
        const int seq = i >> 13, idx = i & 8191, d = idx & 63;
        const float* st = F.STATE() + (size_t)seq * NCH * 8192 + idx; const float* dc = F.DEC() + (size_t)seq * NCH * 64 + d; bf16_t* sp = F.SPREV() + (size_t)seq * NCH * 8192 + idx;
        float carry = 0.f; asm volatile("" : "+v"(carry));
#pragma unroll
        for (int h = 0; h < 2; ++h) {
            float v[32], c[32];
#pragma unroll
            for (int n = 0; n < 32; ++n) { v[n] = st[(size_t)(32 * h + n) * 8192]; c[n] = dc[(size_t)(32 * h + n) * 64]; }
#pragma unroll
            for (int n = 0; n < 32; ++n) { sp[(size_t)(32 * h + n) * 8192] = (bf16_t)f2bf(carry); carry = c[n] * carry + v[n]; asm volatile("" : "+v"(carry)); }
        }
    }
}
constexpr int S5_WL = 16384, S5_BU = 2048, S5_X = 2048 + 8320;
template <bool OUT>
__device__ __forceinline__ void s5_pass(Frame& F, int l) {
    LAS bf16_t* UT = (LAS bf16_t*)(F.lds + F.wave * S5_WL); LAS float* BU = (LAS float*)(F.lds + F.wave * S5_WL + S5_BU); LAS bf16_t* X = (LAS bf16_t*)(F.lds + F.wave * S5_WL + S5_X);
    const int gw = F.vcu * NWAVES + F.wave, NGW = F.G * NWAVES, lane = F.lane, lr = lane & 15, lq = lane >> 4;
    u32x4 ua, uc;
    { const int g = gw & 31, n = (gw >> 5) & 63, b = gw >> 11; const bf16_t* up = F.PROJ() + ((size_t)b * SEQ + (size_t)n * CH + lane) * NIN + C_SU + g * 16; ua = *(const u32x4*)up; uc = *(const u32x4*)(up + 8); }
    for (int unit = gw; unit < BATCH * NCH * 32; unit += NGW) {
        const int g = unit & 31, n = (unit >> 5) & 63, b = unit >> 11; const size_t row0 = (size_t)b * SEQ + (size_t)n * CH;
        *(LAS u32x4*)(UT + lane * 16) = ua; *(LAS u32x4*)(UT + lane * 16 + 8) = uc;
        if (unit + NGW < BATCH * NCH * 32) { const int un = unit + NGW, g2 = un & 31, n2 = (un >> 5) & 63, b2 = un >> 11;
            const bf16_t* up = F.PROJ() + ((size_t)b2 * SEQ + (size_t)n2 * CH + lane) * NIN + C_SU + g2 * 16; ua = *(const u32x4*)up; uc = *(const u32x4*)(up + 8); }
        const int gp = g * 64 + lane; const float ar = F.abar()[2 * gp], ai = F.abar()[2 * gp + 1];
        bf16x8 bfr[8];
#pragma unroll
        for (int q = 0; q < 8; ++q) { bfr[q] = (bf16x8){0, 0, 0, 0, 0, 0, 0, 0}; if (lq < 2) bfr[q] = *(const bf16x8*)(F.bbt() + ((size_t)g * 128 + 16 * q + lr) * 16 + 8 * lq); }
        float xr = 0.f, xi = 0.f;
        bf16x8 cf[4]; float dsk = 0.f;
        if (OUT) { const f32x2 x0 = *(const f32x2*)(F.XEND() + ((((size_t)(b * 32 + g)) * NCH + n) * 64 + lane) * 2); xr = x0.x; xi = x0.y;
#pragma unroll
            for (int ks = 0; ks < 4; ++ks) cf[ks] = *(const bf16x8*)(F.cmt() + ((size_t)(g * 16 + lr)) * 128 + 32 * ks + 8 * lq);
            dsk = F.s5_d()[(size_t)l * BW + g * 16 + lr]; }
        LDS_WAIT();
        for (int sb = 0; sb < 4; ++sb) {
            bf16x8 af = (bf16x8){0, 0, 0, 0, 0, 0, 0, 0}; if (lq < 2) af = *(const LAS bf16x8*)(UT + (16 * sb + lr) * 16 + 8 * lq);
#pragma unroll
            for (int q = 0; q < 8; ++q) { f32x4 acc = (f32x4){0.f, 0.f, 0.f, 0.f}; acc = __builtin_amdgcn_mfma_f32_16x16x32_bf16(af, bfr[q], acc, 0, 0, 0);
#pragma unroll
                for (int i = 0; i < 4; ++i) BU[(4 * lq + i) * 130 + 16 * q + lr] = acc[i]; }
            LDS_WAIT();
            float br[16], bi[16];
#pragma unroll
            for (int tt = 0; tt < 16; ++tt) { br[tt] = BU[tt * 130 + lane]; bi[tt] = BU[tt * 130 + 64 + lane]; }
#pragma unroll
            for (int tt = 0; tt < 16; ++tt) { const float nr = ar * xr - ai * xi + br[tt], ni = ar * xi + ai * xr + bi[tt]; xr = nr; xi = ni; asm volatile("" : "+v"(xr), "+v"(xi));
                if (OUT) { X[tt * 136 + lane] = (bf16_t)f2bf(xr); X[tt * 136 + 64 + lane] = (bf16_t)f2bf(xi); } }
            if (OUT) {
                LDS_WAIT();
                f32x4 acc = (f32x4){0.f, 0.f, 0.f, 0.f}; const LAS bf16_t* xp = X + lr * 136 + 8 * lq;
#pragma unroll
                for (int ks = 0; ks < 4; ++ks) acc = __builtin_amdgcn_mfma_f32_16x16x32_bf16(*(const LAS bf16x8*)(xp + 32 * ks), cf[ks], acc, 0, 0, 0);
#pragma unroll
                for (int i = 0; i < 4; ++i) { const int tl = 16 * sb + 4 * lq + i; const float u = bflo((unsigned)UT[tl * 16 + lr]); const float y = gelu_tanh(acc[i] + dsk * u);
                    F.YBP()[(row0 + tl) * BW + g * 16 + lr] = (bf16_t)f2bf(y); }
            }
            LDS_WAIT();
        }
        if (!OUT) *(f32x2*)(F.XEND() + ((((size_t)(b * 32 + g)) * NCH + n) * 64 + lane) * 2) = (f32x2){xr, xi};
    }
}
__device__ __forceinline__ void s5_scan(Frame& F) {
    const int gt = F.vcu * (NWAVES * 64) + F.tid, NGT = F.G * NWAVES * 64;
    for (int i = gt; i < BATCH * 32 * 64; i += NGT) {
        const int p = i & 63, bg = i >> 6, g = bg & 31; const float pr = F.apow()[2 * (g * 64 + p)], pi = F.apow()[2 * (g * 64 + p) + 1];
        f32x2* xp = (f32x2*)(F.XEND() + (((size_t)bg * NCH) * 64 + p) * 2);
        float cr = 0.f, ci = 0.f; asm volatile("" : "+v"(cr), "+v"(ci));
#pragma unroll
        for (int h = 0; h < 2; ++h) {
            f32x2 v[32];
#pragma unroll
            for (int n = 0; n < 32; ++n) v[n] = xp[(size_t)(32 * h + n) * 64];
#pragma unroll
            for (int n = 0; n < 32; ++n) { xp[(size_t)(32 * h + n) * 64] = (f32x2){cr, ci};
                const float nr = pr * cr - pi * ci + v[n].x, ni = pr * ci + pi * cr + v[n].y; cr = nr; ci = ni; asm volatile("" : "+v"(cr), "+v"(ci)); }
        }
    }
}

__device__ __forceinline__ void pool_phase(Frame& F, int l) {
    const int gw = F.vcu * NWAVES + F.wave, NGW = F.G * NWAVES, lane = F.lane, lr = lane & 15, lq = lane >> 4;
    for (int unit = gw; unit < BATCH * (SEQ / 16) * 4; unit += NGW) {
        const int g = unit & 3, tile = (unit >> 2) & 255, b = unit >> 10; const int win = 2 << g, tpos = 16 * tile + lr; const size_t row = (size_t)b * SEQ + tpos;
        const bf16_t* pp = F.PROJ() + row * NIN + C_PU + g * 128 + 8 * lq;
        float s[4][8];
#pragma unroll
        for (int ks = 0; ks < 4; ++ks)
#pragma unroll
            for (int j = 0; j < 8; ++j) s[ks][j] = 0.f;
        for (int jj = 1; jj < win; ++jj) { if (tpos - jj >= 0) {
#pragma unroll
            for (int ks = 0; ks < 4; ++ks) { float a[8]; unpack8(*(const u32x4*)(pp - (size_t)jj * NIN + 32 * ks), a);
#pragma unroll
                for (int j = 0; j < 8; ++j) s[ks][j] += a[j]; } } }
        const float inv = 1.0f / (float)min(tpos + 1, win);
        bf16x8 mf[4];
#pragma unroll
        for (int ks = 0; ks < 4; ++ks) { float a[8], m[8]; unpack8(*(const u32x4*)(pp + 32 * ks), a);
#pragma unroll
            for (int j = 0; j < 8; ++j) m[j] = (s[ks][j] + a[j]) * inv - a[j];
            const u32x4 w = pack8(m); mf[ks] = __builtin_bit_cast(bf16x8, w); }
        const bf16_t* pw = F.poolw_t() + (size_t)g * 128 * 128 + (size_t)lr * 128 + 8 * lq;
#pragma unroll
        for (int q = 0; q < 8; ++q) { f32x4 acc = (f32x4){0.f, 0.f, 0.f, 0.f};
#pragma unroll
            for (int ks = 0; ks < 4; ++ks) acc = __builtin_amdgcn_mfma_f32_16x16x32_bf16(*(const bf16x8*)(pw + (size_t)(16 * q) * 128 + 32 * ks), mf[ks], acc, 0, 0, 0);
            const int dcol = g * 128 + 16 * q + 4 * lq; const f32x4 sc = *(const f32x4*)(F.pool_scale() + (size_t)l * BW + dcol);
            u32x2 w; w.x = pk2(acc[0] * sc.x, acc[1] * sc.y); w.y = pk2(acc[2] * sc.z, acc[3] * sc.w);
            *(u32x2*)(F.Y() + row * D + 1536 + dcol) = w; }
    }
}

__device__ __forceinline__ void conv_fix_phase(Frame& F, int l) {
    const float* cw = F.conv_w() + (size_t)l * 3 * NUP; const float* cb = F.conv_b() + (size_t)l * NUP; const float* UH = F.UH();
    const int gt = F.vcu * (NWAVES * 64) + F.tid, NGT = F.G * NWAVES * 64;
    constexpr int JG = DFF / 4;
    for (int task = gt; task < (M / 256) * 2 * JG; task += NGT) {
        const int jg = task % JG, q = (task / JG) & 1, pm = task / (2 * JG);
        if ((pm & 15) == 0) continue;
        const int j0 = jg * 4, ucol = 256 * (j0 >> 7) + (j0 & 127);
        const float* u0p = UH + ((size_t)pm * 4 + q) * NUP + ucol;
        const float* u1p = (q == 1) ? UH + ((size_t)pm * 4 + 0) * NUP + ucol : UH + ((size_t)(pm - 1) * 4 + 3) * NUP + ucol;
        const float* u2p = (q == 1) ? UH + ((size_t)(pm - 1) * 4 + 3) * NUP + ucol : UH + ((size_t)(pm - 1) * 4 + 2) * NUP + ucol;
        const f32x4 a0 = *(const f32x4*)u0p, a1 = *(const f32x4*)u1p, a2 = *(const f32x4*)u2p, v0 = *(const f32x4*)(u0p + 128), v1 = *(const f32x4*)(u1p + 128), v2 = *(const f32x4*)(u2p + 128);
        const f32x4 wa0 = *(const f32x4*)(cw + j0), wa1 = *(const f32x4*)(cw + NUP + j0), wa2 = *(const f32x4*)(cw + 2 * NUP + j0), ba = *(const f32x4*)(cb + j0);
        const f32x4 wv0 = *(const f32x4*)(cw + DFF + j0), wv1 = *(const f32x4*)(cw + NUP + DFF + j0), wv2 = *(const f32x4*)(cw + 2 * NUP + DFF + j0), bv = *(const f32x4*)(cb + DFF + j0);
        float o[4];
#pragma unroll
        for (int i = 0; i < 4; ++i) { const float ca = ba[i] + wa0[i] * a2[i] + wa1[i] * a1[i] + wa2[i] * a0[i], cv = bv[i] + wv0[i] * v2[i] + wv1[i] * v1[i] + wv2[i] * v0[i]; o[i] = siluf_(ca) * cv; }
        u32x2 w; w.x = pk2(o[0], o[1]); w.y = pk2(o[2], o[3]);
        *(u32x2*)(F.ACT() + ((size_t)pm * 256 + q) * DFF + j0) = w;
    }
}

constexpr int NPH = 13;
struct Args { const void* in[25]; float* out; unsigned char* ws; int l_lo, l_hi, ph_lo, ph_hi, single, pad; };
__global__ void __launch_bounds__(NWAVES * 64, 2) hybrid_fwd(Args args) {
    extern __shared__ __attribute__((aligned(16))) unsigned char lds[];
    Frame F;
    F.lds = (LAS unsigned char*)lds;
    F.tid = threadIdx.x; F.lane = F.tid & 63; F.wave = __builtin_amdgcn_readfirstlane(F.tid >> 6);
    const int wave0 = F.wave;
    F.G = gridDim.x; { const int bx = blockIdx.x; F.vcu = (F.G % 8 == 0) ? (bx % 8) * (F.G / 8) + bx / 8 : bx; }
    unsigned char* ws = args.ws; F.ws = ws; F.out = args.out; F.l = 0;

    volatile LAS unsigned* MISC = (volatile LAS unsigned*)(F.lds + MISC_OFF);
    if (F.tid < 64) MISC[F.tid] = 0u;
    wg_sync();
    unsigned* ctl = (unsigned*)(ws + WS_CTL);
    XcdBarrier bar; bar.bar = ctl + CW_BAR; bar.x = 0; bar.st = nullptr;
    if (args.single) bar = xcd_barrier_post(ctl + CW_BAR, MISC);
#define GRID_BAR() do { if (args.single) xcd_barrier(bar); } while (0)
    const int lo = args.ph_lo, hi = args.ph_hi;
#define IN(k) (lo <= (k) && (k) < hi)
#define PH_BEGIN() do { unsigned z_ = 0u; asm volatile("" : "+v"(z_)); const int ln_ = (int)__builtin_amdgcn_mbcnt_hi(~0u, __builtin_amdgcn_mbcnt_lo(~0u, z_)); F.lane = ln_; F.tid = wave0 * 64 + ln_; F.wave = wave0; unsigned long long w_ = (unsigned long long)args.ws, o_ = (unsigned long long)args.out; asm volatile("" : "+s"(w_), "+s"(o_)); F.ws = (unsigned char*)(GAS unsigned char*)w_; F.out = (float*)(GAS float*)o_; } while (0)

    for (int l = args.l_lo; l < args.l_hi; ++l) {
        F.l = l;
        if (IN(0)) { PH_BEGIN(); phase_prep(F, l); GRID_BAR(); }
        if (IN(1)) { PH_BEGIN();
            { pg8::Gemm g{(const bf16_t*)F.HN8(), (const bf16_t*)F.W8(), M, 4 * D, D / 2, D / 2, D / 2}; pg8::StaticOrder S; S.init(M, 4 * D, F.G, (int)blockIdx.x); pg8::EpiProj E{F.PROJ(), NIN, 0, C_GATE, 1.0f / 64.0f};
              pg8::gemm_phase<pg8::EpiProj, true>(F.lds, g, S, E, F.tid); }
            PH_BEGIN();
            { pg8::Gemm g{F.HN(), F.win_t(), M, C_GATE, D, D, D}; pg8::StaticOrder S; S.init(M, C_GATE, F.G, (int)blockIdx.x); pg8::EpiProj E{F.PROJ(), NIN, 1 << 20, C_GATE, 1.0f};
              pg8::gemm_phase(F.lds, g, S, E, F.tid); }
            GRID_BAR(); }
        if (IN(2)) { PH_BEGIN(); lin_phase<false>(F, l); PH_BEGIN();
            s5_pass<false>(F, l); pool_phase(F, l); wg_sync();
            GRID_BAR(); }
        if (IN(3)) { PH_BEGIN(); lin_scan(F); s5_scan(F); GRID_BAR(); }
        if (IN(4)) { PH_BEGIN(); lin_phase<true>(F, l); PH_BEGIN();
            s5_pass<true>(F, l); wg_sync();
            GRID_BAR(); }
        if (IN(5)) { PH_BEGIN(); pg8::Gemm g{F.YBP(), F.wglu_t(), M, BW, BW, BW, BW}; pg8::StaticOrder S; S.init(M, BW, F.G, (int)blockIdx.x); pg8::EpiGlu E{F.YBP(), BW, F.Y() + BW, D};
            pg8::gemm_phase(F.lds, g, S, E, F.tid); GRID_BAR(); }
        if (IN(6)) { PH_BEGIN(); pg8::Gemm g{F.Y(), F.wbr_t(), M, D, D, D, D}; pg8::StaticOrder S; S.init(M, D, F.G, (int)blockIdx.x); pg8::EpiMerge E{F.PROJ() + C_GATE, NIN, F.HN(), D};
            pg8::gemm_phase(F.lds, g, S, E, F.tid); GRID_BAR(); }
        if (IN(7)) { PH_BEGIN(); for (int i = 0; i < (F.vcu & 7); ++i) __builtin_amdgcn_s_sleep(50);
            pg8::Gemm g{F.HN(), F.wout_t(), M, D, D, D, D}; pg8::StaticOrder S; S.init(M, D, F.G, (int)blockIdx.x); pg8::EpiResid E{l == 0 ? (const void*)F.x() : (const void*)F.out, l == 0 ? 1 : 0, F.Y(), D, F.SS()};
            pg8::gemm_phase(F.lds, g, S, E, F.tid); GRID_BAR(); }
        if (IN(8)) { PH_BEGIN(); row_scale(F); GRID_BAR(); }
        if (IN(9)) { PH_BEGIN(); pg8::Gemm g{F.Y(), F.wup_t(), M, NUP, D, D, D}; pg8::StaticOrder S; S.init(M, NUP, F.G, (int)blockIdx.x); pg8::EpiConv E{F.conv_w() + (size_t)l * 3 * NUP, F.conv_b() + (size_t)l * NUP, F.ACT(), F.UH(), (LAS float*)(F.lds + pg8::STAGE_BYTES), F.RS()};
            pg8::gemm_phase(F.lds, g, S, E, F.tid); GRID_BAR(); }
        if (IN(10)) { PH_BEGIN(); conv_fix_phase(F, l); GRID_BAR(); }
        if (IN(11)) { PH_BEGIN(); for (int i = 0; i < (F.vcu & 7); ++i) __builtin_amdgcn_s_sleep(50);
            pg8::Gemm g{F.ACT(), F.wdn_t(), M, D, DFF, DFF, DFF}; pg8::StaticOrder S; S.init(M, D, F.G, (int)blockIdx.x); pg8::EpiResid E{(const void*)F.Y(), 0, l == DEPTH - 1 ? F.HN() : (bf16_t*)F.out, D, nullptr};
            pg8::gemm_phase(F.lds, g, S, E, F.tid); GRID_BAR(); }
        if (IN(12) && l == DEPTH - 1) { PH_BEGIN(); rms_rows16_to_f32(F, F.HN(), F.g_final(), F.out); }
    }
#undef IN
#undef PH_BEGIN
#undef GRID_BAR
}

#pragma clang attribute pop
extern "C" void kernel_launch(void* const* d_in, const int* in_sizes, int n_in, void* d_out, int out_size, void* d_ws, size_t ws_size, hipStream_t stream) {
    static int grid = 0;
    if (grid == 0) {
        if (n_in != 25 || in_sizes[0] != M * D || out_size != M * D || ws_size < WS_END) { fprintf(stderr, "kernel_launch: shape/workspace mismatch (n_in %d, in0 %d, out %d, ws %zu, need %zu); nothing launched\n", n_in, n_in > 0 ? in_sizes[0] : -1, out_size, ws_size, (size_t)WS_END); grid = -1; return; }
        int dev = 0, cus = 0, per_cu = 0;
        if (hipGetDevice(&dev) != hipSuccess || hipDeviceGetAttribute(&cus, hipDeviceAttributeMultiprocessorCount, dev) != hipSuccess) { grid = -1; return; }
        if (hipFuncSetAttribute((const void*)hybrid_fwd, hipFuncAttributeMaxDynamicSharedMemorySize, LDS_BYTES) != hipSuccess) { fprintf(stderr, "kernel_launch: hipFuncSetAttribute failed\n"); grid = -1; return; }
        if (hipOccupancyMaxActiveBlocksPerMultiprocessor(&per_cu, (const void*)hybrid_fwd, NWAVES * 64, LDS_BYTES) != hipSuccess || per_cu < 1) { fprintf(stderr, "kernel_launch: occupancy query reports %d workgroups per CU\n", per_cu); }
        (void)hipGetLastError();
        grid = cus;
    }
    if (grid < 0) return;
    if (hipMemsetAsync((char*)d_ws + WS_CTL, 0, CTL_ZERO_BYTES, stream) != hipSuccess) return;
    Args a{};
    for (int i = 0; i < 25; ++i) a.in[i] = d_in[i];
    a.out = (float*)d_out; a.ws = (unsigned char*)d_ws;
#if MK_SINGLE
    a.l_lo = 0; a.l_hi = DEPTH; a.ph_lo = 0; a.ph_hi = NPH; a.single = 1;
    hipLaunchKernelGGL(hybrid_fwd, dim3(grid), dim3(NWAVES * 64), LDS_BYTES, stream, a);
#else
    a.single = 0;
    for (int l = 0; l < DEPTH; ++l)
        for (int p = 0; p < NPH; ++p) { if (p == 12 && l != DEPTH - 1) continue; a.l_lo = l; a.l_hi = l + 1; a.ph_lo = p; a.ph_hi = p + 1;
            hipLaunchKernelGGL(hybrid_fwd, dim3(grid), dim3(NWAVES * 64), LDS_BYTES, stream, a); }
#endif
}
```

```cpp
#include <hip/hip_runtime.h>
#include <cstdio>
#include <cstdint>

#ifndef MK_SINGLE
#define MK_SINGLE 1
#endif

#pragma clang attribute push(__attribute__((target("no-packed-fp32-ops"))), apply_to = function)
#define LAS __attribute__((address_space(3)))
#define GAS __attribute__((address_space(1)))
typedef unsigned short bf16_t;
typedef short bf16x8 __attribute__((ext_vector_type(8)));
typedef float f32x4 __attribute__((ext_vector_type(4)));
typedef float f32x2 __attribute__((ext_vector_type(2)));
typedef unsigned u32x4 __attribute__((ext_vector_type(4)));
typedef unsigned u32x2 __attribute__((ext_vector_type(2)));

constexpr int D = 2048, BATCH = 8, SEQ = 4096, DEPTH = 4, M = BATCH * SEQ;
constexpr int BW = 512;
constexpr int NIN_SRC = 12304, NIN = 12544;
constexpr int DFF = 5504, NUP = 11008;
constexpr int C_RQ = 0, C_RK = 256, C_RV = 512, C_RG = 1024, C_SU = 1536, C_GQ = 2048, C_GK = 2304, C_GV = 2560, C_GG = 3072, C_PU = 3584, C_GR = 4096, C_GATE = 4352;
constexpr float EPS = 1e-6f;
constexpr int NWAVES = 8;
constexpr int CH = 64;
constexpr int NCH = SEQ / CH;

constexpr size_t MiB = 1u << 20;
constexpr size_t WS_CTL = 0, CTL_ZERO_BYTES = 1 * MiB;
constexpr size_t WS_ROT = 1 * MiB;
constexpr size_t WS_S5T = 9 * MiB;
constexpr size_t S5T_ABAR = 0, S5T_APOW = 16384, S5T_BBAR = 32768, S5T_CMT = 32768 + 262144, S5T_BBT = S5T_CMT + 131072;
constexpr size_t WS_WGLU = 10 * MiB;
constexpr size_t WS_POOLW = 10 * MiB + 512 * 1024;
constexpr size_t WS_WIN = 11 * MiB;
constexpr size_t WS_WBR = 60 * MiB;
constexpr size_t WS_WOUT = 68 * MiB;
constexpr size_t WS_WUP = 76 * MiB;
constexpr size_t WS_WDN = 119 * MiB;
constexpr size_t WS_HN = 141 * MiB;
constexpr size_t WS_Y = 269 * MiB;
constexpr size_t WS_SCR = 397 * MiB;
constexpr size_t WS_YBP = WS_SCR;
constexpr size_t WS_STATE = WS_SCR + 32 * MiB;
constexpr size_t WS_SPREV = WS_SCR + 160 * MiB;
constexpr size_t WS_DEC = WS_SCR + 224 * MiB;
constexpr size_t WS_XEND = WS_SCR + 225 * MiB;
constexpr size_t WS_UH = WS_SCR + 128 * MiB;
constexpr size_t WS_PROJ = 637 * MiB;
constexpr size_t WS_ACT = WS_PROJ;
constexpr size_t WS_RS = 1421 * MiB;
constexpr size_t WS_SS = 1422 * MiB;
constexpr size_t WS_HN8 = 1438 * MiB;
constexpr size_t WS_W8 = 1502 * MiB;
constexpr size_t WS_END = 1518 * MiB;
static_assert(WS_PROJ + (size_t)M * NIN * 2 <= WS_RS, "ws map");
static_assert(WS_ACT + (size_t)M * DFF * 2 <= WS_RS, "ws map");
static_assert(WS_XEND + 8 * MiB <= WS_PROJ, "ws map");
static_assert(WS_UH + (size_t)(M / 256) * 4 * NUP * 4 <= WS_PROJ, "ws map");
constexpr int CW_TMO = 0, CW_BAR = 4096;

constexpr int LDS_BYTES = 155648;
constexpr int MISC_OFF = LDS_BYTES - 256;

#define RLX_AGENT __ATOMIC_RELAXED, __HIP_MEMORY_SCOPE_AGENT
__device__ __forceinline__ void lds_sync() { asm volatile("s_waitcnt lgkmcnt(0)" ::: "memory"); __builtin_amdgcn_s_barrier(); asm volatile("" ::: "memory"); }
__device__ __forceinline__ void wg_sync() { __builtin_amdgcn_fence(__ATOMIC_RELEASE, "workgroup"); __builtin_amdgcn_s_barrier(); __builtin_amdgcn_fence(__ATOMIC_ACQUIRE, "workgroup"); }
#define LDS_WAIT() asm volatile("s_waitcnt lgkmcnt(0)" ::: "memory")
#define VM_WAIT() asm volatile("s_waitcnt vmcnt(0)" ::: "memory")
__device__ __forceinline__ unsigned f2bf(float f) { unsigned u = __builtin_bit_cast(unsigned, f); return (u + 0x7fffu + ((u >> 16) & 1u)) >> 16; }
__device__ __forceinline__ unsigned pk2(float lo, float hi) { return f2bf(lo) | (f2bf(hi) << 16); }
__device__ __forceinline__ float bflo(unsigned w) { return __builtin_bit_cast(float, w << 16); }
__device__ __forceinline__ float bfhi(unsigned w) { return __builtin_bit_cast(float, w & 0xffff0000u); }
__device__ __forceinline__ void unpack8(const u32x4 w, float (&v)[8]) { v[0] = bflo(w.x); v[1] = bfhi(w.x); v[2] = bflo(w.y); v[3] = bfhi(w.y); v[4] = bflo(w.z); v[5] = bfhi(w.z); v[6] = bflo(w.w); v[7] = bfhi(w.w); }
__device__ __forceinline__ u32x4 pack8(const float (&v)[8]) { u32x4 w; w.x = pk2(v[0], v[1]); w.y = pk2(v[2], v[3]); w.z = pk2(v[4], v[5]); w.w = pk2(v[6], v[7]); return w; }
__device__ __forceinline__ unsigned pk4_fp8(float a, float b, float c, float d) { unsigned w = 0u; w = __builtin_amdgcn_cvt_pk_fp8_f32(a, b, w, false); w = __builtin_amdgcn_cvt_pk_fp8_f32(c, d, w, true); return w; }
__device__ __forceinline__ float sigmoidf_(float x) { return 1.0f / (1.0f + __expf(-x)); }
__device__ __forceinline__ float siluf_(float x) { return x / (1.0f + __expf(-x)); }
__device__ __forceinline__ float gelu_tanh(float x) { const float u = 1.5957691216f * (x + 0.044715f * x * x * x); return x / (1.0f + __expf(-u)); }
__device__ __forceinline__ float logsigmoidf_(float x) { return fminf(x, 0.f) - __logf(1.0f + __expf(-fabsf(x))); }

namespace pg8 {
constexpr int BM = 256, BK = 64, HALF = 128, HTB = HALF * BK * 2, STAGE_BYTES = 8 * HTB, NXCD = 8, WGM = 4;
__host__ __device__ __forceinline__ int lds_byte(int r, int c) { const int st = (r >> 4) * 2 + (c >> 5), rr = r & 15, cc = c & 31, ob = rr * 64 + cc * 2; return st * 1024 + (ob ^ (((ob >> 9) & 1) << 5)); }
__host__ __device__ __forceinline__ void stage_rc(int b, int& R, int& C) { const int st = b / 1024, sb = b % 1024, swz = sb ^ (((sb >> 9) & 1) << 5); R = (st >> 1) * 16 + swz / 64; C = (st & 1) * 32 + (swz % 64) / 2; }
__host__ __device__ __forceinline__ int perm32(int rho) { const int n = rho >> 4, i = rho & 15; return 8 * (i >> 2) + 4 * n + (i & 3); }

struct Unit { int pm, pn; };
struct Gemm { const bf16_t* A; const bf16_t* Bt; int M, N, K, lda, ldb; };

struct StaticOrder {
    int nM, nN, nwg, G, c;
    __host__ __device__ void init(int M_, int N_, int G_, int c_) { nM = M_ / BM; nN = N_ / BM; nwg = nM * nN; G = G_; c = c_; }
    __host__ __device__ bool next(int i, Unit& u) const {
        const long L = (long)i * G + c; if (L >= nwg) return false;
        int wgid = (int)L; { const int q = nwg / NXCD, r = nwg % NXCD, xcd = wgid % NXCD, off = wgid / NXCD; wgid = (xcd < r ? xcd * (q + 1) : r * (q + 1) + (xcd - r) * q) + off; }
        const int nig = WGM * nN, gid = wgid / nig, fm = gid * WGM, gsz = (nM - fm) < WGM ? (nM - fm) : WGM;
        u.pm = fm + ((wgid % nig) % gsz); u.pn = (wgid % nig) / gsz; return true;
    }
};

__device__ __forceinline__ unsigned cvt_pk_bf16(float lo, float hi) { unsigned r; asm volatile("v_cvt_pk_bf16_f32 %0, %1, %2" : "=v"(r) : "v"(lo), "v"(hi)); return r; }

struct EpiStoreBf16 {
    static constexpr bool PERM = true, KHOOK = false;
    bf16_t* O; int ldc;
    __device__ __forceinline__ void khook(f32x4 (&)[2][2][4][2], const Unit&, int, int, int, int, int) const {}
    __device__ __forceinline__ void operator()(f32x4 (&acc)[2][2][4][2], const Unit& u, int wr, int wc, int fr, int fq) const {
        const int row0 = u.pm * BM + wr * 64 + fr, col0 = u.pn * BM + wc * 32 + 8 * fq;
#pragma unroll
        for (int ai = 0; ai < 2; ++ai)
#pragma unroll
            for (int m = 0; m < 4; ++m) { bf16_t* rowp = O + (size_t)(row0 + ai * HALF + m * 16) * ldc + col0;
#pragma unroll
                for (int bj = 0; bj < 2; ++bj) { const f32x4 v0 = acc[ai][bj][m][0], v1 = acc[ai][bj][m][1];
                    u32x4 w; w.x = cvt_pk_bf16(v0[0], v0[1]); w.y = cvt_pk_bf16(v0[2], v0[3]); w.z = cvt_pk_bf16(v1[0], v1[1]); w.w = cvt_pk_bf16(v1[2], v1[3]);
                    *(u32x4*)(rowp + bj * HALF) = w; } }
    }
};
struct EpiProj {
    static constexpr bool PERM = true, KHOOK = false;
    bf16_t* O; int ldc; int gate_pn0; int gate_col0; float gscale;
    __device__ __forceinline__ void khook(f32x4 (&)[2][2][4][2], const Unit&, int, int, int, int, int) const {}
    __device__ __forceinline__ void operator()(f32x4 (&acc)[2][2][4][2], const Unit& u, int wr, int wc, int fr_, int fq_) const {
        int fr = fr_, fq = fq_; asm volatile("" : "+v"(fr), "+v"(fq));
        const int row0 = u.pm * BM + wr * 64 + fr;
        if (u.pn < gate_pn0) {
            const int col0 = u.pn * BM + wc * 32 + 8 * fq;
#pragma unroll
            for (int ai = 0; ai < 2; ++ai)
#pragma unroll
                for (int m = 0; m < 4; ++m) { bf16_t* rowp = O + (size_t)(row0 + ai * HALF + m * 16) * ldc + col0;
#pragma unroll
                    for (int bj = 0; bj < 2; ++bj) { const f32x4 v0 = acc[ai][bj][m][0], v1 = acc[ai][bj][m][1];
                        u32x4 w; w.x = cvt_pk_bf16(v0[0], v0[1]); w.y = cvt_pk_bf16(v0[2], v0[3]); w.z = cvt_pk_bf16(v1[0], v1[1]); w.w = cvt_pk_bf16(v1[2], v1[3]);
                        *(u32x4*)(rowp + bj * HALF) = w; } }
        } else {
            const int col0 = gate_col0 + 64 * (u.pn - gate_pn0) + 16 * wc + 4 * fq;
#pragma unroll
            for (int ai = 0; ai < 2; ++ai)
#pragma unroll
                for (int m = 0; m < 4; ++m) { bf16_t* rowp = O + (size_t)(row0 + ai * HALF + m * 16) * ldc + col0;
                    float r1[4], r2[4], r3[4], g3[4];
#pragma unroll
                    for (int i = 0; i < 4; ++i) {
                        const float e0 = __expf(-fminf(fmaxf(acc[ai][0][m][0][i] * gscale, -30.f), 30.f)), e1 = __expf(-fminf(fmaxf(acc[ai][0][m][1][i] * gscale, -30.f), 30.f));
                        const float e2 = __expf(-fminf(fmaxf(acc[ai][1][m][0][i] * gscale, -30.f), 30.f)), e3 = __expf(-fminf(fmaxf(acc[ai][1][m][1][i] * gscale, -30.f), 30.f));
                        const float i0 = __builtin_amdgcn_rcpf(1.f + e0), i1 = __builtin_amdgcn_rcpf(1.f + e1), i2 = __builtin_amdgcn_rcpf(1.f + e2), i3 = __builtin_amdgcn_rcpf(1.f + e3);
                        r1[i] = (1.f + e1) * i0; r2[i] = (1.f + e2) * i1; r3[i] = (1.f + e3) * i2; g3[i] = i3; }
                    u32x2 w;
                    w.x = cvt_pk_bf16(r1[0], r1[1]); w.y = cvt_pk_bf16(r1[2], r1[3]); *(u32x2*)(rowp) = w;
                    w.x = cvt_pk_bf16(r2[0], r2[1]); w.y = cvt_pk_bf16(r2[2], r2[3]); *(u32x2*)(rowp + D) = w;
                    w.x = cvt_pk_bf16(r3[0], r3[1]); w.y = cvt_pk_bf16(r3[2], r3[3]); *(u32x2*)(rowp + 2 * D) = w;
                    w.x = cvt_pk_bf16(g3[0], g3[1]); w.y = cvt_pk_bf16(g3[2], g3[3]); *(u32x2*)(rowp + 3 * D) = w; }
        }
    }
};
__device__ __forceinline__ float dpp_ror1(float x) { return __builtin_bit_cast(float, __builtin_amdgcn_update_dpp(0, __builtin_bit_cast(int, x), 0x121, 0xf, 0xf, false)); }
__device__ __forceinline__ float dpp_ror2(float x) { return __builtin_bit_cast(float, __builtin_amdgcn_update_dpp(0, __builtin_bit_cast(int, x), 0x122, 0xf, 0xf, false)); }
struct EpiConv {
    static constexpr bool PERM = true, KHOOK = false;
    const float* cw; const float* cb; bf16_t* O; float* UH; LAS float* halo; const float* RS;
    __device__ __forceinline__ void khook(f32x4 (&)[2][2][4][2], const Unit&, int, int, int, int, int) const {}
    __device__ __forceinline__ void operator()(f32x4 (&acc)[2][2][4][2], const Unit& u, int wr, int wc, int fr_, int fq_) const {
        int fr = fr_, fq = fq_; asm volatile("" : "+v"(fr), "+v"(fq));
        const int cl0 = wc * 32 + 8 * fq;
        const int j0 = 128 * u.pn + cl0;
        const float* rp = RS + ((size_t)(u.pm * 2 + wr) * 16 + fr) * 8; const f32x4 rs0 = *(const f32x4*)rp, rs1 = *(const f32x4*)(rp + 4);
        f32x4 wa0[3], wv0[3];
#pragma unroll
        for (int q = 0; q < 3; ++q) { wa0[q] = *(const f32x4*)(cw + q * NUP + j0); wv0[q] = *(const f32x4*)(cw + q * NUP + DFF + j0); }
        const f32x4 ba0 = *(const f32x4*)(cb + j0), bv0 = *(const f32x4*)(cb + DFF + j0);
#pragma unroll
        for (int ai = 0; ai < 2; ++ai)
#pragma unroll
            for (int m = 0; m < 4; ++m) { const float r = ai == 0 ? rs0[m] : rs1[m];
#pragma unroll
                for (int bj = 0; bj < 2; ++bj)
#pragma unroll
                    for (int n = 0; n < 2; ++n) acc[ai][bj][m][n] *= r; }
        if (fr >= 14) {
#pragma unroll
            for (int ai = 0; ai < 2; ++ai)
#pragma unroll
                for (int bj = 0; bj < 2; ++bj)
#pragma unroll
                    for (int n = 0; n < 2; ++n) *(LAS f32x4*)(halo + (((2 * ai + wr) * 2 + (fr - 14)) * 256 + 128 * bj + cl0 + 4 * n)) = acc[ai][bj][3][n];
        }
        if (wr == 0 && fr < 2) {
#pragma unroll
            for (int bj = 0; bj < 2; ++bj)
#pragma unroll
                for (int n = 0; n < 2; ++n) *(f32x4*)(UH + ((size_t)u.pm * 4 + fr) * NUP + 256 * u.pn + 128 * bj + cl0 + 4 * n) = acc[0][bj][0][n];
        }
        if (wr == 1 && fr >= 14) {
#pragma unroll
            for (int bj = 0; bj < 2; ++bj)
#pragma unroll
                for (int n = 0; n < 2; ++n) *(f32x4*)(UH + ((size_t)u.pm * 4 + 2 + (fr - 14)) * NUP + 256 * u.pn + 128 * bj + cl0 + 4 * n) = acc[1][bj][3][n];
        }
        asm volatile("s_waitcnt lgkmcnt(0)" ::: "memory"); __builtin_amdgcn_s_barrier(); asm volatile("" ::: "memory");
        const bool is15 = fr == 15, ge14 = fr >= 14;
        unsigned keep[2][4][2];
        f32x4 wa1[3], wv1[3];
#pragma unroll
        for (int q = 0; q < 3; ++q) { wa1[q] = *(const f32x4*)(cw + q * NUP + j0 + 4); wv1[q] = *(const f32x4*)(cw + q * NUP + DFF + j0 + 4); }
        const f32x4 ba1 = *(const f32x4*)(cb + j0 + 4), bv1 = *(const f32x4*)(cb + DFF + j0 + 4);
#pragma unroll
        for (int n = 0; n < 2; ++n) {
            f32x4 wa[3], wv[3];
#pragma unroll
            for (int q = 0; q < 3; ++q) { wa[q] = n == 0 ? wa0[q] : wa1[q]; wv[q] = n == 0 ? wv0[q] : wv1[q]; }
            const f32x4 ba = n == 0 ? ba0 : ba1, bv = n == 0 ? bv0 : bv1;
#pragma unroll
            for (int ai = 0; ai < 2; ++ai) {
                const int blk = 2 * ai + wr;
                f32x4 pa = (f32x4){0.f, 0.f, 0.f, 0.f}, pv = (f32x4){0.f, 0.f, 0.f, 0.f};
                if (blk > 0 && ge14) { pa = *(const LAS f32x4*)(halo + (((blk - 1) * 2 + (fr - 14)) * 256 + cl0 + 4 * n)); pv = *(const LAS f32x4*)(halo + (((blk - 1) * 2 + (fr - 14)) * 256 + 128 + cl0 + 4 * n)); }
#pragma unroll
                for (int m = 0; m < 4; ++m) {
                    const f32x4 ca_ = acc[ai][0][m][n], cv_ = acc[ai][1][m][n]; float o[4];
#pragma unroll
                    for (int i = 0; i < 4; ++i) {
                        const float a1 = dpp_ror1(is15 ? pa[i] : ca_[i]), a2 = dpp_ror2(ge14 ? pa[i] : ca_[i]);
                        const float v1 = dpp_ror1(is15 ? pv[i] : cv_[i]), v2 = dpp_ror2(ge14 ? pv[i] : cv_[i]);
                        const float ca = ba[i] + wa[0][i] * a2 + wa[1][i] * a1 + wa[2][i] * ca_[i];
                        const float cv = bv[i] + wv[0][i] * v2 + wv[1][i] * v1 + wv[2][i] * cv_[i];
                        o[i] = siluf_(ca) * cv; }
                    pa = ca_; pv = cv_;
                    const unsigned lo = cvt_pk_bf16(o[0], o[1]), hi = cvt_pk_bf16(o[2], o[3]);
                    if (n == 0) { keep[ai][m][0] = lo; keep[ai][m][1] = hi; }
                    else { u32x4 w; w.x = keep[ai][m][0]; w.y = keep[ai][m][1]; w.z = lo; w.w = hi;
                        *(u32x4*)(O + (size_t)(u.pm * BM + ai * HALF + wr * 64 + m * 16 + fr) * DFF + j0) = w; }
                }
            }
        }
    }
};
struct EpiResid {
    static constexpr bool PERM = true, KHOOK = false;
    const void* base; int base_f32; bf16_t* O; int ldc; float* SS;
    __device__ __forceinline__ void khook(f32x4 (&)[2][2][4][2], const Unit&, int, int, int, int, int) const {}
    __device__ __forceinline__ void finish(const float (&b)[8], const f32x4 v0, const f32x4 v1, bf16_t* op, float& sq) const {
        const float o0 = b[0] + v0[0], o1 = b[1] + v0[1], o2 = b[2] + v0[2], o3 = b[3] + v0[3], o4 = b[4] + v1[0], o5 = b[5] + v1[1], o6 = b[6] + v1[2], o7 = b[7] + v1[3];
        u32x4 w; w.x = cvt_pk_bf16(o0, o1); w.y = cvt_pk_bf16(o2, o3); w.z = cvt_pk_bf16(o4, o5); w.w = cvt_pk_bf16(o6, o7);
        *(u32x4*)op = w;
        sq += ((o0 * o0 + o1 * o1) + (o2 * o2 + o3 * o3)) + ((o4 * o4 + o5 * o5) + (o6 * o6 + o7 * o7));
    }
    __device__ __forceinline__ void rowsum(float sq, const Unit& u, int wc, int fq, int lane, int row) const {
        sq += __builtin_bit_cast(float, __builtin_amdgcn_ds_bpermute((lane ^ 16) << 2, __builtin_bit_cast(int, sq)));
        sq += __builtin_bit_cast(float, __builtin_amdgcn_ds_bpermute((lane ^ 32) << 2, __builtin_bit_cast(int, sq)));
        if (fq == 0) SS[(size_t)(u.pn * 4 + wc) * M + row] = sq;
    }
    __device__ __forceinline__ void operator()(f32x4 (&acc)[2][2][4][2], const Unit& u, int wr, int wc, int fr_, int fq_) const {
        int fr = fr_, fq = fq_; asm volatile("" : "+v"(fr), "+v"(fq));
        const int row0 = u.pm * BM + wr * 64 + fr, col0 = u.pn * BM + wc * 32 + 8 * fq, lane = fq * 16 + fr;
        if (!base_f32) {
            u32x4 bw[2][4][2];
#pragma unroll
            for (int ai = 0; ai < 2; ++ai)
#pragma unroll
                for (int m = 0; m < 4; ++m)
#pragma unroll
                    for (int bj = 0; bj < 2; ++bj) bw[ai][m][bj] = *(const u32x4*)((const bf16_t*)base + (size_t)(row0 + ai * HALF + m * 16) * ldc + col0 + bj * HALF);
#pragma unroll
            for (int ai = 0; ai < 2; ++ai)
#pragma unroll
                for (int m = 0; m < 4; ++m) { const size_t off = (size_t)(row0 + ai * HALF + m * 16) * ldc + col0; float sq = 0.f;
#pragma unroll
                    for (int bj = 0; bj < 2; ++bj) { float b[8]; unpack8(bw[ai][m][bj], b); finish(b, acc[ai][bj][m][0], acc[ai][bj][m][1], O + off + bj * HALF, sq); }
                    if (SS) rowsum(sq, u, wc, fq, lane, row0 + ai * HALF + m * 16); }
        } else {
#pragma unroll
            for (int ai = 0; ai < 2; ++ai)
#pragma unroll
                for (int m = 0; m < 4; ++m) { const size_t off = (size_t)(row0 + ai * HALF + m * 16) * ldc + col0; float sq = 0.f;
#pragma unroll
                    for (int bj = 0; bj < 2; ++bj) { float b[8]; const float* bp = (const float*)base + off + bj * HALF; const f32x4 b0 = *(const f32x4*)bp, b1 = *(const f32x4*)(bp + 4);
                        b[0] = b0.x; b[1] = b0.y; b[2] = b0.z; b[3] = b0.w; b[4] = b1.x; b[5] = b1.y; b[6] = b1.z; b[7] = b1.w;
                        finish(b, acc[ai][bj][m][0], acc[ai][bj][m][1], O + off + bj * HALF, sq); }
                    if (SS) rowsum(sq, u, wc, fq, lane, row0 + ai * HALF + m * 16);
                    asm volatile("" ::: "memory"); }
        }
    }
};
struct EpiGlu {
    static constexpr bool PERM = true, KHOOK = false;
    const bf16_t* Yp; int ldy; bf16_t* O; int ldc;
    __device__ __forceinline__ void khook(f32x4 (&)[2][2][4][2], const Unit&, int, int, int, int, int) const {}
    __device__ __forceinline__ void operator()(f32x4 (&acc)[2][2][4][2], const Unit& u, int wr, int wc, int fr, int fq) const {
        const int row0 = u.pm * BM + wr * 64 + fr, col0 = u.pn * BM + wc * 32 + 8 * fq;
#pragma unroll
        for (int ai = 0; ai < 2; ++ai)
#pragma unroll
            for (int m = 0; m < 4; ++m) { const size_t r = (size_t)(row0 + ai * HALF + m * 16);
#pragma unroll
                for (int bj = 0; bj < 2; ++bj) { const u32x4 yw = *(const u32x4*)(Yp + r * ldy + col0 + bj * HALF); float y[8]; unpack8(yw, y);
                    const f32x4 v0 = acc[ai][bj][m][0], v1 = acc[ai][bj][m][1]; float o[8];
#pragma unroll
                    for (int j = 0; j < 4; ++j) { o[j] = y[j] * sigmoidf_(v0[j]); o[4 + j] = y[4 + j] * sigmoidf_(v1[j]); }
                    u32x4 w; w.x = cvt_pk_bf16(o[0], o[1]); w.y = cvt_pk_bf16(o[2], o[3]); w.z = cvt_pk_bf16(o[4], o[5]); w.w = cvt_pk_bf16(o[6], o[7]);
                    *(u32x4*)(O + r * ldc + col0 + bj * HALF) = w; } }
    }
};
struct EpiMerge {
    static constexpr bool PERM = true, KHOOK = true;
    const bf16_t* G; int ldg; bf16_t* O; int ldc;
    __device__ __forceinline__ void scale(f32x4 (&acc)[2][2][4][2], const Unit& u, int s, int wr, int wc, int fr, int fq) const {
        int row0 = u.pm * BM + wr * 64 + fr, col0 = u.pn * BM + wc * 32 + 8 * fq + s * D; asm volatile("" : "+v"(row0), "+v"(col0));
        u32x4 w[2][4][2];
#pragma unroll
        for (int ai = 0; ai < 2; ++ai)
#pragma unroll
            for (int m = 0; m < 4; ++m) { const bf16_t* gp = G + (size_t)(row0 + ai * HALF + m * 16) * ldg + col0;
#pragma unroll
                for (int bj = 0; bj < 2; ++bj) w[ai][m][bj] = *(const u32x4*)(gp + bj * HALF); }
#pragma unroll
        for (int ai = 0; ai < 2; ++ai)
#pragma unroll
            for (int m = 0; m < 4; ++m)
#pragma unroll
                for (int bj = 0; bj < 2; ++bj) { float f[8]; unpack8(w[ai][m][bj], f);
#pragma unroll
                    for (int j = 0; j < 8; ++j) acc[ai][bj][m][j >> 2][j & 3] *= f[j]; }
    }
    __device__ __forceinline__ void khook(f32x4 (&acc)[2][2][4][2], const Unit& u, int seg, int wr, int wc, int fr, int fq) const { scale(acc, u, seg - 1, wr, wc, fr, fq); }
    __device__ __forceinline__ void operator()(f32x4 (&acc)[2][2][4][2], const Unit& u, int wr, int wc, int fr, int fq) const {
        scale(acc, u, 3, wr, wc, fr, fq);
        const int row0 = u.pm * BM + wr * 64 + fr, col0 = u.pn * BM + wc * 32 + 8 * fq;
#pragma unroll
        for (int ai = 0; ai < 2; ++ai)
#pragma unroll
            for (int m = 0; m < 4; ++m) { bf16_t* rowp = O + (size_t)(row0 + ai * HALF + m * 16) * ldc + col0;
#pragma unroll
                for (int bj = 0; bj < 2; ++bj) { const f32x4 v0 = acc[ai][bj][m][0], v1 = acc[ai][bj][m][1];
                    u32x4 w; w.x = cvt_pk_bf16(v0[0], v0[1]); w.y = cvt_pk_bf16(v0[2], v0[3]); w.z = cvt_pk_bf16(v1[0], v1[1]); w.w = cvt_pk_bf16(v1[2], v1[3]);
                    *(u32x4*)(rowp + bj * HALF) = w; } }
    }
};

typedef int v4i_t __attribute__((ext_vector_type(4)));
typedef int v8i_t __attribute__((ext_vector_type(8)));
template <class Epi, bool F8 = false>
__device__ __forceinline__ void gemm_phase(LAS unsigned char* lds, const Gemm g, const StaticOrder& S, const Epi& E, int tid_in) {
    int tid_ = tid_in; asm volatile("" : "+v"(tid_));
    const int tid = tid_, wid = __builtin_amdgcn_readfirstlane(tid >> 6), lane = tid & 63, wr = wid >> 2, wc = wid & 3, fr = lane & 15, fq = lane >> 4;
    const int K = g.K, nt = K / BK;
    unsigned voffA[2], voffB[2];
#pragma unroll
    for (int i = 0; i < 2; ++i) { int R, C; stage_rc(tid * 16 + i * 8192, R, C); const int Rb = Epi::PERM ? ((R & ~31) + perm32(R & 31)) : R;
        voffA[i] = (unsigned)(R * g.lda + C) * 2u; voffB[i] = (unsigned)(Rb * g.ldb + C) * 2u; }
    const size_t kstep = (size_t)(BK * 2);
    const size_t hstepA = (size_t)HALF * g.lda * 2, hstepB = (size_t)HALF * g.ldb * 2;
    const size_t tstepA = 2 * hstepA, tstepB = 2 * hstepB;
    const unsigned ldsw = (unsigned)wid * 1024u;
    const int aoff = lds_byte(wr * 64 + fr, fq * 8), boff = lds_byte(wc * 32 + fr, fq * 8);
#define PG8_SA(b, h) (((b) * 2 + (h)) * HTB)
#define PG8_SB(b, h) ((4 + (b) * 2 + (h)) * HTB)
#define PG8_STAGE(bufoff, gbase, voff) do { _Pragma("unroll") for (int _i = 0; _i < 2; ++_i) \
        __builtin_amdgcn_global_load_lds((const unsigned*)((const char*)(gbase) + (voff)[_i]), (LAS unsigned*)(lds + (bufoff) + ldsw + _i * 8192), 16, 0, 0); } while (0)
#define PG8_LDA(dst, b, h) do { _Pragma("unroll") for (int m = 0; m < 4; ++m) _Pragma("unroll") for (int k = 0; k < 2; ++k) dst[m][k] = *(const LAS bf16x8*)(lds + PG8_SA(b, h) + aoff + m * 2048 + k * 1024); } while (0)
#define PG8_LDB(dst, b, h) do { _Pragma("unroll") for (int n = 0; n < 2; ++n) _Pragma("unroll") for (int k = 0; k < 2; ++k) dst[n][k] = *(const LAS bf16x8*)(lds + PG8_SB(b, h) + boff + n * 2048 + k * 1024); } while (0)
#define PG8_MMA(ai, bj, At, Bt) do { __builtin_amdgcn_s_setprio(1); _Pragma("unroll") for (int m = 0; m < 4; ++m) _Pragma("unroll") for (int n = 0; n < 2; ++n) _Pragma("unroll") for (int k = 0; k < 2; ++k) \
        acc[ai][bj][m][n] = __builtin_amdgcn_mfma_f32_16x16x32_bf16(Bt[n][k], At[m][k], acc[ai][bj][m][n], 0, 0, 0); __builtin_amdgcn_s_setprio(0); } while (0)
#define PG8_MMA16(ai, bj, At, Bt) PG8_MMA(ai, bj, At, Bt)
#define PG8_MMA8(ai, bj, A8, B8) do { __builtin_amdgcn_s_setprio(1); _Pragma("unroll") for (int m = 0; m < 4; ++m) _Pragma("unroll") for (int n = 0; n < 2; ++n) \
        asm volatile("v_mfma_f32_16x16x128_f8f6f4 %0, %1, %2, %0" : "+v"(acc[ai][bj][m][n]) : "v"(B8[n]), "v"(A8[m])); __builtin_amdgcn_s_setprio(0); } while (0)
#define PG8_LDA8(dst, b, h) do { _Pragma("unroll") for (int m = 0; m < 4; ++m) { dst[m].lo = *(const LAS v4i_t*)(lds + PG8_SA(b, h) + aoff + m * 2048); dst[m].hi = *(const LAS v4i_t*)(lds + PG8_SA(b, h) + aoff + m * 2048 + 1024); } } while (0)
#define PG8_LDB8(dst, b, h) do { _Pragma("unroll") for (int n = 0; n < 2; ++n) { dst[n].lo = *(const LAS v4i_t*)(lds + PG8_SB(b, h) + boff + n * 2048); dst[n].hi = *(const LAS v4i_t*)(lds + PG8_SB(b, h) + boff + n * 2048 + 1024); } } while (0)
#define PG8_XLDA(b, h) do { if constexpr (F8) PG8_LDA8(A8, b, h); else PG8_LDA(At, b, h); } while (0)
#define PG8_XLDB0(b, h) do { if constexpr (F8) PG8_LDB8(B08, b, h); else PG8_LDB(B0, b, h); } while (0)
#define PG8_XLDB1(b, h) do { if constexpr (F8) PG8_LDB8(B18, b, h); else PG8_LDB(B1, b, h); } while (0)
#define PG8_MM0(ai, bj) do { if constexpr (F8) PG8_MMA8(ai, bj, A8, B08); else PG8_MMA16(ai, bj, At, B0); } while (0)
#define PG8_MM1(ai, bj) do { if constexpr (F8) PG8_MMA8(ai, bj, A8, B18); else PG8_MMA16(ai, bj, At, B1); } while (0)
#define PG8_WAIT_V(n) asm volatile("s_waitcnt vmcnt(" #n ")" ::: "memory")
#define PG8_WAIT_L(n) asm volatile("s_waitcnt lgkmcnt(" #n ")" ::: "memory")
#define PG8_BAR __builtin_amdgcn_s_barrier()
#define PG8_SCHED __builtin_amdgcn_sched_barrier(0)
    Unit cur, nxt; int ui = 0;
    if (!S.next(0, cur)) return;
    f32x4 acc[2][2][4][2];
#pragma unroll
    for (int a = 0; a < 2; ++a)
#pragma unroll
        for (int b = 0; b < 2; ++b)
#pragma unroll
            for (int m = 0; m < 4; ++m)
#pragma unroll
                for (int n = 0; n < 2; ++n) acc[a][b][m][n] = (f32x4){0.f, 0.f, 0.f, 0.f};
    bf16x8 At[4][2], B0[2][2], B1[2][2]; v8i_t A8[4], B08[2], B18[2];
    const char* cA = (const char*)g.A + (size_t)cur.pm * tstepA; const char* cB = (const char*)g.Bt + (size_t)cur.pn * tstepB;
    PG8_STAGE(PG8_SB(0, 0), cB, voffB); PG8_STAGE(PG8_SB(0, 1), cB + hstepB, voffB); PG8_STAGE(PG8_SA(0, 0), cA, voffA); PG8_STAGE(PG8_SA(0, 1), cA + hstepA, voffA);
    if (wr == 1) PG8_BAR;
    PG8_WAIT_V(2); PG8_BAR;
    PG8_STAGE(PG8_SB(1, 0), cB + kstep, voffB); PG8_STAGE(PG8_SA(1, 0), cA + kstep, voffA); PG8_STAGE(PG8_SB(1, 1), cB + hstepB + kstep, voffB);
    PG8_WAIT_V(6); PG8_BAR;
    for (;;) {
        const bool has_next = S.next(ui + 1, nxt);
        const char* nA = has_next ? (const char*)g.A + (size_t)nxt.pm * tstepA : cA; const char* nB = has_next ? (const char*)g.Bt + (size_t)nxt.pn * tstepB : cB;
        for (int t = 0; t < nt; t += 2) {
            const bool last = (t == nt - 2);
            const char* a1 = cA + (size_t)(t + 1) * kstep;
            const char* a2 = last ? nA : cA + (size_t)(t + 2) * kstep; const char* b2 = last ? nB : cB + (size_t)(t + 2) * kstep;
            const char* a3 = a2 + kstep; const char* b3 = b2 + kstep;
            if constexpr (Epi::KHOOK) { if (t != 0 && (t & 7) == 0) E.khook(acc, cur, t >> 3, wr, wc, fr, fq); }
            PG8_XLDB0(0, 0); PG8_XLDB1(0, 1); PG8_SCHED; PG8_XLDA(0, 0); PG8_STAGE(PG8_SA(1, 1), a1 + hstepA, voffA);
            PG8_WAIT_V(8); PG8_WAIT_L(0); PG8_BAR; PG8_MM0(0, 0); PG8_MM1(0, 1); PG8_BAR; PG8_SCHED;
            PG8_XLDA(0, 1); PG8_STAGE(PG8_SB(0, 0), b2, voffB); PG8_STAGE(PG8_SB(0, 1), b2 + hstepB, voffB); PG8_STAGE(PG8_SA(0, 0), a2, voffA);
            PG8_WAIT_V(8); PG8_WAIT_L(0); PG8_BAR; PG8_MM0(1, 0); PG8_MM1(1, 1); PG8_BAR; PG8_SCHED;
            PG8_XLDB0(1, 0); PG8_XLDB1(1, 1); PG8_SCHED; PG8_XLDA(1, 0); PG8_STAGE(PG8_SA(0, 1), a2 + hstepA, voffA);
            PG8_WAIT_V(8); PG8_WAIT_L(0); PG8_BAR; PG8_MM0(0, 0); PG8_MM1(0, 1); PG8_BAR; PG8_SCHED;
            PG8_XLDA(1, 1); PG8_STAGE(PG8_SB(1, 0), b3, voffB); PG8_STAGE(PG8_SB(1, 1), b3 + hstepB, voffB); PG8_STAGE(PG8_SA(1, 0), a3, voffA);
            PG8_WAIT_V(8); PG8_WAIT_L(0); PG8_BAR; PG8_MM0(1, 0); PG8_MM1(1, 1); PG8_BAR; PG8_SCHED;
        }
        if (wr == 0) PG8_BAR;
        E(acc, cur, wr, wc, fr, fq);
        if (!has_next) break;
#pragma unroll
        for (int a = 0; a < 2; ++a)
#pragma unroll
            for (int b = 0; b < 2; ++b)
#pragma unroll
                for (int m = 0; m < 4; ++m)
#pragma unroll
                    for (int n = 0; n < 2; ++n) acc[a][b][m][n] = (f32x4){0.f, 0.f, 0.f, 0.f};
        cur = nxt; cA = nA; cB = nB; ++ui;
        if (wr == 1) PG8_BAR;
    }
    PG8_WAIT_V(0);
    PG8_BAR;
#undef PG8_SA
#undef PG8_SB
#undef PG8_STAGE
#undef PG8_LDA
#undef PG8_LDB
#undef PG8_MMA
#undef PG8_MMA8
#undef PG8_MMA16
#undef PG8_LDA8
#undef PG8_LDB8
#undef PG8_XLDA
#undef PG8_XLDB0
#undef PG8_XLDB1
#undef PG8_MM0
#undef PG8_MM1
#undef PG8_WAIT_V
#undef PG8_WAIT_L
#undef PG8_BAR
#undef PG8_SCHED
}
}

#define XB_TMO      128
#define XB_XCNT(j)  (256  + 64 * (j))
#define XB_XSUB(j)  (1280 + 64 * (j))
#define XB_XGEN(j)  (2304 + 64 * (j))
#define XB_TOP      3328
#define XB_TOPGEN   3392
#define XCD_BAR_WORDS 3456
#define XB_SPIN_CAP (1u << 18)
__device__ __forceinline__ unsigned xb_ld(unsigned* p)              { return __hip_atomic_load(p, __ATOMIC_RELAXED, __HIP_MEMORY_SCOPE_AGENT); }
__device__ __forceinline__ unsigned xb_add(unsigned* p, unsigned v) { return __hip_atomic_fetch_add(p, v, __ATOMIC_RELAXED, __HIP_MEMORY_SCOPE_AGENT); }
__device__ __forceinline__ unsigned xb_xcc_id() { return (unsigned)__builtin_amdgcn_s_getreg((3 << 11) | 20) & 0xFu; }
#define XB_SPIN(cond, bar) do { unsigned _sp = 0; while (cond) { __builtin_amdgcn_s_sleep(1); \
    if ((++_sp & 255u) == 0u) { if (xb_ld(&(bar)[XB_TMO])) break; if (_sp > XB_SPIN_CAP) { (void)__hip_atomic_fetch_add(&(bar)[XB_TMO], 1u, __ATOMIC_RELAXED, __HIP_MEMORY_SCOPE_AGENT); break; } } } } while (0)
struct XcdBarrier { unsigned* bar; unsigned x; volatile LAS unsigned* st; };
__device__ __forceinline__ XcdBarrier xcd_barrier_post(unsigned* bar, volatile LAS unsigned* st) {
    XcdBarrier b; b.bar = bar; b.x = xb_xcc_id(); b.st = st;
    if (threadIdx.x == 0) (void)xb_add(&bar[XB_XCNT(b.x)], 1u);
    return b;
}
__device__ __forceinline__ void xcd_barrier_complete(unsigned* bar, unsigned x, unsigned& nloc, unsigned& nx) {
    const unsigned G = gridDim.x * gridDim.y * gridDim.z;
    unsigned sum, cnt, mine, sp = 0u;
    for (;;) {
        sum = 0u; cnt = 0u; mine = 0u;
#pragma nounroll
        for (unsigned j = 0; j < 16; ++j) { const unsigned c = xb_ld(&bar[XB_XCNT(j)]); sum += c; cnt += (c > 0u) ? 1u : 0u; mine = (j == x) ? c : mine; }
        if (sum == G) break;
        __builtin_amdgcn_s_sleep(1);
        if ((++sp & 255u) == 0u) { if (xb_ld(&bar[XB_TMO])) break; if (sp > XB_SPIN_CAP) { (void)__hip_atomic_fetch_add(&bar[XB_TMO], 1u, __ATOMIC_RELAXED, __HIP_MEMORY_SCOPE_AGENT); break; } }
    }
    nloc = mine > 0u ? mine : 1u; nx = cnt > 0u ? cnt : 1u;
}
__device__ __forceinline__ void xcd_barrier(const XcdBarrier& b) {
    asm volatile("s_waitcnt vmcnt(0)" ::: "memory");
    wg_sync();
    if (threadIdx.x == 0) {
        unsigned* bar = b.bar;
        __builtin_amdgcn_s_waitcnt(0);
        unsigned nloc = b.st[0], nx = b.st[1];
        if (nloc == 0u) { xcd_barrier_complete(bar, b.x, nloc, nx); b.st[0] = nloc; b.st[1] = nx; }
        const unsigned old = xb_add(&bar[XB_XSUB(b.x)], 1u);
        const unsigned gen = old / nloc;
        if (old + 1u == (gen + 1u) * nloc) {
            __builtin_amdgcn_fence(__ATOMIC_RELEASE, "agent");
            asm volatile("s_waitcnt vmcnt(0)" ::: "memory");
            const unsigned og = xb_add(&bar[XB_TOP], 1u);
            const unsigned tg = og / nx;
            if (og + 1u == (tg + 1u) * nx) xb_add(&bar[XB_TOPGEN], 1u);
            else XB_SPIN(xb_ld(&bar[XB_TOPGEN]) == tg, bar);
            __builtin_amdgcn_fence(__ATOMIC_ACQUIRE, "agent");
            xb_add(&bar[XB_XGEN(b.x)], 1u);
            asm volatile("s_waitcnt vmcnt(0)" ::: "memory");
        } else {
            XB_SPIN(xb_ld(&bar[XB_XGEN(b.x)]) == gen, bar);
            __builtin_amdgcn_fence(__ATOMIC_ACQUIRE, "agent");
            asm volatile("s_waitcnt vmcnt(0)" ::: "memory");
        }
    }
    wg_sync();
}

__device__ __forceinline__ const void* kin(int k) {
    typedef __attribute__((address_space(4))) const char* kptr_t;
    kptr_t p = (kptr_t)__builtin_amdgcn_kernarg_segment_ptr(); asm volatile("" : "+s"(p));
    const unsigned long long v = *(__attribute__((address_space(4))) const unsigned long long*)(p + 8 * k);
    return (const void*)(GAS const void*)v;
}
struct Frame {
    LAS unsigned char* lds;
    int tid, lane, wave, vcu, G, l;
    unsigned char* ws; float* out;
#define FIN(name, T, k) __device__ __forceinline__ const T* name() const { return (const T*)kin(k); }
    FIN(x, float, 0) FIN(pos, int, 1) FIN(g_mix, float, 2) FIN(w_in, float, 3) FIN(a_re, float, 4) FIN(a_im, float, 5) FIN(log_dt, float, 6) FIN(b_re, float, 7) FIN(b_im, float, 8)
    FIN(c_re, float, 9) FIN(c_im, float, 10) FIN(s5_d, float, 11) FIN(w_glu, float, 12) FIN(gla_wg, float, 13) FIN(gla_bg, float, 14) FIN(pool_w, float, 15) FIN(pool_scale, float, 16)
    FIN(w_branch, float, 17) FIN(w_out, float, 18) FIN(g_ffn, float, 19) FIN(w_up, float, 20) FIN(conv_w, float, 21) FIN(conv_b, float, 22) FIN(w_down, float, 23) FIN(g_final, float, 24)
#undef FIN
#define FWS(name, T, off) __device__ __forceinline__ T* name() const { return (T*)(ws + (off)); }
    FWS(rotc, float, WS_ROT) FWS(rots, float, WS_ROT + (size_t)M * 32 * 4) FWS(abar, float, WS_S5T + S5T_ABAR) FWS(apow, float, WS_S5T + S5T_APOW) FWS(bbar, float, WS_S5T + S5T_BBAR) FWS(cmt, bf16_t, WS_S5T + S5T_CMT) FWS(bbt, bf16_t, WS_S5T + S5T_BBT)
    FWS(wglu_t, bf16_t, WS_WGLU) FWS(poolw_t, bf16_t, WS_POOLW) FWS(win_t, bf16_t, WS_WIN) FWS(wbr_t, bf16_t, WS_WBR) FWS(wout_t, bf16_t, WS_WOUT) FWS(wup_t, bf16_t, WS_WUP) FWS(wdn_t, bf16_t, WS_WDN)
    FWS(HN8, unsigned char, WS_HN8) FWS(W8, unsigned char, WS_W8) FWS(HN, bf16_t, WS_HN) FWS(Y, bf16_t, WS_Y) FWS(YBP, bf16_t, WS_YBP) FWS(PROJ, bf16_t, WS_PROJ) FWS(SPREV, bf16_t, WS_SPREV) FWS(ACT, bf16_t, WS_ACT)
    FWS(SS, float, WS_SS + (size_t)l * 32 * M * 4) FWS(RS, float, WS_RS + (size_t)l * M * 4) FWS(STATE, float, WS_STATE) FWS(DEC, float, WS_DEC) FWS(XEND, float, WS_XEND) FWS(UH, float, WS_UH)
#undef FWS
};

__device__ __forceinline__ float lane_read(float v, int src_lane) { return __builtin_bit_cast(float, __builtin_amdgcn_ds_bpermute(src_lane << 2, __builtin_bit_cast(int, v))); }
__device__ __forceinline__ float wave_sum(float v, int lane) {
#pragma unroll
    for (int o = 1; o < 64; o <<= 1) v += lane_read(v, lane ^ o);
    return v;
}

template <class SrcCol>
__device__ __forceinline__ void transpose_item(const float* W, int Nsrc, bf16_t* WT, int ldt, int kdst0, int k0, int n0, SrcCol srccol, LAS float* scr, int lane, const float* kscale = nullptr) {
    const int sc = srccol(n0 + (lane & 31));
    float wv[32];
#pragma unroll
    for (int i = 0; i < 32; ++i) { const int kk = 2 * i + (lane >> 5); wv[i] = sc >= 0 ? W[(size_t)(k0 + kk) * Nsrc + sc] : 0.f; }
#pragma unroll
    for (int i = 0; i < 32; ++i) { const int kk = 2 * i + (lane >> 5); scr[kk * 33 + (lane & 31)] = kscale ? wv[i] * kscale[k0 + kk] : wv[i]; }
    LDS_WAIT();
    const int c = lane & 7;
#pragma unroll
    for (int j = 0; j < 4; ++j) { const int n = (lane >> 3) + 8 * j; const LAS float* s = scr + (8 * c) * 33 + n;
        u32x4 o; o.x = pk2(s[0 * 33], s[1 * 33]); o.y = pk2(s[2 * 33], s[3 * 33]); o.z = pk2(s[4 * 33], s[5 * 33]); o.w = pk2(s[6 * 33], s[7 * 33]);
        *(u32x4*)(WT + (size_t)(n0 + n) * ldt + kdst0 + k0 + 8 * c) = o; }
    LDS_WAIT();
}
template <class SrcCol>
__device__ __forceinline__ void transpose_item_fp8(const float* W, int Nsrc, unsigned char* WT, int ldt, int k0, int n0src, int n0dst, SrcCol srccol, LAS float* scr, int lane, const float* kscale, float scale) {
    const int sc = srccol(n0src + (lane & 31));
    float wv[32];
#pragma unroll
    for (int i = 0; i < 32; ++i) { const int kk = 2 * i + (lane >> 5); wv[i] = sc >= 0 ? W[(size_t)(k0 + kk) * Nsrc + sc] : 0.f; }
#pragma unroll
    for (int i = 0; i < 32; ++i) { const int kk = 2 * i + (lane >> 5); scr[kk * 33 + (lane & 31)] = (kscale ? wv[i] * kscale[k0 + kk] : wv[i]) * scale; }
    LDS_WAIT();
    const int c = lane & 7;
#pragma unroll
    for (int j = 0; j < 4; ++j) { const int n = (lane >> 3) + 8 * j; const LAS float* s = scr + (8 * c) * 33 + n;
        u32x2 o; o.x = pk4_fp8(s[0 * 33], s[1 * 33], s[2 * 33], s[3 * 33]); o.y = pk4_fp8(s[4 * 33], s[5 * 33], s[6 * 33], s[7 * 33]);
        *(u32x2*)(WT + (size_t)(n0dst + n) * ldt + k0 + 8 * c) = o; }
    LDS_WAIT();
}
struct ColIdent { __device__ __forceinline__ int operator()(int n) const { return n; } };
struct ColWin { __device__ __forceinline__ int operator()(int n) const {
    if (n < 3584) return n; if (n < 4096) return n + 16; if (n < 4112) return n - 512; if (n < 4352) return -1;
    const int t = (n - 4352) >> 8, cl = (n - 4352) & 255; const int br = 2 * (cl >> 7) + ((cl >> 2) & 1), ch = 16 * ((cl >> 5) & 3) + 4 * ((cl >> 3) & 3) + (cl & 3);
    return 4112 + br * 2048 + 64 * t + ch; } };
struct ColWup { __device__ __forceinline__ int operator()(int n) const { const int blk = n >> 8, r = n & 255; return (r < 128) ? (blk * 128 + r) : (DFF + blk * 128 + (r - 128)); } };

__device__ __forceinline__ void rms_row_to_bf16(const float* xrow, const float* g, bf16_t* orow, int lane, unsigned char* orow8 = nullptr) {
    const f32x4* xr = (const f32x4*)xrow + lane; const f32x4* gr = (const f32x4*)g + lane;
    f32x4 v[8]; float s = 0.f;
#pragma unroll
    for (int j = 0; j < 8; ++j) { v[j] = xr[64 * j]; s += (v[j].x * v[j].x + v[j].y * v[j].y) + (v[j].z * v[j].z + v[j].w * v[j].w); }
    const float r = 1.0f / sqrtf(wave_sum(s, lane) * (1.f / D) + EPS);
    u32x2* o8 = (u32x2*)orow + lane;
#pragma unroll
    for (int j = 0; j < 8; ++j) { const f32x4 gg = gr[64 * j]; const float a = v[j].x * r * gg.x, b = v[j].y * r * gg.y, c = v[j].z * r * gg.z, d = v[j].w * r * gg.w; u32x2 w; w.x = pk2(a, b); w.y = pk2(c, d); o8[64 * j] = w;
        if (orow8) ((unsigned*)orow8)[lane + 64 * j] = pk4_fp8(a, b, c, d); }
}
__device__ __forceinline__ void rms_rows(Frame& F, const float* src, const float* g, bf16_t* dst, unsigned char* dst8 = nullptr) {
    const int gw = F.vcu * NWAVES + F.wave, NGW = F.G * NWAVES;
    for (int m = gw; m < M; m += NGW) rms_row_to_bf16(src + (size_t)m * D, g, dst + (size_t)m * D, F.lane, dst8 ? dst8 + (size_t)m * D : nullptr);
}
__device__ __forceinline__ void row_scale(Frame& F) {
    const int gt = F.vcu * (NWAVES * 64) + F.tid, NGT = F.G * NWAVES * 64;
    for (int m = gt; m < M; m += NGT) { float s = 0.f;
#pragma unroll
        for (int j = 0; j < 32; ++j) s += F.SS()[(size_t)j * M + m];
        const int r = m & 255;
        F.RS()[((size_t)((m >> 8) * 2 + ((r >> 6) & 1)) * 16 + (r & 15)) * 8 + (r >> 7) * 4 + ((r >> 4) & 3)] = 1.0f / sqrtf(s * (1.f / D) + EPS); }
}
__device__ __forceinline__ void rms_rows16(Frame& F, const bf16_t* src, const float* g, bf16_t* dst, unsigned char* dst8) {
    const int gw = F.vcu * NWAVES + F.wave, NGW = F.G * NWAVES, lane = F.lane;
    for (int m = gw; m < M; m += NGW) {
        const u32x4* xr = (const u32x4*)(src + (size_t)m * D) + lane; float v[4][8]; float s = 0.f;
#pragma unroll
        for (int j = 0; j < 4; ++j) { unpack8(xr[64 * j], v[j]);
#pragma unroll
            for (int q = 0; q < 8; ++q) s += v[j][q] * v[j][q]; }
        const float r = 1.0f / sqrtf(wave_sum(s, lane) * (1.f / D) + EPS);
        u32x4* o16 = (u32x4*)(dst + (size_t)m * D) + lane; u32x2* o8 = (u32x2*)(dst8 + (size_t)m * D) + lane;
#pragma unroll
        for (int j = 0; j < 4; ++j) { const f32x4 g0 = *((const f32x4*)g + 2 * (lane + 64 * j)), g1 = *((const f32x4*)g + 2 * (lane + 64 * j) + 1); float y[8];
            y[0] = v[j][0] * r * g0.x; y[1] = v[j][1] * r * g0.y; y[2] = v[j][2] * r * g0.z; y[3] = v[j][3] * r * g0.w; y[4] = v[j][4] * r * g1.x; y[5] = v[j][5] * r * g1.y; y[6] = v[j][6] * r * g1.z; y[7] = v[j][7] * r * g1.w;
            o16[64 * j] = pack8(y); u32x2 w8; w8.x = pk4_fp8(y[0], y[1], y[2], y[3]); w8.y = pk4_fp8(y[4], y[5], y[6], y[7]); o8[64 * j] = w8; }
    }
}
__device__ __forceinline__ void rms_rows16_to_f32(Frame& F, const bf16_t* src, const float* g, float* out) {
    const int gw = F.vcu * NWAVES + F.wave, NGW = F.G * NWAVES, lane = F.lane;
    for (int m = gw; m < M; m += NGW) {
        const u32x4* xr = (const u32x4*)(src + (size_t)m * D) + lane; float v[4][8]; float s = 0.f;
#pragma unroll
        for (int j = 0; j < 4; ++j) { unpack8(xr[64 * j], v[j]);
#pragma unroll
            for (int q = 0; q < 8; ++q) s += v[j][q] * v[j][q]; }
        const float r = 1.0f / sqrtf(wave_sum(s, lane) * (1.f / D) + EPS);
        f32x4* o = (f32x4*)(out + (size_t)m * D);
#pragma unroll
        for (int j = 0; j < 4; ++j) { const f32x4 g0 = *((const f32x4*)g + 2 * (lane + 64 * j)), g1 = *((const f32x4*)g + 2 * (lane + 64 * j) + 1);
            o[2 * (lane + 64 * j)] = (f32x4){v[j][0] * r * g0.x, v[j][1] * r * g0.y, v[j][2] * r * g0.z, v[j][3] * r * g0.w};
            o[2 * (lane + 64 * j) + 1] = (f32x4){v[j][4] * r * g1.x, v[j][5] * r * g1.y, v[j][6] * r * g1.z, v[j][7] * r * g1.w}; }
    }
}
__device__ __forceinline__ void rms_rows_f32_inplace(Frame& F, float* buf, const float* g) {
    const int gw = F.vcu * NWAVES + F.wave, NGW = F.G * NWAVES;
    for (int m = gw; m < M; m += NGW) {
        f32x4* xr = (f32x4*)(buf + (size_t)m * D) + F.lane; const f32x4* gr = (const f32x4*)g + F.lane;
        f32x4 v[8]; float s = 0.f;
#pragma unroll
        for (int j = 0; j < 8; ++j) { v[j] = xr[64 * j]; s += (v[j].x * v[j].x + v[j].y * v[j].y) + (v[j].z * v[j].z + v[j].w * v[j].w); }
        const float r = 1.0f / sqrtf(wave_sum(s, F.lane) * (1.f / D) + EPS);
#pragma unroll
        for (int j = 0; j < 8; ++j) { const f32x4 gg = gr[64 * j]; xr[64 * j] = (f32x4){v[j].x * r * gg.x, v[j].y * r * gg.y, v[j].z * r * gg.z, v[j].w * r * gg.w}; }
    }
}

__device__ __forceinline__ void phase_prep(Frame& F, int l) {
    LAS float* scr = (LAS float*)(F.lds + F.wave * 16384);
    const int gw = F.vcu * NWAVES + F.wave, NGW = F.G * NWAVES;
    constexpr int I_IN = (D / 64) * (NIN / 32), I_UP = (D / 64) * (NUP / 32), I_DN = (DFF / 64) * (D / 32), I_BR = 4 * (BW / 64) * (D / 32), I_OUT = (D / 64) * (D / 32), I_GLU = (BW / 64) * (BW / 32), I_PL = 4 * (128 / 64) * (128 / 32);
    constexpr int NITEMS = I_IN + I_UP + I_DN + I_BR + I_OUT + I_GLU + I_PL;
    for (int it = gw; it < NITEMS; it += NGW) {
        int r = it;
        if (r < I_IN) { const int nb = NIN / 32, n0 = 32 * (r % nb);
            if (n0 < C_GATE) transpose_item(F.w_in() + (size_t)l * D * NIN_SRC, NIN_SRC, F.win_t(), D, 0, 64 * (r / nb), n0, ColWin(), scr, F.lane);
            else transpose_item_fp8(F.w_in() + (size_t)l * D * NIN_SRC, NIN_SRC, F.W8(), D, 64 * (r / nb), n0, n0 - C_GATE, ColWin(), scr, F.lane, nullptr, 64.0f);
            continue; } r -= I_IN;
        if (r < I_UP) { const int nb = NUP / 32; transpose_item(F.w_up() + (size_t)l * D * NUP, NUP, F.wup_t(), D, 0, 64 * (r / nb), 32 * (r % nb), ColWup(), scr, F.lane, F.g_ffn() + (size_t)l * D); continue; } r -= I_UP;
        if (r < I_DN) { const int nb = D / 32; transpose_item(F.w_down() + (size_t)l * DFF * D, D, F.wdn_t(), DFF, 0, 64 * (r / nb), 32 * (r % nb), ColIdent(), scr, F.lane); continue; } r -= I_DN;
        if (r < I_BR) { const int per = (BW / 64) * (D / 32), br = r / per, q = r % per, nb = D / 32;
            transpose_item(F.w_branch() + ((size_t)l * 4 + br) * BW * D, D, F.wbr_t(), D, br * BW, 64 * (q / nb), 32 * (q % nb), ColIdent(), scr, F.lane); continue; } r -= I_BR;
        if (r < I_OUT) { const int nb = D / 32; transpose_item(F.w_out() + (size_t)l * D * D, D, F.wout_t(), D, 0, 64 * (r / nb), 32 * (r % nb), ColIdent(), scr, F.lane); continue; } r -= I_OUT;
        if (r < I_GLU) { const int nb = BW / 32; transpose_item(F.w_glu() + (size_t)l * BW * BW, BW, F.wglu_t(), BW, 0, 64 * (r / nb), 32 * (r % nb), ColIdent(), scr, F.lane); continue; } r -= I_GLU;
        { const int grp = r / 8, q = r % 8; transpose_item(F.pool_w() + ((size_t)l * 4 + grp) * 128 * 128, 128, F.poolw_t() + (size_t)grp * 128 * 128, 128, 0, 64 * (q / 4), 32 * (q % 4), ColIdent(), scr, F.lane); }
    }
    const int gt = F.vcu * (NWAVES * 64) + F.tid, NGT = F.G * NWAVES * 64;
    for (int i = gt; i < 32 * 64; i += NGT) {
        const int g = i >> 6;
        const float are = F.a_re()[(size_t)l * 2048 + i], aim = F.a_im()[(size_t)l * 2048 + i], dt = expf(F.log_dt()[l * 32 + g]);
        const float mag = expf(are * dt), th = aim * dt;
        const float abr = mag * cosf(th), abi = mag * sinf(th);
        const float den = are * are + aim * aim, nr = abr - 1.0f, ni = abi;
        const float fre = (nr * are + ni * aim) / den, fim = (ni * are - nr * aim) / den;
        F.abar()[2 * i] = abr; F.abar()[2 * i + 1] = abi;
        float pr = abr, pi = abi;
#pragma unroll
        for (int q = 0; q < 6; ++q) { const float tr = pr * pr - pi * pi, ti = 2.f * pr * pi; pr = tr; pi = ti; }
        F.apow()[2 * i] = pr; F.apow()[2 * i + 1] = pi;
        const float* br = F.b_re() + ((size_t)l * 2048 + i) * 16; const float* bi = F.b_im() + ((size_t)l * 2048 + i) * 16;
#pragma unroll
        for (int c = 0; c < 16; ++c) { const float x = br[c], y = bi[c]; const float vr = fre * x - fim * y, vi = fre * y + fim * x; const int p = i & 63;
            F.bbt()[((size_t)g * 128 + p) * 16 + c] = (bf16_t)f2bf(vr); F.bbt()[((size_t)g * 128 + 64 + p) * 16 + c] = (bf16_t)f2bf(vi); }
    }
    for (int i = gt; i < 32 * 16 * 128; i += NGT) {
        const int k = i & 127, gc = i >> 7;
        const float v = (k < 64) ? F.c_re()[((size_t)l * 512 + gc) * 64 + k] : -F.c_im()[((size_t)l * 512 + gc) * 64 + (k - 64)];
        F.cmt()[i] = (bf16_t)f2bf(v);
    }
    if (l == 0) {
        for (int i = gt; i < M * 32; i += NGT) {
            const int row = i >> 5, j = i & 31;
            const float inv = exp2f(-(float)j * (13.287712379549449f / 32.0f));
            const float ang = (float)F.pos()[row] * inv;
            F.rotc()[i] = cosf(ang); F.rots()[i] = sinf(ang);
        }
    }
    if (l == 0) rms_rows(F, F.x(), F.g_mix(), F.HN(), F.HN8()); else rms_rows16(F, (const bf16_t*)F.out, F.g_mix() + (size_t)l * D, F.HN(), F.HN8());
}

__device__ __forceinline__ f32x4 mma_nt_lds(const LAS bf16_t* X, int px, const LAS bf16_t* Y, int py, int ksteps, f32x4 acc, int lane) {
    const LAS bf16_t* xp = X + (lane & 15) * px + 8 * (lane >> 4);
    const LAS bf16_t* yp = Y + (lane & 15) * py + 8 * (lane >> 4);
    for (int ks = 0; ks < ksteps; ++ks) {
        const bf16x8 a = *(const LAS bf16x8*)(xp + 32 * ks), b = *(const LAS bf16x8*)(yp + 32 * ks);
        acc = __builtin_amdgcn_mfma_f32_16x16x32_bf16(a, b, acc, 0, 0, 0);
    }
    return acc;
}

constexpr int LN_TOT = 16384, LN_QD = 18432, LN_KI = 27648, LN_PM = 36864, LN_VT = 46080, LN_OB = 64512, LN_WG = 98304, LN_END = 98304 + 4096 + 256;
constexpr int LP = 72;
struct LinRaw { u32x4 q0, q1, k0, k1, v0, v1, g0, g1, gr0, gr1; f32x4 c0, c1, s0, s1; bf16x8 sp0, sp1; };
template <bool OUT>
__device__ __forceinline__ void lin_issue(Frame& F, int unit, LinRaw& R) {
    const int n = unit & 63, h = (unit >> 6) & 3, b = (unit >> 8) & 7, mixer = unit >> 11;
    const size_t row0 = (size_t)b * SEQ + (size_t)n * CH; const int s = F.tid >> 3, c = F.tid & 7;
    const int cq = (mixer == 0 ? C_RQ : C_GQ) + h * 64, ck = (mixer == 0 ? C_RK : C_GK) + h * 64, cv = (mixer == 0 ? C_RV : C_GV) + h * 128, cg = (mixer == 0 ? C_RG : C_GG) + h * 128;
    const bf16_t* pr = F.PROJ() + (row0 + s) * NIN;
    R.k0 = *(const u32x4*)(pr + ck + 8 * c); R.k1 = *(const u32x4*)(pr + ck + 8 * (c ^ 4));
    if (OUT) { R.q0 = *(const u32x4*)(pr + cq + 8 * c); R.q1 = *(const u32x4*)(pr + cq + 8 * (c ^ 4)); }
    { const float* cp = F.rotc() + (row0 + s) * 32 + (c & 3) * 8; const float* sp = F.rots() + (row0 + s) * 32 + (c & 3) * 8;
      R.c0 = *(const f32x4*)cp; R.c1 = *(const f32x4*)(cp + 4); R.s0 = *(const f32x4*)sp; R.s1 = *(const f32x4*)(sp + 4); }
    R.gr0 = *(const u32x4*)(pr + C_GR); R.gr1 = *(const u32x4*)(pr + C_GR + 8);
    R.v0 = *(const u32x4*)(F.PROJ() + (row0 + (F.tid >> 4)) * NIN + cv + (F.tid & 15) * 8);
    R.v1 = *(const u32x4*)(F.PROJ() + (row0 + 32 + (F.tid >> 4)) * NIN + cv + (F.tid & 15) * 8);
    if (OUT) { R.g0 = *(const u32x4*)(pr + cg + 16 * c); R.g1 = *(const u32x4*)(pr + cg + 16 * c + 8);
        const bf16_t* sq = F.SPREV() + (size_t)unit * 8192 + (size_t)(16 * F.wave + (F.lane & 15)) * 64 + 8 * (F.lane >> 4);
        R.sp0 = *(const bf16x8*)sq; R.sp1 = *(const bf16x8*)(sq + 32); }
}
__device__ __forceinline__ void lin_rot(const u32x4 own_, const u32x4 oth_, const LinRaw& R, bool rot, bool hi, float scale, float (&v)[8]) {
    float own[8]; unpack8(own_, own);
    if (!rot) {
#pragma unroll
        for (int j = 0; j < 8; ++j) v[j] = own[j] * scale;
        return; }
    float oth[8]; unpack8(oth_, oth);
    const float cs[8] = {R.c0.x, R.c0.y, R.c0.z, R.c0.w, R.c1.x, R.c1.y, R.c1.z, R.c1.w}, sn[8] = {R.s0.x, R.s0.y, R.s0.z, R.s0.w, R.s1.x, R.s1.y, R.s1.z, R.s1.w};
#pragma unroll
    for (int j = 0; j < 8; ++j) { const float os = oth[j] * sn[j]; v[j] = (own[j] * cs[j] + (hi ? os : -os)) * scale; }
}
__device__ __forceinline__ void lin_decay(Frame& F, int mixer, int h, const LinRaw& R, float (&bcum)[8], float (&blast)[8]) {
    LAS float* TOT = (LAS float*)(F.lds + LN_TOT);
    const int s = F.tid >> 3, c = F.tid & 7, d0 = 8 * c;
    if (mixer == 0) {
        const float lg = __logf(1.0f - exp2f(-5.0f - (float)h));
#pragma unroll
        for (int j = 0; j < 8; ++j) { bcum[j] = (float)(s + 1) * lg; blast[j] = 64.0f * lg; }
        lds_sync();
        return;
    }
    const LAS float* WG = (const LAS float*)(F.lds + LN_WG);
    float grf[16]; { float a[8], b2[8]; unpack8(R.gr0, a); unpack8(R.gr1, b2);
#pragma unroll
        for (int j = 0; j < 8; ++j) { grf[j] = a[j]; grf[8 + j] = b2[j]; } }
    float x[8]; { const f32x4 b0 = *(const LAS f32x4*)(WG + 1024 + d0), b1 = *(const LAS f32x4*)(WG + 1024 + d0 + 4); x[0] = b0.x; x[1] = b0.y; x[2] = b0.z; x[3] = b0.w; x[4] = b1.x; x[5] = b1.y; x[6] = b1.z; x[7] = b1.w; }
#pragma unroll
    for (int r = 0; r < 16; ++r) { const f32x4 w0 = *(const LAS f32x4*)(WG + r * 64 + d0), w1 = *(const LAS f32x4*)(WG + r * 64 + d0 + 4);
        x[0] += grf[r] * w0.x; x[1] += grf[r] * w0.y; x[2] += grf[r] * w0.z; x[3] += grf[r] * w0.w; x[4] += grf[r] * w1.x; x[5] += grf[r] * w1.y; x[6] += grf[r] * w1.z; x[7] += grf[r] * w1.w; }
#pragma unroll
    for (int j = 0; j < 8; ++j) x[j] = logsigmoidf_(x[j]) * (1.0f / 16.0f);
#pragma unroll
    for (int st = 8; st <= 32; st <<= 1) {
#pragma unroll
        for (int j = 0; j < 8; ++j) { const float t = lane_read(x[j], F.lane - st); if (F.lane >= st) x[j] += t; } }
    if ((F.lane >> 3) == 7) { *(LAS f32x4*)(TOT + F.wave * 64 + d0) = (f32x4){x[0], x[1], x[2], x[3]}; *(LAS f32x4*)(TOT + F.wave * 64 + d0 + 4) = (f32x4){x[4], x[5], x[6], x[7]}; }
    lds_sync();
    float off[8], tot[8];
#pragma unroll
    for (int j = 0; j < 8; ++j) { off[j] = 0.f; tot[j] = 0.f; }
#pragma unroll
    for (int w = 0; w < 8; ++w) { const f32x4 t0 = *(const LAS f32x4*)(TOT + w * 64 + d0), t1 = *(const LAS f32x4*)(TOT + w * 64 + d0 + 4); const float tv[8] = {t0.x, t0.y, t0.z, t0.w, t1.x, t1.y, t1.z, t1.w};
#pragma unroll
        for (int j = 0; j < 8; ++j) { tot[j] += tv[j]; off[j] += (w < F.wave) ? tv[j] : 0.f; } }
#pragma unroll
    for (int j = 0; j < 8; ++j) { bcum[j] = x[j] + off[j]; blast[j] = tot[j]; }
}
typedef short v4s_t __attribute__((ext_vector_type(4)));
__device__ __forceinline__ bf16x8 tr_frag(const LAS bf16_t* T, int pitch, int k0, int x0, int lane) {
    const int g = lane >> 4, i = lane & 15, q = i >> 2, p = i & 3;
    const LAS bf16_t* a = T + (k0 + 8 * g + q) * pitch + x0 + 4 * p;
    const v4s_t lo = __builtin_amdgcn_ds_read_tr16_b64_v4i16((LAS v4s_t*)a), hi = __builtin_amdgcn_ds_read_tr16_b64_v4i16((LAS v4s_t*)(a + 4 * pitch));
    return __builtin_shufflevector(lo, hi, 0, 1, 2, 3, 4, 5, 6, 7);
}
constexpr int PV = 144;
__device__ __forceinline__ void lin_store_vt(Frame& F, const LinRaw& R) {
    LAS bf16_t* VR = (LAS bf16_t*)(F.lds + LN_VT); const int e0 = (F.tid & 15) * 8;
    *(LAS u32x4*)(VR + (F.tid >> 4) * PV + e0) = R.v0; *(LAS u32x4*)(VR + (32 + (F.tid >> 4)) * PV + e0) = R.v1;
}
__device__ __forceinline__ void lin_state_compute(Frame& F, int unit, const LinRaw& R) {
    const int h = (unit >> 6) & 3, mixer = unit >> 11; const int s = F.tid >> 3, c = F.tid & 7, d0 = 8 * c;
    LAS bf16_t* KDT = (LAS bf16_t*)(F.lds + LN_KI); LAS bf16_t* VT = (LAS bf16_t*)(F.lds + LN_VT);
    float k[8], bcum[8], blast[8];
    lin_rot(R.k0, R.k1, R, mixer == 0, c >= 4, mixer == 0 ? 0.125f : 1.0f, k);
    lin_decay(F, mixer, h, R, bcum, blast);
    { float kd[8];
#pragma unroll
      for (int j = 0; j < 8; ++j) kd[j] = k[j] * __expf(blast[j] - bcum[j]);
      *(LAS u32x4*)(KDT + s * LP + d0) = pack8(kd); }
    lin_store_vt(F, R);
    if (s == 0) { float* dc = F.DEC() + (size_t)unit * 64 + d0;
        *(f32x4*)dc = (f32x4){__expf(blast[0]), __expf(blast[1]), __expf(blast[2]), __expf(blast[3])}; *(f32x4*)(dc + 4) = (f32x4){__expf(blast[4]), __expf(blast[5]), __expf(blast[6]), __expf(blast[7])}; }
    lds_sync();
    { const int w = F.wave, lane = F.lane; float* st = F.STATE() + (size_t)unit * 8192;
      const bf16x8 vf0 = tr_frag(VT, PV, 0, 16 * w, lane), vf1 = tr_frag(VT, PV, 32, 16 * w, lane);
#pragma unroll
      for (int dt = 0; dt < 4; ++dt) { f32x4 acc = (f32x4){0.f, 0.f, 0.f, 0.f};
          acc = __builtin_amdgcn_mfma_f32_16x16x32_bf16(vf0, tr_frag(KDT, LP, 0, 16 * dt, lane), acc, 0, 0, 0);
          acc = __builtin_amdgcn_mfma_f32_16x16x32_bf16(vf1, tr_frag(KDT, LP, 32, 16 * dt, lane), acc, 0, 0, 0);
#pragma unroll
          for (int i = 0; i < 4; ++i) st[(16 * w + 4 * (lane >> 4) + i) * 64 + 16 * dt + (lane & 15)] = acc[i]; } }
}
__device__ __forceinline__ void lin_out_compute(Frame& F, int unit, const LinRaw& R) {
    const int n = unit & 63, h = (unit >> 6) & 3, b = (unit >> 8) & 7, mixer = unit >> 11;
    const size_t row0 = (size_t)b * SEQ + (size_t)n * CH; const int s = F.tid >> 3, c = F.tid & 7, d0 = 8 * c;
    const int ycol = (mixer == 0 ? 0 : 1024) + h * 128;
    LAS bf16_t* QD = (LAS bf16_t*)(F.lds + LN_QD); LAS bf16_t* KI = (LAS bf16_t*)(F.lds + LN_KI); LAS bf16_t* PM = (LAS bf16_t*)(F.lds + LN_PM);
    LAS bf16_t* VT = (LAS bf16_t*)(F.lds + LN_VT); LAS float* OB = (LAS float*)(F.lds + LN_OB);
    float q[8], k[8], bcum[8], blast[8];
    lin_rot(R.q0, R.q1, R, mixer == 0, c >= 4, mixer == 0 ? 1.0f : 0.125f, q);
    lin_rot(R.k0, R.k1, R, mixer == 0, c >= 4, mixer == 0 ? 0.125f : 1.0f, k);
    lin_decay(F, mixer, h, R, bcum, blast);
    { float qd[8], ki[8];
#pragma unroll
      for (int j = 0; j < 8; ++j) { qd[j] = q[j] * __expf(bcum[j]); ki[j] = k[j] * __expf(-bcum[j]); }
      *(LAS u32x4*)(QD + s * LP + d0) = pack8(qd); *(LAS u32x4*)(KI + s * LP + d0) = pack8(ki); }
    lin_store_vt(F, R);
    lds_sync();
    { const int lane = F.lane;
#pragma unroll
      for (int j = 0; j < 2; ++j) { const int tile = 2 * F.wave + j, tt = tile >> 2, st = tile & 3;
          f32x4 acc = (f32x4){0.f, 0.f, 0.f, 0.f};
          if (st <= tt) acc = mma_nt_lds(QD + 16 * tt * LP, LP, KI + 16 * st * LP, LP, 2, acc, lane);
#pragma unroll
          for (int i = 0; i < 4; ++i) { const int t = 16 * tt + 4 * (lane >> 4) + i, s2 = 16 * st + (lane & 15); const float p = (st <= tt && s2 <= t) ? acc[i] : 0.f; PM[t * LP + s2] = (bf16_t)f2bf(p); } } }
    lds_sync();
    { const int w = F.wave, lane = F.lane;
      const bf16x8 vf0 = tr_frag(VT, PV, 0, 16 * w, lane), vf1 = tr_frag(VT, PV, 32, 16 * w, lane);
#pragma unroll
      for (int tt = 0; tt < 4; ++tt) { f32x4 acc = (f32x4){0.f, 0.f, 0.f, 0.f};
          { const LAS bf16_t* pp = PM + (16 * tt + (lane & 15)) * LP + 8 * (lane >> 4);
            acc = __builtin_amdgcn_mfma_f32_16x16x32_bf16(*(const LAS bf16x8*)pp, vf0, acc, 0, 0, 0);
            acc = __builtin_amdgcn_mfma_f32_16x16x32_bf16(*(const LAS bf16x8*)(pp + 32), vf1, acc, 0, 0, 0); }
          const LAS bf16_t* xp = QD + (16 * tt + (lane & 15)) * LP + 8 * (lane >> 4);
          acc = __builtin_amdgcn_mfma_f32_16x16x32_bf16(*(const LAS bf16x8*)xp, R.sp0, acc, 0, 0, 0);
          acc = __builtin_amdgcn_mfma_f32_16x16x32_bf16(*(const LAS bf16x8*)(xp + 32), R.sp1, acc, 0, 0, 0);
#pragma unroll
          for (int i = 0; i < 4; ++i) OB[(16 * tt + 4 * (lane >> 4) + i) * 132 + 16 * w + (lane & 15)] = acc[i]; } }
    lds_sync();
    { const int t = s, part = c; float o[16];
#pragma unroll
      for (int j = 0; j < 4; ++j) { const f32x4 v = *(const LAS f32x4*)(OB + t * 132 + 16 * part + 4 * j); o[4 * j] = v.x; o[4 * j + 1] = v.y; o[4 * j + 2] = v.z; o[4 * j + 3] = v.w; }
      float sm = 0.f;
#pragma unroll
      for (int j = 0; j < 16; ++j) sm += o[j];
      sm += lane_read(sm, F.lane ^ 1); sm += lane_read(sm, F.lane ^ 2); sm += lane_read(sm, F.lane ^ 4);
      const float mu = sm * (1.0f / 128.0f); float qv = 0.f;
#pragma unroll
      for (int j = 0; j < 16; ++j) { const float dlt = o[j] - mu; qv += dlt * dlt; }
      qv += lane_read(qv, F.lane ^ 1); qv += lane_read(qv, F.lane ^ 2); qv += lane_read(qv, F.lane ^ 4);
      const float r = 1.0f / sqrtf(qv * (1.0f / 128.0f) + EPS);
      float g0[8], g1[8]; unpack8(R.g0, g0); unpack8(R.g1, g1);
      float y0[8], y1[8];
#pragma unroll
      for (int j = 0; j < 8; ++j) { y0[j] = (o[j] - mu) * r * siluf_(g0[j]); y1[j] = (o[8 + j] - mu) * r * siluf_(g1[j]); }
      bf16_t* yp = F.Y() + (row0 + t) * D + ycol + 16 * part; *(u32x4*)yp = pack8(y0); *(u32x4*)(yp + 8) = pack8(y1); }
}
template <bool OUT>
__device__ __forceinline__ void lin_phase(Frame& F, int l) {
    { const int h = (F.vcu >> 6) & 3; LAS float* WG = (LAS float*)(F.lds + LN_WG);
      for (int i = F.tid; i < 16 * 64 + 64; i += NWAVES * 64) WG[i] = (i < 1024) ? F.gla_wg()[(size_t)l * 16 * 256 + (i >> 6) * 256 + h * 64 + (i & 63)] : F.gla_bg()[l * 256 + h * 64 + (i - 1024)];
      lds_sync(); }
    LinRaw A, B;
    lin_issue<OUT>(F, F.vcu, A);
    for (int u = F.vcu; u < 4096; u += 2 * F.G) {
        lin_issue<OUT>(F, u + F.G, B);
        if (OUT) lin_out_compute(F, u, A); else lin_state_compute(F, u, A);
        if (u + 2 * F.G < 4096) lin_issue<OUT>(F, u + 2 * F.G, A);
        if (OUT) lin_out_compute(F, u + F.G, B); else lin_state_compute(F, u + F.G, B);
    }
    lds_sync();
}
__device__ __forceinline__ void lin_scan(Frame& F) {
    const int gt = F.vcu * (NWAVES * 64) + F.tid, NGT = F.G * NWAVES * 64;
    for (int i = gt; i < 64 * 8192; i += NGT) {
        const int seq = i >> 13, idx = i & 8191, d = idx & 63;
        const float* st = F.STATE() + (size_t)seq * NCH * 8192 + idx; const float* dc = F.DEC() + (size_t)seq * NCH * 64 + d; bf16_t* sp = F.SPREV() + (size_t)seq * NCH * 8192 + idx;
        float carry = 0.f; asm volatile("" : "+v"(carry));
#pragma unroll
        for (int h = 0; h < 2; ++h) {
            float v[32], c[32];
#pragma unroll
            for (int n = 0; n < 32; ++n) { v[n] = st[(size_t)(32 * h + n) * 8192]; c[n] = dc[(size_t)(32 * h + n) * 64]; }
#pragma unroll
            for (int n = 0; n < 32; ++n) { sp[(size_t)(32 * h + n) * 8192] = (bf16_t)f2bf(carry); carry = c[n] * carry + v[n]; asm volatile("" : "+v"(carry)); }
        }
    }
}
constexpr int S5_WL = 16384, S5_BU = 2048, S5_X = 2048 + 8320;
template <bool OUT>
__device__ __forceinline__ void s5_pass(Frame& F, int l) {
    LAS bf16_t* UT = (LAS bf16_t*)(F.lds + F.wave * S5_WL); LAS float* BU = (LAS float*)(F.lds + F.wave * S5_WL + S5_BU); LAS bf16_t* X = (LAS bf16_t*)(F.lds + F.wave * S5_WL + S5_X);
    const int gw = F.vcu * NWAVES + F.wave, NGW = F.G * NWAVES, lane = F.lane, lr = lane & 15, lq = lane >> 4;
    u32x4 ua, uc;
    { const int g = gw & 31, n = (gw >> 5) & 63, b = gw >> 11; const bf16_t* up = F.PROJ() + ((size_t)b * SEQ + (size_t)n * CH + lane) * NIN + C_SU + g * 16; ua = *(const u32x4*)up; uc = *(const u32x4*)(up + 8); }
    for (int unit = gw; unit < BATCH * NCH * 32; unit += NGW) {
        const int g = unit & 31, n = (unit >> 5) & 63, b = unit >> 11; const size_t row0 = (size_t)b * SEQ + (size_t)n * CH;
        *(LAS u32x4*)(UT + lane * 16) = ua; *(LAS u32x4*)(UT + lane * 16 + 8) = uc;
        if (unit + NGW < BATCH * NCH * 32) { const int un = unit + NGW, g2 = un & 31, n2 = (un >> 5) & 63, b2 = un >> 11;
            const bf16_t* up = F.PROJ() + ((size_t)b2 * SEQ + (size_t)n2 * CH + lane) * NIN + C_SU + g2 * 16; ua = *(const u32x4*)up; uc = *(const u32x4*)(up + 8); }
        const int gp = g * 64 + lane; const float ar = F.abar()[2 * gp], ai = F.abar()[2 * gp + 1];
        bf16x8 bfr[8];
#pragma unroll
        for (int q = 0; q < 8; ++q) { bfr[q] = (bf16x8){0, 0, 0, 0, 0, 0, 0, 0}; if (lq < 2) bfr[q] = *(const bf16x8*)(F.bbt() + ((size_t)g * 128 + 16 * q + lr) * 16 + 8 * lq); }
        float xr = 0.f, xi = 0.f;
        bf16x8 cf[4]; float dsk = 0.f;
        if (OUT) { const f32x2 x0 = *(const f32x2*)(F.XEND() + ((((size_t)(b * 32 + g)) * NCH + n) * 64 + lane) * 2); xr = x0.x; xi = x0.y;
#pragma unroll
            for (int ks = 0; ks < 4; ++ks) cf[ks] = *(const bf16x8*)(F.cmt() + ((size_t)(g * 16 + lr)) * 128 + 32 * ks + 8 * lq);
            dsk = F.s5_d()[(size_t)l * BW + g * 16 + lr]; }
        LDS_WAIT();
        for (int sb = 0; sb < 4; ++sb) {
            bf16x8 af = (bf16x8){0, 0, 0, 0, 0, 0, 0, 0}; if (lq < 2) af = *(const LAS bf16x8*)(UT + (16 * sb + lr) * 16 + 8 * lq);
#pragma unroll
            for (int q = 0; q < 8; ++q) { f32x4 acc = (f32x4){0.f, 0.f, 0.f, 0.f}; acc = __builtin_amdgcn_mfma_f32_16x16x32_bf16(af, bfr[q], acc, 0, 0, 0);
#pragma unroll
                for (int i = 0; i < 4; ++i) BU[(4 * lq + i) * 130 + 16 * q + lr] = acc[i]; }
            LDS_WAIT();
            float br[16], bi[16];
#pragma unroll
            for (int tt = 0; tt < 16; ++tt) { br[tt] = BU[tt * 130 + lane]; bi[tt] = BU[tt * 130 + 64 + lane]; }
#pragma unroll
            for (int tt = 0; tt < 16; ++tt) { const float nr = ar * xr - ai * xi + br[tt], ni = ar * xi + ai * xr + bi[tt]; xr = nr; xi = ni; asm volatile("" : "+v"(xr), "+v"(xi));
                if (OUT) { X[tt * 136 + lane] = (bf16_t)f2bf(xr); X[tt * 136 + 64 + lane] = (bf16_t)f2bf(xi); } }
            if (OUT) {
                LDS_WAIT();
                f32x4 acc = (f32x4){0.f, 0.f, 0.f, 0.f}; const LAS bf16_t* xp = X + lr * 136 + 8 * lq;
#pragma unroll
                for (int ks = 0; ks < 4; ++ks) acc = __builtin_amdgcn_mfma_f32_16x16x32_bf16(*(const LAS bf16x8*)(xp + 32 * ks), cf[ks], acc, 0, 0, 0);
#pragma unroll
                for (int i = 0; i < 4; ++i) { const int tl = 16 * sb + 4 * lq + i; const float u = bflo((unsigned)UT[tl * 16 + lr]); const float y = gelu_tanh(acc[i] + dsk * u);
                    F.YBP()[(row0 + tl) * BW + g * 16 + lr] = (bf16_t)f2bf(y); }
            }
            LDS_WAIT();
        }
        if (!OUT) *(f32x2*)(F.XEND() + ((((size_t)(b * 32 + g)) * NCH + n) * 64 + lane) * 2) = (f32x2){xr, xi};
    }
}
__device__ __forceinline__ void s5_scan(Frame& F) {
    const int gt = F.vcu * (NWAVES * 64) + F.tid, NGT = F.G * NWAVES * 64;
    for (int i = gt; i < BATCH * 32 * 64; i += NGT) {
        const int p = i & 63, bg = i >> 6, g = bg & 31; const float pr = F.apow()[2 * (g * 64 + p)], pi = F.apow()[2 * (g * 64 + p) + 1];
        f32x2* xp = (f32x2*)(F.XEND() + (((size_t)bg * NCH) * 64 + p) * 2);
        float cr = 0.f, ci = 0.f; asm volatile("" : "+v"(cr), "+v"(ci));
#pragma unroll
        for (int h = 0; h < 2; ++h) {
            f32x2 v[32];
#pragma unroll
            for (int n = 0; n < 32; ++n) v[n] = xp[(size_t)(32 * h + n) * 64];
#pragma unroll
            for (int n = 0; n < 32; ++n) { xp[(size_t)(32 * h + n) * 64] = (f32x2){cr, ci};
                const float nr = pr * cr - pi * ci + v[n].x, ni = pr * ci + pi * cr + v[n].y; cr = nr; ci = ni; asm volatile("" : "+v"(cr), "+v"(ci)); }
        }
    }
}

__device__ __forceinline__ void pool_phase(Frame& F, int l) {
    const int gw = F.vcu * NWAVES + F.wave, NGW = F.G * NWAVES, lane = F.lane, lr = lane & 15, lq = lane >> 4;
    for (int unit = gw; unit < BATCH * (SEQ / 16) * 4; unit += NGW) {
        const int g = unit & 3, tile = (unit >> 2) & 255, b = unit >> 10; const int win = 2 << g, tpos = 16 * tile + lr; const size_t row = (size_t)b * SEQ + tpos;
        const bf16_t* pp = F.PROJ() + row * NIN + C_PU + g * 128 + 8 * lq;
        float s[4][8];
#pragma unroll
        for (int ks = 0; ks < 4; ++ks)
#pragma unroll
            for (int j = 0; j < 8; ++j) s[ks][j] = 0.f;
        for (int jj = 1; jj < win; ++jj) { if (tpos - jj >= 0) {
#pragma unroll
            for (int ks = 0; ks < 4; ++ks) { float a[8]; unpack8(*(const u32x4*)(pp - (size_t)jj * NIN + 32 * ks), a);
#pragma unroll
                for (int j = 0; j < 8; ++j) s[ks][j] += a[j]; } } }
        const float inv = 1.0f / (float)min(tpos + 1, win);
        bf16x8 mf[4];
#pragma unroll
        for (int ks = 0; ks < 4; ++ks) { float a[8], m[8]; unpack8(*(const u32x4*)(pp + 32 * ks), a);
#pragma unroll
            for (int j = 0; j < 8; ++j) m[j] = (s[ks][j] + a[j]) * inv - a[j];
            const u32x4 w = pack8(m); mf[ks] = __builtin_bit_cast(bf16x8, w); }
        const bf16_t* pw = F.poolw_t() + (size_t)g * 128 * 128 + (size_t)lr * 128 + 8 * lq;
#pragma unroll
        for (int q = 0; q < 8; ++q) { f32x4 acc = (f32x4){0.f, 0.f, 0.f, 0.f};
#pragma unroll
            for (int ks = 0; ks < 4; ++ks) acc = __builtin_amdgcn_mfma_f32_16x16x32_bf16(*(const bf16x8*)(pw + (size_t)(16 * q) * 128 + 32 * ks), mf[ks], acc, 0, 0, 0);
            const int dcol = g * 128 + 16 * q + 4 * lq; const f32x4 sc = *(const f32x4*)(F.pool_scale() + (size_t)l * BW + dcol);
            u32x2 w; w.x = pk2(acc[0] * sc.x, acc[1] * sc.y); w.y = pk2(acc[2] * sc.z, acc[3] * sc.w);
            *(u32x2*)(F.Y() + row * D + 1536 + dcol) = w; }
    }
}

__device__ __forceinline__ void conv_fix_phase(Frame& F, int l) {
    const float* cw = F.conv_w() + (size_t)l * 3 * NUP; const float* cb = F.conv_b() + (size_t)l * NUP; const float* UH = F.UH();
    const int gt = F.vcu * (NWAVES * 64) + F.tid, NGT = F.G * NWAVES * 64;
    constexpr int JG = DFF / 4;
    for (int task = gt; task < (M / 256) * 2 * JG; task += NGT) {
        const int jg = task % JG, q = (task / JG) & 1, pm = task / (2 * JG);
        if ((pm & 15) == 0) continue;
        const int j0 = jg * 4, ucol = 256 * (j0 >> 7) + (j0 & 127);
        const float* u0p = UH + ((size_t)pm * 4 + q) * NUP + ucol;
        const float* u1p = (q == 1) ? UH + ((size_t)pm * 4 + 0) * NUP + ucol : UH + ((size_t)(pm - 1) * 4 + 3) * NUP + ucol;
        const float* u2p = (q == 1) ? UH + ((size_t)(pm - 1) * 4 + 3) * NUP + ucol : UH + ((size_t)(pm - 1) * 4 + 2) * NUP + ucol;
        const f32x4 a0 = *(const f32x4*)u0p, a1 = *(const f32x4*)u1p, a2 = *(const f32x4*)u2p, v0 = *(const f32x4*)(u0p + 128), v1 = *(const f32x4*)(u1p + 128), v2 = *(const f32x4*)(u2p + 128);
        const f32x4 wa0 = *(const f32x4*)(cw + j0), wa1 = *(const f32x4*)(cw + NUP + j0), wa2 = *(const f32x4*)(cw + 2 * NUP + j0), ba = *(const f32x4*)(cb + j0);
        const f32x4 wv0 = *(const f32x4*)(cw + DFF + j0), wv1 = *(const f32x4*)(cw + NUP + DFF + j0), wv2 = *(const f32x4*)(cw + 2 * NUP + DFF + j0), bv = *(const f32x4*)(cb + DFF + j0);
        float o[4];
#pragma unroll
        for (int i = 0; i < 4; ++i) { const float ca = ba[i] + wa0[i] * a2[i] + wa1[i] * a1[i] + wa2[i] * a0[i], cv = bv[i] + wv0[i] * v2[i] + wv1[i] * v1[i] + wv2[i] * v0[i]; o[i] = siluf_(ca) * cv; }
        u32x2 w; w.x = pk2(o[0], o[1]); w.y = pk2(o[2], o[3]);
        *(u32x2*)(F.ACT() + ((size_t)pm * 256 + q) * DFF + j0) = w;
    }
}

constexpr int NPH = 13;
struct Args { const void* in[25]; float* out; unsigned char* ws; int l_lo, l_hi, ph_lo, ph_hi, single, pad; };
__global__ void __launch_bounds__(NWAVES * 64, 2) hybrid_fwd(Args args) {
    extern __shared__ __attribute__((aligned(16))) unsigned char lds[];
    Frame F;
    F.lds = (LAS unsigned char*)lds;
    F.tid = threadIdx.x; F.lane = F.tid & 63; F.wave = __builtin_amdgcn_readfirstlane(F.tid >> 6);
    const int wave0 = F.wave;
    F.G = gridDim.x; { const int bx = blockIdx.x; F.vcu = (F.G % 8 == 0) ? (bx % 8) * (F.G / 8) + bx / 8 : bx; }
    unsigned char* ws = args.ws; F.ws = ws; F.out = args.out; F.l = 0;

    volatile LAS unsigned* MISC = (volatile LAS unsigned*)(F.lds + MISC_OFF);
    if (F.tid < 64) MISC[F.tid] = 0u;
    wg_sync();
    unsigned* ctl = (unsigned*)(ws + WS_CTL);
    XcdBarrier bar; bar.bar = ctl + CW_BAR; bar.x = 0; bar.st = nullptr;
    if (args.single) bar = xcd_barrier_post(ctl + CW_BAR, MISC);
#define GRID_BAR() do { if (args.single) xcd_barrier(bar); } while (0)
    const int lo = args.ph_lo, hi = args.ph_hi;
#define IN(k) (lo <= (k) && (k) < hi)
#define PH_BEGIN() do { unsigned z_ = 0u; asm volatile("" : "+v"(z_)); const int ln_ = (int)__builtin_amdgcn_mbcnt_hi(~0u, __builtin_amdgcn_mbcnt_lo(~0u, z_)); F.lane = ln_; F.tid = wave0 * 64 + ln_; F.wave = wave0; unsigned long long w_ = (unsigned long long)args.ws, o_ = (unsigned long long)args.out; asm volatile("" : "+s"(w_), "+s"(o_)); F.ws = (unsigned char*)(GAS unsigned char*)w_; F.out = (float*)(GAS float*)o_; } while (0)

    for (int l = args.l_lo; l < args.l_hi; ++l) {
        F.l = l;
        if (IN(0)) { PH_BEGIN(); phase_prep(F, l); GRID_BAR(); }
        if (IN(1)) { PH_BEGIN();
            { pg8::Gemm g{(const bf16_t*)F.HN8(), (const bf16_t*)F.W8(), M, 4 * D, D / 2, D / 2, D / 2}; pg8::StaticOrder S; S.init(M, 4 * D, F.G, (int)blockIdx.x); pg8::EpiProj E{F.PROJ(), NIN, 0, C_GATE, 1.0f / 64.0f};
              pg8::gemm_phase<pg8::EpiProj, true>(F.lds, g, S, E, F.tid); }
            PH_BEGIN();
            { pg8::Gemm g{F.HN(), F.win_t(), M, C_GATE, D, D, D}; pg8::StaticOrder S; S.init(M, C_GATE, F.G, (int)blockIdx.x); pg8::EpiProj E{F.PROJ(), NIN, 1 << 20, C_GATE, 1.0f};
              pg8::gemm_phase(F.lds, g, S, E, F.tid); }
            GRID_BAR(); }
        if (IN(2)) { PH_BEGIN(); lin_phase<false>(F, l); PH_BEGIN();
            s5_pass<false>(F, l); pool_phase(F, l); wg_sync();
            GRID_BAR(); }
        if (IN(3)) { PH_BEGIN(); lin_scan(F); s5_scan(F); GRID_BAR(); }
        if (IN(4)) { PH_BEGIN(); lin_phase<true>(F, l); PH_BEGIN();
            s5_pass<true>(F, l); wg_sync();
            GRID_BAR(); }
        if (IN(5)) { PH_BEGIN(); pg8::Gemm g{F.YBP(), F.wglu_t(), M, BW, BW, BW, BW}; pg8::StaticOrder S; S.init(M, BW, F.G, (int)blockIdx.x); pg8::EpiGlu E{F.YBP(), BW, F.Y() + BW, D};
            pg8::gemm_phase(F.lds, g, S, E, F.tid); GRID_BAR(); }
        if (IN(6)) { PH_BEGIN(); pg8::Gemm g{F.Y(), F.wbr_t(), M, D, D, D, D}; pg8::StaticOrder S; S.init(M, D, F.G, (int)blockIdx.x); pg8::EpiMerge E{F.PROJ() + C_GATE, NIN, F.HN(), D};
            pg8::gemm_phase(F.lds, g, S, E, F.tid); GRID_BAR(); }
        if (IN(7)) { PH_BEGIN(); for (int i = 0; i < (F.vcu & 7); ++i) __builtin_amdgcn_s_sleep(50);
            pg8::Gemm g{F.HN(), F.wout_t(), M, D, D, D, D}; pg8::StaticOrder S; S.init(M, D, F.G, (int)blockIdx.x); pg8::EpiResid E{l == 0 ? (const void*)F.x() : (const void*)F.out, l == 0 ? 1 : 0, F.Y(), D, F.SS()};
            pg8::gemm_phase(F.lds, g, S, E, F.tid); GRID_BAR(); }
        if (IN(8)) { PH_BEGIN(); row_scale(F); GRID_BAR(); }
        if (IN(9)) { PH_BEGIN(); pg8::Gemm g{F.Y(), F.wup_t(), M, NUP, D, D, D}; pg8::StaticOrder S; S.init(M, NUP, F.G, (int)blockIdx.x); pg8::EpiConv E{F.conv_w() + (size_t)l * 3 * NUP, F.conv_b() + (size_t)l * NUP, F.ACT(), F.UH(), (LAS float*)(F.lds + pg8::STAGE_BYTES), F.RS()};
            pg8::gemm_phase(F.lds, g, S, E, F.tid); GRID_BAR(); }
        if (IN(10)) { PH_BEGIN(); conv_fix_phase(F, l); GRID_BAR(); }
        if (IN(11)) { PH_BEGIN(); for (int i = 0; i < (F.vcu & 7); ++i) __builtin_amdgcn_s_sleep(50);
            pg8::Gemm g{F.ACT(), F.wdn_t(), M, D, DFF, DFF, DFF}; pg8::StaticOrder S; S.init(M, D, F.G, (int)blockIdx.x); pg8::EpiResid E{(const void*)F.Y(), 0, l == DEPTH - 1 ? F.HN() : (bf16_t*)F.out, D, nullptr};
            pg8::gemm_phase(F.lds, g, S, E, F.tid); GRID_BAR(); }
        if (IN(12) && l == DEPTH - 1) { PH_BEGIN(); rms_rows16_to_f32(F, F.HN(), F.g_final(), F.out); }
    }
#undef IN
#undef PH_BEGIN
#undef GRID_BAR
}

#pragma clang attribute pop
extern "C" void kernel_launch(void* const* d_in, const int* in_sizes, int n_in, void* d_out, int out_size, void* d_ws, size_t ws_size, hipStream_t stream) {
    static int grid = 0;
    if (grid == 0) {
        if (n_in != 25 || in_sizes[0] != M * D || out_size != M * D || ws_size < WS_END) { fprintf(stderr, "kernel_launch: shape/workspace mismatch (n_in %d, in0 %d, out %d, ws %zu, need %zu); nothing launched\n", n_in, n_in > 0 ? in_sizes[0] : -1, out_size, ws_size, (size_t)WS_END); grid = -1; return; }
        int dev = 0, cus = 0, per_cu = 0;
        if (hipGetDevice(&dev) != hipSuccess || hipDeviceGetAttribute(&cus, hipDeviceAttributeMultiprocessorCount, dev) != hipSuccess) { grid = -1; return; }
        if (hipFuncSetAttribute((const void*)hybrid_fwd, hipFuncAttributeMaxDynamicSharedMemorySize, LDS_BYTES) != hipSuccess) { fprintf(stderr, "kernel_launch: hipFuncSetAttribute failed\n"); grid = -1; return; }
        if (hipOccupancyMaxActiveBlocksPerMultiprocessor(&per_cu, (const void*)hybrid_fwd, NWAVES * 64, LDS_BYTES) != hipSuccess || per_cu < 1) { fprintf(stderr, "kernel_launch: occupancy query reports %d workgroups per CU\n", per_cu); }
        (void)hipGetLastError();
        grid = cus;
    }
    if (grid < 0) return;
    if (hipMemsetAsync((char*)d_ws + WS_CTL, 0, CTL_ZERO_BYTES, stream) != hipSuccess) return;
    Args a{};
    for (int i = 0; i < 25; ++i) a.in[i] = d_in[i];
    a.out = (float*)d_out; a.ws = (unsigned char*)d_ws;
#if MK_SINGLE
    a.l_lo = 0; a.l_hi = DEPTH; a.ph_lo = 0; a.ph_hi = NPH; a.single = 1;
    hipLaunchKernelGGL(hybrid_fwd, dim3(grid), dim3(NWAVES * 64), LDS_BYTES, stream, a);
#else
    a.single = 0;
    for (int l = 0; l < DEPTH; ++l)
        for (int p = 0; p < NPH; ++p) { if (p == 12 && l != DEPTH - 1) continue; a.l_lo = l; a.l_hi = l + 1; a.ph_lo = p; a.ph_hi = p + 1;
            hipLaunchKernelGGL(hybrid_fwd, dim3(grid), dim3(NWAVES * 64), LDS_BYTES, stream, a); }
#endif
}
```

```cpp
#include <hip/hip_runtime.h>
#include <cstdio>
#include <cstdint>

#ifndef MK_SINGLE
#define MK_SINGLE 1
#endif

#pragma clang attribute push(__attribute__((target("no-packed-fp32-ops"))), apply_to = function)
#define LAS __attribute__((address_space(3)))
#define GAS __attribute__((address_space(1)))
typedef unsigned short bf16_t;
typedef short bf16x8 __attribute__((ext_vector_type(8)));
typedef float f32x4 __attribute__((ext_vector_type(4)));
typedef float f32x2 __attribute__((ext_vector_type(2)));
typedef unsigned u32x4 __attribute__((ext_vector_type(4)));
typedef unsigned u32x2 __attribute__((ext_vector_type(2)));

constexpr int D = 2048, BATCH = 8, SEQ = 4096, DEPTH = 4, M = BATCH * SEQ;
constexpr int BW = 512;
constexpr int NIN_SRC = 12304, NIN = 12544;
constexpr int DFF = 5504, NUP = 11008;
constexpr int C_RQ = 0, C_RK = 256, C_RV = 512, C_RG = 1024, C_SU = 1536, C_GQ = 2048, C_GK = 2304, C_GV = 2560, C_GG = 3072, C_PU = 3584, C_GR = 4096, C_GATE = 4352;
constexpr float EPS = 1e-6f;
constexpr int NWAVES = 8;
constexpr int CH = 64;
constexpr int NCH = SEQ / CH;

constexpr size_t MiB = 1u << 20;
constexpr size_t WS_CTL = 0, CTL_ZERO_BYTES = 1 * MiB;
constexpr size_t WS_ROT = 1 * MiB;
constexpr size_t WS_S5T = 9 * MiB;
constexpr size_t S5T_ABAR = 0, S5T_APOW = 16384, S5T_BBAR = 32768, S5T_CMT = 32768 + 262144, S5T_BBT = S5T_CMT + 131072;
constexpr size_t WS_WGLU = 10 * MiB;
constexpr size_t WS_POOLW = 10 * MiB + 512 * 1024;
constexpr size_t WS_WIN = 11 * MiB;
constexpr size_t WS_WBR = 60 * MiB;
constexpr size_t WS_WOUT = 68 * MiB;
constexpr size_t WS_WUP = 76 * MiB;
constexpr size_t WS_WDN = 119 * MiB;
constexpr size_t WS_HN = 141 * MiB;
constexpr size_t WS_Y = 269 * MiB;
constexpr size_t WS_SCR = 397 * MiB;
constexpr size_t WS_YBP = WS_SCR;
constexpr size_t WS_STATE = WS_SCR + 32 * MiB;
constexpr size_t WS_SPREV = WS_SCR + 160 * MiB;
constexpr size_t WS_DEC = WS_SCR + 224 * MiB;
constexpr size_t WS_XEND = WS_SCR + 225 * MiB;
constexpr size_t WS_UH = WS_SCR + 128 * MiB;
constexpr size_t WS_PROJ = 637 * MiB;
constexpr size_t WS_ACT = WS_PROJ;
constexpr size_t WS_RS = 1421 * MiB;
constexpr size_t WS_SS = 1422 * MiB;
constexpr size_t WS_HN8 = 1438 * MiB;
constexpr size_t WS_W8 = 1502 * MiB;
constexpr size_t WS_END = 1518 * MiB;
static_assert(WS_PROJ + (size_t)M * NIN * 2 <= WS_RS, "ws map");
static_assert(WS_ACT + (size_t)M * DFF * 2 <= WS_RS, "ws map");
static_assert(WS_XEND + 8 * MiB <= WS_PROJ, "ws map");
static_assert(WS_UH + (size_t)(M / 256) * 4 * NUP * 4 <= WS_PROJ, "ws map");
constexpr int CW_TMO = 0, CW_BAR = 4096;

constexpr int LDS_BYTES = 155648;
constexpr int MISC_OFF = LDS_BYTES - 256;

#define RLX_AGENT __ATOMIC_RELAXED, __HIP_MEMORY_SCOPE_AGENT
__device__ __forceinline__ void lds_sync() { asm volatile("s_waitcnt lgkmcnt(0)" ::: "memory"); __builtin_amdgcn_s_barrier(); asm volatile("" ::: "memory"); }
__device__ __forceinline__ void wg_sync() { __builtin_amdgcn_fence(__ATOMIC_RELEASE, "workgroup"); __builtin_amdgcn_s_barrier(); __builtin_amdgcn_fence(__ATOMIC_ACQUIRE, "workgroup"); }
#define LDS_WAIT() asm volatile("s_waitcnt lgkmcnt(0)" ::: "memory")
#define VM_WAIT() asm volatile("s_waitcnt vmcnt(0)" ::: "memory")
__device__ __forceinline__ unsigned f2bf(float f) { unsigned u = __builtin_bit_cast(unsigned, f); return (u + 0x7fffu + ((u >> 16) & 1u)) >> 16; }
__device__ __forceinline__ unsigned pk2(float lo, float hi) { return f2bf(lo) | (f2bf(hi) << 16); }
__device__ __forceinline__ float bflo(unsigned w) { return __builtin_bit_cast(float, w << 16); }
__device__ __forceinline__ float bfhi(unsigned w) { return __builtin_bit_cast(float, w & 0xffff0000u); }
__device__ __forceinline__ void unpack8(const u32x4 w, float (&v)[8]) { v[0] = bflo(w.x); v[1] = bfhi(w.x); v[2] = bflo(w.y); v[3] = bfhi(w.y); v[4] = bflo(w.z); v[5] = bfhi(w.z); v[6] = bflo(w.w); v[7] = bfhi(w.w); }
__device__ __forceinline__ u32x4 pack8(const float (&v)[8]) { u32x4 w; w.x = pk2(v[0], v[1]); w.y = pk2(v[2], v[3]); w.z = pk2(v[4], v[5]); w.w = pk2(v[6], v[7]); return w; }
__device__ __forceinline__ unsigned pk4_fp8(float a, float b, float c, float d) { unsigned w = 0u; w = __builtin_amdgcn_cvt_pk_fp8_f32(a, b, w, false); w = __builtin_amdgcn_cvt_pk_fp8_f32(c, d, w, true); return w; }
__device__ __forceinline__ float sigmoidf_(float x) { return 1.0f / (1.0f + __expf(-x)); }
__device__ __forceinline__ float siluf_(float x) { return x / (1.0f + __expf(-x)); }
__device__ __forceinline__ float gelu_tanh(float x) { const float u = 1.5957691216f * (x + 0.044715f * x * x * x); return x / (1.0f + __expf(-u)); }
__device__ __forceinline__ float logsigmoidf_(float x) { return fminf(x, 0.f) - __logf(1.0f + __expf(-fabsf(x))); }

namespace pg8 {
constexpr int BM = 256, BK = 64, HALF = 128, HTB = HALF * BK * 2, STAGE_BYTES = 8 * HTB, NXCD = 8, WGM = 4;
__host__ __device__ __forceinline__ int lds_byte(int r, int c) { const int st = (r >> 4) * 2 + (c >> 5), rr = r & 15, cc = c & 31, ob = rr * 64 + cc * 2; return st * 1024 + (ob ^ (((ob >> 9) & 1) << 5)); }
__host__ __device__ __forceinline__ void stage_rc(int b, int& R, int& C) { const int st = b / 1024, sb = b % 1024, swz = sb ^ (((sb >> 9) & 1) << 5); R = (st >> 1) * 16 + swz / 64; C = (st & 1) * 32 + (swz % 64) / 2; }
__host__ __device__ __forceinline__ int perm32(int rho) { const int n = rho >> 4, i = rho & 15; return 8 * (i >> 2) + 4 * n + (i & 3); }

struct Unit { int pm, pn; };
struct Gemm { const bf16_t* A; const bf16_t* Bt; int M, N, K, lda, ldb; };

struct StaticOrder {
    int nM, nN, nwg, G, c;
    __host__ __device__ void init(int M_, int N_, int G_, int c_) { nM = M_ / BM; nN = N_ / BM; nwg = nM * nN; G = G_; c = c_; }
    __host__ __device__ bool next(int i, Unit& u) const {
        const long L = (long)i * G + c; if (L >= nwg) return false;
        int wgid = (int)L; { const int q = nwg / NXCD, r = nwg % NXCD, xcd = wgid % NXCD, off = wgid / NXCD; wgid = (xcd < r ? xcd * (q + 1) : r * (q + 1) + (xcd - r) * q) + off; }
        const int nig = WGM * nN, gid = wgid / nig, fm = gid * WGM, gsz = (nM - fm) < WGM ? (nM - fm) : WGM;
        u.pm = fm + ((wgid % nig) % gsz); u.pn = (wgid % nig) / gsz; return true;
    }
};

__device__ __forceinline__ unsigned cvt_pk_bf16(float lo, float hi) { unsigned r; asm volatile("v_cvt_pk_bf16_f32 %0, %1, %2" : "=v"(r) : "v"(lo), "v"(hi)); return r; }

struct EpiStoreBf16 {
    static constexpr bool PERM = true, KHOOK = false;
    bf16_t* O; int ldc;
    __device__ __forceinline__ void khook(f32x4 (&)[2][2][4][2], const Unit&, int, int, int, int, int) const {}
    __device__ __forceinline__ void operator()(f32x4 (&acc)[2][2][4][2], const Unit& u, int wr, int wc, int fr, int fq) const {
        const int row0 = u.pm * BM + wr * 64 + fr, col0 = u.pn * BM + wc * 32 + 8 * fq;
#pragma unroll
        for (int ai = 0; ai < 2; ++ai)
#pragma unroll
            for (int m = 0; m < 4; ++m) { bf16_t* rowp = O + (size_t)(row0 + ai * HALF + m * 16) * ldc + col0;
#pragma unroll
                for (int bj = 0; bj < 2; ++bj) { const f32x4 v0 = acc[ai][bj][m][0], v1 = acc[ai][bj][m][1];
                    u32x4 w; w.x = cvt_pk_bf16(v0[0], v0[1]); w.y = cvt_pk_bf16(v0[2], v0[3]); w.z = cvt_pk_bf16(v1[0], v1[1]); w.w = cvt_pk_bf16(v1[2], v1[3]);
                    *(u32x4*)(rowp + bj * HALF) = w; } }
    }
};
struct EpiProj {
    static constexpr bool PERM = true, KHOOK = false;
    bf16_t* O; int ldc; int gate_pn0; int gate_col0; float gscale;
    __device__ __forceinline__ void khook(f32x4 (&)[2][2][4][2], const Unit&, int, int, int, int, int) const {}
    __device__ __forceinline__ void operator()(f32x4 (&acc)[2][2][4][2], const Unit& u, int wr, int wc, int fr_, int fq_) const {
        int fr = fr_, fq = fq_; asm volatile("" : "+v"(fr), "+v"(fq));
        const int row0 = u.pm * BM + wr * 64 + fr;
        if (u.pn < gate_pn0) {
            const int col0 = u.pn * BM + wc * 32 + 8 * fq;
#pragma unroll
            for (int ai = 0; ai < 2; ++ai)
#pragma unroll
                for (int m = 0; m < 4; ++m) { bf16_t* rowp = O + (size_t)(row0 + ai * HALF + m * 16) * ldc + col0;
#pragma unroll
                    for (int bj = 0; bj < 2; ++bj) { const f32x4 v0 = acc[ai][bj][m][0], v1 = acc[ai][bj][m][1];
                        u32x4 w; w.x = cvt_pk_bf16(v0[0], v0[1]); w.y = cvt_pk_bf16(v0[2], v0[3]); w.z = cvt_pk_bf16(v1[0], v1[1]); w.w = cvt_pk_bf16(v1[2], v1[3]);
                        *(u32x4*)(rowp + bj * HALF) = w; } }
        } else {
            const int col0 = gate_col0 + 64 * (u.pn - gate_pn0) + 16 * wc + 4 * fq;
#pragma unroll
            for (int ai = 0; ai < 2; ++ai)
#pragma unroll
                for (int m = 0; m < 4; ++m) { bf16_t* rowp = O + (size_t)(row0 + ai * HALF + m * 16) * ldc + col0;
                    float r1[4], r2[4], r3[4], g3[4];
#pragma unroll
                    for (int i = 0; i < 4; ++i) {
                        const float e0 = __expf(-fminf(fmaxf(acc[ai][0][m][0][i] * gscale, -30.f), 30.f)), e1 = __expf(-fminf(fmaxf(acc[ai][0][m][1][i] * gscale, -30.f), 30.f));
                        const float e2 = __expf(-fminf(fmaxf(acc[ai][1][m][0][i] * gscale, -30.f), 30.f)), e3 = __expf(-fminf(fmaxf(acc[ai][1][m][1][i] * gscale, -30.f), 30.f));
                        const float i0 = __builtin_amdgcn_rcpf(1.f + e0), i1 = __builtin_amdgcn_rcpf(1.f + e1), i2 = __builtin_amdgcn_rcpf(1.f + e2), i3 = __builtin_amdgcn_rcpf(1.f + e3);
                        r1[i] = (1.f + e1) * i0; r2[i] = (1.f + e2) * i1; r3[i] = (1.f + e3) * i2; g3[i] = i3; }
                    u32x2 w;
                    w.x = cvt_pk_bf16(r1[0], r1[1]); w.y = cvt_pk_bf16(r1[2], r1[3]); *(u32x2*)(rowp) = w;
                    w.x = cvt_pk_bf16(r2[0], r2[1]); w.y = cvt_pk_bf16(r2[2], r2[3]); *(u32x2*)(rowp + D) = w;
                    w.x = cvt_pk_bf16(r3[0], r3[1]); w.y = cvt_pk_bf16(r3[2], r3[3]); *(u32x2*)(rowp + 2 * D) = w;
                    w.x = cvt_pk_bf16(g3[0], g3[1]); w.y = cvt_pk_bf16(g3[2], g3[3]); *(u32x2*)(rowp + 3 * D) = w; }
        }
    }
};
__device__ __forceinline__ float dpp_ror1(float x) { return __builtin_bit_cast(float, __builtin_amdgcn_update_dpp(0, __builtin_bit_cast(int, x), 0x121, 0xf, 0xf, false)); }
__device__ __forceinline__ float dpp_ror2(float x) { return __builtin_bit_cast(float, __builtin_amdgcn_update_dpp(0, __builtin_bit_cast(int, x), 0x122, 0xf, 0xf, false)); }
struct EpiConv {
    static constexpr bool PERM = true, KHOOK = false;
    const float* cw; const float* cb; bf16_t* O; float* UH; LAS float* halo; const float* RS;
    __device__ __forceinline__ void khook(f32x4 (&)[2][2][4][2], const Unit&, int, int, int, int, int) const {}
    __device__ __forceinline__ void operator()(f32x4 (&acc)[2][2][4][2], const Unit& u, int wr, int wc, int fr_, int fq_) const {
        int fr = fr_, fq = fq_; asm volatile("" : "+v"(fr), "+v"(fq));
        const int cl0 = wc * 32 + 8 * fq;
        const int j0 = 128 * u.pn + cl0;
        const float* rp = RS + ((size_t)(u.pm * 2 + wr) * 16 + fr) * 8; const f32x4 rs0 = *(const f32x4*)rp, rs1 = *(const f32x4*)(rp + 4);
        f32x4 wa0[3], wv0[3];
#pragma unroll
        for (int q = 0; q < 3; ++q) { wa0[q] = *(const f32x4*)(cw + q * NUP + j0); wv0[q] = *(const f32x4*)(cw + q * NUP + DFF + j0); }
        const f32x4 ba0 = *(const f32x4*)(cb + j0), bv0 = *(const f32x4*)(cb + DFF + j0);
#pragma unroll
        for (int ai = 0; ai < 2; ++ai)
#pragma unroll
            for (int m = 0; m < 4; ++m) { const float r = ai == 0 ? rs0[m] : rs1[m];
#pragma unroll
                for (int bj = 0; bj < 2; ++bj)
#pragma unroll
                    for (int n = 0; n < 2; ++n) acc[ai][bj][m][n] *= r; }
        if (fr >= 14) {
#pragma unroll
            for (int ai = 0; ai < 2; ++ai)
#pragma unroll
                for (int bj = 0; bj < 2; ++bj)
#pragma unroll
                    for (int n = 0; n < 2; ++n) *(LAS f32x4*)(halo + (((2 * ai + wr) * 2 + (fr - 14)) * 256 + 128 * bj + cl0 + 4 * n)) = acc[ai][bj][3][n];
        }
        if (wr == 0 && fr < 2) {
#pragma unroll
            for (int bj = 0; bj < 2; ++bj)
#pragma unroll
                for (int n = 0; n < 2; ++n) *(f32x4*)(UH + ((size_t)u.pm * 4 + fr) * NUP + 256 * u.pn + 128 * bj + cl0 + 4 * n) = acc[0][bj][0][n];
        }
        if (wr == 1 && fr >= 14) {
#pragma unroll
            for (int bj = 0; bj < 2; ++bj)
#pragma unroll
                for (int n = 0; n < 2; ++n) *(f32x4*)(UH + ((size_t)u.pm * 4 + 2 + (fr - 14)) * NUP + 256 * u.pn + 128 * bj + cl0 + 4 * n) = acc[1][bj][3][n];
        }
        asm volatile("s_waitcnt lgkmcnt(0)" ::: "memory"); __builtin_amdgcn_s_barrier(); asm volatile("" ::: "memory");
        const bool is15 = fr == 15, ge14 = fr >= 14;
        unsigned keep[2][4][2];
        f32x4 wa1[3], wv1[3];
#pragma unroll
        for (int q = 0; q < 3; ++q) { wa1[q] = *(const f32x4*)(cw + q * NUP + j0 + 4); wv1[q] = *(const f32x4*)(cw + q * NUP + DFF + j0 + 4); }
        const f32x4 ba1 = *(const f32x4*)(cb + j0 + 4), bv1 = *(const f32x4*)(cb + DFF + j0 + 4);
#pragma unroll
        for (int n = 0; n < 2; ++n) {
            f32x4 wa[3], wv[3];
#pragma unroll
            for (int q = 0; q < 3; ++q) { wa[q] = n == 0 ? wa0[q] : wa1[q]; wv[q] = n == 0 ? wv0[q] : wv1[q]; }
            const f32x4 ba = n == 0 ? ba0 : ba1, bv = n == 0 ? bv0 : bv1;
#pragma unroll
            for (int ai = 0; ai < 2; ++ai) {
                const int blk = 2 * ai + wr;
                f32x4 pa = (f32x4){0.f, 0.f, 0.f, 0.f}, pv = (f32x4){0.f, 0.f, 0.f, 0.f};
                if (blk > 0 && ge14) { pa = *(const LAS f32x4*)(halo + (((blk - 1) * 2 + (fr - 14)) * 256 + cl0 + 4 * n)); pv = *(const LAS f32x4*)(halo + (((blk - 1) * 2 + (fr - 14)) * 256 + 128 + cl0 + 4 * n)); }
#pragma unroll
                for (int m = 0; m < 4; ++m) {
                    const f32x4 ca_ = acc[ai][0][m][n], cv_ = acc[ai][1][m][n]; float o[4];
#pragma unroll
                    for (int i = 0; i < 4; ++i) {
                        const float a1 = dpp_ror1(is15 ? pa[i] : ca_[i]), a2 = dpp_ror2(ge14 ? pa[i] : ca_[i]);
                        const float v1 = dpp_ror1(is15 ? pv[i] : cv_[i]), v2 = dpp_ror2(ge14 ? pv[i] : cv_[i]);
                        const float ca = ba[i] + wa[0][i] * a2 + wa[1][i] * a1 + wa[2][i] * ca_[i];
                        const float cv = bv[i] + wv[0][i] * v2 + wv[1][i] * v1 + wv[2][i] * cv_[i];
                        o[i] = siluf_(ca) * cv; }
                    pa = ca_; pv = cv_;
                    const unsigned lo = cvt_pk_bf16(o[0], o[1]), hi = cvt_pk_bf16(o[2], o[3]);
                    if (n == 0) { keep[ai][m][0] = lo; keep[ai][m][1] = hi; }
                    else { u32x4 w; w.x = keep[ai][m][0]; w.y = keep[ai][m][1]; w.z = lo; w.w = hi;
                        *(u32x4*)(O + (size_t)(u.pm * BM + ai * HALF + wr * 64 + m * 16 + fr) * DFF + j0) = w; }
                }
            }
        }
    }
};
struct EpiResid {
    static constexpr bool PERM = true, KHOOK = false;
    const void* base; int base_f32; bf16_t* O; int ldc; float* SS;
    __device__ __forceinline__ void khook(f32x4 (&)[2][2][4][2], const Unit&, int, int, int, int, int) const {}
    __device__ __forceinline__ void finish(const float (&b)[8], const f32x4 v0, const f32x4 v1, bf16_t* op, float& sq) const {
        const float o0 = b[0] + v0[0], o1 = b[1] + v0[1], o2 = b[2] + v0[2], o3 = b[3] + v0[3], o4 = b[4] + v1[0], o5 = b[5] + v1[1], o6 = b[6] + v1[2], o7 = b[7] + v1[3];
        u32x4 w; w.x = cvt_pk_bf16(o0, o1); w.y = cvt_pk_bf16(o2, o3); w.z = cvt_pk_bf16(o4, o5); w.w = cvt_pk_bf16(o6, o7);
        *(u32x4*)op = w;
        sq += ((o0 * o0 + o1 * o1) + (o2 * o2 + o3 * o3)) + ((o4 * o4 + o5 * o5) + (o6 * o6 + o7 * o7));
    }
    __device__ __forceinline__ void rowsum(float sq, const Unit& u, int wc, int fq, int lane, int row) const {
        sq += __builtin_bit_cast(float, __builtin_amdgcn_ds_bpermute((lane ^ 16) << 2, __builtin_bit_cast(int, sq)));
        sq += __builtin_bit_cast(float, __builtin_amdgcn_ds_bpermute((lane ^ 32) << 2, __builtin_bit_cast(int, sq)));
        if (fq == 0) SS[(size_t)(u.pn * 4 + wc) * M + row] = sq;
    }
    __device__ __forceinline__ void operator()(f32x4 (&acc)[2][2][4][2], const Unit& u, int wr, int wc, int fr_, int fq_) const {
        int fr = fr_, fq = fq_; asm volatile("" : "+v"(fr), "+v"(fq));
        const int row0 = u.pm * BM + wr * 64 + fr, col0 = u.pn * BM + wc * 32 + 8 * fq, lane = fq * 16 + fr;
        if (!base_f32) {
            u32x4 bw[2][4][2];
#pragma unroll
            for (int ai = 0; ai < 2; ++ai)
#pragma unroll
                for (int m = 0; m < 4; ++m)
#pragma unroll
                    for (int bj = 0; bj < 2; ++bj) bw[ai][m][bj] = *(const u32x4*)((const bf16_t*)base + (size_t)(row0 + ai * HALF + m * 16) * ldc + col0 + bj * HALF);
#pragma unroll
            for (int ai = 0; ai < 2; ++ai)
#pragma unroll
                for (int m = 0; m < 4; ++m) { const size_t off = (size_t)(row0 + ai * HALF + m * 16) * ldc + col0; float sq = 0.f;
#pragma unroll
                    for (int bj = 0; bj < 2; ++bj) { float b[8]; unpack8(bw[ai][m][bj], b); finish(b, acc[ai][bj][m][0], acc[ai][bj][m][1], O + off + bj * HALF, sq); }
                    if (SS) rowsum(sq, u, wc, fq, lane, row0 + ai * HALF + m * 16); }
        } else {
#pragma unroll
            for (int ai = 0; ai < 2; ++ai)
#pragma unroll
                for (int m = 0; m < 4; ++m) { const size_t off = (size_t)(row0 + ai * HALF + m * 16) * ldc + col0; float sq = 0.f;
#pragma unroll
                    for (int bj = 0; bj < 2; ++bj) { float b[8]; const float* bp = (const float*)base + off + bj * HALF; const f32x4 b0 = *(const f32x4*)bp, b1 = *(const f32x4*)(bp + 4);
                        b[0] = b0.x; b[1] = b0.y; b[2] = b0.z; b[3] = b0.w; b[4] = b1.x; b[5] = b1.y; b[6] = b1.z; b[7] = b1.w;
                        finish(b, acc[ai][bj][m][0], acc[ai][bj][m][1], O + off + bj * HALF, sq); }
                    if (SS) rowsum(sq, u, wc, fq, lane, row0 + ai * HALF + m * 16);
                    asm volatile("" ::: "memory"); }
        }
    }
};
struct EpiGlu {
    static constexpr bool PERM = true, KHOOK = false;
    const bf16_t* Yp; int ldy; bf16_t* O; int ldc;
    __device__ __forceinline__ void khook(f32x4 (&)[2][2][4][2], const Unit&, int, int, int, int, int) const {}
    __device__ __forceinline__ void operator()(f32x4 (&acc)[2][2][4][2], const Unit& u, int wr, int wc, int fr, int fq) const {
        const int row0 = u.pm * BM + wr * 64 + fr, col0 = u.pn * BM + wc * 32 + 8 * fq;
#pragma unroll
        for (int ai = 0; ai < 2; ++ai)
#pragma unroll
            for (int m = 0; m < 4; ++m) { const size_t r = (size_t)(row0 + ai * HALF + m * 16);
#pragma unroll
                for (int bj = 0; bj < 2; ++bj) { const u32x4 yw = *(const u32x4*)(Yp + r * ldy + col0 + bj * HALF); float y[8]; unpack8(yw, y);
                    const f32x4 v0 = acc[ai][bj][m][0], v1 = acc[ai][bj][m][1]; float o[8];
#pragma unroll
                    for (int j = 0; j < 4; ++j) { o[j] = y[j] * sigmoidf_(v0[j]); o[4 + j] = y[4 + j] * sigmoidf_(v1[j]); }
                    u32x4 w; w.x = cvt_pk_bf16(o[0], o[1]); w.y = cvt_pk_bf16(o[2], o[3]); w.z = cvt_pk_bf16(o[4], o[5]); w.w = cvt_pk_bf16(o[6], o[7]);
                    *(u32x4*)(O + r * ldc + col0 + bj * HALF) = w; } }
    }
};
struct EpiMerge {
    static constexpr bool PERM = true, KHOOK = true;
    const bf16_t* G; int ldg; bf16_t* O; int ldc;
    __device__ __forceinline__ void scale(f32x4 (&acc)[2][2][4][2], const Unit& u, int s, int wr, int wc, int fr, int fq) const {
        int row0 = u.pm * BM + wr * 64 + fr, col0 = u.pn * BM + wc * 32 + 8 * fq + s * D; asm volatile("" : "+v"(row0), "+v"(col0));
        u32x4 w[2][4][2];
#pragma unroll
        for (int ai = 0; ai < 2; ++ai)
#pragma unroll
            for (int m = 0; m < 4; ++m) { const bf16_t* gp = G + (size_t)(row0 + ai * HALF + m * 16) * ldg + col0;
#pragma unroll
                for (int bj = 0; bj < 2; ++bj) w[ai][m][bj] = *(const u32x4*)(gp + bj * HALF); }
#pragma unroll
        for (int ai = 0; ai < 2; ++ai)
#pragma unroll
            for (int m = 0; m < 4; ++m)
#pragma unroll
                for (int bj = 0; bj < 2; ++bj) { float f[8]; unpack8(w[ai][m][bj], f);
#pragma unroll
                    for (int j = 0; j < 8; ++j) acc[ai][bj][m][j >> 2][j & 3] *= f[j]; }
    }
    __device__ __forceinline__ void khook(f32x4 (&acc)[2][2][4][2], const Unit& u, int seg, int wr, int wc, int fr, int fq) const { scale(acc, u, seg - 1, wr, wc, fr, fq); }
    __device__ __forceinline__ void operator()(f32x4 (&acc)[2][2][4][2], const Unit& u, int wr, int wc, int fr, int fq) const {
        scale(acc, u, 3, wr, wc, fr, fq);
        const int row0 = u.pm * BM + wr * 64 + fr, col0 = u.pn * BM + wc * 32 + 8 * fq;
#pragma unroll
        for (int ai = 0; ai < 2; ++ai)
#pragma unroll
            for (int m = 0; m < 4; ++m) { bf16_t* rowp = O + (size_t)(row0 + ai * HALF + m * 16) * ldc + col0;
#pragma unroll
                for (int bj = 0; bj < 2; ++bj) { const f32x4 v0 = acc[ai][bj][m][0], v1 = acc[ai][bj][m][1];
                    u32x4 w; w.x = cvt_pk_bf16(v0[0], v0[1]); w.y = cvt_pk_bf16(v0[2], v0[3]); w.z = cvt_pk_bf16(v1[0], v1[1]); w.w = cvt_pk_bf16(v1[2], v1[3]);
                    *(u32x4*)(rowp + bj * HALF) = w; } }
    }
};

typedef int v4i_t __attribute__((ext_vector_type(4)));
typedef int v8i_t __attribute__((ext_vector_type(8)));
template <class Epi, bool F8 = false>
__device__ __forceinline__ void gemm_phase(LAS unsigned char* lds, const Gemm g, const StaticOrder& S, const Epi& E, int tid_in) {
    int tid_ = tid_in; asm volatile("" : "+v"(tid_));
    const int tid = tid_, wid = __builtin_amdgcn_readfirstlane(tid >> 6), lane = tid & 63, wr = wid >> 2, wc = wid & 3, fr = lane & 15, fq = lane >> 4;
    const int K = g.K, nt = K / BK;
    unsigned voffA[2], voffB[2];
#pragma unroll
    for (int i = 0; i < 2; ++i) { int R, C; stage_rc(tid * 16 + i * 8192, R, C); const int Rb = Epi::PERM ? ((R & ~31) + perm32(R & 31)) : R;
        voffA[i] = (unsigned)(R * g.lda + C) * 2u; voffB[i] = (unsigned)(Rb * g.ldb + C) * 2u; }
    const size_t kstep = (size_t)(BK * 2);
    const size_t hstepA = (size_t)HALF * g.lda * 2, hstepB = (size_t)HALF * g.ldb * 2;
    const size_t tstepA = 2 * hstepA, tstepB = 2 * hstepB;
    const unsigned ldsw = (unsigned)wid * 1024u;
    const int aoff = lds_byte(wr * 64 + fr, fq * 8), boff = lds_byte(wc * 32 + fr, fq * 8);
#define PG8_SA(b, h) (((b) * 2 + (h)) * HTB)
#define PG8_SB(b, h) ((4 + (b) * 2 + (h)) * HTB)
#define PG8_STAGE(bufoff, gbase, voff) do { _Pragma("unroll") for (int _i = 0; _i < 2; ++_i) \
        __builtin_amdgcn_global_load_lds((const unsigned*)((const char*)(gbase) + (voff)[_i]), (LAS unsigned*)(lds + (bufoff) + ldsw + _i * 8192), 16, 0, 0); } while (0)
#define PG8_LDA(dst, b, h) do { _Pragma("unroll") for (int m = 0; m < 4; ++m) _Pragma("unroll") for (int k = 0; k < 2; ++k) dst[m][k] = *(const LAS bf16x8*)(lds + PG8_SA(b, h) + aoff + m * 2048 + k * 1024); } while (0)
#define PG8_LDB(dst, b, h) do { _Pragma("unroll") for (int n = 0; n < 2; ++n) _Pragma("unroll") for (int k = 0; k < 2; ++k) dst[n][k] = *(const LAS bf16x8*)(lds + PG8_SB(b, h) + boff + n * 2048 + k * 1024); } while (0)
#define PG8_MMA(ai, bj, At, Bt) do { __builtin_amdgcn_s_setprio(1); _Pragma("unroll") for (int m = 0; m < 4; ++m) _Pragma("unroll") for (int n = 0; n < 2; ++n) _Pragma("unroll") for (int k = 0; k < 2; ++k) \
        acc[ai][bj][m][n] = __builtin_amdgcn_mfma_f32_16x16x32_bf16(Bt[n][k], At[m][k], acc[ai][bj][m][n], 0, 0, 0); __builtin_amdgcn_s_setprio(0); } while (0)
#define PG8_MMA16(ai, bj, At, Bt) PG8_MMA(ai, bj, At, Bt)
#define PG8_MMA8(ai, bj, A8, B8) do { __builtin_amdgcn_s_setprio(1); _Pragma("unroll") for (int m = 0; m < 4; ++m) _Pragma("unroll") for (int n = 0; n < 2; ++n) \
        asm volatile("v_mfma_f32_16x16x128_f8f6f4 %0, %1, %2, %0" : "+v"(acc[ai][bj][m][n]) : "v"(B8[n]), "v"(A8[m])); __builtin_amdgcn_s_setprio(0); } while (0)
#define PG8_LDA8(dst, b, h) do { _Pragma("unroll") for (int m = 0; m < 4; ++m) { dst[m].lo = *(const LAS v4i_t*)(lds + PG8_SA(b, h) + aoff + m * 2048); dst[m].hi = *(const LAS v4i_t*)(lds + PG8_SA(b, h) + aoff + m * 2048 + 1024); } } while (0)
#define PG8_LDB8(dst, b, h) do { _Pragma("unroll") for (int n = 0; n < 2; ++n) { dst[n].lo = *(const LAS v4i_t*)(lds + PG8_SB(b, h) + boff + n * 2048); dst[n].hi = *(const LAS v4i_t*)(lds + PG8_SB(b, h) + boff + n * 2048 + 1024); } } while (0)
#define PG8_XLDA(b, h) do { if constexpr (F8) PG8_LDA8(A8, b, h); else PG8_LDA(At, b, h); } while (0)
#define PG8_XLDB0(b, h) do { if constexpr (F8) PG8_LDB8(B08, b, h); else PG8_LDB(B0, b, h); } while (0)
#define PG8_XLDB1(b, h) do { if constexpr (F8) PG8_LDB8(B18, b, h); else PG8_LDB(B1, b, h); } while (0)
#define PG8_MM0(ai, bj) do { if constexpr (F8) PG8_MMA8(ai, bj, A8, B08); else PG8_MMA16(ai, bj, At, B0); } while (0)
#define PG8_MM1(ai, bj) do { if constexpr (F8) PG8_MMA8(ai, bj, A8, B18); else PG8_MMA16(ai, bj, At, B1); } while (0)
#define PG8_WAIT_V(n) asm volatile("s_waitcnt vmcnt(" #n ")" ::: "memory")
#define PG8_WAIT_L(n) asm volatile("s_waitcnt lgkmcnt(" #n ")" ::: "memory")
#define PG8_BAR __builtin_amdgcn_s_barrier()
#define PG8_SCHED __builtin_amdgcn_sched_barrier(0)
    Unit cur, nxt; int ui = 0;
    if (!S.next(0, cur)) return;
    f32x4 acc[2][2][4][2];
#pragma unroll
    for (int a = 0; a < 2; ++a)
#pragma unroll
        for (int b = 0; b < 2; ++b)
#pragma unroll
            for (int m = 0; m < 4; ++m)
#pragma unroll
                for (int n = 0; n < 2; ++n) acc[a][b][m][n] = (f32x4){0.f, 0.f, 0.f, 0.f};
    bf16x8 At[4][2], B0[2][2], B1[2][2]; v8i_t A8[4], B08[2], B18[2];
    const char* cA = (const char*)g.A + (size_t)cur.pm * tstepA; const char* cB = (const char*)g.Bt + (size_t)cur.pn * tstepB;
    PG8_STAGE(PG8_SB(0, 0), cB, voffB); PG8_STAGE(PG8_SB(0, 1), cB + hstepB, voffB); PG8_STAGE(PG8_SA(0, 0), cA, voffA); PG8_STAGE(PG8_SA(0, 1), cA + hstepA, voffA);
    if (wr == 1) PG8_BAR;
    PG8_WAIT_V(2); PG8_BAR;
    PG8_STAGE(PG8_SB(1, 0), cB + kstep, voffB); PG8_STAGE(PG8_SA(1, 0), cA + kstep, voffA); PG8_STAGE(PG8_SB(1, 1), cB + hstepB + kstep, voffB);
    PG8_WAIT_V(6); PG8_BAR;
    for (;;) {
        const bool has_next = S.next(ui + 1, nxt);
        const char* nA = has_next ? (const char*)g.A + (size_t)nxt.pm * tstepA : cA; const char* nB = has_next ? (const char*)g.Bt + (size_t)nxt.pn * tstepB : cB;
        for (int t = 0; t < nt; t += 2) {
            const bool last = (t == nt - 2);
            const char* a1 = cA + (size_t)(t + 1) * kstep;
            const char* a2 = last ? nA : cA + (size_t)(t + 2) * kstep; const char* b2 = last ? nB : cB + (size_t)(t + 2) * kstep;
            const char* a3 = a2 + kstep; const char* b3 = b2 + kstep;
            if constexpr (Epi::KHOOK) { if (t != 0 && (t & 7) == 0) E.khook(acc, cur, t >> 3, wr, wc, fr, fq); }
            PG8_XLDB0(0, 0); PG8_XLDB1(0, 1); PG8_SCHED; PG8_XLDA(0, 0); PG8_STAGE(PG8_SA(1, 1), a1 + hstepA, voffA);
            PG8_WAIT_V(8); PG8_WAIT_L(0); PG8_BAR; PG8_MM0(0, 0); PG8_MM1(0, 1); PG8_BAR; PG8_SCHED;
            PG8_XLDA(0, 1); PG8_STAGE(PG8_SB(0, 0), b2, voffB); PG8_STAGE(PG8_SB(0, 1), b2 + hstepB, voffB); PG8_STAGE(PG8_SA(0, 0), a2, voffA);
            PG8_WAIT_V(8); PG8_WAIT_L(0); PG8_BAR; PG8_MM0(1, 0); PG8_MM1(1, 1); PG8_BAR; PG8_SCHED;
            PG8_XLDB0(1, 0); PG8_XLDB1(1, 1); PG8_SCHED; PG8_XLDA(1, 0); PG8_STAGE(PG8_SA(0, 1), a2 + hstepA, voffA);
            PG8_WAIT_V(8); PG8_WAIT_L(0); PG8_BAR; PG8_MM0(0, 0); PG8_MM1(0, 1); PG8_BAR; PG8_SCHED;
            PG8_XLDA(1, 1); PG8_STAGE(PG8_SB(1, 0), b3, voffB); PG8_STAGE(PG8_SB(1, 1), b3 + hstepB, voffB); PG8_STAGE(PG8_SA(1, 0), a3, voffA);
            PG8_WAIT_V(8); PG8_WAIT_L(0); PG8_BAR; PG8_MM0(1, 0); PG8_MM1(1, 1); PG8_BAR; PG8_SCHED;
        }
        if (wr == 0) PG8_BAR;
        E(acc, cur, wr, wc, fr, fq);
        if (!has_next) break;
#pragma unroll
        for (int a = 0; a < 2; ++a)
#pragma unroll
            for (int b = 0; b < 2; ++b)
#pragma unroll
                for (int m = 0; m < 4; ++m)
#pragma unroll
                    for (int n = 0; n < 2; ++n) acc[a][b][m][n] = (f32x4){0.f, 0.f, 0.f, 0.f};
        cur = nxt; cA = nA; cB = nB; ++ui;
        if (wr == 1) PG8_BAR;
    }
    PG8_WAIT_V(0);
    PG8_BAR;
#undef PG8_SA
#undef PG8_SB
#undef PG8_STAGE
#undef PG8_LDA
#undef PG8_LDB
#undef PG8_MMA
#undef PG8_MMA8
#undef PG8_MMA16
#undef PG8_LDA8
#undef PG8_LDB8
#undef PG8_XLDA
#undef PG8_XLDB0
#undef PG8_XLDB1
#undef PG8_MM0
#undef PG8_MM1
#undef PG8_WAIT_V
#undef PG8_WAIT_L
#undef PG8_BAR
#undef PG8_SCHED
}
}

#define XB_TMO      128
#define XB_XCNT(j)  (256  + 64 * (j))
#define XB_XSUB(j)  (1280 + 64 * (j))
#define XB_XGEN(j)  (2304 + 64 * (j))
#define XB_TOP      3328
#define XB_TOPGEN   3392
#define XCD_BAR_WORDS 3456
#define XB_SPIN_CAP (1u << 18)
__device__ __forceinline__ unsigned xb_ld(unsigned* p)              { return __hip_atomic_load(p, __ATOMIC_RELAXED, __HIP_MEMORY_SCOPE_AGENT); }
__device__ __forceinline__ unsigned xb_add(unsigned* p, unsigned v) { return __hip_atomic_fetch_add(p, v, __ATOMIC_RELAXED, __HIP_MEMORY_SCOPE_AGENT); }
__device__ __forceinline__ unsigned xb_xcc_id() { return (unsigned)__builtin_amdgcn_s_getreg((3 << 11) | 20) & 0xFu; }
#define XB_SPIN(cond, bar) do { unsigned _sp = 0; while (cond) { __builtin_amdgcn_s_sleep(1); \
    if ((++_sp & 255u) == 0u) { if (xb_ld(&(bar)[XB_TMO])) break; if (_sp > XB_SPIN_CAP) { (void)__hip_atomic_fetch_add(&(bar)[XB_TMO], 1u, __ATOMIC_RELAXED, __HIP_MEMORY_SCOPE_AGENT); break; } } } } while (0)
struct XcdBarrier { unsigned* bar; unsigned x; volatile LAS unsigned* st; };
__device__ __forceinline__ XcdBarrier xcd_barrier_post(unsigned* bar, volatile LAS unsigned* st) {
    XcdBarrier b; b.bar = bar; b.x = xb_xcc_id(); b.st = st;
    if (threadIdx.x == 0) (void)xb_add(&bar[XB_XCNT(b.x)], 1u);
    return b;
}
__device__ __forceinline__ void xcd_barrier_complete(unsigned* bar, unsigned x, unsigned& nloc, unsigned& nx) {
    const unsigned G = gridDim.x * gridDim.y * gridDim.z;
    unsigned sum, cnt, mine, sp = 0u;
    for (;;) {
        sum = 0u; cnt = 0u; mine = 0u;
#pragma nounroll
        for (unsigned j = 0; j < 16; ++j) { const unsigned c = xb_ld(&bar[XB_XCNT(j)]); sum += c; cnt += (c > 0u) ? 1u : 0u; mine = (j == x) ? c : mine; }
        if (sum == G) break;
        __builtin_amdgcn_s_sleep(1);
        if ((++sp & 255u) == 0u) { if (xb_ld(&bar[XB_TMO])) break; if (sp > XB_SPIN_CAP) { (void)__hip_atomic_fetch_add(&bar[XB_TMO], 1u, __ATOMIC_RELAXED, __HIP_MEMORY_SCOPE_AGENT); break; } }
    }
    nloc = mine > 0u ? mine : 1u; nx = cnt > 0u ? cnt : 1u;
}
__device__ __forceinline__ void xcd_barrier(const XcdBarrier& b) {
    asm volatile("s_waitcnt vmcnt(0)" ::: "memory");
    wg_sync();
    if (threadIdx.x == 0) {
        unsigned* bar = b.bar;
        __builtin_amdgcn_s_waitcnt(0);
        unsigned nloc = b.st[0], nx = b.st[1];
        if (nloc == 0u) { xcd_barrier_complete(bar, b.x, nloc, nx); b.st[0] = nloc; b.st[1] = nx; }
        const unsigned old = xb_add(&bar[XB_XSUB(b.x)], 1u);
        const unsigned gen = old / nloc;
        if (old + 1u == (gen + 1u) * nloc) {
            __builtin_amdgcn_fence(__ATOMIC_RELEASE, "agent");
            asm volatile("s_waitcnt vmcnt(0)" ::: "memory");
            const unsigned og = xb_add(&bar[XB_TOP], 1u);
            const unsigned tg = og / nx;
            if (og + 1u == (tg + 1u) * nx) xb_add(&bar[XB_TOPGEN], 1u);
            else XB_SPIN(xb_ld(&bar[XB_TOPGEN]) == tg, bar);
            __builtin_amdgcn_fence(__ATOMIC_ACQUIRE, "agent");
            xb_add(&bar[XB_XGEN(b.x)], 1u);
            asm volatile("s_waitcnt vmcnt(0)" ::: "memory");
        } else {
            XB_SPIN(xb_ld(&bar[XB_XGEN(b.x)]) == gen, bar);
            __builtin_amdgcn_fence(__ATOMIC_ACQUIRE, "agent");
            asm volatile("s_waitcnt vmcnt(0)" ::: "memory");
        }
    }
    wg_sync();
}

__device__ __forceinline__ const void* kin(int k) {
    typedef __attribute__((address_space(4))) const char* kptr_t;
    kptr_t p = (kptr_t)__builtin_amdgcn_kernarg_segment_ptr(); asm volatile("" : "+s"(p));
    const unsigned long long v = *(__attribute__((address_space(4))) const unsigned long long*)(p + 8 * k);
    return (const void*)(GAS const void*)v;
}
struct Frame {
    LAS unsigned char* lds;
    int tid, lane, wave, vcu, G, l;
    unsigned char* ws; float* out;
#define FIN(name, T, k) __device__ __forceinline__ const T* name() const { return (const T*)kin(k); }
    FIN(x, float, 0) FIN(pos, int, 1) FIN(g_mix, float, 2) FIN(w_in, float, 3) FIN(a_re, float, 4) FIN(a_im, float, 5) FIN(log_dt, float, 6) FIN(b_re, float, 7) FIN(b_im, float, 8)
    FIN(c_re, float, 9) FIN(c_im, float, 10) FIN(s5_d, float, 11) FIN(w_glu, float, 12) FIN(gla_wg, float, 13) FIN(gla_bg, float, 14) FIN(pool_w, float, 15) FIN(pool_scale, float, 16)
    FIN(w_branch, float, 17) FIN(w_out, float, 18) FIN(g_ffn, float, 19) FIN(w_up, float, 20) FIN(conv_w, float, 21) FIN(conv_b, float, 22) FIN(w_down, float, 23) FIN(g_final, float, 24)
#undef FIN
#define FWS(name, T, off) __device__ __forceinline__ T* name() const { return (T*)(ws + (off)); }
    FWS(rotc, float, WS_ROT) FWS(rots, float, WS_ROT + (size_t)M * 32 * 4) FWS(abar, float, WS_S5T + S5T_ABAR) FWS(apow, float, WS_S5T + S5T_APOW) FWS(bbar, float, WS_S5T + S5T_BBAR) FWS(cmt, bf16_t, WS_S5T + S5T_CMT) FWS(bbt, bf16_t, WS_S5T + S5T_BBT)
    FWS(wglu_t, bf16_t, WS_WGLU) FWS(poolw_t, bf16_t, WS_POOLW) FWS(win_t, bf16_t, WS_WIN) FWS(wbr_t, bf16_t, WS_WBR) FWS(wout_t, bf16_t, WS_WOUT) FWS(wup_t, bf16_t, WS_WUP) FWS(wdn_t, bf16_t, WS_WDN)
    FWS(HN8, unsigned char, WS_HN8) FWS(W8, unsigned char, WS_W8) FWS(HN, bf16_t, WS_HN) FWS(Y, bf16_t, WS_Y) FWS(YBP, bf16_t, WS_YBP) FWS(PROJ, bf16_t, WS_PROJ) FWS(SPREV, bf16_t, WS_SPREV) FWS(ACT, bf16_t, WS_ACT)
    FWS(SS, float, WS_SS + (size_t)l * 32 * M * 4) FWS(RS, float, WS_RS + (size_t)l * M * 4) FWS(STATE, float, WS_STATE) FWS(DEC, float, WS_DEC) FWS(XEND, float, WS_XEND) FWS(UH, float, WS_UH)
#undef FWS
};

__device__ __forceinline__ float lane_read(float v, int src_lane) { return __builtin_bit_cast(float, __builtin_amdgcn_ds_bpermute(src_lane << 2, __builtin_bit_cast(int, v))); }
__device__ __forceinline__ float wave_sum(float v, int lane) {
#pragma unroll
    for (int o = 1; o < 64; o <<= 1) v += lane_read(v, lane ^ o);
    return v;
}

template <class SrcCol>
__device__ __forceinline__ void transpose_item(const float* W, int Nsrc, bf16_t* WT, int ldt, int kdst0, int k0, int n0, SrcCol srccol, LAS float* scr, int lane, const float* kscale = nullptr) {
    const int sc = srccol(n0 + (lane & 31));
    float wv[32];
#pragma unroll
    for (int i = 0; i < 32; ++i) { const int kk = 2 * i + (lane >> 5); wv[i] = sc >= 0 ? W[(size_t)(k0 + kk) * Nsrc + sc] : 0.f; }
#pragma unroll
    for (int i = 0; i < 32; ++i) { const int kk = 2 * i + (lane >> 5); scr[kk * 33 + (lane & 31)] = kscale ? wv[i] * kscale[k0 + kk] : wv[i]; }
    LDS_WAIT();
    const int c = lane & 7;
#pragma unroll
    for (int j = 0; j < 4; ++j) { const int n = (lane >> 3) + 8 * j; const LAS float* s = scr + (8 * c) * 33 + n;
        u32x4 o; o.x = pk2(s[0 * 33], s[1 * 33]); o.y = pk2(s[2 * 33], s[3 * 33]); o.z = pk2(s[4 * 33], s[5 * 33]); o.w = pk2(s[6 * 33], s[7 * 33]);
        *(u32x4*)(WT + (size_t)(n0 + n) * ldt + kdst0 + k0 + 8 * c) = o; }
    LDS_WAIT();
}
template <class SrcCol>
__device__ __forceinline__ void transpose_item_fp8(const float* W, int Nsrc, unsigned char* WT, int ldt, int k0, int n0src, int n0dst, SrcCol srccol, LAS float* scr, int lane, const float* kscale, float scale) {
    const int sc = srccol(n0src + (lane & 31));
    float wv[32];
#pragma unroll
    for (int i = 0; i < 32; ++i) { const int kk = 2 * i + (lane >> 5); wv[i] = sc >= 0 ? W[(size_t)(k0 + kk) * Nsrc + sc] : 0.f; }
#pragma unroll
    for (int i = 0; i < 32; ++i) { const int kk = 2 * i + (lane >> 5); scr[kk * 33 + (lane & 31)] = (kscale ? wv[i] * kscale[k0 + kk] : wv[i]) * scale; }
    LDS_WAIT();
    const int c = lane & 7;
#pragma unroll
    for (int j = 0; j < 4; ++j) { const int n = (lane >> 3) + 8 * j; const LAS float* s = scr + (8 * c) * 33 + n;
        u32x2 o; o.x = pk4_fp8(s[0 * 33], s[1 * 33], s[2 * 33], s[3 * 33]); o.y = pk4_fp8(s[4 * 33], s[5 * 33], s[6 * 33], s[7 * 33]);
        *(u32x2*)(WT + (size_t)(n0dst + n) * ldt + k0 + 8 * c) = o; }
    LDS_WAIT();
}
struct ColIdent { __device__ __forceinline__ int operator()(int n) const { return n; } };
struct ColWin { __device__ __forceinline__ int operator()(int n) const {
    if (n < 3584) return n; if (n < 4096) return n + 16; if (n < 4112) return n - 512; if (n < 4352) return -1;
    const int t = (n - 4352) >> 8, cl = (n - 4352) & 255; const int br = 2 * (cl >> 7) + ((cl >> 2) & 1), ch = 16 * ((cl >> 5) & 3) + 4 * ((cl >> 3) & 3) + (cl & 3);
    return 4112 + br * 2048 + 64 * t + ch; } };
struct ColWup { __device__ __forceinline__ int operator()(int n) const { const int blk = n >> 8, r = n & 255; return (r < 128) ? (blk * 128 + r) : (DFF + blk * 128 + (r - 128)); } };

__device__ __forceinline__ void rms_row_to_bf16(const float* xrow, const float* g, bf16_t* orow, int lane, unsigned char* orow8 = nullptr) {
    const f32x4* xr = (const f32x4*)xrow + lane; const f32x4* gr = (const f32x4*)g + lane;
    f32x4 v[8]; float s = 0.f;
#pragma unroll
    for (int j = 0; j < 8; ++j) { v[j] = xr[64 * j]; s += (v[j].x * v[j].x + v[j].y * v[j].y) + (v[j].z * v[j].z + v[j].w * v[j].w); }
    const float r = 1.0f / sqrtf(wave_sum(s, lane) * (1.f / D) + EPS);
    u32x2* o8 = (u32x2*)orow + lane;
#pragma unroll
    for (int j = 0; j < 8; ++j) { const f32x4 gg = gr[64 * j]; const float a = v[j].x * r * gg.x, b = v[j].y * r * gg.y, c = v[j].z * r * gg.z, d = v[j].w * r * gg.w; u32x2 w; w.x = pk2(a, b); w.y = pk2(c, d); o8[64 * j] = w;
        if (orow8) ((unsigned*)orow8)[lane + 64 * j] = pk4_fp8(a, b, c, d); }
}
__device__ __forceinline__ void rms_rows(Frame& F, const float* src, const float* g, bf16_t* dst, unsigned char* dst8 = nullptr) {
    const int gw = F.vcu * NWAVES + F.wave, NGW = F.G * NWAVES;
    for (int m = gw; m < M; m += NGW) rms_row_to_bf16(src + (size_t)m * D, g, dst + (size_t)m * D, F.lane, dst8 ? dst8 + (size_t)m * D : nullptr);
}
__device__ __forceinline__ void row_scale(Frame& F) {
    const int gt = F.vcu * (NWAVES * 64) + F.tid, NGT = F.G * NWAVES * 64;
    for (int m = gt; m < M; m += NGT) { float s = 0.f;
#pragma unroll
        for (int j = 0; j < 32; ++j) s += F.SS()[(size_t)j * M + m];
        const int r = m & 255;
        F.RS()[((size_t)((m >> 8) * 2 + ((r >> 6) & 1)) * 16 + (r & 15)) * 8 + (r >> 7) * 4 + ((r >> 4) & 3)] = 1.0f / sqrtf(s * (1.f / D) + EPS); }
}
__device__ __forceinline__ void rms_rows16(Frame& F, const bf16_t* src, const float* g, bf16_t* dst, unsigned char* dst8) {
    const int gw = F.vcu * NWAVES + F.wave, NGW = F.G * NWAVES, lane = F.lane;
    for (int m = gw; m < M; m += NGW) {
        const u32x4* xr = (const u32x4*)(src + (size_t)m * D) + lane; float v[4][8]; float s = 0.f;
#pragma unroll
        for (int j = 0; j < 4; ++j) { unpack8(xr[64 * j], v[j]);
#pragma unroll
            for (int q = 0; q < 8; ++q) s += v[j][q] * v[j][q]; }
        const float r = 1.0f / sqrtf(wave_sum(s, lane) * (1.f / D) + EPS);
        u32x4* o16 = (u32x4*)(dst + (size_t)m * D) + lane; u32x2* o8 = (u32x2*)(dst8 + (size_t)m * D) + lane;
#pragma unroll
        for (int j = 0; j < 4; ++j) { const f32x4 g0 = *((const f32x4*)g + 2 * (lane + 64 * j)), g1 = *((const f32x4*)g + 2 * (lane + 64 * j) + 1); float y[8];
            y[0] = v[j][0] * r * g0.x; y[1] = v[j][1] * r * g0.y; y[2] = v[j][2] * r * g0.z; y[3] = v[j][3] * r * g0.w; y[4] = v[j][4] * r * g1.x; y[5] = v[j][5] * r * g1.y; y[6] = v[j][6] * r * g1.z; y[7] = v[j][7] * r * g1.w;
            o16[64 * j] = pack8(y); u32x2 w8; w8.x = pk4_fp8(y[0], y[1], y[2], y[3]); w8.y = pk4_fp8(y[4], y[5], y[6], y[7]); o8[64 * j] = w8; }
    }
}
__device__ __forceinline__ void rms_rows16_to_f32(Frame& F, const bf16_t* src, const float* g, float* out) {
    const int gw = F.vcu * NWAVES + F.wave, NGW = F.G * NWAVES, lane = F.lane;
    for (int m = gw; m < M; m += NGW) {
        const u32x4* xr = (const u32x4*)(src + (size_t)m * D) + lane; float v[4][8]; float s = 0.f;
#pragma unroll
        for (int j = 0; j < 4; ++j) { unpack8(xr[64 * j], v[j]);
#pragma unroll
            for (int q = 0; q < 8; ++q) s += v[j][q] * v[j][q]; }
        const float r = 1.0f / sqrtf(wave_sum(s, lane) * (1.f / D) + EPS);
        f32x4* o = (f32x4*)(out + (size_t)m * D);
#pragma unroll
        for (int j = 0; j < 4; ++j) { const f32x4 g0 = *((const f32x4*)g + 2 * (lane + 64 * j)), g1 = *((const f32x4*)g + 2 * (lane + 64 * j) + 1);
            o[2 * (lane + 64 * j)] = (f32x4){v[j][0] * r * g0.x, v[j][1] * r * g0.y, v[j][2] * r * g0.z, v[j][3] * r * g0.w};
            o[2 * (lane + 64 * j) + 1] = (f32x4){v[j][4] * r * g1.x, v[j][5] * r * g1.y, v[j][6] * r * g1.z, v[j][7] * r * g1.w}; }
    }
}
__device__ __forceinline__ void rms_rows_f32_inplace(Frame& F, float* buf, const float* g) {
    const int gw = F.vcu * NWAVES + F.wave, NGW = F.G * NWAVES;
    for (int m = gw; m < M; m += NGW) {
        f32x4* xr = (f32x4*)(buf + (size_t)m * D) + F.lane; const f32x4* gr = (const f32x4*)g + F.lane;
        f32x4 v[8]; float s = 0.f;
#pragma unroll
        for (int j = 0; j < 8; ++j) { v[j] = xr[64 * j]; s += (v[j].x * v[j].x + v[j].y * v[j].y) + (v[j].z * v[j].z + v[j].w * v[j].w); }
        const float r = 1.0f / sqrtf(wave_sum(s, F.lane) * (1.f / D) + EPS);
#pragma unroll
        for (int j = 0; j < 8; ++j) { const f32x4 gg = gr[64 * j]; xr[64 * j] = (f32x4){v[j].x * r * gg.x, v[j].y * r * gg.y, v[j].z * r * gg.z, v[j].w * r * gg.w}; }
    }
}

__device__ __forceinline__ void phase_prep(Frame& F, int l) {
    LAS float* scr = (LAS float*)(F.lds + F.wave * 16384);
    const int gw = F.vcu * NWAVES + F.wave, NGW = F.G * NWAVES;
    constexpr int I_IN = (D / 64) * (NIN / 32), I_UP = (D / 64) * (NUP / 32), I_DN = (DFF / 64) * (D / 32), I_BR = 4 * (BW / 64) * (D / 32), I_OUT = (D / 64) * (D / 32), I_GLU = (BW / 64) * (BW / 32), I_PL = 4 * (128 / 64) * (128 / 32);
    constexpr int NITEMS = I_IN + I_UP + I_DN + I_BR + I_OUT + I_GLU + I_PL;
    for (int it = gw; it < NITEMS; it += NGW) {
        int r = it;
        if (r < I_IN) { const int nb = NIN / 32, n0 = 32 * (r % nb);
            if (n0 < C_GATE) transpose_item(F.w_in() + (size_t)l * D * NIN_SRC, NIN_SRC, F.win_t(), D, 0, 64 * (r / nb), n0, ColWin(), scr, F.lane);
            else transpose_item_fp8(F.w_in() + (size_t)l * D * NIN_SRC, NIN_SRC, F.W8(), D, 64 * (r / nb), n0, n0 - C_GATE, ColWin(), scr, F.lane, nullptr, 64.0f);
            continue; } r -= I_IN;
        if (r < I_UP) { const int nb = NUP / 32; transpose_item(F.w_up() + (size_t)l * D * NUP, NUP, F.wup_t(), D, 0, 64 * (r / nb), 32 * (r % nb), ColWup(), scr, F.lane, F.g_ffn() + (size_t)l * D); continue; } r -= I_UP;
        if (r < I_DN) { const int nb = D / 32; transpose_item(F.w_down() + (size_t)l * DFF * D, D, F.wdn_t(), DFF, 0, 64 * (r / nb), 32 * (r % nb), ColIdent(), scr, F.lane); continue; } r -= I_DN;
        if (r < I_BR) { const int per = (BW / 64) * (D / 32), br = r / per, q = r % per, nb = D / 32;
            transpose_item(F.w_branch() + ((size_t)l * 4 + br) * BW * D, D, F.wbr_t(), D, br * BW, 64 * (q / nb), 32 * (q % nb), ColIdent(), scr, F.lane); continue; } r -= I_BR;
        if (r < I_OUT) { const int nb = D / 32; transpose_item(F.w_out() + (size_t)l * D * D, D, F.wout_t(), D, 0, 64 * (r / nb), 32 * (r % nb), ColIdent(), scr, F.lane); continue; } r -= I_OUT;
        if (r < I_GLU) { const int nb = BW / 32; transpose_item(F.w_glu() + (size_t)l * BW * BW, BW, F.wglu_t(), BW, 0, 64 * (r / nb), 32 * (r % nb), ColIdent(), scr, F.lane); continue; } r -= I_GLU;
        { const int grp = r / 8, q = r % 8; transpose_item(F.pool_w() + ((size_t)l * 4 + grp) * 128 * 128, 128, F.poolw_t() + (size_t)grp * 128 * 128, 128, 0, 64 * (q / 4), 32 * (q % 4), ColIdent(), scr, F.lane); }
    }
    const int gt = F.vcu * (NWAVES * 64) + F.tid, NGT = F.G * NWAVES * 64;
    for (int i = gt; i < 32 * 64; i += NGT) {
        const int g = i >> 6;
        const float are = F.a_re()[(size_t)l * 2048 + i], aim = F.a_im()[(size_t)l * 2048 + i], dt = expf(F.log_dt()[l * 32 + g]);
        const float mag = expf(are * dt), th = aim * dt;
        const float abr = mag * cosf(th), abi = mag * sinf(th);
        const float den = are * are + aim * aim, nr = abr - 1.0f, ni = abi;
        const float fre = (nr * are + ni * aim) / den, fim = (ni * are - nr * aim) / den;
        F.abar()[2 * i] = abr; F.abar()[2 * i + 1] = abi;
        float pr = abr, pi = abi;
#pragma unroll
        for (int q = 0; q < 6; ++q) { const float tr = pr * pr - pi * pi, ti = 2.f * pr * pi; pr = tr; pi = ti; }
        F.apow()[2 * i] = pr; F.apow()[2 * i + 1] = pi;
        const float* br = F.b_re() + ((size_t)l * 2048 + i) * 16; const float* bi = F.b_im() + ((size_t)l * 2048 + i) * 16;
#pragma unroll
        for (int c = 0; c < 16; ++c) { const float x = br[c], y = bi[c]; const float vr = fre * x - fim * y, vi = fre * y + fim * x; const int p = i & 63;
            F.bbt()[((size_t)g * 128 + p) * 16 + c] = (bf16_t)f2bf(vr); F.bbt()[((size_t)g * 128 + 64 + p) * 16 + c] = (bf16_t)f2bf(vi); }
    }
    for (int i = gt; i < 32 * 16 * 128; i += NGT) {
        const int k = i & 127, gc = i >> 7;
        const float v = (k < 64) ? F.c_re()[((size_t)l * 512 + gc) * 64 + k] : -F.c_im()[((size_t)l * 512 + gc) * 64 + (k - 64)];
        F.cmt()[i] = (bf16_t)f2bf(v);
    }
    if (l == 0) {
        for (int i = gt; i < M * 32; i += NGT) {
            const int row = i >> 5, j = i & 31;
            const float inv = exp2f(-(float)j * (13.287712379549449f / 32.0f));
            const float ang = (float)F.pos()[row] * inv;
            F.rotc()[i] = cosf(ang); F.rots()[i] = sinf(ang);
        }
    }
    if (l == 0) rms_rows(F, F.x(), F.g_mix(), F.HN(), F.HN8()); else rms_rows16(F, (const bf16_t*)F.out, F.g_mix() + (size_t)l * D, F.HN(), F.HN8());
}

__device__ __forceinline__ void gr_pass(Frame& F) {
    const int gw = F.vcu * NWAVES + F.wave, NGW = F.G * NWAVES, lane = F.lane, lr = lane & 15, lq = lane >> 4;
    for (int unit = gw; unit < M / 16; unit += NGW) {
        const bf16_t* ap = F.HN() + (size_t)(16 * unit + lr) * D + 8 * lq; const bf16_t* bp = F.win_t() + (size_t)(C_GR + lr) * D + 8 * lq;
        f32x4 acc = (f32x4){0.f, 0.f, 0.f, 0.f};
#pragma unroll 1
        for (int kb = 0; kb < 64; kb += 8) { bf16x8 a[8], b[8];
#pragma unroll
            for (int j = 0; j < 8; ++j) { a[j] = *(const bf16x8*)(ap + 32 * (kb + j)); b[j] = *(const bf16x8*)(bp + 32 * (kb + j)); }
#pragma unroll
            for (int j = 0; j < 8; ++j) acc = __builtin_amdgcn_mfma_f32_16x16x32_bf16(a[j], b[j], acc, 0, 0, 0); }
#pragma unroll
        for (int i = 0; i < 4; ++i) F.PROJ()[(size_t)(16 * unit + 4 * lq + i) * NIN + C_GR + lr] = (bf16_t)f2bf(acc[i]);
    }
}

__device__ __forceinline__ f32x4 mma_nt_lds(const LAS bf16_t* X, int px, const LAS bf16_t* Y, int py, int ksteps, f32x4 acc, int lane) {
    const LAS bf16_t* xp = X + (lane & 15) * px + 8 * (lane >> 4);
    const LAS bf16_t* yp = Y + (lane & 15) * py + 8 * (lane >> 4);
    for (int ks = 0; ks < ksteps; ++ks) {
        const bf16x8 a = *(const LAS bf16x8*)(xp + 32 * ks), b = *(const LAS bf16x8*)(yp + 32 * ks);
        acc = __builtin_amdgcn_mfma_f32_16x16x32_bf16(a, b, acc, 0, 0, 0);
    }
    return acc;
}

constexpr int LN_TOT = 16384, LN_QD = 18432, LN_KI = 27648, LN_PM = 36864, LN_VT = 46080, LN_OB = 64512, LN_WG = 98304, LN_END = 98304 + 4096 + 256;
constexpr int LP = 72;
struct LinRaw { u32x4 q0, q1, k0, k1, v0, v1, g0, g1, gr0, gr1; f32x4 c0, c1, s0, s1; bf16x8 sp0, sp1; };
template <bool OUT>
__device__ __forceinline__ void lin_issue(Frame& F, int unit, LinRaw& R) {
    const int n = unit & 63, h = (unit >> 6) & 3, b = (unit >> 8) & 7, mixer = unit >> 11;
    const size_t row0 = (size_t)b * SEQ + (size_t)n * CH; const int s = F.tid >> 3, c = F.tid & 7;
    const int cq = (mixer == 0 ? C_RQ : C_GQ) + h * 64, ck = (mixer == 0 ? C_RK : C_GK) + h * 64, cv = (mixer == 0 ? C_RV : C_GV) + h * 128, cg = (mixer == 0 ? C_RG : C_GG) + h * 128;
    const bf16_t* pr = F.PROJ() + (row0 + s) * NIN;
    R.k0 = *(const u32x4*)(pr + ck + 8 * c); R.k1 = *(const u32x4*)(pr + ck + 8 * (c ^ 4));
    if (OUT) { R.q0 = *(const u32x4*)(pr + cq + 8 * c); R.q1 = *(const u32x4*)(pr + cq + 8 * (c ^ 4)); }
    { const float* cp = F.rotc() + (row0 + s) * 32 + (c & 3) * 8; const float* sp = F.rots() + (row0 + s) * 32 + (c & 3) * 8;
      R.c0 = *(const f32x4*)cp; R.c1 = *(const f32x4*)(cp + 4); R.s0 = *(const f32x4*)sp; R.s1 = *(const f32x4*)(sp + 4); }
    R.gr0 = *(const u32x4*)(pr + C_GR); R.gr1 = *(const u32x4*)(pr + C_GR + 8);
    R.v0 = *(const u32x4*)(F.PROJ() + (row0 + (F.tid >> 4)) * NIN + cv + (F.tid & 15) * 8);
    R.v1 = *(const u32x4*)(F.PROJ() + (row0 + 32 + (F.tid >> 4)) * NIN + cv + (F.tid & 15) * 8);
    if (OUT) { R.g0 = *(const u32x4*)(pr + cg + 16 * c); R.g1 = *(const u32x4*)(pr + cg + 16 * c + 8);
        const bf16_t* sq = F.SPREV() + (size_t)unit * 8192 + (size_t)(16 * F.wave + (F.lane & 15)) * 64 + 8 * (F.lane >> 4);
        R.sp0 = *(const bf16x8*)sq; R.sp1 = *(const bf16x8*)(sq + 32); }
}
__device__ __forceinline__ void lin_rot(const u32x4 own_, const u32x4 oth_, const LinRaw& R, bool rot, bool hi, float scale, float (&v)[8]) {
    float own[8]; unpack8(own_, own);
    if (!rot) {
#pragma unroll
        for (int j = 0; j < 8; ++j) v[j] = own[j] * scale;
        return; }
    float oth[8]; unpack8(oth_, oth);
    const float cs[8] = {R.c0.x, R.c0.y, R.c0.z, R.c0.w, R.c1.x, R.c1.y, R.c1.z, R.c1.w}, sn[8] = {R.s0.x, R.s0.y, R.s0.z, R.s0.w, R.s1.x, R.s1.y, R.s1.z, R.s1.w};
#pragma unroll
    for (int j = 0; j < 8; ++j) { const float os = oth[j] * sn[j]; v[j] = (own[j] * cs[j] + (hi ? os : -os)) * scale; }
}
__device__ __forceinline__ void lin_decay(Frame& F, int mixer, int h, const LinRaw& R, float (&bcum)[8], float (&blast)[8]) {
    LAS float* TOT = (LAS float*)(F.lds + LN_TOT);
    const int s = F.tid >> 3, c = F.tid & 7, d0 = 8 * c;
    if (mixer == 0) {
        const float lg = __logf(1.0f - exp2f(-5.0f - (float)h));
#pragma unroll
        for (int j = 0; j < 8; ++j) { bcum[j] = (float)(s + 1) * lg; blast[j] = 64.0f * lg; }
        lds_sync();
        return;
    }
    const LAS float* WG = (const LAS float*)(F.lds + LN_WG);
    float grf[16]; { float a[8], b2[8]; unpack8(R.gr0, a); unpack8(R.gr1, b2);
#pragma unroll
        for (int j = 0; j < 8; ++j) { grf[j] = a[j]; grf[8 + j] = b2[j]; } }
    float x[8]; { const f32x4 b0 = *(const LAS f32x4*)(WG + 1024 + d0), b1 = *(const LAS f32x4*)(WG + 1024 + d0 + 4); x[0] = b0.x; x[1] = b0.y; x[2] = b0.z; x[3] = b0.w; x[4] = b1.x; x[5] = b1.y; x[6] = b1.z; x[7] = b1.w; }
#pragma unroll
    for (int r = 0; r < 16; ++r) { const f32x4 w0 = *(const LAS f32x4*)(WG + r * 64 + d0), w1 = *(const LAS f32x4*)(WG + r * 64 + d0 + 4);
        x[0] += grf[r] * w0.x; x[1] += grf[r] * w0.y; x[2] += grf[r] * w0.z; x[3] += grf[r] * w0.w; x[4] += grf[r] * w1.x; x[5] += grf[r] * w1.y; x[6] += grf[r] * w1.z; x[7] += grf[r] * w1.w; }
#pragma unroll
    for (int j = 0; j < 8; ++j) x[j] = logsigmoidf_(x[j]) * (1.0f / 16.0f);
#pragma unroll
    for (int st = 8; st <= 32; st <<= 1) {
#pragma unroll
        for (int j = 0; j < 8; ++j) { const float t = lane_read(x[j], F.lane - st); if (F.lane >= st) x[j] += t; } }
    if ((F.lane >> 3) == 7) { *(LAS f32x4*)(TOT + F.wave * 64 + d0) = (f32x4){x[0], x[1], x[2], x[3]}; *(LAS f32x4*)(TOT + F.wave * 64 + d0 + 4) = (f32x4){x[4], x[5], x[6], x[7]}; }
    lds_sync();
    float off[8], tot[8];
#pragma unroll
    for (int j = 0; j < 8; ++j) { off[j] = 0.f; tot[j] = 0.f; }
#pragma unroll
    for (int w = 0; w < 8; ++w) { const f32x4 t0 = *(const LAS f32x4*)(TOT + w * 64 + d0), t1 = *(const LAS f32x4*)(TOT + w * 64 + d0 + 4); const float tv[8] = {t0.x, t0.y, t0.z, t0.w, t1.x, t1.y, t1.z, t1.w};
#pragma unroll
        for (int j = 0; j < 8; ++j) { tot[j] += tv[j]; off[j] += (w < F.wave) ? tv[j] : 0.f; } }
#pragma unroll
    for (int j = 0; j < 8; ++j) { bcum[j] = x[j] + off[j]; blast[j] = tot[j]; }
}
typedef short v4s_t __attribute__((ext_vector_type(4)));
__device__ __forceinline__ bf16x8 tr_frag(const LAS bf16_t* T, int pitch, int k0, int x0, int lane) {
    const int g = lane >> 4, i = lane & 15, q = i >> 2, p = i & 3;
    const LAS bf16_t* a = T + (k0 + 8 * g + q) * pitch + x0 + 4 * p;
    const v4s_t lo = __builtin_amdgcn_ds_read_tr16_b64_v4i16((LAS v4s_t*)a), hi = __builtin_amdgcn_ds_read_tr16_b64_v4i16((LAS v4s_t*)(a + 4 * pitch));
    return __builtin_shufflevector(lo, hi, 0, 1, 2, 3, 4, 5, 6, 7);
}
constexpr int PV = 144;
__device__ __forceinline__ void lin_store_vt(Frame& F, const LinRaw& R) {
    LAS bf16_t* VR = (LAS bf16_t*)(F.lds + LN_VT); const int e0 = (F.tid & 15) * 8;
    *(LAS u32x4*)(VR + (F.tid >> 4) * PV + e0) = R.v0; *(LAS u32x4*)(VR + (32 + (F.tid >> 4)) * PV + e0) = R.v1;
}
__device__ __forceinline__ void lin_state_compute(Frame& F, int unit, const LinRaw& R) {
    const int h = (unit >> 6) & 3, mixer = unit >> 11; const int s = F.tid >> 3, c = F.tid & 7, d0 = 8 * c;
    LAS bf16_t* KDT = (LAS bf16_t*)(F.lds + LN_KI); LAS bf16_t* VT = (LAS bf16_t*)(F.lds + LN_VT);
    float k[8], bcum[8], blast[8];
    lin_rot(R.k0, R.k1, R, mixer == 0, c >= 4, mixer == 0 ? 0.125f : 1.0f, k);
    lin_decay(F, mixer, h, R, bcum, blast);
    { float kd[8];
#pragma unroll
      for (int j = 0; j < 8; ++j) kd[j] = k[j] * __expf(blast[j] - bcum[j]);
      *(LAS u32x4*)(KDT + s * LP + d0) = pack8(kd); }
    lin_store_vt(F, R);
    if (s == 0) { float* dc = F.DEC() + (size_t)unit * 64 + d0;
        *(f32x4*)dc = (f32x4){__expf(blast[0]), __expf(blast[1]), __expf(blast[2]), __expf(blast[3])}; *(f32x4*)(dc + 4) = (f32x4){__expf(blast[4]), __expf(blast[5]), __expf(blast[6]), __expf(blast[7])}; }
    lds_sync();
    { const int w = F.wave, lane = F.lane; float* st = F.STATE() + (size_t)unit * 8192;
      const bf16x8 vf0 = tr_frag(VT, PV, 0, 16 * w, lane), vf1 = tr_frag(VT, PV, 32, 16 * w, lane);
#pragma unroll
      for (int dt = 0; dt < 4; ++dt) { f32x4 acc = (f32x4){0.f, 0.f, 0.f, 0.f};
          acc = __builtin_amdgcn_mfma_f32_16x16x32_bf16(vf0, tr_frag(KDT, LP, 0, 16 * dt, lane), acc, 0, 0, 0);
          acc = __builtin_amdgcn_mfma_f32_16x16x32_bf16(vf1, tr_frag(KDT, LP, 32, 16 * dt, lane), acc, 0, 0, 0);
#pragma unroll
          for (int i = 0; i < 4; ++i) st[(16 * w + 4 * (lane >> 4) + i) * 64 + 16 * dt + (lane & 15)] = acc[i]; } }
}
__device__ __forceinline__ void lin_out_compute(Frame& F, int unit, const LinRaw& R) {
    const int n = unit & 63, h = (unit >> 6) & 3, b = (unit >> 8) & 7, mixer = unit >> 11;
    const size_t row0 = (size_t)b * SEQ + (size_t)n * CH; const int s = F.tid >> 3, c = F.tid & 7, d0 = 8 * c;
    const int ycol = (mixer == 0 ? 0 : 1024) + h * 128;
    LAS bf16_t* QD = (LAS bf16_t*)(F.lds + LN_QD); LAS bf16_t* KI = (LAS bf16_t*)(F.lds + LN_KI); LAS bf16_t* PM = (LAS bf16_t*)(F.lds + LN_PM);
    LAS bf16_t* VT = (LAS bf16_t*)(F.lds + LN_VT); LAS float* OB = (LAS float*)(F.lds + LN_OB);
    float q[8], k[8], bcum[8], blast[8];
    lin_rot(R.q0, R.q1, R, mixer == 0, c >= 4, mixer == 0 ? 1.0f : 0.125f, q);
    lin_rot(R.k0, R.k1, R, mixer == 0, c >= 4, mixer == 0 ? 0.125f : 1.0f, k);
    lin_decay(F, mixer, h, R, bcum, blast);
    { float qd[8], ki[8];
#pragma unroll
      for (int j = 0; j < 8; ++j) { qd[j] = q[j] * __expf(bcum[j]); ki[j] = k[j] * __expf(-bcum[j]); }
      *(LAS u32x4*)(QD + s * LP + d0) = pack8(qd); *(LAS u32x4*)(KI + s * LP + d0) = pack8(ki); }
    lin_store_vt(F, R);
    lds_sync();
    { const int lane = F.lane;
#pragma unroll
      for (int j = 0; j < 2; ++j) { const int tile = 2 * F.wave + j, tt = tile >> 2, st = tile & 3;
          f32x4 acc = (f32x4){0.f, 0.f, 0.f, 0.f};
          if (st <= tt) acc = mma_nt_lds(QD + 16 * tt * LP, LP, KI + 16 * st * LP, LP, 2, acc, lane);
#pragma unroll
          for (int i = 0; i < 4; ++i) { const int t = 16 * tt + 4 * (lane >> 4) + i, s2 = 16 * st + (lane & 15); const float p = (st <= tt && s2 <= t) ? acc[i] : 0.f; PM[t * LP + s2] = (bf16_t)f2bf(p); } } }
    lds_sync();
    { const int w = F.wave, lane = F.lane;
      const bf16x8 vf0 = tr_frag(VT, PV, 0, 16 * w, lane), vf1 = tr_frag(VT, PV, 32, 16 * w, lane);
#pragma unroll
      for (int tt = 0; tt < 4; ++tt) { f32x4 acc = (f32x4){0.f, 0.f, 0.f, 0.f};
          { const LAS bf16_t* pp = PM + (16 * tt + (lane & 15)) * LP + 8 * (lane >> 4);
            acc = __builtin_amdgcn_mfma_f32_16x16x32_bf16(*(const LAS bf16x8*)pp, vf0, acc, 0, 0, 0);
            acc = __builtin_amdgcn_mfma_f32_16x16x32_bf16(*(const LAS bf16x8*)(pp + 32), vf1, acc, 0, 0, 0); }
          const LAS bf16_t* xp = QD + (16 * tt + (lane & 15)) * LP + 8 * (lane >> 4);
          acc = __builtin_amdgcn_mfma_f32_16x16x32_bf16(*(const LAS bf16x8*)xp, R.sp0, acc, 0, 0, 0);
          acc = __builtin_amdgcn_mfma_f32_16x16x32_bf16(*(const LAS bf16x8*)(xp + 32), R.sp1, acc, 0, 0, 0);
#pragma unroll
          for (int i = 0; i < 4; ++i) OB[(16 * tt + 4 * (lane >> 4) + i) * 132 + 16 * w + (lane & 15)] = acc[i]; } }
    lds_sync();
    { const int t = s, part = c; float o[16];
#pragma unroll
      for (int j = 0; j < 4; ++j) { const f32x4 v = *(const LAS f32x4*)(OB + t * 132 + 16 * part + 4 * j); o[4 * j] = v.x; o[4 * j + 1] = v.y; o[4 * j + 2] = v.z; o[4 * j + 3] = v.w; }
      float sm = 0.f;
#pragma unroll
      for (int j = 0; j < 16; ++j) sm += o[j];
      sm += lane_read(sm, F.lane ^ 1); sm += lane_read(sm, F.lane ^ 2); sm += lane_read(sm, F.lane ^ 4);
      const float mu = sm * (1.0f / 128.0f); float qv = 0.f;
#pragma unroll
      for (int j = 0; j < 16; ++j) { const float dlt = o[j] - mu; qv += dlt * dlt; }
      qv += lane_read(qv, F.lane ^ 1); qv += lane_read(qv, F.lane ^ 2); qv += lane_read(qv, F.lane ^ 4);
      const float r = 1.0f / sqrtf(qv * (1.0f / 128.0f) + EPS);
      float g0[8], g1[8]; unpack8(R.g0, g0); unpack8(R.g1, g1);
      float y0[8], y1[8];
#pragma unroll
      for (int j = 0; j < 8; ++j) { y0[j] = (o[j] - mu) * r * siluf_(g0[j]); y1[j] = (o[8 + j] - mu) * r * siluf_(g1[j]); }
      bf16_t* yp = F.Y() + (row0 + t) * D + ycol + 16 * part; *(u32x4*)yp = pack8(y0); *(u32x4*)(yp + 8) = pack8(y1); }
}
template <bool OUT>
__device__ __forceinline__ void lin_phase(Frame& F, int l) {
    { const int h = (F.vcu >> 6) & 3; LAS float* WG = (LAS float*)(F.lds + LN_WG);
      for (int i = F.tid; i < 16 * 64 + 64; i += NWAVES * 64) WG[i] = (i < 1024) ? F.gla_wg()[(size_t)l * 16 * 256 + (i >> 6) * 256 + h * 64 + (i & 63)] : F.gla_bg()[l * 256 + h * 64 + (i - 1024)];
      lds_sync(); }
    LinRaw A, B;
    lin_issue<OUT>(F, F.vcu, A);
    for (int u = F.vcu; u < 4096; u += 2 * F.G) {
        lin_issue<OUT>(F, u + F.G, B);
        if (OUT) lin_out_compute(F, u, A); else lin_state_compute(F, u, A);
        if (u + 2 * F.G < 4096) lin_issue<OUT>(F, u + 2 * F.G, A);
        if (OUT) lin_out_compute(F, u + F.G, B); else lin_state_compute(F, u + F.G, B);
    }
    lds_sync();
}
__device__ __forceinline__ void lin_scan(Frame& F) {
    const int gt = F.vcu * (NWAVES * 64) + F.tid, NGT = F.G * NWAVES * 64;
    for (int i = gt; i < 64 * 8192; i += NGT) {
        const int seq = i >> 13, idx = i & 8191, d = idx & 63;
        const float* st = F.STATE() + (size_t)seq * NCH * 8192 + idx; const float* dc = F.DEC() + (size_t)seq * NCH * 64 + d; bf16_t* sp = F.SPREV() + (size_t)seq * NCH * 8192 + idx;
        float carry = 0.f; asm volatile("" : "+v"(carry));
#pragma unroll
        for (int h = 0; h < 2; ++h) {
            float v[32], c[32];
#pragma unroll
            for (int n = 0; n < 32; ++n) { v[n] = st[(size_t)(32 * h + n) * 8192]; c[n] = dc[(size_t)(32 * h + n) * 64]; }
#pragma unroll
            for (int n = 0; n < 32; ++n) { sp[(size_t)(32 * h + n) * 8192] = (bf16_t)f2bf(carry); carry = c[n] * carry + v[n]; asm volatile("" : "+v"(carry)); }
        }
    }
}
constexpr int S5_WL = 16384, S5_BU = 2048, S5_X = 2048 + 8320;
template <bool OUT>
__device__ __forceinline__ void s5_pass(Frame& F, int l) {
    LAS bf16_t* UT = (LAS bf16_t*)(F.lds + F.wave * S5_WL); LAS float* BU = (LAS float*)(F.lds + F.wave * S5_WL + S5_BU); LAS bf16_t* X = (LAS bf16_t*)(F.lds + F.wave * S5_WL + S5_X);
    const int gw = F.vcu * NWAVES + F.wave, NGW = F.G * NWAVES, lane = F.lane, lr = lane & 15, lq = lane >> 4;
    u32x4 ua, uc;
    { const int g = gw & 31, n = (gw >> 5) & 63, b = gw >> 11; const bf16_t* up = F.PROJ() + ((size_t)b * SEQ + (size_t)n * CH + lane) * NIN + C_SU + g * 16; ua = *(const u32x4*)up; uc = *(const u32x4*)(up + 8); }
    for (int unit = gw; unit < BATCH * NCH * 32; unit += NGW) {
        const int g = unit & 31, n = (unit >> 5) & 63, b = unit >> 11; const size_t row0 = (size_t)b * SEQ + (size_t)n * CH;
        *(LAS u32x4*)(UT + lane * 16) = ua; *(LAS u32x4*)(UT + lane * 16 + 8) = uc;
        if (unit + NGW < BATCH * NCH * 32) { const int un = unit + NGW, g2 = un & 31, n2 = (un >> 5) & 63, b2 = un >> 11;
            const bf16_t* up = F.PROJ() + ((size_t)b2 * SEQ + (size_t)n2 * CH + lane) * NIN + C_SU + g2 * 16; ua = *(const u32x4*)up; uc = *(const u32x4*)(up + 8); }
        const int gp = g * 64 + lane; const float ar = F.abar()[2 * gp], ai = F.abar()[2 * gp + 1];
        bf16x8 bfr[8];
#pragma unroll
        for (int q = 0; q < 8; ++q) { bfr[q] = (bf16x8){0, 0, 0, 0, 0, 0, 0, 0}; if (lq < 2) bfr[q] = *(const bf16x8*)(F.bbt() + ((size_t)g * 128 + 16 * q + lr) * 16 + 8 * lq); }
        float xr = 0.f, xi = 0.f;
        bf16x8 cf[4]; float dsk = 0.f;
        if (OUT) { const f32x2 x0 = *(const f32x2*)(F.XEND() + ((((size_t)(b * 32 + g)) * NCH + n) * 64 + lane) * 2); xr = x0.x; xi = x0.y;
#pragma unroll
            for (int ks = 0; ks < 4; ++ks) cf[ks] = *(const bf16x8*)(F.cmt() + ((size_t)(g * 16 + lr)) * 128 + 32 * ks + 8 * lq);
            dsk = F.s5_d()[(size_t)l * BW + g * 16 + lr]; }
        LDS_WAIT();
        for (int sb = 0; sb < 4; ++sb) {
            bf16x8 af = (bf16x8){0, 0, 0, 0, 0, 0, 0, 0}; if (lq < 2) af = *(const LAS bf16x8*)(UT + (16 * sb + lr) * 16 + 8 * lq);
#pragma unroll
            for (int q = 0; q < 8; ++q) { f32x4 acc = (f32x4){0.f, 0.f, 0.f, 0.f}; acc = __builtin_amdgcn_mfma_f32_16x16x32_bf16(af, bfr[q], acc, 0, 0, 0);
#pragma unroll
                for (int i = 0; i < 4; ++i) BU[(4 * lq + i) * 130 + 16 * q + lr] = acc[i]; }
            LDS_WAIT();
            float br[16], bi[16];
#pragma unroll
            for (int tt = 0; tt < 16; ++tt) { br[tt] = BU[tt * 130 + lane]; bi[tt] = BU[tt * 130 + 64 + lane]; }
#pragma unroll
            for (int tt = 0; tt < 16; ++tt) { const float nr = ar * xr - ai * xi + br[tt], ni = ar * xi + ai * xr + bi[tt]; xr = nr; xi = ni; asm volatile("" : "+v"(xr), "+v"(xi));
                if (OUT) { X[tt * 136 + lane] = (bf16_t)f2bf(xr); X[tt * 136 + 64 + lane] = (bf16_t)f2bf(xi); } }
            if (OUT) {
                LDS_WAIT();
                f32x4 acc = (f32x4){0.f, 0.f, 0.f, 0.f}; const LAS bf16_t* xp = X + lr * 136 + 8 * lq;
#pragma unroll
                for (int ks = 0; ks < 4; ++ks) acc = __builtin_amdgcn_mfma_f32_16x16x32_bf16(*(const LAS bf16x8*)(xp + 32 * ks), cf[ks], acc, 0, 0, 0);
#pragma unroll
                for (int i = 0; i < 4; ++i) { const int tl = 16 * sb + 4 * lq + i; const float u = bflo((unsigned)UT[tl * 16 + lr]); const float y = gelu_tanh(acc[i] + dsk * u);
                    F.YBP()[(row0 + tl) * BW + g * 16 + lr] = (bf16_t)f2bf(y); }
            }
            LDS_WAIT();
        }
        if (!OUT) *(f32x2*)(F.XEND() + ((((size_t)(b * 32 + g)) * NCH + n) * 64 + lane) * 2) = (f32x2){xr, xi};
    }
}
__device__ __forceinline__ void s5_scan(Frame& F) {
    const int gt = F.vcu * (NWAVES * 64) + F.tid, NGT = F.G * NWAVES * 64;
    for (int i = gt; i < BATCH * 32 * 64; i += NGT) {
        const int p = i & 63, bg = i >> 6, g = bg & 31; const float pr = F.apow()[2 * (g * 64 + p)], pi = F.apow()[2 * (g * 64 + p) + 1];
        f32x2* xp = (f32x2*)(F.XEND() + (((size_t)bg * NCH) * 64 + p) * 2);
        float cr = 0.f, ci = 0.f; asm volatile("" : "+v"(cr), "+v"(ci));
#pragma unroll
        for (int h = 0; h < 2; ++h) {
            f32x2 v[32];
#pragma unroll
            for (int n = 0; n < 32; ++n) v[n] = xp[(size_t)(32 * h + n) * 64];
#pragma unroll
            for (int n = 0; n < 32; ++n) { xp[(size_t)(32 * h + n) * 64] = (f32x2){cr, ci};
                const float nr = pr * cr - pi * ci + v[n].x, ni = pr * ci + pi * cr + v[n].y; cr = nr; ci = ni; asm volatile("" : "+v"(cr), "+v"(ci)); }
        }
    }
}

__device__ __forceinline__ void pool_phase(Frame& F, int l) {
    const int gw = F.vcu * NWAVES + F.wave, NGW = F.G * NWAVES, lane = F.lane, lr = lane & 15, lq = lane >> 4;
    for (int unit = gw; unit < BATCH * (SEQ / 16) * 4; unit += NGW) {
        const int g = unit & 3, tile = (unit >> 2) & 255, b = unit >> 10; const int win = 2 << g, tpos = 16 * tile + lr; const size_t row = (size_t)b * SEQ + tpos;
        const bf16_t* pp = F.PROJ() + row * NIN + C_PU + g * 128 + 8 * lq;
        float s[4][8];
#pragma unroll
        for (int ks = 0; ks < 4; ++ks)
#pragma unroll
            for (int j = 0; j < 8; ++j) s[ks][j] = 0.f;
        for (int jj = 1; jj < win; ++jj) { if (tpos - jj >= 0) {
#pragma unroll
            for (int ks = 0; ks < 4; ++ks) { float a[8]; unpack8(*(const u32x4*)(pp - (size_t)jj * NIN + 32 * ks), a);
#pragma unroll
                for (int j = 0; j < 8; ++j) s[ks][j] += a[j]; } } }
        const float inv = 1.0f / (float)min(tpos + 1, win);
        bf16x8 mf[4];
#pragma unroll
        for (int ks = 0; ks < 4; ++ks) { float a[8], m[8]; unpack8(*(const u32x4*)(pp + 32 * ks), a);
#pragma unroll
            for (int j = 0; j < 8; ++j) m[j] = (s[ks][j] + a[j]) * inv - a[j];
            const u32x4 w = pack8(m); mf[ks] = __builtin_bit_cast(bf16x8, w); }
        const bf16_t* pw = F.poolw_t() + (size_t)g * 128 * 128 + (size_t)lr * 128 + 8 * lq;
#pragma unroll
        for (int q = 0; q < 8; ++q) { f32x4 acc = (f32x4){0.f, 0.f, 0.f, 0.f};
#pragma unroll
            for (int ks = 0; ks < 4; ++ks) acc = __builtin_amdgcn_mfma_f32_16x16x32_bf16(*(const bf16x8*)(pw + (size_t)(16 * q) * 128 + 32 * ks), mf[ks], acc, 0, 0, 0);
            const int dcol = g * 128 + 16 * q + 4 * lq; const f32x4 sc = *(const f32x4*)(F.pool_scale() + (size_t)l * BW + dcol);
            u32x2 w; w.x = pk2(acc[0] * sc.x, acc[1] * sc.y); w.y = pk2(acc[2] * sc.z, acc[3] * sc.w);
            *(u32x2*)(F.Y() + row * D + 1536 + dcol) = w; }
    }
}

__device__ __forceinline__ void conv_fix_phase(Frame& F, int l) {
    const float* cw = F.conv_w() + (size_t)l * 3 * NUP; const float* cb = F.conv_b() + (size_t)l * NUP; const float* UH = F.UH();
    const int gt = F.vcu * (NWAVES * 64) + F.tid, NGT = F.G * NWAVES * 64;
    constexpr int JG = DFF / 4;
    for (int task = gt; task < (M / 256) * 2 * JG; task += NGT) {
        const int jg = task % JG, q = (task / JG) & 1, pm = task / (2 * JG);
        if ((pm & 15) == 0) continue;
        const int j0 = jg * 4, ucol = 256 * (j0 >> 7) + (j0 & 127);
        const float* u0p = UH + ((size_t)pm * 4 + q) * NUP + ucol;
        const float* u1p = (q == 1) ? UH + ((size_t)pm * 4 + 0) * NUP + ucol : UH + ((size_t)(pm - 1) * 4 + 3) * NUP + ucol;
        const float* u2p = (q == 1) ? UH + ((size_t)(pm - 1) * 4 + 3) * NUP + ucol : UH + ((size_t)(pm - 1) * 4 + 2) * NUP + ucol;
        const f32x4 a0 = *(const f32x4*)u0p, a1 = *(const f32x4*)u1p, a2 = *(const f32x4*)u2p, v0 = *(const f32x4*)(u0p + 128), v1 = *(const f32x4*)(u1p + 128), v2 = *(const f32x4*)(u2p + 128);
        const f32x4 wa0 = *(const f32x4*)(cw + j0), wa1 = *(const f32x4*)(cw + NUP + j0), wa2 = *(const f32x4*)(cw + 2 * NUP + j0), ba = *(const f32x4*)(cb + j0);
        const f32x4 wv0 = *(const f32x4*)(cw + DFF + j0), wv1 = *(const f32x4*)(cw + NUP + DFF + j0), wv2 = *(const f32x4*)(cw + 2 * NUP + DFF + j0), bv = *(const f32x4*)(cb + DFF + j0);
        float o[4];
#pragma unroll
        for (int i = 0; i < 4; ++i) { const float ca = ba[i] + wa0[i] * a2[i] + wa1[i] * a1[i] + wa2[i] * a0[i], cv = bv[i] + wv0[i] * v2[i] + wv1[i] * v1[i] + wv2[i] * v0[i]; o[i] = siluf_(ca) * cv; }
        u32x2 w; w.x = pk2(o[0], o[1]); w.y = pk2(o[2], o[3]);
        *(u32x2*)(F.ACT() + ((size_t)pm * 256 + q) * DFF + j0) = w;
    }
}

constexpr int NPH = 13;
struct Args { const void* in[25]; float* out; unsigned char* ws; int l_lo, l_hi, ph_lo, ph_hi, single, pad; };
__global__ void __launch_bounds__(NWAVES * 64, 2) hybrid_fwd(Args args) {
    extern __shared__ __attribute__((aligned(16))) unsigned char lds[];
    Frame F;
    F.lds = (LAS unsigned char*)lds;
    F.tid = threadIdx.x; F.lane = F.tid & 63; F.wave = __builtin_amdgcn_readfirstlane(F.tid >> 6);
    const int wave0 = F.wave;
    F.G = gridDim.x; { const int bx = blockIdx.x; F.vcu = (F.G % 8 == 0) ? (bx % 8) * (F.G / 8) + bx / 8 : bx; }
    unsigned char* ws = args.ws; F.ws = ws; F.out = args.out; F.l = 0;

    volatile LAS unsigned* MISC = (volatile LAS unsigned*)(F.lds + MISC_OFF);
    if (F.tid < 64) MISC[F.tid] = 0u;
    wg_sync();
    unsigned* ctl = (unsigned*)(ws + WS_CTL);
    XcdBarrier bar; bar.bar = ctl + CW_BAR; bar.x = 0; bar.st = nullptr;
    if (args.single) bar = xcd_barrier_post(ctl + CW_BAR, MISC);
#define GRID_BAR() do { if (args.single) xcd_barrier(bar); } while (0)
    const int lo = args.ph_lo, hi = args.ph_hi;
#define IN(k) (lo <= (k) && (k) < hi)
#define PH_BEGIN() do { unsigned z_ = 0u; asm volatile("" : "+v"(z_)); const int ln_ = (int)__builtin_amdgcn_mbcnt_hi(~0u, __builtin_amdgcn_mbcnt_lo(~0u, z_)); F.lane = ln_; F.tid = wave0 * 64 + ln_; F.wave = wave0; unsigned long long w_ = (unsigned long long)args.ws, o_ = (unsigned long long)args.out; asm volatile("" : "+s"(w_), "+s"(o_)); F.ws = (unsigned char*)(GAS unsigned char*)w_; F.out = (float*)(GAS float*)o_; } while (0)

    for (int l = args.l_lo; l < args.l_hi; ++l) {
        F.l = l;
        if (IN(0)) { PH_BEGIN(); phase_prep(F, l); GRID_BAR(); }
        if (IN(1)) { PH_BEGIN();
            { pg8::Gemm g{(const bf16_t*)F.HN8(), (const bf16_t*)F.W8(), M, 4 * D, D / 2, D / 2, D / 2}; pg8::StaticOrder S; S.init(M, 4 * D, F.G, (int)blockIdx.x); pg8::EpiProj E{F.PROJ(), NIN, 0, C_GATE, 1.0f / 64.0f};
              pg8::gemm_phase<pg8::EpiProj, true>(F.lds, g, S, E, F.tid); }
            PH_BEGIN();
            { pg8::Gemm g{F.HN(), F.win_t(), M, C_GR, D, D, D}; pg8::StaticOrder S; S.init(M, C_GR, F.G, (int)blockIdx.x); pg8::EpiProj E{F.PROJ(), NIN, 1 << 20, C_GATE, 1.0f};
              pg8::gemm_phase(F.lds, g, S, E, F.tid); }
            PH_BEGIN(); gr_pass(F);
            GRID_BAR(); }
        if (IN(2)) { PH_BEGIN(); lin_phase<false>(F, l); PH_BEGIN();
            s5_pass<false>(F, l); pool_phase(F, l); wg_sync();
            GRID_BAR(); }
        if (IN(3)) { PH_BEGIN(); lin_scan(F); s5_scan(F); GRID_BAR(); }
        if (IN(4)) { PH_BEGIN(); lin_phase<true>(F, l); PH_BEGIN();
            s5_pass<true>(F, l); wg_sync();
            GRID_BAR(); }
        if (IN(5)) { PH_BEGIN(); pg8::Gemm g{F.YBP(), F.wglu_t(), M, BW, BW, BW, BW}; pg8::StaticOrder S; S.init(M, BW, F.G, (int)blockIdx.x); pg8::EpiGlu E{F.YBP(), BW, F.Y() + BW, D};
            pg8::gemm_phase(F.lds, g, S, E, F.tid); GRID_BAR(); }
        if (IN(6)) { PH_BEGIN(); pg8::Gemm g{F.Y(), F.wbr_t(), M, D, D, D, D}; pg8::StaticOrder S; S.init(M, D, F.G, (int)blockIdx.x); pg8::EpiMerge E{F.PROJ() + C_GATE, NIN, F.HN(), D};
            pg8::gemm_phase(F.lds, g, S, E, F.tid); GRID_BAR(); }
        if (IN(7)) { PH_BEGIN(); for (int i = 0; i < (F.vcu & 7); ++i) __builtin_amdgcn_s_sleep(50);
            pg8::Gemm g{F.HN(), F.wout_t(), M, D, D, D, D}; pg8::StaticOrder S; S.init(M, D, F.G, (int)blockIdx.x); pg8::EpiResid E{l == 0 ? (const void*)F.x() : (const void*)F.out, l == 0 ? 1 : 0, F.Y(), D, F.SS()};
            pg8::gemm_phase(F.lds, g, S, E, F.tid); GRID_BAR(); }
        if (IN(8)) { PH_BEGIN(); row_scale(F); GRID_BAR(); }
        if (IN(9)) { PH_BEGIN(); pg8::Gemm g{F.Y(), F.wup_t(), M, NUP, D, D, D}; pg8::StaticOrder S; S.init(M, NUP, F.G, (int)blockIdx.x); pg8::EpiConv E{F.conv_w() + (size_t)l * 3 * NUP, F.conv_b() + (size_t)l * NUP, F.ACT(), F.UH(), (LAS float*)(F.lds + pg8::STAGE_BYTES), F.RS()};
            pg8::gemm_phase(F.lds, g, S, E, F.tid); GRID_BAR(); }
        if (IN(10)) { PH_BEGIN(); conv_fix_phase(F, l); GRID_BAR(); }
        if (IN(11)) { PH_BEGIN(); for (int i = 0; i < (F.vcu & 7); ++i) __builtin_amdgcn_s_sleep(50);
            pg8::Gemm g{F.ACT(), F.wdn_t(), M, D, DFF, DFF, DFF}; pg8::StaticOrder S; S.init(M, D, F.G, (int)blockIdx.x); pg8::EpiResid E{(const void*)F.Y(), 0, l == DEPTH - 1 ? F.HN() : (bf16_t*)F.out, D, nullptr};
            pg8::gemm_phase(F.lds, g, S, E, F.tid); GRID_BAR(); }
        if (IN(12) && l == DEPTH - 1) { PH_BEGIN(); rms_rows16_to_f32(F, F.HN(), F.g_final(), F.out); }
    }
#undef IN
#undef PH_BEGIN
#undef GRID_BAR
}

#pragma clang attribute pop
extern "C" void kernel_launch(void* const* d_in, const int* in_sizes, int n_in, void* d_out, int out_size, void* d_ws, size_t ws_size, hipStream_t stream) {
    static int grid = 0;
    if (grid == 0) {
        if (n_in != 25 || in_sizes[0] != M * D || out_size != M * D || ws_size < WS_END) { fprintf(stderr, "kernel_launch: shape/workspace mismatch (n_in %d, in0 %d, out %d, ws %zu, need %zu); nothing launched\n", n_in, n_in > 0 ? in_sizes[0] : -1, out_size, ws_size, (size_t)WS_END); grid = -1; return; }
        int dev = 0, cus = 0, per_cu = 0;
        if (hipGetDevice(&dev) != hipSuccess || hipDeviceGetAttribute(&cus, hipDeviceAttributeMultiprocessorCount, dev) != hipSuccess) { grid = -1; return; }
        if (hipFuncSetAttribute((const void*)hybrid_fwd, hipFuncAttributeMaxDynamicSharedMemorySize, LDS_BYTES) != hipSuccess) { fprintf(stderr, "kernel_launch: hipFuncSetAttribute failed\n"); grid = -1; return; }
        if (hipOccupancyMaxActiveBlocksPerMultiprocessor(&per_cu, (const void*)hybrid_fwd, NWAVES * 64, LDS_BYTES) != hipSuccess || per_cu < 1) { fprintf(stderr, "kernel_launch: occupancy query reports %d workgroups per CU\n", per_cu); }
        (void)hipGetLastError();
        grid = cus;
    }
    if (grid < 0) return;
    if (hipMemsetAsync((char*)d_ws + WS_CTL, 0, CTL_ZERO_BYTES, stream) != hipSuccess) return;
    Args a{};
    for (int i = 0; i < 25; ++i) a.in[i] = d_in[i];
    a.out = (float*)d_out; a.ws = (unsigned char*)d_ws;
#if MK_SINGLE
    a.l_lo = 0; a.l_hi = DEPTH; a.ph_lo = 0; a.ph_hi = NPH; a.single = 1;
    hipLaunchKernelGGL(hybrid_fwd, dim3(grid), dim3(NWAVES * 64), LDS_BYTES, stream, a);
#else
    a.single = 0;
    for (int l = 0; l < DEPTH; ++l)
        for (int p = 0; p < NPH; ++p) { if (p == 12 && l != DEPTH - 1) continue; a.l_lo = l; a.l_hi = l + 1; a.ph_lo = p; a.ph_hi = p + 1;
            hipLaunchKernelGGL(hybrid_fwd, dim3(grid), dim3(NWAVES * 64), LDS_BYTES, stream, a); }
#endif
}
```

```cpp
#include <hip/hip_runtime.h>
#include <cstdio>
#include <cstdint>

#ifndef MK_SINGLE
#define MK_SINGLE 1
#endif

#pragma clang attribute push(__attribute__((target("no-packed-fp32-ops"))), apply_to = function)
#define LAS __attribute__((address_space(3)))
#define GAS __attribute__((address_space(1)))
typedef unsigned short bf16_t;
typedef short bf16x8 __attribute__((ext_vector_type(8)));
typedef float f32x4 __attribute__((ext_vector_type(4)));
typedef float f32x2 __attribute__((ext_vector_type(2)));
typedef unsigned u32x4 __attribute__((ext_vector_type(4)));
typedef unsigned u32x2 __attribute__((ext_vector_type(2)));

constexpr int D = 2048, BATCH = 8, SEQ = 4096, DEPTH = 4, M = BATCH * SEQ;
constexpr int BW = 512;
constexpr int NIN_SRC = 12304, NIN = 12544;
constexpr int DFF = 5504, NUP = 11008;
constexpr int C_RQ = 0, C_RK = 256, C_RV = 512, C_RG = 1024, C_SU = 1536, C_GQ = 2048, C_GK = 2304, C_GV = 2560, C_GG = 3072, C_PU = 3584, C_GR = 4096, C_GATE = 4352;
constexpr float EPS = 1e-6f;
constexpr int NWAVES = 8;
constexpr int CH = 64;
constexpr int NCH = SEQ / CH;

constexpr size_t MiB = 1u << 20;
constexpr size_t WS_CTL = 0, CTL_ZERO_BYTES = 1 * MiB;
constexpr size_t WS_ROT = 1 * MiB;
constexpr size_t WS_S5T = 9 * MiB;
constexpr size_t S5T_ABAR = 0, S5T_APOW = 16384, S5T_BBAR = 32768, S5T_CMT = 32768 + 262144, S5T_BBT = S5T_CMT + 131072;
constexpr size_t WS_WGLU = 10 * MiB;
constexpr size_t WS_POOLW = 10 * MiB + 512 * 1024;
constexpr size_t WS_WIN = 11 * MiB;
constexpr size_t WS_WBR = 60 * MiB;
constexpr size_t WS_WOUT = 68 * MiB;
constexpr size_t WS_WUP = 76 * MiB;
constexpr size_t WS_WDN = 119 * MiB;
constexpr size_t WS_HN = 141 * MiB;
constexpr size_t WS_Y = 269 * MiB;
constexpr size_t WS_SCR = 397 * MiB;
constexpr size_t WS_YBP = WS_SCR;
constexpr size_t WS_STATE = WS_SCR + 32 * MiB;
constexpr size_t WS_SPREV = WS_SCR + 160 * MiB;
constexpr size_t WS_DEC = WS_SCR + 224 * MiB;
constexpr size_t WS_XEND = WS_SCR + 225 * MiB;
constexpr size_t WS_UH = WS_SCR + 128 * MiB;
constexpr size_t WS_PROJ = 637 * MiB;
constexpr size_t WS_ACT = WS_PROJ;
constexpr size_t WS_RS = 1421 * MiB;
constexpr size_t WS_SS = 1422 * MiB;
constexpr size_t WS_HN8 = 1438 * MiB;
constexpr size_t WS_W8 = 1502 * MiB;
constexpr size_t WS_END = 1518 * MiB;
static_assert(WS_PROJ + (size_t)M * NIN * 2 <= WS_RS, "ws map");
static_assert(WS_ACT + (size_t)M * DFF * 2 <= WS_RS, "ws map");
static_assert(WS_XEND + 8 * MiB <= WS_PROJ, "ws map");
static_assert(WS_UH + (size_t)(M / 256) * 4 * NUP * 4 <= WS_PROJ, "ws map");
constexpr int CW_TMO = 0, CW_BAR = 4096;

constexpr int LDS_BYTES = 155648;
constexpr int MISC_OFF = LDS_BYTES - 256;

#define RLX_AGENT __ATOMIC_RELAXED, __HIP_MEMORY_SCOPE_AGENT
__device__ __forceinline__ void lds_sync() { asm volatile("s_waitcnt lgkmcnt(0)" ::: "memory"); __builtin_amdgcn_s_barrier(); asm volatile("" ::: "memory"); }
__device__ __forceinline__ void wg_sync() { __builtin_amdgcn_fence(__ATOMIC_RELEASE, "workgroup"); __builtin_amdgcn_s_barrier(); __builtin_amdgcn_fence(__ATOMIC_ACQUIRE, "workgroup"); }
#define LDS_WAIT() asm volatile("s_waitcnt lgkmcnt(0)" ::: "memory")
#define VM_WAIT() asm volatile("s_waitcnt vmcnt(0)" ::: "memory")
__device__ __forceinline__ unsigned f2bf(float f) { unsigned u = __builtin_bit_cast(unsigned, f); return (u + 0x7fffu + ((u >> 16) & 1u)) >> 16; }
__device__ __forceinline__ unsigned pk2(float lo, float hi) { return f2bf(lo) | (f2bf(hi) << 16); }
__device__ __forceinline__ float bflo(unsigned w) { return __builtin_bit_cast(float, w << 16); }
__device__ __forceinline__ float bfhi(unsigned w) { return __builtin_bit_cast(float, w & 0xffff0000u); }
__device__ __forceinline__ void unpack8(const u32x4 w, float (&v)[8]) { v[0] = bflo(w.x); v[1] = bfhi(w.x); v[2] = bflo(w.y); v[3] = bfhi(w.y); v[4] = bflo(w.z); v[5] = bfhi(w.z); v[6] = bflo(w.w); v[7] = bfhi(w.w); }
__device__ __forceinline__ u32x4 pack8(const float (&v)[8]) { u32x4 w; w.x = pk2(v[0], v[1]); w.y = pk2(v[2], v[3]); w.z = pk2(v[4], v[5]); w.w = pk2(v[6], v[7]); return w; }
__device__ __forceinline__ unsigned pk4_fp8(float a, float b, float c, float d) { unsigned w = 0u; w = __builtin_amdgcn_cvt_pk_fp8_f32(a, b, w, false); w = __builtin_amdgcn_cvt_pk_fp8_f32(c, d, w, true); return w; }
__device__ __forceinline__ float sigmoidf_(float x) { return 1.0f / (1.0f + __expf(-x)); }
__device__ __forceinline__ float siluf_(float x) { return x / (1.0f + __expf(-x)); }
__device__ __forceinline__ float gelu_tanh(float x) { const float u = 1.5957691216f * (x + 0.044715f * x * x * x); return x / (1.0f + __expf(-u)); }
__device__ __forceinline__ float logsigmoidf_(float x) { return fminf(x, 0.f) - __logf(1.0f + __expf(-fabsf(x))); }

namespace pg8 {
constexpr int BM = 256, BK = 64, HALF = 128, HTB = HALF * BK * 2, STAGE_BYTES = 8 * HTB, NXCD = 8, WGM = 4;
__host__ __device__ __forceinline__ int lds_byte(int r, int c) { const int st = (r >> 4) * 2 + (c >> 5), rr = r & 15, cc = c & 31, ob = rr * 64 + cc * 2; return st * 1024 + (ob ^ (((ob >> 9) & 1) << 5)); }
__host__ __device__ __forceinline__ void stage_rc(int b, int& R, int& C) { const int st = b / 1024, sb = b % 1024, swz = sb ^ (((sb >> 9) & 1) << 5); R = (st >> 1) * 16 + swz / 64; C = (st & 1) * 32 + (swz % 64) / 2; }
__host__ __device__ __forceinline__ int perm32(int rho) { const int n = rho >> 4, i = rho & 15; return 8 * (i >> 2) + 4 * n + (i & 3); }

struct Unit { int pm, pn; };
struct Gemm { const bf16_t* A; const bf16_t* Bt; int M, N, K, lda, ldb; };

struct StaticOrder {
    int nM, nN, nwg, G, c;
    __host__ __device__ void init(int M_, int N_, int G_, int c_) { nM = M_ / BM; nN = N_ / BM; nwg = nM * nN; G = G_; c = c_; }
    __host__ __device__ bool next(int i, Unit& u) const {
        const long L = (long)i * G + c; if (L >= nwg) return false;
        int wgid = (int)L; { const int q = nwg / NXCD, r = nwg % NXCD, xcd = wgid % NXCD, off = wgid / NXCD; wgid = (xcd < r ? xcd * (q + 1) : r * (q + 1) + (xcd - r) * q) + off; }
        const int nig = WGM * nN, gid = wgid / nig, fm = gid * WGM, gsz = (nM - fm) < WGM ? (nM - fm) : WGM;
        u.pm = fm + ((wgid % nig) % gsz); u.pn = (wgid % nig) / gsz; return true;
    }
};

__device__ __forceinline__ unsigned cvt_pk_bf16(float lo, float hi) { unsigned r; asm volatile("v_cvt_pk_bf16_f32 %0, %1, %2" : "=v"(r) : "v"(lo), "v"(hi)); return r; }

struct EpiStoreBf16 {
    static constexpr bool PERM = true, KHOOK = false;
    bf16_t* O; int ldc;
    __device__ __forceinline__ void khook(f32x4 (&)[2][2][4][2], const Unit&, int, int, int, int, int) const {}
    __device__ __forceinline__ void operator()(f32x4 (&acc)[2][2][4][2], const Unit& u, int wr, int wc, int fr, int fq) const {
        const int row0 = u.pm * BM + wr * 64 + fr, col0 = u.pn * BM + wc * 32 + 8 * fq;
#pragma unroll
        for (int ai = 0; ai < 2; ++ai)
#pragma unroll
            for (int m = 0; m < 4; ++m) { bf16_t* rowp = O + (size_t)(row0 + ai * HALF + m * 16) * ldc + col0;
#pragma unroll
                for (int bj = 0; bj < 2; ++bj) { const f32x4 v0 = acc[ai][bj][m][0], v1 = acc[ai][bj][m][1];
                    u32x4 w; w.x = cvt_pk_bf16(v0[0], v0[1]); w.y = cvt_pk_bf16(v0[2], v0[3]); w.z = cvt_pk_bf16(v1[0], v1[1]); w.w = cvt_pk_bf16(v1[2], v1[3]);
                    *(u32x4*)(rowp + bj * HALF) = w; } }
    }
};
struct EpiProj {
    static constexpr bool PERM = true, KHOOK = false;
    bf16_t* O; int ldc; int gate_pn0; int gate_col0; float gscale;
    __device__ __forceinline__ void khook(f32x4 (&)[2][2][4][2], const Unit&, int, int, int, int, int) const {}
    __device__ __forceinline__ void operator()(f32x4 (&acc)[2][2][4][2], const Unit& u, int wr, int wc, int fr_, int fq_) const {
        int fr = fr_, fq = fq_; asm volatile("" : "+v"(fr), "+v"(fq));
        const int row0 = u.pm * BM + wr * 64 + fr;
        if (u.pn < gate_pn0) {
            const int col0 = u.pn * BM + wc * 32 + 8 * fq;
#pragma unroll
            for (int ai = 0; ai < 2; ++ai)
#pragma unroll
                for (int m = 0; m < 4; ++m) { bf16_t* rowp = O + (size_t)(row0 + ai * HALF + m * 16) * ldc + col0;
#pragma unroll
                    for (int bj = 0; bj < 2; ++bj) { const f32x4 v0 = acc[ai][bj][m][0], v1 = acc[ai][bj][m][1];
                        u32x4 w; w.x = cvt_pk_bf16(v0[0], v0[1]); w.y = cvt_pk_bf16(v0[2], v0[3]); w.z = cvt_pk_bf16(v1[0], v1[1]); w.w = cvt_pk_bf16(v1[2], v1[3]);
                        *(u32x4*)(rowp + bj * HALF) = w; } }
        } else {
            const int col0 = gate_col0 + 64 * (u.pn - gate_pn0) + 16 * wc + 4 * fq;
#pragma unroll
            for (int ai = 0; ai < 2; ++ai)
#pragma unroll
                for (int m = 0; m < 4; ++m) { bf16_t* rowp = O + (size_t)(row0 + ai * HALF + m * 16) * ldc + col0;
                    float r1[4], r2[4], r3[4], g3[4];
#pragma unroll
                    for (int i = 0; i < 4; ++i) {
                        const float e0 = __expf(-fminf(fmaxf(acc[ai][0][m][0][i] * gscale, -30.f), 30.f)), e1 = __expf(-fminf(fmaxf(acc[ai][0][m][1][i] * gscale, -30.f), 30.f));
                        const float e2 = __expf(-fminf(fmaxf(acc[ai][1][m][0][i] * gscale, -30.f), 30.f)), e3 = __expf(-fminf(fmaxf(acc[ai][1][m][1][i] * gscale, -30.f), 30.f));
                        const float i0 = __builtin_amdgcn_rcpf(1.f + e0), i1 = __builtin_amdgcn_rcpf(1.f + e1), i2 = __builtin_amdgcn_rcpf(1.f + e2), i3 = __builtin_amdgcn_rcpf(1.f + e3);
                        r1[i] = (1.f + e1) * i0; r2[i] = (1.f + e2) * i1; r3[i] = (1.f + e3) * i2; g3[i] = i3; }
                    u32x2 w;
                    w.x = cvt_pk_bf16(r1[0], r1[1]); w.y = cvt_pk_bf16(r1[2], r1[3]); *(u32x2*)(rowp) = w;
                    w.x = cvt_pk_bf16(r2[0], r2[1]); w.y = cvt_pk_bf16(r2[2], r2[3]); *(u32x2*)(rowp + D) = w;
                    w.x = cvt_pk_bf16(r3[0], r3[1]); w.y = cvt_pk_bf16(r3[2], r3[3]); *(u32x2*)(rowp + 2 * D) = w;
                    w.x = cvt_pk_bf16(g3[0], g3[1]); w.y = cvt_pk_bf16(g3[2], g3[3]); *(u32x2*)(rowp + 3 * D) = w; }
        }
    }
};
__device__ __forceinline__ float dpp_ror1(float x) { return __builtin_bit_cast(float, __builtin_amdgcn_update_dpp(0, __builtin_bit_cast(int, x), 0x121, 0xf, 0xf, false)); }
__device__ __forceinline__ float dpp_ror2(float x) { return __builtin_bit_cast(float, __builtin_amdgcn_update_dpp(0, __builtin_bit_cast(int, x), 0x122, 0xf, 0xf, false)); }
struct EpiConv {
    static constexpr bool PERM = true, KHOOK = false;
    const float* cw; const float* cb; bf16_t* O; float* UH; LAS float* halo; const float* RS;
    __device__ __forceinline__ void khook(f32x4 (&)[2][2][4][2], const Unit&, int, int, int, int, int) const {}
    __device__ __forceinline__ void operator()(f32x4 (&acc)[2][2][4][2], const Unit& u, int wr, int wc, int fr_, int fq_) const {
        int fr = fr_, fq = fq_; asm volatile("" : "+v"(fr), "+v"(fq));
        const int cl0 = wc * 32 + 8 * fq;
        const int j0 = 128 * u.pn + cl0;
        const float* rp = RS + ((size_t)(u.pm * 2 + wr) * 16 + fr) * 8; const f32x4 rs0 = *(const f32x4*)rp, rs1 = *(const f32x4*)(rp + 4);
        f32x4 wa0[3], wv0[3];
#pragma unroll
        for (int q = 0; q < 3; ++q) { wa0[q] = *(const f32x4*)(cw + q * NUP + j0); wv0[q] = *(const f32x4*)(cw + q * NUP + DFF + j0); }
        const f32x4 ba0 = *(const f32x4*)(cb + j0), bv0 = *(const f32x4*)(cb + DFF + j0);
#pragma unroll
        for (int ai = 0; ai < 2; ++ai)
#pragma unroll
            for (int m = 0; m < 4; ++m) { const float r = ai == 0 ? rs0[m] : rs1[m];
#pragma unroll
                for (int bj = 0; bj < 2; ++bj)
#pragma unroll
                    for (int n = 0; n < 2; ++n) acc[ai][bj][m][n] *= r; }
        if (fr >= 14) {
#pragma unroll
            for (int ai = 0; ai < 2; ++ai)
#pragma unroll
                for (int bj = 0; bj < 2; ++bj)
#pragma unroll
                    for (int n = 0; n < 2; ++n) *(LAS f32x4*)(halo + (((2 * ai + wr) * 2 + (fr - 14)) * 256 + 128 * bj + cl0 + 4 * n)) = acc[ai][bj][3][n];
        }
        if (wr == 0 && fr < 2) {
#pragma unroll
            for (int bj = 0; bj < 2; ++bj)
#pragma unroll
                for (int n = 0; n < 2; ++n) *(f32x4*)(UH + ((size_t)u.pm * 4 + fr) * NUP + 256 * u.pn + 128 * bj + cl0 + 4 * n) = acc[0][bj][0][n];
        }
        if (wr == 1 && fr >= 14) {
#pragma unroll
            for (int bj = 0; bj < 2; ++bj)
#pragma unroll
                for (int n = 0; n < 2; ++n) *(f32x4*)(UH + ((size_t)u.pm * 4 + 2 + (fr - 14)) * NUP + 256 * u.pn + 128 * bj + cl0 + 4 * n) = acc[1][bj][3][n];
        }
        asm volatile("s_waitcnt lgkmcnt(0)" ::: "memory"); __builtin_amdgcn_s_barrier(); asm volatile("" ::: "memory");
        const bool is15 = fr == 15, ge14 = fr >= 14;
        unsigned keep[2][4][2];
        f32x4 wa1[3], wv1[3];
#pragma unroll
        for (int q = 0; q < 3; ++q) { wa1[q] = *(const f32x4*)(cw + q * NUP + j0 + 4); wv1[q] = *(const f32x4*)(cw + q * NUP + DFF + j0 + 4); }
        const f32x4 ba1 = *(const f32x4*)(cb + j0 + 4), bv1 = *(const f32x4*)(cb + DFF + j0 + 4);
#pragma unroll
        for (int n = 0; n < 2; ++n) {
            f32x4 wa[3], wv[3];
#pragma unroll
            for (int q = 0; q < 3; ++q) { wa[q] = n == 0 ? wa0[q] : wa1[q]; wv[q] = n == 0 ? wv0[q] : wv1[q]; }
            const f32x4 ba = n == 0 ? ba0 : ba1, bv = n == 0 ? bv0 : bv1;
#pragma unroll
            for (int ai = 0; ai < 2; ++ai) {
                const int blk = 2 * ai + wr;
                f32x4 pa = (f32x4){0.f, 0.f, 0.f, 0.f}, pv = (f32x4){0.f, 0.f, 0.f, 0.f};
                if (blk > 0 && ge14) { pa = *(const LAS f32x4*)(halo + (((blk - 1) * 2 + (fr - 14)) * 256 + cl0 + 4 * n)); pv = *(const LAS f32x4*)(halo + (((blk - 1) * 2 + (fr - 14)) * 256 + 128 + cl0 + 4 * n)); }
#pragma unroll
                for (int m = 0; m < 4; ++m) {
                    const f32x4 ca_ = acc[ai][0][m][n], cv_ = acc[ai][1][m][n]; float o[4];
#pragma unroll
                    for (int i = 0; i < 4; ++i) {
                        const float a1 = dpp_ror1(is15 ? pa[i] : ca_[i]), a2 = dpp_ror2(ge14 ? pa[i] : ca_[i]);
                        const float v1 = dpp_ror1(is15 ? pv[i] : cv_[i]), v2 = dpp_ror2(ge14 ? pv[i] : cv_[i]);
                        const float ca = ba[i] + wa[0][i] * a2 + wa[1][i] * a1 + wa[2][i] * ca_[i];
                        const float cv = bv[i] + wv[0][i] * v2 + wv[1][i] * v1 + wv[2][i] * cv_[i];
                        o[i] = siluf_(ca) * cv; }
                    pa = ca_; pv = cv_;
                    const unsigned lo = cvt_pk_bf16(o[0], o[1]), hi = cvt_pk_bf16(o[2], o[3]);
                    if (n == 0) { keep[ai][m][0] = lo; keep[ai][m][1] = hi; }
                    else { u32x4 w; w.x = keep[ai][m][0]; w.y = keep[ai][m][1]; w.z = lo; w.w = hi;
                        *(u32x4*)(O + (size_t)(u.pm * BM + ai * HALF + wr * 64 + m * 16 + fr) * DFF + j0) = w; }
                }
            }
        }
    }
};
struct EpiResid {
    static constexpr bool PERM = true, KHOOK = false;
    const void* base; int base_f32; bf16_t* O; int ldc; float* SS;
    __device__ __forceinline__ void khook(f32x4 (&)[2][2][4][2], const Unit&, int, int, int, int, int) const {}
    __device__ __forceinline__ void finish(const float (&b)[8], const f32x4 v0, const f32x4 v1, bf16_t* op, float& sq) const {
        const float o0 = b[0] + v0[0], o1 = b[1] + v0[1], o2 = b[2] + v0[2], o3 = b[3] + v0[3], o4 = b[4] + v1[0], o5 = b[5] + v1[1], o6 = b[6] + v1[2], o7 = b[7] + v1[3];
        u32x4 w; w.x = cvt_pk_bf16(o0, o1); w.y = cvt_pk_bf16(o2, o3); w.z = cvt_pk_bf16(o4, o5); w.w = cvt_pk_bf16(o6, o7);
        *(u32x4*)op = w;
        sq += ((o0 * o0 + o1 * o1) + (o2 * o2 + o3 * o3)) + ((o4 * o4 + o5 * o5) + (o6 * o6 + o7 * o7));
    }
    __device__ __forceinline__ void rowsum(float sq, const Unit& u, int wc, int fq, int lane, int row) const {
        sq += __builtin_bit_cast(float, __builtin_amdgcn_ds_bpermute((lane ^ 16) << 2, __builtin_bit_cast(int, sq)));
        sq += __builtin_bit_cast(float, __builtin_amdgcn_ds_bpermute((lane ^ 32) << 2, __builtin_bit_cast(int, sq)));
        if (fq == 0) SS[(size_t)(u.pn * 4 + wc) * M + row] = sq;
    }
    __device__ __forceinline__ void operator()(f32x4 (&acc)[2][2][4][2], const Unit& u, int wr, int wc, int fr_, int fq_) const {
        int fr = fr_, fq = fq_; asm volatile("" : "+v"(fr), "+v"(fq));
        const int row0 = u.pm * BM + wr * 64 + fr, col0 = u.pn * BM + wc * 32 + 8 * fq, lane = fq * 16 + fr;
        if (!base_f32) {
            u32x4 bw[2][4][2];
#pragma unroll
            for (int ai = 0; ai < 2; ++ai)
#pragma unroll
                for (int m = 0; m < 4; ++m)
#pragma unroll
                    for (int bj = 0; bj < 2; ++bj) bw[ai][m][bj] = *(const u32x4*)((const bf16_t*)base + (size_t)(row0 + ai * HALF + m * 16) * ldc + col0 + bj * HALF);
#pragma unroll
            for (int ai = 0; ai < 2; ++ai)
#pragma unroll
                for (int m = 0; m < 4; ++m) { const size_t off = (size_t)(row0 + ai * HALF + m * 16) * ldc + col0; float sq = 0.f;
#pragma unroll
                    for (int bj = 0; bj < 2; ++bj) { float b[8]; unpack8(bw[ai][m][bj], b); finish(b, acc[ai][bj][m][0], acc[ai][bj][m][1], O + off + bj * HALF, sq); }
                    if (SS) rowsum(sq, u, wc, fq, lane, row0 + ai * HALF + m * 16); }
        } else {
#pragma unroll
            for (int ai = 0; ai < 2; ++ai)
#pragma unroll
                for (int m = 0; m < 4; ++m) { const size_t off = (size_t)(row0 + ai * HALF + m * 16) * ldc + col0; float sq = 0.f;
#pragma unroll
                    for (int bj = 0; bj < 2; ++bj) { float b[8]; const float* bp = (const float*)base + off + bj * HALF; const f32x4 b0 = *(const f32x4*)bp, b1 = *(const f32x4*)(bp + 4);
                        b[0] = b0.x; b[1] = b0.y; b[2] = b0.z; b[3] = b0.w; b[4] = b1.x; b[5] = b1.y; b[6] = b1.z; b[7] = b1.w;
                        finish(b, acc[ai][bj][m][0], acc[ai][bj][m][1], O + off + bj * HALF, sq); }
                    if (SS) rowsum(sq, u, wc, fq, lane, row0 + ai * HALF + m * 16);
                    asm volatile("" ::: "memory"); }
        }
    }
};
struct EpiGlu {
    static constexpr bool PERM = true, KHOOK = false;
    const bf16_t* Yp; int ldy; bf16_t* O; int ldc;
    __device__ __forceinline__ void khook(f32x4 (&)[2][2][4][2], const Unit&, int, int, int, int, int) const {}
    __device__ __forceinline__ void operator()(f32x4 (&acc)[2][2][4][2], const Unit& u, int wr, int wc, int fr, int fq) const {
        const int row0 = u.pm * BM + wr * 64 + fr, col0 = u.pn * BM + wc * 32 + 8 * fq;
#pragma unroll
        for (int ai = 0; ai < 2; ++ai)
#pragma unroll
            for (int m = 0; m < 4; ++m) { const size_t r = (size_t)(row0 + ai * HALF + m * 16);
#pragma unroll
                for (int bj = 0; bj < 2; ++bj) { const u32x4 yw = *(const u32x4*)(Yp + r * ldy + col0 + bj * HALF); float y[8]; unpack8(yw, y);
                    const f32x4 v0 = acc[ai][bj][m][0], v1 = acc[ai][bj][m][1]; float o[8];
#pragma unroll
                    for (int j = 0; j < 4; ++j) { o[j] = y[j] * sigmoidf_(v0[j]); o[4 + j] = y[4 + j] * sigmoidf_(v1[j]); }
                    u32x4 w; w.x = cvt_pk_bf16(o[0], o[1]); w.y = cvt_pk_bf16(o[2], o[3]); w.z = cvt_pk_bf16(o[4], o[5]); w.w = cvt_pk_bf16(o[6], o[7]);
                    *(u32x4*)(O + r * ldc + col0 + bj * HALF) = w; } }
    }
};
struct EpiMerge {
    static constexpr bool PERM = true, KHOOK = true;
    const bf16_t* G; int ldg; bf16_t* O; int ldc;
    __device__ __forceinline__ void scale(f32x4 (&acc)[2][2][4][2], const Unit& u, int s, int wr, int wc, int fr, int fq) const {
        int row0 = u.pm * BM + wr * 64 + fr, col0 = u.pn * BM + wc * 32 + 8 * fq + s * D; asm volatile("" : "+v"(row0), "+v"(col0));
        u32x4 w[2][4][2];
#pragma unroll
        for (int ai = 0; ai < 2; ++ai)
#pragma unroll
            for (int m = 0; m < 4; ++m) { const bf16_t* gp = G + (size_t)(row0 + ai * HALF + m * 16) * ldg + col0;
#pragma unroll
                for (int bj = 0; bj < 2; ++bj) w[ai][m][bj] = *(const u32x4*)(gp + bj * HALF); }
#pragma unroll
        for (int ai = 0; ai < 2; ++ai)
#pragma unroll
            for (int m = 0; m < 4; ++m)
#pragma unroll
                for (int bj = 0; bj < 2; ++bj) { float f[8]; unpack8(w[ai][m][bj], f);
#pragma unroll
                    for (int j = 0; j < 8; ++j) acc[ai][bj][m][j >> 2][j & 3] *= f[j]; }
    }
    __device__ __forceinline__ void khook(f32x4 (&acc)[2][2][4][2], const Unit& u, int seg, int wr, int wc, int fr, int fq) const { scale(acc, u, seg - 1, wr, wc, fr, fq); }
    __device__ __forceinline__ void operator()(f32x4 (&acc)[2][2][4][2], const Unit& u, int wr, int wc, int fr, int fq) const {
        scale(acc, u, 3, wr, wc, fr, fq);
        const int row0 = u.pm * BM + wr * 64 + fr, col0 = u.pn * BM + wc * 32 + 8 * fq;
#pragma unroll
        for (int ai = 0; ai < 2; ++ai)
#pragma unroll
            for (int m = 0; m < 4; ++m) { bf16_t* rowp = O + (size_t)(row0 + ai * HALF + m * 16) * ldc + col0;
#pragma unroll
                for (int bj = 0; bj < 2; ++bj) { const f32x4 v0 = acc[ai][bj][m][0], v1 = acc[ai][bj][m][1];
                    u32x4 w; w.x = cvt_pk_bf16(v0[0], v0[1]); w.y = cvt_pk_bf16(v0[2], v0[3]); w.z = cvt_pk_bf16(v1[0], v1[1]); w.w = cvt_pk_bf16(v1[2], v1[3]);
                    *(u32x4*)(rowp + bj * HALF) = w; } }
    }
};

typedef int v4i_t __attribute__((ext_vector_type(4)));
typedef int v8i_t __attribute__((ext_vector_type(8)));
template <class Epi, bool F8 = false>
__device__ __forceinline__ void gemm_phase(LAS unsigned char* lds, const Gemm g, const StaticOrder& S, const Epi& E, int tid_in) {
    int tid_ = tid_in; asm volatile("" : "+v"(tid_));
    const int tid = tid_, wid = __builtin_amdgcn_readfirstlane(tid >> 6), lane = tid & 63, wr = wid >> 2, wc = wid & 3, fr = lane & 15, fq = lane >> 4;
    const int K = g.K, nt = K / BK;
    unsigned voffA[2], voffB[2];
#pragma unroll
    for (int i = 0; i < 2; ++i) { int R, C; stage_rc(tid * 16 + i * 8192, R, C); const int Rb = Epi::PERM ? ((R & ~31) + perm32(R & 31)) : R;
        voffA[i] = (unsigned)(R * g.lda + C) * 2u; voffB[i] = (unsigned)(Rb * g.ldb + C) * 2u; }
    const size_t kstep = (size_t)(BK * 2);
    const size_t hstepA = (size_t)HALF * g.lda * 2, hstepB = (size_t)HALF * g.ldb * 2;
    const size_t tstepA = 2 * hstepA, tstepB = 2 * hstepB;
    const unsigned ldsw = (unsigned)wid * 1024u;
    const int aoff = lds_byte(wr * 64 + fr, fq * 8), boff = lds_byte(wc * 32 + fr, fq * 8);
#define PG8_SA(b, h) (((b) * 2 + (h)) * HTB)
#define PG8_SB(b, h) ((4 + (b) * 2 + (h)) * HTB)
#define PG8_STAGE(bufoff, gbase, voff) do { _Pragma("unroll") for (int _i = 0; _i < 2; ++_i) \
        __builtin_amdgcn_global_load_lds((const unsigned*)((const char*)(gbase) + (voff)[_i]), (LAS unsigned*)(lds + (bufoff) + ldsw + _i * 8192), 16, 0, 0); } while (0)
#define PG8_LDA(dst, b, h) do { _Pragma("unroll") for (int m = 0; m < 4; ++m) _Pragma("unroll") for (int k = 0; k < 2; ++k) dst[m][k] = *(const LAS bf16x8*)(lds + PG8_SA(b, h) + aoff + m * 2048 + k * 1024); } while (0)
#define PG8_LDB(dst, b, h) do { _Pragma("unroll") for (int n = 0; n < 2; ++n) _Pragma("unroll") for (int k = 0; k < 2; ++k) dst[n][k] = *(const LAS bf16x8*)(lds + PG8_SB(b, h) + boff + n * 2048 + k * 1024); } while (0)
#define PG8_MMA(ai, bj, At, Bt) do { __builtin_amdgcn_s_setprio(1); _Pragma("unroll") for (int m = 0; m < 4; ++m) _Pragma("unroll") for (int n = 0; n < 2; ++n) _Pragma("unroll") for (int k = 0; k < 2; ++k) \
        acc[ai][bj][m][n] = __builtin_amdgcn_mfma_f32_16x16x32_bf16(Bt[n][k], At[m][k], acc[ai][bj][m][n], 0, 0, 0); __builtin_amdgcn_s_setprio(0); } while (0)
#define PG8_MMA16(ai, bj, At, Bt) PG8_MMA(ai, bj, At, Bt)
#define PG8_MMA8(ai, bj, A8, B8) do { __builtin_amdgcn_s_setprio(1); _Pragma("unroll") for (int m = 0; m < 4; ++m) _Pragma("unroll") for (int n = 0; n < 2; ++n) \
        asm volatile("v_mfma_f32_16x16x128_f8f6f4 %0, %1, %2, %0" : "+v"(acc[ai][bj][m][n]) : "v"(B8[n]), "v"(A8[m])); __builtin_amdgcn_s_setprio(0); } while (0)
#define PG8_LDA8(dst, b, h) do { _Pragma("unroll") for (int m = 0; m < 4; ++m) { dst[m].lo = *(const LAS v4i_t*)(lds + PG8_SA(b, h) + aoff + m * 2048); dst[m].hi = *(const LAS v4i_t*)(lds + PG8_SA(b, h) + aoff + m * 2048 + 1024); } } while (0)
#define PG8_LDB8(dst, b, h) do { _Pragma("unroll") for (int n = 0; n < 2; ++n) { dst[n].lo = *(const LAS v4i_t*)(lds + PG8_SB(b, h) + boff + n * 2048); dst[n].hi = *(const LAS v4i_t*)(lds + PG8_SB(b, h) + boff + n * 2048 + 1024); } } while (0)
#define PG8_XLDA(b, h) do { if constexpr (F8) PG8_LDA8(A8, b, h); else PG8_LDA(At, b, h); } while (0)
#define PG8_XLDB0(b, h) do { if constexpr (F8) PG8_LDB8(B08, b, h); else PG8_LDB(B0, b, h); } while (0)
#define PG8_XLDB1(b, h) do { if constexpr (F8) PG8_LDB8(B18, b, h); else PG8_LDB(B1, b, h); } while (0)
#define PG8_MM0(ai, bj) do { if constexpr (F8) PG8_MMA8(ai, bj, A8, B08); else PG8_MMA16(ai, bj, At, B0); } while (0)
#define PG8_MM1(ai, bj) do { if constexpr (F8) PG8_MMA8(ai, bj, A8, B18); else PG8_MMA16(ai, bj, At, B1); } while (0)
#define PG8_WAIT_V(n) asm volatile("s_waitcnt vmcnt(" #n ")" ::: "memory")
#define PG8_WAIT_L(n) asm volatile("s_waitcnt lgkmcnt(" #n ")" ::: "memory")
#define PG8_BAR __builtin_amdgcn_s_barrier()
#define PG8_SCHED __builtin_amdgcn_sched_barrier(0)
    Unit cur, nxt; int ui = 0;
    if (!S.next(0, cur)) return;
    f32x4 acc[2][2][4][2];
#pragma unroll
    for (int a = 0; a < 2; ++a)
#pragma unroll
        for (int b = 0; b < 2; ++b)
#pragma unroll
            for (int m = 0; m < 4; ++m)
#pragma unroll
                for (int n = 0; n < 2; ++n) acc[a][b][m][n] = (f32x4){0.f, 0.f, 0.f, 0.f};
    bf16x8 At[4][2], B0[2][2], B1[2][2]; v8i_t A8[4], B08[2], B18[2];
    const char* cA = (const char*)g.A + (size_t)cur.pm * tstepA; const char* cB = (const char*)g.Bt + (size_t)cur.pn * tstepB;
    PG8_STAGE(PG8_SB(0, 0), cB, voffB); PG8_STAGE(PG8_SB(0, 1), cB + hstepB, voffB); PG8_STAGE(PG8_SA(0, 0), cA, voffA); PG8_STAGE(PG8_SA(0, 1), cA + hstepA, voffA);
    if (wr == 1) PG8_BAR;
    PG8_WAIT_V(2); PG8_BAR;
    PG8_STAGE(PG8_SB(1, 0), cB + kstep, voffB); PG8_STAGE(PG8_SA(1, 0), cA + kstep, voffA); PG8_STAGE(PG8_SB(1, 1), cB + hstepB + kstep, voffB);
    PG8_WAIT_V(6); PG8_BAR;
    for (;;) {
        const bool has_next = S.next(ui + 1, nxt);
        const char* nA = has_next ? (const char*)g.A + (size_t)nxt.pm * tstepA : cA; const char* nB = has_next ? (const char*)g.Bt + (size_t)nxt.pn * tstepB : cB;
        for (int t = 0; t < nt; t += 2) {
            const bool last = (t == nt - 2);
            const char* a1 = cA + (size_t)(t + 1) * kstep;
            const char* a2 = last ? nA : cA + (size_t)(t + 2) * kstep; const char* b2 = last ? nB : cB + (size_t)(t + 2) * kstep;
            const char* a3 = a2 + kstep; const char* b3 = b2 + kstep;
            if constexpr (Epi::KHOOK) { if (t != 0 && (t & 7) == 0) E.khook(acc, cur, t >> 3, wr, wc, fr, fq); }
            PG8_XLDB0(0, 0); PG8_XLDB1(0, 1); PG8_SCHED; PG8_XLDA(0, 0); PG8_STAGE(PG8_SA(1, 1), a1 + hstepA, voffA);
            PG8_WAIT_V(8); PG8_WAIT_L(0); PG8_BAR; PG8_MM0(0, 0); PG8_MM1(0, 1); PG8_BAR; PG8_SCHED;
            PG8_XLDA(0, 1); PG8_STAGE(PG8_SB(0, 0), b2, voffB); PG8_STAGE(PG8_SB(0, 1), b2 + hstepB, voffB); PG8_STAGE(PG8_SA(0, 0), a2, voffA);
            PG8_WAIT_V(8); PG8_WAIT_L(0); PG8_BAR; PG8_MM0(1, 0); PG8_MM1(1, 1); PG8_BAR; PG8_SCHED;
            PG8_XLDB0(1, 0); PG8_XLDB1(1, 1); PG8_SCHED; PG8_XLDA(1, 0); PG8_STAGE(PG8_SA(0, 1), a2 + hstepA, voffA);
            PG8_WAIT_V(8); PG8_WAIT_L(0); PG8_BAR; PG8_MM0(0, 0); PG8_MM1(0, 1); PG8_BAR; PG8_SCHED;
            PG8_XLDA(1, 1); PG8_STAGE(PG8_SB(1, 0), b3, voffB); PG8_STAGE(PG8_SB(1, 1), b3 + hstepB, voffB); PG8_STAGE(PG8_SA(1, 0), a3, voffA);
            PG8_WAIT_V(8); PG8_WAIT_L(0); PG8_BAR; PG8_MM0(1, 0); PG8_MM1(1, 1); PG8_BAR; PG8_SCHED;
        }
        if (wr == 0) PG8_BAR;
        E(acc, cur, wr, wc, fr, fq);
        if (!has_next) break;
#pragma unroll
        for (int a = 0; a < 2; ++a)
#pragma unroll
            for (int b = 0; b < 2; ++b)
#pragma unroll
                for (int m = 0; m < 4; ++m)
#pragma unroll
                    for (int n = 0; n < 2; ++n) acc[a][b][m][n] = (f32x4){0.f, 0.f, 0.f, 0.f};
        cur = nxt; cA = nA; cB = nB; ++ui;
        if (wr == 1) PG8_BAR;
    }
    PG8_WAIT_V(0);
    PG8_BAR;
#undef PG8_SA
#undef PG8_SB
#undef PG8_STAGE
#undef PG8_LDA
#undef PG8_LDB
#undef PG8_MMA
#undef PG8_MMA8
#undef PG8_MMA16
#undef PG8_LDA8
#undef PG8_LDB8
#undef PG8_XLDA
#undef PG8_XLDB0
#undef PG8_XLDB1
#undef PG8_MM0
#undef PG8_MM1
#undef PG8_WAIT_V
#undef PG8_WAIT_L
#undef PG8_BAR
#undef PG8_SCHED
}
}

#define XB_TMO      128
#define XB_XCNT(j)  (256  + 64 * (j))
#define XB_XSUB(j)  (1280 + 64 * (j))
#define XB_XGEN(j)  (2304 + 64 * (j))
#define XB_TOP      3328
#define XB_TOPGEN   3392
#define XCD_BAR_WORDS 3456
#define XB_SPIN_CAP (1u << 18)
__device__ __forceinline__ unsigned xb_ld(unsigned* p)              { return __hip_atomic_load(p, __ATOMIC_RELAXED, __HIP_MEMORY_SCOPE_AGENT); }
__device__ __forceinline__ unsigned xb_add(unsigned* p, unsigned v) { return __hip_atomic_fetch_add(p, v, __ATOMIC_RELAXED, __HIP_MEMORY_SCOPE_AGENT); }
__device__ __forceinline__ unsigned xb_xcc_id() { return (unsigned)__builtin_amdgcn_s_getreg((3 << 11) | 20) & 0xFu; }
#define XB_SPIN(cond, bar) do { unsigned _sp = 0; while (cond) { __builtin_amdgcn_s_sleep(1); \
    if ((++_sp & 255u) == 0u) { if (xb_ld(&(bar)[XB_TMO])) break; if (_sp > XB_SPIN_CAP) { (void)__hip_atomic_fetch_add(&(bar)[XB_TMO], 1u, __ATOMIC_RELAXED, __HIP_MEMORY_SCOPE_AGENT); break; } } } } while (0)
struct XcdBarrier { unsigned* bar; unsigned x; volatile LAS unsigned* st; };
__device__ __forceinline__ XcdBarrier xcd_barrier_post(unsigned* bar, volatile LAS unsigned* st) {
    XcdBarrier b; b.bar = bar; b.x = xb_xcc_id(); b.st = st;
    if (threadIdx.x == 0) (void)xb_add(&bar[XB_XCNT(b.x)], 1u);
    return b;
}
__device__ __forceinline__ void xcd_barrier_complete(unsigned* bar, unsigned x, unsigned& nloc, unsigned& nx) {
    const unsigned G = gridDim.x * gridDim.y * gridDim.z;
    unsigned sum, cnt, mine, sp = 0u;
    for (;;) {
        sum = 0u; cnt = 0u; mine = 0u;
#pragma nounroll
        for (unsigned j = 0; j < 16; ++j) { const unsigned c = xb_ld(&bar[XB_XCNT(j)]); sum += c; cnt += (c > 0u) ? 1u : 0u; mine = (j == x) ? c : mine; }
        if (sum == G) break;
        __builtin_amdgcn_s_sleep(1);
        if ((++sp & 255u) == 0u) { if (xb_ld(&bar[XB_TMO])) break; if (sp > XB_SPIN_CAP) { (void)__hip_atomic_fetch_add(&bar[XB_TMO], 1u, __ATOMIC_RELAXED, __HIP_MEMORY_SCOPE_AGENT); break; } }
    }
    nloc = mine > 0u ? mine : 1u; nx = cnt > 0u ? cnt : 1u;
}
__device__ __forceinline__ void xcd_barrier(const XcdBarrier& b) {
    asm volatile("s_waitcnt vmcnt(0)" ::: "memory");
    wg_sync();
    if (threadIdx.x == 0) {
        unsigned* bar = b.bar;
        __builtin_amdgcn_s_waitcnt(0);
        unsigned nloc = b.st[0], nx = b.st[1];
        if (nloc == 0u) { xcd_barrier_complete(bar, b.x, nloc, nx); b.st[0] = nloc; b.st[1] = nx; }
        const unsigned old = xb_add(&bar[XB_XSUB(b.x)], 1u);
        const unsigned gen = old / nloc;
        if (old + 1u == (gen + 1u) * nloc) {
            __builtin_amdgcn_fence(__ATOMIC_RELEASE, "agent");
            asm volatile("s_waitcnt vmcnt(0)" ::: "memory");
            const unsigned og = xb_add(&bar[XB_TOP], 1u);
            const unsigned tg = og / nx;
            if (og + 1u == (tg + 1u) * nx) xb_add(&bar[XB_TOPGEN], 1u);
            else XB_SPIN(xb_ld(&bar[XB_TOPGEN]) == tg, bar);
            __builtin_amdgcn_fence(__ATOMIC_ACQUIRE, "agent");
            xb_add(&bar[XB_XGEN(b.x)], 1u);
            asm volatile("s_waitcnt vmcnt(0)" ::: "memory");
        } else {
            XB_SPIN(xb_ld(&bar[XB_XGEN(b.x)]) == gen, bar);
            __builtin_amdgcn_fence(__ATOMIC_ACQUIRE, "agent");
            asm volatile("s_waitcnt vmcnt(0)" ::: "memory");
        }
    }
    wg_sync();
}

__device__ __forceinline__ const void* kin(int k) {
    typedef __attribute__((address_space(4))) const char* kptr_t;
    kptr_t p = (kptr_t)__builtin_amdgcn_kernarg_segment_ptr(); asm volatile("" : "+s"(p));
    const unsigned long long v = *(__attribute__((address_space(4))) const unsigned long long*)(p + 8 * k);
    return (const void*)(GAS const void*)v;
}
struct Frame {
    LAS unsigned char* lds;
    int tid, lane, wave, vcu, G, l;
    unsigned char* ws; float* out;
#define FIN(name, T, k) __device__ __forceinline__ const T* name() const { return (const T*)kin(k); }
    FIN(x, float, 0) FIN(pos, int, 1) FIN(g_mix, float, 2) FIN(w_in, float, 3) FIN(a_re, float, 4) FIN(a_im, float, 5) FIN(log_dt, float, 6) FIN(b_re, float, 7) FIN(b_im, float, 8)
    FIN(c_re, float, 9) FIN(c_im, float, 10) FIN(s5_d, float, 11) FIN(w_glu, float, 12) FIN(gla_wg, float, 13) FIN(gla_bg, float, 14) FIN(pool_w, float, 15) FIN(pool_scale, float, 16)
    FIN(w_branch, float, 17) FIN(w_out, float, 18) FIN(g_ffn, float, 19) FIN(w_up, float, 20) FIN(conv_w, float, 21) FIN(conv_b, float, 22) FIN(w_down, float, 23) FIN(g_final, float, 24)
#undef FIN
#define FWS(name, T, off) __device__ __forceinline__ T* name() const { return (T*)(ws + (off)); }
    FWS(rotc, float, WS_ROT) FWS(rots, float, WS_ROT + (size_t)M * 32 * 4) FWS(abar, float, WS_S5T + S5T_ABAR) FWS(apow, float, WS_S5T + S5T_APOW) FWS(bbar, float, WS_S5T + S5T_BBAR) FWS(cmt, bf16_t, WS_S5T + S5T_CMT) FWS(bbt, bf16_t, WS_S5T + S5T_BBT)
    FWS(wglu_t, bf16_t, WS_WGLU) FWS(poolw_t, bf16_t, WS_POOLW) FWS(win_t, bf16_t, WS_WIN) FWS(wbr_t, bf16_t, WS_WBR) FWS(wout_t, bf16_t, WS_WOUT) FWS(wup_t, bf16_t, WS_WUP) FWS(wdn_t, bf16_t, WS_WDN)
    FWS(HN8, unsigned char, WS_HN8) FWS(W8, unsigned char, WS_W8) FWS(HN, bf16_t, WS_HN) FWS(Y, bf16_t, WS_Y) FWS(YBP, bf16_t, WS_YBP) FWS(PROJ, bf16_t, WS_PROJ) FWS(SPREV, bf16_t, WS_SPREV) FWS(ACT, bf16_t, WS_ACT)
    FWS(SS, float, WS_SS + (size_t)l * 32 * M * 4) FWS(RS, float, WS_RS + (size_t)l * M * 4) FWS(STATE, float, WS_STATE) FWS(DEC, float, WS_DEC) FWS(XEND, float, WS_XEND) FWS(UH, float, WS_UH)
#undef FWS
};

__device__ __forceinline__ float lane_read(float v, int src_lane) { return __builtin_bit_cast(float, __builtin_amdgcn_ds_bpermute(src_lane << 2, __builtin_bit_cast(int, v))); }
__device__ __forceinline__ float wave_sum(float v, int lane) {
#pragma unroll
    for (int o = 1; o < 64; o <<= 1) v += lane_read(v, lane ^ o);
    return v;
}

template <class SrcCol>
__device__ __forceinline__ void transpose_item(const float* W, int Nsrc, bf16_t* WT, int ldt, int kdst0, int k0, int n0, SrcCol srccol, LAS float* scr, int lane, const float* kscale = nullptr) {
    const int sc = srccol(n0 + (lane & 31));
    float wv[32];
#pragma unroll
    for (int i = 0; i < 32; ++i) { const int kk = 2 * i + (lane >> 5); wv[i] = sc >= 0 ? W[(size_t)(k0 + kk) * Nsrc + sc] : 0.f; }
#pragma unroll
    for (int i = 0; i < 32; ++i) { const int kk = 2 * i + (lane >> 5); scr[kk * 33 + (lane & 31)] = kscale ? wv[i] * kscale[k0 + kk] : wv[i]; }
    LDS_WAIT();
    const int c = lane & 7;
#pragma unroll
    for (int j = 0; j < 4; ++j) { const int n = (lane >> 3) + 8 * j; const LAS float* s = scr + (8 * c) * 33 + n;
        u32x4 o; o.x = pk2(s[0 * 33], s[1 * 33]); o.y = pk2(s[2 * 33], s[3 * 33]); o.z = pk2(s[4 * 33], s[5 * 33]); o.w = pk2(s[6 * 33], s[7 * 33]);
        *(u32x4*)(WT + (size_t)(n0 + n) * ldt + kdst0 + k0 + 8 * c) = o; }
    LDS_WAIT();
}
template <class SrcCol>
__device__ __forceinline__ void transpose_item_fp8(const float* W, int Nsrc, unsigned char* WT, int ldt, int k0, int n0src, int n0dst, SrcCol srccol, LAS float* scr, int lane, const float* kscale, float scale) {
    const int sc = srccol(n0src + (lane & 31));
    float wv[32];
#pragma unroll
    for (int i = 0; i < 32; ++i) { const int kk = 2 * i + (lane >> 5); wv[i] = sc >= 0 ? W[(size_t)(k0 + kk) * Nsrc + sc] : 0.f; }
#pragma unroll
    for (int i = 0; i < 32; ++i) { const int kk = 2 * i + (lane >> 5); scr[kk * 33 + (lane & 31)] = (kscale ? wv[i] * kscale[k0 + kk] : wv[i]) * scale; }
    LDS_WAIT();
    const int c = lane & 7;
#pragma unroll
    for (int j = 0; j < 4; ++j) { const int n = (lane >> 3) + 8 * j; const LAS float* s = scr + (8 * c) * 33 + n;
        u32x2 o; o.x = pk4_fp8(s[0 * 33], s[1 * 33], s[2 * 33], s[3 * 33]); o.y = pk4_fp8(s[4 * 33], s[5 * 33], s[6 * 33], s[7 * 33]);
        *(u32x2*)(WT + (size_t)(n0dst + n) * ldt + k0 + 8 * c) = o; }
    LDS_WAIT();
}
struct ColIdent { __device__ __forceinline__ int operator()(int n) const { return n; } };
struct ColWin { __device__ __forceinline__ int operator()(int n) const {
    if (n < 3584) return n; if (n < 4096) return n + 16; if (n < 4112) return n - 512; if (n < 4352) return -1;
    const int t = (n - 4352) >> 8, cl = (n - 4352) & 255; const int br = 2 * (cl >> 7) + ((cl >> 2) & 1), ch = 16 * ((cl >> 5) & 3) + 4 * ((cl >> 3) & 3) + (cl & 3);
    return 4112 + br * 2048 + 64 * t + ch; } };
struct ColWup { __device__ __forceinline__ int operator()(int n) const { const int blk = n >> 8, r = n & 255; return (r < 128) ? (blk * 128 + r) : (DFF + blk * 128 + (r - 128)); } };

__device__ __forceinline__ void rms_row_to_bf16(const float* xrow, const float* g, bf16_t* orow, int lane, unsigned char* orow8 = nullptr) {
    const f32x4* xr = (const f32x4*)xrow + lane; const f32x4* gr = (const f32x4*)g + lane;
    f32x4 v[8]; float s = 0.f;
#pragma unroll
    for (int j = 0; j < 8; ++j) { v[j] = xr[64 * j]; s += (v[j].x * v[j].x + v[j].y * v[j].y) + (v[j].z * v[j].z + v[j].w * v[j].w); }
    const float r = 1.0f / sqrtf(wave_sum(s, lane) * (1.f / D) + EPS);
    u32x2* o8 = (u32x2*)orow + lane;
#pragma unroll
    for (int j = 0; j < 8; ++j) { const f32x4 gg = gr[64 * j]; const float a = v[j].x * r * gg.x, b = v[j].y * r * gg.y, c = v[j].z * r * gg.z, d = v[j].w * r * gg.w; u32x2 w; w.x = pk2(a, b); w.y = pk2(c, d); o8[64 * j] = w;
        if (orow8) ((unsigned*)orow8)[lane + 64 * j] = pk4_fp8(a, b, c, d); }
}
__device__ __forceinline__ void rms_rows(Frame& F, const float* src, const float* g, bf16_t* dst, unsigned char* dst8 = nullptr) {
    const int gw = F.vcu * NWAVES + F.wave, NGW = F.G * NWAVES;
    for (int m = gw; m < M; m += NGW) rms_row_to_bf16(src + (size_t)m * D, g, dst + (size_t)m * D, F.lane, dst8 ? dst8 + (size_t)m * D : nullptr);
}
__device__ __forceinline__ void row_scale(Frame& F) {
    const int gt = F.vcu * (NWAVES * 64) + F.tid, NGT = F.G * NWAVES * 64;
    for (int m = gt; m < M; m += NGT) { float s = 0.f;
#pragma unroll
        for (int j = 0; j < 32; ++j) s += F.SS()[(size_t)j * M + m];
        const int r = m & 255;
        F.RS()[((size_t)((m >> 8) * 2 + ((r >> 6) & 1)) * 16 + (r & 15)) * 8 + (r >> 7) * 4 + ((r >> 4) & 3)] = 1.0f / sqrtf(s * (1.f / D) + EPS); }
}
__device__ __forceinline__ void rms_rows16(Frame& F, const bf16_t* src, const float* g, bf16_t* dst, unsigned char* dst8) {
    const int gw = F.vcu * NWAVES + F.wave, NGW = F.G * NWAVES, lane = F.lane;
    for (int m = gw; m < M; m += NGW) {
        const u32x4* xr = (const u32x4*)(src + (size_t)m * D) + lane; float v[4][8]; float s = 0.f;
#pragma unroll
        for (int j = 0; j < 4; ++j) { unpack8(xr[64 * j], v[j]);
#pragma unroll
            for (int q = 0; q < 8; ++q) s += v[j][q] * v[j][q]; }
        const float r = 1.0f / sqrtf(wave_sum(s, lane) * (1.f / D) + EPS);
        u32x4* o16 = (u32x4*)(dst + (size_t)m * D) + lane; u32x2* o8 = (u32x2*)(dst8 + (size_t)m * D) + lane;
#pragma unroll
        for (int j = 0; j < 4; ++j) { const f32x4 g0 = *((const f32x4*)g + 2 * (lane + 64 * j)), g1 = *((const f32x4*)g + 2 * (lane + 64 * j) + 1); float y[8];
            y[0] = v[j][0] * r * g0.x; y[1] = v[j][1] * r * g0.y; y[2] = v[j][2] * r * g0.z; y[3] = v[j][3] * r * g0.w; y[4] = v[j][4] * r * g1.x; y[5] = v[j][5] * r * g1.y; y[6] = v[j][6] * r * g1.z; y[7] = v[j][7] * r * g1.w;
            o16[64 * j] = pack8(y); u32x2 w8; w8.x = pk4_fp8(y[0], y[1], y[2], y[3]); w8.y = pk4_fp8(y[4], y[5], y[6], y[7]); o8[64 * j] = w8; }
    }
}
__device__ __forceinline__ void rms_rows16_to_f32(Frame& F, const bf16_t* src, const float* g, float* out) {
    const int gw = F.vcu * NWAVES + F.wave, NGW = F.G * NWAVES, lane = F.lane;
    for (int m = gw; m < M; m += NGW) {
        const u32x4* xr = (const u32x4*)(src + (size_t)m * D) + lane; float v[4][8]; float s = 0.f;
#pragma unroll
        for (int j = 0; j < 4; ++j) { unpack8(xr[64 * j], v[j]);
#pragma unroll
            for (int q = 0; q < 8; ++q) s += v[j][q] * v[j][q]; }
        const float r = 1.0f / sqrtf(wave_sum(s, lane) * (1.f / D) + EPS);
        f32x4* o = (f32x4*)(out + (size_t)m * D);
#pragma unroll
        for (int j = 0; j < 4; ++j) { const f32x4 g0 = *((const f32x4*)g + 2 * (lane + 64 * j)), g1 = *((const f32x4*)g + 2 * (lane + 64 * j) + 1);
            o[2 * (lane + 64 * j)] = (f32x4){v[j][0] * r * g0.x, v[j][1] * r * g0.y, v[j][2] * r * g0.z, v[j][3] * r * g0.w};
            o[2 * (lane + 64 * j) + 1] = (f32x4){v[j][4] * r * g1.x, v[j][5] * r * g1.y, v[j][6] * r * g1.z, v[j][7] * r * g1.w}; }
    }
}
__device__ __forceinline__ void rms_rows_f32_inplace(Frame& F, float* buf, const float* g) {
    const int gw = F.vcu * NWAVES + F.wave, NGW = F.G * NWAVES;
    for (int m = gw; m < M; m += NGW) {
        f32x4* xr = (f32x4*)(buf + (size_t)m * D) + F.lane; const f32x4* gr = (const f32x4*)g + F.lane;
        f32x4 v[8]; float s = 0.f;
#pragma unroll
        for (int j = 0; j < 8; ++j) { v[j] = xr[64 * j]; s += (v[j].x * v[j].x + v[j].y * v[j].y) + (v[j].z * v[j].z + v[j].w * v[j].w); }
        const float r = 1.0f / sqrtf(wave_sum(s, F.lane) * (1.f / D) + EPS);
#pragma unroll
        for (int j = 0; j < 8; ++j) { const f32x4 gg = gr[64 * j]; xr[64 * j] = (f32x4){v[j].x * r * gg.x, v[j].y * r * gg.y, v[j].z * r * gg.z, v[j].w * r * gg.w}; }
    }
}

__device__ __forceinline__ void phase_prep(Frame& F, int l) {
    LAS float* scr = (LAS float*)(F.lds + F.wave * 16384);
    const int gw = F.vcu * NWAVES + F.wave, NGW = F.G * NWAVES;
    constexpr int I_IN = (D / 64) * (NIN / 32), I_UP = (D / 64) * (NUP / 32), I_DN = (DFF / 64) * (D / 32), I_BR = 4 * (BW / 64) * (D / 32), I_OUT = (D / 64) * (D / 32), I_GLU = (BW / 64) * (BW / 32), I_PL = 4 * (128 / 64) * (128 / 32);
    constexpr int NITEMS = I_IN + I_UP + I_DN + I_BR + I_OUT + I_GLU + I_PL;
    for (int it = gw; it < NITEMS; it += NGW) {
        int r = it;
        if (r < I_IN) { const int nb = NIN / 32, n0 = 32 * (r % nb);
            if (n0 < C_GATE) transpose_item(F.w_in() + (size_t)l * D * NIN_SRC, NIN_SRC, F.win_t(), D, 0, 64 * (r / nb), n0, ColWin(), scr, F.lane);
            else transpose_item_fp8(F.w_in() + (size_t)l * D * NIN_SRC, NIN_SRC, F.W8(), D, 64 * (r / nb), n0, n0 - C_GATE, ColWin(), scr, F.lane, nullptr, 64.0f);
            continue; } r -= I_IN;
        if (r < I_UP) { const int nb = NUP / 32; transpose_item(F.w_up() + (size_t)l * D * NUP, NUP, F.wup_t(), D, 0, 64 * (r / nb), 32 * (r % nb), ColWup(), scr, F.lane, F.g_ffn() + (size_t)l * D); continue; } r -= I_UP;
        if (r < I_DN) { const int nb = D / 32; transpose_item(F.w_down() + (size_t)l * DFF * D, D, F.wdn_t(), DFF, 0, 64 * (r / nb), 32 * (r % nb), ColIdent(), scr, F.lane); continue; } r -= I_DN;
        if (r < I_BR) { const int per = (BW / 64) * (D / 32), br = r / per, q = r % per, nb = D / 32;
            transpose_item(F.w_branch() + ((size_t)l * 4 + br) * BW * D, D, F.wbr_t(), D, br * BW, 64 * (q / nb), 32 * (q % nb), ColIdent(), scr, F.lane); continue; } r -= I_BR;
        if (r < I_OUT) { const int nb = D / 32; transpose_item(F.w_out() + (size_t)l * D * D, D, F.wout_t(), D, 0, 64 * (r / nb), 32 * (r % nb), ColIdent(), scr, F.lane); continue; } r -= I_OUT;
        if (r < I_GLU) { const int nb = BW / 32; transpose_item(F.w_glu() + (size_t)l * BW * BW, BW, F.wglu_t(), BW, 0, 64 * (r / nb), 32 * (r % nb), ColIdent(), scr, F.lane); continue; } r -= I_GLU;
        { const int grp = r / 8, q = r % 8; transpose_item(F.pool_w() + ((size_t)l * 4 + grp) * 128 * 128, 128, F.poolw_t() + (size_t)grp * 128 * 128, 128, 0, 64 * (q / 4), 32 * (q % 4), ColIdent(), scr, F.lane); }
    }
    const int gt = F.vcu * (NWAVES * 64) + F.tid, NGT = F.G * NWAVES * 64;
    for (int i = gt; i < 32 * 64; i += NGT) {
        const int g = i >> 6;
        const float are = F.a_re()[(size_t)l * 2048 + i], aim = F.a_im()[(size_t)l * 2048 + i], dt = expf(F.log_dt()[l * 32 + g]);
        const float mag = expf(are * dt), th = aim * dt;
        const float abr = mag * cosf(th), abi = mag * sinf(th);
        const float den = are * are + aim * aim, nr = abr - 1.0f, ni = abi;
        const float fre = (nr * are + ni * aim) / den, fim = (ni * are - nr * aim) / den;
        F.abar()[2 * i] = abr; F.abar()[2 * i + 1] = abi;
        float pr = abr, pi = abi;
#pragma unroll
        for (int q = 0; q < 6; ++q) { const float tr = pr * pr - pi * pi, ti = 2.f * pr * pi; pr = tr; pi = ti; }
        F.apow()[2 * i] = pr; F.apow()[2 * i + 1] = pi;
        const float* br = F.b_re() + ((size_t)l * 2048 + i) * 16; const float* bi = F.b_im() + ((size_t)l * 2048 + i) * 16;
#pragma unroll
        for (int c = 0; c < 16; ++c) { const float x = br[c], y = bi[c]; const float vr = fre * x - fim * y, vi = fre * y + fim * x; const int p = i & 63;
            F.bbt()[((size_t)g * 128 + p) * 16 + c] = (bf16_t)f2bf(vr); F.bbt()[((size_t)g * 128 + 64 + p) * 16 + c] = (bf16_t)f2bf(vi); }
    }
    for (int i = gt; i < 32 * 16 * 128; i += NGT) {
        const int k = i & 127, gc = i >> 7;
        const float v = (k < 64) ? F.c_re()[((size_t)l * 512 + gc) * 64 + k] : -F.c_im()[((size_t)l * 512 + gc) * 64 + (k - 64)];
        F.cmt()[i] = (bf16_t)f2bf(v);
    }
    if (l == 0) {
        for (int i = gt; i < M * 32; i += NGT) {
            const int row = i >> 5, j = i & 31;
            const float inv = exp2f(-(float)j * (13.287712379549449f / 32.0f));
            const float ang = (float)F.pos()[row] * inv;
            F.rotc()[i] = cosf(ang); F.rots()[i] = sinf(ang);
        }
    }
    if (l == 0) rms_rows(F, F.x(), F.g_mix(), F.HN(), F.HN8()); else rms_rows16(F, (const bf16_t*)F.out, F.g_mix() + (size_t)l * D, F.HN(), F.HN8());
}

__device__ __forceinline__ void gr_pass(Frame& F) {
    const int gw = F.vcu * NWAVES + F.wave, NGW = F.G * NWAVES, lane = F.lane, lr = lane & 15, lq = lane >> 4;
    for (int unit = gw; unit < M / 16; unit += NGW) {
        const bf16_t* ap = F.HN() + (size_t)(16 * unit + lr) * D + 8 * lq; const bf16_t* bp = F.win_t() + (size_t)(C_GR + lr) * D + 8 * lq;
        f32x4 acc = (f32x4){0.f, 0.f, 0.f, 0.f};
#pragma unroll 1
        for (int kb = 0; kb < 64; kb += 8) { bf16x8 a[8], b[8];
#pragma unroll
            for (int j = 0; j < 8; ++j) { a[j] = *(const bf16x8*)(ap + 32 * (kb + j)); b[j] = *(const bf16x8*)(bp + 32 * (kb + j)); }
#pragma unroll
            for (int j = 0; j < 8; ++j) acc = __builtin_amdgcn_mfma_f32_16x16x32_bf16(a[j], b[j], acc, 0, 0, 0); }
#pragma unroll
        for (int i = 0; i < 4; ++i) F.PROJ()[(size_t)(16 * unit + 4 * lq + i) * NIN + C_GR + lr] = (bf16_t)f2bf(acc[i]);
    }
}

__device__ __forceinline__ f32x4 mma_nt_lds(const LAS bf16_t* X, int px, const LAS bf16_t* Y, int py, int ksteps, f32x4 acc, int lane) {
    const LAS bf16_t* xp = X + (lane & 15) * px + 8 * (lane >> 4);
    const LAS bf16_t* yp = Y + (lane & 15) * py + 8 * (lane >> 4);
    for (int ks = 0; ks < ksteps; ++ks) {
        const bf16x8 a = *(const LAS bf16x8*)(xp + 32 * ks), b = *(const LAS bf16x8*)(yp + 32 * ks);
        acc = __builtin_amdgcn_mfma_f32_16x16x32_bf16(a, b, acc, 0, 0, 0);
    }
    return acc;
}

constexpr int LN_TOT = 16384, LN_QD = 18432, LN_KI = 27648, LN_PM = 36864, LN_VT = 46080, LN_OB = 64512, LN_WG = 98304, LN_END = 98304 + 4096 + 256;
constexpr int LP = 72;
struct LinRaw { u32x4 q0, q1, k0, k1, v0, v1, g0, g1, gr0, gr1; f32x4 c0, c1, s0, s1; bf16x8 sp0, sp1; };
template <bool OUT>
__device__ __forceinline__ void lin_issue(Frame& F, int unit, LinRaw& R) {
    const int n = unit & 63, h = (unit >> 6) & 3, b = (unit >> 8) & 7, mixer = unit >> 11;
    const size_t row0 = (size_t)b * SEQ + (size_t)n * CH; const int s = F.tid >> 3, c = F.tid & 7;
    const int cq = (mixer == 0 ? C_RQ : C_GQ) + h * 64, ck = (mixer == 0 ? C_RK : C_GK) + h * 64, cv = (mixer == 0 ? C_RV : C_GV) + h * 128, cg = (mixer == 0 ? C_RG : C_GG) + h * 128;
    const bf16_t* pr = F.PROJ() + (row0 + s) * NIN;
    R.k0 = *(const u32x4*)(pr + ck + 8 * c); R.k1 = *(const u32x4*)(pr + ck + 8 * (c ^ 4));
    if (OUT) { R.q0 = *(const u32x4*)(pr + cq + 8 * c); R.q1 = *(const u32x4*)(pr + cq + 8 * (c ^ 4)); }
    { const float* cp = F.rotc() + (row0 + s) * 32 + (c & 3) * 8; const float* sp = F.rots() + (row0 + s) * 32 + (c & 3) * 8;
      R.c0 = *(const f32x4*)cp; R.c1 = *(const f32x4*)(cp + 4); R.s0 = *(const f32x4*)sp; R.s1 = *(const f32x4*)(sp + 4); }
    R.gr0 = *(const u32x4*)(pr + C_GR); R.gr1 = *(const u32x4*)(pr + C_GR + 8);
    R.v0 = *(const u32x4*)(F.PROJ() + (row0 + (F.tid >> 4)) * NIN + cv + (F.tid & 15) * 8);
    R.v1 = *(const u32x4*)(F.PROJ() + (row0 + 32 + (F.tid >> 4)) * NIN + cv + (F.tid & 15) * 8);
    if (OUT) { R.g0 = *(const u32x4*)(pr + cg + 16 * c); R.g1 = *(const u32x4*)(pr + cg + 16 * c + 8);
        const bf16_t* sq = F.SPREV() + (size_t)unit * 8192 + (size_t)(16 * F.wave + (F.lane & 15)) * 64 + 8 * (F.lane >> 4);
        R.sp0 = *(const bf16x8*)sq; R.sp1 = *(const bf16x8*)(sq + 32); }
}
__device__ __forceinline__ void lin_rot(const u32x4 own_, const u32x4 oth_, const LinRaw& R, bool rot, bool hi, float scale, float (&v)[8]) {
    float own[8]; unpack8(own_, own);
    if (!rot) {
#pragma unroll
        for (int j = 0; j < 8; ++j) v[j] = own[j] * scale;
        return; }
    float oth[8]; unpack8(oth_, oth);
    const float cs[8] = {R.c0.x, R.c0.y, R.c0.z, R.c0.w, R.c1.x, R.c1.y, R.c1.z, R.c1.w}, sn[8] = {R.s0.x, R.s0.y, R.s0.z, R.s0.w, R.s1.x, R.s1.y, R.s1.z, R.s1.w};
#pragma unroll
    for (int j = 0; j < 8; ++j) { const float os = oth[j] * sn[j]; v[j] = (own[j] * cs[j] + (hi ? os : -os)) * scale; }
}
__device__ __forceinline__ void lin_decay(Frame& F, int mixer, int h, const LinRaw& R, float (&bcum)[8], float (&blast)[8]) {
    LAS float* TOT = (LAS float*)(F.lds + LN_TOT);
    const int s = F.tid >> 3, c = F.tid & 7, d0 = 8 * c;
    if (mixer == 0) {
        const float lg = __logf(1.0f - exp2f(-5.0f - (float)h));
#pragma unroll
        for (int j = 0; j < 8; ++j) { bcum[j] = (float)(s + 1) * lg; blast[j] = 64.0f * lg; }
        lds_sync();
        return;
    }
    const LAS float* WG = (const LAS float*)(F.lds + LN_WG);
    float grf[16]; { float a[8], b2[8]; unpack8(R.gr0, a); unpack8(R.gr1, b2);
#pragma unroll
        for (int j = 0; j < 8; ++j) { grf[j] = a[j]; grf[8 + j] = b2[j]; } }
    float x[8]; { const f32x4 b0 = *(const LAS f32x4*)(WG + 1024 + d0), b1 = *(const LAS f32x4*)(WG + 1024 + d0 + 4); x[0] = b0.x; x[1] = b0.y; x[2] = b0.z; x[3] = b0.w; x[4] = b1.x; x[5] = b1.y; x[6] = b1.z; x[7] = b1.w; }
#pragma unroll
    for (int r = 0; r < 16; ++r) { const f32x4 w0 = *(const LAS f32x4*)(WG + r * 64 + d0), w1 = *(const LAS f32x4*)(WG + r * 64 + d0 + 4);
        x[0] += grf[r] * w0.x; x[1] += grf[r] * w0.y; x[2] += grf[r] * w0.z; x[3] += grf[r] * w0.w; x[4] += grf[r] * w1.x; x[5] += grf[r] * w1.y; x[6] += grf[r] * w1.z; x[7] += grf[r] * w1.w; }
#pragma unroll
    for (int j = 0; j < 8; ++j) x[j] = logsigmoidf_(x[j]) * (1.0f / 16.0f);
#pragma unroll
    for (int st = 8; st <= 32; st <<= 1) {
#pragma unroll
        for (int j = 0; j < 8; ++j) { const float t = lane_read(x[j], F.lane - st); if (F.lane >= st) x[j] += t; } }
    if ((F.lane >> 3) == 7) { *(LAS f32x4*)(TOT + F.wave * 64 + d0) = (f32x4){x[0], x[1], x[2], x[3]}; *(LAS f32x4*)(TOT + F.wave * 64 + d0 + 4) = (f32x4){x[4], x[5], x[6], x[7]}; }
    lds_sync();
    float off[8], tot[8];
#pragma unroll
    for (int j = 0; j < 8; ++j) { off[j] = 0.f; tot[j] = 0.f; }
#pragma unroll
    for (int w = 0; w < 8; ++w) { const f32x4 t0 = *(const LAS f32x4*)(TOT + w * 64 + d0), t1 = *(const LAS f32x4*)(TOT + w * 64 + d0 + 4); const float tv[8] = {t0.x, t0.y, t0.z, t0.w, t1.x, t1.y, t1.z, t1.w};
#pragma unroll
        for (int j = 0; j < 8; ++j) { tot[j] += tv[j]; off[j] += (w < F.wave) ? tv[j] : 0.f; } }
#pragma unroll
    for (int j = 0; j < 8; ++j) { bcum[j] = x[j] + off[j]; blast[j] = tot[j]; }
}
typedef short v4s_t __attribute__((ext_vector_type(4)));
__device__ __forceinline__ bf16x8 tr_frag(const LAS bf16_t* T, int pitch, int k0, int x0, int lane) {
    const int g = lane >> 4, i = lane & 15, q = i >> 2, p = i & 3;
    const LAS bf16_t* a = T + (k0 + 8 * g + q) * pitch + x0 + 4 * p;
    const v4s_t lo = __builtin_amdgcn_ds_read_tr16_b64_v4i16((LAS v4s_t*)a), hi = __builtin_amdgcn_ds_read_tr16_b64_v4i16((LAS v4s_t*)(a + 4 * pitch));
    return __builtin_shufflevector(lo, hi, 0, 1, 2, 3, 4, 5, 6, 7);
}
constexpr int PV = 144;
__device__ __forceinline__ void lin_store_vt(Frame& F, const LinRaw& R) {
    LAS bf16_t* VR = (LAS bf16_t*)(F.lds + LN_VT); const int e0 = (F.tid & 15) * 8;
    *(LAS u32x4*)(VR + (F.tid >> 4) * PV + e0) = R.v0; *(LAS u32x4*)(VR + (32 + (F.tid >> 4)) * PV + e0) = R.v1;
}
__device__ __forceinline__ void lin_state_compute(Frame& F, int unit, const LinRaw& R) {
    const int h = (unit >> 6) & 3, mixer = unit >> 11; const int s = F.tid >> 3, c = F.tid & 7, d0 = 8 * c;
    LAS bf16_t* KDT = (LAS bf16_t*)(F.lds + LN_KI); LAS bf16_t* VT = (LAS bf16_t*)(F.lds + LN_VT);
    float k[8], bcum[8], blast[8];
    lin_rot(R.k0, R.k1, R, mixer == 0, c >= 4, mixer == 0 ? 0.125f : 1.0f, k);
    lin_decay(F, mixer, h, R, bcum, blast);
    { float kd[8];
#pragma unroll
      for (int j = 0; j < 8; ++j) kd[j] = k[j] * __expf(blast[j] - bcum[j]);
      *(LAS u32x4*)(KDT + s * LP + d0) = pack8(kd); }
    lin_store_vt(F, R);
    if (s == 0) { float* dc = F.DEC() + (size_t)unit * 64 + d0;
        *(f32x4*)dc = (f32x4){__expf(blast[0]), __expf(blast[1]), __expf(blast[2]), __expf(blast[3])}; *(f32x4*)(dc + 4) = (f32x4){__expf(blast[4]), __expf(blast[5]), __expf(blast[6]), __expf(blast[7])}; }
    lds_sync();
    { const int w = F.wave, lane = F.lane; float* st = F.STATE() + (size_t)unit * 8192;
      const bf16x8 vf0 = tr_frag(VT, PV, 0, 16 * w, lane), vf1 = tr_frag(VT, PV, 32, 16 * w, lane);
#pragma unroll
      for (int dt = 0; dt < 4; ++dt) { f32x4 acc = (f32x4){0.f, 0.f, 0.f, 0.f};
          acc = __builtin_amdgcn_mfma_f32_16x16x32_bf16(vf0, tr_frag(KDT, LP, 0, 16 * dt, lane), acc, 0, 0, 0);
          acc = __builtin_amdgcn_mfma_f32_16x16x32_bf16(vf1, tr_frag(KDT, LP, 32, 16 * dt, lane), acc, 0, 0, 0);
#pragma unroll
          for (int i = 0; i < 4; ++i) st[(16 * w + 4 * (lane >> 4) + i) * 64 + 16 * dt + (lane & 15)] = acc[i]; } }
}
__device__ __forceinline__ void lin_out_compute(Frame& F, int unit, const LinRaw& R) {
    const int n = unit & 63, h = (unit >> 6) & 3, b = (unit >> 8) & 7, mixer = unit >> 11;
    const size_t row0 = (size_t)b * SEQ + (size_t)n * CH; const int s = F.tid >> 3, c = F.tid & 7, d0 = 8 * c;
    const int ycol = (mixer == 0 ? 0 : 1024) + h * 128;
    LAS bf16_t* QD = (LAS bf16_t*)(F.lds + LN_QD); LAS bf16_t* KI = (LAS bf16_t*)(F.lds + LN_KI); LAS bf16_t* PM = (LAS bf16_t*)(F.lds + LN_PM);
    LAS bf16_t* VT = (LAS bf16_t*)(F.lds + LN_VT); LAS float* OB = (LAS float*)(F.lds + LN_OB);
    float q[8], k[8], bcum[8], blast[8];
    lin_rot(R.q0, R.q1, R, mixer == 0, c >= 4, mixer == 0 ? 1.0f : 0.125f, q);
    lin_rot(R.k0, R.k1, R, mixer == 0, c >= 4, mixer == 0 ? 0.125f : 1.0f, k);
    lin_decay(F, mixer, h, R, bcum, blast);
    { float qd[8], ki[8];
#pragma unroll
      for (int j = 0; j < 8; ++j) { qd[j] = q[j] * __expf(bcum[j]); ki[j] = k[j] * __expf(-bcum[j]); }
      *(LAS u32x4*)(QD + s * LP + d0) = pack8(qd); *(LAS u32x4*)(KI + s * LP + d0) = pack8(ki); }
    lin_store_vt(F, R);
    lds_sync();
    { const int lane = F.lane;
#pragma unroll
      for (int j = 0; j < 2; ++j) { const int tile = 2 * F.wave + j, tt = tile >> 2, st = tile & 3;
          f32x4 acc = (f32x4){0.f, 0.f, 0.f, 0.f};
          if (st <= tt) acc = mma_nt_lds(QD + 16 * tt * LP, LP, KI + 16 * st * LP, LP, 2, acc, lane);
#pragma unroll
          for (int i = 0; i < 4; ++i) { const int t = 16 * tt + 4 * (lane >> 4) + i, s2 = 16 * st + (lane & 15); const float p = (st <= tt && s2 <= t) ? acc[i] : 0.f; PM[t * LP + s2] = (bf16_t)f2bf(p); } } }
    lds_sync();
    { const int w = F.wave, lane = F.lane;
      const bf16x8 vf0 = tr_frag(VT, PV, 0, 16 * w, lane), vf1 = tr_frag(VT, PV, 32, 16 * w, lane);
#pragma unroll
      for (int tt = 0; tt < 4; ++tt) { f32x4 acc = (f32x4){0.f, 0.f, 0.f, 0.f};
          { const LAS bf16_t* pp = PM + (16 * tt + (lane & 15)) * LP + 8 * (lane >> 4);
            acc = __builtin_amdgcn_mfma_f32_16x16x32_bf16(*(const LAS bf16x8*)pp, vf0, acc, 0, 0, 0);
            acc = __builtin_amdgcn_mfma_f32_16x16x32_bf16(*(const LAS bf16x8*)(pp + 32), vf1, acc, 0, 0, 0); }
          const LAS bf16_t* xp = QD + (16 * tt + (lane & 15)) * LP + 8 * (lane >> 4);
          acc = __builtin_amdgcn_mfma_f32_16x16x32_bf16(*(const LAS bf16x8*)xp, R.sp0, acc, 0, 0, 0);
          acc = __builtin_amdgcn_mfma_f32_16x16x32_bf16(*(const LAS bf16x8*)(xp + 32), R.sp1, acc, 0, 0, 0);
#pragma unroll
          for (int i = 0; i < 4; ++i) OB[(16 * tt + 4 * (lane >> 4) + i) * 132 + 16 * w + (lane & 15)] = acc[i]; } }
    lds_sync();
    { const int t = s, part = c; float o[16];
#pragma unroll
      for (int j = 0; j < 4; ++j) { const f32x4 v = *(const LAS f32x4*)(OB + t * 132 + 16 * part + 4 * j); o[4 * j] = v.x; o[4 * j + 1] = v.y; o[4 * j + 2] = v.z; o[4 * j + 3] = v.w; }
      float sm = 0.f;
#pragma unroll
      for (int j = 0; j < 16; ++j) sm += o[j];
      sm += lane_read(sm, F.lane ^ 1); sm += lane_read(sm, F.lane ^ 2); sm += lane_read(sm, F.lane ^ 4);
      const float mu = sm * (1.0f / 128.0f); float qv = 0.f;
#pragma unroll
      for (int j = 0; j < 16; ++j) { const float dlt = o[j] - mu; qv += dlt * dlt; }
      qv += lane_read(qv, F.lane ^ 1); qv += lane_read(qv, F.lane ^ 2); qv += lane_read(qv, F.lane ^ 4);
      const float r = 1.0f / sqrtf(qv * (1.0f / 128.0f) + EPS);
      float g0[8], g1[8]; unpack8(R.g0, g0); unpack8(R.g1, g1);
      float y0[8], y1[8];
#pragma unroll
      for (int j = 0; j < 8; ++j) { y0[j] = (o[j] - mu) * r * siluf_(g0[j]); y1[j] = (o[8 + j] - mu) * r * siluf_(g1[j]); }
      bf16_t* yp = F.Y() + (row0 + t) * D + ycol + 16 * part; *(u32x4*)yp = pack8(y0); *(u32x4*)(yp + 8) = pack8(y1); }
}
template <bool OUT>
__device__ __forceinline__ void lin_phase(Frame& F, int l) {
    { const int h = (F.vcu >> 6) & 3; LAS float* WG = (LAS float*)(F.lds + LN_WG);
      for (int i = F.tid; i < 16 * 64 + 64; i += NWAVES * 64) WG[i] = (i < 1024) ? F.gla_wg()[(size_t)l * 16 * 256 + (i >> 6) * 256 + h * 64 + (i & 63)] : F.gla_bg()[l * 256 + h * 64 + (i - 1024)];
      lds_sync(); }
    LinRaw A, B;
    lin_issue<OUT>(F, F.vcu, A);
    for (int u = F.vcu; u < 4096; u += 2 * F.G) {
        lin_issue<OUT>(F, u + F.G, B);
        if (OUT) lin_out_compute(F, u, A); else lin_state_compute(F, u, A);
        if (u + 2 * F.G < 4096) lin_issue<OUT>(F, u + 2 * F.G, A);
        if (OUT) lin_out_compute(F, u + F.G, B); else lin_state_compute(F, u + F.G, B);
    }
    lds_sync();
}
__device__ __forceinline__ void lin_scan(Frame& F) {
    const int gt = F.vcu * (NWAVES * 64) + F.tid, NGT = F.G * NWAVES * 64;
    for (int i = gt; i < 64 * 8192; i += NGT) {
        const int seq = i >> 13, idx = i & 8191, d = idx & 63;
        const float* st = F.STATE() + (size_t)seq * NCH * 8192 + idx; const float* dc = F.DEC() + (size_t)seq * NCH * 64 + d; bf16_t* sp = F.SPREV() + (size_t)seq * NCH * 8192 + idx;
        float carry = 0.f; asm volatile("" : "+v"(carry));
#pragma unroll
        for (int h = 0; h < 2; ++h) {
            float v[32], c[32];
#pragma unroll
            for (int n = 0; n < 32; ++n) { v[n] = st[(size_t)(32 * h + n) * 8192]; c[n] = dc[(size_t)(32 * h + n) * 64]; }
#pragma unroll
            for (int n = 0; n < 32; ++n) { sp[(size_t)(32 * h + n) * 8192] = (bf16_t)f2bf(carry); carry = c[n] * carry + v[n]; asm volatile("" : "+v"(carry)); }
        }
    }
}
constexpr int S5_WL = 16384, S5_BU = 2048, S5_X = 2048 + 8320;
template <bool OUT>
__device__ __forceinline__ void s5_pass(Frame& F, int l) {
    LAS bf16_t* UT = (LAS bf16_t*)(F.lds + F.wave * S5_WL); LAS float* BU = (LAS float*)(F.lds + F.wave * S5_WL + S5_BU); LAS bf16_t* X = (LAS bf16_t*)(F.lds + F.wave * S5_WL + S5_X);
    const int gw = F.vcu * NWAVES + F.wave, NGW = F.G * NWAVES, lane = F.lane, lr = lane & 15, lq = lane >> 4;
    u32x4 ua, uc;
    { const int g = gw & 31, n = (gw >> 5) & 63, b = gw >> 11; const bf16_t* up = F.PROJ() + ((size_t)b * SEQ + (size_t)n * CH + lane) * NIN + C_SU + g * 16; ua = *(const u32x4*)up; uc = *(const u32x4*)(up + 8); }
    for (int unit = gw; unit < BATCH * NCH * 32; unit += NGW) {
        const int g = unit & 31, n = (unit >> 5) & 63, b = unit >> 11; const size_t row0 = (size_t)b * SEQ + (size_t)n * CH;
        *(LAS u32x4*)(UT + lane * 16) = ua; *(LAS u32x4*)(UT + lane * 16 + 8) = uc;
        if (unit + NGW < BATCH * NCH * 32) { const int un = unit + NGW, g2 = un & 31, n2 = (un >> 5) & 63, b2 = un >> 11;
            const bf16_t* up = F.PROJ() + ((size_t)b2 * SEQ + (size_t)n2 * CH + lane) * NIN + C_SU + g2 * 16; ua = *(const u32x4*)up; uc = *(const u32x4*)(up + 8); }
        const int gp = g * 64 + lane; const float ar = F.abar()[2 * gp], ai = F.abar()[2 * gp + 1];
        bf16x8 bfr[8];
#pragma unroll
        for (int q = 0; q < 8; ++q) { bfr[q] = (bf16x8){0, 0, 0, 0, 0, 0, 0, 0}; if (lq < 2) bfr[q] = *(const bf16x8*)(F.bbt() + ((size_t)g * 128 + 16 * q + lr) * 16 + 8 * lq); }
        float xr = 0.f, xi = 0.f;
        bf16x8 cf[4]; float dsk = 0.f;
        if (OUT) { const f32x2 x0 = *(const f32x2*)(F.XEND() + ((((size_t)(b * 32 + g)) * NCH + n) * 64 + lane) * 2); xr = x0.x; xi = x0.y;
#pragma unroll
            for (int ks = 0; ks < 4; ++ks) cf[ks] = *(const bf16x8*)(F.cmt() + ((size_t)(g * 16 + lr)) * 128 + 32 * ks + 8 * lq);
            dsk = F.s5_d()[(size_t)l * BW + g * 16 + lr]; }
        LDS_WAIT();
        for (int sb = 0; sb < 4; ++sb) {
            bf16x8 af = (bf16x8){0, 0, 0, 0, 0, 0, 0, 0}; if (lq < 2) af = *(const LAS bf16x8*)(UT + (16 * sb + lr) * 16 + 8 * lq);
#pragma unroll
            for (int q = 0; q < 8; ++q) { f32x4 acc = (f32x4){0.f, 0.f, 0.f, 0.f}; acc = __builtin_amdgcn_mfma_f32_16x16x32_bf16(af, bfr[q], acc, 0, 0, 0);
#pragma unroll
                for (int i = 0; i < 4; ++i) BU[(4 * lq + i) * 130 + 16 * q + lr] = acc[i]; }
            LDS_WAIT();
            float br[16], bi[16];
#pragma unroll
            for (int tt = 0; tt < 16; ++tt) { br[tt] = BU[tt * 130 + lane]; bi[tt] = BU[tt * 130 + 64 + lane]; }
#pragma unroll
            for (int tt = 0; tt < 16; ++tt) { const float nr = ar * xr - ai * xi + br[tt], ni = ar * xi + ai * xr + bi[tt]; xr = nr; xi = ni; asm volatile("" : "+v"(xr), "+v"(xi));
                if (OUT) { X[tt * 136 + lane] = (bf16_t)f2bf(xr); X[tt * 136 + 64 + lane] = (bf16_t)f2bf(xi); } }
            if (OUT) {
                LDS_WAIT();
                f32x4 acc = (f32x4){0.f, 0.f, 0.f, 0.f}; const LAS bf16_t* xp = X + lr * 136 + 8 * lq;
#pragma unroll
                for (int ks = 0; ks < 4; ++ks) acc = __builtin_amdgcn_mfma_f32_16x16x32_bf16(*(const LAS bf16x8*)(xp + 32 * ks), cf[ks], acc, 0, 0, 0);
#pragma unroll
                for (int i = 0; i < 4; ++i) { const int tl = 16 * sb + 4 * lq + i; const float u = bflo((unsigned)UT[tl * 16 + lr]); const float y = gelu_tanh(acc[i] + dsk * u);
                    F.YBP()[(row0 + tl) * BW + g * 16 + lr] = (bf16_t)f2bf(y); }
            }
            LDS_WAIT();
        }
        if (!OUT) *(f32x2*)(F.XEND() + ((((size_t)(b * 32 + g)) * NCH + n) * 64 + lane) * 2) = (f32x2){xr, xi};
    }
}
__device__ __forceinline__ void s5_scan(Frame& F) {
    const int gt = F.vcu * (NWAVES * 64) + F.tid, NGT = F.G * NWAVES * 64;
    for (int i = gt; i < BATCH * 32 * 64; i += NGT) {
        const int p = i & 63, bg = i >> 6, g = bg & 31; const float pr = F.apow()[2 * (g * 64 + p)], pi = F.apow()[2 * (g * 64 + p) + 1];
        f32x2* xp = (f32x2*)(F.XEND() + (((size_t)bg * NCH) * 64 + p) * 2);
        float cr = 0.f, ci = 0.f; asm volatile("" : "+v"(cr), "+v"(ci));
#pragma unroll
        for (int h = 0; h < 2; ++h) {
            f32x2 v[32];
#pragma unroll
            for (int n = 0; n < 32; ++n) v[n] = xp[(size_t)(32 * h + n) * 64];
#pragma unroll
            for (int n = 0; n < 32; ++n) { xp[(size_t)(32 * h + n) * 64] = (f32x2){cr, ci};
                const float nr = pr * cr - pi * ci + v[n].x, ni = pr * ci + pi * cr + v[n].y; cr = nr; ci = ni; asm volatile("" : "+v"(cr), "+v"(ci)); }
        }
    }
}

__device__ __forceinline__ void pool_phase(Frame& F, int l) {
    const int gw = F.vcu * NWAVES + F.wave, NGW = F.G * NWAVES, lane = F.lane, lr = lane & 15, lq = lane >> 4;
    for (int unit = gw; unit < BATCH * (SEQ / 16) * 4; unit += NGW) {
        const int g = unit & 3, tile = (unit >> 2) & 255, b = unit >> 10; const int win = 2 << g, tpos = 16 * tile + lr; const size_t row = (size_t)b * SEQ + tpos;
        const bf16_t* pp = F.PROJ() + row * NIN + C_PU + g * 128 + 8 * lq;
        float s[4][8];
#pragma unroll
        for (int ks = 0; ks < 4; ++ks)
#pragma unroll
            for (int j = 0; j < 8; ++j) s[ks][j] = 0.f;
        for (int jj = 1; jj < win; ++jj) { if (tpos - jj >= 0) {
#pragma unroll
            for (int ks = 0; ks < 4; ++ks) { float a[8]; unpack8(*(const u32x4*)(pp - (size_t)jj * NIN + 32 * ks), a);
#pragma unroll
                for (int j = 0; j < 8; ++j) s[ks][j] += a[j]; } } }
        const float inv = 1.0f / (float)min(tpos + 1, win);
        bf16x8 mf[4];
#pragma unroll
        for (int ks = 0; ks < 4; ++ks) { float a[8], m[8]; unpack8(*(const u32x4*)(pp + 32 * ks), a);
#pragma unroll
            for (int j = 0; j < 8; ++j) m[j] = (s[ks][j] + a[j]) * inv - a[j];
            const u32x4 w = pack8(m); mf[ks] = __builtin_bit_cast(bf16x8, w); }
        const bf16_t* pw = F.poolw_t() + (size_t)g * 128 * 128 + (size_t)lr * 128 + 8 * lq;
#pragma unroll
        for (int q = 0; q < 8; ++q) { f32x4 acc = (f32x4){0.f, 0.f, 0.f, 0.f};
#pragma unroll
            for (int ks = 0; ks < 4; ++ks) acc = __builtin_amdgcn_mfma_f32_16x16x32_bf16(*(const bf16x8*)(pw + (size_t)(16 * q) * 128 + 32 * ks), mf[ks], acc, 0, 0, 0);
            const int dcol = g * 128 + 16 * q + 4 * lq; const f32x4 sc = *(const f32x4*)(F.pool_scale() + (size_t)l * BW + dcol);
            u32x2 w; w.x = pk2(acc[0] * sc.x, acc[1] * sc.y); w.y = pk2(acc[2] * sc.z, acc[3] * sc.w);
            *(u32x2*)(F.Y() + row * D + 1536 + dcol) = w; }
    }
}

__device__ __forceinline__ void conv_fix_phase(Frame& F, int l) {
    const float* cw = F.conv_w() + (size_t)l * 3 * NUP; const float* cb = F.conv_b() + (size_t)l * NUP; const float* UH = F.UH();
    const int gt = F.vcu * (NWAVES * 64) + F.tid, NGT = F.G * NWAVES * 64;
    constexpr int JG = DFF / 4;
    for (int task = gt; task < (M / 256) * 2 * JG; task += NGT) {
        const int jg = task % JG, q = (task / JG) & 1, pm = task / (2 * JG);
        if ((pm & 15) == 0) continue;
        const int j0 = jg * 4, ucol = 256 * (j0 >> 7) + (j0 & 127);
        const float* u0p = UH + ((size_t)pm * 4 + q) * NUP + ucol;
        const float* u1p = (q == 1) ? UH + ((size_t)pm * 4 + 0) * NUP + ucol : UH + ((size_t)(pm - 1) * 4 + 3) * NUP + ucol;
        const float* u2p = (q == 1) ? UH + ((size_t)(pm - 1) * 4 + 3) * NUP + ucol : UH + ((size_t)(pm - 1) * 4 + 2) * NUP + ucol;
        const f32x4 a0 = *(const f32x4*)u0p, a1 = *(const f32x4*)u1p, a2 = *(const f32x4*)u2p, v0 = *(const f32x4*)(u0p + 128), v1 = *(const f32x4*)(u1p + 128), v2 = *(const f32x4*)(u2p + 128);
        const f32x4 wa0 = *(const f32x4*)(cw + j0), wa1 = *(const f32x4*)(cw + NUP + j0), wa2 = *(const f32x4*)(cw + 2 * NUP + j0), ba = *(const f32x4*)(cb + j0);
        const f32x4 wv0 = *(const f32x4*)(cw + DFF + j0), wv1 = *(const f32x4*)(cw + NUP + DFF + j0), wv2 = *(const f32x4*)(cw + 2 * NUP + DFF + j0), bv = *(const f32x4*)(cb + DFF + j0);
        float o[4];
#pragma unroll
        for (int i = 0; i < 4; ++i) { const float ca = ba[i] + wa0[i] * a2[i] + wa1[i] * a1[i] + wa2[i] * a0[i], cv = bv[i] + wv0[i] * v2[i] + wv1[i] * v1[i] + wv2[i] * v0[i]; o[i] = siluf_(ca) * cv; }
        u32x2 w; w.x = pk2(o[0], o[1]); w.y = pk2(o[2], o[3]);
        *(u32x2*)(F.ACT() + ((size_t)pm * 256 + q) * DFF + j0) = w;
    }
}

constexpr int NPH = 13;
struct Args { const void* in[25]; float* out; unsigned char* ws; int l_lo, l_hi, ph_lo, ph_hi, single, pad; };
__global__ void __launch_bounds__(NWAVES * 64, 2) hybrid_fwd(Args args) {
    extern __shared__ __attribute__((aligned(16))) unsigned char lds[];
    Frame F;
    F.lds = (LAS unsigned char*)lds;
    F.tid = threadIdx.x; F.lane = F.tid & 63; F.wave = __builtin_amdgcn_readfirstlane(F.tid >> 6);
    const int wave0 = F.wave;
    F.G = gridDim.x; { const int bx = blockIdx.x; F.vcu = (F.G % 8 == 0) ? (bx % 8) * (F.G / 8) + bx / 8 : bx; }
    unsigned char* ws = args.ws; F.ws = ws; F.out = args.out; F.l = 0;

    volatile LAS unsigned* MISC = (volatile LAS unsigned*)(F.lds + MISC_OFF);
    if (F.tid < 64) MISC[F.tid] = 0u;
    wg_sync();
    unsigned* ctl = (unsigned*)(ws + WS_CTL);
    XcdBarrier bar; bar.bar = ctl + CW_BAR; bar.x = 0; bar.st = nullptr;
    if (args.single) bar = xcd_barrier_post(ctl + CW_BAR, MISC);
#define GRID_BAR() do { if (args.single) xcd_barrier(bar); } while (0)
    const int lo = args.ph_lo, hi = args.ph_hi;
#define IN(k) (lo <= (k) && (k) < hi)
#define PH_BEGIN() do { unsigned z_ = 0u; asm volatile("" : "+v"(z_)); const int ln_ = (int)__builtin_amdgcn_mbcnt_hi(~0u, __builtin_amdgcn_mbcnt_lo(~0u, z_)); F.lane = ln_; F.tid = wave0 * 64 + ln_; F.wave = wave0; unsigned long long w_ = (unsigned long long)args.ws, o_ = (unsigned long long)args.out; asm volatile("" : "+s"(w_), "+s"(o_)); F.ws = (unsigned char*)(GAS unsigned char*)w_; F.out = (float*)(GAS float*)o_; } while (0)

    for (int l = args.l_lo; l < args.l_hi; ++l) {
        F.l = l;
        if (IN(0)) { PH_BEGIN(); phase_prep(F, l); GRID_BAR(); }
        if (IN(1)) { PH_BEGIN();
            { pg8::Gemm g{(const bf16_t*)F.HN8(), (const bf16_t*)F.W8(), M, 4 * D, D / 2, D / 2, D / 2}; pg8::StaticOrder S; S.init(M, 4 * D, F.G, (int)blockIdx.x); pg8::EpiProj E{F.PROJ(), NIN, 0, C_GATE, 1.0f / 64.0f};
              pg8::gemm_phase<pg8::EpiProj, true>(F.lds, g, S, E, F.tid); }
            PH_BEGIN();
            { pg8::Gemm g{F.HN(), F.win_t(), M, C_GR, D, D, D}; pg8::StaticOrder S; S.init(M, C_GR, F.G, (int)blockIdx.x); pg8::EpiProj E{F.PROJ(), NIN, 1 << 20, C_GATE, 1.0f};
              pg8::gemm_phase(F.lds, g, S, E, F.tid); }
            PH_BEGIN(); gr_pass(F);
            GRID_BAR(); }
        if (IN(2)) { PH_BEGIN(); lin_phase<false>(F, l); PH_BEGIN();
            s5_pass<false>(F, l); pool_phase(F, l); wg_sync();
            GRID_BAR(); }
        if (IN(3)) { PH_BEGIN(); lin_scan(F); s5_scan(F); GRID_BAR(); }
        if (IN(4)) { PH_BEGIN(); lin_phase<true>(F, l); PH_BEGIN();
            s5_pass<true>(F, l); wg_sync();
            GRID_BAR(); }
        if (IN(5)) { PH_BEGIN(); pg8::Gemm g{F.YBP(), F.wglu_t(), M, BW, BW, BW, BW}; pg8::StaticOrder S; S.init(M, BW, F.G, (int)blockIdx.x); pg8::EpiGlu E{F.YBP(), BW, F.Y() + BW, D};
            pg8::gemm_phase(F.lds, g, S, E, F.tid); GRID_BAR(); }
        if (IN(6)) { PH_BEGIN(); pg8::Gemm g{F.Y(), F.wbr_t(), M, D, D, D, D}; pg8::StaticOrder S; S.init(M, D, F.G, (int)blockIdx.x); pg8::EpiMerge E{F.PROJ() + C_GATE, NIN, F.HN(), D};
            pg8::gemm_phase(F.lds, g, S, E, F.tid); GRID_BAR(); }
        if (IN(7)) { PH_BEGIN(); for (int i = 0; i < (F.vcu & 7); ++i) __builtin_amdgcn_s_sleep(50);
            pg8::Gemm g{F.HN(), F.wout_t(), M, D, D, D, D}; pg8::StaticOrder S; S.init(M, D, F.G, (int)blockIdx.x); pg8::EpiResid E{l == 0 ? (const void*)F.x() : (const void*)F.out, l == 0 ? 1 : 0, F.Y(), D, F.SS()};
            pg8::gemm_phase(F.lds, g, S, E, F.tid); GRID_BAR(); }
        if (IN(8)) { PH_BEGIN(); row_scale(F); GRID_BAR(); }
        if (IN(9)) { PH_BEGIN(); pg8::Gemm g{F.Y(), F.wup_t(), M, NUP, D, D, D}; pg8::StaticOrder S; S.init(M, NUP, F.G, (int)blockIdx.x); pg8::EpiConv E{F.conv_w() + (size_t)l * 3 * NUP, F.conv_b() + (size_t)l * NUP, F.ACT(), F.UH(), (LAS float*)(F.lds + pg8::STAGE_BYTES), F.RS()};
            pg8::gemm_phase(F.lds, g, S, E, F.tid); GRID_BAR(); }
        if (IN(10)) { PH_BEGIN(); conv_fix_phase(F, l); GRID_BAR(); }
        if (IN(11)) { PH_BEGIN(); for (int i = 0; i < (F.vcu & 7); ++i) __builtin_amdgcn_s_sleep(50);
            pg8::Gemm g{F.ACT(), F.wdn_t(), M, D, DFF, DFF, DFF}; pg8::StaticOrder S; S.init(M, D, F.G, (int)blockIdx.x); pg8::EpiResid E{(const void*)F.Y(), 0, l == DEPTH - 1 ? F.HN() : (bf16_t*)F.out, D, nullptr};
            pg8::gemm_phase(F.lds, g, S, E, F.tid); GRID_BAR(); }
        if (IN(12) && l == DEPTH - 1) { PH_BEGIN(); rms_rows16_to_f32(F, F.HN(), F.g_final(), F.out); }
    }
#undef IN
#undef PH_BEGIN
#undef GRID_BAR
}

#pragma clang attribute pop
extern "C" void kernel_launch(void* const* d_in, const int* in_sizes, int n_in, void* d_out, int out_size, void* d_ws, size_t ws_size, hipStream_t stream) {
    static int grid = 0;
    if (grid == 0) {
        if (n_in != 25 || in_sizes[0] != M * D || out_size != M * D || ws_size < WS_END) { fprintf(stderr, "kernel_launch: shape/workspace mismatch (n_in %d, in0 %d, out %d, ws %zu, need %zu); nothing launched\n", n_in, n_in > 0 ? in_sizes[0] : -1, out_size, ws_size, (size_t)WS_END); grid = -1; return; }
        int dev = 0, cus = 0, per_cu = 0;
        if (hipGetDevice(&dev) != hipSuccess || hipDeviceGetAttribute(&cus, hipDeviceAttributeMultiprocessorCount, dev) != hipSuccess) { grid = -1; return; }
        if (hipFuncSetAttribute((const void*)hybrid_fwd, hipFuncAttributeMaxDynamicSharedMemorySize, LDS_BYTES) != hipSuccess) { fprintf(stderr, "kernel_launch: hipFuncSetAttribute failed\n"); grid = -1; return; }
        if (hipOccupancyMaxActiveBlocksPerMultiprocessor(&per_cu, (const void*)hybrid_fwd, NWAVES * 64, LDS_BYTES) != hipSuccess || per_cu < 1) { fprintf(stderr, "kernel_launch: occupancy query reports %d workgroups per CU\n", per_cu); }
        (void)hipGetLastError();
        if (cus < 256) { fprintf(stderr, "kernel_launch: built for a 256-CU device (found %d CUs); nothing launched\n", cus); grid = -1; return; }
        grid = 256;
    }
    if (grid < 0) return;
    if (hipMemsetAsync((char*)d_ws + WS_CTL, 0, CTL_ZERO_BYTES, stream) != hipSuccess) return;
    Args a{};
    for (int i = 0; i < 25; ++i) a.in[i] = d_in[i];
    a.out = (float*)d_out; a.ws = (unsigned char*)d_ws;
#if MK_SINGLE
    a.l_lo = 0; a.l_hi = DEPTH; a.ph_lo = 0; a.ph_hi = NPH; a.single = 1;
    hipLaunchKernelGGL(hybrid_fwd, dim3(grid), dim3(NWAVES * 64), LDS_BYTES, stream, a);
#else
    a.single = 0;
    for (int l = 0; l < DEPTH; ++l)
        for (int p = 0; p < NPH; ++p) { if (p == 12 && l != DEPTH - 1) continue; a.l_lo = l; a.l_hi = l + 1; a.ph_lo = p; a.ph_hi = p + 1;
            hipLaunchKernelGGL(hybrid_fwd, dim3(grid), dim3(NWAVES * 64), LDS_BYTES, stream, a); }
#endif
}
```

```cpp
#include <hip/hip_runtime.h>
#include <cstdio>
#include <cstdint>

#ifndef MK_SINGLE
#define MK_SINGLE 1
#endif

#pragma clang attribute push(__attribute__((target("no-packed-fp32-ops"))), apply_to = function)
#define LAS __attribute__((address_space(3)))
#define GAS __attribute__((address_space(1)))
typedef unsigned short bf16_t;
typedef short bf16x8 __attribute__((ext_vector_type(8)));
typedef float f32x4 __attribute__((ext_vector_type(4)));
typedef float f32x2 __attribute__((ext_vector_type(2)));
typedef unsigned u32x4 __attribute__((ext_vector_type(4)));
typedef unsigned u32x2 __attribute__((ext_vector_type(2)));

constexpr int D = 2048, BATCH = 8, SEQ = 4096, DEPTH = 4, M = BATCH * SEQ;
constexpr int BW = 512;
constexpr int NIN_SRC = 12304, NIN = 12544;
constexpr int DFF = 5504, NUP = 11008;
constexpr int C_RQ = 0, C_RK = 256, C_RV = 512, C_RG = 1024, C_SU = 1536, C_GQ = 2048, C_GK = 2304, C_GV = 2560, C_GG = 3072, C_PU = 3584, C_GR = 4096, C_GATE = 4352;
constexpr int LDP = 4224;
constexpr float EPS = 1e-6f;
constexpr int NWAVES = 8;
constexpr int CH = 64;
constexpr int NCH = SEQ / CH;

constexpr size_t MiB = 1u << 20;
constexpr size_t WS_CTL = 0, CTL_ZERO_BYTES = 1 * MiB;
constexpr size_t WS_ROT = 1 * MiB;
constexpr size_t WS_S5T = 9 * MiB;
constexpr size_t S5T_ABAR = 0, S5T_APOW = 16384, S5T_BBAR = 32768, S5T_CMT = 32768 + 262144, S5T_BBT = S5T_CMT + 131072;
constexpr size_t WS_WGLU = 10 * MiB;
constexpr size_t WS_POOLW = 10 * MiB + 512 * 1024;
constexpr size_t WS_WIN = 11 * MiB;
constexpr size_t WS_WBR = 60 * MiB;
constexpr size_t WS_WOUT = 68 * MiB;
constexpr size_t WS_WUP = 76 * MiB;
constexpr size_t WS_WDN = 119 * MiB;
constexpr size_t WS_HN = 141 * MiB;
constexpr size_t WS_Y = 269 * MiB;
constexpr size_t WS_SCR = 397 * MiB;
constexpr size_t WS_YBP = WS_SCR;
constexpr size_t WS_STATE = WS_SCR + 32 * MiB;
constexpr size_t WS_SPREV = WS_SCR + 160 * MiB;
constexpr size_t WS_DEC = WS_SCR + 224 * MiB;
constexpr size_t WS_XEND = WS_SCR + 225 * MiB;
constexpr size_t WS_UH = WS_SCR + 128 * MiB;
constexpr size_t WS_PROJ = 637 * MiB;
constexpr size_t WS_GF = WS_PROJ + 264 * MiB;
constexpr size_t WS_ACT = WS_PROJ;
constexpr size_t WS_RS = 1421 * MiB;
constexpr size_t WS_SS = 1422 * MiB;
constexpr size_t WS_HN8 = 1438 * MiB;
constexpr size_t WS_W8 = 1502 * MiB;
constexpr size_t WS_END = 1518 * MiB;
static_assert(WS_PROJ + (size_t)M * LDP * 2 <= WS_GF && WS_GF + 4 * (size_t)M * D * 2 <= WS_RS, "ws map");
static_assert(WS_ACT + (size_t)M * DFF * 2 <= WS_RS, "ws map");
static_assert(WS_XEND + 8 * MiB <= WS_PROJ, "ws map");
static_assert(WS_UH + (size_t)(M / 256) * 4 * NUP * 4 <= WS_PROJ, "ws map");
constexpr int CW_TMO = 0, CW_BAR = 4096;

constexpr int LDS_BYTES = 155648;
constexpr int MISC_OFF = LDS_BYTES - 256;

#define RLX_AGENT __ATOMIC_RELAXED, __HIP_MEMORY_SCOPE_AGENT
__device__ __forceinline__ void lds_sync() { asm volatile("s_waitcnt lgkmcnt(0)" ::: "memory"); __builtin_amdgcn_s_barrier(); asm volatile("" ::: "memory"); }
__device__ __forceinline__ void wg_sync() { __builtin_amdgcn_fence(__ATOMIC_RELEASE, "workgroup"); __builtin_amdgcn_s_barrier(); __builtin_amdgcn_fence(__ATOMIC_ACQUIRE, "workgroup"); }
#define LDS_WAIT() asm volatile("s_waitcnt lgkmcnt(0)" ::: "memory")
#define VM_WAIT() asm volatile("s_waitcnt vmcnt(0)" ::: "memory")
__device__ __forceinline__ unsigned f2bf(float f) { unsigned u = __builtin_bit_cast(unsigned, f); return (u + 0x7fffu + ((u >> 16) & 1u)) >> 16; }
__device__ __forceinline__ unsigned pk2(float lo, float hi) { return f2bf(lo) | (f2bf(hi) << 16); }
__device__ __forceinline__ float bflo(unsigned w) { return __builtin_bit_cast(float, w << 16); }
__device__ __forceinline__ float bfhi(unsigned w) { return __builtin_bit_cast(float, w & 0xffff0000u); }
__device__ __forceinline__ void unpack8(const u32x4 w, float (&v)[8]) { v[0] = bflo(w.x); v[1] = bfhi(w.x); v[2] = bflo(w.y); v[3] = bfhi(w.y); v[4] = bflo(w.z); v[5] = bfhi(w.z); v[6] = bflo(w.w); v[7] = bfhi(w.w); }
__device__ __forceinline__ u32x4 pack8(const float (&v)[8]) { u32x4 w; w.x = pk2(v[0], v[1]); w.y = pk2(v[2], v[3]); w.z = pk2(v[4], v[5]); w.w = pk2(v[6], v[7]); return w; }
__device__ __forceinline__ unsigned pk4_fp8(float a, float b, float c, float d) { unsigned w = 0u; w = __builtin_amdgcn_cvt_pk_fp8_f32(a, b, w, false); w = __builtin_amdgcn_cvt_pk_fp8_f32(c, d, w, true); return w; }
__device__ __forceinline__ float sigmoidf_(float x) { return 1.0f / (1.0f + __expf(-x)); }
__device__ __forceinline__ float siluf_(float x) { return x / (1.0f + __expf(-x)); }
__device__ __forceinline__ float gelu_tanh(float x) { const float u = 1.5957691216f * (x + 0.044715f * x * x * x); return x / (1.0f + __expf(-u)); }
__device__ __forceinline__ float logsigmoidf_(float x) { return fminf(x, 0.f) - __logf(1.0f + __expf(-fabsf(x))); }

namespace pg8 {
constexpr int BM = 256, BK = 64, HALF = 128, HTB = HALF * BK * 2, STAGE_BYTES = 8 * HTB, NXCD = 8, WGM = 4;
__host__ __device__ __forceinline__ int lds_byte(int r, int c) { const int st = (r >> 4) * 2 + (c >> 5), rr = r & 15, cc = c & 31, ob = rr * 64 + cc * 2; return st * 1024 + (ob ^ (((ob >> 9) & 1) << 5)); }
__host__ __device__ __forceinline__ void stage_rc(int b, int& R, int& C) { const int st = b / 1024, sb = b % 1024, swz = sb ^ (((sb >> 9) & 1) << 5); R = (st >> 1) * 16 + swz / 64; C = (st & 1) * 32 + (swz % 64) / 2; }
__host__ __device__ __forceinline__ int perm32(int rho) { const int n = rho >> 4, i = rho & 15; return 8 * (i >> 2) + 4 * n + (i & 3); }

struct Unit { int pm, pn; };
struct Gemm { const bf16_t* A; const bf16_t* Bt; int M, N, K, lda, ldb; };

struct StaticOrder {
    int nM, nN, nwg, G, c;
    __host__ __device__ void init(int M_, int N_, int G_, int c_) { nM = M_ / BM; nN = N_ / BM; nwg = nM * nN; G = G_; c = c_; }
    __host__ __device__ bool next(int i, Unit& u) const {
        const long L = (long)i * G + c; if (L >= nwg) return false;
        int wgid = (int)L; { const int q = nwg / NXCD, r = nwg % NXCD, xcd = wgid % NXCD, off = wgid / NXCD; wgid = (xcd < r ? xcd * (q + 1) : r * (q + 1) + (xcd - r) * q) + off; }
        const int nig = WGM * nN, gid = wgid / nig, fm = gid * WGM, gsz = (nM - fm) < WGM ? (nM - fm) : WGM;
        u.pm = fm + ((wgid % nig) % gsz); u.pn = (wgid % nig) / gsz; return true;
    }
};

__device__ __forceinline__ unsigned cvt_pk_bf16(float lo, float hi) { unsigned r; asm volatile("v_cvt_pk_bf16_f32 %0, %1, %2" : "=v"(r) : "v"(lo), "v"(hi)); return r; }

struct EpiStoreBf16 {
    static constexpr bool PERM = true, KHOOK = false;
    bf16_t* O; int ldc;
    __device__ __forceinline__ void khook(f32x4 (&)[2][2][4][2], const Unit&, int, int, int, int, int) const {}
    __device__ __forceinline__ void operator()(f32x4 (&acc)[2][2][4][2], const Unit& u, int wr, int wc, int fr, int fq) const {
        const int row0 = u.pm * BM + wr * 64 + fr, col0 = u.pn * BM + wc * 32 + 8 * fq;
#pragma unroll
        for (int ai = 0; ai < 2; ++ai)
#pragma unroll
            for (int m = 0; m < 4; ++m) { bf16_t* rowp = O + (size_t)(row0 + ai * HALF + m * 16) * ldc + col0;
#pragma unroll
                for (int bj = 0; bj < 2; ++bj) { const f32x4 v0 = acc[ai][bj][m][0], v1 = acc[ai][bj][m][1];
                    u32x4 w; w.x = cvt_pk_bf16(v0[0], v0[1]); w.y = cvt_pk_bf16(v0[2], v0[3]); w.z = cvt_pk_bf16(v1[0], v1[1]); w.w = cvt_pk_bf16(v1[2], v1[3]);
                    *(u32x4*)(rowp + bj * HALF) = w; } }
    }
};
struct EpiProj {
    static constexpr bool PERM = true, KHOOK = false;
    bf16_t* O; int ldc; int gate_pn0; bf16_t* GF; float gscale;
    __device__ __forceinline__ void khook(f32x4 (&)[2][2][4][2], const Unit&, int, int, int, int, int) const {}
    __device__ __forceinline__ void operator()(f32x4 (&acc)[2][2][4][2], const Unit& u, int wr, int wc, int fr_, int fq_) const {
        int fr = fr_, fq = fq_; asm volatile("" : "+v"(fr), "+v"(fq));
        const int row0 = u.pm * BM + wr * 64 + fr;
        if (u.pn < gate_pn0) {
            const int col0 = u.pn * BM + wc * 32 + 8 * fq;
#pragma unroll
            for (int ai = 0; ai < 2; ++ai)
#pragma unroll
                for (int m = 0; m < 4; ++m) { bf16_t* rowp = O + (size_t)(row0 + ai * HALF + m * 16) * ldc + col0;
#pragma unroll
                    for (int bj = 0; bj < 2; ++bj) { const f32x4 v0 = acc[ai][bj][m][0], v1 = acc[ai][bj][m][1];
                        u32x4 w; w.x = cvt_pk_bf16(v0[0], v0[1]); w.y = cvt_pk_bf16(v0[2], v0[3]); w.z = cvt_pk_bf16(v1[0], v1[1]); w.w = cvt_pk_bf16(v1[2], v1[3]);
                        *(u32x4*)(rowp + bj * HALF) = w; } }
        } else {
            const int t = u.pn - gate_pn0, c0 = 64 * t + 16 * wc + 4 * fq;
            const size_t gbase = ((size_t)((u.pm * 8 + (c0 >> 8)) * 4) * 16 + ((c0 >> 7) & 1)) * 4096 + (size_t)(((wr * 4 + ((c0 >> 5) & 3)) * 64 + ((c0 >> 3) & 3) * 16 + fr) * 8 + (c0 & 7));
#pragma unroll
            for (int ai = 0; ai < 2; ++ai)
#pragma unroll
                for (int m = 0; m < 4; ++m) { bf16_t* rowp = GF + gbase + (size_t)(ai * 8 + m * 2) * 4096;
                    float r1[4], r2[4], r3[4], g3[4];
#pragma unroll
                    for (int i = 0; i < 4; ++i) {
                        const float e0 = __expf(-fminf(fmaxf(acc[ai][0][m][0][i] * gscale, -30.f), 30.f)), e1 = __expf(-fminf(fmaxf(acc[ai][0][m][1][i] * gscale, -30.f), 30.f));
                        const float e2 = __expf(-fminf(fmaxf(acc[ai][1][m][0][i] * gscale, -30.f), 30.f)), e3 = __expf(-fminf(fmaxf(acc[ai][1][m][1][i] * gscale, -30.f), 30.f));
                        const float i0 = __builtin_amdgcn_rcpf(1.f + e0), i1 = __builtin_amdgcn_rcpf(1.f + e1), i2 = __builtin_amdgcn_rcpf(1.f + e2), i3 = __builtin_amdgcn_rcpf(1.f + e3);
                        r1[i] = (1.f + e1) * i0; r2[i] = (1.f + e2) * i1; r3[i] = (1.f + e3) * i2; g3[i] = i3; }
                    u32x2 w;
                    w.x = cvt_pk_bf16(r1[0], r1[1]); w.y = cvt_pk_bf16(r1[2], r1[3]); *(u32x2*)(rowp) = w;
                    w.x = cvt_pk_bf16(r2[0], r2[1]); w.y = cvt_pk_bf16(r2[2], r2[3]); *(u32x2*)(rowp + 16 * 4096) = w;
                    w.x = cvt_pk_bf16(r3[0], r3[1]); w.y = cvt_pk_bf16(r3[2], r3[3]); *(u32x2*)(rowp + 2 * 16 * 4096) = w;
                    w.x = cvt_pk_bf16(g3[0], g3[1]); w.y = cvt_pk_bf16(g3[2], g3[3]); *(u32x2*)(rowp + 3 * 16 * 4096) = w; }
        }
    }
};
__device__ __forceinline__ float dpp_ror1(float x) { return __builtin_bit_cast(float, __builtin_amdgcn_update_dpp(0, __builtin_bit_cast(int, x), 0x121, 0xf, 0xf, false)); }
__device__ __forceinline__ float dpp_ror2(float x) { return __builtin_bit_cast(float, __builtin_amdgcn_update_dpp(0, __builtin_bit_cast(int, x), 0x122, 0xf, 0xf, false)); }
struct EpiConv {
    static constexpr bool PERM = true, KHOOK = false;
    const float* cw; const float* cb; bf16_t* O; float* UH; LAS float* halo; const float* RS;
    __device__ __forceinline__ void khook(f32x4 (&)[2][2][4][2], const Unit&, int, int, int, int, int) const {}
    __device__ __forceinline__ void operator()(f32x4 (&acc)[2][2][4][2], const Unit& u, int wr, int wc, int fr_, int fq_) const {
        int fr = fr_, fq = fq_; asm volatile("" : "+v"(fr), "+v"(fq));
        const int cl0 = wc * 32 + 8 * fq;
        const int j0 = 128 * u.pn + cl0;
        const float* rp = RS + ((size_t)(u.pm * 2 + wr) * 16 + fr) * 8; const f32x4 rs0 = *(const f32x4*)rp, rs1 = *(const f32x4*)(rp + 4);
        f32x4 wa0[3], wv0[3];
#pragma unroll
        for (int q = 0; q < 3; ++q) { wa0[q] = *(const f32x4*)(cw + q * NUP + j0); wv0[q] = *(const f32x4*)(cw + q * NUP + DFF + j0); }
        const f32x4 ba0 = *(const f32x4*)(cb + j0), bv0 = *(const f32x4*)(cb + DFF + j0);
#pragma unroll
        for (int ai = 0; ai < 2; ++ai)
#pragma unroll
            for (int m = 0; m < 4; ++m) { const float r = ai == 0 ? rs0[m] : rs1[m];
#pragma unroll
                for (int bj = 0; bj < 2; ++bj)
#pragma unroll
                    for (int n = 0; n < 2; ++n) acc[ai][bj][m][n] *= r; }
        if (fr >= 14) {
#pragma unroll
            for (int ai = 0; ai < 2; ++ai)
#pragma unroll
                for (int bj = 0; bj < 2; ++bj)
#pragma unroll
                    for (int n = 0; n < 2; ++n) *(LAS f32x4*)(halo + (((2 * ai + wr) * 2 + (fr - 14)) * 256 + 128 * bj + cl0 + 4 * n)) = acc[ai][bj][3][n];
        }
        if (wr == 0 && fr < 2) {
#pragma unroll
            for (int bj = 0; bj < 2; ++bj)
#pragma unroll
                for (int n = 0; n < 2; ++n) *(f32x4*)(UH + ((size_t)u.pm * 4 + fr) * NUP + 256 * u.pn + 128 * bj + cl0 + 4 * n) = acc[0][bj][0][n];
        }
        if (wr == 1 && fr >= 14) {
#pragma unroll
            for (int bj = 0; bj < 2; ++bj)
#pragma unroll
                for (int n = 0; n < 2; ++n) *(f32x4*)(UH + ((size_t)u.pm * 4 + 2 + (fr - 14)) * NUP + 256 * u.pn + 128 * bj + cl0 + 4 * n) = acc[1][bj][3][n];
        }
        asm volatile("s_waitcnt lgkmcnt(0)" ::: "memory"); __builtin_amdgcn_s_barrier(); asm volatile("" ::: "memory");
        const bool is15 = fr == 15, ge14 = fr >= 14;
        unsigned keep[2][4][2];
        f32x4 wa1[3], wv1[3];
#pragma unroll
        for (int q = 0; q < 3; ++q) { wa1[q] = *(const f32x4*)(cw + q * NUP + j0 + 4); wv1[q] = *(const f32x4*)(cw + q * NUP + DFF + j0 + 4); }
        const f32x4 ba1 = *(const f32x4*)(cb + j0 + 4), bv1 = *(const f32x4*)(cb + DFF + j0 + 4);
#pragma unroll
        for (int n = 0; n < 2; ++n) {
            f32x4 wa[3], wv[3];
#pragma unroll
            for (int q = 0; q < 3; ++q) { wa[q] = n == 0 ? wa0[q] : wa1[q]; wv[q] = n == 0 ? wv0[q] : wv1[q]; }
            const f32x4 ba = n == 0 ? ba0 : ba1, bv = n == 0 ? bv0 : bv1;
#pragma unroll
            for (int ai = 0; ai < 2; ++ai) {
                const int blk = 2 * ai + wr;
                f32x4 pa = (f32x4){0.f, 0.f, 0.f, 0.f}, pv = (f32x4){0.f, 0.f, 0.f, 0.f};
                if (blk > 0 && ge14) { pa = *(const LAS f32x4*)(halo + (((blk - 1) * 2 + (fr - 14)) * 256 + cl0 + 4 * n)); pv = *(const LAS f32x4*)(halo + (((blk - 1) * 2 + (fr - 14)) * 256 + 128 + cl0 + 4 * n)); }
#pragma unroll
                for (int m = 0; m < 4; ++m) {
                    const f32x4 ca_ = acc[ai][0][m][n], cv_ = acc[ai][1][m][n]; float o[4];
#pragma unroll
                    for (int i = 0; i < 4; ++i) {
                        const float a1 = dpp_ror1(is15 ? pa[i] : ca_[i]), a2 = dpp_ror2(ge14 ? pa[i] : ca_[i]);
                        const float v1 = dpp_ror1(is15 ? pv[i] : cv_[i]), v2 = dpp_ror2(ge14 ? pv[i] : cv_[i]);
                        const float ca = ba[i] + wa[0][i] * a2 + wa[1][i] * a1 + wa[2][i] * ca_[i];
                        const float cv = bv[i] + wv[0][i] * v2 + wv[1][i] * v1 + wv[2][i] * cv_[i];
                        o[i] = siluf_(ca) * cv; }
                    pa = ca_; pv = cv_;
                    const unsigned lo = cvt_pk_bf16(o[0], o[1]), hi = cvt_pk_bf16(o[2], o[3]);
                    if (n == 0) { keep[ai][m][0] = lo; keep[ai][m][1] = hi; }
                    else { u32x4 w; w.x = keep[ai][m][0]; w.y = keep[ai][m][1]; w.z = lo; w.w = hi;
                        *(u32x4*)(O + (size_t)(u.pm * BM + ai * HALF + wr * 64 + m * 16 + fr) * DFF + j0) = w; }
                }
            }
        }
    }
};
struct EpiResid {
    static constexpr bool PERM = true, KHOOK = false;
    const void* base; int base_f32; bf16_t* O; int ldc; float* SS;
    __device__ __forceinline__ void khook(f32x4 (&)[2][2][4][2], const Unit&, int, int, int, int, int) const {}
    __device__ __forceinline__ void finish(const float (&b)[8], const f32x4 v0, const f32x4 v1, bf16_t* op, float& sq) const {
        const float o0 = b[0] + v0[0], o1 = b[1] + v0[1], o2 = b[2] + v0[2], o3 = b[3] + v0[3], o4 = b[4] + v1[0], o5 = b[5] + v1[1], o6 = b[6] + v1[2], o7 = b[7] + v1[3];
        u32x4 w; w.x = cvt_pk_bf16(o0, o1); w.y = cvt_pk_bf16(o2, o3); w.z = cvt_pk_bf16(o4, o5); w.w = cvt_pk_bf16(o6, o7);
        *(u32x4*)op = w;
        sq += ((o0 * o0 + o1 * o1) + (o2 * o2 + o3 * o3)) + ((o4 * o4 + o5 * o5) + (o6 * o6 + o7 * o7));
    }
    __device__ __forceinline__ void rowsum(float sq, const Unit& u, int wc, int fq, int lane, int row) const {
        sq += __builtin_bit_cast(float, __builtin_amdgcn_ds_bpermute((lane ^ 16) << 2, __builtin_bit_cast(int, sq)));
        sq += __builtin_bit_cast(float, __builtin_amdgcn_ds_bpermute((lane ^ 32) << 2, __builtin_bit_cast(int, sq)));
        if (fq == 0) SS[(size_t)(u.pn * 4 + wc) * M + row] = sq;
    }
    __device__ __forceinline__ void operator()(f32x4 (&acc)[2][2][4][2], const Unit& u, int wr, int wc, int fr_, int fq_) const {
        int fr = fr_, fq = fq_; asm volatile("" : "+v"(fr), "+v"(fq));
        const int row0 = u.pm * BM + wr * 64 + fr, col0 = u.pn * BM + wc * 32 + 8 * fq, lane = fq * 16 + fr;
        if (!base_f32) {
            u32x4 bw[2][4][2];
#pragma unroll
            for (int ai = 0; ai < 2; ++ai)
#pragma unroll
                for (int m = 0; m < 4; ++m)
#pragma unroll
                    for (int bj = 0; bj < 2; ++bj) bw[ai][m][bj] = *(const u32x4*)((const bf16_t*)base + (size_t)(row0 + ai * HALF + m * 16) * ldc + col0 + bj * HALF);
#pragma unroll
            for (int ai = 0; ai < 2; ++ai)
#pragma unroll
                for (int m = 0; m < 4; ++m) { const size_t off = (size_t)(row0 + ai * HALF + m * 16) * ldc + col0; float sq = 0.f;
#pragma unroll
                    for (int bj = 0; bj < 2; ++bj) { float b[8]; unpack8(bw[ai][m][bj], b); finish(b, acc[ai][bj][m][0], acc[ai][bj][m][1], O + off + bj * HALF, sq); }
                    if (SS) rowsum(sq, u, wc, fq, lane, row0 + ai * HALF + m * 16); }
        } else {
#pragma unroll
            for (int ai = 0; ai < 2; ++ai)
#pragma unroll
                for (int m = 0; m < 4; ++m) { const size_t off = (size_t)(row0 + ai * HALF + m * 16) * ldc + col0; float sq = 0.f;
#pragma unroll
                    for (int bj = 0; bj < 2; ++bj) { float b[8]; const float* bp = (const float*)base + off + bj * HALF; const f32x4 b0 = *(const f32x4*)bp, b1 = *(const f32x4*)(bp + 4);
                        b[0] = b0.x; b[1] = b0.y; b[2] = b0.z; b[3] = b0.w; b[4] = b1.x; b[5] = b1.y; b[6] = b1.z; b[7] = b1.w;
                        finish(b, acc[ai][bj][m][0], acc[ai][bj][m][1], O + off + bj * HALF, sq); }
                    if (SS) rowsum(sq, u, wc, fq, lane, row0 + ai * HALF + m * 16);
                    asm volatile("" ::: "memory"); }
        }
    }
};
struct EpiGlu {
    static constexpr bool PERM = true, KHOOK = false;
    const bf16_t* Yp; int ldy; bf16_t* O; int ldc;
    __device__ __forceinline__ void khook(f32x4 (&)[2][2][4][2], const Unit&, int, int, int, int, int) const {}
    __device__ __forceinline__ void operator()(f32x4 (&acc)[2][2][4][2], const Unit& u, int wr, int wc, int fr, int fq) const {
        const int row0 = u.pm * BM + wr * 64 + fr, col0 = u.pn * BM + wc * 32 + 8 * fq;
#pragma unroll
        for (int ai = 0; ai < 2; ++ai)
#pragma unroll
            for (int m = 0; m < 4; ++m) { const size_t r = (size_t)(row0 + ai * HALF + m * 16);
#pragma unroll
                for (int bj = 0; bj < 2; ++bj) { const u32x4 yw = *(const u32x4*)(Yp + r * ldy + col0 + bj * HALF); float y[8]; unpack8(yw, y);
                    const f32x4 v0 = acc[ai][bj][m][0], v1 = acc[ai][bj][m][1]; float o[8];
#pragma unroll
                    for (int j = 0; j < 4; ++j) { o[j] = y[j] * sigmoidf_(v0[j]); o[4 + j] = y[4 + j] * sigmoidf_(v1[j]); }
                    u32x4 w; w.x = cvt_pk_bf16(o[0], o[1]); w.y = cvt_pk_bf16(o[2], o[3]); w.z = cvt_pk_bf16(o[4], o[5]); w.w = cvt_pk_bf16(o[6], o[7]);
                    *(u32x4*)(O + r * ldc + col0 + bj * HALF) = w; } }
    }
};
struct EpiMerge {
    static constexpr bool PERM = true, KHOOK = true;
    const bf16_t* G; bf16_t* O; int ldc;
    __device__ __forceinline__ void scale(f32x4 (&acc)[2][2][4][2], const Unit& u, int s, int wr, int wc, int fr, int fq) const {
        int toff = ((wr * 4 + wc) * 64 + fq * 16 + fr) * 8; asm volatile("" : "+v"(toff));
        const bf16_t* gb = G + (size_t)(((u.pm * 8 + u.pn) * 4 + s) * 16) * 4096 + toff;
        u32x4 w[2][4][2];
#pragma unroll
        for (int ai = 0; ai < 2; ++ai)
#pragma unroll
            for (int m = 0; m < 4; ++m) {
#pragma unroll
                for (int bj = 0; bj < 2; ++bj) w[ai][m][bj] = *(const u32x4*)(gb + (size_t)(ai * 8 + m * 2 + bj) * 4096); }
#pragma unroll
        for (int ai = 0; ai < 2; ++ai)
#pragma unroll
            for (int m = 0; m < 4; ++m)
#pragma unroll
                for (int bj = 0; bj < 2; ++bj) { float f[8]; unpack8(w[ai][m][bj], f);
#pragma unroll
                    for (int j = 0; j < 8; ++j) acc[ai][bj][m][j >> 2][j & 3] *= f[j]; }
    }
    __device__ __forceinline__ void khook(f32x4 (&acc)[2][2][4][2], const Unit& u, int seg, int wr, int wc, int fr, int fq) const { scale(acc, u, seg - 1, wr, wc, fr, fq); }
    __device__ __forceinline__ void operator()(f32x4 (&acc)[2][2][4][2], const Unit& u, int wr, int wc, int fr, int fq) const {
        scale(acc, u, 3, wr, wc, fr, fq);
        const int row0 = u.pm * BM + wr * 64 + fr, col0 = u.pn * BM + wc * 32 + 8 * fq;
#pragma unroll
        for (int ai = 0; ai < 2; ++ai)
#pragma unroll
            for (int m = 0; m < 4; ++m) { bf16_t* rowp = O + (size_t)(row0 + ai * HALF + m * 16) * ldc + col0;
#pragma unroll
                for (int bj = 0; bj < 2; ++bj) { const f32x4 v0 = acc[ai][bj][m][0], v1 = acc[ai][bj][m][1];
                    u32x4 w; w.x = cvt_pk_bf16(v0[0], v0[1]); w.y = cvt_pk_bf16(v0[2], v0[3]); w.z = cvt_pk_bf16(v1[0], v1[1]); w.w = cvt_pk_bf16(v1[2], v1[3]);
                    *(u32x4*)(rowp + bj * HALF) = w; } }
    }
};

typedef int v4i_t __attribute__((ext_vector_type(4)));
typedef int v8i_t __attribute__((ext_vector_type(8)));
template <class Epi, bool F8 = false>
__device__ __forceinline__ void gemm_phase(LAS unsigned char* lds, const Gemm g, const StaticOrder& S, const Epi& E, int tid_in) {
    int tid_ = tid_in; asm volatile("" : "+v"(tid_));
    const int tid = tid_, wid = __builtin_amdgcn_readfirstlane(tid >> 6), lane = tid & 63, wr = wid >> 2, wc = wid & 3, fr = lane & 15, fq = lane >> 4;
    const int K = g.K, nt = K / BK;
    unsigned voffA[2], voffB[2];
#pragma unroll
    for (int i = 0; i < 2; ++i) { int R, C; stage_rc(tid * 16 + i * 8192, R, C); const int Rb = Epi::PERM ? ((R & ~31) + perm32(R & 31)) : R;
        voffA[i] = (unsigned)(R * g.lda + C) * 2u; voffB[i] = (unsigned)(Rb * g.ldb + C) * 2u; }
    const size_t kstep = (size_t)(BK * 2);
    const size_t hstepA = (size_t)HALF * g.lda * 2, hstepB = (size_t)HALF * g.ldb * 2;
    const size_t tstepA = 2 * hstepA, tstepB = 2 * hstepB;
    const unsigned ldsw = (unsigned)wid * 1024u;
    const int aoff = lds_byte(wr * 64 + fr, fq * 8), boff = lds_byte(wc * 32 + fr, fq * 8);
#define PG8_SA(b, h) (((b) * 2 + (h)) * HTB)
#define PG8_SB(b, h) ((4 + (b) * 2 + (h)) * HTB)
#define PG8_STAGE(bufoff, gbase, voff) do { _Pragma("unroll") for (int _i = 0; _i < 2; ++_i) \
        __builtin_amdgcn_global_load_lds((const unsigned*)((const char*)(gbase) + (voff)[_i]), (LAS unsigned*)(lds + (bufoff) + ldsw + _i * 8192), 16, 0, 0); } while (0)
#define PG8_LDA(dst, b, h) do { _Pragma("unroll") for (int m = 0; m < 4; ++m) _Pragma("unroll") for (int k = 0; k < 2; ++k) dst[m][k] = *(const LAS bf16x8*)(lds + PG8_SA(b, h) + aoff + m * 2048 + k * 1024); } while (0)
#define PG8_LDB(dst, b, h) do { _Pragma("unroll") for (int n = 0; n < 2; ++n) _Pragma("unroll") for (int k = 0; k < 2; ++k) dst[n][k] = *(const LAS bf16x8*)(lds + PG8_SB(b, h) + boff + n * 2048 + k * 1024); } while (0)
#define PG8_MMA(ai, bj, At, Bt) do { __builtin_amdgcn_s_setprio(1); _Pragma("unroll") for (int m = 0; m < 4; ++m) _Pragma("unroll") for (int n = 0; n < 2; ++n) _Pragma("unroll") for (int k = 0; k < 2; ++k) \
        acc[ai][bj][m][n] = __builtin_amdgcn_mfma_f32_16x16x32_bf16(Bt[n][k], At[m][k], acc[ai][bj][m][n], 0, 0, 0); __builtin_amdgcn_s_setprio(0); } while (0)
#define PG8_MMA16(ai, bj, At, Bt) PG8_MMA(ai, bj, At, Bt)
#define PG8_MMA8(ai, bj, A8, B8) do { __builtin_amdgcn_s_setprio(1); _Pragma("unroll") for (int m = 0; m < 4; ++m) _Pragma("unroll") for (int n = 0; n < 2; ++n) \
        asm volatile("v_mfma_f32_16x16x128_f8f6f4 %0, %1, %2, %0" : "+v"(acc[ai][bj][m][n]) : "v"(B8[n]), "v"(A8[m])); __builtin_amdgcn_s_setprio(0); } while (0)
#define PG8_LDA8(dst, b, h) do { _Pragma("unroll") for (int m = 0; m < 4; ++m) { dst[m].lo = *(const LAS v4i_t*)(lds + PG8_SA(b, h) + aoff + m * 2048); dst[m].hi = *(const LAS v4i_t*)(lds + PG8_SA(b, h) + aoff + m * 2048 + 1024); } } while (0)
#define PG8_LDB8(dst, b, h) do { _Pragma("unroll") for (int n = 0; n < 2; ++n) { dst[n].lo = *(const LAS v4i_t*)(lds + PG8_SB(b, h) + boff + n * 2048); dst[n].hi = *(const LAS v4i_t*)(lds + PG8_SB(b, h) + boff + n * 2048 + 1024); } } while (0)
#define PG8_XLDA(b, h) do { if constexpr (F8) PG8_LDA8(A8, b, h); else PG8_LDA(At, b, h); } while (0)
#define PG8_XLDB0(b, h) do { if constexpr (F8) PG8_LDB8(B08, b, h); else PG8_LDB(B0, b, h); } while (0)
#define PG8_XLDB1(b, h) do { if constexpr (F8) PG8_LDB8(B18, b, h); else PG8_LDB(B1, b, h); } while (0)
#define PG8_MM0(ai, bj) do { if constexpr (F8) PG8_MMA8(ai, bj, A8, B08); else PG8_MMA16(ai, bj, At, B0); } while (0)
#define PG8_MM1(ai, bj) do { if constexpr (F8) PG8_MMA8(ai, bj, A8, B18); else PG8_MMA16(ai, bj, At, B1); } while (0)
#define PG8_WAIT_V(n) asm volatile("s_waitcnt vmcnt(" #n ")" ::: "memory")
#define PG8_WAIT_L(n) asm volatile("s_waitcnt lgkmcnt(" #n ")" ::: "memory")
#define PG8_BAR __builtin_amdgcn_s_barrier()
#define PG8_SCHED __builtin_amdgcn_sched_barrier(0)
    Unit cur, nxt; int ui = 0;
    if (!S.next(0, cur)) return;
    f32x4 acc[2][2][4][2];
#pragma unroll
    for (int a = 0; a < 2; ++a)
#pragma unroll
        for (int b = 0; b < 2; ++b)
#pragma unroll
            for (int m = 0; m < 4; ++m)
#pragma unroll
                for (int n = 0; n < 2; ++n) acc[a][b][m][n] = (f32x4){0.f, 0.f, 0.f, 0.f};
    bf16x8 At[4][2], B0[2][2], B1[2][2]; v8i_t A8[4], B08[2], B18[2];
    const char* cA = (const char*)g.A + (size_t)cur.pm * tstepA; const char* cB = (const char*)g.Bt + (size_t)cur.pn * tstepB;
    PG8_STAGE(PG8_SB(0, 0), cB, voffB); PG8_STAGE(PG8_SB(0, 1), cB + hstepB, voffB); PG8_STAGE(PG8_SA(0, 0), cA, voffA); PG8_STAGE(PG8_SA(0, 1), cA + hstepA, voffA);
    if (wr == 1) PG8_BAR;
    PG8_WAIT_V(2); PG8_BAR;
    PG8_STAGE(PG8_SB(1, 0), cB + kstep, voffB); PG8_STAGE(PG8_SA(1, 0), cA + kstep, voffA); PG8_STAGE(PG8_SB(1, 1), cB + hstepB + kstep, voffB);
    PG8_WAIT_V(6); PG8_BAR;
    for (;;) {
        const bool has_next = S.next(ui + 1, nxt);
        const char* nA = has_next ? (const char*)g.A + (size_t)nxt.pm * tstepA : cA; const char* nB = has_next ? (const char*)g.Bt + (size_t)nxt.pn * tstepB : cB;
        for (int t = 0; t < nt; t += 2) {
            const bool last = (t == nt - 2);
            const char* a1 = cA + (size_t)(t + 1) * kstep;
            const char* a2 = last ? nA : cA + (size_t)(t + 2) * kstep; const char* b2 = last ? nB : cB + (size_t)(t + 2) * kstep;
            const char* a3 = a2 + kstep; const char* b3 = b2 + kstep;
            if constexpr (Epi::KHOOK) { if (t != 0 && (t & 7) == 0) E.khook(acc, cur, t >> 3, wr, wc, fr, fq); }
            PG8_XLDB0(0, 0); PG8_XLDB1(0, 1); PG8_SCHED; PG8_XLDA(0, 0); PG8_STAGE(PG8_SA(1, 1), a1 + hstepA, voffA);
            PG8_WAIT_V(8); PG8_WAIT_L(0); PG8_BAR; PG8_MM0(0, 0); PG8_MM1(0, 1); PG8_BAR; PG8_SCHED;
            PG8_XLDA(0, 1); PG8_STAGE(PG8_SB(0, 0), b2, voffB); PG8_STAGE(PG8_SB(0, 1), b2 + hstepB, voffB); PG8_STAGE(PG8_SA(0, 0), a2, voffA);
            PG8_WAIT_V(8); PG8_WAIT_L(0); PG8_BAR; PG8_MM0(1, 0); PG8_MM1(1, 1); PG8_BAR; PG8_SCHED;
            PG8_XLDB0(1, 0); PG8_XLDB1(1, 1); PG8_SCHED; PG8_XLDA(1, 0); PG8_STAGE(PG8_SA(0, 1), a2 + hstepA, voffA);
            PG8_WAIT_V(8); PG8_WAIT_L(0); PG8_BAR; PG8_MM0(0, 0); PG8_MM1(0, 1); PG8_BAR; PG8_SCHED;
            PG8_XLDA(1, 1); PG8_STAGE(PG8_SB(1, 0), b3, voffB); PG8_STAGE(PG8_SB(1, 1), b3 + hstepB, voffB); PG8_STAGE(PG8_SA(1, 0), a3, voffA);
            PG8_WAIT_V(8); PG8_WAIT_L(0); PG8_BAR; PG8_MM0(1, 0); PG8_MM1(1, 1); PG8_BAR; PG8_SCHED;
        }
        if (wr == 0) PG8_BAR;
        E(acc, cur, wr, wc, fr, fq);
        if (!has_next) break;
#pragma unroll
        for (int a = 0; a < 2; ++a)
#pragma unroll
            for (int b = 0; b < 2; ++b)
#pragma unroll
                for (int m = 0; m < 4; ++m)
#pragma unroll
                    for (int n = 0; n < 2; ++n) acc[a][b][m][n] = (f32x4){0.f, 0.f, 0.f, 0.f};
        cur = nxt; cA = nA; cB = nB; ++ui;
        if (wr == 1) PG8_BAR;
    }
    PG8_WAIT_V(0);
    PG8_BAR;
#undef PG8_SA
#undef PG8_SB
#undef PG8_STAGE
#undef PG8_LDA
#undef PG8_LDB
#undef PG8_MMA
#undef PG8_MMA8
#undef PG8_MMA16
#undef PG8_LDA8
#undef PG8_LDB8
#undef PG8_XLDA
#undef PG8_XLDB0
#undef PG8_XLDB1
#undef PG8_MM0
#undef PG8_MM1
#undef PG8_WAIT_V
#undef PG8_WAIT_L
#undef PG8_BAR
#undef PG8_SCHED
}
}

#define XB_TMO      128
#define XB_XCNT(j)  (256  + 64 * (j))
#define XB_XSUB(j)  (1280 + 64 * (j))
#define XB_XGEN(j)  (2304 + 64 * (j))
#define XB_TOP      3328
#define XB_TOPGEN   3392
#define XCD_BAR_WORDS 3456
#define XB_SPIN_CAP (1u << 18)
__device__ __forceinline__ unsigned xb_ld(unsigned* p)              { return __hip_atomic_load(p, __ATOMIC_RELAXED, __HIP_MEMORY_SCOPE_AGENT); }
__device__ __forceinline__ unsigned xb_add(unsigned* p, unsigned v) { return __hip_atomic_fetch_add(p, v, __ATOMIC_RELAXED, __HIP_MEMORY_SCOPE_AGENT); }
__device__ __forceinline__ unsigned xb_xcc_id() { return (unsigned)__builtin_amdgcn_s_getreg((3 << 11) | 20) & 0xFu; }
#define XB_SPIN(cond, bar) do { unsigned _sp = 0; while (cond) { __builtin_amdgcn_s_sleep(1); \
    if ((++_sp & 255u) == 0u) { if (xb_ld(&(bar)[XB_TMO])) break; if (_sp > XB_SPIN_CAP) { (void)__hip_atomic_fetch_add(&(bar)[XB_TMO], 1u, __ATOMIC_RELAXED, __HIP_MEMORY_SCOPE_AGENT); break; } } } } while (0)
struct XcdBarrier { unsigned* bar; unsigned x; volatile LAS unsigned* st; };
__device__ __forceinline__ XcdBarrier xcd_barrier_post(unsigned* bar, volatile LAS unsigned* st) {
    XcdBarrier b; b.bar = bar; b.x = xb_xcc_id(); b.st = st;
    if (threadIdx.x == 0) (void)xb_add(&bar[XB_XCNT(b.x)], 1u);
    return b;
}
__device__ __forceinline__ void xcd_barrier_complete(unsigned* bar, unsigned x, unsigned& nloc, unsigned& nx) {
    const unsigned G = gridDim.x * gridDim.y * gridDim.z;
    unsigned sum, cnt, mine, sp = 0u;
    for (;;) {
        sum = 0u; cnt = 0u; mine = 0u;
#pragma nounroll
        for (unsigned j = 0; j < 16; ++j) { const unsigned c = xb_ld(&bar[XB_XCNT(j)]); sum += c; cnt += (c > 0u) ? 1u : 0u; mine = (j == x) ? c : mine; }
        if (sum == G) break;
        __builtin_amdgcn_s_sleep(1);
        if ((++sp & 255u) == 0u) { if (xb_ld(&bar[XB_TMO])) break; if (sp > XB_SPIN_CAP) { (void)__hip_atomic_fetch_add(&bar[XB_TMO], 1u, __ATOMIC_RELAXED, __HIP_MEMORY_SCOPE_AGENT); break; } }
    }
    nloc = mine > 0u ? mine : 1u; nx = cnt > 0u ? cnt : 1u;
}
__device__ __forceinline__ void xcd_barrier(const XcdBarrier& b) {
    asm volatile("s_waitcnt vmcnt(0)" ::: "memory");
    wg_sync();
    if (threadIdx.x == 0) {
        unsigned* bar = b.bar;
        __builtin_amdgcn_s_waitcnt(0);
        unsigned nloc = b.st[0], nx = b.st[1];
        if (nloc == 0u) { xcd_barrier_complete(bar, b.x, nloc, nx); b.st[0] = nloc; b.st[1] = nx; }
        const unsigned old = xb_add(&bar[XB_XSUB(b.x)], 1u);
        const unsigned gen = old / nloc;
        if (old + 1u == (gen + 1u) * nloc) {
            __builtin_amdgcn_fence(__ATOMIC_RELEASE, "agent");
            asm volatile("s_waitcnt vmcnt(0)" ::: "memory");
            const unsigned og = xb_add(&bar[XB_TOP], 1u);
            const unsigned tg = og / nx;
            if (og + 1u == (tg + 1u) * nx) xb_add(&bar[XB_TOPGEN], 1u);
            else XB_SPIN(xb_ld(&bar[XB_TOPGEN]) == tg, bar);
            __builtin_amdgcn_fence(__ATOMIC_ACQUIRE, "agent");
            xb_add(&bar[XB_XGEN(b.x)], 1u);
            asm volatile("s_waitcnt vmcnt(0)" ::: "memory");
        } else {
            XB_SPIN(xb_ld(&bar[XB_XGEN(b.x)]) == gen, bar);
            __builtin_amdgcn_fence(__ATOMIC_ACQUIRE, "agent");
            asm volatile("s_waitcnt vmcnt(0)" ::: "memory");
        }
    }
    wg_sync();
}

__device__ __forceinline__ const void* kin(int k) {
    typedef __attribute__((address_space(4))) const char* kptr_t;
    kptr_t p = (kptr_t)__builtin_amdgcn_kernarg_segment_ptr(); asm volatile("" : "+s"(p));
    const unsigned long long v = *(__attribute__((address_space(4))) const unsigned long long*)(p + 8 * k);
    return (const void*)(GAS const void*)v;
}
struct Frame {
    LAS unsigned char* lds;
    int tid, lane, wave, vcu, G, l;
    unsigned char* ws; float* out;
#define FIN(name, T, k) __device__ __forceinline__ const T* name() const { return (const T*)kin(k); }
    FIN(x, float, 0) FIN(pos, int, 1) FIN(g_mix, float, 2) FIN(w_in, float, 3) FIN(a_re, float, 4) FIN(a_im, float, 5) FIN(log_dt, float, 6) FIN(b_re, float, 7) FIN(b_im, float, 8)
    FIN(c_re, float, 9) FIN(c_im, float, 10) FIN(s5_d, float, 11) FIN(w_glu, float, 12) FIN(gla_wg, float, 13) FIN(gla_bg, float, 14) FIN(pool_w, float, 15) FIN(pool_scale, float, 16)
    FIN(w_branch, float, 17) FIN(w_out, float, 18) FIN(g_ffn, float, 19) FIN(w_up, float, 20) FIN(conv_w, float, 21) FIN(conv_b, float, 22) FIN(w_down, float, 23) FIN(g_final, float, 24)
#undef FIN
#define FWS(name, T, off) __device__ __forceinline__ T* name() const { return (T*)(ws + (off)); }
    FWS(rotc, float, WS_ROT) FWS(rots, float, WS_ROT + (size_t)M * 32 * 4) FWS(abar, float, WS_S5T + S5T_ABAR) FWS(apow, float, WS_S5T + S5T_APOW) FWS(bbar, float, WS_S5T + S5T_BBAR) FWS(cmt, bf16_t, WS_S5T + S5T_CMT) FWS(bbt, bf16_t, WS_S5T + S5T_BBT)
    FWS(wglu_t, bf16_t, WS_WGLU) FWS(poolw_t, bf16_t, WS_POOLW) FWS(win_t, bf16_t, WS_WIN) FWS(wbr_t, bf16_t, WS_WBR) FWS(wout_t, bf16_t, WS_WOUT) FWS(wup_t, bf16_t, WS_WUP) FWS(wdn_t, bf16_t, WS_WDN)
    FWS(HN8, unsigned char, WS_HN8) FWS(W8, unsigned char, WS_W8) FWS(HN, bf16_t, WS_HN) FWS(Y, bf16_t, WS_Y) FWS(YBP, bf16_t, WS_YBP) FWS(PROJ, bf16_t, WS_PROJ) FWS(GF, bf16_t, WS_GF) FWS(SPREV, bf16_t, WS_SPREV) FWS(ACT, bf16_t, WS_ACT)
    FWS(SS, float, WS_SS + (size_t)l * 32 * M * 4) FWS(RS, float, WS_RS + (size_t)l * M * 4) FWS(STATE, float, WS_STATE) FWS(DEC, float, WS_DEC) FWS(XEND, float, WS_XEND) FWS(UH, float, WS_UH)
#undef FWS
};

__device__ __forceinline__ float lane_read(float v, int src_lane) { return __builtin_bit_cast(float, __builtin_amdgcn_ds_bpermute(src_lane << 2, __builtin_bit_cast(int, v))); }
__device__ __forceinline__ float wave_sum(float v, int lane) {
#pragma unroll
    for (int o = 1; o < 64; o <<= 1) v += lane_read(v, lane ^ o);
    return v;
}

template <class SrcCol>
__device__ __forceinline__ void transpose_item(const float* W, int Nsrc, bf16_t* WT, int ldt, int kdst0, int k0, int n0, SrcCol srccol, LAS float* scr, int lane, const float* kscale = nullptr) {
    const int sc = srccol(n0 + (lane & 31));
    float wv[32];
#pragma unroll
    for (int i = 0; i < 32; ++i) { const int kk = 2 * i + (lane >> 5); wv[i] = sc >= 0 ? W[(size_t)(k0 + kk) * Nsrc + sc] : 0.f; }
#pragma unroll
    for (int i = 0; i < 32; ++i) { const int kk = 2 * i + (lane >> 5); scr[kk * 33 + (lane & 31)] = kscale ? wv[i] * kscale[k0 + kk] : wv[i]; }
    LDS_WAIT();
    const int c = lane & 7;
#pragma unroll
    for (int j = 0; j < 4; ++j) { const int n = (lane >> 3) + 8 * j; const LAS float* s = scr + (8 * c) * 33 + n;
        u32x4 o; o.x = pk2(s[0 * 33], s[1 * 33]); o.y = pk2(s[2 * 33], s[3 * 33]); o.z = pk2(s[4 * 33], s[5 * 33]); o.w = pk2(s[6 * 33], s[7 * 33]);
        *(u32x4*)(WT + (size_t)(n0 + n) * ldt + kdst0 + k0 + 8 * c) = o; }
    LDS_WAIT();
}
template <class SrcCol>
__device__ __forceinline__ void transpose_item_fp8(const float* W, int Nsrc, unsigned char* WT, int ldt, int k0, int n0src, int n0dst, SrcCol srccol, LAS float* scr, int lane, const float* kscale, float scale) {
    const int sc = srccol(n0src + (lane & 31));
    float wv[32];
#pragma unroll
    for (int i = 0; i < 32; ++i) { const int kk = 2 * i + (lane >> 5); wv[i] = sc >= 0 ? W[(size_t)(k0 + kk) * Nsrc + sc] : 0.f; }
#pragma unroll
    for (int i = 0; i < 32; ++i) { const int kk = 2 * i + (lane >> 5); scr[kk * 33 + (lane & 31)] = (kscale ? wv[i] * kscale[k0 + kk] : wv[i]) * scale; }
    LDS_WAIT();
    const int c = lane & 7;
#pragma unroll
    for (int j = 0; j < 4; ++j) { const int n = (lane >> 3) + 8 * j; const LAS float* s = scr + (8 * c) * 33 + n;
        u32x2 o; o.x = pk4_fp8(s[0 * 33], s[1 * 33], s[2 * 33], s[3 * 33]); o.y = pk4_fp8(s[4 * 33], s[5 * 33], s[6 * 33], s[7 * 33]);
        *(u32x2*)(WT + (size_t)(n0dst + n) * ldt + k0 + 8 * c) = o; }
    LDS_WAIT();
}
struct ColIdent { __device__ __forceinline__ int operator()(int n) const { return n; } };
struct ColWin { __device__ __forceinline__ int operator()(int n) const {
    if (n < 3584) return n; if (n < 4096) return n + 16; if (n < 4112) return n - 512; if (n < 4352) return -1;
    const int t = (n - 4352) >> 8, cl = (n - 4352) & 255; const int br = 2 * (cl >> 7) + ((cl >> 2) & 1), ch = 16 * ((cl >> 5) & 3) + 4 * ((cl >> 3) & 3) + (cl & 3);
    return 4112 + br * 2048 + 64 * t + ch; } };
struct ColWup { __device__ __forceinline__ int operator()(int n) const { const int blk = n >> 8, r = n & 255; return (r < 128) ? (blk * 128 + r) : (DFF + blk * 128 + (r - 128)); } };

__device__ __forceinline__ void rms_row_to_bf16(const float* xrow, const float* g, bf16_t* orow, int lane, unsigned char* orow8 = nullptr) {
    const f32x4* xr = (const f32x4*)xrow + lane; const f32x4* gr = (const f32x4*)g + lane;
    f32x4 v[8]; float s = 0.f;
#pragma unroll
    for (int j = 0; j < 8; ++j) { v[j] = xr[64 * j]; s += (v[j].x * v[j].x + v[j].y * v[j].y) + (v[j].z * v[j].z + v[j].w * v[j].w); }
    const float r = 1.0f / sqrtf(wave_sum(s, lane) * (1.f / D) + EPS);
    u32x2* o8 = (u32x2*)orow + lane;
#pragma unroll
    for (int j = 0; j < 8; ++j) { const f32x4 gg = gr[64 * j]; const float a = v[j].x * r * gg.x, b = v[j].y * r * gg.y, c = v[j].z * r * gg.z, d = v[j].w * r * gg.w; u32x2 w; w.x = pk2(a, b); w.y = pk2(c, d); o8[64 * j] = w;
        if (orow8) ((unsigned*)orow8)[lane + 64 * j] = pk4_fp8(a, b, c, d); }
}
__device__ __forceinline__ void rms_rows(Frame& F, const float* src, const float* g, bf16_t* dst, unsigned char* dst8 = nullptr) {
    const int gw = F.vcu * NWAVES + F.wave, NGW = F.G * NWAVES;
    for (int m = gw; m < M; m += NGW) rms_row_to_bf16(src + (size_t)m * D, g, dst + (size_t)m * D, F.lane, dst8 ? dst8 + (size_t)m * D : nullptr);
}
__device__ __forceinline__ void row_scale(Frame& F) {
    const int gt = F.vcu * (NWAVES * 64) + F.tid, NGT = F.G * NWAVES * 64;
    for (int m = gt; m < M; m += NGT) { float s = 0.f;
#pragma unroll
        for (int j = 0; j < 32; ++j) s += F.SS()[(size_t)j * M + m];
        const int r = m & 255;
        F.RS()[((size_t)((m >> 8) * 2 + ((r >> 6) & 1)) * 16 + (r & 15)) * 8 + (r >> 7) * 4 + ((r >> 4) & 3)] = 1.0f / sqrtf(s * (1.f / D) + EPS); }
}
__device__ __forceinline__ void rms_rows16(Frame& F, const bf16_t* src, const float* g, bf16_t* dst, unsigned char* dst8) {
    const int gw = F.vcu * NWAVES + F.wave, NGW = F.G * NWAVES, lane = F.lane;
    for (int m = gw; m < M; m += NGW) {
        const u32x4* xr = (const u32x4*)(src + (size_t)m * D) + lane; float v[4][8]; float s = 0.f;
#pragma unroll
        for (int j = 0; j < 4; ++j) { unpack8(xr[64 * j], v[j]);
#pragma unroll
            for (int q = 0; q < 8; ++q) s += v[j][q] * v[j][q]; }
        const float r = 1.0f / sqrtf(wave_sum(s, lane) * (1.f / D) + EPS);
        u32x4* o16 = (u32x4*)(dst + (size_t)m * D) + lane; u32x2* o8 = (u32x2*)(dst8 + (size_t)m * D) + lane;
#pragma unroll
        for (int j = 0; j < 4; ++j) { const f32x4 g0 = *((const f32x4*)g + 2 * (lane + 64 * j)), g1 = *((const f32x4*)g + 2 * (lane + 64 * j) + 1); float y[8];
            y[0] = v[j][0] * r * g0.x; y[1] = v[j][1] * r * g0.y; y[2] = v[j][2] * r * g0.z; y[3] = v[j][3] * r * g0.w; y[4] = v[j][4] * r * g1.x; y[5] = v[j][5] * r * g1.y; y[6] = v[j][6] * r * g1.z; y[7] = v[j][7] * r * g1.w;
            o16[64 * j] = pack8(y); u32x2 w8; w8.x = pk4_fp8(y[0], y[1], y[2], y[3]); w8.y = pk4_fp8(y[4], y[5], y[6], y[7]); o8[64 * j] = w8; }
    }
}
__device__ __forceinline__ void rms_rows16_to_f32(Frame& F, const bf16_t* src, const float* g, float* out) {
    const int gw = F.vcu * NWAVES + F.wave, NGW = F.G * NWAVES, lane = F.lane;
    for (int m = gw; m < M; m += NGW) {
        const u32x4* xr = (const u32x4*)(src + (size_t)m * D) + lane; float v[4][8]; float s = 0.f;
#pragma unroll
        for (int j = 0; j < 4; ++j) { unpack8(xr[64 * j], v[j]);
#pragma unroll
            for (int q = 0; q < 8; ++q) s += v[j][q] * v[j][q]; }
        const float r = 1.0f / sqrtf(wave_sum(s, lane) * (1.f / D) + EPS);
        f32x4* o = (f32x4*)(out + (size_t)m * D);
#pragma unroll
        for (int j = 0; j < 4; ++j) { const f32x4 g0 = *((const f32x4*)g + 2 * (lane + 64 * j)), g1 = *((const f32x4*)g + 2 * (lane + 64 * j) + 1);
            o[2 * (lane + 64 * j)] = (f32x4){v[j][0] * r * g0.x, v[j][1] * r * g0.y, v[j][2] * r * g0.z, v[j][3] * r * g0.w};
            o[2 * (lane + 64 * j) + 1] = (f32x4){v[j][4] * r * g1.x, v[j][5] * r * g1.y, v[j][6] * r * g1.z, v[j][7] * r * g1.w}; }
    }
}
__device__ __forceinline__ void rms_rows_f32_inplace(Frame& F, float* buf, const float* g) {
    const int gw = F.vcu * NWAVES + F.wave, NGW = F.G * NWAVES;
    for (int m = gw; m < M; m += NGW) {
        f32x4* xr = (f32x4*)(buf + (size_t)m * D) + F.lane; const f32x4* gr = (const f32x4*)g + F.lane;
        f32x4 v[8]; float s = 0.f;
#pragma unroll
        for (int j = 0; j < 8; ++j) { v[j] = xr[64 * j]; s += (v[j].x * v[j].x + v[j].y * v[j].y) + (v[j].z * v[j].z + v[j].w * v[j].w); }
        const float r = 1.0f / sqrtf(wave_sum(s, F.lane) * (1.f / D) + EPS);
#pragma unroll
        for (int j = 0; j < 8; ++j) { const f32x4 gg = gr[64 * j]; xr[64 * j] = (f32x4){v[j].x * r * gg.x, v[j].y * r * gg.y, v[j].z * r * gg.z, v[j].w * r * gg.w}; }
    }
}

__device__ __forceinline__ void phase_prep(Frame& F, int l) {
    LAS float* scr = (LAS float*)(F.lds + F.wave * 16384);
    const int gw = F.vcu * NWAVES + F.wave, NGW = F.G * NWAVES;
    constexpr int I_IN = (D / 64) * (NIN / 32), I_UP = (D / 64) * (NUP / 32), I_DN = (DFF / 64) * (D / 32), I_BR = 4 * (BW / 64) * (D / 32), I_OUT = (D / 64) * (D / 32), I_GLU = (BW / 64) * (BW / 32), I_PL = 4 * (128 / 64) * (128 / 32);
    constexpr int NITEMS = I_IN + I_UP + I_DN + I_BR + I_OUT + I_GLU + I_PL;
    for (int it = gw; it < NITEMS; it += NGW) {
        int r = it;
        if (r < I_IN) { const int nb = NIN / 32, n0 = 32 * (r % nb);
            if (n0 < C_GATE) transpose_item(F.w_in() + (size_t)l * D * NIN_SRC, NIN_SRC, F.win_t(), D, 0, 64 * (r / nb), n0, ColWin(), scr, F.lane);
            else transpose_item_fp8(F.w_in() + (size_t)l * D * NIN_SRC, NIN_SRC, F.W8(), D, 64 * (r / nb), n0, n0 - C_GATE, ColWin(), scr, F.lane, nullptr, 64.0f);
            continue; } r -= I_IN;
        if (r < I_UP) { const int nb = NUP / 32; transpose_item(F.w_up() + (size_t)l * D * NUP, NUP, F.wup_t(), D, 0, 64 * (r / nb), 32 * (r % nb), ColWup(), scr, F.lane, F.g_ffn() + (size_t)l * D); continue; } r -= I_UP;
        if (r < I_DN) { const int nb = D / 32; transpose_item(F.w_down() + (size_t)l * DFF * D, D, F.wdn_t(), DFF, 0, 64 * (r / nb), 32 * (r % nb), ColIdent(), scr, F.lane); continue; } r -= I_DN;
        if (r < I_BR) { const int per = (BW / 64) * (D / 32), br = r / per, q = r % per, nb = D / 32;
            transpose_item(F.w_branch() + ((size_t)l * 4 + br) * BW * D, D, F.wbr_t(), D, br * BW, 64 * (q / nb), 32 * (q % nb), ColIdent(), scr, F.lane); continue; } r -= I_BR;
        if (r < I_OUT) { const int nb = D / 32; transpose_item(F.w_out() + (size_t)l * D * D, D, F.wout_t(), D, 0, 64 * (r / nb), 32 * (r % nb), ColIdent(), scr, F.lane); continue; } r -= I_OUT;
        if (r < I_GLU) { const int nb = BW / 32; transpose_item(F.w_glu() + (size_t)l * BW * BW, BW, F.wglu_t(), BW, 0, 64 * (r / nb), 32 * (r % nb), ColIdent(), scr, F.lane); continue; } r -= I_GLU;
        { const int grp = r / 8, q = r % 8; transpose_item(F.pool_w() + ((size_t)l * 4 + grp) * 128 * 128, 128, F.poolw_t() + (size_t)grp * 128 * 128, 128, 0, 64 * (q / 4), 32 * (q % 4), ColIdent(), scr, F.lane); }
    }
    const int gt = F.vcu * (NWAVES * 64) + F.tid, NGT = F.G * NWAVES * 64;
    for (int i = gt; i < 32 * 64; i += NGT) {
        const int g = i >> 6;
        const float are = F.a_re()[(size_t)l * 2048 + i], aim = F.a_im()[(size_t)l * 2048 + i], dt = expf(F.log_dt()[l * 32 + g]);
        const float mag = expf(are * dt), th = aim * dt;
        const float abr = mag * cosf(th), abi = mag * sinf(th);
        const float den = are * are + aim * aim, nr = abr - 1.0f, ni = abi;
        const float fre = (nr * are + ni * aim) / den, fim = (ni * are - nr * aim) / den;
        F.abar()[2 * i] = abr; F.abar()[2 * i + 1] = abi;
        float pr = abr, pi = abi;
#pragma unroll
        for (int q = 0; q < 6; ++q) { const float tr = pr * pr - pi * pi, ti = 2.f * pr * pi; pr = tr; pi = ti; }
        F.apow()[2 * i] = pr; F.apow()[2 * i + 1] = pi;
        const float* br = F.b_re() + ((size_t)l * 2048 + i) * 16; const float* bi = F.b_im() + ((size_t)l * 2048 + i) * 16;
#pragma unroll
        for (int c = 0; c < 16; ++c) { const float x = br[c], y = bi[c]; const float vr = fre * x - fim * y, vi = fre * y + fim * x; const int p = i & 63;
            F.bbt()[((size_t)g * 128 + p) * 16 + c] = (bf16_t)f2bf(vr); F.bbt()[((size_t)g * 128 + 64 + p) * 16 + c] = (bf16_t)f2bf(vi); }
    }
    for (int i = gt; i < 32 * 16 * 128; i += NGT) {
        const int k = i & 127, gc = i >> 7;
        const float v = (k < 64) ? F.c_re()[((size_t)l * 512 + gc) * 64 + k] : -F.c_im()[((size_t)l * 512 + gc) * 64 + (k - 64)];
        F.cmt()[i] = (bf16_t)f2bf(v);
    }
    if (l == 0) {
        for (int i = gt; i < M * 32; i += NGT) {
            const int row = i >> 5, j = i & 31;
            const float inv = exp2f(-(float)j * (13.287712379549449f / 32.0f));
            const float ang = (float)F.pos()[row] * inv;
            F.rotc()[i] = cosf(ang); F.rots()[i] = sinf(ang);
        }
    }
    if (l == 0) rms_rows(F, F.x(), F.g_mix(), F.HN(), F.HN8()); else rms_rows16(F, (const bf16_t*)F.out, F.g_mix() + (size_t)l * D, F.HN(), F.HN8());
}

__device__ __forceinline__ void gr_pass(Frame& F) {
    const int gw = F.vcu * NWAVES + F.wave, NGW = F.G * NWAVES, lane = F.lane, lr = lane & 15, lq = lane >> 4;
    for (int unit = gw; unit < M / 16; unit += NGW) {
        const bf16_t* ap = F.HN() + (size_t)(16 * unit + lr) * D + 8 * lq; const bf16_t* bp = F.win_t() + (size_t)(C_GR + lr) * D + 8 * lq;
        f32x4 acc = (f32x4){0.f, 0.f, 0.f, 0.f};
#pragma unroll 1
        for (int kb = 0; kb < 64; kb += 8) { bf16x8 a[8], b[8];
#pragma unroll
            for (int j = 0; j < 8; ++j) { a[j] = *(const bf16x8*)(ap + 32 * (kb + j)); b[j] = *(const bf16x8*)(bp + 32 * (kb + j)); }
#pragma unroll
            for (int j = 0; j < 8; ++j) acc = __builtin_amdgcn_mfma_f32_16x16x32_bf16(a[j], b[j], acc, 0, 0, 0); }
#pragma unroll
        for (int i = 0; i < 4; ++i) F.PROJ()[(size_t)(16 * unit + 4 * lq + i) * LDP + C_GR + lr] = (bf16_t)f2bf(acc[i]);
    }
}

__device__ __forceinline__ f32x4 mma_nt_lds(const LAS bf16_t* X, int px, const LAS bf16_t* Y, int py, int ksteps, f32x4 acc, int lane) {
    const LAS bf16_t* xp = X + (lane & 15) * px + 8 * (lane >> 4);
    const LAS bf16_t* yp = Y + (lane & 15) * py + 8 * (lane >> 4);
    for (int ks = 0; ks < ksteps; ++ks) {
        const bf16x8 a = *(const LAS bf16x8*)(xp + 32 * ks), b = *(const LAS bf16x8*)(yp + 32 * ks);
        acc = __builtin_amdgcn_mfma_f32_16x16x32_bf16(a, b, acc, 0, 0, 0);
    }
    return acc;
}

constexpr int LN_TOT = 16384, LN_QD = 18432, LN_KI = 27648, LN_PM = 36864, LN_VT = 46080, LN_OB = 64512, LN_WG = 98304, LN_END = 98304 + 4096 + 256;
constexpr int LP = 72;
struct LinRaw { u32x4 q0, q1, k0, k1, v0, v1, g0, g1, gr0, gr1; f32x4 c0, c1, s0, s1; bf16x8 sp0, sp1; };
template <bool OUT>
__device__ __forceinline__ void lin_issue(Frame& F, int unit, LinRaw& R) {
    const int n = unit & 63, h = (unit >> 6) & 3, b = (unit >> 8) & 7, mixer = unit >> 11;
    const size_t row0 = (size_t)b * SEQ + (size_t)n * CH; const int s = F.tid >> 3, c = F.tid & 7;
    const int cq = (mixer == 0 ? C_RQ : C_GQ) + h * 64, ck = (mixer == 0 ? C_RK : C_GK) + h * 64, cv = (mixer == 0 ? C_RV : C_GV) + h * 128, cg = (mixer == 0 ? C_RG : C_GG) + h * 128;
    const bf16_t* pr = F.PROJ() + (row0 + s) * LDP;
    R.k0 = *(const u32x4*)(pr + ck + 8 * c); R.k1 = *(const u32x4*)(pr + ck + 8 * (c ^ 4));
    if (OUT) { R.q0 = *(const u32x4*)(pr + cq + 8 * c); R.q1 = *(const u32x4*)(pr + cq + 8 * (c ^ 4)); }
    { const float* cp = F.rotc() + (row0 + s) * 32 + (c & 3) * 8; const float* sp = F.rots() + (row0 + s) * 32 + (c & 3) * 8;
      R.c0 = *(const f32x4*)cp; R.c1 = *(const f32x4*)(cp + 4); R.s0 = *(const f32x4*)sp; R.s1 = *(const f32x4*)(sp + 4); }
    R.gr0 = *(const u32x4*)(pr + C_GR); R.gr1 = *(const u32x4*)(pr + C_GR + 8);
    R.v0 = *(const u32x4*)(F.PROJ() + (row0 + (F.tid >> 4)) * LDP + cv + (F.tid & 15) * 8);
    R.v1 = *(const u32x4*)(F.PROJ() + (row0 + 32 + (F.tid >> 4)) * LDP + cv + (F.tid & 15) * 8);
    if (OUT) { R.g0 = *(const u32x4*)(pr + cg + 16 * c); R.g1 = *(const u32x4*)(pr + cg + 16 * c + 8);
        const bf16_t* sq = F.SPREV() + (size_t)unit * 8192 + (size_t)(16 * F.wave + (F.lane & 15)) * 64 + 8 * (F.lane >> 4);
        R.sp0 = *(const bf16x8*)sq; R.sp1 = *(const bf16x8*)(sq + 32); }
}
__device__ __forceinline__ void lin_rot(const u32x4 own_, const u32x4 oth_, const LinRaw& R, bool rot, bool hi, float scale, float (&v)[8]) {
    float own[8]; unpack8(own_, own);
    if (!rot) {
#pragma unroll
        for (int j = 0; j < 8; ++j) v[j] = own[j] * scale;
        return; }
    float oth[8]; unpack8(oth_, oth);
    const float cs[8] = {R.c0.x, R.c0.y, R.c0.z, R.c0.w, R.c1.x, R.c1.y, R.c1.z, R.c1.w}, sn[8] = {R.s0.x, R.s0.y, R.s0.z, R.s0.w, R.s1.x, R.s1.y, R.s1.z, R.s1.w};
#pragma unroll
    for (int j = 0; j < 8; ++j) { const float os = oth[j] * sn[j]; v[j] = (own[j] * cs[j] + (hi ? os : -os)) * scale; }
}
__device__ __forceinline__ void lin_decay(Frame& F, int mixer, int h, const LinRaw& R, float (&bcum)[8], float (&blast)[8]) {
    LAS float* TOT = (LAS float*)(F.lds + LN_TOT);
    const int s = F.tid >> 3, c = F.tid & 7, d0 = 8 * c;
    if (mixer == 0) {
        const float lg = __logf(1.0f - exp2f(-5.0f - (float)h));
#pragma unroll
        for (int j = 0; j < 8; ++j) { bcum[j] = (float)(s + 1) * lg; blast[j] = 64.0f * lg; }
        lds_sync();
        return;
    }
    const LAS float* WG = (const LAS float*)(F.lds + LN_WG);
    float grf[16]; { float a[8], b2[8]; unpack8(R.gr0, a); unpack8(R.gr1, b2);
#pragma unroll
        for (int j = 0; j < 8; ++j) { grf[j] = a[j]; grf[8 + j] = b2[j]; } }
    float x[8]; { const f32x4 b0 = *(const LAS f32x4*)(WG + 1024 + d0), b1 = *(const LAS f32x4*)(WG + 1024 + d0 + 4); x[0] = b0.x; x[1] = b0.y; x[2] = b0.z; x[3] = b0.w; x[4] = b1.x; x[5] = b1.y; x[6] = b1.z; x[7] = b1.w; }
#pragma unroll
    for (int r = 0; r < 16; ++r) { const f32x4 w0 = *(const LAS f32x4*)(WG + r * 64 + d0), w1 = *(const LAS f32x4*)(WG + r * 64 + d0 + 4);
        x[0] += grf[r] * w0.x; x[1] += grf[r] * w0.y; x[2] += grf[r] * w0.z; x[3] += grf[r] * w0.w; x[4] += grf[r] * w1.x; x[5] += grf[r] * w1.y; x[6] += grf[r] * w1.z; x[7] += grf[r] * w1.w; }
#pragma unroll
    for (int j = 0; j < 8; ++j) x[j] = logsigmoidf_(x[j]) * (1.0f / 16.0f);
#pragma unroll
    for (int st = 8; st <= 32; st <<= 1) {
#pragma unroll
        for (int j = 0; j < 8; ++j) { const float t = lane_read(x[j], F.lane - st); if (F.lane >= st) x[j] += t; } }
    if ((F.lane >> 3) == 7) { *(LAS f32x4*)(TOT + F.wave * 64 + d0) = (f32x4){x[0], x[1], x[2], x[3]}; *(LAS f32x4*)(TOT + F.wave * 64 + d0 + 4) = (f32x4){x[4], x[5], x[6], x[7]}; }
    lds_sync();
    float off[8], tot[8];
#pragma unroll
    for (int j = 0; j < 8; ++j) { off[j] = 0.f; tot[j] = 0.f; }
#pragma unroll
    for (int w = 0; w < 8; ++w) { const f32x4 t0 = *(const LAS f32x4*)(TOT + w * 64 + d0), t1 = *(const LAS f32x4*)(TOT + w * 64 + d0 + 4); const float tv[8] = {t0.x, t0.y, t0.z, t0.w, t1.x, t1.y, t1.z, t1.w};
#pragma unroll
        for (int j = 0; j < 8; ++j) { tot[j] += tv[j]; off[j] += (w < F.wave) ? tv[j] : 0.f; } }
#pragma unroll
    for (int j = 0; j < 8; ++j) { bcum[j] = x[j] + off[j]; blast[j] = tot[j]; }
}
typedef short v4s_t __attribute__((ext_vector_type(4)));
__device__ __forceinline__ bf16x8 tr_frag(const LAS bf16_t* T, int pitch, int k0, int x0, int lane) {
    const int g = lane >> 4, i = lane & 15, q = i >> 2, p = i & 3;
    const LAS bf16_t* a = T + (k0 + 8 * g + q) * pitch + x0 + 4 * p;
    const v4s_t lo = __builtin_amdgcn_ds_read_tr16_b64_v4i16((LAS v4s_t*)a), hi = __builtin_amdgcn_ds_read_tr16_b64_v4i16((LAS v4s_t*)(a + 4 * pitch));
    return __builtin_shufflevector(lo, hi, 0, 1, 2, 3, 4, 5, 6, 7);
}
constexpr int PV = 144;
__device__ __forceinline__ void lin_store_vt(Frame& F, const LinRaw& R) {
    LAS bf16_t* VR = (LAS bf16_t*)(F.lds + LN_VT); const int e0 = (F.tid & 15) * 8;
    *(LAS u32x4*)(VR + (F.tid >> 4) * PV + e0) = R.v0; *(LAS u32x4*)(VR + (32 + (F.tid >> 4)) * PV + e0) = R.v1;
}
__device__ __forceinline__ void lin_state_compute(Frame& F, int unit, const LinRaw& R) {
    const int h = (unit >> 6) & 3, mixer = unit >> 11; const int s = F.tid >> 3, c = F.tid & 7, d0 = 8 * c;
    LAS bf16_t* KDT = (LAS bf16_t*)(F.lds + LN_KI); LAS bf16_t* VT = (LAS bf16_t*)(F.lds + LN_VT);
    float k[8], bcum[8], blast[8];
    lin_rot(R.k0, R.k1, R, mixer == 0, c >= 4, mixer == 0 ? 0.125f : 1.0f, k);
    lin_decay(F, mixer, h, R, bcum, blast);
    { float kd[8];
#pragma unroll
      for (int j = 0; j < 8; ++j) kd[j] = k[j] * __expf(blast[j] - bcum[j]);
      *(LAS u32x4*)(KDT + s * LP + d0) = pack8(kd); }
    lin_store_vt(F, R);
    if (s == 0) { float* dc = F.DEC() + (size_t)unit * 64 + d0;
        *(f32x4*)dc = (f32x4){__expf(blast[0]), __expf(blast[1]), __expf(blast[2]), __expf(blast[3])}; *(f32x4*)(dc + 4) = (f32x4){__expf(blast[4]), __expf(blast[5]), __expf(blast[6]), __expf(blast[7])}; }
    lds_sync();
    { const int w = F.wave, lane = F.lane; float* st = F.STATE() + (size_t)unit * 8192;
      const bf16x8 vf0 = tr_frag(VT, PV, 0, 16 * w, lane), vf1 = tr_frag(VT, PV, 32, 16 * w, lane);
#pragma unroll
      for (int dt = 0; dt < 4; ++dt) { f32x4 acc = (f32x4){0.f, 0.f, 0.f, 0.f};
          acc = __builtin_amdgcn_mfma_f32_16x16x32_bf16(vf0, tr_frag(KDT, LP, 0, 16 * dt, lane), acc, 0, 0, 0);
          acc = __builtin_amdgcn_mfma_f32_16x16x32_bf16(vf1, tr_frag(KDT, LP, 32, 16 * dt, lane), acc, 0, 0, 0);
#pragma unroll
          for (int i = 0; i < 4; ++i) st[(16 * w + 4 * (lane >> 4) + i) * 64 + 16 * dt + (lane & 15)] = acc[i]; } }
}
__device__ __forceinline__ void lin_out_compute(Frame& F, int unit, const LinRaw& R) {
    const int n = unit & 63, h = (unit >> 6) & 3, b = (unit >> 8) & 7, mixer = unit >> 11;
    const size_t row0 = (size_t)b * SEQ + (size_t)n * CH; const int s = F.tid >> 3, c = F.tid & 7, d0 = 8 * c;
    const int ycol = (mixer == 0 ? 0 : 1024) + h * 128;
    LAS bf16_t* QD = (LAS bf16_t*)(F.lds + LN_QD); LAS bf16_t* KI = (LAS bf16_t*)(F.lds + LN_KI); LAS bf16_t* PM = (LAS bf16_t*)(F.lds + LN_PM);
    LAS bf16_t* VT = (LAS bf16_t*)(F.lds + LN_VT); LAS float* OB = (LAS float*)(F.lds + LN_OB);
    float q[8], k[8], bcum[8], blast[8];
    lin_rot(R.q0, R.q1, R, mixer == 0, c >= 4, mixer == 0 ? 1.0f : 0.125f, q);
    lin_rot(R.k0, R.k1, R, mixer == 0, c >= 4, mixer == 0 ? 0.125f : 1.0f, k);
    lin_decay(F, mixer, h, R, bcum, blast);
    { float qd[8], ki[8];
#pragma unroll
      for (int j = 0; j < 8; ++j) { qd[j] = q[j] * __expf(bcum[j]); ki[j] = k[j] * __expf(-bcum[j]); }
      *(LAS u32x4*)(QD + s * LP + d0) = pack8(qd); *(LAS u32x4*)(KI + s * LP + d0) = pack8(ki); }
    lin_store_vt(F, R);
    lds_sync();
    { const int lane = F.lane;
#pragma unroll
      for (int j = 0; j < 2; ++j) { const int tile = 2 * F.wave + j, tt = tile >> 2, st = tile & 3;
          f32x4 acc = (f32x4){0.f, 0.f, 0.f, 0.f};
          if (st <= tt) acc = mma_nt_lds(QD + 16 * tt * LP, LP, KI + 16 * st * LP, LP, 2, acc, lane);
#pragma unroll
          for (int i = 0; i < 4; ++i) { const int t = 16 * tt + 4 * (lane >> 4) + i, s2 = 16 * st + (lane & 15); const float p = (st <= tt && s2 <= t) ? acc[i] : 0.f; PM[t * LP + s2] = (bf16_t)f2bf(p); } } }
    lds_sync();
    { const int w = F.wave, lane = F.lane;
      const bf16x8 vf0 = tr_frag(VT, PV, 0, 16 * w, lane), vf1 = tr_frag(VT, PV, 32, 16 * w, lane);
#pragma unroll
      for (int tt = 0; tt < 4; ++tt) { f32x4 acc = (f32x4){0.f, 0.f, 0.f, 0.f};
          { const LAS bf16_t* pp = PM + (16 * tt + (lane & 15)) * LP + 8 * (lane >> 4);
            acc = __builtin_amdgcn_mfma_f32_16x16x32_bf16(*(const LAS bf16x8*)pp, vf0, acc, 0, 0, 0);
            acc = __builtin_amdgcn_mfma_f32_16x16x32_bf16(*(const LAS bf16x8*)(pp + 32), vf1, acc, 0, 0, 0); }
          const LAS bf16_t* xp = QD + (16 * tt + (lane & 15)) * LP + 8 * (lane >> 4);
          acc = __builtin_amdgcn_mfma_f32_16x16x32_bf16(*(const LAS bf16x8*)xp, R.sp0, acc, 0, 0, 0);
          acc = __builtin_amdgcn_mfma_f32_16x16x32_bf16(*(const LAS bf16x8*)(xp + 32), R.sp1, acc, 0, 0, 0);
#pragma unroll
          for (int i = 0; i < 4; ++i) OB[(16 * tt + 4 * (lane >> 4) + i) * 132 + 16 * w + (lane & 15)] = acc[i]; } }
    lds_sync();
    { const int t = s, part = c; float o[16];
#pragma unroll
      for (int j = 0; j < 4; ++j) { const f32x4 v = *(const LAS f32x4*)(OB + t * 132 + 16 * part + 4 * j); o[4 * j] = v.x; o[4 * j + 1] = v.y; o[4 * j + 2] = v.z; o[4 * j + 3] = v.w; }
      float sm = 0.f;
#pragma unroll
      for (int j = 0; j < 16; ++j) sm += o[j];
      sm += lane_read(sm, F.lane ^ 1); sm += lane_read(sm, F.lane ^ 2); sm += lane_read(sm, F.lane ^ 4);
      const float mu = sm * (1.0f / 128.0f); float qv = 0.f;
#pragma unroll
      for (int j = 0; j < 16; ++j) { const float dlt = o[j] - mu; qv += dlt * dlt; }
      qv += lane_read(qv, F.lane ^ 1); qv += lane_read(qv, F.lane ^ 2); qv += lane_read(qv, F.lane ^ 4);
      const float r = 1.0f / sqrtf(qv * (1.0f / 128.0f) + EPS);
      float g0[8], g1[8]; unpack8(R.g0, g0); unpack8(R.g1, g1);
      float y0[8], y1[8];
#pragma unroll
      for (int j = 0; j < 8; ++j) { y0[j] = (o[j] - mu) * r * siluf_(g0[j]); y1[j] = (o[8 + j] - mu) * r * siluf_(g1[j]); }
      bf16_t* yp = F.Y() + (row0 + t) * D + ycol + 16 * part; *(u32x4*)yp = pack8(y0); *(u32x4*)(yp + 8) = pack8(y1); }
}
template <bool OUT>
__device__ __forceinline__ void lin_phase(Frame& F, int l) {
    { const int h = (F.vcu >> 6) & 3; LAS float* WG = (LAS float*)(F.lds + LN_WG);
      for (int i = F.tid; i < 16 * 64 + 64; i += NWAVES * 64) WG[i] = (i < 1024) ? F.gla_wg()[(size_t)l * 16 * 256 + (i >> 6) * 256 + h * 64 + (i & 63)] : F.gla_bg()[l * 256 + h * 64 + (i - 1024)];
      lds_sync(); }
    LinRaw A, B;
    lin_issue<OUT>(F, F.vcu, A);
    for (int u = F.vcu; u < 4096; u += 2 * F.G) {
        lin_issue<OUT>(F, u + F.G, B);
        if (OUT) lin_out_compute(F, u, A); else lin_state_compute(F, u, A);
        if (u + 2 * F.G < 4096) lin_issue<OUT>(F, u + 2 * F.G, A);
        if (OUT) lin_out_compute(F, u + F.G, B); else lin_state_compute(F, u + F.G, B);
    }
    lds_sync();
}
constexpr int L2_TOT = 0, L2_QD = 1024, L2_KI = 10240, L2_V = 19456, L2_SP = 37888, L2_PM = 56320, L2_STRIDE = 65536, L2_WG = 131072;
struct Lin2 { int unit, h, mixer, hw, s, c; size_t row0; LAS unsigned char* base; };
__device__ __forceinline__ void lin2_rot16(const u32x4 (&own)[2], const u32x4 (&oth)[2], const f32x4 (&cs)[4], const f32x4 (&sn)[4], bool rot, bool hi, float scale, float (&v)[16]) {
#pragma unroll
    for (int g = 0; g < 2; ++g) {
        float o[8]; unpack8(own[g], o);
        if (!rot) {
#pragma unroll
            for (int j = 0; j < 8; ++j) v[8 * g + j] = o[j] * scale;
        } else {
            float p[8]; unpack8(oth[g], p);
            const float c8[8] = {cs[2 * g].x, cs[2 * g].y, cs[2 * g].z, cs[2 * g].w, cs[2 * g + 1].x, cs[2 * g + 1].y, cs[2 * g + 1].z, cs[2 * g + 1].w};
            const float s8[8] = {sn[2 * g].x, sn[2 * g].y, sn[2 * g].z, sn[2 * g].w, sn[2 * g + 1].x, sn[2 * g + 1].y, sn[2 * g + 1].z, sn[2 * g + 1].w};
#pragma unroll
            for (int j = 0; j < 8; ++j) { const float os = p[j] * s8[j]; v[8 * g + j] = (o[j] * c8[j] + (hi ? os : -os)) * scale; }
        }
    }
}
__device__ __forceinline__ void lin2_decay(Frame& F, const Lin2& L, const u32x4 gr0, const u32x4 gr1, float (&bcum)[16], float (&blast)[16]) {
    LAS float* TOT = (LAS float*)(L.base + L2_TOT);
    const int d0 = 16 * L.c;
    if (L.mixer == 0) {
        const float lg = __logf(1.0f - exp2f(-5.0f - (float)L.h));
#pragma unroll
        for (int j = 0; j < 16; ++j) { bcum[j] = (float)(L.s + 1) * lg; blast[j] = 64.0f * lg; }
        lds_sync();
        return;
    }
    const LAS float* WG = (const LAS float*)(F.lds + L2_WG);
    float grf[16]; { float a[8], b2[8]; unpack8(gr0, a); unpack8(gr1, b2);
#pragma unroll
        for (int j = 0; j < 8; ++j) { grf[j] = a[j]; grf[8 + j] = b2[j]; } }
    float x[16];
#pragma unroll
    for (int q = 0; q < 4; ++q) { const f32x4 b0 = *(const LAS f32x4*)(WG + 1024 + d0 + 4 * q); x[4 * q] = b0.x; x[4 * q + 1] = b0.y; x[4 * q + 2] = b0.z; x[4 * q + 3] = b0.w; }
#pragma unroll
    for (int r = 0; r < 16; ++r) {
#pragma unroll
        for (int q = 0; q < 4; ++q) { const f32x4 w0 = *(const LAS f32x4*)(WG + r * 64 + d0 + 4 * q);
            x[4 * q] += grf[r] * w0.x; x[4 * q + 1] += grf[r] * w0.y; x[4 * q + 2] += grf[r] * w0.z; x[4 * q + 3] += grf[r] * w0.w; } }
#pragma unroll
    for (int j = 0; j < 16; ++j) x[j] = logsigmoidf_(x[j]) * (1.0f / 16.0f);
#pragma unroll
    for (int st = 4; st <= 32; st <<= 1) {
#pragma unroll
        for (int j = 0; j < 16; ++j) { const float t = lane_read(x[j], F.lane - st); if (F.lane >= st) x[j] += t; } }
    if ((F.lane >> 2) == 15) {
#pragma unroll
        for (int q = 0; q < 4; ++q) *(LAS f32x4*)(TOT + L.hw * 64 + d0 + 4 * q) = (f32x4){x[4 * q], x[4 * q + 1], x[4 * q + 2], x[4 * q + 3]}; }
    lds_sync();
    float off[16], tot[16];
#pragma unroll
    for (int j = 0; j < 16; ++j) { off[j] = 0.f; tot[j] = 0.f; }
#pragma unroll
    for (int w = 0; w < 4; ++w) {
#pragma unroll
        for (int q = 0; q < 4; ++q) { const f32x4 t0 = *(const LAS f32x4*)(TOT + w * 64 + d0 + 4 * q); const float tv[4] = {t0.x, t0.y, t0.z, t0.w};
#pragma unroll
            for (int j = 0; j < 4; ++j) { tot[4 * q + j] += tv[j]; off[4 * q + j] += (w < L.hw) ? tv[j] : 0.f; } } }
#pragma unroll
    for (int j = 0; j < 16; ++j) { bcum[j] = x[j] + off[j]; blast[j] = tot[j]; }
}
__device__ __forceinline__ void lin2_state(Frame& F, const Lin2& L) {
    const int ht = F.tid & 255, lane = F.lane, s = L.s, c = L.c, d0 = 16 * c;
    const int ck = (L.mixer == 0 ? C_RK : C_GK) + L.h * 64, cv = (L.mixer == 0 ? C_RV : C_GV) + L.h * 128;
    LAS bf16_t* KD = (LAS bf16_t*)(L.base + L2_KI); LAS bf16_t* VT = (LAS bf16_t*)(L.base + L2_V);
    const bf16_t* pr = F.PROJ() + (L.row0 + s) * LDP;
    u32x4 ko[2], kp[2], vv[4]; f32x4 cs[4], sn[4];
#pragma unroll
    for (int g = 0; g < 2; ++g) { ko[g] = *(const u32x4*)(pr + ck + d0 + 8 * g); kp[g] = *(const u32x4*)(pr + ck + ((d0 + 8 * g) ^ 32)); }
    { const float* cp = F.rotc() + (L.row0 + s) * 32 + 16 * (c & 1); const float* sp = F.rots() + (L.row0 + s) * 32 + 16 * (c & 1);
#pragma unroll
      for (int q = 0; q < 4; ++q) { cs[q] = *(const f32x4*)(cp + 4 * q); sn[q] = *(const f32x4*)(sp + 4 * q); } }
    const u32x4 gr0 = *(const u32x4*)(pr + C_GR), gr1 = *(const u32x4*)(pr + C_GR + 8);
#pragma unroll
    for (int i = 0; i < 4; ++i) { const int idx = ht + 256 * i; vv[i] = *(const u32x4*)(F.PROJ() + (L.row0 + (idx >> 4)) * LDP + cv + (idx & 15) * 8); }
    float k[16], bcum[16], blast[16];
    lin2_rot16(ko, kp, cs, sn, L.mixer == 0, c >= 2, L.mixer == 0 ? 0.125f : 1.0f, k);
    lin2_decay(F, L, gr0, gr1, bcum, blast);
#pragma unroll
    for (int g = 0; g < 2; ++g) { float kd[8];
#pragma unroll
        for (int j = 0; j < 8; ++j) kd[j] = k[8 * g + j] * __expf(blast[8 * g + j] - bcum[8 * g + j]);
        *(LAS u32x4*)(KD + s * LP + d0 + 8 * g) = pack8(kd); }
#pragma unroll
    for (int i = 0; i < 4; ++i) { const int idx = ht + 256 * i; *(LAS u32x4*)(VT + (idx >> 4) * PV + (idx & 15) * 8) = vv[i]; }
    if (s == 0) { float* dc = F.DEC() + (size_t)L.unit * 64 + d0;
#pragma unroll
        for (int q = 0; q < 4; ++q) *(f32x4*)(dc + 4 * q) = (f32x4){__expf(blast[4 * q]), __expf(blast[4 * q + 1]), __expf(blast[4 * q + 2]), __expf(blast[4 * q + 3])}; }
    lds_sync();
    { float* st = F.STATE() + (size_t)L.unit * 8192;
      const bf16x8 kf0 = tr_frag(KD, LP, 0, 16 * L.hw, lane), kf1 = tr_frag(KD, LP, 32, 16 * L.hw, lane);
#pragma unroll
      for (int et = 0; et < 8; ++et) { f32x4 acc = (f32x4){0.f, 0.f, 0.f, 0.f};
          acc = __builtin_amdgcn_mfma_f32_16x16x32_bf16(kf0, tr_frag(VT, PV, 0, 16 * et, lane), acc, 0, 0, 0);
          acc = __builtin_amdgcn_mfma_f32_16x16x32_bf16(kf1, tr_frag(VT, PV, 32, 16 * et, lane), acc, 0, 0, 0);
          *(f32x4*)(st + (16 * et + (lane & 15)) * 64 + 16 * L.hw + 4 * (lane >> 4)) = acc; } }
}
__device__ __forceinline__ void lin2_out(Frame& F, const Lin2& L) {
    const int ht = F.tid & 255, lane = F.lane, lr = lane & 15, lq = lane >> 4, s = L.s, c = L.c, d0 = 16 * c;
    const int cq = (L.mixer == 0 ? C_RQ : C_GQ) + L.h * 64, ck = (L.mixer == 0 ? C_RK : C_GK) + L.h * 64, cv = (L.mixer == 0 ? C_RV : C_GV) + L.h * 128, cg = (L.mixer == 0 ? C_RG : C_GG) + L.h * 128;
    const int ycol = (L.mixer == 0 ? 0 : 1024) + L.h * 128;
    LAS bf16_t* QD = (LAS bf16_t*)(L.base + L2_QD); LAS bf16_t* KI = (LAS bf16_t*)(L.base + L2_KI); LAS bf16_t* VT = (LAS bf16_t*)(L.base + L2_V);
    LAS bf16_t* SP = (LAS bf16_t*)(L.base + L2_SP); LAS bf16_t* PM = (LAS bf16_t*)(L.base + L2_PM + L.hw * 2304);
    const bf16_t* pr = F.PROJ() + (L.row0 + s) * LDP;
    float q[16], k[16], bcum[16], blast[16];
    u32x4 vv[4], sv[4]; u32x4 gr0, gr1;
    { u32x4 qo[2], qp[2], ko[2], kp[2]; f32x4 cs[4], sn[4];
#pragma unroll
      for (int g = 0; g < 2; ++g) { ko[g] = *(const u32x4*)(pr + ck + d0 + 8 * g); kp[g] = *(const u32x4*)(pr + ck + ((d0 + 8 * g) ^ 32));
          qo[g] = *(const u32x4*)(pr + cq + d0 + 8 * g); qp[g] = *(const u32x4*)(pr + cq + ((d0 + 8 * g) ^ 32)); }
      { const float* cp = F.rotc() + (L.row0 + s) * 32 + 16 * (c & 1); const float* sp = F.rots() + (L.row0 + s) * 32 + 16 * (c & 1);
#pragma unroll
        for (int qq = 0; qq < 4; ++qq) { cs[qq] = *(const f32x4*)(cp + 4 * qq); sn[qq] = *(const f32x4*)(sp + 4 * qq); } }
      gr0 = *(const u32x4*)(pr + C_GR); gr1 = *(const u32x4*)(pr + C_GR + 8);
#pragma unroll
      for (int i = 0; i < 4; ++i) { const int idx = ht + 256 * i; vv[i] = *(const u32x4*)(F.PROJ() + (L.row0 + (idx >> 4)) * LDP + cv + (idx & 15) * 8);
          sv[i] = *(const u32x4*)(F.SPREV() + (size_t)L.unit * 8192 + (size_t)idx * 8); }
      lin2_rot16(qo, qp, cs, sn, L.mixer == 0, c >= 2, L.mixer == 0 ? 1.0f : 0.125f, q);
      lin2_rot16(ko, kp, cs, sn, L.mixer == 0, c >= 2, L.mixer == 0 ? 0.125f : 1.0f, k); }
    lin2_decay(F, L, gr0, gr1, bcum, blast);
#pragma unroll
    for (int g = 0; g < 2; ++g) { float qd[8], ki[8];
#pragma unroll
        for (int j = 0; j < 8; ++j) { qd[j] = q[8 * g + j] * __expf(bcum[8 * g + j]); ki[j] = k[8 * g + j] * __expf(-bcum[8 * g + j]); }
        *(LAS u32x4*)(QD + s * LP + d0 + 8 * g) = pack8(qd); *(LAS u32x4*)(KI + s * LP + d0 + 8 * g) = pack8(ki); }
#pragma unroll
    for (int i = 0; i < 4; ++i) { const int idx = ht + 256 * i; *(LAS u32x4*)(VT + (idx >> 4) * PV + (idx & 15) * 8) = vv[i]; *(LAS u32x4*)(SP + (idx >> 3) * LP + (idx & 7) * 8) = sv[i]; }
    const bf16_t* gp = F.PROJ() + (L.row0 + 16 * L.hw + lr) * LDP + cg + 4 * lq;
    u32x2 gt[8];
#pragma unroll
    for (int et = 0; et < 8; ++et) gt[et] = *(const u32x2*)(gp + 16 * et);
    lds_sync();
    const LAS bf16_t* qrow = QD + (16 * L.hw + lr) * LP + 8 * lq;
    const bf16x8 qf0 = *(const LAS bf16x8*)qrow, qf1 = *(const LAS bf16x8*)(qrow + 32);
#pragma unroll
    for (int st = 0; st < 4; ++st) {
        f32x4 acc = (f32x4){0.f, 0.f, 0.f, 0.f};
        if (st <= L.hw) { const LAS bf16_t* krow = KI + (16 * st + lr) * LP + 8 * lq;
            acc = __builtin_amdgcn_mfma_f32_16x16x32_bf16(*(const LAS bf16x8*)krow, qf0, acc, 0, 0, 0);
            acc = __builtin_amdgcn_mfma_f32_16x16x32_bf16(*(const LAS bf16x8*)(krow + 32), qf1, acc, 0, 0, 0); }
        float p[4];
#pragma unroll
        for (int i = 0; i < 4; ++i) p[i] = (st <= L.hw && 16 * st + 4 * lq + i <= 16 * L.hw + lr) ? acc[i] : 0.f;
        u32x2 w; w.x = pk2(p[0], p[1]); w.y = pk2(p[2], p[3]);
        *(LAS u32x2*)(PM + lr * LP + 16 * st + 4 * lq) = w; }
    asm volatile("s_waitcnt lgkmcnt(0)" ::: "memory");
    const bf16x8 pf0 = *(const LAS bf16x8*)(PM + lr * LP + 8 * lq), pf1 = *(const LAS bf16x8*)(PM + lr * LP + 32 + 8 * lq);
    f32x4 o[8];
#pragma unroll
    for (int et = 0; et < 8; ++et) { f32x4 acc = (f32x4){0.f, 0.f, 0.f, 0.f};
        acc = __builtin_amdgcn_mfma_f32_16x16x32_bf16(tr_frag(VT, PV, 0, 16 * et, lane), pf0, acc, 0, 0, 0);
        acc = __builtin_amdgcn_mfma_f32_16x16x32_bf16(tr_frag(VT, PV, 32, 16 * et, lane), pf1, acc, 0, 0, 0);
        const LAS bf16_t* srow = SP + (16 * et + lr) * LP + 8 * lq;
        acc = __builtin_amdgcn_mfma_f32_16x16x32_bf16(*(const LAS bf16x8*)srow, qf0, acc, 0, 0, 0);
        acc = __builtin_amdgcn_mfma_f32_16x16x32_bf16(*(const LAS bf16x8*)(srow + 32), qf1, acc, 0, 0, 0);
        o[et] = acc; }
    float sm = 0.f;
#pragma unroll
    for (int et = 0; et < 8; ++et) sm += (o[et][0] + o[et][1]) + (o[et][2] + o[et][3]);
    sm += lane_read(sm, lane ^ 16); sm += lane_read(sm, lane ^ 32);
    const float mu = sm * (1.0f / 128.0f); float qv = 0.f;
#pragma unroll
    for (int et = 0; et < 8; ++et) {
#pragma unroll
        for (int i = 0; i < 4; ++i) { const float dlt = o[et][i] - mu; qv += dlt * dlt; } }
    qv += lane_read(qv, lane ^ 16); qv += lane_read(qv, lane ^ 32);
    const float r = 1.0f / sqrtf(qv * (1.0f / 128.0f) + EPS);
    bf16_t* yp = F.Y() + (L.row0 + 16 * L.hw + lr) * D + ycol + 4 * lq;
#pragma unroll
    for (int et = 0; et < 8; ++et) { const float g0 = bflo(gt[et].x), g1 = bfhi(gt[et].x), g2 = bflo(gt[et].y), g3 = bfhi(gt[et].y);
        u32x2 w; w.x = pk2((o[et][0] - mu) * r * siluf_(g0), (o[et][1] - mu) * r * siluf_(g1)); w.y = pk2((o[et][2] - mu) * r * siluf_(g2), (o[et][3] - mu) * r * siluf_(g3));
        *(u32x2*)(yp + 16 * et) = w; }
}
template <bool OUT>
__device__ __forceinline__ void lin2_phase(Frame& F, int l) {
    { const int h = (F.vcu >> 6) & 3; LAS float* WG = (LAS float*)(F.lds + L2_WG);
      for (int i = F.tid; i < 16 * 64 + 64; i += NWAVES * 64) WG[i] = (i < 1024) ? F.gla_wg()[(size_t)l * 16 * 256 + (i >> 6) * 256 + h * 64 + (i & 63)] : F.gla_bg()[l * 256 + h * 64 + (i - 1024)];
      lds_sync(); }
    const int half = F.wave >> 2;
#pragma unroll 1
    for (int j = 0; j < 8; ++j) {
        Lin2 L; L.unit = F.vcu + 256 * (2 * j + half); L.h = (L.unit >> 6) & 3; asm volatile("" : "+s"(L.h)); L.mixer = L.unit >> 11; L.hw = F.wave & 3; L.s = (F.tid & 255) >> 2; L.c = F.tid & 3;
        L.row0 = (size_t)((L.unit >> 8) & 7) * SEQ + (size_t)(L.unit & 63) * CH; L.base = F.lds + half * L2_STRIDE;
        if (OUT) lin2_out(F, L); else lin2_state(F, L);
    }
    lds_sync();
}
__device__ __forceinline__ void lin_scan(Frame& F) {
    const int gt = F.vcu * (NWAVES * 64) + F.tid, NGT = F.G * NWAVES * 64;
    for (int i = gt; i < 64 * 8192; i += NGT) {
        const int seq = i >> 13, idx = i & 8191, d = idx & 63;
        const float* st = F.STATE() + (size_t)seq * NCH * 8192 + idx; const float* dc = F.DEC() + (size_t)seq * NCH * 64 + d; bf16_t* sp = F.SPREV() + (size_t)seq * NCH * 8192 + idx;
        float carry = 0.f; asm volatile("" : "+v"(carry));
#pragma unroll
        for (int h = 0; h < 2; ++h) {
            float v[32], c[32];
#pragma unroll
            for (int n = 0; n < 32; ++n) { v[n] = st[(size_t)(32 * h + n) * 8192]; c[n] = dc[(size_t)(32 * h + n) * 64]; }
#pragma unroll
            for (int n = 0; n < 32; ++n) { sp[(size_t)(32 * h + n) * 8192] = (bf16_t)f2bf(carry); carry = c[n] * carry + v[n]; asm volatile("" : "+v"(carry)); }
        }
    }
}
constexpr int S5_WL = 16384, S5_BU = 2048, S5_X = 2048 + 8320;
template <bool OUT>
__device__ __forceinline__ void s5_pass(Frame& F, int l) {
    LAS bf16_t* UT = (LAS bf16_t*)(F.lds + F.wave * S5_WL); LAS float* BU = (LAS float*)(F.lds + F.wave * S5_WL + S5_BU); LAS bf16_t* X = (LAS bf16_t*)(F.lds + F.wave * S5_WL + S5_X);
    const int gw = F.vcu * NWAVES + F.wave, NGW = F.G * NWAVES, lane = F.lane, lr = lane & 15, lq = lane >> 4;
    u32x4 ua, uc;
    { const int g = gw & 31, n = (gw >> 5) & 63, b = gw >> 11; const bf16_t* up = F.PROJ() + ((size_t)b * SEQ + (size_t)n * CH + lane) * LDP + C_SU + g * 16; ua = *(const u32x4*)up; uc = *(const u32x4*)(up + 8); }
    for (int unit = gw; unit < BATCH * NCH * 32; unit += NGW) {
        const int g = unit & 31, n = (unit >> 5) & 63, b = unit >> 11; const size_t row0 = (size_t)b * SEQ + (size_t)n * CH;
        *(LAS u32x4*)(UT + lane * 16) = ua; *(LAS u32x4*)(UT + lane * 16 + 8) = uc;
        if (unit + NGW < BATCH * NCH * 32) { const int un = unit + NGW, g2 = un & 31, n2 = (un >> 5) & 63, b2 = un >> 11;
            const bf16_t* up = F.PROJ() + ((size_t)b2 * SEQ + (size_t)n2 * CH + lane) * LDP + C_SU + g2 * 16; ua = *(const u32x4*)up; uc = *(const u32x4*)(up + 8); }
        const int gp = g * 64 + lane; const float ar = F.abar()[2 * gp], ai = F.abar()[2 * gp + 1];
        bf16x8 bfr[8];
#pragma unroll
        for (int q = 0; q < 8; ++q) { bfr[q] = (bf16x8){0, 0, 0, 0, 0, 0, 0, 0}; if (lq < 2) bfr[q] = *(const bf16x8*)(F.bbt() + ((size_t)g * 128 + 16 * q + lr) * 16 + 8 * lq); }
        float xr = 0.f, xi = 0.f;
        bf16x8 cf[4]; float dsk = 0.f;
        if (OUT) { const f32x2 x0 = *(const f32x2*)(F.XEND() + ((((size_t)(b * 32 + g)) * NCH + n) * 64 + lane) * 2); xr = x0.x; xi = x0.y;
#pragma unroll
            for (int ks = 0; ks < 4; ++ks) cf[ks] = *(const bf16x8*)(F.cmt() + ((size_t)(g * 16 + lr)) * 128 + 32 * ks + 8 * lq);
            dsk = F.s5_d()[(size_t)l * BW + g * 16 + lr]; }
        LDS_WAIT();
        for (int sb = 0; sb < 4; ++sb) {
            bf16x8 af = (bf16x8){0, 0, 0, 0, 0, 0, 0, 0}; if (lq < 2) af = *(const LAS bf16x8*)(UT + (16 * sb + lr) * 16 + 8 * lq);
#pragma unroll
            for (int q = 0; q < 8; ++q) { f32x4 acc = (f32x4){0.f, 0.f, 0.f, 0.f}; acc = __builtin_amdgcn_mfma_f32_16x16x32_bf16(af, bfr[q], acc, 0, 0, 0);
#pragma unroll
                for (int i = 0; i < 4; ++i) BU[(4 * lq + i) * 130 + 16 * q + lr] = acc[i]; }
            LDS_WAIT();
            float br[16], bi[16];
#pragma unroll
            for (int tt = 0; tt < 16; ++tt) { br[tt] = BU[tt * 130 + lane]; bi[tt] = BU[tt * 130 + 64 + lane]; }
#pragma unroll
            for (int tt = 0; tt < 16; ++tt) { const float nr = ar * xr - ai * xi + br[tt], ni = ar * xi + ai * xr + bi[tt]; xr = nr; xi = ni; asm volatile("" : "+v"(xr), "+v"(xi));
                if (OUT) { X[tt * 136 + lane] = (bf16_t)f2bf(xr); X[tt * 136 + 64 + lane] = (bf16_t)f2bf(xi); } }
            if (OUT) {
                LDS_WAIT();
                f32x4 acc = (f32x4){0.f, 0.f, 0.f, 0.f}; const LAS bf16_t* xp = X + lr * 136 + 8 * lq;
#pragma unroll
                for (int ks = 0; ks < 4; ++ks) acc = __builtin_amdgcn_mfma_f32_16x16x32_bf16(*(const LAS bf16x8*)(xp + 32 * ks), cf[ks], acc, 0, 0, 0);
#pragma unroll
                for (int i = 0; i < 4; ++i) { const int tl = 16 * sb + 4 * lq + i; const float u = bflo((unsigned)UT[tl * 16 + lr]); const float y = gelu_tanh(acc[i] + dsk * u);
                    F.YBP()[(row0 + tl) * BW + g * 16 + lr] = (bf16_t)f2bf(y); }
            }
            LDS_WAIT();
        }
        if (!OUT) *(f32x2*)(F.XEND() + ((((size_t)(b * 32 + g)) * NCH + n) * 64 + lane) * 2) = (f32x2){xr, xi};
    }
}
__device__ __forceinline__ void s5_scan(Frame& F) {
    const int gt = F.vcu * (NWAVES * 64) + F.tid, NGT = F.G * NWAVES * 64;
    for (int i = gt; i < BATCH * 32 * 64; i += NGT) {
        const int p = i & 63, bg = i >> 6, g = bg & 31; const float pr = F.apow()[2 * (g * 64 + p)], pi = F.apow()[2 * (g * 64 + p) + 1];
        f32x2* xp = (f32x2*)(F.XEND() + (((size_t)bg * NCH) * 64 + p) * 2);
        float cr = 0.f, ci = 0.f; asm volatile("" : "+v"(cr), "+v"(ci));
#pragma unroll
        for (int h = 0; h < 2; ++h) {
            f32x2 v[32];
#pragma unroll
            for (int n = 0; n < 32; ++n) v[n] = xp[(size_t)(32 * h + n) * 64];
#pragma unroll
            for (int n = 0; n < 32; ++n) { xp[(size_t)(32 * h + n) * 64] = (f32x2){cr, ci};
                const float nr = pr * cr - pi * ci + v[n].x, ni = pr * ci + pi * cr + v[n].y; cr = nr; ci = ni; asm volatile("" : "+v"(cr), "+v"(ci)); }
        }
    }
}

__device__ __forceinline__ void pool_phase(Frame& F, int l) {
    const int gw = F.vcu * NWAVES + F.wave, NGW = F.G * NWAVES, lane = F.lane, lr = lane & 15, lq = lane >> 4;
    for (int unit = gw; unit < BATCH * (SEQ / 16) * 4; unit += NGW) {
        const int g = unit & 3, tile = (unit >> 2) & 255, b = unit >> 10; const int win = 2 << g, tpos = 16 * tile + lr; const size_t row = (size_t)b * SEQ + tpos;
        const bf16_t* pp = F.PROJ() + row * LDP + C_PU + g * 128 + 8 * lq;
        float s[4][8];
#pragma unroll
        for (int ks = 0; ks < 4; ++ks)
#pragma unroll
            for (int j = 0; j < 8; ++j) s[ks][j] = 0.f;
        for (int jj = 1; jj < win; ++jj) { if (tpos - jj >= 0) {
#pragma unroll
            for (int ks = 0; ks < 4; ++ks) { float a[8]; unpack8(*(const u32x4*)(pp - (size_t)jj * LDP + 32 * ks), a);
#pragma unroll
                for (int j = 0; j < 8; ++j) s[ks][j] += a[j]; } } }
        const float inv = 1.0f / (float)min(tpos + 1, win);
        bf16x8 mf[4];
#pragma unroll
        for (int ks = 0; ks < 4; ++ks) { float a[8], m[8]; unpack8(*(const u32x4*)(pp + 32 * ks), a);
#pragma unroll
            for (int j = 0; j < 8; ++j) m[j] = (s[ks][j] + a[j]) * inv - a[j];
            const u32x4 w = pack8(m); mf[ks] = __builtin_bit_cast(bf16x8, w); }
        const bf16_t* pw = F.poolw_t() + (size_t)g * 128 * 128 + (size_t)lr * 128 + 8 * lq;
#pragma unroll
        for (int q = 0; q < 8; ++q) { f32x4 acc = (f32x4){0.f, 0.f, 0.f, 0.f};
#pragma unroll
            for (int ks = 0; ks < 4; ++ks) acc = __builtin_amdgcn_mfma_f32_16x16x32_bf16(*(const bf16x8*)(pw + (size_t)(16 * q) * 128 + 32 * ks), mf[ks], acc, 0, 0, 0);
            const int dcol = g * 128 + 16 * q + 4 * lq; const f32x4 sc = *(const f32x4*)(F.pool_scale() + (size_t)l * BW + dcol);
            u32x2 w; w.x = pk2(acc[0] * sc.x, acc[1] * sc.y); w.y = pk2(acc[2] * sc.z, acc[3] * sc.w);
            *(u32x2*)(F.Y() + row * D + 1536 + dcol) = w; }
    }
}

__device__ __forceinline__ void conv_fix_phase(Frame& F, int l) {
    const float* cw = F.conv_w() + (size_t)l * 3 * NUP; const float* cb = F.conv_b() + (size_t)l * NUP; const float* UH = F.UH();
    const int gt = F.vcu * (NWAVES * 64) + F.tid, NGT = F.G * NWAVES * 64;
    constexpr int JG = DFF / 4;
    for (int task = gt; task < (M / 256) * 2 * JG; task += NGT) {
        const int jg = task % JG, q = (task / JG) & 1, pm = task / (2 * JG);
        if ((pm & 15) == 0) continue;
        const int j0 = jg * 4, ucol = 256 * (j0 >> 7) + (j0 & 127);
        const float* u0p = UH + ((size_t)pm * 4 + q) * NUP + ucol;
        const float* u1p = (q == 1) ? UH + ((size_t)pm * 4 + 0) * NUP + ucol : UH + ((size_t)(pm - 1) * 4 + 3) * NUP + ucol;
        const float* u2p = (q == 1) ? UH + ((size_t)(pm - 1) * 4 + 3) * NUP + ucol : UH + ((size_t)(pm - 1) * 4 + 2) * NUP + ucol;
        const f32x4 a0 = *(const f32x4*)u0p, a1 = *(const f32x4*)u1p, a2 = *(const f32x4*)u2p, v0 = *(const f32x4*)(u0p + 128), v1 = *(const f32x4*)(u1p + 128), v2 = *(const f32x4*)(u2p + 128);
        const f32x4 wa0 = *(const f32x4*)(cw + j0), wa1 = *(const f32x4*)(cw + NUP + j0), wa2 = *(const f32x4*)(cw + 2 * NUP + j0), ba = *(const f32x4*)(cb + j0);
        const f32x4 wv0 = *(const f32x4*)(cw + DFF + j0), wv1 = *(const f32x4*)(cw + NUP + DFF + j0), wv2 = *(const f32x4*)(cw + 2 * NUP + DFF + j0), bv = *(const f32x4*)(cb + DFF + j0);
        float o[4];
#pragma unroll
        for (int i = 0; i < 4; ++i) { const float ca = ba[i] + wa0[i] * a2[i] + wa1[i] * a1[i] + wa2[i] * a0[i], cv = bv[i] + wv0[i] * v2[i] + wv1[i] * v1[i] + wv2[i] * v0[i]; o[i] = siluf_(ca) * cv; }
        u32x2 w; w.x = pk2(o[0], o[1]); w.y = pk2(o[2], o[3]);
        *(u32x2*)(F.ACT() + ((size_t)pm * 256 + q) * DFF + j0) = w;
    }
}

constexpr int NPH = 13;
struct Args { const void* in[25]; float* out; unsigned char* ws; int l_lo, l_hi, ph_lo, ph_hi, single, pad; };
__global__ void __launch_bounds__(NWAVES * 64, 2) hybrid_fwd(Args args) {
    extern __shared__ __attribute__((aligned(16))) unsigned char lds[];
    Frame F;
    F.lds = (LAS unsigned char*)lds;
    F.tid = threadIdx.x; F.lane = F.tid & 63; F.wave = __builtin_amdgcn_readfirstlane(F.tid >> 6);
    const int wave0 = F.wave;
    F.G = gridDim.x; { const int bx = blockIdx.x; F.vcu = (F.G % 8 == 0) ? (bx % 8) * (F.G / 8) + bx / 8 : bx; }
    unsigned char* ws = args.ws; F.ws = ws; F.out = args.out; F.l = 0;

    volatile LAS unsigned* MISC = (volatile LAS unsigned*)(F.lds + MISC_OFF);
    if (F.tid < 64) MISC[F.tid] = 0u;
    wg_sync();
    unsigned* ctl = (unsigned*)(ws + WS_CTL);
    XcdBarrier bar; bar.bar = ctl + CW_BAR; bar.x = 0; bar.st = nullptr;
    if (args.single) bar = xcd_barrier_post(ctl + CW_BAR, MISC);
#define GRID_BAR() do { if (args.single) xcd_barrier(bar); } while (0)
    const int lo = args.ph_lo, hi = args.ph_hi;
#define IN(k) (lo <= (k) && (k) < hi)
#define PH_BEGIN() do { unsigned z_ = 0u; asm volatile("" : "+v"(z_)); const int ln_ = (int)__builtin_amdgcn_mbcnt_hi(~0u, __builtin_amdgcn_mbcnt_lo(~0u, z_)); F.lane = ln_; F.tid = wave0 * 64 + ln_; F.wave = wave0; unsigned long long w_ = (unsigned long long)args.ws, o_ = (unsigned long long)args.out; asm volatile("" : "+s"(w_), "+s"(o_)); F.ws = (unsigned char*)(GAS unsigned char*)w_; F.out = (float*)(GAS float*)o_; } while (0)

    for (int l = args.l_lo; l < args.l_hi; ++l) {
        F.l = l;
        if (IN(0)) { PH_BEGIN(); phase_prep(F, l); GRID_BAR(); }
        if (IN(1)) { PH_BEGIN();
            { pg8::Gemm g{(const bf16_t*)F.HN8(), (const bf16_t*)F.W8(), M, 4 * D, D / 2, D / 2, D / 2}; pg8::StaticOrder S; S.init(M, 4 * D, F.G, (int)blockIdx.x); pg8::EpiProj E{F.PROJ(), LDP, 0, F.GF(), 1.0f / 64.0f};
              pg8::gemm_phase<pg8::EpiProj, true>(F.lds, g, S, E, F.tid); }
            PH_BEGIN();
            { pg8::Gemm g{F.HN(), F.win_t(), M, C_GR, D, D, D}; pg8::StaticOrder S; S.init(M, C_GR, F.G, (int)blockIdx.x); pg8::EpiProj E{F.PROJ(), LDP, 1 << 20, F.GF(), 1.0f};
              pg8::gemm_phase(F.lds, g, S, E, F.tid); }
            PH_BEGIN(); gr_pass(F);
            GRID_BAR(); }
        if (IN(2)) { PH_BEGIN(); lin2_phase<false>(F, l); PH_BEGIN();
            s5_pass<false>(F, l); pool_phase(F, l); wg_sync();
            GRID_BAR(); }
        if (IN(3)) { PH_BEGIN(); lin_scan(F); s5_scan(F); GRID_BAR(); }
        if (IN(4)) { PH_BEGIN(); lin2_phase<true>(F, l); PH_BEGIN();
            s5_pass<true>(F, l); wg_sync();
            GRID_BAR(); }
        if (IN(5)) { PH_BEGIN(); pg8::Gemm g{F.YBP(), F.wglu_t(), M, BW, BW, BW, BW}; pg8::StaticOrder S; S.init(M, BW, F.G, (int)blockIdx.x); pg8::EpiGlu E{F.YBP(), BW, F.Y() + BW, D};
            pg8::gemm_phase(F.lds, g, S, E, F.tid); GRID_BAR(); }
        if (IN(6)) { PH_BEGIN(); for (int i = 0; i < (F.vcu & 7); ++i) __builtin_amdgcn_s_sleep(56);
            pg8::Gemm g{F.Y(), F.wbr_t(), M, D, D, D, D}; pg8::StaticOrder S; S.init(M, D, F.G, (int)blockIdx.x); pg8::EpiMerge E{F.GF(), F.HN(), D};
            pg8::gemm_phase(F.lds, g, S, E, F.tid); GRID_BAR(); }
        if (IN(7)) { PH_BEGIN(); for (int i = 0; i < (F.vcu & 7); ++i) __builtin_amdgcn_s_sleep(50);
            pg8::Gemm g{F.HN(), F.wout_t(), M, D, D, D, D}; pg8::StaticOrder S; S.init(M, D, F.G, (int)blockIdx.x); pg8::EpiResid E{l == 0 ? (const void*)F.x() : (const void*)F.out, l == 0 ? 1 : 0, F.Y(), D, F.SS()};
            pg8::gemm_phase(F.lds, g, S, E, F.tid); GRID_BAR(); }
        if (IN(8)) { PH_BEGIN(); row_scale(F); GRID_BAR(); }
        if (IN(9)) { PH_BEGIN(); pg8::Gemm g{F.Y(), F.wup_t(), M, NUP, D, D, D}; pg8::StaticOrder S; S.init(M, NUP, F.G, (int)blockIdx.x); pg8::EpiConv E{F.conv_w() + (size_t)l * 3 * NUP, F.conv_b() + (size_t)l * NUP, F.ACT(), F.UH(), (LAS float*)(F.lds + pg8::STAGE_BYTES), F.RS()};
            pg8::gemm_phase(F.lds, g, S, E, F.tid); GRID_BAR(); }
        if (IN(10)) { PH_BEGIN(); conv_fix_phase(F, l); GRID_BAR(); }
        if (IN(11)) { PH_BEGIN(); for (int i = 0; i < (F.vcu & 7); ++i) __builtin_amdgcn_s_sleep(50);
            pg8::Gemm g{F.ACT(), F.wdn_t(), M, D, DFF, DFF, DFF}; pg8::StaticOrder S; S.init(M, D, F.G, (int)blockIdx.x); pg8::EpiResid E{(const void*)F.Y(), 0, l == DEPTH - 1 ? F.HN() : (bf16_t*)F.out, D, nullptr};
            pg8::gemm_phase(F.lds, g, S, E, F.tid); GRID_BAR(); }
        if (IN(12) && l == DEPTH - 1) { PH_BEGIN(); rms_rows16_to_f32(F, F.HN(), F.g_final(), F.out); }
    }
#undef IN
#undef PH_BEGIN
#undef GRID_BAR
}

#pragma clang attribute pop
extern "C" void kernel_launch(void* const* d_in, const int* in_sizes, int n_in, void* d_out, int out_size, void* d_ws, size_t ws_size, hipStream_t stream) {
    static int grid = 0;
    if (grid == 0) {
        if (n_in != 25 || in_sizes[0] != M * D || out_size != M * D || ws_size < WS_END) { fprintf(stderr, "kernel_launch: shape/workspace mismatch (n_in %d, in0 %d, out %d, ws %zu, need %zu); nothing launched\n", n_in, n_in > 0 ? in_sizes[0] : -1, out_size, ws_size, (size_t)WS_END); grid = -1; return; }
        int dev = 0, cus = 0, per_cu = 0;
        if (hipGetDevice(&dev) != hipSuccess || hipDeviceGetAttribute(&cus, hipDeviceAttributeMultiprocessorCount, dev) != hipSuccess) { grid = -1; return; }
        if (hipFuncSetAttribute((const void*)hybrid_fwd, hipFuncAttributeMaxDynamicSharedMemorySize, LDS_BYTES) != hipSuccess) { fprintf(stderr, "kernel_launch: hipFuncSetAttribute failed\n"); grid = -1; return; }
        if (hipOccupancyMaxActiveBlocksPerMultiprocessor(&per_cu, (const void*)hybrid_fwd, NWAVES * 64, LDS_BYTES) != hipSuccess || per_cu < 1) { fprintf(stderr, "kernel_launch: occupancy query reports %d workgroups per CU\n", per_cu); }
        (void)hipGetLastError();
        if (cus < 256) { fprintf(stderr, "kernel_launch: built for a 256-CU device (found %d CUs); nothing launched\n", cus); grid = -1; return; }
        grid = 256;
    }
    if (grid < 0) return;
    if (hipMemsetAsync((char*)d_ws + WS_CTL, 0, CTL_ZERO_BYTES, stream) != hipSuccess) return;
    Args a{};
    for (int i = 0; i < 25; ++i) a.in[i] = d_in[i];
    a.out = (float*)d_out; a.ws = (unsigned char*)d_ws;
#if MK_SINGLE
    a.l_lo = 0; a.l_hi = DEPTH; a.ph_lo = 0; a.ph_hi = NPH; a.single = 1;
    hipLaunchKernelGGL(hybrid_fwd, dim3(grid), dim3(NWAVES * 64), LDS_BYTES, stream, a);
#else
    a.single = 0;
    for (int l = 0; l < DEPTH; ++l)
        for (int p = 0; p < NPH; ++p) { if (p == 12 && l != DEPTH - 1) continue; a.l_lo = l; a.l_hi = l + 1; a.ph_lo = p; a.ph_hi = p + 1;
            hipLaunchKernelGGL(hybrid_fwd, dim3(grid), dim3(NWAVES * 64), LDS_BYTES, stream, a); }
#endif
}
```

```cpp
#include <hip/hip_runtime.h>
#include <cstdio>
#include <cstdint>

#ifndef MK_SINGLE
#define MK_SINGLE 1
#endif

#pragma clang attribute push(__attribute__((target("no-packed-fp32-ops"))), apply_to = function)
#define LAS __attribute__((address_space(3)))
#define GAS __attribute__((address_space(1)))
typedef unsigned short bf16_t;
typedef short bf16x8 __attribute__((ext_vector_type(8)));
typedef float f32x4 __attribute__((ext_vector_type(4)));
typedef float f32x2 __attribute__((ext_vector_type(2)));
typedef unsigned u32x4 __attribute__((ext_vector_type(4)));
typedef unsigned u32x2 __attribute__((ext_vector_type(2)));

constexpr int D = 2048, BATCH = 8, SEQ = 4096, DEPTH = 4, M = BATCH * SEQ;
constexpr int BW = 512;
constexpr int NIN_SRC = 12304, NIN = 12544;
constexpr int DFF = 5504, NUP = 11008;
constexpr int C_RQ = 0, C_RK = 256, C_RV = 512, C_RG = 1024, C_SU = 1536, C_GQ = 2048, C_GK = 2304, C_GV = 2560, C_GG = 3072, C_PU = 3584, C_GR = 4096, C_GATE = 4352;
constexpr int LDP = 4224;
constexpr float EPS = 1e-6f;
constexpr int NWAVES = 8;
constexpr int CH = 64;
constexpr int NCH = SEQ / CH;

constexpr size_t MiB = 1u << 20;
constexpr size_t WS_CTL = 0, CTL_ZERO_BYTES = 1 * MiB;
constexpr size_t WS_ROT = 1 * MiB;
constexpr size_t WS_S5T = 9 * MiB;
constexpr size_t S5T_ABAR = 0, S5T_APOW = 16384, S5T_BBAR = 32768, S5T_CMT = 32768 + 262144, S5T_BBT = S5T_CMT + 131072;
constexpr size_t WS_WGLU = 10 * MiB;
constexpr size_t WS_POOLW = 10 * MiB + 512 * 1024;
constexpr size_t WS_WIN = 11 * MiB;
constexpr size_t WS_WBR = 60 * MiB;
constexpr size_t WS_WOUT = 68 * MiB;
constexpr size_t WS_WUP = 76 * MiB;
constexpr size_t WS_WDN = 119 * MiB;
constexpr size_t WS_HN = 141 * MiB;
constexpr size_t WS_Y = 269 * MiB;
constexpr size_t WS_SCR = 397 * MiB;
constexpr size_t WS_YBP = WS_SCR;
constexpr size_t WS_STATE = WS_SCR + 32 * MiB;
constexpr size_t WS_SPREV = WS_SCR + 160 * MiB;
constexpr size_t WS_DEC = WS_SCR + 224 * MiB;
constexpr size_t WS_XEND = WS_SCR + 225 * MiB;
constexpr size_t WS_UH = WS_SCR + 128 * MiB;
constexpr size_t WS_PROJ = 637 * MiB;
constexpr size_t WS_GF = WS_PROJ + 264 * MiB;
constexpr size_t WS_ACT = WS_PROJ;
constexpr size_t WS_RS = 1421 * MiB;
constexpr size_t WS_SS = 1422 * MiB;
constexpr size_t WS_HN8 = 1438 * MiB;
constexpr size_t WS_W8 = 1502 * MiB;
constexpr size_t WS_END = 1518 * MiB;
static_assert(WS_PROJ + (size_t)M * LDP * 2 <= WS_GF && WS_GF + 4 * (size_t)M * D * 2 <= WS_RS, "ws map");
static_assert(WS_ACT + (size_t)M * DFF * 2 <= WS_RS, "ws map");
static_assert(WS_XEND + 8 * MiB <= WS_PROJ, "ws map");
static_assert(WS_UH + (size_t)(M / 256) * 4 * NUP * 4 <= WS_PROJ, "ws map");
constexpr int CW_TMO = 0, CW_BAR = 4096;

constexpr int LDS_BYTES = 155648;
constexpr int MISC_OFF = LDS_BYTES - 256;

#define RLX_AGENT __ATOMIC_RELAXED, __HIP_MEMORY_SCOPE_AGENT
__device__ __forceinline__ void lds_sync() { asm volatile("s_waitcnt lgkmcnt(0)" ::: "memory"); __builtin_amdgcn_s_barrier(); asm volatile("" ::: "memory"); }
__device__ __forceinline__ void wg_sync() { __builtin_amdgcn_fence(__ATOMIC_RELEASE, "workgroup"); __builtin_amdgcn_s_barrier(); __builtin_amdgcn_fence(__ATOMIC_ACQUIRE, "workgroup"); }
#define LDS_WAIT() asm volatile("s_waitcnt lgkmcnt(0)" ::: "memory")
#define VM_WAIT() asm volatile("s_waitcnt vmcnt(0)" ::: "memory")
__device__ __forceinline__ unsigned f2bf(float f) { unsigned u = __builtin_bit_cast(unsigned, f); return (u + 0x7fffu + ((u >> 16) & 1u)) >> 16; }
__device__ __forceinline__ unsigned pk2(float lo, float hi) { return f2bf(lo) | (f2bf(hi) << 16); }
__device__ __forceinline__ float bflo(unsigned w) { return __builtin_bit_cast(float, w << 16); }
__device__ __forceinline__ float bfhi(unsigned w) { return __builtin_bit_cast(float, w & 0xffff0000u); }
__device__ __forceinline__ void unpack8(const u32x4 w, float (&v)[8]) { v[0] = bflo(w.x); v[1] = bfhi(w.x); v[2] = bflo(w.y); v[3] = bfhi(w.y); v[4] = bflo(w.z); v[5] = bfhi(w.z); v[6] = bflo(w.w); v[7] = bfhi(w.w); }
__device__ __forceinline__ u32x4 pack8(const float (&v)[8]) { u32x4 w; w.x = pk2(v[0], v[1]); w.y = pk2(v[2], v[3]); w.z = pk2(v[4], v[5]); w.w = pk2(v[6], v[7]); return w; }
__device__ __forceinline__ unsigned pk4_fp8(float a, float b, float c, float d) { unsigned w = 0u; w = __builtin_amdgcn_cvt_pk_fp8_f32(a, b, w, false); w = __builtin_amdgcn_cvt_pk_fp8_f32(c, d, w, true); return w; }
__device__ __forceinline__ float sigmoidf_(float x) { return __builtin_amdgcn_rcpf(1.0f + __expf(-x)); }
__device__ __forceinline__ float siluf_(float x) { return x * __builtin_amdgcn_rcpf(1.0f + __expf(-x)); }
__device__ __forceinline__ float gelu_tanh(float x) { const float u = 1.5957691216f * (x + 0.044715f * x * x * x); return x * __builtin_amdgcn_rcpf(1.0f + __expf(-u)); }
__device__ __forceinline__ float logsigmoidf_(float x) { return fminf(x, 0.f) - __logf(1.0f + __expf(-fabsf(x))); }

namespace pg8 {
constexpr int BM = 256, BK = 64, HALF = 128, HTB = HALF * BK * 2, STAGE_BYTES = 8 * HTB, NXCD = 8, WGM = 4;
__host__ __device__ __forceinline__ int lds_byte(int r, int c) { const int st = (r >> 4) * 2 + (c >> 5), rr = r & 15, cc = c & 31, ob = rr * 64 + cc * 2; return st * 1024 + (ob ^ (((ob >> 9) & 1) << 5)); }
__host__ __device__ __forceinline__ void stage_rc(int b, int& R, int& C) { const int st = b / 1024, sb = b % 1024, swz = sb ^ (((sb >> 9) & 1) << 5); R = (st >> 1) * 16 + swz / 64; C = (st & 1) * 32 + (swz % 64) / 2; }
__host__ __device__ __forceinline__ int perm32(int rho) { const int n = rho >> 4, i = rho & 15; return 8 * (i >> 2) + 4 * n + (i & 3); }

struct Unit { int pm, pn; };
struct Gemm { const bf16_t* A; const bf16_t* Bt; int M, N, K, lda, ldb; };

struct StaticOrder {
    int nM, nN, nwg, G, c;
    __host__ __device__ void init(int M_, int N_, int G_, int c_) { nM = M_ / BM; nN = N_ / BM; nwg = nM * nN; G = G_; c = c_; }
    __host__ __device__ bool next(int i, Unit& u) const {
        const long L = (long)i * G + c; if (L >= nwg) return false;
        int wgid = (int)L; { const int q = nwg / NXCD, r = nwg % NXCD, xcd = wgid % NXCD, off = wgid / NXCD; wgid = (xcd < r ? xcd * (q + 1) : r * (q + 1) + (xcd - r) * q) + off; }
        const int nig = WGM * nN, gid = wgid / nig, fm = gid * WGM, gsz = (nM - fm) < WGM ? (nM - fm) : WGM;
        u.pm = fm + ((wgid % nig) % gsz); u.pn = (wgid % nig) / gsz; return true;
    }
};

__device__ __forceinline__ unsigned cvt_pk_bf16(float lo, float hi) { unsigned r; asm volatile("v_cvt_pk_bf16_f32 %0, %1, %2" : "=v"(r) : "v"(lo), "v"(hi)); return r; }

struct EpiStoreBf16 {
    static constexpr bool PERM = true, KHOOK = false;
    bf16_t* O; int ldc;
    __device__ __forceinline__ void khook(f32x4 (&)[2][2][4][2], const Unit&, int, int, int, int, int) const {}
    __device__ __forceinline__ void operator()(f32x4 (&acc)[2][2][4][2], const Unit& u, int wr, int wc, int fr, int fq) const {
        const int row0 = u.pm * BM + wr * 64 + fr, col0 = u.pn * BM + wc * 32 + 8 * fq;
#pragma unroll
        for (int ai = 0; ai < 2; ++ai)
#pragma unroll
            for (int m = 0; m < 4; ++m) { bf16_t* rowp = O + (size_t)(row0 + ai * HALF + m * 16) * ldc + col0;
#pragma unroll
                for (int bj = 0; bj < 2; ++bj) { const f32x4 v0 = acc[ai][bj][m][0], v1 = acc[ai][bj][m][1];
                    u32x4 w; w.x = cvt_pk_bf16(v0[0], v0[1]); w.y = cvt_pk_bf16(v0[2], v0[3]); w.z = cvt_pk_bf16(v1[0], v1[1]); w.w = cvt_pk_bf16(v1[2], v1[3]);
                    *(u32x4*)(rowp + bj * HALF) = w; } }
    }
};
struct EpiProj {
    static constexpr bool PERM = true, KHOOK = false;
    bf16_t* O; int ldc; int gate_pn0; bf16_t* GF; float gscale;
    __device__ __forceinline__ void khook(f32x4 (&)[2][2][4][2], const Unit&, int, int, int, int, int) const {}
    __device__ __forceinline__ void operator()(f32x4 (&acc)[2][2][4][2], const Unit& u, int wr, int wc, int fr_, int fq_) const {
        int fr = fr_, fq = fq_; asm volatile("" : "+v"(fr), "+v"(fq));
        const int row0 = u.pm * BM + wr * 64 + fr;
        if (u.pn < gate_pn0) {
            const int col0 = u.pn * BM + wc * 32 + 8 * fq;
#pragma unroll
            for (int ai = 0; ai < 2; ++ai)
#pragma unroll
                for (int m = 0; m < 4; ++m) { bf16_t* rowp = O + (size_t)(row0 + ai * HALF + m * 16) * ldc + col0;
#pragma unroll
                    for (int bj = 0; bj < 2; ++bj) { const f32x4 v0 = acc[ai][bj][m][0], v1 = acc[ai][bj][m][1];
                        u32x4 w; w.x = cvt_pk_bf16(v0[0], v0[1]); w.y = cvt_pk_bf16(v0[2], v0[3]); w.z = cvt_pk_bf16(v1[0], v1[1]); w.w = cvt_pk_bf16(v1[2], v1[3]);
                        *(u32x4*)(rowp + bj * HALF) = w; } }
        } else {
            const int t = u.pn - gate_pn0, c0 = 64 * t + 16 * wc + 4 * fq;
            const size_t gbase = ((size_t)((u.pm * 8 + (c0 >> 8)) * 4) * 16 + ((c0 >> 7) & 1)) * 4096 + (size_t)(((wr * 4 + ((c0 >> 5) & 3)) * 64 + ((c0 >> 3) & 3) * 16 + fr) * 8 + (c0 & 7));
#pragma unroll
            for (int ai = 0; ai < 2; ++ai)
#pragma unroll
                for (int m = 0; m < 4; ++m) { bf16_t* rowp = GF + gbase + (size_t)(ai * 8 + m * 2) * 4096;
                    float r1[4], r2[4], r3[4], g3[4];
#pragma unroll
                    for (int i = 0; i < 4; ++i) {
                        const float e0 = __expf(-fminf(fmaxf(acc[ai][0][m][0][i] * gscale, -30.f), 30.f)), e1 = __expf(-fminf(fmaxf(acc[ai][0][m][1][i] * gscale, -30.f), 30.f));
                        const float e2 = __expf(-fminf(fmaxf(acc[ai][1][m][0][i] * gscale, -30.f), 30.f)), e3 = __expf(-fminf(fmaxf(acc[ai][1][m][1][i] * gscale, -30.f), 30.f));
                        const float i0 = __builtin_amdgcn_rcpf(1.f + e0), i1 = __builtin_amdgcn_rcpf(1.f + e1), i2 = __builtin_amdgcn_rcpf(1.f + e2), i3 = __builtin_amdgcn_rcpf(1.f + e3);
                        r1[i] = (1.f + e1) * i0; r2[i] = (1.f + e2) * i1; r3[i] = (1.f + e3) * i2; g3[i] = i3; }
                    u32x2 w;
                    w.x = cvt_pk_bf16(r1[0], r1[1]); w.y = cvt_pk_bf16(r1[2], r1[3]); *(u32x2*)(rowp) = w;
                    w.x = cvt_pk_bf16(r2[0], r2[1]); w.y = cvt_pk_bf16(r2[2], r2[3]); *(u32x2*)(rowp + 16 * 4096) = w;
                    w.x = cvt_pk_bf16(r3[0], r3[1]); w.y = cvt_pk_bf16(r3[2], r3[3]); *(u32x2*)(rowp + 2 * 16 * 4096) = w;
                    w.x = cvt_pk_bf16(g3[0], g3[1]); w.y = cvt_pk_bf16(g3[2], g3[3]); *(u32x2*)(rowp + 3 * 16 * 4096) = w; }
        }
    }
};
__device__ __forceinline__ float dpp_ror1(float x) { return __builtin_bit_cast(float, __builtin_amdgcn_update_dpp(0, __builtin_bit_cast(int, x), 0x121, 0xf, 0xf, false)); }
__device__ __forceinline__ float dpp_ror2(float x) { return __builtin_bit_cast(float, __builtin_amdgcn_update_dpp(0, __builtin_bit_cast(int, x), 0x122, 0xf, 0xf, false)); }
struct EpiConv {
    static constexpr bool PERM = true, KHOOK = false;
    const float* cw; const float* cb; bf16_t* O; float* UH; LAS float* halo; const float* RS;
    __device__ __forceinline__ void khook(f32x4 (&)[2][2][4][2], const Unit&, int, int, int, int, int) const {}
    __device__ __forceinline__ void operator()(f32x4 (&acc)[2][2][4][2], const Unit& u, int wr, int wc, int fr_, int fq_) const {
        int fr = fr_, fq = fq_; asm volatile("" : "+v"(fr), "+v"(fq));
        const int cl0 = wc * 32 + 8 * fq;
        const int j0 = 128 * u.pn + cl0;
        const float* rp = RS + ((size_t)(u.pm * 2 + wr) * 16 + fr) * 8; const f32x4 rs0 = *(const f32x4*)rp, rs1 = *(const f32x4*)(rp + 4);
        f32x4 wa0[3], wv0[3];
#pragma unroll
        for (int q = 0; q < 3; ++q) { wa0[q] = *(const f32x4*)(cw + q * NUP + j0); wv0[q] = *(const f32x4*)(cw + q * NUP + DFF + j0); }
        const f32x4 ba0 = *(const f32x4*)(cb + j0), bv0 = *(const f32x4*)(cb + DFF + j0);
#pragma unroll
        for (int ai = 0; ai < 2; ++ai)
#pragma unroll
            for (int m = 0; m < 4; ++m) { const float r = ai == 0 ? rs0[m] : rs1[m];
#pragma unroll
                for (int bj = 0; bj < 2; ++bj)
#pragma unroll
                    for (int n = 0; n < 2; ++n) acc[ai][bj][m][n] *= r; }
        if (fr >= 14) {
#pragma unroll
            for (int ai = 0; ai < 2; ++ai)
#pragma unroll
                for (int bj = 0; bj < 2; ++bj)
#pragma unroll
                    for (int n = 0; n < 2; ++n) *(LAS f32x4*)(halo + (((2 * ai + wr) * 2 + (fr - 14)) * 256 + 128 * bj + cl0 + 4 * n)) = acc[ai][bj][3][n];
        }
        if (wr == 0 && fr < 2) {
#pragma unroll
            for (int bj = 0; bj < 2; ++bj)
#pragma unroll
                for (int n = 0; n < 2; ++n) *(f32x4*)(UH + ((size_t)u.pm * 4 + fr) * NUP + 256 * u.pn + 128 * bj + cl0 + 4 * n) = acc[0][bj][0][n];
        }
        if (wr == 1 && fr >= 14) {
#pragma unroll
            for (int bj = 0; bj < 2; ++bj)
#pragma unroll
                for (int n = 0; n < 2; ++n) *(f32x4*)(UH + ((size_t)u.pm * 4 + 2 + (fr - 14)) * NUP + 256 * u.pn + 128 * bj + cl0 + 4 * n) = acc[1][bj][3][n];
        }
        asm volatile("s_waitcnt lgkmcnt(0)" ::: "memory"); __builtin_amdgcn_s_barrier(); asm volatile("" ::: "memory");
        const bool is15 = fr == 15, ge14 = fr >= 14;
        unsigned keep[2][4][2];
        f32x4 wa1[3], wv1[3];
#pragma unroll
        for (int q = 0; q < 3; ++q) { wa1[q] = *(const f32x4*)(cw + q * NUP + j0 + 4); wv1[q] = *(const f32x4*)(cw + q * NUP + DFF + j0 + 4); }
        const f32x4 ba1 = *(const f32x4*)(cb + j0 + 4), bv1 = *(const f32x4*)(cb + DFF + j0 + 4);
#pragma unroll
        for (int n = 0; n < 2; ++n) {
            f32x4 wa[3], wv[3];
#pragma unroll
            for (int q = 0; q < 3; ++q) { wa[q] = n == 0 ? wa0[q] : wa1[q]; wv[q] = n == 0 ? wv0[q] : wv1[q]; }
            const f32x4 ba = n == 0 ? ba0 : ba1, bv = n == 0 ? bv0 : bv1;
#pragma unroll
            for (int ai = 0; ai < 2; ++ai) {
                const int blk = 2 * ai + wr;
                f32x4 pa = (f32x4){0.f, 0.f, 0.f, 0.f}, pv = (f32x4){0.f, 0.f, 0.f, 0.f};
                if (blk > 0 && ge14) { pa = *(const LAS f32x4*)(halo + (((blk - 1) * 2 + (fr - 14)) * 256 + cl0 + 4 * n)); pv = *(const LAS f32x4*)(halo + (((blk - 1) * 2 + (fr - 14)) * 256 + 128 + cl0 + 4 * n)); }
#pragma unroll
                for (int m = 0; m < 4; ++m) {
                    const f32x4 ca_ = acc[ai][0][m][n], cv_ = acc[ai][1][m][n]; float o[4];
#pragma unroll
                    for (int i = 0; i < 4; ++i) {
                        const float a1 = dpp_ror1(is15 ? pa[i] : ca_[i]), a2 = dpp_ror2(ge14 ? pa[i] : ca_[i]);
                        const float v1 = dpp_ror1(is15 ? pv[i] : cv_[i]), v2 = dpp_ror2(ge14 ? pv[i] : cv_[i]);
                        const float ca = ba[i] + wa[0][i] * a2 + wa[1][i] * a1 + wa[2][i] * ca_[i];
                        const float cv = bv[i] + wv[0][i] * v2 + wv[1][i] * v1 + wv[2][i] * cv_[i];
                        o[i] = siluf_(ca) * cv; }
                    pa = ca_; pv = cv_;
                    const unsigned lo = cvt_pk_bf16(o[0], o[1]), hi = cvt_pk_bf16(o[2], o[3]);
                    if (n == 0) { keep[ai][m][0] = lo; keep[ai][m][1] = hi; }
                    else { u32x4 w; w.x = keep[ai][m][0]; w.y = keep[ai][m][1]; w.z = lo; w.w = hi;
                        *(u32x4*)(O + (size_t)(u.pm * BM + ai * HALF + wr * 64 + m * 16 + fr) * DFF + j0) = w; }
                }
            }
        }
    }
};
struct EpiResid {
    static constexpr bool PERM = true, KHOOK = false;
    const void* base; int base_f32; bf16_t* O; int ldc; float* SS;
    __device__ __forceinline__ void khook(f32x4 (&)[2][2][4][2], const Unit&, int, int, int, int, int) const {}
    __device__ __forceinline__ void finish(const float (&b)[8], const f32x4 v0, const f32x4 v1, bf16_t* op, float& sq) const {
        const float o0 = b[0] + v0[0], o1 = b[1] + v0[1], o2 = b[2] + v0[2], o3 = b[3] + v0[3], o4 = b[4] + v1[0], o5 = b[5] + v1[1], o6 = b[6] + v1[2], o7 = b[7] + v1[3];
        u32x4 w; w.x = cvt_pk_bf16(o0, o1); w.y = cvt_pk_bf16(o2, o3); w.z = cvt_pk_bf16(o4, o5); w.w = cvt_pk_bf16(o6, o7);
        *(u32x4*)op = w;
        sq += ((o0 * o0 + o1 * o1) + (o2 * o2 + o3 * o3)) + ((o4 * o4 + o5 * o5) + (o6 * o6 + o7 * o7));
    }
    __device__ __forceinline__ void rowsum(float sq, const Unit& u, int wc, int fq, int lane, int row) const {
        sq += __builtin_bit_cast(float, __builtin_amdgcn_ds_bpermute((lane ^ 16) << 2, __builtin_bit_cast(int, sq)));
        sq += __builtin_bit_cast(float, __builtin_amdgcn_ds_bpermute((lane ^ 32) << 2, __builtin_bit_cast(int, sq)));
        if (fq == 0) SS[(size_t)(u.pn * 4 + wc) * M + row] = sq;
    }
    __device__ __forceinline__ void operator()(f32x4 (&acc)[2][2][4][2], const Unit& u, int wr, int wc, int fr_, int fq_) const {
        int fr = fr_, fq = fq_; asm volatile("" : "+v"(fr), "+v"(fq));
        const int row0 = u.pm * BM + wr * 64 + fr, col0 = u.pn * BM + wc * 32 + 8 * fq, lane = fq * 16 + fr;
        if (!base_f32) {
            u32x4 bw[2][4][2];
#pragma unroll
            for (int ai = 0; ai < 2; ++ai)
#pragma unroll
                for (int m = 0; m < 4; ++m)
#pragma unroll
                    for (int bj = 0; bj < 2; ++bj) bw[ai][m][bj] = *(const u32x4*)((const bf16_t*)base + (size_t)(row0 + ai * HALF + m * 16) * ldc + col0 + bj * HALF);
#pragma unroll
            for (int ai = 0; ai < 2; ++ai)
#pragma unroll
                for (int m = 0; m < 4; ++m) { const size_t off = (size_t)(row0 + ai * HALF + m * 16) * ldc + col0; float sq = 0.f;
#pragma unroll
                    for (int bj = 0; bj < 2; ++bj) { float b[8]; unpack8(bw[ai][m][bj], b); finish(b, acc[ai][bj][m][0], acc[ai][bj][m][1], O + off + bj * HALF, sq); }
                    if (SS) rowsum(sq, u, wc, fq, lane, row0 + ai * HALF + m * 16); }
        } else {
#pragma unroll
            for (int ai = 0; ai < 2; ++ai)
#pragma unroll
                for (int m = 0; m < 4; ++m) { const size_t off = (size_t)(row0 + ai * HALF + m * 16) * ldc + col0; float sq = 0.f;
#pragma unroll
                    for (int bj = 0; bj < 2; ++bj) { float b[8]; const float* bp = (const float*)base + off + bj * HALF; const f32x4 b0 = *(const f32x4*)bp, b1 = *(const f32x4*)(bp + 4);
                        b[0] = b0.x; b[1] = b0.y; b[2] = b0.z; b[3] = b0.w; b[4] = b1.x; b[5] = b1.y; b[6] = b1.z; b[7] = b1.w;
                        finish(b, acc[ai][bj][m][0], acc[ai][bj][m][1], O + off + bj * HALF, sq); }
                    if (SS) rowsum(sq, u, wc, fq, lane, row0 + ai * HALF + m * 16);
                    asm volatile("" ::: "memory"); }
        }
    }
};
struct EpiGlu {
    static constexpr bool PERM = true, KHOOK = false;
    const bf16_t* Yp; int ldy; bf16_t* O; int ldc;
    __device__ __forceinline__ void khook(f32x4 (&)[2][2][4][2], const Unit&, int, int, int, int, int) const {}
    __device__ __forceinline__ void operator()(f32x4 (&acc)[2][2][4][2], const Unit& u, int wr, int wc, int fr, int fq) const {
        const int row0 = u.pm * BM + wr * 64 + fr, col0 = u.pn * BM + wc * 32 + 8 * fq;
#pragma unroll
        for (int ai = 0; ai < 2; ++ai)
#pragma unroll
            for (int m = 0; m < 4; ++m) { const size_t r = (size_t)(row0 + ai * HALF + m * 16);
#pragma unroll
                for (int bj = 0; bj < 2; ++bj) { const u32x4 yw = *(const u32x4*)(Yp + r * ldy + col0 + bj * HALF); float y[8]; unpack8(yw, y);
                    const f32x4 v0 = acc[ai][bj][m][0], v1 = acc[ai][bj][m][1]; float o[8];
#pragma unroll
                    for (int j = 0; j < 4; ++j) { o[j] = y[j] * sigmoidf_(v0[j]); o[4 + j] = y[4 + j] * sigmoidf_(v1[j]); }
                    u32x4 w; w.x = cvt_pk_bf16(o[0], o[1]); w.y = cvt_pk_bf16(o[2], o[3]); w.z = cvt_pk_bf16(o[4], o[5]); w.w = cvt_pk_bf16(o[6], o[7]);
                    *(u32x4*)(O + r * ldc + col0 + bj * HALF) = w; } }
    }
};
struct EpiMerge {
    static constexpr bool PERM = true, KHOOK = true;
    const bf16_t* G; bf16_t* O; int ldc;
    __device__ __forceinline__ void scale(f32x4 (&acc)[2][2][4][2], const Unit& u, int s, int wr, int wc, int fr, int fq) const {
        int toff = ((wr * 4 + wc) * 64 + fq * 16 + fr) * 8; asm volatile("" : "+v"(toff));
        const bf16_t* gb = G + (size_t)(((u.pm * 8 + u.pn) * 4 + s) * 16) * 4096 + toff;
        u32x4 w[2][4][2];
#pragma unroll
        for (int ai = 0; ai < 2; ++ai)
#pragma unroll
            for (int m = 0; m < 4; ++m) {
#pragma unroll
                for (int bj = 0; bj < 2; ++bj) w[ai][m][bj] = *(const u32x4*)(gb + (size_t)(ai * 8 + m * 2 + bj) * 4096); }
#pragma unroll
        for (int ai = 0; ai < 2; ++ai)
#pragma unroll
            for (int m = 0; m < 4; ++m)
#pragma unroll
                for (int bj = 0; bj < 2; ++bj) { float f[8]; unpack8(w[ai][m][bj], f);
#pragma unroll
                    for (int j = 0; j < 8; ++j) acc[ai][bj][m][j >> 2][j & 3] *= f[j]; }
    }
    __device__ __forceinline__ void khook(f32x4 (&acc)[2][2][4][2], const Unit& u, int seg, int wr, int wc, int fr, int fq) const { scale(acc, u, seg - 1, wr, wc, fr, fq); }
    __device__ __forceinline__ void operator()(f32x4 (&acc)[2][2][4][2], const Unit& u, int wr, int wc, int fr, int fq) const {
        scale(acc, u, 3, wr, wc, fr, fq);
        const int row0 = u.pm * BM + wr * 64 + fr, col0 = u.pn * BM + wc * 32 + 8 * fq;
#pragma unroll
        for (int ai = 0; ai < 2; ++ai)
#pragma unroll
            for (int m = 0; m < 4; ++m) { bf16_t* rowp = O + (size_t)(row0 + ai * HALF + m * 16) * ldc + col0;
#pragma unroll
                for (int bj = 0; bj < 2; ++bj) { const f32x4 v0 = acc[ai][bj][m][0], v1 = acc[ai][bj][m][1];
                    u32x4 w; w.x = cvt_pk_bf16(v0[0], v0[1]); w.y = cvt_pk_bf16(v0[2], v0[3]); w.z = cvt_pk_bf16(v1[0], v1[1]); w.w = cvt_pk_bf16(v1[2], v1[3]);
                    *(u32x4*)(rowp + bj * HALF) = w; } }
    }
};

typedef int v4i_t __attribute__((ext_vector_type(4)));
typedef int v8i_t __attribute__((ext_vector_type(8)));
template <class Epi, bool F8 = false>
__device__ __forceinline__ void gemm_phase(LAS unsigned char* lds, const Gemm g, const StaticOrder& S, const Epi& E, int tid_in) {
    int tid_ = tid_in; asm volatile("" : "+v"(tid_));
    const int tid = tid_, wid = __builtin_amdgcn_readfirstlane(tid >> 6), lane = tid & 63, wr = wid >> 2, wc = wid & 3, fr = lane & 15, fq = lane >> 4;
    const int K = g.K, nt = K / BK;
    unsigned voffA[2], voffB[2];
#pragma unroll
    for (int i = 0; i < 2; ++i) { int R, C; stage_rc(tid * 16 + i * 8192, R, C); const int Rb = Epi::PERM ? ((R & ~31) + perm32(R & 31)) : R;
        voffA[i] = (unsigned)(R * g.lda + C) * 2u; voffB[i] = (unsigned)(Rb * g.ldb + C) * 2u; }
    const size_t kstep = (size_t)(BK * 2);
    const size_t hstepA = (size_t)HALF * g.lda * 2, hstepB = (size_t)HALF * g.ldb * 2;
    const size_t tstepA = 2 * hstepA, tstepB = 2 * hstepB;
    const unsigned ldsw = (unsigned)wid * 1024u;
    const int aoff = lds_byte(wr * 64 + fr, fq * 8), boff = lds_byte(wc * 32 + fr, fq * 8);
#define PG8_SA(b, h) (((b) * 2 + (h)) * HTB)
#define PG8_SB(b, h) ((4 + (b) * 2 + (h)) * HTB)
#define PG8_STAGE(bufoff, gbase, voff) do { _Pragma("unroll") for (int _i = 0; _i < 2; ++_i) \
        __builtin_amdgcn_global_load_lds((const unsigned*)((const char*)(gbase) + (voff)[_i]), (LAS unsigned*)(lds + (bufoff) + ldsw + _i * 8192), 16, 0, 0); } while (0)
#define PG8_LDA(dst, b, h) do { _Pragma("unroll") for (int m = 0; m < 4; ++m) _Pragma("unroll") for (int k = 0; k < 2; ++k) dst[m][k] = *(const LAS bf16x8*)(lds + PG8_SA(b, h) + aoff + m * 2048 + k * 1024); } while (0)
#define PG8_LDB(dst, b, h) do { _Pragma("unroll") for (int n = 0; n < 2; ++n) _Pragma("unroll") for (int k = 0; k < 2; ++k) dst[n][k] = *(const LAS bf16x8*)(lds + PG8_SB(b, h) + boff + n * 2048 + k * 1024); } while (0)
#define PG8_MMA(ai, bj, At, Bt) do { __builtin_amdgcn_s_setprio(1); _Pragma("unroll") for (int m = 0; m < 4; ++m) _Pragma("unroll") for (int n = 0; n < 2; ++n) _Pragma("unroll") for (int k = 0; k < 2; ++k) \
        acc[ai][bj][m][n] = __builtin_amdgcn_mfma_f32_16x16x32_bf16(Bt[n][k], At[m][k], acc[ai][bj][m][n], 0, 0, 0); __builtin_amdgcn_s_setprio(0); } while (0)
#define PG8_MMA16(ai, bj, At, Bt) PG8_MMA(ai, bj, At, Bt)
#define PG8_MMA8(ai, bj, A8, B8) do { __builtin_amdgcn_s_setprio(1); _Pragma("unroll") for (int m = 0; m < 4; ++m) _Pragma("unroll") for (int n = 0; n < 2; ++n) \
        asm volatile("v_mfma_f32_16x16x128_f8f6f4 %0, %1, %2, %0" : "+v"(acc[ai][bj][m][n]) : "v"(B8[n]), "v"(A8[m])); __builtin_amdgcn_s_setprio(0); } while (0)
#define PG8_LDA8(dst, b, h) do { _Pragma("unroll") for (int m = 0; m < 4; ++m) { dst[m].lo = *(const LAS v4i_t*)(lds + PG8_SA(b, h) + aoff + m * 2048); dst[m].hi = *(const LAS v4i_t*)(lds + PG8_SA(b, h) + aoff + m * 2048 + 1024); } } while (0)
#define PG8_LDB8(dst, b, h) do { _Pragma("unroll") for (int n = 0; n < 2; ++n) { dst[n].lo = *(const LAS v4i_t*)(lds + PG8_SB(b, h) + boff + n * 2048); dst[n].hi = *(const LAS v4i_t*)(lds + PG8_SB(b, h) + boff + n * 2048 + 1024); } } while (0)
#define PG8_XLDA(b, h) do { if constexpr (F8) PG8_LDA8(A8, b, h); else PG8_LDA(At, b, h); } while (0)
#define PG8_XLDB0(b, h) do { if constexpr (F8) PG8_LDB8(B08, b, h); else PG8_LDB(B0, b, h); } while (0)
#define PG8_XLDB1(b, h) do { if constexpr (F8) PG8_LDB8(B18, b, h); else PG8_LDB(B1, b, h); } while (0)
#define PG8_MM0(ai, bj) do { if constexpr (F8) PG8_MMA8(ai, bj, A8, B08); else PG8_MMA16(ai, bj, At, B0); } while (0)
#define PG8_MM1(ai, bj) do { if constexpr (F8) PG8_MMA8(ai, bj, A8, B18); else PG8_MMA16(ai, bj, At, B1); } while (0)
#define PG8_WAIT_V(n) asm volatile("s_waitcnt vmcnt(" #n ")" ::: "memory")
#define PG8_WAIT_L(n) asm volatile("s_waitcnt lgkmcnt(" #n ")" ::: "memory")
#define PG8_BAR __builtin_amdgcn_s_barrier()
#define PG8_SCHED __builtin_amdgcn_sched_barrier(0)
    Unit cur, nxt; int ui = 0;
    if (!S.next(0, cur)) return;
    f32x4 acc[2][2][4][2];
#pragma unroll
    for (int a = 0; a < 2; ++a)
#pragma unroll
        for (int b = 0; b < 2; ++b)
#pragma unroll
            for (int m = 0; m < 4; ++m)
#pragma unroll
                for (int n = 0; n < 2; ++n) acc[a][b][m][n] = (f32x4){0.f, 0.f, 0.f, 0.f};
    bf16x8 At[4][2], B0[2][2], B1[2][2]; v8i_t A8[4], B08[2], B18[2];
    const char* cA = (const char*)g.A + (size_t)cur.pm * tstepA; const char* cB = (const char*)g.Bt + (size_t)cur.pn * tstepB;
    PG8_STAGE(PG8_SB(0, 0), cB, voffB); PG8_STAGE(PG8_SB(0, 1), cB + hstepB, voffB); PG8_STAGE(PG8_SA(0, 0), cA, voffA); PG8_STAGE(PG8_SA(0, 1), cA + hstepA, voffA);
    if (wr == 1) PG8_BAR;
    PG8_WAIT_V(2); PG8_BAR;
    PG8_STAGE(PG8_SB(1, 0), cB + kstep, voffB); PG8_STAGE(PG8_SA(1, 0), cA + kstep, voffA); PG8_STAGE(PG8_SB(1, 1), cB + hstepB + kstep, voffB);
    PG8_WAIT_V(6); PG8_BAR;
    for (;;) {
        const bool has_next = S.next(ui + 1, nxt);
        const char* nA = has_next ? (const char*)g.A + (size_t)nxt.pm * tstepA : cA; const char* nB = has_next ? (const char*)g.Bt + (size_t)nxt.pn * tstepB : cB;
        for (int t = 0; t < nt; t += 2) {
            const bool last = (t == nt - 2);
            const char* a1 = cA + (size_t)(t + 1) * kstep;
            const char* a2 = last ? nA : cA + (size_t)(t + 2) * kstep; const char* b2 = last ? nB : cB + (size_t)(t + 2) * kstep;
            const char* a3 = a2 + kstep; const char* b3 = b2 + kstep;
            if constexpr (Epi::KHOOK) { if (t != 0 && (t & 7) == 0) E.khook(acc, cur, t >> 3, wr, wc, fr, fq); }
            PG8_XLDB0(0, 0); PG8_XLDB1(0, 1); PG8_SCHED; PG8_XLDA(0, 0); PG8_STAGE(PG8_SA(1, 1), a1 + hstepA, voffA);
            PG8_WAIT_V(8); PG8_WAIT_L(0); PG8_BAR; PG8_MM0(0, 0); PG8_MM1(0, 1); PG8_BAR; PG8_SCHED;
            PG8_XLDA(0, 1); PG8_STAGE(PG8_SB(0, 0), b2, voffB); PG8_STAGE(PG8_SB(0, 1), b2 + hstepB, voffB); PG8_STAGE(PG8_SA(0, 0), a2, voffA);
            PG8_WAIT_V(8); PG8_WAIT_L(0); PG8_BAR; PG8_MM0(1, 0); PG8_MM1(1, 1); PG8_BAR; PG8_SCHED;
            PG8_XLDB0(1, 0); PG8_XLDB1(1, 1); PG8_SCHED; PG8_XLDA(1, 0); PG8_STAGE(PG8_SA(0, 1), a2 + hstepA, voffA);
            PG8_WAIT_V(8); PG8_WAIT_L(0); PG8_BAR; PG8_MM0(0, 0); PG8_MM1(0, 1); PG8_BAR; PG8_SCHED;
            PG8_XLDA(1, 1); PG8_STAGE(PG8_SB(1, 0), b3, voffB); PG8_STAGE(PG8_SB(1, 1), b3 + hstepB, voffB); PG8_STAGE(PG8_SA(1, 0), a3, voffA);
            PG8_WAIT_V(8); PG8_WAIT_L(0); PG8_BAR; PG8_MM0(1, 0); PG8_MM1(1, 1); PG8_BAR; PG8_SCHED;
        }
        if (wr == 0) PG8_BAR;
        E(acc, cur, wr, wc, fr, fq);
        if (!has_next) break;
#pragma unroll
        for (int a = 0; a < 2; ++a)
#pragma unroll
            for (int b = 0; b < 2; ++b)
#pragma unroll
                for (int m = 0; m < 4; ++m)
#pragma unroll
                    for (int n = 0; n < 2; ++n) acc[a][b][m][n] = (f32x4){0.f, 0.f, 0.f, 0.f};
        cur = nxt; cA = nA; cB = nB; ++ui;
        if (wr == 1) PG8_BAR;
    }
    PG8_WAIT_V(0);
    PG8_BAR;
#undef PG8_SA
#undef PG8_SB
#undef PG8_STAGE
#undef PG8_LDA
#undef PG8_LDB
#undef PG8_MMA
#undef PG8_MMA8
#undef PG8_MMA16
#undef PG8_LDA8
#undef PG8_LDB8
#undef PG8_XLDA
#undef PG8_XLDB0
#undef PG8_XLDB1
#undef PG8_MM0
#undef PG8_MM1
#undef PG8_WAIT_V
#undef PG8_WAIT_L
#undef PG8_BAR
#undef PG8_SCHED
}
}

#define XB_TMO      128
#define XB_XCNT(j)  (256  + 64 * (j))
#define XB_XSUB(j)  (1280 + 64 * (j))
#define XB_XGEN(j)  (2304 + 64 * (j))
#define XB_TOP      3328
#define XB_TOPGEN   3392
#define XCD_BAR_WORDS 3456
#define XB_SPIN_CAP (1u << 18)
__device__ __forceinline__ unsigned xb_ld(unsigned* p)              { return __hip_atomic_load(p, __ATOMIC_RELAXED, __HIP_MEMORY_SCOPE_AGENT); }
__device__ __forceinline__ unsigned xb_add(unsigned* p, unsigned v) { return __hip_atomic_fetch_add(p, v, __ATOMIC_RELAXED, __HIP_MEMORY_SCOPE_AGENT); }
__device__ __forceinline__ unsigned xb_xcc_id() { return (unsigned)__builtin_amdgcn_s_getreg((3 << 11) | 20) & 0xFu; }
#define XB_SPIN(cond, bar) do { unsigned _sp = 0; while (cond) { __builtin_amdgcn_s_sleep(1); \
    if ((++_sp & 255u) == 0u) { if (xb_ld(&(bar)[XB_TMO])) break; if (_sp > XB_SPIN_CAP) { (void)__hip_atomic_fetch_add(&(bar)[XB_TMO], 1u, __ATOMIC_RELAXED, __HIP_MEMORY_SCOPE_AGENT); break; } } } } while (0)
struct XcdBarrier { unsigned* bar; unsigned x; volatile LAS unsigned* st; };
__device__ __forceinline__ XcdBarrier xcd_barrier_post(unsigned* bar, volatile LAS unsigned* st) {
    XcdBarrier b; b.bar = bar; b.x = xb_xcc_id(); b.st = st;
    if (threadIdx.x == 0) (void)xb_add(&bar[XB_XCNT(b.x)], 1u);
    return b;
}
__device__ __forceinline__ void xcd_barrier_complete(unsigned* bar, unsigned x, unsigned& nloc, unsigned& nx) {
    const unsigned G = gridDim.x * gridDim.y * gridDim.z;
    unsigned sum, cnt, mine, sp = 0u;
    for (;;) {
        sum = 0u; cnt = 0u; mine = 0u;
#pragma nounroll
        for (unsigned j = 0; j < 16; ++j) { const unsigned c = xb_ld(&bar[XB_XCNT(j)]); sum += c; cnt += (c > 0u) ? 1u : 0u; mine = (j == x) ? c : mine; }
        if (sum == G) break;
        __builtin_amdgcn_s_sleep(1);
        if ((++sp & 255u) == 0u) { if (xb_ld(&bar[XB_TMO])) break; if (sp > XB_SPIN_CAP) { (void)__hip_atomic_fetch_add(&bar[XB_TMO], 1u, __ATOMIC_RELAXED, __HIP_MEMORY_SCOPE_AGENT); break; } }
    }
    nloc = mine > 0u ? mine : 1u; nx = cnt > 0u ? cnt : 1u;
}
__device__ __forceinline__ void xcd_barrier(const XcdBarrier& b) {
    asm volatile("s_waitcnt vmcnt(0)" ::: "memory");
    wg_sync();
    if (threadIdx.x == 0) {
        unsigned* bar = b.bar;
        __builtin_amdgcn_s_waitcnt(0);
        unsigned nloc = b.st[0], nx = b.st[1];
        if (nloc == 0u) { xcd_barrier_complete(bar, b.x, nloc, nx); b.st[0] = nloc; b.st[1] = nx; }
        const unsigned old = xb_add(&bar[XB_XSUB(b.x)], 1u);
        const unsigned gen = old / nloc;
        if (old + 1u == (gen + 1u) * nloc) {
            __builtin_amdgcn_fence(__ATOMIC_RELEASE, "agent");
            asm volatile("s_waitcnt vmcnt(0)" ::: "memory");
            const unsigned og = xb_add(&bar[XB_TOP], 1u);
            const unsigned tg = og / nx;
            if (og + 1u == (tg + 1u) * nx) xb_add(&bar[XB_TOPGEN], 1u);
            else XB_SPIN(xb_ld(&bar[XB_TOPGEN]) == tg, bar);
            __builtin_amdgcn_fence(__ATOMIC_ACQUIRE, "agent");
            xb_add(&bar[XB_XGEN(b.x)], 1u);
            asm volatile("s_waitcnt vmcnt(0)" ::: "memory");
        } else {
            XB_SPIN(xb_ld(&bar[XB_XGEN(b.x)]) == gen, bar);
            __builtin_amdgcn_fence(__ATOMIC_ACQUIRE, "agent");
            asm volatile("s_waitcnt vmcnt(0)" ::: "memory");
        }
    }
    wg_sync();
}

__device__ __forceinline__ const void* kin(int k) {
    typedef __attribute__((address_space(4))) const char* kptr_t;
    kptr_t p = (kptr_t)__builtin_amdgcn_kernarg_segment_ptr(); asm volatile("" : "+s"(p));
    const unsigned long long v = *(__attribute__((address_space(4))) const unsigned long long*)(p + 8 * k);
    return (const void*)(GAS const void*)v;
}
struct Frame {
    LAS unsigned char* lds;
    int tid, lane, wave, vcu, G, l;
    unsigned char* ws; float* out;
#define FIN(name, T, k) __device__ __forceinline__ const T* name() const { return (const T*)kin(k); }
    FIN(x, float, 0) FIN(pos, int, 1) FIN(g_mix, float, 2) FIN(w_in, float, 3) FIN(a_re, float, 4) FIN(a_im, float, 5) FIN(log_dt, float, 6) FIN(b_re, float, 7) FIN(b_im, float, 8)
    FIN(c_re, float, 9) FIN(c_im, float, 10) FIN(s5_d, float, 11) FIN(w_glu, float, 12) FIN(gla_wg, float, 13) FIN(gla_bg, float, 14) FIN(pool_w, float, 15) FIN(pool_scale, float, 16)
    FIN(w_branch, float, 17) FIN(w_out, float, 18) FIN(g_ffn, float, 19) FIN(w_up, float, 20) FIN(conv_w, float, 21) FIN(conv_b, float, 22) FIN(w_down, float, 23) FIN(g_final, float, 24)
#undef FIN
#define FWS(name, T, off) __device__ __forceinline__ T* name() const { return (T*)(ws + (off)); }
    FWS(rotc, float, WS_ROT) FWS(rots, float, WS_ROT + (size_t)M * 32 * 4) FWS(abar, float, WS_S5T + S5T_ABAR) FWS(apow, float, WS_S5T + S5T_APOW) FWS(bbar, float, WS_S5T + S5T_BBAR) FWS(cmt, bf16_t, WS_S5T + S5T_CMT) FWS(bbt, bf16_t, WS_S5T + S5T_BBT)
    FWS(wglu_t, bf16_t, WS_WGLU) FWS(poolw_t, bf16_t, WS_POOLW) FWS(win_t, bf16_t, WS_WIN) FWS(wbr_t, bf16_t, WS_WBR) FWS(wout_t, bf16_t, WS_WOUT) FWS(wup_t, bf16_t, WS_WUP) FWS(wdn_t, bf16_t, WS_WDN)
    FWS(HN8, unsigned char, WS_HN8) FWS(W8, unsigned char, WS_W8) FWS(HN, bf16_t, WS_HN) FWS(Y, bf16_t, WS_Y) FWS(YBP, bf16_t, WS_YBP) FWS(PROJ, bf16_t, WS_PROJ) FWS(GF, bf16_t, WS_GF) FWS(SPREV, bf16_t, WS_SPREV) FWS(ACT, bf16_t, WS_ACT)
    FWS(SS, float, WS_SS + (size_t)l * 32 * M * 4) FWS(RS, float, WS_RS + (size_t)l * M * 4) FWS(STATE, float, WS_STATE) FWS(DEC, float, WS_DEC) FWS(XEND, float, WS_XEND) FWS(UH, float, WS_UH)
#undef FWS
};

__device__ __forceinline__ float lane_read(float v, int src_lane) { return __builtin_bit_cast(float, __builtin_amdgcn_ds_bpermute(src_lane << 2, __builtin_bit_cast(int, v))); }
__device__ __forceinline__ float wave_sum(float v, int lane) {
#pragma unroll
    for (int o = 1; o < 64; o <<= 1) v += lane_read(v, lane ^ o);
    return v;
}

template <class SrcCol>
__device__ __forceinline__ void transpose_item(const float* W, int Nsrc, bf16_t* WT, int ldt, int kdst0, int k0, int n0, SrcCol srccol, LAS float* scr, int lane, const float* kscale = nullptr) {
    const int sc = srccol(n0 + (lane & 31));
    float wv[32];
#pragma unroll
    for (int i = 0; i < 32; ++i) { const int kk = 2 * i + (lane >> 5); wv[i] = sc >= 0 ? W[(size_t)(k0 + kk) * Nsrc + sc] : 0.f; }
#pragma unroll
    for (int i = 0; i < 32; ++i) { const int kk = 2 * i + (lane >> 5); scr[kk * 33 + (lane & 31)] = kscale ? wv[i] * kscale[k0 + kk] : wv[i]; }
    LDS_WAIT();
    const int c = lane & 7;
#pragma unroll
    for (int j = 0; j < 4; ++j) { const int n = (lane >> 3) + 8 * j; const LAS float* s = scr + (8 * c) * 33 + n;
        u32x4 o; o.x = pk2(s[0 * 33], s[1 * 33]); o.y = pk2(s[2 * 33], s[3 * 33]); o.z = pk2(s[4 * 33], s[5 * 33]); o.w = pk2(s[6 * 33], s[7 * 33]);
        *(u32x4*)(WT + (size_t)(n0 + n) * ldt + kdst0 + k0 + 8 * c) = o; }
    LDS_WAIT();
}
template <class SrcCol>
__device__ __forceinline__ void transpose_item_fp8(const float* W, int Nsrc, unsigned char* WT, int ldt, int k0, int n0src, int n0dst, SrcCol srccol, LAS float* scr, int lane, const float* kscale, float scale) {
    const int sc = srccol(n0src + (lane & 31));
    float wv[32];
#pragma unroll
    for (int i = 0; i < 32; ++i) { const int kk = 2 * i + (lane >> 5); wv[i] = sc >= 0 ? W[(size_t)(k0 + kk) * Nsrc + sc] : 0.f; }
#pragma unroll
    for (int i = 0; i < 32; ++i) { const int kk = 2 * i + (lane >> 5); scr[kk * 33 + (lane & 31)] = (kscale ? wv[i] * kscale[k0 + kk] : wv[i]) * scale; }
    LDS_WAIT();
    const int c = lane & 7;
#pragma unroll
    for (int j = 0; j < 4; ++j) { const int n = (lane >> 3) + 8 * j; const LAS float* s = scr + (8 * c) * 33 + n;
        u32x2 o; o.x = pk4_fp8(s[0 * 33], s[1 * 33], s[2 * 33], s[3 * 33]); o.y = pk4_fp8(s[4 * 33], s[5 * 33], s[6 * 33], s[7 * 33]);
        *(u32x2*)(WT + (size_t)(n0dst + n) * ldt + k0 + 8 * c) = o; }
    LDS_WAIT();
}
struct ColIdent { __device__ __forceinline__ int operator()(int n) const { return n; } };
struct ColWin { __device__ __forceinline__ int operator()(int n) const {
    if (n < 3584) return n; if (n < 4096) return n + 16; if (n < 4112) return n - 512; if (n < 4352) return -1;
    const int t = (n - 4352) >> 8, cl = (n - 4352) & 255; const int br = 2 * (cl >> 7) + ((cl >> 2) & 1), ch = 16 * ((cl >> 5) & 3) + 4 * ((cl >> 3) & 3) + (cl & 3);
    return 4112 + br * 2048 + 64 * t + ch; } };
struct ColWup { __device__ __forceinline__ int operator()(int n) const { const int blk = n >> 8, r = n & 255; return (r < 128) ? (blk * 128 + r) : (DFF + blk * 128 + (r - 128)); } };

__device__ __forceinline__ void rms_row_to_bf16(const float* xrow, const float* g, bf16_t* orow, int lane, unsigned char* orow8 = nullptr) {
    const f32x4* xr = (const f32x4*)xrow + lane; const f32x4* gr = (const f32x4*)g + lane;
    f32x4 v[8]; float s = 0.f;
#pragma unroll
    for (int j = 0; j < 8; ++j) { v[j] = xr[64 * j]; s += (v[j].x * v[j].x + v[j].y * v[j].y) + (v[j].z * v[j].z + v[j].w * v[j].w); }
    const float r = 1.0f / sqrtf(wave_sum(s, lane) * (1.f / D) + EPS);
    u32x2* o8 = (u32x2*)orow + lane;
#pragma unroll
    for (int j = 0; j < 8; ++j) { const f32x4 gg = gr[64 * j]; const float a = v[j].x * r * gg.x, b = v[j].y * r * gg.y, c = v[j].z * r * gg.z, d = v[j].w * r * gg.w; u32x2 w; w.x = pk2(a, b); w.y = pk2(c, d); o8[64 * j] = w;
        if (orow8) ((unsigned*)orow8)[lane + 64 * j] = pk4_fp8(a, b, c, d); }
}
__device__ __forceinline__ void rms_rows(Frame& F, const float* src, const float* g, bf16_t* dst, unsigned char* dst8 = nullptr) {
    const int gw = F.vcu * NWAVES + F.wave, NGW = F.G * NWAVES;
    for (int m = gw; m < M; m += NGW) rms_row_to_bf16(src + (size_t)m * D, g, dst + (size_t)m * D, F.lane, dst8 ? dst8 + (size_t)m * D : nullptr);
}
__device__ __forceinline__ void row_scale(Frame& F) {
    const int gt = F.vcu * (NWAVES * 64) + F.tid, NGT = F.G * NWAVES * 64;
    for (int m = gt; m < M; m += NGT) { float s = 0.f;
#pragma unroll
        for (int j = 0; j < 32; ++j) s += F.SS()[(size_t)j * M + m];
        const int r = m & 255;
        F.RS()[((size_t)((m >> 8) * 2 + ((r >> 6) & 1)) * 16 + (r & 15)) * 8 + (r >> 7) * 4 + ((r >> 4) & 3)] = 1.0f / sqrtf(s * (1.f / D) + EPS); }
}
__device__ __forceinline__ void rms_rows16(Frame& F, const bf16_t* src, const float* g, bf16_t* dst, unsigned char* dst8) {
    const int gw = F.vcu * NWAVES + F.wave, NGW = F.G * NWAVES, lane = F.lane;
    for (int m = gw; m < M; m += NGW) {
        const u32x4* xr = (const u32x4*)(src + (size_t)m * D) + lane; float v[4][8]; float s = 0.f;
#pragma unroll
        for (int j = 0; j < 4; ++j) { unpack8(xr[64 * j], v[j]);
#pragma unroll
            for (int q = 0; q < 8; ++q) s += v[j][q] * v[j][q]; }
        const float r = 1.0f / sqrtf(wave_sum(s, lane) * (1.f / D) + EPS);
        u32x4* o16 = (u32x4*)(dst + (size_t)m * D) + lane; u32x2* o8 = (u32x2*)(dst8 + (size_t)m * D) + lane;
#pragma unroll
        for (int j = 0; j < 4; ++j) { const f32x4 g0 = *((const f32x4*)g + 2 * (lane + 64 * j)), g1 = *((const f32x4*)g + 2 * (lane + 64 * j) + 1); float y[8];
            y[0] = v[j][0] * r * g0.x; y[1] = v[j][1] * r * g0.y; y[2] = v[j][2] * r * g0.z; y[3] = v[j][3] * r * g0.w; y[4] = v[j][4] * r * g1.x; y[5] = v[j][5] * r * g1.y; y[6] = v[j][6] * r * g1.z; y[7] = v[j][7] * r * g1.w;
            o16[64 * j] = pack8(y); u32x2 w8; w8.x = pk4_fp8(y[0], y[1], y[2], y[3]); w8.y = pk4_fp8(y[4], y[5], y[6], y[7]); o8[64 * j] = w8; }
    }
}
__device__ __forceinline__ void rms_rows16_to_f32(Frame& F, const bf16_t* src, const float* g, float* out) {
    const int gw = F.vcu * NWAVES + F.wave, NGW = F.G * NWAVES, lane = F.lane;
    for (int m = gw; m < M; m += NGW) {
        const u32x4* xr = (const u32x4*)(src + (size_t)m * D) + lane; float v[4][8]; float s = 0.f;
#pragma unroll
        for (int j = 0; j < 4; ++j) { unpack8(xr[64 * j], v[j]);
#pragma unroll
            for (int q = 0; q < 8; ++q) s += v[j][q] * v[j][q]; }
        const float r = 1.0f / sqrtf(wave_sum(s, lane) * (1.f / D) + EPS);
        f32x4* o = (f32x4*)(out + (size_t)m * D);
#pragma unroll
        for (int j = 0; j < 4; ++j) { const f32x4 g0 = *((const f32x4*)g + 2 * (lane + 64 * j)), g1 = *((const f32x4*)g + 2 * (lane + 64 * j) + 1);
            o[2 * (lane + 64 * j)] = (f32x4){v[j][0] * r * g0.x, v[j][1] * r * g0.y, v[j][2] * r * g0.z, v[j][3] * r * g0.w};
            o[2 * (lane + 64 * j) + 1] = (f32x4){v[j][4] * r * g1.x, v[j][5] * r * g1.y, v[j][6] * r * g1.z, v[j][7] * r * g1.w}; }
    }
}
__device__ __forceinline__ void rms_rows_f32_inplace(Frame& F, float* buf, const float* g) {
    const int gw = F.vcu * NWAVES + F.wave, NGW = F.G * NWAVES;
    for (int m = gw; m < M; m += NGW) {
        f32x4* xr = (f32x4*)(buf + (size_t)m * D) + F.lane; const f32x4* gr = (const f32x4*)g + F.lane;
        f32x4 v[8]; float s = 0.f;
#pragma unroll
        for (int j = 0; j < 8; ++j) { v[j] = xr[64 * j]; s += (v[j].x * v[j].x + v[j].y * v[j].y) + (v[j].z * v[j].z + v[j].w * v[j].w); }
        const float r = 1.0f / sqrtf(wave_sum(s, F.lane) * (1.f / D) + EPS);
#pragma unroll
        for (int j = 0; j < 8; ++j) { const f32x4 gg = gr[64 * j]; xr[64 * j] = (f32x4){v[j].x * r * gg.x, v[j].y * r * gg.y, v[j].z * r * gg.z, v[j].w * r * gg.w}; }
    }
}

__device__ __forceinline__ void phase_prep(Frame& F, int l) {
    LAS float* scr = (LAS float*)(F.lds + F.wave * 16384);
    const int gw = F.vcu * NWAVES + F.wave, NGW = F.G * NWAVES;
    constexpr int I_IN = (D / 64) * (NIN / 32), I_UP = (D / 64) * (NUP / 32), I_DN = (DFF / 64) * (D / 32), I_BR = 4 * (BW / 64) * (D / 32), I_OUT = (D / 64) * (D / 32), I_GLU = (BW / 64) * (BW / 32), I_PL = 4 * (128 / 64) * (128 / 32);
    constexpr int NITEMS = I_IN + I_UP + I_DN + I_BR + I_OUT + I_GLU + I_PL;
    for (int it = gw; it < NITEMS; it += NGW) {
        int r = it;
        if (r < I_IN) { const int nb = NIN / 32, n0 = 32 * (r % nb);
            if (n0 < C_GATE) transpose_item(F.w_in() + (size_t)l * D * NIN_SRC, NIN_SRC, F.win_t(), D, 0, 64 * (r / nb), n0, ColWin(), scr, F.lane);
            else transpose_item_fp8(F.w_in() + (size_t)l * D * NIN_SRC, NIN_SRC, F.W8(), D, 64 * (r / nb), n0, n0 - C_GATE, ColWin(), scr, F.lane, nullptr, 64.0f);
            continue; } r -= I_IN;
        if (r < I_UP) { const int nb = NUP / 32; transpose_item(F.w_up() + (size_t)l * D * NUP, NUP, F.wup_t(), D, 0, 64 * (r / nb), 32 * (r % nb), ColWup(), scr, F.lane, F.g_ffn() + (size_t)l * D); continue; } r -= I_UP;
        if (r < I_DN) { const int nb = D / 32; transpose_item(F.w_down() + (size_t)l * DFF * D, D, F.wdn_t(), DFF, 0, 64 * (r / nb), 32 * (r % nb), ColIdent(), scr, F.lane); continue; } r -= I_DN;
        if (r < I_BR) { const int per = (BW / 64) * (D / 32), br = r / per, q = r % per, nb = D / 32;
            transpose_item(F.w_branch() + ((size_t)l * 4 + br) * BW * D, D, F.wbr_t(), D, br * BW, 64 * (q / nb), 32 * (q % nb), ColIdent(), scr, F.lane); continue; } r -= I_BR;
        if (r < I_OUT) { const int nb = D / 32; transpose_item(F.w_out() + (size_t)l * D * D, D, F.wout_t(), D, 0, 64 * (r / nb), 32 * (r % nb), ColIdent(), scr, F.lane); continue; } r -= I_OUT;
        if (r < I_GLU) { const int nb = BW / 32; transpose_item(F.w_glu() + (size_t)l * BW * BW, BW, F.wglu_t(), BW, 0, 64 * (r / nb), 32 * (r % nb), ColIdent(), scr, F.lane); continue; } r -= I_GLU;
        { const int grp = r / 8, q = r % 8; transpose_item(F.pool_w() + ((size_t)l * 4 + grp) * 128 * 128, 128, F.poolw_t() + (size_t)grp * 128 * 128, 128, 0, 64 * (q / 4), 32 * (q % 4), ColIdent(), scr, F.lane); }
    }
    const int gt = F.vcu * (NWAVES * 64) + F.tid, NGT = F.G * NWAVES * 64;
    for (int i = gt; i < 32 * 64; i += NGT) {
        const int g = i >> 6;
        const float are = F.a_re()[(size_t)l * 2048 + i], aim = F.a_im()[(size_t)l * 2048 + i], dt = expf(F.log_dt()[l * 32 + g]);
        const float mag = expf(are * dt), th = aim * dt;
        const float abr = mag * cosf(th), abi = mag * sinf(th);
        const float den = are * are + aim * aim, nr = abr - 1.0f, ni = abi;
        const float fre = (nr * are + ni * aim) / den, fim = (ni * are - nr * aim) / den;
        F.abar()[2 * i] = abr; F.abar()[2 * i + 1] = abi;
        float pr = abr, pi = abi;
#pragma unroll
        for (int q = 0; q < 6; ++q) { const float tr = pr * pr - pi * pi, ti = 2.f * pr * pi; pr = tr; pi = ti; }
        F.apow()[2 * i] = pr; F.apow()[2 * i + 1] = pi;
        const float* br = F.b_re() + ((size_t)l * 2048 + i) * 16; const float* bi = F.b_im() + ((size_t)l * 2048 + i) * 16;
#pragma unroll
        for (int c = 0; c < 16; ++c) { const float x = br[c], y = bi[c]; const float vr = fre * x - fim * y, vi = fre * y + fim * x; const int p = i & 63;
            F.bbt()[((size_t)g * 128 + p) * 16 + c] = (bf16_t)f2bf(vr); F.bbt()[((size_t)g * 128 + 64 + p) * 16 + c] = (bf16_t)f2bf(vi); }
    }
    for (int i = gt; i < 32 * 16 * 128; i += NGT) {
        const int k = i & 127, gc = i >> 7;
        const float v = (k < 64) ? F.c_re()[((size_t)l * 512 + gc) * 64 + k] : -F.c_im()[((size_t)l * 512 + gc) * 64 + (k - 64)];
        F.cmt()[i] = (bf16_t)f2bf(v);
    }
    if (l == 0) {
        for (int i = gt; i < M * 32; i += NGT) {
            const int row = i >> 5, j = i & 31;
            const float inv = exp2f(-(float)j * (13.287712379549449f / 32.0f));
            const float ang = (float)F.pos()[row] * inv;
            F.rotc()[i] = cosf(ang); F.rots()[i] = sinf(ang);
        }
    }
    if (l == 0) rms_rows(F, F.x(), F.g_mix(), F.HN(), F.HN8()); else rms_rows16(F, (const bf16_t*)F.out, F.g_mix() + (size_t)l * D, F.HN(), F.HN8());
}

__device__ __forceinline__ void gr_pass(Frame& F) {
    const int gw = F.vcu * NWAVES + F.wave, NGW = F.G * NWAVES, lane = F.lane, lr = lane & 15, lq = lane >> 4;
    for (int unit = gw; unit < M / 16; unit += NGW) {
        const bf16_t* ap = F.HN() + (size_t)(16 * unit + lr) * D + 8 * lq; const bf16_t* bp = F.win_t() + (size_t)(C_GR + lr) * D + 8 * lq;
        f32x4 acc = (f32x4){0.f, 0.f, 0.f, 0.f};
#pragma unroll 1
        for (int kb = 0; kb < 64; kb += 8) { bf16x8 a[8], b[8];
#pragma unroll
            for (int j = 0; j < 8; ++j) { a[j] = *(const bf16x8*)(ap + 32 * (kb + j)); b[j] = *(const bf16x8*)(bp + 32 * (kb + j)); }
#pragma unroll
            for (int j = 0; j < 8; ++j) acc = __builtin_amdgcn_mfma_f32_16x16x32_bf16(a[j], b[j], acc, 0, 0, 0); }
#pragma unroll
        for (int i = 0; i < 4; ++i) F.PROJ()[(size_t)(16 * unit + 4 * lq + i) * LDP + C_GR + lr] = (bf16_t)f2bf(acc[i]);
    }
}

__device__ __forceinline__ f32x4 mma_nt_lds(const LAS bf16_t* X, int px, const LAS bf16_t* Y, int py, int ksteps, f32x4 acc, int lane) {
    const LAS bf16_t* xp = X + (lane & 15) * px + 8 * (lane >> 4);
    const LAS bf16_t* yp = Y + (lane & 15) * py + 8 * (lane >> 4);
    for (int ks = 0; ks < ksteps; ++ks) {
        const bf16x8 a = *(const LAS bf16x8*)(xp + 32 * ks), b = *(const LAS bf16x8*)(yp + 32 * ks);
        acc = __builtin_amdgcn_mfma_f32_16x16x32_bf16(a, b, acc, 0, 0, 0);
    }
    return acc;
}

constexpr int LN_TOT = 16384, LN_QD = 18432, LN_KI = 27648, LN_PM = 36864, LN_VT = 46080, LN_OB = 64512, LN_WG = 98304, LN_END = 98304 + 4096 + 256;
constexpr int LP = 72;
struct LinRaw { u32x4 q0, q1, k0, k1, v0, v1, g0, g1, gr0, gr1; f32x4 c0, c1, s0, s1; bf16x8 sp0, sp1; };
template <bool OUT>
__device__ __forceinline__ void lin_issue(Frame& F, int unit, LinRaw& R) {
    const int n = unit & 63, h = (unit >> 6) & 3, b = (unit >> 8) & 7, mixer = unit >> 11;
    const size_t row0 = (size_t)b * SEQ + (size_t)n * CH; const int s = F.tid >> 3, c = F.tid & 7;
    const int cq = (mixer == 0 ? C_RQ : C_GQ) + h * 64, ck = (mixer == 0 ? C_RK : C_GK) + h * 64, cv = (mixer == 0 ? C_RV : C_GV) + h * 128, cg = (mixer == 0 ? C_RG : C_GG) + h * 128;
    const bf16_t* pr = F.PROJ() + (row0 + s) * LDP;
    R.k0 = *(const u32x4*)(pr + ck + 8 * c); R.k1 = *(const u32x4*)(pr + ck + 8 * (c ^ 4));
    if (OUT) { R.q0 = *(const u32x4*)(pr + cq + 8 * c); R.q1 = *(const u32x4*)(pr + cq + 8 * (c ^ 4)); }
    { const float* cp = F.rotc() + (row0 + s) * 32 + (c & 3) * 8; const float* sp = F.rots() + (row0 + s) * 32 + (c & 3) * 8;
      R.c0 = *(const f32x4*)cp; R.c1 = *(const f32x4*)(cp + 4); R.s0 = *(const f32x4*)sp; R.s1 = *(const f32x4*)(sp + 4); }
    R.gr0 = *(const u32x4*)(pr + C_GR); R.gr1 = *(const u32x4*)(pr + C_GR + 8);
    R.v0 = *(const u32x4*)(F.PROJ() + (row0 + (F.tid >> 4)) * LDP + cv + (F.tid & 15) * 8);
    R.v1 = *(const u32x4*)(F.PROJ() + (row0 + 32 + (F.tid >> 4)) * LDP + cv + (F.tid & 15) * 8);
    if (OUT) { R.g0 = *(const u32x4*)(pr + cg + 16 * c); R.g1 = *(const u32x4*)(pr + cg + 16 * c + 8);
        const bf16_t* sq = F.SPREV() + (size_t)unit * 8192 + (size_t)(16 * F.wave + (F.lane & 15)) * 64 + 8 * (F.lane >> 4);
        R.sp0 = *(const bf16x8*)sq; R.sp1 = *(const bf16x8*)(sq + 32); }
}
__device__ __forceinline__ void lin_rot(const u32x4 own_, const u32x4 oth_, const LinRaw& R, bool rot, bool hi, float scale, float (&v)[8]) {
    float own[8]; unpack8(own_, own);
    if (!rot) {
#pragma unroll
        for (int j = 0; j < 8; ++j) v[j] = own[j] * scale;
        return; }
    float oth[8]; unpack8(oth_, oth);
    const float cs[8] = {R.c0.x, R.c0.y, R.c0.z, R.c0.w, R.c1.x, R.c1.y, R.c1.z, R.c1.w}, sn[8] = {R.s0.x, R.s0.y, R.s0.z, R.s0.w, R.s1.x, R.s1.y, R.s1.z, R.s1.w};
#pragma unroll
    for (int j = 0; j < 8; ++j) { const float os = oth[j] * sn[j]; v[j] = (own[j] * cs[j] + (hi ? os : -os)) * scale; }
}
__device__ __forceinline__ void lin_decay(Frame& F, int mixer, int h, const LinRaw& R, float (&bcum)[8], float (&blast)[8]) {
    LAS float* TOT = (LAS float*)(F.lds + LN_TOT);
    const int s = F.tid >> 3, c = F.tid & 7, d0 = 8 * c;
    if (mixer == 0) {
        const float lg = __logf(1.0f - exp2f(-5.0f - (float)h));
#pragma unroll
        for (int j = 0; j < 8; ++j) { bcum[j] = (float)(s + 1) * lg; blast[j] = 64.0f * lg; }
        lds_sync();
        return;
    }
    const LAS float* WG = (const LAS float*)(F.lds + LN_WG);
    float grf[16]; { float a[8], b2[8]; unpack8(R.gr0, a); unpack8(R.gr1, b2);
#pragma unroll
        for (int j = 0; j < 8; ++j) { grf[j] = a[j]; grf[8 + j] = b2[j]; } }
    float x[8]; { const f32x4 b0 = *(const LAS f32x4*)(WG + 1024 + d0), b1 = *(const LAS f32x4*)(WG + 1024 + d0 + 4); x[0] = b0.x; x[1] = b0.y; x[2] = b0.z; x[3] = b0.w; x[4] = b1.x; x[5] = b1.y; x[6] = b1.z; x[7] = b1.w; }
#pragma unroll
    for (int r = 0; r < 16; ++r) { const f32x4 w0 = *(const LAS f32x4*)(WG + r * 64 + d0), w1 = *(const LAS f32x4*)(WG + r * 64 + d0 + 4);
        x[0] += grf[r] * w0.x; x[1] += grf[r] * w0.y; x[2] += grf[r] * w0.z; x[3] += grf[r] * w0.w; x[4] += grf[r] * w1.x; x[5] += grf[r] * w1.y; x[6] += grf[r] * w1.z; x[7] += grf[r] * w1.w; }
#pragma unroll
    for (int j = 0; j < 8; ++j) x[j] = logsigmoidf_(x[j]) * (1.0f / 16.0f);
#pragma unroll
    for (int st = 8; st <= 32; st <<= 1) {
#pragma unroll
        for (int j = 0; j < 8; ++j) { const float t = lane_read(x[j], F.lane - st); if (F.lane >= st) x[j] += t; } }
    if ((F.lane >> 3) == 7) { *(LAS f32x4*)(TOT + F.wave * 64 + d0) = (f32x4){x[0], x[1], x[2], x[3]}; *(LAS f32x4*)(TOT + F.wave * 64 + d0 + 4) = (f32x4){x[4], x[5], x[6], x[7]}; }
    lds_sync();
    float off[8], tot[8];
#pragma unroll
    for (int j = 0; j < 8; ++j) { off[j] = 0.f; tot[j] = 0.f; }
#pragma unroll
    for (int w = 0; w < 8; ++w) { const f32x4 t0 = *(const LAS f32x4*)(TOT + w * 64 + d0), t1 = *(const LAS f32x4*)(TOT + w * 64 + d0 + 4); const float tv[8] = {t0.x, t0.y, t0.z, t0.w, t1.x, t1.y, t1.z, t1.w};
#pragma unroll
        for (int j = 0; j < 8; ++j) { tot[j] += tv[j]; off[j] += (w < F.wave) ? tv[j] : 0.f; } }
#pragma unroll
    for (int j = 0; j < 8; ++j) { bcum[j] = x[j] + off[j]; blast[j] = tot[j]; }
}
typedef short v4s_t __attribute__((ext_vector_type(4)));
__device__ __forceinline__ bf16x8 tr_frag(const LAS bf16_t* T, int pitch, int k0, int x0, int lane) {
    const int g = lane >> 4, i = lane & 15, q = i >> 2, p = i & 3;
    const LAS bf16_t* a = T + (k0 + 8 * g + q) * pitch + x0 + 4 * p;
    const v4s_t lo = __builtin_amdgcn_ds_read_tr16_b64_v4i16((LAS v4s_t*)a), hi = __builtin_amdgcn_ds_read_tr16_b64_v4i16((LAS v4s_t*)(a + 4 * pitch));
    return __builtin_shufflevector(lo, hi, 0, 1, 2, 3, 4, 5, 6, 7);
}
constexpr int PV = 144;
__device__ __forceinline__ void lin_store_vt(Frame& F, const LinRaw& R) {
    LAS bf16_t* VR = (LAS bf16_t*)(F.lds + LN_VT); const int e0 = (F.tid & 15) * 8;
    *(LAS u32x4*)(VR + (F.tid >> 4) * PV + e0) = R.v0; *(LAS u32x4*)(VR + (32 + (F.tid >> 4)) * PV + e0) = R.v1;
}
__device__ __forceinline__ void lin_state_compute(Frame& F, int unit, const LinRaw& R) {
    const int h = (unit >> 6) & 3, mixer = unit >> 11; const int s = F.tid >> 3, c = F.tid & 7, d0 = 8 * c;
    LAS bf16_t* KDT = (LAS bf16_t*)(F.lds + LN_KI); LAS bf16_t* VT = (LAS bf16_t*)(F.lds + LN_VT);
    float k[8], bcum[8], blast[8];
    lin_rot(R.k0, R.k1, R, mixer == 0, c >= 4, mixer == 0 ? 0.125f : 1.0f, k);
    lin_decay(F, mixer, h, R, bcum, blast);
    { float kd[8];
#pragma unroll
      for (int j = 0; j < 8; ++j) kd[j] = k[j] * __expf(blast[j] - bcum[j]);
      *(LAS u32x4*)(KDT + s * LP + d0) = pack8(kd); }
    lin_store_vt(F, R);
    if (s == 0) { float* dc = F.DEC() + (size_t)unit * 64 + d0;
        *(f32x4*)dc = (f32x4){__expf(blast[0]), __expf(blast[1]), __expf(blast[2]), __expf(blast[3])}; *(f32x4*)(dc + 4) = (f32x4){__expf(blast[4]), __expf(blast[5]), __expf(blast[6]), __expf(blast[7])}; }
    lds_sync();
    { const int w = F.wave, lane = F.lane; float* st = F.STATE() + (size_t)unit * 8192;
      const bf16x8 vf0 = tr_frag(VT, PV, 0, 16 * w, lane), vf1 = tr_frag(VT, PV, 32, 16 * w, lane);
#pragma unroll
      for (int dt = 0; dt < 4; ++dt) { f32x4 acc = (f32x4){0.f, 0.f, 0.f, 0.f};
          acc = __builtin_amdgcn_mfma_f32_16x16x32_bf16(vf0, tr_frag(KDT, LP, 0, 16 * dt, lane), acc, 0, 0, 0);
          acc = __builtin_amdgcn_mfma_f32_16x16x32_bf16(vf1, tr_frag(KDT, LP, 32, 16 * dt, lane), acc, 0, 0, 0);
#pragma unroll
          for (int i = 0; i < 4; ++i) st[(16 * w + 4 * (lane >> 4) + i) * 64 + 16 * dt + (lane & 15)] = acc[i]; } }
}
__device__ __forceinline__ void lin_out_compute(Frame& F, int unit, const LinRaw& R) {
    const int n = unit & 63, h = (unit >> 6) & 3, b = (unit >> 8) & 7, mixer = unit >> 11;
    const size_t row0 = (size_t)b * SEQ + (size_t)n * CH; const int s = F.tid >> 3, c = F.tid & 7, d0 = 8 * c;
    const int ycol = (mixer == 0 ? 0 : 1024) + h * 128;
    LAS bf16_t* QD = (LAS bf16_t*)(F.lds + LN_QD); LAS bf16_t* KI = (LAS bf16_t*)(F.lds + LN_KI); LAS bf16_t* PM = (LAS bf16_t*)(F.lds + LN_PM);
    LAS bf16_t* VT = (LAS bf16_t*)(F.lds + LN_VT); LAS float* OB = (LAS float*)(F.lds + LN_OB);
    float q[8], k[8], bcum[8], blast[8];
    lin_rot(R.q0, R.q1, R, mixer == 0, c >= 4, mixer == 0 ? 1.0f : 0.125f, q);
    lin_rot(R.k0, R.k1, R, mixer == 0, c >= 4, mixer == 0 ? 0.125f : 1.0f, k);
    lin_decay(F, mixer, h, R, bcum, blast);
    { float qd[8], ki[8];
#pragma unroll
      for (int j = 0; j < 8; ++j) { qd[j] = q[j] * __expf(bcum[j]); ki[j] = k[j] * __expf(-bcum[j]); }
      *(LAS u32x4*)(QD + s * LP + d0) = pack8(qd); *(LAS u32x4*)(KI + s * LP + d0) = pack8(ki); }
    lin_store_vt(F, R);
    lds_sync();
    { const int lane = F.lane;
#pragma unroll
      for (int j = 0; j < 2; ++j) { const int tile = 2 * F.wave + j, tt = tile >> 2, st = tile & 3;
          f32x4 acc = (f32x4){0.f, 0.f, 0.f, 0.f};
          if (st <= tt) acc = mma_nt_lds(QD + 16 * tt * LP, LP, KI + 16 * st * LP, LP, 2, acc, lane);
#pragma unroll
          for (int i = 0; i < 4; ++i) { const int t = 16 * tt + 4 * (lane >> 4) + i, s2 = 16 * st + (lane & 15); const float p = (st <= tt && s2 <= t) ? acc[i] : 0.f; PM[t * LP + s2] = (bf16_t)f2bf(p); } } }
    lds_sync();
    { const int w = F.wave, lane = F.lane;
      const bf16x8 vf0 = tr_frag(VT, PV, 0, 16 * w, lane), vf1 = tr_frag(VT, PV, 32, 16 * w, lane);
#pragma unroll
      for (int tt = 0; tt < 4; ++tt) { f32x4 acc = (f32x4){0.f, 0.f, 0.f, 0.f};
          { const LAS bf16_t* pp = PM + (16 * tt + (lane & 15)) * LP + 8 * (lane >> 4);
            acc = __builtin_amdgcn_mfma_f32_16x16x32_bf16(*(const LAS bf16x8*)pp, vf0, acc, 0, 0, 0);
            acc = __builtin_amdgcn_mfma_f32_16x16x32_bf16(*(const LAS bf16x8*)(pp + 32), vf1, acc, 0, 0, 0); }
          const LAS bf16_t* xp = QD + (16 * tt + (lane & 15)) * LP + 8 * (lane >> 4);
          acc = __builtin_amdgcn_mfma_f32_16x16x32_bf16(*(const LAS bf16x8*)xp, R.sp0, acc, 0, 0, 0);
          acc = __builtin_amdgcn_mfma_f32_16x16x32_bf16(*(const LAS bf16x8*)(xp + 32), R.sp1, acc, 0, 0, 0);
#pragma unroll
          for (int i = 0; i < 4; ++i) OB[(16 * tt + 4 * (lane >> 4) + i) * 132 + 16 * w + (lane & 15)] = acc[i]; } }
    lds_sync();
    { const int t = s, part = c; float o[16];
#pragma unroll
      for (int j = 0; j < 4; ++j) { const f32x4 v = *(const LAS f32x4*)(OB + t * 132 + 16 * part + 4 * j); o[4 * j] = v.x; o[4 * j + 1] = v.y; o[4 * j + 2] = v.z; o[4 * j + 3] = v.w; }
      float sm = 0.f;
#pragma unroll
      for (int j = 0; j < 16; ++j) sm += o[j];
      sm += lane_read(sm, F.lane ^ 1); sm += lane_read(sm, F.lane ^ 2); sm += lane_read(sm, F.lane ^ 4);
      const float mu = sm * (1.0f / 128.0f); float qv = 0.f;
#pragma unroll
      for (int j = 0; j < 16; ++j) { const float dlt = o[j] - mu; qv += dlt * dlt; }
      qv += lane_read(qv, F.lane ^ 1); qv += lane_read(qv, F.lane ^ 2); qv += lane_read(qv, F.lane ^ 4);
      const float r = 1.0f / sqrtf(qv * (1.0f / 128.0f) + EPS);
      float g0[8], g1[8]; unpack8(R.g0, g0); unpack8(R.g1, g1);
      float y0[8], y1[8];
#pragma unroll
      for (int j = 0; j < 8; ++j) { y0[j] = (o[j] - mu) * r * siluf_(g0[j]); y1[j] = (o[8 + j] - mu) * r * siluf_(g1[j]); }
      bf16_t* yp = F.Y() + (row0 + t) * D + ycol + 16 * part; *(u32x4*)yp = pack8(y0); *(u32x4*)(yp + 8) = pack8(y1); }
}
template <bool OUT>
__device__ __forceinline__ void lin_phase(Frame& F, int l) {
    { const int h = (F.vcu >> 6) & 3; LAS float* WG = (LAS float*)(F.lds + LN_WG);
      for (int i = F.tid; i < 16 * 64 + 64; i += NWAVES * 64) WG[i] = (i < 1024) ? F.gla_wg()[(size_t)l * 16 * 256 + (i >> 6) * 256 + h * 64 + (i & 63)] : F.gla_bg()[l * 256 + h * 64 + (i - 1024)];
      lds_sync(); }
    LinRaw A, B;
    lin_issue<OUT>(F, F.vcu, A);
    for (int u = F.vcu; u < 4096; u += 2 * F.G) {
        lin_issue<OUT>(F, u + F.G, B);
        if (OUT) lin_out_compute(F, u, A); else lin_state_compute(F, u, A);
        if (u + 2 * F.G < 4096) lin_issue<OUT>(F, u + 2 * F.G, A);
        if (OUT) lin_out_compute(F, u + F.G, B); else lin_state_compute(F, u + F.G, B);
    }
    lds_sync();
}
constexpr int L2_TOT = 0, L2_QD = 1024, L2_KI = 10240, L2_V = 19456, L2_SP = 37888, L2_PM = 56320, L2_STRIDE = 65536, L2_WG = 131072;
struct Lin2 { int unit, h, mixer, hw, s, c; size_t row0; LAS unsigned char* base; };
__device__ __forceinline__ void lin2_rot16(const u32x4 lo_, const u32x4 hi_, const f32x4 (&cs)[2], const f32x4 (&sn)[2], bool rot, float scale, float (&v)[16]) {
    float lo[8], hi[8]; unpack8(lo_, lo); unpack8(hi_, hi);
    if (!rot) {
#pragma unroll
        for (int j = 0; j < 8; ++j) { v[j] = lo[j] * scale; v[8 + j] = hi[j] * scale; }
    } else {
        const float c8[8] = {cs[0].x, cs[0].y, cs[0].z, cs[0].w, cs[1].x, cs[1].y, cs[1].z, cs[1].w}, s8[8] = {sn[0].x, sn[0].y, sn[0].z, sn[0].w, sn[1].x, sn[1].y, sn[1].z, sn[1].w};
#pragma unroll
        for (int j = 0; j < 8; ++j) { v[j] = (lo[j] * c8[j] - hi[j] * s8[j]) * scale; v[8 + j] = (hi[j] * c8[j] + lo[j] * s8[j]) * scale; }
    }
}
__device__ __forceinline__ void lin2_decay(Frame& F, const Lin2& L, const u32x4 gr0, const u32x4 gr1, float (&bcum)[16], float (&blast)[16]) {
    LAS float* TOT = (LAS float*)(L.base + L2_TOT);
    const int d0 = 8 * L.c;
    if (L.mixer == 0) {
        const float lg = __logf(1.0f - exp2f(-5.0f - (float)L.h));
#pragma unroll
        for (int j = 0; j < 16; ++j) { bcum[j] = (float)(L.s + 1) * lg; blast[j] = 64.0f * lg; }
        lds_sync();
        return;
    }
    const LAS float* WG = (const LAS float*)(F.lds + L2_WG);
    float grf[16]; { float a[8], b2[8]; unpack8(gr0, a); unpack8(gr1, b2);
#pragma unroll
        for (int j = 0; j < 8; ++j) { grf[j] = a[j]; grf[8 + j] = b2[j]; } }
    float x[16];
#pragma unroll
    for (int q = 0; q < 4; ++q) { const f32x4 b0 = *(const LAS f32x4*)(WG + 1024 + d0 + 32 * (q >> 1) + 4 * (q & 1)); x[4 * q] = b0.x; x[4 * q + 1] = b0.y; x[4 * q + 2] = b0.z; x[4 * q + 3] = b0.w; }
#pragma unroll
    for (int r = 0; r < 16; ++r) {
#pragma unroll
        for (int q = 0; q < 4; ++q) { const f32x4 w0 = *(const LAS f32x4*)(WG + r * 64 + d0 + 32 * (q >> 1) + 4 * (q & 1));
            x[4 * q] += grf[r] * w0.x; x[4 * q + 1] += grf[r] * w0.y; x[4 * q + 2] += grf[r] * w0.z; x[4 * q + 3] += grf[r] * w0.w; } }
#pragma unroll
    for (int j = 0; j < 16; ++j) x[j] = logsigmoidf_(x[j]) * (1.0f / 16.0f);
#pragma unroll
    for (int st = 4; st <= 32; st <<= 1) {
#pragma unroll
        for (int j = 0; j < 16; ++j) { const float t = lane_read(x[j], F.lane - st); if (F.lane >= st) x[j] += t; } }
    if ((F.lane >> 2) == 15) {
#pragma unroll
        for (int q = 0; q < 4; ++q) *(LAS f32x4*)(TOT + L.hw * 64 + d0 + 32 * (q >> 1) + 4 * (q & 1)) = (f32x4){x[4 * q], x[4 * q + 1], x[4 * q + 2], x[4 * q + 3]}; }
    lds_sync();
    float off[16], tot[16];
#pragma unroll
    for (int j = 0; j < 16; ++j) { off[j] = 0.f; tot[j] = 0.f; }
#pragma unroll
    for (int w = 0; w < 4; ++w) {
#pragma unroll
        for (int q = 0; q < 4; ++q) { const f32x4 t0 = *(const LAS f32x4*)(TOT + w * 64 + d0 + 32 * (q >> 1) + 4 * (q & 1)); const float tv[4] = {t0.x, t0.y, t0.z, t0.w};
#pragma unroll
            for (int j = 0; j < 4; ++j) { tot[4 * q + j] += tv[j]; off[4 * q + j] += (w < L.hw) ? tv[j] : 0.f; } } }
#pragma unroll
    for (int j = 0; j < 16; ++j) { bcum[j] = x[j] + off[j]; blast[j] = tot[j]; }
}
__device__ __forceinline__ bf16x8 tr_frag8(const LAS bf16_t* T, int pitch, int k0, int x0, int lane) {
    const int g = lane >> 4, i = lane & 15, q = i >> 2, p = i & 3;
    const LAS bf16_t* a = T + (k0 + 8 * g + q) * pitch + x0 + 8 * p;
    const v4s_t lo = __builtin_amdgcn_ds_read_tr16_b64_v4i16((LAS v4s_t*)a), hi = __builtin_amdgcn_ds_read_tr16_b64_v4i16((LAS v4s_t*)(a + 4 * pitch));
    return __builtin_shufflevector(lo, hi, 0, 1, 2, 3, 4, 5, 6, 7);
}
__device__ __forceinline__ void lin2_state(Frame& F, const Lin2& L) {
    const int ht = F.tid & 255, lane = F.lane, s = L.s, c = L.c, d0 = 8 * c;
    const int ck = (L.mixer == 0 ? C_RK : C_GK) + L.h * 64, cv = (L.mixer == 0 ? C_RV : C_GV) + L.h * 128;
    LAS bf16_t* KD = (LAS bf16_t*)(L.base + L2_KI); LAS bf16_t* VT = (LAS bf16_t*)(L.base + L2_V);
    const bf16_t* pr = F.PROJ() + (L.row0 + s) * LDP;
    u32x4 vv[4]; f32x4 cs[2], sn[2];
    const u32x4 klo = *(const u32x4*)(pr + ck + d0), khi = *(const u32x4*)(pr + ck + 32 + d0);
    { const float* cp = F.rotc() + (L.row0 + s) * 32 + d0; const float* sp = F.rots() + (L.row0 + s) * 32 + d0;
      cs[0] = *(const f32x4*)cp; cs[1] = *(const f32x4*)(cp + 4); sn[0] = *(const f32x4*)sp; sn[1] = *(const f32x4*)(sp + 4); }
    const u32x4 gr0 = *(const u32x4*)(pr + C_GR), gr1 = *(const u32x4*)(pr + C_GR + 8);
#pragma unroll
    for (int i = 0; i < 4; ++i) { const int idx = ht + 256 * i; vv[i] = *(const u32x4*)(F.PROJ() + (L.row0 + (idx >> 4)) * LDP + cv + (idx & 15) * 8); }
    float k[16], bcum[16], blast[16];
    lin2_rot16(klo, khi, cs, sn, L.mixer == 0, L.mixer == 0 ? 0.125f : 1.0f, k);
    lin2_decay(F, L, gr0, gr1, bcum, blast);
#pragma unroll
    for (int g = 0; g < 2; ++g) { float kd[8];
#pragma unroll
        for (int j = 0; j < 8; ++j) kd[j] = k[8 * g + j] * __expf(blast[8 * g + j] - bcum[8 * g + j]);
        *(LAS u32x4*)(KD + s * LP + d0 + 32 * g) = pack8(kd); }
#pragma unroll
    for (int i = 0; i < 4; ++i) { const int idx = ht + 256 * i; *(LAS u32x4*)(VT + (idx >> 4) * PV + (idx & 15) * 8) = vv[i]; }
    if (s == 0) { float* dc = F.DEC() + (size_t)L.unit * 64 + d0;
#pragma unroll
        for (int q = 0; q < 4; ++q) *(f32x4*)(dc + 32 * (q >> 1) + 4 * (q & 1)) = (f32x4){__expf(blast[4 * q]), __expf(blast[4 * q + 1]), __expf(blast[4 * q + 2]), __expf(blast[4 * q + 3])}; }
    lds_sync();
    { float* st = F.STATE() + (size_t)L.unit * 8192;
      const bf16x8 kf0 = tr_frag(KD, LP, 0, 16 * L.hw, lane), kf1 = tr_frag(KD, LP, 32, 16 * L.hw, lane);
#pragma unroll
      for (int et = 0; et < 8; ++et) { f32x4 acc = (f32x4){0.f, 0.f, 0.f, 0.f};
          acc = __builtin_amdgcn_mfma_f32_16x16x32_bf16(kf0, tr_frag(VT, PV, 0, 16 * et, lane), acc, 0, 0, 0);
          acc = __builtin_amdgcn_mfma_f32_16x16x32_bf16(kf1, tr_frag(VT, PV, 32, 16 * et, lane), acc, 0, 0, 0);
          *(f32x4*)(st + (16 * et + (lane & 15)) * 64 + 16 * L.hw + 4 * (lane >> 4)) = acc; } }
}
__device__ __forceinline__ void lin2_out(Frame& F, const Lin2& L) {
    const int ht = F.tid & 255, lane = F.lane, lr = lane & 15, lq = lane >> 4, s = L.s, c = L.c, d0 = 8 * c;
    const int cq = (L.mixer == 0 ? C_RQ : C_GQ) + L.h * 64, ck = (L.mixer == 0 ? C_RK : C_GK) + L.h * 64, cv = (L.mixer == 0 ? C_RV : C_GV) + L.h * 128, cg = (L.mixer == 0 ? C_RG : C_GG) + L.h * 128;
    const int ycol = (L.mixer == 0 ? 0 : 1024) + L.h * 128;
    LAS bf16_t* QD = (LAS bf16_t*)(L.base + L2_QD); LAS bf16_t* KI = (LAS bf16_t*)(L.base + L2_KI); LAS bf16_t* VT = (LAS bf16_t*)(L.base + L2_V);
    LAS bf16_t* SP = (LAS bf16_t*)(L.base + L2_SP); LAS bf16_t* PM = (LAS bf16_t*)(L.base + L2_PM + L.hw * 2304);
    const bf16_t* pr = F.PROJ() + (L.row0 + s) * LDP;
    float q[16], k[16], bcum[16], blast[16];
    u32x4 vv[4], sv[4]; u32x4 gr0, gr1;
    { f32x4 cs[2], sn[2];
      const u32x4 klo = *(const u32x4*)(pr + ck + d0), khi = *(const u32x4*)(pr + ck + 32 + d0), qlo = *(const u32x4*)(pr + cq + d0), qhi = *(const u32x4*)(pr + cq + 32 + d0);
      { const float* cp = F.rotc() + (L.row0 + s) * 32 + d0; const float* sp = F.rots() + (L.row0 + s) * 32 + d0;
        cs[0] = *(const f32x4*)cp; cs[1] = *(const f32x4*)(cp + 4); sn[0] = *(const f32x4*)sp; sn[1] = *(const f32x4*)(sp + 4); }
      gr0 = *(const u32x4*)(pr + C_GR); gr1 = *(const u32x4*)(pr + C_GR + 8);
#pragma unroll
      for (int i = 0; i < 4; ++i) { const int idx = ht + 256 * i; vv[i] = *(const u32x4*)(F.PROJ() + (L.row0 + (idx >> 4)) * LDP + cv + (idx & 15) * 8);
          sv[i] = *(const u32x4*)(F.SPREV() + (size_t)L.unit * 8192 + (size_t)idx * 8); }
      lin2_rot16(qlo, qhi, cs, sn, L.mixer == 0, L.mixer == 0 ? 1.0f : 0.125f, q);
      lin2_rot16(klo, khi, cs, sn, L.mixer == 0, L.mixer == 0 ? 0.125f : 1.0f, k); }
    lin2_decay(F, L, gr0, gr1, bcum, blast);
#pragma unroll
    for (int g = 0; g < 2; ++g) { float qd[8], ki[8];
#pragma unroll
        for (int j = 0; j < 8; ++j) { qd[j] = q[8 * g + j] * __expf(bcum[8 * g + j]); ki[j] = k[8 * g + j] * __expf(-bcum[8 * g + j]); }
        *(LAS u32x4*)(QD + s * LP + d0 + 32 * g) = pack8(qd); *(LAS u32x4*)(KI + s * LP + d0 + 32 * g) = pack8(ki); }
#pragma unroll
    for (int i = 0; i < 4; ++i) { const int idx = ht + 256 * i; *(LAS u32x4*)(VT + (idx >> 4) * PV + (idx & 15) * 8) = vv[i]; *(LAS u32x4*)(SP + (idx >> 3) * LP + (idx & 7) * 8) = sv[i]; }
    const bf16_t* gp = F.PROJ() + (L.row0 + 16 * L.hw + lr) * LDP + cg + 8 * lq;
    u32x4 gt[4];
#pragma unroll
    for (int pe = 0; pe < 4; ++pe) gt[pe] = *(const u32x4*)(gp + 32 * pe);
    lds_sync();
    const LAS bf16_t* qrow = QD + (16 * L.hw + lr) * LP + 8 * lq;
    const bf16x8 qf0 = *(const LAS bf16x8*)qrow, qf1 = *(const LAS bf16x8*)(qrow + 32);
#pragma unroll
    for (int st = 0; st < 4; ++st) {
        f32x4 acc = (f32x4){0.f, 0.f, 0.f, 0.f};
        if (st <= L.hw) { const LAS bf16_t* krow = KI + (16 * st + lr) * LP + 8 * lq;
            acc = __builtin_amdgcn_mfma_f32_16x16x32_bf16(*(const LAS bf16x8*)krow, qf0, acc, 0, 0, 0);
            acc = __builtin_amdgcn_mfma_f32_16x16x32_bf16(*(const LAS bf16x8*)(krow + 32), qf1, acc, 0, 0, 0); }
        float p[4];
#pragma unroll
        for (int i = 0; i < 4; ++i) p[i] = (st <= L.hw && 16 * st + 4 * lq + i <= 16 * L.hw + lr) ? acc[i] : 0.f;
        u32x2 w; w.x = pk2(p[0], p[1]); w.y = pk2(p[2], p[3]);
        *(LAS u32x2*)(PM + lr * LP + 16 * st + 4 * lq) = w; }
    asm volatile("s_waitcnt lgkmcnt(0)" ::: "memory");
    const bf16x8 pf0 = *(const LAS bf16x8*)(PM + lr * LP + 8 * lq), pf1 = *(const LAS bf16x8*)(PM + lr * LP + 32 + 8 * lq);
    f32x4 o[8];
    const int erow = 8 * (lr >> 2) + (lr & 3);
#pragma unroll
    for (int et = 0; et < 8; ++et) { const int e0 = 32 * (et >> 1) + 4 * (et & 1); f32x4 acc = (f32x4){0.f, 0.f, 0.f, 0.f};
        acc = __builtin_amdgcn_mfma_f32_16x16x32_bf16(tr_frag8(VT, PV, 0, e0, lane), pf0, acc, 0, 0, 0);
        acc = __builtin_amdgcn_mfma_f32_16x16x32_bf16(tr_frag8(VT, PV, 32, e0, lane), pf1, acc, 0, 0, 0);
        const LAS bf16_t* srow = SP + (e0 + erow) * LP + 8 * lq;
        acc = __builtin_amdgcn_mfma_f32_16x16x32_bf16(*(const LAS bf16x8*)srow, qf0, acc, 0, 0, 0);
        acc = __builtin_amdgcn_mfma_f32_16x16x32_bf16(*(const LAS bf16x8*)(srow + 32), qf1, acc, 0, 0, 0);
        o[et] = acc; }
    float sm = 0.f;
#pragma unroll
    for (int et = 0; et < 8; ++et) sm += (o[et][0] + o[et][1]) + (o[et][2] + o[et][3]);
    sm += lane_read(sm, lane ^ 16); sm += lane_read(sm, lane ^ 32);
    const float mu = sm * (1.0f / 128.0f); float qv = 0.f;
#pragma unroll
    for (int et = 0; et < 8; ++et) {
#pragma unroll
        for (int i = 0; i < 4; ++i) { const float dlt = o[et][i] - mu; qv += dlt * dlt; } }
    qv += lane_read(qv, lane ^ 16); qv += lane_read(qv, lane ^ 32);
    const float r = 1.0f / sqrtf(qv * (1.0f / 128.0f) + EPS);
    bf16_t* yp = F.Y() + (L.row0 + 16 * L.hw + lr) * D + ycol + 8 * lq;
#pragma unroll
    for (int pe = 0; pe < 4; ++pe) { float g[8], y[8]; unpack8(gt[pe], g);
#pragma unroll
        for (int j = 0; j < 8; ++j) y[j] = (o[2 * pe + (j >> 2)][j & 3] - mu) * r * siluf_(g[j]);
        *(u32x4*)(yp + 32 * pe) = pack8(y); }
}
template <bool OUT>
__device__ __forceinline__ void lin2_phase(Frame& F, int l) {
    { const int h = (F.vcu >> 6) & 3; LAS float* WG = (LAS float*)(F.lds + L2_WG);
      for (int i = F.tid; i < 16 * 64 + 64; i += NWAVES * 64) WG[i] = (i < 1024) ? F.gla_wg()[(size_t)l * 16 * 256 + (i >> 6) * 256 + h * 64 + (i & 63)] : F.gla_bg()[l * 256 + h * 64 + (i - 1024)];
      lds_sync(); }
    const int half = F.wave >> 2;
#pragma unroll 1
    for (int j = 0; j < 8; ++j) {
        Lin2 L; L.unit = F.vcu + 256 * (2 * j + half); L.h = (L.unit >> 6) & 3; asm volatile("" : "+s"(L.h)); L.mixer = L.unit >> 11; L.hw = F.wave & 3; L.s = (F.tid & 255) >> 2; L.c = F.tid & 3;
        L.row0 = (size_t)((L.unit >> 8) & 7) * SEQ + (size_t)(L.unit & 63) * CH; L.base = F.lds + half * L2_STRIDE;
        if (OUT) lin2_out(F, L); else lin2_state(F, L);
    }
    lds_sync();
}
__device__ __forceinline__ void lin_scan(Frame& F) {
    const int gt = F.vcu * (NWAVES * 64) + F.tid, NGT = F.G * NWAVES * 64;
    for (int i = gt; i < 64 * 8192; i += NGT) {
        const int seq = i >> 13, idx = i & 8191, d = idx & 63;
        const float* st = F.STATE() + (size_t)seq * NCH * 8192 + idx; const float* dc = F.DEC() + (size_t)seq * NCH * 64 + d; bf16_t* sp = F.SPREV() + (size_t)seq * NCH * 8192 + idx;
        float carry = 0.f; asm volatile("" : "+v"(carry));
#pragma unroll
        for (int h = 0; h < 2; ++h) {
            float v[32], c[32];
#pragma unroll
            for (int n = 0; n < 32; ++n) { v[n] = st[(size_t)(32 * h + n) * 8192]; c[n] = dc[(size_t)(32 * h + n) * 64]; }
#pragma unroll
            for (int n = 0; n < 32; ++n) { sp[(size_t)(32 * h + n) * 8192] = (bf16_t)f2bf(carry); carry = c[n] * carry + v[n]; asm volatile("" : "+v"(carry)); }
        }
    }
}
constexpr int S5_WL = 16384, S5_BU = 2048, S5_X = 2048 + 8320;
template <bool OUT>
__device__ __forceinline__ void s5_pass(Frame& F, int l) {
    LAS bf16_t* UT = (LAS bf16_t*)(F.lds + F.wave * S5_WL); LAS float* BU = (LAS float*)(F.lds + F.wave * S5_WL + S5_BU); LAS bf16_t* X = (LAS bf16_t*)(F.lds + F.wave * S5_WL + S5_X);
    const int gw = F.vcu * NWAVES + F.wave, NGW = F.G * NWAVES, lane = F.lane, lr = lane & 15, lq = lane >> 4;
    u32x4 ua, uc;
    { const int g = gw & 31, n = (gw >> 5) & 63, b = gw >> 11; const bf16_t* up = F.PROJ() + ((size_t)b * SEQ + (size_t)n * CH + lane) * LDP + C_SU + g * 16; ua = *(const u32x4*)up; uc = *(const u32x4*)(up + 8); }
    for (int unit = gw; unit < BATCH * NCH * 32; unit += NGW) {
        const int g = unit & 31, n = (unit >> 5) & 63, b = unit >> 11; const size_t row0 = (size_t)b * SEQ + (size_t)n * CH;
        *(LAS u32x4*)(UT + lane * 16) = ua; *(LAS u32x4*)(UT + lane * 16 + 8) = uc;
        if (unit + NGW < BATCH * NCH * 32) { const int un = unit + NGW, g2 = un & 31, n2 = (un >> 5) & 63, b2 = un >> 11;
            const bf16_t* up = F.PROJ() + ((size_t)b2 * SEQ + (size_t)n2 * CH + lane) * LDP + C_SU + g2 * 16; ua = *(const u32x4*)up; uc = *(const u32x4*)(up + 8); }
        const int gp = g * 64 + lane; const float ar = F.abar()[2 * gp], ai = F.abar()[2 * gp + 1];
        bf16x8 bfr[8];
#pragma unroll
        for (int q = 0; q < 8; ++q) { bfr[q] = (bf16x8){0, 0, 0, 0, 0, 0, 0, 0}; if (lq < 2) bfr[q] = *(const bf16x8*)(F.bbt() + ((size_t)g * 128 + 16 * q + lr) * 16 + 8 * lq); }
        float xr = 0.f, xi = 0.f;
        bf16x8 cf[4]; float dsk = 0.f;
        if (OUT) { const f32x2 x0 = *(const f32x2*)(F.XEND() + ((((size_t)(b * 32 + g)) * NCH + n) * 64 + lane) * 2); xr = x0.x; xi = x0.y;
#pragma unroll
            for (int ks = 0; ks < 4; ++ks) cf[ks] = *(const bf16x8*)(F.cmt() + ((size_t)(g * 16 + lr)) * 128 + 32 * ks + 8 * lq);
            dsk = F.s5_d()[(size_t)l * BW + g * 16 + lr]; }
        LDS_WAIT();
        for (int sb = 0; sb < 4; ++sb) {
            bf16x8 af = (bf16x8){0, 0, 0, 0, 0, 0, 0, 0}; if (lq < 2) af = *(const LAS bf16x8*)(UT + (16 * sb + lr) * 16 + 8 * lq);
#pragma unroll
            for (int q = 0; q < 8; ++q) { f32x4 acc = (f32x4){0.f, 0.f, 0.f, 0.f}; acc = __builtin_amdgcn_mfma_f32_16x16x32_bf16(af, bfr[q], acc, 0, 0, 0);
#pragma unroll
                for (int i = 0; i < 4; ++i) BU[(4 * lq + i) * 130 + 16 * q + lr] = acc[i]; }
            LDS_WAIT();
            float br[16], bi[16];
#pragma unroll
            for (int tt = 0; tt < 16; ++tt) { br[tt] = BU[tt * 130 + lane]; bi[tt] = BU[tt * 130 + 64 + lane]; }
#pragma unroll
            for (int tt = 0; tt < 16; ++tt) { const float nr = ar * xr - ai * xi + br[tt], ni = ar * xi + ai * xr + bi[tt]; xr = nr; xi = ni; asm volatile("" : "+v"(xr), "+v"(xi));
                if (OUT) { X[tt * 136 + lane] = (bf16_t)f2bf(xr); X[tt * 136 + 64 + lane] = (bf16_t)f2bf(xi); } }
            if (OUT) {
                LDS_WAIT();
                f32x4 acc = (f32x4){0.f, 0.f, 0.f, 0.f}; const LAS bf16_t* xp = X + lr * 136 + 8 * lq;
#pragma unroll
                for (int ks = 0; ks < 4; ++ks) acc = __builtin_amdgcn_mfma_f32_16x16x32_bf16(*(const LAS bf16x8*)(xp + 32 * ks), cf[ks], acc, 0, 0, 0);
#pragma unroll
                for (int i = 0; i < 4; ++i) { const int tl = 16 * sb + 4 * lq + i; const float u = bflo((unsigned)UT[tl * 16 + lr]); const float y = gelu_tanh(acc[i] + dsk * u);
                    F.YBP()[(row0 + tl) * BW + g * 16 + lr] = (bf16_t)f2bf(y); }
            }
            LDS_WAIT();
        }
        if (!OUT) *(f32x2*)(F.XEND() + ((((size_t)(b * 32 + g)) * NCH + n) * 64 + lane) * 2) = (f32x2){xr, xi};
    }
}
__device__ __forceinline__ void s5_scan(Frame& F) {
    const int gt = F.vcu * (NWAVES * 64) + F.tid, NGT = F.G * NWAVES * 64;
    for (int i = gt; i < BATCH * 32 * 64; i += NGT) {
        const int p = i & 63, bg = i >> 6, g = bg & 31; const float pr = F.apow()[2 * (g * 64 + p)], pi = F.apow()[2 * (g * 64 + p) + 1];
        f32x2* xp = (f32x2*)(F.XEND() + (((size_t)bg * NCH) * 64 + p) * 2);
        float cr = 0.f, ci = 0.f; asm volatile("" : "+v"(cr), "+v"(ci));
#pragma unroll
        for (int h = 0; h < 2; ++h) {
            f32x2 v[32];
#pragma unroll
            for (int n = 0; n < 32; ++n) v[n] = xp[(size_t)(32 * h + n) * 64];
#pragma unroll
            for (int n = 0; n < 32; ++n) { xp[(size_t)(32 * h + n) * 64] = (f32x2){cr, ci};
                const float nr = pr * cr - pi * ci + v[n].x, ni = pr * ci + pi * cr + v[n].y; cr = nr; ci = ni; asm volatile("" : "+v"(cr), "+v"(ci)); }
        }
    }
}

__device__ __forceinline__ void pool_phase(Frame& F, int l) {
    const int gw = F.vcu * NWAVES + F.wave, NGW = F.G * NWAVES, lane = F.lane, lr = lane & 15, lq = lane >> 4;
    for (int unit = gw; unit < BATCH * (SEQ / 16) * 4; unit += NGW) {
        const int g = unit & 3, tile = (unit >> 2) & 255, b = unit >> 10; const int win = 2 << g, tpos = 16 * tile + lr; const size_t row = (size_t)b * SEQ + tpos;
        const bf16_t* pp = F.PROJ() + row * LDP + C_PU + g * 128 + 8 * lq;
        float s[4][8];
#pragma unroll
        for (int ks = 0; ks < 4; ++ks)
#pragma unroll
            for (int j = 0; j < 8; ++j) s[ks][j] = 0.f;
        for (int jj = 1; jj < win; ++jj) { if (tpos - jj >= 0) {
#pragma unroll
            for (int ks = 0; ks < 4; ++ks) { float a[8]; unpack8(*(const u32x4*)(pp - (size_t)jj * LDP + 32 * ks), a);
#pragma unroll
                for (int j = 0; j < 8; ++j) s[ks][j] += a[j]; } } }
        const float inv = 1.0f / (float)min(tpos + 1, win);
        bf16x8 mf[4];
#pragma unroll
        for (int ks = 0; ks < 4; ++ks) { float a[8], m[8]; unpack8(*(const u32x4*)(pp + 32 * ks), a);
#pragma unroll
            for (int j = 0; j < 8; ++j) m[j] = (s[ks][j] + a[j]) * inv - a[j];
            const u32x4 w = pack8(m); mf[ks] = __builtin_bit_cast(bf16x8, w); }
        const bf16_t* pw = F.poolw_t() + (size_t)g * 128 * 128 + (size_t)lr * 128 + 8 * lq;
#pragma unroll
        for (int q = 0; q < 8; ++q) { f32x4 acc = (f32x4){0.f, 0.f, 0.f, 0.f};
#pragma unroll
            for (int ks = 0; ks < 4; ++ks) acc = __builtin_amdgcn_mfma_f32_16x16x32_bf16(*(const bf16x8*)(pw + (size_t)(16 * q) * 128 + 32 * ks), mf[ks], acc, 0, 0, 0);
            const int dcol = g * 128 + 16 * q + 4 * lq; const f32x4 sc = *(const f32x4*)(F.pool_scale() + (size_t)l * BW + dcol);
            u32x2 w; w.x = pk2(acc[0] * sc.x, acc[1] * sc.y); w.y = pk2(acc[2] * sc.z, acc[3] * sc.w);
            *(u32x2*)(F.Y() + row * D + 1536 + dcol) = w; }
    }
}

__device__ __forceinline__ void conv_fix_phase(Frame& F, int l) {
    const float* cw = F.conv_w() + (size_t)l * 3 * NUP; const float* cb = F.conv_b() + (size_t)l * NUP; const float* UH = F.UH();
    const int gt = F.vcu * (NWAVES * 64) + F.tid, NGT = F.G * NWAVES * 64;
    constexpr int JG = DFF / 4;
    for (int task = gt; task < (M / 256) * 2 * JG; task += NGT) {
        const int jg = task % JG, q = (task / JG) & 1, pm = task / (2 * JG);
        if ((pm & 15) == 0) continue;
        const int j0 = jg * 4, ucol = 256 * (j0 >> 7) + (j0 & 127);
        const float* u0p = UH + ((size_t)pm * 4 + q) * NUP + ucol;
        const float* u1p = (q == 1) ? UH + ((size_t)pm * 4 + 0) * NUP + ucol : UH + ((size_t)(pm - 1) * 4 + 3) * NUP + ucol;
        const float* u2p = (q == 1) ? UH + ((size_t)(pm - 1) * 4 + 3) * NUP + ucol : UH + ((size_t)(pm - 1) * 4 + 2) * NUP + ucol;
        const f32x4 a0 = *(const f32x4*)u0p, a1 = *(const f32x4*)u1p, a2 = *(const f32x4*)u2p, v0 = *(const f32x4*)(u0p + 128), v1 = *(const f32x4*)(u1p + 128), v2 = *(const f32x4*)(u2p + 128);
        const f32x4 wa0 = *(const f32x4*)(cw + j0), wa1 = *(const f32x4*)(cw + NUP + j0), wa2 = *(const f32x4*)(cw + 2 * NUP + j0), ba = *(const f32x4*)(cb + j0);
        const f32x4 wv0 = *(const f32x4*)(cw + DFF + j0), wv1 = *(const f32x4*)(cw + NUP + DFF + j0), wv2 = *(const f32x4*)(cw + 2 * NUP + DFF + j0), bv = *(const f32x4*)(cb + DFF + j0);
        float o[4];
#pragma unroll
        for (int i = 0; i < 4; ++i) { const float ca = ba[i] + wa0[i] * a2[i] + wa1[i] * a1[i] + wa2[i] * a0[i], cv = bv[i] + wv0[i] * v2[i] + wv1[i] * v1[i] + wv2[i] * v0[i]; o[i] = siluf_(ca) * cv; }
        u32x2 w; w.x = pk2(o[0], o[1]); w.y = pk2(o[2], o[3]);
        *(u32x2*)(F.ACT() + ((size_t)pm * 256 + q) * DFF + j0) = w;
    }
}

constexpr int NPH = 13;
struct Args { const void* in[25]; float* out; unsigned char* ws; int l_lo, l_hi, ph_lo, ph_hi, single, pad; };
__global__ void __launch_bounds__(NWAVES * 64, 2) hybrid_fwd(Args args) {
    extern __shared__ __attribute__((aligned(16))) unsigned char lds[];
    Frame F;
    F.lds = (LAS unsigned char*)lds;
    F.tid = threadIdx.x; F.lane = F.tid & 63; F.wave = __builtin_amdgcn_readfirstlane(F.tid >> 6);
    const int wave0 = F.wave;
    F.G = gridDim.x; { const int bx = blockIdx.x; F.vcu = (F.G % 8 == 0) ? (bx % 8) * (F.G / 8) + bx / 8 : bx; }
    unsigned char* ws = args.ws; F.ws = ws; F.out = args.out; F.l = 0;

    volatile LAS unsigned* MISC = (volatile LAS unsigned*)(F.lds + MISC_OFF);
    if (F.tid < 64) MISC[F.tid] = 0u;
    wg_sync();
    unsigned* ctl = (unsigned*)(ws + WS_CTL);
    XcdBarrier bar; bar.bar = ctl + CW_BAR; bar.x = 0; bar.st = nullptr;
    if (args.single) bar = xcd_barrier_post(ctl + CW_BAR, MISC);
#define GRID_BAR() do { if (args.single) xcd_barrier(bar); } while (0)
    const int lo = args.ph_lo, hi = args.ph_hi;
#define IN(k) (lo <= (k) && (k) < hi)
#define PH_BEGIN() do { unsigned z_ = 0u; asm volatile("" : "+v"(z_)); const int ln_ = (int)__builtin_amdgcn_mbcnt_hi(~0u, __builtin_amdgcn_mbcnt_lo(~0u, z_)); F.lane = ln_; F.tid = wave0 * 64 + ln_; F.wave = wave0; unsigned long long w_ = (unsigned long long)args.ws, o_ = (unsigned long long)args.out; asm volatile("" : "+s"(w_), "+s"(o_)); F.ws = (unsigned char*)(GAS unsigned char*)w_; F.out = (float*)(GAS float*)o_; } while (0)

    for (int l = args.l_lo; l < args.l_hi; ++l) {
        F.l = l;
        if (IN(0)) { PH_BEGIN(); phase_prep(F, l); GRID_BAR(); }
        if (IN(1)) { PH_BEGIN();
            { pg8::Gemm g{(const bf16_t*)F.HN8(), (const bf16_t*)F.W8(), M, 4 * D, D / 2, D / 2, D / 2}; pg8::StaticOrder S; S.init(M, 4 * D, F.G, (int)blockIdx.x); pg8::EpiProj E{F.PROJ(), LDP, 0, F.GF(), 1.0f / 64.0f};
              pg8::gemm_phase<pg8::EpiProj, true>(F.lds, g, S, E, F.tid); }
            PH_BEGIN();
            { pg8::Gemm g{F.HN(), F.win_t(), M, C_GR, D, D, D}; pg8::StaticOrder S; S.init(M, C_GR, F.G, (int)blockIdx.x); pg8::EpiProj E{F.PROJ(), LDP, 1 << 20, F.GF(), 1.0f};
              pg8::gemm_phase(F.lds, g, S, E, F.tid); }
            PH_BEGIN(); gr_pass(F);
            GRID_BAR(); }
        if (IN(2)) { PH_BEGIN(); lin2_phase<false>(F, l); PH_BEGIN();
            s5_pass<false>(F, l); pool_phase(F, l); wg_sync();
            GRID_BAR(); }
        if (IN(3)) { PH_BEGIN(); lin_scan(F); s5_scan(F); GRID_BAR(); }
        if (IN(4)) { PH_BEGIN(); lin2_phase<true>(F, l); PH_BEGIN();
            s5_pass<true>(F, l); wg_sync();
            GRID_BAR(); }
        if (IN(5)) { PH_BEGIN(); pg8::Gemm g{F.YBP(), F.wglu_t(), M, BW, BW, BW, BW}; pg8::StaticOrder S; S.init(M, BW, F.G, (int)blockIdx.x); pg8::EpiGlu E{F.YBP(), BW, F.Y() + BW, D};
            pg8::gemm_phase(F.lds, g, S, E, F.tid); GRID_BAR(); }
        if (IN(6)) { PH_BEGIN(); for (int i = 0; i < (F.vcu & 7); ++i) __builtin_amdgcn_s_sleep(56);
            pg8::Gemm g{F.Y(), F.wbr_t(), M, D, D, D, D}; pg8::StaticOrder S; S.init(M, D, F.G, (int)blockIdx.x); pg8::EpiMerge E{F.GF(), F.HN(), D};
            pg8::gemm_phase(F.lds, g, S, E, F.tid); GRID_BAR(); }
        if (IN(7)) { PH_BEGIN(); for (int i = 0; i < (F.vcu & 7); ++i) __builtin_amdgcn_s_sleep(50);
            pg8::Gemm g{F.HN(), F.wout_t(), M, D, D, D, D}; pg8::StaticOrder S; S.init(M, D, F.G, (int)blockIdx.x); pg8::EpiResid E{l == 0 ? (const void*)F.x() : (const void*)F.out, l == 0 ? 1 : 0, F.Y(), D, F.SS()};
            pg8::gemm_phase(F.lds, g, S, E, F.tid); GRID_BAR(); }
        if (IN(8)) { PH_BEGIN(); row_scale(F); GRID_BAR(); }
        if (IN(9)) { PH_BEGIN(); pg8::Gemm g{F.Y(), F.wup_t(), M, NUP, D, D, D}; pg8::StaticOrder S; S.init(M, NUP, F.G, (int)blockIdx.x); pg8::EpiConv E{F.conv_w() + (size_t)l * 3 * NUP, F.conv_b() + (size_t)l * NUP, F.ACT(), F.UH(), (LAS float*)(F.lds + pg8::STAGE_BYTES), F.RS()};
            pg8::gemm_phase(F.lds, g, S, E, F.tid); GRID_BAR(); }
        if (IN(10)) { PH_BEGIN(); conv_fix_phase(F, l); GRID_BAR(); }
        if (IN(11)) { PH_BEGIN(); for (int i = 0; i < (F.vcu & 7); ++i) __builtin_amdgcn_s_sleep(50);
            pg8::Gemm g{F.ACT(), F.wdn_t(), M, D, DFF, DFF, DFF}; pg8::StaticOrder S; S.init(M, D, F.G, (int)blockIdx.x); pg8::EpiResid E{(const void*)F.Y(), 0, l == DEPTH - 1 ? F.HN() : (bf16_t*)F.out, D, nullptr};
            pg8::gemm_phase(F.lds, g, S, E, F.tid); GRID_BAR(); }
        if (IN(12) && l == DEPTH - 1) { PH_BEGIN(); rms_rows16_to_f32(F, F.HN(), F.g_final(), F.out); }
    }
#undef IN
#undef PH_BEGIN
#undef GRID_BAR
}

#pragma clang attribute pop
extern "C" void kernel_launch(void* const* d_in, const int* in_sizes, int n_in, void* d_out, int out_size, void* d_ws, size_t ws_size, hipStream_t stream) {
    static int grid = 0;
    if (grid == 0) {
        if (n_in != 25 || in_sizes[0] != M * D || out_size != M * D || ws_size < WS_END) { fprintf(stderr, "kernel_launch: shape/workspace mismatch (n_in %d, in0 %d, out %d, ws %zu, need %zu); nothing launched\n", n_in, n_in > 0 ? in_sizes[0] : -1, out_size, ws_size, (size_t)WS_END); grid = -1; return; }
        int dev = 0, cus = 0, per_cu = 0;
        if (hipGetDevice(&dev) != hipSuccess || hipDeviceGetAttribute(&cus, hipDeviceAttributeMultiprocessorCount, dev) != hipSuccess) { grid = -1; return; }
        if (hipFuncSetAttribute((const void*)hybrid_fwd, hipFuncAttributeMaxDynamicSharedMemorySize, LDS_BYTES) != hipSuccess) { fprintf(stderr, "kernel_launch: hipFuncSetAttribute failed\n"); grid = -1; return; }
        if (hipOccupancyMaxActiveBlocksPerMultiprocessor(&per_cu, (const void*)hybrid_fwd, NWAVES * 64, LDS_BYTES) != hipSuccess || per_cu < 1) { fprintf(stderr, "kernel_launch: occupancy query reports %d workgroups per CU\n", per_cu); }
        (void)hipGetLastError();
        if (cus < 256) { fprintf(stderr, "kernel_launch: built for a 256-CU device (found %d CUs); nothing launched\n", cus); grid = -1; return; }
        grid = 256;
    }
    if (grid < 0) return;
    if (hipMemsetAsync((char*)d_ws + WS_CTL, 0, CTL_ZERO_BYTES, stream) != hipSuccess) return;
    Args a{};
    for (int i = 0; i < 25; ++i) a.in[i] = d_in[i];
    a.out = (float*)d_out; a.ws = (unsigned char*)d_ws;
#if MK_SINGLE
    a.l_lo = 0; a.l_hi = DEPTH; a.ph_lo = 0; a.ph_hi = NPH; a.single = 1;
    hipLaunchKernelGGL(hybrid_fwd, dim3(grid), dim3(NWAVES * 64), LDS_BYTES, stream, a);
#else
    a.single = 0;
    for (int l = 0; l < DEPTH; ++l)
        for (int p = 0; p < NPH; ++p) { if (p == 12 && l != DEPTH - 1) continue; a.l_lo = l; a.l_hi = l + 1; a.ph_lo = p; a.ph_hi = p + 1;
            hipLaunchKernelGGL(hybrid_fwd, dim3(grid), dim3(NWAVES * 64), LDS_BYTES, stream, a); }
#endif
}
```

```cpp
#include <hip/hip_runtime.h>
#include <cstdio>
#include <cstdint>

#ifndef MK_SINGLE
#define MK_SINGLE 1
#endif

#pragma clang attribute push(__attribute__((target("no-packed-fp32-ops"))), apply_to = function)
#define LAS __attribute__((address_space(3)))
#define GAS __attribute__((address_space(1)))
typedef unsigned short bf16_t;
typedef short bf16x8 __attribute__((ext_vector_type(8)));
typedef float f32x4 __attribute__((ext_vector_type(4)));
typedef float f32x2 __attribute__((ext_vector_type(2)));
typedef unsigned u32x4 __attribute__((ext_vector_type(4)));
typedef unsigned u32x2 __attribute__((ext_vector_type(2)));

constexpr int D = 2048, BATCH = 8, SEQ = 4096, DEPTH = 4, M = BATCH * SEQ;
constexpr int BW = 512;
constexpr int NIN_SRC = 12304, NIN = 12544;
constexpr int DFF = 5504, NUP = 11008;
constexpr int C_RQ = 0, C_RK = 256, C_RV = 512, C_RG = 1024, C_SU = 1536, C_GQ = 2048, C_GK = 2304, C_GV = 2560, C_GG = 3072, C_PU = 3584, C_GR = 4096, C_GATE = 4352;
constexpr int LDP = 4224;
constexpr float EPS = 1e-6f;
constexpr int NWAVES = 8;
constexpr int CH = 64;
constexpr int NCH = SEQ / CH;

constexpr size_t MiB = 1u << 20;
constexpr size_t WS_CTL = 0, CTL_ZERO_BYTES = 1 * MiB;
constexpr size_t WS_ROT = 1 * MiB;
constexpr size_t WS_S5T = 9 * MiB;
constexpr size_t S5T_ABAR = 0, S5T_APOW = 16384, S5T_BBAR = 32768, S5T_CMT = 32768 + 262144, S5T_BBT = S5T_CMT + 131072;
constexpr size_t WS_WGLU = 10 * MiB;
constexpr size_t WS_POOLW = 10 * MiB + 512 * 1024;
constexpr size_t WS_WIN = 11 * MiB;
constexpr size_t WS_WBR = 60 * MiB;
constexpr size_t WS_WOUT = 68 * MiB;
constexpr size_t WS_WUP = 76 * MiB;
constexpr size_t WS_WDN = 119 * MiB;
constexpr size_t WS_HN = 141 * MiB;
constexpr size_t WS_Y = 269 * MiB;
constexpr size_t WS_SCR = 397 * MiB;
constexpr size_t WS_YBP = WS_SCR;
constexpr size_t WS_STATE = WS_SCR + 32 * MiB;
constexpr size_t WS_SPREV = WS_SCR + 160 * MiB;
constexpr size_t WS_DEC = WS_SCR + 224 * MiB;
constexpr size_t WS_XEND = WS_SCR + 225 * MiB;
constexpr size_t WS_UH = WS_SCR + 128 * MiB;
constexpr size_t WS_PROJ = 637 * MiB;
constexpr size_t WS_GF = WS_PROJ + 264 * MiB;
constexpr size_t WS_ACT = WS_PROJ;
constexpr size_t WS_RS = 1421 * MiB;
constexpr size_t WS_SS = 1422 * MiB;
constexpr size_t WS_HN8 = 1438 * MiB;
constexpr size_t WS_W8 = 1502 * MiB;
constexpr size_t WS_END = 1518 * MiB;
static_assert(WS_PROJ + (size_t)M * LDP * 2 <= WS_GF && WS_GF + 4 * (size_t)M * D * 2 <= WS_RS, "ws map");
static_assert(WS_ACT + (size_t)M * DFF * 2 <= WS_RS, "ws map");
static_assert(WS_XEND + 8 * MiB <= WS_PROJ, "ws map");
static_assert(WS_UH + (size_t)(M / 256) * 4 * NUP * 4 <= WS_PROJ, "ws map");
constexpr int CW_TMO = 0, CW_BAR = 4096;

constexpr int LDS_BYTES = 155648;
constexpr int MISC_OFF = LDS_BYTES - 256;

#define RLX_AGENT __ATOMIC_RELAXED, __HIP_MEMORY_SCOPE_AGENT
__device__ __forceinline__ void lds_sync() { asm volatile("s_waitcnt lgkmcnt(0)" ::: "memory"); __builtin_amdgcn_s_barrier(); asm volatile("" ::: "memory"); }
__device__ __forceinline__ void wg_sync() { __builtin_amdgcn_fence(__ATOMIC_RELEASE, "workgroup"); __builtin_amdgcn_s_barrier(); __builtin_amdgcn_fence(__ATOMIC_ACQUIRE, "workgroup"); }
#define LDS_WAIT() asm volatile("s_waitcnt lgkmcnt(0)" ::: "memory")
#define VM_WAIT() asm volatile("s_waitcnt vmcnt(0)" ::: "memory")
__device__ __forceinline__ unsigned f2bf(float f) { unsigned u = __builtin_bit_cast(unsigned, f); return (u + 0x7fffu + ((u >> 16) & 1u)) >> 16; }
__device__ __forceinline__ unsigned pk2(float lo, float hi) { return f2bf(lo) | (f2bf(hi) << 16); }
__device__ __forceinline__ float bflo(unsigned w) { return __builtin_bit_cast(float, w << 16); }
__device__ __forceinline__ float bfhi(unsigned w) { return __builtin_bit_cast(float, w & 0xffff0000u); }
__device__ __forceinline__ void unpack8(const u32x4 w, float (&v)[8]) { v[0] = bflo(w.x); v[1] = bfhi(w.x); v[2] = bflo(w.y); v[3] = bfhi(w.y); v[4] = bflo(w.z); v[5] = bfhi(w.z); v[6] = bflo(w.w); v[7] = bfhi(w.w); }
__device__ __forceinline__ u32x4 pack8(const float (&v)[8]) { u32x4 w; w.x = pk2(v[0], v[1]); w.y = pk2(v[2], v[3]); w.z = pk2(v[4], v[5]); w.w = pk2(v[6], v[7]); return w; }
__device__ __forceinline__ unsigned pk4_fp8(float a, float b, float c, float d) { unsigned w = 0u; w = __builtin_amdgcn_cvt_pk_fp8_f32(a, b, w, false); w = __builtin_amdgcn_cvt_pk_fp8_f32(c, d, w, true); return w; }
__device__ __forceinline__ float sigmoidf_(float x) { return __builtin_amdgcn_rcpf(1.0f + __expf(-x)); }
__device__ __forceinline__ float siluf_(float x) { return x * __builtin_amdgcn_rcpf(1.0f + __expf(-x)); }
__device__ __forceinline__ float gelu_tanh(float x) { const float u = 1.5957691216f * (x + 0.044715f * x * x * x); return x * __builtin_amdgcn_rcpf(1.0f + __expf(-u)); }
__device__ __forceinline__ float logsigmoidf_(float x) { return fminf(x, 0.f) - __logf(1.0f + __expf(-fabsf(x))); }

namespace pg8 {
constexpr int BM = 256, BK = 64, HALF = 128, HTB = HALF * BK * 2, STAGE_BYTES = 8 * HTB, NXCD = 8, WGM = 4;
__host__ __device__ __forceinline__ int lds_byte(int r, int c) { const int st = (r >> 4) * 2 + (c >> 5), rr = r & 15, cc = c & 31, ob = rr * 64 + cc * 2; return st * 1024 + (ob ^ (((ob >> 9) & 1) << 5)); }
__host__ __device__ __forceinline__ void stage_rc(int b, int& R, int& C) { const int st = b / 1024, sb = b % 1024, swz = sb ^ (((sb >> 9) & 1) << 5); R = (st >> 1) * 16 + swz / 64; C = (st & 1) * 32 + (swz % 64) / 2; }
__host__ __device__ __forceinline__ int perm32(int rho) { const int n = rho >> 4, i = rho & 15; return 8 * (i >> 2) + 4 * n + (i & 3); }

struct Unit { int pm, pn; };
struct Gemm { const bf16_t* A; const bf16_t* Bt; int M, N, K, lda, ldb; };

struct StaticOrder {
    int nM, nN, nwg, G, c;
    __host__ __device__ void init(int M_, int N_, int G_, int c_) { nM = M_ / BM; nN = N_ / BM; nwg = nM * nN; G = G_; c = c_; }
    __host__ __device__ bool next(int i, Unit& u) const {
        const long L = (long)i * G + c; if (L >= nwg) return false;
        int wgid = (int)L; { const int q = nwg / NXCD, r = nwg % NXCD, xcd = wgid % NXCD, off = wgid / NXCD; wgid = (xcd < r ? xcd * (q + 1) : r * (q + 1) + (xcd - r) * q) + off; }
        const int nig = WGM * nN, gid = wgid / nig, fm = gid * WGM, gsz = (nM - fm) < WGM ? (nM - fm) : WGM;
        u.pm = fm + ((wgid % nig) % gsz); u.pn = (wgid % nig) / gsz; return true;
    }
};

__device__ __forceinline__ unsigned cvt_pk_bf16(float lo, float hi) { unsigned r; asm volatile("v_cvt_pk_bf16_f32 %0, %1, %2" : "=v"(r) : "v"(lo), "v"(hi)); return r; }

struct EpiStoreBf16 {
    static constexpr bool PERM = true, KHOOK = false;
    bf16_t* O; int ldc;
    __device__ __forceinline__ void khook(f32x4 (&)[2][2][4][2], const Unit&, int, int, int, int, int) const {}
    __device__ __forceinline__ void operator()(f32x4 (&acc)[2][2][4][2], const Unit& u, int wr, int wc, int fr, int fq) const {
        const int row0 = u.pm * BM + wr * 64 + fr, col0 = u.pn * BM + wc * 32 + 8 * fq;
#pragma unroll
        for (int ai = 0; ai < 2; ++ai)
#pragma unroll
            for (int m = 0; m < 4; ++m) { bf16_t* rowp = O + (size_t)(row0 + ai * HALF + m * 16) * ldc + col0;
#pragma unroll
                for (int bj = 0; bj < 2; ++bj) { const f32x4 v0 = acc[ai][bj][m][0], v1 = acc[ai][bj][m][1];
                    u32x4 w; w.x = cvt_pk_bf16(v0[0], v0[1]); w.y = cvt_pk_bf16(v0[2], v0[3]); w.z = cvt_pk_bf16(v1[0], v1[1]); w.w = cvt_pk_bf16(v1[2], v1[3]);
                    *(u32x4*)(rowp + bj * HALF) = w; } }
    }
};
struct EpiProj {
    static constexpr bool PERM = true, KHOOK = false;
    bf16_t* O; int ldc; int gate_pn0; bf16_t* GF; float gscale;
    __device__ __forceinline__ void khook(f32x4 (&)[2][2][4][2], const Unit&, int, int, int, int, int) const {}
    __device__ __forceinline__ void operator()(f32x4 (&acc)[2][2][4][2], const Unit& u, int wr, int wc, int fr_, int fq_) const {
        int fr = fr_, fq = fq_; asm volatile("" : "+v"(fr), "+v"(fq));
        const int row0 = u.pm * BM + wr * 64 + fr;
        if (u.pn < gate_pn0) {
            const int col0 = u.pn * BM + wc * 32 + 8 * fq;
#pragma unroll
            for (int ai = 0; ai < 2; ++ai)
#pragma unroll
                for (int m = 0; m < 4; ++m) { bf16_t* rowp = O + (size_t)(row0 + ai * HALF + m * 16) * ldc + col0;
#pragma unroll
                    for (int bj = 0; bj < 2; ++bj) { const f32x4 v0 = acc[ai][bj][m][0], v1 = acc[ai][bj][m][1];
                        u32x4 w; w.x = cvt_pk_bf16(v0[0], v0[1]); w.y = cvt_pk_bf16(v0[2], v0[3]); w.z = cvt_pk_bf16(v1[0], v1[1]); w.w = cvt_pk_bf16(v1[2], v1[3]);
                        *(u32x4*)(rowp + bj * HALF) = w; } }
        } else {
            const int t = u.pn - gate_pn0, c0 = 64 * t + 16 * wc + 4 * fq;
            const float kc = -1.4426950408889634f * gscale, KL = 30.0f * 1.4426950408889634f;
            const size_t gbase = ((size_t)((u.pm * 8 + (c0 >> 8)) * 4) * 16 + ((c0 >> 7) & 1)) * 4096 + (size_t)(((wr * 4 + ((c0 >> 5) & 3)) * 64 + ((c0 >> 3) & 3) * 16 + fr) * 8 + (c0 & 7));
#pragma unroll
            for (int ai = 0; ai < 2; ++ai)
#pragma unroll
                for (int m = 0; m < 4; ++m) { bf16_t* rowp = GF + gbase + (size_t)(ai * 8 + m * 2) * 4096;
                    float r1[4], r2[4], r3[4], g3[4];
#pragma unroll
                    for (int i = 0; i < 4; ++i) {
                        const float e0 = __builtin_amdgcn_exp2f(__builtin_amdgcn_fmed3f(acc[ai][0][m][0][i] * kc, -KL, KL)), e1 = __builtin_amdgcn_exp2f(__builtin_amdgcn_fmed3f(acc[ai][0][m][1][i] * kc, -KL, KL));
                        const float e2 = __builtin_amdgcn_exp2f(__builtin_amdgcn_fmed3f(acc[ai][1][m][0][i] * kc, -KL, KL)), e3 = __builtin_amdgcn_exp2f(__builtin_amdgcn_fmed3f(acc[ai][1][m][1][i] * kc, -KL, KL));
                        const float i0 = __builtin_amdgcn_rcpf(1.f + e0), i1 = __builtin_amdgcn_rcpf(1.f + e1), i2 = __builtin_amdgcn_rcpf(1.f + e2), i3 = __builtin_amdgcn_rcpf(1.f + e3);
                        r1[i] = (1.f + e1) * i0; r2[i] = (1.f + e2) * i1; r3[i] = (1.f + e3) * i2; g3[i] = i3; }
                    u32x2 w;
                    w.x = cvt_pk_bf16(r1[0], r1[1]); w.y = cvt_pk_bf16(r1[2], r1[3]); *(u32x2*)(rowp) = w;
                    w.x = cvt_pk_bf16(r2[0], r2[1]); w.y = cvt_pk_bf16(r2[2], r2[3]); *(u32x2*)(rowp + 16 * 4096) = w;
                    w.x = cvt_pk_bf16(r3[0], r3[1]); w.y = cvt_pk_bf16(r3[2], r3[3]); *(u32x2*)(rowp + 2 * 16 * 4096) = w;
                    w.x = cvt_pk_bf16(g3[0], g3[1]); w.y = cvt_pk_bf16(g3[2], g3[3]); *(u32x2*)(rowp + 3 * 16 * 4096) = w; }
        }
    }
};
__device__ __forceinline__ float dpp_ror1(float x) { return __builtin_bit_cast(float, __builtin_amdgcn_update_dpp(0, __builtin_bit_cast(int, x), 0x121, 0xf, 0xf, true)); }
__device__ __forceinline__ float dpp_ror2(float x) { return __builtin_bit_cast(float, __builtin_amdgcn_update_dpp(0, __builtin_bit_cast(int, x), 0x122, 0xf, 0xf, true)); }
struct EpiConv {
    static constexpr bool PERM = true, KHOOK = false;
    const float* cw; const float* cb; bf16_t* O; float* UH; LAS float* halo; const float* RS;
    __device__ __forceinline__ void khook(f32x4 (&)[2][2][4][2], const Unit&, int, int, int, int, int) const {}
    __device__ __forceinline__ void operator()(f32x4 (&acc)[2][2][4][2], const Unit& u, int wr, int wc, int fr_, int fq_) const {
        int fr = fr_, fq = fq_; asm volatile("" : "+v"(fr), "+v"(fq));
        const int cl0 = wc * 32 + 8 * fq;
        const int j0 = 128 * u.pn + cl0;
        const float* rp = RS + ((size_t)(u.pm * 2 + wr) * 16 + fr) * 8; const f32x4 rs0 = *(const f32x4*)rp, rs1 = *(const f32x4*)(rp + 4);
        f32x4 wa0[3], wv0[3];
#pragma unroll
        for (int q = 0; q < 3; ++q) { wa0[q] = *(const f32x4*)(cw + q * NUP + j0); wv0[q] = *(const f32x4*)(cw + q * NUP + DFF + j0); }
        const f32x4 ba0 = *(const f32x4*)(cb + j0), bv0 = *(const f32x4*)(cb + DFF + j0);
#pragma unroll
        for (int ai = 0; ai < 2; ++ai)
#pragma unroll
            for (int m = 0; m < 4; ++m) { const float r = ai == 0 ? rs0[m] : rs1[m];
#pragma unroll
                for (int bj = 0; bj < 2; ++bj)
#pragma unroll
                    for (int n = 0; n < 2; ++n) acc[ai][bj][m][n] *= r; }
        if (fr >= 14) {
#pragma unroll
            for (int ai = 0; ai < 2; ++ai)
#pragma unroll
                for (int bj = 0; bj < 2; ++bj)
#pragma unroll
                    for (int n = 0; n < 2; ++n) *(LAS f32x4*)(halo + (((2 * ai + wr) * 2 + (fr - 14)) * 256 + 128 * bj + cl0 + 4 * n)) = acc[ai][bj][3][n];
        }
        if (wr == 0 && fr < 2) {
#pragma unroll
            for (int bj = 0; bj < 2; ++bj)
#pragma unroll
                for (int n = 0; n < 2; ++n) *(f32x4*)(UH + ((size_t)u.pm * 4 + fr) * NUP + 256 * u.pn + 128 * bj + cl0 + 4 * n) = acc[0][bj][0][n];
        }
        if (wr == 1 && fr >= 14) {
#pragma unroll
            for (int bj = 0; bj < 2; ++bj)
#pragma unroll
                for (int n = 0; n < 2; ++n) *(f32x4*)(UH + ((size_t)u.pm * 4 + 2 + (fr - 14)) * NUP + 256 * u.pn + 128 * bj + cl0 + 4 * n) = acc[1][bj][3][n];
        }
        asm volatile("s_waitcnt lgkmcnt(0)" ::: "memory"); __builtin_amdgcn_s_barrier(); asm volatile("" ::: "memory");
        const bool is15 = fr == 15, ge14 = fr >= 14;
        unsigned keep[2][4][2];
        f32x4 wa1[3], wv1[3];
#pragma unroll
        for (int q = 0; q < 3; ++q) { wa1[q] = *(const f32x4*)(cw + q * NUP + j0 + 4); wv1[q] = *(const f32x4*)(cw + q * NUP + DFF + j0 + 4); }
        const f32x4 ba1 = *(const f32x4*)(cb + j0 + 4), bv1 = *(const f32x4*)(cb + DFF + j0 + 4);
#pragma unroll
        for (int n = 0; n < 2; ++n) {
            f32x4 wa[3], wv[3];
#pragma unroll
            for (int q = 0; q < 3; ++q) { wa[q] = n == 0 ? wa0[q] : wa1[q]; wv[q] = n == 0 ? wv0[q] : wv1[q]; }
            const f32x4 ba = n == 0 ? ba0 : ba1, bv = n == 0 ? bv0 : bv1;
#pragma unroll
            for (int ai = 0; ai < 2; ++ai) {
                const int blk = 2 * ai + wr;
                f32x4 pa = (f32x4){0.f, 0.f, 0.f, 0.f}, pv = (f32x4){0.f, 0.f, 0.f, 0.f};
                if (blk > 0 && ge14) { pa = *(const LAS f32x4*)(halo + (((blk - 1) * 2 + (fr - 14)) * 256 + cl0 + 4 * n)); pv = *(const LAS f32x4*)(halo + (((blk - 1) * 2 + (fr - 14)) * 256 + 128 + cl0 + 4 * n)); }
#pragma unroll
                for (int m = 0; m < 4; ++m) {
                    const f32x4 ca_ = acc[ai][0][m][n], cv_ = acc[ai][1][m][n]; float o[4];
#pragma unroll
                    for (int i = 0; i < 4; ++i) {
                        const float a1 = dpp_ror1(is15 ? pa[i] : ca_[i]), a2 = dpp_ror2(ge14 ? pa[i] : ca_[i]);
                        const float v1 = dpp_ror1(is15 ? pv[i] : cv_[i]), v2 = dpp_ror2(ge14 ? pv[i] : cv_[i]);
                        const float ca = ba[i] + wa[0][i] * a2 + wa[1][i] * a1 + wa[2][i] * ca_[i];
                        const float cv = bv[i] + wv[0][i] * v2 + wv[1][i] * v1 + wv[2][i] * cv_[i];
                        o[i] = siluf_(ca) * cv; }
                    pa = ca_; pv = cv_;
                    const unsigned lo = cvt_pk_bf16(o[0], o[1]), hi = cvt_pk_bf16(o[2], o[3]);
                    if (n == 0) { keep[ai][m][0] = lo; keep[ai][m][1] = hi; }
                    else { u32x4 w; w.x = keep[ai][m][0]; w.y = keep[ai][m][1]; w.z = lo; w.w = hi;
                        *(u32x4*)(O + (size_t)(u.pm * BM + ai * HALF + wr * 64 + m * 16 + fr) * DFF + j0) = w; }
                }
            }
        }
    }
};
struct EpiResid {
    static constexpr bool PERM = true, KHOOK = false;
    const void* base; int base_f32; bf16_t* O; int ldc; float* SS;
    __device__ __forceinline__ void khook(f32x4 (&)[2][2][4][2], const Unit&, int, int, int, int, int) const {}
    __device__ __forceinline__ void finish(const float (&b)[8], const f32x4 v0, const f32x4 v1, bf16_t* op, float& sq) const {
        const float o0 = b[0] + v0[0], o1 = b[1] + v0[1], o2 = b[2] + v0[2], o3 = b[3] + v0[3], o4 = b[4] + v1[0], o5 = b[5] + v1[1], o6 = b[6] + v1[2], o7 = b[7] + v1[3];
        u32x4 w; w.x = cvt_pk_bf16(o0, o1); w.y = cvt_pk_bf16(o2, o3); w.z = cvt_pk_bf16(o4, o5); w.w = cvt_pk_bf16(o6, o7);
        *(u32x4*)op = w;
        sq += ((o0 * o0 + o1 * o1) + (o2 * o2 + o3 * o3)) + ((o4 * o4 + o5 * o5) + (o6 * o6 + o7 * o7));
    }
    __device__ __forceinline__ void rowsum(float sq, const Unit& u, int wc, int fq, int lane, int row) const {
        sq += __builtin_bit_cast(float, __builtin_amdgcn_ds_bpermute((lane ^ 16) << 2, __builtin_bit_cast(int, sq)));
        sq += __builtin_bit_cast(float, __builtin_amdgcn_ds_bpermute((lane ^ 32) << 2, __builtin_bit_cast(int, sq)));
        if (fq == 0) SS[(size_t)(u.pn * 4 + wc) * M + row] = sq;
    }
    __device__ __forceinline__ void operator()(f32x4 (&acc)[2][2][4][2], const Unit& u, int wr, int wc, int fr_, int fq_) const {
        int fr = fr_, fq = fq_; asm volatile("" : "+v"(fr), "+v"(fq));
        const int row0 = u.pm * BM + wr * 64 + fr, col0 = u.pn * BM + wc * 32 + 8 * fq, lane = fq * 16 + fr;
        if (!base_f32) {
            u32x4 bw[2][4][2];
#pragma unroll
            for (int ai = 0; ai < 2; ++ai)
#pragma unroll
                for (int m = 0; m < 4; ++m)
#pragma unroll
                    for (int bj = 0; bj < 2; ++bj) bw[ai][m][bj] = *(const u32x4*)((const bf16_t*)base + (size_t)(row0 + ai * HALF + m * 16) * ldc + col0 + bj * HALF);
#pragma unroll
            for (int ai = 0; ai < 2; ++ai)
#pragma unroll
                for (int m = 0; m < 4; ++m) { const size_t off = (size_t)(row0 + ai * HALF + m * 16) * ldc + col0; float sq = 0.f;
#pragma unroll
                    for (int bj = 0; bj < 2; ++bj) { float b[8]; unpack8(bw[ai][m][bj], b); finish(b, acc[ai][bj][m][0], acc[ai][bj][m][1], O + off + bj * HALF, sq); }
                    if (SS) rowsum(sq, u, wc, fq, lane, row0 + ai * HALF + m * 16); }
        } else {
#pragma unroll
            for (int ai = 0; ai < 2; ++ai)
#pragma unroll
                for (int m = 0; m < 4; ++m) { const size_t off = (size_t)(row0 + ai * HALF + m * 16) * ldc + col0; float sq = 0.f;
#pragma unroll
                    for (int bj = 0; bj < 2; ++bj) { float b[8]; const float* bp = (const float*)base + off + bj * HALF; const f32x4 b0 = *(const f32x4*)bp, b1 = *(const f32x4*)(bp + 4);
                        b[0] = b0.x; b[1] = b0.y; b[2] = b0.z; b[3] = b0.w; b[4] = b1.x; b[5] = b1.y; b[6] = b1.z; b[7] = b1.w;
                        finish(b, acc[ai][bj][m][0], acc[ai][bj][m][1], O + off + bj * HALF, sq); }
                    if (SS) rowsum(sq, u, wc, fq, lane, row0 + ai * HALF + m * 16);
                    asm volatile("" ::: "memory"); }
        }
    }
};
struct EpiGlu {
    static constexpr bool PERM = true, KHOOK = false;
    const bf16_t* Yp; int ldy; bf16_t* O; int ldc;
    __device__ __forceinline__ void khook(f32x4 (&)[2][2][4][2], const Unit&, int, int, int, int, int) const {}
    __device__ __forceinline__ void operator()(f32x4 (&acc)[2][2][4][2], const Unit& u, int wr, int wc, int fr, int fq) const {
        const int row0 = u.pm * BM + wr * 64 + fr, col0 = u.pn * BM + wc * 32 + 8 * fq;
#pragma unroll
        for (int ai = 0; ai < 2; ++ai)
#pragma unroll
            for (int m = 0; m < 4; ++m) { const size_t r = (size_t)(row0 + ai * HALF + m * 16);
#pragma unroll
                for (int bj = 0; bj < 2; ++bj) { const u32x4 yw = *(const u32x4*)(Yp + r * ldy + col0 + bj * HALF); float y[8]; unpack8(yw, y);
                    const f32x4 v0 = acc[ai][bj][m][0], v1 = acc[ai][bj][m][1]; float o[8];
#pragma unroll
                    for (int j = 0; j < 4; ++j) { o[j] = y[j] * sigmoidf_(v0[j]); o[4 + j] = y[4 + j] * sigmoidf_(v1[j]); }
                    u32x4 w; w.x = cvt_pk_bf16(o[0], o[1]); w.y = cvt_pk_bf16(o[2], o[3]); w.z = cvt_pk_bf16(o[4], o[5]); w.w = cvt_pk_bf16(o[6], o[7]);
                    *(u32x4*)(O + r * ldc + col0 + bj * HALF) = w; } }
    }
};
struct EpiMerge {
    static constexpr bool PERM = true, KHOOK = true;
    const bf16_t* G; bf16_t* O; int ldc;
    __device__ __forceinline__ void scale(f32x4 (&acc)[2][2][4][2], const Unit& u, int s, int wr, int wc, int fr, int fq) const {
        int toff = ((wr * 4 + wc) * 64 + fq * 16 + fr) * 8; asm volatile("" : "+v"(toff));
        const bf16_t* gb = G + (size_t)(((u.pm * 8 + u.pn) * 4 + s) * 16) * 4096 + toff;
        u32x4 w[2][4][2];
#pragma unroll
        for (int ai = 0; ai < 2; ++ai)
#pragma unroll
            for (int m = 0; m < 4; ++m) {
#pragma unroll
                for (int bj = 0; bj < 2; ++bj) w[ai][m][bj] = *(const u32x4*)(gb + (size_t)(ai * 8 + m * 2 + bj) * 4096); }
#pragma unroll
        for (int ai = 0; ai < 2; ++ai)
#pragma unroll
            for (int m = 0; m < 4; ++m)
#pragma unroll
                for (int bj = 0; bj < 2; ++bj) { float f[8]; unpack8(w[ai][m][bj], f);
#pragma unroll
                    for (int j = 0; j < 8; ++j) acc[ai][bj][m][j >> 2][j & 3] *= f[j]; }
    }
    __device__ __forceinline__ void khook(f32x4 (&acc)[2][2][4][2], const Unit& u, int seg, int wr, int wc, int fr, int fq) const { scale(acc, u, seg - 1, wr, wc, fr, fq); }
    __device__ __forceinline__ void operator()(f32x4 (&acc)[2][2][4][2], const Unit& u, int wr, int wc, int fr, int fq) const {
        scale(acc, u, 3, wr, wc, fr, fq);
        const int row0 = u.pm * BM + wr * 64 + fr, col0 = u.pn * BM + wc * 32 + 8 * fq;
#pragma unroll
        for (int ai = 0; ai < 2; ++ai)
#pragma unroll
            for (int m = 0; m < 4; ++m) { bf16_t* rowp = O + (size_t)(row0 + ai * HALF + m * 16) * ldc + col0;
#pragma unroll
                for (int bj = 0; bj < 2; ++bj) { const f32x4 v0 = acc[ai][bj][m][0], v1 = acc[ai][bj][m][1];
                    u32x4 w; w.x = cvt_pk_bf16(v0[0], v0[1]); w.y = cvt_pk_bf16(v0[2], v0[3]); w.z = cvt_pk_bf16(v1[0], v1[1]); w.w = cvt_pk_bf16(v1[2], v1[3]);
                    *(u32x4*)(rowp + bj * HALF) = w; } }
    }
};

typedef int v4i_t __attribute__((ext_vector_type(4)));
typedef int v8i_t __attribute__((ext_vector_type(8)));
template <class Epi, bool F8 = false>
__device__ __forceinline__ void gemm_phase(LAS unsigned char* lds, const Gemm g, const StaticOrder& S, const Epi& E, int tid_in) {
    int tid_ = tid_in; asm volatile("" : "+v"(tid_));
    const int tid = tid_, wid = __builtin_amdgcn_readfirstlane(tid >> 6), lane = tid & 63, wr = wid >> 2, wc = wid & 3, fr = lane & 15, fq = lane >> 4;
    const int K = g.K, nt = K / BK;
    unsigned voffA[2], voffB[2];
#pragma unroll
    for (int i = 0; i < 2; ++i) { int R, C; stage_rc(tid * 16 + i * 8192, R, C); const int Rb = Epi::PERM ? ((R & ~31) + perm32(R & 31)) : R;
        voffA[i] = (unsigned)(R * g.lda + C) * 2u; voffB[i] = (unsigned)(Rb * g.ldb + C) * 2u; }
    const size_t kstep = (size_t)(BK * 2);
    const size_t hstepA = (size_t)HALF * g.lda * 2, hstepB = (size_t)HALF * g.ldb * 2;
    const size_t tstepA = 2 * hstepA, tstepB = 2 * hstepB;
    const unsigned ldsw = (unsigned)wid * 1024u;
    const int aoff = lds_byte(wr * 64 + fr, fq * 8), boff = lds_byte(wc * 32 + fr, fq * 8);
#define PG8_SA(b, h) (((b) * 2 + (h)) * HTB)
#define PG8_SB(b, h) ((4 + (b) * 2 + (h)) * HTB)
#define PG8_STAGE(bufoff, gbase, voff) do { _Pragma("unroll") for (int _i = 0; _i < 2; ++_i) \
        __builtin_amdgcn_global_load_lds((const unsigned*)((const char*)(gbase) + (voff)[_i]), (LAS unsigned*)(lds + (bufoff) + ldsw + _i * 8192), 16, 0, 0); } while (0)
#define PG8_LDA(dst, b, h) do { _Pragma("unroll") for (int m = 0; m < 4; ++m) _Pragma("unroll") for (int k = 0; k < 2; ++k) dst[m][k] = *(const LAS bf16x8*)(lds + PG8_SA(b, h) + aoff + m * 2048 + k * 1024); } while (0)
#define PG8_LDB(dst, b, h) do { _Pragma("unroll") for (int n = 0; n < 2; ++n) _Pragma("unroll") for (int k = 0; k < 2; ++k) dst[n][k] = *(const LAS bf16x8*)(lds + PG8_SB(b, h) + boff + n * 2048 + k * 1024); } while (0)
#define PG8_MMA(ai, bj, At, Bt) do { __builtin_amdgcn_s_setprio(1); _Pragma("unroll") for (int m = 0; m < 4; ++m) _Pragma("unroll") for (int n = 0; n < 2; ++n) _Pragma("unroll") for (int k = 0; k < 2; ++k) \
        acc[ai][bj][m][n] = __builtin_amdgcn_mfma_f32_16x16x32_bf16(Bt[n][k], At[m][k], acc[ai][bj][m][n], 0, 0, 0); __builtin_amdgcn_s_setprio(0); } while (0)
#define PG8_MMA16(ai, bj, At, Bt) PG8_MMA(ai, bj, At, Bt)
#define PG8_MMA8(ai, bj, A8, B8) do { __builtin_amdgcn_s_setprio(1); _Pragma("unroll") for (int m = 0; m < 4; ++m) _Pragma("unroll") for (int n = 0; n < 2; ++n) \
        asm volatile("v_mfma_f32_16x16x128_f8f6f4 %0, %1, %2, %0" : "+v"(acc[ai][bj][m][n]) : "v"(B8[n]), "v"(A8[m])); __builtin_amdgcn_s_setprio(0); } while (0)
#define PG8_LDA8(dst, b, h) do { _Pragma("unroll") for (int m = 0; m < 4; ++m) { dst[m].lo = *(const LAS v4i_t*)(lds + PG8_SA(b, h) + aoff + m * 2048); dst[m].hi = *(const LAS v4i_t*)(lds + PG8_SA(b, h) + aoff + m * 2048 + 1024); } } while (0)
#define PG8_LDB8(dst, b, h) do { _Pragma("unroll") for (int n = 0; n < 2; ++n) { dst[n].lo = *(const LAS v4i_t*)(lds + PG8_SB(b, h) + boff + n * 2048); dst[n].hi = *(const LAS v4i_t*)(lds + PG8_SB(b, h) + boff + n * 2048 + 1024); } } while (0)
#define PG8_XLDA(b, h) do { if constexpr (F8) PG8_LDA8(A8, b, h); else PG8_LDA(At, b, h); } while (0)
#define PG8_XLDB0(b, h) do { if constexpr (F8) PG8_LDB8(B08, b, h); else PG8_LDB(B0, b, h); } while (0)
#define PG8_XLDB1(b, h) do { if constexpr (F8) PG8_LDB8(B18, b, h); else PG8_LDB(B1, b, h); } while (0)
#define PG8_MM0(ai, bj) do { if constexpr (F8) PG8_MMA8(ai, bj, A8, B08); else PG8_MMA16(ai, bj, At, B0); } while (0)
#define PG8_MM1(ai, bj) do { if constexpr (F8) PG8_MMA8(ai, bj, A8, B18); else PG8_MMA16(ai, bj, At, B1); } while (0)
#define PG8_WAIT_V(n) asm volatile("s_waitcnt vmcnt(" #n ")" ::: "memory")
#define PG8_WAIT_L(n) asm volatile("s_waitcnt lgkmcnt(" #n ")" ::: "memory")
#define PG8_BAR __builtin_amdgcn_s_barrier()
#define PG8_SCHED __builtin_amdgcn_sched_barrier(0)
    Unit cur, nxt; int ui = 0;
    if (!S.next(0, cur)) return;
    f32x4 acc[2][2][4][2];
#pragma unroll
    for (int a = 0; a < 2; ++a)
#pragma unroll
        for (int b = 0; b < 2; ++b)
#pragma unroll
            for (int m = 0; m < 4; ++m)
#pragma unroll
                for (int n = 0; n < 2; ++n) acc[a][b][m][n] = (f32x4){0.f, 0.f, 0.f, 0.f};
    bf16x8 At[4][2], B0[2][2], B1[2][2]; v8i_t A8[4], B08[2], B18[2];
    const char* cA = (const char*)g.A + (size_t)cur.pm * tstepA; const char* cB = (const char*)g.Bt + (size_t)cur.pn * tstepB;
    PG8_STAGE(PG8_SB(0, 0), cB, voffB); PG8_STAGE(PG8_SB(0, 1), cB + hstepB, voffB); PG8_STAGE(PG8_SA(0, 0), cA, voffA); PG8_STAGE(PG8_SA(0, 1), cA + hstepA, voffA);
    if (wr == 1) PG8_BAR;
    PG8_WAIT_V(2); PG8_BAR;
    PG8_STAGE(PG8_SB(1, 0), cB + kstep, voffB); PG8_STAGE(PG8_SA(1, 0), cA + kstep, voffA); PG8_STAGE(PG8_SB(1, 1), cB + hstepB + kstep, voffB);
    PG8_WAIT_V(6); PG8_BAR;
    for (;;) {
        const bool has_next = S.next(ui + 1, nxt);
        const char* nA = has_next ? (const char*)g.A + (size_t)nxt.pm * tstepA : cA; const char* nB = has_next ? (const char*)g.Bt + (size_t)nxt.pn * tstepB : cB;
        for (int t = 0; t < nt; t += 2) {
            const bool last = (t == nt - 2);
            const char* a1 = cA + (size_t)(t + 1) * kstep;
            const char* a2 = last ? nA : cA + (size_t)(t + 2) * kstep; const char* b2 = last ? nB : cB + (size_t)(t + 2) * kstep;
            const char* a3 = a2 + kstep; const char* b3 = b2 + kstep;
            if constexpr (Epi::KHOOK) { if (t != 0 && (t & 7) == 0) E.khook(acc, cur, t >> 3, wr, wc, fr, fq); }
            PG8_XLDB0(0, 0); PG8_XLDB1(0, 1); PG8_SCHED; PG8_XLDA(0, 0); PG8_STAGE(PG8_SA(1, 1), a1 + hstepA, voffA);
            PG8_WAIT_V(8); PG8_WAIT_L(0); PG8_BAR; PG8_MM0(0, 0); PG8_MM1(0, 1); PG8_BAR; PG8_SCHED;
            PG8_XLDA(0, 1); PG8_STAGE(PG8_SB(0, 0), b2, voffB); PG8_STAGE(PG8_SB(0, 1), b2 + hstepB, voffB); PG8_STAGE(PG8_SA(0, 0), a2, voffA);
            PG8_WAIT_V(8); PG8_WAIT_L(0); PG8_BAR; PG8_MM0(1, 0); PG8_MM1(1, 1); PG8_BAR; PG8_SCHED;
            PG8_XLDB0(1, 0); PG8_XLDB1(1, 1); PG8_SCHED; PG8_XLDA(1, 0); PG8_STAGE(PG8_SA(0, 1), a2 + hstepA, voffA);
            PG8_WAIT_V(8); PG8_WAIT_L(0); PG8_BAR; PG8_MM0(0, 0); PG8_MM1(0, 1); PG8_BAR; PG8_SCHED;
            PG8_XLDA(1, 1); PG8_STAGE(PG8_SB(1, 0), b3, voffB); PG8_STAGE(PG8_SB(1, 1), b3 + hstepB, voffB); PG8_STAGE(PG8_SA(1, 0), a3, voffA);
            PG8_WAIT_V(8); PG8_WAIT_L(0); PG8_BAR; PG8_MM0(1, 0); PG8_MM1(1, 1); PG8_BAR; PG8_SCHED;
        }
        if (wr == 0) PG8_BAR;
        E(acc, cur, wr, wc, fr, fq);
        if (!has_next) break;
#pragma unroll
        for (int a = 0; a < 2; ++a)
#pragma unroll
            for (int b = 0; b < 2; ++b)
#pragma unroll
                for (int m = 0; m < 4; ++m)
#pragma unroll
                    for (int n = 0; n < 2; ++n) acc[a][b][m][n] = (f32x4){0.f, 0.f, 0.f, 0.f};
        cur = nxt; cA = nA; cB = nB; ++ui;
        if (wr == 1) PG8_BAR;
    }
    PG8_WAIT_V(0);
    PG8_BAR;
#undef PG8_SA
#undef PG8_SB
#undef PG8_STAGE
#undef PG8_LDA
#undef PG8_LDB
#undef PG8_MMA
#undef PG8_MMA8
#undef PG8_MMA16
#undef PG8_LDA8
#undef PG8_LDB8
#undef PG8_XLDA
#undef PG8_XLDB0
#undef PG8_XLDB1
#undef PG8_MM0
#undef PG8_MM1
#undef PG8_WAIT_V
#undef PG8_WAIT_L
#undef PG8_BAR
#undef PG8_SCHED
}
}

#define XB_TMO      128
#define XB_XCNT(j)  (256  + 64 * (j))
#define XB_XSUB(j)  (1280 + 64 * (j))
#define XB_XGEN(j)  (2304 + 64 * (j))
#define XB_TOP      3328
#define XB_TOPGEN   3392
#define XCD_BAR_WORDS 3456
#define XB_SPIN_CAP (1u << 18)
__device__ __forceinline__ unsigned xb_ld(unsigned* p)              { return __hip_atomic_load(p, __ATOMIC_RELAXED, __HIP_MEMORY_SCOPE_AGENT); }
__device__ __forceinline__ unsigned xb_add(unsigned* p, unsigned v) { return __hip_atomic_fetch_add(p, v, __ATOMIC_RELAXED, __HIP_MEMORY_SCOPE_AGENT); }
__device__ __forceinline__ unsigned xb_xcc_id() { return (unsigned)__builtin_amdgcn_s_getreg((3 << 11) | 20) & 0xFu; }
#define XB_SPIN(cond, bar) do { unsigned _sp = 0; while (cond) { __builtin_amdgcn_s_sleep(1); \
    if ((++_sp & 255u) == 0u) { if (xb_ld(&(bar)[XB_TMO])) break; if (_sp > XB_SPIN_CAP) { (void)__hip_atomic_fetch_add(&(bar)[XB_TMO], 1u, __ATOMIC_RELAXED, __HIP_MEMORY_SCOPE_AGENT); break; } } } } while (0)
struct XcdBarrier { unsigned* bar; unsigned x; volatile LAS unsigned* st; };
__device__ __forceinline__ XcdBarrier xcd_barrier_post(unsigned* bar, volatile LAS unsigned* st) {
    XcdBarrier b; b.bar = bar; b.x = xb_xcc_id(); b.st = st;
    if (threadIdx.x == 0) (void)xb_add(&bar[XB_XCNT(b.x)], 1u);
    return b;
}
__device__ __forceinline__ void xcd_barrier_complete(unsigned* bar, unsigned x, unsigned& nloc, unsigned& nx) {
    const unsigned G = gridDim.x * gridDim.y * gridDim.z;
    unsigned sum, cnt, mine, sp = 0u;
    for (;;) {
        sum = 0u; cnt = 0u; mine = 0u;
#pragma nounroll
        for (unsigned j = 0; j < 16; ++j) { const unsigned c = xb_ld(&bar[XB_XCNT(j)]); sum += c; cnt += (c > 0u) ? 1u : 0u; mine = (j == x) ? c : mine; }
        if (sum == G) break;
        __builtin_amdgcn_s_sleep(1);
        if ((++sp & 255u) == 0u) { if (xb_ld(&bar[XB_TMO])) break; if (sp > XB_SPIN_CAP) { (void)__hip_atomic_fetch_add(&bar[XB_TMO], 1u, __ATOMIC_RELAXED, __HIP_MEMORY_SCOPE_AGENT); break; } }
    }
    nloc = mine > 0u ? mine : 1u; nx = cnt > 0u ? cnt : 1u;
}
__device__ __forceinline__ void xcd_barrier(const XcdBarrier& b) {
    asm volatile("s_waitcnt vmcnt(0)" ::: "memory");
    wg_sync();
    if (threadIdx.x == 0) {
        unsigned* bar = b.bar;
        __builtin_amdgcn_s_waitcnt(0);
        unsigned nloc = b.st[0], nx = b.st[1];
        if (nloc == 0u) { xcd_barrier_complete(bar, b.x, nloc, nx); b.st[0] = nloc; b.st[1] = nx; }
        const unsigned old = xb_add(&bar[XB_XSUB(b.x)], 1u);
        const unsigned gen = old / nloc;
        if (old + 1u == (gen + 1u) * nloc) {
            __builtin_amdgcn_fence(__ATOMIC_RELEASE, "agent");
            asm volatile("s_waitcnt vmcnt(0)" ::: "memory");
            const unsigned og = xb_add(&bar[XB_TOP], 1u);
            const unsigned tg = og / nx;
            if (og + 1u == (tg + 1u) * nx) xb_add(&bar[XB_TOPGEN], 1u);
            else XB_SPIN(xb_ld(&bar[XB_TOPGEN]) == tg, bar);
            __builtin_amdgcn_fence(__ATOMIC_ACQUIRE, "agent");
            xb_add(&bar[XB_XGEN(b.x)], 1u);
            asm volatile("s_waitcnt vmcnt(0)" ::: "memory");
        } else {
            XB_SPIN(xb_ld(&bar[XB_XGEN(b.x)]) == gen, bar);
            __builtin_amdgcn_fence(__ATOMIC_ACQUIRE, "agent");
            asm volatile("s_waitcnt vmcnt(0)" ::: "memory");
        }
    }
    wg_sync();
}

__device__ __forceinline__ const void* kin(int k) {
    typedef __attribute__((address_space(4))) const char* kptr_t;
    kptr_t p = (kptr_t)__builtin_amdgcn_kernarg_segment_ptr(); asm volatile("" : "+s"(p));
    const unsigned long long v = *(__attribute__((address_space(4))) const unsigned long long*)(p + 8 * k);
    return (const void*)(GAS const void*)v;
}
struct Frame {
    LAS unsigned char* lds;
    int tid, lane, wave, vcu, G, l;
    unsigned char* ws; float* out;
#define FIN(name, T, k) __device__ __forceinline__ const T* name() const { return (const T*)kin(k); }
    FIN(x, float, 0) FIN(pos, int, 1) FIN(g_mix, float, 2) FIN(w_in, float, 3) FIN(a_re, float, 4) FIN(a_im, float, 5) FIN(log_dt, float, 6) FIN(b_re, float, 7) FIN(b_im, float, 8)
    FIN(c_re, float, 9) FIN(c_im, float, 10) FIN(s5_d, float, 11) FIN(w_glu, float, 12) FIN(gla_wg, float, 13) FIN(gla_bg, float, 14) FIN(pool_w, float, 15) FIN(pool_scale, float, 16)
    FIN(w_branch, float, 17) FIN(w_out, float, 18) FIN(g_ffn, float, 19) FIN(w_up, float, 20) FIN(conv_w, float, 21) FIN(conv_b, float, 22) FIN(w_down, float, 23) FIN(g_final, float, 24)
#undef FIN
#define FWS(name, T, off) __device__ __forceinline__ T* name() const { return (T*)(ws + (off)); }
    FWS(rotc, float, WS_ROT) FWS(rots, float, WS_ROT + (size_t)M * 32 * 4) FWS(abar, float, WS_S5T + S5T_ABAR) FWS(apow, float, WS_S5T + S5T_APOW) FWS(bbar, float, WS_S5T + S5T_BBAR) FWS(cmt, bf16_t, WS_S5T + S5T_CMT) FWS(bbt, bf16_t, WS_S5T + S5T_BBT)
    FWS(wglu_t, bf16_t, WS_WGLU) FWS(poolw_t, bf16_t, WS_POOLW) FWS(win_t, bf16_t, WS_WIN) FWS(wbr_t, bf16_t, WS_WBR) FWS(wout_t, bf16_t, WS_WOUT) FWS(wup_t, bf16_t, WS_WUP) FWS(wdn_t, bf16_t, WS_WDN)
    FWS(HN8, unsigned char, WS_HN8) FWS(W8, unsigned char, WS_W8) FWS(HN, bf16_t, WS_HN) FWS(Y, bf16_t, WS_Y) FWS(YBP, bf16_t, WS_YBP) FWS(PROJ, bf16_t, WS_PROJ) FWS(GF, bf16_t, WS_GF) FWS(SPREV, bf16_t, WS_SPREV) FWS(ACT, bf16_t, WS_ACT)
    FWS(SS, float, WS_SS + (size_t)l * 32 * M * 4) FWS(RS, float, WS_RS + (size_t)l * M * 4) FWS(STATE, float, WS_STATE) FWS(DEC, float, WS_DEC) FWS(XEND, float, WS_XEND) FWS(UH, float, WS_UH)
#undef FWS
};

__device__ __forceinline__ float lane_read(float v, int src_lane) { return __builtin_bit_cast(float, __builtin_amdgcn_ds_bpermute(src_lane << 2, __builtin_bit_cast(int, v))); }
__device__ __forceinline__ float wave_sum(float v, int lane) {
#pragma unroll
    for (int o = 1; o < 64; o <<= 1) v += lane_read(v, lane ^ o);
    return v;
}

template <class SrcCol>
__device__ __forceinline__ void transpose_item(const float* W, int Nsrc, bf16_t* WT, int ldt, int kdst0, int k0, int n0, SrcCol srccol, LAS float* scr, int lane, const float* kscale = nullptr) {
    const int sc = srccol(n0 + (lane & 31));
    float wv[32];
#pragma unroll
    for (int i = 0; i < 32; ++i) { const int kk = 2 * i + (lane >> 5); wv[i] = sc >= 0 ? W[(size_t)(k0 + kk) * Nsrc + sc] : 0.f; }
#pragma unroll
    for (int i = 0; i < 32; ++i) { const int kk = 2 * i + (lane >> 5); scr[kk * 33 + (lane & 31)] = kscale ? wv[i] * kscale[k0 + kk] : wv[i]; }
    LDS_WAIT();
    const int c = lane & 7;
#pragma unroll
    for (int j = 0; j < 4; ++j) { const int n = (lane >> 3) + 8 * j; const LAS float* s = scr + (8 * c) * 33 + n;
        u32x4 o; o.x = pk2(s[0 * 33], s[1 * 33]); o.y = pk2(s[2 * 33], s[3 * 33]); o.z = pk2(s[4 * 33], s[5 * 33]); o.w = pk2(s[6 * 33], s[7 * 33]);
        *(u32x4*)(WT + (size_t)(n0 + n) * ldt + kdst0 + k0 + 8 * c) = o; }
    LDS_WAIT();
}
template <class SrcCol>
__device__ __forceinline__ void transpose_item_fp8(const float* W, int Nsrc, unsigned char* WT, int ldt, int k0, int n0src, int n0dst, SrcCol srccol, LAS float* scr, int lane, const float* kscale, float scale) {
    const int sc = srccol(n0src + (lane & 31));
    float wv[32];
#pragma unroll
    for (int i = 0; i < 32; ++i) { const int kk = 2 * i + (lane >> 5); wv[i] = sc >= 0 ? W[(size_t)(k0 + kk) * Nsrc + sc] : 0.f; }
#pragma unroll
    for (int i = 0; i < 32; ++i) { const int kk = 2 * i + (lane >> 5); scr[kk * 33 + (lane & 31)] = (kscale ? wv[i] * kscale[k0 + kk] : wv[i]) * scale; }
    LDS_WAIT();
    const int c = lane & 7;
#pragma unroll
    for (int j = 0; j < 4; ++j) { const int n = (lane >> 3) + 8 * j; const LAS float* s = scr + (8 * c) * 33 + n;
        u32x2 o; o.x = pk4_fp8(s[0 * 33], s[1 * 33], s[2 * 33], s[3 * 33]); o.y = pk4_fp8(s[4 * 33], s[5 * 33], s[6 * 33], s[7 * 33]);
        *(u32x2*)(WT + (size_t)(n0dst + n) * ldt + k0 + 8 * c) = o; }
    LDS_WAIT();
}
struct ColIdent { __device__ __forceinline__ int operator()(int n) const { return n; } };
struct ColWin { __device__ __forceinline__ int operator()(int n) const {
    if (n < 3584) return n; if (n < 4096) return n + 16; if (n < 4112) return n - 512; if (n < 4352) return -1;
    const int t = (n - 4352) >> 8, cl = (n - 4352) & 255; const int br = 2 * (cl >> 7) + ((cl >> 2) & 1), ch = 16 * ((cl >> 5) & 3) + 4 * ((cl >> 3) & 3) + (cl & 3);
    return 4112 + br * 2048 + 64 * t + ch; } };
struct ColWup { __device__ __forceinline__ int operator()(int n) const { const int blk = n >> 8, r = n & 255; return (r < 128) ? (blk * 128 + r) : (DFF + blk * 128 + (r - 128)); } };

__device__ __forceinline__ void rms_row_to_bf16(const float* xrow, const float* g, bf16_t* orow, int lane, unsigned char* orow8 = nullptr) {
    const f32x4* xr = (const f32x4*)xrow + lane; const f32x4* gr = (const f32x4*)g + lane;
    f32x4 v[8]; float s = 0.f;
#pragma unroll
    for (int j = 0; j < 8; ++j) { v[j] = xr[64 * j]; s += (v[j].x * v[j].x + v[j].y * v[j].y) + (v[j].z * v[j].z + v[j].w * v[j].w); }
    const float r = 1.0f / sqrtf(wave_sum(s, lane) * (1.f / D) + EPS);
    u32x2* o8 = (u32x2*)orow + lane;
#pragma unroll
    for (int j = 0; j < 8; ++j) { const f32x4 gg = gr[64 * j]; const float a = v[j].x * r * gg.x, b = v[j].y * r * gg.y, c = v[j].z * r * gg.z, d = v[j].w * r * gg.w; u32x2 w; w.x = pk2(a, b); w.y = pk2(c, d); o8[64 * j] = w;
        if (orow8) ((unsigned*)orow8)[lane + 64 * j] = pk4_fp8(a, b, c, d); }
}
__device__ __forceinline__ void rms_rows(Frame& F, const float* src, const float* g, bf16_t* dst, unsigned char* dst8 = nullptr) {
    const int gw = F.vcu * NWAVES + F.wave, NGW = F.G * NWAVES;
    for (int m = gw; m < M; m += NGW) rms_row_to_bf16(src + (size_t)m * D, g, dst + (size_t)m * D, F.lane, dst8 ? dst8 + (size_t)m * D : nullptr);
}
__device__ __forceinline__ void row_scale(Frame& F) {
    const int gt = F.vcu * (NWAVES * 64) + F.tid, NGT = F.G * NWAVES * 64;
    for (int m = gt; m < M; m += NGT) { float s = 0.f;
#pragma unroll
        for (int j = 0; j < 32; ++j) s += F.SS()[(size_t)j * M + m];
        const int r = m & 255;
        F.RS()[((size_t)((m >> 8) * 2 + ((r >> 6) & 1)) * 16 + (r & 15)) * 8 + (r >> 7) * 4 + ((r >> 4) & 3)] = 1.0f / sqrtf(s * (1.f / D) + EPS); }
}
__device__ __forceinline__ void rms_rows16(Frame& F, const bf16_t* src, const float* g, bf16_t* dst, unsigned char* dst8) {
    const int gw = F.vcu * NWAVES + F.wave, NGW = F.G * NWAVES, lane = F.lane;
    for (int m = gw; m < M; m += NGW) {
        const u32x4* xr = (const u32x4*)(src + (size_t)m * D) + lane; float v[4][8]; float s = 0.f;
#pragma unroll
        for (int j = 0; j < 4; ++j) { unpack8(xr[64 * j], v[j]);
#pragma unroll
            for (int q = 0; q < 8; ++q) s += v[j][q] * v[j][q]; }
        const float r = 1.0f / sqrtf(wave_sum(s, lane) * (1.f / D) + EPS);
        u32x4* o16 = (u32x4*)(dst + (size_t)m * D) + lane; u32x2* o8 = (u32x2*)(dst8 + (size_t)m * D) + lane;
#pragma unroll
        for (int j = 0; j < 4; ++j) { const f32x4 g0 = *((const f32x4*)g + 2 * (lane + 64 * j)), g1 = *((const f32x4*)g + 2 * (lane + 64 * j) + 1); float y[8];
            y[0] = v[j][0] * r * g0.x; y[1] = v[j][1] * r * g0.y; y[2] = v[j][2] * r * g0.z; y[3] = v[j][3] * r * g0.w; y[4] = v[j][4] * r * g1.x; y[5] = v[j][5] * r * g1.y; y[6] = v[j][6] * r * g1.z; y[7] = v[j][7] * r * g1.w;
            o16[64 * j] = pack8(y); u32x2 w8; w8.x = pk4_fp8(y[0], y[1], y[2], y[3]); w8.y = pk4_fp8(y[4], y[5], y[6], y[7]); o8[64 * j] = w8; }
    }
}
__device__ __forceinline__ void rms_rows16_to_f32(Frame& F, const bf16_t* src, const float* g, float* out) {
    const int gw = F.vcu * NWAVES + F.wave, NGW = F.G * NWAVES, lane = F.lane;
    for (int m = gw; m < M; m += NGW) {
        const u32x4* xr = (const u32x4*)(src + (size_t)m * D) + lane; float v[4][8]; float s = 0.f;
#pragma unroll
        for (int j = 0; j < 4; ++j) { unpack8(xr[64 * j], v[j]);
#pragma unroll
            for (int q = 0; q < 8; ++q) s += v[j][q] * v[j][q]; }
        const float r = 1.0f / sqrtf(wave_sum(s, lane) * (1.f / D) + EPS);
        f32x4* o = (f32x4*)(out + (size_t)m * D);
#pragma unroll
        for (int j = 0; j < 4; ++j) { const f32x4 g0 = *((const f32x4*)g + 2 * (lane + 64 * j)), g1 = *((const f32x4*)g + 2 * (lane + 64 * j) + 1);
            o[2 * (lane + 64 * j)] = (f32x4){v[j][0] * r * g0.x, v[j][1] * r * g0.y, v[j][2] * r * g0.z, v[j][3] * r * g0.w};
            o[2 * (lane + 64 * j) + 1] = (f32x4){v[j][4] * r * g1.x, v[j][5] * r * g1.y, v[j][6] * r * g1.z, v[j][7] * r * g1.w}; }
    }
}
__device__ __forceinline__ void rms_rows_f32_inplace(Frame& F, float* buf, const float* g) {
    const int gw = F.vcu * NWAVES + F.wave, NGW = F.G * NWAVES;
    for (int m = gw; m < M; m += NGW) {
        f32x4* xr = (f32x4*)(buf + (size_t)m * D) + F.lane; const f32x4* gr = (const f32x4*)g + F.lane;
        f32x4 v[8]; float s = 0.f;
#pragma unroll
        for (int j = 0; j < 8; ++j) { v[j] = xr[64 * j]; s += (v[j].x * v[j].x + v[j].y * v[j].y) + (v[j].z * v[j].z + v[j].w * v[j].w); }
        const float r = 1.0f / sqrtf(wave_sum(s, F.lane) * (1.f / D) + EPS);
#pragma unroll
        for (int j = 0; j < 8; ++j) { const f32x4 gg = gr[64 * j]; xr[64 * j] = (f32x4){v[j].x * r * gg.x, v[j].y * r * gg.y, v[j].z * r * gg.z, v[j].w * r * gg.w}; }
    }
}

__device__ __forceinline__ void phase_prep(Frame& F, int l) {
    LAS float* scr = (LAS float*)(F.lds + F.wave * 16384);
    const int gw = F.vcu * NWAVES + F.wave, NGW = F.G * NWAVES;
    constexpr int I_IN = (D / 64) * (NIN / 32), I_UP = (D / 64) * (NUP / 32), I_DN = (DFF / 64) * (D / 32), I_BR = 4 * (BW / 64) * (D / 32), I_OUT = (D / 64) * (D / 32), I_GLU = (BW / 64) * (BW / 32), I_PL = 4 * (128 / 64) * (128 / 32);
    constexpr int NITEMS = I_IN + I_UP + I_DN + I_BR + I_OUT + I_GLU + I_PL;
    for (int it = gw; it < NITEMS; it += NGW) {
        int r = it;
        if (r < I_IN) { const int nb = NIN / 32, n0 = 32 * (r % nb);
            if (n0 < C_GATE) transpose_item(F.w_in() + (size_t)l * D * NIN_SRC, NIN_SRC, F.win_t(), D, 0, 64 * (r / nb), n0, ColWin(), scr, F.lane);
            else transpose_item_fp8(F.w_in() + (size_t)l * D * NIN_SRC, NIN_SRC, F.W8(), D, 64 * (r / nb), n0, n0 - C_GATE, ColWin(), scr, F.lane, nullptr, 64.0f);
            continue; } r -= I_IN;
        if (r < I_UP) { const int nb = NUP / 32; transpose_item(F.w_up() + (size_t)l * D * NUP, NUP, F.wup_t(), D, 0, 64 * (r / nb), 32 * (r % nb), ColWup(), scr, F.lane, F.g_ffn() + (size_t)l * D); continue; } r -= I_UP;
        if (r < I_DN) { const int nb = D / 32; transpose_item(F.w_down() + (size_t)l * DFF * D, D, F.wdn_t(), DFF, 0, 64 * (r / nb), 32 * (r % nb), ColIdent(), scr, F.lane); continue; } r -= I_DN;
        if (r < I_BR) { const int per = (BW / 64) * (D / 32), br = r / per, q = r % per, nb = D / 32;
            transpose_item(F.w_branch() + ((size_t)l * 4 + br) * BW * D, D, F.wbr_t(), D, br * BW, 64 * (q / nb), 32 * (q % nb), ColIdent(), scr, F.lane); continue; } r -= I_BR;
        if (r < I_OUT) { const int nb = D / 32; transpose_item(F.w_out() + (size_t)l * D * D, D, F.wout_t(), D, 0, 64 * (r / nb), 32 * (r % nb), ColIdent(), scr, F.lane); continue; } r -= I_OUT;
        if (r < I_GLU) { const int nb = BW / 32; transpose_item(F.w_glu() + (size_t)l * BW * BW, BW, F.wglu_t(), BW, 0, 64 * (r / nb), 32 * (r % nb), ColIdent(), scr, F.lane); continue; } r -= I_GLU;
        { const int grp = r / 8, q = r % 8; transpose_item(F.pool_w() + ((size_t)l * 4 + grp) * 128 * 128, 128, F.poolw_t() + (size_t)grp * 128 * 128, 128, 0, 64 * (q / 4), 32 * (q % 4), ColIdent(), scr, F.lane); }
    }
    const int gt = F.vcu * (NWAVES * 64) + F.tid, NGT = F.G * NWAVES * 64;
    for (int i = gt; i < 32 * 64; i += NGT) {
        const int g = i >> 6;
        const float are = F.a_re()[(size_t)l * 2048 + i], aim = F.a_im()[(size_t)l * 2048 + i], dt = expf(F.log_dt()[l * 32 + g]);
        const float mag = expf(are * dt), th = aim * dt;
        const float abr = mag * cosf(th), abi = mag * sinf(th);
        const float den = are * are + aim * aim, nr = abr - 1.0f, ni = abi;
        const float fre = (nr * are + ni * aim) / den, fim = (ni * are - nr * aim) / den;
        F.abar()[2 * i] = abr; F.abar()[2 * i + 1] = abi;
        float pr = abr, pi = abi;
#pragma unroll
        for (int q = 0; q < 6; ++q) { const float tr = pr * pr - pi * pi, ti = 2.f * pr * pi; pr = tr; pi = ti; }
        F.apow()[2 * i] = pr; F.apow()[2 * i + 1] = pi;
        const float* br = F.b_re() + ((size_t)l * 2048 + i) * 16; const float* bi = F.b_im() + ((size_t)l * 2048 + i) * 16;
#pragma unroll
        for (int c = 0; c < 16; ++c) { const float x = br[c], y = bi[c]; const float vr = fre * x - fim * y, vi = fre * y + fim * x; const int p = i & 63;
            F.bbt()[((size_t)g * 128 + p) * 16 + c] = (bf16_t)f2bf(vr); F.bbt()[((size_t)g * 128 + 64 + p) * 16 + c] = (bf16_t)f2bf(vi); }
    }
    for (int i = gt; i < 32 * 16 * 128; i += NGT) {
        const int k = i & 127, gc = i >> 7;
        const float v = (k < 64) ? F.c_re()[((size_t)l * 512 + gc) * 64 + k] : -F.c_im()[((size_t)l * 512 + gc) * 64 + (k - 64)];
        F.cmt()[i] = (bf16_t)f2bf(v);
    }
    if (l == 0) {
        for (int i = gt; i < M * 32; i += NGT) {
            const int row = i >> 5, j = i & 31;
            const float inv = exp2f(-(float)j * (13.287712379549449f / 32.0f));
            const float ang = (float)F.pos()[row] * inv;
            F.rotc()[i] = cosf(ang); F.rots()[i] = sinf(ang);
        }
    }
    if (l == 0) rms_rows(F, F.x(), F.g_mix(), F.HN(), F.HN8()); else rms_rows16(F, (const bf16_t*)F.out, F.g_mix() + (size_t)l * D, F.HN(), F.HN8());
}

__device__ __forceinline__ void gr_pass(Frame& F) {
    const int gw = F.vcu * NWAVES + F.wave, NGW = F.G * NWAVES, lane = F.lane, lr = lane & 15, lq = lane >> 4;
    for (int unit = gw; unit < M / 16; unit += NGW) {
        const bf16_t* ap = F.HN() + (size_t)(16 * unit + lr) * D + 8 * lq; const bf16_t* bp = F.win_t() + (size_t)(C_GR + lr) * D + 8 * lq;
        f32x4 acc = (f32x4){0.f, 0.f, 0.f, 0.f};
#pragma unroll 1
        for (int kb = 0; kb < 64; kb += 8) { bf16x8 a[8], b[8];
#pragma unroll
            for (int j = 0; j < 8; ++j) { a[j] = *(const bf16x8*)(ap + 32 * (kb + j)); b[j] = *(const bf16x8*)(bp + 32 * (kb + j)); }
#pragma unroll
            for (int j = 0; j < 8; ++j) acc = __builtin_amdgcn_mfma_f32_16x16x32_bf16(a[j], b[j], acc, 0, 0, 0); }
#pragma unroll
        for (int i = 0; i < 4; ++i) F.PROJ()[(size_t)(16 * unit + 4 * lq + i) * LDP + C_GR + lr] = (bf16_t)f2bf(acc[i]);
    }
}

__device__ __forceinline__ f32x4 mma_nt_lds(const LAS bf16_t* X, int px, const LAS bf16_t* Y, int py, int ksteps, f32x4 acc, int lane) {
    const LAS bf16_t* xp = X + (lane & 15) * px + 8 * (lane >> 4);
    const LAS bf16_t* yp = Y + (lane & 15) * py + 8 * (lane >> 4);
    for (int ks = 0; ks < ksteps; ++ks) {
        const bf16x8 a = *(const LAS bf16x8*)(xp + 32 * ks), b = *(const LAS bf16x8*)(yp + 32 * ks);
        acc = __builtin_amdgcn_mfma_f32_16x16x32_bf16(a, b, acc, 0, 0, 0);
    }
    return acc;
}

constexpr int LN_TOT = 16384, LN_QD = 18432, LN_KI = 27648, LN_PM = 36864, LN_VT = 46080, LN_OB = 64512, LN_WG = 98304, LN_END = 98304 + 4096 + 256;
constexpr int LP = 72;
struct LinRaw { u32x4 q0, q1, k0, k1, v0, v1, g0, g1, gr0, gr1; f32x4 c0, c1, s0, s1; bf16x8 sp0, sp1; };
template <bool OUT>
__device__ __forceinline__ void lin_issue(Frame& F, int unit, LinRaw& R) {
    const int n = unit & 63, h = (unit >> 6) & 3, b = (unit >> 8) & 7, mixer = unit >> 11;
    const size_t row0 = (size_t)b * SEQ + (size_t)n * CH; const int s = F.tid >> 3, c = F.tid & 7;
    const int cq = (mixer == 0 ? C_RQ : C_GQ) + h * 64, ck = (mixer == 0 ? C_RK : C_GK) + h * 64, cv = (mixer == 0 ? C_RV : C_GV) + h * 128, cg = (mixer == 0 ? C_RG : C_GG) + h * 128;
    const bf16_t* pr = F.PROJ() + (row0 + s) * LDP;
    R.k0 = *(const u32x4*)(pr + ck + 8 * c); R.k1 = *(const u32x4*)(pr + ck + 8 * (c ^ 4));
    if (OUT) { R.q0 = *(const u32x4*)(pr + cq + 8 * c); R.q1 = *(const u32x4*)(pr + cq + 8 * (c ^ 4)); }
    { const float* cp = F.rotc() + (row0 + s) * 32 + (c & 3) * 8; const float* sp = F.rots() + (row0 + s) * 32 + (c & 3) * 8;
      R.c0 = *(const f32x4*)cp; R.c1 = *(const f32x4*)(cp + 4); R.s0 = *(const f32x4*)sp; R.s1 = *(const f32x4*)(sp + 4); }
    R.gr0 = *(const u32x4*)(pr + C_GR); R.gr1 = *(const u32x4*)(pr + C_GR + 8);
    R.v0 = *(const u32x4*)(F.PROJ() + (row0 + (F.tid >> 4)) * LDP + cv + (F.tid & 15) * 8);
    R.v1 = *(const u32x4*)(F.PROJ() + (row0 + 32 + (F.tid >> 4)) * LDP + cv + (F.tid & 15) * 8);
    if (OUT) { R.g0 = *(const u32x4*)(pr + cg + 16 * c); R.g1 = *(const u32x4*)(pr + cg + 16 * c + 8);
        const bf16_t* sq = F.SPREV() + (size_t)unit * 8192 + (size_t)(16 * F.wave + (F.lane & 15)) * 64 + 8 * (F.lane >> 4);
        R.sp0 = *(const bf16x8*)sq; R.sp1 = *(const bf16x8*)(sq + 32); }
}
__device__ __forceinline__ void lin_rot(const u32x4 own_, const u32x4 oth_, const LinRaw& R, bool rot, bool hi, float scale, float (&v)[8]) {
    float own[8]; unpack8(own_, own);
    if (!rot) {
#pragma unroll
        for (int j = 0; j < 8; ++j) v[j] = own[j] * scale;
        return; }
    float oth[8]; unpack8(oth_, oth);
    const float cs[8] = {R.c0.x, R.c0.y, R.c0.z, R.c0.w, R.c1.x, R.c1.y, R.c1.z, R.c1.w}, sn[8] = {R.s0.x, R.s0.y, R.s0.z, R.s0.w, R.s1.x, R.s1.y, R.s1.z, R.s1.w};
#pragma unroll
    for (int j = 0; j < 8; ++j) { const float os = oth[j] * sn[j]; v[j] = (own[j] * cs[j] + (hi ? os : -os)) * scale; }
}
__device__ __forceinline__ void lin_decay(Frame& F, int mixer, int h, const LinRaw& R, float (&bcum)[8], float (&blast)[8]) {
    LAS float* TOT = (LAS float*)(F.lds + LN_TOT);
    const int s = F.tid >> 3, c = F.tid & 7, d0 = 8 * c;
    if (mixer == 0) {
        const float lg = __logf(1.0f - exp2f(-5.0f - (float)h));
#pragma unroll
        for (int j = 0; j < 8; ++j) { bcum[j] = (float)(s + 1) * lg; blast[j] = 64.0f * lg; }
        lds_sync();
        return;
    }
    const LAS float* WG = (const LAS float*)(F.lds + LN_WG);
    float grf[16]; { float a[8], b2[8]; unpack8(R.gr0, a); unpack8(R.gr1, b2);
#pragma unroll
        for (int j = 0; j < 8; ++j) { grf[j] = a[j]; grf[8 + j] = b2[j]; } }
    float x[8]; { const f32x4 b0 = *(const LAS f32x4*)(WG + 1024 + d0), b1 = *(const LAS f32x4*)(WG + 1024 + d0 + 4); x[0] = b0.x; x[1] = b0.y; x[2] = b0.z; x[3] = b0.w; x[4] = b1.x; x[5] = b1.y; x[6] = b1.z; x[7] = b1.w; }
#pragma unroll
    for (int r = 0; r < 16; ++r) { const f32x4 w0 = *(const LAS f32x4*)(WG + r * 64 + d0), w1 = *(const LAS f32x4*)(WG + r * 64 + d0 + 4);
        x[0] += grf[r] * w0.x; x[1] += grf[r] * w0.y; x[2] += grf[r] * w0.z; x[3] += grf[r] * w0.w; x[4] += grf[r] * w1.x; x[5] += grf[r] * w1.y; x[6] += grf[r] * w1.z; x[7] += grf[r] * w1.w; }
#pragma unroll
    for (int j = 0; j < 8; ++j) x[j] = logsigmoidf_(x[j]) * (1.0f / 16.0f);
#pragma unroll
    for (int st = 8; st <= 32; st <<= 1) {
#pragma unroll
        for (int j = 0; j < 8; ++j) { const float t = lane_read(x[j], F.lane - st); if (F.lane >= st) x[j] += t; } }
    if ((F.lane >> 3) == 7) { *(LAS f32x4*)(TOT + F.wave * 64 + d0) = (f32x4){x[0], x[1], x[2], x[3]}; *(LAS f32x4*)(TOT + F.wave * 64 + d0 + 4) = (f32x4){x[4], x[5], x[6], x[7]}; }
    lds_sync();
    float off[8], tot[8];
#pragma unroll
    for (int j = 0; j < 8; ++j) { off[j] = 0.f; tot[j] = 0.f; }
#pragma unroll
    for (int w = 0; w < 8; ++w) { const f32x4 t0 = *(const LAS f32x4*)(TOT + w * 64 + d0), t1 = *(const LAS f32x4*)(TOT + w * 64 + d0 + 4); const float tv[8] = {t0.x, t0.y, t0.z, t0.w, t1.x, t1.y, t1.z, t1.w};
#pragma unroll
        for (int j = 0; j < 8; ++j) { tot[j] += tv[j]; off[j] += (w < F.wave) ? tv[j] : 0.f; } }
#pragma unroll
    for (int j = 0; j < 8; ++j) { bcum[j] = x[j] + off[j]; blast[j] = tot[j]; }
}
typedef short v4s_t __attribute__((ext_vector_type(4)));
__device__ __forceinline__ bf16x8 tr_frag(const LAS bf16_t* T, int pitch, int k0, int x0, int lane) {
    const int g = lane >> 4, i = lane & 15, q = i >> 2, p = i & 3;
    const LAS bf16_t* a = T + (k0 + 8 * g + q) * pitch + x0 + 4 * p;
    const v4s_t lo = __builtin_amdgcn_ds_read_tr16_b64_v4i16((LAS v4s_t*)a), hi = __builtin_amdgcn_ds_read_tr16_b64_v4i16((LAS v4s_t*)(a + 4 * pitch));
    return __builtin_shufflevector(lo, hi, 0, 1, 2, 3, 4, 5, 6, 7);
}
constexpr int PV = 144;
__device__ __forceinline__ void lin_store_vt(Frame& F, const LinRaw& R) {
    LAS bf16_t* VR = (LAS bf16_t*)(F.lds + LN_VT); const int e0 = (F.tid & 15) * 8;
    *(LAS u32x4*)(VR + (F.tid >> 4) * PV + e0) = R.v0; *(LAS u32x4*)(VR + (32 + (F.tid >> 4)) * PV + e0) = R.v1;
}
__device__ __forceinline__ void lin_state_compute(Frame& F, int unit, const LinRaw& R) {
    const int h = (unit >> 6) & 3, mixer = unit >> 11; const int s = F.tid >> 3, c = F.tid & 7, d0 = 8 * c;
    LAS bf16_t* KDT = (LAS bf16_t*)(F.lds + LN_KI); LAS bf16_t* VT = (LAS bf16_t*)(F.lds + LN_VT);
    float k[8], bcum[8], blast[8];
    lin_rot(R.k0, R.k1, R, mixer == 0, c >= 4, mixer == 0 ? 0.125f : 1.0f, k);
    lin_decay(F, mixer, h, R, bcum, blast);
    { float kd[8];
#pragma unroll
      for (int j = 0; j < 8; ++j) kd[j] = k[j] * __expf(blast[j] - bcum[j]);
      *(LAS u32x4*)(KDT + s * LP + d0) = pack8(kd); }
    lin_store_vt(F, R);
    if (s == 0) { float* dc = F.DEC() + (size_t)unit * 64 + d0;
        *(f32x4*)dc = (f32x4){__expf(blast[0]), __expf(blast[1]), __expf(blast[2]), __expf(blast[3])}; *(f32x4*)(dc + 4) = (f32x4){__expf(blast[4]), __expf(blast[5]), __expf(blast[6]), __expf(blast[7])}; }
    lds_sync();
    { const int w = F.wave, lane = F.lane; float* st = F.STATE() + (size_t)unit * 8192;
      const bf16x8 vf0 = tr_frag(VT, PV, 0, 16 * w, lane), vf1 = tr_frag(VT, PV, 32, 16 * w, lane);
#pragma unroll
      for (int dt = 0; dt < 4; ++dt) { f32x4 acc = (f32x4){0.f, 0.f, 0.f, 0.f};
          acc = __builtin_amdgcn_mfma_f32_16x16x32_bf16(vf0, tr_frag(KDT, LP, 0, 16 * dt, lane), acc, 0, 0, 0);
          acc = __builtin_amdgcn_mfma_f32_16x16x32_bf16(vf1, tr_frag(KDT, LP, 32, 16 * dt, lane), acc, 0, 0, 0);
#pragma unroll
          for (int i = 0; i < 4; ++i) st[(16 * w + 4 * (lane >> 4) + i) * 64 + 16 * dt + (lane & 15)] = acc[i]; } }
}
__device__ __forceinline__ void lin_out_compute(Frame& F, int unit, const LinRaw& R) {
    const int n = unit & 63, h = (unit >> 6) & 3, b = (unit >> 8) & 7, mixer = unit >> 11;
    const size_t row0 = (size_t)b * SEQ + (size_t)n * CH; const int s = F.tid >> 3, c = F.tid & 7, d0 = 8 * c;
    const int ycol = (mixer == 0 ? 0 : 1024) + h * 128;
    LAS bf16_t* QD = (LAS bf16_t*)(F.lds + LN_QD); LAS bf16_t* KI = (LAS bf16_t*)(F.lds + LN_KI); LAS bf16_t* PM = (LAS bf16_t*)(F.lds + LN_PM);
    LAS bf16_t* VT = (LAS bf16_t*)(F.lds + LN_VT); LAS float* OB = (LAS float*)(F.lds + LN_OB);
    float q[8], k[8], bcum[8], blast[8];
    lin_rot(R.q0, R.q1, R, mixer == 0, c >= 4, mixer == 0 ? 1.0f : 0.125f, q);
    lin_rot(R.k0, R.k1, R, mixer == 0, c >= 4, mixer == 0 ? 0.125f : 1.0f, k);
    lin_decay(F, mixer, h, R, bcum, blast);
    { float qd[8], ki[8];
#pragma unroll
      for (int j = 0; j < 8; ++j) { qd[j] = q[j] * __expf(bcum[j]); ki[j] = k[j] * __expf(-bcum[j]); }
      *(LAS u32x4*)(QD + s * LP + d0) = pack8(qd); *(LAS u32x4*)(KI + s * LP + d0) = pack8(ki); }
    lin_store_vt(F, R);
    lds_sync();
    { const int lane = F.lane;
#pragma unroll
      for (int j = 0; j < 2; ++j) { const int tile = 2 * F.wave + j, tt = tile >> 2, st = tile & 3;
          f32x4 acc = (f32x4){0.f, 0.f, 0.f, 0.f};
          if (st <= tt) acc = mma_nt_lds(QD + 16 * tt * LP, LP, KI + 16 * st * LP, LP, 2, acc, lane);
#pragma unroll
          for (int i = 0; i < 4; ++i) { const int t = 16 * tt + 4 * (lane >> 4) + i, s2 = 16 * st + (lane & 15); const float p = (st <= tt && s2 <= t) ? acc[i] : 0.f; PM[t * LP + s2] = (bf16_t)f2bf(p); } } }
    lds_sync();
    { const int w = F.wave, lane = F.lane;
      const bf16x8 vf0 = tr_frag(VT, PV, 0, 16 * w, lane), vf1 = tr_frag(VT, PV, 32, 16 * w, lane);
#pragma unroll
      for (int tt = 0; tt < 4; ++tt) { f32x4 acc = (f32x4){0.f, 0.f, 0.f, 0.f};
          { const LAS bf16_t* pp = PM + (16 * tt + (lane & 15)) * LP + 8 * (lane >> 4);
            acc = __builtin_amdgcn_mfma_f32_16x16x32_bf16(*(const LAS bf16x8*)pp, vf0, acc, 0, 0, 0);
            acc = __builtin_amdgcn_mfma_f32_16x16x32_bf16(*(const LAS bf16x8*)(pp + 32), vf1, acc, 0, 0, 0); }
          const LAS bf16_t* xp = QD + (16 * tt + (lane & 15)) * LP + 8 * (lane >> 4);
          acc = __builtin_amdgcn_mfma_f32_16x16x32_bf16(*(const LAS bf16x8*)xp, R.sp0, acc, 0, 0, 0);
          acc = __builtin_amdgcn_mfma_f32_16x16x32_bf16(*(const LAS bf16x8*)(xp + 32), R.sp1, acc, 0, 0, 0);
#pragma unroll
          for (int i = 0; i < 4; ++i) OB[(16 * tt + 4 * (lane >> 4) + i) * 132 + 16 * w + (lane & 15)] = acc[i]; } }
    lds_sync();
    { const int t = s, part = c; float o[16];
#pragma unroll
      for (int j = 0; j < 4; ++j) { const f32x4 v = *(const LAS f32x4*)(OB + t * 132 + 16 * part + 4 * j); o[4 * j] = v.x; o[4 * j + 1] = v.y; o[4 * j + 2] = v.z; o[4 * j + 3] = v.w; }
      float sm = 0.f;
#pragma unroll
      for (int j = 0; j < 16; ++j) sm += o[j];
      sm += lane_read(sm, F.lane ^ 1); sm += lane_read(sm, F.lane ^ 2); sm += lane_read(sm, F.lane ^ 4);
      const float mu = sm * (1.0f / 128.0f); float qv = 0.f;
#pragma unroll
      for (int j = 0; j < 16; ++j) { const float dlt = o[j] - mu; qv += dlt * dlt; }
      qv += lane_read(qv, F.lane ^ 1); qv += lane_read(qv, F.lane ^ 2); qv += lane_read(qv, F.lane ^ 4);
      const float r = 1.0f / sqrtf(qv * (1.0f / 128.0f) + EPS);
      float g0[8], g1[8]; unpack8(R.g0, g0); unpack8(R.g1, g1);
      float y0[8], y1[8];
#pragma unroll
      for (int j = 0; j < 8; ++j) { y0[j] = (o[j] - mu) * r * siluf_(g0[j]); y1[j] = (o[8 + j] - mu) * r * siluf_(g1[j]); }
      bf16_t* yp = F.Y() + (row0 + t) * D + ycol + 16 * part; *(u32x4*)yp = pack8(y0); *(u32x4*)(yp + 8) = pack8(y1); }
}
template <bool OUT>
__device__ __forceinline__ void lin_phase(Frame& F, int l) {
    { const int h = (F.vcu >> 6) & 3; LAS float* WG = (LAS float*)(F.lds + LN_WG);
      for (int i = F.tid; i < 16 * 64 + 64; i += NWAVES * 64) WG[i] = (i < 1024) ? F.gla_wg()[(size_t)l * 16 * 256 + (i >> 6) * 256 + h * 64 + (i & 63)] : F.gla_bg()[l * 256 + h * 64 + (i - 1024)];
      lds_sync(); }
    LinRaw A, B;
    lin_issue<OUT>(F, F.vcu, A);
    for (int u = F.vcu; u < 4096; u += 2 * F.G) {
        lin_issue<OUT>(F, u + F.G, B);
        if (OUT) lin_out_compute(F, u, A); else lin_state_compute(F, u, A);
        if (u + 2 * F.G < 4096) lin_issue<OUT>(F, u + 2 * F.G, A);
        if (OUT) lin_out_compute(F, u + F.G, B); else lin_state_compute(F, u + F.G, B);
    }
    lds_sync();
}
constexpr int L2_TOT = 0, L2_QD = 1024, L2_KI = 10240, L2_V = 19456, L2_SP = 37888, L2_PM = 56320, L2_STRIDE = 65536, L2_WG = 131072;
struct Lin2 { int unit, h, mixer, hw, s, c; size_t row0; LAS unsigned char* base; };
__device__ __forceinline__ void lin2_rot16(const u32x4 lo_, const u32x4 hi_, const f32x4 (&cs)[2], const f32x4 (&sn)[2], bool rot, float scale, float (&v)[16]) {
    float lo[8], hi[8]; unpack8(lo_, lo); unpack8(hi_, hi);
    if (!rot) {
#pragma unroll
        for (int j = 0; j < 8; ++j) { v[j] = lo[j] * scale; v[8 + j] = hi[j] * scale; }
    } else {
        const float c8[8] = {cs[0].x, cs[0].y, cs[0].z, cs[0].w, cs[1].x, cs[1].y, cs[1].z, cs[1].w}, s8[8] = {sn[0].x, sn[0].y, sn[0].z, sn[0].w, sn[1].x, sn[1].y, sn[1].z, sn[1].w};
#pragma unroll
        for (int j = 0; j < 8; ++j) { v[j] = (lo[j] * c8[j] - hi[j] * s8[j]) * scale; v[8 + j] = (hi[j] * c8[j] + lo[j] * s8[j]) * scale; }
    }
}
__device__ __forceinline__ void lin2_decay(Frame& F, const Lin2& L, const u32x4 gr0, const u32x4 gr1, float (&bcum)[16], float (&blast)[16]) {
    LAS float* TOT = (LAS float*)(L.base + L2_TOT);
    const int d0 = 8 * L.c;
    if (L.mixer == 0) {
        const float lg = __logf(1.0f - exp2f(-5.0f - (float)L.h));
#pragma unroll
        for (int j = 0; j < 16; ++j) { bcum[j] = (float)(L.s + 1) * lg; blast[j] = 64.0f * lg; }
        lds_sync();
        return;
    }
    const LAS float* WG = (const LAS float*)(F.lds + L2_WG);
    float grf[16]; { float a[8], b2[8]; unpack8(gr0, a); unpack8(gr1, b2);
#pragma unroll
        for (int j = 0; j < 8; ++j) { grf[j] = a[j]; grf[8 + j] = b2[j]; } }
    float x[16];
#pragma unroll
    for (int q = 0; q < 4; ++q) { const f32x4 b0 = *(const LAS f32x4*)(WG + 1024 + d0 + 32 * (q >> 1) + 4 * (q & 1)); x[4 * q] = b0.x; x[4 * q + 1] = b0.y; x[4 * q + 2] = b0.z; x[4 * q + 3] = b0.w; }
#pragma unroll
    for (int r = 0; r < 16; ++r) {
#pragma unroll
        for (int q = 0; q < 4; ++q) { const f32x4 w0 = *(const LAS f32x4*)(WG + r * 64 + d0 + 32 * (q >> 1) + 4 * (q & 1));
            x[4 * q] += grf[r] * w0.x; x[4 * q + 1] += grf[r] * w0.y; x[4 * q + 2] += grf[r] * w0.z; x[4 * q + 3] += grf[r] * w0.w; } }
#pragma unroll
    for (int j = 0; j < 16; ++j) x[j] = logsigmoidf_(x[j]) * (1.0f / 16.0f);
#pragma unroll
    for (int st = 4; st <= 32; st <<= 1) {
#pragma unroll
        for (int j = 0; j < 16; ++j) { const float t = lane_read(x[j], F.lane - st); if (F.lane >= st) x[j] += t; } }
    if ((F.lane >> 2) == 15) {
#pragma unroll
        for (int q = 0; q < 4; ++q) *(LAS f32x4*)(TOT + L.hw * 64 + d0 + 32 * (q >> 1) + 4 * (q & 1)) = (f32x4){x[4 * q], x[4 * q + 1], x[4 * q + 2], x[4 * q + 3]}; }
    lds_sync();
    float off[16], tot[16];
#pragma unroll
    for (int j = 0; j < 16; ++j) { off[j] = 0.f; tot[j] = 0.f; }
#pragma unroll
    for (int w = 0; w < 4; ++w) {
#pragma unroll
        for (int q = 0; q < 4; ++q) { const f32x4 t0 = *(const LAS f32x4*)(TOT + w * 64 + d0 + 32 * (q >> 1) + 4 * (q & 1)); const float tv[4] = {t0.x, t0.y, t0.z, t0.w};
#pragma unroll
            for (int j = 0; j < 4; ++j) { tot[4 * q + j] += tv[j]; off[4 * q + j] += (w < L.hw) ? tv[j] : 0.f; } } }
#pragma unroll
    for (int j = 0; j < 16; ++j) { bcum[j] = x[j] + off[j]; blast[j] = tot[j]; }
}
__device__ __forceinline__ bf16x8 tr_frag8(const LAS bf16_t* T, int pitch, int k0, int x0, int lane) {
    const int g = lane >> 4, i = lane & 15, q = i >> 2, p = i & 3;
    const LAS bf16_t* a = T + (k0 + 8 * g + q) * pitch + x0 + 8 * p;
    const v4s_t lo = __builtin_amdgcn_ds_read_tr16_b64_v4i16((LAS v4s_t*)a), hi = __builtin_amdgcn_ds_read_tr16_b64_v4i16((LAS v4s_t*)(a + 4 * pitch));
    return __builtin_shufflevector(lo, hi, 0, 1, 2, 3, 4, 5, 6, 7);
}
__device__ __forceinline__ void lin2_state(Frame& F, const Lin2& L) {
    const int ht = F.tid & 255, lane = F.lane, s = L.s, c = L.c, d0 = 8 * c;
    const int ck = (L.mixer == 0 ? C_RK : C_GK) + L.h * 64, cv = (L.mixer == 0 ? C_RV : C_GV) + L.h * 128;
    LAS bf16_t* KD = (LAS bf16_t*)(L.base + L2_KI); LAS bf16_t* VT = (LAS bf16_t*)(L.base + L2_V);
    const bf16_t* pr = F.PROJ() + (L.row0 + s) * LDP;
    u32x4 vv[4]; f32x4 cs[2], sn[2];
    const u32x4 klo = *(const u32x4*)(pr + ck + d0), khi = *(const u32x4*)(pr + ck + 32 + d0);
    { const float* cp = F.rotc() + (L.row0 + s) * 32 + d0; const float* sp = F.rots() + (L.row0 + s) * 32 + d0;
      cs[0] = *(const f32x4*)cp; cs[1] = *(const f32x4*)(cp + 4); sn[0] = *(const f32x4*)sp; sn[1] = *(const f32x4*)(sp + 4); }
    const u32x4 gr0 = *(const u32x4*)(pr + C_GR), gr1 = *(const u32x4*)(pr + C_GR + 8);
#pragma unroll
    for (int i = 0; i < 4; ++i) { const int idx = ht + 256 * i; vv[i] = *(const u32x4*)(F.PROJ() + (L.row0 + (idx >> 4)) * LDP + cv + (idx & 15) * 8); }
    float k[16], bcum[16], blast[16];
    lin2_rot16(klo, khi, cs, sn, L.mixer == 0, L.mixer == 0 ? 0.125f : 1.0f, k);
    lin2_decay(F, L, gr0, gr1, bcum, blast);
#pragma unroll
    for (int g = 0; g < 2; ++g) { float kd[8];
#pragma unroll
        for (int j = 0; j < 8; ++j) kd[j] = k[8 * g + j] * __expf(blast[8 * g + j] - bcum[8 * g + j]);
        *(LAS u32x4*)(KD + s * LP + d0 + 32 * g) = pack8(kd); }
#pragma unroll
    for (int i = 0; i < 4; ++i) { const int idx = ht + 256 * i; *(LAS u32x4*)(VT + (idx >> 4) * PV + (idx & 15) * 8) = vv[i]; }
    if (s == 0) { float* dc = F.DEC() + (size_t)L.unit * 64 + d0;
#pragma unroll
        for (int q = 0; q < 4; ++q) *(f32x4*)(dc + 32 * (q >> 1) + 4 * (q & 1)) = (f32x4){__expf(blast[4 * q]), __expf(blast[4 * q + 1]), __expf(blast[4 * q + 2]), __expf(blast[4 * q + 3])}; }
    lds_sync();
    { float* st = F.STATE() + (size_t)L.unit * 8192;
      const bf16x8 kf0 = tr_frag(KD, LP, 0, 16 * L.hw, lane), kf1 = tr_frag(KD, LP, 32, 16 * L.hw, lane);
#pragma unroll
      for (int et = 0; et < 8; ++et) { f32x4 acc = (f32x4){0.f, 0.f, 0.f, 0.f};
          acc = __builtin_amdgcn_mfma_f32_16x16x32_bf16(kf0, tr_frag(VT, PV, 0, 16 * et, lane), acc, 0, 0, 0);
          acc = __builtin_amdgcn_mfma_f32_16x16x32_bf16(kf1, tr_frag(VT, PV, 32, 16 * et, lane), acc, 0, 0, 0);
          *(f32x4*)(st + (16 * et + (lane & 15)) * 64 + 16 * L.hw + 4 * (lane >> 4)) = acc; } }
}
__device__ __forceinline__ void lin2_out(Frame& F, const Lin2& L) {
    const int ht = F.tid & 255, lane = F.lane, lr = lane & 15, lq = lane >> 4, s = L.s, c = L.c, d0 = 8 * c;
    const int cq = (L.mixer == 0 ? C_RQ : C_GQ) + L.h * 64, ck = (L.mixer == 0 ? C_RK : C_GK) + L.h * 64, cv = (L.mixer == 0 ? C_RV : C_GV) + L.h * 128, cg = (L.mixer == 0 ? C_RG : C_GG) + L.h * 128;
    const int ycol = (L.mixer == 0 ? 0 : 1024) + L.h * 128;
    LAS bf16_t* QD = (LAS bf16_t*)(L.base + L2_QD); LAS bf16_t* KI = (LAS bf16_t*)(L.base + L2_KI); LAS bf16_t* VT = (LAS bf16_t*)(L.base + L2_V);
    LAS bf16_t* SP = (LAS bf16_t*)(L.base + L2_SP); LAS bf16_t* PM = (LAS bf16_t*)(L.base + L2_PM + L.hw * 2304);
    const bf16_t* pr = F.PROJ() + (L.row0 + s) * LDP;
    float q[16], k[16], bcum[16], blast[16];
    u32x4 vv[4], sv[4]; u32x4 gr0, gr1;
    { f32x4 cs[2], sn[2];
      const u32x4 klo = *(const u32x4*)(pr + ck + d0), khi = *(const u32x4*)(pr + ck + 32 + d0), qlo = *(const u32x4*)(pr + cq + d0), qhi = *(const u32x4*)(pr + cq + 32 + d0);
      { const float* cp = F.rotc() + (L.row0 + s) * 32 + d0; const float* sp = F.rots() + (L.row0 + s) * 32 + d0;
        cs[0] = *(const f32x4*)cp; cs[1] = *(const f32x4*)(cp + 4); sn[0] = *(const f32x4*)sp; sn[1] = *(const f32x4*)(sp + 4); }
      gr0 = *(const u32x4*)(pr + C_GR); gr1 = *(const u32x4*)(pr + C_GR + 8);
#pragma unroll
      for (int i = 0; i < 4; ++i) { const int idx = ht + 256 * i; vv[i] = *(const u32x4*)(F.PROJ() + (L.row0 + (idx >> 4)) * LDP + cv + (idx & 15) * 8);
          sv[i] = *(const u32x4*)(F.SPREV() + (size_t)L.unit * 8192 + (size_t)idx * 8); }
      lin2_rot16(qlo, qhi, cs, sn, L.mixer == 0, L.mixer == 0 ? 1.0f : 0.125f, q);
      lin2_rot16(klo, khi, cs, sn, L.mixer == 0, L.mixer == 0 ? 0.125f : 1.0f, k); }
    lin2_decay(F, L, gr0, gr1, bcum, blast);
#pragma unroll
    for (int g = 0; g < 2; ++g) { float qd[8], ki[8];
#pragma unroll
        for (int j = 0; j < 8; ++j) { qd[j] = q[8 * g + j] * __expf(bcum[8 * g + j]); ki[j] = k[8 * g + j] * __expf(-bcum[8 * g + j]); }
        *(LAS u32x4*)(QD + s * LP + d0 + 32 * g) = pack8(qd); *(LAS u32x4*)(KI + s * LP + d0 + 32 * g) = pack8(ki); }
#pragma unroll
    for (int i = 0; i < 4; ++i) { const int idx = ht + 256 * i; *(LAS u32x4*)(VT + (idx >> 4) * PV + (idx & 15) * 8) = vv[i]; *(LAS u32x4*)(SP + (idx >> 3) * LP + (idx & 7) * 8) = sv[i]; }
    const bf16_t* gp = F.PROJ() + (L.row0 + 16 * L.hw + lr) * LDP + cg + 8 * lq;
    u32x4 gt[4];
#pragma unroll
    for (int pe = 0; pe < 4; ++pe) gt[pe] = *(const u32x4*)(gp + 32 * pe);
    lds_sync();
    const LAS bf16_t* qrow = QD + (16 * L.hw + lr) * LP + 8 * lq;
    const bf16x8 qf0 = *(const LAS bf16x8*)qrow, qf1 = *(const LAS bf16x8*)(qrow + 32);
#pragma unroll
    for (int st = 0; st < 4; ++st) {
        f32x4 acc = (f32x4){0.f, 0.f, 0.f, 0.f};
        if (st <= L.hw) { const LAS bf16_t* krow = KI + (16 * st + lr) * LP + 8 * lq;
            acc = __builtin_amdgcn_mfma_f32_16x16x32_bf16(*(const LAS bf16x8*)krow, qf0, acc, 0, 0, 0);
            acc = __builtin_amdgcn_mfma_f32_16x16x32_bf16(*(const LAS bf16x8*)(krow + 32), qf1, acc, 0, 0, 0); }
        float p[4];
#pragma unroll
        for (int i = 0; i < 4; ++i) p[i] = (st <= L.hw && 16 * st + 4 * lq + i <= 16 * L.hw + lr) ? acc[i] : 0.f;
        u32x2 w; w.x = pk2(p[0], p[1]); w.y = pk2(p[2], p[3]);
        *(LAS u32x2*)(PM + lr * LP + 16 * st + 4 * lq) = w; }
    asm volatile("s_waitcnt lgkmcnt(0)" ::: "memory");
    const bf16x8 pf0 = *(const LAS bf16x8*)(PM + lr * LP + 8 * lq), pf1 = *(const LAS bf16x8*)(PM + lr * LP + 32 + 8 * lq);
    f32x4 o[8];
    const int erow = 8 * (lr >> 2) + (lr & 3);
#pragma unroll
    for (int et = 0; et < 8; ++et) { const int e0 = 32 * (et >> 1) + 4 * (et & 1); f32x4 acc = (f32x4){0.f, 0.f, 0.f, 0.f};
        acc = __builtin_amdgcn_mfma_f32_16x16x32_bf16(tr_frag8(VT, PV, 0, e0, lane), pf0, acc, 0, 0, 0);
        acc = __builtin_amdgcn_mfma_f32_16x16x32_bf16(tr_frag8(VT, PV, 32, e0, lane), pf1, acc, 0, 0, 0);
        const LAS bf16_t* srow = SP + (e0 + erow) * LP + 8 * lq;
        acc = __builtin_amdgcn_mfma_f32_16x16x32_bf16(*(const LAS bf16x8*)srow, qf0, acc, 0, 0, 0);
        acc = __builtin_amdgcn_mfma_f32_16x16x32_bf16(*(const LAS bf16x8*)(srow + 32), qf1, acc, 0, 0, 0);
        o[et] = acc; }
    float sm = 0.f;
#pragma unroll
    for (int et = 0; et < 8; ++et) sm += (o[et][0] + o[et][1]) + (o[et][2] + o[et][3]);
    sm += lane_read(sm, lane ^ 16); sm += lane_read(sm, lane ^ 32);
    const float mu = sm * (1.0f / 128.0f); float qv = 0.f;
#pragma unroll
    for (int et = 0; et < 8; ++et) {
#pragma unroll
        for (int i = 0; i < 4; ++i) { const float dlt = o[et][i] - mu; qv += dlt * dlt; } }
    qv += lane_read(qv, lane ^ 16); qv += lane_read(qv, lane ^ 32);
    const float r = 1.0f / sqrtf(qv * (1.0f / 128.0f) + EPS);
    bf16_t* yp = F.Y() + (L.row0 + 16 * L.hw + lr) * D + ycol + 8 * lq;
#pragma unroll
    for (int pe = 0; pe < 4; ++pe) { float g[8], y[8]; unpack8(gt[pe], g);
#pragma unroll
        for (int j = 0; j < 8; ++j) y[j] = (o[2 * pe + (j >> 2)][j & 3] - mu) * r * siluf_(g[j]);
        *(u32x4*)(yp + 32 * pe) = pack8(y); }
}
template <bool OUT>
__device__ __forceinline__ void lin2_phase(Frame& F, int l) {
    { const int h = (F.vcu >> 6) & 3; LAS float* WG = (LAS float*)(F.lds + L2_WG);
      for (int i = F.tid; i < 16 * 64 + 64; i += NWAVES * 64) WG[i] = (i < 1024) ? F.gla_wg()[(size_t)l * 16 * 256 + (i >> 6) * 256 + h * 64 + (i & 63)] : F.gla_bg()[l * 256 + h * 64 + (i - 1024)];
      lds_sync(); }
    const int half = F.wave >> 2;
#pragma unroll 1
    for (int j = 0; j < 8; ++j) {
        Lin2 L; L.unit = F.vcu + 256 * (2 * j + half); L.h = (L.unit >> 6) & 3; asm volatile("" : "+s"(L.h)); L.mixer = L.unit >> 11; L.hw = F.wave & 3; L.s = (F.tid & 255) >> 2; L.c = F.tid & 3;
        L.row0 = (size_t)((L.unit >> 8) & 7) * SEQ + (size_t)(L.unit & 63) * CH; L.base = F.lds + half * L2_STRIDE;
        if (OUT) lin2_out(F, L); else lin2_state(F, L);
    }
    lds_sync();
}
__device__ __forceinline__ void lin_scan(Frame& F) {
    const int gt = F.vcu * (NWAVES * 64) + F.tid, NGT = F.G * NWAVES * 64;
    for (int i = gt; i < 64 * 8192; i += NGT) {
        const int seq = i >> 13, idx = i & 8191, d = idx & 63;
        const float* st = F.STATE() + (size_t)seq * NCH * 8192 + idx; const float* dc = F.DEC() + (size_t)seq * NCH * 64 + d; bf16_t* sp = F.SPREV() + (size_t)seq * NCH * 8192 + idx;
        float carry = 0.f; asm volatile("" : "+v"(carry));
#pragma unroll
        for (int h = 0; h < 2; ++h) {
            float v[32], c[32];
#pragma unroll
            for (int n = 0; n < 32; ++n) { v[n] = st[(size_t)(32 * h + n) * 8192]; c[n] = dc[(size_t)(32 * h + n) * 64]; }
#pragma unroll
            for (int n = 0; n < 32; ++n) { sp[(size_t)(32 * h + n) * 8192] = (bf16_t)f2bf(carry); carry = c[n] * carry + v[n]; asm volatile("" : "+v"(carry)); }
        }
    }
}
constexpr int S5_WL = 16384, S5_BU = 2048, S5_X = 2048 + 8320;
template <bool OUT>
__device__ __forceinline__ void s5_pass(Frame& F, int l) {
    LAS bf16_t* UT = (LAS bf16_t*)(F.lds + F.wave * S5_WL); LAS float* BU = (LAS float*)(F.lds + F.wave * S5_WL + S5_BU); LAS bf16_t* X = (LAS bf16_t*)(F.lds + F.wave * S5_WL + S5_X);
    const int gw = F.vcu * NWAVES + F.wave, NGW = F.G * NWAVES, lane = F.lane, lr = lane & 15, lq = lane >> 4;
    u32x4 ua, uc;
    { const int g = gw & 31, n = (gw >> 5) & 63, b = gw >> 11; const bf16_t* up = F.PROJ() + ((size_t)b * SEQ + (size_t)n * CH + lane) * LDP + C_SU + g * 16; ua = *(const u32x4*)up; uc = *(const u32x4*)(up + 8); }
    for (int unit = gw; unit < BATCH * NCH * 32; unit += NGW) {
        const int g = unit & 31, n = (unit >> 5) & 63, b = unit >> 11; const size_t row0 = (size_t)b * SEQ + (size_t)n * CH;
        *(LAS u32x4*)(UT + lane * 16) = ua; *(LAS u32x4*)(UT + lane * 16 + 8) = uc;
        if (unit + NGW < BATCH * NCH * 32) { const int un = unit + NGW, g2 = un & 31, n2 = (un >> 5) & 63, b2 = un >> 11;
            const bf16_t* up = F.PROJ() + ((size_t)b2 * SEQ + (size_t)n2 * CH + lane) * LDP + C_SU + g2 * 16; ua = *(const u32x4*)up; uc = *(const u32x4*)(up + 8); }
        const int gp = g * 64 + lane; const float ar = F.abar()[2 * gp], ai = F.abar()[2 * gp + 1];
        bf16x8 bfr[8];
#pragma unroll
        for (int q = 0; q < 8; ++q) { bfr[q] = (bf16x8){0, 0, 0, 0, 0, 0, 0, 0}; if (lq < 2) bfr[q] = *(const bf16x8*)(F.bbt() + ((size_t)g * 128 + 16 * q + lr) * 16 + 8 * lq); }
        float xr = 0.f, xi = 0.f;
        bf16x8 cf[4]; float dsk = 0.f;
        if (OUT) { const f32x2 x0 = *(const f32x2*)(F.XEND() + ((((size_t)(b * 32 + g)) * NCH + n) * 64 + lane) * 2); xr = x0.x; xi = x0.y;
#pragma unroll
            for (int ks = 0; ks < 4; ++ks) cf[ks] = *(const bf16x8*)(F.cmt() + ((size_t)(g * 16 + lr)) * 128 + 32 * ks + 8 * lq);
            dsk = F.s5_d()[(size_t)l * BW + g * 16 + lr]; }
        LDS_WAIT();
        for (int sb = 0; sb < 4; ++sb) {
            bf16x8 af = (bf16x8){0, 0, 0, 0, 0, 0, 0, 0}; if (lq < 2) af = *(const LAS bf16x8*)(UT + (16 * sb + lr) * 16 + 8 * lq);
#pragma unroll
            for (int q = 0; q < 8; ++q) { f32x4 acc = (f32x4){0.f, 0.f, 0.f, 0.f}; acc = __builtin_amdgcn_mfma_f32_16x16x32_bf16(af, bfr[q], acc, 0, 0, 0);
#pragma unroll
                for (int i = 0; i < 4; ++i) BU[(4 * lq + i) * 130 + 16 * q + lr] = acc[i]; }
            LDS_WAIT();
            float br[16], bi[16];
#pragma unroll
            for (int tt = 0; tt < 16; ++tt) { br[tt] = BU[tt * 130 + lane]; bi[tt] = BU[tt * 130 + 64 + lane]; }
#pragma unroll
            for (int tt = 0; tt < 16; ++tt) { const float nr = ar * xr - ai * xi + br[tt], ni = ar * xi + ai * xr + bi[tt]; xr = nr; xi = ni; asm volatile("" : "+v"(xr), "+v"(xi));
                if (OUT) { X[tt * 136 + lane] = (bf16_t)f2bf(xr); X[tt * 136 + 64 + lane] = (bf16_t)f2bf(xi); } }
            if (OUT) {
                LDS_WAIT();
                f32x4 acc = (f32x4){0.f, 0.f, 0.f, 0.f}; const LAS bf16_t* xp = X + lr * 136 + 8 * lq;
#pragma unroll
                for (int ks = 0; ks < 4; ++ks) acc = __builtin_amdgcn_mfma_f32_16x16x32_bf16(*(const LAS bf16x8*)(xp + 32 * ks), cf[ks], acc, 0, 0, 0);
#pragma unroll
                for (int i = 0; i < 4; ++i) { const int tl = 16 * sb + 4 * lq + i; const float u = bflo((unsigned)UT[tl * 16 + lr]); const float y = gelu_tanh(acc[i] + dsk * u);
                    F.YBP()[(row0 + tl) * BW + g * 16 + lr] = (bf16_t)f2bf(y); }
            }
            LDS_WAIT();
        }
        if (!OUT) *(f32x2*)(F.XEND() + ((((size_t)(b * 32 + g)) * NCH + n) * 64 + lane) * 2) = (f32x2){xr, xi};
    }
}
__device__ __forceinline__ void s5_scan(Frame& F) {
    const int gt = F.vcu * (NWAVES * 64) + F.tid, NGT = F.G * NWAVES * 64;
    for (int i = gt; i < BATCH * 32 * 64; i += NGT) {
        const int p = i & 63, bg = i >> 6, g = bg & 31; const float pr = F.apow()[2 * (g * 64 + p)], pi = F.apow()[2 * (g * 64 + p) + 1];
        f32x2* xp = (f32x2*)(F.XEND() + (((size_t)bg * NCH) * 64 + p) * 2);
        float cr = 0.f, ci = 0.f; asm volatile("" : "+v"(cr), "+v"(ci));
#pragma unroll
        for (int h = 0; h < 2; ++h) {
            f32x2 v[32];
#pragma unroll
            for (int n = 0; n < 32; ++n) v[n] = xp[(size_t)(32 * h + n) * 64];
#pragma unroll
            for (int n = 0; n < 32; ++n) { xp[(size_t)(32 * h + n) * 64] = (f32x2){cr, ci};
                const float nr = pr * cr - pi * ci + v[n].x, ni = pr * ci + pi * cr + v[n].y; cr = nr; ci = ni; asm volatile("" : "+v"(cr), "+v"(ci)); }
        }
    }
}

__device__ __forceinline__ void pool_phase(Frame& F, int l) {
    const int gw = F.vcu * NWAVES + F.wave, NGW = F.G * NWAVES, lane = F.lane, lr = lane & 15, lq = lane >> 4;
    for (int unit = gw; unit < BATCH * (SEQ / 16) * 4; unit += NGW) {
        const int g = unit & 3, tile = (unit >> 2) & 255, b = unit >> 10; const int win = 2 << g, tpos = 16 * tile + lr; const size_t row = (size_t)b * SEQ + tpos;
        const bf16_t* pp = F.PROJ() + row * LDP + C_PU + g * 128 + 8 * lq;
        float s[4][8];
#pragma unroll
        for (int ks = 0; ks < 4; ++ks)
#pragma unroll
            for (int j = 0; j < 8; ++j) s[ks][j] = 0.f;
        for (int jj = 1; jj < win; ++jj) { if (tpos - jj >= 0) {
#pragma unroll
            for (int ks = 0; ks < 4; ++ks) { float a[8]; unpack8(*(const u32x4*)(pp - (size_t)jj * LDP + 32 * ks), a);
#pragma unroll
                for (int j = 0; j < 8; ++j) s[ks][j] += a[j]; } } }
        const float inv = 1.0f / (float)min(tpos + 1, win);
        bf16x8 mf[4];
#pragma unroll
        for (int ks = 0; ks < 4; ++ks) { float a[8], m[8]; unpack8(*(const u32x4*)(pp + 32 * ks), a);
#pragma unroll
            for (int j = 0; j < 8; ++j) m[j] = (s[ks][j] + a[j]) * inv - a[j];
            const u32x4 w = pack8(m); mf[ks] = __builtin_bit_cast(bf16x8, w); }
        const bf16_t* pw = F.poolw_t() + (size_t)g * 128 * 128 + (size_t)lr * 128 + 8 * lq;
#pragma unroll
        for (int q = 0; q < 8; ++q) { f32x4 acc = (f32x4){0.f, 0.f, 0.f, 0.f};
#pragma unroll
            for (int ks = 0; ks < 4; ++ks) acc = __builtin_amdgcn_mfma_f32_16x16x32_bf16(*(const bf16x8*)(pw + (size_t)(16 * q) * 128 + 32 * ks), mf[ks], acc, 0, 0, 0);
            const int dcol = g * 128 + 16 * q + 4 * lq; const f32x4 sc = *(const f32x4*)(F.pool_scale() + (size_t)l * BW + dcol);
            u32x2 w; w.x = pk2(acc[0] * sc.x, acc[1] * sc.y); w.y = pk2(acc[2] * sc.z, acc[3] * sc.w);
            *(u32x2*)(F.Y() + row * D + 1536 + dcol) = w; }
    }
}

__device__ __forceinline__ void conv_fix_phase(Frame& F, int l) {
    const float* cw = F.conv_w() + (size_t)l * 3 * NUP; const float* cb = F.conv_b() + (size_t)l * NUP; const float* UH = F.UH();
    const int gt = F.vcu * (NWAVES * 64) + F.tid, NGT = F.G * NWAVES * 64;
    constexpr int JG = DFF / 4;
    for (int task = gt; task < (M / 256) * 2 * JG; task += NGT) {
        const int jg = task % JG, q = (task / JG) & 1, pm = task / (2 * JG);
        if ((pm & 15) == 0) continue;
        const int j0 = jg * 4, ucol = 256 * (j0 >> 7) + (j0 & 127);
        const float* u0p = UH + ((size_t)pm * 4 + q) * NUP + ucol;
        const float* u1p = (q == 1) ? UH + ((size_t)pm * 4 + 0) * NUP + ucol : UH + ((size_t)(pm - 1) * 4 + 3) * NUP + ucol;
        const float* u2p = (q == 1) ? UH + ((size_t)(pm - 1) * 4 + 3) * NUP + ucol : UH + ((size_t)(pm - 1) * 4 + 2) * NUP + ucol;
        const f32x4 a0 = *(const f32x4*)u0p, a1 = *(const f32x4*)u1p, a2 = *(const f32x4*)u2p, v0 = *(const f32x4*)(u0p + 128), v1 = *(const f32x4*)(u1p + 128), v2 = *(const f32x4*)(u2p + 128);
        const f32x4 wa0 = *(const f32x4*)(cw + j0), wa1 = *(const f32x4*)(cw + NUP + j0), wa2 = *(const f32x4*)(cw + 2 * NUP + j0), ba = *(const f32x4*)(cb + j0);
        const f32x4 wv0 = *(const f32x4*)(cw + DFF + j0), wv1 = *(const f32x4*)(cw + NUP + DFF + j0), wv2 = *(const f32x4*)(cw + 2 * NUP + DFF + j0), bv = *(const f32x4*)(cb + DFF + j0);
        float o[4];
#pragma unroll
        for (int i = 0; i < 4; ++i) { const float ca = ba[i] + wa0[i] * a2[i] + wa1[i] * a1[i] + wa2[i] * a0[i], cv = bv[i] + wv0[i] * v2[i] + wv1[i] * v1[i] + wv2[i] * v0[i]; o[i] = siluf_(ca) * cv; }
        u32x2 w; w.x = pk2(o[0], o[1]); w.y = pk2(o[2], o[3]);
        *(u32x2*)(F.ACT() + ((size_t)pm * 256 + q) * DFF + j0) = w;
    }
}

constexpr int NPH = 13;
struct Args { const void* in[25]; float* out; unsigned char* ws; int l_lo, l_hi, ph_lo, ph_hi, single, pad; };
__global__ void __launch_bounds__(NWAVES * 64, 2) hybrid_fwd(Args args) {
    extern __shared__ __attribute__((aligned(16))) unsigned char lds[];
    Frame F;
    F.lds = (LAS unsigned char*)lds;
    F.tid = threadIdx.x; F.lane = F.tid & 63; F.wave = __builtin_amdgcn_readfirstlane(F.tid >> 6);
    const int wave0 = F.wave;
    F.G = gridDim.x; { const int bx = blockIdx.x; F.vcu = (F.G % 8 == 0) ? (bx % 8) * (F.G / 8) + bx / 8 : bx; }
    unsigned char* ws = args.ws; F.ws = ws; F.out = args.out; F.l = 0;

    volatile LAS unsigned* MISC = (volatile LAS unsigned*)(F.lds + MISC_OFF);
    if (F.tid < 64) MISC[F.tid] = 0u;
    wg_sync();
    unsigned* ctl = (unsigned*)(ws + WS_CTL);
    XcdBarrier bar; bar.bar = ctl + CW_BAR; bar.x = 0; bar.st = nullptr;
    if (args.single) bar = xcd_barrier_post(ctl + CW_BAR, MISC);
#define GRID_BAR() do { if (args.single) xcd_barrier(bar); } while (0)
    const int lo = args.ph_lo, hi = args.ph_hi;
#define IN(k) (lo <= (k) && (k) < hi)
#define PH_BEGIN() do { unsigned z_ = 0u; asm volatile("" : "+v"(z_)); const int ln_ = (int)__builtin_amdgcn_mbcnt_hi(~0u, __builtin_amdgcn_mbcnt_lo(~0u, z_)); F.lane = ln_; F.tid = wave0 * 64 + ln_; F.wave = wave0; unsigned long long w_ = (unsigned long long)args.ws, o_ = (unsigned long long)args.out; asm volatile("" : "+s"(w_), "+s"(o_)); F.ws = (unsigned char*)(GAS unsigned char*)w_; F.out = (float*)(GAS float*)o_; } while (0)

    for (int l = args.l_lo; l < args.l_hi; ++l) {
        F.l = l;
        if (IN(0)) { PH_BEGIN(); phase_prep(F, l); GRID_BAR(); }
        if (IN(1)) { PH_BEGIN();
            { pg8::Gemm g{(const bf16_t*)F.HN8(), (const bf16_t*)F.W8(), M, 4 * D, D / 2, D / 2, D / 2}; pg8::StaticOrder S; S.init(M, 4 * D, F.G, (int)blockIdx.x); pg8::EpiProj E{F.PROJ(), LDP, 0, F.GF(), 1.0f / 64.0f};
              pg8::gemm_phase<pg8::EpiProj, true>(F.lds, g, S, E, F.tid); }
            PH_BEGIN();
            { pg8::Gemm g{F.HN(), F.win_t(), M, C_GR, D, D, D}; pg8::StaticOrder S; S.init(M, C_GR, F.G, (int)blockIdx.x); pg8::EpiProj E{F.PROJ(), LDP, 1 << 20, F.GF(), 1.0f};
              pg8::gemm_phase(F.lds, g, S, E, F.tid); }
            PH_BEGIN(); gr_pass(F);
            GRID_BAR(); }
        if (IN(2)) { PH_BEGIN(); lin2_phase<false>(F, l); PH_BEGIN();
            s5_pass<false>(F, l); pool_phase(F, l); wg_sync();
            GRID_BAR(); }
        if (IN(3)) { PH_BEGIN(); lin_scan(F); s5_scan(F); GRID_BAR(); }
        if (IN(4)) { PH_BEGIN(); lin2_phase<true>(F, l); PH_BEGIN();
            s5_pass<true>(F, l); wg_sync();
            GRID_BAR(); }
        if (IN(5)) { PH_BEGIN(); pg8::Gemm g{F.YBP(), F.wglu_t(), M, BW, BW, BW, BW}; pg8::StaticOrder S; S.init(M, BW, F.G, (int)blockIdx.x); pg8::EpiGlu E{F.YBP(), BW, F.Y() + BW, D};
            pg8::gemm_phase(F.lds, g, S, E, F.tid); GRID_BAR(); }
        if (IN(6)) { PH_BEGIN(); for (int i = 0; i < (F.vcu & 7); ++i) __builtin_amdgcn_s_sleep(56);
            pg8::Gemm g{F.Y(), F.wbr_t(), M, D, D, D, D}; pg8::StaticOrder S; S.init(M, D, F.G, (int)blockIdx.x); pg8::EpiMerge E{F.GF(), F.HN(), D};
            pg8::gemm_phase(F.lds, g, S, E, F.tid); GRID_BAR(); }
        if (IN(7)) { PH_BEGIN(); for (int i = 0; i < (F.vcu & 7); ++i) __builtin_amdgcn_s_sleep(50);
            pg8::Gemm g{F.HN(), F.wout_t(), M, D, D, D, D}; pg8::StaticOrder S; S.init(M, D, F.G, (int)blockIdx.x); pg8::EpiResid E{l == 0 ? (const void*)F.x() : (const void*)F.out, l == 0 ? 1 : 0, F.Y(), D, F.SS()};
            pg8::gemm_phase(F.lds, g, S, E, F.tid); GRID_BAR(); }
        if (IN(8)) { PH_BEGIN(); row_scale(F); GRID_BAR(); }
        if (IN(9)) { PH_BEGIN(); pg8::Gemm g{F.Y(), F.wup_t(), M, NUP, D, D, D}; pg8::StaticOrder S; S.init(M, NUP, F.G, (int)blockIdx.x); pg8::EpiConv E{F.conv_w() + (size_t)l * 3 * NUP, F.conv_b() + (size_t)l * NUP, F.ACT(), F.UH(), (LAS float*)(F.lds + pg8::STAGE_BYTES), F.RS()};
            pg8::gemm_phase(F.lds, g, S, E, F.tid); GRID_BAR(); }
        if (IN(10)) { PH_BEGIN(); conv_fix_phase(F, l); GRID_BAR(); }
        if (IN(11)) { PH_BEGIN(); for (int i = 0; i < (F.vcu & 7); ++i) __builtin_amdgcn_s_sleep(50);
            pg8::Gemm g{F.ACT(), F.wdn_t(), M, D, DFF, DFF, DFF}; pg8::StaticOrder S; S.init(M, D, F.G, (int)blockIdx.x); pg8::EpiResid E{(const void*)F.Y(), 0, l == DEPTH - 1 ? F.HN() : (bf16_t*)F.out, D, nullptr};
            pg8::gemm_phase(F.lds, g, S, E, F.tid); GRID_BAR(); }
        if (IN(12) && l == DEPTH - 1) { PH_BEGIN(); rms_rows16_to_f32(F, F.HN(), F.g_final(), F.out); }
    }
#undef IN
#undef PH_BEGIN
#undef GRID_BAR
}

#pragma clang attribute pop
extern "C" void kernel_launch(void* const* d_in, const int* in_sizes, int n_in, void* d_out, int out_size, void* d_ws, size_t ws_size, hipStream_t stream) {
    static int grid = 0;
    if (grid == 0) {
        if (n_in != 25 || in_sizes[0] != M * D || out_size != M * D || ws_size < WS_END) { fprintf(stderr, "kernel_launch: shape/workspace mismatch (n_in %d, in0 %d, out %d, ws %zu, need %zu); nothing launched\n", n_in, n_in > 0 ? in_sizes[0] : -1, out_size, ws_size, (size_t)WS_END); grid = -1; return; }
        int dev = 0, cus = 0, per_cu = 0;
        if (hipGetDevice(&dev) != hipSuccess || hipDeviceGetAttribute(&cus, hipDeviceAttributeMultiprocessorCount, dev) != hipSuccess) { grid = -1; return; }
        if (hipFuncSetAttribute((const void*)hybrid_fwd, hipFuncAttributeMaxDynamicSharedMemorySize, LDS_BYTES) != hipSuccess) { fprintf(stderr, "kernel_launch: hipFuncSetAttribute failed\n"); grid = -1; return; }
        if (hipOccupancyMaxActiveBlocksPerMultiprocessor(&per_cu, (const void*)hybrid_fwd, NWAVES * 64, LDS_BYTES) != hipSuccess || per_cu < 1) { fprintf(stderr, "kernel_launch: occupancy query reports %d workgroups per CU\n", per_cu); }
        (void)hipGetLastError();
        if (cus < 256) { fprintf(stderr, "kernel_launch: built for a 256-CU device (found %d CUs); nothing launched\n", cus); grid = -1; return; }
        grid = 256;
    }
    if (grid < 0) return;
    if (hipMemsetAsync((char*)d_ws + WS_CTL, 0, CTL_ZERO_BYTES, stream) != hipSuccess) return;
    Args a{};
    for (int i = 0; i < 25; ++i) a.in[i] = d_in[i];
    a.out = (float*)d_out; a.ws = (unsigned char*)d_ws;
#if MK_SINGLE
    a.l_lo = 0; a.l_hi = DEPTH; a.ph_lo = 0; a.ph_hi = NPH; a.single = 1;
    hipLaunchKernelGGL(hybrid_fwd, dim3(grid), dim3(NWAVES * 64), LDS_BYTES, stream, a);
#else
    a.single = 0;
    for (int l = 0; l < DEPTH; ++l)
        for (int p = 0; p < NPH; ++p) { if (p == 12 && l != DEPTH - 1) continue; a.l_lo = l; a.l_hi = l + 1; a.ph_lo = p; a.ph_hi = p + 1;
            hipLaunchKernelGGL(hybrid_fwd, dim3(grid), dim3(NWAVES * 64), LDS_BYTES, stream, a); }
#endif
}
```

```cpp
#include <hip/hip_runtime.h>
#include <cstdio>
#include <cstdint>

#ifndef MK_SINGLE
#define MK_SINGLE 1
#endif

#pragma clang attribute push(__attribute__((target("no-packed-fp32-ops"))), apply_to = function)
#define LAS __attribute__((address_space(3)))
#define GAS __attribute__((address_space(1)))
typedef unsigned short bf16_t;
typedef short bf16x8 __attribute__((ext_vector_type(8)));
typedef float f32x4 __attribute__((ext_vector_type(4)));
typedef float f32x2 __attribute__((ext_vector_type(2)));
typedef unsigned u32x4 __attribute__((ext_vector_type(4)));
typedef unsigned u32x2 __attribute__((ext_vector_type(2)));

constexpr int D = 2048, BATCH = 8, SEQ = 4096, DEPTH = 4, M = BATCH * SEQ;
constexpr int BW = 512;
constexpr int NIN_SRC = 12304, NIN = 12544;
constexpr int DFF = 5504, NUP = 11008;
constexpr int C_RQ = 0, C_RK = 256, C_RV = 512, C_RG = 1024, C_SU = 1536, C_GQ = 2048, C_GK = 2304, C_GV = 2560, C_GG = 3072, C_PU = 3584, C_GR = 4096, C_GATE = 4352;
constexpr int LDP = 4224;
constexpr float EPS = 1e-6f;
constexpr int NWAVES = 8;
constexpr int CH = 64;
constexpr int NCH = SEQ / CH;

constexpr size_t MiB = 1u << 20;
constexpr size_t WS_CTL = 0, CTL_ZERO_BYTES = 1 * MiB;
constexpr size_t WS_ROT = 1 * MiB;
constexpr size_t WS_S5T = 9 * MiB;
constexpr size_t S5T_ABAR = 0, S5T_APOW = 16384, S5T_BBAR = 32768, S5T_CMT = 32768 + 262144, S5T_BBT = S5T_CMT + 131072;
constexpr size_t WS_WGLU = 10 * MiB;
constexpr size_t WS_POOLW = 10 * MiB + 512 * 1024;
constexpr size_t WS_WIN = 11 * MiB;
constexpr size_t WS_WBR = 60 * MiB;
constexpr size_t WS_WOUT = 68 * MiB;
constexpr size_t WS_WUP = 76 * MiB;
constexpr size_t WS_WDN = 119 * MiB;
constexpr size_t WS_HN = 141 * MiB;
constexpr size_t WS_Y = 269 * MiB;
constexpr size_t WS_SCR = 397 * MiB;
constexpr size_t WS_YBP = WS_SCR;
constexpr size_t WS_STATE = WS_SCR + 32 * MiB;
constexpr size_t WS_SPREV = WS_SCR + 160 * MiB;
constexpr size_t WS_DEC = WS_SCR + 224 * MiB;
constexpr size_t WS_XEND = WS_SCR + 225 * MiB;
constexpr size_t WS_UH = WS_SCR + 128 * MiB;
constexpr size_t WS_PROJ = 637 * MiB;
constexpr size_t WS_GF = WS_PROJ + 264 * MiB;
constexpr size_t WS_ACT = WS_PROJ;
constexpr size_t WS_RS = 1421 * MiB;
constexpr size_t WS_SS = 1422 * MiB;
constexpr size_t WS_HN8 = 1438 * MiB;
constexpr size_t WS_W8 = 1502 * MiB;
constexpr size_t WS_END = 1518 * MiB;
static_assert(WS_PROJ + (size_t)M * LDP * 2 <= WS_GF && WS_GF + 4 * (size_t)M * D * 2 <= WS_RS, "ws map");
static_assert(WS_ACT + (size_t)M * DFF * 2 <= WS_RS, "ws map");
static_assert(WS_XEND + 8 * MiB <= WS_PROJ, "ws map");
static_assert(WS_UH + (size_t)(M / 256) * 4 * NUP * 4 <= WS_PROJ, "ws map");
constexpr int CW_TMO = 0, CW_BAR = 4096;

constexpr int LDS_BYTES = 155648;
constexpr int MISC_OFF = LDS_BYTES - 256;

#define RLX_AGENT __ATOMIC_RELAXED, __HIP_MEMORY_SCOPE_AGENT
__device__ __forceinline__ void lds_sync() { asm volatile("s_waitcnt lgkmcnt(0)" ::: "memory"); __builtin_amdgcn_s_barrier(); asm volatile("" ::: "memory"); }
__device__ __forceinline__ void wg_sync() { __builtin_amdgcn_fence(__ATOMIC_RELEASE, "workgroup"); __builtin_amdgcn_s_barrier(); __builtin_amdgcn_fence(__ATOMIC_ACQUIRE, "workgroup"); }
#define LDS_WAIT() asm volatile("s_waitcnt lgkmcnt(0)" ::: "memory")
#define VM_WAIT() asm volatile("s_waitcnt vmcnt(0)" ::: "memory")
__device__ __forceinline__ unsigned f2bf(float f) { unsigned u = __builtin_bit_cast(unsigned, f); return (u + 0x7fffu + ((u >> 16) & 1u)) >> 16; }
__device__ __forceinline__ unsigned pk2(float lo, float hi) { return f2bf(lo) | (f2bf(hi) << 16); }
__device__ __forceinline__ float bflo(unsigned w) { return __builtin_bit_cast(float, w << 16); }
__device__ __forceinline__ float bfhi(unsigned w) { return __builtin_bit_cast(float, w & 0xffff0000u); }
__device__ __forceinline__ void unpack8(const u32x4 w, float (&v)[8]) { v[0] = bflo(w.x); v[1] = bfhi(w.x); v[2] = bflo(w.y); v[3] = bfhi(w.y); v[4] = bflo(w.z); v[5] = bfhi(w.z); v[6] = bflo(w.w); v[7] = bfhi(w.w); }
__device__ __forceinline__ u32x4 pack8(const float (&v)[8]) { u32x4 w; w.x = pk2(v[0], v[1]); w.y = pk2(v[2], v[3]); w.z = pk2(v[4], v[5]); w.w = pk2(v[6], v[7]); return w; }
__device__ __forceinline__ unsigned pk4_fp8(float a, float b, float c, float d) { unsigned w = 0u; w = __builtin_amdgcn_cvt_pk_fp8_f32(a, b, w, false); w = __builtin_amdgcn_cvt_pk_fp8_f32(c, d, w, true); return w; }
__device__ __forceinline__ float sigmoidf_(float x) { return __builtin_amdgcn_rcpf(1.0f + __expf(-x)); }
__device__ __forceinline__ float siluf_(float x) { return x * __builtin_amdgcn_rcpf(1.0f + __expf(-x)); }
__device__ __forceinline__ float gelu_tanh(float x) { const float u = 1.5957691216f * (x + 0.044715f * x * x * x); return x * __builtin_amdgcn_rcpf(1.0f + __expf(-u)); }
__device__ __forceinline__ float logsigmoidf_(float x) { return fminf(x, 0.f) - __logf(1.0f + __expf(-fabsf(x))); }

namespace pg8 {
constexpr int BM = 256, BK = 64, HALF = 128, HTB = HALF * BK * 2, STAGE_BYTES = 8 * HTB, NXCD = 8, WGM = 4;
__host__ __device__ __forceinline__ int lds_byte(int r, int c) { const int st = (r >> 4) * 2 + (c >> 5), rr = r & 15, cc = c & 31, ob = rr * 64 + cc * 2; return st * 1024 + (ob ^ (((ob >> 9) & 1) << 5)); }
__host__ __device__ __forceinline__ void stage_rc(int b, int& R, int& C) { const int st = b / 1024, sb = b % 1024, swz = sb ^ (((sb >> 9) & 1) << 5); R = (st >> 1) * 16 + swz / 64; C = (st & 1) * 32 + (swz % 64) / 2; }
__host__ __device__ __forceinline__ int perm32(int rho) { const int n = rho >> 4, i = rho & 15; return 8 * (i >> 2) + 4 * n + (i & 3); }

struct Unit { int pm, pn; };
struct Gemm { const bf16_t* A; const bf16_t* Bt; int M, N, K, lda, ldb; };

struct StaticOrder {
    int nM, nN, nwg, G, c;
    __host__ __device__ void init(int M_, int N_, int G_, int c_) { nM = M_ / BM; nN = N_ / BM; nwg = nM * nN; G = G_; c = c_; }
    __host__ __device__ bool next(int i, Unit& u) const {
        const long L = (long)i * G + c; if (L >= nwg) return false;
        int wgid = (int)L; { const int q = nwg / NXCD, r = nwg % NXCD, xcd = wgid % NXCD, off = wgid / NXCD; wgid = (xcd < r ? xcd * (q + 1) : r * (q + 1) + (xcd - r) * q) + off; }
        const int nig = WGM * nN, gid = wgid / nig, fm = gid * WGM, gsz = (nM - fm) < WGM ? (nM - fm) : WGM;
        u.pm = fm + ((wgid % nig) % gsz); u.pn = (wgid % nig) / gsz; return true;
    }
};

__device__ __forceinline__ unsigned cvt_pk_bf16(float lo, float hi) { unsigned r; asm volatile("v_cvt_pk_bf16_f32 %0, %1, %2" : "=v"(r) : "v"(lo), "v"(hi)); return r; }

struct EpiStoreBf16 {
    static constexpr bool PERM = true, KHOOK = false;
    bf16_t* O; int ldc;
    __device__ __forceinline__ void khook(f32x4 (&)[2][2][4][2], const Unit&, int, int, int, int, int) const {}
    __device__ __forceinline__ void operator()(f32x4 (&acc)[2][2][4][2], const Unit& u, int wr, int wc, int fr, int fq) const {
        const int row0 = u.pm * BM + wr * 64 + fr, col0 = u.pn * BM + wc * 32 + 8 * fq;
#pragma unroll
        for (int ai = 0; ai < 2; ++ai)
#pragma unroll
            for (int m = 0; m < 4; ++m) { bf16_t* rowp = O + (size_t)(row0 + ai * HALF + m * 16) * ldc + col0;
#pragma unroll
                for (int bj = 0; bj < 2; ++bj) { const f32x4 v0 = acc[ai][bj][m][0], v1 = acc[ai][bj][m][1];
                    u32x4 w; w.x = cvt_pk_bf16(v0[0], v0[1]); w.y = cvt_pk_bf16(v0[2], v0[3]); w.z = cvt_pk_bf16(v1[0], v1[1]); w.w = cvt_pk_bf16(v1[2], v1[3]);
                    *(u32x4*)(rowp + bj * HALF) = w; } }
    }
};
struct EpiProj {
    static constexpr bool PERM = true, KHOOK = false;
    bf16_t* O; int ldc; int gate_pn0; bf16_t* GF; float gscale;
    __device__ __forceinline__ void khook(f32x4 (&)[2][2][4][2], const Unit&, int, int, int, int, int) const {}
    __device__ __forceinline__ void operator()(f32x4 (&acc)[2][2][4][2], const Unit& u, int wr, int wc, int fr_, int fq_) const {
        int fr = fr_, fq = fq_; asm volatile("" : "+v"(fr), "+v"(fq));
        const int row0 = u.pm * BM + wr * 64 + fr;
        if (u.pn < gate_pn0) {
            const int col0 = u.pn * BM + wc * 32 + 8 * fq;
#pragma unroll
            for (int ai = 0; ai < 2; ++ai)
#pragma unroll
                for (int m = 0; m < 4; ++m) { bf16_t* rowp = O + (size_t)(row0 + ai * HALF + m * 16) * ldc + col0;
#pragma unroll
                    for (int bj = 0; bj < 2; ++bj) { const f32x4 v0 = acc[ai][bj][m][0], v1 = acc[ai][bj][m][1];
                        u32x4 w; w.x = cvt_pk_bf16(v0[0], v0[1]); w.y = cvt_pk_bf16(v0[2], v0[3]); w.z = cvt_pk_bf16(v1[0], v1[1]); w.w = cvt_pk_bf16(v1[2], v1[3]);
                        *(u32x4*)(rowp + bj * HALF) = w; } }
        } else {
            const int t = u.pn - gate_pn0, c0 = 64 * t + 16 * wc + 4 * fq;
            const float kc = -1.4426950408889634f * gscale, KL = 30.0f * 1.4426950408889634f;
            const size_t gbase = ((size_t)((u.pm * 8 + (c0 >> 8)) * 4) * 16 + ((c0 >> 7) & 1)) * 4096 + (size_t)(((wr * 4 + ((c0 >> 5) & 3)) * 64 + ((c0 >> 3) & 3) * 16 + fr) * 8 + (c0 & 7));
#pragma unroll
            for (int ai = 0; ai < 2; ++ai)
#pragma unroll
                for (int m = 0; m < 4; ++m) { bf16_t* rowp = GF + gbase + (size_t)(ai * 8 + m * 2) * 4096;
                    float r1[4], r2[4], r3[4], g3[4];
#pragma unroll
                    for (int i = 0; i < 4; ++i) {
                        const float e0 = __builtin_amdgcn_exp2f(__builtin_amdgcn_fmed3f(acc[ai][0][m][0][i] * kc, -KL, KL)), e1 = __builtin_amdgcn_exp2f(__builtin_amdgcn_fmed3f(acc[ai][0][m][1][i] * kc, -KL, KL));
                        const float e2 = __builtin_amdgcn_exp2f(__builtin_amdgcn_fmed3f(acc[ai][1][m][0][i] * kc, -KL, KL)), e3 = __builtin_amdgcn_exp2f(__builtin_amdgcn_fmed3f(acc[ai][1][m][1][i] * kc, -KL, KL));
                        const float i0 = __builtin_amdgcn_rcpf(1.f + e0), i1 = __builtin_amdgcn_rcpf(1.f + e1), i2 = __builtin_amdgcn_rcpf(1.f + e2), i3 = __builtin_amdgcn_rcpf(1.f + e3);
                        r1[i] = (1.f + e1) * i0; r2[i] = (1.f + e2) * i1; r3[i] = (1.f + e3) * i2; g3[i] = i3; }
                    u32x2 w;
                    w.x = cvt_pk_bf16(r1[0], r1[1]); w.y = cvt_pk_bf16(r1[2], r1[3]); *(u32x2*)(rowp) = w;
                    w.x = cvt_pk_bf16(r2[0], r2[1]); w.y = cvt_pk_bf16(r2[2], r2[3]); *(u32x2*)(rowp + 16 * 4096) = w;
                    w.x = cvt_pk_bf16(r3[0], r3[1]); w.y = cvt_pk_bf16(r3[2], r3[3]); *(u32x2*)(rowp + 2 * 16 * 4096) = w;
                    w.x = cvt_pk_bf16(g3[0], g3[1]); w.y = cvt_pk_bf16(g3[2], g3[3]); *(u32x2*)(rowp + 3 * 16 * 4096) = w; }
        }
    }
};
__device__ __forceinline__ float dpp_ror1(float x) { return __builtin_bit_cast(float, __builtin_amdgcn_update_dpp(0, __builtin_bit_cast(int, x), 0x121, 0xf, 0xf, true)); }
__device__ __forceinline__ float dpp_ror2(float x) { return __builtin_bit_cast(float, __builtin_amdgcn_update_dpp(0, __builtin_bit_cast(int, x), 0x122, 0xf, 0xf, true)); }
struct EpiConv {
    static constexpr bool PERM = true, KHOOK = false;
    const float* cw; const float* cb; bf16_t* O; float* UH; LAS float* halo; const float* RS;
    __device__ __forceinline__ void khook(f32x4 (&)[2][2][4][2], const Unit&, int, int, int, int, int) const {}
    __device__ __forceinline__ void operator()(f32x4 (&acc)[2][2][4][2], const Unit& u, int wr, int wc, int fr_, int fq_) const {
        int fr = fr_, fq = fq_; asm volatile("" : "+v"(fr), "+v"(fq));
        const int cl0 = wc * 32 + 8 * fq;
        const int j0 = 128 * u.pn + cl0;
        const float* rp = RS + ((size_t)(u.pm * 2 + wr) * 16 + fr) * 8; const f32x4 rs0 = *(const f32x4*)rp, rs1 = *(const f32x4*)(rp + 4);
        f32x4 wa0[3], wv0[3];
#pragma unroll
        for (int q = 0; q < 3; ++q) { wa0[q] = *(const f32x4*)(cw + q * NUP + j0); wv0[q] = *(const f32x4*)(cw + q * NUP + DFF + j0); }
        const f32x4 ba0 = *(const f32x4*)(cb + j0), bv0 = *(const f32x4*)(cb + DFF + j0);
#pragma unroll
        for (int ai = 0; ai < 2; ++ai)
#pragma unroll
            for (int m = 0; m < 4; ++m) { const float r = ai == 0 ? rs0[m] : rs1[m];
#pragma unroll
                for (int bj = 0; bj < 2; ++bj)
#pragma unroll
                    for (int n = 0; n < 2; ++n) acc[ai][bj][m][n] *= r; }
        if (fr >= 14) {
#pragma unroll
            for (int ai = 0; ai < 2; ++ai)
#pragma unroll
                for (int bj = 0; bj < 2; ++bj)
#pragma unroll
                    for (int n = 0; n < 2; ++n) *(LAS f32x4*)(halo + (((2 * ai + wr) * 2 + (fr - 14)) * 256 + 128 * bj + cl0 + 4 * n)) = acc[ai][bj][3][n];
        }
        if (wr == 0 && fr < 2) {
#pragma unroll
            for (int bj = 0; bj < 2; ++bj)
#pragma unroll
                for (int n = 0; n < 2; ++n) *(f32x4*)(UH + ((size_t)u.pm * 4 + fr) * NUP + 256 * u.pn + 128 * bj + cl0 + 4 * n) = acc[0][bj][0][n];
        }
        if (wr == 1 && fr >= 14) {
#pragma unroll
            for (int bj = 0; bj < 2; ++bj)
#pragma unroll
                for (int n = 0; n < 2; ++n) *(f32x4*)(UH + ((size_t)u.pm * 4 + 2 + (fr - 14)) * NUP + 256 * u.pn + 128 * bj + cl0 + 4 * n) = acc[1][bj][3][n];
        }
        asm volatile("s_waitcnt lgkmcnt(0)" ::: "memory"); __builtin_amdgcn_s_barrier(); asm volatile("" ::: "memory");
        const bool is15 = fr == 15, ge14 = fr >= 14;
        unsigned keep[2][4][2];
        f32x4 wa1[3], wv1[3];
#pragma unroll
        for (int q = 0; q < 3; ++q) { wa1[q] = *(const f32x4*)(cw + q * NUP + j0 + 4); wv1[q] = *(const f32x4*)(cw + q * NUP + DFF + j0 + 4); }
        const f32x4 ba1 = *(const f32x4*)(cb + j0 + 4), bv1 = *(const f32x4*)(cb + DFF + j0 + 4);
#pragma unroll
        for (int n = 0; n < 2; ++n) {
            f32x4 wa[3], wv[3];
#pragma unroll
            for (int q = 0; q < 3; ++q) { wa[q] = n == 0 ? wa0[q] : wa1[q]; wv[q] = n == 0 ? wv0[q] : wv1[q]; }
            const f32x4 ba = n == 0 ? ba0 : ba1, bv = n == 0 ? bv0 : bv1;
#pragma unroll
            for (int ai = 0; ai < 2; ++ai) {
                const int blk = 2 * ai + wr;
                f32x4 pa = (f32x4){0.f, 0.f, 0.f, 0.f}, pv = (f32x4){0.f, 0.f, 0.f, 0.f};
                if (blk > 0 && ge14) { pa = *(const LAS f32x4*)(halo + (((blk - 1) * 2 + (fr - 14)) * 256 + cl0 + 4 * n)); pv = *(const LAS f32x4*)(halo + (((blk - 1) * 2 + (fr - 14)) * 256 + 128 + cl0 + 4 * n)); }
#pragma unroll
                for (int m = 0; m < 4; ++m) {
                    const f32x4 ca_ = acc[ai][0][m][n], cv_ = acc[ai][1][m][n]; float o[4];
#pragma unroll
                    for (int i = 0; i < 4; ++i) {
                        const float a1 = dpp_ror1(is15 ? pa[i] : ca_[i]), a2 = dpp_ror2(ge14 ? pa[i] : ca_[i]);
                        const float v1 = dpp_ror1(is15 ? pv[i] : cv_[i]), v2 = dpp_ror2(ge14 ? pv[i] : cv_[i]);
                        const float ca = ba[i] + wa[0][i] * a2 + wa[1][i] * a1 + wa[2][i] * ca_[i];
                        const float cv = bv[i] + wv[0][i] * v2 + wv[1][i] * v1 + wv[2][i] * cv_[i];
                        o[i] = siluf_(ca) * cv; }
                    pa = ca_; pv = cv_;
                    const unsigned lo = cvt_pk_bf16(o[0], o[1]), hi = cvt_pk_bf16(o[2], o[3]);
                    if (n == 0) { keep[ai][m][0] = lo; keep[ai][m][1] = hi; }
                    else { u32x4 w; w.x = keep[ai][m][0]; w.y = keep[ai][m][1]; w.z = lo; w.w = hi;
                        *(u32x4*)(O + (size_t)(u.pm * BM + ai * HALF + wr * 64 + m * 16 + fr) * DFF + j0) = w; }
                }
            }
        }
    }
};
struct EpiResid {
    static constexpr bool PERM = true, KHOOK = false;
    const void* base; int base_f32; bf16_t* O; int ldc; float* SS;
    __device__ __forceinline__ void khook(f32x4 (&)[2][2][4][2], const Unit&, int, int, int, int, int) const {}
    __device__ __forceinline__ void finish(const float (&b)[8], const f32x4 v0, const f32x4 v1, bf16_t* op, float& sq) const {
        const float o0 = b[0] + v0[0], o1 = b[1] + v0[1], o2 = b[2] + v0[2], o3 = b[3] + v0[3], o4 = b[4] + v1[0], o5 = b[5] + v1[1], o6 = b[6] + v1[2], o7 = b[7] + v1[3];
        u32x4 w; w.x = cvt_pk_bf16(o0, o1); w.y = cvt_pk_bf16(o2, o3); w.z = cvt_pk_bf16(o4, o5); w.w = cvt_pk_bf16(o6, o7);
        *(u32x4*)op = w;
        sq += ((o0 * o0 + o1 * o1) + (o2 * o2 + o3 * o3)) + ((o4 * o4 + o5 * o5) + (o6 * o6 + o7 * o7));
    }
    __device__ __forceinline__ void rowsum(float sq, const Unit& u, int wc, int fq, int lane, int row) const {
        sq += __builtin_bit_cast(float, __builtin_amdgcn_ds_bpermute((lane ^ 16) << 2, __builtin_bit_cast(int, sq)));
        sq += __builtin_bit_cast(float, __builtin_amdgcn_ds_bpermute((lane ^ 32) << 2, __builtin_bit_cast(int, sq)));
        if (fq == 0) SS[(size_t)(u.pn * 4 + wc) * M + row] = sq;
    }
    __device__ __forceinline__ void operator()(f32x4 (&acc)[2][2][4][2], const Unit& u, int wr, int wc, int fr_, int fq_) const {
        int fr = fr_, fq = fq_; asm volatile("" : "+v"(fr), "+v"(fq));
        const int row0 = u.pm * BM + wr * 64 + fr, col0 = u.pn * BM + wc * 32 + 8 * fq, lane = fq * 16 + fr;
        if (!base_f32) {
            u32x4 bw[2][4][2];
#pragma unroll
            for (int ai = 0; ai < 2; ++ai)
#pragma unroll
                for (int m = 0; m < 4; ++m)
#pragma unroll
                    for (int bj = 0; bj < 2; ++bj) bw[ai][m][bj] = *(const u32x4*)((const bf16_t*)base + (size_t)(row0 + ai * HALF + m * 16) * ldc + col0 + bj * HALF);
#pragma unroll
            for (int ai = 0; ai < 2; ++ai)
#pragma unroll
                for (int m = 0; m < 4; ++m) { const size_t off = (size_t)(row0 + ai * HALF + m * 16) * ldc + col0; float sq = 0.f;
#pragma unroll
                    for (int bj = 0; bj < 2; ++bj) { float b[8]; unpack8(bw[ai][m][bj], b); finish(b, acc[ai][bj][m][0], acc[ai][bj][m][1], O + off + bj * HALF, sq); }
                    if (SS) rowsum(sq, u, wc, fq, lane, row0 + ai * HALF + m * 16); }
        } else {
#pragma unroll
            for (int ai = 0; ai < 2; ++ai)
#pragma unroll
                for (int m = 0; m < 4; ++m) { const size_t off = (size_t)(row0 + ai * HALF + m * 16) * ldc + col0; float sq = 0.f;
#pragma unroll
                    for (int bj = 0; bj < 2; ++bj) { float b[8]; const float* bp = (const float*)base + off + bj * HALF; const f32x4 b0 = *(const f32x4*)bp, b1 = *(const f32x4*)(bp + 4);
                        b[0] = b0.x; b[1] = b0.y; b[2] = b0.z; b[3] = b0.w; b[4] = b1.x; b[5] = b1.y; b[6] = b1.z; b[7] = b1.w;
                        finish(b, acc[ai][bj][m][0], acc[ai][bj][m][1], O + off + bj * HALF, sq); }
                    if (SS) rowsum(sq, u, wc, fq, lane, row0 + ai * HALF + m * 16);
                    asm volatile("" ::: "memory"); }
        }
    }
};
struct EpiGlu {
    static constexpr bool PERM = true, KHOOK = false;
    const bf16_t* Yp; int ldy; bf16_t* O; int ldc;
    __device__ __forceinline__ void khook(f32x4 (&)[2][2][4][2], const Unit&, int, int, int, int, int) const {}
    __device__ __forceinline__ void operator()(f32x4 (&acc)[2][2][4][2], const Unit& u, int wr, int wc, int fr, int fq) const {
        const int row0 = u.pm * BM + wr * 64 + fr, col0 = u.pn * BM + wc * 32 + 8 * fq;
#pragma unroll
        for (int ai = 0; ai < 2; ++ai)
#pragma unroll
            for (int m = 0; m < 4; ++m) { const size_t r = (size_t)(row0 + ai * HALF + m * 16);
#pragma unroll
                for (int bj = 0; bj < 2; ++bj) { const u32x4 yw = *(const u32x4*)(Yp + r * ldy + col0 + bj * HALF); float y[8]; unpack8(yw, y);
                    const f32x4 v0 = acc[ai][bj][m][0], v1 = acc[ai][bj][m][1]; float o[8];
#pragma unroll
                    for (int j = 0; j < 4; ++j) { o[j] = y[j] * sigmoidf_(v0[j]); o[4 + j] = y[4 + j] * sigmoidf_(v1[j]); }
                    u32x4 w; w.x = cvt_pk_bf16(o[0], o[1]); w.y = cvt_pk_bf16(o[2], o[3]); w.z = cvt_pk_bf16(o[4], o[5]); w.w = cvt_pk_bf16(o[6], o[7]);
                    *(u32x4*)(O + r * ldc + col0 + bj * HALF) = w; } }
    }
};
struct EpiMerge {
    static constexpr bool PERM = true, KHOOK = true;
    const bf16_t* G; bf16_t* O; int ldc;
    __device__ __forceinline__ void scale(f32x4 (&acc)[2][2][4][2], const Unit& u, int s, int wr, int wc, int fr, int fq) const {
        int toff = ((wr * 4 + wc) * 64 + fq * 16 + fr) * 8; asm volatile("" : "+v"(toff));
        const bf16_t* gb = G + (size_t)(((u.pm * 8 + u.pn) * 4 + s) * 16) * 4096 + toff;
        u32x4 w[2][4][2];
#pragma unroll
        for (int ai = 0; ai < 2; ++ai)
#pragma unroll
            for (int m = 0; m < 4; ++m) {
#pragma unroll
                for (int bj = 0; bj < 2; ++bj) w[ai][m][bj] = *(const u32x4*)(gb + (size_t)(ai * 8 + m * 2 + bj) * 4096); }
#pragma unroll
        for (int ai = 0; ai < 2; ++ai)
#pragma unroll
            for (int m = 0; m < 4; ++m)
#pragma unroll
                for (int bj = 0; bj < 2; ++bj) { float f[8]; unpack8(w[ai][m][bj], f);
#pragma unroll
                    for (int j = 0; j < 8; ++j) acc[ai][bj][m][j >> 2][j & 3] *= f[j]; }
    }
    __device__ __forceinline__ void khook(f32x4 (&acc)[2][2][4][2], const Unit& u, int seg, int wr, int wc, int fr, int fq) const { scale(acc, u, seg - 1, wr, wc, fr, fq); }
    __device__ __forceinline__ void operator()(f32x4 (&acc)[2][2][4][2], const Unit& u, int wr, int wc, int fr, int fq) const {
        scale(acc, u, 3, wr, wc, fr, fq);
        const int row0 = u.pm * BM + wr * 64 + fr, col0 = u.pn * BM + wc * 32 + 8 * fq;
#pragma unroll
        for (int ai = 0; ai < 2; ++ai)
#pragma unroll
            for (int m = 0; m < 4; ++m) { bf16_t* rowp = O + (size_t)(row0 + ai * HALF + m * 16) * ldc + col0;
#pragma unroll
                for (int bj = 0; bj < 2; ++bj) { const f32x4 v0 = acc[ai][bj][m][0], v1 = acc[ai][bj][m][1];
                    u32x4 w; w.x = cvt_pk_bf16(v0[0], v0[1]); w.y = cvt_pk_bf16(v0[2], v0[3]); w.z = cvt_pk_bf16(v1[0], v1[1]); w.w = cvt_pk_bf16(v1[2], v1[3]);
                    *(u32x4*)(rowp + bj * HALF) = w; } }
    }
};

typedef int v4i_t __attribute__((ext_vector_type(4)));
typedef int v8i_t __attribute__((ext_vector_type(8)));
template <class Epi, bool F8 = false>
__device__ __forceinline__ void gemm_phase(LAS unsigned char* lds, const Gemm g, const StaticOrder& S, const Epi& E, int tid_in) {
    int tid_ = tid_in; asm volatile("" : "+v"(tid_));
    const int tid = tid_, wid = __builtin_amdgcn_readfirstlane(tid >> 6), lane = tid & 63, wr = wid >> 2, wc = wid & 3, fr = lane & 15, fq = lane >> 4;
    const int K = g.K, nt = K / BK;
    unsigned voffA[2], voffB[2];
#pragma unroll
    for (int i = 0; i < 2; ++i) { int R, C; stage_rc(tid * 16 + i * 8192, R, C); const int Rb = Epi::PERM ? ((R & ~31) + perm32(R & 31)) : R;
        voffA[i] = (unsigned)(R * g.lda + C) * 2u; voffB[i] = (unsigned)(Rb * g.ldb + C) * 2u; }
    const size_t kstep = (size_t)(BK * 2);
    const size_t hstepA = (size_t)HALF * g.lda * 2, hstepB = (size_t)HALF * g.ldb * 2;
    const size_t tstepA = 2 * hstepA, tstepB = 2 * hstepB;
    const unsigned ldsw = (unsigned)wid * 1024u;
    const int aoff = lds_byte(wr * 64 + fr, fq * 8), boff = lds_byte(wc * 32 + fr, fq * 8);
#define PG8_SA(b, h) (((b) * 2 + (h)) * HTB)
#define PG8_SB(b, h) ((4 + (b) * 2 + (h)) * HTB)
#define PG8_STAGE(bufoff, gbase, voff) do { _Pragma("unroll") for (int _i = 0; _i < 2; ++_i) \
        __builtin_amdgcn_global_load_lds((const unsigned*)((const char*)(gbase) + (voff)[_i]), (LAS unsigned*)(lds + (bufoff) + ldsw + _i * 8192), 16, 0, 0); } while (0)
#define PG8_LDA(dst, b, h) do { _Pragma("unroll") for (int m = 0; m < 4; ++m) _Pragma("unroll") for (int k = 0; k < 2; ++k) dst[m][k] = *(const LAS bf16x8*)(lds + PG8_SA(b, h) + aoff + m * 2048 + k * 1024); } while (0)
#define PG8_LDB(dst, b, h) do { _Pragma("unroll") for (int n = 0; n < 2; ++n) _Pragma("unroll") for (int k = 0; k < 2; ++k) dst[n][k] = *(const LAS bf16x8*)(lds + PG8_SB(b, h) + boff + n * 2048 + k * 1024); } while (0)
#define PG8_MMA(ai, bj, At, Bt) do { __builtin_amdgcn_s_setprio(1); _Pragma("unroll") for (int m = 0; m < 4; ++m) _Pragma("unroll") for (int n = 0; n < 2; ++n) _Pragma("unroll") for (int k = 0; k < 2; ++k) \
        acc[ai][bj][m][n] = __builtin_amdgcn_mfma_f32_16x16x32_bf16(Bt[n][k], At[m][k], acc[ai][bj][m][n], 0, 0, 0); __builtin_amdgcn_s_setprio(0); } while (0)
#define PG8_MMA16(ai, bj, At, Bt) PG8_MMA(ai, bj, At, Bt)
#define PG8_MMA8(ai, bj, A8, B8) do { __builtin_amdgcn_s_setprio(1); _Pragma("unroll") for (int m = 0; m < 4; ++m) _Pragma("unroll") for (int n = 0; n < 2; ++n) \
        asm volatile("v_mfma_f32_16x16x128_f8f6f4 %0, %1, %2, %0" : "+v"(acc[ai][bj][m][n]) : "v"(B8[n]), "v"(A8[m])); __builtin_amdgcn_s_setprio(0); } while (0)
#define PG8_LDA8(dst, b, h) do { _Pragma("unroll") for (int m = 0; m < 4; ++m) { dst[m].lo = *(const LAS v4i_t*)(lds + PG8_SA(b, h) + aoff + m * 2048); dst[m].hi = *(const LAS v4i_t*)(lds + PG8_SA(b, h) + aoff + m * 2048 + 1024); } } while (0)
#define PG8_LDB8(dst, b, h) do { _Pragma("unroll") for (int n = 0; n < 2; ++n) { dst[n].lo = *(const LAS v4i_t*)(lds + PG8_SB(b, h) + boff + n * 2048); dst[n].hi = *(const LAS v4i_t*)(lds + PG8_SB(b, h) + boff + n * 2048 + 1024); } } while (0)
#define PG8_XLDA(b, h) do { if constexpr (F8) PG8_LDA8(A8, b, h); else PG8_LDA(At, b, h); } while (0)
#define PG8_XLDB0(b, h) do { if constexpr (F8) PG8_LDB8(B08, b, h); else PG8_LDB(B0, b, h); } while (0)
#define PG8_XLDB1(b, h) do { if constexpr (F8) PG8_LDB8(B18, b, h); else PG8_LDB(B1, b, h); } while (0)
#define PG8_MM0(ai, bj) do { if constexpr (F8) PG8_MMA8(ai, bj, A8, B08); else PG8_MMA16(ai, bj, At, B0); } while (0)
#define PG8_MM1(ai, bj) do { if constexpr (F8) PG8_MMA8(ai, bj, A8, B18); else PG8_MMA16(ai, bj, At, B1); } while (0)
#define PG8_WAIT_V(n) asm volatile("s_waitcnt vmcnt(" #n ")" ::: "memory")
#define PG8_WAIT_L(n) asm volatile("s_waitcnt lgkmcnt(" #n ")" ::: "memory")
#define PG8_BAR __builtin_amdgcn_s_barrier()
#define PG8_SCHED __builtin_amdgcn_sched_barrier(0)
    Unit cur, nxt; int ui = 0;
    if (!S.next(0, cur)) return;
    f32x4 acc[2][2][4][2];
#pragma unroll
    for (int a = 0; a < 2; ++a)
#pragma unroll
        for (int b = 0; b < 2; ++b)
#pragma unroll
            for (int m = 0; m < 4; ++m)
#pragma unroll
                for (int n = 0; n < 2; ++n) acc[a][b][m][n] = (f32x4){0.f, 0.f, 0.f, 0.f};
    bf16x8 At[4][2], B0[2][2], B1[2][2]; v8i_t A8[4], B08[2], B18[2];
    const char* cA = (const char*)g.A + (size_t)cur.pm * tstepA; const char* cB = (const char*)g.Bt + (size_t)cur.pn * tstepB;
    PG8_STAGE(PG8_SB(0, 0), cB, voffB); PG8_STAGE(PG8_SB(0, 1), cB + hstepB, voffB); PG8_STAGE(PG8_SA(0, 0), cA, voffA); PG8_STAGE(PG8_SA(0, 1), cA + hstepA, voffA);
    if (wr == 1) PG8_BAR;
    PG8_WAIT_V(2); PG8_BAR;
    PG8_STAGE(PG8_SB(1, 0), cB + kstep, voffB); PG8_STAGE(PG8_SA(1, 0), cA + kstep, voffA); PG8_STAGE(PG8_SB(1, 1), cB + hstepB + kstep, voffB);
    PG8_WAIT_V(6); PG8_BAR;
    for (;;) {
        const bool has_next = S.next(ui + 1, nxt);
        const char* nA = has_next ? (const char*)g.A + (size_t)nxt.pm * tstepA : cA; const char* nB = has_next ? (const char*)g.Bt + (size_t)nxt.pn * tstepB : cB;
        for (int t = 0; t < nt; t += 2) {
            const bool last = (t == nt - 2);
            const char* a1 = cA + (size_t)(t + 1) * kstep;
            const char* a2 = last ? nA : cA + (size_t)(t + 2) * kstep; const char* b2 = last ? nB : cB + (size_t)(t + 2) * kstep;
            const char* a3 = a2 + kstep; const char* b3 = b2 + kstep;
            if constexpr (Epi::KHOOK) { if (t != 0 && (t & 7) == 0) E.khook(acc, cur, t >> 3, wr, wc, fr, fq); }
            PG8_XLDB0(0, 0); PG8_XLDB1(0, 1); PG8_SCHED; PG8_XLDA(0, 0); PG8_STAGE(PG8_SA(1, 1), a1 + hstepA, voffA);
            PG8_WAIT_V(8); PG8_WAIT_L(0); PG8_BAR; PG8_MM0(0, 0); PG8_MM1(0, 1); PG8_BAR; PG8_SCHED;
            PG8_XLDA(0, 1); PG8_STAGE(PG8_SB(0, 0), b2, voffB); PG8_STAGE(PG8_SB(0, 1), b2 + hstepB, voffB); PG8_STAGE(PG8_SA(0, 0), a2, voffA);
            PG8_WAIT_V(8); PG8_WAIT_L(0); PG8_BAR; PG8_MM0(1, 0); PG8_MM1(1, 1); PG8_BAR; PG8_SCHED;
            PG8_XLDB0(1, 0); PG8_XLDB1(1, 1); PG8_SCHED; PG8_XLDA(1, 0); PG8_STAGE(PG8_SA(0, 1), a2 + hstepA, voffA);
            PG8_WAIT_V(8); PG8_WAIT_L(0); PG8_BAR; PG8_MM0(0, 0); PG8_MM1(0, 1); PG8_BAR; PG8_SCHED;
            PG8_XLDA(1, 1); PG8_STAGE(PG8_SB(1, 0), b3, voffB); PG8_STAGE(PG8_SB(1, 1), b3 + hstepB, voffB); PG8_STAGE(PG8_SA(1, 0), a3, voffA);
            PG8_WAIT_V(8); PG8_WAIT_L(0); PG8_BAR; PG8_MM0(1, 0); PG8_MM1(1, 1); PG8_BAR; PG8_SCHED;
        }
        if (wr == 0) PG8_BAR;
        E(acc, cur, wr, wc, fr, fq);
        if (!has_next) break;
#pragma unroll
        for (int a = 0; a < 2; ++a)
#pragma unroll
            for (int b = 0; b < 2; ++b)
#pragma unroll
                for (int m = 0; m < 4; ++m)
#pragma unroll
                    for (int n = 0; n < 2; ++n) acc[a][b][m][n] = (f32x4){0.f, 0.f, 0.f, 0.f};
        cur = nxt; cA = nA; cB = nB; ++ui;
        if (wr == 1) PG8_BAR;
    }
    PG8_WAIT_V(0);
    PG8_BAR;
#undef PG8_SA
#undef PG8_SB
#undef PG8_STAGE
#undef PG8_LDA
#undef PG8_LDB
#undef PG8_MMA
#undef PG8_MMA8
#undef PG8_MMA16
#undef PG8_LDA8
#undef PG8_LDB8
#undef PG8_XLDA
#undef PG8_XLDB0
#undef PG8_XLDB1
#undef PG8_MM0
#undef PG8_MM1
#undef PG8_WAIT_V
#undef PG8_WAIT_L
#undef PG8_BAR
#undef PG8_SCHED
}
}

#define XB_TMO      128
#define XB_XCNT(j)  (256  + 64 * (j))
#define XB_XSUB(j)  (1280 + 64 * (j))
#define XB_XGEN(j)  (2304 + 64 * (j))
#define XB_TOP      3328
#define XB_TOPGEN   3392
#define XCD_BAR_WORDS 3456
#define XB_SPIN_CAP (1u << 18)
__device__ __forceinline__ unsigned xb_ld(unsigned* p)              { return __hip_atomic_load(p, __ATOMIC_RELAXED, __HIP_MEMORY_SCOPE_AGENT); }
__device__ __forceinline__ unsigned xb_add(unsigned* p, unsigned v) { return __hip_atomic_fetch_add(p, v, __ATOMIC_RELAXED, __HIP_MEMORY_SCOPE_AGENT); }
__device__ __forceinline__ unsigned xb_xcc_id() { return (unsigned)__builtin_amdgcn_s_getreg((3 << 11) | 20) & 0xFu; }
#define XB_SPIN(cond, bar) do { unsigned _sp = 0; while (cond) { __builtin_amdgcn_s_sleep(1); \
    if ((++_sp & 255u) == 0u) { if (xb_ld(&(bar)[XB_TMO])) break; if (_sp > XB_SPIN_CAP) { (void)__hip_atomic_fetch_add(&(bar)[XB_TMO], 1u, __ATOMIC_RELAXED, __HIP_MEMORY_SCOPE_AGENT); break; } } } } while (0)
struct XcdBarrier { unsigned* bar; unsigned x; volatile LAS unsigned* st; };
__device__ __forceinline__ XcdBarrier xcd_barrier_post(unsigned* bar, volatile LAS unsigned* st) {
    XcdBarrier b; b.bar = bar; b.x = xb_xcc_id(); b.st = st;
    if (threadIdx.x == 0) (void)xb_add(&bar[XB_XCNT(b.x)], 1u);
    return b;
}
__device__ __forceinline__ void xcd_barrier_complete(unsigned* bar, unsigned x, unsigned& nloc, unsigned& nx) {
    const unsigned G = gridDim.x * gridDim.y * gridDim.z;
    unsigned sum, cnt, mine, sp = 0u;
    for (;;) {
        sum = 0u; cnt = 0u; mine = 0u;
#pragma nounroll
        for (unsigned j = 0; j < 16; ++j) { const unsigned c = xb_ld(&bar[XB_XCNT(j)]); sum += c; cnt += (c > 0u) ? 1u : 0u; mine = (j == x) ? c : mine; }
        if (sum == G) break;
        __builtin_amdgcn_s_sleep(1);
        if ((++sp & 255u) == 0u) { if (xb_ld(&bar[XB_TMO])) break; if (sp > XB_SPIN_CAP) { (void)__hip_atomic_fetch_add(&bar[XB_TMO], 1u, __ATOMIC_RELAXED, __HIP_MEMORY_SCOPE_AGENT); break; } }
    }
    nloc = mine > 0u ? mine : 1u; nx = cnt > 0u ? cnt : 1u;
}
__device__ __forceinline__ void xcd_barrier(const XcdBarrier& b) {
    asm volatile("s_waitcnt vmcnt(0)" ::: "memory");
    wg_sync();
    if (threadIdx.x == 0) {
        unsigned* bar = b.bar;
        __builtin_amdgcn_s_waitcnt(0);
        unsigned nloc = b.st[0], nx = b.st[1];
        if (nloc == 0u) { xcd_barrier_complete(bar, b.x, nloc, nx); b.st[0] = nloc; b.st[1] = nx; }
        const unsigned old = xb_add(&bar[XB_XSUB(b.x)], 1u);
        const unsigned gen = old / nloc;
        if (old + 1u == (gen + 1u) * nloc) {
            __builtin_amdgcn_fence(__ATOMIC_RELEASE, "agent");
            asm volatile("s_waitcnt vmcnt(0)" ::: "memory");
            const unsigned og = xb_add(&bar[XB_TOP], 1u);
            const unsigned tg = og / nx;
            if (og + 1u == (tg + 1u) * nx) xb_add(&bar[XB_TOPGEN], 1u);
            else XB_SPIN(xb_ld(&bar[XB_TOPGEN]) == tg, bar);
            __builtin_amdgcn_fence(__ATOMIC_ACQUIRE, "agent");
            xb_add(&bar[XB_XGEN(b.x)], 1u);
            asm volatile("s_waitcnt vmcnt(0)" ::: "memory");
        } else {
            XB_SPIN(xb_ld(&bar[XB_XGEN(b.x)]) == gen, bar);
            __builtin_amdgcn_fence(__ATOMIC_ACQUIRE, "agent");
            asm volatile("s_waitcnt vmcnt(0)" ::: "memory");
        }
    }
    wg_sync();
}

__device__ __forceinline__ const void* kin(int k) {
    typedef __attribute__((address_space(4))) const char* kptr_t;
    kptr_t p = (kptr_t)__builtin_amdgcn_kernarg_segment_ptr(); asm volatile("" : "+s"(p));
    const unsigned long long v = *(__attribute__((address_space(4))) const unsigned long long*)(p + 8 * k);
    return (const void*)(GAS const void*)v;
}
struct Frame {
    LAS unsigned char* lds;
    int tid, lane, wave, vcu, G, l;
    unsigned char* ws; float* out;
#define FIN(name, T, k) __device__ __forceinline__ const T* name() const { return (const T*)kin(k); }
    FIN(x, float, 0) FIN(pos, int, 1) FIN(g_mix, float, 2) FIN(w_in, float, 3) FIN(a_re, float, 4) FIN(a_im, float, 5) FIN(log_dt, float, 6) FIN(b_re, float, 7) FIN(b_im, float, 8)
    FIN(c_re, float, 9) FIN(c_im, float, 10) FIN(s5_d, float, 11) FIN(w_glu, float, 12) FIN(gla_wg, float, 13) FIN(gla_bg, float, 14) FIN(pool_w, float, 15) FIN(pool_scale, float, 16)
    FIN(w_branch, float, 17) FIN(w_out, float, 18) FIN(g_ffn, float, 19) FIN(w_up, float, 20) FIN(conv_w, float, 21) FIN(conv_b, float, 22) FIN(w_down, float, 23) FIN(g_final, float, 24)
#undef FIN
#define FWS(name, T, off) __device__ __forceinline__ T* name() const { return (T*)(ws + (off)); }
    FWS(rotc, float, WS_ROT) FWS(rots, float, WS_ROT + (size_t)M * 32 * 4) FWS(abar, float, WS_S5T + S5T_ABAR) FWS(apow, float, WS_S5T + S5T_APOW) FWS(bbar, float, WS_S5T + S5T_BBAR) FWS(cmt, bf16_t, WS_S5T + S5T_CMT) FWS(bbt, bf16_t, WS_S5T + S5T_BBT)
    FWS(wglu_t, bf16_t, WS_WGLU) FWS(poolw_t, bf16_t, WS_POOLW) FWS(win_t, bf16_t, WS_WIN) FWS(wbr_t, bf16_t, WS_WBR) FWS(wout_t, bf16_t, WS_WOUT) FWS(wup_t, bf16_t, WS_WUP) FWS(wdn_t, bf16_t, WS_WDN)
    FWS(HN8, unsigned char, WS_HN8) FWS(W8, unsigned char, WS_W8) FWS(HN, bf16_t, WS_HN) FWS(Y, bf16_t, WS_Y) FWS(YBP, bf16_t, WS_YBP) FWS(PROJ, bf16_t, WS_PROJ) FWS(GF, bf16_t, WS_GF) FWS(SPREV, bf16_t, WS_SPREV) FWS(ACT, bf16_t, WS_ACT)
    FWS(SS, float, WS_SS + (size_t)l * 32 * M * 4) FWS(RS, float, WS_RS + (size_t)l * M * 4) FWS(STATE, float, WS_STATE) FWS(DEC, float, WS_DEC) FWS(XEND, float, WS_XEND) FWS(UH, float, WS_UH)
#undef FWS
};

__device__ __forceinline__ float lane_read(float v, int src_lane) { return __builtin_bit_cast(float, __builtin_amdgcn_ds_bpermute(src_lane << 2, __builtin_bit_cast(int, v))); }
__device__ __forceinline__ float wave_sum(float v, int lane) {
#pragma unroll
    for (int o = 1; o < 64; o <<= 1) v += lane_read(v, lane ^ o);
    return v;
}

template <class SrcCol>
__device__ __forceinline__ void transpose_item(const float* W, int Nsrc, bf16_t* WT, int ldt, int kdst0, int k0, int n0, SrcCol srccol, LAS float* scr, int lane, const float* kscale = nullptr) {
    const int sc = srccol(n0 + (lane & 31));
    float wv[32];
#pragma unroll
    for (int i = 0; i < 32; ++i) { const int kk = 2 * i + (lane >> 5); wv[i] = sc >= 0 ? W[(size_t)(k0 + kk) * Nsrc + sc] : 0.f; }
#pragma unroll
    for (int i = 0; i < 32; ++i) { const int kk = 2 * i + (lane >> 5); scr[kk * 33 + (lane & 31)] = kscale ? wv[i] * kscale[k0 + kk] : wv[i]; }
    LDS_WAIT();
    const int c = lane & 7;
#pragma unroll
    for (int j = 0; j < 4; ++j) { const int n = (lane >> 3) + 8 * j; const LAS float* s = scr + (8 * c) * 33 + n;
        u32x4 o; o.x = pk2(s[0 * 33], s[1 * 33]); o.y = pk2(s[2 * 33], s[3 * 33]); o.z = pk2(s[4 * 33], s[5 * 33]); o.w = pk2(s[6 * 33], s[7 * 33]);
        *(u32x4*)(WT + (size_t)(n0 + n) * ldt + kdst0 + k0 + 8 * c) = o; }
    LDS_WAIT();
}
template <class SrcCol>
__device__ __forceinline__ void transpose_item_fp8(const float* W, int Nsrc, unsigned char* WT, int ldt, int k0, int n0src, int n0dst, SrcCol srccol, LAS float* scr, int lane, const float* kscale, float scale) {
    const int sc = srccol(n0src + (lane & 31));
    float wv[32];
#pragma unroll
    for (int i = 0; i < 32; ++i) { const int kk = 2 * i + (lane >> 5); wv[i] = sc >= 0 ? W[(size_t)(k0 + kk) * Nsrc + sc] : 0.f; }
#pragma unroll
    for (int i = 0; i < 32; ++i) { const int kk = 2 * i + (lane >> 5); scr[kk * 33 + (lane & 31)] = (kscale ? wv[i] * kscale[k0 + kk] : wv[i]) * scale; }
    LDS_WAIT();
    const int c = lane & 7;
#pragma unroll
    for (int j = 0; j < 4; ++j) { const int n = (lane >> 3) + 8 * j; const LAS float* s = scr + (8 * c) * 33 + n;
        u32x2 o; o.x = pk4_fp8(s[0 * 33], s[1 * 33], s[2 * 33], s[3 * 33]); o.y = pk4_fp8(s[4 * 33], s[5 * 33], s[6 * 33], s[7 * 33]);
        *(u32x2*)(WT + (size_t)(n0dst + n) * ldt + k0 + 8 * c) = o; }
    LDS_WAIT();
}
struct ColIdent { __device__ __forceinline__ int operator()(int n) const { return n; } };
struct ColWin { __device__ __forceinline__ int operator()(int n) const {
    if (n < 3584) return n; if (n < 4096) return n + 16; if (n < 4112) return n - 512; if (n < 4352) return -1;
    const int t = (n - 4352) >> 8, cl = (n - 4352) & 255; const int br = 2 * (cl >> 7) + ((cl >> 2) & 1), ch = 16 * ((cl >> 5) & 3) + 4 * ((cl >> 3) & 3) + (cl & 3);
    return 4112 + br * 2048 + 64 * t + ch; } };
struct ColWup { __device__ __forceinline__ int operator()(int n) const { const int blk = n >> 8, r = n & 255; return (r < 128) ? (blk * 128 + r) : (DFF + blk * 128 + (r - 128)); } };

__device__ __forceinline__ void rms_row_to_bf16(const float* xrow, const float* g, bf16_t* orow, int lane, unsigned char* orow8 = nullptr) {
    const f32x4* xr = (const f32x4*)xrow + lane; const f32x4* gr = (const f32x4*)g + lane;
    f32x4 v[8]; float s = 0.f;
#pragma unroll
    for (int j = 0; j < 8; ++j) { v[j] = xr[64 * j]; s += (v[j].x * v[j].x + v[j].y * v[j].y) + (v[j].z * v[j].z + v[j].w * v[j].w); }
    const float r = 1.0f / sqrtf(wave_sum(s, lane) * (1.f / D) + EPS);
    u32x2* o8 = (u32x2*)orow + lane;
#pragma unroll
    for (int j = 0; j < 8; ++j) { const f32x4 gg = gr[64 * j]; const float a = v[j].x * r * gg.x, b = v[j].y * r * gg.y, c = v[j].z * r * gg.z, d = v[j].w * r * gg.w; u32x2 w; w.x = pk2(a, b); w.y = pk2(c, d); o8[64 * j] = w;
        if (orow8) ((unsigned*)orow8)[lane + 64 * j] = pk4_fp8(a, b, c, d); }
}
__device__ __forceinline__ void rms_rows(Frame& F, const float* src, const float* g, bf16_t* dst, unsigned char* dst8 = nullptr) {
    const int gw = F.vcu * NWAVES + F.wave, NGW = F.G * NWAVES;
    for (int m = gw; m < M; m += NGW) rms_row_to_bf16(src + (size_t)m * D, g, dst + (size_t)m * D, F.lane, dst8 ? dst8 + (size_t)m * D : nullptr);
}
__device__ __forceinline__ void row_scale(Frame& F) {
    const int gt = F.vcu * (NWAVES * 64) + F.tid, NGT = F.G * NWAVES * 64;
    for (int m = gt; m < M; m += NGT) { float s = 0.f;
#pragma unroll
        for (int j = 0; j < 32; ++j) s += F.SS()[(size_t)j * M + m];
        const int r = m & 255;
        F.RS()[((size_t)((m >> 8) * 2 + ((r >> 6) & 1)) * 16 + (r & 15)) * 8 + (r >> 7) * 4 + ((r >> 4) & 3)] = 1.0f / sqrtf(s * (1.f / D) + EPS); }
}
__device__ __forceinline__ void rms_rows16(Frame& F, const bf16_t* src, const float* g, bf16_t* dst, unsigned char* dst8) {
    const int gw = F.vcu * NWAVES + F.wave, NGW = F.G * NWAVES, lane = F.lane;
    for (int m = gw; m < M; m += NGW) {
        const u32x4* xr = (const u32x4*)(src + (size_t)m * D) + lane; float v[4][8]; float s = 0.f;
#pragma unroll
        for (int j = 0; j < 4; ++j) { unpack8(xr[64 * j], v[j]);
#pragma unroll
            for (int q = 0; q < 8; ++q) s += v[j][q] * v[j][q]; }
        const float r = 1.0f / sqrtf(wave_sum(s, lane) * (1.f / D) + EPS);
        u32x4* o16 = (u32x4*)(dst + (size_t)m * D) + lane; u32x2* o8 = (u32x2*)(dst8 + (size_t)m * D) + lane;
#pragma unroll
        for (int j = 0; j < 4; ++j) { const f32x4 g0 = *((const f32x4*)g + 2 * (lane + 64 * j)), g1 = *((const f32x4*)g + 2 * (lane + 64 * j) + 1); float y[8];
            y[0] = v[j][0] * r * g0.x; y[1] = v[j][1] * r * g0.y; y[2] = v[j][2] * r * g0.z; y[3] = v[j][3] * r * g0.w; y[4] = v[j][4] * r * g1.x; y[5] = v[j][5] * r * g1.y; y[6] = v[j][6] * r * g1.z; y[7] = v[j][7] * r * g1.w;
            o16[64 * j] = pack8(y); u32x2 w8; w8.x = pk4_fp8(y[0], y[1], y[2], y[3]); w8.y = pk4_fp8(y[4], y[5], y[6], y[7]); o8[64 * j] = w8; }
    }
}
__device__ __forceinline__ void rms_rows16_to_f32(Frame& F, const bf16_t* src, const float* g, float* out) {
    const int gw = F.vcu * NWAVES + F.wave, NGW = F.G * NWAVES, lane = F.lane;
    for (int m = gw; m < M; m += NGW) {
        const u32x4* xr = (const u32x4*)(src + (size_t)m * D) + lane; float v[4][8]; float s = 0.f;
#pragma unroll
        for (int j = 0; j < 4; ++j) { unpack8(xr[64 * j], v[j]);
#pragma unroll
            for (int q = 0; q < 8; ++q) s += v[j][q] * v[j][q]; }
        const float r = 1.0f / sqrtf(wave_sum(s, lane) * (1.f / D) + EPS);
        f32x4* o = (f32x4*)(out + (size_t)m * D);
#pragma unroll
        for (int j = 0; j < 4; ++j) { const f32x4 g0 = *((const f32x4*)g + 2 * (lane + 64 * j)), g1 = *((const f32x4*)g + 2 * (lane + 64 * j) + 1);
            o[2 * (lane + 64 * j)] = (f32x4){v[j][0] * r * g0.x, v[j][1] * r * g0.y, v[j][2] * r * g0.z, v[j][3] * r * g0.w};
            o[2 * (lane + 64 * j) + 1] = (f32x4){v[j][4] * r * g1.x, v[j][5] * r * g1.y, v[j][6] * r * g1.z, v[j][7] * r * g1.w}; }
    }
}
__device__ __forceinline__ void rms_rows_f32_inplace(Frame& F, float* buf, const float* g) {
    const int gw = F.vcu * NWAVES + F.wave, NGW = F.G * NWAVES;
    for (int m = gw; m < M; m += NGW) {
        f32x4* xr = (f32x4*)(buf + (size_t)m * D) + F.lane; const f32x4* gr = (const f32x4*)g + F.lane;
        f32x4 v[8]; float s = 0.f;
#pragma unroll
        for (int j = 0; j < 8; ++j) { v[j] = xr[64 * j]; s += (v[j].x * v[j].x + v[j].y * v[j].y) + (v[j].z * v[j].z + v[j].w * v[j].w); }
        const float r = 1.0f / sqrtf(wave_sum(s, F.lane) * (1.f / D) + EPS);
#pragma unroll
        for (int j = 0; j < 8; ++j) { const f32x4 gg = gr[64 * j]; xr[64 * j] = (f32x4){v[j].x * r * gg.x, v[j].y * r * gg.y, v[j].z * r * gg.z, v[j].w * r * gg.w}; }
    }
}

__device__ __forceinline__ void phase_prep(Frame& F, int l) {
    LAS float* scr = (LAS float*)(F.lds + F.wave * 16384);
    const int gw = F.vcu * NWAVES + F.wave, NGW = F.G * NWAVES;
    constexpr int I_IN = (D / 64) * (NIN / 32), I_UP = (D / 64) * (NUP / 32), I_DN = (DFF / 64) * (D / 32), I_BR = 4 * (BW / 64) * (D / 32), I_OUT = (D / 64) * (D / 32), I_GLU = (BW / 64) * (BW / 32), I_PL = 4 * (128 / 64) * (128 / 32);
    constexpr int NITEMS = I_IN + I_UP + I_DN + I_BR + I_OUT + I_GLU + I_PL;
    for (int it = gw; it < NITEMS; it += NGW) {
        int r = it;
        if (r < I_IN) { const int nb = NIN / 32, n0 = 32 * (r % nb);
            if (n0 < C_GATE) transpose_item(F.w_in() + (size_t)l * D * NIN_SRC, NIN_SRC, F.win_t(), D, 0, 64 * (r / nb), n0, ColWin(), scr, F.lane);
            else transpose_item_fp8(F.w_in() + (size_t)l * D * NIN_SRC, NIN_SRC, F.W8(), D, 64 * (r / nb), n0, n0 - C_GATE, ColWin(), scr, F.lane, nullptr, 64.0f);
            continue; } r -= I_IN;
        if (r < I_UP) { const int nb = NUP / 32; transpose_item(F.w_up() + (size_t)l * D * NUP, NUP, F.wup_t(), D, 0, 64 * (r / nb), 32 * (r % nb), ColWup(), scr, F.lane, F.g_ffn() + (size_t)l * D); continue; } r -= I_UP;
        if (r < I_DN) { const int nb = D / 32; transpose_item(F.w_down() + (size_t)l * DFF * D, D, F.wdn_t(), DFF, 0, 64 * (r / nb), 32 * (r % nb), ColIdent(), scr, F.lane); continue; } r -= I_DN;
        if (r < I_BR) { const int per = (BW / 64) * (D / 32), br = r / per, q = r % per, nb = D / 32;
            transpose_item(F.w_branch() + ((size_t)l * 4 + br) * BW * D, D, F.wbr_t(), D, br * BW, 64 * (q / nb), 32 * (q % nb), ColIdent(), scr, F.lane); continue; } r -= I_BR;
        if (r < I_OUT) { const int nb = D / 32; transpose_item(F.w_out() + (size_t)l * D * D, D, F.wout_t(), D, 0, 64 * (r / nb), 32 * (r % nb), ColIdent(), scr, F.lane); continue; } r -= I_OUT;
        if (r < I_GLU) { const int nb = BW / 32; transpose_item(F.w_glu() + (size_t)l * BW * BW, BW, F.wglu_t(), BW, 0, 64 * (r / nb), 32 * (r % nb), ColIdent(), scr, F.lane); continue; } r -= I_GLU;
        { const int grp = r / 8, q = r % 8; transpose_item(F.pool_w() + ((size_t)l * 4 + grp) * 128 * 128, 128, F.poolw_t() + (size_t)grp * 128 * 128, 128, 0, 64 * (q / 4), 32 * (q % 4), ColIdent(), scr, F.lane); }
    }
    const int gt = F.vcu * (NWAVES * 64) + F.tid, NGT = F.G * NWAVES * 64;
    for (int i = gt; i < 32 * 64; i += NGT) {
        const int g = i >> 6;
        const float are = F.a_re()[(size_t)l * 2048 + i], aim = F.a_im()[(size_t)l * 2048 + i], dt = expf(F.log_dt()[l * 32 + g]);
        const float mag = expf(are * dt), th = aim * dt;
        const float abr = mag * cosf(th), abi = mag * sinf(th);
        const float den = are * are + aim * aim, nr = abr - 1.0f, ni = abi;
        const float fre = (nr * are + ni * aim) / den, fim = (ni * are - nr * aim) / den;
        F.abar()[2 * i] = abr; F.abar()[2 * i + 1] = abi;
        float pr = abr, pi = abi;
#pragma unroll
        for (int q = 0; q < 6; ++q) { const float tr = pr * pr - pi * pi, ti = 2.f * pr * pi; pr = tr; pi = ti; }
        F.apow()[2 * i] = pr; F.apow()[2 * i + 1] = pi;
        const float* br = F.b_re() + ((size_t)l * 2048 + i) * 16; const float* bi = F.b_im() + ((size_t)l * 2048 + i) * 16;
#pragma unroll
        for (int c = 0; c < 16; ++c) { const float x = br[c], y = bi[c]; const float vr = fre * x - fim * y, vi = fre * y + fim * x; const int p = i & 63;
            F.bbt()[((size_t)g * 128 + p) * 16 + c] = (bf16_t)f2bf(vr); F.bbt()[((size_t)g * 128 + 64 + p) * 16 + c] = (bf16_t)f2bf(vi); }
    }
    for (int i = gt; i < 32 * 16 * 128; i += NGT) {
        const int k = i & 127, gc = i >> 7;
        const float v = (k < 64) ? F.c_re()[((size_t)l * 512 + gc) * 64 + k] : -F.c_im()[((size_t)l * 512 + gc) * 64 + (k - 64)];
        F.cmt()[i] = (bf16_t)f2bf(v);
    }
    if (l == 0) {
        for (int i = gt; i < M * 32; i += NGT) {
            const int row = i >> 5, j = i & 31;
            const float inv = exp2f(-(float)j * (13.287712379549449f / 32.0f));
            const float ang = (float)F.pos()[row] * inv;
            F.rotc()[i] = cosf(ang); F.rots()[i] = sinf(ang);
        }
    }
    if (l == 0) rms_rows(F, F.x(), F.g_mix(), F.HN(), F.HN8()); else rms_rows16(F, (const bf16_t*)F.out, F.g_mix() + (size_t)l * D, F.HN(), F.HN8());
}

__device__ __forceinline__ void gr_pass(Frame& F) {
    const int gw = F.vcu * NWAVES + F.wave, NGW = F.G * NWAVES, lane = F.lane, lr = lane & 15, lq = lane >> 4;
    for (int unit = gw; unit < M / 16; unit += NGW) {
        const bf16_t* ap = F.HN() + (size_t)(16 * unit + lr) * D + 8 * lq; const bf16_t* bp = F.win_t() + (size_t)(C_GR + lr) * D + 8 * lq;
        f32x4 acc = (f32x4){0.f, 0.f, 0.f, 0.f};
#pragma unroll 1
        for (int kb = 0; kb < 64; kb += 16) { bf16x8 a[16], b[16];
#pragma unroll
            for (int j = 0; j < 16; ++j) { a[j] = *(const bf16x8*)(ap + 32 * (kb + j)); b[j] = *(const bf16x8*)(bp + 32 * (kb + j)); }
#pragma unroll
            for (int j = 0; j < 16; ++j) acc = __builtin_amdgcn_mfma_f32_16x16x32_bf16(a[j], b[j], acc, 0, 0, 0); }
#pragma unroll
        for (int i = 0; i < 4; ++i) F.PROJ()[(size_t)(16 * unit + 4 * lq + i) * LDP + C_GR + lr] = (bf16_t)f2bf(acc[i]);
    }
}

__device__ __forceinline__ f32x4 mma_nt_lds(const LAS bf16_t* X, int px, const LAS bf16_t* Y, int py, int ksteps, f32x4 acc, int lane) {
    const LAS bf16_t* xp = X + (lane & 15) * px + 8 * (lane >> 4);
    const LAS bf16_t* yp = Y + (lane & 15) * py + 8 * (lane >> 4);
    for (int ks = 0; ks < ksteps; ++ks) {
        const bf16x8 a = *(const LAS bf16x8*)(xp + 32 * ks), b = *(const LAS bf16x8*)(yp + 32 * ks);
        acc = __builtin_amdgcn_mfma_f32_16x16x32_bf16(a, b, acc, 0, 0, 0);
    }
    return acc;
}

constexpr int LN_TOT = 16384, LN_QD = 18432, LN_KI = 27648, LN_PM = 36864, LN_VT = 46080, LN_OB = 64512, LN_WG = 98304, LN_END = 98304 + 4096 + 256;
constexpr int LP = 72;
struct LinRaw { u32x4 q0, q1, k0, k1, v0, v1, g0, g1, gr0, gr1; f32x4 c0, c1, s0, s1; bf16x8 sp0, sp1; };
template <bool OUT>
__device__ __forceinline__ void lin_issue(Frame& F, int unit, LinRaw& R) {
    const int n = unit & 63, h = (unit >> 6) & 3, b = (unit >> 8) & 7, mixer = unit >> 11;
    const size_t row0 = (size_t)b * SEQ + (size_t)n * CH; const int s = F.tid >> 3, c = F.tid & 7;
    const int cq = (mixer == 0 ? C_RQ : C_GQ) + h * 64, ck = (mixer == 0 ? C_RK : C_GK) + h * 64, cv = (mixer == 0 ? C_RV : C_GV) + h * 128, cg = (mixer == 0 ? C_RG : C_GG) + h * 128;
    const bf16_t* pr = F.PROJ() + (row0 + s) * LDP;
    R.k0 = *(const u32x4*)(pr + ck + 8 * c); R.k1 = *(const u32x4*)(pr + ck + 8 * (c ^ 4));
    if (OUT) { R.q0 = *(const u32x4*)(pr + cq + 8 * c); R.q1 = *(const u32x4*)(pr + cq + 8 * (c ^ 4)); }
    { const float* cp = F.rotc() + (row0 + s) * 32 + (c & 3) * 8; const float* sp = F.rots() + (row0 + s) * 32 + (c & 3) * 8;
      R.c0 = *(const f32x4*)cp; R.c1 = *(const f32x4*)(cp + 4); R.s0 = *(const f32x4*)sp; R.s1 = *(const f32x4*)(sp + 4); }
    R.gr0 = *(const u32x4*)(pr + C_GR); R.gr1 = *(const u32x4*)(pr + C_GR + 8);
    R.v0 = *(const u32x4*)(F.PROJ() + (row0 + (F.tid >> 4)) * LDP + cv + (F.tid & 15) * 8);
    R.v1 = *(const u32x4*)(F.PROJ() + (row0 + 32 + (F.tid >> 4)) * LDP + cv + (F.tid & 15) * 8);
    if (OUT) { R.g0 = *(const u32x4*)(pr + cg + 16 * c); R.g1 = *(const u32x4*)(pr + cg + 16 * c + 8);
        const bf16_t* sq = F.SPREV() + (size_t)unit * 8192 + (size_t)(16 * F.wave + (F.lane & 15)) * 64 + 8 * (F.lane >> 4);
        R.sp0 = *(const bf16x8*)sq; R.sp1 = *(const bf16x8*)(sq + 32); }
}
__device__ __forceinline__ void lin_rot(const u32x4 own_, const u32x4 oth_, const LinRaw& R, bool rot, bool hi, float scale, float (&v)[8]) {
    float own[8]; unpack8(own_, own);
    if (!rot) {
#pragma unroll
        for (int j = 0; j < 8; ++j) v[j] = own[j] * scale;
        return; }
    float oth[8]; unpack8(oth_, oth);
    const float cs[8] = {R.c0.x, R.c0.y, R.c0.z, R.c0.w, R.c1.x, R.c1.y, R.c1.z, R.c1.w}, sn[8] = {R.s0.x, R.s0.y, R.s0.z, R.s0.w, R.s1.x, R.s1.y, R.s1.z, R.s1.w};
#pragma unroll
    for (int j = 0; j < 8; ++j) { const float os = oth[j] * sn[j]; v[j] = (own[j] * cs[j] + (hi ? os : -os)) * scale; }
}
__device__ __forceinline__ void lin_decay(Frame& F, int mixer, int h, const LinRaw& R, float (&bcum)[8], float (&blast)[8]) {
    LAS float* TOT = (LAS float*)(F.lds + LN_TOT);
    const int s = F.tid >> 3, c = F.tid & 7, d0 = 8 * c;
    if (mixer == 0) {
        const float lg = __logf(1.0f - exp2f(-5.0f - (float)h));
#pragma unroll
        for (int j = 0; j < 8; ++j) { bcum[j] = (float)(s + 1) * lg; blast[j] = 64.0f * lg; }
        lds_sync();
        return;
    }
    const LAS float* WG = (const LAS float*)(F.lds + LN_WG);
    float grf[16]; { float a[8], b2[8]; unpack8(R.gr0, a); unpack8(R.gr1, b2);
#pragma unroll
        for (int j = 0; j < 8; ++j) { grf[j] = a[j]; grf[8 + j] = b2[j]; } }
    float x[8]; { const f32x4 b0 = *(const LAS f32x4*)(WG + 1024 + d0), b1 = *(const LAS f32x4*)(WG + 1024 + d0 + 4); x[0] = b0.x; x[1] = b0.y; x[2] = b0.z; x[3] = b0.w; x[4] = b1.x; x[5] = b1.y; x[6] = b1.z; x[7] = b1.w; }
#pragma unroll
    for (int r = 0; r < 16; ++r) { const f32x4 w0 = *(const LAS f32x4*)(WG + r * 64 + d0), w1 = *(const LAS f32x4*)(WG + r * 64 + d0 + 4);
        x[0] += grf[r] * w0.x; x[1] += grf[r] * w0.y; x[2] += grf[r] * w0.z; x[3] += grf[r] * w0.w; x[4] += grf[r] * w1.x; x[5] += grf[r] * w1.y; x[6] += grf[r] * w1.z; x[7] += grf[r] * w1.w; }
#pragma unroll
    for (int j = 0; j < 8; ++j) x[j] = logsigmoidf_(x[j]) * (1.0f / 16.0f);
#pragma unroll
    for (int st = 8; st <= 32; st <<= 1) {
#pragma unroll
        for (int j = 0; j < 8; ++j) { const float t = lane_read(x[j], F.lane - st); if (F.lane >= st) x[j] += t; } }
    if ((F.lane >> 3) == 7) { *(LAS f32x4*)(TOT + F.wave * 64 + d0) = (f32x4){x[0], x[1], x[2], x[3]}; *(LAS f32x4*)(TOT + F.wave * 64 + d0 + 4) = (f32x4){x[4], x[5], x[6], x[7]}; }
    lds_sync();
    float off[8], tot[8];
#pragma unroll
    for (int j = 0; j < 8; ++j) { off[j] = 0.f; tot[j] = 0.f; }
#pragma unroll
    for (int w = 0; w < 8; ++w) { const f32x4 t0 = *(const LAS f32x4*)(TOT + w * 64 + d0), t1 = *(const LAS f32x4*)(TOT + w * 64 + d0 + 4); const float tv[8] = {t0.x, t0.y, t0.z, t0.w, t1.x, t1.y, t1.z, t1.w};
#pragma unroll
        for (int j = 0; j < 8; ++j) { tot[j] += tv[j]; off[j] += (w < F.wave) ? tv[j] : 0.f; } }
#pragma unroll
    for (int j = 0; j < 8; ++j) { bcum[j] = x[j] + off[j]; blast[j] = tot[j]; }
}
typedef short v4s_t __attribute__((ext_vector_type(4)));
__device__ __forceinline__ bf16x8 tr_frag(const LAS bf16_t* T, int pitch, int k0, int x0, int lane) {
    const int g = lane >> 4, i = lane & 15, q = i >> 2, p = i & 3;
    const LAS bf16_t* a = T + (k0 + 8 * g + q) * pitch + x0 + 4 * p;
    const v4s_t lo = __builtin_amdgcn_ds_read_tr16_b64_v4i16((LAS v4s_t*)a), hi = __builtin_amdgcn_ds_read_tr16_b64_v4i16((LAS v4s_t*)(a + 4 * pitch));
    return __builtin_shufflevector(lo, hi, 0, 1, 2, 3, 4, 5, 6, 7);
}
constexpr int PV = 144;
__device__ __forceinline__ void lin_store_vt(Frame& F, const LinRaw& R) {
    LAS bf16_t* VR = (LAS bf16_t*)(F.lds + LN_VT); const int e0 = (F.tid & 15) * 8;
    *(LAS u32x4*)(VR + (F.tid >> 4) * PV + e0) = R.v0; *(LAS u32x4*)(VR + (32 + (F.tid >> 4)) * PV + e0) = R.v1;
}
__device__ __forceinline__ void lin_state_compute(Frame& F, int unit, const LinRaw& R) {
    const int h = (unit >> 6) & 3, mixer = unit >> 11; const int s = F.tid >> 3, c = F.tid & 7, d0 = 8 * c;
    LAS bf16_t* KDT = (LAS bf16_t*)(F.lds + LN_KI); LAS bf16_t* VT = (LAS bf16_t*)(F.lds + LN_VT);
    float k[8], bcum[8], blast[8];
    lin_rot(R.k0, R.k1, R, mixer == 0, c >= 4, mixer == 0 ? 0.125f : 1.0f, k);
    lin_decay(F, mixer, h, R, bcum, blast);
    { float kd[8];
#pragma unroll
      for (int j = 0; j < 8; ++j) kd[j] = k[j] * __expf(blast[j] - bcum[j]);
      *(LAS u32x4*)(KDT + s * LP + d0) = pack8(kd); }
    lin_store_vt(F, R);
    if (s == 0) { float* dc = F.DEC() + (size_t)unit * 64 + d0;
        *(f32x4*)dc = (f32x4){__expf(blast[0]), __expf(blast[1]), __expf(blast[2]), __expf(blast[3])}; *(f32x4*)(dc + 4) = (f32x4){__expf(blast[4]), __expf(blast[5]), __expf(blast[6]), __expf(blast[7])}; }
    lds_sync();
    { const int w = F.wave, lane = F.lane; float* st = F.STATE() + (size_t)unit * 8192;
      const bf16x8 vf0 = tr_frag(VT, PV, 0, 16 * w, lane), vf1 = tr_frag(VT, PV, 32, 16 * w, lane);
#pragma unroll
      for (int dt = 0; dt < 4; ++dt) { f32x4 acc = (f32x4){0.f, 0.f, 0.f, 0.f};
          acc = __builtin_amdgcn_mfma_f32_16x16x32_bf16(vf0, tr_frag(KDT, LP, 0, 16 * dt, lane), acc, 0, 0, 0);
          acc = __builtin_amdgcn_mfma_f32_16x16x32_bf16(vf1, tr_frag(KDT, LP, 32, 16 * dt, lane), acc, 0, 0, 0);
#pragma unroll
          for (int i = 0; i < 4; ++i) st[(16 * w + 4 * (lane >> 4) + i) * 64 + 16 * dt + (lane & 15)] = acc[i]; } }
}
__device__ __forceinline__ void lin_out_compute(Frame& F, int unit, const LinRaw& R) {
    const int n = unit & 63, h = (unit >> 6) & 3, b = (unit >> 8) & 7, mixer = unit >> 11;
    const size_t row0 = (size_t)b * SEQ + (size_t)n * CH; const int s = F.tid >> 3, c = F.tid & 7, d0 = 8 * c;
    const int ycol = (mixer == 0 ? 0 : 1024) + h * 128;
    LAS bf16_t* QD = (LAS bf16_t*)(F.lds + LN_QD); LAS bf16_t* KI = (LAS bf16_t*)(F.lds + LN_KI); LAS bf16_t* PM = (LAS bf16_t*)(F.lds + LN_PM);
    LAS bf16_t* VT = (LAS bf16_t*)(F.lds + LN_VT); LAS float* OB = (LAS float*)(F.lds + LN_OB);
    float q[8], k[8], bcum[8], blast[8];
    lin_rot(R.q0, R.q1, R, mixer == 0, c >= 4, mixer == 0 ? 1.0f : 0.125f, q);
    lin_rot(R.k0, R.k1, R, mixer == 0, c >= 4, mixer == 0 ? 0.125f : 1.0f, k);
    lin_decay(F, mixer, h, R, bcum, blast);
    { float qd[8], ki[8];
#pragma unroll
      for (int j = 0; j < 8; ++j) { qd[j] = q[j] * __expf(bcum[j]); ki[j] = k[j] * __expf(-bcum[j]); }
      *(LAS u32x4*)(QD + s * LP + d0) = pack8(qd); *(LAS u32x4*)(KI + s * LP + d0) = pack8(ki); }
    lin_store_vt(F, R);
    lds_sync();
    { const int lane = F.lane;
#pragma unroll
      for (int j = 0; j < 2; ++j) { const int tile = 2 * F.wave + j, tt = tile >> 2, st = tile & 3;
          f32x4 acc = (f32x4){0.f, 0.f, 0.f, 0.f};
          if (st <= tt) acc = mma_nt_lds(QD + 16 * tt * LP, LP, KI + 16 * st * LP, LP, 2, acc, lane);
#pragma unroll
          for (int i = 0; i < 4; ++i) { const int t = 16 * tt + 4 * (lane >> 4) + i, s2 = 16 * st + (lane & 15); const float p = (st <= tt && s2 <= t) ? acc[i] : 0.f; PM[t * LP + s2] = (bf16_t)f2bf(p); } } }
    lds_sync();
    { const int w = F.wave, lane = F.lane;
      const bf16x8 vf0 = tr_frag(VT, PV, 0, 16 * w, lane), vf1 = tr_frag(VT, PV, 32, 16 * w, lane);
#pragma unroll
      for (int tt = 0; tt < 4; ++tt) { f32x4 acc = (f32x4){0.f, 0.f, 0.f, 0.f};
          { const LAS bf16_t* pp = PM + (16 * tt + (lane & 15)) * LP + 8 * (lane >> 4);
            acc = __builtin_amdgcn_mfma_f32_16x16x32_bf16(*(const LAS bf16x8*)pp, vf0, acc, 0, 0, 0);
            acc = __builtin_amdgcn_mfma_f32_16x16x32_bf16(*(const LAS bf16x8*)(pp + 32), vf1, acc, 0, 0, 0); }
          const LAS bf16_t* xp = QD + (16 * tt + (lane & 15)) * LP + 8 * (lane >> 4);
          acc = __builtin_amdgcn_mfma_f32_16x16x32_bf16(*(const LAS bf16x8*)xp, R.sp0, acc, 0, 0, 0);
          acc = __builtin_amdgcn_mfma_f32_16x16x32_bf16(*(const LAS bf16x8*)(xp + 32), R.sp1, acc, 0, 0, 0);
#pragma unroll
          for (int i = 0; i < 4; ++i) OB[(16 * tt + 4 * (lane >> 4) + i) * 132 + 16 * w + (lane & 15)] = acc[i]; } }
    lds_sync();
    { const int t = s, part = c; float o[16];
#pragma unroll
      for (int j = 0; j < 4; ++j) { const f32x4 v = *(const LAS f32x4*)(OB + t * 132 + 16 * part + 4 * j); o[4 * j] = v.x; o[4 * j + 1] = v.y; o[4 * j + 2] = v.z; o[4 * j + 3] = v.w; }
      float sm = 0.f;
#pragma unroll
      for (int j = 0; j < 16; ++j) sm += o[j];
      sm += lane_read(sm, F.lane ^ 1); sm += lane_read(sm, F.lane ^ 2); sm += lane_read(sm, F.lane ^ 4);
      const float mu = sm * (1.0f / 128.0f); float qv = 0.f;
#pragma unroll
      for (int j = 0; j < 16; ++j) { const float dlt = o[j] - mu; qv += dlt * dlt; }
      qv += lane_read(qv, F.lane ^ 1); qv += lane_read(qv, F.lane ^ 2); qv += lane_read(qv, F.lane ^ 4);
      const float r = 1.0f / sqrtf(qv * (1.0f / 128.0f) + EPS);
      float g0[8], g1[8]; unpack8(R.g0, g0); unpack8(R.g1, g1);
      float y0[8], y1[8];
#pragma unroll
      for (int j = 0; j < 8; ++j) { y0[j] = (o[j] - mu) * r * siluf_(g0[j]); y1[j] = (o[8 + j] - mu) * r * siluf_(g1[j]); }
      bf16_t* yp = F.Y() + (row0 + t) * D + ycol + 16 * part; *(u32x4*)yp = pack8(y0); *(u32x4*)(yp + 8) = pack8(y1); }
}
template <bool OUT>
__device__ __forceinline__ void lin_phase(Frame& F, int l) {
    { const int h = (F.vcu >> 6) & 3; LAS float* WG = (LAS float*)(F.lds + LN_WG);
      for (int i = F.tid; i < 16 * 64 + 64; i += NWAVES * 64) WG[i] = (i < 1024) ? F.gla_wg()[(size_t)l * 16 * 256 + (i >> 6) * 256 + h * 64 + (i & 63)] : F.gla_bg()[l * 256 + h * 64 + (i - 1024)];
      lds_sync(); }
    LinRaw A, B;
    lin_issue<OUT>(F, F.vcu, A);
    for (int u = F.vcu; u < 4096; u += 2 * F.G) {
        lin_issue<OUT>(F, u + F.G, B);
        if (OUT) lin_out_compute(F, u, A); else lin_state_compute(F, u, A);
        if (u + 2 * F.G < 4096) lin_issue<OUT>(F, u + 2 * F.G, A);
        if (OUT) lin_out_compute(F, u + F.G, B); else lin_state_compute(F, u + F.G, B);
    }
    lds_sync();
}
constexpr int L2_TOT = 0, L2_QD = 1024, L2_KI = 10240, L2_V = 19456, L2_SP = 37888, L2_PM = 56320, L2_STRIDE = 65536, L2_WG = 131072;
struct Lin2 { int unit, h, mixer, hw, s, c; size_t row0; LAS unsigned char* base; };
__device__ __forceinline__ void lin2_rot16(const u32x4 lo_, const u32x4 hi_, const f32x4 (&cs)[2], const f32x4 (&sn)[2], bool rot, float scale, float (&v)[16]) {
    float lo[8], hi[8]; unpack8(lo_, lo); unpack8(hi_, hi);
    if (!rot) {
#pragma unroll
        for (int j = 0; j < 8; ++j) { v[j] = lo[j] * scale; v[8 + j] = hi[j] * scale; }
    } else {
        const float c8[8] = {cs[0].x, cs[0].y, cs[0].z, cs[0].w, cs[1].x, cs[1].y, cs[1].z, cs[1].w}, s8[8] = {sn[0].x, sn[0].y, sn[0].z, sn[0].w, sn[1].x, sn[1].y, sn[1].z, sn[1].w};
#pragma unroll
        for (int j = 0; j < 8; ++j) { v[j] = (lo[j] * c8[j] - hi[j] * s8[j]) * scale; v[8 + j] = (hi[j] * c8[j] + lo[j] * s8[j]) * scale; }
    }
}
__device__ __forceinline__ void lin2_decay(Frame& F, const Lin2& L, const u32x4 gr0, const u32x4 gr1, float (&bcum)[16], float (&blast)[16]) {
    LAS float* TOT = (LAS float*)(L.base + L2_TOT);
    const int d0 = 8 * L.c;
    if (L.mixer == 0) {
        const float lg = __logf(1.0f - exp2f(-5.0f - (float)L.h));
#pragma unroll
        for (int j = 0; j < 16; ++j) { bcum[j] = (float)(L.s + 1) * lg; blast[j] = 64.0f * lg; }
        lds_sync();
        return;
    }
    const LAS float* WG = (const LAS float*)(F.lds + L2_WG);
    float grf[16]; { float a[8], b2[8]; unpack8(gr0, a); unpack8(gr1, b2);
#pragma unroll
        for (int j = 0; j < 8; ++j) { grf[j] = a[j]; grf[8 + j] = b2[j]; } }
    float x[16];
#pragma unroll
    for (int q = 0; q < 4; ++q) { const f32x4 b0 = *(const LAS f32x4*)(WG + 1024 + d0 + 32 * (q >> 1) + 4 * (q & 1)); x[4 * q] = b0.x; x[4 * q + 1] = b0.y; x[4 * q + 2] = b0.z; x[4 * q + 3] = b0.w; }
#pragma unroll
    for (int r = 0; r < 16; ++r) {
#pragma unroll
        for (int q = 0; q < 4; ++q) { const f32x4 w0 = *(const LAS f32x4*)(WG + r * 64 + d0 + 32 * (q >> 1) + 4 * (q & 1));
            x[4 * q] += grf[r] * w0.x; x[4 * q + 1] += grf[r] * w0.y; x[4 * q + 2] += grf[r] * w0.z; x[4 * q + 3] += grf[r] * w0.w; } }
#pragma unroll
    for (int j = 0; j < 16; ++j) x[j] = logsigmoidf_(x[j]) * (1.0f / 16.0f);
#pragma unroll
    for (int st = 4; st <= 32; st <<= 1) {
#pragma unroll
        for (int j = 0; j < 16; ++j) { const float t = lane_read(x[j], F.lane - st); if (F.lane >= st) x[j] += t; } }
    if ((F.lane >> 2) == 15) {
#pragma unroll
        for (int q = 0; q < 4; ++q) *(LAS f32x4*)(TOT + L.hw * 64 + d0 + 32 * (q >> 1) + 4 * (q & 1)) = (f32x4){x[4 * q], x[4 * q + 1], x[4 * q + 2], x[4 * q + 3]}; }
    lds_sync();
    float off[16], tot[16];
#pragma unroll
    for (int j = 0; j < 16; ++j) { off[j] = 0.f; tot[j] = 0.f; }
#pragma unroll
    for (int w = 0; w < 4; ++w) {
#pragma unroll
        for (int q = 0; q < 4; ++q) { const f32x4 t0 = *(const LAS f32x4*)(TOT + w * 64 + d0 + 32 * (q >> 1) + 4 * (q & 1)); const float tv[4] = {t0.x, t0.y, t0.z, t0.w};
#pragma unroll
            for (int j = 0; j < 4; ++j) { tot[4 * q + j] += tv[j]; off[4 * q + j] += (w < L.hw) ? tv[j] : 0.f; } } }
#pragma unroll
    for (int j = 0; j < 16; ++j) { bcum[j] = x[j] + off[j]; blast[j] = tot[j]; }
}
__device__ __forceinline__ bf16x8 tr_frag8(const LAS bf16_t* T, int pitch, int k0, int x0, int lane) {
    const int g = lane >> 4, i = lane & 15, q = i >> 2, p = i & 3;
    const LAS bf16_t* a = T + (k0 + 8 * g + q) * pitch + x0 + 8 * p;
    const v4s_t lo = __builtin_amdgcn_ds_read_tr16_b64_v4i16((LAS v4s_t*)a), hi = __builtin_amdgcn_ds_read_tr16_b64_v4i16((LAS v4s_t*)(a + 4 * pitch));
    return __builtin_shufflevector(lo, hi, 0, 1, 2, 3, 4, 5, 6, 7);
}
__device__ __forceinline__ void lin2_state(Frame& F, const Lin2& L) {
    const int ht = F.tid & 255, lane = F.lane, s = L.s, c = L.c, d0 = 8 * c;
    const int ck = (L.mixer == 0 ? C_RK : C_GK) + L.h * 64, cv = (L.mixer == 0 ? C_RV : C_GV) + L.h * 128;
    LAS bf16_t* KD = (LAS bf16_t*)(L.base + L2_KI); LAS bf16_t* VT = (LAS bf16_t*)(L.base + L2_V);
    const bf16_t* pr = F.PROJ() + (L.row0 + s) * LDP;
    u32x4 vv[4]; f32x4 cs[2], sn[2];
    const u32x4 klo = *(const u32x4*)(pr + ck + d0), khi = *(const u32x4*)(pr + ck + 32 + d0);
    u32x4 gr0 = (u32x4){0u, 0u, 0u, 0u}, gr1 = gr0;
    cs[0] = cs[1] = sn[0] = sn[1] = (f32x4){0.f, 0.f, 0.f, 0.f};
    if (L.mixer == 0) { const float* cp = F.rotc() + (L.row0 + s) * 32 + d0; const float* sp = F.rots() + (L.row0 + s) * 32 + d0;
      cs[0] = *(const f32x4*)cp; cs[1] = *(const f32x4*)(cp + 4); sn[0] = *(const f32x4*)sp; sn[1] = *(const f32x4*)(sp + 4); }
    else { gr0 = *(const u32x4*)(pr + C_GR); gr1 = *(const u32x4*)(pr + C_GR + 8); }
#pragma unroll
    for (int i = 0; i < 4; ++i) { const int idx = ht + 256 * i; vv[i] = *(const u32x4*)(F.PROJ() + (L.row0 + (idx >> 4)) * LDP + cv + (idx & 15) * 8); }
    float k[16], bcum[16], blast[16];
    lin2_rot16(klo, khi, cs, sn, L.mixer == 0, L.mixer == 0 ? 0.125f : 1.0f, k);
    lin2_decay(F, L, gr0, gr1, bcum, blast);
#pragma unroll
    for (int g = 0; g < 2; ++g) { float kd[8];
#pragma unroll
        for (int j = 0; j < 8; ++j) kd[j] = k[8 * g + j] * __expf(blast[8 * g + j] - bcum[8 * g + j]);
        *(LAS u32x4*)(KD + s * LP + d0 + 32 * g) = pack8(kd); }
#pragma unroll
    for (int i = 0; i < 4; ++i) { const int idx = ht + 256 * i; *(LAS u32x4*)(VT + (idx >> 4) * PV + (idx & 15) * 8) = vv[i]; }
    if (s == 0) { float* dc = F.DEC() + (size_t)L.unit * 64 + d0;
#pragma unroll
        for (int q = 0; q < 4; ++q) *(f32x4*)(dc + 32 * (q >> 1) + 4 * (q & 1)) = (f32x4){__expf(blast[4 * q]), __expf(blast[4 * q + 1]), __expf(blast[4 * q + 2]), __expf(blast[4 * q + 3])}; }
    lds_sync();
    { float* st = F.STATE() + (size_t)L.unit * 8192;
      const bf16x8 kf0 = tr_frag(KD, LP, 0, 16 * L.hw, lane), kf1 = tr_frag(KD, LP, 32, 16 * L.hw, lane);
#pragma unroll
      for (int et = 0; et < 8; ++et) { f32x4 acc = (f32x4){0.f, 0.f, 0.f, 0.f};
          acc = __builtin_amdgcn_mfma_f32_16x16x32_bf16(kf0, tr_frag(VT, PV, 0, 16 * et, lane), acc, 0, 0, 0);
          acc = __builtin_amdgcn_mfma_f32_16x16x32_bf16(kf1, tr_frag(VT, PV, 32, 16 * et, lane), acc, 0, 0, 0);
          *(f32x4*)(st + (16 * et + (lane & 15)) * 64 + 16 * L.hw + 4 * (lane >> 4)) = acc; } }
}
__device__ __forceinline__ void lin2_out(Frame& F, const Lin2& L) {
    const int ht = F.tid & 255, lane = F.lane, lr = lane & 15, lq = lane >> 4, s = L.s, c = L.c, d0 = 8 * c;
    const int cq = (L.mixer == 0 ? C_RQ : C_GQ) + L.h * 64, ck = (L.mixer == 0 ? C_RK : C_GK) + L.h * 64, cv = (L.mixer == 0 ? C_RV : C_GV) + L.h * 128, cg = (L.mixer == 0 ? C_RG : C_GG) + L.h * 128;
    const int ycol = (L.mixer == 0 ? 0 : 1024) + L.h * 128;
    LAS bf16_t* QD = (LAS bf16_t*)(L.base + L2_QD); LAS bf16_t* KI = (LAS bf16_t*)(L.base + L2_KI); LAS bf16_t* VT = (LAS bf16_t*)(L.base + L2_V);
    LAS bf16_t* SP = (LAS bf16_t*)(L.base + L2_SP); LAS bf16_t* PM = (LAS bf16_t*)(L.base + L2_PM + L.hw * 2304);
    const bf16_t* pr = F.PROJ() + (L.row0 + s) * LDP;
    float q[16], k[16], bcum[16], blast[16];
    u32x4 vv[4], sv[4]; u32x4 gr0, gr1;
    { f32x4 cs[2], sn[2];
      const u32x4 klo = *(const u32x4*)(pr + ck + d0), khi = *(const u32x4*)(pr + ck + 32 + d0), qlo = *(const u32x4*)(pr + cq + d0), qhi = *(const u32x4*)(pr + cq + 32 + d0);
      gr0 = (u32x4){0u, 0u, 0u, 0u}; gr1 = gr0; cs[0] = cs[1] = sn[0] = sn[1] = (f32x4){0.f, 0.f, 0.f, 0.f};
      if (L.mixer == 0) { const float* cp = F.rotc() + (L.row0 + s) * 32 + d0; const float* sp = F.rots() + (L.row0 + s) * 32 + d0;
        cs[0] = *(const f32x4*)cp; cs[1] = *(const f32x4*)(cp + 4); sn[0] = *(const f32x4*)sp; sn[1] = *(const f32x4*)(sp + 4); }
      else { gr0 = *(const u32x4*)(pr + C_GR); gr1 = *(const u32x4*)(pr + C_GR + 8); }
#pragma unroll
      for (int i = 0; i < 4; ++i) { const int idx = ht + 256 * i; vv[i] = *(const u32x4*)(F.PROJ() + (L.row0 + (idx >> 4)) * LDP + cv + (idx & 15) * 8);
          sv[i] = *(const u32x4*)(F.SPREV() + (size_t)L.unit * 8192 + (size_t)idx * 8); }
      lin2_rot16(qlo, qhi, cs, sn, L.mixer == 0, L.mixer == 0 ? 1.0f : 0.125f, q);
      lin2_rot16(klo, khi, cs, sn, L.mixer == 0, L.mixer == 0 ? 0.125f : 1.0f, k); }
    lin2_decay(F, L, gr0, gr1, bcum, blast);
#pragma unroll
    for (int g = 0; g < 2; ++g) { float qd[8], ki[8];
#pragma unroll
        for (int j = 0; j < 8; ++j) { qd[j] = q[8 * g + j] * __expf(bcum[8 * g + j]); ki[j] = k[8 * g + j] * __expf(-bcum[8 * g + j]); }
        *(LAS u32x4*)(QD + s * LP + d0 + 32 * g) = pack8(qd); *(LAS u32x4*)(KI + s * LP + d0 + 32 * g) = pack8(ki); }
#pragma unroll
    for (int i = 0; i < 4; ++i) { const int idx = ht + 256 * i; *(LAS u32x4*)(VT + (idx >> 4) * PV + (idx & 15) * 8) = vv[i]; *(LAS u32x4*)(SP + (idx >> 3) * LP + (idx & 7) * 8) = sv[i]; }
    const bf16_t* gp = F.PROJ() + (L.row0 + 16 * L.hw + lr) * LDP + cg + 8 * lq;
    u32x4 gt[4];
#pragma unroll
    for (int pe = 0; pe < 4; ++pe) gt[pe] = *(const u32x4*)(gp + 32 * pe);
    lds_sync();
    const LAS bf16_t* qrow = QD + (16 * L.hw + lr) * LP + 8 * lq;
    const bf16x8 qf0 = *(const LAS bf16x8*)qrow, qf1 = *(const LAS bf16x8*)(qrow + 32);
#pragma unroll
    for (int st = 0; st < 4; ++st) {
        f32x4 acc = (f32x4){0.f, 0.f, 0.f, 0.f};
        if (st <= L.hw) { const LAS bf16_t* krow = KI + (16 * st + lr) * LP + 8 * lq;
            acc = __builtin_amdgcn_mfma_f32_16x16x32_bf16(*(const LAS bf16x8*)krow, qf0, acc, 0, 0, 0);
            acc = __builtin_amdgcn_mfma_f32_16x16x32_bf16(*(const LAS bf16x8*)(krow + 32), qf1, acc, 0, 0, 0); }
        float p[4];
#pragma unroll
        for (int i = 0; i < 4; ++i) p[i] = (st <= L.hw && 16 * st + 4 * lq + i <= 16 * L.hw + lr) ? acc[i] : 0.f;
        u32x2 w; w.x = pk2(p[0], p[1]); w.y = pk2(p[2], p[3]);
        *(LAS u32x2*)(PM + lr * LP + 16 * st + 4 * lq) = w; }
    asm volatile("s_waitcnt lgkmcnt(0)" ::: "memory");
    const bf16x8 pf0 = *(const LAS bf16x8*)(PM + lr * LP + 8 * lq), pf1 = *(const LAS bf16x8*)(PM + lr * LP + 32 + 8 * lq);
    f32x4 o[8];
    const int erow = 8 * (lr >> 2) + (lr & 3);
#pragma unroll
    for (int et = 0; et < 8; ++et) { const int e0 = 32 * (et >> 1) + 4 * (et & 1); f32x4 acc = (f32x4){0.f, 0.f, 0.f, 0.f};
        acc = __builtin_amdgcn_mfma_f32_16x16x32_bf16(tr_frag8(VT, PV, 0, e0, lane), pf0, acc, 0, 0, 0);
        acc = __builtin_amdgcn_mfma_f32_16x16x32_bf16(tr_frag8(VT, PV, 32, e0, lane), pf1, acc, 0, 0, 0);
        const LAS bf16_t* srow = SP + (e0 + erow) * LP + 8 * lq;
        acc = __builtin_amdgcn_mfma_f32_16x16x32_bf16(*(const LAS bf16x8*)srow, qf0, acc, 0, 0, 0);
        acc = __builtin_amdgcn_mfma_f32_16x16x32_bf16(*(const LAS bf16x8*)(srow + 32), qf1, acc, 0, 0, 0);
        o[et] = acc; }
    float sm = 0.f;
#pragma unroll
    for (int et = 0; et < 8; ++et) sm += (o[et][0] + o[et][1]) + (o[et][2] + o[et][3]);
    sm += lane_read(sm, lane ^ 16); sm += lane_read(sm, lane ^ 32);
    const float mu = sm * (1.0f / 128.0f); float qv = 0.f;
#pragma unroll
    for (int et = 0; et < 8; ++et) {
#pragma unroll
        for (int i = 0; i < 4; ++i) { const float dlt = o[et][i] - mu; qv += dlt * dlt; } }
    qv += lane_read(qv, lane ^ 16); qv += lane_read(qv, lane ^ 32);
    const float r = 1.0f / sqrtf(qv * (1.0f / 128.0f) + EPS);
    bf16_t* yp = F.Y() + (L.row0 + 16 * L.hw + lr) * D + ycol + 8 * lq;
#pragma unroll
    for (int pe = 0; pe < 4; ++pe) { float g[8], y[8]; unpack8(gt[pe], g);
#pragma unroll
        for (int j = 0; j < 8; ++j) y[j] = (o[2 * pe + (j >> 2)][j & 3] - mu) * r * siluf_(g[j]);
        *(u32x4*)(yp + 32 * pe) = pack8(y); }
}
template <bool OUT>
__device__ __forceinline__ void lin2_phase(Frame& F, int l) {
    { const int h = (F.vcu >> 6) & 3; LAS float* WG = (LAS float*)(F.lds + L2_WG);
      for (int i = F.tid; i < 16 * 64 + 64; i += NWAVES * 64) WG[i] = (i < 1024) ? F.gla_wg()[(size_t)l * 16 * 256 + (i >> 6) * 256 + h * 64 + (i & 63)] : F.gla_bg()[l * 256 + h * 64 + (i - 1024)];
      lds_sync(); }
    const int half = F.wave >> 2;
#pragma unroll 1
    for (int j = 0; j < 8; ++j) {
        Lin2 L; L.unit = F.vcu + 256 * (2 * j + half); L.h = (L.unit >> 6) & 3; asm volatile("" : "+s"(L.h)); L.mixer = L.unit >> 11; L.hw = F.wave & 3; L.s = (F.tid & 255) >> 2; L.c = F.tid & 3;
        L.row0 = (size_t)((L.unit >> 8) & 7) * SEQ + (size_t)(L.unit & 63) * CH; L.base = F.lds + half * L2_STRIDE;
        if (OUT) lin2_out(F, L); else lin2_state(F, L);
    }
    lds_sync();
}
__device__ __forceinline__ void lin_scan(Frame& F) {
    const int gt = F.vcu * (NWAVES * 64) + F.tid, NGT = F.G * NWAVES * 64;
    for (int i = gt; i < 64 * 8192; i += NGT) {
        const int seq = i >> 13, idx = i & 8191, d = idx & 63;
        const float* st = F.STATE() + (size_t)seq * NCH * 8192 + idx; const float* dc = F.DEC() + (size_t)seq * NCH * 64 + d; bf16_t* sp = F.SPREV() + (size_t)seq * NCH * 8192 + idx;
        float carry = 0.f; asm volatile("" : "+v"(carry));
#pragma unroll
        for (int h = 0; h < 2; ++h) {
            float v[32], c[32];
#pragma unroll
            for (int n = 0; n < 32; ++n) { v[n] = st[(size_t)(32 * h + n) * 8192]; c[n] = dc[(size_t)(32 * h + n) * 64]; }
#pragma unroll
            for (int n = 0; n < 32; ++n) { sp[(size_t)(32 * h + n) * 8192] = (bf16_t)f2bf(carry); carry = c[n] * carry + v[n]; asm volatile("" : "+v"(carry)); }
        }
    }
}
constexpr int S5_WL = 16384, S5_BU = 2048, S5_X = 2048 + 8320;
template <bool OUT>
__device__ __forceinline__ void s5_pass(Frame& F, int l) {
    LAS bf16_t* UT = (LAS bf16_t*)(F.lds + F.wave * S5_WL); LAS float* BU = (LAS float*)(F.lds + F.wave * S5_WL + S5_BU); LAS bf16_t* X = (LAS bf16_t*)(F.lds + F.wave * S5_WL + S5_X);
    const int gw = F.vcu * NWAVES + F.wave, NGW = F.G * NWAVES, lane = F.lane, lr = lane & 15, lq = lane >> 4;
    u32x4 ua, uc;
    { const int g = gw & 31, n = (gw >> 5) & 63, b = gw >> 11; const bf16_t* up = F.PROJ() + ((size_t)b * SEQ + (size_t)n * CH + lane) * LDP + C_SU + g * 16; ua = *(const u32x4*)up; uc = *(const u32x4*)(up + 8); }
    const int g = gw & 31;
    const int gp = g * 64 + lane; const float ar = F.abar()[2 * gp], ai = F.abar()[2 * gp + 1];
    bf16x8 bfr[8];
#pragma unroll
    for (int q = 0; q < 8; ++q) { bfr[q] = (bf16x8){0, 0, 0, 0, 0, 0, 0, 0}; if (lq < 2) bfr[q] = *(const bf16x8*)(F.bbt() + ((size_t)g * 128 + 16 * q + lr) * 16 + 8 * lq); }
    bf16x8 cf[4]; float dsk = 0.f;
    if (OUT) {
#pragma unroll
        for (int ks = 0; ks < 4; ++ks) cf[ks] = *(const bf16x8*)(F.cmt() + ((size_t)(g * 16 + lr)) * 128 + 32 * ks + 8 * lq);
        dsk = F.s5_d()[(size_t)l * BW + g * 16 + lr]; }
    for (int unit = gw; unit < BATCH * NCH * 32; unit += NGW) {
        const int n = (unit >> 5) & 63, b = unit >> 11; const size_t row0 = (size_t)b * SEQ + (size_t)n * CH;
        *(LAS u32x4*)(UT + lane * 16) = ua; *(LAS u32x4*)(UT + lane * 16 + 8) = uc;
        if (unit + NGW < BATCH * NCH * 32) { const int un = unit + NGW, g2 = un & 31, n2 = (un >> 5) & 63, b2 = un >> 11;
            const bf16_t* up = F.PROJ() + ((size_t)b2 * SEQ + (size_t)n2 * CH + lane) * LDP + C_SU + g2 * 16; ua = *(const u32x4*)up; uc = *(const u32x4*)(up + 8); }
        float xr = 0.f, xi = 0.f;
        if (OUT) { const f32x2 x0 = *(const f32x2*)(F.XEND() + ((((size_t)(b * 32 + g)) * NCH + n) * 64 + lane) * 2); xr = x0.x; xi = x0.y; }
        LDS_WAIT();
        for (int sb = 0; sb < 4; ++sb) {
            bf16x8 af = (bf16x8){0, 0, 0, 0, 0, 0, 0, 0}; if (lq < 2) af = *(const LAS bf16x8*)(UT + (16 * sb + lr) * 16 + 8 * lq);
#pragma unroll
            for (int q = 0; q < 8; ++q) { f32x4 acc = (f32x4){0.f, 0.f, 0.f, 0.f}; acc = __builtin_amdgcn_mfma_f32_16x16x32_bf16(af, bfr[q], acc, 0, 0, 0);
#pragma unroll
                for (int i = 0; i < 4; ++i) BU[(4 * lq + i) * 130 + 16 * q + lr] = acc[i]; }
            LDS_WAIT();
            float br[16], bi[16];
#pragma unroll
            for (int tt = 0; tt < 16; ++tt) { br[tt] = BU[tt * 130 + lane]; bi[tt] = BU[tt * 130 + 64 + lane]; }
#pragma unroll
            for (int tt = 0; tt < 16; ++tt) { const float nr = ar * xr - ai * xi + br[tt], ni = ar * xi + ai * xr + bi[tt]; xr = nr; xi = ni; asm volatile("" : "+v"(xr), "+v"(xi));
                if (OUT) { X[tt * 136 + lane] = (bf16_t)f2bf(xr); X[tt * 136 + 64 + lane] = (bf16_t)f2bf(xi); } }
            if (OUT) {
                LDS_WAIT();
                f32x4 acc = (f32x4){0.f, 0.f, 0.f, 0.f}; const LAS bf16_t* xp = X + lr * 136 + 8 * lq;
#pragma unroll
                for (int ks = 0; ks < 4; ++ks) acc = __builtin_amdgcn_mfma_f32_16x16x32_bf16(*(const LAS bf16x8*)(xp + 32 * ks), cf[ks], acc, 0, 0, 0);
#pragma unroll
                for (int i = 0; i < 4; ++i) { const int tl = 16 * sb + 4 * lq + i; const float u = bflo((unsigned)UT[tl * 16 + lr]); const float y = gelu_tanh(acc[i] + dsk * u);
                    F.YBP()[(row0 + tl) * BW + g * 16 + lr] = (bf16_t)f2bf(y); }
            }
            LDS_WAIT();
        }
        if (!OUT) *(f32x2*)(F.XEND() + ((((size_t)(b * 32 + g)) * NCH + n) * 64 + lane) * 2) = (f32x2){xr, xi};
    }
}
__device__ __forceinline__ void s5_scan(Frame& F) {
    const int gt = F.vcu * (NWAVES * 64) + F.tid, NGT = F.G * NWAVES * 64;
    for (int i = gt; i < BATCH * 32 * 64; i += NGT) {
        const int p = i & 63, bg = i >> 6, g = bg & 31; const float pr = F.apow()[2 * (g * 64 + p)], pi = F.apow()[2 * (g * 64 + p) + 1];
        f32x2* xp = (f32x2*)(F.XEND() + (((size_t)bg * NCH) * 64 + p) * 2);
        float cr = 0.f, ci = 0.f; asm volatile("" : "+v"(cr), "+v"(ci));
#pragma unroll
        for (int h = 0; h < 2; ++h) {
            f32x2 v[32];
#pragma unroll
            for (int n = 0; n < 32; ++n) v[n] = xp[(size_t)(32 * h + n) * 64];
#pragma unroll
            for (int n = 0; n < 32; ++n) { xp[(size_t)(32 * h + n) * 64] = (f32x2){cr, ci};
                const float nr = pr * cr - pi * ci + v[n].x, ni = pr * ci + pi * cr + v[n].y; cr = nr; ci = ni; asm volatile("" : "+v"(cr), "+v"(ci)); }
        }
    }
}

__device__ __forceinline__ void pool_phase(Frame& F, int l) {
    const int gw = F.vcu * NWAVES + F.wave, NGW = F.G * NWAVES, lane = F.lane, lr = lane & 15, lq = lane >> 4;
    for (int unit = gw; unit < BATCH * (SEQ / 16) * 4; unit += NGW) {
        const int g = ((unit & 3) + (unit >> 11)) & 3, tile = (unit >> 2) & 255, b = (unit >> 10) & 7; const int win = 2 << g, tpos = 16 * tile + lr; const size_t row = (size_t)b * SEQ + tpos;
        const bf16_t* pp = F.PROJ() + row * LDP + C_PU + g * 128 + 8 * lq;
        float s[4][8];
#pragma unroll
        for (int ks = 0; ks < 4; ++ks)
#pragma unroll
            for (int j = 0; j < 8; ++j) s[ks][j] = 0.f;
        for (int j0 = 1; j0 < win; j0 += 5) {
            u32x4 t[5][4];
#pragma unroll
            for (int q = 0; q < 5; ++q) { const int je = min(j0 + q, tpos);
#pragma unroll
                for (int ks = 0; ks < 4; ++ks) t[q][ks] = *(const u32x4*)(pp - (size_t)je * LDP + 32 * ks); }
#pragma unroll
            for (int q = 0; q < 5; ++q) { const float wgt = (j0 + q < win && j0 + q <= tpos) ? 1.f : 0.f;
#pragma unroll
                for (int ks = 0; ks < 4; ++ks) { float a[8]; unpack8(t[q][ks], a);
#pragma unroll
                    for (int j = 0; j < 8; ++j) s[ks][j] += wgt * a[j]; } } }
        const float inv = 1.0f / (float)min(tpos + 1, win);
        u32x4 cur[4]; bf16x8 wf[8][4]; f32x4 scv[8];
        const bf16_t* pw = F.poolw_t() + (size_t)g * 128 * 128 + (size_t)lr * 128 + 8 * lq;
#pragma unroll
        for (int ks = 0; ks < 4; ++ks) cur[ks] = *(const u32x4*)(pp + 32 * ks);
#pragma unroll
        for (int q = 0; q < 8; ++q) {
#pragma unroll
            for (int ks = 0; ks < 4; ++ks) wf[q][ks] = *(const bf16x8*)(pw + (size_t)(16 * q) * 128 + 32 * ks);
            scv[q] = *(const f32x4*)(F.pool_scale() + (size_t)l * BW + g * 128 + 16 * q + 4 * lq); }
        bf16x8 mf[4];
#pragma unroll
        for (int ks = 0; ks < 4; ++ks) { float a[8], m[8]; unpack8(cur[ks], a);
#pragma unroll
            for (int j = 0; j < 8; ++j) m[j] = (s[ks][j] + a[j]) * inv - a[j];
            const u32x4 w = pack8(m); mf[ks] = __builtin_bit_cast(bf16x8, w); }
        u32x2 ow[8];
#pragma unroll
        for (int q = 0; q < 8; ++q) { f32x4 acc = (f32x4){0.f, 0.f, 0.f, 0.f};
#pragma unroll
            for (int ks = 0; ks < 4; ++ks) acc = __builtin_amdgcn_mfma_f32_16x16x32_bf16(wf[q][ks], mf[ks], acc, 0, 0, 0);
            ow[q].x = pk2(acc[0] * scv[q].x, acc[1] * scv[q].y); ow[q].y = pk2(acc[2] * scv[q].z, acc[3] * scv[q].w); }
#pragma unroll
        for (int q = 0; q < 8; ++q) *(u32x2*)(F.Y() + row * D + 1536 + g * 128 + 16 * q + 4 * lq) = ow[q];
    }
}

__device__ __forceinline__ void conv_fix_phase(Frame& F, int l) {
    const float* cw = F.conv_w() + (size_t)l * 3 * NUP; const float* cb = F.conv_b() + (size_t)l * NUP; const float* UH = F.UH();
    const int gt = F.vcu * (NWAVES * 64) + F.tid, NGT = F.G * NWAVES * 64;
    constexpr int JG = DFF / 4;
    for (int task = gt; task < (M / 256) * 2 * JG; task += NGT) {
        const int jg = task % JG, q = (task / JG) & 1, pm = task / (2 * JG);
        if ((pm & 15) == 0) continue;
        const int j0 = jg * 4, ucol = 256 * (j0 >> 7) + (j0 & 127);
        const float* u0p = UH + ((size_t)pm * 4 + q) * NUP + ucol;
        const float* u1p = (q == 1) ? UH + ((size_t)pm * 4 + 0) * NUP + ucol : UH + ((size_t)(pm - 1) * 4 + 3) * NUP + ucol;
        const float* u2p = (q == 1) ? UH + ((size_t)(pm - 1) * 4 + 3) * NUP + ucol : UH + ((size_t)(pm - 1) * 4 + 2) * NUP + ucol;
        const f32x4 a0 = *(const f32x4*)u0p, a1 = *(const f32x4*)u1p, a2 = *(const f32x4*)u2p, v0 = *(const f32x4*)(u0p + 128), v1 = *(const f32x4*)(u1p + 128), v2 = *(const f32x4*)(u2p + 128);
        const f32x4 wa0 = *(const f32x4*)(cw + j0), wa1 = *(const f32x4*)(cw + NUP + j0), wa2 = *(const f32x4*)(cw + 2 * NUP + j0), ba = *(const f32x4*)(cb + j0);
        const f32x4 wv0 = *(const f32x4*)(cw + DFF + j0), wv1 = *(const f32x4*)(cw + NUP + DFF + j0), wv2 = *(const f32x4*)(cw + 2 * NUP + DFF + j0), bv = *(const f32x4*)(cb + DFF + j0);
        float o[4];
#pragma unroll
        for (int i = 0; i < 4; ++i) { const float ca = ba[i] + wa0[i] * a2[i] + wa1[i] * a1[i] + wa2[i] * a0[i], cv = bv[i] + wv0[i] * v2[i] + wv1[i] * v1[i] + wv2[i] * v0[i]; o[i] = siluf_(ca) * cv; }
        u32x2 w; w.x = pk2(o[0], o[1]); w.y = pk2(o[2], o[3]);
        *(u32x2*)(F.ACT() + ((size_t)pm * 256 + q) * DFF + j0) = w;
    }
}

constexpr int NPH = 13;
struct Args { const void* in[25]; float* out; unsigned char* ws; int l_lo, l_hi, ph_lo, ph_hi, single, pad; };
__global__ void __launch_bounds__(NWAVES * 64, 2) hybrid_fwd(Args args) {
    extern __shared__ __attribute__((aligned(16))) unsigned char lds[];
    Frame F;
    F.lds = (LAS unsigned char*)lds;
    F.tid = threadIdx.x; F.lane = F.tid & 63; F.wave = __builtin_amdgcn_readfirstlane(F.tid >> 6);
    const int wave0 = F.wave;
    F.G = gridDim.x; { const int bx = blockIdx.x; F.vcu = (F.G % 8 == 0) ? (bx % 8) * (F.G / 8) + bx / 8 : bx; }
    unsigned char* ws = args.ws; F.ws = ws; F.out = args.out; F.l = 0;

    volatile LAS unsigned* MISC = (volatile LAS unsigned*)(F.lds + MISC_OFF);
    if (F.tid < 64) MISC[F.tid] = 0u;
    wg_sync();
    unsigned* ctl = (unsigned*)(ws + WS_CTL);
    XcdBarrier bar; bar.bar = ctl + CW_BAR; bar.x = 0; bar.st = nullptr;
    if (args.single) bar = xcd_barrier_post(ctl + CW_BAR, MISC);
#define GRID_BAR() do { if (args.single) xcd_barrier(bar); } while (0)
    const int lo = args.ph_lo, hi = args.ph_hi;
#define IN(k) (lo <= (k) && (k) < hi)
#define PH_BEGIN() do { unsigned z_ = 0u; asm volatile("" : "+v"(z_)); const int ln_ = (int)__builtin_amdgcn_mbcnt_hi(~0u, __builtin_amdgcn_mbcnt_lo(~0u, z_)); F.lane = ln_; F.tid = wave0 * 64 + ln_; F.wave = wave0; unsigned long long w_ = (unsigned long long)args.ws, o_ = (unsigned long long)args.out; asm volatile("" : "+s"(w_), "+s"(o_)); F.ws = (unsigned char*)(GAS unsigned char*)w_; F.out = (float*)(GAS float*)o_; } while (0)

    for (int l = args.l_lo; l < args.l_hi; ++l) {
        F.l = l;
        if (IN(0)) { PH_BEGIN(); phase_prep(F, l); GRID_BAR(); }
        if (IN(1)) { PH_BEGIN();
            { pg8::Gemm g{(const bf16_t*)F.HN8(), (const bf16_t*)F.W8(), M, 4 * D, D / 2, D / 2, D / 2}; pg8::StaticOrder S; S.init(M, 4 * D, F.G, (int)blockIdx.x); pg8::EpiProj E{F.PROJ(), LDP, 0, F.GF(), 1.0f / 64.0f};
              pg8::gemm_phase<pg8::EpiProj, true>(F.lds, g, S, E, F.tid); }
            PH_BEGIN();
            { pg8::Gemm g{F.HN(), F.win_t(), M, C_GR, D, D, D}; pg8::StaticOrder S; S.init(M, C_GR, F.G, (int)blockIdx.x); pg8::EpiProj E{F.PROJ(), LDP, 1 << 20, F.GF(), 1.0f};
              pg8::gemm_phase(F.lds, g, S, E, F.tid); }
            PH_BEGIN(); gr_pass(F);
            GRID_BAR(); }
        if (IN(2)) { PH_BEGIN(); lin2_phase<false>(F, l); PH_BEGIN();
            s5_pass<false>(F, l); pool_phase(F, l); wg_sync();
            GRID_BAR(); }
        if (IN(3)) { PH_BEGIN(); lin_scan(F); s5_scan(F); GRID_BAR(); }
        if (IN(4)) { PH_BEGIN(); lin2_phase<true>(F, l); PH_BEGIN();
            s5_pass<true>(F, l); wg_sync();
            GRID_BAR(); }
        if (IN(5)) { PH_BEGIN(); pg8::Gemm g{F.YBP(), F.wglu_t(), M, BW, BW, BW, BW}; pg8::StaticOrder S; S.init(M, BW, F.G, (int)blockIdx.x); pg8::EpiGlu E{F.YBP(), BW, F.Y() + BW, D};
            pg8::gemm_phase(F.lds, g, S, E, F.tid); GRID_BAR(); }
        if (IN(6)) { PH_BEGIN(); for (int i = 0; i < (F.vcu & 7); ++i) __builtin_amdgcn_s_sleep(56);
            pg8::Gemm g{F.Y(), F.wbr_t(), M, D, D, D, D}; pg8::StaticOrder S; S.init(M, D, F.G, (int)blockIdx.x); pg8::EpiMerge E{F.GF(), F.HN(), D};
            pg8::gemm_phase(F.lds, g, S, E, F.tid); GRID_BAR(); }
        if (IN(7)) { PH_BEGIN(); for (int i = 0; i < (F.vcu & 7); ++i) __builtin_amdgcn_s_sleep(50);
            pg8::Gemm g{F.HN(), F.wout_t(), M, D, D, D, D}; pg8::StaticOrder S; S.init(M, D, F.G, (int)blockIdx.x); pg8::EpiResid E{l == 0 ? (const void*)F.x() : (const void*)F.out, l == 0 ? 1 : 0, F.Y(), D, F.SS()};
            pg8::gemm_phase(F.lds, g, S, E, F.tid); GRID_BAR(); }
        if (IN(8)) { PH_BEGIN(); row_scale(F); GRID_BAR(); }
        if (IN(9)) { PH_BEGIN(); pg8::Gemm g{F.Y(), F.wup_t(), M, NUP, D, D, D}; pg8::StaticOrder S; S.init(M, NUP, F.G, (int)blockIdx.x); pg8::EpiConv E{F.conv_w() + (size_t)l * 3 * NUP, F.conv_b() + (size_t)l * NUP, F.ACT(), F.UH(), (LAS float*)(F.lds + pg8::STAGE_BYTES), F.RS()};
            pg8::gemm_phase(F.lds, g, S, E, F.tid); GRID_BAR(); }
        if (IN(10)) { PH_BEGIN(); conv_fix_phase(F, l); GRID_BAR(); }
        if (IN(11)) { PH_BEGIN(); for (int i = 0; i < (F.vcu & 7); ++i) __builtin_amdgcn_s_sleep(50);
            pg8::Gemm g{F.ACT(), F.wdn_t(), M, D, DFF, DFF, DFF}; pg8::StaticOrder S; S.init(M, D, F.G, (int)blockIdx.x); pg8::EpiResid E{(const void*)F.Y(), 0, l == DEPTH - 1 ? F.HN() : (bf16_t*)F.out, D, nullptr};
            pg8::gemm_phase(F.lds, g, S, E, F.tid); GRID_BAR(); }
        if (IN(12) && l == DEPTH - 1) { PH_BEGIN(); rms_rows16_to_f32(F, F.HN(), F.g_final(), F.out); }
    }
#undef IN
#undef PH_BEGIN
#undef GRID_BAR
}

#pragma clang attribute pop
extern "C" void kernel_launch(void* const* d_in, const int* in_sizes, int n_in, void* d_out, int out_size, void* d_ws, size_t ws_size, hipStream_t stream) {
    static int grid = 0;
    if (grid == 0) {
        if (n_in != 25 || in_sizes[0] != M * D || out_size != M * D || ws_size < WS_END) { fprintf(stderr, "kernel_launch: shape/workspace mismatch (n_in %d, in0 %d, out %d, ws %zu, need %zu); nothing launched\n", n_in, n_in > 0 ? in_sizes[0] : -1, out_size, ws_size, (size_t)WS_END); grid = -1; return; }
        int dev = 0, cus = 0, per_cu = 0;
        if (hipGetDevice(&dev) != hipSuccess || hipDeviceGetAttribute(&cus, hipDeviceAttributeMultiprocessorCount, dev) != hipSuccess) { grid = -1; return; }
        if (hipFuncSetAttribute((const void*)hybrid_fwd, hipFuncAttributeMaxDynamicSharedMemorySize, LDS_BYTES) != hipSuccess) { fprintf(stderr, "kernel_launch: hipFuncSetAttribute failed\n"); grid = -1; return; }
        if (hipOccupancyMaxActiveBlocksPerMultiprocessor(&per_cu, (const void*)hybrid_fwd, NWAVES * 64, LDS_BYTES) != hipSuccess || per_cu < 1) { fprintf(stderr, "kernel_launch: occupancy query reports %d workgroups per CU\n", per_cu); }
        (void)hipGetLastError();
        if (cus < 256) { fprintf(stderr, "kernel_launch: built for a 256-CU device (found %d CUs); nothing launched\n", cus); grid = -1; return; }
        grid = 256;
    }
    if (grid < 0) return;
    if (hipMemsetAsync((char*)d_ws + WS_CTL, 0, CTL_ZERO_BYTES, stream) != hipSuccess) return;
    Args a{};
    for (int i = 0; i < 25; ++i) a.in[i] = d_in[i];
    a.out = (float*)d_out; a.ws = (unsigned char*)d_ws;
#if MK_SINGLE
    a.l_lo = 0; a.l_hi = DEPTH; a.ph_lo = 0; a.ph_hi = NPH; a.single = 1;
    hipLaunchKernelGGL(hybrid_fwd, dim3(grid), dim3(NWAVES * 64), LDS_BYTES, stream, a);
#else
    a.single = 0;
    for (int l = 0; l < DEPTH; ++l)
        for (int p = 0; p < NPH; ++p) { if (p == 12 && l != DEPTH - 1) continue; a.l_lo = l; a.l_hi = l + 1; a.ph_lo = p; a.ph_hi = p + 1;
            hipLaunchKernelGGL(hybrid_fwd, dim3(grid), dim3(NWAVES * 64), LDS_BYTES, stream, a); }
#endif
}
```

```cpp
#include <hip/hip_runtime.h>
#include <cstdio>
#include <cstdint>

#ifndef MK_SINGLE
#define MK_SINGLE 1
#endif

#pragma clang attribute push(__attribute__((target("no-packed-fp32-ops"))), apply_to = function)
#define LAS __attribute__((address_space(3)))
#define GAS __attribute__((address_space(1)))
typedef unsigned short bf16_t;
typedef short bf16x8 __attribute__((ext_vector_type(8)));
typedef float f32x4 __attribute__((ext_vector_type(4)));
typedef float f32x2 __attribute__((ext_vector_type(2)));
typedef unsigned u32x4 __attribute__((ext_vector_type(4)));
typedef unsigned u32x2 __attribute__((ext_vector_type(2)));

constexpr int D = 2048, BATCH = 8, SEQ = 4096, DEPTH = 4, M = BATCH * SEQ;
constexpr int BW = 512;
constexpr int NIN_SRC = 12304, NIN = 12544;
constexpr int DFF = 5504, NUP = 11008;
constexpr int C_RQ = 0, C_RK = 256, C_RV = 512, C_RG = 1024, C_SU = 1536, C_GQ = 2048, C_GK = 2304, C_GV = 2560, C_GG = 3072, C_PU = 3584, C_GR = 4096, C_GATE = 4352;
constexpr int LDP = 4224;
constexpr float EPS = 1e-6f;
constexpr int NWAVES = 8;
constexpr int CH = 64;
constexpr int NCH = SEQ / CH;

constexpr size_t MiB = 1u << 20;
constexpr size_t WS_CTL = 0, CTL_ZERO_BYTES = 1 * MiB;
constexpr size_t WS_ROT = 1 * MiB;
constexpr size_t WS_S5T = 9 * MiB;
constexpr size_t S5T_ABAR = 0, S5T_APOW = 16384, S5T_BBAR = 32768, S5T_CMT = 32768 + 262144, S5T_BBT = S5T_CMT + 131072;
constexpr size_t WS_WGLU = 10 * MiB;
constexpr size_t WS_POOLW = 10 * MiB + 512 * 1024;
constexpr size_t WS_WIN = 11 * MiB;
constexpr size_t WS_WBR = 60 * MiB;
constexpr size_t WS_WOUT = 68 * MiB;
constexpr size_t WS_WUP = 76 * MiB;
constexpr size_t WS_WDN = 119 * MiB;
constexpr size_t WS_HN = 141 * MiB;
constexpr size_t WS_Y = 269 * MiB;
constexpr size_t WS_SCR = 397 * MiB;
constexpr size_t WS_YBP = WS_SCR;
constexpr size_t WS_STATE = WS_SCR + 32 * MiB;
constexpr size_t WS_SPREV = WS_SCR + 160 * MiB;
constexpr size_t WS_DEC = WS_SCR + 224 * MiB;
constexpr size_t WS_XEND = WS_SCR + 225 * MiB;
constexpr size_t WS_UH = WS_SCR + 128 * MiB;
constexpr size_t WS_PROJ = 637 * MiB;
constexpr size_t WS_GF = WS_PROJ + 264 * MiB;
constexpr size_t WS_ACT = WS_PROJ;
constexpr size_t WS_RS = 1421 * MiB;
constexpr size_t WS_SS = 1422 * MiB;
constexpr size_t WS_HN8 = 1438 * MiB;
constexpr size_t WS_W8 = 1502 * MiB;
constexpr size_t WS_END = 1518 * MiB;
static_assert(WS_PROJ + (size_t)M * LDP * 2 <= WS_GF && WS_GF + 4 * (size_t)M * D * 2 <= WS_RS, "ws map");
static_assert(WS_ACT + (size_t)M * DFF * 2 <= WS_RS, "ws map");
static_assert(WS_XEND + 8 * MiB <= WS_PROJ, "ws map");
static_assert(WS_UH + (size_t)(M / 256) * 4 * NUP * 4 <= WS_PROJ, "ws map");
constexpr int CW_TMO = 0, CW_BAR = 4096;

constexpr int LDS_BYTES = 155648;
constexpr int MISC_OFF = LDS_BYTES - 256;

#define RLX_AGENT __ATOMIC_RELAXED, __HIP_MEMORY_SCOPE_AGENT
__device__ __forceinline__ void lds_sync() { asm volatile("s_waitcnt lgkmcnt(0)" ::: "memory"); __builtin_amdgcn_s_barrier(); asm volatile("" ::: "memory"); }
__device__ __forceinline__ void wg_sync() { __builtin_amdgcn_fence(__ATOMIC_RELEASE, "workgroup"); __builtin_amdgcn_s_barrier(); __builtin_amdgcn_fence(__ATOMIC_ACQUIRE, "workgroup"); }
#define LDS_WAIT() asm volatile("s_waitcnt lgkmcnt(0)" ::: "memory")
#define VM_WAIT() asm volatile("s_waitcnt vmcnt(0)" ::: "memory")
__device__ __forceinline__ unsigned f2bf(float f) { unsigned u = __builtin_bit_cast(unsigned, f); return (u + 0x7fffu + ((u >> 16) & 1u)) >> 16; }
__device__ __forceinline__ unsigned pk2(float lo, float hi) { return f2bf(lo) | (f2bf(hi) << 16); }
__device__ __forceinline__ float bflo(unsigned w) { return __builtin_bit_cast(float, w << 16); }
__device__ __forceinline__ float bfhi(unsigned w) { return __builtin_bit_cast(float, w & 0xffff0000u); }
__device__ __forceinline__ void unpack8(const u32x4 w, float (&v)[8]) { v[0] = bflo(w.x); v[1] = bfhi(w.x); v[2] = bflo(w.y); v[3] = bfhi(w.y); v[4] = bflo(w.z); v[5] = bfhi(w.z); v[6] = bflo(w.w); v[7] = bfhi(w.w); }
__device__ __forceinline__ u32x4 pack8(const float (&v)[8]) { u32x4 w; w.x = pk2(v[0], v[1]); w.y = pk2(v[2], v[3]); w.z = pk2(v[4], v[5]); w.w = pk2(v[6], v[7]); return w; }
__device__ __forceinline__ unsigned pk4_fp8(float a, float b, float c, float d) { unsigned w = 0u; w = __builtin_amdgcn_cvt_pk_fp8_f32(a, b, w, false); w = __builtin_amdgcn_cvt_pk_fp8_f32(c, d, w, true); return w; }
__device__ __forceinline__ float sigmoidf_(float x) { return __builtin_amdgcn_rcpf(1.0f + __expf(-x)); }
__device__ __forceinline__ float siluf_(float x) { return x * __builtin_amdgcn_rcpf(1.0f + __expf(-x)); }
__device__ __forceinline__ float gelu_tanh(float x) { const float u = 1.5957691216f * (x + 0.044715f * x * x * x); return x * __builtin_amdgcn_rcpf(1.0f + __expf(-u)); }
__device__ __forceinline__ float logsigmoidf_(float x) { return fminf(x, 0.f) - __logf(1.0f + __expf(-fabsf(x))); }

namespace pg8 {
constexpr int BM = 256, BK = 64, HALF = 128, HTB = HALF * BK * 2, STAGE_BYTES = 8 * HTB, NXCD = 8, WGM = 4;
__host__ __device__ __forceinline__ int lds_byte(int r, int c) { const int st = (r >> 4) * 2 + (c >> 5), rr = r & 15, cc = c & 31, ob = rr * 64 + cc * 2; return st * 1024 + (ob ^ (((ob >> 9) & 1) << 5)); }
__host__ __device__ __forceinline__ void stage_rc(int b, int& R, int& C) { const int st = b / 1024, sb = b % 1024, swz = sb ^ (((sb >> 9) & 1) << 5); R = (st >> 1) * 16 + swz / 64; C = (st & 1) * 32 + (swz % 64) / 2; }
__host__ __device__ __forceinline__ int perm32(int rho) { const int n = rho >> 4, i = rho & 15; return 8 * (i >> 2) + 4 * n + (i & 3); }

struct Unit { int pm, pn; };
struct Gemm { const bf16_t* A; const bf16_t* Bt; int M, N, K, lda, ldb; };

struct StaticOrder {
    int nM, nN, nwg, G, c;
    __host__ __device__ void init(int M_, int N_, int G_, int c_) { nM = M_ / BM; nN = N_ / BM; nwg = nM * nN; G = G_; c = c_; }
    __host__ __device__ bool next(int i, Unit& u) const {
        const long L = (long)i * G + c; if (L >= nwg) return false;
        int wgid = (int)L; { const int q = nwg / NXCD, r = nwg % NXCD, xcd = wgid % NXCD, off = wgid / NXCD; wgid = (xcd < r ? xcd * (q + 1) : r * (q + 1) + (xcd - r) * q) + off; }
        const int nig = WGM * nN, gid = wgid / nig, fm = gid * WGM, gsz = (nM - fm) < WGM ? (nM - fm) : WGM;
        u.pm = fm + ((wgid % nig) % gsz); u.pn = (wgid % nig) / gsz; return true;
    }
};

__device__ __forceinline__ unsigned cvt_pk_bf16(float lo, float hi) { unsigned r; asm volatile("v_cvt_pk_bf16_f32 %0, %1, %2" : "=v"(r) : "v"(lo), "v"(hi)); return r; }

struct EpiStoreBf16 {
    static constexpr bool PERM = true, KHOOK = false;
    bf16_t* O; int ldc;
    __device__ __forceinline__ void khook(f32x4 (&)[2][2][4][2], const Unit&, int, int, int, int, int) const {}
    __device__ __forceinline__ void operator()(f32x4 (&acc)[2][2][4][2], const Unit& u, int wr, int wc, int fr, int fq) const {
        const int row0 = u.pm * BM + wr * 64 + fr, col0 = u.pn * BM + wc * 32 + 8 * fq;
#pragma unroll
        for (int ai = 0; ai < 2; ++ai)
#pragma unroll
            for (int m = 0; m < 4; ++m) { bf16_t* rowp = O + (size_t)(row0 + ai * HALF + m * 16) * ldc + col0;
#pragma unroll
                for (int bj = 0; bj < 2; ++bj) { const f32x4 v0 = acc[ai][bj][m][0], v1 = acc[ai][bj][m][1];
                    u32x4 w; w.x = cvt_pk_bf16(v0[0], v0[1]); w.y = cvt_pk_bf16(v0[2], v0[3]); w.z = cvt_pk_bf16(v1[0], v1[1]); w.w = cvt_pk_bf16(v1[2], v1[3]);
                    *(u32x4*)(rowp + bj * HALF) = w; } }
    }
};
struct EpiProj {
    static constexpr bool PERM = true, KHOOK = false;
    bf16_t* O; int ldc; int gate_pn0; bf16_t* GF; float gscale;
    __device__ __forceinline__ void khook(f32x4 (&)[2][2][4][2], const Unit&, int, int, int, int, int) const {}
    __device__ __forceinline__ void operator()(f32x4 (&acc)[2][2][4][2], const Unit& u, int wr, int wc, int fr_, int fq_) const {
        int fr = fr_, fq = fq_; asm volatile("" : "+v"(fr), "+v"(fq));
        const int row0 = u.pm * BM + wr * 64 + fr;
        if (u.pn < gate_pn0) {
            const int col0 = u.pn * BM + wc * 32 + 8 * fq;
#pragma unroll
            for (int ai = 0; ai < 2; ++ai)
#pragma unroll
                for (int m = 0; m < 4; ++m) { bf16_t* rowp = O + (size_t)(row0 + ai * HALF + m * 16) * ldc + col0;
#pragma unroll
                    for (int bj = 0; bj < 2; ++bj) { const f32x4 v0 = acc[ai][bj][m][0], v1 = acc[ai][bj][m][1];
                        u32x4 w; w.x = cvt_pk_bf16(v0[0], v0[1]); w.y = cvt_pk_bf16(v0[2], v0[3]); w.z = cvt_pk_bf16(v1[0], v1[1]); w.w = cvt_pk_bf16(v1[2], v1[3]);
                        *(u32x4*)(rowp + bj * HALF) = w; } }
        } else {
            const int t = u.pn - gate_pn0, c0 = 64 * t + 16 * wc + 4 * fq;
            const float kc = -1.4426950408889634f * gscale, KL = 30.0f * 1.4426950408889634f;
            const size_t gbase = ((size_t)((u.pm * 8 + (c0 >> 8)) * 4) * 16 + ((c0 >> 7) & 1)) * 4096 + (size_t)(((wr * 4 + ((c0 >> 5) & 3)) * 64 + ((c0 >> 3) & 3) * 16 + fr) * 8 + (c0 & 7));
#pragma unroll
            for (int ai = 0; ai < 2; ++ai)
#pragma unroll
                for (int m = 0; m < 4; ++m) { bf16_t* rowp = GF + gbase + (size_t)(ai * 8 + m * 2) * 4096;
                    float r1[4], r2[4], r3[4], g3[4];
#pragma unroll
                    for (int i = 0; i < 4; ++i) {
                        const float e0 = __builtin_amdgcn_exp2f(__builtin_amdgcn_fmed3f(acc[ai][0][m][0][i] * kc, -KL, KL)), e1 = __builtin_amdgcn_exp2f(__builtin_amdgcn_fmed3f(acc[ai][0][m][1][i] * kc, -KL, KL));
                        const float e2 = __builtin_amdgcn_exp2f(__builtin_amdgcn_fmed3f(acc[ai][1][m][0][i] * kc, -KL, KL)), e3 = __builtin_amdgcn_exp2f(__builtin_amdgcn_fmed3f(acc[ai][1][m][1][i] * kc, -KL, KL));
                        const float i0 = __builtin_amdgcn_rcpf(1.f + e0), i1 = __builtin_amdgcn_rcpf(1.f + e1), i2 = __builtin_amdgcn_rcpf(1.f + e2), i3 = __builtin_amdgcn_rcpf(1.f + e3);
                        r1[i] = (1.f + e1) * i0; r2[i] = (1.f + e2) * i1; r3[i] = (1.f + e3) * i2; g3[i] = i3; }
                    u32x2 w;
                    w.x = cvt_pk_bf16(r1[0], r1[1]); w.y = cvt_pk_bf16(r1[2], r1[3]); *(u32x2*)(rowp) = w;
                    w.x = cvt_pk_bf16(r2[0], r2[1]); w.y = cvt_pk_bf16(r2[2], r2[3]); *(u32x2*)(rowp + 16 * 4096) = w;
                    w.x = cvt_pk_bf16(r3[0], r3[1]); w.y = cvt_pk_bf16(r3[2], r3[3]); *(u32x2*)(rowp + 2 * 16 * 4096) = w;
                    w.x = cvt_pk_bf16(g3[0], g3[1]); w.y = cvt_pk_bf16(g3[2], g3[3]); *(u32x2*)(rowp + 3 * 16 * 4096) = w; }
        }
    }
};
__device__ __forceinline__ float dpp_ror1(float x) { return __builtin_bit_cast(float, __builtin_amdgcn_update_dpp(0, __builtin_bit_cast(int, x), 0x121, 0xf, 0xf, true)); }
__device__ __forceinline__ float dpp_ror2(float x) { return __builtin_bit_cast(float, __builtin_amdgcn_update_dpp(0, __builtin_bit_cast(int, x), 0x122, 0xf, 0xf, true)); }
struct EpiConv {
    static constexpr bool PERM = true, KHOOK = false;
    const float* cw; const float* cb; bf16_t* O; float* UH; LAS float* halo; const float* RS;
    __device__ __forceinline__ void khook(f32x4 (&)[2][2][4][2], const Unit&, int, int, int, int, int) const {}
    __device__ __forceinline__ void operator()(f32x4 (&acc)[2][2][4][2], const Unit& u, int wr, int wc, int fr_, int fq_) const {
        int fr = fr_, fq = fq_; asm volatile("" : "+v"(fr), "+v"(fq));
        const int cl0 = wc * 32 + 8 * fq;
        const int j0 = 128 * u.pn + cl0;
        const float* rp = RS + ((size_t)(u.pm * 2 + wr) * 16 + fr) * 8; const f32x4 rs0 = *(const f32x4*)rp, rs1 = *(const f32x4*)(rp + 4);
        f32x4 wa0[3], wv0[3];
#pragma unroll
        for (int q = 0; q < 3; ++q) { wa0[q] = *(const f32x4*)(cw + q * NUP + j0); wv0[q] = *(const f32x4*)(cw + q * NUP + DFF + j0); }
        const f32x4 ba0 = *(const f32x4*)(cb + j0), bv0 = *(const f32x4*)(cb + DFF + j0);
#pragma unroll
        for (int ai = 0; ai < 2; ++ai)
#pragma unroll
            for (int m = 0; m < 4; ++m) { const float r = ai == 0 ? rs0[m] : rs1[m];
#pragma unroll
                for (int bj = 0; bj < 2; ++bj)
#pragma unroll
                    for (int n = 0; n < 2; ++n) acc[ai][bj][m][n] *= r; }
        if (fr >= 14) {
#pragma unroll
            for (int ai = 0; ai < 2; ++ai)
#pragma unroll
                for (int bj = 0; bj < 2; ++bj)
#pragma unroll
                    for (int n = 0; n < 2; ++n) *(LAS f32x4*)(halo + (((2 * ai + wr) * 2 + (fr - 14)) * 256 + 128 * bj + cl0 + 4 * n)) = acc[ai][bj][3][n];
        }
        if (wr == 0 && fr < 2) {
#pragma unroll
            for (int bj = 0; bj < 2; ++bj)
#pragma unroll
                for (int n = 0; n < 2; ++n) *(f32x4*)(UH + ((size_t)u.pm * 4 + fr) * NUP + 256 * u.pn + 128 * bj + cl0 + 4 * n) = acc[0][bj][0][n];
        }
        if (wr == 1 && fr >= 14) {
#pragma unroll
            for (int bj = 0; bj < 2; ++bj)
#pragma unroll
                for (int n = 0; n < 2; ++n) *(f32x4*)(UH + ((size_t)u.pm * 4 + 2 + (fr - 14)) * NUP + 256 * u.pn + 128 * bj + cl0 + 4 * n) = acc[1][bj][3][n];
        }
        asm volatile("s_waitcnt lgkmcnt(0)" ::: "memory"); __builtin_amdgcn_s_barrier(); asm volatile("" ::: "memory");
        const bool is15 = fr == 15, ge14 = fr >= 14;
        unsigned keep[2][4][2];
        f32x4 wa1[3], wv1[3];
#pragma unroll
        for (int q = 0; q < 3; ++q) { wa1[q] = *(const f32x4*)(cw + q * NUP + j0 + 4); wv1[q] = *(const f32x4*)(cw + q * NUP + DFF + j0 + 4); }
        const f32x4 ba1 = *(const f32x4*)(cb + j0 + 4), bv1 = *(const f32x4*)(cb + DFF + j0 + 4);
#pragma unroll
        for (int n = 0; n < 2; ++n) {
            f32x4 wa[3], wv[3];
#pragma unroll
            for (int q = 0; q < 3; ++q) { wa[q] = n == 0 ? wa0[q] : wa1[q]; wv[q] = n == 0 ? wv0[q] : wv1[q]; }
            const f32x4 ba = n == 0 ? ba0 : ba1, bv = n == 0 ? bv0 : bv1;
#pragma unroll
            for (int ai = 0; ai < 2; ++ai) {
                const int blk = 2 * ai + wr;
                f32x4 pa = (f32x4){0.f, 0.f, 0.f, 0.f}, pv = (f32x4){0.f, 0.f, 0.f, 0.f};
                if (blk > 0 && ge14) { pa = *(const LAS f32x4*)(halo + (((blk - 1) * 2 + (fr - 14)) * 256 + cl0 + 4 * n)); pv = *(const LAS f32x4*)(halo + (((blk - 1) * 2 + (fr - 14)) * 256 + 128 + cl0 + 4 * n)); }
#pragma unroll
                for (int m = 0; m < 4; ++m) {
                    const f32x4 ca_ = acc[ai][0][m][n], cv_ = acc[ai][1][m][n]; float o[4];
#pragma unroll
                    for (int i = 0; i < 4; ++i) {
                        const float a1 = dpp_ror1(is15 ? pa[i] : ca_[i]), a2 = dpp_ror2(ge14 ? pa[i] : ca_[i]);
                        const float v1 = dpp_ror1(is15 ? pv[i] : cv_[i]), v2 = dpp_ror2(ge14 ? pv[i] : cv_[i]);
                        const float ca = ba[i] + wa[0][i] * a2 + wa[1][i] * a1 + wa[2][i] * ca_[i];
                        const float cv = bv[i] + wv[0][i] * v2 + wv[1][i] * v1 + wv[2][i] * cv_[i];
                        o[i] = siluf_(ca) * cv; }
                    pa = ca_; pv = cv_;
                    const unsigned lo = cvt_pk_bf16(o[0], o[1]), hi = cvt_pk_bf16(o[2], o[3]);
                    if (n == 0) { keep[ai][m][0] = lo; keep[ai][m][1] = hi; }
                    else { u32x4 w; w.x = keep[ai][m][0]; w.y = keep[ai][m][1]; w.z = lo; w.w = hi;
                        *(u32x4*)(O + (size_t)(u.pm * BM + ai * HALF + wr * 64 + m * 16 + fr) * DFF + j0) = w; }
                }
            }
        }
    }
};
struct EpiResid {
    static constexpr bool PERM = true, KHOOK = false;
    const void* base; int base_f32; bf16_t* O; int ldc; float* SS;
    __device__ __forceinline__ void khook(f32x4 (&)[2][2][4][2], const Unit&, int, int, int, int, int) const {}
    __device__ __forceinline__ void finish(const float (&b)[8], const f32x4 v0, const f32x4 v1, bf16_t* op, float& sq) const {
        const float o0 = b[0] + v0[0], o1 = b[1] + v0[1], o2 = b[2] + v0[2], o3 = b[3] + v0[3], o4 = b[4] + v1[0], o5 = b[5] + v1[1], o6 = b[6] + v1[2], o7 = b[7] + v1[3];
        u32x4 w; w.x = cvt_pk_bf16(o0, o1); w.y = cvt_pk_bf16(o2, o3); w.z = cvt_pk_bf16(o4, o5); w.w = cvt_pk_bf16(o6, o7);
        *(u32x4*)op = w;
        sq += ((o0 * o0 + o1 * o1) + (o2 * o2 + o3 * o3)) + ((o4 * o4 + o5 * o5) + (o6 * o6 + o7 * o7));
    }
    __device__ __forceinline__ void rowsum(float sq, const Unit& u, int wc, int fq, int lane, int row) const {
        sq += __builtin_bit_cast(float, __builtin_amdgcn_ds_bpermute((lane ^ 16) << 2, __builtin_bit_cast(int, sq)));
        sq += __builtin_bit_cast(float, __builtin_amdgcn_ds_bpermute((lane ^ 32) << 2, __builtin_bit_cast(int, sq)));
        if (fq == 0) SS[(size_t)(u.pn * 4 + wc) * M + row] = sq;
    }
    __device__ __forceinline__ void operator()(f32x4 (&acc)[2][2][4][2], const Unit& u, int wr, int wc, int fr_, int fq_) const {
        int fr = fr_, fq = fq_; asm volatile("" : "+v"(fr), "+v"(fq));
        const int row0 = u.pm * BM + wr * 64 + fr, col0 = u.pn * BM + wc * 32 + 8 * fq, lane = fq * 16 + fr;
        if (!base_f32) {
            u32x4 bw[2][4][2];
#pragma unroll
            for (int ai = 0; ai < 2; ++ai)
#pragma unroll
                for (int m = 0; m < 4; ++m)
#pragma unroll
                    for (int bj = 0; bj < 2; ++bj) bw[ai][m][bj] = *(const u32x4*)((const bf16_t*)base + (size_t)(row0 + ai * HALF + m * 16) * ldc + col0 + bj * HALF);
#pragma unroll
            for (int ai = 0; ai < 2; ++ai)
#pragma unroll
                for (int m = 0; m < 4; ++m) { const size_t off = (size_t)(row0 + ai * HALF + m * 16) * ldc + col0; float sq = 0.f;
#pragma unroll
                    for (int bj = 0; bj < 2; ++bj) { float b[8]; unpack8(bw[ai][m][bj], b); finish(b, acc[ai][bj][m][0], acc[ai][bj][m][1], O + off + bj * HALF, sq); }
                    if (SS) rowsum(sq, u, wc, fq, lane, row0 + ai * HALF + m * 16); }
        } else {
#pragma unroll
            for (int ai = 0; ai < 2; ++ai)
#pragma unroll
                for (int m = 0; m < 4; ++m) { const size_t off = (size_t)(row0 + ai * HALF + m * 16) * ldc + col0; float sq = 0.f;
#pragma unroll
                    for (int bj = 0; bj < 2; ++bj) { float b[8]; const float* bp = (const float*)base + off + bj * HALF; const f32x4 b0 = *(const f32x4*)bp, b1 = *(const f32x4*)(bp + 4);
                        b[0] = b0.x; b[1] = b0.y; b[2] = b0.z; b[3] = b0.w; b[4] = b1.x; b[5] = b1.y; b[6] = b1.z; b[7] = b1.w;
                        finish(b, acc[ai][bj][m][0], acc[ai][bj][m][1], O + off + bj * HALF, sq); }
                    if (SS) rowsum(sq, u, wc, fq, lane, row0 + ai * HALF + m * 16);
                    asm volatile("" ::: "memory"); }
        }
    }
};
struct EpiGlu {
    static constexpr bool PERM = true, KHOOK = false;
    const bf16_t* Yp; int ldy; bf16_t* O; int ldc;
    __device__ __forceinline__ void khook(f32x4 (&)[2][2][4][2], const Unit&, int, int, int, int, int) const {}
    __device__ __forceinline__ void operator()(f32x4 (&acc)[2][2][4][2], const Unit& u, int wr, int wc, int fr, int fq) const {
        const int row0 = u.pm * BM + wr * 64 + fr, col0 = u.pn * BM + wc * 32 + 8 * fq;
#pragma unroll
        for (int ai = 0; ai < 2; ++ai)
#pragma unroll
            for (int m = 0; m < 4; ++m) { const size_t r = (size_t)(row0 + ai * HALF + m * 16);
#pragma unroll
                for (int bj = 0; bj < 2; ++bj) { const u32x4 yw = *(const u32x4*)(Yp + r * ldy + col0 + bj * HALF); float y[8]; unpack8(yw, y);
                    const f32x4 v0 = acc[ai][bj][m][0], v1 = acc[ai][bj][m][1]; float o[8];
#pragma unroll
                    for (int j = 0; j < 4; ++j) { o[j] = y[j] * sigmoidf_(v0[j]); o[4 + j] = y[4 + j] * sigmoidf_(v1[j]); }
                    u32x4 w; w.x = cvt_pk_bf16(o[0], o[1]); w.y = cvt_pk_bf16(o[2], o[3]); w.z = cvt_pk_bf16(o[4], o[5]); w.w = cvt_pk_bf16(o[6], o[7]);
                    *(u32x4*)(O + r * ldc + col0 + bj * HALF) = w; } }
    }
};
struct EpiMerge {
    static constexpr bool PERM = true, KHOOK = true;
    const bf16_t* G; bf16_t* O; int ldc;
    __device__ __forceinline__ void scale(f32x4 (&acc)[2][2][4][2], const Unit& u, int s, int wr, int wc, int fr, int fq) const {
        int toff = ((wr * 4 + wc) * 64 + fq * 16 + fr) * 8; asm volatile("" : "+v"(toff));
        const bf16_t* gb = G + (size_t)(((u.pm * 8 + u.pn) * 4 + s) * 16) * 4096 + toff;
        u32x4 w[2][4][2];
#pragma unroll
        for (int ai = 0; ai < 2; ++ai)
#pragma unroll
            for (int m = 0; m < 4; ++m) {
#pragma unroll
                for (int bj = 0; bj < 2; ++bj) w[ai][m][bj] = *(const u32x4*)(gb + (size_t)(ai * 8 + m * 2 + bj) * 4096); }
#pragma unroll
        for (int ai = 0; ai < 2; ++ai)
#pragma unroll
            for (int m = 0; m < 4; ++m)
#pragma unroll
                for (int bj = 0; bj < 2; ++bj) { float f[8]; unpack8(w[ai][m][bj], f);
#pragma unroll
                    for (int j = 0; j < 8; ++j) acc[ai][bj][m][j >> 2][j & 3] *= f[j]; }
    }
    __device__ __forceinline__ void khook(f32x4 (&acc)[2][2][4][2], const Unit& u, int seg, int wr, int wc, int fr, int fq) const { scale(acc, u, seg - 1, wr, wc, fr, fq); }
    __device__ __forceinline__ void operator()(f32x4 (&acc)[2][2][4][2], const Unit& u, int wr, int wc, int fr, int fq) const {
        scale(acc, u, 3, wr, wc, fr, fq);
        const int row0 = u.pm * BM + wr * 64 + fr, col0 = u.pn * BM + wc * 32 + 8 * fq;
#pragma unroll
        for (int ai = 0; ai < 2; ++ai)
#pragma unroll
            for (int m = 0; m < 4; ++m) { bf16_t* rowp = O + (size_t)(row0 + ai * HALF + m * 16) * ldc + col0;
#pragma unroll
                for (int bj = 0; bj < 2; ++bj) { const f32x4 v0 = acc[ai][bj][m][0], v1 = acc[ai][bj][m][1];
                    u32x4 w; w.x = cvt_pk_bf16(v0[0], v0[1]); w.y = cvt_pk_bf16(v0[2], v0[3]); w.z = cvt_pk_bf16(v1[0], v1[1]); w.w = cvt_pk_bf16(v1[2], v1[3]);
                    *(u32x4*)(rowp + bj * HALF) = w; } }
    }
};

typedef int v4i_t __attribute__((ext_vector_type(4)));
typedef int v8i_t __attribute__((ext_vector_type(8)));
template <class Epi, bool F8 = false>
__device__ __forceinline__ void gemm_phase(LAS unsigned char* lds, const Gemm g, const StaticOrder& S, const Epi& E, int tid_in) {
    int tid_ = tid_in; asm volatile("" : "+v"(tid_));
    const int tid = tid_, wid = __builtin_amdgcn_readfirstlane(tid >> 6), lane = tid & 63, wr = wid >> 2, wc = wid & 3, fr = lane & 15, fq = lane >> 4;
    const int K = g.K, nt = K / BK;
    unsigned voffA[2], voffB[2];
#pragma unroll
    for (int i = 0; i < 2; ++i) { int R, C; stage_rc(tid * 16 + i * 8192, R, C); const int Rb = Epi::PERM ? ((R & ~31) + perm32(R & 31)) : R;
        voffA[i] = (unsigned)(R * g.lda + C) * 2u; voffB[i] = (unsigned)(Rb * g.ldb + C) * 2u; }
    const size_t kstep = (size_t)(BK * 2);
    const size_t hstepA = (size_t)HALF * g.lda * 2, hstepB = (size_t)HALF * g.ldb * 2;
    const size_t tstepA = 2 * hstepA, tstepB = 2 * hstepB;
    const unsigned ldsw = (unsigned)wid * 1024u;
    const int aoff = lds_byte(wr * 64 + fr, fq * 8), boff = lds_byte(wc * 32 + fr, fq * 8);
#define PG8_SA(b, h) (((b) * 2 + (h)) * HTB)
#define PG8_SB(b, h) ((4 + (b) * 2 + (h)) * HTB)
#define PG8_STAGE(bufoff, gbase, voff) do { _Pragma("unroll") for (int _i = 0; _i < 2; ++_i) \
        __builtin_amdgcn_global_load_lds((const unsigned*)((const char*)(gbase) + (voff)[_i]), (LAS unsigned*)(lds + (bufoff) + ldsw + _i * 8192), 16, 0, 0); } while (0)
#define PG8_LDA(dst, b, h) do { _Pragma("unroll") for (int m = 0; m < 4; ++m) _Pragma("unroll") for (int k = 0; k < 2; ++k) dst[m][k] = *(const LAS bf16x8*)(lds + PG8_SA(b, h) + aoff + m * 2048 + k * 1024); } while (0)
#define PG8_LDB(dst, b, h) do { _Pragma("unroll") for (int n = 0; n < 2; ++n) _Pragma("unroll") for (int k = 0; k < 2; ++k) dst[n][k] = *(const LAS bf16x8*)(lds + PG8_SB(b, h) + boff + n * 2048 + k * 1024); } while (0)
#define PG8_MMA(ai, bj, At, Bt) do { __builtin_amdgcn_s_setprio(1); _Pragma("unroll") for (int m = 0; m < 4; ++m) _Pragma("unroll") for (int n = 0; n < 2; ++n) _Pragma("unroll") for (int k = 0; k < 2; ++k) \
        acc[ai][bj][m][n] = __builtin_amdgcn_mfma_f32_16x16x32_bf16(Bt[n][k], At[m][k], acc[ai][bj][m][n], 0, 0, 0); __builtin_amdgcn_s_setprio(0); } while (0)
#define PG8_MMA16(ai, bj, At, Bt) PG8_MMA(ai, bj, At, Bt)
#define PG8_MMA8(ai, bj, A8, B8) do { __builtin_amdgcn_s_setprio(1); _Pragma("unroll") for (int m = 0; m < 4; ++m) _Pragma("unroll") for (int n = 0; n < 2; ++n) \
        asm volatile("v_mfma_f32_16x16x128_f8f6f4 %0, %1, %2, %0" : "+v"(acc[ai][bj][m][n]) : "v"(B8[n]), "v"(A8[m])); __builtin_amdgcn_s_setprio(0); } while (0)
#define PG8_LDA8(dst, b, h) do { _Pragma("unroll") for (int m = 0; m < 4; ++m) { dst[m].lo = *(const LAS v4i_t*)(lds + PG8_SA(b, h) + aoff + m * 2048); dst[m].hi = *(const LAS v4i_t*)(lds + PG8_SA(b, h) + aoff + m * 2048 + 1024); } } while (0)
#define PG8_LDB8(dst, b, h) do { _Pragma("unroll") for (int n = 0; n < 2; ++n) { dst[n].lo = *(const LAS v4i_t*)(lds + PG8_SB(b, h) + boff + n * 2048); dst[n].hi = *(const LAS v4i_t*)(lds + PG8_SB(b, h) + boff + n * 2048 + 1024); } } while (0)
#define PG8_XLDA(b, h) do { if constexpr (F8) PG8_LDA8(A8, b, h); else PG8_LDA(At, b, h); } while (0)
#define PG8_XLDB0(b, h) do { if constexpr (F8) PG8_LDB8(B08, b, h); else PG8_LDB(B0, b, h); } while (0)
#define PG8_XLDB1(b, h) do { if constexpr (F8) PG8_LDB8(B18, b, h); else PG8_LDB(B1, b, h); } while (0)
#define PG8_MM0(ai, bj) do { if constexpr (F8) PG8_MMA8(ai, bj, A8, B08); else PG8_MMA16(ai, bj, At, B0); } while (0)
#define PG8_MM1(ai, bj) do { if constexpr (F8) PG8_MMA8(ai, bj, A8, B18); else PG8_MMA16(ai, bj, At, B1); } while (0)
#define PG8_WAIT_V(n) asm volatile("s_waitcnt vmcnt(" #n ")" ::: "memory")
#define PG8_WAIT_L(n) asm volatile("s_waitcnt lgkmcnt(" #n ")" ::: "memory")
#define PG8_BAR __builtin_amdgcn_s_barrier()
#define PG8_SCHED __builtin_amdgcn_sched_barrier(0)
    Unit cur, nxt; int ui = 0;
    if (!S.next(0, cur)) return;
    f32x4 acc[2][2][4][2];
#pragma unroll
    for (int a = 0; a < 2; ++a)
#pragma unroll
        for (int b = 0; b < 2; ++b)
#pragma unroll
            for (int m = 0; m < 4; ++m)
#pragma unroll
                for (int n = 0; n < 2; ++n) acc[a][b][m][n] = (f32x4){0.f, 0.f, 0.f, 0.f};
    bf16x8 At[4][2], B0[2][2], B1[2][2]; v8i_t A8[4], B08[2], B18[2];
    const char* cA = (const char*)g.A + (size_t)cur.pm * tstepA; const char* cB = (const char*)g.Bt + (size_t)cur.pn * tstepB;
    PG8_STAGE(PG8_SB(0, 0), cB, voffB); PG8_STAGE(PG8_SB(0, 1), cB + hstepB, voffB); PG8_STAGE(PG8_SA(0, 0), cA, voffA); PG8_STAGE(PG8_SA(0, 1), cA + hstepA, voffA);
    if (wr == 1) PG8_BAR;
    PG8_WAIT_V(2); PG8_BAR;
    PG8_STAGE(PG8_SB(1, 0), cB + kstep, voffB); PG8_STAGE(PG8_SA(1, 0), cA + kstep, voffA); PG8_STAGE(PG8_SB(1, 1), cB + hstepB + kstep, voffB);
    PG8_WAIT_V(6); PG8_BAR;
    for (;;) {
        const bool has_next = S.next(ui + 1, nxt);
        const char* nA = has_next ? (const char*)g.A + (size_t)nxt.pm * tstepA : cA; const char* nB = has_next ? (const char*)g.Bt + (size_t)nxt.pn * tstepB : cB;
        for (int t = 0; t < nt; t += 2) {
            const bool last = (t == nt - 2);
            const char* a1 = cA + (size_t)(t + 1) * kstep;
            const char* a2 = last ? nA : cA + (size_t)(t + 2) * kstep; const char* b2 = last ? nB : cB + (size_t)(t + 2) * kstep;
            const char* a3 = a2 + kstep; const char* b3 = b2 + kstep;
            if constexpr (Epi::KHOOK) { if (t != 0 && (t & 7) == 0) E.khook(acc, cur, t >> 3, wr, wc, fr, fq); }
            PG8_XLDB0(0, 0); PG8_XLDB1(0, 1); PG8_SCHED; PG8_XLDA(0, 0); PG8_STAGE(PG8_SA(1, 1), a1 + hstepA, voffA);
            PG8_WAIT_V(8); PG8_WAIT_L(0); PG8_BAR; PG8_MM0(0, 0); PG8_MM1(0, 1); PG8_BAR; PG8_SCHED;
            PG8_XLDA(0, 1); PG8_STAGE(PG8_SB(0, 0), b2, voffB); PG8_STAGE(PG8_SB(0, 1), b2 + hstepB, voffB); PG8_STAGE(PG8_SA(0, 0), a2, voffA);
            PG8_WAIT_V(8); PG8_WAIT_L(0); PG8_BAR; PG8_MM0(1, 0); PG8_MM1(1, 1); PG8_BAR; PG8_SCHED;
            PG8_XLDB0(1, 0); PG8_XLDB1(1, 1); PG8_SCHED; PG8_XLDA(1, 0); PG8_STAGE(PG8_SA(0, 1), a2 + hstepA, voffA);
            PG8_WAIT_V(8); PG8_WAIT_L(0); PG8_BAR; PG8_MM0(0, 0); PG8_MM1(0, 1); PG8_BAR; PG8_SCHED;
            PG8_XLDA(1, 1); PG8_STAGE(PG8_SB(1, 0), b3, voffB); PG8_STAGE(PG8_SB(1, 1), b3 + hstepB, voffB); PG8_STAGE(PG8_SA(1, 0), a3, voffA);
            PG8_WAIT_V(8); PG8_WAIT_L(0); PG8_BAR; PG8_MM0(1, 0); PG8_MM1(1, 1); PG8_BAR; PG8_SCHED;
        }
        if (wr == 0) PG8_BAR;
        E(acc, cur, wr, wc, fr, fq);
        if (!has_next) break;
#pragma unroll
        for (int a = 0; a < 2; ++a)
#pragma unroll
            for (int b = 0; b < 2; ++b)
#pragma unroll
                for (int m = 0; m < 4; ++m)
#pragma unroll
                    for (int n = 0; n < 2; ++n) acc[a][b][m][n] = (f32x4){0.f, 0.f, 0.f, 0.f};
        cur = nxt; cA = nA; cB = nB; ++ui;
        if (wr == 1) PG8_BAR;
    }
    PG8_WAIT_V(0);
    PG8_BAR;
#undef PG8_SA
#undef PG8_SB
#undef PG8_STAGE
#undef PG8_LDA
#undef PG8_LDB
#undef PG8_MMA
#undef PG8_MMA8
#undef PG8_MMA16
#undef PG8_LDA8
#undef PG8_LDB8
#undef PG8_XLDA
#undef PG8_XLDB0
#undef PG8_XLDB1
#undef PG8_MM0
#undef PG8_MM1
#undef PG8_WAIT_V
#undef PG8_WAIT_L
#undef PG8_BAR
#undef PG8_SCHED
}
}

#define XB_TMO      128
#define XB_XCNT(j)  (256  + 64 * (j))
#define XB_XSUB(j)  (1280 + 64 * (j))
#define XB_XGEN(j)  (2304 + 64 * (j))
#define XB_TOP      3328
#define XB_TOPGEN   3392
#define XCD_BAR_WORDS 3456
#define XB_SPIN_CAP (1u << 18)
__device__ __forceinline__ unsigned xb_ld(unsigned* p)              { return __hip_atomic_load(p, __ATOMIC_RELAXED, __HIP_MEMORY_SCOPE_AGENT); }
__device__ __forceinline__ unsigned xb_add(unsigned* p, unsigned v) { return __hip_atomic_fetch_add(p, v, __ATOMIC_RELAXED, __HIP_MEMORY_SCOPE_AGENT); }
__device__ __forceinline__ unsigned xb_xcc_id() { return (unsigned)__builtin_amdgcn_s_getreg((3 << 11) | 20) & 0xFu; }
#define XB_SPIN(cond, bar) do { unsigned _sp = 0; while (cond) { __builtin_amdgcn_s_sleep(1); \
    if ((++_sp & 255u) == 0u) { if (xb_ld(&(bar)[XB_TMO])) break; if (_sp > XB_SPIN_CAP) { (void)__hip_atomic_fetch_add(&(bar)[XB_TMO], 1u, __ATOMIC_RELAXED, __HIP_MEMORY_SCOPE_AGENT); break; } } } } while (0)
struct XcdBarrier { unsigned* bar; unsigned x; volatile LAS unsigned* st; };
__device__ __forceinline__ XcdBarrier xcd_barrier_post(unsigned* bar, volatile LAS unsigned* st) {
    XcdBarrier b; b.bar = bar; b.x = xb_xcc_id(); b.st = st;
    if (threadIdx.x == 0) (void)xb_add(&bar[XB_XCNT(b.x)], 1u);
    return b;
}
__device__ __forceinline__ void xcd_barrier_complete(unsigned* bar, unsigned x, unsigned& nloc, unsigned& nx) {
    const unsigned G = gridDim.x * gridDim.y * gridDim.z;
    unsigned sum, cnt, mine, sp = 0u;
    for (;;) {
        sum = 0u; cnt = 0u; mine = 0u;
#pragma nounroll
        for (unsigned j = 0; j < 16; ++j) { const unsigned c = xb_ld(&bar[XB_XCNT(j)]); sum += c; cnt += (c > 0u) ? 1u : 0u; mine = (j == x) ? c : mine; }
        if (sum == G) break;
        __builtin_amdgcn_s_sleep(1);
        if ((++sp & 255u) == 0u) { if (xb_ld(&bar[XB_TMO])) break; if (sp > XB_SPIN_CAP) { (void)__hip_atomic_fetch_add(&bar[XB_TMO], 1u, __ATOMIC_RELAXED, __HIP_MEMORY_SCOPE_AGENT); break; } }
    }
    nloc = mine > 0u ? mine : 1u; nx = cnt > 0u ? cnt : 1u;
}
__device__ __forceinline__ void xcd_barrier(const XcdBarrier& b) {
    asm volatile("s_waitcnt vmcnt(0)" ::: "memory");
    wg_sync();
    if (threadIdx.x == 0) {
        unsigned* bar = b.bar;
        __builtin_amdgcn_s_waitcnt(0);
        unsigned nloc = b.st[0], nx = b.st[1];
        if (nloc == 0u) { xcd_barrier_complete(bar, b.x, nloc, nx); b.st[0] = nloc; b.st[1] = nx; }
        const unsigned old = xb_add(&bar[XB_XSUB(b.x)], 1u);
        const unsigned gen = old / nloc;
        if (old + 1u == (gen + 1u) * nloc) {
            __builtin_amdgcn_fence(__ATOMIC_RELEASE, "agent");
            asm volatile("s_waitcnt vmcnt(0)" ::: "memory");
            const unsigned og = xb_add(&bar[XB_TOP], 1u);
            const unsigned tg = og / nx;
            if (og + 1u == (tg + 1u) * nx) xb_add(&bar[XB_TOPGEN], 1u);
            else XB_SPIN(xb_ld(&bar[XB_TOPGEN]) == tg, bar);
            __builtin_amdgcn_fence(__ATOMIC_ACQUIRE, "agent");
            xb_add(&bar[XB_XGEN(b.x)], 1u);
            asm volatile("s_waitcnt vmcnt(0)" ::: "memory");
        } else {
            XB_SPIN(xb_ld(&bar[XB_XGEN(b.x)]) == gen, bar);
            __builtin_amdgcn_fence(__ATOMIC_ACQUIRE, "agent");
            asm volatile("s_waitcnt vmcnt(0)" ::: "memory");
        }
    }
    wg_sync();
}

__device__ __forceinline__ const void* kin(int k) {
    typedef __attribute__((address_space(4))) const char* kptr_t;
    kptr_t p = (kptr_t)__builtin_amdgcn_kernarg_segment_ptr(); asm volatile("" : "+s"(p));
    const unsigned long long v = *(__attribute__((address_space(4))) const unsigned long long*)(p + 8 * k);
    return (const void*)(GAS const void*)v;
}
struct Frame {
    LAS unsigned char* lds;
    int tid, lane, wave, vcu, G, l;
    unsigned char* ws; float* out;
#define FIN(name, T, k) __device__ __forceinline__ const T* name() const { return (const T*)kin(k); }
    FIN(x, float, 0) FIN(pos, int, 1) FIN(g_mix, float, 2) FIN(w_in, float, 3) FIN(a_re, float, 4) FIN(a_im, float, 5) FIN(log_dt, float, 6) FIN(b_re, float, 7) FIN(b_im, float, 8)
    FIN(c_re, float, 9) FIN(c_im, float, 10) FIN(s5_d, float, 11) FIN(w_glu, float, 12) FIN(gla_wg, float, 13) FIN(gla_bg, float, 14) FIN(pool_w, float, 15) FIN(pool_scale, float, 16)
    FIN(w_branch, float, 17) FIN(w_out, float, 18) FIN(g_ffn, float, 19) FIN(w_up, float, 20) FIN(conv_w, float, 21) FIN(conv_b, float, 22) FIN(w_down, float, 23) FIN(g_final, float, 24)
#undef FIN
#define FWS(name, T, off) __device__ __forceinline__ T* name() const { return (T*)(ws + (off)); }
    FWS(rotc, float, WS_ROT) FWS(rots, float, WS_ROT + (size_t)M * 32 * 4) FWS(abar, float, WS_S5T + S5T_ABAR) FWS(apow, float, WS_S5T + S5T_APOW) FWS(bbar, float, WS_S5T + S5T_BBAR) FWS(cmt, bf16_t, WS_S5T + S5T_CMT) FWS(bbt, bf16_t, WS_S5T + S5T_BBT)
    FWS(wglu_t, bf16_t, WS_WGLU) FWS(poolw_t, bf16_t, WS_POOLW) FWS(win_t, bf16_t, WS_WIN) FWS(wbr_t, bf16_t, WS_WBR) FWS(wout_t, bf16_t, WS_WOUT) FWS(wup_t, bf16_t, WS_WUP) FWS(wdn_t, bf16_t, WS_WDN)
    FWS(HN8, unsigned char, WS_HN8) FWS(W8, unsigned char, WS_W8) FWS(HN, bf16_t, WS_HN) FWS(Y, bf16_t, WS_Y) FWS(YBP, bf16_t, WS_YBP) FWS(PROJ, bf16_t, WS_PROJ) FWS(GF, bf16_t, WS_GF) FWS(SPREV, bf16_t, WS_SPREV) FWS(ACT, bf16_t, WS_ACT)
    FWS(SS, float, WS_SS + (size_t)l * 32 * M * 4) FWS(RS, float, WS_RS + (size_t)l * M * 4) FWS(STATE, float, WS_STATE) FWS(DEC, float, WS_DEC) FWS(XEND, float, WS_XEND) FWS(UH, float, WS_UH)
#undef FWS
};

__device__ __forceinline__ float lane_read(float v, int src_lane) { return __builtin_bit_cast(float, __builtin_amdgcn_ds_bpermute(src_lane << 2, __builtin_bit_cast(int, v))); }
__device__ __forceinline__ float wave_sum(float v, int lane) {
#pragma unroll
    for (int o = 1; o < 64; o <<= 1) v += lane_read(v, lane ^ o);
    return v;
}

template <class SrcCol>
__device__ __forceinline__ void transpose_item(const float* W, int Nsrc, bf16_t* WT, int ldt, int kdst0, int k0, int n0, SrcCol srccol, LAS float* scr, int lane, const float* kscale = nullptr) {
    const int sc = srccol(n0 + (lane & 31));
    float wv[32];
#pragma unroll
    for (int i = 0; i < 32; ++i) { const int kk = 2 * i + (lane >> 5); wv[i] = sc >= 0 ? W[(size_t)(k0 + kk) * Nsrc + sc] : 0.f; }
#pragma unroll
    for (int i = 0; i < 32; ++i) { const int kk = 2 * i + (lane >> 5); scr[kk * 33 + (lane & 31)] = kscale ? wv[i] * kscale[k0 + kk] : wv[i]; }
    LDS_WAIT();
    const int c = lane & 7;
#pragma unroll
    for (int j = 0; j < 4; ++j) { const int n = (lane >> 3) + 8 * j; const LAS float* s = scr + (8 * c) * 33 + n;
        u32x4 o; o.x = pk2(s[0 * 33], s[1 * 33]); o.y = pk2(s[2 * 33], s[3 * 33]); o.z = pk2(s[4 * 33], s[5 * 33]); o.w = pk2(s[6 * 33], s[7 * 33]);
        *(u32x4*)(WT + (size_t)(n0 + n) * ldt + kdst0 + k0 + 8 * c) = o; }
    LDS_WAIT();
}
template <class SrcCol>
__device__ __forceinline__ void transpose_item_fp8(const float* W, int Nsrc, unsigned char* WT, int ldt, int k0, int n0src, int n0dst, SrcCol srccol, LAS float* scr, int lane, const float* kscale, float scale) {
    const int sc = srccol(n0src + (lane & 31));
    float wv[32];
#pragma unroll
    for (int i = 0; i < 32; ++i) { const int kk = 2 * i + (lane >> 5); wv[i] = sc >= 0 ? W[(size_t)(k0 + kk) * Nsrc + sc] : 0.f; }
#pragma unroll
    for (int i = 0; i < 32; ++i) { const int kk = 2 * i + (lane >> 5); scr[kk * 33 + (lane & 31)] = (kscale ? wv[i] * kscale[k0 + kk] : wv[i]) * scale; }
    LDS_WAIT();
    const int c = lane & 7;
#pragma unroll
    for (int j = 0; j < 4; ++j) { const int n = (lane >> 3) + 8 * j; const LAS float* s = scr + (8 * c) * 33 + n;
        u32x2 o; o.x = pk4_fp8(s[0 * 33], s[1 * 33], s[2 * 33], s[3 * 33]); o.y = pk4_fp8(s[4 * 33], s[5 * 33], s[6 * 33], s[7 * 33]);
        *(u32x2*)(WT + (size_t)(n0dst + n) * ldt + k0 + 8 * c) = o; }
    LDS_WAIT();
}
struct ColIdent { __device__ __forceinline__ int operator()(int n) const { return n; } };
struct ColWin { __device__ __forceinline__ int operator()(int n) const {
    if (n < 3584) return n; if (n < 4096) return n + 16; if (n < 4112) return n - 512; if (n < 4352) return -1;
    const int t = (n - 4352) >> 8, cl = (n - 4352) & 255; const int br = 2 * (cl >> 7) + ((cl >> 2) & 1), ch = 16 * ((cl >> 5) & 3) + 4 * ((cl >> 3) & 3) + (cl & 3);
    return 4112 + br * 2048 + 64 * t + ch; } };
struct ColWup { __device__ __forceinline__ int operator()(int n) const { const int blk = n >> 8, r = n & 255; return (r < 128) ? (blk * 128 + r) : (DFF + blk * 128 + (r - 128)); } };

__device__ __forceinline__ void rms_row_to_bf16(const float* xrow, const float* g, bf16_t* orow, int lane, unsigned char* orow8 = nullptr) {
    const f32x4* xr = (const f32x4*)xrow + lane; const f32x4* gr = (const f32x4*)g + lane;
    f32x4 v[8]; float s = 0.f;
#pragma unroll
    for (int j = 0; j < 8; ++j) { v[j] = xr[64 * j]; s += (v[j].x * v[j].x + v[j].y * v[j].y) + (v[j].z * v[j].z + v[j].w * v[j].w); }
    const float r = 1.0f / sqrtf(wave_sum(s, lane) * (1.f / D) + EPS);
    u32x2* o8 = (u32x2*)orow + lane;
#pragma unroll
    for (int j = 0; j < 8; ++j) { const f32x4 gg = gr[64 * j]; const float a = v[j].x * r * gg.x, b = v[j].y * r * gg.y, c = v[j].z * r * gg.z, d = v[j].w * r * gg.w; u32x2 w; w.x = pk2(a, b); w.y = pk2(c, d); o8[64 * j] = w;
        if (orow8) ((unsigned*)orow8)[lane + 64 * j] = pk4_fp8(a, b, c, d); }
}
__device__ __forceinline__ void rms_rows(Frame& F, const float* src, const float* g, bf16_t* dst, unsigned char* dst8 = nullptr) {
    const int gw = F.vcu * NWAVES + F.wave, NGW = F.G * NWAVES;
    for (int m = gw; m < M; m += NGW) rms_row_to_bf16(src + (size_t)m * D, g, dst + (size_t)m * D, F.lane, dst8 ? dst8 + (size_t)m * D : nullptr);
}
__device__ __forceinline__ void row_scale(Frame& F) {
    const int gt = F.vcu * (NWAVES * 64) + F.tid, NGT = F.G * NWAVES * 64;
    for (int m = gt; m < M; m += NGT) { float s = 0.f;
#pragma unroll
        for (int j = 0; j < 32; ++j) s += F.SS()[(size_t)j * M + m];
        const int r = m & 255;
        F.RS()[((size_t)((m >> 8) * 2 + ((r >> 6) & 1)) * 16 + (r & 15)) * 8 + (r >> 7) * 4 + ((r >> 4) & 3)] = 1.0f / sqrtf(s * (1.f / D) + EPS); }
}
__device__ __forceinline__ void rms_rows16(Frame& F, const bf16_t* src, const float* g, bf16_t* dst, unsigned char* dst8) {
    const int gw = F.vcu * NWAVES + F.wave, NGW = F.G * NWAVES, lane = F.lane;
    for (int m = gw; m < M; m += NGW) {
        const u32x4* xr = (const u32x4*)(src + (size_t)m * D) + lane; float v[4][8]; float s = 0.f;
#pragma unroll
        for (int j = 0; j < 4; ++j) { unpack8(xr[64 * j], v[j]);
#pragma unroll
            for (int q = 0; q < 8; ++q) s += v[j][q] * v[j][q]; }
        const float r = 1.0f / sqrtf(wave_sum(s, lane) * (1.f / D) + EPS);
        u32x4* o16 = (u32x4*)(dst + (size_t)m * D) + lane; u32x2* o8 = (u32x2*)(dst8 + (size_t)m * D) + lane;
#pragma unroll
        for (int j = 0; j < 4; ++j) { const f32x4 g0 = *((const f32x4*)g + 2 * (lane + 64 * j)), g1 = *((const f32x4*)g + 2 * (lane + 64 * j) + 1); float y[8];
            y[0] = v[j][0] * r * g0.x; y[1] = v[j][1] * r * g0.y; y[2] = v[j][2] * r * g0.z; y[3] = v[j][3] * r * g0.w; y[4] = v[j][4] * r * g1.x; y[5] = v[j][5] * r * g1.y; y[6] = v[j][6] * r * g1.z; y[7] = v[j][7] * r * g1.w;
            o16[64 * j] = pack8(y); u32x2 w8; w8.x = pk4_fp8(y[0], y[1], y[2], y[3]); w8.y = pk4_fp8(y[4], y[5], y[6], y[7]); o8[64 * j] = w8; }
    }
}
__device__ __forceinline__ void rms_rows16_to_f32(Frame& F, const bf16_t* src, const float* g, float* out) {
    const int gw = F.vcu * NWAVES + F.wave, NGW = F.G * NWAVES, lane = F.lane;
    for (int m = gw; m < M; m += NGW) {
        const u32x4* xr = (const u32x4*)(src + (size_t)m * D) + lane; float v[4][8]; float s = 0.f;
#pragma unroll
        for (int j = 0; j < 4; ++j) { unpack8(xr[64 * j], v[j]);
#pragma unroll
            for (int q = 0; q < 8; ++q) s += v[j][q] * v[j][q]; }
        const float r = 1.0f / sqrtf(wave_sum(s, lane) * (1.f / D) + EPS);
        f32x4* o = (f32x4*)(out + (size_t)m * D);
#pragma unroll
        for (int j = 0; j < 4; ++j) { const f32x4 g0 = *((const f32x4*)g + 2 * (lane + 64 * j)), g1 = *((const f32x4*)g + 2 * (lane + 64 * j) + 1);
            o[2 * (lane + 64 * j)] = (f32x4){v[j][0] * r * g0.x, v[j][1] * r * g0.y, v[j][2] * r * g0.z, v[j][3] * r * g0.w};
            o[2 * (lane + 64 * j) + 1] = (f32x4){v[j][4] * r * g1.x, v[j][5] * r * g1.y, v[j][6] * r * g1.z, v[j][7] * r * g1.w}; }
    }
}
__device__ __forceinline__ void rms_rows_f32_inplace(Frame& F, float* buf, const float* g) {
    const int gw = F.vcu * NWAVES + F.wave, NGW = F.G * NWAVES;
    for (int m = gw; m < M; m += NGW) {
        f32x4* xr = (f32x4*)(buf + (size_t)m * D) + F.lane; const f32x4* gr = (const f32x4*)g + F.lane;
        f32x4 v[8]; float s = 0.f;
#pragma unroll
        for (int j = 0; j < 8; ++j) { v[j] = xr[64 * j]; s += (v[j].x * v[j].x + v[j].y * v[j].y) + (v[j].z * v[j].z + v[j].w * v[j].w); }
        const float r = 1.0f / sqrtf(wave_sum(s, F.lane) * (1.f / D) + EPS);
#pragma unroll
        for (int j = 0; j < 8; ++j) { const f32x4 gg = gr[64 * j]; xr[64 * j] = (f32x4){v[j].x * r * gg.x, v[j].y * r * gg.y, v[j].z * r * gg.z, v[j].w * r * gg.w}; }
    }
}

__device__ __forceinline__ void phase_prep(Frame& F, int l) {
    LAS float* scr = (LAS float*)(F.lds + F.wave * 16384);
    const int gw = F.vcu * NWAVES + F.wave, NGW = F.G * NWAVES;
    constexpr int I_IN = (D / 64) * (NIN / 32), I_UP = (D / 64) * (NUP / 32), I_DN = (DFF / 64) * (D / 32), I_BR = 4 * (BW / 64) * (D / 32), I_OUT = (D / 64) * (D / 32), I_GLU = (BW / 64) * (BW / 32), I_PL = 4 * (128 / 64) * (128 / 32);
    constexpr int NITEMS = I_IN + I_UP + I_DN + I_BR + I_OUT + I_GLU + I_PL;
    for (int it = gw; it < NITEMS; it += NGW) {
        int r = it;
        if (r < I_IN) { const int nb = NIN / 32, n0 = 32 * (r % nb);
            if (n0 < C_GATE) transpose_item(F.w_in() + (size_t)l * D * NIN_SRC, NIN_SRC, F.win_t(), D, 0, 64 * (r / nb), n0, ColWin(), scr, F.lane);
            else transpose_item_fp8(F.w_in() + (size_t)l * D * NIN_SRC, NIN_SRC, F.W8(), D, 64 * (r / nb), n0, n0 - C_GATE, ColWin(), scr, F.lane, nullptr, 64.0f);
            continue; } r -= I_IN;
        if (r < I_UP) { const int nb = NUP / 32; transpose_item(F.w_up() + (size_t)l * D * NUP, NUP, F.wup_t(), D, 0, 64 * (r / nb), 32 * (r % nb), ColWup(), scr, F.lane, F.g_ffn() + (size_t)l * D); continue; } r -= I_UP;
        if (r < I_DN) { const int nb = D / 32; transpose_item(F.w_down() + (size_t)l * DFF * D, D, F.wdn_t(), DFF, 0, 64 * (r / nb), 32 * (r % nb), ColIdent(), scr, F.lane); continue; } r -= I_DN;
        if (r < I_BR) { const int per = (BW / 64) * (D / 32), br = r / per, q = r % per, nb = D / 32;
            transpose_item(F.w_branch() + ((size_t)l * 4 + br) * BW * D, D, F.wbr_t(), D, br * BW, 64 * (q / nb), 32 * (q % nb), ColIdent(), scr, F.lane); continue; } r -= I_BR;
        if (r < I_OUT) { const int nb = D / 32; transpose_item(F.w_out() + (size_t)l * D * D, D, F.wout_t(), D, 0, 64 * (r / nb), 32 * (r % nb), ColIdent(), scr, F.lane); continue; } r -= I_OUT;
        if (r < I_GLU) { const int nb = BW / 32; transpose_item(F.w_glu() + (size_t)l * BW * BW, BW, F.wglu_t(), BW, 0, 64 * (r / nb), 32 * (r % nb), ColIdent(), scr, F.lane); continue; } r -= I_GLU;
        { const int grp = r / 8, q = r % 8; transpose_item(F.pool_w() + ((size_t)l * 4 + grp) * 128 * 128, 128, F.poolw_t() + (size_t)grp * 128 * 128, 128, 0, 64 * (q / 4), 32 * (q % 4), ColIdent(), scr, F.lane); }
    }
    const int gt = F.vcu * (NWAVES * 64) + F.tid, NGT = F.G * NWAVES * 64;
    for (int i = gt; i < 32 * 64; i += NGT) {
        const int g = i >> 6;
        const float are = F.a_re()[(size_t)l * 2048 + i], aim = F.a_im()[(size_t)l * 2048 + i], dt = expf(F.log_dt()[l * 32 + g]);
        const float mag = expf(are * dt), th = aim * dt;
        const float abr = mag * cosf(th), abi = mag * sinf(th);
        const float den = are * are + aim * aim, nr = abr - 1.0f, ni = abi;
        const float fre = (nr * are + ni * aim) / den, fim = (ni * are - nr * aim) / den;
        F.abar()[2 * i] = abr; F.abar()[2 * i + 1] = abi;
        float pr = abr, pi = abi;
#pragma unroll
        for (int q = 0; q < 6; ++q) { const float tr = pr * pr - pi * pi, ti = 2.f * pr * pi; pr = tr; pi = ti; }
        F.apow()[2 * i] = pr; F.apow()[2 * i + 1] = pi;
        const float* br = F.b_re() + ((size_t)l * 2048 + i) * 16; const float* bi = F.b_im() + ((size_t)l * 2048 + i) * 16;
#pragma unroll
        for (int c = 0; c < 16; ++c) { const float x = br[c], y = bi[c]; const float vr = fre * x - fim * y, vi = fre * y + fim * x; const int p = i & 63;
            F.bbt()[((size_t)g * 128 + p) * 16 + c] = (bf16_t)f2bf(vr); F.bbt()[((size_t)g * 128 + 64 + p) * 16 + c] = (bf16_t)f2bf(vi); }
    }
    for (int i = gt; i < 32 * 16 * 128; i += NGT) {
        const int k = i & 127, gc = i >> 7;
        const float v = (k < 64) ? F.c_re()[((size_t)l * 512 + gc) * 64 + k] : -F.c_im()[((size_t)l * 512 + gc) * 64 + (k - 64)];
        F.cmt()[i] = (bf16_t)f2bf(v);
    }
    if (l == 0) {
        for (int i = gt; i < M * 32; i += NGT) {
            const int row = i >> 5, j = i & 31;
            const float inv = exp2f(-(float)j * (13.287712379549449f / 32.0f));
            const float ang = (float)F.pos()[row] * inv;
            F.rotc()[i] = cosf(ang); F.rots()[i] = sinf(ang);
        }
    }
    if (l == 0) rms_rows(F, F.x(), F.g_mix(), F.HN(), F.HN8()); else rms_rows16(F, (const bf16_t*)F.out, F.g_mix() + (size_t)l * D, F.HN(), F.HN8());
}

__device__ __forceinline__ void gr_pass(Frame& F) {
    const int gw = F.vcu * NWAVES + F.wave, NGW = F.G * NWAVES, lane = F.lane, lr = lane & 15, lq = lane >> 4;
    for (int unit = gw; unit < M / 16; unit += NGW) {
        const bf16_t* ap = F.HN() + (size_t)(16 * unit + lr) * D + 8 * lq; const bf16_t* bp = F.win_t() + (size_t)(C_GR + lr) * D + 8 * lq;
        f32x4 acc = (f32x4){0.f, 0.f, 0.f, 0.f};
#pragma unroll 1
        for (int kb = 0; kb < 64; kb += 16) { bf16x8 a[16], b[16];
#pragma unroll
            for (int j = 0; j < 16; ++j) { a[j] = *(const bf16x8*)(ap + 32 * (kb + j)); b[j] = *(const bf16x8*)(bp + 32 * (kb + j)); }
#pragma unroll
            for (int j = 0; j < 16; ++j) acc = __builtin_amdgcn_mfma_f32_16x16x32_bf16(a[j], b[j], acc, 0, 0, 0); }
#pragma unroll
        for (int i = 0; i < 4; ++i) F.PROJ()[(size_t)(16 * unit + 4 * lq + i) * LDP + C_GR + lr] = (bf16_t)f2bf(acc[i]);
    }
}

__device__ __forceinline__ f32x4 mma_nt_lds(const LAS bf16_t* X, int px, const LAS bf16_t* Y, int py, int ksteps, f32x4 acc, int lane) {
    const LAS bf16_t* xp = X + (lane & 15) * px + 8 * (lane >> 4);
    const LAS bf16_t* yp = Y + (lane & 15) * py + 8 * (lane >> 4);
    for (int ks = 0; ks < ksteps; ++ks) {
        const bf16x8 a = *(const LAS bf16x8*)(xp + 32 * ks), b = *(const LAS bf16x8*)(yp + 32 * ks);
        acc = __builtin_amdgcn_mfma_f32_16x16x32_bf16(a, b, acc, 0, 0, 0);
    }
    return acc;
}

constexpr int LN_TOT = 16384, LN_QD = 18432, LN_KI = 27648, LN_PM = 36864, LN_VT = 46080, LN_OB = 64512, LN_WG = 98304, LN_END = 98304 + 4096 + 256;
constexpr int LP = 72;
struct LinRaw { u32x4 q0, q1, k0, k1, v0, v1, g0, g1, gr0, gr1; f32x4 c0, c1, s0, s1; bf16x8 sp0, sp1; };
template <bool OUT>
__device__ __forceinline__ void lin_issue(Frame& F, int unit, LinRaw& R) {
    const int n = unit & 63, h = (unit >> 6) & 3, b = (unit >> 8) & 7, mixer = unit >> 11;
    const size_t row0 = (size_t)b * SEQ + (size_t)n * CH; const int s = F.tid >> 3, c = F.tid & 7;
    const int cq = (mixer == 0 ? C_RQ : C_GQ) + h * 64, ck = (mixer == 0 ? C_RK : C_GK) + h * 64, cv = (mixer == 0 ? C_RV : C_GV) + h * 128, cg = (mixer == 0 ? C_RG : C_GG) + h * 128;
    const bf16_t* pr = F.PROJ() + (row0 + s) * LDP;
    R.k0 = *(const u32x4*)(pr + ck + 8 * c); R.k1 = *(const u32x4*)(pr + ck + 8 * (c ^ 4));
    if (OUT) { R.q0 = *(const u32x4*)(pr + cq + 8 * c); R.q1 = *(const u32x4*)(pr + cq + 8 * (c ^ 4)); }
    { const float* cp = F.rotc() + (row0 + s) * 32 + (c & 3) * 8; const float* sp = F.rots() + (row0 + s) * 32 + (c & 3) * 8;
      R.c0 = *(const f32x4*)cp; R.c1 = *(const f32x4*)(cp + 4); R.s0 = *(const f32x4*)sp; R.s1 = *(const f32x4*)(sp + 4); }
    R.gr0 = *(const u32x4*)(pr + C_GR); R.gr1 = *(const u32x4*)(pr + C_GR + 8);
    R.v0 = *(const u32x4*)(F.PROJ() + (row0 + (F.tid >> 4)) * LDP + cv + (F.tid & 15) * 8);
    R.v1 = *(const u32x4*)(F.PROJ() + (row0 + 32 + (F.tid >> 4)) * LDP + cv + (F.tid & 15) * 8);
    if (OUT) { R.g0 = *(const u32x4*)(pr + cg + 16 * c); R.g1 = *(const u32x4*)(pr + cg + 16 * c + 8);
        const bf16_t* sq = F.SPREV() + (size_t)unit * 8192 + (size_t)(16 * F.wave + (F.lane & 15)) * 64 + 8 * (F.lane >> 4);
        R.sp0 = *(const bf16x8*)sq; R.sp1 = *(const bf16x8*)(sq + 32); }
}
__device__ __forceinline__ void lin_rot(const u32x4 own_, const u32x4 oth_, const LinRaw& R, bool rot, bool hi, float scale, float (&v)[8]) {
    float own[8]; unpack8(own_, own);
    if (!rot) {
#pragma unroll
        for (int j = 0; j < 8; ++j) v[j] = own[j] * scale;
        return; }
    float oth[8]; unpack8(oth_, oth);
    const float cs[8] = {R.c0.x, R.c0.y, R.c0.z, R.c0.w, R.c1.x, R.c1.y, R.c1.z, R.c1.w}, sn[8] = {R.s0.x, R.s0.y, R.s0.z, R.s0.w, R.s1.x, R.s1.y, R.s1.z, R.s1.w};
#pragma unroll
    for (int j = 0; j < 8; ++j) { const float os = oth[j] * sn[j]; v[j] = (own[j] * cs[j] + (hi ? os : -os)) * scale; }
}
__device__ __forceinline__ void lin_decay(Frame& F, int mixer, int h, const LinRaw& R, float (&bcum)[8], float (&blast)[8]) {
    LAS float* TOT = (LAS float*)(F.lds + LN_TOT);
    const int s = F.tid >> 3, c = F.tid & 7, d0 = 8 * c;
    if (mixer == 0) {
        const float lg = __logf(1.0f - exp2f(-5.0f - (float)h));
#pragma unroll
        for (int j = 0; j < 8; ++j) { bcum[j] = (float)(s + 1) * lg; blast[j] = 64.0f * lg; }
        lds_sync();
        return;
    }
    const LAS float* WG = (const LAS float*)(F.lds + LN_WG);
    float grf[16]; { float a[8], b2[8]; unpack8(R.gr0, a); unpack8(R.gr1, b2);
#pragma unroll
        for (int j = 0; j < 8; ++j) { grf[j] = a[j]; grf[8 + j] = b2[j]; } }
    float x[8]; { const f32x4 b0 = *(const LAS f32x4*)(WG + 1024 + d0), b1 = *(const LAS f32x4*)(WG + 1024 + d0 + 4); x[0] = b0.x; x[1] = b0.y; x[2] = b0.z; x[3] = b0.w; x[4] = b1.x; x[5] = b1.y; x[6] = b1.z; x[7] = b1.w; }
#pragma unroll
    for (int r = 0; r < 16; ++r) { const f32x4 w0 = *(const LAS f32x4*)(WG + r * 64 + d0), w1 = *(const LAS f32x4*)(WG + r * 64 + d0 + 4);
        x[0] += grf[r] * w0.x; x[1] += grf[r] * w0.y; x[2] += grf[r] * w0.z; x[3] += grf[r] * w0.w; x[4] += grf[r] * w1.x; x[5] += grf[r] * w1.y; x[6] += grf[r] * w1.z; x[7] += grf[r] * w1.w; }
#pragma unroll
    for (int j = 0; j < 8; ++j) x[j] = logsigmoidf_(x[j]) * (1.0f / 16.0f);
#pragma unroll
    for (int st = 8; st <= 32; st <<= 1) {
#pragma unroll
        for (int j = 0; j < 8; ++j) { const float t = lane_read(x[j], F.lane - st); if (F.lane >= st) x[j] += t; } }
    if ((F.lane >> 3) == 7) { *(LAS f32x4*)(TOT + F.wave * 64 + d0) = (f32x4){x[0], x[1], x[2], x[3]}; *(LAS f32x4*)(TOT + F.wave * 64 + d0 + 4) = (f32x4){x[4], x[5], x[6], x[7]}; }
    lds_sync();
    float off[8], tot[8];
#pragma unroll
    for (int j = 0; j < 8; ++j) { off[j] = 0.f; tot[j] = 0.f; }
#pragma unroll
    for (int w = 0; w < 8; ++w) { const f32x4 t0 = *(const LAS f32x4*)(TOT + w * 64 + d0), t1 = *(const LAS f32x4*)(TOT + w * 64 + d0 + 4); const float tv[8] = {t0.x, t0.y, t0.z, t0.w, t1.x, t1.y, t1.z, t1.w};
#pragma unroll
        for (int j = 0; j < 8; ++j) { tot[j] += tv[j]; off[j] += (w < F.wave) ? tv[j] : 0.f; } }
#pragma unroll
    for (int j = 0; j < 8; ++j) { bcum[j] = x[j] + off[j]; blast[j] = tot[j]; }
}
typedef short v4s_t __attribute__((ext_vector_type(4)));
__device__ __forceinline__ bf16x8 tr_frag(const LAS bf16_t* T, int pitch, int k0, int x0, int lane) {
    const int g = lane >> 4, i = lane & 15, q = i >> 2, p = i & 3;
    const LAS bf16_t* a = T + (k0 + 8 * g + q) * pitch + x0 + 4 * p;
    const v4s_t lo = __builtin_amdgcn_ds_read_tr16_b64_v4i16((LAS v4s_t*)a), hi = __builtin_amdgcn_ds_read_tr16_b64_v4i16((LAS v4s_t*)(a + 4 * pitch));
    return __builtin_shufflevector(lo, hi, 0, 1, 2, 3, 4, 5, 6, 7);
}
constexpr int PV = 144;
__device__ __forceinline__ void lin_store_vt(Frame& F, const LinRaw& R) {
    LAS bf16_t* VR = (LAS bf16_t*)(F.lds + LN_VT); const int e0 = (F.tid & 15) * 8;
    *(LAS u32x4*)(VR + (F.tid >> 4) * PV + e0) = R.v0; *(LAS u32x4*)(VR + (32 + (F.tid >> 4)) * PV + e0) = R.v1;
}
__device__ __forceinline__ void lin_state_compute(Frame& F, int unit, const LinRaw& R) {
    const int h = (unit >> 6) & 3, mixer = unit >> 11; const int s = F.tid >> 3, c = F.tid & 7, d0 = 8 * c;
    LAS bf16_t* KDT = (LAS bf16_t*)(F.lds + LN_KI); LAS bf16_t* VT = (LAS bf16_t*)(F.lds + LN_VT);
    float k[8], bcum[8], blast[8];
    lin_rot(R.k0, R.k1, R, mixer == 0, c >= 4, mixer == 0 ? 0.125f : 1.0f, k);
    lin_decay(F, mixer, h, R, bcum, blast);
    { float kd[8];
#pragma unroll
      for (int j = 0; j < 8; ++j) kd[j] = k[j] * __expf(blast[j] - bcum[j]);
      *(LAS u32x4*)(KDT + s * LP + d0) = pack8(kd); }
    lin_store_vt(F, R);
    if (s == 0) { float* dc = F.DEC() + (size_t)unit * 64 + d0;
        *(f32x4*)dc = (f32x4){__expf(blast[0]), __expf(blast[1]), __expf(blast[2]), __expf(blast[3])}; *(f32x4*)(dc + 4) = (f32x4){__expf(blast[4]), __expf(blast[5]), __expf(blast[6]), __expf(blast[7])}; }
    lds_sync();
    { const int w = F.wave, lane = F.lane; float* st = F.STATE() + (size_t)unit * 8192;
      const bf16x8 vf0 = tr_frag(VT, PV, 0, 16 * w, lane), vf1 = tr_frag(VT, PV, 32, 16 * w, lane);
#pragma unroll
      for (int dt = 0; dt < 4; ++dt) { f32x4 acc = (f32x4){0.f, 0.f, 0.f, 0.f};
          acc = __builtin_amdgcn_mfma_f32_16x16x32_bf16(vf0, tr_frag(KDT, LP, 0, 16 * dt, lane), acc, 0, 0, 0);
          acc = __builtin_amdgcn_mfma_f32_16x16x32_bf16(vf1, tr_frag(KDT, LP, 32, 16 * dt, lane), acc, 0, 0, 0);
#pragma unroll
          for (int i = 0; i < 4; ++i) st[(16 * w + 4 * (lane >> 4) + i) * 64 + 16 * dt + (lane & 15)] = acc[i]; } }
}
__device__ __forceinline__ void lin_out_compute(Frame& F, int unit, const LinRaw& R) {
    const int n = unit & 63, h = (unit >> 6) & 3, b = (unit >> 8) & 7, mixer = unit >> 11;
    const size_t row0 = (size_t)b * SEQ + (size_t)n * CH; const int s = F.tid >> 3, c = F.tid & 7, d0 = 8 * c;
    const int ycol = (mixer == 0 ? 0 : 1024) + h * 128;
    LAS bf16_t* QD = (LAS bf16_t*)(F.lds + LN_QD); LAS bf16_t* KI = (LAS bf16_t*)(F.lds + LN_KI); LAS bf16_t* PM = (LAS bf16_t*)(F.lds + LN_PM);
    LAS bf16_t* VT = (LAS bf16_t*)(F.lds + LN_VT); LAS float* OB = (LAS float*)(F.lds + LN_OB);
    float q[8], k[8], bcum[8], blast[8];
    lin_rot(R.q0, R.q1, R, mixer == 0, c >= 4, mixer == 0 ? 1.0f : 0.125f, q);
    lin_rot(R.k0, R.k1, R, mixer == 0, c >= 4, mixer == 0 ? 0.125f : 1.0f, k);
    lin_decay(F, mixer, h, R, bcum, blast);
    { float qd[8], ki[8];
#pragma unroll
      for (int j = 0; j < 8; ++j) { qd[j] = q[j] * __expf(bcum[j]); ki[j] = k[j] * __expf(-bcum[j]); }
      *(LAS u32x4*)(QD + s * LP + d0) = pack8(qd); *(LAS u32x4*)(KI + s * LP + d0) = pack8(ki); }
    lin_store_vt(F, R);
    lds_sync();
    { const int lane = F.lane;
#pragma unroll
      for (int j = 0; j < 2; ++j) { const int tile = 2 * F.wave + j, tt = tile >> 2, st = tile & 3;
          f32x4 acc = (f32x4){0.f, 0.f, 0.f, 0.f};
          if (st <= tt) acc = mma_nt_lds(QD + 16 * tt * LP, LP, KI + 16 * st * LP, LP, 2, acc, lane);
#pragma unroll
          for (int i = 0; i < 4; ++i) { const int t = 16 * tt + 4 * (lane >> 4) + i, s2 = 16 * st + (lane & 15); const float p = (st <= tt && s2 <= t) ? acc[i] : 0.f; PM[t * LP + s2] = (bf16_t)f2bf(p); } } }
    lds_sync();
    { const int w = F.wave, lane = F.lane;
      const bf16x8 vf0 = tr_frag(VT, PV, 0, 16 * w, lane), vf1 = tr_frag(VT, PV, 32, 16 * w, lane);
#pragma unroll
      for (int tt = 0; tt < 4; ++tt) { f32x4 acc = (f32x4){0.f, 0.f, 0.f, 0.f};
          { const LAS bf16_t* pp = PM + (16 * tt + (lane & 15)) * LP + 8 * (lane >> 4);
            acc = __builtin_amdgcn_mfma_f32_16x16x32_bf16(*(const LAS bf16x8*)pp, vf0, acc, 0, 0, 0);
            acc = __builtin_amdgcn_mfma_f32_16x16x32_bf16(*(const LAS bf16x8*)(pp + 32), vf1, acc, 0, 0, 0); }
          const LAS bf16_t* xp = QD + (16 * tt + (lane & 15)) * LP + 8 * (lane >> 4);
          acc = __builtin_amdgcn_mfma_f32_16x16x32_bf16(*(const LAS bf16x8*)xp, R.sp0, acc, 0, 0, 0);
          acc = __builtin_amdgcn_mfma_f32_16x16x32_bf16(*(const LAS bf16x8*)(xp + 32), R.sp1, acc, 0, 0, 0);
#pragma unroll
          for (int i = 0; i < 4; ++i) OB[(16 * tt + 4 * (lane >> 4) + i) * 132 + 16 * w + (lane & 15)] = acc[i]; } }
    lds_sync();
    { const int t = s, part = c; float o[16];
#pragma unroll
      for (int j = 0; j < 4; ++j) { const f32x4 v = *(const LAS f32x4*)(OB + t * 132 + 16 * part + 4 * j); o[4 * j] = v.x; o[4 * j + 1] = v.y; o[4 * j + 2] = v.z; o[4 * j + 3] = v.w; }
      float sm = 0.f;
#pragma unroll
      for (int j = 0; j < 16; ++j) sm += o[j];
      sm += lane_read(sm, F.lane ^ 1); sm += lane_read(sm, F.lane ^ 2); sm += lane_read(sm, F.lane ^ 4);
      const float mu = sm * (1.0f / 128.0f); float qv = 0.f;
#pragma unroll
      for (int j = 0; j < 16; ++j) { const float dlt = o[j] - mu; qv += dlt * dlt; }
      qv += lane_read(qv, F.lane ^ 1); qv += lane_read(qv, F.lane ^ 2); qv += lane_read(qv, F.lane ^ 4);
      const float r = 1.0f / sqrtf(qv * (1.0f / 128.0f) + EPS);
      float g0[8], g1[8]; unpack8(R.g0, g0); unpack8(R.g1, g1);
      float y0[8], y1[8];
#pragma unroll
      for (int j = 0; j < 8; ++j) { y0[j] = (o[j] - mu) * r * siluf_(g0[j]); y1[j] = (o[8 + j] - mu) * r * siluf_(g1[j]); }
      bf16_t* yp = F.Y() + (row0 + t) * D + ycol + 16 * part; *(u32x4*)yp = pack8(y0); *(u32x4*)(yp + 8) = pack8(y1); }
}
template <bool OUT>
__device__ __forceinline__ void lin_phase(Frame& F, int l) {
    { const int h = (F.vcu >> 6) & 3; LAS float* WG = (LAS float*)(F.lds + LN_WG);
      for (int i = F.tid; i < 16 * 64 + 64; i += NWAVES * 64) WG[i] = (i < 1024) ? F.gla_wg()[(size_t)l * 16 * 256 + (i >> 6) * 256 + h * 64 + (i & 63)] : F.gla_bg()[l * 256 + h * 64 + (i - 1024)];
      lds_sync(); }
    LinRaw A, B;
    lin_issue<OUT>(F, F.vcu, A);
    for (int u = F.vcu; u < 4096; u += 2 * F.G) {
        lin_issue<OUT>(F, u + F.G, B);
        if (OUT) lin_out_compute(F, u, A); else lin_state_compute(F, u, A);
        if (u + 2 * F.G < 4096) lin_issue<OUT>(F, u + 2 * F.G, A);
        if (OUT) lin_out_compute(F, u + F.G, B); else lin_state_compute(F, u + F.G, B);
    }
    lds_sync();
}
constexpr int L2_TOT = 0, L2_QD = 1024, L2_KI = 10240, L2_V = 19456, L2_SP = 37888, L2_PM = 56320, L2_STRIDE = 65536, L2_WG = 131072;
struct Lin2 { int unit, h, mixer, hw, s, c; size_t row0; LAS unsigned char* base; };
__device__ __forceinline__ void lin2_rot16(const u32x4 lo_, const u32x4 hi_, const f32x4 (&cs)[2], const f32x4 (&sn)[2], bool rot, float scale, float (&v)[16]) {
    float lo[8], hi[8]; unpack8(lo_, lo); unpack8(hi_, hi);
    if (!rot) {
#pragma unroll
        for (int j = 0; j < 8; ++j) { v[j] = lo[j] * scale; v[8 + j] = hi[j] * scale; }
    } else {
        const float c8[8] = {cs[0].x, cs[0].y, cs[0].z, cs[0].w, cs[1].x, cs[1].y, cs[1].z, cs[1].w}, s8[8] = {sn[0].x, sn[0].y, sn[0].z, sn[0].w, sn[1].x, sn[1].y, sn[1].z, sn[1].w};
#pragma unroll
        for (int j = 0; j < 8; ++j) { v[j] = (lo[j] * c8[j] - hi[j] * s8[j]) * scale; v[8 + j] = (hi[j] * c8[j] + lo[j] * s8[j]) * scale; }
    }
}
__device__ __forceinline__ void lin2_decay(Frame& F, const Lin2& L, const u32x4 gr0, const u32x4 gr1, float (&bcum)[16], float (&blast)[16]) {
    LAS float* TOT = (LAS float*)(L.base + L2_TOT);
    const int d0 = 8 * L.c;
    if (L.mixer == 0) {
        const float lg = __logf(1.0f - exp2f(-5.0f - (float)L.h));
#pragma unroll
        for (int j = 0; j < 16; ++j) { bcum[j] = (float)(L.s + 1) * lg; blast[j] = 64.0f * lg; }
        lds_sync();
        return;
    }
    const LAS float* WG = (const LAS float*)(F.lds + L2_WG);
    float grf[16]; { float a[8], b2[8]; unpack8(gr0, a); unpack8(gr1, b2);
#pragma unroll
        for (int j = 0; j < 8; ++j) { grf[j] = a[j]; grf[8 + j] = b2[j]; } }
    float x[16];
#pragma unroll
    for (int q = 0; q < 4; ++q) { const f32x4 b0 = *(const LAS f32x4*)(WG + 1024 + d0 + 32 * (q >> 1) + 4 * (q & 1)); x[4 * q] = b0.x; x[4 * q + 1] = b0.y; x[4 * q + 2] = b0.z; x[4 * q + 3] = b0.w; }
#pragma unroll
    for (int r = 0; r < 16; ++r) {
#pragma unroll
        for (int q = 0; q < 4; ++q) { const f32x4 w0 = *(const LAS f32x4*)(WG + r * 64 + d0 + 32 * (q >> 1) + 4 * (q & 1));
            x[4 * q] += grf[r] * w0.x; x[4 * q + 1] += grf[r] * w0.y; x[4 * q + 2] += grf[r] * w0.z; x[4 * q + 3] += grf[r] * w0.w; } }
#pragma unroll
    for (int j = 0; j < 16; ++j) x[j] = logsigmoidf_(x[j]) * (1.0f / 16.0f);
#pragma unroll
    for (int st = 4; st <= 32; st <<= 1) {
#pragma unroll
        for (int j = 0; j < 16; ++j) { const float t = lane_read(x[j], F.lane - st); if (F.lane >= st) x[j] += t; } }
    if ((F.lane >> 2) == 15) {
#pragma unroll
        for (int q = 0; q < 4; ++q) *(LAS f32x4*)(TOT + L.hw * 64 + d0 + 32 * (q >> 1) + 4 * (q & 1)) = (f32x4){x[4 * q], x[4 * q + 1], x[4 * q + 2], x[4 * q + 3]}; }
    lds_sync();
    float off[16], tot[16];
#pragma unroll
    for (int j = 0; j < 16; ++j) { off[j] = 0.f; tot[j] = 0.f; }
#pragma unroll
    for (int w = 0; w < 4; ++w) {
#pragma unroll
        for (int q = 0; q < 4; ++q) { const f32x4 t0 = *(const LAS f32x4*)(TOT + w * 64 + d0 + 32 * (q >> 1) + 4 * (q & 1)); const float tv[4] = {t0.x, t0.y, t0.z, t0.w};
#pragma unroll
            for (int j = 0; j < 4; ++j) { tot[4 * q + j] += tv[j]; off[4 * q + j] += (w < L.hw) ? tv[j] : 0.f; } } }
#pragma unroll
    for (int j = 0; j < 16; ++j) { bcum[j] = x[j] + off[j]; blast[j] = tot[j]; }
}
__device__ __forceinline__ bf16x8 tr_frag8(const LAS bf16_t* T, int pitch, int k0, int x0, int lane) {
    const int g = lane >> 4, i = lane & 15, q = i >> 2, p = i & 3;
    const LAS bf16_t* a = T + (k0 + 8 * g + q) * pitch + x0 + 8 * p;
    const v4s_t lo = __builtin_amdgcn_ds_read_tr16_b64_v4i16((LAS v4s_t*)a), hi = __builtin_amdgcn_ds_read_tr16_b64_v4i16((LAS v4s_t*)(a + 4 * pitch));
    return __builtin_shufflevector(lo, hi, 0, 1, 2, 3, 4, 5, 6, 7);
}
__device__ __forceinline__ void lin2_state(Frame& F, const Lin2& L) {
    const int ht = F.tid & 255, lane = F.lane, s = L.s, c = L.c, d0 = 8 * c;
    const int ck = (L.mixer == 0 ? C_RK : C_GK) + L.h * 64, cv = (L.mixer == 0 ? C_RV : C_GV) + L.h * 128;
    LAS bf16_t* KD = (LAS bf16_t*)(L.base + L2_KI); LAS bf16_t* VT = (LAS bf16_t*)(L.base + L2_V);
    const bf16_t* pr = F.PROJ() + (L.row0 + s) * LDP;
    u32x4 vv[4]; f32x4 cs[2], sn[2];
    const u32x4 klo = *(const u32x4*)(pr + ck + d0), khi = *(const u32x4*)(pr + ck + 32 + d0);
    u32x4 gr0 = (u32x4){0u, 0u, 0u, 0u}, gr1 = gr0;
    cs[0] = cs[1] = sn[0] = sn[1] = (f32x4){0.f, 0.f, 0.f, 0.f};
    if (L.mixer == 0) { const float* cp = F.rotc() + (L.row0 + s) * 32 + d0; const float* sp = F.rots() + (L.row0 + s) * 32 + d0;
      cs[0] = *(const f32x4*)cp; cs[1] = *(const f32x4*)(cp + 4); sn[0] = *(const f32x4*)sp; sn[1] = *(const f32x4*)(sp + 4); }
    else { gr0 = *(const u32x4*)(pr + C_GR); gr1 = *(const u32x4*)(pr + C_GR + 8); }
#pragma unroll
    for (int i = 0; i < 4; ++i) { const int idx = ht + 256 * i; vv[i] = *(const u32x4*)(F.PROJ() + (L.row0 + (idx >> 4)) * LDP + cv + (idx & 15) * 8); }
    float k[16], bcum[16], blast[16];
    lin2_rot16(klo, khi, cs, sn, L.mixer == 0, L.mixer == 0 ? 0.125f : 1.0f, k);
    lin2_decay(F, L, gr0, gr1, bcum, blast);
#pragma unroll
    for (int g = 0; g < 2; ++g) { float kd[8];
#pragma unroll
        for (int j = 0; j < 8; ++j) kd[j] = k[8 * g + j] * __expf(blast[8 * g + j] - bcum[8 * g + j]);
        *(LAS u32x4*)(KD + s * LP + d0 + 32 * g) = pack8(kd); }
#pragma unroll
    for (int i = 0; i < 4; ++i) { const int idx = ht + 256 * i; *(LAS u32x4*)(VT + (idx >> 4) * PV + (idx & 15) * 8) = vv[i]; }
    if (s == 0) { float* dc = F.DEC() + (size_t)L.unit * 64 + d0;
#pragma unroll
        for (int q = 0; q < 4; ++q) *(f32x4*)(dc + 32 * (q >> 1) + 4 * (q & 1)) = (f32x4){__expf(blast[4 * q]), __expf(blast[4 * q + 1]), __expf(blast[4 * q + 2]), __expf(blast[4 * q + 3])}; }
    lds_sync();
    { float* st = F.STATE() + (size_t)L.unit * 8192;
      const bf16x8 kf0 = tr_frag(KD, LP, 0, 16 * L.hw, lane), kf1 = tr_frag(KD, LP, 32, 16 * L.hw, lane);
#pragma unroll
      for (int et = 0; et < 8; ++et) { f32x4 acc = (f32x4){0.f, 0.f, 0.f, 0.f};
          acc = __builtin_amdgcn_mfma_f32_16x16x32_bf16(kf0, tr_frag(VT, PV, 0, 16 * et, lane), acc, 0, 0, 0);
          acc = __builtin_amdgcn_mfma_f32_16x16x32_bf16(kf1, tr_frag(VT, PV, 32, 16 * et, lane), acc, 0, 0, 0);
          *(f32x4*)(st + (16 * et + (lane & 15)) * 64 + 16 * L.hw + 4 * (lane >> 4)) = acc; } }
}
__device__ __forceinline__ void lin2_out(Frame& F, const Lin2& L) {
    const int ht = F.tid & 255, lane = F.lane, lr = lane & 15, lq = lane >> 4, s = L.s, c = L.c, d0 = 8 * c;
    const int cq = (L.mixer == 0 ? C_RQ : C_GQ) + L.h * 64, ck = (L.mixer == 0 ? C_RK : C_GK) + L.h * 64, cv = (L.mixer == 0 ? C_RV : C_GV) + L.h * 128, cg = (L.mixer == 0 ? C_RG : C_GG) + L.h * 128;
    const int ycol = (L.mixer == 0 ? 0 : 1024) + L.h * 128;
    LAS bf16_t* QD = (LAS bf16_t*)(L.base + L2_QD); LAS bf16_t* KI = (LAS bf16_t*)(L.base + L2_KI); LAS bf16_t* VT = (LAS bf16_t*)(L.base + L2_V);
    LAS bf16_t* SP = (LAS bf16_t*)(L.base + L2_SP); LAS bf16_t* PM = (LAS bf16_t*)(L.base + L2_PM + L.hw * 2304);
    const bf16_t* pr = F.PROJ() + (L.row0 + s) * LDP;
    float q[16], k[16], bcum[16], blast[16];
    u32x4 vv[4], sv[4]; u32x4 gr0, gr1;
    { f32x4 cs[2], sn[2];
      const u32x4 klo = *(const u32x4*)(pr + ck + d0), khi = *(const u32x4*)(pr + ck + 32 + d0), qlo = *(const u32x4*)(pr + cq + d0), qhi = *(const u32x4*)(pr + cq + 32 + d0);
      gr0 = (u32x4){0u, 0u, 0u, 0u}; gr1 = gr0; cs[0] = cs[1] = sn[0] = sn[1] = (f32x4){0.f, 0.f, 0.f, 0.f};
      if (L.mixer == 0) { const float* cp = F.rotc() + (L.row0 + s) * 32 + d0; const float* sp = F.rots() + (L.row0 + s) * 32 + d0;
        cs[0] = *(const f32x4*)cp; cs[1] = *(const f32x4*)(cp + 4); sn[0] = *(const f32x4*)sp; sn[1] = *(const f32x4*)(sp + 4); }
      else { gr0 = *(const u32x4*)(pr + C_GR); gr1 = *(const u32x4*)(pr + C_GR + 8); }
#pragma unroll
      for (int i = 0; i < 4; ++i) { const int idx = ht + 256 * i; vv[i] = *(const u32x4*)(F.PROJ() + (L.row0 + (idx >> 4)) * LDP + cv + (idx & 15) * 8);
          sv[i] = *(const u32x4*)(F.SPREV() + (size_t)L.unit * 8192 + (size_t)idx * 8); }
      lin2_rot16(qlo, qhi, cs, sn, L.mixer == 0, L.mixer == 0 ? 1.0f : 0.125f, q);
      lin2_rot16(klo, khi, cs, sn, L.mixer == 0, L.mixer == 0 ? 0.125f : 1.0f, k); }
    lin2_decay(F, L, gr0, gr1, bcum, blast);
#pragma unroll
    for (int g = 0; g < 2; ++g) { float qd[8], ki[8];
#pragma unroll
        for (int j = 0; j < 8; ++j) { qd[j] = q[8 * g + j] * __expf(bcum[8 * g + j]); ki[j] = k[8 * g + j] * __expf(-bcum[8 * g + j]); }
        *(LAS u32x4*)(QD + s * LP + d0 + 32 * g) = pack8(qd); *(LAS u32x4*)(KI + s * LP + d0 + 32 * g) = pack8(ki); }
#pragma unroll
    for (int i = 0; i < 4; ++i) { const int idx = ht + 256 * i; *(LAS u32x4*)(VT + (idx >> 4) * PV + (idx & 15) * 8) = vv[i]; *(LAS u32x4*)(SP + (idx >> 3) * LP + (idx & 7) * 8) = sv[i]; }
    const bf16_t* gp = F.PROJ() + (L.row0 + 16 * L.hw + lr) * LDP + cg + 8 * lq;
    u32x4 gt[4];
#pragma unroll
    for (int pe = 0; pe < 4; ++pe) gt[pe] = *(const u32x4*)(gp + 32 * pe);
    lds_sync();
    const LAS bf16_t* qrow = QD + (16 * L.hw + lr) * LP + 8 * lq;
    const bf16x8 qf0 = *(const LAS bf16x8*)qrow, qf1 = *(const LAS bf16x8*)(qrow + 32);
#pragma unroll
    for (int st = 0; st < 4; ++st) {
        f32x4 acc = (f32x4){0.f, 0.f, 0.f, 0.f};
        if (st <= L.hw) { const LAS bf16_t* krow = KI + (16 * st + lr) * LP + 8 * lq;
            acc = __builtin_amdgcn_mfma_f32_16x16x32_bf16(*(const LAS bf16x8*)krow, qf0, acc, 0, 0, 0);
            acc = __builtin_amdgcn_mfma_f32_16x16x32_bf16(*(const LAS bf16x8*)(krow + 32), qf1, acc, 0, 0, 0); }
        float p[4];
#pragma unroll
        for (int i = 0; i < 4; ++i) p[i] = (st <= L.hw && 16 * st + 4 * lq + i <= 16 * L.hw + lr) ? acc[i] : 0.f;
        u32x2 w; w.x = pk2(p[0], p[1]); w.y = pk2(p[2], p[3]);
        *(LAS u32x2*)(PM + lr * LP + 16 * st + 4 * lq) = w; }
    asm volatile("s_waitcnt lgkmcnt(0)" ::: "memory");
    const bf16x8 pf0 = *(const LAS bf16x8*)(PM + lr * LP + 8 * lq), pf1 = *(const LAS bf16x8*)(PM + lr * LP + 32 + 8 * lq);
    f32x4 o[8];
    const int erow = 8 * (lr >> 2) + (lr & 3);
#pragma unroll
    for (int et = 0; et < 8; ++et) { const int e0 = 32 * (et >> 1) + 4 * (et & 1); f32x4 acc = (f32x4){0.f, 0.f, 0.f, 0.f};
        acc = __builtin_amdgcn_mfma_f32_16x16x32_bf16(tr_frag8(VT, PV, 0, e0, lane), pf0, acc, 0, 0, 0);
        acc = __builtin_amdgcn_mfma_f32_16x16x32_bf16(tr_frag8(VT, PV, 32, e0, lane), pf1, acc, 0, 0, 0);
        const LAS bf16_t* srow = SP + (e0 + erow) * LP + 8 * lq;
        acc = __builtin_amdgcn_mfma_f32_16x16x32_bf16(*(const LAS bf16x8*)srow, qf0, acc, 0, 0, 0);
        acc = __builtin_amdgcn_mfma_f32_16x16x32_bf16(*(const LAS bf16x8*)(srow + 32), qf1, acc, 0, 0, 0);
        o[et] = acc; }
    float sm = 0.f;
#pragma unroll
    for (int et = 0; et < 8; ++et) sm += (o[et][0] + o[et][1]) + (o[et][2] + o[et][3]);
    sm += lane_read(sm, lane ^ 16); sm += lane_read(sm, lane ^ 32);
    const float mu = sm * (1.0f / 128.0f); float qv = 0.f;
#pragma unroll
    for (int et = 0; et < 8; ++et) {
#pragma unroll
        for (int i = 0; i < 4; ++i) { const float dlt = o[et][i] - mu; qv += dlt * dlt; } }
    qv += lane_read(qv, lane ^ 16); qv += lane_read(qv, lane ^ 32);
    const float r = 1.0f / sqrtf(qv * (1.0f / 128.0f) + EPS);
    bf16_t* yp = F.Y() + (L.row0 + 16 * L.hw + lr) * D + ycol + 8 * lq;
#pragma unroll
    for (int pe = 0; pe < 4; ++pe) { float g[8], y[8]; unpack8(gt[pe], g);
#pragma unroll
        for (int j = 0; j < 8; ++j) y[j] = (o[2 * pe + (j >> 2)][j & 3] - mu) * r * siluf_(g[j]);
        *(u32x4*)(yp + 32 * pe) = pack8(y); }
}
template <bool OUT>
__device__ __forceinline__ void lin2_phase(Frame& F, int l) {
    { const int h = (F.vcu >> 6) & 3; LAS float* WG = (LAS float*)(F.lds + L2_WG);
      for (int i = F.tid; i < 16 * 64 + 64; i += NWAVES * 64) WG[i] = (i < 1024) ? F.gla_wg()[(size_t)l * 16 * 256 + (i >> 6) * 256 + h * 64 + (i & 63)] : F.gla_bg()[l * 256 + h * 64 + (i - 1024)];
      lds_sync(); }
    const int half = F.wave >> 2;
#pragma unroll 1
    for (int j = 0; j < 8; ++j) {
        Lin2 L; L.unit = F.vcu + 256 * (2 * j + half); L.h = (L.unit >> 6) & 3; asm volatile("" : "+s"(L.h)); L.mixer = L.unit >> 11; L.hw = F.wave & 3; L.s = (F.tid & 255) >> 2; L.c = F.tid & 3;
        L.row0 = (size_t)((L.unit >> 8) & 7) * SEQ + (size_t)(L.unit & 63) * CH; L.base = F.lds + half * L2_STRIDE;
        if (OUT) lin2_out(F, L); else lin2_state(F, L);
    }
    lds_sync();
}
__device__ __forceinline__ void lin_scan(Frame& F) {
    const int gt = F.vcu * (NWAVES * 64) + F.tid, NGT = F.G * NWAVES * 64;
    for (int i = gt; i < 64 * 8192; i += NGT) {
        const int seq = i >> 13, idx = i & 8191, d = idx & 63;
        const float* st = F.STATE() + (size_t)seq * NCH * 8192 + idx; const float* dc = F.DEC() + (size_t)seq * NCH * 64 + d; bf16_t* sp = F.SPREV() + (size_t)seq * NCH * 8192 + idx;
        float carry = 0.f; asm volatile("" : "+v"(carry));
#pragma unroll
        for (int h = 0; h < 2; ++h) {
            float v[32], c[32];
#pragma unroll
            for (int n = 0; n < 32; ++n) { v[n] = st[(size_t)(32 * h + n) * 8192]; c[n] = dc[(size_t)(32 * h + n) * 64]; }
#pragma unroll
            for (int n = 0; n < 32; ++n) { sp[(size_t)(32 * h + n) * 8192] = (bf16_t)f2bf(carry); carry = c[n] * carry + v[n]; asm volatile("" : "+v"(carry)); }
        }
    }
}
constexpr int S5_WL = 16384, S5_BU = 2048, S5_X = 2048 + 8320;
template <bool OUT>
__device__ __forceinline__ void s5_pass(Frame& F, int l) {
    LAS bf16_t* UT = (LAS bf16_t*)(F.lds + F.wave * S5_WL); LAS float* BU = (LAS float*)(F.lds + F.wave * S5_WL + S5_BU); LAS bf16_t* X = (LAS bf16_t*)(F.lds + F.wave * S5_WL + S5_X);
    const int gw = F.vcu * NWAVES + F.wave, NGW = F.G * NWAVES, lane = F.lane, lr = lane & 15, lq = lane >> 4;
    u32x4 ua, uc;
    { const int g = gw & 31, n = (gw >> 5) & 63, b = gw >> 11; const bf16_t* up = F.PROJ() + ((size_t)b * SEQ + (size_t)n * CH + lane) * LDP + C_SU + g * 16; ua = *(const u32x4*)up; uc = *(const u32x4*)(up + 8); }
    const int g = gw & 31;
    const int gp = g * 64 + lane; const float ar = F.abar()[2 * gp], ai = F.abar()[2 * gp + 1];
    bf16x8 bfr[8];
#pragma unroll
    for (int q = 0; q < 8; ++q) { bfr[q] = (bf16x8){0, 0, 0, 0, 0, 0, 0, 0}; if (lq < 2) bfr[q] = *(const bf16x8*)(F.bbt() + ((size_t)g * 128 + 16 * q + lr) * 16 + 8 * lq); }
    bf16x8 cf[4]; float dsk = 0.f;
    if (OUT) {
#pragma unroll
        for (int ks = 0; ks < 4; ++ks) cf[ks] = *(const bf16x8*)(F.cmt() + ((size_t)(g * 16 + lr)) * 128 + 32 * ks + 8 * lq);
        dsk = F.s5_d()[(size_t)l * BW + g * 16 + lr]; }
    for (int unit = gw; unit < BATCH * NCH * 32; unit += NGW) {
        const int n = (unit >> 5) & 63, b = unit >> 11; const size_t row0 = (size_t)b * SEQ + (size_t)n * CH;
        *(LAS u32x4*)(UT + lane * 16) = ua; *(LAS u32x4*)(UT + lane * 16 + 8) = uc;
        if (unit + NGW < BATCH * NCH * 32) { const int un = unit + NGW, g2 = un & 31, n2 = (un >> 5) & 63, b2 = un >> 11;
            const bf16_t* up = F.PROJ() + ((size_t)b2 * SEQ + (size_t)n2 * CH + lane) * LDP + C_SU + g2 * 16; ua = *(const u32x4*)up; uc = *(const u32x4*)(up + 8); }
        float xr = 0.f, xi = 0.f;
        if (OUT) { const f32x2 x0 = *(const f32x2*)(F.XEND() + ((((size_t)(b * 32 + g)) * NCH + n) * 64 + lane) * 2); xr = x0.x; xi = x0.y; }
        LDS_WAIT();
        for (int sb = 0; sb < 4; ++sb) {
            bf16x8 af = (bf16x8){0, 0, 0, 0, 0, 0, 0, 0}; if (lq < 2) af = *(const LAS bf16x8*)(UT + (16 * sb + lr) * 16 + 8 * lq);
#pragma unroll
            for (int q = 0; q < 8; ++q) { f32x4 acc = (f32x4){0.f, 0.f, 0.f, 0.f}; acc = __builtin_amdgcn_mfma_f32_16x16x32_bf16(af, bfr[q], acc, 0, 0, 0);
#pragma unroll
                for (int i = 0; i < 4; ++i) BU[(4 * lq + i) * 130 + 16 * q + lr] = acc[i]; }
            LDS_WAIT();
            float br[16], bi[16];
#pragma unroll
            for (int tt = 0; tt < 16; ++tt) { br[tt] = BU[tt * 130 + lane]; bi[tt] = BU[tt * 130 + 64 + lane]; }
#pragma unroll
            for (int tt = 0; tt < 16; ++tt) { const float nr = ar * xr - ai * xi + br[tt], ni = ar * xi + ai * xr + bi[tt]; xr = nr; xi = ni; asm volatile("" : "+v"(xr), "+v"(xi));
                if (OUT) { X[tt * 136 + lane] = (bf16_t)f2bf(xr); X[tt * 136 + 64 + lane] = (bf16_t)f2bf(xi); } }
            if (OUT) {
                LDS_WAIT();
                f32x4 acc = (f32x4){0.f, 0.f, 0.f, 0.f}; const LAS bf16_t* xp = X + lr * 136 + 8 * lq;
#pragma unroll
                for (int ks = 0; ks < 4; ++ks) acc = __builtin_amdgcn_mfma_f32_16x16x32_bf16(*(const LAS bf16x8*)(xp + 32 * ks), cf[ks], acc, 0, 0, 0);
#pragma unroll
                for (int i = 0; i < 4; ++i) { const int tl = 16 * sb + 4 * lq + i; const float u = bflo((unsigned)UT[tl * 16 + lr]); const float y = gelu_tanh(acc[i] + dsk * u);
                    F.YBP()[(row0 + tl) * BW + g * 16 + lr] = (bf16_t)f2bf(y); }
            }
            LDS_WAIT();
        }
        if (!OUT) *(f32x2*)(F.XEND() + ((((size_t)(b * 32 + g)) * NCH + n) * 64 + lane) * 2) = (f32x2){xr, xi};
    }
}
__device__ __forceinline__ void s5_scan(Frame& F) {
    const int gt = F.vcu * (NWAVES * 64) + F.tid, NGT = F.G * NWAVES * 64;
    for (int i = gt; i < BATCH * 32 * 64; i += NGT) {
        const int p = i & 63, bg = i >> 6, g = bg & 31; const float pr = F.apow()[2 * (g * 64 + p)], pi = F.apow()[2 * (g * 64 + p) + 1];
        f32x2* xp = (f32x2*)(F.XEND() + (((size_t)bg * NCH) * 64 + p) * 2);
        float cr = 0.f, ci = 0.f; asm volatile("" : "+v"(cr), "+v"(ci));
#pragma unroll
        for (int h = 0; h < 2; ++h) {
            f32x2 v[32];
#pragma unroll
            for (int n = 0; n < 32; ++n) v[n] = xp[(size_t)(32 * h + n) * 64];
#pragma unroll
            for (int n = 0; n < 32; ++n) { xp[(size_t)(32 * h + n) * 64] = (f32x2){cr, ci};
                const float nr = pr * cr - pi * ci + v[n].x, ni = pr * ci + pi * cr + v[n].y; cr = nr; ci = ni; asm volatile("" : "+v"(cr), "+v"(ci)); }
        }
    }
}

constexpr int PWP = 136;
constexpr int PL_SC = 4 * 128 * PWP * 2;
template <int CTRL> __device__ __forceinline__ float dppf(float x) { return __builtin_bit_cast(float, __builtin_amdgcn_update_dpp(0, __builtin_bit_cast(int, x), CTRL, 0xf, 0xf, true)); }
template <int SH> __device__ __forceinline__ void pool_step(float (&c)[8], float (&p)[8], float mk) {
#pragma unroll
    for (int j = 0; j < 8; ++j) { const float nc = c[j] + dppf<0x110 + SH>(c[j]) + mk * dppf<0x120 + SH>(p[j]);
        p[j] = p[j] + dppf<0x110 + SH>(p[j]); c[j] = nc; }
}
__device__ __forceinline__ void pool_phase(Frame& F, int l) {
    const int gw = F.vcu * NWAVES + F.wave, NGW = F.G * NWAVES, lane = F.lane, lr = lane & 15, lq = lane >> 4;
    LAS bf16_t* PW = (LAS bf16_t*)F.lds; LAS float* PS = (LAS float*)(F.lds + PL_SC);
    wg_sync();
    for (int i = F.tid; i < 4 * 128 * 16; i += NWAVES * 64) { const int rowi = i >> 4, ch = i & 15; *(LAS u32x4*)(PW + rowi * PWP + 8 * ch) = *(const u32x4*)(F.poolw_t() + (size_t)rowi * 128 + 8 * ch); }
    if (F.tid < 128) *(LAS f32x4*)(PS + 4 * F.tid) = *(const f32x4*)(F.pool_scale() + (size_t)l * BW + 4 * F.tid);
    lds_sync();
    const int g = gw & 3, win = 2 << g;
    const int erow = 8 * (lr >> 2) + (lr & 3);
    for (int unit = gw; unit < BATCH * (SEQ / 16) * 4; unit += NGW) {
        const int tile = (unit >> 2) & 255, b = unit >> 10; const int tpos = 16 * tile + lr; const size_t row = (size_t)b * SEQ + tpos;
        const bf16_t* pp = F.PROJ() + row * LDP + C_PU + g * 128 + 8 * lq;
        u32x4 cur[4], prv[4];
#pragma unroll
        for (int ks = 0; ks < 4; ++ks) { cur[ks] = *(const u32x4*)(pp + 32 * ks); prv[ks] = (u32x4){0u, 0u, 0u, 0u}; }
        if (tile > 0) {
#pragma unroll
            for (int ks = 0; ks < 4; ++ks) prv[ks] = *(const u32x4*)(pp - (size_t)16 * LDP + 32 * ks); }
        const float inv = 1.0f / (float)min(tpos + 1, win);
        const float mk1 = lr < 1 ? 1.f : 0.f, mk2 = lr < 2 ? 1.f : 0.f, mk4 = lr < 4 ? 1.f : 0.f, mk8 = lr < 8 ? 1.f : 0.f;
        bf16x8 mf[4];
#pragma unroll
        for (int ks = 0; ks < 4; ++ks) { float a[8], c[8], p[8], m[8]; unpack8(cur[ks], a); unpack8(prv[ks], p);
#pragma unroll
            for (int j = 0; j < 8; ++j) c[j] = a[j];
            pool_step<1>(c, p, mk1);
            if (win > 2) pool_step<2>(c, p, mk2);
            if (win > 4) pool_step<4>(c, p, mk4);
            if (win > 8) pool_step<8>(c, p, mk8);
#pragma unroll
            for (int j = 0; j < 8; ++j) m[j] = c[j] * inv - a[j];
            const u32x4 w = pack8(m); mf[ks] = __builtin_bit_cast(bf16x8, w); }
        bf16_t* yp = F.Y() + row * D + 1536 + g * 128 + 8 * lq;
        int woff = (g * 128 + erow) * PWP + 8 * lq; asm volatile("" : "+v"(woff));
#pragma unroll
        for (int pe = 0; pe < 4; ++pe) { f32x4 acc[2];
#pragma unroll
            for (int hh = 0; hh < 2; ++hh) { acc[hh] = (f32x4){0.f, 0.f, 0.f, 0.f}; const LAS bf16_t* wr_ = PW + woff + (32 * pe + 4 * hh) * PWP;
#pragma unroll
                for (int ks = 0; ks < 4; ++ks) acc[hh] = __builtin_amdgcn_mfma_f32_16x16x32_bf16(*(const LAS bf16x8*)(wr_ + 32 * ks), mf[ks], acc[hh], 0, 0, 0); }
            const f32x4 s0 = *(const LAS f32x4*)(PS + g * 128 + 32 * pe + 8 * lq), s1 = *(const LAS f32x4*)(PS + g * 128 + 32 * pe + 8 * lq + 4);
            u32x4 w; w.x = pk2(acc[0][0] * s0.x, acc[0][1] * s0.y); w.y = pk2(acc[0][2] * s0.z, acc[0][3] * s0.w); w.z = pk2(acc[1][0] * s1.x, acc[1][1] * s1.y); w.w = pk2(acc[1][2] * s1.z, acc[1][3] * s1.w);
            *(u32x4*)(yp + 32 * pe) = w; }
    }
}

__device__ __forceinline__ void conv_fix_phase(Frame& F, int l) {
    const float* cw = F.conv_w() + (size_t)l * 3 * NUP; const float* cb = F.conv_b() + (size_t)l * NUP; const float* UH = F.UH();
    const int gt = F.vcu * (NWAVES * 64) + F.tid, NGT = F.G * NWAVES * 64;
    constexpr int JG = DFF / 4;
    for (int task = gt; task < (M / 256) * 2 * JG; task += NGT) {
        const int jg = task % JG, q = (task / JG) & 1, pm = task / (2 * JG);
        if ((pm & 15) == 0) continue;
        const int j0 = jg * 4, ucol = 256 * (j0 >> 7) + (j0 & 127);
        const float* u0p = UH + ((size_t)pm * 4 + q) * NUP + ucol;
        const float* u1p = (q == 1) ? UH + ((size_t)pm * 4 + 0) * NUP + ucol : UH + ((size_t)(pm - 1) * 4 + 3) * NUP + ucol;
        const float* u2p = (q == 1) ? UH + ((size_t)(pm - 1) * 4 + 3) * NUP + ucol : UH + ((size_t)(pm - 1) * 4 + 2) * NUP + ucol;
        const f32x4 a0 = *(const f32x4*)u0p, a1 = *(const f32x4*)u1p, a2 = *(const f32x4*)u2p, v0 = *(const f32x4*)(u0p + 128), v1 = *(const f32x4*)(u1p + 128), v2 = *(const f32x4*)(u2p + 128);
        const f32x4 wa0 = *(const f32x4*)(cw + j0), wa1 = *(const f32x4*)(cw + NUP + j0), wa2 = *(const f32x4*)(cw + 2 * NUP + j0), ba = *(const f32x4*)(cb + j0);
        const f32x4 wv0 = *(const f32x4*)(cw + DFF + j0), wv1 = *(const f32x4*)(cw + NUP + DFF + j0), wv2 = *(const f32x4*)(cw + 2 * NUP + DFF + j0), bv = *(const f32x4*)(cb + DFF + j0);
        float o[4];
#pragma unroll
        for (int i = 0; i < 4; ++i) { const float ca = ba[i] + wa0[i] * a2[i] + wa1[i] * a1[i] + wa2[i] * a0[i], cv = bv[i] + wv0[i] * v2[i] + wv1[i] * v1[i] + wv2[i] * v0[i]; o[i] = siluf_(ca) * cv; }
        u32x2 w; w.x = pk2(o[0], o[1]); w.y = pk2(o[2], o[3]);
        *(u32x2*)(F.ACT() + ((size_t)pm * 256 + q) * DFF + j0) = w;
    }
}

constexpr int NPH = 13;
struct Args { const void* in[25]; float* out; unsigned char* ws; int l_lo, l_hi, ph_lo, ph_hi, single, pad; };
__global__ void __launch_bounds__(NWAVES * 64, 2) hybrid_fwd(Args args) {
    extern __shared__ __attribute__((aligned(16))) unsigned char lds[];
    Frame F;
    F.lds = (LAS unsigned char*)lds;
    F.tid = threadIdx.x; F.lane = F.tid & 63; F.wave = __builtin_amdgcn_readfirstlane(F.tid >> 6);
    const int wave0 = F.wave;
    F.G = gridDim.x; { const int bx = blockIdx.x; F.vcu = (F.G % 8 == 0) ? (bx % 8) * (F.G / 8) + bx / 8 : bx; }
    unsigned char* ws = args.ws; F.ws = ws; F.out = args.out; F.l = 0;

    volatile LAS unsigned* MISC = (volatile LAS unsigned*)(F.lds + MISC_OFF);
    if (F.tid < 64) MISC[F.tid] = 0u;
    wg_sync();
    unsigned* ctl = (unsigned*)(ws + WS_CTL);
    XcdBarrier bar; bar.bar = ctl + CW_BAR; bar.x = 0; bar.st = nullptr;
    if (args.single) bar = xcd_barrier_post(ctl + CW_BAR, MISC);
#define GRID_BAR() do { if (args.single) xcd_barrier(bar); } while (0)
    const int lo = args.ph_lo, hi = args.ph_hi;
#define IN(k) (lo <= (k) && (k) < hi)
#define PH_BEGIN() do { unsigned z_ = 0u; asm volatile("" : "+v"(z_)); const int ln_ = (int)__builtin_amdgcn_mbcnt_hi(~0u, __builtin_amdgcn_mbcnt_lo(~0u, z_)); F.lane = ln_; F.tid = wave0 * 64 + ln_; F.wave = wave0; unsigned long long w_ = (unsigned long long)args.ws, o_ = (unsigned long long)args.out; asm volatile("" : "+s"(w_), "+s"(o_)); F.ws = (unsigned char*)(GAS unsigned char*)w_; F.out = (float*)(GAS float*)o_; } while (0)

    for (int l = args.l_lo; l < args.l_hi; ++l) {
        F.l = l;
        if (IN(0)) { PH_BEGIN(); phase_prep(F, l); GRID_BAR(); }
        if (IN(1)) { PH_BEGIN();
            { pg8::Gemm g{(const bf16_t*)F.HN8(), (const bf16_t*)F.W8(), M, 4 * D, D / 2, D / 2, D / 2}; pg8::StaticOrder S; S.init(M, 4 * D, F.G, (int)blockIdx.x); pg8::EpiProj E{F.PROJ(), LDP, 0, F.GF(), 1.0f / 64.0f};
              pg8::gemm_phase<pg8::EpiProj, true>(F.lds, g, S, E, F.tid); }
            PH_BEGIN();
            { pg8::Gemm g{F.HN(), F.win_t(), M, C_GR, D, D, D}; pg8::StaticOrder S; S.init(M, C_GR, F.G, (int)blockIdx.x); pg8::EpiProj E{F.PROJ(), LDP, 1 << 20, F.GF(), 1.0f};
              pg8::gemm_phase(F.lds, g, S, E, F.tid); }
            PH_BEGIN(); gr_pass(F);
            GRID_BAR(); }
        if (IN(2)) { PH_BEGIN(); lin2_phase<false>(F, l); PH_BEGIN();
            s5_pass<false>(F, l); pool_phase(F, l); wg_sync();
            GRID_BAR(); }
        if (IN(3)) { PH_BEGIN(); lin_scan(F); s5_scan(F); GRID_BAR(); }
        if (IN(4)) { PH_BEGIN(); lin2_phase<true>(F, l); PH_BEGIN();
            s5_pass<true>(F, l); wg_sync();
            GRID_BAR(); }
        if (IN(5)) { PH_BEGIN(); pg8::Gemm g{F.YBP(), F.wglu_t(), M, BW, BW, BW, BW}; pg8::StaticOrder S; S.init(M, BW, F.G, (int)blockIdx.x); pg8::EpiGlu E{F.YBP(), BW, F.Y() + BW, D};
            pg8::gemm_phase(F.lds, g, S, E, F.tid); GRID_BAR(); }
        if (IN(6)) { PH_BEGIN(); for (int i = 0; i < (F.vcu & 7); ++i) __builtin_amdgcn_s_sleep(56);
            pg8::Gemm g{F.Y(), F.wbr_t(), M, D, D, D, D}; pg8::StaticOrder S; S.init(M, D, F.G, (int)blockIdx.x); pg8::EpiMerge E{F.GF(), F.HN(), D};
            pg8::gemm_phase(F.lds, g, S, E, F.tid); GRID_BAR(); }
        if (IN(7)) { PH_BEGIN(); for (int i = 0; i < (F.vcu & 7); ++i) __builtin_amdgcn_s_sleep(50);
            pg8::Gemm g{F.HN(), F.wout_t(), M, D, D, D, D}; pg8::StaticOrder S; S.init(M, D, F.G, (int)blockIdx.x); pg8::EpiResid E{l == 0 ? (const void*)F.x() : (const void*)F.out, l == 0 ? 1 : 0, F.Y(), D, F.SS()};
            pg8::gemm_phase(F.lds, g, S, E, F.tid); GRID_BAR(); }
        if (IN(8)) { PH_BEGIN(); row_scale(F); GRID_BAR(); }
        if (IN(9)) { PH_BEGIN(); pg8::Gemm g{F.Y(), F.wup_t(), M, NUP, D, D, D}; pg8::StaticOrder S; S.init(M, NUP, F.G, (int)blockIdx.x); pg8::EpiConv E{F.conv_w() + (size_t)l * 3 * NUP, F.conv_b() + (size_t)l * NUP, F.ACT(), F.UH(), (LAS float*)(F.lds + pg8::STAGE_BYTES), F.RS()};
            pg8::gemm_phase(F.lds, g, S, E, F.tid); GRID_BAR(); }
        if (IN(10)) { PH_BEGIN(); conv_fix_phase(F, l); GRID_BAR(); }
        if (IN(11)) { PH_BEGIN(); for (int i = 0; i < (F.vcu & 7); ++i) __builtin_amdgcn_s_sleep(50);
            pg8::Gemm g{F.ACT(), F.wdn_t(), M, D, DFF, DFF, DFF}; pg8::StaticOrder S; S.init(M, D, F.G, (int)blockIdx.x); pg8::EpiResid E{(const void*)F.Y(), 0, l == DEPTH - 1 ? F.HN() : (bf16_t*)F.out, D, nullptr};
            pg8::gemm_phase(F.lds, g, S, E, F.tid); GRID_BAR(); }
        if (IN(12) && l == DEPTH - 1) { PH_BEGIN(); rms_rows16_to_f32(F, F.HN(), F.g_final(), F.out); }
    }
#undef IN
#undef PH_BEGIN
#undef GRID_BAR
}

#pragma clang attribute pop
extern "C" void kernel_launch(void* const* d_in, const int* in_sizes, int n_in, void* d_out, int out_size, void* d_ws, size_t ws_size, hipStream_t stream) {
    static int grid = 0;
    if (grid == 0) {
        if (n_in != 25 || in_sizes[0] != M * D || out_size != M * D || ws_size < WS_END) { fprintf(stderr, "kernel_launch: shape/workspace mismatch (n_in %d, in0 %d, out %d, ws %zu, need %zu); nothing launched\n", n_in, n_in > 0 ? in_sizes[0] : -1, out_size, ws_size, (size_t)WS_END); grid = -1; return; }
        int dev = 0, cus = 0, per_cu = 0;
        if (hipGetDevice(&dev) != hipSuccess || hipDeviceGetAttribute(&cus, hipDeviceAttributeMultiprocessorCount, dev) != hipSuccess) { grid = -1; return; }
        if (hipFuncSetAttribute((const void*)hybrid_fwd, hipFuncAttributeMaxDynamicSharedMemorySize, LDS_BYTES) != hipSuccess) { fprintf(stderr, "kernel_launch: hipFuncSetAttribute failed\n"); grid = -1; return; }
        if (hipOccupancyMaxActiveBlocksPerMultiprocessor(&per_cu, (const void*)hybrid_fwd, NWAVES * 64, LDS_BYTES) != hipSuccess || per_cu < 1) { fprintf(stderr, "kernel_launch: occupancy query reports %d workgroups per CU\n", per_cu); }
        (void)hipGetLastError();
        if (cus < 256) { fprintf(stderr, "kernel_launch: built for a 256-CU device (found %d CUs); nothing launched\n", cus); grid = -1; return; }
        grid = 256;
    }
    if (grid < 0) return;
    if (hipMemsetAsync((char*)d_ws + WS_CTL, 0, CTL_ZERO_BYTES, stream) != hipSuccess) return;
    Args a{};
    for (int i = 0; i < 25; ++i) a.in[i] = d_in[i];
    a.out = (float*)d_out; a.ws = (unsigned char*)d_ws;
#if MK_SINGLE
    a.l_lo = 0; a.l_hi = DEPTH; a.ph_lo = 0; a.ph_hi = NPH; a.single = 1;
    hipLaunchKernelGGL(hybrid_fwd, dim3(grid), dim3(NWAVES * 64), LDS_BYTES, stream, a);
#else
    a.single = 0;
    for (int l = 0; l < DEPTH; ++l)
        for (int p = 0; p < NPH; ++p) { if (p == 12 && l != DEPTH - 1) continue; a.l_lo = l; a.l_hi = l + 1; a.ph_lo = p; a.ph_hi = p + 1;
            hipLaunchKernelGGL(hybrid_fwd, dim3(grid), dim3(NWAVES * 64), LDS_BYTES, stream, a); }
#endif
}
```

```cpp
#include <hip/hip_runtime.h>
#include <cstdio>
#include <cstdint>

#ifndef MK_SINGLE
#define MK_SINGLE 1
#endif

#pragma clang attribute push(__attribute__((target("no-packed-fp32-ops"))), apply_to = function)
#define LAS __attribute__((address_space(3)))
#define GAS __attribute__((address_space(1)))
typedef unsigned short bf16_t;
typedef short bf16x8 __attribute__((ext_vector_type(8)));
typedef float f32x4 __attribute__((ext_vector_type(4)));
typedef float f32x2 __attribute__((ext_vector_type(2)));
typedef unsigned u32x4 __attribute__((ext_vector_type(4)));
typedef unsigned u32x2 __attribute__((ext_vector_type(2)));

constexpr int D = 2048, BATCH = 8, SEQ = 4096, DEPTH = 4, M = BATCH * SEQ;
constexpr int BW = 512;
constexpr int NIN_SRC = 12304, NIN = 12544;
constexpr int DFF = 5504, NUP = 11008;
constexpr int C_RQ = 0, C_RK = 256, C_RV = 512, C_RG = 1024, C_SU = 1536, C_GQ = 2048, C_GK = 2304, C_GV = 2560, C_GG = 3072, C_PU = 3584, C_GR = 4096, C_GATE = 4352;
constexpr int LDP = 4224;
constexpr float EPS = 1e-6f;
constexpr int NWAVES = 8;
constexpr int CH = 64;
constexpr int NCH = SEQ / CH;

constexpr size_t MiB = 1u << 20;
constexpr size_t WS_CTL = 0, CTL_ZERO_BYTES = 1 * MiB;
constexpr size_t WS_ROT = 1 * MiB;
constexpr size_t WS_S5T = 9 * MiB;
constexpr size_t S5T_ABAR = 0, S5T_APOW = 16384, S5T_BBAR = 32768, S5T_CMT = 32768 + 262144, S5T_BBT = S5T_CMT + 131072;
constexpr size_t WS_WGLU = 10 * MiB;
constexpr size_t WS_POOLW = 10 * MiB + 512 * 1024;
constexpr size_t WS_WIN = 11 * MiB;
constexpr size_t WS_WBR = 60 * MiB;
constexpr size_t WS_WOUT = 68 * MiB;
constexpr size_t WS_WUP = 76 * MiB;
constexpr size_t WS_WDN = 119 * MiB;
constexpr size_t WS_HN = 141 * MiB;
constexpr size_t WS_Y = 269 * MiB;
constexpr size_t WS_SCR = 397 * MiB;
constexpr size_t WS_YBP = WS_SCR;
constexpr size_t WS_STATE = WS_SCR + 32 * MiB;
constexpr size_t WS_SPREV = WS_SCR + 160 * MiB;
constexpr size_t WS_DEC = WS_SCR + 224 * MiB;
constexpr size_t WS_XEND = WS_SCR + 225 * MiB;
constexpr size_t WS_UH = WS_SCR + 128 * MiB;
constexpr size_t WS_PROJ = 637 * MiB;
constexpr size_t WS_GF = WS_PROJ + 264 * MiB;
constexpr size_t WS_ACT = WS_PROJ;
constexpr size_t WS_RS = 1421 * MiB;
constexpr size_t WS_SS = 1422 * MiB;
constexpr size_t WS_HN8 = 1438 * MiB;
constexpr size_t WS_W8 = 1502 * MiB;
constexpr size_t WS_END = 1518 * MiB;
static_assert(WS_PROJ + (size_t)M * LDP * 2 <= WS_GF && WS_GF + 4 * (size_t)M * D * 2 <= WS_RS, "ws map");
static_assert(WS_ACT + (size_t)M * DFF * 2 <= WS_RS, "ws map");
static_assert(WS_XEND + 8 * MiB <= WS_PROJ, "ws map");
static_assert(WS_UH + (size_t)(M / 256) * 4 * NUP * 4 <= WS_PROJ, "ws map");
constexpr int CW_TMO = 0, CW_BAR = 4096;

constexpr int LDS_BYTES = 155648;
constexpr int MISC_OFF = LDS_BYTES - 256;

#define RLX_AGENT __ATOMIC_RELAXED, __HIP_MEMORY_SCOPE_AGENT
__device__ __forceinline__ void lds_sync() { asm volatile("s_waitcnt lgkmcnt(0)" ::: "memory"); __builtin_amdgcn_s_barrier(); asm volatile("" ::: "memory"); }
__device__ __forceinline__ void wg_sync() { __builtin_amdgcn_fence(__ATOMIC_RELEASE, "workgroup"); __builtin_amdgcn_s_barrier(); __builtin_amdgcn_fence(__ATOMIC_ACQUIRE, "workgroup"); }
#define LDS_WAIT() asm volatile("s_waitcnt lgkmcnt(0)" ::: "memory")
#define VM_WAIT() asm volatile("s_waitcnt vmcnt(0)" ::: "memory")
__device__ __forceinline__ unsigned f2bf(float f) { unsigned u = __builtin_bit_cast(unsigned, f); return (u + 0x7fffu + ((u >> 16) & 1u)) >> 16; }
__device__ __forceinline__ unsigned pk2(float lo, float hi) { return f2bf(lo) | (f2bf(hi) << 16); }
__device__ __forceinline__ float bflo(unsigned w) { return __builtin_bit_cast(float, w << 16); }
__device__ __forceinline__ float bfhi(unsigned w) { return __builtin_bit_cast(float, w & 0xffff0000u); }
__device__ __forceinline__ void unpack8(const u32x4 w, float (&v)[8]) { v[0] = bflo(w.x); v[1] = bfhi(w.x); v[2] = bflo(w.y); v[3] = bfhi(w.y); v[4] = bflo(w.z); v[5] = bfhi(w.z); v[6] = bflo(w.w); v[7] = bfhi(w.w); }
__device__ __forceinline__ u32x4 pack8(const float (&v)[8]) { u32x4 w; w.x = pk2(v[0], v[1]); w.y = pk2(v[2], v[3]); w.z = pk2(v[4], v[5]); w.w = pk2(v[6], v[7]); return w; }
__device__ __forceinline__ unsigned pk4_fp8(float a, float b, float c, float d) { unsigned w = 0u; w = __builtin_amdgcn_cvt_pk_fp8_f32(a, b, w, false); w = __builtin_amdgcn_cvt_pk_fp8_f32(c, d, w, true); return w; }
__device__ __forceinline__ float sigmoidf_(float x) { return __builtin_amdgcn_rcpf(1.0f + __expf(-x)); }
__device__ __forceinline__ float siluf_(float x) { return x * __builtin_amdgcn_rcpf(1.0f + __expf(-x)); }
__device__ __forceinline__ float gelu_tanh(float x) { const float u = 1.5957691216f * (x + 0.044715f * x * x * x); return x * __builtin_amdgcn_rcpf(1.0f + __expf(-u)); }
__device__ __forceinline__ float logsigmoidf_(float x) { return fminf(x, 0.f) - __logf(1.0f + __expf(-fabsf(x))); }

namespace pg8 {
constexpr int BM = 256, BK = 64, HALF = 128, HTB = HALF * BK * 2, STAGE_BYTES = 8 * HTB, NXCD = 8, WGM = 4;
__host__ __device__ __forceinline__ int lds_byte(int r, int c) { const int st = (r >> 4) * 2 + (c >> 5), rr = r & 15, cc = c & 31, ob = rr * 64 + cc * 2; return st * 1024 + (ob ^ (((ob >> 9) & 1) << 5)); }
__host__ __device__ __forceinline__ void stage_rc(int b, int& R, int& C) { const int st = b / 1024, sb = b % 1024, swz = sb ^ (((sb >> 9) & 1) << 5); R = (st >> 1) * 16 + swz / 64; C = (st & 1) * 32 + (swz % 64) / 2; }
__host__ __device__ __forceinline__ int perm32(int rho) { const int n = rho >> 4, i = rho & 15; return 8 * (i >> 2) + 4 * n + (i & 3); }

struct Unit { int pm, pn; };
struct Gemm { const bf16_t* A; const bf16_t* Bt; int M, N, K, lda, ldb; };

struct StaticOrder {
    int nM, nN, nwg, G, c;
    __host__ __device__ void init(int M_, int N_, int G_, int c_) { nM = M_ / BM; nN = N_ / BM; nwg = nM * nN; G = G_; c = c_; }
    __host__ __device__ bool next(int i, Unit& u) const {
        const long L = (long)i * G + c; if (L >= nwg) return false;
        int wgid = (int)L; { const int q = nwg / NXCD, r = nwg % NXCD, xcd = wgid % NXCD, off = wgid / NXCD; wgid = (xcd < r ? xcd * (q + 1) : r * (q + 1) + (xcd - r) * q) + off; }
        const int nig = WGM * nN, gid = wgid / nig, fm = gid * WGM, gsz = (nM - fm) < WGM ? (nM - fm) : WGM;
        u.pm = fm + ((wgid % nig) % gsz); u.pn = (wgid % nig) / gsz; return true;
    }
};

__device__ __forceinline__ unsigned cvt_pk_bf16(float lo, float hi) { unsigned r; asm volatile("v_cvt_pk_bf16_f32 %0, %1, %2" : "=v"(r) : "v"(lo), "v"(hi)); return r; }

struct EpiStoreBf16 {
    static constexpr bool PERM = true, KHOOK = false;
    bf16_t* O; int ldc;
    __device__ __forceinline__ void khook(f32x4 (&)[2][2][4][2], const Unit&, int, int, int, int, int) const {}
    __device__ __forceinline__ void operator()(f32x4 (&acc)[2][2][4][2], const Unit& u, int wr, int wc, int fr, int fq) const {
        const int row0 = u.pm * BM + wr * 64 + fr, col0 = u.pn * BM + wc * 32 + 8 * fq;
#pragma unroll
        for (int ai = 0; ai < 2; ++ai)
#pragma unroll
            for (int m = 0; m < 4; ++m) { bf16_t* rowp = O + (size_t)(row0 + ai * HALF + m * 16) * ldc + col0;
#pragma unroll
                for (int bj = 0; bj < 2; ++bj) { const f32x4 v0 = acc[ai][bj][m][0], v1 = acc[ai][bj][m][1];
                    u32x4 w; w.x = cvt_pk_bf16(v0[0], v0[1]); w.y = cvt_pk_bf16(v0[2], v0[3]); w.z = cvt_pk_bf16(v1[0], v1[1]); w.w = cvt_pk_bf16(v1[2], v1[3]);
                    *(u32x4*)(rowp + bj * HALF) = w; } }
    }
};
struct EpiProj {
    static constexpr bool PERM = true, KHOOK = false;
    bf16_t* O; int ldc; int gate_pn0; bf16_t* GF; float gscale;
    __device__ __forceinline__ void khook(f32x4 (&)[2][2][4][2], const Unit&, int, int, int, int, int) const {}
    __device__ __forceinline__ void operator()(f32x4 (&acc)[2][2][4][2], const Unit& u, int wr, int wc, int fr_, int fq_) const {
        int fr = fr_, fq = fq_; asm volatile("" : "+v"(fr), "+v"(fq));
        const int row0 = u.pm * BM + wr * 64 + fr;
        if (u.pn < gate_pn0) {
            const int col0 = u.pn * BM + wc * 32 + 8 * fq;
#pragma unroll
            for (int ai = 0; ai < 2; ++ai)
#pragma unroll
                for (int m = 0; m < 4; ++m) { bf16_t* rowp = O + (size_t)(row0 + ai * HALF + m * 16) * ldc + col0;
#pragma unroll
                    for (int bj = 0; bj < 2; ++bj) { const f32x4 v0 = acc[ai][bj][m][0], v1 = acc[ai][bj][m][1];
                        u32x4 w; w.x = cvt_pk_bf16(v0[0], v0[1]); w.y = cvt_pk_bf16(v0[2], v0[3]); w.z = cvt_pk_bf16(v1[0], v1[1]); w.w = cvt_pk_bf16(v1[2], v1[3]);
                        *(u32x4*)(rowp + bj * HALF) = w; } }
        } else {
            const int t = u.pn - gate_pn0, c0 = 64 * t + 16 * wc + 4 * fq;
            const float kc = -1.4426950408889634f * gscale, KL = 30.0f * 1.4426950408889634f;
            const size_t gbase = ((size_t)((u.pm * 8 + (c0 >> 8)) * 4) * 16 + ((c0 >> 7) & 1)) * 4096 + (size_t)(((wr * 4 + ((c0 >> 5) & 3)) * 64 + ((c0 >> 3) & 3) * 16 + fr) * 8 + (c0 & 7));
#pragma unroll
            for (int ai = 0; ai < 2; ++ai)
#pragma unroll
                for (int m = 0; m < 4; ++m) { bf16_t* rowp = GF + gbase + (size_t)(ai * 8 + m * 2) * 4096;
                    float r1[4], r2[4], r3[4], g3[4];
#pragma unroll
                    for (int i = 0; i < 4; ++i) {
                        const float e0 = __builtin_amdgcn_exp2f(__builtin_amdgcn_fmed3f(acc[ai][0][m][0][i] * kc, -KL, KL)), e1 = __builtin_amdgcn_exp2f(__builtin_amdgcn_fmed3f(acc[ai][0][m][1][i] * kc, -KL, KL));
                        const float e2 = __builtin_amdgcn_exp2f(__builtin_amdgcn_fmed3f(acc[ai][1][m][0][i] * kc, -KL, KL)), e3 = __builtin_amdgcn_exp2f(__builtin_amdgcn_fmed3f(acc[ai][1][m][1][i] * kc, -KL, KL));
                        const float i0 = __builtin_amdgcn_rcpf(1.f + e0), i1 = __builtin_amdgcn_rcpf(1.f + e1), i2 = __builtin_amdgcn_rcpf(1.f + e2), i3 = __builtin_amdgcn_rcpf(1.f + e3);
                        r1[i] = (1.f + e1) * i0; r2[i] = (1.f + e2) * i1; r3[i] = (1.f + e3) * i2; g3[i] = i3; }
                    u32x2 w;
                    w.x = cvt_pk_bf16(r1[0], r1[1]); w.y = cvt_pk_bf16(r1[2], r1[3]); *(u32x2*)(rowp) = w;
                    w.x = cvt_pk_bf16(r2[0], r2[1]); w.y = cvt_pk_bf16(r2[2], r2[3]); *(u32x2*)(rowp + 16 * 4096) = w;
                    w.x = cvt_pk_bf16(r3[0], r3[1]); w.y = cvt_pk_bf16(r3[2], r3[3]); *(u32x2*)(rowp + 2 * 16 * 4096) = w;
                    w.x = cvt_pk_bf16(g3[0], g3[1]); w.y = cvt_pk_bf16(g3[2], g3[3]); *(u32x2*)(rowp + 3 * 16 * 4096) = w; }
        }
    }
};
__device__ __forceinline__ float dpp_ror1(float x) { return __builtin_bit_cast(float, __builtin_amdgcn_update_dpp(0, __builtin_bit_cast(int, x), 0x121, 0xf, 0xf, true)); }
__device__ __forceinline__ float dpp_ror2(float x) { return __builtin_bit_cast(float, __builtin_amdgcn_update_dpp(0, __builtin_bit_cast(int, x), 0x122, 0xf, 0xf, true)); }
struct EpiConv {
    static constexpr bool PERM = true, KHOOK = false;
    const float* cw; const float* cb; bf16_t* O; float* UH; LAS float* halo; const float* RS;
    __device__ __forceinline__ void khook(f32x4 (&)[2][2][4][2], const Unit&, int, int, int, int, int) const {}
    __device__ __forceinline__ void operator()(f32x4 (&acc)[2][2][4][2], const Unit& u, int wr, int wc, int fr_, int fq_) const {
        int fr = fr_, fq = fq_; asm volatile("" : "+v"(fr), "+v"(fq));
        const int cl0 = wc * 32 + 8 * fq;
        const int j0 = 128 * u.pn + cl0;
        const float* rp = RS + ((size_t)(u.pm * 2 + wr) * 16 + fr) * 8; const f32x4 rs0 = *(const f32x4*)rp, rs1 = *(const f32x4*)(rp + 4);
        f32x4 wa0[3], wv0[3];
#pragma unroll
        for (int q = 0; q < 3; ++q) { wa0[q] = *(const f32x4*)(cw + q * NUP + j0); wv0[q] = *(const f32x4*)(cw + q * NUP + DFF + j0); }
        const f32x4 ba0 = *(const f32x4*)(cb + j0), bv0 = *(const f32x4*)(cb + DFF + j0);
#pragma unroll
        for (int ai = 0; ai < 2; ++ai)
#pragma unroll
            for (int m = 0; m < 4; ++m) { const float r = ai == 0 ? rs0[m] : rs1[m];
#pragma unroll
                for (int bj = 0; bj < 2; ++bj)
#pragma unroll
                    for (int n = 0; n < 2; ++n) acc[ai][bj][m][n] *= r; }
        if (fr >= 14) {
#pragma unroll
            for (int ai = 0; ai < 2; ++ai)
#pragma unroll
                for (int bj = 0; bj < 2; ++bj)
#pragma unroll
                    for (int n = 0; n < 2; ++n) *(LAS f32x4*)(halo + (((2 * ai + wr) * 2 + (fr - 14)) * 256 + 128 * bj + cl0 + 4 * n)) = acc[ai][bj][3][n];
        }
        if (wr == 0 && fr < 2) {
#pragma unroll
            for (int bj = 0; bj < 2; ++bj)
#pragma unroll
                for (int n = 0; n < 2; ++n) *(f32x4*)(UH + ((size_t)u.pm * 4 + fr) * NUP + 256 * u.pn + 128 * bj + cl0 + 4 * n) = acc[0][bj][0][n];
        }
        if (wr == 1 && fr >= 14) {
#pragma unroll
            for (int bj = 0; bj < 2; ++bj)
#pragma unroll
                for (int n = 0; n < 2; ++n) *(f32x4*)(UH + ((size_t)u.pm * 4 + 2 + (fr - 14)) * NUP + 256 * u.pn + 128 * bj + cl0 + 4 * n) = acc[1][bj][3][n];
        }
        asm volatile("s_waitcnt lgkmcnt(0)" ::: "memory"); __builtin_amdgcn_s_barrier(); asm volatile("" ::: "memory");
        const bool is15 = fr == 15, ge14 = fr >= 14;
        unsigned keep[2][4][2];
        f32x4 wa1[3], wv1[3];
#pragma unroll
        for (int q = 0; q < 3; ++q) { wa1[q] = *(const f32x4*)(cw + q * NUP + j0 + 4); wv1[q] = *(const f32x4*)(cw + q * NUP + DFF + j0 + 4); }
        const f32x4 ba1 = *(const f32x4*)(cb + j0 + 4), bv1 = *(const f32x4*)(cb + DFF + j0 + 4);
#pragma unroll
        for (int n = 0; n < 2; ++n) {
            f32x4 wa[3], wv[3];
#pragma unroll
            for (int q = 0; q < 3; ++q) { wa[q] = n == 0 ? wa0[q] : wa1[q]; wv[q] = n == 0 ? wv0[q] : wv1[q]; }
            const f32x4 ba = n == 0 ? ba0 : ba1, bv = n == 0 ? bv0 : bv1;
#pragma unroll
            for (int ai = 0; ai < 2; ++ai) {
                const int blk = 2 * ai + wr;
                f32x4 pa = (f32x4){0.f, 0.f, 0.f, 0.f}, pv = (f32x4){0.f, 0.f, 0.f, 0.f};
                if (blk > 0 && ge14) { pa = *(const LAS f32x4*)(halo + (((blk - 1) * 2 + (fr - 14)) * 256 + cl0 + 4 * n)); pv = *(const LAS f32x4*)(halo + (((blk - 1) * 2 + (fr - 14)) * 256 + 128 + cl0 + 4 * n)); }
#pragma unroll
                for (int m = 0; m < 4; ++m) {
                    const f32x4 ca_ = acc[ai][0][m][n], cv_ = acc[ai][1][m][n]; float o[4];
#pragma unroll
                    for (int i = 0; i < 4; ++i) {
                        const float a1 = dpp_ror1(is15 ? pa[i] : ca_[i]), a2 = dpp_ror2(ge14 ? pa[i] : ca_[i]);
                        const float v1 = dpp_ror1(is15 ? pv[i] : cv_[i]), v2 = dpp_ror2(ge14 ? pv[i] : cv_[i]);
                        const float ca = ba[i] + wa[0][i] * a2 + wa[1][i] * a1 + wa[2][i] * ca_[i];
                        const float cv = bv[i] + wv[0][i] * v2 + wv[1][i] * v1 + wv[2][i] * cv_[i];
                        o[i] = siluf_(ca) * cv; }
                    pa = ca_; pv = cv_;
                    const unsigned lo = cvt_pk_bf16(o[0], o[1]), hi = cvt_pk_bf16(o[2], o[3]);
                    if (n == 0) { keep[ai][m][0] = lo; keep[ai][m][1] = hi; }
                    else { u32x4 w; w.x = keep[ai][m][0]; w.y = keep[ai][m][1]; w.z = lo; w.w = hi;
                        *(u32x4*)(O + (size_t)(u.pm * BM + ai * HALF + wr * 64 + m * 16 + fr) * DFF + j0) = w; }
                }
            }
        }
    }
};
struct EpiResid {
    static constexpr bool PERM = true, KHOOK = false;
    const void* base; int base_f32; bf16_t* O; int ldc; float* SS;
    __device__ __forceinline__ void khook(f32x4 (&)[2][2][4][2], const Unit&, int, int, int, int, int) const {}
    __device__ __forceinline__ void finish(const float (&b)[8], const f32x4 v0, const f32x4 v1, bf16_t* op, float& sq) const {
        const float o0 = b[0] + v0[0], o1 = b[1] + v0[1], o2 = b[2] + v0[2], o3 = b[3] + v0[3], o4 = b[4] + v1[0], o5 = b[5] + v1[1], o6 = b[6] + v1[2], o7 = b[7] + v1[3];
        u32x4 w; w.x = cvt_pk_bf16(o0, o1); w.y = cvt_pk_bf16(o2, o3); w.z = cvt_pk_bf16(o4, o5); w.w = cvt_pk_bf16(o6, o7);
        *(u32x4*)op = w;
        sq += ((o0 * o0 + o1 * o1) + (o2 * o2 + o3 * o3)) + ((o4 * o4 + o5 * o5) + (o6 * o6 + o7 * o7));
    }
    __device__ __forceinline__ void rowsum(float sq, const Unit& u, int wc, int fq, int lane, int row) const {
        sq += __builtin_bit_cast(float, __builtin_amdgcn_ds_bpermute((lane ^ 16) << 2, __builtin_bit_cast(int, sq)));
        sq += __builtin_bit_cast(float, __builtin_amdgcn_ds_bpermute((lane ^ 32) << 2, __builtin_bit_cast(int, sq)));
        if (fq == 0) SS[(size_t)(u.pn * 4 + wc) * M + row] = sq;
    }
    __device__ __forceinline__ void operator()(f32x4 (&acc)[2][2][4][2], const Unit& u, int wr, int wc, int fr_, int fq_) const {
        int fr = fr_, fq = fq_; asm volatile("" : "+v"(fr), "+v"(fq));
        const int row0 = u.pm * BM + wr * 64 + fr, col0 = u.pn * BM + wc * 32 + 8 * fq, lane = fq * 16 + fr;
        if (!base_f32) {
            u32x4 bw[2][4][2];
#pragma unroll
            for (int ai = 0; ai < 2; ++ai)
#pragma unroll
                for (int m = 0; m < 4; ++m)
#pragma unroll
                    for (int bj = 0; bj < 2; ++bj) bw[ai][m][bj] = *(const u32x4*)((const bf16_t*)base + (size_t)(row0 + ai * HALF + m * 16) * ldc + col0 + bj * HALF);
#pragma unroll
            for (int ai = 0; ai < 2; ++ai)
#pragma unroll
                for (int m = 0; m < 4; ++m) { const size_t off = (size_t)(row0 + ai * HALF + m * 16) * ldc + col0; float sq = 0.f;
#pragma unroll
                    for (int bj = 0; bj < 2; ++bj) { float b[8]; unpack8(bw[ai][m][bj], b); finish(b, acc[ai][bj][m][0], acc[ai][bj][m][1], O + off + bj * HALF, sq); }
                    if (SS) rowsum(sq, u, wc, fq, lane, row0 + ai * HALF + m * 16); }
        } else {
#pragma unroll
            for (int ai = 0; ai < 2; ++ai)
#pragma unroll
                for (int m = 0; m < 4; ++m) { const size_t off = (size_t)(row0 + ai * HALF + m * 16) * ldc + col0; float sq = 0.f;
#pragma unroll
                    for (int bj = 0; bj < 2; ++bj) { float b[8]; const float* bp = (const float*)base + off + bj * HALF; const f32x4 b0 = *(const f32x4*)bp, b1 = *(const f32x4*)(bp + 4);
                        b[0] = b0.x; b[1] = b0.y; b[2] = b0.z; b[3] = b0.w; b[4] = b1.x; b[5] = b1.y; b[6] = b1.z; b[7] = b1.w;
                        finish(b, acc[ai][bj][m][0], acc[ai][bj][m][1], O + off + bj * HALF, sq); }
                    if (SS) rowsum(sq, u, wc, fq, lane, row0 + ai * HALF + m * 16);
                    asm volatile("" ::: "memory"); }
        }
    }
};
struct EpiGlu {
    static constexpr bool PERM = true, KHOOK = false;
    const bf16_t* Yp; int ldy; bf16_t* O; int ldc;
    __device__ __forceinline__ void khook(f32x4 (&)[2][2][4][2], const Unit&, int, int, int, int, int) const {}
    __device__ __forceinline__ void operator()(f32x4 (&acc)[2][2][4][2], const Unit& u, int wr, int wc, int fr, int fq) const {
        const int row0 = u.pm * BM + wr * 64 + fr, col0 = u.pn * BM + wc * 32 + 8 * fq;
#pragma unroll
        for (int ai = 0; ai < 2; ++ai)
#pragma unroll
            for (int m = 0; m < 4; ++m) { const size_t r = (size_t)(row0 + ai * HALF + m * 16);
#pragma unroll
                for (int bj = 0; bj < 2; ++bj) { const u32x4 yw = *(const u32x4*)(Yp + r * ldy + col0 + bj * HALF); float y[8]; unpack8(yw, y);
                    const f32x4 v0 = acc[ai][bj][m][0], v1 = acc[ai][bj][m][1]; float o[8];
#pragma unroll
                    for (int j = 0; j < 4; ++j) { o[j] = y[j] * sigmoidf_(v0[j]); o[4 + j] = y[4 + j] * sigmoidf_(v1[j]); }
                    u32x4 w; w.x = cvt_pk_bf16(o[0], o[1]); w.y = cvt_pk_bf16(o[2], o[3]); w.z = cvt_pk_bf16(o[4], o[5]); w.w = cvt_pk_bf16(o[6], o[7]);
                    *(u32x4*)(O + r * ldc + col0 + bj * HALF) = w; } }
    }
};
struct EpiMerge {
    static constexpr bool PERM = true, KHOOK = true;
    const bf16_t* G; bf16_t* O; int ldc;
    __device__ __forceinline__ void scale(f32x4 (&acc)[2][2][4][2], const Unit& u, int s, int wr, int wc, int fr, int fq) const {
        int toff = ((wr * 4 + wc) * 64 + fq * 16 + fr) * 8; asm volatile("" : "+v"(toff));
        const bf16_t* gb = G + (size_t)(((u.pm * 8 + u.pn) * 4 + s) * 16) * 4096 + toff;
        u32x4 w[2][4][2];
#pragma unroll
        for (int ai = 0; ai < 2; ++ai)
#pragma unroll
            for (int m = 0; m < 4; ++m) {
#pragma unroll
                for (int bj = 0; bj < 2; ++bj) w[ai][m][bj] = *(const u32x4*)(gb + (size_t)(ai * 8 + m * 2 + bj) * 4096); }
#pragma unroll
        for (int ai = 0; ai < 2; ++ai)
#pragma unroll
            for (int m = 0; m < 4; ++m)
#pragma unroll
                for (int bj = 0; bj < 2; ++bj) { float f[8]; unpack8(w[ai][m][bj], f);
#pragma unroll
                    for (int j = 0; j < 8; ++j) acc[ai][bj][m][j >> 2][j & 3] *= f[j]; }
    }
    __device__ __forceinline__ void khook(f32x4 (&acc)[2][2][4][2], const Unit& u, int seg, int wr, int wc, int fr, int fq) const { scale(acc, u, seg - 1, wr, wc, fr, fq); }
    __device__ __forceinline__ void operator()(f32x4 (&acc)[2][2][4][2], const Unit& u, int wr, int wc, int fr, int fq) const {
        scale(acc, u, 3, wr, wc, fr, fq);
        const int row0 = u.pm * BM + wr * 64 + fr, col0 = u.pn * BM + wc * 32 + 8 * fq;
#pragma unroll
        for (int ai = 0; ai < 2; ++ai)
#pragma unroll
            for (int m = 0; m < 4; ++m) { bf16_t* rowp = O + (size_t)(row0 + ai * HALF + m * 16) * ldc + col0;
#pragma unroll
                for (int bj = 0; bj < 2; ++bj) { const f32x4 v0 = acc[ai][bj][m][0], v1 = acc[ai][bj][m][1];
                    u32x4 w; w.x = cvt_pk_bf16(v0[0], v0[1]); w.y = cvt_pk_bf16(v0[2], v0[3]); w.z = cvt_pk_bf16(v1[0], v1[1]); w.w = cvt_pk_bf16(v1[2], v1[3]);
                    *(u32x4*)(rowp + bj * HALF) = w; } }
    }
};

typedef int v4i_t __attribute__((ext_vector_type(4)));
typedef int v8i_t __attribute__((ext_vector_type(8)));
template <class Epi, bool F8 = false>
__device__ __forceinline__ void gemm_phase(LAS unsigned char* lds, const Gemm g, const StaticOrder& S, const Epi& E, int tid_in) {
    int tid_ = tid_in; asm volatile("" : "+v"(tid_));
    const int tid = tid_, wid = __builtin_amdgcn_readfirstlane(tid >> 6), lane = tid & 63, wr = wid >> 2, wc = wid & 3, fr = lane & 15, fq = lane >> 4;
    const int K = g.K, nt = K / BK;
    unsigned voffA[2], voffB[2];
#pragma unroll
    for (int i = 0; i < 2; ++i) { int R, C; stage_rc(tid * 16 + i * 8192, R, C); const int Rb = Epi::PERM ? ((R & ~31) + perm32(R & 31)) : R;
        voffA[i] = (unsigned)(R * g.lda + C) * 2u; voffB[i] = (unsigned)(Rb * g.ldb + C) * 2u; }
    const size_t kstep = (size_t)(BK * 2);
    const size_t hstepA = (size_t)HALF * g.lda * 2, hstepB = (size_t)HALF * g.ldb * 2;
    const size_t tstepA = 2 * hstepA, tstepB = 2 * hstepB;
    const unsigned ldsw = (unsigned)wid * 1024u;
    const int aoff = lds_byte(wr * 64 + fr, fq * 8), boff = lds_byte(wc * 32 + fr, fq * 8);
#define PG8_SA(b, h) (((b) * 2 + (h)) * HTB)
#define PG8_SB(b, h) ((4 + (b) * 2 + (h)) * HTB)
#define PG8_STAGE(bufoff, gbase, voff) do { _Pragma("unroll") for (int _i = 0; _i < 2; ++_i) \
        __builtin_amdgcn_global_load_lds((const unsigned*)((const char*)(gbase) + (voff)[_i]), (LAS unsigned*)(lds + (bufoff) + ldsw + _i * 8192), 16, 0, 0); } while (0)
#define PG8_LDA(dst, b, h) do { _Pragma("unroll") for (int m = 0; m < 4; ++m) _Pragma("unroll") for (int k = 0; k < 2; ++k) dst[m][k] = *(const LAS bf16x8*)(lds + PG8_SA(b, h) + aoff + m * 2048 + k * 1024); } while (0)
#define PG8_LDB(dst, b, h) do { _Pragma("unroll") for (int n = 0; n < 2; ++n) _Pragma("unroll") for (int k = 0; k < 2; ++k) dst[n][k] = *(const LAS bf16x8*)(lds + PG8_SB(b, h) + boff + n * 2048 + k * 1024); } while (0)
#define PG8_MMA(ai, bj, At, Bt) do { __builtin_amdgcn_s_setprio(1); _Pragma("unroll") for (int m = 0; m < 4; ++m) _Pragma("unroll") for (int n = 0; n < 2; ++n) _Pragma("unroll") for (int k = 0; k < 2; ++k) \
        acc[ai][bj][m][n] = __builtin_amdgcn_mfma_f32_16x16x32_bf16(Bt[n][k], At[m][k], acc[ai][bj][m][n], 0, 0, 0); __builtin_amdgcn_s_setprio(0); } while (0)
#define PG8_MMA16(ai, bj, At, Bt) PG8_MMA(ai, bj, At, Bt)
#define PG8_MMA8(ai, bj, A8, B8) do { __builtin_amdgcn_s_setprio(1); _Pragma("unroll") for (int m = 0; m < 4; ++m) _Pragma("unroll") for (int n = 0; n < 2; ++n) \
        asm volatile("v_mfma_f32_16x16x128_f8f6f4 %0, %1, %2, %0" : "+v"(acc[ai][bj][m][n]) : "v"(B8[n]), "v"(A8[m])); __builtin_amdgcn_s_setprio(0); } while (0)
#define PG8_LDA8(dst, b, h) do { _Pragma("unroll") for (int m = 0; m < 4; ++m) { dst[m].lo = *(const LAS v4i_t*)(lds + PG8_SA(b, h) + aoff + m * 2048); dst[m].hi = *(const LAS v4i_t*)(lds + PG8_SA(b, h) + aoff + m * 2048 + 1024); } } while (0)
#define PG8_LDB8(dst, b, h) do { _Pragma("unroll") for (int n = 0; n < 2; ++n) { dst[n].lo = *(const LAS v4i_t*)(lds + PG8_SB(b, h) + boff + n * 2048); dst[n].hi = *(const LAS v4i_t*)(lds + PG8_SB(b, h) + boff + n * 2048 + 1024); } } while (0)
#define PG8_XLDA(b, h) do { if constexpr (F8) PG8_LDA8(A8, b, h); else PG8_LDA(At, b, h); } while (0)
#define PG8_XLDB0(b, h) do { if constexpr (F8) PG8_LDB8(B08, b, h); else PG8_LDB(B0, b, h); } while (0)
#define PG8_XLDB1(b, h) do { if constexpr (F8) PG8_LDB8(B18, b, h); else PG8_LDB(B1, b, h); } while (0)
#define PG8_MM0(ai, bj) do { if constexpr (F8) PG8_MMA8(ai, bj, A8, B08); else PG8_MMA16(ai, bj, At, B0); } while (0)
#define PG8_MM1(ai, bj) do { if constexpr (F8) PG8_MMA8(ai, bj, A8, B18); else PG8_MMA16(ai, bj, At, B1); } while (0)
#define PG8_WAIT_V(n) asm volatile("s_waitcnt vmcnt(" #n ")" ::: "memory")
#define PG8_WAIT_L(n) asm volatile("s_waitcnt lgkmcnt(" #n ")" ::: "memory")
#define PG8_BAR __builtin_amdgcn_s_barrier()
#define PG8_SCHED __builtin_amdgcn_sched_barrier(0)
    Unit cur, nxt; int ui = 0;
    if (!S.next(0, cur)) return;
    f32x4 acc[2][2][4][2];
#pragma unroll
    for (int a = 0; a < 2; ++a)
#pragma unroll
        for (int b = 0; b < 2; ++b)
#pragma unroll
            for (int m = 0; m < 4; ++m)
#pragma unroll
                for (int n = 0; n < 2; ++n) acc[a][b][m][n] = (f32x4){0.f, 0.f, 0.f, 0.f};
    bf16x8 At[4][2], B0[2][2], B1[2][2]; v8i_t A8[4], B08[2], B18[2];
    const char* cA = (const char*)g.A + (size_t)cur.pm * tstepA; const char* cB = (const char*)g.Bt + (size_t)cur.pn * tstepB;
    PG8_STAGE(PG8_SB(0, 0), cB, voffB); PG8_STAGE(PG8_SB(0, 1), cB + hstepB, voffB); PG8_STAGE(PG8_SA(0, 0), cA, voffA); PG8_STAGE(PG8_SA(0, 1), cA + hstepA, voffA);
    if (wr == 1) PG8_BAR;
    PG8_WAIT_V(2); PG8_BAR;
    PG8_STAGE(PG8_SB(1, 0), cB + kstep, voffB); PG8_STAGE(PG8_SA(1, 0), cA + kstep, voffA); PG8_STAGE(PG8_SB(1, 1), cB + hstepB + kstep, voffB);
    PG8_WAIT_V(6); PG8_BAR;
    for (;;) {
        const bool has_next = S.next(ui + 1, nxt);
        const char* nA = has_next ? (const char*)g.A + (size_t)nxt.pm * tstepA : cA; const char* nB = has_next ? (const char*)g.Bt + (size_t)nxt.pn * tstepB : cB;
        for (int t = 0; t < nt; t += 2) {
            const bool last = (t == nt - 2);
            const char* a1 = cA + (size_t)(t + 1) * kstep;
            const char* a2 = last ? nA : cA + (size_t)(t + 2) * kstep; const char* b2 = last ? nB : cB + (size_t)(t + 2) * kstep;
            const char* a3 = a2 + kstep; const char* b3 = b2 + kstep;
            if constexpr (Epi::KHOOK) { if (t != 0 && (t & 7) == 0) E.khook(acc, cur, t >> 3, wr, wc, fr, fq); }
            PG8_XLDB0(0, 0); PG8_XLDB1(0, 1); PG8_SCHED; PG8_XLDA(0, 0); PG8_STAGE(PG8_SA(1, 1), a1 + hstepA, voffA);
            PG8_WAIT_V(8); PG8_WAIT_L(0); PG8_BAR; PG8_MM0(0, 0); PG8_MM1(0, 1); PG8_BAR; PG8_SCHED;
            PG8_XLDA(0, 1); PG8_STAGE(PG8_SB(0, 0), b2, voffB); PG8_STAGE(PG8_SB(0, 1), b2 + hstepB, voffB); PG8_STAGE(PG8_SA(0, 0), a2, voffA);
            PG8_WAIT_V(8); PG8_WAIT_L(0); PG8_BAR; PG8_MM0(1, 0); PG8_MM1(1, 1); PG8_BAR; PG8_SCHED;
            PG8_XLDB0(1, 0); PG8_XLDB1(1, 1); PG8_SCHED; PG8_XLDA(1, 0); PG8_STAGE(PG8_SA(0, 1), a2 + hstepA, voffA);
            PG8_WAIT_V(8); PG8_WAIT_L(0); PG8_BAR; PG8_MM0(0, 0); PG8_MM1(0, 1); PG8_BAR; PG8_SCHED;
            PG8_XLDA(1, 1); PG8_STAGE(PG8_SB(1, 0), b3, voffB); PG8_STAGE(PG8_SB(1, 1), b3 + hstepB, voffB); PG8_STAGE(PG8_SA(1, 0), a3, voffA);
            PG8_WAIT_V(8); PG8_WAIT_L(0); PG8_BAR; PG8_MM0(1, 0); PG8_MM1(1, 1); PG8_BAR; PG8_SCHED;
        }
        if (wr == 0) PG8_BAR;
        E(acc, cur, wr, wc, fr, fq);
        if (!has_next) break;
#pragma unroll
        for (int a = 0; a < 2; ++a)
#pragma unroll
            for (int b = 0; b < 2; ++b)
#pragma unroll
                for (int m = 0; m < 4; ++m)
#pragma unroll
                    for (int n = 0; n < 2; ++n) acc[a][b][m][n] = (f32x4){0.f, 0.f, 0.f, 0.f};
        cur = nxt; cA = nA; cB = nB; ++ui;
        if (wr == 1) PG8_BAR;
    }
    PG8_WAIT_V(0);
    PG8_BAR;
#undef PG8_SA
#undef PG8_SB
#undef PG8_STAGE
#undef PG8_LDA
#undef PG8_LDB
#undef PG8_MMA
#undef PG8_MMA8
#undef PG8_MMA16
#undef PG8_LDA8
#undef PG8_LDB8
#undef PG8_XLDA
#undef PG8_XLDB0
#undef PG8_XLDB1
#undef PG8_MM0
#undef PG8_MM1
#undef PG8_WAIT_V
#undef PG8_WAIT_L
#undef PG8_BAR
#undef PG8_SCHED
}
}

#define XB_TMO      128
#define XB_XCNT(j)  (256  + 64 * (j))
#define XB_XSUB(j)  (1280 + 64 * (j))
#define XB_XGEN(j)  (2304 + 64 * (j))
#define XB_TOP      3328
#define XB_TOPGEN   3392
#define XCD_BAR_WORDS 3456
#define XB_SPIN_CAP (1u << 18)
__device__ __forceinline__ unsigned xb_ld(unsigned* p)              { return __hip_atomic_load(p, __ATOMIC_RELAXED, __HIP_MEMORY_SCOPE_AGENT); }
__device__ __forceinline__ unsigned xb_add(unsigned* p, unsigned v) { return __hip_atomic_fetch_add(p, v, __ATOMIC_RELAXED, __HIP_MEMORY_SCOPE_AGENT); }
__device__ __forceinline__ unsigned xb_xcc_id() { return (unsigned)__builtin_amdgcn_s_getreg((3 << 11) | 20) & 0xFu; }
#define XB_SPIN(cond, bar) do { unsigned _sp = 0; while (cond) { __builtin_amdgcn_s_sleep(1); \
    if ((++_sp & 255u) == 0u) { if (xb_ld(&(bar)[XB_TMO])) break; if (_sp > XB_SPIN_CAP) { (void)__hip_atomic_fetch_add(&(bar)[XB_TMO], 1u, __ATOMIC_RELAXED, __HIP_MEMORY_SCOPE_AGENT); break; } } } } while (0)
struct XcdBarrier { unsigned* bar; unsigned x; volatile LAS unsigned* st; };
__device__ __forceinline__ XcdBarrier xcd_barrier_post(unsigned* bar, volatile LAS unsigned* st) {
    XcdBarrier b; b.bar = bar; b.x = xb_xcc_id(); b.st = st;
    if (threadIdx.x == 0) (void)xb_add(&bar[XB_XCNT(b.x)], 1u);
    return b;
}
__device__ __forceinline__ void xcd_barrier_complete(unsigned* bar, unsigned x, unsigned& nloc, unsigned& nx) {
    const unsigned G = gridDim.x * gridDim.y * gridDim.z;
    unsigned sum, cnt, mine, sp = 0u;
    for (;;) {
        sum = 0u; cnt = 0u; mine = 0u;
#pragma nounroll
        for (unsigned j = 0; j < 16; ++j) { const unsigned c = xb_ld(&bar[XB_XCNT(j)]); sum += c; cnt += (c > 0u) ? 1u : 0u; mine = (j == x) ? c : mine; }
        if (sum == G) break;
        __builtin_amdgcn_s_sleep(1);
        if ((++sp & 255u) == 0u) { if (xb_ld(&bar[XB_TMO])) break; if (sp > XB_SPIN_CAP) { (void)__hip_atomic_fetch_add(&bar[XB_TMO], 1u, __ATOMIC_RELAXED, __HIP_MEMORY_SCOPE_AGENT); break; } }
    }
    nloc = mine > 0u ? mine : 1u; nx = cnt > 0u ? cnt : 1u;
}
__device__ __forceinline__ void xcd_barrier(const XcdBarrier& b) {
    asm volatile("s_waitcnt vmcnt(0)" ::: "memory");
    wg_sync();
    if (threadIdx.x == 0) {
        unsigned* bar = b.bar;
        __builtin_amdgcn_s_waitcnt(0);
        unsigned nloc = b.st[0], nx = b.st[1];
        if (nloc == 0u) { xcd_barrier_complete(bar, b.x, nloc, nx); b.st[0] = nloc; b.st[1] = nx; }
        const unsigned old = xb_add(&bar[XB_XSUB(b.x)], 1u);
        const unsigned gen = old / nloc;
        if (old + 1u == (gen + 1u) * nloc) {
            __builtin_amdgcn_fence(__ATOMIC_RELEASE, "agent");
            asm volatile("s_waitcnt vmcnt(0)" ::: "memory");
            const unsigned og = xb_add(&bar[XB_TOP], 1u);
            const unsigned tg = og / nx;
            if (og + 1u == (tg + 1u) * nx) xb_add(&bar[XB_TOPGEN], 1u);
            else XB_SPIN(xb_ld(&bar[XB_TOPGEN]) == tg, bar);
            __builtin_amdgcn_fence(__ATOMIC_ACQUIRE, "agent");
            xb_add(&bar[XB_XGEN(b.x)], 1u);
            asm volatile("s_waitcnt vmcnt(0)" ::: "memory");
        } else {
            XB_SPIN(xb_ld(&bar[XB_XGEN(b.x)]) == gen, bar);
            __builtin_amdgcn_fence(__ATOMIC_ACQUIRE, "agent");
            asm volatile("s_waitcnt vmcnt(0)" ::: "memory");
        }
    }
    wg_sync();
}

__device__ __forceinline__ const void* kin(int k) {
    typedef __attribute__((address_space(4))) const char* kptr_t;
    kptr_t p = (kptr_t)__builtin_amdgcn_kernarg_segment_ptr(); asm volatile("" : "+s"(p));
    const unsigned long long v = *(__attribute__((address_space(4))) const unsigned long long*)(p + 8 * k);
    return (const void*)(GAS const void*)v;
}
struct Frame {
    LAS unsigned char* lds;
    int tid, lane, wave, vcu, G, l;
    unsigned char* ws; float* out;
#define FIN(name, T, k) __device__ __forceinline__ const T* name() const { return (const T*)kin(k); }
    FIN(x, float, 0) FIN(pos, int, 1) FIN(g_mix, float, 2) FIN(w_in, float, 3) FIN(a_re, float, 4) FIN(a_im, float, 5) FIN(log_dt, float, 6) FIN(b_re, float, 7) FIN(b_im, float, 8)
    FIN(c_re, float, 9) FIN(c_im, float, 10) FIN(s5_d, float, 11) FIN(w_glu, float, 12) FIN(gla_wg, float, 13) FIN(gla_bg, float, 14) FIN(pool_w, float, 15) FIN(pool_scale, float, 16)
    FIN(w_branch, float, 17) FIN(w_out, float, 18) FIN(g_ffn, float, 19) FIN(w_up, float, 20) FIN(conv_w, float, 21) FIN(conv_b, float, 22) FIN(w_down, float, 23) FIN(g_final, float, 24)
#undef FIN
#define FWS(name, T, off) __device__ __forceinline__ T* name() const { return (T*)(ws + (off)); }
    FWS(rotc, float, WS_ROT) FWS(rots, float, WS_ROT + (size_t)M * 32 * 4) FWS(abar, float, WS_S5T + S5T_ABAR) FWS(apow, float, WS_S5T + S5T_APOW) FWS(bbar, float, WS_S5T + S5T_BBAR) FWS(cmt, bf16_t, WS_S5T + S5T_CMT) FWS(bbt, bf16_t, WS_S5T + S5T_BBT)
    FWS(wglu_t, bf16_t, WS_WGLU) FWS(poolw_t, bf16_t, WS_POOLW) FWS(win_t, bf16_t, WS_WIN) FWS(wbr_t, bf16_t, WS_WBR) FWS(wout_t, bf16_t, WS_WOUT) FWS(wup_t, bf16_t, WS_WUP) FWS(wdn_t, bf16_t, WS_WDN)
    FWS(HN8, unsigned char, WS_HN8) FWS(W8, unsigned char, WS_W8) FWS(HN, bf16_t, WS_HN) FWS(Y, bf16_t, WS_Y) FWS(YBP, bf16_t, WS_YBP) FWS(PROJ, bf16_t, WS_PROJ) FWS(GF, bf16_t, WS_GF) FWS(SPREV, bf16_t, WS_SPREV) FWS(ACT, bf16_t, WS_ACT)
    FWS(SS, float, WS_SS + (size_t)l * 32 * M * 4) FWS(RS, float, WS_RS + (size_t)l * M * 4) FWS(STATE, float, WS_STATE) FWS(DEC, float, WS_DEC) FWS(XEND, float, WS_XEND) FWS(UH, float, WS_UH)
#undef FWS
};

__device__ __forceinline__ float lane_read(float v, int src_lane) { return __builtin_bit_cast(float, __builtin_amdgcn_ds_bpermute(src_lane << 2, __builtin_bit_cast(int, v))); }
__device__ __forceinline__ float wave_sum(float v, int lane) {
#pragma unroll
    for (int o = 1; o < 64; o <<= 1) v += lane_read(v, lane ^ o);
    return v;
}

template <class SrcCol>
__device__ __forceinline__ void transpose_item(const float* W, int Nsrc, bf16_t* WT, int ldt, int kdst0, int k0, int n0, SrcCol srccol, LAS float* scr, int lane, const float* kscale = nullptr) {
    const int sc = srccol(n0 + (lane & 31));
    float wv[32];
#pragma unroll
    for (int i = 0; i < 32; ++i) { const int kk = 2 * i + (lane >> 5); wv[i] = sc >= 0 ? W[(size_t)(k0 + kk) * Nsrc + sc] : 0.f; }
#pragma unroll
    for (int i = 0; i < 32; ++i) { const int kk = 2 * i + (lane >> 5); scr[kk * 33 + (lane & 31)] = kscale ? wv[i] * kscale[k0 + kk] : wv[i]; }
    LDS_WAIT();
    const int c = lane & 7;
#pragma unroll
    for (int j = 0; j < 4; ++j) { const int n = (lane >> 3) + 8 * j; const LAS float* s = scr + (8 * c) * 33 + n;
        u32x4 o; o.x = pk2(s[0 * 33], s[1 * 33]); o.y = pk2(s[2 * 33], s[3 * 33]); o.z = pk2(s[4 * 33], s[5 * 33]); o.w = pk2(s[6 * 33], s[7 * 33]);
        *(u32x4*)(WT + (size_t)(n0 + n) * ldt + kdst0 + k0 + 8 * c) = o; }
    LDS_WAIT();
}
template <class SrcCol>
__device__ __forceinline__ void transpose_item_fp8(const float* W, int Nsrc, unsigned char* WT, int ldt, int k0, int n0src, int n0dst, SrcCol srccol, LAS float* scr, int lane, const float* kscale, float scale) {
    const int sc = srccol(n0src + (lane & 31));
    float wv[32];
#pragma unroll
    for (int i = 0; i < 32; ++i) { const int kk = 2 * i + (lane >> 5); wv[i] = sc >= 0 ? W[(size_t)(k0 + kk) * Nsrc + sc] : 0.f; }
#pragma unroll
    for (int i = 0; i < 32; ++i) { const int kk = 2 * i + (lane >> 5); scr[kk * 33 + (lane & 31)] = (kscale ? wv[i] * kscale[k0 + kk] : wv[i]) * scale; }
    LDS_WAIT();
    const int c = lane & 7;
#pragma unroll
    for (int j = 0; j < 4; ++j) { const int n = (lane >> 3) + 8 * j; const LAS float* s = scr + (8 * c) * 33 + n;
        u32x2 o; o.x = pk4_fp8(s[0 * 33], s[1 * 33], s[2 * 33], s[3 * 33]); o.y = pk4_fp8(s[4 * 33], s[5 * 33], s[6 * 33], s[7 * 33]);
        *(u32x2*)(WT + (size_t)(n0dst + n) * ldt + k0 + 8 * c) = o; }
    LDS_WAIT();
}
struct ColIdent { __device__ __forceinline__ int operator()(int n) const { return n; } };
struct ColWin { __device__ __forceinline__ int operator()(int n) const {
    if (n < 3584) return n; if (n < 4096) return n + 16; if (n < 4112) return n - 512; if (n < 4352) return -1;
    const int t = (n - 4352) >> 8, cl = (n - 4352) & 255; const int br = 2 * (cl >> 7) + ((cl >> 2) & 1), ch = 16 * ((cl >> 5) & 3) + 4 * ((cl >> 3) & 3) + (cl & 3);
    return 4112 + br * 2048 + 64 * t + ch; } };
struct ColWup { __device__ __forceinline__ int operator()(int n) const { const int blk = n >> 8, r = n & 255; return (r < 128) ? (blk * 128 + r) : (DFF + blk * 128 + (r - 128)); } };

__device__ __forceinline__ void rms_row_to_bf16(const float* xrow, const float* g, bf16_t* orow, int lane, unsigned char* orow8 = nullptr) {
    const f32x4* xr = (const f32x4*)xrow + lane; const f32x4* gr = (const f32x4*)g + lane;
    f32x4 v[8]; float s = 0.f;
#pragma unroll
    for (int j = 0; j < 8; ++j) { v[j] = xr[64 * j]; s += (v[j].x * v[j].x + v[j].y * v[j].y) + (v[j].z * v[j].z + v[j].w * v[j].w); }
    const float r = 1.0f / sqrtf(wave_sum(s, lane) * (1.f / D) + EPS);
    u32x2* o8 = (u32x2*)orow + lane;
#pragma unroll
    for (int j = 0; j < 8; ++j) { const f32x4 gg = gr[64 * j]; const float a = v[j].x * r * gg.x, b = v[j].y * r * gg.y, c = v[j].z * r * gg.z, d = v[j].w * r * gg.w; u32x2 w; w.x = pk2(a, b); w.y = pk2(c, d); o8[64 * j] = w;
        if (orow8) ((unsigned*)orow8)[lane + 64 * j] = pk4_fp8(a, b, c, d); }
}
__device__ __forceinline__ void rms_rows(Frame& F, const float* src, const float* g, bf16_t* dst, unsigned char* dst8 = nullptr) {
    const int gw = F.vcu * NWAVES + F.wave, NGW = F.G * NWAVES;
    for (int m = gw; m < M; m += NGW) rms_row_to_bf16(src + (size_t)m * D, g, dst + (size_t)m * D, F.lane, dst8 ? dst8 + (size_t)m * D : nullptr);
}
__device__ __forceinline__ void row_scale(Frame& F) {
    const int gt = F.vcu * (NWAVES * 64) + F.tid, NGT = F.G * NWAVES * 64;
    for (int m = gt; m < M; m += NGT) { float s = 0.f;
#pragma unroll
        for (int j = 0; j < 32; ++j) s += F.SS()[(size_t)j * M + m];
        const int r = m & 255;
        F.RS()[((size_t)((m >> 8) * 2 + ((r >> 6) & 1)) * 16 + (r & 15)) * 8 + (r >> 7) * 4 + ((r >> 4) & 3)] = 1.0f / sqrtf(s * (1.f / D) + EPS); }
}
__device__ __forceinline__ void rms_rows16(Frame& F, const bf16_t* src, const float* g, bf16_t* dst, unsigned char* dst8) {
    const int gw = F.vcu * NWAVES + F.wave, NGW = F.G * NWAVES, lane = F.lane;
    for (int m = gw; m < M; m += NGW) {
        const u32x4* xr = (const u32x4*)(src + (size_t)m * D) + lane; float v[4][8]; float s = 0.f;
#pragma unroll
        for (int j = 0; j < 4; ++j) { unpack8(xr[64 * j], v[j]);
#pragma unroll
            for (int q = 0; q < 8; ++q) s += v[j][q] * v[j][q]; }
        const float r = 1.0f / sqrtf(wave_sum(s, lane) * (1.f / D) + EPS);
        u32x4* o16 = (u32x4*)(dst + (size_t)m * D) + lane; u32x2* o8 = (u32x2*)(dst8 + (size_t)m * D) + lane;
#pragma unroll
        for (int j = 0; j < 4; ++j) { const f32x4 g0 = *((const f32x4*)g + 2 * (lane + 64 * j)), g1 = *((const f32x4*)g + 2 * (lane + 64 * j) + 1); float y[8];
            y[0] = v[j][0] * r * g0.x; y[1] = v[j][1] * r * g0.y; y[2] = v[j][2] * r * g0.z; y[3] = v[j][3] * r * g0.w; y[4] = v[j][4] * r * g1.x; y[5] = v[j][5] * r * g1.y; y[6] = v[j][6] * r * g1.z; y[7] = v[j][7] * r * g1.w;
            o16[64 * j] = pack8(y); u32x2 w8; w8.x = pk4_fp8(y[0], y[1], y[2], y[3]); w8.y = pk4_fp8(y[4], y[5], y[6], y[7]); o8[64 * j] = w8; }
    }
}
__device__ __forceinline__ void rms_rows16_to_f32(Frame& F, const bf16_t* src, const float* g, float* out) {
    const int gw = F.vcu * NWAVES + F.wave, NGW = F.G * NWAVES, lane = F.lane;
    for (int m = gw; m < M; m += NGW) {
        const u32x4* xr = (const u32x4*)(src + (size_t)m * D) + lane; float v[4][8]; float s = 0.f;
#pragma unroll
        for (int j = 0; j < 4; ++j) { unpack8(xr[64 * j], v[j]);
#pragma unroll
            for (int q = 0; q < 8; ++q) s += v[j][q] * v[j][q]; }
        const float r = 1.0f / sqrtf(wave_sum(s, lane) * (1.f / D) + EPS);
        f32x4* o = (f32x4*)(out + (size_t)m * D);
#pragma unroll
        for (int j = 0; j < 4; ++j) { const f32x4 g0 = *((const f32x4*)g + 2 * (lane + 64 * j)), g1 = *((const f32x4*)g + 2 * (lane + 64 * j) + 1);
            o[2 * (lane + 64 * j)] = (f32x4){v[j][0] * r * g0.x, v[j][1] * r * g0.y, v[j][2] * r * g0.z, v[j][3] * r * g0.w};
            o[2 * (lane + 64 * j) + 1] = (f32x4){v[j][4] * r * g1.x, v[j][5] * r * g1.y, v[j][6] * r * g1.z, v[j][7] * r * g1.w}; }
    }
}
__device__ __forceinline__ void rms_rows_f32_inplace(Frame& F, float* buf, const float* g) {
    const int gw = F.vcu * NWAVES + F.wave, NGW = F.G * NWAVES;
    for (int m = gw; m < M; m += NGW) {
        f32x4* xr = (f32x4*)(buf + (size_t)m * D) + F.lane; const f32x4* gr = (const f32x4*)g + F.lane;
        f32x4 v[8]; float s = 0.f;
#pragma unroll
        for (int j = 0; j < 8; ++j) { v[j] = xr[64 * j]; s += (v[j].x * v[j].x + v[j].y * v[j].y) + (v[j].z * v[j].z + v[j].w * v[j].w); }
        const float r = 1.0f / sqrtf(wave_sum(s, F.lane) * (1.f / D) + EPS);
#pragma unroll
        for (int j = 0; j < 8; ++j) { const f32x4 gg = gr[64 * j]; xr[64 * j] = (f32x4){v[j].x * r * gg.x, v[j].y * r * gg.y, v[j].z * r * gg.z, v[j].w * r * gg.w}; }
    }
}

__device__ __forceinline__ void phase_prep(Frame& F, int l) {
    LAS float* scr = (LAS float*)(F.lds + F.wave * 16384);
    const int gw = F.vcu * NWAVES + F.wave, NGW = F.G * NWAVES;
    constexpr int I_IN = (D / 64) * (NIN / 32), I_UP = (D / 64) * (NUP / 32), I_DN = (DFF / 64) * (D / 32), I_BR = 4 * (BW / 64) * (D / 32), I_OUT = (D / 64) * (D / 32), I_GLU = (BW / 64) * (BW / 32), I_PL = 4 * (128 / 64) * (128 / 32);
    constexpr int NITEMS = I_IN + I_UP + I_DN + I_BR + I_OUT + I_GLU + I_PL;
    for (int it = gw; it < NITEMS; it += NGW) {
        int r = it;
        if (r < I_IN) { const int nb = NIN / 32, n0 = 32 * (r % nb);
            if (n0 < C_GATE) transpose_item(F.w_in() + (size_t)l * D * NIN_SRC, NIN_SRC, F.win_t(), D, 0, 64 * (r / nb), n0, ColWin(), scr, F.lane);
            else transpose_item_fp8(F.w_in() + (size_t)l * D * NIN_SRC, NIN_SRC, F.W8(), D, 64 * (r / nb), n0, n0 - C_GATE, ColWin(), scr, F.lane, nullptr, 64.0f);
            continue; } r -= I_IN;
        if (r < I_UP) { const int nb = NUP / 32; transpose_item(F.w_up() + (size_t)l * D * NUP, NUP, F.wup_t(), D, 0, 64 * (r / nb), 32 * (r % nb), ColWup(), scr, F.lane, F.g_ffn() + (size_t)l * D); continue; } r -= I_UP;
        if (r < I_DN) { const int nb = D / 32; transpose_item(F.w_down() + (size_t)l * DFF * D, D, F.wdn_t(), DFF, 0, 64 * (r / nb), 32 * (r % nb), ColIdent(), scr, F.lane); continue; } r -= I_DN;
        if (r < I_BR) { const int per = (BW / 64) * (D / 32), br = r / per, q = r % per, nb = D / 32;
            transpose_item(F.w_branch() + ((size_t)l * 4 + br) * BW * D, D, F.wbr_t(), D, br * BW, 64 * (q / nb), 32 * (q % nb), ColIdent(), scr, F.lane); continue; } r -= I_BR;
        if (r < I_OUT) { const int nb = D / 32; transpose_item(F.w_out() + (size_t)l * D * D, D, F.wout_t(), D, 0, 64 * (r / nb), 32 * (r % nb), ColIdent(), scr, F.lane); continue; } r -= I_OUT;
        if (r < I_GLU) { const int nb = BW / 32; transpose_item(F.w_glu() + (size_t)l * BW * BW, BW, F.wglu_t(), BW, 0, 64 * (r / nb), 32 * (r % nb), ColIdent(), scr, F.lane); continue; } r -= I_GLU;
        { const int grp = r / 8, q = r % 8; transpose_item(F.pool_w() + ((size_t)l * 4 + grp) * 128 * 128, 128, F.poolw_t() + (size_t)grp * 128 * 128, 128, 0, 64 * (q / 4), 32 * (q % 4), ColIdent(), scr, F.lane); }
    }
    const int gt = F.vcu * (NWAVES * 64) + F.tid, NGT = F.G * NWAVES * 64;
    for (int i = gt; i < 32 * 64; i += NGT) {
        const int g = i >> 6;
        const float are = F.a_re()[(size_t)l * 2048 + i], aim = F.a_im()[(size_t)l * 2048 + i], dt = expf(F.log_dt()[l * 32 + g]);
        const float mag = expf(are * dt), th = aim * dt;
        const float abr = mag * cosf(th), abi = mag * sinf(th);
        const float den = are * are + aim * aim, nr = abr - 1.0f, ni = abi;
        const float fre = (nr * are + ni * aim) / den, fim = (ni * are - nr * aim) / den;
        F.abar()[2 * i] = abr; F.abar()[2 * i + 1] = abi;
        float pr = abr, pi = abi;
#pragma unroll
        for (int q = 0; q < 6; ++q) { const float tr = pr * pr - pi * pi, ti = 2.f * pr * pi; pr = tr; pi = ti; }
        F.apow()[2 * i] = pr; F.apow()[2 * i + 1] = pi;
        const float* br = F.b_re() + ((size_t)l * 2048 + i) * 16; const float* bi = F.b_im() + ((size_t)l * 2048 + i) * 16;
#pragma unroll
        for (int c = 0; c < 16; ++c) { const float x = br[c], y = bi[c]; const float vr = fre * x - fim * y, vi = fre * y + fim * x; const int p = i & 63;
            F.bbt()[((size_t)g * 128 + p) * 16 + c] = (bf16_t)f2bf(vr); F.bbt()[((size_t)g * 128 + 64 + p) * 16 + c] = (bf16_t)f2bf(vi); }
    }
    for (int i = gt; i < 32 * 16 * 128; i += NGT) {
        const int k = i & 127, gc = i >> 7;
        const float v = (k < 64) ? F.c_re()[((size_t)l * 512 + gc) * 64 + k] : -F.c_im()[((size_t)l * 512 + gc) * 64 + (k - 64)];
        F.cmt()[i] = (bf16_t)f2bf(v);
    }
    if (l == 0) {
        for (int i = gt; i < M * 32; i += NGT) {
            const int row = i >> 5, j = i & 31;
            const float inv = exp2f(-(float)j * (13.287712379549449f / 32.0f));
            const float ang = (float)F.pos()[row] * inv;
            F.rotc()[i] = cosf(ang); F.rots()[i] = sinf(ang);
        }
    }
    if (l == 0) rms_rows(F, F.x(), F.g_mix(), F.HN(), F.HN8()); else rms_rows16(F, (const bf16_t*)F.out, F.g_mix() + (size_t)l * D, F.HN(), F.HN8());
}

__device__ __forceinline__ void gr_pass(Frame& F) {
    const int gw = F.vcu * NWAVES + F.wave, NGW = F.G * NWAVES, lane = F.lane, lr = lane & 15, lq = lane >> 4;
    for (int unit = gw; unit < M / 16; unit += NGW) {
        const bf16_t* ap = F.HN() + (size_t)(16 * unit + lr) * D + 8 * lq; const bf16_t* bp = F.win_t() + (size_t)(C_GR + lr) * D + 8 * lq;
        f32x4 acc = (f32x4){0.f, 0.f, 0.f, 0.f};
#pragma unroll 1
        for (int kb = 0; kb < 64; kb += 16) { bf16x8 a[16], b[16];
#pragma unroll
            for (int j = 0; j < 16; ++j) { a[j] = *(const bf16x8*)(ap + 32 * (kb + j)); b[j] = *(const bf16x8*)(bp + 32 * (kb + j)); }
#pragma unroll
            for (int j = 0; j < 16; ++j) acc = __builtin_amdgcn_mfma_f32_16x16x32_bf16(a[j], b[j], acc, 0, 0, 0); }
#pragma unroll
        for (int i = 0; i < 4; ++i) F.PROJ()[(size_t)(16 * unit + 4 * lq + i) * LDP + C_GR + lr] = (bf16_t)f2bf(acc[i]);
    }
}

__device__ __forceinline__ f32x4 mma_nt_lds(const LAS bf16_t* X, int px, const LAS bf16_t* Y, int py, int ksteps, f32x4 acc, int lane) {
    const LAS bf16_t* xp = X + (lane & 15) * px + 8 * (lane >> 4);
    const LAS bf16_t* yp = Y + (lane & 15) * py + 8 * (lane >> 4);
    for (int ks = 0; ks < ksteps; ++ks) {
        const bf16x8 a = *(const LAS bf16x8*)(xp + 32 * ks), b = *(const LAS bf16x8*)(yp + 32 * ks);
        acc = __builtin_amdgcn_mfma_f32_16x16x32_bf16(a, b, acc, 0, 0, 0);
    }
    return acc;
}

constexpr int LN_TOT = 16384, LN_QD = 18432, LN_KI = 27648, LN_PM = 36864, LN_VT = 46080, LN_OB = 64512, LN_WG = 98304, LN_END = 98304 + 4096 + 256;
constexpr int LP = 72;
struct LinRaw { u32x4 q0, q1, k0, k1, v0, v1, g0, g1, gr0, gr1; f32x4 c0, c1, s0, s1; bf16x8 sp0, sp1; };
template <bool OUT>
__device__ __forceinline__ void lin_issue(Frame& F, int unit, LinRaw& R) {
    const int n = unit & 63, h = (unit >> 6) & 3, b = (unit >> 8) & 7, mixer = unit >> 11;
    const size_t row0 = (size_t)b * SEQ + (size_t)n * CH; const int s = F.tid >> 3, c = F.tid & 7;
    const int cq = (mixer == 0 ? C_RQ : C_GQ) + h * 64, ck = (mixer == 0 ? C_RK : C_GK) + h * 64, cv = (mixer == 0 ? C_RV : C_GV) + h * 128, cg = (mixer == 0 ? C_RG : C_GG) + h * 128;
    const bf16_t* pr = F.PROJ() + (row0 + s) * LDP;
    R.k0 = *(const u32x4*)(pr + ck + 8 * c); R.k1 = *(const u32x4*)(pr + ck + 8 * (c ^ 4));
    if (OUT) { R.q0 = *(const u32x4*)(pr + cq + 8 * c); R.q1 = *(const u32x4*)(pr + cq + 8 * (c ^ 4)); }
    { const float* cp = F.rotc() + (row0 + s) * 32 + (c & 3) * 8; const float* sp = F.rots() + (row0 + s) * 32 + (c & 3) * 8;
      R.c0 = *(const f32x4*)cp; R.c1 = *(const f32x4*)(cp + 4); R.s0 = *(const f32x4*)sp; R.s1 = *(const f32x4*)(sp + 4); }
    R.gr0 = *(const u32x4*)(pr + C_GR); R.gr1 = *(const u32x4*)(pr + C_GR + 8);
    R.v0 = *(const u32x4*)(F.PROJ() + (row0 + (F.tid >> 4)) * LDP + cv + (F.tid & 15) * 8);
    R.v1 = *(const u32x4*)(F.PROJ() + (row0 + 32 + (F.tid >> 4)) * LDP + cv + (F.tid & 15) * 8);
    if (OUT) { R.g0 = *(const u32x4*)(pr + cg + 16 * c); R.g1 = *(const u32x4*)(pr + cg + 16 * c + 8);
        const bf16_t* sq = F.SPREV() + (size_t)unit * 8192 + (size_t)(16 * F.wave + (F.lane & 15)) * 64 + 8 * (F.lane >> 4);
        R.sp0 = *(const bf16x8*)sq; R.sp1 = *(const bf16x8*)(sq + 32); }
}
__device__ __forceinline__ void lin_rot(const u32x4 own_, const u32x4 oth_, const LinRaw& R, bool rot, bool hi, float scale, float (&v)[8]) {
    float own[8]; unpack8(own_, own);
    if (!rot) {
#pragma unroll
        for (int j = 0; j < 8; ++j) v[j] = own[j] * scale;
        return; }
    float oth[8]; unpack8(oth_, oth);
    const float cs[8] = {R.c0.x, R.c0.y, R.c0.z, R.c0.w, R.c1.x, R.c1.y, R.c1.z, R.c1.w}, sn[8] = {R.s0.x, R.s0.y, R.s0.z, R.s0.w, R.s1.x, R.s1.y, R.s1.z, R.s1.w};
#pragma unroll
    for (int j = 0; j < 8; ++j) { const float os = oth[j] * sn[j]; v[j] = (own[j] * cs[j] + (hi ? os : -os)) * scale; }
}
__device__ __forceinline__ void lin_decay(Frame& F, int mixer, int h, const LinRaw& R, float (&bcum)[8], float (&blast)[8]) {
    LAS float* TOT = (LAS float*)(F.lds + LN_TOT);
    const int s = F.tid >> 3, c = F.tid & 7, d0 = 8 * c;
    if (mixer == 0) {
        const float lg = __logf(1.0f - exp2f(-5.0f - (float)h));
#pragma unroll
        for (int j = 0; j < 8; ++j) { bcum[j] = (float)(s + 1) * lg; blast[j] = 64.0f * lg; }
        lds_sync();
        return;
    }
    const LAS float* WG = (const LAS float*)(F.lds + LN_WG);
    float grf[16]; { float a[8], b2[8]; unpack8(R.gr0, a); unpack8(R.gr1, b2);
#pragma unroll
        for (int j = 0; j < 8; ++j) { grf[j] = a[j]; grf[8 + j] = b2[j]; } }
    float x[8]; { const f32x4 b0 = *(const LAS f32x4*)(WG + 1024 + d0), b1 = *(const LAS f32x4*)(WG + 1024 + d0 + 4); x[0] = b0.x; x[1] = b0.y; x[2] = b0.z; x[3] = b0.w; x[4] = b1.x; x[5] = b1.y; x[6] = b1.z; x[7] = b1.w; }
#pragma unroll
    for (int r = 0; r < 16; ++r) { const f32x4 w0 = *(const LAS f32x4*)(WG + r * 64 + d0), w1 = *(const LAS f32x4*)(WG + r * 64 + d0 + 4);
        x[0] += grf[r] * w0.x; x[1] += grf[r] * w0.y; x[2] += grf[r] * w0.z; x[3] += grf[r] * w0.w; x[4] += grf[r] * w1.x; x[5] += grf[r] * w1.y; x[6] += grf[r] * w1.z; x[7] += grf[r] * w1.w; }
#pragma unroll
    for (int j = 0; j < 8; ++j) x[j] = logsigmoidf_(x[j]) * (1.0f / 16.0f);
#pragma unroll
    for (int st = 8; st <= 32; st <<= 1) {
#pragma unroll
        for (int j = 0; j < 8; ++j) { const float t = lane_read(x[j], F.lane - st); if (F.lane >= st) x[j] += t; } }
    if ((F.lane >> 3) == 7) { *(LAS f32x4*)(TOT + F.wave * 64 + d0) = (f32x4){x[0], x[1], x[2], x[3]}; *(LAS f32x4*)(TOT + F.wave * 64 + d0 + 4) = (f32x4){x[4], x[5], x[6], x[7]}; }
    lds_sync();
    float off[8], tot[8];
#pragma unroll
    for (int j = 0; j < 8; ++j) { off[j] = 0.f; tot[j] = 0.f; }
#pragma unroll
    for (int w = 0; w < 8; ++w) { const f32x4 t0 = *(const LAS f32x4*)(TOT + w * 64 + d0), t1 = *(const LAS f32x4*)(TOT + w * 64 + d0 + 4); const float tv[8] = {t0.x, t0.y, t0.z, t0.w, t1.x, t1.y, t1.z, t1.w};
#pragma unroll
        for (int j = 0; j < 8; ++j) { tot[j] += tv[j]; off[j] += (w < F.wave) ? tv[j] : 0.f; } }
#pragma unroll
    for (int j = 0; j < 8; ++j) { bcum[j] = x[j] + off[j]; blast[j] = tot[j]; }
}
typedef short v4s_t __attribute__((ext_vector_type(4)));
__device__ __forceinline__ bf16x8 tr_frag(const LAS bf16_t* T, int pitch, int k0, int x0, int lane) {
    const int g = lane >> 4, i = lane & 15, q = i >> 2, p = i & 3;
    const LAS bf16_t* a = T + (k0 + 8 * g + q) * pitch + x0 + 4 * p;
    const v4s_t lo = __builtin_amdgcn_ds_read_tr16_b64_v4i16((LAS v4s_t*)a), hi = __builtin_amdgcn_ds_read_tr16_b64_v4i16((LAS v4s_t*)(a + 4 * pitch));
    return __builtin_shufflevector(lo, hi, 0, 1, 2, 3, 4, 5, 6, 7);
}
constexpr int PV = 144;
__device__ __forceinline__ void lin_store_vt(Frame& F, const LinRaw& R) {
    LAS bf16_t* VR = (LAS bf16_t*)(F.lds + LN_VT); const int e0 = (F.tid & 15) * 8;
    *(LAS u32x4*)(VR + (F.tid >> 4) * PV + e0) = R.v0; *(LAS u32x4*)(VR + (32 + (F.tid >> 4)) * PV + e0) = R.v1;
}
__device__ __forceinline__ void lin_state_compute(Frame& F, int unit, const LinRaw& R) {
    const int h = (unit >> 6) & 3, mixer = unit >> 11; const int s = F.tid >> 3, c = F.tid & 7, d0 = 8 * c;
    LAS bf16_t* KDT = (LAS bf16_t*)(F.lds + LN_KI); LAS bf16_t* VT = (LAS bf16_t*)(F.lds + LN_VT);
    float k[8], bcum[8], blast[8];
    lin_rot(R.k0, R.k1, R, mixer == 0, c >= 4, mixer == 0 ? 0.125f : 1.0f, k);
    lin_decay(F, mixer, h, R, bcum, blast);
    { float kd[8];
#pragma unroll
      for (int j = 0; j < 8; ++j) kd[j] = k[j] * __expf(blast[j] - bcum[j]);
      *(LAS u32x4*)(KDT + s * LP + d0) = pack8(kd); }
    lin_store_vt(F, R);
    if (s == 0) { float* dc = F.DEC() + (size_t)unit * 64 + d0;
        *(f32x4*)dc = (f32x4){__expf(blast[0]), __expf(blast[1]), __expf(blast[2]), __expf(blast[3])}; *(f32x4*)(dc + 4) = (f32x4){__expf(blast[4]), __expf(blast[5]), __expf(blast[6]), __expf(blast[7])}; }
    lds_sync();
    { const int w = F.wave, lane = F.lane; float* st = F.STATE() + (size_t)unit * 8192;
      const bf16x8 vf0 = tr_frag(VT, PV, 0, 16 * w, lane), vf1 = tr_frag(VT, PV, 32, 16 * w, lane);
#pragma unroll
      for (int dt = 0; dt < 4; ++dt) { f32x4 acc = (f32x4){0.f, 0.f, 0.f, 0.f};
          acc = __builtin_amdgcn_mfma_f32_16x16x32_bf16(vf0, tr_frag(KDT, LP, 0, 16 * dt, lane), acc, 0, 0, 0);
          acc = __builtin_amdgcn_mfma_f32_16x16x32_bf16(vf1, tr_frag(KDT, LP, 32, 16 * dt, lane), acc, 0, 0, 0);
#pragma unroll
          for (int i = 0; i < 4; ++i) st[(16 * w + 4 * (lane >> 4) + i) * 64 + 16 * dt + (lane & 15)] = acc[i]; } }
}
__device__ __forceinline__ void lin_out_compute(Frame& F, int unit, const LinRaw& R) {
    const int n = unit & 63, h = (unit >> 6) & 3, b = (unit >> 8) & 7, mixer = unit >> 11;
    const size_t row0 = (size_t)b * SEQ + (size_t)n * CH; const int s = F.tid >> 3, c = F.tid & 7, d0 = 8 * c;
    const int ycol = (mixer == 0 ? 0 : 1024) + h * 128;
    LAS bf16_t* QD = (LAS bf16_t*)(F.lds + LN_QD); LAS bf16_t* KI = (LAS bf16_t*)(F.lds + LN_KI); LAS bf16_t* PM = (LAS bf16_t*)(F.lds + LN_PM);
    LAS bf16_t* VT = (LAS bf16_t*)(F.lds + LN_VT); LAS float* OB = (LAS float*)(F.lds + LN_OB);
    float q[8], k[8], bcum[8], blast[8];
    lin_rot(R.q0, R.q1, R, mixer == 0, c >= 4, mixer == 0 ? 1.0f : 0.125f, q);
    lin_rot(R.k0, R.k1, R, mixer == 0, c >= 4, mixer == 0 ? 0.125f : 1.0f, k);
    lin_decay(F, mixer, h, R, bcum, blast);
    { float qd[8], ki[8];
#pragma unroll
      for (int j = 0; j < 8; ++j) { qd[j] = q[j] * __expf(bcum[j]); ki[j] = k[j] * __expf(-bcum[j]); }
      *(LAS u32x4*)(QD + s * LP + d0) = pack8(qd); *(LAS u32x4*)(KI + s * LP + d0) = pack8(ki); }
    lin_store_vt(F, R);
    lds_sync();
    { const int lane = F.lane;
#pragma unroll
      for (int j = 0; j < 2; ++j) { const int tile = 2 * F.wave + j, tt = tile >> 2, st = tile & 3;
          f32x4 acc = (f32x4){0.f, 0.f, 0.f, 0.f};
          if (st <= tt) acc = mma_nt_lds(QD + 16 * tt * LP, LP, KI + 16 * st * LP, LP, 2, acc, lane);
#pragma unroll
          for (int i = 0; i < 4; ++i) { const int t = 16 * tt + 4 * (lane >> 4) + i, s2 = 16 * st + (lane & 15); const float p = (st <= tt && s2 <= t) ? acc[i] : 0.f; PM[t * LP + s2] = (bf16_t)f2bf(p); } } }
    lds_sync();
    { const int w = F.wave, lane = F.lane;
      const bf16x8 vf0 = tr_frag(VT, PV, 0, 16 * w, lane), vf1 = tr_frag(VT, PV, 32, 16 * w, lane);
#pragma unroll
      for (int tt = 0; tt < 4; ++tt) { f32x4 acc = (f32x4){0.f, 0.f, 0.f, 0.f};
          { const LAS bf16_t* pp = PM + (16 * tt + (lane & 15)) * LP + 8 * (lane >> 4);
            acc = __builtin_amdgcn_mfma_f32_16x16x32_bf16(*(const LAS bf16x8*)pp, vf0, acc, 0, 0, 0);
            acc = __builtin_amdgcn_mfma_f32_16x16x32_bf16(*(const LAS bf16x8*)(pp + 32), vf1, acc, 0, 0, 0); }
          const LAS bf16_t* xp = QD + (16 * tt + (lane & 15)) * LP + 8 * (lane >> 4);
          acc = __builtin_amdgcn_mfma_f32_16x16x32_bf16(*(const LAS bf16x8*)xp, R.sp0, acc, 0, 0, 0);
          acc = __builtin_amdgcn_mfma_f32_16x16x32_bf16(*(const LAS bf16x8*)(xp + 32), R.sp1, acc, 0, 0, 0);
#pragma unroll
          for (int i = 0; i < 4; ++i) OB[(16 * tt + 4 * (lane >> 4) + i) * 132 + 16 * w + (lane & 15)] = acc[i]; } }
    lds_sync();
    { const int t = s, part = c; float o[16];
#pragma unroll
      for (int j = 0; j < 4; ++j) { const f32x4 v = *(const LAS f32x4*)(OB + t * 132 + 16 * part + 4 * j); o[4 * j] = v.x; o[4 * j + 1] = v.y; o[4 * j + 2] = v.z; o[4 * j + 3] = v.w; }
      float sm = 0.f;
#pragma unroll
      for (int j = 0; j < 16; ++j) sm += o[j];
      sm += lane_read(sm, F.lane ^ 1); sm += lane_read(sm, F.lane ^ 2); sm += lane_read(sm, F.lane ^ 4);
      const float mu = sm * (1.0f / 128.0f); float qv = 0.f;
#pragma unroll
      for (int j = 0; j < 16; ++j) { const float dlt = o[j] - mu; qv += dlt * dlt; }
      qv += lane_read(qv, F.lane ^ 1); qv += lane_read(qv, F.lane ^ 2); qv += lane_read(qv, F.lane ^ 4);
      const float r = 1.0f / sqrtf(qv * (1.0f / 128.0f) + EPS);
      float g0[8], g1[8]; unpack8(R.g0, g0); unpack8(R.g1, g1);
      float y0[8], y1[8];
#pragma unroll
      for (int j = 0; j < 8; ++j) { y0[j] = (o[j] - mu) * r * siluf_(g0[j]); y1[j] = (o[8 + j] - mu) * r * siluf_(g1[j]); }
      bf16_t* yp = F.Y() + (row0 + t) * D + ycol + 16 * part; *(u32x4*)yp = pack8(y0); *(u32x4*)(yp + 8) = pack8(y1); }
}
template <bool OUT>
__device__ __forceinline__ void lin_phase(Frame& F, int l) {
    { const int h = (F.vcu >> 6) & 3; LAS float* WG = (LAS float*)(F.lds + LN_WG);
      for (int i = F.tid; i < 16 * 64 + 64; i += NWAVES * 64) WG[i] = (i < 1024) ? F.gla_wg()[(size_t)l * 16 * 256 + (i >> 6) * 256 + h * 64 + (i & 63)] : F.gla_bg()[l * 256 + h * 64 + (i - 1024)];
      lds_sync(); }
    LinRaw A, B;
    lin_issue<OUT>(F, F.vcu, A);
    for (int u = F.vcu; u < 4096; u += 2 * F.G) {
        lin_issue<OUT>(F, u + F.G, B);
        if (OUT) lin_out_compute(F, u, A); else lin_state_compute(F, u, A);
        if (u + 2 * F.G < 4096) lin_issue<OUT>(F, u + 2 * F.G, A);
        if (OUT) lin_out_compute(F, u + F.G, B); else lin_state_compute(F, u + F.G, B);
    }
    lds_sync();
}
constexpr int L2_TOT = 0, L2_QD = 1024, L2_KI = 10240, L2_V = 19456, L2_SP = 37888, L2_PM = 56320, L2_STRIDE = 65536, L2_WG = 131072;
struct Lin2 { int unit, h, mixer, hw, s, c; size_t row0; LAS unsigned char* base; };
__device__ __forceinline__ void lin2_rot16(const u32x4 lo_, const u32x4 hi_, const f32x4 (&cs)[2], const f32x4 (&sn)[2], bool rot, float scale, float (&v)[16]) {
    float lo[8], hi[8]; unpack8(lo_, lo); unpack8(hi_, hi);
    if (!rot) {
#pragma unroll
        for (int j = 0; j < 8; ++j) { v[j] = lo[j] * scale; v[8 + j] = hi[j] * scale; }
    } else {
        const float c8[8] = {cs[0].x, cs[0].y, cs[0].z, cs[0].w, cs[1].x, cs[1].y, cs[1].z, cs[1].w}, s8[8] = {sn[0].x, sn[0].y, sn[0].z, sn[0].w, sn[1].x, sn[1].y, sn[1].z, sn[1].w};
#pragma unroll
        for (int j = 0; j < 8; ++j) { v[j] = (lo[j] * c8[j] - hi[j] * s8[j]) * scale; v[8 + j] = (hi[j] * c8[j] + lo[j] * s8[j]) * scale; }
    }
}
__device__ __forceinline__ void lin2_decay(Frame& F, const Lin2& L, const u32x4 gr0, const u32x4 gr1, float (&bcum)[16], float (&blast)[16]) {
    LAS float* TOT = (LAS float*)(L.base + L2_TOT);
    const int d0 = 8 * L.c;
    if (L.mixer == 0) {
        const float lg = __logf(1.0f - exp2f(-5.0f - (float)L.h));
#pragma unroll
        for (int j = 0; j < 16; ++j) { bcum[j] = (float)(L.s + 1) * lg; blast[j] = 64.0f * lg; }
        lds_sync();
        return;
    }
    const LAS float* WG = (const LAS float*)(F.lds + L2_WG);
    float grf[16]; { float a[8], b2[8]; unpack8(gr0, a); unpack8(gr1, b2);
#pragma unroll
        for (int j = 0; j < 8; ++j) { grf[j] = a[j]; grf[8 + j] = b2[j]; } }
    float x[16];
#pragma unroll
    for (int q = 0; q < 4; ++q) { const f32x4 b0 = *(const LAS f32x4*)(WG + 1024 + d0 + 32 * (q >> 1) + 4 * (q & 1)); x[4 * q] = b0.x; x[4 * q + 1] = b0.y; x[4 * q + 2] = b0.z; x[4 * q + 3] = b0.w; }
#pragma unroll
    for (int r = 0; r < 16; ++r) {
#pragma unroll
        for (int q = 0; q < 4; ++q) { const f32x4 w0 = *(const LAS f32x4*)(WG + r * 64 + d0 + 32 * (q >> 1) + 4 * (q & 1));
            x[4 * q] += grf[r] * w0.x; x[4 * q + 1] += grf[r] * w0.y; x[4 * q + 2] += grf[r] * w0.z; x[4 * q + 3] += grf[r] * w0.w; } }
#pragma unroll
    for (int j = 0; j < 16; ++j) x[j] = logsigmoidf_(x[j]) * (1.0f / 16.0f);
#pragma unroll
    for (int st = 4; st <= 32; st <<= 1) {
#pragma unroll
        for (int j = 0; j < 16; ++j) { const float t = lane_read(x[j], F.lane - st); if (F.lane >= st) x[j] += t; } }
    if ((F.lane >> 2) == 15) {
#pragma unroll
        for (int q = 0; q < 4; ++q) *(LAS f32x4*)(TOT + L.hw * 64 + d0 + 32 * (q >> 1) + 4 * (q & 1)) = (f32x4){x[4 * q], x[4 * q + 1], x[4 * q + 2], x[4 * q + 3]}; }
    lds_sync();
    float off[16], tot[16];
#pragma unroll
    for (int j = 0; j < 16; ++j) { off[j] = 0.f; tot[j] = 0.f; }
#pragma unroll
    for (int w = 0; w < 4; ++w) {
#pragma unroll
        for (int q = 0; q < 4; ++q) { const f32x4 t0 = *(const LAS f32x4*)(TOT + w * 64 + d0 + 32 * (q >> 1) + 4 * (q & 1)); const float tv[4] = {t0.x, t0.y, t0.z, t0.w};
#pragma unroll
            for (int j = 0; j < 4; ++j) { tot[4 * q + j] += tv[j]; off[4 * q + j] += (w < L.hw) ? tv[j] : 0.f; } } }
#pragma unroll
    for (int j = 0; j < 16; ++j) { bcum[j] = x[j] + off[j]; blast[j] = tot[j]; }
}
__device__ __forceinline__ bf16x8 tr_frag8(const LAS bf16_t* T, int pitch, int k0, int x0, int lane) {
    const int g = lane >> 4, i = lane & 15, q = i >> 2, p = i & 3;
    const LAS bf16_t* a = T + (k0 + 8 * g + q) * pitch + x0 + 8 * p;
    const v4s_t lo = __builtin_amdgcn_ds_read_tr16_b64_v4i16((LAS v4s_t*)a), hi = __builtin_amdgcn_ds_read_tr16_b64_v4i16((LAS v4s_t*)(a + 4 * pitch));
    return __builtin_shufflevector(lo, hi, 0, 1, 2, 3, 4, 5, 6, 7);
}
__device__ __forceinline__ void lin2_state(Frame& F, const Lin2& L) {
    const int ht = F.tid & 255, lane = F.lane, s = L.s, c = L.c, d0 = 8 * c;
    const int ck = (L.mixer == 0 ? C_RK : C_GK) + L.h * 64, cv = (L.mixer == 0 ? C_RV : C_GV) + L.h * 128;
    LAS bf16_t* KD = (LAS bf16_t*)(L.base + L2_KI); LAS bf16_t* VT = (LAS bf16_t*)(L.base + L2_V);
    const bf16_t* pr = F.PROJ() + (L.row0 + s) * LDP;
    u32x4 vv[4]; f32x4 cs[2], sn[2];
    const u32x4 klo = *(const u32x4*)(pr + ck + d0), khi = *(const u32x4*)(pr + ck + 32 + d0);
    u32x4 gr0 = (u32x4){0u, 0u, 0u, 0u}, gr1 = gr0;
    cs[0] = cs[1] = sn[0] = sn[1] = (f32x4){0.f, 0.f, 0.f, 0.f};
    if (L.mixer == 0) { const float* cp = F.rotc() + (L.row0 + s) * 32 + d0; const float* sp = F.rots() + (L.row0 + s) * 32 + d0;
      cs[0] = *(const f32x4*)cp; cs[1] = *(const f32x4*)(cp + 4); sn[0] = *(const f32x4*)sp; sn[1] = *(const f32x4*)(sp + 4); }
    else { gr0 = *(const u32x4*)(pr + C_GR); gr1 = *(const u32x4*)(pr + C_GR + 8); }
#pragma unroll
    for (int i = 0; i < 4; ++i) { const int idx = ht + 256 * i; vv[i] = *(const u32x4*)(F.PROJ() + (L.row0 + (idx >> 4)) * LDP + cv + (idx & 15) * 8); }
    float k[16], bcum[16], blast[16];
    lin2_rot16(klo, khi, cs, sn, L.mixer == 0, L.mixer == 0 ? 0.125f : 1.0f, k);
    lin2_decay(F, L, gr0, gr1, bcum, blast);
#pragma unroll
    for (int g = 0; g < 2; ++g) { float kd[8];
#pragma unroll
        for (int j = 0; j < 8; ++j) kd[j] = k[8 * g + j] * __expf(blast[8 * g + j] - bcum[8 * g + j]);
        *(LAS u32x4*)(KD + s * LP + d0 + 32 * g) = pack8(kd); }
#pragma unroll
    for (int i = 0; i < 4; ++i) { const int idx = ht + 256 * i; *(LAS u32x4*)(VT + (idx >> 4) * PV + (idx & 15) * 8) = vv[i]; }
    if (s == 0) { float* dc = F.DEC() + (size_t)L.unit * 64 + d0;
#pragma unroll
        for (int q = 0; q < 4; ++q) *(f32x4*)(dc + 32 * (q >> 1) + 4 * (q & 1)) = (f32x4){__expf(blast[4 * q]), __expf(blast[4 * q + 1]), __expf(blast[4 * q + 2]), __expf(blast[4 * q + 3])}; }
    lds_sync();
    { bf16_t* st = (bf16_t*)F.STATE() + (size_t)L.unit * 8192;
      const int dh = 32 * (L.hw & 1), eh = 64 * (L.hw >> 1);
      bf16x8 kf[2][2];
#pragma unroll
      for (int hh = 0; hh < 2; ++hh) { kf[hh][0] = tr_frag8(KD, LP, 0, dh + 4 * hh, lane); kf[hh][1] = tr_frag8(KD, LP, 32, dh + 4 * hh, lane); }
#pragma unroll
      for (int et = 0; et < 4; ++et) { const bf16x8 v0 = tr_frag(VT, PV, 0, eh + 16 * et, lane), v1 = tr_frag(VT, PV, 32, eh + 16 * et, lane);
          f32x4 a0 = (f32x4){0.f, 0.f, 0.f, 0.f}, a1 = a0;
          a0 = __builtin_amdgcn_mfma_f32_16x16x32_bf16(kf[0][0], v0, a0, 0, 0, 0); a0 = __builtin_amdgcn_mfma_f32_16x16x32_bf16(kf[0][1], v1, a0, 0, 0, 0);
          a1 = __builtin_amdgcn_mfma_f32_16x16x32_bf16(kf[1][0], v0, a1, 0, 0, 0); a1 = __builtin_amdgcn_mfma_f32_16x16x32_bf16(kf[1][1], v1, a1, 0, 0, 0);
          u32x4 w; w.x = pk2(a0[0], a0[1]); w.y = pk2(a0[2], a0[3]); w.z = pk2(a1[0], a1[1]); w.w = pk2(a1[2], a1[3]);
          *(u32x4*)(st + (eh + 16 * et + (lane & 15)) * 64 + dh + 8 * (lane >> 4)) = w; } }
}
__device__ __forceinline__ void lin2_out(Frame& F, const Lin2& L) {
    const int ht = F.tid & 255, lane = F.lane, lr = lane & 15, lq = lane >> 4, s = L.s, c = L.c, d0 = 8 * c;
    const int cq = (L.mixer == 0 ? C_RQ : C_GQ) + L.h * 64, ck = (L.mixer == 0 ? C_RK : C_GK) + L.h * 64, cv = (L.mixer == 0 ? C_RV : C_GV) + L.h * 128, cg = (L.mixer == 0 ? C_RG : C_GG) + L.h * 128;
    const int ycol = (L.mixer == 0 ? 0 : 1024) + L.h * 128;
    LAS bf16_t* QD = (LAS bf16_t*)(L.base + L2_QD); LAS bf16_t* KI = (LAS bf16_t*)(L.base + L2_KI); LAS bf16_t* VT = (LAS bf16_t*)(L.base + L2_V);
    LAS bf16_t* SP = (LAS bf16_t*)(L.base + L2_SP); LAS bf16_t* PM = (LAS bf16_t*)(L.base + L2_PM + L.hw * 2304);
    const bf16_t* pr = F.PROJ() + (L.row0 + s) * LDP;
    float q[16], k[16], bcum[16], blast[16];
    u32x4 vv[4], sv[4]; u32x4 gr0, gr1;
    { f32x4 cs[2], sn[2];
      const u32x4 klo = *(const u32x4*)(pr + ck + d0), khi = *(const u32x4*)(pr + ck + 32 + d0), qlo = *(const u32x4*)(pr + cq + d0), qhi = *(const u32x4*)(pr + cq + 32 + d0);
      gr0 = (u32x4){0u, 0u, 0u, 0u}; gr1 = gr0; cs[0] = cs[1] = sn[0] = sn[1] = (f32x4){0.f, 0.f, 0.f, 0.f};
      if (L.mixer == 0) { const float* cp = F.rotc() + (L.row0 + s) * 32 + d0; const float* sp = F.rots() + (L.row0 + s) * 32 + d0;
        cs[0] = *(const f32x4*)cp; cs[1] = *(const f32x4*)(cp + 4); sn[0] = *(const f32x4*)sp; sn[1] = *(const f32x4*)(sp + 4); }
      else { gr0 = *(const u32x4*)(pr + C_GR); gr1 = *(const u32x4*)(pr + C_GR + 8); }
#pragma unroll
      for (int i = 0; i < 4; ++i) { const int idx = ht + 256 * i; vv[i] = *(const u32x4*)(F.PROJ() + (L.row0 + (idx >> 4)) * LDP + cv + (idx & 15) * 8);
          sv[i] = *(const u32x4*)(F.SPREV() + (size_t)L.unit * 8192 + (size_t)idx * 8); }
      lin2_rot16(qlo, qhi, cs, sn, L.mixer == 0, L.mixer == 0 ? 1.0f : 0.125f, q);
      lin2_rot16(klo, khi, cs, sn, L.mixer == 0, L.mixer == 0 ? 0.125f : 1.0f, k); }
    lin2_decay(F, L, gr0, gr1, bcum, blast);
#pragma unroll
    for (int g = 0; g < 2; ++g) { float qd[8], ki[8];
#pragma unroll
        for (int j = 0; j < 8; ++j) { qd[j] = q[8 * g + j] * __expf(bcum[8 * g + j]); ki[j] = k[8 * g + j] * __expf(-bcum[8 * g + j]); }
        *(LAS u32x4*)(QD + s * LP + d0 + 32 * g) = pack8(qd); *(LAS u32x4*)(KI + s * LP + d0 + 32 * g) = pack8(ki); }
#pragma unroll
    for (int i = 0; i < 4; ++i) { const int idx = ht + 256 * i; *(LAS u32x4*)(VT + (idx >> 4) * PV + (idx & 15) * 8) = vv[i]; *(LAS u32x4*)(SP + (idx >> 3) * LP + (idx & 7) * 8) = sv[i]; }
    const bf16_t* gp = F.PROJ() + (L.row0 + 16 * L.hw + lr) * LDP + cg + 8 * lq;
    u32x4 gt[4];
#pragma unroll
    for (int pe = 0; pe < 4; ++pe) gt[pe] = *(const u32x4*)(gp + 32 * pe);
    lds_sync();
    const LAS bf16_t* qrow = QD + (16 * L.hw + lr) * LP + 8 * lq;
    const bf16x8 qf0 = *(const LAS bf16x8*)qrow, qf1 = *(const LAS bf16x8*)(qrow + 32);
#pragma unroll
    for (int st = 0; st < 4; ++st) {
        f32x4 acc = (f32x4){0.f, 0.f, 0.f, 0.f};
        if (st <= L.hw) { const LAS bf16_t* krow = KI + (16 * st + lr) * LP + 8 * lq;
            acc = __builtin_amdgcn_mfma_f32_16x16x32_bf16(*(const LAS bf16x8*)krow, qf0, acc, 0, 0, 0);
            acc = __builtin_amdgcn_mfma_f32_16x16x32_bf16(*(const LAS bf16x8*)(krow + 32), qf1, acc, 0, 0, 0); }
        float p[4];
#pragma unroll
        for (int i = 0; i < 4; ++i) p[i] = (st <= L.hw && 16 * st + 4 * lq + i <= 16 * L.hw + lr) ? acc[i] : 0.f;
        u32x2 w; w.x = pk2(p[0], p[1]); w.y = pk2(p[2], p[3]);
        *(LAS u32x2*)(PM + lr * LP + 16 * st + 4 * lq) = w; }
    asm volatile("s_waitcnt lgkmcnt(0)" ::: "memory");
    const bf16x8 pf0 = *(const LAS bf16x8*)(PM + lr * LP + 8 * lq), pf1 = *(const LAS bf16x8*)(PM + lr * LP + 32 + 8 * lq);
    f32x4 o[8];
    const int erow = 8 * (lr >> 2) + (lr & 3);
#pragma unroll
    for (int et = 0; et < 8; ++et) { const int e0 = 32 * (et >> 1) + 4 * (et & 1); f32x4 acc = (f32x4){0.f, 0.f, 0.f, 0.f};
        acc = __builtin_amdgcn_mfma_f32_16x16x32_bf16(tr_frag8(VT, PV, 0, e0, lane), pf0, acc, 0, 0, 0);
        acc = __builtin_amdgcn_mfma_f32_16x16x32_bf16(tr_frag8(VT, PV, 32, e0, lane), pf1, acc, 0, 0, 0);
        const LAS bf16_t* srow = SP + (e0 + erow) * LP + 8 * lq;
        acc = __builtin_amdgcn_mfma_f32_16x16x32_bf16(*(const LAS bf16x8*)srow, qf0, acc, 0, 0, 0);
        acc = __builtin_amdgcn_mfma_f32_16x16x32_bf16(*(const LAS bf16x8*)(srow + 32), qf1, acc, 0, 0, 0);
        o[et] = acc; }
    float sm = 0.f;
#pragma unroll
    for (int et = 0; et < 8; ++et) sm += (o[et][0] + o[et][1]) + (o[et][2] + o[et][3]);
    sm += lane_read(sm, lane ^ 16); sm += lane_read(sm, lane ^ 32);
    const float mu = sm * (1.0f / 128.0f); float qv = 0.f;
#pragma unroll
    for (int et = 0; et < 8; ++et) {
#pragma unroll
        for (int i = 0; i < 4; ++i) { const float dlt = o[et][i] - mu; qv += dlt * dlt; } }
    qv += lane_read(qv, lane ^ 16); qv += lane_read(qv, lane ^ 32);
    const float r = 1.0f / sqrtf(qv * (1.0f / 128.0f) + EPS);
    bf16_t* yp = F.Y() + (L.row0 + 16 * L.hw + lr) * D + ycol + 8 * lq;
#pragma unroll
    for (int pe = 0; pe < 4; ++pe) { float g[8], y[8]; unpack8(gt[pe], g);
#pragma unroll
        for (int j = 0; j < 8; ++j) y[j] = (o[2 * pe + (j >> 2)][j & 3] - mu) * r * siluf_(g[j]);
        *(u32x4*)(yp + 32 * pe) = pack8(y); }
}
template <bool OUT>
__device__ __forceinline__ void lin2_phase(Frame& F, int l) {
    { const int h = (F.vcu >> 6) & 3; LAS float* WG = (LAS float*)(F.lds + L2_WG);
      for (int i = F.tid; i < 16 * 64 + 64; i += NWAVES * 64) WG[i] = (i < 1024) ? F.gla_wg()[(size_t)l * 16 * 256 + (i >> 6) * 256 + h * 64 + (i & 63)] : F.gla_bg()[l * 256 + h * 64 + (i - 1024)];
      lds_sync(); }
    const int half = F.wave >> 2;
#pragma unroll 1
    for (int j = 0; j < 8; ++j) {
        Lin2 L; L.unit = F.vcu + 256 * (2 * j + half); L.h = (L.unit >> 6) & 3; asm volatile("" : "+s"(L.h)); L.mixer = L.unit >> 11; L.hw = F.wave & 3; L.s = (F.tid & 255) >> 2; L.c = F.tid & 3;
        L.row0 = (size_t)((L.unit >> 8) & 7) * SEQ + (size_t)(L.unit & 63) * CH; L.base = F.lds + half * L2_STRIDE;
        if (OUT) lin2_out(F, L); else lin2_state(F, L);
    }
    lds_sync();
}
__device__ __forceinline__ void lin_scan(Frame& F) {
    const int gt = F.vcu * (NWAVES * 64) + F.tid, NGT = F.G * NWAVES * 64;
    for (int i = gt; i < 64 * 2048; i += NGT) {
        const int seq = i >> 11, idx = (i & 2047) * 4, d = idx & 63;
        const bf16_t* st = (const bf16_t*)F.STATE() + (size_t)seq * NCH * 8192 + idx; const float* dc = F.DEC() + (size_t)seq * NCH * 64 + d; bf16_t* sp = F.SPREV() + (size_t)seq * NCH * 8192 + idx;
        float carry[4] = {0.f, 0.f, 0.f, 0.f}; asm volatile("" : "+v"(carry[0]), "+v"(carry[1]), "+v"(carry[2]), "+v"(carry[3]));
#pragma unroll 1
        for (int h = 0; h < 4; ++h) {
            u32x2 v[16]; f32x4 c[16];
#pragma unroll
            for (int n = 0; n < 16; ++n) { v[n] = *(const u32x2*)(st + (size_t)(16 * h + n) * 8192); c[n] = *(const f32x4*)(dc + (size_t)(16 * h + n) * 64); }
#pragma unroll
            for (int n = 0; n < 16; ++n) { u32x2 w; w.x = pk2(carry[0], carry[1]); w.y = pk2(carry[2], carry[3]); *(u32x2*)(sp + (size_t)(16 * h + n) * 8192) = w;
                carry[0] = c[n].x * carry[0] + bflo(v[n].x); carry[1] = c[n].y * carry[1] + bfhi(v[n].x); carry[2] = c[n].z * carry[2] + bflo(v[n].y); carry[3] = c[n].w * carry[3] + bfhi(v[n].y);
                asm volatile("" : "+v"(carry[0]), "+v"(carry[1]), "+v"(carry[2]), "+v"(carry[3])); }
        }
    }
}
constexpr int S5_WL = 16384, S5_BU = 2048, S5_X = 2048 + 8320;
template <bool OUT>
__device__ __forceinline__ void s5_pass(Frame& F, int l) {
    LAS bf16_t* UT = (LAS bf16_t*)(F.lds + F.wave * S5_WL); LAS float* BU = (LAS float*)(F.lds + F.wave * S5_WL + S5_BU); LAS bf16_t* X = (LAS bf16_t*)(F.lds + F.wave * S5_WL + S5_X);
    const int gw = F.vcu * NWAVES + F.wave, NGW = F.G * NWAVES, lane = F.lane, lr = lane & 15, lq = lane >> 4;
    u32x4 ua, uc;
    { const int g = gw & 31, n = (gw >> 5) & 63, b = gw >> 11; const bf16_t* up = F.PROJ() + ((size_t)b * SEQ + (size_t)n * CH + lane) * LDP + C_SU + g * 16; ua = *(const u32x4*)up; uc = *(const u32x4*)(up + 8); }
    const int g = gw & 31;
    const int gp = g * 64 + lane; const float ar = F.abar()[2 * gp], ai = F.abar()[2 * gp + 1];
    bf16x8 bfr[8];
#pragma unroll
    for (int q = 0; q < 8; ++q) { bfr[q] = (bf16x8){0, 0, 0, 0, 0, 0, 0, 0}; if (lq < 2) bfr[q] = *(const bf16x8*)(F.bbt() + ((size_t)g * 128 + 16 * q + lr) * 16 + 8 * lq); }
    bf16x8 cf[4]; float dsk = 0.f;
    if (OUT) {
#pragma unroll
        for (int ks = 0; ks < 4; ++ks) cf[ks] = *(const bf16x8*)(F.cmt() + ((size_t)(g * 16 + lr)) * 128 + 32 * ks + 8 * lq);
        dsk = F.s5_d()[(size_t)l * BW + g * 16 + lr]; }
    for (int unit = gw; unit < BATCH * NCH * 32; unit += NGW) {
        const int n = (unit >> 5) & 63, b = unit >> 11; const size_t row0 = (size_t)b * SEQ + (size_t)n * CH;
        *(LAS u32x4*)(UT + lane * 16) = ua; *(LAS u32x4*)(UT + lane * 16 + 8) = uc;
        if (unit + NGW < BATCH * NCH * 32) { const int un = unit + NGW, g2 = un & 31, n2 = (un >> 5) & 63, b2 = un >> 11;
            const bf16_t* up = F.PROJ() + ((size_t)b2 * SEQ + (size_t)n2 * CH + lane) * LDP + C_SU + g2 * 16; ua = *(const u32x4*)up; uc = *(const u32x4*)(up + 8); }
        float xr = 0.f, xi = 0.f;
        if (OUT) { const f32x2 x0 = *(const f32x2*)(F.XEND() + ((((size_t)(b * 32 + g)) * NCH + n) * 64 + lane) * 2); xr = x0.x; xi = x0.y; }
        LDS_WAIT();
        for (int sb = 0; sb < 4; ++sb) {
            bf16x8 af = (bf16x8){0, 0, 0, 0, 0, 0, 0, 0}; if (lq < 2) af = *(const LAS bf16x8*)(UT + (16 * sb + lr) * 16 + 8 * lq);
#pragma unroll
            for (int q = 0; q < 8; ++q) { f32x4 acc = (f32x4){0.f, 0.f, 0.f, 0.f}; acc = __builtin_amdgcn_mfma_f32_16x16x32_bf16(af, bfr[q], acc, 0, 0, 0);
#pragma unroll
                for (int i = 0; i < 4; ++i) BU[(4 * lq + i) * 130 + 16 * q + lr] = acc[i]; }
            LDS_WAIT();
            float br[16], bi[16];
#pragma unroll
            for (int tt = 0; tt < 16; ++tt) { br[tt] = BU[tt * 130 + lane]; bi[tt] = BU[tt * 130 + 64 + lane]; }
#pragma unroll
            for (int tt = 0; tt < 16; ++tt) { const float nr = ar * xr - ai * xi + br[tt], ni = ar * xi + ai * xr + bi[tt]; xr = nr; xi = ni; asm volatile("" : "+v"(xr), "+v"(xi));
                if (OUT) { X[tt * 136 + lane] = (bf16_t)f2bf(xr); X[tt * 136 + 64 + lane] = (bf16_t)f2bf(xi); } }
            if (OUT) {
                LDS_WAIT();
                f32x4 acc = (f32x4){0.f, 0.f, 0.f, 0.f}; const LAS bf16_t* xp = X + lr * 136 + 8 * lq;
#pragma unroll
                for (int ks = 0; ks < 4; ++ks) acc = __builtin_amdgcn_mfma_f32_16x16x32_bf16(*(const LAS bf16x8*)(xp + 32 * ks), cf[ks], acc, 0, 0, 0);
#pragma unroll
                for (int i = 0; i < 4; ++i) { const int tl = 16 * sb + 4 * lq + i; const float u = bflo((unsigned)UT[tl * 16 + lr]); const float y = gelu_tanh(acc[i] + dsk * u);
                    F.YBP()[(row0 + tl) * BW + g * 16 + lr] = (bf16_t)f2bf(y); }
            }
            LDS_WAIT();
        }
        if (!OUT) *(f32x2*)(F.XEND() + ((((size_t)(b * 32 + g)) * NCH + n) * 64 + lane) * 2) = (f32x2){xr, xi};
    }
}
__device__ __forceinline__ void s5_scan(Frame& F) {
    const int gt = F.vcu * (NWAVES * 64) + F.tid, NGT = F.G * NWAVES * 64;
    for (int i = gt; i < BATCH * 32 * 64; i += NGT) {
        const int p = i & 63, bg = i >> 6, g = bg & 31; const float pr = F.apow()[2 * (g * 64 + p)], pi = F.apow()[2 * (g * 64 + p) + 1];
        f32x2* xp = (f32x2*)(F.XEND() + (((size_t)bg * NCH) * 64 + p) * 2);
        float cr = 0.f, ci = 0.f; asm volatile("" : "+v"(cr), "+v"(ci));
#pragma unroll
        for (int h = 0; h < 2; ++h) {
            f32x2 v[32];
#pragma unroll
            for (int n = 0; n < 32; ++n) v[n] = xp[(size_t)(32 * h + n) * 64];
#pragma unroll
            for (int n = 0; n < 32; ++n) { xp[(size_t)(32 * h + n) * 64] = (f32x2){cr, ci};
                const float nr = pr * cr - pi * ci + v[n].x, ni = pr * ci + pi * cr + v[n].y; cr = nr; ci = ni; asm volatile("" : "+v"(cr), "+v"(ci)); }
        }
    }
}

constexpr int PWP = 136;
constexpr int PL_SC = 4 * 128 * PWP * 2;
template <int CTRL> __device__ __forceinline__ float dppf(float x) { return __builtin_bit_cast(float, __builtin_amdgcn_update_dpp(0, __builtin_bit_cast(int, x), CTRL, 0xf, 0xf, true)); }
template <int SH> __device__ __forceinline__ void pool_step(float (&c)[8], float (&p)[8], float mk) {
#pragma unroll
    for (int j = 0; j < 8; ++j) { const float nc = c[j] + dppf<0x110 + SH>(c[j]) + mk * dppf<0x120 + SH>(p[j]);
        p[j] = p[j] + dppf<0x110 + SH>(p[j]); c[j] = nc; }
}
__device__ __forceinline__ void pool_phase(Frame& F, int l) {
    const int gw = F.vcu * NWAVES + F.wave, NGW = F.G * NWAVES, lane = F.lane, lr = lane & 15, lq = lane >> 4;
    LAS bf16_t* PW = (LAS bf16_t*)F.lds; LAS float* PS = (LAS float*)(F.lds + PL_SC);
    wg_sync();
    for (int i = F.tid; i < 4 * 128 * 16; i += NWAVES * 64) { const int rowi = i >> 4, ch = i & 15; *(LAS u32x4*)(PW + rowi * PWP + 8 * ch) = *(const u32x4*)(F.poolw_t() + (size_t)rowi * 128 + 8 * ch); }
    if (F.tid < 128) *(LAS f32x4*)(PS + 4 * F.tid) = *(const f32x4*)(F.pool_scale() + (size_t)l * BW + 4 * F.tid);
    lds_sync();
    const int g = gw & 3, win = 2 << g;
    const int erow = 8 * (lr >> 2) + (lr & 3);
    for (int unit = gw; unit < BATCH * (SEQ / 16) * 4; unit += NGW) {
        const int tile = (unit >> 2) & 255, b = unit >> 10; const int tpos = 16 * tile + lr; const size_t row = (size_t)b * SEQ + tpos;
        const bf16_t* pp = F.PROJ() + row * LDP + C_PU + g * 128 + 8 * lq;
        u32x4 cur[4], prv[4];
#pragma unroll
        for (int ks = 0; ks < 4; ++ks) { cur[ks] = *(const u32x4*)(pp + 32 * ks); prv[ks] = (u32x4){0u, 0u, 0u, 0u}; }
        if (tile > 0) {
#pragma unroll
            for (int ks = 0; ks < 4; ++ks) prv[ks] = *(const u32x4*)(pp - (size_t)16 * LDP + 32 * ks); }
        const float inv = 1.0f / (float)min(tpos + 1, win);
        const float mk1 = lr < 1 ? 1.f : 0.f, mk2 = lr < 2 ? 1.f : 0.f, mk4 = lr < 4 ? 1.f : 0.f, mk8 = lr < 8 ? 1.f : 0.f;
        bf16x8 mf[4];
#pragma unroll
        for (int ks = 0; ks < 4; ++ks) { float a[8], c[8], p[8], m[8]; unpack8(cur[ks], a); unpack8(prv[ks], p);
#pragma unroll
            for (int j = 0; j < 8; ++j) c[j] = a[j];
            pool_step<1>(c, p, mk1);
            if (win > 2) pool_step<2>(c, p, mk2);
            if (win > 4) pool_step<4>(c, p, mk4);
            if (win > 8) pool_step<8>(c, p, mk8);
#pragma unroll
            for (int j = 0; j < 8; ++j) m[j] = c[j] * inv - a[j];
            const u32x4 w = pack8(m); mf[ks] = __builtin_bit_cast(bf16x8, w); }
        bf16_t* yp = F.Y() + row * D + 1536 + g * 128 + 8 * lq;
        int woff = (g * 128 + erow) * PWP + 8 * lq; asm volatile("" : "+v"(woff));
#pragma unroll
        for (int pe = 0; pe < 4; ++pe) { f32x4 acc[2];
#pragma unroll
            for (int hh = 0; hh < 2; ++hh) { acc[hh] = (f32x4){0.f, 0.f, 0.f, 0.f}; const LAS bf16_t* wr_ = PW + woff + (32 * pe + 4 * hh) * PWP;
#pragma unroll
                for (int ks = 0; ks < 4; ++ks) acc[hh] = __builtin_amdgcn_mfma_f32_16x16x32_bf16(*(const LAS bf16x8*)(wr_ + 32 * ks), mf[ks], acc[hh], 0, 0, 0); }
            const f32x4 s0 = *(const LAS f32x4*)(PS + g * 128 + 32 * pe + 8 * lq), s1 = *(const LAS f32x4*)(PS + g * 128 + 32 * pe + 8 * lq + 4);
            u32x4 w; w.x = pk2(acc[0][0] * s0.x, acc[0][1] * s0.y); w.y = pk2(acc[0][2] * s0.z, acc[0][3] * s0.w); w.z = pk2(acc[1][0] * s1.x, acc[1][1] * s1.y); w.w = pk2(acc[1][2] * s1.z, acc[1][3] * s1.w);
            *(u32x4*)(yp + 32 * pe) = w; }
    }
}

__device__ __forceinline__ void conv_fix_phase(Frame& F, int l) {
    const float* cw = F.conv_w() + (size_t)l * 3 * NUP; const float* cb = F.conv_b() + (size_t)l * NUP; const float* UH = F.UH();
    const int gt = F.vcu * (NWAVES * 64) + F.tid, NGT = F.G * NWAVES * 64;
    constexpr int JG = DFF / 4;
    for (int task = gt; task < (M / 256) * 2 * JG; task += NGT) {
        const int jg = task % JG, q = (task / JG) & 1, pm = task / (2 * JG);
        if ((pm & 15) == 0) continue;
        const int j0 = jg * 4, ucol = 256 * (j0 >> 7) + (j0 & 127);
        const float* u0p = UH + ((size_t)pm * 4 + q) * NUP + ucol;
        const float* u1p = (q == 1) ? UH + ((size_t)pm * 4 + 0) * NUP + ucol : UH + ((size_t)(pm - 1) * 4 + 3) * NUP + ucol;
        const float* u2p = (q == 1) ? UH + ((size_t)(pm - 1) * 4 + 3) * NUP + ucol : UH + ((size_t)(pm - 1) * 4 + 2) * NUP + ucol;
        const f32x4 a0 = *(const f32x4*)u0p, a1 = *(const f32x4*)u1p, a2 = *(const f32x4*)u2p, v0 = *(const f32x4*)(u0p + 128), v1 = *(const f32x4*)(u1p + 128), v2 = *(const f32x4*)(u2p + 128);
        const f32x4 wa0 = *(const f32x4*)(cw + j0), wa1 = *(const f32x4*)(cw + NUP + j0), wa2 = *(const f32x4*)(cw + 2 * NUP + j0), ba = *(const f32x4*)(cb + j0);
        const f32x4 wv0 = *(const f32x4*)(cw + DFF + j0), wv1 = *(const f32x4*)(cw + NUP + DFF + j0), wv2 = *(const f32x4*)(cw + 2 * NUP + DFF + j0), bv = *(const f32x4*)(cb + DFF + j0);
        float o[4];
#pragma unroll
        for (int i = 0; i < 4; ++i) { const float ca = ba[i] + wa0[i] * a2[i] + wa1[i] * a1[i] + wa2[i] * a0[i], cv = bv[i] + wv0[i] * v2[i] + wv1[i] * v1[i] + wv2[i] * v0[i]; o[i] = siluf_(ca) * cv; }
        u32x2 w; w.x = pk2(o[0], o[1]); w.y = pk2(o[2], o[3]);
        *(u32x2*)(F.ACT() + ((size_t)pm * 256 + q) * DFF + j0) = w;
    }
}

constexpr int NPH = 13;
struct Args { const void* in[25]; float* out; unsigned char* ws; int l_lo, l_hi, ph_lo, ph_hi, single, pad; };
__global__ void __launch_bounds__(NWAVES * 64, 2) hybrid_fwd(Args args) {
    extern __shared__ __attribute__((aligned(16))) unsigned char lds[];
    Frame F;
    F.lds = (LAS unsigned char*)lds;
    F.tid = threadIdx.x; F.lane = F.tid & 63; F.wave = __builtin_amdgcn_readfirstlane(F.tid >> 6);
    const int wave0 = F.wave;
    F.G = gridDim.x; { const int bx = blockIdx.x; F.vcu = (F.G % 8 == 0) ? (bx % 8) * (F.G / 8) + bx / 8 : bx; }
    unsigned char* ws = args.ws; F.ws = ws; F.out = args.out; F.l = 0;

    volatile LAS unsigned* MISC = (volatile LAS unsigned*)(F.lds + MISC_OFF);
    if (F.tid < 64) MISC[F.tid] = 0u;
    wg_sync();
    unsigned* ctl = (unsigned*)(ws + WS_CTL);
    XcdBarrier bar; bar.bar = ctl + CW_BAR; bar.x = 0; bar.st = nullptr;
    if (args.single) bar = xcd_barrier_post(ctl + CW_BAR, MISC);
#define GRID_BAR() do { if (args.single) xcd_barrier(bar); } while (0)
    const int lo = args.ph_lo, hi = args.ph_hi;
#define IN(k) (lo <= (k) && (k) < hi)
#define PH_BEGIN() do { unsigned z_ = 0u; asm volatile("" : "+v"(z_)); const int ln_ = (int)__builtin_amdgcn_mbcnt_hi(~0u, __builtin_amdgcn_mbcnt_lo(~0u, z_)); F.lane = ln_; F.tid = wave0 * 64 + ln_; F.wave = wave0; unsigned long long w_ = (unsigned long long)args.ws, o_ = (unsigned long long)args.out; asm volatile("" : "+s"(w_), "+s"(o_)); F.ws = (unsigned char*)(GAS unsigned char*)w_; F.out = (float*)(GAS float*)o_; } while (0)

    for (int l = args.l_lo; l < args.l_hi; ++l) {
        F.l = l;
        if (IN(0)) { PH_BEGIN(); phase_prep(F, l); GRID_BAR(); }
        if (IN(1)) { PH_BEGIN();
            { pg8::Gemm g{(const bf16_t*)F.HN8(), (const bf16_t*)F.W8(), M, 4 * D, D / 2, D / 2, D / 2}; pg8::StaticOrder S; S.init(M, 4 * D, F.G, (int)blockIdx.x); pg8::EpiProj E{F.PROJ(), LDP, 0, F.GF(), 1.0f / 64.0f};
              pg8::gemm_phase<pg8::EpiProj, true>(F.lds, g, S, E, F.tid); }
            PH_BEGIN();
            { pg8::Gemm g{F.HN(), F.win_t(), M, C_GR, D, D, D}; pg8::StaticOrder S; S.init(M, C_GR, F.G, (int)blockIdx.x); pg8::EpiProj E{F.PROJ(), LDP, 1 << 20, F.GF(), 1.0f};
              pg8::gemm_phase(F.lds, g, S, E, F.tid); }
            PH_BEGIN(); gr_pass(F);
            GRID_BAR(); }
        if (IN(2)) { PH_BEGIN(); lin2_phase<false>(F, l); PH_BEGIN();
            s5_pass<false>(F, l); pool_phase(F, l); wg_sync();
            GRID_BAR(); }
        if (IN(3)) { PH_BEGIN(); lin_scan(F); s5_scan(F); GRID_BAR(); }
        if (IN(4)) { PH_BEGIN(); lin2_phase<true>(F, l); PH_BEGIN();
            s5_pass<true>(F, l); wg_sync();
            GRID_BAR(); }
        if (IN(5)) { PH_BEGIN(); pg8::Gemm g{F.YBP(), F.wglu_t(), M, BW, BW, BW, BW}; pg8::StaticOrder S; S.init(M, BW, F.G, (int)blockIdx.x); pg8::EpiGlu E{F.YBP(), BW, F.Y() + BW, D};
            pg8::gemm_phase(F.lds, g, S, E, F.tid); GRID_BAR(); }
        if (IN(6)) { PH_BEGIN(); for (int i = 0; i < (F.vcu & 7); ++i) __builtin_amdgcn_s_sleep(56);
            pg8::Gemm g{F.Y(), F.wbr_t(), M, D, D, D, D}; pg8::StaticOrder S; S.init(M, D, F.G, (int)blockIdx.x); pg8::EpiMerge E{F.GF(), F.HN(), D};
            pg8::gemm_phase(F.lds, g, S, E, F.tid); GRID_BAR(); }
        if (IN(7)) { PH_BEGIN(); for (int i = 0; i < (F.vcu & 7); ++i) __builtin_amdgcn_s_sleep(50);
            pg8::Gemm g{F.HN(), F.wout_t(), M, D, D, D, D}; pg8::StaticOrder S; S.init(M, D, F.G, (int)blockIdx.x); pg8::EpiResid E{l == 0 ? (const void*)F.x() : (const void*)F.out, l == 0 ? 1 : 0, F.Y(), D, F.SS()};
            pg8::gemm_phase(F.lds, g, S, E, F.tid); GRID_BAR(); }
        if (IN(8)) { PH_BEGIN(); row_scale(F); GRID_BAR(); }
        if (IN(9)) { PH_BEGIN(); pg8::Gemm g{F.Y(), F.wup_t(), M, NUP, D, D, D}; pg8::StaticOrder S; S.init(M, NUP, F.G, (int)blockIdx.x); pg8::EpiConv E{F.conv_w() + (size_t)l * 3 * NUP, F.conv_b() + (size_t)l * NUP, F.ACT(), F.UH(), (LAS float*)(F.lds + pg8::STAGE_BYTES), F.RS()};
            pg8::gemm_phase(F.lds, g, S, E, F.tid); GRID_BAR(); }
        if (IN(10)) { PH_BEGIN(); conv_fix_phase(F, l); GRID_BAR(); }
        if (IN(11)) { PH_BEGIN(); for (int i = 0; i < (F.vcu & 7); ++i) __builtin_amdgcn_s_sleep(50);
            pg8::Gemm g{F.ACT(), F.wdn_t(), M, D, DFF, DFF, DFF}; pg8::StaticOrder S; S.init(M, D, F.G, (int)blockIdx.x); pg8::EpiResid E{(const void*)F.Y(), 0, l == DEPTH - 1 ? F.HN() : (bf16_t*)F.out, D, nullptr};
            pg8::gemm_phase(F.lds, g, S, E, F.tid); GRID_BAR(); }
        if (IN(12) && l == DEPTH - 1) { PH_BEGIN(); rms_rows16_to_f32(F, F.HN(), F.g_final(), F.out); }
    }
#undef IN
#undef PH_BEGIN
#undef GRID_BAR
}

#pragma clang attribute pop
extern "C" void kernel_launch(void* const* d_in, const int* in_sizes, int n_in, void* d_out, int out_size, void* d_ws, size_t ws_size, hipStream_t stream) {
    static int grid = 0;
    if (grid == 0) {
        if (n_in != 25 || in_sizes[0] != M * D || out_size != M * D || ws_size < WS_END) { fprintf(stderr, "kernel_launch: shape/workspace mismatch (n_in %d, in0 %d, out %d, ws %zu, need %zu); nothing launched\n", n_in, n_in > 0 ? in_sizes[0] : -1, out_size, ws_size, (size_t)WS_END); grid = -1; return; }
        int dev = 0, cus = 0, per_cu = 0;
        if (hipGetDevice(&dev) != hipSuccess || hipDeviceGetAttribute(&cus, hipDeviceAttributeMultiprocessorCount, dev) != hipSuccess) { grid = -1; return; }
        if (hipFuncSetAttribute((const void*)hybrid_fwd, hipFuncAttributeMaxDynamicSharedMemorySize, LDS_BYTES) != hipSuccess) { fprintf(stderr, "kernel_launch: hipFuncSetAttribute failed\n"); grid = -1; return; }
        if (hipOccupancyMaxActiveBlocksPerMultiprocessor(&per_cu, (const void*)hybrid_fwd, NWAVES * 64, LDS_BYTES) != hipSuccess || per_cu < 1) { fprintf(stderr, "kernel_launch: occupancy query reports %d workgroups per CU\n", per_cu); }
        (void)hipGetLastError();
        if (cus < 256) { fprintf(stderr, "kernel_launch: built for a 256-CU device (found %d CUs); nothing launched\n", cus); grid = -1; return; }
        grid = 256;
    }
    if (grid < 0) return;
    if (hipMemsetAsync((char*)d_ws + WS_CTL, 0, CTL_ZERO_BYTES, stream) != hipSuccess) return;
    Args a{};
    for (int i = 0; i < 25; ++i) a.in[i] = d_in[i];
    a.out = (float*)d_out; a.ws = (unsigned char*)d_ws;
#if MK_SINGLE
    a.l_lo = 0; a.l_hi = DEPTH; a.ph_lo = 0; a.ph_hi = NPH; a.single = 1;
    hipLaunchKernelGGL(hybrid_fwd, dim3(grid), dim3(NWAVES * 64), LDS_BYTES, stream, a);
#else
    a.single = 0;
    for (int l = 0; l < DEPTH; ++l)
        for (int p = 0; p < NPH; ++p) { if (p == 12 && l != DEPTH - 1) continue; a.l_lo = l; a.l_hi = l + 1; a.ph_lo = p; a.ph_hi = p + 1;
            hipLaunchKernelGGL(hybrid_fwd, dim3(grid), dim3(NWAVES * 64), LDS_BYTES, stream, a); }
#endif
}
```

```cpp
#include <hip/hip_runtime.h>
#include <cstdio>
#include <cstdint>

#ifndef MK_SINGLE
#define MK_SINGLE 1
#endif

#pragma clang attribute push(__attribute__((target("no-packed-fp32-ops"))), apply_to = function)
#define LAS __attribute__((address_space(3)))
#define GAS __attribute__((address_space(1)))
typedef unsigned short bf16_t;
typedef short bf16x8 __attribute__((ext_vector_type(8)));
typedef float f32x4 __attribute__((ext_vector_type(4)));
typedef float f32x2 __attribute__((ext_vector_type(2)));
typedef unsigned u32x4 __attribute__((ext_vector_type(4)));
typedef unsigned u32x2 __attribute__((ext_vector_type(2)));

constexpr int D = 2048, BATCH = 8, SEQ = 4096, DEPTH = 4, M = BATCH * SEQ;
constexpr int BW = 512;
constexpr int NIN_SRC = 12304, NIN = 12544;
constexpr int DFF = 5504, NUP = 11008;
constexpr int C_RQ = 0, C_RK = 256, C_RV = 512, C_RG = 1024, C_SU = 1536, C_GQ = 2048, C_GK = 2304, C_GV = 2560, C_GG = 3072, C_PU = 3584, C_GR = 4096, C_GATE = 4352;
constexpr int LDP = 4224;
constexpr float EPS = 1e-6f;
constexpr int NWAVES = 8;
constexpr int CH = 64;
constexpr int NCH = SEQ / CH;

constexpr size_t MiB = 1u << 20;
constexpr size_t WS_CTL = 0, CTL_ZERO_BYTES = 1 * MiB;
constexpr size_t WS_ROT = 1 * MiB;
constexpr size_t WS_S5T = 9 * MiB;
constexpr size_t S5T_ABAR = 0, S5T_APOW = 16384, S5T_BBAR = 32768, S5T_CMT = 32768 + 262144, S5T_BBT = S5T_CMT + 131072;
constexpr size_t WS_WGLU = 10 * MiB;
constexpr size_t WS_POOLW = 10 * MiB + 512 * 1024;
constexpr size_t WS_WIN = 11 * MiB;
constexpr size_t WS_WBR = 60 * MiB;
constexpr size_t WS_WOUT = 68 * MiB;
constexpr size_t WS_WUP = 76 * MiB;
constexpr size_t WS_WDN = 119 * MiB;
constexpr size_t WS_HN = 141 * MiB;
constexpr size_t WS_Y = 269 * MiB;
constexpr size_t WS_SCR = 397 * MiB;
constexpr size_t WS_YBP = WS_SCR;
constexpr size_t WS_STATE = WS_SCR + 32 * MiB;
constexpr size_t WS_SPREV = WS_SCR + 160 * MiB;
constexpr size_t WS_DEC = WS_SCR + 224 * MiB;
constexpr size_t WS_XEND = WS_SCR + 225 * MiB;
constexpr size_t WS_UH = WS_SCR + 128 * MiB;
constexpr size_t WS_PROJ = 637 * MiB;
constexpr size_t WS_GF = WS_PROJ + 264 * MiB;
constexpr size_t WS_ACT = WS_PROJ;
constexpr size_t WS_RS = 1421 * MiB;
constexpr size_t WS_SS = 1422 * MiB;
constexpr size_t WS_HN8 = 1438 * MiB;
constexpr size_t WS_W8 = 1502 * MiB;
constexpr size_t WS_END = 1518 * MiB;
static_assert(WS_PROJ + (size_t)M * LDP * 2 <= WS_GF && WS_GF + 4 * (size_t)M * D * 2 <= WS_RS, "ws map");
static_assert(WS_ACT + (size_t)M * DFF * 2 <= WS_RS, "ws map");
static_assert(WS_XEND + 8 * MiB <= WS_PROJ, "ws map");
static_assert(WS_UH + (size_t)(M / 256) * 4 * NUP * 4 <= WS_PROJ, "ws map");
constexpr int CW_TMO = 0, CW_BAR = 4096;

constexpr int LDS_BYTES = 155648;
constexpr int MISC_OFF = LDS_BYTES - 256;

#define RLX_AGENT __ATOMIC_RELAXED, __HIP_MEMORY_SCOPE_AGENT
__device__ __forceinline__ void lds_sync() { asm volatile("s_waitcnt lgkmcnt(0)" ::: "memory"); __builtin_amdgcn_s_barrier(); asm volatile("" ::: "memory"); }
__device__ __forceinline__ void wg_sync() { __builtin_amdgcn_fence(__ATOMIC_RELEASE, "workgroup"); __builtin_amdgcn_s_barrier(); __builtin_amdgcn_fence(__ATOMIC_ACQUIRE, "workgroup"); }
#define LDS_WAIT() asm volatile("s_waitcnt lgkmcnt(0)" ::: "memory")
#define VM_WAIT() asm volatile("s_waitcnt vmcnt(0)" ::: "memory")
__device__ __forceinline__ unsigned f2bf(float f) { unsigned u = __builtin_bit_cast(unsigned, f); return (u + 0x7fffu + ((u >> 16) & 1u)) >> 16; }
__device__ __forceinline__ unsigned pk2(float lo, float hi) { return f2bf(lo) | (f2bf(hi) << 16); }
__device__ __forceinline__ float bflo(unsigned w) { return __builtin_bit_cast(float, w << 16); }
__device__ __forceinline__ float bfhi(unsigned w) { return __builtin_bit_cast(float, w & 0xffff0000u); }
__device__ __forceinline__ void unpack8(const u32x4 w, float (&v)[8]) { v[0] = bflo(w.x); v[1] = bfhi(w.x); v[2] = bflo(w.y); v[3] = bfhi(w.y); v[4] = bflo(w.z); v[5] = bfhi(w.z); v[6] = bflo(w.w); v[7] = bfhi(w.w); }
__device__ __forceinline__ u32x4 pack8(const float (&v)[8]) { u32x4 w; w.x = pk2(v[0], v[1]); w.y = pk2(v[2], v[3]); w.z = pk2(v[4], v[5]); w.w = pk2(v[6], v[7]); return w; }
__device__ __forceinline__ unsigned pk4_fp8(float a, float b, float c, float d) { unsigned w = 0u; w = __builtin_amdgcn_cvt_pk_fp8_f32(a, b, w, false); w = __builtin_amdgcn_cvt_pk_fp8_f32(c, d, w, true); return w; }
__device__ __forceinline__ float sigmoidf_(float x) { return __builtin_amdgcn_rcpf(1.0f + __expf(-x)); }
__device__ __forceinline__ float siluf_(float x) { return x * __builtin_amdgcn_rcpf(1.0f + __expf(-x)); }
__device__ __forceinline__ float gelu_tanh(float x) { const float u = 1.5957691216f * (x + 0.044715f * x * x * x); return x * __builtin_amdgcn_rcpf(1.0f + __expf(-u)); }
__device__ __forceinline__ float logsigmoidf_(float x) { return fminf(x, 0.f) - __logf(1.0f + __expf(-fabsf(x))); }

namespace pg8 {
constexpr int BM = 256, BK = 64, HALF = 128, HTB = HALF * BK * 2, STAGE_BYTES = 8 * HTB, NXCD = 8, WGM = 4;
__host__ __device__ __forceinline__ int lds_byte(int r, int c) { const int st = (r >> 4) * 2 + (c >> 5), rr = r & 15, cc = c & 31, ob = rr * 64 + cc * 2; return st * 1024 + (ob ^ (((ob >> 9) & 1) << 5)); }
__host__ __device__ __forceinline__ void stage_rc(int b, int& R, int& C) { const int st = b / 1024, sb = b % 1024, swz = sb ^ (((sb >> 9) & 1) << 5); R = (st >> 1) * 16 + swz / 64; C = (st & 1) * 32 + (swz % 64) / 2; }
__host__ __device__ __forceinline__ int perm32(int rho) { const int n = rho >> 4, i = rho & 15; return 8 * (i >> 2) + 4 * n + (i & 3); }

struct Unit { int pm, pn; };
struct Gemm { const bf16_t* A; const bf16_t* Bt; int M, N, K, lda, ldb; };

struct StaticOrder {
    int nM, nN, nwg, G, c;
    __host__ __device__ void init(int M_, int N_, int G_, int c_) { nM = M_ / BM; nN = N_ / BM; nwg = nM * nN; G = G_; c = c_; }
    __host__ __device__ bool next(int i, Unit& u) const {
        const long L = (long)i * G + c; if (L >= nwg) return false;
        int wgid = (int)L; { const int q = nwg / NXCD, r = nwg % NXCD, xcd = wgid % NXCD, off = wgid / NXCD; wgid = (xcd < r ? xcd * (q + 1) : r * (q + 1) + (xcd - r) * q) + off; }
        const int nig = WGM * nN, gid = wgid / nig, fm = gid * WGM, gsz = (nM - fm) < WGM ? (nM - fm) : WGM;
        u.pm = fm + ((wgid % nig) % gsz); u.pn = (wgid % nig) / gsz; return true;
    }
};

__device__ __forceinline__ unsigned cvt_pk_bf16(float lo, float hi) { unsigned r; asm volatile("v_cvt_pk_bf16_f32 %0, %1, %2" : "=v"(r) : "v"(lo), "v"(hi)); return r; }

struct EpiStoreBf16 {
    static constexpr bool PERM = true, KHOOK = false;
    bf16_t* O; int ldc;
    __device__ __forceinline__ void khook(f32x4 (&)[2][2][4][2], const Unit&, int, int, int, int, int) const {}
    __device__ __forceinline__ void operator()(f32x4 (&acc)[2][2][4][2], const Unit& u, int wr, int wc, int fr, int fq) const {
        const int row0 = u.pm * BM + wr * 64 + fr, col0 = u.pn * BM + wc * 32 + 8 * fq;
#pragma unroll
        for (int ai = 0; ai < 2; ++ai)
#pragma unroll
            for (int m = 0; m < 4; ++m) { bf16_t* rowp = O + (size_t)(row0 + ai * HALF + m * 16) * ldc + col0;
#pragma unroll
                for (int bj = 0; bj < 2; ++bj) { const f32x4 v0 = acc[ai][bj][m][0], v1 = acc[ai][bj][m][1];
                    u32x4 w; w.x = cvt_pk_bf16(v0[0], v0[1]); w.y = cvt_pk_bf16(v0[2], v0[3]); w.z = cvt_pk_bf16(v1[0], v1[1]); w.w = cvt_pk_bf16(v1[2], v1[3]);
                    *(u32x4*)(rowp + bj * HALF) = w; } }
    }
};
struct EpiProj {
    static constexpr bool PERM = true, KHOOK = false;
    bf16_t* O; int ldc; int gate_pn0; bf16_t* GF; float gscale;
    __device__ __forceinline__ void khook(f32x4 (&)[2][2][4][2], const Unit&, int, int, int, int, int) const {}
    __device__ __forceinline__ void operator()(f32x4 (&acc)[2][2][4][2], const Unit& u, int wr, int wc, int fr_, int fq_) const {
        int fr = fr_, fq = fq_; asm volatile("" : "+v"(fr), "+v"(fq));
        const int row0 = u.pm * BM + wr * 64 + fr;
        if (u.pn < gate_pn0) {
            const int col0 = u.pn * BM + wc * 32 + 8 * fq;
#pragma unroll
            for (int ai = 0; ai < 2; ++ai)
#pragma unroll
                for (int m = 0; m < 4; ++m) { bf16_t* rowp = O + (size_t)(row0 + ai * HALF + m * 16) * ldc + col0;
#pragma unroll
                    for (int bj = 0; bj < 2; ++bj) { const f32x4 v0 = acc[ai][bj][m][0], v1 = acc[ai][bj][m][1];
                        u32x4 w; w.x = cvt_pk_bf16(v0[0], v0[1]); w.y = cvt_pk_bf16(v0[2], v0[3]); w.z = cvt_pk_bf16(v1[0], v1[1]); w.w = cvt_pk_bf16(v1[2], v1[3]);
                        *(u32x4*)(rowp + bj * HALF) = w; } }
        } else {
            const int t = u.pn - gate_pn0, c0 = 64 * t + 16 * wc + 4 * fq;
            const float kc = -1.4426950408889634f * gscale, KL = 30.0f * 1.4426950408889634f;
            const size_t gbase = ((size_t)((u.pm * 8 + (c0 >> 8)) * 4) * 16 + ((c0 >> 7) & 1)) * 4096 + (size_t)(((wr * 4 + ((c0 >> 5) & 3)) * 64 + ((c0 >> 3) & 3) * 16 + fr) * 8 + (c0 & 7));
#pragma unroll
            for (int ai = 0; ai < 2; ++ai)
#pragma unroll
                for (int m = 0; m < 4; ++m) { bf16_t* rowp = GF + gbase + (size_t)(ai * 8 + m * 2) * 4096;
                    float r1[4], r2[4], r3[4], g3[4];
#pragma unroll
                    for (int i = 0; i < 4; ++i) {
                        const float e0 = __builtin_amdgcn_exp2f(__builtin_amdgcn_fmed3f(acc[ai][0][m][0][i] * kc, -KL, KL)), e1 = __builtin_amdgcn_exp2f(__builtin_amdgcn_fmed3f(acc[ai][0][m][1][i] * kc, -KL, KL));
                        const float e2 = __builtin_amdgcn_exp2f(__builtin_amdgcn_fmed3f(acc[ai][1][m][0][i] * kc, -KL, KL)), e3 = __builtin_amdgcn_exp2f(__builtin_amdgcn_fmed3f(acc[ai][1][m][1][i] * kc, -KL, KL));
                        const float i0 = __builtin_amdgcn_rcpf(1.f + e0), i1 = __builtin_amdgcn_rcpf(1.f + e1), i2 = __builtin_amdgcn_rcpf(1.f + e2), i3 = __builtin_amdgcn_rcpf(1.f + e3);
                        r1[i] = (1.f + e1) * i0; r2[i] = (1.f + e2) * i1; r3[i] = (1.f + e3) * i2; g3[i] = i3; }
                    u32x2 w;
                    w.x = cvt_pk_bf16(r1[0], r1[1]); w.y = cvt_pk_bf16(r1[2], r1[3]); *(u32x2*)(rowp) = w;
                    w.x = cvt_pk_bf16(r2[0], r2[1]); w.y = cvt_pk_bf16(r2[2], r2[3]); *(u32x2*)(rowp + 16 * 4096) = w;
                    w.x = cvt_pk_bf16(r3[0], r3[1]); w.y = cvt_pk_bf16(r3[2], r3[3]); *(u32x2*)(rowp + 2 * 16 * 4096) = w;
                    w.x = cvt_pk_bf16(g3[0], g3[1]); w.y = cvt_pk_bf16(g3[2], g3[3]); *(u32x2*)(rowp + 3 * 16 * 4096) = w; }
        }
    }
};
__device__ __forceinline__ float dpp_ror1(float x) { return __builtin_bit_cast(float, __builtin_amdgcn_update_dpp(0, __builtin_bit_cast(int, x), 0x121, 0xf, 0xf, true)); }
__device__ __forceinline__ float dpp_ror2(float x) { return __builtin_bit_cast(float, __builtin_amdgcn_update_dpp(0, __builtin_bit_cast(int, x), 0x122, 0xf, 0xf, true)); }
struct EpiConv {
    static constexpr bool PERM = true, KHOOK = false;
    const float* cw; const float* cb; bf16_t* O; float* UH; LAS float* halo; const float* RS;
    __device__ __forceinline__ void khook(f32x4 (&)[2][2][4][2], const Unit&, int, int, int, int, int) const {}
    __device__ __forceinline__ void operator()(f32x4 (&acc)[2][2][4][2], const Unit& u, int wr, int wc, int fr_, int fq_) const {
        int fr = fr_, fq = fq_; asm volatile("" : "+v"(fr), "+v"(fq));
        const int cl0 = wc * 32 + 8 * fq;
        const int j0 = 128 * u.pn + cl0;
        const float* rp = RS + ((size_t)(u.pm * 2 + wr) * 16 + fr) * 8; const f32x4 rs0 = *(const f32x4*)rp, rs1 = *(const f32x4*)(rp + 4);
        f32x4 wa0[3], wv0[3];
#pragma unroll
        for (int q = 0; q < 3; ++q) { wa0[q] = *(const f32x4*)(cw + q * NUP + j0); wv0[q] = *(const f32x4*)(cw + q * NUP + DFF + j0); }
        const f32x4 ba0 = *(const f32x4*)(cb + j0), bv0 = *(const f32x4*)(cb + DFF + j0);
#pragma unroll
        for (int ai = 0; ai < 2; ++ai)
#pragma unroll
            for (int m = 0; m < 4; ++m) { const float r = ai == 0 ? rs0[m] : rs1[m];
#pragma unroll
                for (int bj = 0; bj < 2; ++bj)
#pragma unroll
                    for (int n = 0; n < 2; ++n) acc[ai][bj][m][n] *= r; }
        if (fr >= 14) {
#pragma unroll
            for (int ai = 0; ai < 2; ++ai)
#pragma unroll
                for (int bj = 0; bj < 2; ++bj)
#pragma unroll
                    for (int n = 0; n < 2; ++n) *(LAS f32x4*)(halo + (((2 * ai + wr) * 2 + (fr - 14)) * 256 + 128 * bj + cl0 + 4 * n)) = acc[ai][bj][3][n];
        }
        if (wr == 0 && fr < 2) {
#pragma unroll
            for (int bj = 0; bj < 2; ++bj)
#pragma unroll
                for (int n = 0; n < 2; ++n) *(f32x4*)(UH + ((size_t)u.pm * 4 + fr) * NUP + 256 * u.pn + 128 * bj + cl0 + 4 * n) = acc[0][bj][0][n];
        }
        if (wr == 1 && fr >= 14) {
#pragma unroll
            for (int bj = 0; bj < 2; ++bj)
#pragma unroll
                for (int n = 0; n < 2; ++n) *(f32x4*)(UH + ((size_t)u.pm * 4 + 2 + (fr - 14)) * NUP + 256 * u.pn + 128 * bj + cl0 + 4 * n) = acc[1][bj][3][n];
        }
        asm volatile("s_waitcnt lgkmcnt(0)" ::: "memory"); __builtin_amdgcn_s_barrier(); asm volatile("" ::: "memory");
        const bool is15 = fr == 15, ge14 = fr >= 14;
        unsigned keep[2][4][2];
        f32x4 wa1[3], wv1[3];
#pragma unroll
        for (int q = 0; q < 3; ++q) { wa1[q] = *(const f32x4*)(cw + q * NUP + j0 + 4); wv1[q] = *(const f32x4*)(cw + q * NUP + DFF + j0 + 4); }
        const f32x4 ba1 = *(const f32x4*)(cb + j0 + 4), bv1 = *(const f32x4*)(cb + DFF + j0 + 4);
#pragma unroll
        for (int n = 0; n < 2; ++n) {
            f32x4 wa[3], wv[3];
#pragma unroll
            for (int q = 0; q < 3; ++q) { wa[q] = n == 0 ? wa0[q] : wa1[q]; wv[q] = n == 0 ? wv0[q] : wv1[q]; }
            const f32x4 ba = n == 0 ? ba0 : ba1, bv = n == 0 ? bv0 : bv1;
#pragma unroll
            for (int ai = 0; ai < 2; ++ai) {
                const int blk = 2 * ai + wr;
                f32x4 pa = (f32x4){0.f, 0.f, 0.f, 0.f}, pv = (f32x4){0.f, 0.f, 0.f, 0.f};
                if (blk > 0 && ge14) { pa = *(const LAS f32x4*)(halo + (((blk - 1) * 2 + (fr - 14)) * 256 + cl0 + 4 * n)); pv = *(const LAS f32x4*)(halo + (((blk - 1) * 2 + (fr - 14)) * 256 + 128 + cl0 + 4 * n)); }
#pragma unroll
                for (int m = 0; m < 4; ++m) {
                    const f32x4 ca_ = acc[ai][0][m][n], cv_ = acc[ai][1][m][n]; float o[4];
#pragma unroll
                    for (int i = 0; i < 4; ++i) {
                        const float a1 = dpp_ror1(is15 ? pa[i] : ca_[i]), a2 = dpp_ror2(ge14 ? pa[i] : ca_[i]);
                        const float v1 = dpp_ror1(is15 ? pv[i] : cv_[i]), v2 = dpp_ror2(ge14 ? pv[i] : cv_[i]);
                        const float ca = ba[i] + wa[0][i] * a2 + wa[1][i] * a1 + wa[2][i] * ca_[i];
                        const float cv = bv[i] + wv[0][i] * v2 + wv[1][i] * v1 + wv[2][i] * cv_[i];
                        o[i] = siluf_(ca) * cv; }
                    pa = ca_; pv = cv_;
                    const unsigned lo = cvt_pk_bf16(o[0], o[1]), hi = cvt_pk_bf16(o[2], o[3]);
                    if (n == 0) { keep[ai][m][0] = lo; keep[ai][m][1] = hi; }
                    else { u32x4 w; w.x = keep[ai][m][0]; w.y = keep[ai][m][1]; w.z = lo; w.w = hi;
                        *(u32x4*)(O + (size_t)(u.pm * BM + ai * HALF + wr * 64 + m * 16 + fr) * DFF + j0) = w; }
                }
            }
        }
    }
};
struct EpiResid {
    static constexpr bool PERM = true, KHOOK = false;
    const void* base; int base_f32; bf16_t* O; int ldc; float* SS;
    __device__ __forceinline__ void khook(f32x4 (&)[2][2][4][2], const Unit&, int, int, int, int, int) const {}
    __device__ __forceinline__ void finish(const float (&b)[8], const f32x4 v0, const f32x4 v1, bf16_t* op, float& sq) const {
        const float o0 = b[0] + v0[0], o1 = b[1] + v0[1], o2 = b[2] + v0[2], o3 = b[3] + v0[3], o4 = b[4] + v1[0], o5 = b[5] + v1[1], o6 = b[6] + v1[2], o7 = b[7] + v1[3];
        u32x4 w; w.x = cvt_pk_bf16(o0, o1); w.y = cvt_pk_bf16(o2, o3); w.z = cvt_pk_bf16(o4, o5); w.w = cvt_pk_bf16(o6, o7);
        *(u32x4*)op = w;
        sq += ((o0 * o0 + o1 * o1) + (o2 * o2 + o3 * o3)) + ((o4 * o4 + o5 * o5) + (o6 * o6 + o7 * o7));
    }
    __device__ __forceinline__ void rowsum(float sq, const Unit& u, int wc, int fq, int lane, int row) const {
        sq += __builtin_bit_cast(float, __builtin_amdgcn_ds_bpermute((lane ^ 16) << 2, __builtin_bit_cast(int, sq)));
        sq += __builtin_bit_cast(float, __builtin_amdgcn_ds_bpermute((lane ^ 32) << 2, __builtin_bit_cast(int, sq)));
        if (fq == 0) SS[(size_t)(u.pn * 4 + wc) * M + row] = sq;
    }
    __device__ __forceinline__ void operator()(f32x4 (&acc)[2][2][4][2], const Unit& u, int wr, int wc, int fr_, int fq_) const {
        int fr = fr_, fq = fq_; asm volatile("" : "+v"(fr), "+v"(fq));
        const int row0 = u.pm * BM + wr * 64 + fr, col0 = u.pn * BM + wc * 32 + 8 * fq, lane = fq * 16 + fr;
        if (!base_f32) {
            u32x4 bw[2][4][2];
#pragma unroll
            for (int ai = 0; ai < 2; ++ai)
#pragma unroll
                for (int m = 0; m < 4; ++m)
#pragma unroll
                    for (int bj = 0; bj < 2; ++bj) bw[ai][m][bj] = *(const u32x4*)((const bf16_t*)base + (size_t)(row0 + ai * HALF + m * 16) * ldc + col0 + bj * HALF);
#pragma unroll
            for (int ai = 0; ai < 2; ++ai)
#pragma unroll
                for (int m = 0; m < 4; ++m) { const size_t off = (size_t)(row0 + ai * HALF + m * 16) * ldc + col0; float sq = 0.f;
#pragma unroll
                    for (int bj = 0; bj < 2; ++bj) { float b[8]; unpack8(bw[ai][m][bj], b); finish(b, acc[ai][bj][m][0], acc[ai][bj][m][1], O + off + bj * HALF, sq); }
                    if (SS) rowsum(sq, u, wc, fq, lane, row0 + ai * HALF + m * 16); }
        } else {
#pragma unroll
            for (int ai = 0; ai < 2; ++ai)
#pragma unroll
                for (int m = 0; m < 4; ++m) { const size_t off = (size_t)(row0 + ai * HALF + m * 16) * ldc + col0; float sq = 0.f;
#pragma unroll
                    for (int bj = 0; bj < 2; ++bj) { float b[8]; const float* bp = (const float*)base + off + bj * HALF; const f32x4 b0 = *(const f32x4*)bp, b1 = *(const f32x4*)(bp + 4);
                        b[0] = b0.x; b[1] = b0.y; b[2] = b0.z; b[3] = b0.w; b[4] = b1.x; b[5] = b1.y; b[6] = b1.z; b[7] = b1.w;
                        finish(b, acc[ai][bj][m][0], acc[ai][bj][m][1], O + off + bj * HALF, sq); }
                    if (SS) rowsum(sq, u, wc, fq, lane, row0 + ai * HALF + m * 16);
                    asm volatile("" ::: "memory"); }
        }
    }
};
struct EpiGlu {
    static constexpr bool PERM = true, KHOOK = false;
    const bf16_t* Yp; int ldy; bf16_t* O; int ldc;
    __device__ __forceinline__ void khook(f32x4 (&)[2][2][4][2], const Unit&, int, int, int, int, int) const {}
    __device__ __forceinline__ void operator()(f32x4 (&acc)[2][2][4][2], const Unit& u, int wr, int wc, int fr, int fq) const {
        const int row0 = u.pm * BM + wr * 64 + fr, col0 = u.pn * BM + wc * 32 + 8 * fq;
#pragma unroll
        for (int ai = 0; ai < 2; ++ai)
#pragma unroll
            for (int m = 0; m < 4; ++m) { const size_t r = (size_t)(row0 + ai * HALF + m * 16);
#pragma unroll
                for (int bj = 0; bj < 2; ++bj) { const u32x4 yw = *(const u32x4*)(Yp + r * ldy + col0 + bj * HALF); float y[8]; unpack8(yw, y);
                    const f32x4 v0 = acc[ai][bj][m][0], v1 = acc[ai][bj][m][1]; float o[8];
#pragma unroll
                    for (int j = 0; j < 4; ++j) { o[j] = y[j] * sigmoidf_(v0[j]); o[4 + j] = y[4 + j] * sigmoidf_(v1[j]); }
                    u32x4 w; w.x = cvt_pk_bf16(o[0], o[1]); w.y = cvt_pk_bf16(o[2], o[3]); w.z = cvt_pk_bf16(o[4], o[5]); w.w = cvt_pk_bf16(o[6], o[7]);
                    *(u32x4*)(O + r * ldc + col0 + bj * HALF) = w; } }
    }
};
struct EpiMerge {
    static constexpr bool PERM = true, KHOOK = true;
    const bf16_t* G; bf16_t* O; int ldc;
    __device__ __forceinline__ void scale(f32x4 (&acc)[2][2][4][2], const Unit& u, int s, int wr, int wc, int fr, int fq) const {
        int toff = ((wr * 4 + wc) * 64 + fq * 16 + fr) * 8; asm volatile("" : "+v"(toff));
        const bf16_t* gb = G + (size_t)(((u.pm * 8 + u.pn) * 4 + s) * 16) * 4096 + toff;
        u32x4 w[2][4][2];
#pragma unroll
        for (int ai = 0; ai < 2; ++ai)
#pragma unroll
            for (int m = 0; m < 4; ++m) {
#pragma unroll
                for (int bj = 0; bj < 2; ++bj) w[ai][m][bj] = *(const u32x4*)(gb + (size_t)(ai * 8 + m * 2 + bj) * 4096); }
#pragma unroll
        for (int ai = 0; ai < 2; ++ai)
#pragma unroll
            for (int m = 0; m < 4; ++m)
#pragma unroll
                for (int bj = 0; bj < 2; ++bj) { float f[8]; unpack8(w[ai][m][bj], f);
#pragma unroll
                    for (int j = 0; j < 8; ++j) acc[ai][bj][m][j >> 2][j & 3] *= f[j]; }
    }
    __device__ __forceinline__ void khook(f32x4 (&acc)[2][2][4][2], const Unit& u, int seg, int wr, int wc, int fr, int fq) const { scale(acc, u, seg - 1, wr, wc, fr, fq); }
    __device__ __forceinline__ void operator()(f32x4 (&acc)[2][2][4][2], const Unit& u, int wr, int wc, int fr, int fq) const {
        scale(acc, u, 3, wr, wc, fr, fq);
        const int row0 = u.pm * BM + wr * 64 + fr, col0 = u.pn * BM + wc * 32 + 8 * fq;
#pragma unroll
        for (int ai = 0; ai < 2; ++ai)
#pragma unroll
            for (int m = 0; m < 4; ++m) { bf16_t* rowp = O + (size_t)(row0 + ai * HALF + m * 16) * ldc + col0;
#pragma unroll
                for (int bj = 0; bj < 2; ++bj) { const f32x4 v0 = acc[ai][bj][m][0], v1 = acc[ai][bj][m][1];
                    u32x4 w; w.x = cvt_pk_bf16(v0[0], v0[1]); w.y = cvt_pk_bf16(v0[2], v0[3]); w.z = cvt_pk_bf16(v1[0], v1[1]); w.w = cvt_pk_bf16(v1[2], v1[3]);
                    *(u32x4*)(rowp + bj * HALF) = w; } }
    }
};

typedef int v4i_t __attribute__((ext_vector_type(4)));
typedef int v8i_t __attribute__((ext_vector_type(8)));
template <class Epi, bool F8 = false>
__device__ __forceinline__ void gemm_phase(LAS unsigned char* lds, const Gemm g, const StaticOrder& S, const Epi& E, int tid_in) {
    int tid_ = tid_in; asm volatile("" : "+v"(tid_));
    const int tid = tid_, wid = __builtin_amdgcn_readfirstlane(tid >> 6), lane = tid & 63, wr = wid >> 2, wc = wid & 3, fr = lane & 15, fq = lane >> 4;
    const int K = g.K, nt = K / BK;
    unsigned voffA[2], voffB[2];
#pragma unroll
    for (int i = 0; i < 2; ++i) { int R, C; stage_rc(tid * 16 + i * 8192, R, C); const int Rb = Epi::PERM ? ((R & ~31) + perm32(R & 31)) : R;
        voffA[i] = (unsigned)(R * g.lda + C) * 2u; voffB[i] = (unsigned)(Rb * g.ldb + C) * 2u; }
    const size_t kstep = (size_t)(BK * 2);
    const size_t hstepA = (size_t)HALF * g.lda * 2, hstepB = (size_t)HALF * g.ldb * 2;
    const size_t tstepA = 2 * hstepA, tstepB = 2 * hstepB;
    const unsigned ldsw = (unsigned)wid * 1024u;
    const int aoff = lds_byte(wr * 64 + fr, fq * 8), boff = lds_byte(wc * 32 + fr, fq * 8);
#define PG8_SA(b, h) (((b) * 2 + (h)) * HTB)
#define PG8_SB(b, h) ((4 + (b) * 2 + (h)) * HTB)
#define PG8_STAGE(bufoff, gbase, voff) do { _Pragma("unroll") for (int _i = 0; _i < 2; ++_i) \
        __builtin_amdgcn_global_load_lds((const unsigned*)((const char*)(gbase) + (voff)[_i]), (LAS unsigned*)(lds + (bufoff) + ldsw + _i * 8192), 16, 0, 0); } while (0)
#define PG8_LDA(dst, b, h) do { _Pragma("unroll") for (int m = 0; m < 4; ++m) _Pragma("unroll") for (int k = 0; k < 2; ++k) dst[m][k] = *(const LAS bf16x8*)(lds + PG8_SA(b, h) + aoff + m * 2048 + k * 1024); } while (0)
#define PG8_LDB(dst, b, h) do { _Pragma("unroll") for (int n = 0; n < 2; ++n) _Pragma("unroll") for (int k = 0; k < 2; ++k) dst[n][k] = *(const LAS bf16x8*)(lds + PG8_SB(b, h) + boff + n * 2048 + k * 1024); } while (0)
#define PG8_MMA(ai, bj, At, Bt) do { __builtin_amdgcn_s_setprio(1); _Pragma("unroll") for (int m = 0; m < 4; ++m) _Pragma("unroll") for (int n = 0; n < 2; ++n) _Pragma("unroll") for (int k = 0; k < 2; ++k) \
        acc[ai][bj][m][n] = __builtin_amdgcn_mfma_f32_16x16x32_bf16(Bt[n][k], At[m][k], acc[ai][bj][m][n], 0, 0, 0); __builtin_amdgcn_s_setprio(0); } while (0)
#define PG8_MMA16(ai, bj, At, Bt) PG8_MMA(ai, bj, At, Bt)
#define PG8_MMA8(ai, bj, A8, B8) do { __builtin_amdgcn_s_setprio(1); _Pragma("unroll") for (int m = 0; m < 4; ++m) _Pragma("unroll") for (int n = 0; n < 2; ++n) \
        asm volatile("v_mfma_f32_16x16x128_f8f6f4 %0, %1, %2, %0" : "+v"(acc[ai][bj][m][n]) : "v"(B8[n]), "v"(A8[m])); __builtin_amdgcn_s_setprio(0); } while (0)
#define PG8_LDA8(dst, b, h) do { _Pragma("unroll") for (int m = 0; m < 4; ++m) { dst[m].lo = *(const LAS v4i_t*)(lds + PG8_SA(b, h) + aoff + m * 2048); dst[m].hi = *(const LAS v4i_t*)(lds + PG8_SA(b, h) + aoff + m * 2048 + 1024); } } while (0)
#define PG8_LDB8(dst, b, h) do { _Pragma("unroll") for (int n = 0; n < 2; ++n) { dst[n].lo = *(const LAS v4i_t*)(lds + PG8_SB(b, h) + boff + n * 2048); dst[n].hi = *(const LAS v4i_t*)(lds + PG8_SB(b, h) + boff + n * 2048 + 1024); } } while (0)
#define PG8_XLDA(b, h) do { if constexpr (F8) PG8_LDA8(A8, b, h); else PG8_LDA(At, b, h); } while (0)
#define PG8_XLDB0(b, h) do { if constexpr (F8) PG8_LDB8(B08, b, h); else PG8_LDB(B0, b, h); } while (0)
#define PG8_XLDB1(b, h) do { if constexpr (F8) PG8_LDB8(B18, b, h); else PG8_LDB(B1, b, h); } while (0)
#define PG8_MM0(ai, bj) do { if constexpr (F8) PG8_MMA8(ai, bj, A8, B08); else PG8_MMA16(ai, bj, At, B0); } while (0)
#define PG8_MM1(ai, bj) do { if constexpr (F8) PG8_MMA8(ai, bj, A8, B18); else PG8_MMA16(ai, bj, At, B1); } while (0)
#define PG8_WAIT_V(n) asm volatile("s_waitcnt vmcnt(" #n ")" ::: "memory")
#define PG8_WAIT_L(n) asm volatile("s_waitcnt lgkmcnt(" #n ")" ::: "memory")
#define PG8_BAR __builtin_amdgcn_s_barrier()
#define PG8_SCHED __builtin_amdgcn_sched_barrier(0)
    Unit cur, nxt; int ui = 0;
    if (!S.next(0, cur)) return;
    f32x4 acc[2][2][4][2];
#pragma unroll
    for (int a = 0; a < 2; ++a)
#pragma unroll
        for (int b = 0; b < 2; ++b)
#pragma unroll
            for (int m = 0; m < 4; ++m)
#pragma unroll
                for (int n = 0; n < 2; ++n) acc[a][b][m][n] = (f32x4){0.f, 0.f, 0.f, 0.f};
    bf16x8 At[4][2], B0[2][2], B1[2][2]; v8i_t A8[4], B08[2], B18[2];
    const char* cA = (const char*)g.A + (size_t)cur.pm * tstepA; const char* cB = (const char*)g.Bt + (size_t)cur.pn * tstepB;
    PG8_STAGE(PG8_SB(0, 0), cB, voffB); PG8_STAGE(PG8_SB(0, 1), cB + hstepB, voffB); PG8_STAGE(PG8_SA(0, 0), cA, voffA); PG8_STAGE(PG8_SA(0, 1), cA + hstepA, voffA);
    if (wr == 1) PG8_BAR;
    PG8_WAIT_V(2); PG8_BAR;
    PG8_STAGE(PG8_SB(1, 0), cB + kstep, voffB); PG8_STAGE(PG8_SA(1, 0), cA + kstep, voffA); PG8_STAGE(PG8_SB(1, 1), cB + hstepB + kstep, voffB);
    PG8_WAIT_V(6); PG8_BAR;
    for (;;) {
        const bool has_next = S.next(ui + 1, nxt);
        const char* nA = has_next ? (const char*)g.A + (size_t)nxt.pm * tstepA : cA; const char* nB = has_next ? (const char*)g.Bt + (size_t)nxt.pn * tstepB : cB;
        for (int t = 0; t < nt; t += 2) {
            const bool last = (t == nt - 2);
            const char* a1 = cA + (size_t)(t + 1) * kstep;
            const char* a2 = last ? nA : cA + (size_t)(t + 2) * kstep; const char* b2 = last ? nB : cB + (size_t)(t + 2) * kstep;
            const char* a3 = a2 + kstep; const char* b3 = b2 + kstep;
            if constexpr (Epi::KHOOK) { if (t != 0 && (t & 7) == 0) E.khook(acc, cur, t >> 3, wr, wc, fr, fq); }
            PG8_XLDB0(0, 0); PG8_XLDB1(0, 1); PG8_SCHED; PG8_XLDA(0, 0); PG8_STAGE(PG8_SA(1, 1), a1 + hstepA, voffA);
            PG8_WAIT_V(8); PG8_WAIT_L(0); PG8_BAR; PG8_MM0(0, 0); PG8_MM1(0, 1); PG8_BAR; PG8_SCHED;
            PG8_XLDA(0, 1); PG8_STAGE(PG8_SB(0, 0), b2, voffB); PG8_STAGE(PG8_SB(0, 1), b2 + hstepB, voffB); PG8_STAGE(PG8_SA(0, 0), a2, voffA);
            PG8_WAIT_V(8); PG8_WAIT_L(0); PG8_BAR; PG8_MM0(1, 0); PG8_MM1(1, 1); PG8_BAR; PG8_SCHED;
            PG8_XLDB0(1, 0); PG8_XLDB1(1, 1); PG8_SCHED; PG8_XLDA(1, 0); PG8_STAGE(PG8_SA(0, 1), a2 + hstepA, voffA);
            PG8_WAIT_V(8); PG8_WAIT_L(0); PG8_BAR; PG8_MM0(0, 0); PG8_MM1(0, 1); PG8_BAR; PG8_SCHED;
            PG8_XLDA(1, 1); PG8_STAGE(PG8_SB(1, 0), b3, voffB); PG8_STAGE(PG8_SB(1, 1), b3 + hstepB, voffB); PG8_STAGE(PG8_SA(1, 0), a3, voffA);
            PG8_WAIT_V(8); PG8_WAIT_L(0); PG8_BAR; PG8_MM0(1, 0); PG8_MM1(1, 1); PG8_BAR; PG8_SCHED;
        }
        if (wr == 0) PG8_BAR;
        E(acc, cur, wr, wc, fr, fq);
        if (!has_next) break;
#pragma unroll
        for (int a = 0; a < 2; ++a)
#pragma unroll
            for (int b = 0; b < 2; ++b)
#pragma unroll
                for (int m = 0; m < 4; ++m)
#pragma unroll
                    for (int n = 0; n < 2; ++n) acc[a][b][m][n] = (f32x4){0.f, 0.f, 0.f, 0.f};
        cur = nxt; cA = nA; cB = nB; ++ui;
        if (wr == 1) PG8_BAR;
    }
    PG8_WAIT_V(0);
    PG8_BAR;
#undef PG8_SA
#undef PG8_SB
#undef PG8_STAGE
#undef PG8_LDA
#undef PG8_LDB
#undef PG8_MMA
#undef PG8_MMA8
#undef PG8_MMA16
#undef PG8_LDA8
#undef PG8_LDB8
#undef PG8_XLDA
#undef PG8_XLDB0
#undef PG8_XLDB1
#undef PG8_MM0
#undef PG8_MM1
#undef PG8_WAIT_V
#undef PG8_WAIT_L
#undef PG8_BAR
#undef PG8_SCHED
}
}

#define XB_TMO      128
#define XB_XCNT(j)  (256  + 64 * (j))
#define XB_XSUB(j)  (1280 + 64 * (j))
#define XB_XGEN(j)  (2304 + 64 * (j))
#define XB_TOP      3328
#define XB_TOPGEN   3392
#define XCD_BAR_WORDS 3456
#define XB_SPIN_CAP (1u << 18)
__device__ __forceinline__ unsigned xb_ld(unsigned* p)              { return __hip_atomic_load(p, __ATOMIC_RELAXED, __HIP_MEMORY_SCOPE_AGENT); }
__device__ __forceinline__ unsigned xb_add(unsigned* p, unsigned v) { return __hip_atomic_fetch_add(p, v, __ATOMIC_RELAXED, __HIP_MEMORY_SCOPE_AGENT); }
__device__ __forceinline__ unsigned xb_xcc_id() { return (unsigned)__builtin_amdgcn_s_getreg((3 << 11) | 20) & 0xFu; }
#define XB_SPIN(cond, bar) do { unsigned _sp = 0; while (cond) { __builtin_amdgcn_s_sleep(1); \
    if ((++_sp & 255u) == 0u) { if (xb_ld(&(bar)[XB_TMO])) break; if (_sp > XB_SPIN_CAP) { (void)__hip_atomic_fetch_add(&(bar)[XB_TMO], 1u, __ATOMIC_RELAXED, __HIP_MEMORY_SCOPE_AGENT); break; } } } } while (0)
struct XcdBarrier { unsigned* bar; unsigned x; volatile LAS unsigned* st; };
__device__ __forceinline__ XcdBarrier xcd_barrier_post(unsigned* bar, volatile LAS unsigned* st) {
    XcdBarrier b; b.bar = bar; b.x = xb_xcc_id(); b.st = st;
    if (threadIdx.x == 0) (void)xb_add(&bar[XB_XCNT(b.x)], 1u);
    return b;
}
__device__ __forceinline__ void xcd_barrier_complete(unsigned* bar, unsigned x, unsigned& nloc, unsigned& nx) {
    const unsigned G = gridDim.x * gridDim.y * gridDim.z;
    unsigned sum, cnt, mine, sp = 0u;
    for (;;) {
        sum = 0u; cnt = 0u; mine = 0u;
#pragma nounroll
        for (unsigned j = 0; j < 16; ++j) { const unsigned c = xb_ld(&bar[XB_XCNT(j)]); sum += c; cnt += (c > 0u) ? 1u : 0u; mine = (j == x) ? c : mine; }
        if (sum == G) break;
        __builtin_amdgcn_s_sleep(1);
        if ((++sp & 255u) == 0u) { if (xb_ld(&bar[XB_TMO])) break; if (sp > XB_SPIN_CAP) { (void)__hip_atomic_fetch_add(&bar[XB_TMO], 1u, __ATOMIC_RELAXED, __HIP_MEMORY_SCOPE_AGENT); break; } }
    }
    nloc = mine > 0u ? mine : 1u; nx = cnt > 0u ? cnt : 1u;
}
__device__ __forceinline__ void xcd_barrier(const XcdBarrier& b) {
    asm volatile("s_waitcnt vmcnt(0)" ::: "memory");
    wg_sync();
    if (threadIdx.x == 0) {
        unsigned* bar = b.bar;
        __builtin_amdgcn_s_waitcnt(0);
        unsigned nloc = b.st[0], nx = b.st[1];
        if (nloc == 0u) { xcd_barrier_complete(bar, b.x, nloc, nx); b.st[0] = nloc; b.st[1] = nx; }
        const unsigned old = xb_add(&bar[XB_XSUB(b.x)], 1u);
        const unsigned gen = old / nloc;
        if (old + 1u == (gen + 1u) * nloc) {
            __builtin_amdgcn_fence(__ATOMIC_RELEASE, "agent");
            asm volatile("s_waitcnt vmcnt(0)" ::: "memory");
            const unsigned og = xb_add(&bar[XB_TOP], 1u);
            const unsigned tg = og / nx;
            if (og + 1u == (tg + 1u) * nx) xb_add(&bar[XB_TOPGEN], 1u);
            else XB_SPIN(xb_ld(&bar[XB_TOPGEN]) == tg, bar);
            __builtin_amdgcn_fence(__ATOMIC_ACQUIRE, "agent");
            xb_add(&bar[XB_XGEN(b.x)], 1u);
            asm volatile("s_waitcnt vmcnt(0)" ::: "memory");
        } else {
            XB_SPIN(xb_ld(&bar[XB_XGEN(b.x)]) == gen, bar);
            __builtin_amdgcn_fence(__ATOMIC_ACQUIRE, "agent");
            asm volatile("s_waitcnt vmcnt(0)" ::: "memory");
        }
    }
    wg_sync();
}

__device__ __forceinline__ const void* kin(int k) {
    typedef __attribute__((address_space(4))) const char* kptr_t;
    kptr_t p = (kptr_t)__builtin_amdgcn_kernarg_segment_ptr(); asm volatile("" : "+s"(p));
    const unsigned long long v = *(__attribute__((address_space(4))) const unsigned long long*)(p + 8 * k);
    return (const void*)(GAS const void*)v;
}
struct Frame {
    LAS unsigned char* lds;
    int tid, lane, wave, vcu, G, l;
    unsigned char* ws; float* out;
#define FIN(name, T, k) __device__ __forceinline__ const T* name() const { return (const T*)kin(k); }
    FIN(x, float, 0) FIN(pos, int, 1) FIN(g_mix, float, 2) FIN(w_in, float, 3) FIN(a_re, float, 4) FIN(a_im, float, 5) FIN(log_dt, float, 6) FIN(b_re, float, 7) FIN(b_im, float, 8)
    FIN(c_re, float, 9) FIN(c_im, float, 10) FIN(s5_d, float, 11) FIN(w_glu, float, 12) FIN(gla_wg, float, 13) FIN(gla_bg, float, 14) FIN(pool_w, float, 15) FIN(pool_scale, float, 16)
    FIN(w_branch, float, 17) FIN(w_out, float, 18) FIN(g_ffn, float, 19) FIN(w_up, float, 20) FIN(conv_w, float, 21) FIN(conv_b, float, 22) FIN(w_down, float, 23) FIN(g_final, float, 24)
#undef FIN
#define FWS(name, T, off) __device__ __forceinline__ T* name() const { return (T*)(ws + (off)); }
    FWS(rotc, float, WS_ROT) FWS(rots, float, WS_ROT + (size_t)M * 32 * 4) FWS(abar, float, WS_S5T + S5T_ABAR) FWS(apow, float, WS_S5T + S5T_APOW) FWS(bbar, float, WS_S5T + S5T_BBAR) FWS(cmt, bf16_t, WS_S5T + S5T_CMT) FWS(bbt, bf16_t, WS_S5T + S5T_BBT)
    FWS(wglu_t, bf16_t, WS_WGLU) FWS(poolw_t, bf16_t, WS_POOLW) FWS(win_t, bf16_t, WS_WIN) FWS(wbr_t, bf16_t, WS_WBR) FWS(wout_t, bf16_t, WS_WOUT) FWS(wup_t, bf16_t, WS_WUP) FWS(wdn_t, bf16_t, WS_WDN)
    FWS(HN8, unsigned char, WS_HN8) FWS(W8, unsigned char, WS_W8) FWS(HN, bf16_t, WS_HN) FWS(Y, bf16_t, WS_Y) FWS(YBP, bf16_t, WS_YBP) FWS(PROJ, bf16_t, WS_PROJ) FWS(GF, bf16_t, WS_GF) FWS(SPREV, bf16_t, WS_SPREV) FWS(ACT, bf16_t, WS_ACT)
    FWS(SS, float, WS_SS + (size_t)l * 32 * M * 4) FWS(RS, float, WS_RS + (size_t)l * M * 4) FWS(STATE, float, WS_STATE) FWS(DEC, float, WS_DEC) FWS(XEND, float, WS_XEND) FWS(UH, float, WS_UH)
#undef FWS
};

__device__ __forceinline__ float lane_read(float v, int src_lane) { return __builtin_bit_cast(float, __builtin_amdgcn_ds_bpermute(src_lane << 2, __builtin_bit_cast(int, v))); }
__device__ __forceinline__ float wave_sum(float v, int lane) {
#pragma unroll
    for (int o = 1; o < 64; o <<= 1) v += lane_read(v, lane ^ o);
    return v;
}

template <class SrcCol>
__device__ __forceinline__ void transpose_item(const float* W, int Nsrc, bf16_t* WT, int ldt, int kdst0, int k0, int n0, SrcCol srccol, LAS float* scr, int lane, const float* kscale = nullptr) {
    const int sc = srccol(n0 + (lane & 31));
    float wv[32];
#pragma unroll
    for (int i = 0; i < 32; ++i) { const int kk = 2 * i + (lane >> 5); wv[i] = sc >= 0 ? W[(size_t)(k0 + kk) * Nsrc + sc] : 0.f; }
#pragma unroll
    for (int i = 0; i < 32; ++i) { const int kk = 2 * i + (lane >> 5); scr[kk * 33 + (lane & 31)] = kscale ? wv[i] * kscale[k0 + kk] : wv[i]; }
    LDS_WAIT();
    const int c = lane & 7;
#pragma unroll
    for (int j = 0; j < 4; ++j) { const int n = (lane >> 3) + 8 * j; const LAS float* s = scr + (8 * c) * 33 + n;
        u32x4 o; o.x = pk2(s[0 * 33], s[1 * 33]); o.y = pk2(s[2 * 33], s[3 * 33]); o.z = pk2(s[4 * 33], s[5 * 33]); o.w = pk2(s[6 * 33], s[7 * 33]);
        *(u32x4*)(WT + (size_t)(n0 + n) * ldt + kdst0 + k0 + 8 * c) = o; }
    LDS_WAIT();
}
template <class SrcCol>
__device__ __forceinline__ void transpose_item_fp8(const float* W, int Nsrc, unsigned char* WT, int ldt, int k0, int n0src, int n0dst, SrcCol srccol, LAS float* scr, int lane, const float* kscale, float scale) {
    const int sc = srccol(n0src + (lane & 31));
    float wv[32];
#pragma unroll
    for (int i = 0; i < 32; ++i) { const int kk = 2 * i + (lane >> 5); wv[i] = sc >= 0 ? W[(size_t)(k0 + kk) * Nsrc + sc] : 0.f; }
#pragma unroll
    for (int i = 0; i < 32; ++i) { const int kk = 2 * i + (lane >> 5); scr[kk * 33 + (lane & 31)] = (kscale ? wv[i] * kscale[k0 + kk] : wv[i]) * scale; }
    LDS_WAIT();
    const int c = lane & 7;
#pragma unroll
    for (int j = 0; j < 4; ++j) { const int n = (lane >> 3) + 8 * j; const LAS float* s = scr + (8 * c) * 33 + n;
        u32x2 o; o.x = pk4_fp8(s[0 * 33], s[1 * 33], s[2 * 33], s[3 * 33]); o.y = pk4_fp8(s[4 * 33], s[5 * 33], s[6 * 33], s[7 * 33]);
        *(u32x2*)(WT + (size_t)(n0dst + n) * ldt + k0 + 8 * c) = o; }
    LDS_WAIT();
}
struct ColIdent { __device__ __forceinline__ int operator()(int n) const { return n; } };
struct ColWin { __device__ __forceinline__ int operator()(int n) const {
    if (n < 3584) return n; if (n < 4096) return n + 16; if (n < 4112) return n - 512; if (n < 4352) return -1;
    const int t = (n - 4352) >> 8, cl = (n - 4352) & 255; const int br = 2 * (cl >> 7) + ((cl >> 2) & 1), ch = 16 * ((cl >> 5) & 3) + 4 * ((cl >> 3) & 3) + (cl & 3);
    return 4112 + br * 2048 + 64 * t + ch; } };
struct ColWup { __device__ __forceinline__ int operator()(int n) const { const int blk = n >> 8, r = n & 255; return (r < 128) ? (blk * 128 + r) : (DFF + blk * 128 + (r - 128)); } };

__device__ __forceinline__ void rms_row_to_bf16(const float* xrow, const float* g, bf16_t* orow, int lane, unsigned char* orow8 = nullptr) {
    const f32x4* xr = (const f32x4*)xrow + lane; const f32x4* gr = (const f32x4*)g + lane;
    f32x4 v[8]; float s = 0.f;
#pragma unroll
    for (int j = 0; j < 8; ++j) { v[j] = xr[64 * j]; s += (v[j].x * v[j].x + v[j].y * v[j].y) + (v[j].z * v[j].z + v[j].w * v[j].w); }
    const float r = 1.0f / sqrtf(wave_sum(s, lane) * (1.f / D) + EPS);
    u32x2* o8 = (u32x2*)orow + lane;
#pragma unroll
    for (int j = 0; j < 8; ++j) { const f32x4 gg = gr[64 * j]; const float a = v[j].x * r * gg.x, b = v[j].y * r * gg.y, c = v[j].z * r * gg.z, d = v[j].w * r * gg.w; u32x2 w; w.x = pk2(a, b); w.y = pk2(c, d); o8[64 * j] = w;
        if (orow8) ((unsigned*)orow8)[lane + 64 * j] = pk4_fp8(a, b, c, d); }
}
__device__ __forceinline__ void rms_rows(Frame& F, const float* src, const float* g, bf16_t* dst, unsigned char* dst8 = nullptr) {
    const int gw = F.vcu * NWAVES + F.wave, NGW = F.G * NWAVES;
    for (int m = gw; m < M; m += NGW) rms_row_to_bf16(src + (size_t)m * D, g, dst + (size_t)m * D, F.lane, dst8 ? dst8 + (size_t)m * D : nullptr);
}
__device__ __forceinline__ void row_scale(Frame& F) {
    const int gt = F.vcu * (NWAVES * 64) + F.tid, NGT = F.G * NWAVES * 64;
    for (int m = gt; m < M; m += NGT) { float s = 0.f;
#pragma unroll
        for (int j = 0; j < 32; ++j) s += F.SS()[(size_t)j * M + m];
        const int r = m & 255;
        F.RS()[((size_t)((m >> 8) * 2 + ((r >> 6) & 1)) * 16 + (r & 15)) * 8 + (r >> 7) * 4 + ((r >> 4) & 3)] = 1.0f / sqrtf(s * (1.f / D) + EPS); }
}
__device__ __forceinline__ void rms_rows16(Frame& F, const bf16_t* src, const float* g, bf16_t* dst, unsigned char* dst8) {
    const int gw = F.vcu * NWAVES + F.wave, NGW = F.G * NWAVES, lane = F.lane;
    for (int m = gw; m < M; m += NGW) {
        const u32x4* xr = (const u32x4*)(src + (size_t)m * D) + lane; float v[4][8]; float s = 0.f;
#pragma unroll
        for (int j = 0; j < 4; ++j) { unpack8(xr[64 * j], v[j]);
#pragma unroll
            for (int q = 0; q < 8; ++q) s += v[j][q] * v[j][q]; }
        const float r = 1.0f / sqrtf(wave_sum(s, lane) * (1.f / D) + EPS);
        u32x4* o16 = (u32x4*)(dst + (size_t)m * D) + lane; u32x2* o8 = (u32x2*)(dst8 + (size_t)m * D) + lane;
#pragma unroll
        for (int j = 0; j < 4; ++j) { const f32x4 g0 = *((const f32x4*)g + 2 * (lane + 64 * j)), g1 = *((const f32x4*)g + 2 * (lane + 64 * j) + 1); float y[8];
            y[0] = v[j][0] * r * g0.x; y[1] = v[j][1] * r * g0.y; y[2] = v[j][2] * r * g0.z; y[3] = v[j][3] * r * g0.w; y[4] = v[j][4] * r * g1.x; y[5] = v[j][5] * r * g1.y; y[6] = v[j][6] * r * g1.z; y[7] = v[j][7] * r * g1.w;
            o16[64 * j] = pack8(y); u32x2 w8; w8.x = pk4_fp8(y[0], y[1], y[2], y[3]); w8.y = pk4_fp8(y[4], y[5], y[6], y[7]); o8[64 * j] = w8; }
    }
}
__device__ __forceinline__ void rms_rows16_to_f32(Frame& F, const bf16_t* src, const float* g, float* out) {
    const int gw = F.vcu * NWAVES + F.wave, NGW = F.G * NWAVES, lane = F.lane;
    for (int m = gw; m < M; m += NGW) {
        const u32x4* xr = (const u32x4*)(src + (size_t)m * D) + lane; float v[4][8]; float s = 0.f;
#pragma unroll
        for (int j = 0; j < 4; ++j) { unpack8(xr[64 * j], v[j]);
#pragma unroll
            for (int q = 0; q < 8; ++q) s += v[j][q] * v[j][q]; }
        const float r = 1.0f / sqrtf(wave_sum(s, lane) * (1.f / D) + EPS);
        f32x4* o = (f32x4*)(out + (size_t)m * D);
#pragma unroll
        for (int j = 0; j < 4; ++j) { const f32x4 g0 = *((const f32x4*)g + 2 * (lane + 64 * j)), g1 = *((const f32x4*)g + 2 * (lane + 64 * j) + 1);
            o[2 * (lane + 64 * j)] = (f32x4){v[j][0] * r * g0.x, v[j][1] * r * g0.y, v[j][2] * r * g0.z, v[j][3] * r * g0.w};
            o[2 * (lane + 64 * j) + 1] = (f32x4){v[j][4] * r * g1.x, v[j][5] * r * g1.y, v[j][6] * r * g1.z, v[j][7] * r * g1.w}; }
    }
}
__device__ __forceinline__ void rms_rows_f32_inplace(Frame& F, float* buf, const float* g) {
    const int gw = F.vcu * NWAVES + F.wave, NGW = F.G * NWAVES;
    for (int m = gw; m < M; m += NGW) {
        f32x4* xr = (f32x4*)(buf + (size_t)m * D) + F.lane; const f32x4* gr = (const f32x4*)g + F.lane;
        f32x4 v[8]; float s = 0.f;
#pragma unroll
        for (int j = 0; j < 8; ++j) { v[j] = xr[64 * j]; s += (v[j].x * v[j].x + v[j].y * v[j].y) + (v[j].z * v[j].z + v[j].w * v[j].w); }
        const float r = 1.0f / sqrtf(wave_sum(s, F.lane) * (1.f / D) + EPS);
#pragma unroll
        for (int j = 0; j < 8; ++j) { const f32x4 gg = gr[64 * j]; xr[64 * j] = (f32x4){v[j].x * r * gg.x, v[j].y * r * gg.y, v[j].z * r * gg.z, v[j].w * r * gg.w}; }
    }
}

__device__ __forceinline__ void phase_prep(Frame& F, int l) {
    LAS float* scr = (LAS float*)(F.lds + F.wave * 16384);
    const int gw = F.vcu * NWAVES + F.wave, NGW = F.G * NWAVES;
    constexpr int I_IN = (D / 64) * (NIN / 32), I_UP = (D / 64) * (NUP / 32), I_DN = (DFF / 64) * (D / 32), I_BR = 4 * (BW / 64) * (D / 32), I_OUT = (D / 64) * (D / 32), I_GLU = (BW / 64) * (BW / 32), I_PL = 4 * (128 / 64) * (128 / 32);
    constexpr int NITEMS = I_IN + I_UP + I_DN + I_BR + I_OUT + I_GLU + I_PL;
    for (int it = gw; it < NITEMS; it += NGW) {
        int r = it;
        if (r < I_IN) { const int nb = NIN / 32, n0 = 32 * (r % nb);
            if (n0 < C_GATE) transpose_item(F.w_in() + (size_t)l * D * NIN_SRC, NIN_SRC, F.win_t(), D, 0, 64 * (r / nb), n0, ColWin(), scr, F.lane);
            else transpose_item_fp8(F.w_in() + (size_t)l * D * NIN_SRC, NIN_SRC, F.W8(), D, 64 * (r / nb), n0, n0 - C_GATE, ColWin(), scr, F.lane, nullptr, 64.0f);
            continue; } r -= I_IN;
        if (r < I_UP) { const int nb = NUP / 32; transpose_item(F.w_up() + (size_t)l * D * NUP, NUP, F.wup_t(), D, 0, 64 * (r / nb), 32 * (r % nb), ColWup(), scr, F.lane, F.g_ffn() + (size_t)l * D); continue; } r -= I_UP;
        if (r < I_DN) { const int nb = D / 32; transpose_item(F.w_down() + (size_t)l * DFF * D, D, F.wdn_t(), DFF, 0, 64 * (r / nb), 32 * (r % nb), ColIdent(), scr, F.lane); continue; } r -= I_DN;
        if (r < I_BR) { const int per = (BW / 64) * (D / 32), br = r / per, q = r % per, nb = D / 32;
            transpose_item(F.w_branch() + ((size_t)l * 4 + br) * BW * D, D, F.wbr_t(), D, br * BW, 64 * (q / nb), 32 * (q % nb), ColIdent(), scr, F.lane); continue; } r -= I_BR;
        if (r < I_OUT) { const int nb = D / 32; transpose_item(F.w_out() + (size_t)l * D * D, D, F.wout_t(), D, 0, 64 * (r / nb), 32 * (r % nb), ColIdent(), scr, F.lane); continue; } r -= I_OUT;
        if (r < I_GLU) { const int nb = BW / 32; transpose_item(F.w_glu() + (size_t)l * BW * BW, BW, F.wglu_t(), BW, 0, 64 * (r / nb), 32 * (r % nb), ColIdent(), scr, F.lane); continue; } r -= I_GLU;
        { const int grp = r / 8, q = r % 8; transpose_item(F.pool_w() + ((size_t)l * 4 + grp) * 128 * 128, 128, F.poolw_t() + (size_t)grp * 128 * 128, 128, 0, 64 * (q / 4), 32 * (q % 4), ColIdent(), scr, F.lane); }
    }
    const int gt = F.vcu * (NWAVES * 64) + F.tid, NGT = F.G * NWAVES * 64;
    for (int i = gt; i < 32 * 64; i += NGT) {
        const int g = i >> 6;
        const float are = F.a_re()[(size_t)l * 2048 + i], aim = F.a_im()[(size_t)l * 2048 + i], dt = expf(F.log_dt()[l * 32 + g]);
        const float mag = expf(are * dt), th = aim * dt;
        const float abr = mag * cosf(th), abi = mag * sinf(th);
        const float den = are * are + aim * aim, nr = abr - 1.0f, ni = abi;
        const float fre = (nr * are + ni * aim) / den, fim = (ni * are - nr * aim) / den;
        F.abar()[2 * i] = abr; F.abar()[2 * i + 1] = abi;
        float pr = abr, pi = abi;
#pragma unroll
        for (int q = 0; q < 6; ++q) { const float tr = pr * pr - pi * pi, ti = 2.f * pr * pi; pr = tr; pi = ti; }
        F.apow()[2 * i] = pr; F.apow()[2 * i + 1] = pi;
        const float* br = F.b_re() + ((size_t)l * 2048 + i) * 16; const float* bi = F.b_im() + ((size_t)l * 2048 + i) * 16;
#pragma unroll
        for (int c = 0; c < 16; ++c) { const float x = br[c], y = bi[c]; const float vr = fre * x - fim * y, vi = fre * y + fim * x; const int p = i & 63;
            F.bbt()[((size_t)g * 128 + p) * 16 + c] = (bf16_t)f2bf(vr); F.bbt()[((size_t)g * 128 + 64 + p) * 16 + c] = (bf16_t)f2bf(vi); }
    }
    for (int i = gt; i < 32 * 16 * 128; i += NGT) {
        const int k = i & 127, gc = i >> 7;
        const float v = (k < 64) ? F.c_re()[((size_t)l * 512 + gc) * 64 + k] : -F.c_im()[((size_t)l * 512 + gc) * 64 + (k - 64)];
        F.cmt()[i] = (bf16_t)f2bf(v);
    }
    if (l == 0) {
        for (int i = gt; i < M * 32; i += NGT) {
            const int row = i >> 5, j = i & 31;
            const float inv = exp2f(-(float)j * (13.287712379549449f / 32.0f));
            const float ang = (float)F.pos()[row] * inv;
            F.rotc()[i] = cosf(ang); F.rots()[i] = sinf(ang);
        }
    }
    if (l == 0) rms_rows(F, F.x(), F.g_mix(), F.HN(), F.HN8()); else rms_rows16(F, (const bf16_t*)F.out, F.g_mix() + (size_t)l * D, F.HN(), F.HN8());
}

__device__ __forceinline__ void gr_pass(Frame& F) {
    const int gw = F.vcu * NWAVES + F.wave, NGW = F.G * NWAVES, lane = F.lane, lr = lane & 15, lq = lane >> 4;
    for (int unit = gw; unit < M / 16; unit += NGW) {
        const bf16_t* ap = F.HN() + (size_t)(16 * unit + lr) * D + 8 * lq; const bf16_t* bp = F.win_t() + (size_t)(C_GR + lr) * D + 8 * lq;
        f32x4 acc = (f32x4){0.f, 0.f, 0.f, 0.f};
#pragma unroll 1
        for (int kb = 0; kb < 64; kb += 16) { bf16x8 a[16], b[16];
#pragma unroll
            for (int j = 0; j < 16; ++j) { a[j] = *(const bf16x8*)(ap + 32 * (kb + j)); b[j] = *(const bf16x8*)(bp + 32 * (kb + j)); }
#pragma unroll
            for (int j = 0; j < 16; ++j) acc = __builtin_amdgcn_mfma_f32_16x16x32_bf16(a[j], b[j], acc, 0, 0, 0); }
#pragma unroll
        for (int i = 0; i < 4; ++i) F.PROJ()[(size_t)(16 * unit + 4 * lq + i) * LDP + C_GR + lr] = (bf16_t)f2bf(acc[i]);
    }
}

__device__ __forceinline__ f32x4 mma_nt_lds(const LAS bf16_t* X, int px, const LAS bf16_t* Y, int py, int ksteps, f32x4 acc, int lane) {
    const LAS bf16_t* xp = X + (lane & 15) * px + 8 * (lane >> 4);
    const LAS bf16_t* yp = Y + (lane & 15) * py + 8 * (lane >> 4);
    for (int ks = 0; ks < ksteps; ++ks) {
        const bf16x8 a = *(const LAS bf16x8*)(xp + 32 * ks), b = *(const LAS bf16x8*)(yp + 32 * ks);
        acc = __builtin_amdgcn_mfma_f32_16x16x32_bf16(a, b, acc, 0, 0, 0);
    }
    return acc;
}

constexpr int LN_TOT = 16384, LN_QD = 18432, LN_KI = 27648, LN_PM = 36864, LN_VT = 46080, LN_OB = 64512, LN_WG = 98304, LN_END = 98304 + 4096 + 256;
constexpr int LP = 72;
struct LinRaw { u32x4 q0, q1, k0, k1, v0, v1, g0, g1, gr0, gr1; f32x4 c0, c1, s0, s1; bf16x8 sp0, sp1; };
template <bool OUT>
__device__ __forceinline__ void lin_issue(Frame& F, int unit, LinRaw& R) {
    const int n = unit & 63, h = (unit >> 6) & 3, b = (unit >> 8) & 7, mixer = unit >> 11;
    const size_t row0 = (size_t)b * SEQ + (size_t)n * CH; const int s = F.tid >> 3, c = F.tid & 7;
    const int cq = (mixer == 0 ? C_RQ : C_GQ) + h * 64, ck = (mixer == 0 ? C_RK : C_GK) + h * 64, cv = (mixer == 0 ? C_RV : C_GV) + h * 128, cg = (mixer == 0 ? C_RG : C_GG) + h * 128;
    const bf16_t* pr = F.PROJ() + (row0 + s) * LDP;
    R.k0 = *(const u32x4*)(pr + ck + 8 * c); R.k1 = *(const u32x4*)(pr + ck + 8 * (c ^ 4));
    if (OUT) { R.q0 = *(const u32x4*)(pr + cq + 8 * c); R.q1 = *(const u32x4*)(pr + cq + 8 * (c ^ 4)); }
    { const float* cp = F.rotc() + (row0 + s) * 32 + (c & 3) * 8; const float* sp = F.rots() + (row0 + s) * 32 + (c & 3) * 8;
      R.c0 = *(const f32x4*)cp; R.c1 = *(const f32x4*)(cp + 4); R.s0 = *(const f32x4*)sp; R.s1 = *(const f32x4*)(sp + 4); }
    R.gr0 = *(const u32x4*)(pr + C_GR); R.gr1 = *(const u32x4*)(pr + C_GR + 8);
    R.v0 = *(const u32x4*)(F.PROJ() + (row0 + (F.tid >> 4)) * LDP + cv + (F.tid & 15) * 8);
    R.v1 = *(const u32x4*)(F.PROJ() + (row0 + 32 + (F.tid >> 4)) * LDP + cv + (F.tid & 15) * 8);
    if (OUT) { R.g0 = *(const u32x4*)(pr + cg + 16 * c); R.g1 = *(const u32x4*)(pr + cg + 16 * c + 8);
        const bf16_t* sq = F.SPREV() + (size_t)unit * 8192 + (size_t)(16 * F.wave + (F.lane & 15)) * 64 + 8 * (F.lane >> 4);
        R.sp0 = *(const bf16x8*)sq; R.sp1 = *(const bf16x8*)(sq + 32); }
}
__device__ __forceinline__ void lin_rot(const u32x4 own_, const u32x4 oth_, const LinRaw& R, bool rot, bool hi, float scale, float (&v)[8]) {
    float own[8]; unpack8(own_, own);
    if (!rot) {
#pragma unroll
        for (int j = 0; j < 8; ++j) v[j] = own[j] * scale;
        return; }
    float oth[8]; unpack8(oth_, oth);
    const float cs[8] = {R.c0.x, R.c0.y, R.c0.z, R.c0.w, R.c1.x, R.c1.y, R.c1.z, R.c1.w}, sn[8] = {R.s0.x, R.s0.y, R.s0.z, R.s0.w, R.s1.x, R.s1.y, R.s1.z, R.s1.w};
#pragma unroll
    for (int j = 0; j < 8; ++j) { const float os = oth[j] * sn[j]; v[j] = (own[j] * cs[j] + (hi ? os : -os)) * scale; }
}
__device__ __forceinline__ void lin_decay(Frame& F, int mixer, int h, const LinRaw& R, float (&bcum)[8], float (&blast)[8]) {
    LAS float* TOT = (LAS float*)(F.lds + LN_TOT);
    const int s = F.tid >> 3, c = F.tid & 7, d0 = 8 * c;
    if (mixer == 0) {
        const float lg = __logf(1.0f - exp2f(-5.0f - (float)h));
#pragma unroll
        for (int j = 0; j < 8; ++j) { bcum[j] = (float)(s + 1) * lg; blast[j] = 64.0f * lg; }
        lds_sync();
        return;
    }
    const LAS float* WG = (const LAS float*)(F.lds + LN_WG);
    float grf[16]; { float a[8], b2[8]; unpack8(R.gr0, a); unpack8(R.gr1, b2);
#pragma unroll
        for (int j = 0; j < 8; ++j) { grf[j] = a[j]; grf[8 + j] = b2[j]; } }
    float x[8]; { const f32x4 b0 = *(const LAS f32x4*)(WG + 1024 + d0), b1 = *(const LAS f32x4*)(WG + 1024 + d0 + 4); x[0] = b0.x; x[1] = b0.y; x[2] = b0.z; x[3] = b0.w; x[4] = b1.x; x[5] = b1.y; x[6] = b1.z; x[7] = b1.w; }
#pragma unroll
    for (int r = 0; r < 16; ++r) { const f32x4 w0 = *(const LAS f32x4*)(WG + r * 64 + d0), w1 = *(const LAS f32x4*)(WG + r * 64 + d0 + 4);
        x[0] += grf[r] * w0.x; x[1] += grf[r] * w0.y; x[2] += grf[r] * w0.z; x[3] += grf[r] * w0.w; x[4] += grf[r] * w1.x; x[5] += grf[r] * w1.y; x[6] += grf[r] * w1.z; x[7] += grf[r] * w1.w; }
#pragma unroll
    for (int j = 0; j < 8; ++j) x[j] = logsigmoidf_(x[j]) * (1.0f / 16.0f);
#pragma unroll
    for (int st = 8; st <= 32; st <<= 1) {
#pragma unroll
        for (int j = 0; j < 8; ++j) { const float t = lane_read(x[j], F.lane - st); if (F.lane >= st) x[j] += t; } }
    if ((F.lane >> 3) == 7) { *(LAS f32x4*)(TOT + F.wave * 64 + d0) = (f32x4){x[0], x[1], x[2], x[3]}; *(LAS f32x4*)(TOT + F.wave * 64 + d0 + 4) = (f32x4){x[4], x[5], x[6], x[7]}; }
    lds_sync();
    float off[8], tot[8];
#pragma unroll
    for (int j = 0; j < 8; ++j) { off[j] = 0.f; tot[j] = 0.f; }
#pragma unroll
    for (int w = 0; w < 8; ++w) { const f32x4 t0 = *(const LAS f32x4*)(TOT + w * 64 + d0), t1 = *(const LAS f32x4*)(TOT + w * 64 + d0 + 4); const float tv[8] = {t0.x, t0.y, t0.z, t0.w, t1.x, t1.y, t1.z, t1.w};
#pragma unroll
        for (int j = 0; j < 8; ++j) { tot[j] += tv[j]; off[j] += (w < F.wave) ? tv[j] : 0.f; } }
#pragma unroll
    for (int j = 0; j < 8; ++j) { bcum[j] = x[j] + off[j]; blast[j] = tot[j]; }
}
typedef short v4s_t __attribute__((ext_vector_type(4)));
__device__ __forceinline__ bf16x8 tr_frag(const LAS bf16_t* T, int pitch, int k0, int x0, int lane) {
    const int g = lane >> 4, i = lane & 15, q = i >> 2, p = i & 3;
    const LAS bf16_t* a = T + (k0 + 8 * g + q) * pitch + x0 + 4 * p;
    const v4s_t lo = __builtin_amdgcn_ds_read_tr16_b64_v4i16((LAS v4s_t*)a), hi = __builtin_amdgcn_ds_read_tr16_b64_v4i16((LAS v4s_t*)(a + 4 * pitch));
    return __builtin_shufflevector(lo, hi, 0, 1, 2, 3, 4, 5, 6, 7);
}
constexpr int PV = 144;
__device__ __forceinline__ void lin_store_vt(Frame& F, const LinRaw& R) {
    LAS bf16_t* VR = (LAS bf16_t*)(F.lds + LN_VT); const int e0 = (F.tid & 15) * 8;
    *(LAS u32x4*)(VR + (F.tid >> 4) * PV + e0) = R.v0; *(LAS u32x4*)(VR + (32 + (F.tid >> 4)) * PV + e0) = R.v1;
}
__device__ __forceinline__ void lin_state_compute(Frame& F, int unit, const LinRaw& R) {
    const int h = (unit >> 6) & 3, mixer = unit >> 11; const int s = F.tid >> 3, c = F.tid & 7, d0 = 8 * c;
    LAS bf16_t* KDT = (LAS bf16_t*)(F.lds + LN_KI); LAS bf16_t* VT = (LAS bf16_t*)(F.lds + LN_VT);
    float k[8], bcum[8], blast[8];
    lin_rot(R.k0, R.k1, R, mixer == 0, c >= 4, mixer == 0 ? 0.125f : 1.0f, k);
    lin_decay(F, mixer, h, R, bcum, blast);
    { float kd[8];
#pragma unroll
      for (int j = 0; j < 8; ++j) kd[j] = k[j] * __expf(blast[j] - bcum[j]);
      *(LAS u32x4*)(KDT + s * LP + d0) = pack8(kd); }
    lin_store_vt(F, R);
    if (s == 0) { float* dc = F.DEC() + (size_t)unit * 64 + d0;
        *(f32x4*)dc = (f32x4){__expf(blast[0]), __expf(blast[1]), __expf(blast[2]), __expf(blast[3])}; *(f32x4*)(dc + 4) = (f32x4){__expf(blast[4]), __expf(blast[5]), __expf(blast[6]), __expf(blast[7])}; }
    lds_sync();
    { const int w = F.wave, lane = F.lane; float* st = F.STATE() + (size_t)unit * 8192;
      const bf16x8 vf0 = tr_frag(VT, PV, 0, 16 * w, lane), vf1 = tr_frag(VT, PV, 32, 16 * w, lane);
#pragma unroll
      for (int dt = 0; dt < 4; ++dt) { f32x4 acc = (f32x4){0.f, 0.f, 0.f, 0.f};
          acc = __builtin_amdgcn_mfma_f32_16x16x32_bf16(vf0, tr_frag(KDT, LP, 0, 16 * dt, lane), acc, 0, 0, 0);
          acc = __builtin_amdgcn_mfma_f32_16x16x32_bf16(vf1, tr_frag(KDT, LP, 32, 16 * dt, lane), acc, 0, 0, 0);
#pragma unroll
          for (int i = 0; i < 4; ++i) st[(16 * w + 4 * (lane >> 4) + i) * 64 + 16 * dt + (lane & 15)] = acc[i]; } }
}
__device__ __forceinline__ void lin_out_compute(Frame& F, int unit, const LinRaw& R) {
    const int n = unit & 63, h = (unit >> 6) & 3, b = (unit >> 8) & 7, mixer = unit >> 11;
    const size_t row0 = (size_t)b * SEQ + (size_t)n * CH; const int s = F.tid >> 3, c = F.tid & 7, d0 = 8 * c;
    const int ycol = (mixer == 0 ? 0 : 1024) + h * 128;
    LAS bf16_t* QD = (LAS bf16_t*)(F.lds + LN_QD); LAS bf16_t* KI = (LAS bf16_t*)(F.lds + LN_KI); LAS bf16_t* PM = (LAS bf16_t*)(F.lds + LN_PM);
    LAS bf16_t* VT = (LAS bf16_t*)(F.lds + LN_VT); LAS float* OB = (LAS float*)(F.lds + LN_OB);
    float q[8], k[8], bcum[8], blast[8];
    lin_rot(R.q0, R.q1, R, mixer == 0, c >= 4, mixer == 0 ? 1.0f : 0.125f, q);
    lin_rot(R.k0, R.k1, R, mixer == 0, c >= 4, mixer == 0 ? 0.125f : 1.0f, k);
    lin_decay(F, mixer, h, R, bcum, blast);
    { float qd[8], ki[8];
#pragma unroll
      for (int j = 0; j < 8; ++j) { qd[j] = q[j] * __expf(bcum[j]); ki[j] = k[j] * __expf(-bcum[j]); }
      *(LAS u32x4*)(QD + s * LP + d0) = pack8(qd); *(LAS u32x4*)(KI + s * LP + d0) = pack8(ki); }
    lin_store_vt(F, R);
    lds_sync();
    { const int lane = F.lane;
#pragma unroll
      for (int j = 0; j < 2; ++j) { const int tile = 2 * F.wave + j, tt = tile >> 2, st = tile & 3;
          f32x4 acc = (f32x4){0.f, 0.f, 0.f, 0.f};
          if (st <= tt) acc = mma_nt_lds(QD + 16 * tt * LP, LP, KI + 16 * st * LP, LP, 2, acc, lane);
#pragma unroll
          for (int i = 0; i < 4; ++i) { const int t = 16 * tt + 4 * (lane >> 4) + i, s2 = 16 * st + (lane & 15); const float p = (st <= tt && s2 <= t) ? acc[i] : 0.f; PM[t * LP + s2] = (bf16_t)f2bf(p); } } }
    lds_sync();
    { const int w = F.wave, lane = F.lane;
      const bf16x8 vf0 = tr_frag(VT, PV, 0, 16 * w, lane), vf1 = tr_frag(VT, PV, 32, 16 * w, lane);
#pragma unroll
      for (int tt = 0; tt < 4; ++tt) { f32x4 acc = (f32x4){0.f, 0.f, 0.f, 0.f};
          { const LAS bf16_t* pp = PM + (16 * tt + (lane & 15)) * LP + 8 * (lane >> 4);
            acc = __builtin_amdgcn_mfma_f32_16x16x32_bf16(*(const LAS bf16x8*)pp, vf0, acc, 0, 0, 0);
            acc = __builtin_amdgcn_mfma_f32_16x16x32_bf16(*(const LAS bf16x8*)(pp + 32), vf1, acc, 0, 0, 0); }
          const LAS bf16_t* xp = QD + (16 * tt + (lane & 15)) * LP + 8 * (lane >> 4);
          acc = __builtin_amdgcn_mfma_f32_16x16x32_bf16(*(const LAS bf16x8*)xp, R.sp0, acc, 0, 0, 0);
          acc = __builtin_amdgcn_mfma_f32_16x16x32_bf16(*(const LAS bf16x8*)(xp + 32), R.sp1, acc, 0, 0, 0);
#pragma unroll
          for (int i = 0; i < 4; ++i) OB[(16 * tt + 4 * (lane >> 4) + i) * 132 + 16 * w + (lane & 15)] = acc[i]; } }
    lds_sync();
    { const int t = s, part = c; float o[16];
#pragma unroll
      for (int j = 0; j < 4; ++j) { const f32x4 v = *(const LAS f32x4*)(OB + t * 132 + 16 * part + 4 * j); o[4 * j] = v.x; o[4 * j + 1] = v.y; o[4 * j + 2] = v.z; o[4 * j + 3] = v.w; }
      float sm = 0.f;
#pragma unroll
      for (int j = 0; j < 16; ++j) sm += o[j];
      sm += lane_read(sm, F.lane ^ 1); sm += lane_read(sm, F.lane ^ 2); sm += lane_read(sm, F.lane ^ 4);
      const float mu = sm * (1.0f / 128.0f); float qv = 0.f;
#pragma unroll
      for (int j = 0; j < 16; ++j) { const float dlt = o[j] - mu; qv += dlt * dlt; }
      qv += lane_read(qv, F.lane ^ 1); qv += lane_read(qv, F.lane ^ 2); qv += lane_read(qv, F.lane ^ 4);
      const float r = 1.0f / sqrtf(qv * (1.0f / 128.0f) + EPS);
      float g0[8], g1[8]; unpack8(R.g0, g0); unpack8(R.g1, g1);
      float y0[8], y1[8];
#pragma unroll
      for (int j = 0; j < 8; ++j) { y0[j] = (o[j] - mu) * r * siluf_(g0[j]); y1[j] = (o[8 + j] - mu) * r * siluf_(g1[j]); }
      bf16_t* yp = F.Y() + (row0 + t) * D + ycol + 16 * part; *(u32x4*)yp = pack8(y0); *(u32x4*)(yp + 8) = pack8(y1); }
}
template <bool OUT>
__device__ __forceinline__ void lin_phase(Frame& F, int l) {
    { const int h = (F.vcu >> 6) & 3; LAS float* WG = (LAS float*)(F.lds + LN_WG);
      for (int i = F.tid; i < 16 * 64 + 64; i += NWAVES * 64) WG[i] = (i < 1024) ? F.gla_wg()[(size_t)l * 16 * 256 + (i >> 6) * 256 + h * 64 + (i & 63)] : F.gla_bg()[l * 256 + h * 64 + (i - 1024)];
      lds_sync(); }
    LinRaw A, B;
    lin_issue<OUT>(F, F.vcu, A);
    for (int u = F.vcu; u < 4096; u += 2 * F.G) {
        lin_issue<OUT>(F, u + F.G, B);
        if (OUT) lin_out_compute(F, u, A); else lin_state_compute(F, u, A);
        if (u + 2 * F.G < 4096) lin_issue<OUT>(F, u + 2 * F.G, A);
        if (OUT) lin_out_compute(F, u + F.G, B); else lin_state_compute(F, u + F.G, B);
    }
    lds_sync();
}
constexpr int L2_TOT = 0, L2_QD = 1024, L2_KI = 10240, L2_V = 19456, L2_SP = 37888, L2_PM = 56320, L2_STRIDE = 65536, L2_WG = 131072;
struct Lin2 { int unit, h, mixer, hw, s, c; size_t row0; LAS unsigned char* base; };
__device__ __forceinline__ void lin2_rot16(const u32x4 lo_, const u32x4 hi_, const f32x4 (&cs)[2], const f32x4 (&sn)[2], bool rot, float scale, float (&v)[16]) {
    float lo[8], hi[8]; unpack8(lo_, lo); unpack8(hi_, hi);
    if (!rot) {
#pragma unroll
        for (int j = 0; j < 8; ++j) { v[j] = lo[j] * scale; v[8 + j] = hi[j] * scale; }
    } else {
        const float c8[8] = {cs[0].x, cs[0].y, cs[0].z, cs[0].w, cs[1].x, cs[1].y, cs[1].z, cs[1].w}, s8[8] = {sn[0].x, sn[0].y, sn[0].z, sn[0].w, sn[1].x, sn[1].y, sn[1].z, sn[1].w};
#pragma unroll
        for (int j = 0; j < 8; ++j) { v[j] = (lo[j] * c8[j] - hi[j] * s8[j]) * scale; v[8 + j] = (hi[j] * c8[j] + lo[j] * s8[j]) * scale; }
    }
}
__device__ __forceinline__ void lin2_decay(Frame& F, const Lin2& L, const u32x4 gr0, const u32x4 gr1, float (&bcum)[16], float (&blast)[16]) {
    LAS float* TOT = (LAS float*)(L.base + L2_TOT);
    const int d0 = 8 * L.c;
    if (L.mixer == 0) {
        const float lg = __logf(1.0f - exp2f(-5.0f - (float)L.h));
#pragma unroll
        for (int j = 0; j < 16; ++j) { bcum[j] = (float)(L.s + 1) * lg; blast[j] = 64.0f * lg; }
        lds_sync();
        return;
    }
    const LAS float* WG = (const LAS float*)(F.lds + L2_WG);
    float grf[16]; { float a[8], b2[8]; unpack8(gr0, a); unpack8(gr1, b2);
#pragma unroll
        for (int j = 0; j < 8; ++j) { grf[j] = a[j]; grf[8 + j] = b2[j]; } }
    float x[16];
#pragma unroll
    for (int q = 0; q < 4; ++q) { const f32x4 b0 = *(const LAS f32x4*)(WG + 1024 + d0 + 32 * (q >> 1) + 4 * (q & 1)); x[4 * q] = b0.x; x[4 * q + 1] = b0.y; x[4 * q + 2] = b0.z; x[4 * q + 3] = b0.w; }
#pragma unroll
    for (int r = 0; r < 16; ++r) {
#pragma unroll
        for (int q = 0; q < 4; ++q) { const f32x4 w0 = *(const LAS f32x4*)(WG + r * 64 + d0 + 32 * (q >> 1) + 4 * (q & 1));
            x[4 * q] += grf[r] * w0.x; x[4 * q + 1] += grf[r] * w0.y; x[4 * q + 2] += grf[r] * w0.z; x[4 * q + 3] += grf[r] * w0.w; } }
#pragma unroll
    for (int j = 0; j < 16; ++j) x[j] = logsigmoidf_(x[j]) * (1.0f / 16.0f);
#pragma unroll
    for (int st = 4; st <= 32; st <<= 1) {
#pragma unroll
        for (int j = 0; j < 16; ++j) { const float t = lane_read(x[j], F.lane - st); if (F.lane >= st) x[j] += t; } }
    if ((F.lane >> 2) == 15) {
#pragma unroll
        for (int q = 0; q < 4; ++q) *(LAS f32x4*)(TOT + L.hw * 64 + d0 + 32 * (q >> 1) + 4 * (q & 1)) = (f32x4){x[4 * q], x[4 * q + 1], x[4 * q + 2], x[4 * q + 3]}; }
    lds_sync();
    float off[16], tot[16];
#pragma unroll
    for (int j = 0; j < 16; ++j) { off[j] = 0.f; tot[j] = 0.f; }
#pragma unroll
    for (int w = 0; w < 4; ++w) {
#pragma unroll
        for (int q = 0; q < 4; ++q) { const f32x4 t0 = *(const LAS f32x4*)(TOT + w * 64 + d0 + 32 * (q >> 1) + 4 * (q & 1)); const float tv[4] = {t0.x, t0.y, t0.z, t0.w};
#pragma unroll
            for (int j = 0; j < 4; ++j) { tot[4 * q + j] += tv[j]; off[4 * q + j] += (w < L.hw) ? tv[j] : 0.f; } } }
#pragma unroll
    for (int j = 0; j < 16; ++j) { bcum[j] = x[j] + off[j]; blast[j] = tot[j]; }
}
__device__ __forceinline__ bf16x8 tr_frag8(const LAS bf16_t* T, int pitch, int k0, int x0, int lane) {
    const int g = lane >> 4, i = lane & 15, q = i >> 2, p = i & 3;
    const LAS bf16_t* a = T + (k0 + 8 * g + q) * pitch + x0 + 8 * p;
    const v4s_t lo = __builtin_amdgcn_ds_read_tr16_b64_v4i16((LAS v4s_t*)a), hi = __builtin_amdgcn_ds_read_tr16_b64_v4i16((LAS v4s_t*)(a + 4 * pitch));
    return __builtin_shufflevector(lo, hi, 0, 1, 2, 3, 4, 5, 6, 7);
}
__device__ __forceinline__ void lin2_state(Frame& F, const Lin2& L) {
    const int ht = F.tid & 255, lane = F.lane, s = L.s, c = L.c, d0 = 8 * c;
    const int ck = (L.mixer == 0 ? C_RK : C_GK) + L.h * 64, cv = (L.mixer == 0 ? C_RV : C_GV) + L.h * 128;
    LAS bf16_t* KD = (LAS bf16_t*)(L.base + L2_KI); LAS bf16_t* VT = (LAS bf16_t*)(L.base + L2_V);
    const bf16_t* pr = F.PROJ() + (L.row0 + s) * LDP;
    u32x4 vv[4]; f32x4 cs[2], sn[2];
    const u32x4 klo = *(const u32x4*)(pr + ck + d0), khi = *(const u32x4*)(pr + ck + 32 + d0);
    u32x4 gr0 = (u32x4){0u, 0u, 0u, 0u}, gr1 = gr0;
    cs[0] = cs[1] = sn[0] = sn[1] = (f32x4){0.f, 0.f, 0.f, 0.f};
    if (L.mixer == 0) { const float* cp = F.rotc() + (L.row0 + s) * 32 + d0; const float* sp = F.rots() + (L.row0 + s) * 32 + d0;
      cs[0] = *(const f32x4*)cp; cs[1] = *(const f32x4*)(cp + 4); sn[0] = *(const f32x4*)sp; sn[1] = *(const f32x4*)(sp + 4); }
    else { gr0 = *(const u32x4*)(pr + C_GR); gr1 = *(const u32x4*)(pr + C_GR + 8); }
#pragma unroll
    for (int i = 0; i < 4; ++i) { const int idx = ht + 256 * i; vv[i] = *(const u32x4*)(F.PROJ() + (L.row0 + (idx >> 4)) * LDP + cv + (idx & 15) * 8); }
    float k[16], bcum[16], blast[16];
    lin2_rot16(klo, khi, cs, sn, L.mixer == 0, L.mixer == 0 ? 0.125f : 1.0f, k);
    lin2_decay(F, L, gr0, gr1, bcum, blast);
#pragma unroll
    for (int g = 0; g < 2; ++g) { float kd[8];
#pragma unroll
        for (int j = 0; j < 8; ++j) kd[j] = k[8 * g + j] * __expf(blast[8 * g + j] - bcum[8 * g + j]);
        *(LAS u32x4*)(KD + s * LP + d0 + 32 * g) = pack8(kd); }
#pragma unroll
    for (int i = 0; i < 4; ++i) { const int idx = ht + 256 * i; *(LAS u32x4*)(VT + (idx >> 4) * PV + (idx & 15) * 8) = vv[i]; }
    if (s == 0) { float* dc = F.DEC() + (size_t)L.unit * 64 + d0;
#pragma unroll
        for (int q = 0; q < 4; ++q) *(f32x4*)(dc + 32 * (q >> 1) + 4 * (q & 1)) = (f32x4){__expf(blast[4 * q]), __expf(blast[4 * q + 1]), __expf(blast[4 * q + 2]), __expf(blast[4 * q + 3])}; }
    lds_sync();
    { bf16_t* st = (bf16_t*)F.STATE() + (size_t)L.unit * 8192;
      const int dh = 32 * (L.hw & 1), eh = 64 * (L.hw >> 1);
      bf16x8 kf[2][2];
#pragma unroll
      for (int hh = 0; hh < 2; ++hh) { kf[hh][0] = tr_frag8(KD, LP, 0, dh + 4 * hh, lane); kf[hh][1] = tr_frag8(KD, LP, 32, dh + 4 * hh, lane); }
#pragma unroll
      for (int et = 0; et < 4; ++et) { const bf16x8 v0 = tr_frag(VT, PV, 0, eh + 16 * et, lane), v1 = tr_frag(VT, PV, 32, eh + 16 * et, lane);
          f32x4 a0 = (f32x4){0.f, 0.f, 0.f, 0.f}, a1 = a0;
          a0 = __builtin_amdgcn_mfma_f32_16x16x32_bf16(kf[0][0], v0, a0, 0, 0, 0); a0 = __builtin_amdgcn_mfma_f32_16x16x32_bf16(kf[0][1], v1, a0, 0, 0, 0);
          a1 = __builtin_amdgcn_mfma_f32_16x16x32_bf16(kf[1][0], v0, a1, 0, 0, 0); a1 = __builtin_amdgcn_mfma_f32_16x16x32_bf16(kf[1][1], v1, a1, 0, 0, 0);
          u32x4 w; w.x = pk2(a0[0], a0[1]); w.y = pk2(a0[2], a0[3]); w.z = pk2(a1[0], a1[1]); w.w = pk2(a1[2], a1[3]);
          *(u32x4*)(st + (eh + 16 * et + (lane & 15)) * 64 + dh + 8 * (lane >> 4)) = w; } }
}
__device__ __forceinline__ void lin2_out(Frame& F, const Lin2& L) {
    const int ht = F.tid & 255, lane = F.lane, lr = lane & 15, lq = lane >> 4, s = L.s, c = L.c, d0 = 8 * c;
    const int cq = (L.mixer == 0 ? C_RQ : C_GQ) + L.h * 64, ck = (L.mixer == 0 ? C_RK : C_GK) + L.h * 64, cv = (L.mixer == 0 ? C_RV : C_GV) + L.h * 128, cg = (L.mixer == 0 ? C_RG : C_GG) + L.h * 128;
    const int ycol = (L.mixer == 0 ? 0 : 1024) + L.h * 128;
    LAS bf16_t* QD = (LAS bf16_t*)(L.base + L2_QD); LAS bf16_t* KI = (LAS bf16_t*)(L.base + L2_KI); LAS bf16_t* VT = (LAS bf16_t*)(L.base + L2_V);
    LAS bf16_t* SP = (LAS bf16_t*)(L.base + L2_SP); LAS bf16_t* PM = (LAS bf16_t*)(L.base + L2_PM + L.hw * 2304);
    const bf16_t* pr = F.PROJ() + (L.row0 + s) * LDP;
    float q[16], k[16], bcum[16], blast[16];
    u32x4 vv[4], sv[4]; u32x4 gr0, gr1;
    { f32x4 cs[2], sn[2];
      const u32x4 klo = *(const u32x4*)(pr + ck + d0), khi = *(const u32x4*)(pr + ck + 32 + d0), qlo = *(const u32x4*)(pr + cq + d0), qhi = *(const u32x4*)(pr + cq + 32 + d0);
      gr0 = (u32x4){0u, 0u, 0u, 0u}; gr1 = gr0; cs[0] = cs[1] = sn[0] = sn[1] = (f32x4){0.f, 0.f, 0.f, 0.f};
      if (L.mixer == 0) { const float* cp = F.rotc() + (L.row0 + s) * 32 + d0; const float* sp = F.rots() + (L.row0 + s) * 32 + d0;
        cs[0] = *(const f32x4*)cp; cs[1] = *(const f32x4*)(cp + 4); sn[0] = *(const f32x4*)sp; sn[1] = *(const f32x4*)(sp + 4); }
      else { gr0 = *(const u32x4*)(pr + C_GR); gr1 = *(const u32x4*)(pr + C_GR + 8); }
#pragma unroll
      for (int i = 0; i < 4; ++i) { const int idx = ht + 256 * i; vv[i] = *(const u32x4*)(F.PROJ() + (L.row0 + (idx >> 4)) * LDP + cv + (idx & 15) * 8);
          sv[i] = *(const u32x4*)(F.SPREV() + (size_t)L.unit * 8192 + (size_t)idx * 8); }
      lin2_rot16(qlo, qhi, cs, sn, L.mixer == 0, L.mixer == 0 ? 1.0f : 0.125f, q);
      lin2_rot16(klo, khi, cs, sn, L.mixer == 0, L.mixer == 0 ? 0.125f : 1.0f, k); }
    lin2_decay(F, L, gr0, gr1, bcum, blast);
#pragma unroll
    for (int g = 0; g < 2; ++g) { float qd[8], ki[8];
#pragma unroll
        for (int j = 0; j < 8; ++j) { qd[j] = q[8 * g + j] * __expf(bcum[8 * g + j]); ki[j] = k[8 * g + j] * __expf(-bcum[8 * g + j]); }
        *(LAS u32x4*)(QD + s * LP + d0 + 32 * g) = pack8(qd); *(LAS u32x4*)(KI + s * LP + d0 + 32 * g) = pack8(ki); }
#pragma unroll
    for (int i = 0; i < 4; ++i) { const int idx = ht + 256 * i; *(LAS u32x4*)(VT + (idx >> 4) * PV + (idx & 15) * 8) = vv[i]; *(LAS u32x4*)(SP + (idx >> 3) * LP + (idx & 7) * 8) = sv[i]; }
    const bf16_t* gp = F.PROJ() + (L.row0 + 16 * L.hw + lr) * LDP + cg + 8 * lq;
    u32x4 gt[4];
#pragma unroll
    for (int pe = 0; pe < 4; ++pe) gt[pe] = *(const u32x4*)(gp + 32 * pe);
    lds_sync();
    const LAS bf16_t* qrow = QD + (16 * L.hw + lr) * LP + 8 * lq;
    const bf16x8 qf0 = *(const LAS bf16x8*)qrow, qf1 = *(const LAS bf16x8*)(qrow + 32);
#pragma unroll
    for (int st = 0; st < 4; ++st) {
        f32x4 acc = (f32x4){0.f, 0.f, 0.f, 0.f};
        if (st <= L.hw) { const LAS bf16_t* krow = KI + (16 * st + lr) * LP + 8 * lq;
            acc = __builtin_amdgcn_mfma_f32_16x16x32_bf16(*(const LAS bf16x8*)krow, qf0, acc, 0, 0, 0);
            acc = __builtin_amdgcn_mfma_f32_16x16x32_bf16(*(const LAS bf16x8*)(krow + 32), qf1, acc, 0, 0, 0); }
        float p[4];
#pragma unroll
        for (int i = 0; i < 4; ++i) p[i] = (st <= L.hw && 16 * st + 4 * lq + i <= 16 * L.hw + lr) ? acc[i] : 0.f;
        u32x2 w; w.x = pk2(p[0], p[1]); w.y = pk2(p[2], p[3]);
        *(LAS u32x2*)(PM + lr * LP + 16 * st + 4 * lq) = w; }
    asm volatile("s_waitcnt lgkmcnt(0)" ::: "memory");
    const bf16x8 pf0 = *(const LAS bf16x8*)(PM + lr * LP + 8 * lq), pf1 = *(const LAS bf16x8*)(PM + lr * LP + 32 + 8 * lq);
    f32x4 o[8];
    const int erow = 8 * (lr >> 2) + (lr & 3);
#pragma unroll
    for (int et = 0; et < 8; ++et) { const int e0 = 32 * (et >> 1) + 4 * (et & 1); f32x4 acc = (f32x4){0.f, 0.f, 0.f, 0.f};
        acc = __builtin_amdgcn_mfma_f32_16x16x32_bf16(tr_frag8(VT, PV, 0, e0, lane), pf0, acc, 0, 0, 0);
        acc = __builtin_amdgcn_mfma_f32_16x16x32_bf16(tr_frag8(VT, PV, 32, e0, lane), pf1, acc, 0, 0, 0);
        const LAS bf16_t* srow = SP + (e0 + erow) * LP + 8 * lq;
        acc = __builtin_amdgcn_mfma_f32_16x16x32_bf16(*(const LAS bf16x8*)srow, qf0, acc, 0, 0, 0);
        acc = __builtin_amdgcn_mfma_f32_16x16x32_bf16(*(const LAS bf16x8*)(srow + 32), qf1, acc, 0, 0, 0);
        o[et] = acc; }
    float sm = 0.f;
#pragma unroll
    for (int et = 0; et < 8; ++et) sm += (o[et][0] + o[et][1]) + (o[et][2] + o[et][3]);
    sm += lane_read(sm, lane ^ 16); sm += lane_read(sm, lane ^ 32);
    const float mu = sm * (1.0f / 128.0f); float qv = 0.f;
#pragma unroll
    for (int et = 0; et < 8; ++et) {
#pragma unroll
        for (int i = 0; i < 4; ++i) { const float dlt = o[et][i] - mu; qv += dlt * dlt; } }
    qv += lane_read(qv, lane ^ 16); qv += lane_read(qv, lane ^ 32);
    const float r = 1.0f / sqrtf(qv * (1.0f / 128.0f) + EPS);
    bf16_t* yp = F.Y() + (L.row0 + 16 * L.hw + lr) * D + ycol + 8 * lq;
#pragma unroll
    for (int pe = 0; pe < 4; ++pe) { float g[8], y[8]; unpack8(gt[pe], g);
#pragma unroll
        for (int j = 0; j < 8; ++j) y[j] = (o[2 * pe + (j >> 2)][j & 3] - mu) * r * siluf_(g[j]);
        *(u32x4*)(yp + 32 * pe) = pack8(y); }
}
template <bool OUT>
__device__ __forceinline__ void lin2_phase(Frame& F, int l) {
    { const int h = (F.vcu >> 6) & 3; LAS float* WG = (LAS float*)(F.lds + L2_WG);
      for (int i = F.tid; i < 16 * 64 + 64; i += NWAVES * 64) WG[i] = (i < 1024) ? F.gla_wg()[(size_t)l * 16 * 256 + (i >> 6) * 256 + h * 64 + (i & 63)] : F.gla_bg()[l * 256 + h * 64 + (i - 1024)];
      lds_sync(); }
    const int half = F.wave >> 2;
#pragma unroll 1
    for (int j = 0; j < 8; ++j) {
        Lin2 L; L.unit = F.vcu + 256 * (2 * j + half); L.h = (L.unit >> 6) & 3; asm volatile("" : "+s"(L.h)); L.mixer = L.unit >> 11; L.hw = F.wave & 3; L.s = (F.tid & 255) >> 2; L.c = F.tid & 3;
        L.row0 = (size_t)((L.unit >> 8) & 7) * SEQ + (size_t)(L.unit & 63) * CH; L.base = F.lds + half * L2_STRIDE;
        if (OUT) lin2_out(F, L); else lin2_state(F, L);
    }
    lds_sync();
}
__device__ __forceinline__ void lin_scan(Frame& F) {
    const int gt = F.vcu * (NWAVES * 64) + F.tid, NGT = F.G * NWAVES * 64;
    for (int i = gt; i < 64 * 2048; i += NGT) {
        const int seq = i >> 11, idx = (i & 2047) * 4, d = idx & 63;
        const bf16_t* st = (const bf16_t*)F.STATE() + (size_t)seq * NCH * 8192 + idx; const float* dc = F.DEC() + (size_t)seq * NCH * 64 + d; bf16_t* sp = F.SPREV() + (size_t)seq * NCH * 8192 + idx;
        float carry[4] = {0.f, 0.f, 0.f, 0.f}; asm volatile("" : "+v"(carry[0]), "+v"(carry[1]), "+v"(carry[2]), "+v"(carry[3]));
#pragma unroll 1
        for (int h = 0; h < 4; ++h) {
            u32x2 v[16]; f32x4 c[16];
#pragma unroll
            for (int n = 0; n < 16; ++n) { v[n] = *(const u32x2*)(st + (size_t)(16 * h + n) * 8192); c[n] = *(const f32x4*)(dc + (size_t)(16 * h + n) * 64); }
#pragma unroll
            for (int n = 0; n < 16; ++n) { u32x2 w; w.x = pk2(carry[0], carry[1]); w.y = pk2(carry[2], carry[3]); *(u32x2*)(sp + (size_t)(16 * h + n) * 8192) = w;
                carry[0] = c[n].x * carry[0] + bflo(v[n].x); carry[1] = c[n].y * carry[1] + bfhi(v[n].x); carry[2] = c[n].z * carry[2] + bflo(v[n].y); carry[3] = c[n].w * carry[3] + bfhi(v[n].y);
                asm volatile("" : "+v"(carry[0]), "+v"(carry[1]), "+v"(carry[2]), "+v"(carry[3])); }
        }
    }
}
constexpr int S5_WL = 18432, S5_BU = 2048, S5_X = 2048 + 10240;
constexpr int S5_BP = 20, S5_XP = 24;
template <bool OUT>
__device__ __forceinline__ void s5_pass(Frame& F, int l) {
    LAS bf16_t* UT = (LAS bf16_t*)(F.lds + F.wave * S5_WL); LAS float* BUT = (LAS float*)(F.lds + F.wave * S5_WL + S5_BU); LAS bf16_t* XT = (LAS bf16_t*)(F.lds + F.wave * S5_WL + S5_X);
    const int gw = F.vcu * NWAVES + F.wave, NGW = F.G * NWAVES, lane = F.lane, lr = lane & 15, lq = lane >> 4;
    u32x4 ua, uc;
    { const int g = gw & 31, n = (gw >> 5) & 63, b = gw >> 11; const bf16_t* up = F.PROJ() + ((size_t)b * SEQ + (size_t)n * CH + lane) * LDP + C_SU + g * 16; ua = *(const u32x4*)up; uc = *(const u32x4*)(up + 8); }
    const int g = gw & 31;
    const int gp = g * 64 + lane; const float ar = F.abar()[2 * gp], ai = F.abar()[2 * gp + 1];
    bf16x8 bfr[8];
#pragma unroll
    for (int q = 0; q < 8; ++q) { bfr[q] = (bf16x8){0, 0, 0, 0, 0, 0, 0, 0}; if (lq < 2) bfr[q] = *(const bf16x8*)(F.bbt() + ((size_t)g * 128 + 16 * q + lr) * 16 + 8 * lq); }
    bf16x8 cf[4]; f32x4 dsk = (f32x4){0.f, 0.f, 0.f, 0.f};
    if (OUT) {
#pragma unroll
        for (int ks = 0; ks < 4; ++ks) cf[ks] = *(const bf16x8*)(F.cmt() + ((size_t)(g * 16 + lr)) * 128 + 32 * ks + 8 * lq);
        dsk = *(const f32x4*)(F.s5_d() + (size_t)l * BW + g * 16 + 4 * lq); }
    for (int unit = gw; unit < BATCH * NCH * 32; unit += NGW) {
        const int n = (unit >> 5) & 63, b = unit >> 11; const size_t row0 = (size_t)b * SEQ + (size_t)n * CH;
        *(LAS u32x4*)(UT + lane * 16) = ua; *(LAS u32x4*)(UT + lane * 16 + 8) = uc;
        if (unit + NGW < BATCH * NCH * 32) { const int un = unit + NGW, g2 = un & 31, n2 = (un >> 5) & 63, b2 = un >> 11;
            const bf16_t* up = F.PROJ() + ((size_t)b2 * SEQ + (size_t)n2 * CH + lane) * LDP + C_SU + g2 * 16; ua = *(const u32x4*)up; uc = *(const u32x4*)(up + 8); }
        float xr = 0.f, xi = 0.f;
        if (OUT) { const f32x2 x0 = *(const f32x2*)(F.XEND() + ((((size_t)(b * 32 + g)) * NCH + n) * 64 + lane) * 2); xr = x0.x; xi = x0.y; }
        LDS_WAIT();
        for (int sb = 0; sb < 4; ++sb) {
            bf16x8 af = (bf16x8){0, 0, 0, 0, 0, 0, 0, 0}; if (lq < 2) af = *(const LAS bf16x8*)(UT + (16 * sb + lr) * 16 + 8 * lq);
#pragma unroll
            for (int q = 0; q < 8; ++q) { f32x4 acc = (f32x4){0.f, 0.f, 0.f, 0.f}; acc = __builtin_amdgcn_mfma_f32_16x16x32_bf16(af, bfr[q], acc, 0, 0, 0);
                *(LAS f32x4*)(BUT + (16 * q + lr) * S5_BP + 4 * lq) = acc; }
            LDS_WAIT();
            float br[16], bi[16];
#pragma unroll
            for (int t4 = 0; t4 < 4; ++t4) { const f32x4 r4 = *(const LAS f32x4*)(BUT + lane * S5_BP + 4 * t4), i4 = *(const LAS f32x4*)(BUT + (64 + lane) * S5_BP + 4 * t4);
                br[4 * t4] = r4.x; br[4 * t4 + 1] = r4.y; br[4 * t4 + 2] = r4.z; br[4 * t4 + 3] = r4.w; bi[4 * t4] = i4.x; bi[4 * t4 + 1] = i4.y; bi[4 * t4 + 2] = i4.z; bi[4 * t4 + 3] = i4.w; }
            float sr[16], si[16];
#pragma unroll
            for (int tt = 0; tt < 16; ++tt) { const float nr = ar * xr - ai * xi + br[tt], ni = ar * xi + ai * xr + bi[tt]; xr = nr; xi = ni; asm volatile("" : "+v"(xr), "+v"(xi)); sr[tt] = xr; si[tt] = xi; }
            if (OUT) {
                u32x4 w0, w1, w2, w3;
                w0.x = pg8::cvt_pk_bf16(sr[0], sr[1]); w0.y = pg8::cvt_pk_bf16(sr[2], sr[3]); w0.z = pg8::cvt_pk_bf16(sr[4], sr[5]); w0.w = pg8::cvt_pk_bf16(sr[6], sr[7]);
                w1.x = pg8::cvt_pk_bf16(sr[8], sr[9]); w1.y = pg8::cvt_pk_bf16(sr[10], sr[11]); w1.z = pg8::cvt_pk_bf16(sr[12], sr[13]); w1.w = pg8::cvt_pk_bf16(sr[14], sr[15]);
                w2.x = pg8::cvt_pk_bf16(si[0], si[1]); w2.y = pg8::cvt_pk_bf16(si[2], si[3]); w2.z = pg8::cvt_pk_bf16(si[4], si[5]); w2.w = pg8::cvt_pk_bf16(si[6], si[7]);
                w3.x = pg8::cvt_pk_bf16(si[8], si[9]); w3.y = pg8::cvt_pk_bf16(si[10], si[11]); w3.z = pg8::cvt_pk_bf16(si[12], si[13]); w3.w = pg8::cvt_pk_bf16(si[14], si[15]);
                *(LAS u32x4*)(XT + lane * S5_XP) = w0; *(LAS u32x4*)(XT + lane * S5_XP + 8) = w1; *(LAS u32x4*)(XT + (64 + lane) * S5_XP) = w2; *(LAS u32x4*)(XT + (64 + lane) * S5_XP + 8) = w3;
                LDS_WAIT();
                f32x4 acc = (f32x4){0.f, 0.f, 0.f, 0.f};
#pragma unroll
                for (int ks = 0; ks < 4; ++ks) acc = __builtin_amdgcn_mfma_f32_16x16x32_bf16(cf[ks], tr_frag(XT, S5_XP, 32 * ks, 0, lane), acc, 0, 0, 0);
                const u32x2 uw = *(const LAS u32x2*)(UT + (16 * sb + lr) * 16 + 4 * lq);
                const float y0 = gelu_tanh(acc[0] + dsk.x * bflo(uw.x)), y1 = gelu_tanh(acc[1] + dsk.y * bfhi(uw.x)), y2 = gelu_tanh(acc[2] + dsk.z * bflo(uw.y)), y3 = gelu_tanh(acc[3] + dsk.w * bfhi(uw.y));
                u32x2 ow; ow.x = pg8::cvt_pk_bf16(y0, y1); ow.y = pg8::cvt_pk_bf16(y2, y3);
                *(u32x2*)(F.YBP() + (row0 + 16 * sb + lr) * BW + g * 16 + 4 * lq) = ow;
            }
            LDS_WAIT();
        }
        if (!OUT) *(f32x2*)(F.XEND() + ((((size_t)(b * 32 + g)) * NCH + n) * 64 + lane) * 2) = (f32x2){xr, xi};
    }
}
__device__ __forceinline__ void s5_scan(Frame& F) {
    const int gt = F.vcu * (NWAVES * 64) + F.tid, NGT = F.G * NWAVES * 64;
    for (int i = gt; i < BATCH * 32 * 64; i += NGT) {
        const int p = i & 63, bg = i >> 6, g = bg & 31; const float pr = F.apow()[2 * (g * 64 + p)], pi = F.apow()[2 * (g * 64 + p) + 1];
        f32x2* xp = (f32x2*)(F.XEND() + (((size_t)bg * NCH) * 64 + p) * 2);
        float cr = 0.f, ci = 0.f; asm volatile("" : "+v"(cr), "+v"(ci));
#pragma unroll
        for (int h = 0; h < 2; ++h) {
            f32x2 v[32];
#pragma unroll
            for (int n = 0; n < 32; ++n) v[n] = xp[(size_t)(32 * h + n) * 64];
#pragma unroll
            for (int n = 0; n < 32; ++n) { xp[(size_t)(32 * h + n) * 64] = (f32x2){cr, ci};
                const float nr = pr * cr - pi * ci + v[n].x, ni = pr * ci + pi * cr + v[n].y; cr = nr; ci = ni; asm volatile("" : "+v"(cr), "+v"(ci)); }
        }
    }
}

constexpr int PWP = 136;
constexpr int PL_SC = 4 * 128 * PWP * 2;
template <int CTRL> __device__ __forceinline__ float dppf(float x) { return __builtin_bit_cast(float, __builtin_amdgcn_update_dpp(0, __builtin_bit_cast(int, x), CTRL, 0xf, 0xf, true)); }
template <int SH> __device__ __forceinline__ void pool_step(float (&c)[8], float (&p)[8], float mk) {
#pragma unroll
    for (int j = 0; j < 8; ++j) { const float nc = c[j] + dppf<0x110 + SH>(c[j]) + mk * dppf<0x120 + SH>(p[j]);
        p[j] = p[j] + dppf<0x110 + SH>(p[j]); c[j] = nc; }
}
__device__ __forceinline__ void pool_phase(Frame& F, int l) {
    const int gw = F.vcu * NWAVES + F.wave, NGW = F.G * NWAVES, lane = F.lane, lr = lane & 15, lq = lane >> 4;
    LAS bf16_t* PW = (LAS bf16_t*)F.lds; LAS float* PS = (LAS float*)(F.lds + PL_SC);
    wg_sync();
    for (int i = F.tid; i < 4 * 128 * 16; i += NWAVES * 64) { const int rowi = i >> 4, ch = i & 15; *(LAS u32x4*)(PW + rowi * PWP + 8 * ch) = *(const u32x4*)(F.poolw_t() + (size_t)rowi * 128 + 8 * ch); }
    if (F.tid < 128) *(LAS f32x4*)(PS + 4 * F.tid) = *(const f32x4*)(F.pool_scale() + (size_t)l * BW + 4 * F.tid);
    lds_sync();
    const int g = gw & 3, win = 2 << g;
    const int erow = 8 * (lr >> 2) + (lr & 3);
    for (int unit = gw; unit < BATCH * (SEQ / 16) * 4; unit += NGW) {
        const int tile = (unit >> 2) & 255, b = unit >> 10; const int tpos = 16 * tile + lr; const size_t row = (size_t)b * SEQ + tpos;
        const bf16_t* pp = F.PROJ() + row * LDP + C_PU + g * 128 + 8 * lq;
        u32x4 cur[4], prv[4];
#pragma unroll
        for (int ks = 0; ks < 4; ++ks) { cur[ks] = *(const u32x4*)(pp + 32 * ks); prv[ks] = (u32x4){0u, 0u, 0u, 0u}; }
        if (tile > 0) {
#pragma unroll
            for (int ks = 0; ks < 4; ++ks) prv[ks] = *(const u32x4*)(pp - (size_t)16 * LDP + 32 * ks); }
        const float inv = 1.0f / (float)min(tpos + 1, win);
        const float mk1 = lr < 1 ? 1.f : 0.f, mk2 = lr < 2 ? 1.f : 0.f, mk4 = lr < 4 ? 1.f : 0.f, mk8 = lr < 8 ? 1.f : 0.f;
        bf16x8 mf[4];
#pragma unroll
        for (int ks = 0; ks < 4; ++ks) { float a[8], c[8], p[8], m[8]; unpack8(cur[ks], a); unpack8(prv[ks], p);
#pragma unroll
            for (int j = 0; j < 8; ++j) c[j] = a[j];
            pool_step<1>(c, p, mk1);
            if (win > 2) pool_step<2>(c, p, mk2);
            if (win > 4) pool_step<4>(c, p, mk4);
            if (win > 8) pool_step<8>(c, p, mk8);
#pragma unroll
            for (int j = 0; j < 8; ++j) m[j] = c[j] * inv - a[j];
            const u32x4 w = pack8(m); mf[ks] = __builtin_bit_cast(bf16x8, w); }
        bf16_t* yp = F.Y() + row * D + 1536 + g * 128 + 8 * lq;
        int woff = (g * 128 + erow) * PWP + 8 * lq; asm volatile("" : "+v"(woff));
#pragma unroll
        for (int pe = 0; pe < 4; ++pe) { f32x4 acc[2];
#pragma unroll
            for (int hh = 0; hh < 2; ++hh) { acc[hh] = (f32x4){0.f, 0.f, 0.f, 0.f}; const LAS bf16_t* wr_ = PW + woff + (32 * pe + 4 * hh) * PWP;
#pragma unroll
                for (int ks = 0; ks < 4; ++ks) acc[hh] = __builtin_amdgcn_mfma_f32_16x16x32_bf16(*(const LAS bf16x8*)(wr_ + 32 * ks), mf[ks], acc[hh], 0, 0, 0); }
            const f32x4 s0 = *(const LAS f32x4*)(PS + g * 128 + 32 * pe + 8 * lq), s1 = *(const LAS f32x4*)(PS + g * 128 + 32 * pe + 8 * lq + 4);
            u32x4 w; w.x = pk2(acc[0][0] * s0.x, acc[0][1] * s0.y); w.y = pk2(acc[0][2] * s0.z, acc[0][3] * s0.w); w.z = pk2(acc[1][0] * s1.x, acc[1][1] * s1.y); w.w = pk2(acc[1][2] * s1.z, acc[1][3] * s1.w);
            *(u32x4*)(yp + 32 * pe) = w; }
    }
}

__device__ __forceinline__ void conv_fix_phase(Frame& F, int l) {
    const float* cw = F.conv_w() + (size_t)l * 3 * NUP; const float* cb = F.conv_b() + (size_t)l * NUP; const float* UH = F.UH();
    const int gt = F.vcu * (NWAVES * 64) + F.tid, NGT = F.G * NWAVES * 64;
    constexpr int JG = DFF / 4;
    for (int task = gt; task < (M / 256) * 2 * JG; task += NGT) {
        const int jg = task % JG, q = (task / JG) & 1, pm = task / (2 * JG);
        if ((pm & 15) == 0) continue;
        const int j0 = jg * 4, ucol = 256 * (j0 >> 7) + (j0 & 127);
        const float* u0p = UH + ((size_t)pm * 4 + q) * NUP + ucol;
        const float* u1p = (q == 1) ? UH + ((size_t)pm * 4 + 0) * NUP + ucol : UH + ((size_t)(pm - 1) * 4 + 3) * NUP + ucol;
        const float* u2p = (q == 1) ? UH + ((size_t)(pm - 1) * 4 + 3) * NUP + ucol : UH + ((size_t)(pm - 1) * 4 + 2) * NUP + ucol;
        const f32x4 a0 = *(const f32x4*)u0p, a1 = *(const f32x4*)u1p, a2 = *(const f32x4*)u2p, v0 = *(const f32x4*)(u0p + 128), v1 = *(const f32x4*)(u1p + 128), v2 = *(const f32x4*)(u2p + 128);
        const f32x4 wa0 = *(const f32x4*)(cw + j0), wa1 = *(const f32x4*)(cw + NUP + j0), wa2 = *(const f32x4*)(cw + 2 * NUP + j0), ba = *(const f32x4*)(cb + j0);
        const f32x4 wv0 = *(const f32x4*)(cw + DFF + j0), wv1 = *(const f32x4*)(cw + NUP + DFF + j0), wv2 = *(const f32x4*)(cw + 2 * NUP + DFF + j0), bv = *(const f32x4*)(cb + DFF + j0);
        float o[4];
#pragma unroll
        for (int i = 0; i < 4; ++i) { const float ca = ba[i] + wa0[i] * a2[i] + wa1[i] * a1[i] + wa2[i] * a0[i], cv = bv[i] + wv0[i] * v2[i] + wv1[i] * v1[i] + wv2[i] * v0[i]; o[i] = siluf_(ca) * cv; }
        u32x2 w; w.x = pk2(o[0], o[1]); w.y = pk2(o[2], o[3]);
        *(u32x2*)(F.ACT() + ((size_t)pm * 256 + q) * DFF + j0) = w;
    }
}

constexpr int NPH = 13;
struct Args { const void* in[25]; float* out; unsigned char* ws; int l_lo, l_hi, ph_lo, ph_hi, single, pad; };
__global__ void __launch_bounds__(NWAVES * 64, 2) hybrid_fwd(Args args) {
    extern __shared__ __attribute__((aligned(16))) unsigned char lds[];
    Frame F;
    F.lds = (LAS unsigned char*)lds;
    F.tid = threadIdx.x; F.lane = F.tid & 63; F.wave = __builtin_amdgcn_readfirstlane(F.tid >> 6);
    const int wave0 = F.wave;
    F.G = gridDim.x; { const int bx = blockIdx.x; F.vcu = (F.G % 8 == 0) ? (bx % 8) * (F.G / 8) + bx / 8 : bx; }
    unsigned char* ws = args.ws; F.ws = ws; F.out = args.out; F.l = 0;

    volatile LAS unsigned* MISC = (volatile LAS unsigned*)(F.lds + MISC_OFF);
    if (F.tid < 64) MISC[F.tid] = 0u;
    wg_sync();
    unsigned* ctl = (unsigned*)(ws + WS_CTL);
    XcdBarrier bar; bar.bar = ctl + CW_BAR; bar.x = 0; bar.st = nullptr;
    if (args.single) bar = xcd_barrier_post(ctl + CW_BAR, MISC);
#define GRID_BAR() do { if (args.single) xcd_barrier(bar); } while (0)
    const int lo = args.ph_lo, hi = args.ph_hi;
#define IN(k) (lo <= (k) && (k) < hi)
#define PH_BEGIN() do { unsigned z_ = 0u; asm volatile("" : "+v"(z_)); const int ln_ = (int)__builtin_amdgcn_mbcnt_hi(~0u, __builtin_amdgcn_mbcnt_lo(~0u, z_)); F.lane = ln_; F.tid = wave0 * 64 + ln_; F.wave = wave0; unsigned long long w_ = (unsigned long long)args.ws, o_ = (unsigned long long)args.out; asm volatile("" : "+s"(w_), "+s"(o_)); F.ws = (unsigned char*)(GAS unsigned char*)w_; F.out = (float*)(GAS float*)o_; } while (0)

    for (int l = args.l_lo; l < args.l_hi; ++l) {
        F.l = l;
        if (IN(0)) { PH_BEGIN(); phase_prep(F, l); GRID_BAR(); }
        if (IN(1)) { PH_BEGIN();
            { pg8::Gemm g{(const bf16_t*)F.HN8(), (const bf16_t*)F.W8(), M, 4 * D, D / 2, D / 2, D / 2}; pg8::StaticOrder S; S.init(M, 4 * D, F.G, (int)blockIdx.x); pg8::EpiProj E{F.PROJ(), LDP, 0, F.GF(), 1.0f / 64.0f};
              pg8::gemm_phase<pg8::EpiProj, true>(F.lds, g, S, E, F.tid); }
            PH_BEGIN();
            { pg8::Gemm g{F.HN(), F.win_t(), M, C_GR, D, D, D}; pg8::StaticOrder S; S.init(M, C_GR, F.G, (int)blockIdx.x); pg8::EpiProj E{F.PROJ(), LDP, 1 << 20, F.GF(), 1.0f};
              pg8::gemm_phase(F.lds, g, S, E, F.tid); }
            PH_BEGIN(); gr_pass(F);
            GRID_BAR(); }
        if (IN(2)) { PH_BEGIN(); lin2_phase<false>(F, l); PH_BEGIN();
            s5_pass<false>(F, l); pool_phase(F, l); wg_sync();
            GRID_BAR(); }
        if (IN(3)) { PH_BEGIN(); lin_scan(F); s5_scan(F); GRID_BAR(); }
        if (IN(4)) { PH_BEGIN(); lin2_phase<true>(F, l); PH_BEGIN();
            s5_pass<true>(F, l); wg_sync();
            GRID_BAR(); }
        if (IN(5)) { PH_BEGIN(); pg8::Gemm g{F.YBP(), F.wglu_t(), M, BW, BW, BW, BW}; pg8::StaticOrder S; S.init(M, BW, F.G, (int)blockIdx.x); pg8::EpiGlu E{F.YBP(), BW, F.Y() + BW, D};
            pg8::gemm_phase(F.lds, g, S, E, F.tid); GRID_BAR(); }
        if (IN(6)) { PH_BEGIN(); for (int i = 0; i < (F.vcu & 7); ++i) __builtin_amdgcn_s_sleep(56);
            pg8::Gemm g{F.Y(), F.wbr_t(), M, D, D, D, D}; pg8::StaticOrder S; S.init(M, D, F.G, (int)blockIdx.x); pg8::EpiMerge E{F.GF(), F.HN(), D};
            pg8::gemm_phase(F.lds, g, S, E, F.tid); GRID_BAR(); }
        if (IN(7)) { PH_BEGIN(); for (int i = 0; i < (F.vcu & 7); ++i) __builtin_amdgcn_s_sleep(50);
            pg8::Gemm g{F.HN(), F.wout_t(), M, D, D, D, D}; pg8::StaticOrder S; S.init(M, D, F.G, (int)blockIdx.x); pg8::EpiResid E{l == 0 ? (const void*)F.x() : (const void*)F.out, l == 0 ? 1 : 0, F.Y(), D, F.SS()};
            pg8::gemm_phase(F.lds, g, S, E, F.tid); GRID_BAR(); }
        if (IN(8)) { PH_BEGIN(); row_scale(F); GRID_BAR(); }
        if (IN(9)) { PH_BEGIN(); pg8::Gemm g{F.Y(), F.wup_t(), M, NUP, D, D, D}; pg8::StaticOrder S; S.init(M, NUP, F.G, (int)blockIdx.x); pg8::EpiConv E{F.conv_w() + (size_t)l * 3 * NUP, F.conv_b() + (size_t)l * NUP, F.ACT(), F.UH(), (LAS float*)(F.lds + pg8::STAGE_BYTES), F.RS()};
            pg8::gemm_phase(F.lds, g, S, E, F.tid); GRID_BAR(); }
        if (IN(10)) { PH_BEGIN(); conv_fix_phase(F, l); GRID_BAR(); }
        if (IN(11)) { PH_BEGIN(); for (int i = 0; i < (F.vcu & 7); ++i) __builtin_amdgcn_s_sleep(50);
            pg8::Gemm g{F.ACT(), F.wdn_t(), M, D, DFF, DFF, DFF}; pg8::StaticOrder S; S.init(M, D, F.G, (int)blockIdx.x); pg8::EpiResid E{(const void*)F.Y(), 0, l == DEPTH - 1 ? F.HN() : (bf16_t*)F.out, D, nullptr};
            pg8::gemm_phase(F.lds, g, S, E, F.tid); GRID_BAR(); }
        if (IN(12) && l == DEPTH - 1) { PH_BEGIN(); rms_rows16_to_f32(F, F.HN(), F.g_final(), F.out); }
    }
#undef IN
#undef PH_BEGIN
#undef GRID_BAR
}

#pragma clang attribute pop
extern "C" void kernel_launch(void* const* d_in, const int* in_sizes, int n_in, void* d_out, int out_size, void* d_ws, size_t ws_size, hipStream_t stream) {
    static int grid = 0;
    if (grid == 0) {
        if (n_in != 25 || in_sizes[0] != M * D || out_size != M * D || ws_size < WS_END) { fprintf(stderr, "kernel_launch: shape/workspace mismatch (n_in %d, in0 %d, out %d, ws %zu, need %zu); nothing launched\n", n_in, n_in > 0 ? in_sizes[0] : -1, out_size, ws_size, (size_t)WS_END); grid = -1; return; }
        int dev = 0, cus = 0, per_cu = 0;
        if (hipGetDevice(&dev) != hipSuccess || hipDeviceGetAttribute(&cus, hipDeviceAttributeMultiprocessorCount, dev) != hipSuccess) { grid = -1; return; }
        if (hipFuncSetAttribute((const void*)hybrid_fwd, hipFuncAttributeMaxDynamicSharedMemorySize, LDS_BYTES) != hipSuccess) { fprintf(stderr, "kernel_launch: hipFuncSetAttribute failed\n"); grid = -1; return; }
        if (hipOccupancyMaxActiveBlocksPerMultiprocessor(&per_cu, (const void*)hybrid_fwd, NWAVES * 64, LDS_BYTES) != hipSuccess || per_cu < 1) { fprintf(stderr, "kernel_launch: occupancy query reports %d workgroups per CU\n", per_cu); }
        (void)hipGetLastError();
        if (cus < 256) { fprintf(stderr, "kernel_launch: built for a 256-CU device (found %d CUs); nothing launched\n", cus); grid = -1; return; }
        grid = 256;
    }
    if (grid < 0) return;
    if (hipMemsetAsync((char*)d_ws + WS_CTL, 0, CTL_ZERO_BYTES, stream) != hipSuccess) return;
    Args a{};
    for (int i = 0; i < 25; ++i) a.in[i] = d_in[i];
    a.out = (float*)d_out; a.ws = (unsigned char*)d_ws;
#if MK_SINGLE
    a.l_lo = 0; a.l_hi = DEPTH; a.ph_lo = 0; a.ph_hi = NPH; a.single = 1;
    hipLaunchKernelGGL(hybrid_fwd, dim3(grid), dim3(NWAVES * 64), LDS_BYTES, stream, a);
#else
    a.single = 0;
    for (int l = 0; l < DEPTH; ++l)
        for (int p = 0; p < NPH; ++p) { if (p == 12 && l != DEPTH - 1) continue; a.l_lo = l; a.l_hi = l + 1; a.ph_lo = p; a.ph_hi = p + 1;
            hipLaunchKernelGGL(hybrid_fwd, dim3(grid), dim3(NWAVES * 64), LDS_BYTES, stream, a); }
#endif
}
```
